# Optimizing an MI355X kernel written in HIP

```python
import jax, jax.numpy as jnp
from jax import lax
import numpy as np

D_MODEL = 1024
BATCH = 8
SEQ = 2048
DEPTH = 2

GRID_W = 64
CTX_LEN = 256
N_MOD = 6
HEAD_DIM = 64
ROPE_BASE = 10000.0
Q_BLOCK = 128
EPS = 1e-6

MLA_HEADS = 4
MLA_Q_LORA = 256
MLA_KV_LORA = 128
MLA_NOPE = 64
MLA_ROPE = 32
MLA_V = 64
MLA_QK = MLA_NOPE + MLA_ROPE
MLA_COLS = MLA_Q_LORA + MLA_KV_LORA + MLA_ROPE
MLA_WIDTH = MLA_HEADS * MLA_V

RW_HEADS = 6
RW_N = 64
RW_WIDTH = RW_HEADS * RW_N
RW_DECAY_LORA = 64
RW_A_LORA = 64
RW_GATE_LORA = 160
RW_COLS = 3 * RW_WIDTH + 2 * RW_DECAY_LORA + 2 * RW_A_LORA + RW_GATE_LORA
RW_GN_EPS = 64e-5

GQA_HEADS = 6
GQA_KV_HEADS = 2
GQA_GROUP = GQA_HEADS // GQA_KV_HEADS
GQA_COLS = (GQA_HEADS + 2 * GQA_KV_HEADS) * HEAD_DIM
GQA_WIDTH = GQA_HEADS * HEAD_DIM

D_MIX = MLA_WIDTH + RW_WIDTH + GQA_WIDTH
IN_COLS = MLA_COLS + RW_COLS + GQA_COLS

PEER_HEADS = 8
PEER_NKEYS = 128
PEER_N = PEER_NKEYS * PEER_NKEYS
PEER_QDIM = 256
PEER_HALF = PEER_QDIM // 2
PEER_TOPK = 16
PEER_CHUNK = 128

kernel_name = "hybrid_mla_rwkv7_gqa_peer_dit"

F32 = jnp.float32


def rmsnorm(x, g, eps=EPS):
    x32 = x.astype(F32)
    y = x32 * lax.rsqrt(jnp.mean(x32 * x32, axis=-1, keepdims=True) + eps)
    return (y * g.astype(F32)).astype(x.dtype)


def modulate(h, shift, scale):
    return h * (1 + scale) + shift


def grid_positions(n_tokens):
    rows = n_tokens // GRID_W
    row = jnp.repeat(jnp.arange(rows, dtype=jnp.int32), GRID_W)
    col = jnp.tile(jnp.arange(GRID_W, dtype=jnp.int32), rows)
    return row, col


def rope_2d(x, row, col):
    rdim = x.shape[-1]
    quarter = rdim // 4
    inv_freq = ROPE_BASE ** (-jnp.arange(quarter, dtype=F32) / quarter)
    ang = jnp.concatenate([row.astype(F32)[:, None] * inv_freq,
                           col.astype(F32)[:, None] * inv_freq], axis=-1)
    cos = jnp.cos(ang)[:, None, :]
    sin = jnp.sin(ang)[:, None, :]
    x32 = x.astype(F32)
    xa, xb = x32[..., :rdim // 2], x32[..., rdim // 2:]
    return jnp.concatenate([xa * cos - xb * sin, xa * sin + xb * cos], axis=-1).astype(x.dtype)


def attend(q, k, v):
    B, T, Hkv, G, dq = q.shape
    scale = dq ** -0.5
    nb = T // Q_BLOCK
    qb = jnp.moveaxis(q.reshape(B, nb, Q_BLOCK, Hkv, G, dq), 1, 0)

    def one_block(qblk):
        s = jnp.einsum('bqhgd,bkhd->bhgqk', qblk, k).astype(F32) * scale
        p = jax.nn.softmax(s, axis=-1).astype(v.dtype)
        return jnp.einsum('bhgqk,bkhd->bqhgd', p, v)

    o = lax.map(one_block, qb)
    return jnp.moveaxis(o, 0, 1).reshape(B, T, Hkv * G * v.shape[-1])


def mla_project(p, q_norm_g, w_qb, kv_norm_g, w_kvb, qk_g):
    B, T, _ = p.shape
    cq, ckv, k_rope = jnp.split(p, [MLA_Q_LORA, MLA_Q_LORA + MLA_KV_LORA], axis=-1)
    q = (rmsnorm(cq, q_norm_g) @ w_qb).reshape(B, T, MLA_HEADS, MLA_QK)
    kv = (rmsnorm(ckv, kv_norm_g) @ w_kvb).reshape(B, T, MLA_HEADS, MLA_NOPE + MLA_V)
    k_nope, v = kv[..., :MLA_NOPE], kv[..., MLA_NOPE:]
    k = jnp.concatenate([k_nope, jnp.broadcast_to(k_rope[:, :, None, :], (B, T, MLA_HEADS, MLA_ROPE))], axis=-1)
    return rmsnorm(q, qk_g[0]), rmsnorm(k, qk_g[1]), v


def mla_mixer(p_lat, p_ctx, row, col, q_norm_g, w_qb, kv_norm_g, w_kvb, qk_g, need_ctx):
    ql, kl, vl = mla_project(p_lat, q_norm_g, w_qb, kv_norm_g, w_kvb, qk_g)
    qc, kc, vc = mla_project(p_ctx, q_norm_g, w_qb, kv_norm_g, w_kvb, qk_g)
    ql = jnp.concatenate([ql[..., :MLA_NOPE], rope_2d(ql[..., MLA_NOPE:], row, col)], axis=-1)
    kl = jnp.concatenate([kl[..., :MLA_NOPE], rope_2d(kl[..., MLA_NOPE:], row, col)], axis=-1)
    k_all = jnp.concatenate([kc, kl], axis=1)
    v_all = jnp.concatenate([vc, vl], axis=1)
    o_lat = attend(ql[:, :, :, None, :], k_all, v_all)
    o_ctx = attend(qc[:, :, :, None, :], kc, vc) if need_ctx else None
    return o_lat, o_ctx


def token_shift(p, mu):
    prev = jnp.pad(p, ((0, 0), (1, 0), (0, 0)))[:, :-1]
    nxt = jnp.pad(p, ((0, 0), (0, 1), (0, 0)))[:, 1:]
    return p + mu[0] * (prev - p) + mu[1] * (nxt - p)


def rwkv_prep(p, mu, w0, w2, a0, a2, g2, k_k, k_a):
    B, T, _ = p.shape
    xs = token_shift(p, mu)
    W, DL, AL = RW_WIDTH, RW_DECAY_LORA, RW_A_LORA
    r, k, v, wl, al, gl = jnp.split(xs, [W, 2 * W, 3 * W, 3 * W + 2 * DL, 3 * W + 2 * DL + 2 * AL], axis=-1)
    wl = wl.reshape(B, T, 2, DL)
    al = al.reshape(B, T, 2, AL)
    w_raw = (w0 + jnp.einsum('btdr,drc->btdc', jnp.tanh(wl), w2)).astype(F32)
    decay = jnp.exp(-jnp.exp(-jax.nn.softplus(-w_raw) - 0.5))
    a = jax.nn.sigmoid((a0 + jnp.einsum('btdr,drc->btdc', al, a2)).astype(F32))
    heads = lambda t: t.reshape(*t.shape[:-1], RW_HEADS, RW_N)
    kk = heads((k * k_k).astype(F32))
    kk = kk * lax.rsqrt(jnp.sum(kk * kk, axis=-1, keepdims=True) + 1e-12)
    a_h = heads(a)
    k_dir = heads(k.astype(F32))[:, :, None] * (1 + (a_h - 1) * heads(k_a.astype(F32)))
    b_dir = kk[:, :, None] * a_h
    g = jax.nn.sigmoid(gl) @ g2
    return heads(r), heads(decay), k_dir, heads(v), kk, b_dir, g


def rwkv_scan(s0, r, decay, k, v, kk, b, reverse, with_outputs):
    xs = tuple(jnp.moveaxis(t.astype(F32), 1, 0) for t in (r, decay, k, v, kk, b))

    def step(S, inp):
        r_t, w_t, k_t, v_t, kk_t, b_t = inp
        s_kk = jnp.einsum('bhij,bhj->bhi', S, kk_t)
        S = S * w_t[:, :, None, :] - s_kk[..., :, None] * b_t[:, :, None, :] + v_t[..., :, None] * k_t[:, :, None, :]
        y = jnp.einsum('bhij,bhj->bhi', S, r_t) if with_outputs else None
        return S, y

    s_final, ys = lax.scan(step, s0, xs, reverse=reverse)
    return s_final, (jnp.moveaxis(ys, 0, 1) if with_outputs else None)


def rwkv_readout(y, r, k_dir, v, g, r_k, ln_g, ln_b, dtype):
    B, T, H, N = y.shape
    mean = jnp.mean(y, axis=-1, keepdims=True)
    var = jnp.mean((y - mean) ** 2, axis=-1, keepdims=True)
    yn = ((y - mean) * lax.rsqrt(var + RW_GN_EPS)).reshape(B, T, H * N) * ln_g + ln_b
    coef = jnp.sum(r[:, :, None].astype(F32) * k_dir * r_k.astype(F32), axis=(2, 4))[..., None]
    bonus = (coef * v.astype(F32)).reshape(B, T, H * N)
    return ((yn + bonus) * g).astype(dtype)


def rwkv_mixer(p_lat, p_ctx, mu, w0, w2, a0, a2, g2, k_k, k_a, r_k, ln_g, ln_b, need_ctx):
    lr, ldec, lk, lv, lkk, lb, lg = rwkv_prep(p_lat, mu, w0, w2, a0, a2, g2, k_k, k_a)
    cr, cdec, ck, cv, ckk, cb, cg = rwkv_prep(p_ctx, mu, w0, w2, a0, a2, g2, k_k, k_a)
    B = p_lat.shape[0]
    s0 = jnp.zeros((B, RW_HEADS, RW_N, RW_N), F32)
    ys_lat, ys_ctx = [], []
    for d in range(2):
        rev = d == 1
        s_ctx, y_c = rwkv_scan(s0, cr, cdec[:, :, d], ck[:, :, d], cv, ckk, cb[:, :, d], rev, need_ctx)
        _, y_l = rwkv_scan(s_ctx, lr, ldec[:, :, d], lk[:, :, d], lv, lkk, lb[:, :, d], rev, True)
        ys_lat.append(y_l)
        ys_ctx.append(y_c)
    o_lat = rwkv_readout(ys_lat[0] + ys_lat[1], lr, lk, lv, lg, r_k, ln_g, ln_b, p_lat.dtype)
    o_ctx = rwkv_readout(ys_ctx[0] + ys_ctx[1], cr, ck, cv, cg, r_k, ln_g, ln_b, p_ctx.dtype) if need_ctx else None
    return o_lat, o_ctx


def gqa_project(p, qk_g):
    B, T, _ = p.shape
    q, k, v = jnp.split(p, [GQA_HEADS * HEAD_DIM, (GQA_HEADS + GQA_KV_HEADS) * HEAD_DIM], axis=-1)
    q = rmsnorm(q.reshape(B, T, GQA_HEADS, HEAD_DIM), qk_g[0])
    k = rmsnorm(k.reshape(B, T, GQA_KV_HEADS, HEAD_DIM), qk_g[1])
    return q, k, v.reshape(B, T, GQA_KV_HEADS, HEAD_DIM)


def gqa_mixer(p_lat, p_ctx, row, col, qk_g, need_ctx):
    ql, kl, vl = gqa_project(p_lat, qk_g)
    qc, kc, vc = gqa_project(p_ctx, qk_g)
    ql = rope_2d(ql, row, col)
    kl = rope_2d(kl, row, col)
    B, T = ql.shape[:2]
    k_all = jnp.concatenate([kc, kl], axis=1)
    v_all = jnp.concatenate([vc, vl], axis=1)
    o_lat = attend(ql.reshape(B, T, GQA_KV_HEADS, GQA_GROUP, HEAD_DIM), k_all, v_all)
    o_ctx = attend(qc.reshape(B, qc.shape[1], GQA_KV_HEADS, GQA_GROUP, HEAD_DIM), kc, vc) if need_ctx else None
    return o_lat, o_ctx


def peer_ffn(h, w_q, sub_keys, u_tab, v_tab):
    B, T, D = h.shape
    chunks = h.reshape(-1, PEER_CHUNK, D)

    def one_chunk(xc):
        q = (xc @ w_q).reshape(PEER_CHUNK, PEER_HEADS, 2, PEER_HALF)
        s = jnp.einsum('cpsd,pskd->cpsk', q, sub_keys).astype(F32)
        s1, i1 = lax.top_k(s[:, :, 0], PEER_TOPK)
        s2, i2 = lax.top_k(s[:, :, 1], PEER_TOPK)
        cand_s = (s1[..., :, None] + s2[..., None, :]).reshape(PEER_CHUNK, PEER_HEADS, PEER_TOPK * PEER_TOPK)
        cand_i = (i1[..., :, None] * PEER_NKEYS + i2[..., None, :]).reshape(PEER_CHUNK, PEER_HEADS, PEER_TOPK * PEER_TOPK)
        top_s, pos = lax.top_k(cand_s, PEER_TOPK)
        e_idx = jnp.take_along_axis(cand_i, pos, axis=-1)
        gate = jax.nn.softmax(top_s, axis=-1)
        act = jax.nn.gelu(jnp.einsum('cd,cpkd->cpk', xc, u_tab[e_idx]).astype(F32))
        w = (gate * act).astype(xc.dtype)
        return jnp.einsum('cpk,cpkd->cd', w, v_tab[e_idx])

    return lax.map(one_chunk, chunks).reshape(B, T, D)


def setup_inputs(seed: int = 0) -> dict:
    key = jax.random.key(seed)
    ks = iter(jax.random.split(key, 40))
    nrm = lambda shape, scale: scale * jax.random.normal(next(ks), shape, F32)
    gain = lambda shape: 1.0 + 0.02 * jax.random.normal(next(ks), shape, F32)
    return {
        "x": nrm((BATCH, SEQ, D_MODEL), 1.0),
        "c": nrm((BATCH, D_MODEL), 1.0),
        "ctx": nrm((BATCH, CTX_LEN, D_MODEL), 1.0),
        "c_ctx": nrm((D_MODEL,), 1.0),
        "ada_w": nrm((DEPTH, D_MODEL, N_MOD * D_MODEL), 0.5 * D_MODEL ** -0.5),
        "ada_b": nrm((DEPTH, N_MOD * D_MODEL), 0.02),
        "norm_mix_g": gain((DEPTH, D_MODEL)),
        "norm_ffn_g": gain((DEPTH, D_MODEL)),
        "w_in": nrm((DEPTH, D_MODEL, IN_COLS), D_MODEL ** -0.5),
        "w_out": nrm((DEPTH, D_MIX, D_MODEL), D_MIX ** -0.5),
        "mla_q_norm_g": gain((DEPTH, MLA_Q_LORA)),
        "mla_w_qb": nrm((DEPTH, MLA_Q_LORA, MLA_HEADS * MLA_QK), MLA_Q_LORA ** -0.5),
        "mla_kv_norm_g": gain((DEPTH, MLA_KV_LORA)),
        "mla_w_kvb": nrm((DEPTH, MLA_KV_LORA, MLA_HEADS * (MLA_NOPE + MLA_V)), MLA_KV_LORA ** -0.5),
        "mla_qk_g": gain((DEPTH, 2, MLA_QK)),
        "rw_mu": jax.random.uniform(next(ks), (DEPTH, 2, RW_COLS), F32, 0.0, 0.5),
        "rw_w0": jax.random.uniform(next(ks), (DEPTH, 2, RW_WIDTH), F32, -6.0, 0.0),
        "rw_w2": nrm((DEPTH, 2, RW_DECAY_LORA, RW_WIDTH), 0.1),
        "rw_a0": nrm((DEPTH, 2, RW_WIDTH), 0.1),
        "rw_a2": nrm((DEPTH, 2, RW_A_LORA, RW_WIDTH), 0.1),
        "rw_g2": nrm((DEPTH, RW_GATE_LORA, RW_WIDTH), RW_GATE_LORA ** -0.5),
        "rw_k_k": 0.85 + nrm((DEPTH, RW_WIDTH), 0.02),
        "rw_k_a": gain((DEPTH, RW_WIDTH)),
        "rw_r_k": nrm((DEPTH, RW_HEADS, RW_N), 0.1),
        "rw_ln_g": gain((DEPTH, RW_WIDTH)),
        "rw_ln_b": nrm((DEPTH, RW_WIDTH), 0.02),
        "gqa_qk_g": gain((DEPTH, 2, HEAD_DIM)),
        "pe_wq": nrm((DEPTH, D_MODEL, PEER_HEADS * PEER_QDIM), D_MODEL ** -0.5),
        "pe_keys": nrm((DEPTH, PEER_HEADS, 2, PEER_NKEYS, PEER_HALF), PEER_HALF ** -0.5),
        "pe_u": nrm((DEPTH, PEER_N, D_MODEL), D_MODEL ** -0.5),
        "pe_v": nrm((DEPTH, PEER_N, D_MODEL), 0.3),
    }


def reference(x, c, ctx, c_ctx, ada_w, ada_b, norm_mix_g, norm_ffn_g, w_in, w_out,
              mla_q_norm_g, mla_w_qb, mla_kv_norm_g, mla_w_kvb, mla_qk_g,
              rw_mu, rw_w0, rw_w2, rw_a0, rw_a2, rw_g2, rw_k_k, rw_k_a, rw_r_k, rw_ln_g, rw_ln_b,
              gqa_qk_g, pe_wq, pe_keys, pe_u, pe_v):
    B = x.shape[0]
    row, col = grid_positions(x.shape[1])
    for l in range(DEPTH):
        need_ctx = l < DEPTH - 1
        m = (jax.nn.silu(c) @ ada_w[l] + ada_b[l]).reshape(B, N_MOD, 1, D_MODEL)
        mc = (jax.nn.silu(c_ctx) @ ada_w[l] + ada_b[l]).reshape(N_MOD, D_MODEL)
        p = modulate(rmsnorm(x, norm_mix_g[l]), m[:, 0], m[:, 1]) @ w_in[l]
        pc = modulate(rmsnorm(ctx, norm_mix_g[l]), mc[0], mc[1]) @ w_in[l]
        p_mla, p_rw, p_gqa = jnp.split(p, [MLA_COLS, MLA_COLS + RW_COLS], axis=-1)
        pc_mla, pc_rw, pc_gqa = jnp.split(pc, [MLA_COLS, MLA_COLS + RW_COLS], axis=-1)
        a_lat, a_ctx = mla_mixer(p_mla, pc_mla, row, col, mla_q_norm_g[l], mla_w_qb[l],
                                 mla_kv_norm_g[l], mla_w_kvb[l], mla_qk_g[l], need_ctx)
        r_lat, r_ctx = rwkv_mixer(p_rw, pc_rw, rw_mu[l], rw_w0[l], rw_w2[l], rw_a0[l], rw_a2[l],
                                  rw_g2[l], rw_k_k[l], rw_k_a[l], rw_r_k[l], rw_ln_g[l], rw_ln_b[l], need_ctx)
        g_lat, g_ctx = gqa_mixer(p_gqa, pc_gqa, row, col, gqa_qk_g[l], need_ctx)
        x = x + m[:, 2] * (jnp.concatenate([a_lat, r_lat, g_lat], axis=-1) @ w_out[l])
        x = x + m[:, 5] * peer_ffn(modulate(rmsnorm(x, norm_ffn_g[l]), m[:, 3], m[:, 4]),
                                   pe_wq[l], pe_keys[l], pe_u[l], pe_v[l])
        if need_ctx:
            ctx = ctx + mc[2] * (jnp.concatenate([a_ctx, r_ctx, g_ctx], axis=-1) @ w_out[l])
            ctx = ctx + mc[5] * peer_ffn(modulate(rmsnorm(ctx, norm_ffn_g[l]), mc[3], mc[4]),
                                         pe_wq[l], pe_keys[l], pe_u[l], pe_v[l])
    return x
```

```cpp
#include <hip/hip_runtime.h>
#ifndef BATCH
#define BATCH 8
#endif
#ifndef SEQ
#define SEQ 2048
#endif
#ifndef CTX_LEN
#define CTX_LEN 256
#endif
#define DM 1024
#define RB (SEQ + CTX_LEN)
#define NROWS (BATCH * RB)
#define IN_COLS 2624
#define MLA_OFF 0
#define RW_OFF 416
#define GQA_OFF 1984
#define RWC 1568
#define EPSN 1e-6f

__device__ inline float sigmoidf_(float x) { return 1.f / (1.f + expf(-x)); }
__device__ inline float siluf_(float x) { return x * sigmoidf_(x); }
__device__ inline float softplusf_(float x) { return fmaxf(x, 0.f) + log1pf(expf(-fabsf(x))); }
__device__ inline float geluf_(float x) { return 0.5f * x * (1.f + tanhf(0.7978845608028654f * (x + 0.044715f * x * x * x))); }

__global__ void nk_copy_in(const float* x, const float* ctx, float* xs) {
  long i = (long)blockIdx.x * blockDim.x + threadIdx.x;
  if (i >= (long)NROWS * DM) return;
  int d = i % DM; long row = i / DM; int b = row / RB, lr = row % RB;
  xs[i] = lr < SEQ ? x[((long)b * SEQ + lr) * DM + d] : ctx[((long)b * CTX_LEN + (lr - SEQ)) * DM + d];
}
__global__ void nk_copy_out(const float* xs, float* out) {
  long i = (long)blockIdx.x * blockDim.x + threadIdx.x;
  if (i >= (long)BATCH * SEQ * DM) return;
  int d = i % DM; long row = i / DM; int b = row / SEQ, t = row % SEQ;
  out[i] = xs[((long)b * RB + t) * DM + d];
}
__global__ void nk_mod(const float* c, const float* c_ctx, const float* ada_w, const float* ada_b, float* mod) {
  long i = (long)blockIdx.x * blockDim.x + threadIdx.x;
  if (i >= 2L * (BATCH + 1) * 6144) return;
  int j = i % 6144; int bb = (i / 6144) % (BATCH + 1); int l = i / (6144 * (BATCH + 1));
  const float* cv = bb < BATCH ? c + (long)bb * DM : c_ctx;
  const float* w = ada_w + (long)l * DM * 6144;
  float acc = 0.f;
  for (int k = 0; k < DM; ++k) acc += siluf_(cv[k]) * w[(long)k * 6144 + j];
  mod[i] = acc + ada_b[l * 6144 + j];
}
__global__ void nk_norm_mod(const float* xs, const float* g, const float* modl, int shift_idx, float* xn, int M, int bidx) {
  long row = (long)blockIdx.x * blockDim.x + threadIdx.x;
  if (row >= M) return;
  int lr = row % RB; int bb = lr < SEQ ? bidx : BATCH;
  const float* sh = modl + ((long)bb * 6 + shift_idx) * DM; const float* sc = sh + DM;
  const float* xr = xs + row * DM; float ss = 0.f;
  for (int d = 0; d < DM; ++d) ss += xr[d] * xr[d];
  float inv = 1.f / sqrtf(ss / DM + EPSN);
  for (int d = 0; d < DM; ++d) xn[row * DM + d] = xr[d] * inv * g[d] * (1.f + sc[d]) + sh[d];
}
__global__ void nk_gemm(const float* A, const float* W, float* C, int M, int N, int K) {
  long i = (long)blockIdx.x * blockDim.x + threadIdx.x;
  if (i >= (long)M * N) return;
  int n = i % N; long m = i / N; float acc = 0.f;
  for (int k = 0; k < K; ++k) acc += A[m * K + k] * W[(long)k * N + n];
  C[i] = acc;
}
__global__ void nk_mla_q1(const float* P, const float* qng, const float* wqb, float* tq, int M) {
  long i = (long)blockIdx.x * blockDim.x + threadIdx.x;
  if (i >= (long)M * 384) return;
  int j = i % 384; long r = i / 384; const float* cq = P + r * IN_COLS;
  float ss = 0.f; for (int k = 0; k < 256; ++k) ss += cq[k] * cq[k];
  float inv = 1.f / sqrtf(ss / 256 + EPSN), acc = 0.f;
  for (int k = 0; k < 256; ++k) acc += cq[k] * inv * qng[k] * wqb[k * 384 + j];
  tq[i] = acc;
}
__global__ void nk_mla_kv1(const float* P, const float* kvng, const float* wkvb, float* tkv, int M) {
  long i = (long)blockIdx.x * blockDim.x + threadIdx.x;
  if (i >= (long)M * 512) return;
  int j = i % 512; long r = i / 512; const float* ck = P + r * IN_COLS + 256;
  float ss = 0.f; for (int k = 0; k < 128; ++k) ss += ck[k] * ck[k];
  float inv = 1.f / sqrtf(ss / 128 + EPSN), acc = 0.f;
  for (int k = 0; k < 128; ++k) acc += ck[k] * inv * kvng[k] * wkvb[k * 512 + j];
  tkv[i] = acc;
}
__global__ void nk_mla_qk2(const float* P, const float* tq, const float* tkv, const float* qkg, float* mq, float* mk, int M) {
  long i = (long)blockIdx.x * blockDim.x + threadIdx.x;
  if (i >= (long)M * 8) return;
  int which = i % 2, h = (i / 2) % 4; long r = i / 8; int lr = r % RB;
  float ss = 0.f;
  for (int e = 0; e < 96; ++e) {
    float v = which == 0 ? tq[r * 384 + h * 96 + e] : (e < 64 ? tkv[r * 512 + h * 128 + e] : P[r * IN_COLS + 384 + (e - 64)]);
    ss += v * v;
  }
  float inv = 1.f / sqrtf(ss / 96 + EPSN);
  const float* g = qkg + which * 96; float* o = (which == 0 ? mq : mk) + r * 384 + h * 96;
  for (int e = 0; e < 64; ++e) {
    float v = which == 0 ? tq[r * 384 + h * 96 + e] : tkv[r * 512 + h * 128 + e];
    o[e] = v * inv * g[e];
  }
  for (int j = 0; j < 16; ++j) {
    float va = which == 0 ? tq[r * 384 + h * 96 + 64 + j] : P[r * IN_COLS + 384 + j];
    float vb = which == 0 ? tq[r * 384 + h * 96 + 80 + j] : P[r * IN_COLS + 384 + 16 + j];
    va *= inv * g[64 + j]; vb *= inv * g[80 + j];
    if (lr < SEQ) {
      int pos = j < 8 ? lr / 64 : lr % 64; float fr = powf(10000.f, -(float)(j & 7) / 8.f);
      float ang = (float)pos * fr, cs = cosf(ang), sn = sinf(ang);
      o[64 + j] = va * cs - vb * sn; o[80 + j] = va * sn + vb * cs;
    } else { o[64 + j] = va; o[80 + j] = vb; }
  }
}
__global__ void nk_gqa_prep(const float* P, const float* qkg, float* gq, float* gk, int M) {
  long i = (long)blockIdx.x * blockDim.x + threadIdx.x;
  if (i >= (long)M * 8) return;
  int h = i % 8; long r = i / 8; int lr = r % RB;
  const float* src = P + r * IN_COLS + GQA_OFF + h * 64;
  const float* g = qkg + (h < 6 ? 0 : 64);
  float* o = h < 6 ? gq + r * 384 + h * 64 : gk + r * 128 + (h - 6) * 64;
  float ss = 0.f; for (int e = 0; e < 64; ++e) ss += src[e] * src[e];
  float inv = 1.f / sqrtf(ss / 64 + EPSN);
  for (int j = 0; j < 32; ++j) {
    float va = src[j] * inv * g[j], vb = src[32 + j] * inv * g[32 + j];
    if (lr < SEQ) {
      int pos = j < 16 ? lr / 64 : lr % 64; float fr = powf(10000.f, -(float)(j & 15) / 16.f);
      float ang = (float)pos * fr, cs = cosf(ang), sn = sinf(ang);
      o[j] = va * cs - vb * sn; o[32 + j] = va * sn + vb * cs;
    } else { o[j] = va; o[32 + j] = vb; }
  }
}
template <int DQ>
__global__ void __launch_bounds__(256) nk_attn(const float* q, int qs, const float* k, int ks, const float* v, int vs, int vhs, int H, int G, float* mix, int ooff, int M) {
  long i = (long)blockIdx.x * blockDim.x + threadIdx.x;
  if (i >= (long)M * H) return;
  int h = i % H; long r = i / H; int b = r / RB, lr = r % RB; int kh = h / G;
  float qv[DQ];
#pragma unroll
  for (int e = 0; e < DQ; ++e) qv[e] = q[r * qs + h * DQ + e];
  float acc[64];
#pragma unroll
  for (int e = 0; e < 64; ++e) acc[e] = 0.f;
  float mx = -1e30f, l = 0.f; const float scale = 1.f / sqrtf((float)DQ);
  int k0 = lr < SEQ ? 0 : SEQ, k1 = RB;
  for (int kr = k0; kr < k1; ++kr) {
    long rr = (long)b * RB + kr; const float* kp = k + rr * ks + kh * DQ; float s = 0.f;
#pragma unroll
    for (int e = 0; e < DQ; ++e) s += qv[e] * kp[e];
    s *= scale;
    float mn = fmaxf(mx, s), al = expf(mx - mn), pp = expf(s - mn);
    l = l * al + pp; mx = mn; const float* vp = v + rr * vs + kh * vhs;
#pragma unroll
    for (int e = 0; e < 64; ++e) acc[e] = acc[e] * al + pp * vp[e];
  }
#pragma unroll
  for (int e = 0; e < 64; ++e) mix[r * DM + ooff + h * 64 + e] = acc[e] / l;
}
__global__ void nk_rw_shift(const float* P, const float* mu, float* rwx, int M) {
  long i = (long)blockIdx.x * blockDim.x + threadIdx.x;
  if (i >= (long)M * RWC) return;
  int c = i % RWC; long r = i / RWC; int lr = r % RB;
  bool first = (lr == 0) || (lr == SEQ), last = (lr == SEQ - 1) || (lr == RB - 1);
  float p = P[r * IN_COLS + RW_OFF + c];
  float pv = first ? 0.f : P[(r - 1) * IN_COLS + RW_OFF + c], nx = last ? 0.f : P[(r + 1) * IN_COLS + RW_OFF + c];
  rwx[i] = p + mu[c] * (pv - p) + mu[RWC + c] * (nx - p);
}
__global__ void nk_rw_prep(const float* rwx, const float* w0, const float* w2, const float* a0, const float* a2, const float* g2,
                           const float* k_k, const float* k_a, float* dec, float* kd, float* bd, float* kk, float* gg, int M) {
  long i = (long)blockIdx.x * blockDim.x + threadIdx.x;
  if (i >= (long)M * 384) return;
  int c = i % 384; long r = i / 384; int h = c / 64; const float* xr = rwx + r * RWC;
  float kv = xr[384 + c];
  float ss = 0.f; for (int n = 0; n < 64; ++n) { float t = xr[384 + h * 64 + n] * k_k[h * 64 + n]; ss += t * t; }
  float kkv = kv * k_k[c] / sqrtf(ss + 1e-12f);
  kk[i] = kkv;
  for (int d = 0; d < 2; ++d) {
    float wr = w0[d * 384 + c], ar = a0[d * 384 + c];
    for (int j = 0; j < 64; ++j) { wr += tanhf(xr[1152 + d * 64 + j]) * w2[(d * 64 + j) * 384 + c]; ar += xr[1280 + d * 64 + j] * a2[(d * 64 + j) * 384 + c]; }
    float dc = expf(-expf(-softplusf_(-wr) - 0.5f)); float a = sigmoidf_(ar);
    dec[(long)d * M * 384 + i] = dc; kd[(long)d * M * 384 + i] = kv * (1.f + (a - 1.f) * k_a[c]); bd[(long)d * M * 384 + i] = kkv * a;
  }
  float g = 0.f; for (int j = 0; j < 160; ++j) g += sigmoidf_(xr[1408 + j]) * g2[j * 384 + c];
  gg[i] = g;
}
__global__ void __launch_bounds__(256) nk_rw_scan(const float* rwx, const float* dec, const float* kd, const float* bd, const float* kk, float* y, int M, int nb) {
  long t = (long)blockIdx.x * blockDim.x + threadIdx.x;
  if (t >= (long)nb * 2 * 6 * 64) return;
  int i = t % 64, h = (t / 64) % 6, d = (t / 384) % 2, b = t / 768;
  float S[64];
#pragma unroll
  for (int j = 0; j < 64; ++j) S[j] = 0.f;
  for (int step = 0; step < RB; ++step) {
    int lr;
    if (step < CTX_LEN) lr = SEQ + (d == 0 ? step : CTX_LEN - 1 - step);
    else lr = d == 0 ? step - CTX_LEN : SEQ - 1 - (step - CTX_LEN);
    long r = (long)b * RB + lr; long o = (long)d * M * 384 + r * 384 + h * 64;
    const float* rp = rwx + r * RWC + h * 64; const float* wp = dec + o; const float* kp = kd + o; const float* bp = bd + o; const float* kkp = kk + r * 384 + h * 64;
    float vi = rwx[r * RWC + 768 + h * 64 + i];
    float skk = 0.f;
#pragma unroll
    for (int j = 0; j < 64; ++j) skk += S[j] * kkp[j];
    float yy = 0.f;
#pragma unroll
    for (int j = 0; j < 64; ++j) { S[j] = S[j] * wp[j] - skk * bp[j] + vi * kp[j]; yy += S[j] * rp[j]; }
    y[o + i] = yy;
  }
}
__global__ void nk_rw_readout(const float* rwx, const float* y, const float* kd, const float* gg, const float* r_k, const float* ln_g, const float* ln_b, float* mix, int M, long yds) {
  long i = (long)blockIdx.x * blockDim.x + threadIdx.x;
  if (i >= (long)M * 6) return;
  int h = i % 6; long r = i / 6; long o = r * 384 + h * 64; long ds = (long)M * 384;
  float mean = 0.f; for (int n = 0; n < 64; ++n) mean += y[o + n] + y[yds + o + n];
  mean /= 64.f;
  float var = 0.f, coef = 0.f;
  for (int n = 0; n < 64; ++n) {
    float yy = y[o + n] + y[yds + o + n] - mean; var += yy * yy;
    coef += rwx[r * RWC + h * 64 + n] * (kd[o + n] + kd[ds + o + n]) * r_k[h * 64 + n];
  }
  var /= 64.f; float inv = 1.f / sqrtf(var + 64e-5f);
  for (int n = 0; n < 64; ++n) {
    float yn = (y[o + n] + y[yds + o + n] - mean) * inv * ln_g[h * 64 + n] + ln_b[h * 64 + n];
    mix[r * DM + 256 + h * 64 + n] = (yn + coef * rwx[r * RWC + 768 + h * 64 + n]) * gg[o + n];
  }
}
__global__ void nk_gemm_res(const float* A, const float* W, const float* modl, int gi, float* xs, int M, int bidx) {
  long i = (long)blockIdx.x * blockDim.x + threadIdx.x;
  if (i >= (long)M * DM) return;
  int j = i % DM; long r = i / DM; int lr = r % RB; int bb = lr < SEQ ? bidx : BATCH;
  float acc = 0.f; for (int k = 0; k < DM; ++k) acc += A[r * DM + k] * W[(long)k * DM + j];
  xs[i] += modl[((long)bb * 6 + gi) * DM + j] * acc;
}
__global__ void nk_peer_score(const float* pq, const float* keys, float* sc, int M) {
  long i = (long)blockIdx.x * blockDim.x + threadIdx.x;
  if (i >= (long)M * 2048) return;
  int k = i % 128, ps = (i / 128) % 16; long r = i / 2048;
  const float* q = pq + r * 2048 + ps * 128; const float* ky = keys + ((long)ps * 128 + k) * 128;
  float acc = 0.f; for (int d = 0; d < 128; ++d) acc += q[d] * ky[d];
  sc[i] = acc;
}
__global__ void nk_peer_top1(const float* sc, float* ts, int* ti, int M) {
  long i = (long)blockIdx.x * blockDim.x + threadIdx.x;
  if (i >= (long)M * 16) return;
  const float* s = sc + i * 128; float pv = 3e38f; int pi = -1;
  for (int t = 0; t < 16; ++t) {
    float bv = -3e38f; int bi = -1;
    for (int k = 0; k < 128; ++k) {
      float v = s[k]; bool ok = (v < pv) || (v == pv && k > pi);
      if (ok && (bi < 0 || v > bv)) { bv = v; bi = k; }
    }
    ts[i * 16 + t] = bv; ti[i * 16 + t] = bi; pv = bv; pi = bi;
  }
}
__global__ void nk_peer_top2(const float* ts, const int* ti, int* pe, float* pg, int M) {
  long i = (long)blockIdx.x * blockDim.x + threadIdx.x;
  if (i >= (long)M * 8) return;
  const float* s1 = ts + i * 32; const float* s2 = s1 + 16; const int* i1 = ti + i * 32; const int* i2 = i1 + 16;
  float pv = 3e38f; int pi = -1; float mx = 0.f, sum = 0.f;
  for (int t = 0; t < 16; ++t) {
    float bv = -3e38f; int bi = -1;
    for (int c = 0; c < 256; ++c) {
      float v = s1[c / 16] + s2[c % 16]; bool ok = (v < pv) || (v == pv && c > pi);
      if (ok && (bi < 0 || v > bv)) { bv = v; bi = c; }
    }
    if (t == 0) mx = bv;
    float e = expf(bv - mx); sum += e;
    pe[i * 16 + t] = i1[bi / 16] * 128 + i2[bi % 16]; pg[i * 16 + t] = e; pv = bv; pi = bi;
  }
  for (int t = 0; t < 16; ++t) pg[i * 16 + t] /= sum;
}
__global__ void nk_peer_act(const float* xn, const float* u, const int* pe, const float* pg, float* pw, int M) {
  long i = (long)blockIdx.x * blockDim.x + threadIdx.x;
  if (i >= (long)M * 128) return;
  long r = i / 128; const float* ur = u + (long)pe[i] * DM; const float* xr = xn + r * DM;
  float acc = 0.f; for (int d = 0; d < DM; ++d) acc += xr[d] * ur[d];
  pw[i] = pg[i] * geluf_(acc);
}
__global__ void nk_peer_out(const float* v, const int* pe, const float* pw, const float* modl, float* xs, int M, int bidx) {
  long i = (long)blockIdx.x * blockDim.x + threadIdx.x;
  if (i >= (long)M * DM) return;
  int j = i % DM; long r = i / DM; int lr = r % RB; int bb = lr < SEQ ? bidx : BATCH;
  float acc = 0.f; for (int k = 0; k < 128; ++k) acc += pw[r * 128 + k] * v[(long)pe[r * 128 + k] * DM + j];
  xs[i] += modl[((long)bb * 6 + 5) * DM + j] * acc;
}

#ifndef LAUNCH
#define LAUNCH(kern, nthreads, ...) kern<<<(unsigned)(((long)(nthreads) + 255) / 256), 256, 0, stream>>>(__VA_ARGS__)
#endif

struct NaiveIn {
  const float *x, *c, *ctx, *c_ctx, *ada_w, *ada_b, *norm_mix_g, *norm_ffn_g, *w_in, *w_out, *mla_q_norm_g, *mla_w_qb, *mla_kv_norm_g,
      *mla_w_kvb, *mla_qk_g, *rw_mu, *rw_w0, *rw_w2, *rw_a0, *rw_a2, *rw_g2, *rw_k_k, *rw_k_a, *rw_r_k, *rw_ln_g, *rw_ln_b, *gqa_qk_g,
      *pe_wq, *pe_keys, *pe_u, *pe_v;
};

static void naive_forward(const NaiveIn& I, float* out, float* ws, hipStream_t stream) {
  const long M = RB;
  float* p = ws;
  float* xs = p;  p += (long)NROWS * DM;
  float* mod = p; p += 2L * (BATCH + 1) * 6144;
  float* xn = p;  p += M * DM;
  float* P = p;   p += M * IN_COLS;
  float* mix = p; p += M * DM;
  float* big = p;
  float* tq = big;            float* tkv = tq + M * 384;  float* mq = tkv + M * 512; float* mk = mq + M * 384;
  float* gq = mk + M * 384;   float* gk = gq + M * 384;
  float* rwx = gk + M * 128;  float* dec = rwx + M * RWC; float* kd = dec + 2 * M * 384; float* bd = kd + 2 * M * 384;
  float* kk = bd + 2 * M * 384; float* gg = kk + M * 384; float* yy = gg + M * 384;
  float* pq = P; float* sc = big; float* ts = sc + M * 2048; int* ti = (int*)(ts + M * 256); int* pe = ti + M * 256;
  float* pg = (float*)(pe + M * 128); float* pw = pg + M * 128;

  LAUNCH(nk_copy_in, (long)NROWS * DM, I.x, I.ctx, xs);
  LAUNCH(nk_mod, 2L * (BATCH + 1) * 6144, I.c, I.c_ctx, I.ada_w, I.ada_b, mod);
  for (int l = 0; l < 2; ++l) for (int b = 0; b < BATCH; ++b) {
    const float* modl = mod + (long)l * (BATCH + 1) * 6144;
    float* xb = xs + (long)b * RB * DM;
    LAUNCH(nk_norm_mod, M, xb, I.norm_mix_g + l * DM, modl, 0, xn, (int)M, b);
    LAUNCH(nk_gemm, M * IN_COLS, xn, I.w_in + (long)l * DM * IN_COLS, P, (int)M, IN_COLS, DM);
    LAUNCH(nk_mla_q1, M * 384, P, I.mla_q_norm_g + l * 256, I.mla_w_qb + (long)l * 256 * 384, tq, (int)M);
    LAUNCH(nk_mla_kv1, M * 512, P, I.mla_kv_norm_g + l * 128, I.mla_w_kvb + (long)l * 128 * 512, tkv, (int)M);
    LAUNCH(nk_mla_qk2, M * 8, P, tq, tkv, I.mla_qk_g + l * 192, mq, mk, (int)M);
    LAUNCH(nk_gqa_prep, M * 8, P, I.gqa_qk_g + l * 128, gq, gk, (int)M);
    LAUNCH(nk_attn<96>, M * 4, mq, 384, mk, 384, tkv + 64, 512, 128, 4, 1, mix, 0, (int)M);
    LAUNCH(nk_attn<64>, M * 6, gq, 384, gk, 128, P + GQA_OFF + 512, IN_COLS, 64, 6, 3, mix, 640, (int)M);
    LAUNCH(nk_rw_shift, M * RWC, P, I.rw_mu + (long)l * 2 * RWC, rwx, (int)M);
    LAUNCH(nk_rw_prep, M * 384, rwx, I.rw_w0 + l * 768, I.rw_w2 + (long)l * 2 * 64 * 384, I.rw_a0 + l * 768, I.rw_a2 + (long)l * 2 * 64 * 384,
           I.rw_g2 + (long)l * 160 * 384, I.rw_k_k + l * 384, I.rw_k_a + l * 384, dec, kd, bd, kk, gg, (int)M);
    LAUNCH(nk_rw_scan, 768L, rwx, dec, kd, bd, kk, yy, (int)M, 1);
    LAUNCH(nk_rw_readout, M * 6, rwx, yy, kd, gg, I.rw_r_k + l * 384, I.rw_ln_g + l * 384, I.rw_ln_b + l * 384, mix, (int)M, (long)M * 384);
    LAUNCH(nk_gemm_res, M * DM, mix, I.w_out + (long)l * DM * DM, modl, 2, xb, (int)M, b);
    LAUNCH(nk_norm_mod, M, xb, I.norm_ffn_g + l * DM, modl, 3, xn, (int)M, b);
    LAUNCH(nk_gemm, M * 2048, xn, I.pe_wq + (long)l * DM * 2048, pq, (int)M, 2048, DM);
    LAUNCH(nk_peer_score, M * 2048, pq, I.pe_keys + (long)l * 16 * 128 * 128, sc, (int)M);
#ifdef HOST_PEER_TEST
    LAUNCH(hk_peer_top1, M * 16, pq, I.pe_keys + (long)l * 16 * 128 * 128, (unsigned*)ts, (int)M);
    LAUNCH(hk_peer_combine, M * 8, (const unsigned*)ts, pe, pg, (int)M);
#else
    LAUNCH(nk_peer_top1, M * 16, sc, ts, ti, (int)M);
    LAUNCH(nk_peer_top2, M * 8, ts, ti, pe, pg, (int)M);
#endif
    LAUNCH(nk_peer_act, M * 128, xn, I.pe_u + (long)l * 16384 * DM, pe, pg, pw, (int)M);
    LAUNCH(nk_peer_out, M * DM, I.pe_v + (long)l * 16384 * DM, pe, pw, modl, xb, (int)M, b);
  }
  LAUNCH(nk_copy_out, (long)BATCH * SEQ * DM, xs, out);
}
__device__ __forceinline__ unsigned f2sortable(float s) { unsigned f = __float_as_uint(s); return (f & 0x80000000u) ? ~f : (f | 0x80000000u); }
__device__ __forceinline__ float sortable2f(unsigned o) { unsigned f = (o & 0x80000000u) ? (o & 0x7fffffffu) : ~o; return __uint_as_float(f); }
__device__ __forceinline__ unsigned enc_key(float s, int idx) { return (f2sortable(s) & ~127u) | (unsigned)(127 - idx); }
__device__ __forceinline__ void dec_key(unsigned k, float& s, int& idx) { idx = 127 - (int)(k & 127u); s = sortable2f(k & ~127u); }
__device__ __forceinline__ unsigned umax_(unsigned a, unsigned b) { return a > b ? a : b; }
__device__ __forceinline__ unsigned umin_(unsigned a, unsigned b) { return a < b ? a : b; }
__device__ __forceinline__ void ins16(unsigned (&l)[16], unsigned x) {
#pragma unroll
  for (int i = 0; i < 16; ++i) { unsigned mx = umax_(l[i], x); x = umin_(l[i], x); l[i] = mx; }
}
__device__ __forceinline__ void merge16(unsigned (&a)[16], const unsigned (&brev)[16]) {
#pragma unroll
  for (int i = 0; i < 16; ++i) a[i] = umax_(a[i], brev[i]);
#pragma unroll
  for (int d = 8; d >= 1; d >>= 1)
#pragma unroll
    for (int i = 0; i < 16; ++i) if ((i & d) == 0) { unsigned hi = umax_(a[i], a[i + d]), lo = umin_(a[i], a[i + d]); a[i] = hi; a[i + d] = lo; }
}
__device__ __forceinline__ void peer_combine(const unsigned* L0, const unsigned* L1, int* e_out, float* g_out) {
  float s0[16], s1[16];
#pragma unroll
  for (int i = 0; i < 16; ++i) { int ix; dec_key(L0[i], s0[i], ix); dec_key(L1[i], s1[i], ix); }
  unsigned sel[16];
#pragma unroll
  for (int i = 0; i < 16; ++i) sel[i] = 0u;
#pragma unroll
  for (int i = 0; i < 16; ++i)
#pragma unroll
    for (int j = 0; j < 16; ++j)
      if ((i + 1) * (j + 1) <= 16) { unsigned k = (f2sortable(s0[i] + s1[j]) & ~255u) | (unsigned)(255 - (i * 16 + j)); ins16(sel, k); }
  float mx = -3e38f;
#pragma unroll
  for (int t = 0; t < 16; ++t) {
    int c = 255 - (int)(sel[t] & 255u); int i = c >> 4, j = c & 15;
    float a, b; int ia, ib; dec_key(L0[i], a, ia); dec_key(L1[j], b, ib);
    float s = a + b; e_out[t] = ia * 128 + ib; g_out[t] = s; mx = fmaxf(mx, s);
  }
  float sum = 0.f;
#pragma unroll
  for (int t = 0; t < 16; ++t) { float e = expf(g_out[t] - mx); g_out[t] = e; sum += e; }
  float inv = 1.f / sum;
#pragma unroll
  for (int t = 0; t < 16; ++t) g_out[t] *= inv;
}
__global__ void hk_peer_top1(const float* pq, const float* keys, unsigned* top1, int M) {
  long i = (long)blockIdx.x * blockDim.x + threadIdx.x;
  if (i >= (long)M * 16) return;
  int ps = i % 16; long r = i / 16; const float* q = pq + r * 2048 + ps * 128;
  unsigned la[16], lb[16], lbr[16];
#pragma unroll
  for (int t = 0; t < 16; ++t) { la[t] = 0u; lb[t] = 0u; }
  for (int k = 0; k < 128; ++k) {
    const float* ky = keys + ((long)ps * 128 + k) * 128; float acc = 0.f;
    for (int d = 0; d < 128; ++d) acc += q[d] * ky[d];
    unsigned key = enc_key(acc, k);
    if (k < 64) ins16(la, key); else ins16(lb, key);
  }
#pragma unroll
  for (int t = 0; t < 16; ++t) lbr[t] = lb[15 - t];
  merge16(la, lbr);
#pragma unroll
  for (int t = 0; t < 16; ++t) top1[i * 16 + t] = la[t];
}
__global__ void hk_peer_combine(const unsigned* top1, int* pe, float* pg, int M) {
  long i = (long)blockIdx.x * blockDim.x + threadIdx.x;
  if (i >= (long)M * 8) return;
  peer_combine(top1 + i * 32, top1 + i * 32 + 16, pe + i * 16, pg + i * 16);
}
typedef unsigned short bf16_t;
typedef __attribute__((ext_vector_type(8))) short bf16x8;
typedef __attribute__((ext_vector_type(4))) float f32x4;
typedef __attribute__((ext_vector_type(16))) float f32x16;
typedef __attribute__((ext_vector_type(4))) unsigned u32x4;

__device__ __forceinline__ bf16_t f2bf(float f) {
  unsigned u = __float_as_uint(f); u += 0x7fffu + ((u >> 16) & 1u); return (bf16_t)(u >> 16);
}
__device__ __forceinline__ float bf2f(bf16_t h) { return __uint_as_float(((unsigned)h) << 16); }
__device__ __forceinline__ unsigned pack2bf(float a, float b) { return (unsigned)f2bf(a) | ((unsigned)f2bf(b) << 16); }

#define GEMM_LDS_BYTES 32768
template <class Epi>
__device__ __forceinline__ void gemm_tile_128(const bf16_t* __restrict__ A, int lda, const bf16_t* __restrict__ Bt, int ldb, int K,
                                              int tile_m, int tile_n, char* smem, Epi epi) {
  const int t = threadIdx.x, lane = t & 63, wave = t >> 6;
  const int wm = wave >> 1, wn = wave & 1;
  char* As = smem; char* Bs = smem + 16384;
  const int lrow = t >> 3, lchunk = t & 7;
  const bf16_t* ag = A + (long)(tile_m * 128 + lrow) * lda + lchunk * 8;
  const bf16_t* bg = Bt + (long)(tile_n * 128 + lrow) * ldb + lchunk * 8;
  u32x4 ra[4], rb[4];
#pragma unroll
  for (int i = 0; i < 4; ++i) {
    ra[i] = *(const u32x4*)(ag + (long)(32 * i) * lda);
    rb[i] = *(const u32x4*)(bg + (long)(32 * i) * ldb);
  }
  f32x4 acc[4][4];
#pragma unroll
  for (int i = 0; i < 4; ++i)
#pragma unroll
    for (int j = 0; j < 4; ++j) acc[i][j] = (f32x4){0.f, 0.f, 0.f, 0.f};
  const int fr = lane & 15, fq = lane >> 4;
  for (int k0 = 0; k0 < K; k0 += 64) {
    __syncthreads();
#pragma unroll
    for (int i = 0; i < 4; ++i) {
      int r = lrow + 32 * i; int off = r * 128 + ((lchunk ^ (r & 7)) << 4);
      *(u32x4*)(As + off) = ra[i]; *(u32x4*)(Bs + off) = rb[i];
    }
    __syncthreads();
    if (k0 + 64 < K) {
#pragma unroll
      for (int i = 0; i < 4; ++i) {
        ra[i] = *(const u32x4*)(ag + (long)(32 * i) * lda + k0 + 64);
        rb[i] = *(const u32x4*)(bg + (long)(32 * i) * ldb + k0 + 64);
      }
    }
#pragma unroll
    for (int ks = 0; ks < 2; ++ks) {
      bf16x8 af[4], bfr[4];
#pragma unroll
      for (int i = 0; i < 4; ++i) {
        int r = wm * 64 + i * 16 + fr; af[i] = *(const bf16x8*)(As + r * 128 + (((ks * 4 + fq) ^ (r & 7)) << 4));
        int rn = wn * 64 + i * 16 + fr; bfr[i] = *(const bf16x8*)(Bs + rn * 128 + (((ks * 4 + fq) ^ (rn & 7)) << 4));
      }
#pragma unroll
      for (int i = 0; i < 4; ++i)
#pragma unroll
        for (int j = 0; j < 4; ++j) acc[i][j] = __builtin_amdgcn_mfma_f32_16x16x32_bf16(bfr[j], af[i], acc[i][j], 0, 0, 0);
    }
  }
#pragma unroll
  for (int i = 0; i < 4; ++i)
#pragma unroll
    for (int j = 0; j < 4; ++j) {
      int m = tile_m * 128 + wm * 64 + i * 16 + fr; int n0 = tile_n * 128 + wn * 64 + j * 16 + fq * 4;
      epi(m, n0, acc[i][j]);
    }
}

__global__ void ok_cvt_wT(const float* W, bf16_t* Wt, int K, int N, int Npad) {
  long i = (long)blockIdx.x * blockDim.x + threadIdx.x;
  if (i >= (long)Npad * K) return;
  int k = i % K; int n = i / K;
  Wt[i] = n < N ? f2bf(W[(long)k * N + n]) : (bf16_t)0;
}
__global__ void ok_f32_to_bf16(const float* s, bf16_t* d, long n) {
  long i = (long)blockIdx.x * blockDim.x + threadIdx.x; if (i < n) d[i] = f2bf(s[i]);
}
__global__ void ok_bf16_to_f32(const bf16_t* s, float* d, long n) {
  long i = (long)blockIdx.x * blockDim.x + threadIdx.x; if (i < n) d[i] = bf2f(s[i]);
}
__global__ void ok_norm_mod_bf16(const float* xs, const float* g, const float* modl, int shift_idx, bf16_t* xn, int M) {
  int row = blockIdx.x * 4 + (threadIdx.x >> 6); int lane = threadIdx.x & 63;
  if (row >= M) return;
  int b = row / RB, lr = row % RB; int bb = lr < SEQ ? b : BATCH;
  const float* sh = modl + ((long)bb * 6 + shift_idx) * DM; const float* sc = sh + DM;
  const float* xr = xs + (long)row * DM; float v[16]; float ss = 0.f;
#pragma unroll
  for (int i = 0; i < 4; ++i) { float4 q = *(const float4*)(xr + i * 256 + lane * 4); v[i*4]=q.x; v[i*4+1]=q.y; v[i*4+2]=q.z; v[i*4+3]=q.w; ss += q.x*q.x+q.y*q.y+q.z*q.z+q.w*q.w; }
#pragma unroll
  for (int o = 32; o > 0; o >>= 1) ss += __shfl_xor(ss, o);
  float inv = 1.f / sqrtf(ss / DM + EPSN);
#pragma unroll
  for (int i = 0; i < 4; ++i) {
    int d = i * 256 + lane * 4; float o[4];
#pragma unroll
    for (int e = 0; e < 4; ++e) o[e] = v[i*4+e] * inv * g[d+e] * (1.f + sc[d+e]) + sh[d+e];
    uint2 pk; pk.x = pack2bf(o[0], o[1]); pk.y = pack2bf(o[2], o[3]);
    *(uint2*)(xn + (long)row * DM + d) = pk;
  }
}

struct EpiStoreBf16 { bf16_t* C; int ldc; int N;
  __device__ __forceinline__ void operator()(int m, int n0, f32x4 v) const {
    if (n0 < N) { uint2 pk; pk.x = pack2bf(v[0], v[1]); pk.y = pack2bf(v[2], v[3]); *(uint2*)(C + (long)m * ldc + n0) = pk; } } };
struct EpiStoreF32 { float* C; int ldc; int N;
  __device__ __forceinline__ void operator()(int m, int n0, f32x4 v) const {
    if (n0 < N) *(float4*)(C + (long)m * ldc + n0) = make_float4(v[0], v[1], v[2], v[3]); } };
struct EpiResid { float* xs; const float* modl; int gi; int pad;
  __device__ __forceinline__ void operator()(int m, int n0, f32x4 v) const {
    int b = m / RB, lr = m % RB; int bb = lr < SEQ ? b : BATCH; const float* g = modl + ((long)bb * 6 + gi) * DM + n0;
    float4 x = *(float4*)(xs + (long)m * DM + n0);
    x.x += g[0] * v[0]; x.y += g[1] * v[1]; x.z += g[2] * v[2]; x.w += g[3] * v[3];
    *(float4*)(xs + (long)m * DM + n0) = x; } };

template <class Epi>
__global__ void __launch_bounds__(256) ok_gemm(const bf16_t* A, int lda, const bf16_t* Bt, int ldb, int K, int tiles_m, int tiles_n, Epi epi) {
  __shared__ __attribute__((aligned(16))) char smem[GEMM_LDS_BYTES];
  for (int tile = blockIdx.x; tile < tiles_m * tiles_n; tile += gridDim.x) {
    int tm = tile / tiles_n, tn = tile % tiles_n;
    gemm_tile_128(A, lda, Bt, ldb, K, tm, tn, smem, epi);
  }
}

typedef __attribute__((ext_vector_type(2))) __bf16 bf16v2;
__device__ __forceinline__ float dot2bf(unsigned a, unsigned b, float c) {
  return __builtin_amdgcn_fdot2_f32_bf16(*(bf16v2*)&a, *(bf16v2*)&b, c, false);
}
__global__ void ok_cvt_bf16_v8(const float* s, bf16_t* d, long n8) {
  long i = (long)blockIdx.x * blockDim.x + threadIdx.x; if (i >= n8) return;
  float4 a = *(const float4*)(s + i * 8), b = *(const float4*)(s + i * 8 + 4);
  u32x4 o; o[0] = pack2bf(a.x, a.y); o[1] = pack2bf(a.z, a.w); o[2] = pack2bf(b.x, b.y); o[3] = pack2bf(b.z, b.w);
  *(u32x4*)(d + i * 8) = o;
}

#define P5_LDS_BYTES (128 * 128 * 4)
__device__ __forceinline__ void peer_q_top1_tile(const bf16_t* __restrict__ A, const bf16_t* __restrict__ WqT, const bf16_t* __restrict__ keysb,
                                                 unsigned* __restrict__ top1, int tm, int ps, char* smem) {
  const int t = threadIdx.x, lane = t & 63, wave = t >> 6, wm = wave >> 1, wn = wave & 1, fr = lane & 15, fq = lane >> 4;
  f32x4 acc[4][4];
  {
    char* As = smem; char* Bs = smem + 16384;
    const int lrow = t >> 3, lchunk = t & 7;
    const bf16_t* ag = A + (long)(tm * 128 + lrow) * DM + lchunk * 8;
    const bf16_t* bg = WqT + (long)(ps * 128 + lrow) * DM + lchunk * 8;
    u32x4 ra[4], rb[4];
#pragma unroll
    for (int i = 0; i < 4; ++i) { ra[i] = *(const u32x4*)(ag + (long)(32 * i) * DM); rb[i] = *(const u32x4*)(bg + (long)(32 * i) * DM); }
#pragma unroll
    for (int i = 0; i < 4; ++i)
#pragma unroll
      for (int j = 0; j < 4; ++j) acc[i][j] = (f32x4){0.f, 0.f, 0.f, 0.f};
    for (int k0 = 0; k0 < DM; k0 += 64) {
      __syncthreads();
#pragma unroll
      for (int i = 0; i < 4; ++i) { int r = lrow + 32 * i; int off = r * 128 + ((lchunk ^ (r & 7)) << 4); *(u32x4*)(As + off) = ra[i]; *(u32x4*)(Bs + off) = rb[i]; }
      __syncthreads();
      if (k0 + 64 < DM) {
#pragma unroll
        for (int i = 0; i < 4; ++i) { ra[i] = *(const u32x4*)(ag + (long)(32 * i) * DM + k0 + 64); rb[i] = *(const u32x4*)(bg + (long)(32 * i) * DM + k0 + 64); }
      }
#pragma unroll
      for (int ks = 0; ks < 2; ++ks) {
        bf16x8 af[4], bfr[4];
#pragma unroll
        for (int i = 0; i < 4; ++i) {
          int r = wm * 64 + i * 16 + fr; af[i] = *(const bf16x8*)(As + r * 128 + (((ks * 4 + fq) ^ (r & 7)) << 4));
          int rn = wn * 64 + i * 16 + fr; bfr[i] = *(const bf16x8*)(Bs + rn * 128 + (((ks * 4 + fq) ^ (rn & 7)) << 4));
        }
#pragma unroll
        for (int i = 0; i < 4; ++i)
#pragma unroll
          for (int j = 0; j < 4; ++j) acc[i][j] = __builtin_amdgcn_mfma_f32_16x16x32_bf16(bfr[j], af[i], acc[i][j], 0, 0, 0);
      }
    }
  }
  __syncthreads();
  char* Qs = smem; char* Ks = smem + 32768;
#pragma unroll
  for (int i = 0; i < 4; ++i)
#pragma unroll
    for (int j = 0; j < 4; ++j) {
      int m = wm * 64 + i * 16 + fr; int n0 = wn * 64 + j * 16 + fq * 4;
      uint2 pk; pk.x = pack2bf(acc[i][j][0], acc[i][j][1]); pk.y = pack2bf(acc[i][j][2], acc[i][j][3]);
      *(uint2*)(Qs + m * 256 + ((((n0 >> 3) ^ (m & 15)) << 4) | ((n0 & 7) << 1))) = pk;
    }
  {
    const bf16_t* kg = keysb + (long)ps * 128 * 128;
#pragma unroll
    for (int i = 0; i < 8; ++i) { int idx = t + 256 * i; int r = idx >> 4, c = idx & 15; *(u32x4*)(Ks + r * 256 + ((c ^ (r & 15)) << 4)) = *(const u32x4*)(kg + r * 128 + c * 8); }
  }
  __syncthreads();
#pragma unroll
  for (int i = 0; i < 4; ++i)
#pragma unroll
    for (int j = 0; j < 4; ++j) acc[i][j] = (f32x4){0.f, 0.f, 0.f, 0.f};
#pragma unroll
  for (int ks = 0; ks < 4; ++ks) {
    bf16x8 af[4], bfr[4];
#pragma unroll
    for (int i = 0; i < 4; ++i) {
      int r = wm * 64 + i * 16 + fr; af[i] = *(const bf16x8*)(Qs + r * 256 + (((ks * 4 + fq) ^ (r & 15)) << 4));
      int rn = wn * 64 + i * 16 + fr; bfr[i] = *(const bf16x8*)(Ks + rn * 256 + (((ks * 4 + fq) ^ (rn & 15)) << 4));
    }
#pragma unroll
    for (int i = 0; i < 4; ++i)
#pragma unroll
      for (int j = 0; j < 4; ++j) acc[i][j] = __builtin_amdgcn_mfma_f32_16x16x32_bf16(bfr[j], af[i], acc[i][j], 0, 0, 0);
  }
  __syncthreads();
  unsigned* Sc = (unsigned*)smem;
#pragma unroll
  for (int i = 0; i < 4; ++i)
#pragma unroll
    for (int j = 0; j < 4; ++j) {
      int m = wm * 64 + i * 16 + fr; int n0 = wn * 64 + j * 16 + fq * 4;
#pragma unroll
      for (int e = 0; e < 4; ++e) Sc[(n0 + e) * 128 + (m ^ ((((n0 + e) >> 2) & 1) << 4))] = enc_key(acc[i][j][e], n0 + e);
    }
  __syncthreads();
  {
    const int r = t & 127, half = t >> 7;
    unsigned l[16];
#pragma unroll
    for (int i = 0; i < 16; ++i) l[i] = 0u;
    for (int k = 0; k < 64; ++k) ins16(l, Sc[(half * 64 + k) * 128 + (r ^ (((k >> 2) & 1) << 4))]);
    __syncthreads();
    unsigned* Ls = (unsigned*)smem;
    if (half == 1) {
#pragma unroll
      for (int i = 0; i < 16; ++i) Ls[r * 17 + i] = l[15 - i];
    }
    __syncthreads();
    if (half == 0) {
      unsigned br[16];
#pragma unroll
      for (int i = 0; i < 16; ++i) br[i] = Ls[r * 17 + i];
      merge16(l, br);
      unsigned* o = top1 + ((long)(tm * 128 + r) * 16 + ps) * 16;
#pragma unroll
      for (int i = 0; i < 4; ++i) { u32x4 v; v[0] = l[4*i]; v[1] = l[4*i+1]; v[2] = l[4*i+2]; v[3] = l[4*i+3]; *(u32x4*)(o + 4 * i) = v; }
    }
  }
}
__global__ void __launch_bounds__(256) ok_peer_q_top1(const bf16_t* A, const bf16_t* WqT, const bf16_t* keysb, unsigned* top1, int tiles_m) {
  __shared__ __attribute__((aligned(16))) char smem[P5_LDS_BYTES];
  for (int tile = blockIdx.x; tile < tiles_m * 16; tile += gridDim.x) { peer_q_top1_tile(A, WqT, keysb, top1, tile / 16, tile % 16, smem); __syncthreads(); }
}

#define P6_LDS_BYTES (32 * 128 * 4 * 3)
__device__ __forceinline__ void peer_gather_group(const bf16_t* __restrict__ xn, const unsigned* __restrict__ top1, const bf16_t* __restrict__ ub,
                                                  const bf16_t* __restrict__ vb, const float* __restrict__ modl, float* __restrict__ xs, int grp, char* smem) {
  const int t = threadIdx.x, lane = t & 63, wave = t >> 6;
  int* pe_l = (int*)smem; float* pg_l = (float*)(smem + 32 * 128 * 4); float* pw_l = (float*)(smem + 2 * 32 * 128 * 4);
  {
    int tl = t >> 3, p = t & 7; long row = (long)grp * 32 + tl;
    peer_combine(top1 + (row * 16 + p * 2) * 16, top1 + (row * 16 + p * 2 + 1) * 16, pe_l + tl * 128 + p * 16, pg_l + tl * 128 + p * 16);
  }
  __syncthreads();
  for (int ti = 0; ti < 8; ++ti) {
    const int tl = wave * 8 + ti; const long row = (long)grp * 32 + tl;
    const int* pe = pe_l + tl * 128; float* pw = pw_l + tl * 128;
    u32x4 h0 = *(const u32x4*)(xn + row * DM + lane * 8), h1 = *(const u32x4*)(xn + row * DM + 512 + lane * 8);
    for (int b = 0; b < 16; ++b) {
      u32x4 u0[8], u1[8];
#pragma unroll
      for (int j = 0; j < 8; ++j) { const bf16_t* ur = ub + (long)pe[b * 8 + j] * DM + lane * 8; u0[j] = *(const u32x4*)ur; u1[j] = *(const u32x4*)(ur + 512); }
      float pd[8];
#pragma unroll
      for (int j = 0; j < 8; ++j) {
        float a = 0.f;
#pragma unroll
        for (int e = 0; e < 4; ++e) { a = dot2bf(h0[e], u0[j][e], a); a = dot2bf(h1[e], u1[j][e], a); }
        pd[j] = a;
      }
      float q4[4], q2[2], q1;
#pragma unroll
      for (int j = 0; j < 4; ++j) { bool hi = lane & 1; float keep = hi ? pd[2*j+1] : pd[2*j], send = hi ? pd[2*j] : pd[2*j+1]; q4[j] = keep + __shfl_xor(send, 1); }
#pragma unroll
      for (int j = 0; j < 2; ++j) { bool hi = lane & 2; float keep = hi ? q4[2*j+1] : q4[2*j], send = hi ? q4[2*j] : q4[2*j+1]; q2[j] = keep + __shfl_xor(send, 2); }
      { bool hi = lane & 4; float keep = hi ? q2[1] : q2[0], send = hi ? q2[0] : q2[1]; q1 = keep + __shfl_xor(send, 4); }
      q1 += __shfl_xor(q1, 8); q1 += __shfl_xor(q1, 16); q1 += __shfl_xor(q1, 32);
      if (lane < 8) { int j = lane & 7; pw[b * 8 + j] = q1; }
    }
    {
      float d0 = pw[lane], d1 = pw[64 + lane];
      pw[lane] = pg_l[tl * 128 + lane] * geluf_(d0); pw[64 + lane] = pg_l[tl * 128 + 64 + lane] * geluf_(d1);
    }
    float o[16];
#pragma unroll
    for (int e = 0; e < 16; ++e) o[e] = 0.f;
    for (int b = 0; b < 16; ++b) {
      u32x4 v0[8], v1[8];
#pragma unroll
      for (int j = 0; j < 8; ++j) { const bf16_t* vr = vb + (long)pe[b * 8 + j] * DM + lane * 8; v0[j] = *(const u32x4*)vr; v1[j] = *(const u32x4*)(vr + 512); }
#pragma unroll
      for (int j = 0; j < 8; ++j) {
        float w = pw[b * 8 + j];
#pragma unroll
        for (int e = 0; e < 4; ++e) {
          o[2*e]     += w * __uint_as_float(v0[j][e] << 16); o[2*e+1]     += w * __uint_as_float(v0[j][e] & 0xffff0000u);
          o[8 + 2*e] += w * __uint_as_float(v1[j][e] << 16); o[8 + 2*e+1] += w * __uint_as_float(v1[j][e] & 0xffff0000u);
        }
      }
    }
    {
      int b = row / RB, lr = row % RB; int bb = lr < SEQ ? b : BATCH; const float* g5 = modl + ((long)bb * 6 + 5) * DM;
      float* xr = xs + row * DM;
#pragma unroll
      for (int hf = 0; hf < 2; ++hf) {
        int d = hf * 512 + lane * 8;
        float4 x0 = *(float4*)(xr + d), x1 = *(float4*)(xr + d + 4); float4 g0 = *(const float4*)(g5 + d), g1 = *(const float4*)(g5 + d + 4);
        x0.x += g0.x * o[hf*8+0]; x0.y += g0.y * o[hf*8+1]; x0.z += g0.z * o[hf*8+2]; x0.w += g0.w * o[hf*8+3];
        x1.x += g1.x * o[hf*8+4]; x1.y += g1.y * o[hf*8+5]; x1.z += g1.z * o[hf*8+6]; x1.w += g1.w * o[hf*8+7];
        *(float4*)(xr + d) = x0; *(float4*)(xr + d + 4) = x1;
      }
    }
  }
}
__global__ void __launch_bounds__(256) ok_peer_gather(const bf16_t* xn, const unsigned* top1, const bf16_t* ub, const bf16_t* vb, const float* modl, float* xs, int ngroups) {
  __shared__ __attribute__((aligned(16))) char smem[P6_LDS_BYTES];
  for (int g = blockIdx.x; g < ngroups; g += gridDim.x) { peer_gather_group(xn, top1, ub, vb, modl, xs, g, smem); __syncthreads(); }
}

template <int DQ> struct AttnCfg { static constexpr int KROW = DQ * 2 + 16; static constexpr int VROW = 136; static constexpr int KBYTES = 64 * KROW; static constexpr int LDS = 64 * KROW + 64 * VROW; };
#define ATTN_LDS_BYTES (64 * 208 + 64 * 136)
template <int DQ>
__device__ __forceinline__ void attn_block(const bf16_t* __restrict__ qb, int HQ, const bf16_t* __restrict__ kb, int HK, const bf16_t* __restrict__ vT, int G,
                                           bf16_t* __restrict__ mixall, int ooff, int b, int head, int qt, char* smem) {
  constexpr int KROW = AttnCfg<DQ>::KROW, VROW = 136, NKK = DQ / 16, KCH = DQ / 8;
  constexpr int KLD = (64 * KCH) / 256;
  const int t = threadIdx.x, lane = t & 63, wave = t >> 6, lq = lane & 31, lh = lane >> 5;
  const int hk = head / G;
  char* Ks = smem; char* Vs = smem + 64 * KROW;
  const long qrow = (long)b * RB + qt * 128 + wave * 32 + lq;
  bf16x8 qf[NKK];
#pragma unroll
  for (int kk = 0; kk < NKK; ++kk) qf[kk] = *(const bf16x8*)(qb + (qrow * HQ + head) * DQ + kk * 16 + lh * 8);
  const int key0 = qt < 16 ? 0 : SEQ; const int nt = qt < 16 ? RB / 64 : CTX_LEN / 64;
  const bf16_t* kbase = kb + ((long)b * RB * HK + hk) * DQ; const bf16_t* vbase = vT + ((long)(b * HK + hk) * 64) * RB;
  u32x4 rk[KLD], rv[2];
  auto issue = [&](int tile) {
    int k0 = key0 + tile * 64;
#pragma unroll
    for (int i = 0; i < KLD; ++i) { int c = t + 256 * i; int r = c / KCH, cc = c % KCH; rk[i] = *(const u32x4*)(kbase + (long)(k0 + r) * HK * DQ + cc * 8); }
#pragma unroll
    for (int i = 0; i < 2; ++i) { int c = t + 256 * i; int r = c >> 3, cc = c & 7; rv[i] = *(const u32x4*)(vbase + (long)r * RB + k0 + cc * 8); }
  };
  issue(0);
  f32x16 ot[2];
#pragma unroll
  for (int d = 0; d < 2; ++d)
#pragma unroll
    for (int r = 0; r < 16; ++r) ot[d][r] = 0.f;
  float mrun = -1e30f, lrun = 0.f;
  for (int tile = 0; tile < nt; ++tile) {
    __syncthreads();
#pragma unroll
    for (int i = 0; i < KLD; ++i) { int c = t + 256 * i; int r = c / KCH, cc = c % KCH; *(u32x4*)(Ks + r * KROW + cc * 16) = rk[i]; }
#pragma unroll
    for (int i = 0; i < 2; ++i) { int c = t + 256 * i; int r = c >> 3, cc = c & 7; *(uint2*)(Vs + r * VROW + cc * 16) = make_uint2(rv[i][0], rv[i][1]); *(uint2*)(Vs + r * VROW + cc * 16 + 8) = make_uint2(rv[i][2], rv[i][3]); }
    __syncthreads();
    if (tile + 1 < nt) issue(tile + 1);
    f32x16 st[2];
#pragma unroll
    for (int kt = 0; kt < 2; ++kt) {
#pragma unroll
      for (int r = 0; r < 16; ++r) st[kt][r] = 0.f;
#pragma unroll
      for (int kk = 0; kk < NKK; ++kk) {
        bf16x8 ka = *(const bf16x8*)(Ks + (kt * 32 + lq) * KROW + kk * 32 + lh * 16);
        st[kt] = __builtin_amdgcn_mfma_f32_32x32x16_bf16(ka, qf[kk], st[kt], 0, 0, 0);
      }
    }
    float mt = st[0][0];
#pragma unroll
    for (int kt = 0; kt < 2; ++kt)
#pragma unroll
      for (int r = 0; r < 16; ++r) mt = fmaxf(mt, st[kt][r]);
    mt = fmaxf(mt, __shfl_xor(mt, 32));
    float mnew = fmaxf(mrun, mt); float alpha = __builtin_amdgcn_exp2f(mrun - mnew); mrun = mnew;
    float ps = 0.f;
#pragma unroll
    for (int kt = 0; kt < 2; ++kt)
#pragma unroll
      for (int r = 0; r < 16; ++r) { float p = __builtin_amdgcn_exp2f(st[kt][r] - mnew); st[kt][r] = p; ps += p; }
    lrun = lrun * alpha + ps;
#pragma unroll
    for (int d = 0; d < 2; ++d)
#pragma unroll
      for (int r = 0; r < 16; ++r) ot[d][r] *= alpha;
#pragma unroll
    for (int kt = 0; kt < 2; ++kt)
#pragma unroll
      for (int s = 0; s < 2; ++s) {
        union { bf16x8 v; unsigned u[4]; } pb;
#pragma unroll
        for (int j = 0; j < 4; ++j) pb.u[j] = pack2bf(st[kt][8 * s + 2 * j], st[kt][8 * s + 2 * j + 1]);
#pragma unroll
        for (int d = 0; d < 2; ++d) {
          const char* vp = Vs + (d * 32 + lq) * VROW + (kt * 32 + 16 * s + 4 * lh) * 2;
          union { bf16x8 v; uint2 h[2]; } va; va.h[0] = *(const uint2*)vp; va.h[1] = *(const uint2*)(vp + 16);
          ot[d] = __builtin_amdgcn_mfma_f32_32x32x16_bf16(va.v, pb.v, ot[d], 0, 0, 0);
        }
      }
  }
  float ltot = lrun + __shfl_xor(lrun, 32); float inv = 1.f / ltot;
  bf16_t* orow = mixall + qrow * DM + ooff + head * 64;
#pragma unroll
  for (int d = 0; d < 2; ++d)
#pragma unroll
    for (int g = 0; g < 4; ++g) {
      uint2 pk; pk.x = pack2bf(ot[d][4 * g] * inv, ot[d][4 * g + 1] * inv); pk.y = pack2bf(ot[d][4 * g + 2] * inv, ot[d][4 * g + 3] * inv);
      *(uint2*)(orow + d * 32 + 8 * g + 4 * lh) = pk;
    }
}
__global__ void __launch_bounds__(256) ok_attn(const bf16_t* mq, const bf16_t* mk, const bf16_t* mvT, const bf16_t* gq, const bf16_t* gk, const bf16_t* gvT, bf16_t* mixall, int nqt) {
  __shared__ __attribute__((aligned(16))) char smem[ATTN_LDS_BYTES];
  const int n_mla = BATCH * 4 * nqt, n_gqa = BATCH * 6 * nqt;
  for (int w = blockIdx.x; w < n_mla + n_gqa; w += gridDim.x) {
    if (w < n_mla) { int qt = w % nqt, head = (w / nqt) % 4, b = w / (nqt * 4); attn_block<96>(mq, 4, mk, 4, mvT, 1, mixall, 0, b, head, qt, smem); }
    else { int v = w - n_mla; int qt = v % nqt, head = (v / nqt) % 6, b = v / (nqt * 6); attn_block<64>(gq, 6, gk, 2, gvT, 3, mixall, 640, b, head, qt, smem); }
    __syncthreads();
  }
}
__global__ void ok_adapt_rows(const float* src, int sld, int scol, int ncols, float scale, bf16_t* dst, int dld, int nrows) {
  long i = (long)blockIdx.x * blockDim.x + threadIdx.x; if (i >= (long)nrows * ncols) return;
  int c = i % ncols; long r = i / ncols; dst[r * dld + c] = f2bf(src[r * sld + scol + c] * scale);
}
__global__ void ok_adapt_vT(const float* src, int sld, int scol, int hstride, int H, bf16_t* dst) {
  long i = (long)blockIdx.x * blockDim.x + threadIdx.x; if (i >= (long)H * 64 * RB) return;
  int lr = i % RB; int d = (i / RB) % 64; int h = i / ((long)RB * 64);
  dst[i] = f2bf(src[(long)lr * sld + scol + h * hstride + d]);
}

typedef __attribute__((ext_vector_type(2))) float f32x2;
#define SCAN_TS 16
#define SCAN_LDS_BYTES (2 * SCAN_TS * 1536 + 2 * SCAN_TS * 32 * 4)
__device__ __forceinline__ float reduce8(float x) {
  x += __builtin_bit_cast(float, __builtin_amdgcn_update_dpp(0, __builtin_bit_cast(int, x), 0xB1, 0xf, 0xf, true));
  x += __builtin_bit_cast(float, __builtin_amdgcn_update_dpp(0, __builtin_bit_cast(int, x), 0x4E, 0xf, 0xf, true));
  x += __builtin_bit_cast(float, __builtin_amdgcn_update_dpp(0, __builtin_bit_cast(int, x), 0x141, 0xf, 0xf, true));
  return x;
}
__device__ __forceinline__ int scan_row(int dir, int s) {
  if (s < CTX_LEN) return SEQ + (dir == 0 ? s : CTX_LEN - 1 - s);
  return dir == 0 ? s - CTX_LEN : SEQ - 1 - (s - CTX_LEN);
}
__device__ __forceinline__ void rw_scan_block(const bf16_t* __restrict__ r_, const bf16_t* __restrict__ v_, const bf16_t* __restrict__ kk_, const bf16_t* __restrict__ kd_,
                                              const bf16_t* __restrict__ bd_, const float* __restrict__ w_, float* __restrict__ y_, int item, long dstride, char* smem) {
  const int t = threadIdx.x, lane = t & 63, wave = t >> 6, cg = lane & 7, il = wave * 8 + (lane >> 3);
  const int half = item & 1, dir = (item >> 1) & 1, h = (item >> 2) % 6, b = item / 24;
  const long rowbase = (long)b * RB; const int col0 = h * 64;
  float* ybuf = (float*)(smem + 2 * SCAN_TS * 1536);
  const int st_ld = t >> 4, part = t & 15;
  u32x4 la, lb, lc, lw;
  auto issue = [&](int c) {
    long row = rowbase + scan_row(dir, c * SCAN_TS + st_ld); long o = row * 384 + col0;
    const int ch = (part & 7) * 8;
    la = *(const u32x4*)((part < 8 ? kk_ + o : bd_ + dir * dstride + o) + ch);
    lb = *(const u32x4*)((part < 8 ? kd_ + dir * dstride + o : r_ + o) + ch);
    lc = *(const u32x4*)(v_ + o + ch);
    lw = *(const u32x4*)(w_ + dir * dstride + o + part * 4);
  };
  auto stash = [&](int buf) {
    float* base = (float*)(smem + buf * SCAN_TS * 1536 + st_ld * 1536);
    const int ch = (part & 7) * 8;
    float* pa = base + (part < 8 ? 64 : 128) + ch; float* pb = base + (part < 8 ? 192 : 256) + ch;
    f32x4 x0, x1;
#pragma unroll
    for (int e = 0; e < 2; ++e) { x0[2*e] = __uint_as_float(la[e] << 16); x0[2*e+1] = __uint_as_float(la[e] & 0xffff0000u); x1[2*e] = __uint_as_float(la[2+e] << 16); x1[2*e+1] = __uint_as_float(la[2+e] & 0xffff0000u); }
    *(f32x4*)pa = x0; *(f32x4*)(pa + 4) = x1;
#pragma unroll
    for (int e = 0; e < 2; ++e) { x0[2*e] = __uint_as_float(lb[e] << 16); x0[2*e+1] = __uint_as_float(lb[e] & 0xffff0000u); x1[2*e] = __uint_as_float(lb[2+e] << 16); x1[2*e+1] = __uint_as_float(lb[2+e] & 0xffff0000u); }
    *(f32x4*)pb = x0; *(f32x4*)(pb + 4) = x1;
    if (part < 8) {
      float* pc = base + 320 + ch;
#pragma unroll
      for (int e = 0; e < 2; ++e) { x0[2*e] = __uint_as_float(lc[e] << 16); x0[2*e+1] = __uint_as_float(lc[e] & 0xffff0000u); x1[2*e] = __uint_as_float(lc[2+e] << 16); x1[2*e+1] = __uint_as_float(lc[2+e] & 0xffff0000u); }
      *(f32x4*)pc = x0; *(f32x4*)(pc + 4) = x1;
    }
    *(u32x4*)(base + part * 4) = lw;
  };
  f32x2 S[4];
#pragma unroll
  for (int j = 0; j < 4; ++j) S[j] = (f32x2){0.f, 0.f};
  const int NCH = RB / SCAN_TS;
  issue(0);
  for (int c = 0; c < NCH; ++c) {
    const int buf = c & 1;
    stash(buf);
    __syncthreads();
    if (c > 0 && t < 128) {
      int st = t >> 3, i4 = (t & 7) * 4; long row = rowbase + scan_row(dir, (c - 1) * SCAN_TS + st);
      *(f32x4*)(y_ + dir * dstride + row * 384 + col0 + half * 32 + i4) = *(const f32x4*)(ybuf + (buf ^ 1) * SCAN_TS * 32 + st * 32 + i4);
    }
    if (c + 1 < NCH) issue(c + 1);
    const float* ob = (const float*)(smem + buf * SCAN_TS * 1536) + cg * 8;
    float yk[SCAN_TS];
#pragma unroll
    for (int st = 0; st < SCAN_TS; ++st) {
      const float* o = ob + st * 384;
      f32x4 w0 = *(const f32x4*)(o), w1 = *(const f32x4*)(o + 4), k0 = *(const f32x4*)(o + 64), k1 = *(const f32x4*)(o + 68);
      f32x4 b0 = *(const f32x4*)(o + 128), b1 = *(const f32x4*)(o + 132), d0 = *(const f32x4*)(o + 192), d1 = *(const f32x4*)(o + 196);
      f32x4 r0 = *(const f32x4*)(o + 256), r1 = *(const f32x4*)(o + 260);
      float vi = ob[st * 384 + 320 - cg * 8 + half * 32 + il];
      f32x2 a2 = S[0] * (f32x2){k0[0], k0[1]}; a2 += S[1] * (f32x2){k0[2], k0[3]}; a2 += S[2] * (f32x2){k1[0], k1[1]}; a2 += S[3] * (f32x2){k1[2], k1[3]};
      float skk = reduce8(a2[0] + a2[1]);
      f32x2 vv = (f32x2){vi, vi}, ns = (f32x2){-skk, -skk};
      S[0] = S[0] * (f32x2){w0[0], w0[1]} + (vv * (f32x2){d0[0], d0[1]} + ns * (f32x2){b0[0], b0[1]});
      S[1] = S[1] * (f32x2){w0[2], w0[3]} + (vv * (f32x2){d0[2], d0[3]} + ns * (f32x2){b0[2], b0[3]});
      S[2] = S[2] * (f32x2){w1[0], w1[1]} + (vv * (f32x2){d1[0], d1[1]} + ns * (f32x2){b1[0], b1[1]});
      S[3] = S[3] * (f32x2){w1[2], w1[3]} + (vv * (f32x2){d1[2], d1[3]} + ns * (f32x2){b1[2], b1[3]});
      f32x2 y2 = S[0] * (f32x2){r0[0], r0[1]}; y2 += S[1] * (f32x2){r0[2], r0[3]}; y2 += S[2] * (f32x2){r1[0], r1[1]}; y2 += S[3] * (f32x2){r1[2], r1[3]};
      yk[st] = reduce8(y2[0] + y2[1]);
    }
    if (cg == 0) {
#pragma unroll
      for (int st = 0; st < SCAN_TS; ++st) ybuf[buf * SCAN_TS * 32 + st * 32 + il] = yk[st];
    }
  }
  __syncthreads();
  if (t < 128) {
    int st = t >> 3, i4 = (t & 7) * 4; long row = rowbase + scan_row(dir, (NCH - 1) * SCAN_TS + st);
    *(f32x4*)(y_ + dir * dstride + row * 384 + col0 + half * 32 + i4) = *(const f32x4*)(ybuf + ((NCH - 1) & 1) * SCAN_TS * 32 + st * 32 + i4);
  }
}
__global__ void __launch_bounds__(256) ok_rw_scan(const bf16_t* r_, const bf16_t* v_, const bf16_t* kk_, const bf16_t* kd_, const bf16_t* bd_, const float* w_, float* y_, int item0, int nitems, long dstride) {
  __shared__ __attribute__((aligned(16))) char smem[SCAN_LDS_BYTES];
  for (int it = item0 + blockIdx.x; it < item0 + nitems; it += gridDim.x) { rw_scan_block(r_, v_, kk_, kd_, bd_, w_, y_, it, dstride, smem); __syncthreads(); }
}
__global__ void ok_copy_rows_f32(const float* src, int sld, int scol, int ncols, float* dst, int dld, int nrows) {
  long i = (long)blockIdx.x * blockDim.x + threadIdx.x; if (i >= (long)nrows * ncols) return;
  int c = i % ncols; long r = i / ncols; dst[r * dld + c] = src[r * sld + scol + c];
}
static void forward_v5(const NaiveIn& I, float* out, char* wsb, hipStream_t stream) {
  const long MA = NROWS, M = RB;
  char* p = wsb;
  auto carve = [&](size_t bytes) { char* r = p; p += (bytes + 255) & ~(size_t)255; return r; };
  float* xs = (float*)carve(MA * DM * 4);
  float* mod = (float*)carve(2L * (BATCH + 1) * 6144 * 4);
  bf16_t* xn = (bf16_t*)carve(MA * DM * 2);
  bf16_t* Pb = (bf16_t*)carve(MA * IN_COLS * 2);
  bf16_t* mixall = (bf16_t*)carve(MA * DM * 2);
  bf16_t* w_inT = (bf16_t*)carve(2L * 2688 * 1024 * 2);
  bf16_t* w_outT = (bf16_t*)carve(2L * 1024 * 1024 * 2);
  bf16_t* wqT = (bf16_t*)carve(2L * 2048 * 1024 * 2);
  bf16_t* keysb = (bf16_t*)carve(2L * 16 * 128 * 128 * 2);
  unsigned* top1 = (unsigned*)mixall;
  bf16_t* ub = Pb; bf16_t* vb = Pb + 16384L * DM;
  bf16_t* mq_b = (bf16_t*)carve(MA * 384 * 2); bf16_t* mk_b = (bf16_t*)carve(MA * 384 * 2); bf16_t* mvT = (bf16_t*)carve((long)BATCH * 4 * 64 * RB * 2);
  bf16_t* gq_b = (bf16_t*)carve(MA * 384 * 2); bf16_t* gk_b = (bf16_t*)carve(MA * 128 * 2); bf16_t* gvT = (bf16_t*)carve((long)BATCH * 2 * 64 * RB * 2);
  bf16_t* r_b = (bf16_t*)carve(M * 384 * 2); bf16_t* v_b = (bf16_t*)carve(M * 384 * 2); bf16_t* kk_b = (bf16_t*)carve(M * 384 * 2);
  bf16_t* kd_b = (bf16_t*)carve(2 * M * 384 * 2); bf16_t* bd_b = (bf16_t*)carve(2 * M * 384 * 2); float* w_f = (float*)carve(2 * M * 384 * 4);
  float* y_f = (float*)carve(2 * M * 384 * 4);
  float* P = (float*)carve(M * IN_COLS * 4);
  float* mix = (float*)carve(M * DM * 4);
  float* big = (float*)carve(M * 7584 * 4);
  float* tq = big;            float* tkv = tq + M * 384;  float* mq = tkv + M * 512; float* mk = mq + M * 384;
  float* gq = mk + M * 384;   float* gk = gq + M * 384;
  float* rwx = gk + M * 128;  float* dec = rwx + M * RWC; float* kd = dec + 2 * M * 384; float* bd = kd + 2 * M * 384;
  float* kk = bd + 2 * M * 384; float* gg = kk + M * 384; float* yy = gg + M * 384;

  LAUNCH(nk_copy_in, MA * DM, I.x, I.ctx, xs);
  LAUNCH(nk_mod, 2L * (BATCH + 1) * 6144, I.c, I.c_ctx, I.ada_w, I.ada_b, mod);
  for (int l = 0; l < 2; ++l) {
    LAUNCH(ok_cvt_wT, 2688L * 1024, I.w_in + (long)l * DM * IN_COLS, w_inT + (long)l * 2688 * 1024, 1024, IN_COLS, 2688);
    LAUNCH(ok_cvt_wT, 1024L * 1024, I.w_out + (long)l * DM * DM, w_outT + (long)l * 1024 * 1024, 1024, 1024, 1024);
    LAUNCH(ok_cvt_wT, 2048L * 1024, I.pe_wq + (long)l * DM * 2048, wqT + (long)l * 2048 * 1024, 1024, 2048, 2048);
  }
  LAUNCH(ok_cvt_bf16_v8, 2L * 16 * 128 * 128 / 8, I.pe_keys, keysb, 2L * 16 * 128 * 128 / 8);
  const int TM = NROWS / 128;
  for (int l = 0; l < 2; ++l) {
    const float* modl = mod + (long)l * (BATCH + 1) * 6144;
    ok_norm_mod_bf16<<<(NROWS + 3) / 4, 256, 0, stream>>>(xs, I.norm_mix_g + l * DM, modl, 0, xn, NROWS);
    ok_gemm<<<TM * 21, 256, 0, stream>>>(xn, DM, w_inT + (long)l * 2688 * 1024, 1024, 1024, TM, 21, EpiStoreBf16{Pb, IN_COLS, IN_COLS});
    for (int b = 0; b < BATCH; ++b) {
      LAUNCH(ok_bf16_to_f32, M * IN_COLS, Pb + (long)b * RB * IN_COLS, P, M * IN_COLS);
      LAUNCH(nk_mla_q1, M * 384, P, I.mla_q_norm_g + l * 256, I.mla_w_qb + (long)l * 256 * 384, tq, (int)M);
      LAUNCH(nk_mla_kv1, M * 512, P, I.mla_kv_norm_g + l * 128, I.mla_w_kvb + (long)l * 128 * 512, tkv, (int)M);
      LAUNCH(nk_mla_qk2, M * 8, P, tq, tkv, I.mla_qk_g + l * 192, mq, mk, (int)M);
      LAUNCH(nk_gqa_prep, M * 8, P, I.gqa_qk_g + l * 128, gq, gk, (int)M);
      LAUNCH(ok_adapt_rows, M * 384, mq, 384, 0, 384, 0.14724445f, mq_b + (long)b * RB * 384, 384, (int)M);
      LAUNCH(ok_adapt_rows, M * 384, mk, 384, 0, 384, 1.f, mk_b + (long)b * RB * 384, 384, (int)M);
      LAUNCH(ok_adapt_vT, 4L * 64 * RB, tkv, 512, 64, 128, 4, mvT + (long)b * 4 * 64 * RB);
      LAUNCH(ok_adapt_rows, M * 384, gq, 384, 0, 384, 0.18033688f, gq_b + (long)b * RB * 384, 384, (int)M);
      LAUNCH(ok_adapt_rows, M * 128, gk, 128, 0, 128, 1.f, gk_b + (long)b * RB * 128, 128, (int)M);
      LAUNCH(ok_adapt_vT, 2L * 64 * RB, P, IN_COLS, GQA_OFF + 512, 64, 2, gvT + (long)b * 2 * 64 * RB);
      LAUNCH(nk_rw_shift, M * RWC, P, I.rw_mu + (long)l * 2 * RWC, rwx, (int)M);
      LAUNCH(nk_rw_prep, M * 384, rwx, I.rw_w0 + l * 768, I.rw_w2 + (long)l * 2 * 64 * 384, I.rw_a0 + l * 768, I.rw_a2 + (long)l * 2 * 64 * 384,
             I.rw_g2 + (long)l * 160 * 384, I.rw_k_k + l * 384, I.rw_k_a + l * 384, dec, kd, bd, kk, gg, (int)M);
      LAUNCH(ok_adapt_rows, M * 384, rwx, RWC, 0, 384, 1.f, r_b, 384, (int)M);
      LAUNCH(ok_adapt_rows, M * 384, rwx, RWC, 768, 384, 1.f, v_b, 384, (int)M);
      LAUNCH(ok_adapt_rows, M * 384, kk, 384, 0, 384, 1.f, kk_b, 384, (int)M);
      for (int d = 0; d < 2; ++d) {
        LAUNCH(ok_adapt_rows, M * 384, kd + d * M * 384, 384, 0, 384, 1.f, kd_b + d * M * 384, 384, (int)M);
        LAUNCH(ok_adapt_rows, M * 384, bd + d * M * 384, 384, 0, 384, 1.f, bd_b + d * M * 384, 384, (int)M);
        LAUNCH(ok_copy_rows_f32, M * 384, dec + d * M * 384, 384, 0, 384, w_f + d * M * 384, 384, (int)M);
      }
      ok_rw_scan<<<24, 256, 0, stream>>>(r_b, v_b, kk_b, kd_b, bd_b, w_f, y_f, 0, 24, (long)M * 384);
      LAUNCH(nk_rw_readout, M * 6, rwx, y_f, kd, gg, I.rw_r_k + l * 384, I.rw_ln_g + l * 384, I.rw_ln_b + l * 384, mix, (int)M, (long)M * 384);
      LAUNCH(ok_adapt_rows, M * 384, mix, 1024, 256, 384, 1.f, mixall + (long)b * RB * DM + 256, 1024, (int)M);
    }
    ok_attn<<<BATCH * 10 * 18, 256, 0, stream>>>(mq_b, mk_b, mvT, gq_b, gk_b, gvT, mixall, 18);
    ok_gemm<<<TM * 8, 256, 0, stream>>>(mixall, DM, w_outT + (long)l * 1024 * 1024, 1024, 1024, TM, 8, EpiResid{xs, modl, 2, 0});
    ok_norm_mod_bf16<<<(NROWS + 3) / 4, 256, 0, stream>>>(xs, I.norm_ffn_g + l * DM, modl, 3, xn, NROWS);
    LAUNCH(ok_cvt_bf16_v8, 16384L * DM / 8, I.pe_u + (long)l * 16384 * DM, ub, 16384L * DM / 8);
    LAUNCH(ok_cvt_bf16_v8, 16384L * DM / 8, I.pe_v + (long)l * 16384 * DM, vb, 16384L * DM / 8);
    ok_peer_q_top1<<<TM * 16, 256, 0, stream>>>(xn, wqT + (long)l * 2048 * 1024, keysb + (long)l * 16 * 128 * 128, top1, TM);
    ok_peer_gather<<<NROWS / 32, 256, 0, stream>>>(xn, top1, ub, vb, modl, xs, NROWS / 32);
  }
  LAUNCH(nk_copy_out, (long)BATCH * SEQ * DM, xs, out);
}

extern "C" void kernel_launch(void* const* d_in, const int* in_sizes, int n_in, void* d_out, int out_size, void* d_ws, size_t ws_size,
                              hipStream_t stream) {
  NaiveIn I; const float** pp = (const float**)&I;
  for (int i = 0; i < 31; ++i) pp[i] = (const float*)d_in[i];
  forward_v5(I, (float*)d_out, (char*)d_ws, stream);
}
```

```cpp
#include <hip/hip_runtime.h>
#ifndef BATCH
#define BATCH 8
#endif
#ifndef SEQ
#define SEQ 2048
#endif
#ifndef CTX_LEN
#define CTX_LEN 256
#endif
#define DM 1024
#define RB (SEQ + CTX_LEN)
#define NROWS (BATCH * RB)
#define IN_COLS 2624
#define MLA_OFF 0
#define RW_OFF 416
#define GQA_OFF 1984
#define RWC 1568
#define EPSN 1e-6f

__device__ inline float sigmoidf_(float x) { return 1.f / (1.f + expf(-x)); }
__device__ inline float siluf_(float x) { return x * sigmoidf_(x); }
__device__ inline float softplusf_(float x) { return fmaxf(x, 0.f) + log1pf(expf(-fabsf(x))); }
__device__ inline float geluf_(float x) { return 0.5f * x * (1.f + tanhf(0.7978845608028654f * (x + 0.044715f * x * x * x))); }

__global__ void nk_copy_in(const float* x, const float* ctx, float* xs) {
  long i = (long)blockIdx.x * blockDim.x + threadIdx.x;
  if (i >= (long)NROWS * DM) return;
  int d = i % DM; long row = i / DM; int b = row / RB, lr = row % RB;
  xs[i] = lr < SEQ ? x[((long)b * SEQ + lr) * DM + d] : ctx[((long)b * CTX_LEN + (lr - SEQ)) * DM + d];
}
__global__ void nk_copy_out(const float* xs, float* out) {
  long i = (long)blockIdx.x * blockDim.x + threadIdx.x;
  if (i >= (long)BATCH * SEQ * DM) return;
  int d = i % DM; long row = i / DM; int b = row / SEQ, t = row % SEQ;
  out[i] = xs[((long)b * RB + t) * DM + d];
}
__global__ void nk_mod(const float* c, const float* c_ctx, const float* ada_w, const float* ada_b, float* mod) {
  long i = (long)blockIdx.x * blockDim.x + threadIdx.x;
  if (i >= 2L * (BATCH + 1) * 6144) return;
  int j = i % 6144; int bb = (i / 6144) % (BATCH + 1); int l = i / (6144 * (BATCH + 1));
  const float* cv = bb < BATCH ? c + (long)bb * DM : c_ctx;
  const float* w = ada_w + (long)l * DM * 6144;
  float acc = 0.f;
  for (int k = 0; k < DM; ++k) acc += siluf_(cv[k]) * w[(long)k * 6144 + j];
  mod[i] = acc + ada_b[l * 6144 + j];
}
__global__ void nk_norm_mod(const float* xs, const float* g, const float* modl, int shift_idx, float* xn, int M, int bidx) {
  long row = (long)blockIdx.x * blockDim.x + threadIdx.x;
  if (row >= M) return;
  int lr = row % RB; int bb = lr < SEQ ? bidx : BATCH;
  const float* sh = modl + ((long)bb * 6 + shift_idx) * DM; const float* sc = sh + DM;
  const float* xr = xs + row * DM; float ss = 0.f;
  for (int d = 0; d < DM; ++d) ss += xr[d] * xr[d];
  float inv = 1.f / sqrtf(ss / DM + EPSN);
  for (int d = 0; d < DM; ++d) xn[row * DM + d] = xr[d] * inv * g[d] * (1.f + sc[d]) + sh[d];
}
__global__ void nk_gemm(const float* A, const float* W, float* C, int M, int N, int K) {
  long i = (long)blockIdx.x * blockDim.x + threadIdx.x;
  if (i >= (long)M * N) return;
  int n = i % N; long m = i / N; float acc = 0.f;
  for (int k = 0; k < K; ++k) acc += A[m * K + k] * W[(long)k * N + n];
  C[i] = acc;
}
__global__ void nk_mla_q1(const float* P, const float* qng, const float* wqb, float* tq, int M) {
  long i = (long)blockIdx.x * blockDim.x + threadIdx.x;
  if (i >= (long)M * 384) return;
  int j = i % 384; long r = i / 384; const float* cq = P + r * IN_COLS;
  float ss = 0.f; for (int k = 0; k < 256; ++k) ss += cq[k] * cq[k];
  float inv = 1.f / sqrtf(ss / 256 + EPSN), acc = 0.f;
  for (int k = 0; k < 256; ++k) acc += cq[k] * inv * qng[k] * wqb[k * 384 + j];
  tq[i] = acc;
}
__global__ void nk_mla_kv1(const float* P, const float* kvng, const float* wkvb, float* tkv, int M) {
  long i = (long)blockIdx.x * blockDim.x + threadIdx.x;
  if (i >= (long)M * 512) return;
  int j = i % 512; long r = i / 512; const float* ck = P + r * IN_COLS + 256;
  float ss = 0.f; for (int k = 0; k < 128; ++k) ss += ck[k] * ck[k];
  float inv = 1.f / sqrtf(ss / 128 + EPSN), acc = 0.f;
  for (int k = 0; k < 128; ++k) acc += ck[k] * inv * kvng[k] * wkvb[k * 512 + j];
  tkv[i] = acc;
}
__global__ void nk_mla_qk2(const float* P, const float* tq, const float* tkv, const float* qkg, float* mq, float* mk, int M) {
  long i = (long)blockIdx.x * blockDim.x + threadIdx.x;
  if (i >= (long)M * 8) return;
  int which = i % 2, h = (i / 2) % 4; long r = i / 8; int lr = r % RB;
  float ss = 0.f;
  for (int e = 0; e < 96; ++e) {
    float v = which == 0 ? tq[r * 384 + h * 96 + e] : (e < 64 ? tkv[r * 512 + h * 128 + e] : P[r * IN_COLS + 384 + (e - 64)]);
    ss += v * v;
  }
  float inv = 1.f / sqrtf(ss / 96 + EPSN);
  const float* g = qkg + which * 96; float* o = (which == 0 ? mq : mk) + r * 384 + h * 96;
  for (int e = 0; e < 64; ++e) {
    float v = which == 0 ? tq[r * 384 + h * 96 + e] : tkv[r * 512 + h * 128 + e];
    o[e] = v * inv * g[e];
  }
  for (int j = 0; j < 16; ++j) {
    float va = which == 0 ? tq[r * 384 + h * 96 + 64 + j] : P[r * IN_COLS + 384 + j];
    float vb = which == 0 ? tq[r * 384 + h * 96 + 80 + j] : P[r * IN_COLS + 384 + 16 + j];
    va *= inv * g[64 + j]; vb *= inv * g[80 + j];
    if (lr < SEQ) {
      int pos = j < 8 ? lr / 64 : lr % 64; float fr = powf(10000.f, -(float)(j & 7) / 8.f);
      float ang = (float)pos * fr, cs = cosf(ang), sn = sinf(ang);
      o[64 + j] = va * cs - vb * sn; o[80 + j] = va * sn + vb * cs;
    } else { o[64 + j] = va; o[80 + j] = vb; }
  }
}
__global__ void nk_gqa_prep(const float* P, const float* qkg, float* gq, float* gk, int M) {
  long i = (long)blockIdx.x * blockDim.x + threadIdx.x;
  if (i >= (long)M * 8) return;
  int h = i % 8; long r = i / 8; int lr = r % RB;
  const float* src = P + r * IN_COLS + GQA_OFF + h * 64;
  const float* g = qkg + (h < 6 ? 0 : 64);
  float* o = h < 6 ? gq + r * 384 + h * 64 : gk + r * 128 + (h - 6) * 64;
  float ss = 0.f; for (int e = 0; e < 64; ++e) ss += src[e] * src[e];
  float inv = 1.f / sqrtf(ss / 64 + EPSN);
  for (int j = 0; j < 32; ++j) {
    float va = src[j] * inv * g[j], vb = src[32 + j] * inv * g[32 + j];
    if (lr < SEQ) {
      int pos = j < 16 ? lr / 64 : lr % 64; float fr = powf(10000.f, -(float)(j & 15) / 16.f);
      float ang = (float)pos * fr, cs = cosf(ang), sn = sinf(ang);
      o[j] = va * cs - vb * sn; o[32 + j] = va * sn + vb * cs;
    } else { o[j] = va; o[32 + j] = vb; }
  }
}
template <int DQ>
__global__ void __launch_bounds__(256) nk_attn(const float* q, int qs, const float* k, int ks, const float* v, int vs, int vhs, int H, int G, float* mix, int ooff, int M) {
  long i = (long)blockIdx.x * blockDim.x + threadIdx.x;
  if (i >= (long)M * H) return;
  int h = i % H; long r = i / H; int b = r / RB, lr = r % RB; int kh = h / G;
  float qv[DQ];
#pragma unroll
  for (int e = 0; e < DQ; ++e) qv[e] = q[r * qs + h * DQ + e];
  float acc[64];
#pragma unroll
  for (int e = 0; e < 64; ++e) acc[e] = 0.f;
  float mx = -1e30f, l = 0.f; const float scale = 1.f / sqrtf((float)DQ);
  int k0 = lr < SEQ ? 0 : SEQ, k1 = RB;
  for (int kr = k0; kr < k1; ++kr) {
    long rr = (long)b * RB + kr; const float* kp = k + rr * ks + kh * DQ; float s = 0.f;
#pragma unroll
    for (int e = 0; e < DQ; ++e) s += qv[e] * kp[e];
    s *= scale;
    float mn = fmaxf(mx, s), al = expf(mx - mn), pp = expf(s - mn);
    l = l * al + pp; mx = mn; const float* vp = v + rr * vs + kh * vhs;
#pragma unroll
    for (int e = 0; e < 64; ++e) acc[e] = acc[e] * al + pp * vp[e];
  }
#pragma unroll
  for (int e = 0; e < 64; ++e) mix[r * DM + ooff + h * 64 + e] = acc[e] / l;
}
__global__ void nk_rw_shift(const float* P, const float* mu, float* rwx, int M) {
  long i = (long)blockIdx.x * blockDim.x + threadIdx.x;
  if (i >= (long)M * RWC) return;
  int c = i % RWC; long r = i / RWC; int lr = r % RB;
  bool first = (lr == 0) || (lr == SEQ), last = (lr == SEQ - 1) || (lr == RB - 1);
  float p = P[r * IN_COLS + RW_OFF + c];
  float pv = first ? 0.f : P[(r - 1) * IN_COLS + RW_OFF + c], nx = last ? 0.f : P[(r + 1) * IN_COLS + RW_OFF + c];
  rwx[i] = p + mu[c] * (pv - p) + mu[RWC + c] * (nx - p);
}
__global__ void nk_rw_prep(const float* rwx, const float* w0, const float* w2, const float* a0, const float* a2, const float* g2,
                           const float* k_k, const float* k_a, float* dec, float* kd, float* bd, float* kk, float* gg, int M) {
  long i = (long)blockIdx.x * blockDim.x + threadIdx.x;
  if (i >= (long)M * 384) return;
  int c = i % 384; long r = i / 384; int h = c / 64; const float* xr = rwx + r * RWC;
  float kv = xr[384 + c];
  float ss = 0.f; for (int n = 0; n < 64; ++n) { float t = xr[384 + h * 64 + n] * k_k[h * 64 + n]; ss += t * t; }
  float kkv = kv * k_k[c] / sqrtf(ss + 1e-12f);
  kk[i] = kkv;
  for (int d = 0; d < 2; ++d) {
    float wr = w0[d * 384 + c], ar = a0[d * 384 + c];
    for (int j = 0; j < 64; ++j) { wr += tanhf(xr[1152 + d * 64 + j]) * w2[(d * 64 + j) * 384 + c]; ar += xr[1280 + d * 64 + j] * a2[(d * 64 + j) * 384 + c]; }
    float dc = expf(-expf(-softplusf_(-wr) - 0.5f)); float a = sigmoidf_(ar);
    dec[(long)d * M * 384 + i] = dc; kd[(long)d * M * 384 + i] = kv * (1.f + (a - 1.f) * k_a[c]); bd[(long)d * M * 384 + i] = kkv * a;
  }
  float g = 0.f; for (int j = 0; j < 160; ++j) g += sigmoidf_(xr[1408 + j]) * g2[j * 384 + c];
  gg[i] = g;
}
__global__ void __launch_bounds__(256) nk_rw_scan(const float* rwx, const float* dec, const float* kd, const float* bd, const float* kk, float* y, int M, int nb) {
  long t = (long)blockIdx.x * blockDim.x + threadIdx.x;
  if (t >= (long)nb * 2 * 6 * 64) return;
  int i = t % 64, h = (t / 64) % 6, d = (t / 384) % 2, b = t / 768;
  float S[64];
#pragma unroll
  for (int j = 0; j < 64; ++j) S[j] = 0.f;
  for (int step = 0; step < RB; ++step) {
    int lr;
    if (step < CTX_LEN) lr = SEQ + (d == 0 ? step : CTX_LEN - 1 - step);
    else lr = d == 0 ? step - CTX_LEN : SEQ - 1 - (step - CTX_LEN);
    long r = (long)b * RB + lr; long o = (long)d * M * 384 + r * 384 + h * 64;
    const float* rp = rwx + r * RWC + h * 64; const float* wp = dec + o; const float* kp = kd + o; const float* bp = bd + o; const float* kkp = kk + r * 384 + h * 64;
    float vi = rwx[r * RWC + 768 + h * 64 + i];
    float skk = 0.f;
#pragma unroll
    for (int j = 0; j < 64; ++j) skk += S[j] * kkp[j];
    float yy = 0.f;
#pragma unroll
    for (int j = 0; j < 64; ++j) { S[j] = S[j] * wp[j] - skk * bp[j] + vi * kp[j]; yy += S[j] * rp[j]; }
    y[o + i] = yy;
  }
}
__global__ void nk_rw_readout(const float* rwx, const float* y, const float* kd, const float* gg, const float* r_k, const float* ln_g, const float* ln_b, float* mix, int M, long yds) {
  long i = (long)blockIdx.x * blockDim.x + threadIdx.x;
  if (i >= (long)M * 6) return;
  int h = i % 6; long r = i / 6; long o = r * 384 + h * 64; long ds = (long)M * 384;
  float mean = 0.f; for (int n = 0; n < 64; ++n) mean += y[o + n] + y[yds + o + n];
  mean /= 64.f;
  float var = 0.f, coef = 0.f;
  for (int n = 0; n < 64; ++n) {
    float yy = y[o + n] + y[yds + o + n] - mean; var += yy * yy;
    coef += rwx[r * RWC + h * 64 + n] * (kd[o + n] + kd[ds + o + n]) * r_k[h * 64 + n];
  }
  var /= 64.f; float inv = 1.f / sqrtf(var + 64e-5f);
  for (int n = 0; n < 64; ++n) {
    float yn = (y[o + n] + y[yds + o + n] - mean) * inv * ln_g[h * 64 + n] + ln_b[h * 64 + n];
    mix[r * DM + 256 + h * 64 + n] = (yn + coef * rwx[r * RWC + 768 + h * 64 + n]) * gg[o + n];
  }
}
__global__ void nk_gemm_res(const float* A, const float* W, const float* modl, int gi, float* xs, int M, int bidx) {
  long i = (long)blockIdx.x * blockDim.x + threadIdx.x;
  if (i >= (long)M * DM) return;
  int j = i % DM; long r = i / DM; int lr = r % RB; int bb = lr < SEQ ? bidx : BATCH;
  float acc = 0.f; for (int k = 0; k < DM; ++k) acc += A[r * DM + k] * W[(long)k * DM + j];
  xs[i] += modl[((long)bb * 6 + gi) * DM + j] * acc;
}
__global__ void nk_peer_score(const float* pq, const float* keys, float* sc, int M) {
  long i = (long)blockIdx.x * blockDim.x + threadIdx.x;
  if (i >= (long)M * 2048) return;
  int k = i % 128, ps = (i / 128) % 16; long r = i / 2048;
  const float* q = pq + r * 2048 + ps * 128; const float* ky = keys + ((long)ps * 128 + k) * 128;
  float acc = 0.f; for (int d = 0; d < 128; ++d) acc += q[d] * ky[d];
  sc[i] = acc;
}
__global__ void nk_peer_top1(const float* sc, float* ts, int* ti, int M) {
  long i = (long)blockIdx.x * blockDim.x + threadIdx.x;
  if (i >= (long)M * 16) return;
  const float* s = sc + i * 128; float pv = 3e38f; int pi = -1;
  for (int t = 0; t < 16; ++t) {
    float bv = -3e38f; int bi = -1;
    for (int k = 0; k < 128; ++k) {
      float v = s[k]; bool ok = (v < pv) || (v == pv && k > pi);
      if (ok && (bi < 0 || v > bv)) { bv = v; bi = k; }
    }
    ts[i * 16 + t] = bv; ti[i * 16 + t] = bi; pv = bv; pi = bi;
  }
}
__global__ void nk_peer_top2(const float* ts, const int* ti, int* pe, float* pg, int M) {
  long i = (long)blockIdx.x * blockDim.x + threadIdx.x;
  if (i >= (long)M * 8) return;
  const float* s1 = ts + i * 32; const float* s2 = s1 + 16; const int* i1 = ti + i * 32; const int* i2 = i1 + 16;
  float pv = 3e38f; int pi = -1; float mx = 0.f, sum = 0.f;
  for (int t = 0; t < 16; ++t) {
    float bv = -3e38f; int bi = -1;
    for (int c = 0; c < 256; ++c) {
      float v = s1[c / 16] + s2[c % 16]; bool ok = (v < pv) || (v == pv && c > pi);
      if (ok && (bi < 0 || v > bv)) { bv = v; bi = c; }
    }
    if (t == 0) mx = bv;
    float e = expf(bv - mx); sum += e;
    pe[i * 16 + t] = i1[bi / 16] * 128 + i2[bi % 16]; pg[i * 16 + t] = e; pv = bv; pi = bi;
  }
  for (int t = 0; t < 16; ++t) pg[i * 16 + t] /= sum;
}
__global__ void nk_peer_act(const float* xn, const float* u, const int* pe, const float* pg, float* pw, int M) {
  long i = (long)blockIdx.x * blockDim.x + threadIdx.x;
  if (i >= (long)M * 128) return;
  long r = i / 128; const float* ur = u + (long)pe[i] * DM; const float* xr = xn + r * DM;
  float acc = 0.f; for (int d = 0; d < DM; ++d) acc += xr[d] * ur[d];
  pw[i] = pg[i] * geluf_(acc);
}
__global__ void nk_peer_out(const float* v, const int* pe, const float* pw, const float* modl, float* xs, int M, int bidx) {
  long i = (long)blockIdx.x * blockDim.x + threadIdx.x;
  if (i >= (long)M * DM) return;
  int j = i % DM; long r = i / DM; int lr = r % RB; int bb = lr < SEQ ? bidx : BATCH;
  float acc = 0.f; for (int k = 0; k < 128; ++k) acc += pw[r * 128 + k] * v[(long)pe[r * 128 + k] * DM + j];
  xs[i] += modl[((long)bb * 6 + 5) * DM + j] * acc;
}

#ifndef LAUNCH
#define LAUNCH(kern, nthreads, ...) kern<<<(unsigned)(((long)(nthreads) + 255) / 256), 256, 0, stream>>>(__VA_ARGS__)
#endif

struct NaiveIn {
  const float *x, *c, *ctx, *c_ctx, *ada_w, *ada_b, *norm_mix_g, *norm_ffn_g, *w_in, *w_out, *mla_q_norm_g, *mla_w_qb, *mla_kv_norm_g,
      *mla_w_kvb, *mla_qk_g, *rw_mu, *rw_w0, *rw_w2, *rw_a0, *rw_a2, *rw_g2, *rw_k_k, *rw_k_a, *rw_r_k, *rw_ln_g, *rw_ln_b, *gqa_qk_g,
      *pe_wq, *pe_keys, *pe_u, *pe_v;
};

static void naive_forward(const NaiveIn& I, float* out, float* ws, hipStream_t stream) {
  const long M = RB;
  float* p = ws;
  float* xs = p;  p += (long)NROWS * DM;
  float* mod = p; p += 2L * (BATCH + 1) * 6144;
  float* xn = p;  p += M * DM;
  float* P = p;   p += M * IN_COLS;
  float* mix = p; p += M * DM;
  float* big = p;
  float* tq = big;            float* tkv = tq + M * 384;  float* mq = tkv + M * 512; float* mk = mq + M * 384;
  float* gq = mk + M * 384;   float* gk = gq + M * 384;
  float* rwx = gk + M * 128;  float* dec = rwx + M * RWC; float* kd = dec + 2 * M * 384; float* bd = kd + 2 * M * 384;
  float* kk = bd + 2 * M * 384; float* gg = kk + M * 384; float* yy = gg + M * 384;
  float* pq = P; float* sc = big; float* ts = sc + M * 2048; int* ti = (int*)(ts + M * 256); int* pe = ti + M * 256;
  float* pg = (float*)(pe + M * 128); float* pw = pg + M * 128;

  LAUNCH(nk_copy_in, (long)NROWS * DM, I.x, I.ctx, xs);
  LAUNCH(nk_mod, 2L * (BATCH + 1) * 6144, I.c, I.c_ctx, I.ada_w, I.ada_b, mod);
  for (int l = 0; l < 2; ++l) for (int b = 0; b < BATCH; ++b) {
    const float* modl = mod + (long)l * (BATCH + 1) * 6144;
    float* xb = xs + (long)b * RB * DM;
    LAUNCH(nk_norm_mod, M, xb, I.norm_mix_g + l * DM, modl, 0, xn, (int)M, b);
    LAUNCH(nk_gemm, M * IN_COLS, xn, I.w_in + (long)l * DM * IN_COLS, P, (int)M, IN_COLS, DM);
    LAUNCH(nk_mla_q1, M * 384, P, I.mla_q_norm_g + l * 256, I.mla_w_qb + (long)l * 256 * 384, tq, (int)M);
    LAUNCH(nk_mla_kv1, M * 512, P, I.mla_kv_norm_g + l * 128, I.mla_w_kvb + (long)l * 128 * 512, tkv, (int)M);
    LAUNCH(nk_mla_qk2, M * 8, P, tq, tkv, I.mla_qk_g + l * 192, mq, mk, (int)M);
    LAUNCH(nk_gqa_prep, M * 8, P, I.gqa_qk_g + l * 128, gq, gk, (int)M);
    LAUNCH(nk_attn<96>, M * 4, mq, 384, mk, 384, tkv + 64, 512, 128, 4, 1, mix, 0, (int)M);
    LAUNCH(nk_attn<64>, M * 6, gq, 384, gk, 128, P + GQA_OFF + 512, IN_COLS, 64, 6, 3, mix, 640, (int)M);
    LAUNCH(nk_rw_shift, M * RWC, P, I.rw_mu + (long)l * 2 * RWC, rwx, (int)M);
    LAUNCH(nk_rw_prep, M * 384, rwx, I.rw_w0 + l * 768, I.rw_w2 + (long)l * 2 * 64 * 384, I.rw_a0 + l * 768, I.rw_a2 + (long)l * 2 * 64 * 384,
           I.rw_g2 + (long)l * 160 * 384, I.rw_k_k + l * 384, I.rw_k_a + l * 384, dec, kd, bd, kk, gg, (int)M);
    LAUNCH(nk_rw_scan, 768L, rwx, dec, kd, bd, kk, yy, (int)M, 1);
    LAUNCH(nk_rw_readout, M * 6, rwx, yy, kd, gg, I.rw_r_k + l * 384, I.rw_ln_g + l * 384, I.rw_ln_b + l * 384, mix, (int)M, (long)M * 384);
    LAUNCH(nk_gemm_res, M * DM, mix, I.w_out + (long)l * DM * DM, modl, 2, xb, (int)M, b);
    LAUNCH(nk_norm_mod, M, xb, I.norm_ffn_g + l * DM, modl, 3, xn, (int)M, b);
    LAUNCH(nk_gemm, M * 2048, xn, I.pe_wq + (long)l * DM * 2048, pq, (int)M, 2048, DM);
    LAUNCH(nk_peer_score, M * 2048, pq, I.pe_keys + (long)l * 16 * 128 * 128, sc, (int)M);
#ifdef HOST_PEER_TEST
    LAUNCH(hk_peer_top1, M * 16, pq, I.pe_keys + (long)l * 16 * 128 * 128, (unsigned*)ts, (int)M);
    LAUNCH(hk_peer_combine, M * 8, (const unsigned*)ts, pe, pg, (int)M);
#else
    LAUNCH(nk_peer_top1, M * 16, sc, ts, ti, (int)M);
    LAUNCH(nk_peer_top2, M * 8, ts, ti, pe, pg, (int)M);
#endif
    LAUNCH(nk_peer_act, M * 128, xn, I.pe_u + (long)l * 16384 * DM, pe, pg, pw, (int)M);
    LAUNCH(nk_peer_out, M * DM, I.pe_v + (long)l * 16384 * DM, pe, pw, modl, xb, (int)M, b);
  }
  LAUNCH(nk_copy_out, (long)BATCH * SEQ * DM, xs, out);
}
__device__ __forceinline__ unsigned f2sortable(float s) { unsigned f = __float_as_uint(s); return (f & 0x80000000u) ? ~f : (f | 0x80000000u); }
__device__ __forceinline__ float sortable2f(unsigned o) { unsigned f = (o & 0x80000000u) ? (o & 0x7fffffffu) : ~o; return __uint_as_float(f); }
__device__ __forceinline__ unsigned enc_key(float s, int idx) { return (f2sortable(s) & ~127u) | (unsigned)(127 - idx); }
__device__ __forceinline__ void dec_key(unsigned k, float& s, int& idx) { idx = 127 - (int)(k & 127u); s = sortable2f(k & ~127u); }
__device__ __forceinline__ unsigned umax_(unsigned a, unsigned b) { return a > b ? a : b; }
__device__ __forceinline__ unsigned umin_(unsigned a, unsigned b) { return a < b ? a : b; }
__device__ __forceinline__ void ins16(unsigned (&l)[16], unsigned x) {
#pragma unroll
  for (int i = 0; i < 16; ++i) { unsigned mx = umax_(l[i], x); x = umin_(l[i], x); l[i] = mx; }
}
__device__ __forceinline__ void merge16(unsigned (&a)[16], const unsigned (&brev)[16]) {
#pragma unroll
  for (int i = 0; i < 16; ++i) a[i] = umax_(a[i], brev[i]);
#pragma unroll
  for (int d = 8; d >= 1; d >>= 1)
#pragma unroll
    for (int i = 0; i < 16; ++i) if ((i & d) == 0) { unsigned hi = umax_(a[i], a[i + d]), lo = umin_(a[i], a[i + d]); a[i] = hi; a[i + d] = lo; }
}
__device__ __forceinline__ void peer_combine(const unsigned* L0, const unsigned* L1, int* e_out, float* g_out) {
  float s0[16], s1[16];
#pragma unroll
  for (int i = 0; i < 16; ++i) { int ix; dec_key(L0[i], s0[i], ix); dec_key(L1[i], s1[i], ix); }
  unsigned sel[16];
#pragma unroll
  for (int i = 0; i < 16; ++i) sel[i] = 0u;
#pragma unroll
  for (int i = 0; i < 16; ++i)
#pragma unroll
    for (int j = 0; j < 16; ++j)
      if ((i + 1) * (j + 1) <= 16) { unsigned k = (f2sortable(s0[i] + s1[j]) & ~255u) | (unsigned)(255 - (i * 16 + j)); ins16(sel, k); }
  float mx = -3e38f;
#pragma unroll
  for (int t = 0; t < 16; ++t) {
    int c = 255 - (int)(sel[t] & 255u); int i = c >> 4, j = c & 15;
    float a, b; int ia, ib; dec_key(L0[i], a, ia); dec_key(L1[j], b, ib);
    float s = a + b; e_out[t] = ia * 128 + ib; g_out[t] = s; mx = fmaxf(mx, s);
  }
  float sum = 0.f;
#pragma unroll
  for (int t = 0; t < 16; ++t) { float e = expf(g_out[t] - mx); g_out[t] = e; sum += e; }
  float inv = 1.f / sum;
#pragma unroll
  for (int t = 0; t < 16; ++t) g_out[t] *= inv;
}
__global__ void hk_peer_top1(const float* pq, const float* keys, unsigned* top1, int M) {
  long i = (long)blockIdx.x * blockDim.x + threadIdx.x;
  if (i >= (long)M * 16) return;
  int ps = i % 16; long r = i / 16; const float* q = pq + r * 2048 + ps * 128;
  unsigned la[16], lb[16], lbr[16];
#pragma unroll
  for (int t = 0; t < 16; ++t) { la[t] = 0u; lb[t] = 0u; }
  for (int k = 0; k < 128; ++k) {
    const float* ky = keys + ((long)ps * 128 + k) * 128; float acc = 0.f;
    for (int d = 0; d < 128; ++d) acc += q[d] * ky[d];
    unsigned key = enc_key(acc, k);
    if (k < 64) ins16(la, key); else ins16(lb, key);
  }
#pragma unroll
  for (int t = 0; t < 16; ++t) lbr[t] = lb[15 - t];
  merge16(la, lbr);
#pragma unroll
  for (int t = 0; t < 16; ++t) top1[i * 16 + t] = la[t];
}
__global__ void hk_peer_combine(const unsigned* top1, int* pe, float* pg, int M) {
  long i = (long)blockIdx.x * blockDim.x + threadIdx.x;
  if (i >= (long)M * 8) return;
  peer_combine(top1 + i * 32, top1 + i * 32 + 16, pe + i * 16, pg + i * 16);
}
typedef unsigned short bf16_t;
typedef __attribute__((ext_vector_type(8))) short bf16x8;
typedef __attribute__((ext_vector_type(4))) float f32x4;
typedef __attribute__((ext_vector_type(16))) float f32x16;
typedef __attribute__((ext_vector_type(4))) unsigned u32x4;

__device__ __forceinline__ bf16_t f2bf(float f) {
  unsigned u = __float_as_uint(f); u += 0x7fffu + ((u >> 16) & 1u); return (bf16_t)(u >> 16);
}
__device__ __forceinline__ float bf2f(bf16_t h) { return __uint_as_float(((unsigned)h) << 16); }
__device__ __forceinline__ unsigned pack2bf(float a, float b) { return (unsigned)f2bf(a) | ((unsigned)f2bf(b) << 16); }

#define GEMM_LDS_BYTES 32768
struct ALoadPlain { const bf16_t* A; int lda;
  __device__ __forceinline__ u32x4 operator()(int row, int k) const { return *(const u32x4*)(A + (long)row * lda + k); } };
template <class ALoad, class Epi>
__device__ __forceinline__ void gemm_tile_128(ALoad aload, const bf16_t* __restrict__ Bt, int ldb, int K,
                                              int tile_m, int tile_n, char* smem, Epi epi) {
  const int t = threadIdx.x, lane = t & 63, wave = t >> 6;
  const int wm = wave >> 1, wn = wave & 1;
  char* As = smem; char* Bs = smem + 16384;
  const int lrow = t >> 3, lchunk = t & 7;
  const int arow = tile_m * 128 + lrow;
  const bf16_t* bg = Bt + (long)(tile_n * 128 + lrow) * ldb + lchunk * 8;
  u32x4 ra[4], rb[4];
#pragma unroll
  for (int i = 0; i < 4; ++i) {
    ra[i] = aload(arow + 32 * i, lchunk * 8);
    rb[i] = *(const u32x4*)(bg + (long)(32 * i) * ldb);
  }
  f32x4 acc[4][4];
#pragma unroll
  for (int i = 0; i < 4; ++i)
#pragma unroll
    for (int j = 0; j < 4; ++j) acc[i][j] = (f32x4){0.f, 0.f, 0.f, 0.f};
  const int fr = lane & 15, fq = lane >> 4;
  for (int k0 = 0; k0 < K; k0 += 64) {
    __syncthreads();
#pragma unroll
    for (int i = 0; i < 4; ++i) {
      int r = lrow + 32 * i; int off = r * 128 + ((lchunk ^ (r & 7)) << 4);
      *(u32x4*)(As + off) = ra[i]; *(u32x4*)(Bs + off) = rb[i];
    }
    __syncthreads();
    if (k0 + 64 < K) {
#pragma unroll
      for (int i = 0; i < 4; ++i) {
        ra[i] = aload(arow + 32 * i, k0 + 64 + lchunk * 8);
        rb[i] = *(const u32x4*)(bg + (long)(32 * i) * ldb + k0 + 64);
      }
    }
#pragma unroll
    for (int ks = 0; ks < 2; ++ks) {
      bf16x8 af[4], bfr[4];
#pragma unroll
      for (int i = 0; i < 4; ++i) {
        int r = wm * 64 + i * 16 + fr; af[i] = *(const bf16x8*)(As + r * 128 + (((ks * 4 + fq) ^ (r & 7)) << 4));
        int rn = wn * 64 + i * 16 + fr; bfr[i] = *(const bf16x8*)(Bs + rn * 128 + (((ks * 4 + fq) ^ (rn & 7)) << 4));
      }
#pragma unroll
      for (int i = 0; i < 4; ++i)
#pragma unroll
        for (int j = 0; j < 4; ++j) acc[i][j] = __builtin_amdgcn_mfma_f32_16x16x32_bf16(bfr[j], af[i], acc[i][j], 0, 0, 0);
    }
  }
#pragma unroll
  for (int i = 0; i < 4; ++i)
#pragma unroll
    for (int j = 0; j < 4; ++j) {
      int m = tile_m * 128 + wm * 64 + i * 16 + fr; int n0 = tile_n * 128 + wn * 64 + j * 16 + fq * 4;
      epi(m, n0, acc[i][j]);
    }
}

__global__ void ok_cvt_wT(const float* W, bf16_t* Wt, int K, int N, int Npad) {
  long i = (long)blockIdx.x * blockDim.x + threadIdx.x;
  if (i >= (long)Npad * K) return;
  int k = i % K; int n = i / K;
  Wt[i] = n < N ? f2bf(W[(long)k * N + n]) : (bf16_t)0;
}
__global__ void ok_f32_to_bf16(const float* s, bf16_t* d, long n) {
  long i = (long)blockIdx.x * blockDim.x + threadIdx.x; if (i < n) d[i] = f2bf(s[i]);
}
__global__ void ok_bf16_to_f32(const bf16_t* s, float* d, long n) {
  long i = (long)blockIdx.x * blockDim.x + threadIdx.x; if (i < n) d[i] = bf2f(s[i]);
}
__global__ void ok_norm_mod_bf16(const float* xs, const float* g, const float* modl, int shift_idx, bf16_t* xn, int M) {
  int row = blockIdx.x * 4 + (threadIdx.x >> 6); int lane = threadIdx.x & 63;
  if (row >= M) return;
  int b = row / RB, lr = row % RB; int bb = lr < SEQ ? b : BATCH;
  const float* sh = modl + ((long)bb * 6 + shift_idx) * DM; const float* sc = sh + DM;
  const float* xr = xs + (long)row * DM; float v[16]; float ss = 0.f;
#pragma unroll
  for (int i = 0; i < 4; ++i) { float4 q = *(const float4*)(xr + i * 256 + lane * 4); v[i*4]=q.x; v[i*4+1]=q.y; v[i*4+2]=q.z; v[i*4+3]=q.w; ss += q.x*q.x+q.y*q.y+q.z*q.z+q.w*q.w; }
#pragma unroll
  for (int o = 32; o > 0; o >>= 1) ss += __shfl_xor(ss, o);
  float inv = 1.f / sqrtf(ss / DM + EPSN);
#pragma unroll
  for (int i = 0; i < 4; ++i) {
    int d = i * 256 + lane * 4; float o[4];
#pragma unroll
    for (int e = 0; e < 4; ++e) o[e] = v[i*4+e] * inv * g[d+e] * (1.f + sc[d+e]) + sh[d+e];
    uint2 pk; pk.x = pack2bf(o[0], o[1]); pk.y = pack2bf(o[2], o[3]);
    *(uint2*)(xn + (long)row * DM + d) = pk;
  }
}

struct EpiStoreBf16 { bf16_t* C; int ldc; int N;
  __device__ __forceinline__ void operator()(int m, int n0, f32x4 v) const {
    if (n0 < N) { uint2 pk; pk.x = pack2bf(v[0], v[1]); pk.y = pack2bf(v[2], v[3]); *(uint2*)(C + (long)m * ldc + n0) = pk; } } };
struct EpiStoreF32 { float* C; int ldc; int N;
  __device__ __forceinline__ void operator()(int m, int n0, f32x4 v) const {
    if (n0 < N) *(float4*)(C + (long)m * ldc + n0) = make_float4(v[0], v[1], v[2], v[3]); } };
struct EpiResid { float* xs; const float* modl; int gi; int pad;
  __device__ __forceinline__ void operator()(int m, int n0, f32x4 v) const {
    int b = m / RB, lr = m % RB; int bb = lr < SEQ ? b : BATCH; const float* g = modl + ((long)bb * 6 + gi) * DM + n0;
    float4 x = *(float4*)(xs + (long)m * DM + n0);
    x.x += g[0] * v[0]; x.y += g[1] * v[1]; x.z += g[2] * v[2]; x.w += g[3] * v[3];
    *(float4*)(xs + (long)m * DM + n0) = x; } };

template <class Epi>
__global__ void __launch_bounds__(256) ok_gemm(const bf16_t* A, int lda, const bf16_t* Bt, int ldb, int K, int tiles_m, int tiles_n, Epi epi) {
  __shared__ __attribute__((aligned(16))) char smem[GEMM_LDS_BYTES];
  for (int tile = blockIdx.x; tile < tiles_m * tiles_n; tile += gridDim.x) {
    int tm = tile / tiles_n, tn = tile % tiles_n;
    gemm_tile_128(ALoadPlain{A, lda}, Bt, ldb, K, tm, tn, smem, epi);
  }
}

typedef __attribute__((ext_vector_type(2))) __bf16 bf16v2;
__device__ __forceinline__ float dot2bf(unsigned a, unsigned b, float c) {
  return __builtin_amdgcn_fdot2_f32_bf16(*(bf16v2*)&a, *(bf16v2*)&b, c, false);
}
__global__ void ok_cvt_bf16_v8(const float* s, bf16_t* d, long n8) {
  long i = (long)blockIdx.x * blockDim.x + threadIdx.x; if (i >= n8) return;
  float4 a = *(const float4*)(s + i * 8), b = *(const float4*)(s + i * 8 + 4);
  u32x4 o; o[0] = pack2bf(a.x, a.y); o[1] = pack2bf(a.z, a.w); o[2] = pack2bf(b.x, b.y); o[3] = pack2bf(b.z, b.w);
  *(u32x4*)(d + i * 8) = o;
}

#define P5_LDS_BYTES (128 * 128 * 4)
__device__ __forceinline__ void peer_q_top1_tile(const bf16_t* __restrict__ A, const bf16_t* __restrict__ WqT, const bf16_t* __restrict__ keysb,
                                                 unsigned* __restrict__ top1, int tm, int ps, char* smem) {
  const int t = threadIdx.x, lane = t & 63, wave = t >> 6, wm = wave >> 1, wn = wave & 1, fr = lane & 15, fq = lane >> 4;
  f32x4 acc[4][4];
  {
    char* As = smem; char* Bs = smem + 16384;
    const int lrow = t >> 3, lchunk = t & 7;
    const bf16_t* ag = A + (long)(tm * 128 + lrow) * DM + lchunk * 8;
    const bf16_t* bg = WqT + (long)(ps * 128 + lrow) * DM + lchunk * 8;
    u32x4 ra[4], rb[4];
#pragma unroll
    for (int i = 0; i < 4; ++i) { ra[i] = *(const u32x4*)(ag + (long)(32 * i) * DM); rb[i] = *(const u32x4*)(bg + (long)(32 * i) * DM); }
#pragma unroll
    for (int i = 0; i < 4; ++i)
#pragma unroll
      for (int j = 0; j < 4; ++j) acc[i][j] = (f32x4){0.f, 0.f, 0.f, 0.f};
    for (int k0 = 0; k0 < DM; k0 += 64) {
      __syncthreads();
#pragma unroll
      for (int i = 0; i < 4; ++i) { int r = lrow + 32 * i; int off = r * 128 + ((lchunk ^ (r & 7)) << 4); *(u32x4*)(As + off) = ra[i]; *(u32x4*)(Bs + off) = rb[i]; }
      __syncthreads();
      if (k0 + 64 < DM) {
#pragma unroll
        for (int i = 0; i < 4; ++i) { ra[i] = *(const u32x4*)(ag + (long)(32 * i) * DM + k0 + 64); rb[i] = *(const u32x4*)(bg + (long)(32 * i) * DM + k0 + 64); }
      }
#pragma unroll
      for (int ks = 0; ks < 2; ++ks) {
        bf16x8 af[4], bfr[4];
#pragma unroll
        for (int i = 0; i < 4; ++i) {
          int r = wm * 64 + i * 16 + fr; af[i] = *(const bf16x8*)(As + r * 128 + (((ks * 4 + fq) ^ (r & 7)) << 4));
          int rn = wn * 64 + i * 16 + fr; bfr[i] = *(const bf16x8*)(Bs + rn * 128 + (((ks * 4 + fq) ^ (rn & 7)) << 4));
        }
#pragma unroll
        for (int i = 0; i < 4; ++i)
#pragma unroll
          for (int j = 0; j < 4; ++j) acc[i][j] = __builtin_amdgcn_mfma_f32_16x16x32_bf16(bfr[j], af[i], acc[i][j], 0, 0, 0);
      }
    }
  }
  __syncthreads();
  char* Qs = smem; char* Ks = smem + 32768;
#pragma unroll
  for (int i = 0; i < 4; ++i)
#pragma unroll
    for (int j = 0; j < 4; ++j) {
      int m = wm * 64 + i * 16 + fr; int n0 = wn * 64 + j * 16 + fq * 4;
      uint2 pk; pk.x = pack2bf(acc[i][j][0], acc[i][j][1]); pk.y = pack2bf(acc[i][j][2], acc[i][j][3]);
      *(uint2*)(Qs + m * 256 + ((((n0 >> 3) ^ (m & 15)) << 4) | ((n0 & 7) << 1))) = pk;
    }
  {
    const bf16_t* kg = keysb + (long)ps * 128 * 128;
#pragma unroll
    for (int i = 0; i < 8; ++i) { int idx = t + 256 * i; int r = idx >> 4, c = idx & 15; *(u32x4*)(Ks + r * 256 + ((c ^ (r & 15)) << 4)) = *(const u32x4*)(kg + r * 128 + c * 8); }
  }
  __syncthreads();
#pragma unroll
  for (int i = 0; i < 4; ++i)
#pragma unroll
    for (int j = 0; j < 4; ++j) acc[i][j] = (f32x4){0.f, 0.f, 0.f, 0.f};
#pragma unroll
  for (int ks = 0; ks < 4; ++ks) {
    bf16x8 af[4], bfr[4];
#pragma unroll
    for (int i = 0; i < 4; ++i) {
      int r = wm * 64 + i * 16 + fr; af[i] = *(const bf16x8*)(Qs + r * 256 + (((ks * 4 + fq) ^ (r & 15)) << 4));
      int rn = wn * 64 + i * 16 + fr; bfr[i] = *(const bf16x8*)(Ks + rn * 256 + (((ks * 4 + fq) ^ (rn & 15)) << 4));
    }
#pragma unroll
    for (int i = 0; i < 4; ++i)
#pragma unroll
      for (int j = 0; j < 4; ++j) acc[i][j] = __builtin_amdgcn_mfma_f32_16x16x32_bf16(bfr[j], af[i], acc[i][j], 0, 0, 0);
  }
  __syncthreads();
  unsigned* Sc = (unsigned*)smem;
#pragma unroll
  for (int i = 0; i < 4; ++i)
#pragma unroll
    for (int j = 0; j < 4; ++j) {
      int m = wm * 64 + i * 16 + fr; int n0 = wn * 64 + j * 16 + fq * 4;
#pragma unroll
      for (int e = 0; e < 4; ++e) Sc[(n0 + e) * 128 + (m ^ ((((n0 + e) >> 2) & 1) << 4))] = enc_key(acc[i][j][e], n0 + e);
    }
  __syncthreads();
  {
    const int r = t & 127, half = t >> 7;
    unsigned l[16];
#pragma unroll
    for (int i = 0; i < 16; ++i) l[i] = 0u;
    for (int k = 0; k < 64; ++k) ins16(l, Sc[(half * 64 + k) * 128 + (r ^ (((k >> 2) & 1) << 4))]);
    __syncthreads();
    unsigned* Ls = (unsigned*)smem;
    if (half == 1) {
#pragma unroll
      for (int i = 0; i < 16; ++i) Ls[r * 17 + i] = l[15 - i];
    }
    __syncthreads();
    if (half == 0) {
      unsigned br[16];
#pragma unroll
      for (int i = 0; i < 16; ++i) br[i] = Ls[r * 17 + i];
      merge16(l, br);
      unsigned* o = top1 + ((long)(tm * 128 + r) * 16 + ps) * 16;
#pragma unroll
      for (int i = 0; i < 4; ++i) { u32x4 v; v[0] = l[4*i]; v[1] = l[4*i+1]; v[2] = l[4*i+2]; v[3] = l[4*i+3]; *(u32x4*)(o + 4 * i) = v; }
    }
  }
}
__global__ void __launch_bounds__(256) ok_peer_q_top1(const bf16_t* A, const bf16_t* WqT, const bf16_t* keysb, unsigned* top1, int tiles_m) {
  __shared__ __attribute__((aligned(16))) char smem[P5_LDS_BYTES];
  for (int tile = blockIdx.x; tile < tiles_m * 16; tile += gridDim.x) { peer_q_top1_tile(A, WqT, keysb, top1, tile / 16, tile % 16, smem); __syncthreads(); }
}

#define P6_LDS_BYTES (32 * 128 * 4 * 3)
__device__ __forceinline__ void peer_gather_group(const bf16_t* __restrict__ xn, const unsigned* __restrict__ top1, const bf16_t* __restrict__ ub,
                                                  const bf16_t* __restrict__ vb, const float* __restrict__ modl, float* __restrict__ xs, int grp, char* smem) {
  const int t = threadIdx.x, lane = t & 63, wave = t >> 6;
  int* pe_l = (int*)smem; float* pg_l = (float*)(smem + 32 * 128 * 4); float* pw_l = (float*)(smem + 2 * 32 * 128 * 4);
  {
    int tl = t >> 3, p = t & 7; long row = (long)grp * 32 + tl;
    peer_combine(top1 + (row * 16 + p * 2) * 16, top1 + (row * 16 + p * 2 + 1) * 16, pe_l + tl * 128 + p * 16, pg_l + tl * 128 + p * 16);
  }
  __syncthreads();
  for (int ti = 0; ti < 8; ++ti) {
    const int tl = wave * 8 + ti; const long row = (long)grp * 32 + tl;
    const int* pe = pe_l + tl * 128; float* pw = pw_l + tl * 128;
    u32x4 h0 = *(const u32x4*)(xn + row * DM + lane * 8), h1 = *(const u32x4*)(xn + row * DM + 512 + lane * 8);
    for (int b = 0; b < 16; ++b) {
      u32x4 u0[8], u1[8];
#pragma unroll
      for (int j = 0; j < 8; ++j) { const bf16_t* ur = ub + (long)pe[b * 8 + j] * DM + lane * 8; u0[j] = *(const u32x4*)ur; u1[j] = *(const u32x4*)(ur + 512); }
      float pd[8];
#pragma unroll
      for (int j = 0; j < 8; ++j) {
        float a = 0.f;
#pragma unroll
        for (int e = 0; e < 4; ++e) { a = dot2bf(h0[e], u0[j][e], a); a = dot2bf(h1[e], u1[j][e], a); }
        pd[j] = a;
      }
      float q4[4], q2[2], q1;
#pragma unroll
      for (int j = 0; j < 4; ++j) { bool hi = lane & 1; float keep = hi ? pd[2*j+1] : pd[2*j], send = hi ? pd[2*j] : pd[2*j+1]; q4[j] = keep + __shfl_xor(send, 1); }
#pragma unroll
      for (int j = 0; j < 2; ++j) { bool hi = lane & 2; float keep = hi ? q4[2*j+1] : q4[2*j], send = hi ? q4[2*j] : q4[2*j+1]; q2[j] = keep + __shfl_xor(send, 2); }
      { bool hi = lane & 4; float keep = hi ? q2[1] : q2[0], send = hi ? q2[0] : q2[1]; q1 = keep + __shfl_xor(send, 4); }
      q1 += __shfl_xor(q1, 8); q1 += __shfl_xor(q1, 16); q1 += __shfl_xor(q1, 32);
      if (lane < 8) { int j = lane & 7; pw[b * 8 + j] = q1; }
    }
    {
      float d0 = pw[lane], d1 = pw[64 + lane];
      pw[lane] = pg_l[tl * 128 + lane] * geluf_(d0); pw[64 + lane] = pg_l[tl * 128 + 64 + lane] * geluf_(d1);
    }
    float o[16];
#pragma unroll
    for (int e = 0; e < 16; ++e) o[e] = 0.f;
    for (int b = 0; b < 16; ++b) {
      u32x4 v0[8], v1[8];
#pragma unroll
      for (int j = 0; j < 8; ++j) { const bf16_t* vr = vb + (long)pe[b * 8 + j] * DM + lane * 8; v0[j] = *(const u32x4*)vr; v1[j] = *(const u32x4*)(vr + 512); }
#pragma unroll
      for (int j = 0; j < 8; ++j) {
        float w = pw[b * 8 + j];
#pragma unroll
        for (int e = 0; e < 4; ++e) {
          o[2*e]     += w * __uint_as_float(v0[j][e] << 16); o[2*e+1]     += w * __uint_as_float(v0[j][e] & 0xffff0000u);
          o[8 + 2*e] += w * __uint_as_float(v1[j][e] << 16); o[8 + 2*e+1] += w * __uint_as_float(v1[j][e] & 0xffff0000u);
        }
      }
    }
    {
      int b = row / RB, lr = row % RB; int bb = lr < SEQ ? b : BATCH; const float* g5 = modl + ((long)bb * 6 + 5) * DM;
      float* xr = xs + row * DM;
#pragma unroll
      for (int hf = 0; hf < 2; ++hf) {
        int d = hf * 512 + lane * 8;
        float4 x0 = *(float4*)(xr + d), x1 = *(float4*)(xr + d + 4); float4 g0 = *(const float4*)(g5 + d), g1 = *(const float4*)(g5 + d + 4);
        x0.x += g0.x * o[hf*8+0]; x0.y += g0.y * o[hf*8+1]; x0.z += g0.z * o[hf*8+2]; x0.w += g0.w * o[hf*8+3];
        x1.x += g1.x * o[hf*8+4]; x1.y += g1.y * o[hf*8+5]; x1.z += g1.z * o[hf*8+6]; x1.w += g1.w * o[hf*8+7];
        *(float4*)(xr + d) = x0; *(float4*)(xr + d + 4) = x1;
      }
    }
  }
}
__global__ void __launch_bounds__(256) ok_peer_gather(const bf16_t* xn, const unsigned* top1, const bf16_t* ub, const bf16_t* vb, const float* modl, float* xs, int ngroups) {
  __shared__ __attribute__((aligned(16))) char smem[P6_LDS_BYTES];
  for (int g = blockIdx.x; g < ngroups; g += gridDim.x) { peer_gather_group(xn, top1, ub, vb, modl, xs, g, smem); __syncthreads(); }
}

template <int DQ> struct AttnCfg { static constexpr int KROW = DQ * 2 + 16; static constexpr int VROW = 136; static constexpr int KBYTES = 64 * KROW; static constexpr int LDS = 64 * KROW + 64 * VROW; };
#define ATTN_LDS_BYTES (64 * 208 + 64 * 136)
template <int DQ>
__device__ __forceinline__ void attn_block(const bf16_t* __restrict__ qb, int HQ, const bf16_t* __restrict__ kb, int HK, const bf16_t* __restrict__ vT, int G,
                                           bf16_t* __restrict__ mixall, int ooff, int b, int head, int qt, char* smem) {
  constexpr int KROW = AttnCfg<DQ>::KROW, VROW = 136, NKK = DQ / 16, KCH = DQ / 8;
  constexpr int KLD = (64 * KCH) / 256;
  const int t = threadIdx.x, lane = t & 63, wave = t >> 6, lq = lane & 31, lh = lane >> 5;
  const int hk = head / G;
  char* Ks = smem; char* Vs = smem + 64 * KROW;
  const long qrow = (long)b * RB + qt * 128 + wave * 32 + lq;
  bf16x8 qf[NKK];
#pragma unroll
  for (int kk = 0; kk < NKK; ++kk) qf[kk] = *(const bf16x8*)(qb + (qrow * HQ + head) * DQ + kk * 16 + lh * 8);
  const int key0 = qt < 16 ? 0 : SEQ; const int nt = qt < 16 ? RB / 64 : CTX_LEN / 64;
  const bf16_t* kbase = kb + ((long)b * RB * HK + hk) * DQ; const bf16_t* vbase = vT + ((long)(b * HK + hk) * 64) * RB;
  u32x4 rk[KLD], rv[2];
  auto issue = [&](int tile) {
    int k0 = key0 + tile * 64;
#pragma unroll
    for (int i = 0; i < KLD; ++i) { int c = t + 256 * i; int r = c / KCH, cc = c % KCH; rk[i] = *(const u32x4*)(kbase + (long)(k0 + r) * HK * DQ + cc * 8); }
#pragma unroll
    for (int i = 0; i < 2; ++i) { int c = t + 256 * i; int r = c >> 3, cc = c & 7; rv[i] = *(const u32x4*)(vbase + (long)r * RB + k0 + cc * 8); }
  };
  issue(0);
  f32x16 ot[2];
#pragma unroll
  for (int d = 0; d < 2; ++d)
#pragma unroll
    for (int r = 0; r < 16; ++r) ot[d][r] = 0.f;
  float mrun = -1e30f, lrun = 0.f;
  for (int tile = 0; tile < nt; ++tile) {
    __syncthreads();
#pragma unroll
    for (int i = 0; i < KLD; ++i) { int c = t + 256 * i; int r = c / KCH, cc = c % KCH; *(u32x4*)(Ks + r * KROW + cc * 16) = rk[i]; }
#pragma unroll
    for (int i = 0; i < 2; ++i) { int c = t + 256 * i; int r = c >> 3, cc = c & 7; *(uint2*)(Vs + r * VROW + cc * 16) = make_uint2(rv[i][0], rv[i][1]); *(uint2*)(Vs + r * VROW + cc * 16 + 8) = make_uint2(rv[i][2], rv[i][3]); }
    __syncthreads();
    if (tile + 1 < nt) issue(tile + 1);
    f32x16 st[2];
#pragma unroll
    for (int kt = 0; kt < 2; ++kt) {
#pragma unroll
      for (int r = 0; r < 16; ++r) st[kt][r] = 0.f;
#pragma unroll
      for (int kk = 0; kk < NKK; ++kk) {
        bf16x8 ka = *(const bf16x8*)(Ks + (kt * 32 + lq) * KROW + kk * 32 + lh * 16);
        st[kt] = __builtin_amdgcn_mfma_f32_32x32x16_bf16(ka, qf[kk], st[kt], 0, 0, 0);
      }
    }
    float mt = st[0][0];
#pragma unroll
    for (int kt = 0; kt < 2; ++kt)
#pragma unroll
      for (int r = 0; r < 16; ++r) mt = fmaxf(mt, st[kt][r]);
    mt = fmaxf(mt, __shfl_xor(mt, 32));
    float mnew = fmaxf(mrun, mt); float alpha = __builtin_amdgcn_exp2f(mrun - mnew); mrun = mnew;
    float ps = 0.f;
#pragma unroll
    for (int kt = 0; kt < 2; ++kt)
#pragma unroll
      for (int r = 0; r < 16; ++r) { float p = __builtin_amdgcn_exp2f(st[kt][r] - mnew); st[kt][r] = p; ps += p; }
    lrun = lrun * alpha + ps;
#pragma unroll
    for (int d = 0; d < 2; ++d)
#pragma unroll
      for (int r = 0; r < 16; ++r) ot[d][r] *= alpha;
#pragma unroll
    for (int kt = 0; kt < 2; ++kt)
#pragma unroll
      for (int s = 0; s < 2; ++s) {
        union { bf16x8 v; unsigned u[4]; } pb;
#pragma unroll
        for (int j = 0; j < 4; ++j) pb.u[j] = pack2bf(st[kt][8 * s + 2 * j], st[kt][8 * s + 2 * j + 1]);
#pragma unroll
        for (int d = 0; d < 2; ++d) {
          const char* vp = Vs + (d * 32 + lq) * VROW + (kt * 32 + 16 * s + 4 * lh) * 2;
          union { bf16x8 v; uint2 h[2]; } va; va.h[0] = *(const uint2*)vp; va.h[1] = *(const uint2*)(vp + 16);
          ot[d] = __builtin_amdgcn_mfma_f32_32x32x16_bf16(va.v, pb.v, ot[d], 0, 0, 0);
        }
      }
  }
  float ltot = lrun + __shfl_xor(lrun, 32); float inv = 1.f / ltot;
  bf16_t* orow = mixall + qrow * DM + ooff + head * 64;
#pragma unroll
  for (int d = 0; d < 2; ++d)
#pragma unroll
    for (int g = 0; g < 4; ++g) {
      uint2 pk; pk.x = pack2bf(ot[d][4 * g] * inv, ot[d][4 * g + 1] * inv); pk.y = pack2bf(ot[d][4 * g + 2] * inv, ot[d][4 * g + 3] * inv);
      *(uint2*)(orow + d * 32 + 8 * g + 4 * lh) = pk;
    }
}
__global__ void __launch_bounds__(256) ok_attn(const bf16_t* mq, const bf16_t* mk, const bf16_t* mvT, const bf16_t* gq, const bf16_t* gk, const bf16_t* gvT, bf16_t* mixall, int nqt) {
  __shared__ __attribute__((aligned(16))) char smem[ATTN_LDS_BYTES];
  const int n_mla = BATCH * 4 * nqt, n_gqa = BATCH * 6 * nqt;
  for (int w = blockIdx.x; w < n_mla + n_gqa; w += gridDim.x) {
    if (w < n_mla) { int qt = w % nqt, head = (w / nqt) % 4, b = w / (nqt * 4); attn_block<96>(mq, 4, mk, 4, mvT, 1, mixall, 0, b, head, qt, smem); }
    else { int v = w - n_mla; int qt = v % nqt, head = (v / nqt) % 6, b = v / (nqt * 6); attn_block<64>(gq, 6, gk, 2, gvT, 3, mixall, 640, b, head, qt, smem); }
    __syncthreads();
  }
}
__global__ void ok_adapt_rows(const float* src, int sld, int scol, int ncols, float scale, bf16_t* dst, int dld, int nrows) {
  long i = (long)blockIdx.x * blockDim.x + threadIdx.x; if (i >= (long)nrows * ncols) return;
  int c = i % ncols; long r = i / ncols; dst[r * dld + c] = f2bf(src[r * sld + scol + c] * scale);
}
__global__ void ok_adapt_vT(const float* src, int sld, int scol, int hstride, int H, bf16_t* dst) {
  long i = (long)blockIdx.x * blockDim.x + threadIdx.x; if (i >= (long)H * 64 * RB) return;
  int lr = i % RB; int d = (i / RB) % 64; int h = i / ((long)RB * 64);
  dst[i] = f2bf(src[(long)lr * sld + scol + h * hstride + d]);
}

typedef __attribute__((ext_vector_type(2))) float f32x2;
#define SCAN_TS 16
#define SCAN_LDS_BYTES (2 * SCAN_TS * 1536 + 2 * SCAN_TS * 32 * 4)
__device__ __forceinline__ float reduce8(float x) {
  x += __builtin_bit_cast(float, __builtin_amdgcn_update_dpp(0, __builtin_bit_cast(int, x), 0xB1, 0xf, 0xf, true));
  x += __builtin_bit_cast(float, __builtin_amdgcn_update_dpp(0, __builtin_bit_cast(int, x), 0x4E, 0xf, 0xf, true));
  x += __builtin_bit_cast(float, __builtin_amdgcn_update_dpp(0, __builtin_bit_cast(int, x), 0x141, 0xf, 0xf, true));
  return x;
}
__device__ __forceinline__ int scan_row(int dir, int s) {
  if (s < CTX_LEN) return SEQ + (dir == 0 ? s : CTX_LEN - 1 - s);
  return dir == 0 ? s - CTX_LEN : SEQ - 1 - (s - CTX_LEN);
}
__device__ __forceinline__ void rw_scan_block(const bf16_t* __restrict__ r_, const bf16_t* __restrict__ v_, const bf16_t* __restrict__ kk_, const bf16_t* __restrict__ kd_,
                                              const bf16_t* __restrict__ bd_, const float* __restrict__ w_, float* __restrict__ y_, int item, long dstride, char* smem) {
  const int t = threadIdx.x, lane = t & 63, wave = t >> 6, cg = lane & 7, il = wave * 8 + (lane >> 3);
  const int half = item & 1, dir = (item >> 1) & 1, h = (item >> 2) % 6, b = item / 24;
  const long rowbase = (long)b * RB; const int col0 = h * 64;
  float* ybuf = (float*)(smem + 2 * SCAN_TS * 1536);
  const int st_ld = t >> 4, part = t & 15;
  u32x4 la, lb, lc, lw;
  auto issue = [&](int c) {
    long row = rowbase + scan_row(dir, c * SCAN_TS + st_ld); long o = row * 384 + col0;
    const int ch = (part & 7) * 8;
    la = *(const u32x4*)((part < 8 ? kk_ + o : bd_ + dir * dstride + o) + ch);
    lb = *(const u32x4*)((part < 8 ? kd_ + dir * dstride + o : r_ + o) + ch);
    lc = *(const u32x4*)(v_ + o + ch);
    lw = *(const u32x4*)(w_ + dir * dstride + o + part * 4);
  };
  auto stash = [&](int buf) {
    float* base = (float*)(smem + buf * SCAN_TS * 1536 + st_ld * 1536);
    const int ch = (part & 7) * 8;
    float* pa = base + (part < 8 ? 64 : 128) + ch; float* pb = base + (part < 8 ? 192 : 256) + ch;
    f32x4 x0, x1;
#pragma unroll
    for (int e = 0; e < 2; ++e) { x0[2*e] = __uint_as_float(la[e] << 16); x0[2*e+1] = __uint_as_float(la[e] & 0xffff0000u); x1[2*e] = __uint_as_float(la[2+e] << 16); x1[2*e+1] = __uint_as_float(la[2+e] & 0xffff0000u); }
    *(f32x4*)pa = x0; *(f32x4*)(pa + 4) = x1;
#pragma unroll
    for (int e = 0; e < 2; ++e) { x0[2*e] = __uint_as_float(lb[e] << 16); x0[2*e+1] = __uint_as_float(lb[e] & 0xffff0000u); x1[2*e] = __uint_as_float(lb[2+e] << 16); x1[2*e+1] = __uint_as_float(lb[2+e] & 0xffff0000u); }
    *(f32x4*)pb = x0; *(f32x4*)(pb + 4) = x1;
    if (part < 8) {
      float* pc = base + 320 + ch;
#pragma unroll
      for (int e = 0; e < 2; ++e) { x0[2*e] = __uint_as_float(lc[e] << 16); x0[2*e+1] = __uint_as_float(lc[e] & 0xffff0000u); x1[2*e] = __uint_as_float(lc[2+e] << 16); x1[2*e+1] = __uint_as_float(lc[2+e] & 0xffff0000u); }
      *(f32x4*)pc = x0; *(f32x4*)(pc + 4) = x1;
    }
    *(u32x4*)(base + part * 4) = lw;
  };
  f32x2 S[4];
#pragma unroll
  for (int j = 0; j < 4; ++j) S[j] = (f32x2){0.f, 0.f};
  const int NCH = RB / SCAN_TS;
  issue(0);
  for (int c = 0; c < NCH; ++c) {
    const int buf = c & 1;
    stash(buf);
    __syncthreads();
    if (c > 0 && t < 128) {
      int st = t >> 3, i4 = (t & 7) * 4; long row = rowbase + scan_row(dir, (c - 1) * SCAN_TS + st);
      *(f32x4*)(y_ + dir * dstride + row * 384 + col0 + half * 32 + i4) = *(const f32x4*)(ybuf + (buf ^ 1) * SCAN_TS * 32 + st * 32 + i4);
    }
    if (c + 1 < NCH) issue(c + 1);
    const float* ob = (const float*)(smem + buf * SCAN_TS * 1536) + cg * 8;
    float yk[SCAN_TS];
#pragma unroll
    for (int st = 0; st < SCAN_TS; ++st) {
      const float* o = ob + st * 384;
      f32x4 w0 = *(const f32x4*)(o), w1 = *(const f32x4*)(o + 4), k0 = *(const f32x4*)(o + 64), k1 = *(const f32x4*)(o + 68);
      f32x4 b0 = *(const f32x4*)(o + 128), b1 = *(const f32x4*)(o + 132), d0 = *(const f32x4*)(o + 192), d1 = *(const f32x4*)(o + 196);
      f32x4 r0 = *(const f32x4*)(o + 256), r1 = *(const f32x4*)(o + 260);
      float vi = ob[st * 384 + 320 - cg * 8 + half * 32 + il];
      f32x2 a2 = S[0] * (f32x2){k0[0], k0[1]}; a2 += S[1] * (f32x2){k0[2], k0[3]}; a2 += S[2] * (f32x2){k1[0], k1[1]}; a2 += S[3] * (f32x2){k1[2], k1[3]};
      float skk = reduce8(a2[0] + a2[1]);
      f32x2 vv = (f32x2){vi, vi}, ns = (f32x2){-skk, -skk};
      S[0] = S[0] * (f32x2){w0[0], w0[1]} + (vv * (f32x2){d0[0], d0[1]} + ns * (f32x2){b0[0], b0[1]});
      S[1] = S[1] * (f32x2){w0[2], w0[3]} + (vv * (f32x2){d0[2], d0[3]} + ns * (f32x2){b0[2], b0[3]});
      S[2] = S[2] * (f32x2){w1[0], w1[1]} + (vv * (f32x2){d1[0], d1[1]} + ns * (f32x2){b1[0], b1[1]});
      S[3] = S[3] * (f32x2){w1[2], w1[3]} + (vv * (f32x2){d1[2], d1[3]} + ns * (f32x2){b1[2], b1[3]});
      f32x2 y2 = S[0] * (f32x2){r0[0], r0[1]}; y2 += S[1] * (f32x2){r0[2], r0[3]}; y2 += S[2] * (f32x2){r1[0], r1[1]}; y2 += S[3] * (f32x2){r1[2], r1[3]};
      yk[st] = reduce8(y2[0] + y2[1]);
    }
    if (cg == 0) {
#pragma unroll
      for (int st = 0; st < SCAN_TS; ++st) ybuf[buf * SCAN_TS * 32 + st * 32 + il] = yk[st];
    }
  }
  __syncthreads();
  if (t < 128) {
    int st = t >> 3, i4 = (t & 7) * 4; long row = rowbase + scan_row(dir, (NCH - 1) * SCAN_TS + st);
    *(f32x4*)(y_ + dir * dstride + row * 384 + col0 + half * 32 + i4) = *(const f32x4*)(ybuf + ((NCH - 1) & 1) * SCAN_TS * 32 + st * 32 + i4);
  }
}
__global__ void __launch_bounds__(256) ok_rw_scan(const bf16_t* r_, const bf16_t* v_, const bf16_t* kk_, const bf16_t* kd_, const bf16_t* bd_, const float* w_, float* y_, int item0, int nitems, long dstride) {
  __shared__ __attribute__((aligned(16))) char smem[SCAN_LDS_BYTES];
  for (int it = item0 + blockIdx.x; it < item0 + nitems; it += gridDim.x) { rw_scan_block(r_, v_, kk_, kd_, bd_, w_, y_, it, dstride, smem); __syncthreads(); }
}
__global__ void ok_copy_rows_f32(const float* src, int sld, int scol, int ncols, float* dst, int dld, int nrows) {
  long i = (long)blockIdx.x * blockDim.x + threadIdx.x; if (i >= (long)nrows * ncols) return;
  int c = i % ncols; long r = i / ncols; dst[r * dld + c] = src[r * sld + scol + c];
}

__global__ void ok_cvt_wT_g(const float* W, const float* g, bf16_t* Wt, int K, int N, int Kpad) {
  long i = (long)blockIdx.x * blockDim.x + threadIdx.x;
  if (i >= (long)N * Kpad) return;
  int k = i % Kpad; int n = i / Kpad;
  Wt[i] = k < K ? f2bf(W[(long)k * N + n] * (g ? g[k] : 1.f)) : (bf16_t)0;
}
struct ALoadShift { const bf16_t* P; const float* mu; int col0; int mucol0; int act; int kvalid;
  __device__ __forceinline__ u32x4 operator()(int row, int k) const {
    u32x4 z = {0u, 0u, 0u, 0u};
    if (k >= kvalid) return z;
    int lr = row % RB; bool first = (lr == 0) || (lr == SEQ), last = (lr == SEQ - 1) || (lr == RB - 1);
    const bf16_t* p = P + (long)row * IN_COLS + col0 + k;
    u32x4 c = *(const u32x4*)p; u32x4 pv = first ? z : *(const u32x4*)(p - IN_COLS); u32x4 nx = last ? z : *(const u32x4*)(p + IN_COLS);
    const float* m0 = mu + mucol0 + k; const float* m1 = m0 + RWC;
    u32x4 o;
#pragma unroll
    for (int e = 0; e < 4; ++e) {
      float c0 = __uint_as_float(c[e] << 16), c1 = __uint_as_float(c[e] & 0xffff0000u);
      float p0 = __uint_as_float(pv[e] << 16), p1 = __uint_as_float(pv[e] & 0xffff0000u);
      float n0 = __uint_as_float(nx[e] << 16), n1 = __uint_as_float(nx[e] & 0xffff0000u);
      float x0 = c0 + m0[2*e] * (p0 - c0) + m1[2*e] * (n0 - c0), x1 = c1 + m0[2*e+1] * (p1 - c1) + m1[2*e+1] * (n1 - c1);
      if (act == 1) { x0 = tanhf(x0); x1 = tanhf(x1); } else if (act == 2) { x0 = sigmoidf_(x0); x1 = sigmoidf_(x1); }
      o[e] = pack2bf(x0, x1);
    }
    return o;
  } };
struct EpiDecay { float* w; const float* w0; int pad0; int pad1;
  __device__ __forceinline__ void operator()(int m, int n0, f32x4 v) const {
    f32x4 o;
#pragma unroll
    for (int e = 0; e < 4; ++e) o[e] = expf(-expf(-softplusf_(-(w0[n0 + e] + v[e])) - 0.5f));
    *(f32x4*)(w + (long)m * 384 + n0) = o; } };
struct EpiSigA { bf16_t* a; const float* a0;
  __device__ __forceinline__ void operator()(int m, int n0, f32x4 v) const {
    uint2 pk; pk.x = pack2bf(sigmoidf_(a0[n0] + v[0]), sigmoidf_(a0[n0+1] + v[1])); pk.y = pack2bf(sigmoidf_(a0[n0+2] + v[2]), sigmoidf_(a0[n0+3] + v[3]));
    *(uint2*)(a + (long)m * 384 + n0) = pk; } };

struct PrepW { const bf16_t *wqbT, *wkvbT, *w2T, *a2T, *g2T; const float *mu, *w0, *a0; };
struct PrepBuf { const bf16_t* P; bf16_t *tq, *tkv, *a_b, *g_b; float* w_f; };
__device__ __forceinline__ void prep_gemm_tile(const PrepW& W, const PrepBuf& B, int tm, int ct, char* smem) {
  const long MA = NROWS;
  if (ct < 3) gemm_tile_128(ALoadPlain{B.P, IN_COLS}, W.wqbT, 256, 256, tm, ct, smem, EpiStoreBf16{B.tq, 384, 384});
  else if (ct < 7) gemm_tile_128(ALoadPlain{B.P + 256, IN_COLS}, W.wkvbT, 128, 128, tm, ct - 3, smem, EpiStoreBf16{B.tkv, 512, 512});
  else if (ct < 13) { int d = (ct - 7) / 3, tn = (ct - 7) % 3;
    gemm_tile_128(ALoadShift{B.P, W.mu, RW_OFF + 1152 + d * 64, 1152 + d * 64, 1, 64}, W.w2T + d * 384 * 64, 64, 64, tm, tn, smem, EpiDecay{B.w_f + d * MA * 384, W.w0 + d * 384, 0, 0}); }
  else if (ct < 19) { int d = (ct - 13) / 3, tn = (ct - 13) % 3;
    gemm_tile_128(ALoadShift{B.P, W.mu, RW_OFF + 1280 + d * 64, 1280 + d * 64, 0, 64}, W.a2T + d * 384 * 64, 64, 64, tm, tn, smem, EpiSigA{B.a_b + d * MA * 384, W.a0 + d * 384}); }
  else gemm_tile_128(ALoadShift{B.P, W.mu, RW_OFF + 1408, 1408, 2, 160}, W.g2T, 192, 192, tm, ct - 19, smem, EpiStoreBf16{B.g_b, 384, 384});
}
__global__ void __launch_bounds__(256) ok_prep_gemm(PrepW W, PrepBuf B) {
  __shared__ __attribute__((aligned(16))) char smem[GEMM_LDS_BYTES];
  for (int tile = blockIdx.x; tile < (NROWS / 128) * 22; tile += gridDim.x) prep_gemm_tile(W, B, tile / 22, tile % 22, smem);
}

__device__ __forceinline__ float wave_sum(float x) {
#pragma unroll
  for (int o = 32; o > 0; o >>= 1) x += __shfl_xor(x, o);
  return x;
}
__device__ __forceinline__ float ldbf(const bf16_t* p) { return bf2f(*p); }
struct FinW { const float *mla_qk_g, *gqa_qk_g, *mu, *k_k, *k_a; };
struct FinBuf { const bf16_t *P, *tq, *tkv, *a_b; bf16_t *mq, *mk, *mvT, *gq, *gk, *gvT, *r_b, *v_b, *kk_b, *kd_b, *bd_b; };
#define FIN_LDS_BYTES (384 * 132)
__device__ __forceinline__ void prep_finish_tile(const FinW& W, const FinBuf& B, int tile, char* smem) {
  const int t = threadIdx.x, lane = t & 63, wave = t >> 6; const long MA = NROWS;
  bf16_t* vbuf = (bf16_t*)smem;
  const long row0 = (long)tile * 64; const int b = row0 / RB; const int lr0 = row0 % RB;
  for (int it = 0; it < 16; ++it) {
    const int rl = it * 4 + wave; const long row = row0 + rl; const int lr = lr0 + rl; const bool lat = lr < SEQ;
    const bf16_t* Pr = B.P + row * IN_COLS;
    float sq = 0.f;
#pragma unroll
    for (int i = 0; i < 4; ++i) { float x = ldbf(Pr + i * 64 + lane); sq += x * x; }
    float skv = 0.f;
#pragma unroll
    for (int i = 0; i < 2; ++i) { float x = ldbf(Pr + 256 + i * 64 + lane); skv += x * x; }
    const float cq = 1.f / sqrtf(wave_sum(sq) / 256.f + EPSN), ckv = 1.f / sqrtf(wave_sum(skv) / 128.f + EPSN);
    const float krope = lane < 32 ? ldbf(Pr + 384 + lane) : 0.f;
    float cs_m = 1.f, sn_m = 0.f;
    { int j = lane & 15; int pos = j < 8 ? lr / 64 : lr % 64; float ang = (float)pos * powf(10000.f, -(float)(j & 7) / 8.f); if (lat) { cs_m = cosf(ang); sn_m = sinf(ang); } }
    const float* gq_ = W.mla_qk_g; const float* gk_ = W.mla_qk_g + 96;
#pragma unroll
    for (int h = 0; h < 4; ++h) {
      float qa = cq * ldbf(B.tq + row * 384 + h * 96 + lane); float qb = lane < 32 ? cq * ldbf(B.tq + row * 384 + h * 96 + 64 + lane) : 0.f;
      float inv = 1.f / sqrtf(wave_sum(qa * qa + qb * qb) / 96.f + EPSN);
      qa *= inv * gq_[lane]; qb *= inv * (lane < 32 ? gq_[64 + lane] : 0.f);
      { float other = __shfl_xor(qb, 16); float rr = (lane & 16) ? (other * sn_m + qb * cs_m) : (qb * cs_m - other * sn_m); qb = rr; }
      const float qs = 0.14724445f;
      B.mq[row * 384 + h * 96 + lane] = f2bf(qa * qs); if (lane < 32) B.mq[row * 384 + h * 96 + 64 + lane] = f2bf(qb * qs);
      float ka = ckv * ldbf(B.tkv + row * 512 + h * 128 + lane); float kb = krope;
      float invk = 1.f / sqrtf(wave_sum(ka * ka + kb * kb) / 96.f + EPSN);
      ka *= invk * gk_[lane]; kb *= invk * (lane < 32 ? gk_[64 + lane] : 0.f);
      { float other = __shfl_xor(kb, 16); float rr = (lane & 16) ? (other * sn_m + kb * cs_m) : (kb * cs_m - other * sn_m); kb = rr; }
      B.mk[row * 384 + h * 96 + lane] = f2bf(ka); if (lane < 32) B.mk[row * 384 + h * 96 + 64 + lane] = f2bf(kb);
      vbuf[(h * 64 + lane) * 66 + rl] = f2bf(ckv * ldbf(B.tkv + row * 512 + h * 128 + 64 + lane));
    }
    float cs_g = 1.f, sn_g = 0.f;
    { int j = lane & 31; int pos = j < 16 ? lr / 64 : lr % 64; float ang = (float)pos * powf(10000.f, -(float)(j & 15) / 16.f); if (lat) { cs_g = cosf(ang); sn_g = sinf(ang); } }
#pragma unroll
    for (int h = 0; h < 8; ++h) {
      float x = ldbf(Pr + GQA_OFF + h * 64 + lane);
      float inv = 1.f / sqrtf(wave_sum(x * x) / 64.f + EPSN);
      x *= inv * W.gqa_qk_g[(h < 6 ? 0 : 64) + lane];
      float other = __shfl_xor(x, 32); float rr = (lane & 32) ? (other * sn_g + x * cs_g) : (x * cs_g - other * sn_g);
      if (h < 6) B.gq[row * 384 + h * 64 + lane] = f2bf(rr * 0.18033688f); else B.gk[row * 128 + (h - 6) * 64 + lane] = f2bf(rr);
    }
#pragma unroll
    for (int hk = 0; hk < 2; ++hk) vbuf[((4 + hk) * 64 + lane) * 66 + rl] = Pr[GQA_OFF + 512 + hk * 64 + lane];
    const bool first = (lr == 0) || (lr == SEQ), last = (lr == SEQ - 1) || (lr == RB - 1);
#pragma unroll
    for (int h = 0; h < 6; ++h) {
      float xs3[3];
#pragma unroll
      for (int part = 0; part < 3; ++part) {
        int c = part * 384 + h * 64 + lane; const bf16_t* pp = Pr + RW_OFF + c;
        float p = ldbf(pp), pv = first ? 0.f : ldbf(pp - IN_COLS), nx = last ? 0.f : ldbf(pp + IN_COLS);
        xs3[part] = p + W.mu[c] * (pv - p) + W.mu[RWC + c] * (nx - p);
      }
      const int c = h * 64 + lane; const long o = row * 384 + c;
      float kv = xs3[1]; float tk = kv * W.k_k[c]; float kkv = tk / sqrtf(wave_sum(tk * tk) + 1e-12f);
      B.r_b[o] = f2bf(xs3[0]); B.v_b[o] = f2bf(xs3[2]); B.kk_b[o] = f2bf(kkv);
#pragma unroll
      for (int d = 0; d < 2; ++d) { float a = ldbf(B.a_b + d * MA * 384 + o); B.kd_b[d * MA * 384 + o] = f2bf(kv * (1.f + (a - 1.f) * W.k_a[c])); B.bd_b[d * MA * 384 + o] = f2bf(kkv * a); }
    }
  }
  __syncthreads();
  for (int i = t; i < 384 * 32; i += 256) {
    int rr = i >> 5, w2 = i & 31; int slot = rr >> 6, d = rr & 63;
    unsigned val = *(const unsigned*)(vbuf + rr * 66 + w2 * 2);
    bf16_t* dst = slot < 4 ? B.mvT + ((long)(b * 4 + slot) * 64 + d) * RB : B.gvT + ((long)(b * 2 + (slot - 4)) * 64 + d) * RB;
    *(unsigned*)(dst + lr0 + w2 * 2) = val;
  }
  __syncthreads();
}
__global__ void __launch_bounds__(256) ok_prep_finish(FinW W, FinBuf B) {
  __shared__ __attribute__((aligned(16))) char smem[FIN_LDS_BYTES];
  for (int tile = blockIdx.x; tile < NROWS / 64; tile += gridDim.x) prep_finish_tile(W, B, tile, smem);
}
struct RdW { const float *r_k, *ln_g, *ln_b; };
__device__ __forceinline__ void rw_readout_row(const RdW& W, const float* __restrict__ y, const bf16_t* __restrict__ r_b, const bf16_t* __restrict__ v_b, const bf16_t* __restrict__ kd_b,
                                               const bf16_t* __restrict__ g_b, bf16_t* __restrict__ mixall, long row, int lane) {
  const long MA = NROWS;
#pragma unroll
  for (int h = 0; h < 6; ++h) {
    const int c = h * 64 + lane; const long o = row * 384 + c;
    float yy = y[o] + y[MA * 384 + o];
    float mean = wave_sum(yy) * (1.f / 64.f); float dv = yy - mean; float var = wave_sum(dv * dv) * (1.f / 64.f);
    float coef = wave_sum(ldbf(r_b + o) * (ldbf(kd_b + o) + ldbf(kd_b + MA * 384 + o)) * W.r_k[c]);
    float yn = dv / sqrtf(var + 64e-5f) * W.ln_g[c] + W.ln_b[c];
    mixall[row * DM + 256 + c] = f2bf((yn + coef * ldbf(v_b + o)) * ldbf(g_b + o));
  }
}
__global__ void __launch_bounds__(256) ok_rw_readout(RdW W, const float* y, const bf16_t* r_b, const bf16_t* v_b, const bf16_t* kd_b, const bf16_t* g_b, bf16_t* mixall) {
  for (long row = blockIdx.x * 4 + (threadIdx.x >> 6); row < NROWS; row += gridDim.x * 4) rw_readout_row(W, y, r_b, v_b, kd_b, g_b, mixall, row, threadIdx.x & 63);
}
struct Ws {
  float *xs, *mod, *w_f, *y_f; bf16_t *xn, *Pb, *mixall, *w_inT, *w_outT, *wqT, *keysb, *wqbT, *wkvbT, *w2T, *a2T, *g2T;
  bf16_t *tq, *tkv, *a_b, *g_b, *mq, *mk, *mvT, *gq, *gk, *gvT, *r_b, *v_b, *kk_b, *kd_b, *bd_b, *ub, *vb; unsigned* top1; size_t total;
};
static Ws carve_ws(char* wsb) {
  Ws w; const long MA = NROWS; char* p = wsb;
  auto carve = [&](size_t bytes) { char* r = p; p += (bytes + 255) & ~(size_t)255; return r; };
  w.xs = (float*)carve(MA * DM * 4); w.mod = (float*)carve(2L * (BATCH + 1) * 6144 * 4); w.xn = (bf16_t*)carve(MA * DM * 2);
  w.Pb = (bf16_t*)carve(MA * IN_COLS * 2);
  w.y_f = (float*)w.Pb; w.ub = w.Pb; w.vb = w.Pb + 16384L * DM;
  w.tq = (bf16_t*)carve(MA * 384 * 2); w.tkv = (bf16_t*)carve(MA * 512 * 2); w.a_b = (bf16_t*)carve(2 * MA * 384 * 2);
  w.mixall = w.tq; w.top1 = (unsigned*)w.tq;
  w.g_b = (bf16_t*)carve(MA * 384 * 2); w.w_f = (float*)carve(2 * MA * 384 * 4);
  w.mq = (bf16_t*)carve(MA * 384 * 2); w.mk = (bf16_t*)carve(MA * 384 * 2); w.mvT = (bf16_t*)carve((long)BATCH * 4 * 64 * RB * 2);
  w.gq = (bf16_t*)carve(MA * 384 * 2); w.gk = (bf16_t*)carve(MA * 128 * 2); w.gvT = (bf16_t*)carve((long)BATCH * 2 * 64 * RB * 2);
  w.r_b = (bf16_t*)carve(MA * 384 * 2); w.v_b = (bf16_t*)carve(MA * 384 * 2); w.kk_b = (bf16_t*)carve(MA * 384 * 2);
  w.kd_b = (bf16_t*)carve(2 * MA * 384 * 2); w.bd_b = (bf16_t*)carve(2 * MA * 384 * 2);
  w.w_inT = (bf16_t*)carve(2L * 2688 * 1024 * 2); w.w_outT = (bf16_t*)carve(2L * 1024 * 1024 * 2); w.wqT = (bf16_t*)carve(2L * 2048 * 1024 * 2);
  w.keysb = (bf16_t*)carve(2L * 16 * 128 * 128 * 2); w.wqbT = (bf16_t*)carve(2L * 384 * 256 * 2); w.wkvbT = (bf16_t*)carve(2L * 512 * 128 * 2);
  w.w2T = (bf16_t*)carve(2L * 2 * 384 * 64 * 2); w.a2T = (bf16_t*)carve(2L * 2 * 384 * 64 * 2); w.g2T = (bf16_t*)carve(2L * 384 * 192 * 2);
  w.total = p - wsb; return w;
}
static void forward_v6(const NaiveIn& I, float* out, char* wsb, size_t ws_size, hipStream_t stream) {
  const long MA = NROWS; Ws w = carve_ws(wsb);
  if (w.total > ws_size) return;
  LAUNCH(nk_copy_in, MA * DM, I.x, I.ctx, w.xs);
  LAUNCH(nk_mod, 2L * (BATCH + 1) * 6144, I.c, I.c_ctx, I.ada_w, I.ada_b, w.mod);
  for (int l = 0; l < 2; ++l) {
    LAUNCH(ok_cvt_wT, 2688L * 1024, I.w_in + (long)l * DM * IN_COLS, w.w_inT + (long)l * 2688 * 1024, 1024, IN_COLS, 2688);
    LAUNCH(ok_cvt_wT, 1024L * 1024, I.w_out + (long)l * DM * DM, w.w_outT + (long)l * 1024 * 1024, 1024, 1024, 1024);
    LAUNCH(ok_cvt_wT, 2048L * 1024, I.pe_wq + (long)l * DM * 2048, w.wqT + (long)l * 2048 * 1024, 1024, 2048, 2048);
    LAUNCH(ok_cvt_wT_g, 384L * 256, I.mla_w_qb + (long)l * 256 * 384, I.mla_q_norm_g + l * 256, w.wqbT + (long)l * 384 * 256, 256, 384, 256);
    LAUNCH(ok_cvt_wT_g, 512L * 128, I.mla_w_kvb + (long)l * 128 * 512, I.mla_kv_norm_g + l * 128, w.wkvbT + (long)l * 512 * 128, 128, 512, 128);
    for (int d = 0; d < 2; ++d) {
      LAUNCH(ok_cvt_wT_g, 384L * 64, I.rw_w2 + ((long)l * 2 + d) * 64 * 384, (const float*)nullptr, w.w2T + ((long)l * 2 + d) * 384 * 64, 64, 384, 64);
      LAUNCH(ok_cvt_wT_g, 384L * 64, I.rw_a2 + ((long)l * 2 + d) * 64 * 384, (const float*)nullptr, w.a2T + ((long)l * 2 + d) * 384 * 64, 64, 384, 64);
    }
    LAUNCH(ok_cvt_wT_g, 384L * 192, I.rw_g2 + (long)l * 160 * 384, (const float*)nullptr, w.g2T + (long)l * 384 * 192, 160, 384, 192);
  }
  LAUNCH(ok_cvt_bf16_v8, 2L * 16 * 128 * 128 / 8, I.pe_keys, w.keysb, 2L * 16 * 128 * 128 / 8);
  const int TM = NROWS / 128;
  for (int l = 0; l < 2; ++l) {
    const float* modl = w.mod + (long)l * (BATCH + 1) * 6144;
    ok_norm_mod_bf16<<<(NROWS + 3) / 4, 256, 0, stream>>>(w.xs, I.norm_mix_g + l * DM, modl, 0, w.xn, NROWS);
    ok_gemm<<<TM * 21, 256, 0, stream>>>(w.xn, DM, w.w_inT + (long)l * 2688 * 1024, 1024, 1024, TM, 21, EpiStoreBf16{w.Pb, IN_COLS, IN_COLS});
    PrepW pw{w.wqbT + (long)l * 384 * 256, w.wkvbT + (long)l * 512 * 128, w.w2T + (long)l * 2 * 384 * 64, w.a2T + (long)l * 2 * 384 * 64, w.g2T + (long)l * 384 * 192,
             I.rw_mu + (long)l * 2 * RWC, I.rw_w0 + l * 768, I.rw_a0 + l * 768};
    PrepBuf pb{w.Pb, w.tq, w.tkv, w.a_b, w.g_b, w.w_f};
    ok_prep_gemm<<<TM * 22, 256, 0, stream>>>(pw, pb);
    FinW fw{I.mla_qk_g + l * 192, I.gqa_qk_g + l * 128, I.rw_mu + (long)l * 2 * RWC, I.rw_k_k + l * 384, I.rw_k_a + l * 384};
    FinBuf fb{w.Pb, w.tq, w.tkv, w.a_b, w.mq, w.mk, w.mvT, w.gq, w.gk, w.gvT, w.r_b, w.v_b, w.kk_b, w.kd_b, w.bd_b};
    ok_prep_finish<<<NROWS / 64, 256, 0, stream>>>(fw, fb);
    ok_rw_scan<<<BATCH * 24, 256, 0, stream>>>(w.r_b, w.v_b, w.kk_b, w.kd_b, w.bd_b, w.w_f, w.y_f, 0, BATCH * 24, (long)MA * 384);
    ok_attn<<<BATCH * 10 * 18, 256, 0, stream>>>(w.mq, w.mk, w.mvT, w.gq, w.gk, w.gvT, w.mixall, 18);
    RdW rw{I.rw_r_k + l * 384, I.rw_ln_g + l * 384, I.rw_ln_b + l * 384};
    ok_rw_readout<<<NROWS / 4, 256, 0, stream>>>(rw, w.y_f, w.r_b, w.v_b, w.kd_b, w.g_b, w.mixall);
    ok_gemm<<<TM * 8, 256, 0, stream>>>(w.mixall, DM, w.w_outT + (long)l * 1024 * 1024, 1024, 1024, TM, 8, EpiResid{w.xs, modl, 2, 0});
    ok_norm_mod_bf16<<<(NROWS + 3) / 4, 256, 0, stream>>>(w.xs, I.norm_ffn_g + l * DM, modl, 3, w.xn, NROWS);
    LAUNCH(ok_cvt_bf16_v8, 16384L * DM / 8, I.pe_u + (long)l * 16384 * DM, w.ub, 16384L * DM / 8);
    LAUNCH(ok_cvt_bf16_v8, 16384L * DM / 8, I.pe_v + (long)l * 16384 * DM, w.vb, 16384L * DM / 8);
    ok_peer_q_top1<<<TM * 16, 256, 0, stream>>>(w.xn, w.wqT + (long)l * 2048 * 1024, w.keysb + (long)l * 16 * 128 * 128, w.top1, TM);
    ok_peer_gather<<<NROWS / 32, 256, 0, stream>>>(w.xn, w.top1, w.ub, w.vb, modl, w.xs, NROWS / 32);
  }
  LAUNCH(nk_copy_out, (long)BATCH * SEQ * DM, w.xs, out);
}

extern "C" void kernel_launch(void* const* d_in, const int* in_sizes, int n_in, void* d_out, int out_size, void* d_ws, size_t ws_size,
                              hipStream_t stream) {
  NaiveIn I; const float** pp = (const float**)&I;
  for (int i = 0; i < 31; ++i) pp[i] = (const float*)d_in[i];
  forward_v6(I, (float*)d_out, (char*)d_ws, ws_size, stream);
}
```

```cpp
#include <hip/hip_runtime.h>
#ifndef BATCH
#define BATCH 8
#endif
#ifndef SEQ
#define SEQ 2048
#endif
#ifndef CTX_LEN
#define CTX_LEN 256
#endif
#define DM 1024
#define RB (SEQ + CTX_LEN)
#define NROWS (BATCH * RB)
#define IN_COLS 2624
#define MLA_OFF 0
#define RW_OFF 416
#define GQA_OFF 1984
#define RWC 1568
#define EPSN 1e-6f

__device__ inline float sigmoidf_(float x) { return 1.f / (1.f + expf(-x)); }
__device__ inline float siluf_(float x) { return x * sigmoidf_(x); }
__device__ inline float softplusf_(float x) { return fmaxf(x, 0.f) + log1pf(expf(-fabsf(x))); }
__device__ inline float geluf_(float x) { return 0.5f * x * (1.f + tanhf(0.7978845608028654f * (x + 0.044715f * x * x * x))); }

__global__ void nk_copy_in(const float* x, const float* ctx, float* xs) {
  long i = (long)blockIdx.x * blockDim.x + threadIdx.x;
  if (i >= (long)NROWS * DM) return;
  int d = i % DM; long row = i / DM; int b = row / RB, lr = row % RB;
  xs[i] = lr < SEQ ? x[((long)b * SEQ + lr) * DM + d] : ctx[((long)b * CTX_LEN + (lr - SEQ)) * DM + d];
}
__global__ void nk_copy_out(const float* xs, float* out) {
  long i = (long)blockIdx.x * blockDim.x + threadIdx.x;
  if (i >= (long)BATCH * SEQ * DM) return;
  int d = i % DM; long row = i / DM; int b = row / SEQ, t = row % SEQ;
  out[i] = xs[((long)b * RB + t) * DM + d];
}
__global__ void nk_mod(const float* c, const float* c_ctx, const float* ada_w, const float* ada_b, float* mod) {
  long i = (long)blockIdx.x * blockDim.x + threadIdx.x;
  if (i >= 2L * (BATCH + 1) * 6144) return;
  int j = i % 6144; int bb = (i / 6144) % (BATCH + 1); int l = i / (6144 * (BATCH + 1));
  const float* cv = bb < BATCH ? c + (long)bb * DM : c_ctx;
  const float* w = ada_w + (long)l * DM * 6144;
  float acc = 0.f;
  for (int k = 0; k < DM; ++k) acc += siluf_(cv[k]) * w[(long)k * 6144 + j];
  mod[i] = acc + ada_b[l * 6144 + j];
}
__global__ void nk_norm_mod(const float* xs, const float* g, const float* modl, int shift_idx, float* xn, int M, int bidx) {
  long row = (long)blockIdx.x * blockDim.x + threadIdx.x;
  if (row >= M) return;
  int lr = row % RB; int bb = lr < SEQ ? bidx : BATCH;
  const float* sh = modl + ((long)bb * 6 + shift_idx) * DM; const float* sc = sh + DM;
  const float* xr = xs + row * DM; float ss = 0.f;
  for (int d = 0; d < DM; ++d) ss += xr[d] * xr[d];
  float inv = 1.f / sqrtf(ss / DM + EPSN);
  for (int d = 0; d < DM; ++d) xn[row * DM + d] = xr[d] * inv * g[d] * (1.f + sc[d]) + sh[d];
}
__global__ void nk_gemm(const float* A, const float* W, float* C, int M, int N, int K) {
  long i = (long)blockIdx.x * blockDim.x + threadIdx.x;
  if (i >= (long)M * N) return;
  int n = i % N; long m = i / N; float acc = 0.f;
  for (int k = 0; k < K; ++k) acc += A[m * K + k] * W[(long)k * N + n];
  C[i] = acc;
}
__global__ void nk_mla_q1(const float* P, const float* qng, const float* wqb, float* tq, int M) {
  long i = (long)blockIdx.x * blockDim.x + threadIdx.x;
  if (i >= (long)M * 384) return;
  int j = i % 384; long r = i / 384; const float* cq = P + r * IN_COLS;
  float ss = 0.f; for (int k = 0; k < 256; ++k) ss += cq[k] * cq[k];
  float inv = 1.f / sqrtf(ss / 256 + EPSN), acc = 0.f;
  for (int k = 0; k < 256; ++k) acc += cq[k] * inv * qng[k] * wqb[k * 384 + j];
  tq[i] = acc;
}
__global__ void nk_mla_kv1(const float* P, const float* kvng, const float* wkvb, float* tkv, int M) {
  long i = (long)blockIdx.x * blockDim.x + threadIdx.x;
  if (i >= (long)M * 512) return;
  int j = i % 512; long r = i / 512; const float* ck = P + r * IN_COLS + 256;
  float ss = 0.f; for (int k = 0; k < 128; ++k) ss += ck[k] * ck[k];
  float inv = 1.f / sqrtf(ss / 128 + EPSN), acc = 0.f;
  for (int k = 0; k < 128; ++k) acc += ck[k] * inv * kvng[k] * wkvb[k * 512 + j];
  tkv[i] = acc;
}
__global__ void nk_mla_qk2(const float* P, const float* tq, const float* tkv, const float* qkg, float* mq, float* mk, int M) {
  long i = (long)blockIdx.x * blockDim.x + threadIdx.x;
  if (i >= (long)M * 8) return;
  int which = i % 2, h = (i / 2) % 4; long r = i / 8; int lr = r % RB;
  float ss = 0.f;
  for (int e = 0; e < 96; ++e) {
    float v = which == 0 ? tq[r * 384 + h * 96 + e] : (e < 64 ? tkv[r * 512 + h * 128 + e] : P[r * IN_COLS + 384 + (e - 64)]);
    ss += v * v;
  }
  float inv = 1.f / sqrtf(ss / 96 + EPSN);
  const float* g = qkg + which * 96; float* o = (which == 0 ? mq : mk) + r * 384 + h * 96;
  for (int e = 0; e < 64; ++e) {
    float v = which == 0 ? tq[r * 384 + h * 96 + e] : tkv[r * 512 + h * 128 + e];
    o[e] = v * inv * g[e];
  }
  for (int j = 0; j < 16; ++j) {
    float va = which == 0 ? tq[r * 384 + h * 96 + 64 + j] : P[r * IN_COLS + 384 + j];
    float vb = which == 0 ? tq[r * 384 + h * 96 + 80 + j] : P[r * IN_COLS + 384 + 16 + j];
    va *= inv * g[64 + j]; vb *= inv * g[80 + j];
    if (lr < SEQ) {
      int pos = j < 8 ? lr / 64 : lr % 64; float fr = powf(10000.f, -(float)(j & 7) / 8.f);
      float ang = (float)pos * fr, cs = cosf(ang), sn = sinf(ang);
      o[64 + j] = va * cs - vb * sn; o[80 + j] = va * sn + vb * cs;
    } else { o[64 + j] = va; o[80 + j] = vb; }
  }
}
__global__ void nk_gqa_prep(const float* P, const float* qkg, float* gq, float* gk, int M) {
  long i = (long)blockIdx.x * blockDim.x + threadIdx.x;
  if (i >= (long)M * 8) return;
  int h = i % 8; long r = i / 8; int lr = r % RB;
  const float* src = P + r * IN_COLS + GQA_OFF + h * 64;
  const float* g = qkg + (h < 6 ? 0 : 64);
  float* o = h < 6 ? gq + r * 384 + h * 64 : gk + r * 128 + (h - 6) * 64;
  float ss = 0.f; for (int e = 0; e < 64; ++e) ss += src[e] * src[e];
  float inv = 1.f / sqrtf(ss / 64 + EPSN);
  for (int j = 0; j < 32; ++j) {
    float va = src[j] * inv * g[j], vb = src[32 + j] * inv * g[32 + j];
    if (lr < SEQ) {
      int pos = j < 16 ? lr / 64 : lr % 64; float fr = powf(10000.f, -(float)(j & 15) / 16.f);
      float ang = (float)pos * fr, cs = cosf(ang), sn = sinf(ang);
      o[j] = va * cs - vb * sn; o[32 + j] = va * sn + vb * cs;
    } else { o[j] = va; o[32 + j] = vb; }
  }
}
template <int DQ>
__global__ void __launch_bounds__(256) nk_attn(const float* q, int qs, const float* k, int ks, const float* v, int vs, int vhs, int H, int G, float* mix, int ooff, int M) {
  long i = (long)blockIdx.x * blockDim.x + threadIdx.x;
  if (i >= (long)M * H) return;
  int h = i % H; long r = i / H; int b = r / RB, lr = r % RB; int kh = h / G;
  float qv[DQ];
#pragma unroll
  for (int e = 0; e < DQ; ++e) qv[e] = q[r * qs + h * DQ + e];
  float acc[64];
#pragma unroll
  for (int e = 0; e < 64; ++e) acc[e] = 0.f;
  float mx = -1e30f, l = 0.f; const float scale = 1.f / sqrtf((float)DQ);
  int k0 = lr < SEQ ? 0 : SEQ, k1 = RB;
  for (int kr = k0; kr < k1; ++kr) {
    long rr = (long)b * RB + kr; const float* kp = k + rr * ks + kh * DQ; float s = 0.f;
#pragma unroll
    for (int e = 0; e < DQ; ++e) s += qv[e] * kp[e];
    s *= scale;
    float mn = fmaxf(mx, s), al = expf(mx - mn), pp = expf(s - mn);
    l = l * al + pp; mx = mn; const float* vp = v + rr * vs + kh * vhs;
#pragma unroll
    for (int e = 0; e < 64; ++e) acc[e] = acc[e] * al + pp * vp[e];
  }
#pragma unroll
  for (int e = 0; e < 64; ++e) mix[r * DM + ooff + h * 64 + e] = acc[e] / l;
}
__global__ void nk_rw_shift(const float* P, const float* mu, float* rwx, int M) {
  long i = (long)blockIdx.x * blockDim.x + threadIdx.x;
  if (i >= (long)M * RWC) return;
  int c = i % RWC; long r = i / RWC; int lr = r % RB;
  bool first = (lr == 0) || (lr == SEQ), last = (lr == SEQ - 1) || (lr == RB - 1);
  float p = P[r * IN_COLS + RW_OFF + c];
  float pv = first ? 0.f : P[(r - 1) * IN_COLS + RW_OFF + c], nx = last ? 0.f : P[(r + 1) * IN_COLS + RW_OFF + c];
  rwx[i] = p + mu[c] * (pv - p) + mu[RWC + c] * (nx - p);
}
__global__ void nk_rw_prep(const float* rwx, const float* w0, const float* w2, const float* a0, const float* a2, const float* g2,
                           const float* k_k, const float* k_a, float* dec, float* kd, float* bd, float* kk, float* gg, int M) {
  long i = (long)blockIdx.x * blockDim.x + threadIdx.x;
  if (i >= (long)M * 384) return;
  int c = i % 384; long r = i / 384; int h = c / 64; const float* xr = rwx + r * RWC;
  float kv = xr[384 + c];
  float ss = 0.f; for (int n = 0; n < 64; ++n) { float t = xr[384 + h * 64 + n] * k_k[h * 64 + n]; ss += t * t; }
  float kkv = kv * k_k[c] / sqrtf(ss + 1e-12f);
  kk[i] = kkv;
  for (int d = 0; d < 2; ++d) {
    float wr = w0[d * 384 + c], ar = a0[d * 384 + c];
    for (int j = 0; j < 64; ++j) { wr += tanhf(xr[1152 + d * 64 + j]) * w2[(d * 64 + j) * 384 + c]; ar += xr[1280 + d * 64 + j] * a2[(d * 64 + j) * 384 + c]; }
    float dc = expf(-expf(-softplusf_(-wr) - 0.5f)); float a = sigmoidf_(ar);
    dec[(long)d * M * 384 + i] = dc; kd[(long)d * M * 384 + i] = kv * (1.f + (a - 1.f) * k_a[c]); bd[(long)d * M * 384 + i] = kkv * a;
  }
  float g = 0.f; for (int j = 0; j < 160; ++j) g += sigmoidf_(xr[1408 + j]) * g2[j * 384 + c];
  gg[i] = g;
}
__global__ void __launch_bounds__(256) nk_rw_scan(const float* rwx, const float* dec, const float* kd, const float* bd, const float* kk, float* y, int M, int nb) {
  long t = (long)blockIdx.x * blockDim.x + threadIdx.x;
  if (t >= (long)nb * 2 * 6 * 64) return;
  int i = t % 64, h = (t / 64) % 6, d = (t / 384) % 2, b = t / 768;
  float S[64];
#pragma unroll
  for (int j = 0; j < 64; ++j) S[j] = 0.f;
  for (int step = 0; step < RB; ++step) {
    int lr;
    if (step < CTX_LEN) lr = SEQ + (d == 0 ? step : CTX_LEN - 1 - step);
    else lr = d == 0 ? step - CTX_LEN : SEQ - 1 - (step - CTX_LEN);
    long r = (long)b * RB + lr; long o = (long)d * M * 384 + r * 384 + h * 64;
    const float* rp = rwx + r * RWC + h * 64; const float* wp = dec + o; const float* kp = kd + o; const float* bp = bd + o; const float* kkp = kk + r * 384 + h * 64;
    float vi = rwx[r * RWC + 768 + h * 64 + i];
    float skk = 0.f;
#pragma unroll
    for (int j = 0; j < 64; ++j) skk += S[j] * kkp[j];
    float yy = 0.f;
#pragma unroll
    for (int j = 0; j < 64; ++j) { S[j] = S[j] * wp[j] - skk * bp[j] + vi * kp[j]; yy += S[j] * rp[j]; }
    y[o + i] = yy;
  }
}
__global__ void nk_rw_readout(const float* rwx, const float* y, const float* kd, const float* gg, const float* r_k, const float* ln_g, const float* ln_b, float* mix, int M, long yds) {
  long i = (long)blockIdx.x * blockDim.x + threadIdx.x;
  if (i >= (long)M * 6) return;
  int h = i % 6; long r = i / 6; long o = r * 384 + h * 64; long ds = (long)M * 384;
  float mean = 0.f; for (int n = 0; n < 64; ++n) mean += y[o + n] + y[yds + o + n];
  mean /= 64.f;
  float var = 0.f, coef = 0.f;
  for (int n = 0; n < 64; ++n) {
    float yy = y[o + n] + y[yds + o + n] - mean; var += yy * yy;
    coef += rwx[r * RWC + h * 64 + n] * (kd[o + n] + kd[ds + o + n]) * r_k[h * 64 + n];
  }
  var /= 64.f; float inv = 1.f / sqrtf(var + 64e-5f);
  for (int n = 0; n < 64; ++n) {
    float yn = (y[o + n] + y[yds + o + n] - mean) * inv * ln_g[h * 64 + n] + ln_b[h * 64 + n];
    mix[r * DM + 256 + h * 64 + n] = (yn + coef * rwx[r * RWC + 768 + h * 64 + n]) * gg[o + n];
  }
}
__global__ void nk_gemm_res(const float* A, const float* W, const float* modl, int gi, float* xs, int M, int bidx) {
  long i = (long)blockIdx.x * blockDim.x + threadIdx.x;
  if (i >= (long)M * DM) return;
  int j = i % DM; long r = i / DM; int lr = r % RB; int bb = lr < SEQ ? bidx : BATCH;
  float acc = 0.f; for (int k = 0; k < DM; ++k) acc += A[r * DM + k] * W[(long)k * DM + j];
  xs[i] += modl[((long)bb * 6 + gi) * DM + j] * acc;
}
__global__ void nk_peer_score(const float* pq, const float* keys, float* sc, int M) {
  long i = (long)blockIdx.x * blockDim.x + threadIdx.x;
  if (i >= (long)M * 2048) return;
  int k = i % 128, ps = (i / 128) % 16; long r = i / 2048;
  const float* q = pq + r * 2048 + ps * 128; const float* ky = keys + ((long)ps * 128 + k) * 128;
  float acc = 0.f; for (int d = 0; d < 128; ++d) acc += q[d] * ky[d];
  sc[i] = acc;
}
__global__ void nk_peer_top1(const float* sc, float* ts, int* ti, int M) {
  long i = (long)blockIdx.x * blockDim.x + threadIdx.x;
  if (i >= (long)M * 16) return;
  const float* s = sc + i * 128; float pv = 3e38f; int pi = -1;
  for (int t = 0; t < 16; ++t) {
    float bv = -3e38f; int bi = -1;
    for (int k = 0; k < 128; ++k) {
      float v = s[k]; bool ok = (v < pv) || (v == pv && k > pi);
      if (ok && (bi < 0 || v > bv)) { bv = v; bi = k; }
    }
    ts[i * 16 + t] = bv; ti[i * 16 + t] = bi; pv = bv; pi = bi;
  }
}
__global__ void nk_peer_top2(const float* ts, const int* ti, int* pe, float* pg, int M) {
  long i = (long)blockIdx.x * blockDim.x + threadIdx.x;
  if (i >= (long)M * 8) return;
  const float* s1 = ts + i * 32; const float* s2 = s1 + 16; const int* i1 = ti + i * 32; const int* i2 = i1 + 16;
  float pv = 3e38f; int pi = -1; float mx = 0.f, sum = 0.f;
  for (int t = 0; t < 16; ++t) {
    float bv = -3e38f; int bi = -1;
    for (int c = 0; c < 256; ++c) {
      float v = s1[c / 16] + s2[c % 16]; bool ok = (v < pv) || (v == pv && c > pi);
      if (ok && (bi < 0 || v > bv)) { bv = v; bi = c; }
    }
    if (t == 0) mx = bv;
    float e = expf(bv - mx); sum += e;
    pe[i * 16 + t] = i1[bi / 16] * 128 + i2[bi % 16]; pg[i * 16 + t] = e; pv = bv; pi = bi;
  }
  for (int t = 0; t < 16; ++t) pg[i * 16 + t] /= sum;
}
__global__ void nk_peer_act(const float* xn, const float* u, const int* pe, const float* pg, float* pw, int M) {
  long i = (long)blockIdx.x * blockDim.x + threadIdx.x;
  if (i >= (long)M * 128) return;
  long r = i / 128; const float* ur = u + (long)pe[i] * DM; const float* xr = xn + r * DM;
  float acc = 0.f; for (int d = 0; d < DM; ++d) acc += xr[d] * ur[d];
  pw[i] = pg[i] * geluf_(acc);
}
__global__ void nk_peer_out(const float* v, const int* pe, const float* pw, const float* modl, float* xs, int M, int bidx) {
  long i = (long)blockIdx.x * blockDim.x + threadIdx.x;
  if (i >= (long)M * DM) return;
  int j = i % DM; long r = i / DM; int lr = r % RB; int bb = lr < SEQ ? bidx : BATCH;
  float acc = 0.f; for (int k = 0; k < 128; ++k) acc += pw[r * 128 + k] * v[(long)pe[r * 128 + k] * DM + j];
  xs[i] += modl[((long)bb * 6 + 5) * DM + j] * acc;
}


__device__ __forceinline__ unsigned f2sortable(float s) { unsigned f = __float_as_uint(s); return (f & 0x80000000u) ? ~f : (f | 0x80000000u); }
__device__ __forceinline__ float sortable2f(unsigned o) { unsigned f = (o & 0x80000000u) ? (o & 0x7fffffffu) : ~o; return __uint_as_float(f); }
__device__ __forceinline__ unsigned enc_key(float s, int idx) { return (f2sortable(s) & ~127u) | (unsigned)(127 - idx); }
__device__ __forceinline__ void dec_key(unsigned k, float& s, int& idx) { idx = 127 - (int)(k & 127u); s = sortable2f(k & ~127u); }
__device__ __forceinline__ unsigned umax_(unsigned a, unsigned b) { return a > b ? a : b; }
__device__ __forceinline__ unsigned umin_(unsigned a, unsigned b) { return a < b ? a : b; }
__device__ __forceinline__ void ins16(unsigned (&l)[16], unsigned x) {
#pragma unroll
  for (int i = 0; i < 16; ++i) { unsigned mx = umax_(l[i], x); x = umin_(l[i], x); l[i] = mx; }
}
__device__ __forceinline__ void merge16(unsigned (&a)[16], const unsigned (&brev)[16]) {
#pragma unroll
  for (int i = 0; i < 16; ++i) a[i] = umax_(a[i], brev[i]);
#pragma unroll
  for (int d = 8; d >= 1; d >>= 1)
#pragma unroll
    for (int i = 0; i < 16; ++i) if ((i & d) == 0) { unsigned hi = umax_(a[i], a[i + d]), lo = umin_(a[i], a[i + d]); a[i] = hi; a[i + d] = lo; }
}
__device__ __forceinline__ void peer_combine(const unsigned* L0, const unsigned* L1, int* e_out, float* g_out) {
  float s0[16], s1[16];
#pragma unroll
  for (int i = 0; i < 16; ++i) { int ix; dec_key(L0[i], s0[i], ix); dec_key(L1[i], s1[i], ix); }
  unsigned sel[16];
#pragma unroll
  for (int i = 0; i < 16; ++i) sel[i] = 0u;
#pragma unroll
  for (int i = 0; i < 16; ++i)
#pragma unroll
    for (int j = 0; j < 16; ++j)
      if ((i + 1) * (j + 1) <= 16) { unsigned k = (f2sortable(s0[i] + s1[j]) & ~255u) | (unsigned)(255 - (i * 16 + j)); ins16(sel, k); }
  float mx = -3e38f;
#pragma unroll
  for (int t = 0; t < 16; ++t) {
    int c = 255 - (int)(sel[t] & 255u); int i = c >> 4, j = c & 15;
    float a, b; int ia, ib; dec_key(L0[i], a, ia); dec_key(L1[j], b, ib);
    float s = a + b; e_out[t] = ia * 128 + ib; g_out[t] = s; mx = fmaxf(mx, s);
  }
  float sum = 0.f;
#pragma unroll
  for (int t = 0; t < 16; ++t) { float e = expf(g_out[t] - mx); g_out[t] = e; sum += e; }
  float inv = 1.f / sum;
#pragma unroll
  for (int t = 0; t < 16; ++t) g_out[t] *= inv;
}
__global__ void hk_peer_top1(const float* pq, const float* keys, unsigned* top1, int M) {
  long i = (long)blockIdx.x * blockDim.x + threadIdx.x;
  if (i >= (long)M * 16) return;
  int ps = i % 16; long r = i / 16; const float* q = pq + r * 2048 + ps * 128;
  unsigned la[16], lb[16], lbr[16];
#pragma unroll
  for (int t = 0; t < 16; ++t) { la[t] = 0u; lb[t] = 0u; }
  for (int k = 0; k < 128; ++k) {
    const float* ky = keys + ((long)ps * 128 + k) * 128; float acc = 0.f;
    for (int d = 0; d < 128; ++d) acc += q[d] * ky[d];
    unsigned key = enc_key(acc, k);
    if (k < 64) ins16(la, key); else ins16(lb, key);
  }
#pragma unroll
  for (int t = 0; t < 16; ++t) lbr[t] = lb[15 - t];
  merge16(la, lbr);
#pragma unroll
  for (int t = 0; t < 16; ++t) top1[i * 16 + t] = la[t];
}
__global__ void hk_peer_combine(const unsigned* top1, int* pe, float* pg, int M) {
  long i = (long)blockIdx.x * blockDim.x + threadIdx.x;
  if (i >= (long)M * 8) return;
  peer_combine(top1 + i * 32, top1 + i * 32 + 16, pe + i * 16, pg + i * 16);
}
typedef unsigned short bf16_t;
__device__ __forceinline__ int tid_opaque() { int t = threadIdx.x; asm volatile("" : "+v"(t)); return t; }
typedef __attribute__((ext_vector_type(8))) short bf16x8;
typedef __attribute__((ext_vector_type(4))) float f32x4;
typedef __attribute__((ext_vector_type(16))) float f32x16;
typedef __attribute__((ext_vector_type(4))) unsigned u32x4;

__device__ __forceinline__ bf16_t f2bf(float f) {
  unsigned u = __float_as_uint(f); u += 0x7fffu + ((u >> 16) & 1u); return (bf16_t)(u >> 16);
}
__device__ __forceinline__ float bf2f(bf16_t h) { return __uint_as_float(((unsigned)h) << 16); }
__device__ __forceinline__ unsigned pack2bf(float a, float b) { return (unsigned)f2bf(a) | ((unsigned)f2bf(b) << 16); }

#define GEMM_LDS_BYTES 32768
struct ALoadPlain { const bf16_t* A; int lda;
  __device__ __forceinline__ u32x4 operator()(int row, int k) const { return *(const u32x4*)(A + (long)row * lda + k); } };
template <class ALoad, class Epi>
__device__ __forceinline__ void gemm_tile_128(ALoad aload, const bf16_t* __restrict__ Bt, int ldb, int K,
                                              int tile_m, int tile_n, char* smem, Epi epi) {
  const int t = tid_opaque(), lane = t & 63, wave = t >> 6;
  const int wm = wave >> 1, wn = wave & 1;
  char* As = smem; char* Bs = smem + 16384;
  const int lrow = t >> 3, lchunk = t & 7;
  const int arow = tile_m * 128 + lrow;
  const bf16_t* bg = Bt + (long)(tile_n * 128 + lrow) * ldb + lchunk * 8;
  u32x4 ra[4], rb[4];
#pragma unroll
  for (int i = 0; i < 4; ++i) {
    ra[i] = aload(arow + 32 * i, lchunk * 8);
    rb[i] = *(const u32x4*)(bg + (long)(32 * i) * ldb);
  }
  f32x4 acc[4][4];
#pragma unroll
  for (int i = 0; i < 4; ++i)
#pragma unroll
    for (int j = 0; j < 4; ++j) acc[i][j] = (f32x4){0.f, 0.f, 0.f, 0.f};
  const int fr = lane & 15, fq = lane >> 4;
  for (int k0 = 0; k0 < K; k0 += 64) {
    __syncthreads();
#pragma unroll
    for (int i = 0; i < 4; ++i) {
      int r = lrow + 32 * i; int off = r * 128 + ((lchunk ^ (r & 7)) << 4);
      *(u32x4*)(As + off) = ra[i]; *(u32x4*)(Bs + off) = rb[i];
    }
    __syncthreads();
    if (k0 + 64 < K) {
#pragma unroll
      for (int i = 0; i < 4; ++i) {
        ra[i] = aload(arow + 32 * i, k0 + 64 + lchunk * 8);
        rb[i] = *(const u32x4*)(bg + (long)(32 * i) * ldb + k0 + 64);
      }
    }
#pragma unroll
    for (int ks = 0; ks < 2; ++ks) {
      bf16x8 af[4], bfr[4];
#pragma unroll
      for (int i = 0; i < 4; ++i) {
        int r = wm * 64 + i * 16 + fr; af[i] = *(const bf16x8*)(As + r * 128 + (((ks * 4 + fq) ^ (r & 7)) << 4));
        int rn = wn * 64 + i * 16 + fr; bfr[i] = *(const bf16x8*)(Bs + rn * 128 + (((ks * 4 + fq) ^ (rn & 7)) << 4));
      }
#pragma unroll
      for (int i = 0; i < 4; ++i)
#pragma unroll
        for (int j = 0; j < 4; ++j) acc[i][j] = __builtin_amdgcn_mfma_f32_16x16x32_bf16(bfr[j], af[i], acc[i][j], 0, 0, 0);
    }
  }
#pragma unroll
  for (int i = 0; i < 4; ++i)
#pragma unroll
    for (int j = 0; j < 4; ++j) {
      int m = tile_m * 128 + wm * 64 + i * 16 + fr; int n0 = tile_n * 128 + wn * 64 + j * 16 + fq * 4;
      epi(m, n0, acc[i][j]);
    }
}

__global__ void ok_cvt_wT(const float* W, bf16_t* Wt, int K, int N, int Npad) {
  long i = (long)blockIdx.x * blockDim.x + threadIdx.x;
  if (i >= (long)Npad * K) return;
  int k = i % K; int n = i / K;
  Wt[i] = n < N ? f2bf(W[(long)k * N + n]) : (bf16_t)0;
}
__global__ void ok_f32_to_bf16(const float* s, bf16_t* d, long n) {
  long i = (long)blockIdx.x * blockDim.x + threadIdx.x; if (i < n) d[i] = f2bf(s[i]);
}
__global__ void ok_bf16_to_f32(const bf16_t* s, float* d, long n) {
  long i = (long)blockIdx.x * blockDim.x + threadIdx.x; if (i < n) d[i] = bf2f(s[i]);
}
__global__ void ok_norm_mod_bf16(const float* xs, const float* g, const float* modl, int shift_idx, bf16_t* xn, int M) {
  int row = blockIdx.x * 4 + (threadIdx.x >> 6); int lane = threadIdx.x & 63;
  if (row >= M) return;
  int b = row / RB, lr = row % RB; int bb = lr < SEQ ? b : BATCH;
  const float* sh = modl + ((long)bb * 6 + shift_idx) * DM; const float* sc = sh + DM;
  const float* xr = xs + (long)row * DM; float v[16]; float ss = 0.f;
#pragma unroll
  for (int i = 0; i < 4; ++i) { float4 q = *(const float4*)(xr + i * 256 + lane * 4); v[i*4]=q.x; v[i*4+1]=q.y; v[i*4+2]=q.z; v[i*4+3]=q.w; ss += q.x*q.x+q.y*q.y+q.z*q.z+q.w*q.w; }
#pragma unroll
  for (int o = 32; o > 0; o >>= 1) ss += __shfl_xor(ss, o);
  float inv = 1.f / sqrtf(ss / DM + EPSN);
#pragma unroll
  for (int i = 0; i < 4; ++i) {
    int d = i * 256 + lane * 4; float o[4];
#pragma unroll
    for (int e = 0; e < 4; ++e) o[e] = v[i*4+e] * inv * g[d+e] * (1.f + sc[d+e]) + sh[d+e];
    uint2 pk; pk.x = pack2bf(o[0], o[1]); pk.y = pack2bf(o[2], o[3]);
    *(uint2*)(xn + (long)row * DM + d) = pk;
  }
}

struct EpiStoreBf16 { bf16_t* C; int ldc; int N;
  __device__ __forceinline__ void operator()(int m, int n0, f32x4 v) const {
    if (n0 < N) { uint2 pk; pk.x = pack2bf(v[0], v[1]); pk.y = pack2bf(v[2], v[3]); *(uint2*)(C + (long)m * ldc + n0) = pk; } } };
struct EpiStoreF32 { float* C; int ldc; int N;
  __device__ __forceinline__ void operator()(int m, int n0, f32x4 v) const {
    if (n0 < N) *(float4*)(C + (long)m * ldc + n0) = make_float4(v[0], v[1], v[2], v[3]); } };
struct EpiResid { float* xs; const float* modl; int gi; int pad;
  __device__ __forceinline__ void operator()(int m, int n0, f32x4 v) const {
    int b = m / RB, lr = m % RB; int bb = lr < SEQ ? b : BATCH; const float* g = modl + ((long)bb * 6 + gi) * DM + n0;
    float4 x = *(float4*)(xs + (long)m * DM + n0);
    x.x += g[0] * v[0]; x.y += g[1] * v[1]; x.z += g[2] * v[2]; x.w += g[3] * v[3];
    *(float4*)(xs + (long)m * DM + n0) = x; } };

template <class Epi>
__global__ void __launch_bounds__(256) ok_gemm(const bf16_t* A, int lda, const bf16_t* Bt, int ldb, int K, int tiles_m, int tiles_n, Epi epi) {
  __shared__ __attribute__((aligned(16))) char smem[GEMM_LDS_BYTES];
  for (int tile = blockIdx.x; tile < tiles_m * tiles_n; tile += gridDim.x) {
    int tm = tile / tiles_n, tn = tile % tiles_n;
    gemm_tile_128(ALoadPlain{A, lda}, Bt, ldb, K, tm, tn, smem, epi);
  }
}

typedef __attribute__((ext_vector_type(2))) __bf16 bf16v2;
__device__ __forceinline__ float dot2bf(unsigned a, unsigned b, float c) {
  return __builtin_amdgcn_fdot2_f32_bf16(*(bf16v2*)&a, *(bf16v2*)&b, c, false);
}
__global__ void ok_cvt_bf16_v8(const float* s, bf16_t* d, long n8) {
  long i = (long)blockIdx.x * blockDim.x + threadIdx.x; if (i >= n8) return;
  float4 a = *(const float4*)(s + i * 8), b = *(const float4*)(s + i * 8 + 4);
  u32x4 o; o[0] = pack2bf(a.x, a.y); o[1] = pack2bf(a.z, a.w); o[2] = pack2bf(b.x, b.y); o[3] = pack2bf(b.z, b.w);
  *(u32x4*)(d + i * 8) = o;
}

#define P5_LDS_BYTES (128 * 128 * 4)
__device__ __forceinline__ void peer_q_top1_tile(const bf16_t* __restrict__ A, const bf16_t* __restrict__ WqT, const bf16_t* __restrict__ keysb,
                                                 unsigned* __restrict__ top1, int tm, int ps, char* smem) {
  const int t = tid_opaque(), lane = t & 63, wave = t >> 6, wm = wave >> 1, wn = wave & 1, fr = lane & 15, fq = lane >> 4;
  f32x4 acc[4][4];
  {
    char* As = smem; char* Bs = smem + 16384;
    const int lrow = t >> 3, lchunk = t & 7;
    const bf16_t* ag = A + (long)(tm * 128 + lrow) * DM + lchunk * 8;
    const bf16_t* bg = WqT + (long)(ps * 128 + lrow) * DM + lchunk * 8;
    u32x4 ra[4], rb[4];
#pragma unroll
    for (int i = 0; i < 4; ++i) { ra[i] = *(const u32x4*)(ag + (long)(32 * i) * DM); rb[i] = *(const u32x4*)(bg + (long)(32 * i) * DM); }
#pragma unroll
    for (int i = 0; i < 4; ++i)
#pragma unroll
      for (int j = 0; j < 4; ++j) acc[i][j] = (f32x4){0.f, 0.f, 0.f, 0.f};
    for (int k0 = 0; k0 < DM; k0 += 64) {
      __syncthreads();
#pragma unroll
      for (int i = 0; i < 4; ++i) { int r = lrow + 32 * i; int off = r * 128 + ((lchunk ^ (r & 7)) << 4); *(u32x4*)(As + off) = ra[i]; *(u32x4*)(Bs + off) = rb[i]; }
      __syncthreads();
      if (k0 + 64 < DM) {
#pragma unroll
        for (int i = 0; i < 4; ++i) { ra[i] = *(const u32x4*)(ag + (long)(32 * i) * DM + k0 + 64); rb[i] = *(const u32x4*)(bg + (long)(32 * i) * DM + k0 + 64); }
      }
#pragma unroll
      for (int ks = 0; ks < 2; ++ks) {
        bf16x8 af[4], bfr[4];
#pragma unroll
        for (int i = 0; i < 4; ++i) {
          int r = wm * 64 + i * 16 + fr; af[i] = *(const bf16x8*)(As + r * 128 + (((ks * 4 + fq) ^ (r & 7)) << 4));
          int rn = wn * 64 + i * 16 + fr; bfr[i] = *(const bf16x8*)(Bs + rn * 128 + (((ks * 4 + fq) ^ (rn & 7)) << 4));
        }
#pragma unroll
        for (int i = 0; i < 4; ++i)
#pragma unroll
          for (int j = 0; j < 4; ++j) acc[i][j] = __builtin_amdgcn_mfma_f32_16x16x32_bf16(bfr[j], af[i], acc[i][j], 0, 0, 0);
      }
    }
  }
  __syncthreads();
  char* Qs = smem; char* Ks = smem + 32768;
#pragma unroll
  for (int i = 0; i < 4; ++i)
#pragma unroll
    for (int j = 0; j < 4; ++j) {
      int m = wm * 64 + i * 16 + fr; int n0 = wn * 64 + j * 16 + fq * 4;
      uint2 pk; pk.x = pack2bf(acc[i][j][0], acc[i][j][1]); pk.y = pack2bf(acc[i][j][2], acc[i][j][3]);
      *(uint2*)(Qs + m * 256 + ((((n0 >> 3) ^ (m & 15)) << 4) | ((n0 & 7) << 1))) = pk;
    }
  {
    const bf16_t* kg = keysb + (long)ps * 128 * 128;
#pragma unroll
    for (int i = 0; i < 8; ++i) { int idx = t + 256 * i; int r = idx >> 4, c = idx & 15; *(u32x4*)(Ks + r * 256 + ((c ^ (r & 15)) << 4)) = *(const u32x4*)(kg + r * 128 + c * 8); }
  }
  __syncthreads();
#pragma unroll
  for (int i = 0; i < 4; ++i)
#pragma unroll
    for (int j = 0; j < 4; ++j) acc[i][j] = (f32x4){0.f, 0.f, 0.f, 0.f};
#pragma unroll
  for (int ks = 0; ks < 4; ++ks) {
    bf16x8 af[4], bfr[4];
#pragma unroll
    for (int i = 0; i < 4; ++i) {
      int r = wm * 64 + i * 16 + fr; af[i] = *(const bf16x8*)(Qs + r * 256 + (((ks * 4 + fq) ^ (r & 15)) << 4));
      int rn = wn * 64 + i * 16 + fr; bfr[i] = *(const bf16x8*)(Ks + rn * 256 + (((ks * 4 + fq) ^ (rn & 15)) << 4));
    }
#pragma unroll
    for (int i = 0; i < 4; ++i)
#pragma unroll
      for (int j = 0; j < 4; ++j) acc[i][j] = __builtin_amdgcn_mfma_f32_16x16x32_bf16(bfr[j], af[i], acc[i][j], 0, 0, 0);
  }
  __syncthreads();
  unsigned* Sc = (unsigned*)smem;
#pragma unroll
  for (int i = 0; i < 4; ++i)
#pragma unroll
    for (int j = 0; j < 4; ++j) {
      int m = wm * 64 + i * 16 + fr; int n0 = wn * 64 + j * 16 + fq * 4;
#pragma unroll
      for (int e = 0; e < 4; ++e) Sc[(n0 + e) * 128 + (m ^ ((((n0 + e) >> 2) & 1) << 4))] = enc_key(acc[i][j][e], n0 + e);
    }
  __syncthreads();
  {
    const int r = t & 127, half = t >> 7;
    unsigned l[16];
#pragma unroll
    for (int i = 0; i < 16; ++i) l[i] = 0u;
    for (int k = 0; k < 64; ++k) ins16(l, Sc[(half * 64 + k) * 128 + (r ^ (((k >> 2) & 1) << 4))]);
    __syncthreads();
    unsigned* Ls = (unsigned*)smem;
    if (half == 1) {
#pragma unroll
      for (int i = 0; i < 16; ++i) Ls[r * 17 + i] = l[15 - i];
    }
    __syncthreads();
    if (half == 0) {
      unsigned br[16];
#pragma unroll
      for (int i = 0; i < 16; ++i) br[i] = Ls[r * 17 + i];
      merge16(l, br);
      unsigned* o = top1 + ((long)(tm * 128 + r) * 16 + ps) * 16;
#pragma unroll
      for (int i = 0; i < 4; ++i) { u32x4 v; v[0] = l[4*i]; v[1] = l[4*i+1]; v[2] = l[4*i+2]; v[3] = l[4*i+3]; *(u32x4*)(o + 4 * i) = v; }
    }
  }
}
__global__ void __launch_bounds__(256) ok_peer_q_top1(const bf16_t* A, const bf16_t* WqT, const bf16_t* keysb, unsigned* top1, int tiles_m) {
  __shared__ __attribute__((aligned(16))) char smem[P5_LDS_BYTES];
  for (int tile = blockIdx.x; tile < tiles_m * 16; tile += gridDim.x) { peer_q_top1_tile(A, WqT, keysb, top1, tile / 16, tile % 16, smem); __syncthreads(); }
}

#define P6_LDS_BYTES (32 * 128 * 4 * 3)
__device__ __forceinline__ void peer_gather_group(const bf16_t* __restrict__ xn, const unsigned* __restrict__ top1, const bf16_t* __restrict__ ub,
                                                  const bf16_t* __restrict__ vb, const float* __restrict__ modl, float* __restrict__ xs, int grp, char* smem) {
  const int t = tid_opaque(), lane = t & 63, wave = t >> 6;
  int* pe_l = (int*)smem; float* pg_l = (float*)(smem + 32 * 128 * 4); float* pw_l = (float*)(smem + 2 * 32 * 128 * 4);
  {
    int tl = t >> 3, p = t & 7; long row = (long)grp * 32 + tl;
    peer_combine(top1 + (row * 16 + p * 2) * 16, top1 + (row * 16 + p * 2 + 1) * 16, pe_l + tl * 128 + p * 16, pg_l + tl * 128 + p * 16);
  }
  __syncthreads();
  for (int ti = 0; ti < 8; ++ti) {
    const int tl = wave * 8 + ti; const long row = (long)grp * 32 + tl;
    const int* pe = pe_l + tl * 128; float* pw = pw_l + tl * 128;
    u32x4 h0 = *(const u32x4*)(xn + row * DM + lane * 8), h1 = *(const u32x4*)(xn + row * DM + 512 + lane * 8);
    for (int b = 0; b < 16; ++b) {
      u32x4 u0[8], u1[8];
#pragma unroll
      for (int j = 0; j < 8; ++j) { const bf16_t* ur = ub + (long)pe[b * 8 + j] * DM + lane * 8; u0[j] = *(const u32x4*)ur; u1[j] = *(const u32x4*)(ur + 512); }
      float pd[8];
#pragma unroll
      for (int j = 0; j < 8; ++j) {
        float a = 0.f;
#pragma unroll
        for (int e = 0; e < 4; ++e) { a = dot2bf(h0[e], u0[j][e], a); a = dot2bf(h1[e], u1[j][e], a); }
        pd[j] = a;
      }
      float q4[4], q2[2], q1;
#pragma unroll
      for (int j = 0; j < 4; ++j) { bool hi = lane & 1; float keep = hi ? pd[2*j+1] : pd[2*j], send = hi ? pd[2*j] : pd[2*j+1]; q4[j] = keep + __shfl_xor(send, 1); }
#pragma unroll
      for (int j = 0; j < 2; ++j) { bool hi = lane & 2; float keep = hi ? q4[2*j+1] : q4[2*j], send = hi ? q4[2*j] : q4[2*j+1]; q2[j] = keep + __shfl_xor(send, 2); }
      { bool hi = lane & 4; float keep = hi ? q2[1] : q2[0], send = hi ? q2[0] : q2[1]; q1 = keep + __shfl_xor(send, 4); }
      q1 += __shfl_xor(q1, 8); q1 += __shfl_xor(q1, 16); q1 += __shfl_xor(q1, 32);
      if (lane < 8) { int j = lane & 7; pw[b * 8 + j] = q1; }
    }
    {
      float d0 = pw[lane], d1 = pw[64 + lane];
      pw[lane] = pg_l[tl * 128 + lane] * geluf_(d0); pw[64 + lane] = pg_l[tl * 128 + 64 + lane] * geluf_(d1);
    }
    float o[16];
#pragma unroll
    for (int e = 0; e < 16; ++e) o[e] = 0.f;
    for (int b = 0; b < 16; ++b) {
      u32x4 v0[8], v1[8];
#pragma unroll
      for (int j = 0; j < 8; ++j) { const bf16_t* vr = vb + (long)pe[b * 8 + j] * DM + lane * 8; v0[j] = *(const u32x4*)vr; v1[j] = *(const u32x4*)(vr + 512); }
#pragma unroll
      for (int j = 0; j < 8; ++j) {
        float w = pw[b * 8 + j];
#pragma unroll
        for (int e = 0; e < 4; ++e) {
          o[2*e]     += w * __uint_as_float(v0[j][e] << 16); o[2*e+1]     += w * __uint_as_float(v0[j][e] & 0xffff0000u);
          o[8 + 2*e] += w * __uint_as_float(v1[j][e] << 16); o[8 + 2*e+1] += w * __uint_as_float(v1[j][e] & 0xffff0000u);
        }
      }
    }
    {
      int b = row / RB, lr = row % RB; int bb = lr < SEQ ? b : BATCH; const float* g5 = modl + ((long)bb * 6 + 5) * DM;
      float* xr = xs + row * DM;
#pragma unroll
      for (int hf = 0; hf < 2; ++hf) {
        int d = hf * 512 + lane * 8;
        float4 x0 = *(float4*)(xr + d), x1 = *(float4*)(xr + d + 4); float4 g0 = *(const float4*)(g5 + d), g1 = *(const float4*)(g5 + d + 4);
        x0.x += g0.x * o[hf*8+0]; x0.y += g0.y * o[hf*8+1]; x0.z += g0.z * o[hf*8+2]; x0.w += g0.w * o[hf*8+3];
        x1.x += g1.x * o[hf*8+4]; x1.y += g1.y * o[hf*8+5]; x1.z += g1.z * o[hf*8+6]; x1.w += g1.w * o[hf*8+7];
        *(float4*)(xr + d) = x0; *(float4*)(xr + d + 4) = x1;
      }
    }
  }
}
__global__ void __launch_bounds__(256) ok_peer_gather(const bf16_t* xn, const unsigned* top1, const bf16_t* ub, const bf16_t* vb, const float* modl, float* xs, int ngroups) {
  __shared__ __attribute__((aligned(16))) char smem[P6_LDS_BYTES];
  for (int g = blockIdx.x; g < ngroups; g += gridDim.x) { peer_gather_group(xn, top1, ub, vb, modl, xs, g, smem); __syncthreads(); }
}

template <int DQ> struct AttnCfg { static constexpr int KROW = DQ * 2 + 16; static constexpr int VROW = 136; static constexpr int KBYTES = 64 * KROW; static constexpr int LDS = 64 * KROW + 64 * VROW; };
#define ATTN_LDS_BYTES (64 * 208 + 64 * 136)
template <int DQ>
__device__ __forceinline__ void attn_block(const bf16_t* __restrict__ qb, int HQ, const bf16_t* __restrict__ kb, int HK, const bf16_t* __restrict__ vT, int G,
                                           bf16_t* __restrict__ mixall, int ooff, int b, int head, int qt, char* smem) {
  constexpr int KROW = AttnCfg<DQ>::KROW, VROW = 136, NKK = DQ / 16, KCH = DQ / 8;
  constexpr int KLD = (64 * KCH) / 256;
  const int t = tid_opaque(), lane = t & 63, wave = t >> 6, lq = lane & 31, lh = lane >> 5;
  const int hk = head / G;
  char* Ks = smem; char* Vs = smem + 64 * KROW;
  const long qrow = (long)b * RB + qt * 128 + wave * 32 + lq;
  bf16x8 qf[NKK];
#pragma unroll
  for (int kk = 0; kk < NKK; ++kk) qf[kk] = *(const bf16x8*)(qb + (qrow * HQ + head) * DQ + kk * 16 + lh * 8);
  const int key0 = qt < 16 ? 0 : SEQ; const int nt = qt < 16 ? RB / 64 : CTX_LEN / 64;
  const bf16_t* kbase = kb + ((long)b * RB * HK + hk) * DQ; const bf16_t* vbase = vT + ((long)(b * HK + hk) * 64) * RB;
  u32x4 rk[KLD], rv[2];
  auto issue = [&](int tile) {
    int k0 = key0 + tile * 64;
#pragma unroll
    for (int i = 0; i < KLD; ++i) { int c = t + 256 * i; int r = c / KCH, cc = c % KCH; rk[i] = *(const u32x4*)(kbase + (long)(k0 + r) * HK * DQ + cc * 8); }
#pragma unroll
    for (int i = 0; i < 2; ++i) { int c = t + 256 * i; int r = c >> 3, cc = c & 7; rv[i] = *(const u32x4*)(vbase + (long)r * RB + k0 + cc * 8); }
  };
  issue(0);
  f32x16 ot[2];
#pragma unroll
  for (int d = 0; d < 2; ++d)
#pragma unroll
    for (int r = 0; r < 16; ++r) ot[d][r] = 0.f;
  float mrun = -1e30f, lrun = 0.f;
  for (int tile = 0; tile < nt; ++tile) {
    __syncthreads();
#pragma unroll
    for (int i = 0; i < KLD; ++i) { int c = t + 256 * i; int r = c / KCH, cc = c % KCH; *(u32x4*)(Ks + r * KROW + cc * 16) = rk[i]; }
#pragma unroll
    for (int i = 0; i < 2; ++i) { int c = t + 256 * i; int r = c >> 3, cc = c & 7; *(uint2*)(Vs + r * VROW + cc * 16) = make_uint2(rv[i][0], rv[i][1]); *(uint2*)(Vs + r * VROW + cc * 16 + 8) = make_uint2(rv[i][2], rv[i][3]); }
    __syncthreads();
    if (tile + 1 < nt) issue(tile + 1);
    f32x16 st[2];
#pragma unroll
    for (int kt = 0; kt < 2; ++kt) {
#pragma unroll
      for (int r = 0; r < 16; ++r) st[kt][r] = 0.f;
#pragma unroll
      for (int kk = 0; kk < NKK; ++kk) {
        bf16x8 ka = *(const bf16x8*)(Ks + (kt * 32 + lq) * KROW + kk * 32 + lh * 16);
        st[kt] = __builtin_amdgcn_mfma_f32_32x32x16_bf16(ka, qf[kk], st[kt], 0, 0, 0);
      }
    }
    float mt = st[0][0];
#pragma unroll
    for (int kt = 0; kt < 2; ++kt)
#pragma unroll
      for (int r = 0; r < 16; ++r) mt = fmaxf(mt, st[kt][r]);
    mt = fmaxf(mt, __shfl_xor(mt, 32));
    float mnew = fmaxf(mrun, mt); float alpha = __builtin_amdgcn_exp2f(mrun - mnew); mrun = mnew;
    float ps = 0.f;
#pragma unroll
    for (int kt = 0; kt < 2; ++kt)
#pragma unroll
      for (int r = 0; r < 16; ++r) { float p = __builtin_amdgcn_exp2f(st[kt][r] - mnew); st[kt][r] = p; ps += p; }
    lrun = lrun * alpha + ps;
#pragma unroll
    for (int d = 0; d < 2; ++d)
#pragma unroll
      for (int r = 0; r < 16; ++r) ot[d][r] *= alpha;
#pragma unroll
    for (int kt = 0; kt < 2; ++kt)
#pragma unroll
      for (int s = 0; s < 2; ++s) {
        union { bf16x8 v; unsigned u[4]; } pb;
#pragma unroll
        for (int j = 0; j < 4; ++j) pb.u[j] = pack2bf(st[kt][8 * s + 2 * j], st[kt][8 * s + 2 * j + 1]);
#pragma unroll
        for (int d = 0; d < 2; ++d) {
          const char* vp = Vs + (d * 32 + lq) * VROW + (kt * 32 + 16 * s + 4 * lh) * 2;
          union { bf16x8 v; uint2 h[2]; } va; va.h[0] = *(const uint2*)vp; va.h[1] = *(const uint2*)(vp + 16);
          ot[d] = __builtin_amdgcn_mfma_f32_32x32x16_bf16(va.v, pb.v, ot[d], 0, 0, 0);
        }
      }
  }
  float ltot = lrun + __shfl_xor(lrun, 32); float inv = 1.f / ltot;
  bf16_t* orow = mixall + qrow * DM + ooff + head * 64;
#pragma unroll
  for (int d = 0; d < 2; ++d)
#pragma unroll
    for (int g = 0; g < 4; ++g) {
      uint2 pk; pk.x = pack2bf(ot[d][4 * g] * inv, ot[d][4 * g + 1] * inv); pk.y = pack2bf(ot[d][4 * g + 2] * inv, ot[d][4 * g + 3] * inv);
      *(uint2*)(orow + d * 32 + 8 * g + 4 * lh) = pk;
    }
}
__global__ void __launch_bounds__(256) ok_attn(const bf16_t* mq, const bf16_t* mk, const bf16_t* mvT, const bf16_t* gq, const bf16_t* gk, const bf16_t* gvT, bf16_t* mixall, int nqt) {
  __shared__ __attribute__((aligned(16))) char smem[ATTN_LDS_BYTES];
  const int n_mla = BATCH * 4 * nqt, n_gqa = BATCH * 6 * nqt;
  for (int w = blockIdx.x; w < n_mla + n_gqa; w += gridDim.x) {
    if (w < n_mla) { int qt = w % nqt, head = (w / nqt) % 4, b = w / (nqt * 4); attn_block<96>(mq, 4, mk, 4, mvT, 1, mixall, 0, b, head, qt, smem); }
    else { int v = w - n_mla; int qt = v % nqt, head = (v / nqt) % 6, b = v / (nqt * 6); attn_block<64>(gq, 6, gk, 2, gvT, 3, mixall, 640, b, head, qt, smem); }
    __syncthreads();
  }
}
__global__ void ok_adapt_rows(const float* src, int sld, int scol, int ncols, float scale, bf16_t* dst, int dld, int nrows) {
  long i = (long)blockIdx.x * blockDim.x + threadIdx.x; if (i >= (long)nrows * ncols) return;
  int c = i % ncols; long r = i / ncols; dst[r * dld + c] = f2bf(src[r * sld + scol + c] * scale);
}
__global__ void ok_adapt_vT(const float* src, int sld, int scol, int hstride, int H, bf16_t* dst) {
  long i = (long)blockIdx.x * blockDim.x + threadIdx.x; if (i >= (long)H * 64 * RB) return;
  int lr = i % RB; int d = (i / RB) % 64; int h = i / ((long)RB * 64);
  dst[i] = f2bf(src[(long)lr * sld + scol + h * hstride + d]);
}

typedef __attribute__((ext_vector_type(2))) float f32x2;
#define SCAN_TS 16
#define SCAN_LDS_BYTES (2 * SCAN_TS * 1536 + 2 * SCAN_TS * 32 * 4)
__device__ __forceinline__ float reduce8(float x) {
  x += __builtin_bit_cast(float, __builtin_amdgcn_update_dpp(0, __builtin_bit_cast(int, x), 0xB1, 0xf, 0xf, true));
  x += __builtin_bit_cast(float, __builtin_amdgcn_update_dpp(0, __builtin_bit_cast(int, x), 0x4E, 0xf, 0xf, true));
  x += __builtin_bit_cast(float, __builtin_amdgcn_update_dpp(0, __builtin_bit_cast(int, x), 0x141, 0xf, 0xf, true));
  return x;
}
__device__ __forceinline__ int scan_row(int dir, int s) {
  if (s < CTX_LEN) return SEQ + (dir == 0 ? s : CTX_LEN - 1 - s);
  return dir == 0 ? s - CTX_LEN : SEQ - 1 - (s - CTX_LEN);
}
__device__ __forceinline__ void rw_scan_block(const bf16_t* __restrict__ r_, const bf16_t* __restrict__ v_, const bf16_t* __restrict__ kk_, const bf16_t* __restrict__ kd_,
                                              const bf16_t* __restrict__ bd_, const float* __restrict__ w_, float* __restrict__ y_, int item, long dstride, char* smem) {
  const int t = tid_opaque(), lane = t & 63, wave = t >> 6, cg = lane & 7, il = wave * 8 + (lane >> 3);
  const int half = item & 1, dir = (item >> 1) & 1, h = (item >> 2) % 6, b = item / 24;
  const long rowbase = (long)b * RB; const int col0 = h * 64;
  float* ybuf = (float*)(smem + 2 * SCAN_TS * 1536);
  const int st_ld = t >> 4, part = t & 15;
  u32x4 la, lb, lc, lw;
  auto issue = [&](int c) {
    long row = rowbase + scan_row(dir, c * SCAN_TS + st_ld); long o = row * 384 + col0;
    const int ch = (part & 7) * 8;
    la = *(const u32x4*)((part < 8 ? kk_ + o : bd_ + dir * dstride + o) + ch);
    lb = *(const u32x4*)((part < 8 ? kd_ + dir * dstride + o : r_ + o) + ch);
    lc = *(const u32x4*)(v_ + o + ch);
    lw = *(const u32x4*)(w_ + dir * dstride + o + part * 4);
  };
  auto stash = [&](int buf) {
    float* base = (float*)(smem + buf * SCAN_TS * 1536 + st_ld * 1536);
    const int ch = (part & 7) * 8;
    float* pa = base + (part < 8 ? 64 : 128) + ch; float* pb = base + (part < 8 ? 192 : 256) + ch;
    f32x4 x0, x1;
#pragma unroll
    for (int e = 0; e < 2; ++e) { x0[2*e] = __uint_as_float(la[e] << 16); x0[2*e+1] = __uint_as_float(la[e] & 0xffff0000u); x1[2*e] = __uint_as_float(la[2+e] << 16); x1[2*e+1] = __uint_as_float(la[2+e] & 0xffff0000u); }
    *(f32x4*)pa = x0; *(f32x4*)(pa + 4) = x1;
#pragma unroll
    for (int e = 0; e < 2; ++e) { x0[2*e] = __uint_as_float(lb[e] << 16); x0[2*e+1] = __uint_as_float(lb[e] & 0xffff0000u); x1[2*e] = __uint_as_float(lb[2+e] << 16); x1[2*e+1] = __uint_as_float(lb[2+e] & 0xffff0000u); }
    *(f32x4*)pb = x0; *(f32x4*)(pb + 4) = x1;
    if (part < 8) {
      float* pc = base + 320 + ch;
#pragma unroll
      for (int e = 0; e < 2; ++e) { x0[2*e] = __uint_as_float(lc[e] << 16); x0[2*e+1] = __uint_as_float(lc[e] & 0xffff0000u); x1[2*e] = __uint_as_float(lc[2+e] << 16); x1[2*e+1] = __uint_as_float(lc[2+e] & 0xffff0000u); }
      *(f32x4*)pc = x0; *(f32x4*)(pc + 4) = x1;
    }
    *(u32x4*)(base + part * 4) = lw;
  };
  f32x2 S[4];
#pragma unroll
  for (int j = 0; j < 4; ++j) S[j] = (f32x2){0.f, 0.f};
  const int NCH = RB / SCAN_TS;
  issue(0);
  for (int c = 0; c < NCH; ++c) {
    const int buf = c & 1;
    stash(buf);
    __syncthreads();
    if (c > 0 && t < 128) {
      int st = t >> 3, i4 = (t & 7) * 4; long row = rowbase + scan_row(dir, (c - 1) * SCAN_TS + st);
      *(f32x4*)(y_ + dir * dstride + row * 384 + col0 + half * 32 + i4) = *(const f32x4*)(ybuf + (buf ^ 1) * SCAN_TS * 32 + st * 32 + i4);
    }
    if (c + 1 < NCH) issue(c + 1);
    const float* ob = (const float*)(smem + buf * SCAN_TS * 1536) + cg * 8;
    float yk[SCAN_TS];
#pragma unroll
    for (int st = 0; st < SCAN_TS; ++st) {
      const float* o = ob + st * 384;
      f32x4 w0 = *(const f32x4*)(o), w1 = *(const f32x4*)(o + 4), k0 = *(const f32x4*)(o + 64), k1 = *(const f32x4*)(o + 68);
      f32x4 b0 = *(const f32x4*)(o + 128), b1 = *(const f32x4*)(o + 132), d0 = *(const f32x4*)(o + 192), d1 = *(const f32x4*)(o + 196);
      f32x4 r0 = *(const f32x4*)(o + 256), r1 = *(const f32x4*)(o + 260);
      float vi = ob[st * 384 + 320 - cg * 8 + half * 32 + il];
      f32x2 a2 = S[0] * (f32x2){k0[0], k0[1]}; a2 += S[1] * (f32x2){k0[2], k0[3]}; a2 += S[2] * (f32x2){k1[0], k1[1]}; a2 += S[3] * (f32x2){k1[2], k1[3]};
      float skk = reduce8(a2[0] + a2[1]);
      f32x2 vv = (f32x2){vi, vi}, ns = (f32x2){-skk, -skk};
      S[0] = S[0] * (f32x2){w0[0], w0[1]} + (vv * (f32x2){d0[0], d0[1]} + ns * (f32x2){b0[0], b0[1]});
      S[1] = S[1] * (f32x2){w0[2], w0[3]} + (vv * (f32x2){d0[2], d0[3]} + ns * (f32x2){b0[2], b0[3]});
      S[2] = S[2] * (f32x2){w1[0], w1[1]} + (vv * (f32x2){d1[0], d1[1]} + ns * (f32x2){b1[0], b1[1]});
      S[3] = S[3] * (f32x2){w1[2], w1[3]} + (vv * (f32x2){d1[2], d1[3]} + ns * (f32x2){b1[2], b1[3]});
      f32x2 y2 = S[0] * (f32x2){r0[0], r0[1]}; y2 += S[1] * (f32x2){r0[2], r0[3]}; y2 += S[2] * (f32x2){r1[0], r1[1]}; y2 += S[3] * (f32x2){r1[2], r1[3]};
      yk[st] = reduce8(y2[0] + y2[1]);
    }
    if (cg == 0) {
#pragma unroll
      for (int st = 0; st < SCAN_TS; ++st) ybuf[buf * SCAN_TS * 32 + st * 32 + il] = yk[st];
    }
  }
  __syncthreads();
  if (t < 128) {
    int st = t >> 3, i4 = (t & 7) * 4; long row = rowbase + scan_row(dir, (NCH - 1) * SCAN_TS + st);
    *(f32x4*)(y_ + dir * dstride + row * 384 + col0 + half * 32 + i4) = *(const f32x4*)(ybuf + ((NCH - 1) & 1) * SCAN_TS * 32 + st * 32 + i4);
  }
}
__global__ void __launch_bounds__(256) ok_rw_scan(const bf16_t* r_, const bf16_t* v_, const bf16_t* kk_, const bf16_t* kd_, const bf16_t* bd_, const float* w_, float* y_, int item0, int nitems, long dstride) {
  __shared__ __attribute__((aligned(16))) char smem[SCAN_LDS_BYTES];
  for (int it = item0 + blockIdx.x; it < item0 + nitems; it += gridDim.x) { rw_scan_block(r_, v_, kk_, kd_, bd_, w_, y_, it, dstride, smem); __syncthreads(); }
}
__global__ void ok_copy_rows_f32(const float* src, int sld, int scol, int ncols, float* dst, int dld, int nrows) {
  long i = (long)blockIdx.x * blockDim.x + threadIdx.x; if (i >= (long)nrows * ncols) return;
  int c = i % ncols; long r = i / ncols; dst[r * dld + c] = src[r * sld + scol + c];
}

__global__ void ok_cvt_wT_g(const float* W, const float* g, bf16_t* Wt, int K, int N, int Kpad) {
  long i = (long)blockIdx.x * blockDim.x + threadIdx.x;
  if (i >= (long)N * Kpad) return;
  int k = i % Kpad; int n = i / Kpad;
  Wt[i] = k < K ? f2bf(W[(long)k * N + n] * (g ? g[k] : 1.f)) : (bf16_t)0;
}
struct ALoadShift { const bf16_t* P; const float* mu; int col0; int mucol0; int act; int kvalid;
  __device__ __forceinline__ u32x4 operator()(int row, int k) const {
    u32x4 z = {0u, 0u, 0u, 0u};
    if (k >= kvalid) return z;
    int lr = row % RB; bool first = (lr == 0) || (lr == SEQ), last = (lr == SEQ - 1) || (lr == RB - 1);
    const bf16_t* p = P + (long)row * IN_COLS + col0 + k;
    u32x4 c = *(const u32x4*)p; u32x4 pv = first ? z : *(const u32x4*)(p - IN_COLS); u32x4 nx = last ? z : *(const u32x4*)(p + IN_COLS);
    const float* m0 = mu + mucol0 + k; const float* m1 = m0 + RWC;
    u32x4 o;
#pragma unroll
    for (int e = 0; e < 4; ++e) {
      float c0 = __uint_as_float(c[e] << 16), c1 = __uint_as_float(c[e] & 0xffff0000u);
      float p0 = __uint_as_float(pv[e] << 16), p1 = __uint_as_float(pv[e] & 0xffff0000u);
      float n0 = __uint_as_float(nx[e] << 16), n1 = __uint_as_float(nx[e] & 0xffff0000u);
      float x0 = c0 + m0[2*e] * (p0 - c0) + m1[2*e] * (n0 - c0), x1 = c1 + m0[2*e+1] * (p1 - c1) + m1[2*e+1] * (n1 - c1);
      if (act == 1) { x0 = tanhf(x0); x1 = tanhf(x1); } else if (act == 2) { x0 = sigmoidf_(x0); x1 = sigmoidf_(x1); }
      o[e] = pack2bf(x0, x1);
    }
    return o;
  } };
struct EpiDecay { float* w; const float* w0; int pad0; int pad1;
  __device__ __forceinline__ void operator()(int m, int n0, f32x4 v) const {
    f32x4 o;
#pragma unroll
    for (int e = 0; e < 4; ++e) o[e] = expf(-expf(-softplusf_(-(w0[n0 + e] + v[e])) - 0.5f));
    *(f32x4*)(w + (long)m * 384 + n0) = o; } };
struct EpiSigA { bf16_t* a; const float* a0;
  __device__ __forceinline__ void operator()(int m, int n0, f32x4 v) const {
    uint2 pk; pk.x = pack2bf(sigmoidf_(a0[n0] + v[0]), sigmoidf_(a0[n0+1] + v[1])); pk.y = pack2bf(sigmoidf_(a0[n0+2] + v[2]), sigmoidf_(a0[n0+3] + v[3]));
    *(uint2*)(a + (long)m * 384 + n0) = pk; } };

struct PrepW { const bf16_t *wqbT, *wkvbT, *w2T, *a2T, *g2T; const float *mu, *w0, *a0; };
struct PrepBuf { const bf16_t* P; bf16_t *tq, *tkv, *a_b, *g_b; float* w_f; };
__device__ __forceinline__ void prep_gemm_tile(const PrepW& W, const PrepBuf& B, int tm, int ct, char* smem) {
  const long MA = NROWS;
  if (ct < 3) gemm_tile_128(ALoadPlain{B.P, IN_COLS}, W.wqbT, 256, 256, tm, ct, smem, EpiStoreBf16{B.tq, 384, 384});
  else if (ct < 7) gemm_tile_128(ALoadPlain{B.P + 256, IN_COLS}, W.wkvbT, 128, 128, tm, ct - 3, smem, EpiStoreBf16{B.tkv, 512, 512});
  else if (ct < 13) { int d = (ct - 7) / 3, tn = (ct - 7) % 3;
    gemm_tile_128(ALoadShift{B.P, W.mu, RW_OFF + 1152 + d * 64, 1152 + d * 64, 1, 64}, W.w2T + d * 384 * 64, 64, 64, tm, tn, smem, EpiDecay{B.w_f + d * MA * 384, W.w0 + d * 384, 0, 0}); }
  else if (ct < 19) { int d = (ct - 13) / 3, tn = (ct - 13) % 3;
    gemm_tile_128(ALoadShift{B.P, W.mu, RW_OFF + 1280 + d * 64, 1280 + d * 64, 0, 64}, W.a2T + d * 384 * 64, 64, 64, tm, tn, smem, EpiSigA{B.a_b + d * MA * 384, W.a0 + d * 384}); }
  else gemm_tile_128(ALoadShift{B.P, W.mu, RW_OFF + 1408, 1408, 2, 160}, W.g2T, 192, 192, tm, ct - 19, smem, EpiStoreBf16{B.g_b, 384, 384});
}
__global__ void __launch_bounds__(256) ok_prep_gemm(PrepW W, PrepBuf B) {
  __shared__ __attribute__((aligned(16))) char smem[GEMM_LDS_BYTES];
  for (int tile = blockIdx.x; tile < (NROWS / 128) * 22; tile += gridDim.x) prep_gemm_tile(W, B, tile / 22, tile % 22, smem);
}

__device__ __forceinline__ float wave_sum(float x) {
#pragma unroll
  for (int o = 32; o > 0; o >>= 1) x += __shfl_xor(x, o);
  return x;
}
__device__ __forceinline__ float ldbf(const bf16_t* p) { return bf2f(*p); }
struct FinW { const float *mla_qk_g, *gqa_qk_g, *mu, *k_k, *k_a; };
struct FinBuf { const bf16_t *P, *tq, *tkv, *a_b; bf16_t *mq, *mk, *mvT, *gq, *gk, *gvT, *r_b, *v_b, *kk_b, *kd_b, *bd_b; };
#define FIN_LDS_BYTES (384 * 132)
__device__ __forceinline__ void prep_finish_tile(const FinW& W, const FinBuf& B, int tile, char* smem) {
  const int t = tid_opaque(), lane = t & 63, wave = t >> 6; const long MA = NROWS;
  bf16_t* vbuf = (bf16_t*)smem;
  const long row0 = (long)tile * 64; const int b = row0 / RB; const int lr0 = row0 % RB;
  for (int it = 0; it < 16; ++it) {
    const int rl = it * 4 + wave; const long row = row0 + rl; const int lr = lr0 + rl; const bool lat = lr < SEQ;
    const bf16_t* Pr = B.P + row * IN_COLS;
    float sq = 0.f;
#pragma unroll
    for (int i = 0; i < 4; ++i) { float x = ldbf(Pr + i * 64 + lane); sq += x * x; }
    float skv = 0.f;
#pragma unroll
    for (int i = 0; i < 2; ++i) { float x = ldbf(Pr + 256 + i * 64 + lane); skv += x * x; }
    const float cq = 1.f / sqrtf(wave_sum(sq) / 256.f + EPSN), ckv = 1.f / sqrtf(wave_sum(skv) / 128.f + EPSN);
    const float krope = lane < 32 ? ldbf(Pr + 384 + lane) : 0.f;
    float cs_m = 1.f, sn_m = 0.f;
    { int j = lane & 15; int pos = j < 8 ? lr / 64 : lr % 64; float ang = (float)pos * powf(10000.f, -(float)(j & 7) / 8.f); if (lat) { cs_m = cosf(ang); sn_m = sinf(ang); } }
    const float* gq_ = W.mla_qk_g; const float* gk_ = W.mla_qk_g + 96;
#pragma unroll
    for (int h = 0; h < 4; ++h) {
      float qa = cq * ldbf(B.tq + row * 384 + h * 96 + lane); float qb = lane < 32 ? cq * ldbf(B.tq + row * 384 + h * 96 + 64 + lane) : 0.f;
      float inv = 1.f / sqrtf(wave_sum(qa * qa + qb * qb) / 96.f + EPSN);
      qa *= inv * gq_[lane]; qb *= inv * (lane < 32 ? gq_[64 + lane] : 0.f);
      { float other = __shfl_xor(qb, 16); float rr = (lane & 16) ? (other * sn_m + qb * cs_m) : (qb * cs_m - other * sn_m); qb = rr; }
      const float qs = 0.14724445f;
      B.mq[row * 384 + h * 96 + lane] = f2bf(qa * qs); if (lane < 32) B.mq[row * 384 + h * 96 + 64 + lane] = f2bf(qb * qs);
      float ka = ckv * ldbf(B.tkv + row * 512 + h * 128 + lane); float kb = krope;
      float invk = 1.f / sqrtf(wave_sum(ka * ka + kb * kb) / 96.f + EPSN);
      ka *= invk * gk_[lane]; kb *= invk * (lane < 32 ? gk_[64 + lane] : 0.f);
      { float other = __shfl_xor(kb, 16); float rr = (lane & 16) ? (other * sn_m + kb * cs_m) : (kb * cs_m - other * sn_m); kb = rr; }
      B.mk[row * 384 + h * 96 + lane] = f2bf(ka); if (lane < 32) B.mk[row * 384 + h * 96 + 64 + lane] = f2bf(kb);
      vbuf[(h * 64 + lane) * 66 + rl] = f2bf(ckv * ldbf(B.tkv + row * 512 + h * 128 + 64 + lane));
    }
    float cs_g = 1.f, sn_g = 0.f;
    { int j = lane & 31; int pos = j < 16 ? lr / 64 : lr % 64; float ang = (float)pos * powf(10000.f, -(float)(j & 15) / 16.f); if (lat) { cs_g = cosf(ang); sn_g = sinf(ang); } }
#pragma unroll
    for (int h = 0; h < 8; ++h) {
      float x = ldbf(Pr + GQA_OFF + h * 64 + lane);
      float inv = 1.f / sqrtf(wave_sum(x * x) / 64.f + EPSN);
      x *= inv * W.gqa_qk_g[(h < 6 ? 0 : 64) + lane];
      float other = __shfl_xor(x, 32); float rr = (lane & 32) ? (other * sn_g + x * cs_g) : (x * cs_g - other * sn_g);
      if (h < 6) B.gq[row * 384 + h * 64 + lane] = f2bf(rr * 0.18033688f); else B.gk[row * 128 + (h - 6) * 64 + lane] = f2bf(rr);
    }
#pragma unroll
    for (int hk = 0; hk < 2; ++hk) vbuf[((4 + hk) * 64 + lane) * 66 + rl] = Pr[GQA_OFF + 512 + hk * 64 + lane];
    const bool first = (lr == 0) || (lr == SEQ), last = (lr == SEQ - 1) || (lr == RB - 1);
#pragma unroll
    for (int h = 0; h < 6; ++h) {
      float xs3[3];
#pragma unroll
      for (int part = 0; part < 3; ++part) {
        int c = part * 384 + h * 64 + lane; const bf16_t* pp = Pr + RW_OFF + c;
        float p = ldbf(pp), pv = first ? 0.f : ldbf(pp - IN_COLS), nx = last ? 0.f : ldbf(pp + IN_COLS);
        xs3[part] = p + W.mu[c] * (pv - p) + W.mu[RWC + c] * (nx - p);
      }
      const int c = h * 64 + lane; const long o = row * 384 + c;
      float kv = xs3[1]; float tk = kv * W.k_k[c]; float kkv = tk / sqrtf(wave_sum(tk * tk) + 1e-12f);
      B.r_b[o] = f2bf(xs3[0]); B.v_b[o] = f2bf(xs3[2]); B.kk_b[o] = f2bf(kkv);
#pragma unroll
      for (int d = 0; d < 2; ++d) { float a = ldbf(B.a_b + d * MA * 384 + o); B.kd_b[d * MA * 384 + o] = f2bf(kv * (1.f + (a - 1.f) * W.k_a[c])); B.bd_b[d * MA * 384 + o] = f2bf(kkv * a); }
    }
  }
  __syncthreads();
  for (int i = t; i < 384 * 32; i += 256) {
    int rr = i >> 5, w2 = i & 31; int slot = rr >> 6, d = rr & 63;
    unsigned val = *(const unsigned*)(vbuf + rr * 66 + w2 * 2);
    bf16_t* dst = slot < 4 ? B.mvT + ((long)(b * 4 + slot) * 64 + d) * RB : B.gvT + ((long)(b * 2 + (slot - 4)) * 64 + d) * RB;
    *(unsigned*)(dst + lr0 + w2 * 2) = val;
  }
  __syncthreads();
}
__global__ void __launch_bounds__(256) ok_prep_finish(FinW W, FinBuf B) {
  __shared__ __attribute__((aligned(16))) char smem[FIN_LDS_BYTES];
  for (int tile = blockIdx.x; tile < NROWS / 64; tile += gridDim.x) prep_finish_tile(W, B, tile, smem);
}
struct RdW { const float *r_k, *ln_g, *ln_b; };
__device__ __forceinline__ void rw_readout_row(const RdW& W, const float* __restrict__ y, const bf16_t* __restrict__ r_b, const bf16_t* __restrict__ v_b, const bf16_t* __restrict__ kd_b,
                                               const bf16_t* __restrict__ g_b, bf16_t* __restrict__ mixall, long row, int lane) {
  const long MA = NROWS;
#pragma unroll
  for (int h = 0; h < 6; ++h) {
    const int c = h * 64 + lane; const long o = row * 384 + c;
    float yy = y[o] + y[MA * 384 + o];
    float mean = wave_sum(yy) * (1.f / 64.f); float dv = yy - mean; float var = wave_sum(dv * dv) * (1.f / 64.f);
    float coef = wave_sum(ldbf(r_b + o) * (ldbf(kd_b + o) + ldbf(kd_b + MA * 384 + o)) * W.r_k[c]);
    float yn = dv / sqrtf(var + 64e-5f) * W.ln_g[c] + W.ln_b[c];
    mixall[row * DM + 256 + c] = f2bf((yn + coef * ldbf(v_b + o)) * ldbf(g_b + o));
  }
}
__global__ void __launch_bounds__(256) ok_rw_readout(RdW W, const float* y, const bf16_t* r_b, const bf16_t* v_b, const bf16_t* kd_b, const bf16_t* g_b, bf16_t* mixall) {
  for (long row = blockIdx.x * 4 + (threadIdx.x >> 6); row < NROWS; row += gridDim.x * 4) rw_readout_row(W, y, r_b, v_b, kd_b, g_b, mixall, row, threadIdx.x & 63);
}
#include <hip/hip_cooperative_groups.h>
namespace cg = cooperative_groups;

#define XB_TMO      128
#define XB_XCNT(j)  (256  + 64 * (j))
#define XB_XSUB(j)  (1280 + 64 * (j))
#define XB_XGEN(j)  (2304 + 64 * (j))
#define XB_TOP      3328
#define XB_TOPGEN   3392
#define XB_QUEUE(i) (3456 + 64 * (i))
#define XCD_BAR_WORDS 4096
#define XB_SPIN_CAP (1u << 22)
#define LAS __attribute__((address_space(3)))
__device__ __forceinline__ unsigned xb_ld(unsigned* p)              { return __hip_atomic_load(p, __ATOMIC_RELAXED, __HIP_MEMORY_SCOPE_AGENT); }
__device__ __forceinline__ unsigned xb_add(unsigned* p, unsigned v) { return __hip_atomic_fetch_add(p, v, __ATOMIC_RELAXED, __HIP_MEMORY_SCOPE_AGENT); }
__device__ __forceinline__ unsigned xb_xcc_id() { return (unsigned)__builtin_amdgcn_s_getreg((3 << 11) | 20) & 0xFu; }
#define XB_SPIN(cond, bar) do { unsigned _sp = 0; while (cond) { __builtin_amdgcn_s_sleep(1); \
    if ((++_sp & 255u) == 0u) { if (xb_ld(&(bar)[XB_TMO])) break; if (_sp > XB_SPIN_CAP) { atomicAdd(&(bar)[XB_TMO], 1u); break; } } } } while (0)
struct XcdBarrier { unsigned* bar; unsigned x; volatile LAS unsigned* st; };
__device__ __forceinline__ XcdBarrier xcd_barrier_post(unsigned* bar, volatile LAS unsigned* st) {
  XcdBarrier b; b.bar = bar; b.x = xb_xcc_id(); b.st = st;
  if (threadIdx.x == 0) (void)xb_add(&bar[XB_XCNT(b.x)], 1u);
  return b;
}
__device__ __forceinline__ void xcd_barrier_complete(unsigned* bar, unsigned x, unsigned& nloc, unsigned& nx) {
  const unsigned G = gridDim.x; unsigned sum, cnt, mine, sp = 0u;
  for (;;) {
    sum = 0u; cnt = 0u; mine = 0u;
#pragma unroll
    for (unsigned j = 0; j < 16; ++j) { const unsigned c = xb_ld(&bar[XB_XCNT(j)]); sum += c; cnt += (c > 0u) ? 1u : 0u; mine = (j == x) ? c : mine; }
    if (sum == G) break;
    __builtin_amdgcn_s_sleep(1);
    if ((++sp & 255u) == 0u) { if (xb_ld(&bar[XB_TMO])) break; if (sp > XB_SPIN_CAP) { atomicAdd(&bar[XB_TMO], 1u); break; } }
  }
  nloc = mine > 0u ? mine : 1u; nx = cnt > 0u ? cnt : 1u;
}
__device__ __forceinline__ void xcd_barrier(const XcdBarrier& b) {
  asm volatile("s_waitcnt vmcnt(0)" ::: "memory");
  __syncthreads();
  if (threadIdx.x == 0) {
    unsigned* bar = b.bar;
    __builtin_amdgcn_s_waitcnt(0);
    unsigned nloc = b.st[0], nx = b.st[1];
    if (nloc == 0u) { xcd_barrier_complete(bar, b.x, nloc, nx); b.st[0] = nloc; b.st[1] = nx; }
    const unsigned old = xb_add(&bar[XB_XSUB(b.x)], 1u);
    const unsigned gen = old / nloc;
    if (old + 1u == (gen + 1u) * nloc) {
      __builtin_amdgcn_fence(__ATOMIC_RELEASE, "agent");
      asm volatile("s_waitcnt vmcnt(0)" ::: "memory");
      const unsigned og = xb_add(&bar[XB_TOP], 1u);
      const unsigned tg = og / nx;
      if (og + 1u == (tg + 1u) * nx) xb_add(&bar[XB_TOPGEN], 1u);
      else XB_SPIN(xb_ld(&bar[XB_TOPGEN]) == tg, bar);
      __builtin_amdgcn_fence(__ATOMIC_ACQUIRE, "agent");
      xb_add(&bar[XB_XGEN(b.x)], 1u);
      asm volatile("s_waitcnt vmcnt(0)" ::: "memory");
    } else {
      XB_SPIN(xb_ld(&bar[XB_XGEN(b.x)]) == gen, bar);
      __builtin_amdgcn_fence(__ATOMIC_ACQUIRE, "agent");
      asm volatile("s_waitcnt vmcnt(0)" ::: "memory");
    }
  }
  __syncthreads();
}


constexpr size_t al256(size_t x) { return (x + 255) & ~(size_t)255; }
struct WsOff { size_t xs, mod, xn, Pb, tq, tkv, a_b, g_b, w_f, mq, mk, mvT, gq, gk, gvT, r_b, v_b, kk_b, kd_b, bd_b, w_inT, w_outT, wqT, keysb, wqbT, wkvbT, w2T, a2T, g2T, total; };
constexpr WsOff make_wsoff() {
  WsOff o{}; size_t p = 16384; const size_t MA = NROWS;
  o.xs = p; p += al256(MA * DM * 4); o.mod = p; p += al256(2 * (BATCH + 1) * 6144 * 4); o.xn = p; p += al256(MA * DM * 2);
  o.Pb = p; p += al256(MA * IN_COLS * 2);
  o.tq = p; p += al256(MA * 384 * 2); o.tkv = p; p += al256(MA * 512 * 2); o.a_b = p; p += al256(2 * MA * 384 * 2);
  o.g_b = p; p += al256(MA * 384 * 2); o.w_f = p; p += al256(2 * MA * 384 * 4);
  o.mq = p; p += al256(MA * 384 * 2); o.mk = p; p += al256(MA * 384 * 2); o.mvT = p; p += al256((size_t)BATCH * 4 * 64 * RB * 2);
  o.gq = p; p += al256(MA * 384 * 2); o.gk = p; p += al256(MA * 128 * 2); o.gvT = p; p += al256((size_t)BATCH * 2 * 64 * RB * 2);
  o.r_b = p; p += al256(MA * 384 * 2); o.v_b = p; p += al256(MA * 384 * 2); o.kk_b = p; p += al256(MA * 384 * 2);
  o.kd_b = p; p += al256(2 * MA * 384 * 2); o.bd_b = p; p += al256(2 * MA * 384 * 2);
  o.w_inT = p; p += al256((size_t)2 * 2688 * 1024 * 2); o.w_outT = p; p += al256((size_t)2 * 1024 * 1024 * 2); o.wqT = p; p += al256((size_t)2 * 2048 * 1024 * 2);
  o.keysb = p; p += al256((size_t)2 * 16 * 128 * 128 * 2); o.wqbT = p; p += al256((size_t)2 * 384 * 256 * 2); o.wkvbT = p; p += al256((size_t)2 * 512 * 128 * 2);
  o.w2T = p; p += al256((size_t)2 * 2 * 384 * 64 * 2); o.a2T = p; p += al256((size_t)2 * 2 * 384 * 64 * 2); o.g2T = p; p += al256((size_t)2 * 384 * 192 * 2);
  o.total = p; return o;
}
constexpr WsOff WO = make_wsoff();
#define WS_PTR(T, off) ((T*)(ws + (off)))
#define LAUNDER_S(x) asm volatile("" : "+s"(x))

struct NaiveIn {
  const float *x, *c, *ctx, *c_ctx, *ada_w, *ada_b, *norm_mix_g, *norm_ffn_g, *w_in, *w_out, *mla_q_norm_g, *mla_w_qb, *mla_kv_norm_g,
      *mla_w_kvb, *mla_qk_g, *rw_mu, *rw_w0, *rw_w2, *rw_a0, *rw_a2, *rw_g2, *rw_k_k, *rw_k_a, *rw_r_k, *rw_ln_g, *rw_ln_b, *gqa_qk_g,
      *pe_wq, *pe_keys, *pe_u, *pe_v;
};
struct MegaP { NaiveIn in; char* ws; float* out; };

#ifndef MEGA_CG
#define MEGA_CG 1
#endif
#if MEGA_CG
#define GRID_BARRIER() cg::this_grid().sync()
#else
#define GRID_BARRIER() xcd_barrier(xb)
#endif
#define MEGA_LDS_BYTES 65536
#ifndef PHASE_MASK
#define PHASE_MASK 0xFFFF
#endif
#define PH(k) if (PHASE_MASK & (1 << (k)))

__device__ __forceinline__ void ph_norm_mod(const float* xs, const float* g, const float* modl, int shift_idx, bf16_t* xn) {
  const int tt_ = tid_opaque(); const int lane = tt_ & 63;
  for (long row = blockIdx.x * 4 + (tt_ >> 6); row < NROWS; row += (long)gridDim.x * 4) {
    int b = row / RB, lr = row % RB; int bb = lr < SEQ ? b : BATCH;
    const float* sh = modl + ((long)bb * 6 + shift_idx) * DM; const float* sc = sh + DM;
    const float* xr = xs + row * DM; f32x4 v[4]; float ss = 0.f;
#pragma unroll
    for (int i = 0; i < 4; ++i) { v[i] = *(const f32x4*)(xr + i * 256 + lane * 4); ss += v[i][0]*v[i][0] + v[i][1]*v[i][1] + v[i][2]*v[i][2] + v[i][3]*v[i][3]; }
    ss = wave_sum(ss);
    float inv = 1.f / sqrtf(ss / DM + EPSN);
#pragma unroll
    for (int i = 0; i < 4; ++i) {
      int d = i * 256 + lane * 4; float o[4];
#pragma unroll
      for (int e = 0; e < 4; ++e) o[e] = v[i][e] * inv * g[d+e] * (1.f + sc[d+e]) + sh[d+e];
      uint2 pk; pk.x = pack2bf(o[0], o[1]); pk.y = pack2bf(o[2], o[3]);
      *(uint2*)(xn + row * DM + d) = pk;
    }
  }
}
__device__ __forceinline__ void ph_cvt_wT(const float* W, const float* g, bf16_t* Wt, int K, int N, int Npad, int Kpad) {
  const long n_el = (long)Npad * Kpad;
  const int tt_ = tid_opaque();
  for (long i = (long)blockIdx.x * 256 + tt_; i < n_el; i += (long)gridDim.x * 256) {
    int k = i % Kpad; int n = i / Kpad;
    Wt[i] = (k < K && n < N) ? f2bf(W[(long)k * N + n] * (g ? g[k] : 1.f)) : (bf16_t)0;
  }
}
__device__ __forceinline__ void ph_cvt_bf16(const float* s, bf16_t* d, long n8) {
  const int tt_ = tid_opaque();
  for (long i = (long)blockIdx.x * 256 + tt_; i < n8; i += (long)gridDim.x * 256) {
    f32x4 a = *(const f32x4*)(s + i * 8), b = *(const f32x4*)(s + i * 8 + 4);
    u32x4 o; o[0] = pack2bf(a[0], a[1]); o[1] = pack2bf(a[2], a[3]); o[2] = pack2bf(b[0], b[1]); o[3] = pack2bf(b[2], b[3]);
    *(u32x4*)(d + i * 8) = o;
  }
}

__global__ void __launch_bounds__(256, 2) mega_kernel(MegaP p) {
  __shared__ __attribute__((aligned(16))) char smem[MEGA_LDS_BYTES];
  __shared__ uint4 xb_words;
  const int t0 = threadIdx.x;
#if !MEGA_CG
  if (t0 == 0) xb_words = make_uint4(0u, 0u, 0u, 0u);
  __syncthreads();
  XcdBarrier xb = xcd_barrier_post((unsigned*)p.ws, (volatile LAS unsigned*)&xb_words);
#endif
  const NaiveIn& I = p.in; const long MA = NROWS; const int TM = NROWS / 128;
  PH(0) {
    char* ws = p.ws; LAUNDER_S(ws); const int t = tid_opaque();
    float* xs = WS_PTR(float, WO.xs); float* mod = WS_PTR(float, WO.mod);
    for (long i = (long)blockIdx.x * 256 + t; i < MA * DM / 4; i += (long)gridDim.x * 256) {
      long e = i * 4; int d = e % DM; long row = e / DM; int b = row / RB, lr = row % RB;
      const float* src = lr < SEQ ? I.x + ((long)b * SEQ + lr) * DM + d : I.ctx + ((long)b * CTX_LEN + (lr - SEQ)) * DM + d;
      *(f32x4*)(xs + e) = *(const f32x4*)src;
    }
    for (long i = (long)blockIdx.x * 256 + t; i < 2L * (BATCH + 1) * 6144; i += (long)gridDim.x * 256) {
      int j = i % 6144; int bb = (i / 6144) % (BATCH + 1); int l = i / (6144 * (BATCH + 1));
      const float* cv = bb < BATCH ? I.c + (long)bb * DM : I.c_ctx; const float* wp = I.ada_w + (long)l * DM * 6144 + j;
      float acc = 0.f;
#pragma unroll 4
      for (int k = 0; k < DM; ++k) acc += siluf_(cv[k]) * wp[(long)k * 6144];
      mod[i] = acc + I.ada_b[l * 6144 + j];
    }
    for (int l = 0; l < 2; ++l) {
      ph_cvt_wT(I.w_in + (long)l * DM * IN_COLS, nullptr, WS_PTR(bf16_t, WO.w_inT) + (long)l * 2688 * 1024, 1024, IN_COLS, 2688, 1024);
      ph_cvt_wT(I.w_out + (long)l * DM * DM, nullptr, WS_PTR(bf16_t, WO.w_outT) + (long)l * 1024 * 1024, 1024, 1024, 1024, 1024);
      ph_cvt_wT(I.pe_wq + (long)l * DM * 2048, nullptr, WS_PTR(bf16_t, WO.wqT) + (long)l * 2048 * 1024, 1024, 2048, 2048, 1024);
      ph_cvt_wT(I.mla_w_qb + (long)l * 256 * 384, I.mla_q_norm_g + l * 256, WS_PTR(bf16_t, WO.wqbT) + (long)l * 384 * 256, 256, 384, 384, 256);
      ph_cvt_wT(I.mla_w_kvb + (long)l * 128 * 512, I.mla_kv_norm_g + l * 128, WS_PTR(bf16_t, WO.wkvbT) + (long)l * 512 * 128, 128, 512, 512, 128);
      for (int d = 0; d < 2; ++d) {
        ph_cvt_wT(I.rw_w2 + ((long)l * 2 + d) * 64 * 384, nullptr, WS_PTR(bf16_t, WO.w2T) + ((long)l * 2 + d) * 384 * 64, 64, 384, 384, 64);
        ph_cvt_wT(I.rw_a2 + ((long)l * 2 + d) * 64 * 384, nullptr, WS_PTR(bf16_t, WO.a2T) + ((long)l * 2 + d) * 384 * 64, 64, 384, 384, 64);
      }
      ph_cvt_wT(I.rw_g2 + (long)l * 160 * 384, nullptr, WS_PTR(bf16_t, WO.g2T) + (long)l * 384 * 192, 160, 384, 384, 192);
    }
    ph_cvt_bf16(I.pe_keys, WS_PTR(bf16_t, WO.keysb), 2L * 16 * 128 * 128 / 8);
  }
  GRID_BARRIER();
  for (int lq = 0; lq < 2; ++lq) {
    int l = lq; LAUNDER_S(l);
    PH(1) {
      char* ws = p.ws; LAUNDER_S(ws); const int t = tid_opaque(); (void)t;
      ph_norm_mod(WS_PTR(float, WO.xs), I.norm_mix_g + l * DM, WS_PTR(float, WO.mod) + (long)l * (BATCH + 1) * 6144, 0, WS_PTR(bf16_t, WO.xn));
    }
    GRID_BARRIER();
    PH(2) {
      char* ws = p.ws; LAUNDER_S(ws); const int t = tid_opaque(); (void)t;
      const bf16_t* xn = WS_PTR(bf16_t, WO.xn); const bf16_t* wT = WS_PTR(bf16_t, WO.w_inT) + (long)l * 2688 * 1024; bf16_t* Pb = WS_PTR(bf16_t, WO.Pb);
      for (int tile = blockIdx.x; tile < TM * 21; tile += gridDim.x)
        gemm_tile_128(ALoadPlain{xn, DM}, wT, 1024, 1024, tile / 21, tile % 21, smem, EpiStoreBf16{Pb, IN_COLS, IN_COLS});
    }
    GRID_BARRIER();
    PH(3) {
      char* ws = p.ws; LAUNDER_S(ws); const int t = tid_opaque(); (void)t;
      PrepW pw{WS_PTR(bf16_t, WO.wqbT) + (long)l * 384 * 256, WS_PTR(bf16_t, WO.wkvbT) + (long)l * 512 * 128, WS_PTR(bf16_t, WO.w2T) + (long)l * 2 * 384 * 64,
               WS_PTR(bf16_t, WO.a2T) + (long)l * 2 * 384 * 64, WS_PTR(bf16_t, WO.g2T) + (long)l * 384 * 192, I.rw_mu + (long)l * 2 * RWC, I.rw_w0 + l * 768, I.rw_a0 + l * 768};
      PrepBuf pb{WS_PTR(bf16_t, WO.Pb), WS_PTR(bf16_t, WO.tq), WS_PTR(bf16_t, WO.tkv), WS_PTR(bf16_t, WO.a_b), WS_PTR(bf16_t, WO.g_b), WS_PTR(float, WO.w_f)};
      for (int tile = blockIdx.x; tile < TM * 22; tile += gridDim.x) prep_gemm_tile(pw, pb, tile / 22, tile % 22, smem);
    }
    GRID_BARRIER();
    PH(4) {
      char* ws = p.ws; LAUNDER_S(ws); const int t = tid_opaque(); (void)t;
      FinW fw{I.mla_qk_g + l * 192, I.gqa_qk_g + l * 128, I.rw_mu + (long)l * 2 * RWC, I.rw_k_k + l * 384, I.rw_k_a + l * 384};
      FinBuf fb{WS_PTR(bf16_t, WO.Pb), WS_PTR(bf16_t, WO.tq), WS_PTR(bf16_t, WO.tkv), WS_PTR(bf16_t, WO.a_b), WS_PTR(bf16_t, WO.mq), WS_PTR(bf16_t, WO.mk), WS_PTR(bf16_t, WO.mvT),
                WS_PTR(bf16_t, WO.gq), WS_PTR(bf16_t, WO.gk), WS_PTR(bf16_t, WO.gvT), WS_PTR(bf16_t, WO.r_b), WS_PTR(bf16_t, WO.v_b), WS_PTR(bf16_t, WO.kk_b), WS_PTR(bf16_t, WO.kd_b), WS_PTR(bf16_t, WO.bd_b)};
      for (int tile = blockIdx.x; tile < NROWS / 64; tile += gridDim.x) prep_finish_tile(fw, fb, tile, smem);
    }
    GRID_BARRIER();
    PH(5) {
      char* ws = p.ws; LAUNDER_S(ws); const int t = tid_opaque(); (void)t;
      if (blockIdx.x < BATCH * 24) {
        rw_scan_block(WS_PTR(bf16_t, WO.r_b), WS_PTR(bf16_t, WO.v_b), WS_PTR(bf16_t, WO.kk_b), WS_PTR(bf16_t, WO.kd_b), WS_PTR(bf16_t, WO.bd_b), WS_PTR(float, WO.w_f), WS_PTR(float, WO.Pb),
                      blockIdx.x, (long)MA * 384, smem);
        __syncthreads();
      }
      const int nqt = l == 0 ? 18 : 16; const int n_mla = BATCH * 4 * nqt, n_all = BATCH * 10 * nqt;
      unsigned* qctr = (unsigned*)ws + XB_QUEUE(l);
      int* s_item = (int*)(smem + MEGA_LDS_BYTES - 16);
      for (;;) {
        __syncthreads();
        if (t == 0) *s_item = (int)xb_add(qctr, 1u);
        __syncthreads();
        const int it = *s_item;
        if (it >= n_all) break;
        char* ws2 = p.ws; LAUNDER_S(ws2);
        if (it < n_mla) { int qt = it / (BATCH * 4), r = it % (BATCH * 4);
          attn_block<96>((const bf16_t*)(ws2 + WO.mq), 4, (const bf16_t*)(ws2 + WO.mk), 4, (const bf16_t*)(ws2 + WO.mvT), 1, (bf16_t*)(ws2 + WO.tq), 0, r / 4, r % 4, qt, smem); }
        else { int v = it - n_mla; int qt = v / (BATCH * 6), r = v % (BATCH * 6);
          attn_block<64>((const bf16_t*)(ws2 + WO.gq), 6, (const bf16_t*)(ws2 + WO.gk), 2, (const bf16_t*)(ws2 + WO.gvT), 3, (bf16_t*)(ws2 + WO.tq), 640, r / 6, r % 6, qt, smem); }
      }
    }
    GRID_BARRIER();
    PH(6) {
      char* ws = p.ws; LAUNDER_S(ws); const int t = tid_opaque(); (void)t;
      RdW rw{I.rw_r_k + l * 384, I.rw_ln_g + l * 384, I.rw_ln_b + l * 384};
      for (long row = blockIdx.x * 4 + (t >> 6); row < NROWS; row += (long)gridDim.x * 4)
        rw_readout_row(rw, WS_PTR(float, WO.Pb), WS_PTR(bf16_t, WO.r_b), WS_PTR(bf16_t, WO.v_b), WS_PTR(bf16_t, WO.kd_b), WS_PTR(bf16_t, WO.g_b), WS_PTR(bf16_t, WO.tq), row, t & 63);
    }
    GRID_BARRIER();
    PH(7) {
      char* ws = p.ws; LAUNDER_S(ws); const int t = tid_opaque(); (void)t;
      const bf16_t* mix = WS_PTR(bf16_t, WO.tq); const bf16_t* wT = WS_PTR(bf16_t, WO.w_outT) + (long)l * 1024 * 1024; float* xs = WS_PTR(float, WO.xs);
      const float* modl = WS_PTR(float, WO.mod) + (long)l * (BATCH + 1) * 6144;
      for (int tile = blockIdx.x; tile < TM * 8; tile += gridDim.x)
        gemm_tile_128(ALoadPlain{mix, DM}, wT, 1024, 1024, tile / 8, tile % 8, smem, EpiResid{xs, modl, 2, 0});
    }
    GRID_BARRIER();
    PH(8) {
      char* ws = p.ws; LAUNDER_S(ws); const int t = tid_opaque(); (void)t;
      ph_norm_mod(WS_PTR(float, WO.xs), I.norm_ffn_g + l * DM, WS_PTR(float, WO.mod) + (long)l * (BATCH + 1) * 6144, 3, WS_PTR(bf16_t, WO.xn));
      ph_cvt_bf16(I.pe_u + (long)l * 16384 * DM, WS_PTR(bf16_t, WO.Pb), 16384L * DM / 8);
      ph_cvt_bf16(I.pe_v + (long)l * 16384 * DM, WS_PTR(bf16_t, WO.Pb) + 16384L * DM, 16384L * DM / 8);
    }
    GRID_BARRIER();
    PH(9) {
      char* ws = p.ws; LAUNDER_S(ws); const int t = tid_opaque(); (void)t;
      const bf16_t* xn = WS_PTR(bf16_t, WO.xn); const bf16_t* wT = WS_PTR(bf16_t, WO.wqT) + (long)l * 2048 * 1024; const bf16_t* kb = WS_PTR(bf16_t, WO.keysb) + (long)l * 16 * 128 * 128;
      unsigned* top1 = WS_PTR(unsigned, WO.tq);
      for (int tile = blockIdx.x; tile < TM * 16; tile += gridDim.x) { peer_q_top1_tile(xn, wT, kb, top1, tile / 16, tile % 16, smem); __syncthreads(); }
    }
    GRID_BARRIER();
    PH(10) {
      char* ws = p.ws; LAUNDER_S(ws); const int t = tid_opaque(); (void)t;
      const float* modl = WS_PTR(float, WO.mod) + (long)l * (BATCH + 1) * 6144;
      for (int g = blockIdx.x; g < NROWS / 32; g += gridDim.x) {
        peer_gather_group(WS_PTR(bf16_t, WO.xn), WS_PTR(unsigned, WO.tq), WS_PTR(bf16_t, WO.Pb), WS_PTR(bf16_t, WO.Pb) + 16384L * DM, modl, WS_PTR(float, WO.xs), g, smem);
        __syncthreads();
      }
    }
    GRID_BARRIER();
  }
  {
    char* ws = p.ws; LAUNDER_S(ws); const int t = tid_opaque(); const float* xs = WS_PTR(float, WO.xs);
    for (long i = (long)blockIdx.x * 256 + t; i < (long)BATCH * SEQ * DM / 4; i += (long)gridDim.x * 256) {
      long e = i * 4; int d = e % DM; long row = e / DM; int b = row / SEQ, tt = row % SEQ;
      *(f32x4*)(p.out + e) = *(const f32x4*)(xs + ((long)b * RB + tt) * DM + d);
    }
  }
}

extern "C" void kernel_launch(void* const* d_in, const int* in_sizes, int n_in, void* d_out, int out_size, void* d_ws, size_t ws_size,
                              hipStream_t stream) {
  MegaP p{};
  const float** pp = (const float**)&p.in;
  for (int i = 0; i < 31; ++i) pp[i] = (const float*)d_in[i];
  p.ws = (char*)d_ws; p.out = (float*)d_out;
  if (WO.total > ws_size) return;
  static int grid_blocks = 0;
  if (!grid_blocks) {
    int dev = 0, cus = 0, per_cu = 0;
    hipGetDevice(&dev);
    hipDeviceGetAttribute(&cus, hipDeviceAttributeMultiprocessorCount, dev);
    hipOccupancyMaxActiveBlocksPerMultiprocessor(&per_cu, mega_kernel, 256, 0);
    if (per_cu > 2) per_cu = 2;
    if (per_cu < 1) per_cu = 1;
    grid_blocks = cus * per_cu;
  }
  hipMemsetAsync(d_ws, 0, 16384, stream);
  void* args[] = {&p};
  hipLaunchCooperativeKernel((void*)mega_kernel, dim3(grid_blocks), dim3(256), args, 0, stream);
}
```

```cpp
#include <hip/hip_runtime.h>
#ifndef BATCH
#define BATCH 8
#endif
#ifndef SEQ
#define SEQ 2048
#endif
#ifndef CTX_LEN
#define CTX_LEN 256
#endif
#define DM 1024
#define RB (SEQ + CTX_LEN)
#define NROWS (BATCH * RB)
#define IN_COLS 2624
#define MLA_OFF 0
#define RW_OFF 416
#define GQA_OFF 1984
#define RWC 1568
#define EPSN 1e-6f

__device__ inline float sigmoidf_(float x) { return 1.f / (1.f + expf(-x)); }
__device__ inline float siluf_(float x) { return x * sigmoidf_(x); }
__device__ inline float softplusf_(float x) { return fmaxf(x, 0.f) + log1pf(expf(-fabsf(x))); }
__device__ inline float geluf_(float x) { return 0.5f * x * (1.f + tanhf(0.7978845608028654f * (x + 0.044715f * x * x * x))); }

__global__ void nk_copy_in(const float* x, const float* ctx, float* xs) {
  long i = (long)blockIdx.x * blockDim.x + threadIdx.x;
  if (i >= (long)NROWS * DM) return;
  int d = i % DM; long row = i / DM; int b = row / RB, lr = row % RB;
  xs[i] = lr < SEQ ? x[((long)b * SEQ + lr) * DM + d] : ctx[((long)b * CTX_LEN + (lr - SEQ)) * DM + d];
}
__global__ void nk_copy_out(const float* xs, float* out) {
  long i = (long)blockIdx.x * blockDim.x + threadIdx.x;
  if (i >= (long)BATCH * SEQ * DM) return;
  int d = i % DM; long row = i / DM; int b = row / SEQ, t = row % SEQ;
  out[i] = xs[((long)b * RB + t) * DM + d];
}
__global__ void nk_mod(const float* c, const float* c_ctx, const float* ada_w, const float* ada_b, float* mod) {
  long i = (long)blockIdx.x * blockDim.x + threadIdx.x;
  if (i >= 2L * (BATCH + 1) * 6144) return;
  int j = i % 6144; int bb = (i / 6144) % (BATCH + 1); int l = i / (6144 * (BATCH + 1));
  const float* cv = bb < BATCH ? c + (long)bb * DM : c_ctx;
  const float* w = ada_w + (long)l * DM * 6144;
  float acc = 0.f;
  for (int k = 0; k < DM; ++k) acc += siluf_(cv[k]) * w[(long)k * 6144 + j];
  mod[i] = acc + ada_b[l * 6144 + j];
}
__global__ void nk_norm_mod(const float* xs, const float* g, const float* modl, int shift_idx, float* xn, int M, int bidx) {
  long row = (long)blockIdx.x * blockDim.x + threadIdx.x;
  if (row >= M) return;
  int lr = row % RB; int bb = lr < SEQ ? bidx : BATCH;
  const float* sh = modl + ((long)bb * 6 + shift_idx) * DM; const float* sc = sh + DM;
  const float* xr = xs + row * DM; float ss = 0.f;
  for (int d = 0; d < DM; ++d) ss += xr[d] * xr[d];
  float inv = 1.f / sqrtf(ss / DM + EPSN);
  for (int d = 0; d < DM; ++d) xn[row * DM + d] = xr[d] * inv * g[d] * (1.f + sc[d]) + sh[d];
}
__global__ void nk_gemm(const float* A, const float* W, float* C, int M, int N, int K) {
  long i = (long)blockIdx.x * blockDim.x + threadIdx.x;
  if (i >= (long)M * N) return;
  int n = i % N; long m = i / N; float acc = 0.f;
  for (int k = 0; k < K; ++k) acc += A[m * K + k] * W[(long)k * N + n];
  C[i] = acc;
}
__global__ void nk_mla_q1(const float* P, const float* qng, const float* wqb, float* tq, int M) {
  long i = (long)blockIdx.x * blockDim.x + threadIdx.x;
  if (i >= (long)M * 384) return;
  int j = i % 384; long r = i / 384; const float* cq = P + r * IN_COLS;
  float ss = 0.f; for (int k = 0; k < 256; ++k) ss += cq[k] * cq[k];
  float inv = 1.f / sqrtf(ss / 256 + EPSN), acc = 0.f;
  for (int k = 0; k < 256; ++k) acc += cq[k] * inv * qng[k] * wqb[k * 384 + j];
  tq[i] = acc;
}
__global__ void nk_mla_kv1(const float* P, const float* kvng, const float* wkvb, float* tkv, int M) {
  long i = (long)blockIdx.x * blockDim.x + threadIdx.x;
  if (i >= (long)M * 512) return;
  int j = i % 512; long r = i / 512; const float* ck = P + r * IN_COLS + 256;
  float ss = 0.f; for (int k = 0; k < 128; ++k) ss += ck[k] * ck[k];
  float inv = 1.f / sqrtf(ss / 128 + EPSN), acc = 0.f;
  for (int k = 0; k < 128; ++k) acc += ck[k] * inv * kvng[k] * wkvb[k * 512 + j];
  tkv[i] = acc;
}
__global__ void nk_mla_qk2(const float* P, const float* tq, const float* tkv, const float* qkg, float* mq, float* mk, int M) {
  long i = (long)blockIdx.x * blockDim.x + threadIdx.x;
  if (i >= (long)M * 8) return;
  int which = i % 2, h = (i / 2) % 4; long r = i / 8; int lr = r % RB;
  float ss = 0.f;
  for (int e = 0; e < 96; ++e) {
    float v = which == 0 ? tq[r * 384 + h * 96 + e] : (e < 64 ? tkv[r * 512 + h * 128 + e] : P[r * IN_COLS + 384 + (e - 64)]);
    ss += v * v;
  }
  float inv = 1.f / sqrtf(ss / 96 + EPSN);
  const float* g = qkg + which * 96; float* o = (which == 0 ? mq : mk) + r * 384 + h * 96;
  for (int e = 0; e < 64; ++e) {
    float v = which == 0 ? tq[r * 384 + h * 96 + e] : tkv[r * 512 + h * 128 + e];
    o[e] = v * inv * g[e];
  }
  for (int j = 0; j < 16; ++j) {
    float va = which == 0 ? tq[r * 384 + h * 96 + 64 + j] : P[r * IN_COLS + 384 + j];
    float vb = which == 0 ? tq[r * 384 + h * 96 + 80 + j] : P[r * IN_COLS + 384 + 16 + j];
    va *= inv * g[64 + j]; vb *= inv * g[80 + j];
    if (lr < SEQ) {
      int pos = j < 8 ? lr / 64 : lr % 64; float fr = powf(10000.f, -(float)(j & 7) / 8.f);
      float ang = (float)pos * fr, cs = cosf(ang), sn = sinf(ang);
      o[64 + j] = va * cs - vb * sn; o[80 + j] = va * sn + vb * cs;
    } else { o[64 + j] = va; o[80 + j] = vb; }
  }
}
__global__ void nk_gqa_prep(const float* P, const float* qkg, float* gq, float* gk, int M) {
  long i = (long)blockIdx.x * blockDim.x + threadIdx.x;
  if (i >= (long)M * 8) return;
  int h = i % 8; long r = i / 8; int lr = r % RB;
  const float* src = P + r * IN_COLS + GQA_OFF + h * 64;
  const float* g = qkg + (h < 6 ? 0 : 64);
  float* o = h < 6 ? gq + r * 384 + h * 64 : gk + r * 128 + (h - 6) * 64;
  float ss = 0.f; for (int e = 0; e < 64; ++e) ss += src[e] * src[e];
  float inv = 1.f / sqrtf(ss / 64 + EPSN);
  for (int j = 0; j < 32; ++j) {
    float va = src[j] * inv * g[j], vb = src[32 + j] * inv * g[32 + j];
    if (lr < SEQ) {
      int pos = j < 16 ? lr / 64 : lr % 64; float fr = powf(10000.f, -(float)(j & 15) / 16.f);
      float ang = (float)pos * fr, cs = cosf(ang), sn = sinf(ang);
      o[j] = va * cs - vb * sn; o[32 + j] = va * sn + vb * cs;
    } else { o[j] = va; o[32 + j] = vb; }
  }
}
template <int DQ>
__global__ void __launch_bounds__(256) nk_attn(const float* q, int qs, const float* k, int ks, const float* v, int vs, int vhs, int H, int G, float* mix, int ooff, int M) {
  long i = (long)blockIdx.x * blockDim.x + threadIdx.x;
  if (i >= (long)M * H) return;
  int h = i % H; long r = i / H; int b = r / RB, lr = r % RB; int kh = h / G;
  float qv[DQ];
#pragma unroll
  for (int e = 0; e < DQ; ++e) qv[e] = q[r * qs + h * DQ + e];
  float acc[64];
#pragma unroll
  for (int e = 0; e < 64; ++e) acc[e] = 0.f;
  float mx = -1e30f, l = 0.f; const float scale = 1.f / sqrtf((float)DQ);
  int k0 = lr < SEQ ? 0 : SEQ, k1 = RB;
  for (int kr = k0; kr < k1; ++kr) {
    long rr = (long)b * RB + kr; const float* kp = k + rr * ks + kh * DQ; float s = 0.f;
#pragma unroll
    for (int e = 0; e < DQ; ++e) s += qv[e] * kp[e];
    s *= scale;
    float mn = fmaxf(mx, s), al = expf(mx - mn), pp = expf(s - mn);
    l = l * al + pp; mx = mn; const float* vp = v + rr * vs + kh * vhs;
#pragma unroll
    for (int e = 0; e < 64; ++e) acc[e] = acc[e] * al + pp * vp[e];
  }
#pragma unroll
  for (int e = 0; e < 64; ++e) mix[r * DM + ooff + h * 64 + e] = acc[e] / l;
}
__global__ void nk_rw_shift(const float* P, const float* mu, float* rwx, int M) {
  long i = (long)blockIdx.x * blockDim.x + threadIdx.x;
  if (i >= (long)M * RWC) return;
  int c = i % RWC; long r = i / RWC; int lr = r % RB;
  bool first = (lr == 0) || (lr == SEQ), last = (lr == SEQ - 1) || (lr == RB - 1);
  float p = P[r * IN_COLS + RW_OFF + c];
  float pv = first ? 0.f : P[(r - 1) * IN_COLS + RW_OFF + c], nx = last ? 0.f : P[(r + 1) * IN_COLS + RW_OFF + c];
  rwx[i] = p + mu[c] * (pv - p) + mu[RWC + c] * (nx - p);
}
__global__ void nk_rw_prep(const float* rwx, const float* w0, const float* w2, const float* a0, const float* a2, const float* g2,
                           const float* k_k, const float* k_a, float* dec, float* kd, float* bd, float* kk, float* gg, int M) {
  long i = (long)blockIdx.x * blockDim.x + threadIdx.x;
  if (i >= (long)M * 384) return;
  int c = i % 384; long r = i / 384; int h = c / 64; const float* xr = rwx + r * RWC;
  float kv = xr[384 + c];
  float ss = 0.f; for (int n = 0; n < 64; ++n) { float t = xr[384 + h * 64 + n] * k_k[h * 64 + n]; ss += t * t; }
  float kkv = kv * k_k[c] / sqrtf(ss + 1e-12f);
  kk[i] = kkv;
  for (int d = 0; d < 2; ++d) {
    float wr = w0[d * 384 + c], ar = a0[d * 384 + c];
    for (int j = 0; j < 64; ++j) { wr += tanhf(xr[1152 + d * 64 + j]) * w2[(d * 64 + j) * 384 + c]; ar += xr[1280 + d * 64 + j] * a2[(d * 64 + j) * 384 + c]; }
    float dc = expf(-expf(-softplusf_(-wr) - 0.5f)); float a = sigmoidf_(ar);
    dec[(long)d * M * 384 + i] = dc; kd[(long)d * M * 384 + i] = kv * (1.f + (a - 1.f) * k_a[c]); bd[(long)d * M * 384 + i] = kkv * a;
  }
  float g = 0.f; for (int j = 0; j < 160; ++j) g += sigmoidf_(xr[1408 + j]) * g2[j * 384 + c];
  gg[i] = g;
}
__global__ void __launch_bounds__(256) nk_rw_scan(const float* rwx, const float* dec, const float* kd, const float* bd, const float* kk, float* y, int M, int nb) {
  long t = (long)blockIdx.x * blockDim.x + threadIdx.x;
  if (t >= (long)nb * 2 * 6 * 64) return;
  int i = t % 64, h = (t / 64) % 6, d = (t / 384) % 2, b = t / 768;
  float S[64];
#pragma unroll
  for (int j = 0; j < 64; ++j) S[j] = 0.f;
  for (int step = 0; step < RB; ++step) {
    int lr;
    if (step < CTX_LEN) lr = SEQ + (d == 0 ? step : CTX_LEN - 1 - step);
    else lr = d == 0 ? step - CTX_LEN : SEQ - 1 - (step - CTX_LEN);
    long r = (long)b * RB + lr; long o = (long)d * M * 384 + r * 384 + h * 64;
    const float* rp = rwx + r * RWC + h * 64; const float* wp = dec + o; const float* kp = kd + o; const float* bp = bd + o; const float* kkp = kk + r * 384 + h * 64;
    float vi = rwx[r * RWC + 768 + h * 64 + i];
    float skk = 0.f;
#pragma unroll
    for (int j = 0; j < 64; ++j) skk += S[j] * kkp[j];
    float yy = 0.f;
#pragma unroll
    for (int j = 0; j < 64; ++j) { S[j] = S[j] * wp[j] - skk * bp[j] + vi * kp[j]; yy += S[j] * rp[j]; }
    y[o + i] = yy;
  }
}
__global__ void nk_rw_readout(const float* rwx, const float* y, const float* kd, const float* gg, const float* r_k, const float* ln_g, const float* ln_b, float* mix, int M, long yds) {
  long i = (long)blockIdx.x * blockDim.x + threadIdx.x;
  if (i >= (long)M * 6) return;
  int h = i % 6; long r = i / 6; long o = r * 384 + h * 64; long ds = (long)M * 384;
  float mean = 0.f; for (int n = 0; n < 64; ++n) mean += y[o + n] + y[yds + o + n];
  mean /= 64.f;
  float var = 0.f, coef = 0.f;
  for (int n = 0; n < 64; ++n) {
    float yy = y[o + n] + y[yds + o + n] - mean; var += yy * yy;
    coef += rwx[r * RWC + h * 64 + n] * (kd[o + n] + kd[ds + o + n]) * r_k[h * 64 + n];
  }
  var /= 64.f; float inv = 1.f / sqrtf(var + 64e-5f);
  for (int n = 0; n < 64; ++n) {
    float yn = (y[o + n] + y[yds + o + n] - mean) * inv * ln_g[h * 64 + n] + ln_b[h * 64 + n];
    mix[r * DM + 256 + h * 64 + n] = (yn + coef * rwx[r * RWC + 768 + h * 64 + n]) * gg[o + n];
  }
}
__global__ void nk_gemm_res(const float* A, const float* W, const float* modl, int gi, float* xs, int M, int bidx) {
  long i = (long)blockIdx.x * blockDim.x + threadIdx.x;
  if (i >= (long)M * DM) return;
  int j = i % DM; long r = i / DM; int lr = r % RB; int bb = lr < SEQ ? bidx : BATCH;
  float acc = 0.f; for (int k = 0; k < DM; ++k) acc += A[r * DM + k] * W[(long)k * DM + j];
  xs[i] += modl[((long)bb * 6 + gi) * DM + j] * acc;
}
__global__ void nk_peer_score(const float* pq, const float* keys, float* sc, int M) {
  long i = (long)blockIdx.x * blockDim.x + threadIdx.x;
  if (i >= (long)M * 2048) return;
  int k = i % 128, ps = (i / 128) % 16; long r = i / 2048;
  const float* q = pq + r * 2048 + ps * 128; const float* ky = keys + ((long)ps * 128 + k) * 128;
  float acc = 0.f; for (int d = 0; d < 128; ++d) acc += q[d] * ky[d];
  sc[i] = acc;
}
__global__ void nk_peer_top1(const float* sc, float* ts, int* ti, int M) {
  long i = (long)blockIdx.x * blockDim.x + threadIdx.x;
  if (i >= (long)M * 16) return;
  const float* s = sc + i * 128; float pv = 3e38f; int pi = -1;
  for (int t = 0; t < 16; ++t) {
    float bv = -3e38f; int bi = -1;
    for (int k = 0; k < 128; ++k) {
      float v = s[k]; bool ok = (v < pv) || (v == pv && k > pi);
      if (ok && (bi < 0 || v > bv)) { bv = v; bi = k; }
    }
    ts[i * 16 + t] = bv; ti[i * 16 + t] = bi; pv = bv; pi = bi;
  }
}
__global__ void nk_peer_top2(const float* ts, const int* ti, int* pe, float* pg, int M) {
  long i = (long)blockIdx.x * blockDim.x + threadIdx.x;
  if (i >= (long)M * 8) return;
  const float* s1 = ts + i * 32; const float* s2 = s1 + 16; const int* i1 = ti + i * 32; const int* i2 = i1 + 16;
  float pv = 3e38f; int pi = -1; float mx = 0.f, sum = 0.f;
  for (int t = 0; t < 16; ++t) {
    float bv = -3e38f; int bi = -1;
    for (int c = 0; c < 256; ++c) {
      float v = s1[c / 16] + s2[c % 16]; bool ok = (v < pv) || (v == pv && c > pi);
      if (ok && (bi < 0 || v > bv)) { bv = v; bi = c; }
    }
    if (t == 0) mx = bv;
    float e = expf(bv - mx); sum += e;
    pe[i * 16 + t] = i1[bi / 16] * 128 + i2[bi % 16]; pg[i * 16 + t] = e; pv = bv; pi = bi;
  }
  for (int t = 0; t < 16; ++t) pg[i * 16 + t] /= sum;
}
__global__ void nk_peer_act(const float* xn, const float* u, const int* pe, const float* pg, float* pw, int M) {
  long i = (long)blockIdx.x * blockDim.x + threadIdx.x;
  if (i >= (long)M * 128) return;
  long r = i / 128; const float* ur = u + (long)pe[i] * DM; const float* xr = xn + r * DM;
  float acc = 0.f; for (int d = 0; d < DM; ++d) acc += xr[d] * ur[d];
  pw[i] = pg[i] * geluf_(acc);
}
__global__ void nk_peer_out(const float* v, const int* pe, const float* pw, const float* modl, float* xs, int M, int bidx) {
  long i = (long)blockIdx.x * blockDim.x + threadIdx.x;
  if (i >= (long)M * DM) return;
  int j = i % DM; long r = i / DM; int lr = r % RB; int bb = lr < SEQ ? bidx : BATCH;
  float acc = 0.f; for (int k = 0; k < 128; ++k) acc += pw[r * 128 + k] * v[(long)pe[r * 128 + k] * DM + j];
  xs[i] += modl[((long)bb * 6 + 5) * DM + j] * acc;
}


__device__ __forceinline__ unsigned f2sortable(float s) { unsigned f = __float_as_uint(s); return (f & 0x80000000u) ? ~f : (f | 0x80000000u); }
__device__ __forceinline__ float sortable2f(unsigned o) { unsigned f = (o & 0x80000000u) ? (o & 0x7fffffffu) : ~o; return __uint_as_float(f); }
__device__ __forceinline__ unsigned enc_key(float s, int idx) { return (f2sortable(s) & ~127u) | (unsigned)(127 - idx); }
__device__ __forceinline__ void dec_key(unsigned k, float& s, int& idx) { idx = 127 - (int)(k & 127u); s = sortable2f(k & ~127u); }
__device__ __forceinline__ unsigned umax_(unsigned a, unsigned b) { return a > b ? a : b; }
__device__ __forceinline__ unsigned umin_(unsigned a, unsigned b) { return a < b ? a : b; }
__device__ __forceinline__ void ins16(unsigned (&l)[16], unsigned x) {
#pragma unroll
  for (int i = 0; i < 16; ++i) { unsigned mx = umax_(l[i], x); x = umin_(l[i], x); l[i] = mx; }
}
__device__ __forceinline__ void merge16(unsigned (&a)[16], const unsigned (&brev)[16]) {
#pragma unroll
  for (int i = 0; i < 16; ++i) a[i] = umax_(a[i], brev[i]);
#pragma unroll
  for (int d = 8; d >= 1; d >>= 1)
#pragma unroll
    for (int i = 0; i < 16; ++i) if ((i & d) == 0) { unsigned hi = umax_(a[i], a[i + d]), lo = umin_(a[i], a[i + d]); a[i] = hi; a[i + d] = lo; }
}
__device__ __forceinline__ void peer_combine(const unsigned* L0, const unsigned* L1, int* e_out, float* g_out) {
  float s0[16], s1[16];
#pragma unroll
  for (int i = 0; i < 16; ++i) { int ix; dec_key(L0[i], s0[i], ix); dec_key(L1[i], s1[i], ix); }
  unsigned sel[16];
#pragma unroll
  for (int i = 0; i < 16; ++i) sel[i] = 0u;
#pragma unroll
  for (int i = 0; i < 16; ++i)
#pragma unroll
    for (int j = 0; j < 16; ++j)
      if ((i + 1) * (j + 1) <= 16) { unsigned k = (f2sortable(s0[i] + s1[j]) & ~255u) | (unsigned)(255 - (i * 16 + j)); ins16(sel, k); }
  float mx = -3e38f;
#pragma unroll
  for (int t = 0; t < 16; ++t) {
    int c = 255 - (int)(sel[t] & 255u); int i = c >> 4, j = c & 15;
    float a, b; int ia, ib; dec_key(L0[i], a, ia); dec_key(L1[j], b, ib);
    float s = a + b; e_out[t] = ia * 128 + ib; g_out[t] = s; mx = fmaxf(mx, s);
  }
  float sum = 0.f;
#pragma unroll
  for (int t = 0; t < 16; ++t) { float e = expf(g_out[t] - mx); g_out[t] = e; sum += e; }
  float inv = 1.f / sum;
#pragma unroll
  for (int t = 0; t < 16; ++t) g_out[t] *= inv;
}
__global__ void hk_peer_top1(const float* pq, const float* keys, unsigned* top1, int M) {
  long i = (long)blockIdx.x * blockDim.x + threadIdx.x;
  if (i >= (long)M * 16) return;
  int ps = i % 16; long r = i / 16; const float* q = pq + r * 2048 + ps * 128;
  unsigned la[16], lb[16], lbr[16];
#pragma unroll
  for (int t = 0; t < 16; ++t) { la[t] = 0u; lb[t] = 0u; }
  for (int k = 0; k < 128; ++k) {
    const float* ky = keys + ((long)ps * 128 + k) * 128; float acc = 0.f;
    for (int d = 0; d < 128; ++d) acc += q[d] * ky[d];
    unsigned key = enc_key(acc, k);
    if (k < 64) ins16(la, key); else ins16(lb, key);
  }
#pragma unroll
  for (int t = 0; t < 16; ++t) lbr[t] = lb[15 - t];
  merge16(la, lbr);
#pragma unroll
  for (int t = 0; t < 16; ++t) top1[i * 16 + t] = la[t];
}
__global__ void hk_peer_combine(const unsigned* top1, int* pe, float* pg, int M) {
  long i = (long)blockIdx.x * blockDim.x + threadIdx.x;
  if (i >= (long)M * 8) return;
  peer_combine(top1 + i * 32, top1 + i * 32 + 16, pe + i * 16, pg + i * 16);
}
typedef unsigned short bf16_t;
__device__ __forceinline__ int tid_opaque() { int t = threadIdx.x; asm volatile("" : "+v"(t)); return t; }
typedef __attribute__((ext_vector_type(8))) short bf16x8;
typedef __attribute__((ext_vector_type(4))) float f32x4;
typedef __attribute__((ext_vector_type(16))) float f32x16;
typedef __attribute__((ext_vector_type(4))) unsigned u32x4;

__device__ __forceinline__ bf16_t f2bf(float f) {
  unsigned u = __float_as_uint(f); u += 0x7fffu + ((u >> 16) & 1u); return (bf16_t)(u >> 16);
}
__device__ __forceinline__ float bf2f(bf16_t h) { return __uint_as_float(((unsigned)h) << 16); }
__device__ __forceinline__ unsigned pack2bf(float a, float b) { return (unsigned)f2bf(a) | ((unsigned)f2bf(b) << 16); }

#define GEMM_LDS_BYTES 32768
struct ALoadPlain { const bf16_t* A; int lda;
  __device__ __forceinline__ u32x4 operator()(int row, int k) const { return *(const u32x4*)(A + (long)row * lda + k); } };
template <class ALoad, class Epi>
__device__ __forceinline__ void gemm_tile_128(ALoad aload, const bf16_t* __restrict__ Bt, int ldb, int K,
                                              int tile_m, int tile_n, char* smem, Epi epi) {
  const int t = tid_opaque(), lane = t & 63, wave = t >> 6;
  const int wm = wave >> 1, wn = wave & 1;
  char* As = smem; char* Bs = smem + 16384;
  const int lrow = t >> 3, lchunk = t & 7;
  const int arow = tile_m * 128 + lrow;
  const bf16_t* bg = Bt + (long)(tile_n * 128 + lrow) * ldb + lchunk * 8;
  u32x4 ra[4], rb[4];
#pragma unroll
  for (int i = 0; i < 4; ++i) {
    ra[i] = aload(arow + 32 * i, lchunk * 8);
    rb[i] = *(const u32x4*)(bg + (long)(32 * i) * ldb);
  }
  f32x4 acc[4][4];
#pragma unroll
  for (int i = 0; i < 4; ++i)
#pragma unroll
    for (int j = 0; j < 4; ++j) acc[i][j] = (f32x4){0.f, 0.f, 0.f, 0.f};
  const int fr = lane & 15, fq = lane >> 4;
  for (int k0 = 0; k0 < K; k0 += 64) {
    __syncthreads();
#pragma unroll
    for (int i = 0; i < 4; ++i) {
      int r = lrow + 32 * i; int off = r * 128 + ((lchunk ^ (r & 7)) << 4);
      *(u32x4*)(As + off) = ra[i]; *(u32x4*)(Bs + off) = rb[i];
    }
    __syncthreads();
    if (k0 + 64 < K) {
#pragma unroll
      for (int i = 0; i < 4; ++i) {
        ra[i] = aload(arow + 32 * i, k0 + 64 + lchunk * 8);
        rb[i] = *(const u32x4*)(bg + (long)(32 * i) * ldb + k0 + 64);
      }
    }
#pragma unroll
    for (int ks = 0; ks < 2; ++ks) {
      bf16x8 af[4], bfr[4];
#pragma unroll
      for (int i = 0; i < 4; ++i) {
        int r = wm * 64 + i * 16 + fr; af[i] = *(const bf16x8*)(As + r * 128 + (((ks * 4 + fq) ^ (r & 7)) << 4));
        int rn = wn * 64 + i * 16 + fr; bfr[i] = *(const bf16x8*)(Bs + rn * 128 + (((ks * 4 + fq) ^ (rn & 7)) << 4));
      }
#pragma unroll
      for (int i = 0; i < 4; ++i)
#pragma unroll
        for (int j = 0; j < 4; ++j) acc[i][j] = __builtin_amdgcn_mfma_f32_16x16x32_bf16(bfr[j], af[i], acc[i][j], 0, 0, 0);
    }
  }
#pragma unroll
  for (int i = 0; i < 4; ++i)
#pragma unroll
    for (int j = 0; j < 4; ++j) {
      int m = tile_m * 128 + wm * 64 + i * 16 + fr; int n0 = tile_n * 128 + wn * 64 + j * 16 + fq * 4;
      epi(m, n0, acc[i][j]);
    }
}

__global__ void ok_cvt_wT(const float* W, bf16_t* Wt, int K, int N, int Npad) {
  long i = (long)blockIdx.x * blockDim.x + threadIdx.x;
  if (i >= (long)Npad * K) return;
  int k = i % K; int n = i / K;
  Wt[i] = n < N ? f2bf(W[(long)k * N + n]) : (bf16_t)0;
}
__global__ void ok_f32_to_bf16(const float* s, bf16_t* d, long n) {
  long i = (long)blockIdx.x * blockDim.x + threadIdx.x; if (i < n) d[i] = f2bf(s[i]);
}
__global__ void ok_bf16_to_f32(const bf16_t* s, float* d, long n) {
  long i = (long)blockIdx.x * blockDim.x + threadIdx.x; if (i < n) d[i] = bf2f(s[i]);
}
__global__ void ok_norm_mod_bf16(const float* xs, const float* g, const float* modl, int shift_idx, bf16_t* xn, int M) {
  int row = blockIdx.x * 4 + (threadIdx.x >> 6); int lane = threadIdx.x & 63;
  if (row >= M) return;
  int b = row / RB, lr = row % RB; int bb = lr < SEQ ? b : BATCH;
  const float* sh = modl + ((long)bb * 6 + shift_idx) * DM; const float* sc = sh + DM;
  const float* xr = xs + (long)row * DM; float v[16]; float ss = 0.f;
#pragma unroll
  for (int i = 0; i < 4; ++i) { float4 q = *(const float4*)(xr + i * 256 + lane * 4); v[i*4]=q.x; v[i*4+1]=q.y; v[i*4+2]=q.z; v[i*4+3]=q.w; ss += q.x*q.x+q.y*q.y+q.z*q.z+q.w*q.w; }
#pragma unroll
  for (int o = 32; o > 0; o >>= 1) ss += __shfl_xor(ss, o);
  float inv = 1.f / sqrtf(ss / DM + EPSN);
#pragma unroll
  for (int i = 0; i < 4; ++i) {
    int d = i * 256 + lane * 4; float o[4];
#pragma unroll
    for (int e = 0; e < 4; ++e) o[e] = v[i*4+e] * inv * g[d+e] * (1.f + sc[d+e]) + sh[d+e];
    uint2 pk; pk.x = pack2bf(o[0], o[1]); pk.y = pack2bf(o[2], o[3]);
    *(uint2*)(xn + (long)row * DM + d) = pk;
  }
}

struct EpiStoreBf16 { bf16_t* C; int ldc; int N;
  __device__ __forceinline__ void operator()(int m, int n0, f32x4 v) const {
    if (n0 < N) { uint2 pk; pk.x = pack2bf(v[0], v[1]); pk.y = pack2bf(v[2], v[3]); *(uint2*)(C + (long)m * ldc + n0) = pk; } } };
struct EpiStoreF32 { float* C; int ldc; int N;
  __device__ __forceinline__ void operator()(int m, int n0, f32x4 v) const {
    if (n0 < N) *(float4*)(C + (long)m * ldc + n0) = make_float4(v[0], v[1], v[2], v[3]); } };
struct EpiResid { float* xs; const float* modl; int gi; int pad;
  __device__ __forceinline__ void operator()(int m, int n0, f32x4 v) const {
    int b = m / RB, lr = m % RB; int bb = lr < SEQ ? b : BATCH; const float* g = modl + ((long)bb * 6 + gi) * DM + n0;
    float4 x = *(float4*)(xs + (long)m * DM + n0);
    x.x += g[0] * v[0]; x.y += g[1] * v[1]; x.z += g[2] * v[2]; x.w += g[3] * v[3];
    *(float4*)(xs + (long)m * DM + n0) = x; } };

template <class Epi>
__global__ void __launch_bounds__(256) ok_gemm(const bf16_t* A, int lda, const bf16_t* Bt, int ldb, int K, int tiles_m, int tiles_n, Epi epi) {
  __shared__ __attribute__((aligned(16))) char smem[GEMM_LDS_BYTES];
  for (int tile = blockIdx.x; tile < tiles_m * tiles_n; tile += gridDim.x) {
    int tm = tile / tiles_n, tn = tile % tiles_n;
    gemm_tile_128(ALoadPlain{A, lda}, Bt, ldb, K, tm, tn, smem, epi);
  }
}

typedef __attribute__((ext_vector_type(2))) __bf16 bf16v2;
__device__ __forceinline__ float dot2bf(unsigned a, unsigned b, float c) {
  return __builtin_amdgcn_fdot2_f32_bf16(*(bf16v2*)&a, *(bf16v2*)&b, c, false);
}
__global__ void ok_cvt_bf16_v8(const float* s, bf16_t* d, long n8) {
  long i = (long)blockIdx.x * blockDim.x + threadIdx.x; if (i >= n8) return;
  float4 a = *(const float4*)(s + i * 8), b = *(const float4*)(s + i * 8 + 4);
  u32x4 o; o[0] = pack2bf(a.x, a.y); o[1] = pack2bf(a.z, a.w); o[2] = pack2bf(b.x, b.y); o[3] = pack2bf(b.z, b.w);
  *(u32x4*)(d + i * 8) = o;
}

#define P5_LDS_BYTES (128 * 128 * 4)
__device__ __forceinline__ void peer_q_top1_tile(const bf16_t* __restrict__ A, const bf16_t* __restrict__ WqT, const bf16_t* __restrict__ keysb,
                                                 unsigned* __restrict__ top1, int tm, int ps, char* smem) {
  const int t = tid_opaque(), lane = t & 63, wave = t >> 6, wm = wave >> 1, wn = wave & 1, fr = lane & 15, fq = lane >> 4;
  f32x4 acc[4][4];
  {
    char* As = smem; char* Bs = smem + 16384;
    const int lrow = t >> 3, lchunk = t & 7;
    const bf16_t* ag = A + (long)(tm * 128 + lrow) * DM + lchunk * 8;
    const bf16_t* bg = WqT + (long)(ps * 128 + lrow) * DM + lchunk * 8;
    u32x4 ra[4], rb[4];
#pragma unroll
    for (int i = 0; i < 4; ++i) { ra[i] = *(const u32x4*)(ag + (long)(32 * i) * DM); rb[i] = *(const u32x4*)(bg + (long)(32 * i) * DM); }
#pragma unroll
    for (int i = 0; i < 4; ++i)
#pragma unroll
      for (int j = 0; j < 4; ++j) acc[i][j] = (f32x4){0.f, 0.f, 0.f, 0.f};
    for (int k0 = 0; k0 < DM; k0 += 64) {
      __syncthreads();
#pragma unroll
      for (int i = 0; i < 4; ++i) { int r = lrow + 32 * i; int off = r * 128 + ((lchunk ^ (r & 7)) << 4); *(u32x4*)(As + off) = ra[i]; *(u32x4*)(Bs + off) = rb[i]; }
      __syncthreads();
      if (k0 + 64 < DM) {
#pragma unroll
        for (int i = 0; i < 4; ++i) { ra[i] = *(const u32x4*)(ag + (long)(32 * i) * DM + k0 + 64); rb[i] = *(const u32x4*)(bg + (long)(32 * i) * DM + k0 + 64); }
      }
#pragma unroll
      for (int ks = 0; ks < 2; ++ks) {
        bf16x8 af[4], bfr[4];
#pragma unroll
        for (int i = 0; i < 4; ++i) {
          int r = wm * 64 + i * 16 + fr; af[i] = *(const bf16x8*)(As + r * 128 + (((ks * 4 + fq) ^ (r & 7)) << 4));
          int rn = wn * 64 + i * 16 + fr; bfr[i] = *(const bf16x8*)(Bs + rn * 128 + (((ks * 4 + fq) ^ (rn & 7)) << 4));
        }
#pragma unroll
        for (int i = 0; i < 4; ++i)
#pragma unroll
          for (int j = 0; j < 4; ++j) acc[i][j] = __builtin_amdgcn_mfma_f32_16x16x32_bf16(bfr[j], af[i], acc[i][j], 0, 0, 0);
      }
    }
  }
  __syncthreads();
  char* Qs = smem; char* Ks = smem + 32768;
#pragma unroll
  for (int i = 0; i < 4; ++i)
#pragma unroll
    for (int j = 0; j < 4; ++j) {
      int m = wm * 64 + i * 16 + fr; int n0 = wn * 64 + j * 16 + fq * 4;
      uint2 pk; pk.x = pack2bf(acc[i][j][0], acc[i][j][1]); pk.y = pack2bf(acc[i][j][2], acc[i][j][3]);
      *(uint2*)(Qs + m * 256 + ((((n0 >> 3) ^ (m & 15)) << 4) | ((n0 & 7) << 1))) = pk;
    }
  {
    const bf16_t* kg = keysb + (long)ps * 128 * 128;
#pragma unroll
    for (int i = 0; i < 8; ++i) { int idx = t + 256 * i; int r = idx >> 4, c = idx & 15; *(u32x4*)(Ks + r * 256 + ((c ^ (r & 15)) << 4)) = *(const u32x4*)(kg + r * 128 + c * 8); }
  }
  __syncthreads();
#pragma unroll
  for (int i = 0; i < 4; ++i)
#pragma unroll
    for (int j = 0; j < 4; ++j) acc[i][j] = (f32x4){0.f, 0.f, 0.f, 0.f};
#pragma unroll
  for (int ks = 0; ks < 4; ++ks) {
    bf16x8 af[4], bfr[4];
#pragma unroll
    for (int i = 0; i < 4; ++i) {
      int r = wm * 64 + i * 16 + fr; af[i] = *(const bf16x8*)(Qs + r * 256 + (((ks * 4 + fq) ^ (r & 15)) << 4));
      int rn = wn * 64 + i * 16 + fr; bfr[i] = *(const bf16x8*)(Ks + rn * 256 + (((ks * 4 + fq) ^ (rn & 15)) << 4));
    }
#pragma unroll
    for (int i = 0; i < 4; ++i)
#pragma unroll
      for (int j = 0; j < 4; ++j) acc[i][j] = __builtin_amdgcn_mfma_f32_16x16x32_bf16(bfr[j], af[i], acc[i][j], 0, 0, 0);
  }
  __syncthreads();
  unsigned* Sc = (unsigned*)smem;
#pragma unroll
  for (int i = 0; i < 4; ++i)
#pragma unroll
    for (int j = 0; j < 4; ++j) {
      int m = wm * 64 + i * 16 + fr; int n0 = wn * 64 + j * 16 + fq * 4;
#pragma unroll
      for (int e = 0; e < 4; ++e) Sc[(n0 + e) * 128 + (m ^ ((((n0 + e) >> 2) & 1) << 4))] = enc_key(acc[i][j][e], n0 + e);
    }
  __syncthreads();
  {
    const int r = t & 127, half = t >> 7;
    unsigned l[16];
#pragma unroll
    for (int i = 0; i < 16; ++i) l[i] = 0u;
    for (int k = 0; k < 64; ++k) ins16(l, Sc[(half * 64 + k) * 128 + (r ^ (((k >> 2) & 1) << 4))]);
    __syncthreads();
    unsigned* Ls = (unsigned*)smem;
    if (half == 1) {
#pragma unroll
      for (int i = 0; i < 16; ++i) Ls[r * 17 + i] = l[15 - i];
    }
    __syncthreads();
    if (half == 0) {
      unsigned br[16];
#pragma unroll
      for (int i = 0; i < 16; ++i) br[i] = Ls[r * 17 + i];
      merge16(l, br);
      unsigned* o = top1 + ((long)(tm * 128 + r) * 16 + ps) * 16;
#pragma unroll
      for (int i = 0; i < 4; ++i) { u32x4 v; v[0] = l[4*i]; v[1] = l[4*i+1]; v[2] = l[4*i+2]; v[3] = l[4*i+3]; *(u32x4*)(o + 4 * i) = v; }
    }
  }
}
__global__ void __launch_bounds__(256) ok_peer_q_top1(const bf16_t* A, const bf16_t* WqT, const bf16_t* keysb, unsigned* top1, int tiles_m) {
  __shared__ __attribute__((aligned(16))) char smem[P5_LDS_BYTES];
  for (int tile = blockIdx.x; tile < tiles_m * 16; tile += gridDim.x) { peer_q_top1_tile(A, WqT, keysb, top1, tile / 16, tile % 16, smem); __syncthreads(); }
}

#define P6_LDS_BYTES (32 * 128 * 4 * 3)
__device__ __forceinline__ void peer_gather_group(const bf16_t* __restrict__ xn, const unsigned* __restrict__ top1, const bf16_t* __restrict__ ub,
                                                  const bf16_t* __restrict__ vb, const float* __restrict__ modl, float* __restrict__ xs, int grp, char* smem) {
  const int t = tid_opaque(), lane = t & 63, wave = t >> 6;
  int* pe_l = (int*)smem; float* pg_l = (float*)(smem + 32 * 128 * 4); float* pw_l = (float*)(smem + 2 * 32 * 128 * 4);
  {
    int tl = t >> 3, p = t & 7; long row = (long)grp * 32 + tl;
    peer_combine(top1 + (row * 16 + p * 2) * 16, top1 + (row * 16 + p * 2 + 1) * 16, pe_l + tl * 128 + p * 16, pg_l + tl * 128 + p * 16);
  }
  __syncthreads();
  for (int ti = 0; ti < 8; ++ti) {
    const int tl = wave * 8 + ti; const long row = (long)grp * 32 + tl;
    const int* pe = pe_l + tl * 128; float* pw = pw_l + tl * 128;
    u32x4 h0 = *(const u32x4*)(xn + row * DM + lane * 8), h1 = *(const u32x4*)(xn + row * DM + 512 + lane * 8);
    for (int b = 0; b < 16; ++b) {
      u32x4 u0[8], u1[8];
#pragma unroll
      for (int j = 0; j < 8; ++j) { const bf16_t* ur = ub + (long)pe[b * 8 + j] * DM + lane * 8; u0[j] = *(const u32x4*)ur; u1[j] = *(const u32x4*)(ur + 512); }
      float pd[8];
#pragma unroll
      for (int j = 0; j < 8; ++j) {
        float a = 0.f;
#pragma unroll
        for (int e = 0; e < 4; ++e) { a = dot2bf(h0[e], u0[j][e], a); a = dot2bf(h1[e], u1[j][e], a); }
        pd[j] = a;
      }
      float q4[4], q2[2], q1;
#pragma unroll
      for (int j = 0; j < 4; ++j) { bool hi = lane & 1; float keep = hi ? pd[2*j+1] : pd[2*j], send = hi ? pd[2*j] : pd[2*j+1]; q4[j] = keep + __shfl_xor(send, 1); }
#pragma unroll
      for (int j = 0; j < 2; ++j) { bool hi = lane & 2; float keep = hi ? q4[2*j+1] : q4[2*j], send = hi ? q4[2*j] : q4[2*j+1]; q2[j] = keep + __shfl_xor(send, 2); }
      { bool hi = lane & 4; float keep = hi ? q2[1] : q2[0], send = hi ? q2[0] : q2[1]; q1 = keep + __shfl_xor(send, 4); }
      q1 += __shfl_xor(q1, 8); q1 += __shfl_xor(q1, 16); q1 += __shfl_xor(q1, 32);
      if (lane < 8) { int j = lane & 7; pw[b * 8 + j] = q1; }
    }
    {
      float d0 = pw[lane], d1 = pw[64 + lane];
      pw[lane] = pg_l[tl * 128 + lane] * geluf_(d0); pw[64 + lane] = pg_l[tl * 128 + 64 + lane] * geluf_(d1);
    }
    float o[16];
#pragma unroll
    for (int e = 0; e < 16; ++e) o[e] = 0.f;
    for (int b = 0; b < 16; ++b) {
      u32x4 v0[8], v1[8];
#pragma unroll
      for (int j = 0; j < 8; ++j) { const bf16_t* vr = vb + (long)pe[b * 8 + j] * DM + lane * 8; v0[j] = *(const u32x4*)vr; v1[j] = *(const u32x4*)(vr + 512); }
#pragma unroll
      for (int j = 0; j < 8; ++j) {
        float w = pw[b * 8 + j];
#pragma unroll
        for (int e = 0; e < 4; ++e) {
          o[2*e]     += w * __uint_as_float(v0[j][e] << 16); o[2*e+1]     += w * __uint_as_float(v0[j][e] & 0xffff0000u);
          o[8 + 2*e] += w * __uint_as_float(v1[j][e] << 16); o[8 + 2*e+1] += w * __uint_as_float(v1[j][e] & 0xffff0000u);
        }
      }
    }
    {
      int b = row / RB, lr = row % RB; int bb = lr < SEQ ? b : BATCH; const float* g5 = modl + ((long)bb * 6 + 5) * DM;
      float* xr = xs + row * DM;
#pragma unroll
      for (int hf = 0; hf < 2; ++hf) {
        int d = hf * 512 + lane * 8;
        float4 x0 = *(float4*)(xr + d), x1 = *(float4*)(xr + d + 4); float4 g0 = *(const float4*)(g5 + d), g1 = *(const float4*)(g5 + d + 4);
        x0.x += g0.x * o[hf*8+0]; x0.y += g0.y * o[hf*8+1]; x0.z += g0.z * o[hf*8+2]; x0.w += g0.w * o[hf*8+3];
        x1.x += g1.x * o[hf*8+4]; x1.y += g1.y * o[hf*8+5]; x1.z += g1.z * o[hf*8+6]; x1.w += g1.w * o[hf*8+7];
        *(float4*)(xr + d) = x0; *(float4*)(xr + d + 4) = x1;
      }
    }
  }
}
__global__ void __launch_bounds__(256) ok_peer_gather(const bf16_t* xn, const unsigned* top1, const bf16_t* ub, const bf16_t* vb, const float* modl, float* xs, int ngroups) {
  __shared__ __attribute__((aligned(16))) char smem[P6_LDS_BYTES];
  for (int g = blockIdx.x; g < ngroups; g += gridDim.x) { peer_gather_group(xn, top1, ub, vb, modl, xs, g, smem); __syncthreads(); }
}

template <int DQ> struct AttnCfg { static constexpr int KROW = DQ * 2 + 16; static constexpr int VROW = 136; static constexpr int KBYTES = 64 * KROW; static constexpr int LDS = 64 * KROW + 64 * VROW; };
#define ATTN_LDS_BYTES (64 * 208 + 64 * 136)
template <int DQ>
__device__ __forceinline__ void attn_block(const bf16_t* __restrict__ qb, int HQ, const bf16_t* __restrict__ kb, int HK, const bf16_t* __restrict__ vT, int G,
                                           bf16_t* __restrict__ mixall, int ooff, int b, int head, int qt, char* smem) {
  constexpr int KROW = AttnCfg<DQ>::KROW, VROW = 136, NKK = DQ / 16, KCH = DQ / 8;
  constexpr int KLD = (64 * KCH) / 256;
  const int t = tid_opaque(), lane = t & 63, wave = t >> 6, lq = lane & 31, lh = lane >> 5;
  const int hk = head / G;
  char* Ks = smem; char* Vs = smem + 64 * KROW;
  const long qrow = (long)b * RB + qt * 128 + wave * 32 + lq;
  bf16x8 qf[NKK];
#pragma unroll
  for (int kk = 0; kk < NKK; ++kk) qf[kk] = *(const bf16x8*)(qb + (qrow * HQ + head) * DQ + kk * 16 + lh * 8);
  const int key0 = qt < 16 ? 0 : SEQ; const int nt = qt < 16 ? RB / 64 : CTX_LEN / 64;
  const bf16_t* kbase = kb + ((long)b * RB * HK + hk) * DQ; const bf16_t* vbase = vT + ((long)(b * HK + hk) * 64) * RB;
  u32x4 rk[KLD], rv[2];
  auto issue = [&](int tile) {
    int k0 = key0 + tile * 64;
#pragma unroll
    for (int i = 0; i < KLD; ++i) { int c = t + 256 * i; int r = c / KCH, cc = c % KCH; rk[i] = *(const u32x4*)(kbase + (long)(k0 + r) * HK * DQ + cc * 8); }
#pragma unroll
    for (int i = 0; i < 2; ++i) { int c = t + 256 * i; int r = c >> 3, cc = c & 7; rv[i] = *(const u32x4*)(vbase + (long)r * RB + k0 + cc * 8); }
  };
  issue(0);
  f32x16 ot[2];
#pragma unroll
  for (int d = 0; d < 2; ++d)
#pragma unroll
    for (int r = 0; r < 16; ++r) ot[d][r] = 0.f;
  float mrun = -1e30f, lrun = 0.f;
  for (int tile = 0; tile < nt; ++tile) {
    __syncthreads();
#pragma unroll
    for (int i = 0; i < KLD; ++i) { int c = t + 256 * i; int r = c / KCH, cc = c % KCH; *(u32x4*)(Ks + r * KROW + cc * 16) = rk[i]; }
#pragma unroll
    for (int i = 0; i < 2; ++i) { int c = t + 256 * i; int r = c >> 3, cc = c & 7; *(uint2*)(Vs + r * VROW + cc * 16) = make_uint2(rv[i][0], rv[i][1]); *(uint2*)(Vs + r * VROW + cc * 16 + 8) = make_uint2(rv[i][2], rv[i][3]); }
    __syncthreads();
    if (tile + 1 < nt) issue(tile + 1);
    f32x16 st[2];
#pragma unroll
    for (int kt = 0; kt < 2; ++kt) {
#pragma unroll
      for (int r = 0; r < 16; ++r) st[kt][r] = 0.f;
#pragma unroll
      for (int kk = 0; kk < NKK; ++kk) {
        bf16x8 ka = *(const bf16x8*)(Ks + (kt * 32 + lq) * KROW + kk * 32 + lh * 16);
        st[kt] = __builtin_amdgcn_mfma_f32_32x32x16_bf16(ka, qf[kk], st[kt], 0, 0, 0);
      }
    }
    float mt = st[0][0];
#pragma unroll
    for (int kt = 0; kt < 2; ++kt)
#pragma unroll
      for (int r = 0; r < 16; ++r) mt = fmaxf(mt, st[kt][r]);
    mt = fmaxf(mt, __shfl_xor(mt, 32));
    float mnew = fmaxf(mrun, mt); float alpha = __builtin_amdgcn_exp2f(mrun - mnew); mrun = mnew;
    float ps = 0.f;
#pragma unroll
    for (int kt = 0; kt < 2; ++kt)
#pragma unroll
      for (int r = 0; r < 16; ++r) { float p = __builtin_amdgcn_exp2f(st[kt][r] - mnew); st[kt][r] = p; ps += p; }
    lrun = lrun * alpha + ps;
#pragma unroll
    for (int d = 0; d < 2; ++d)
#pragma unroll
      for (int r = 0; r < 16; ++r) ot[d][r] *= alpha;
#pragma unroll
    for (int kt = 0; kt < 2; ++kt)
#pragma unroll
      for (int s = 0; s < 2; ++s) {
        union { bf16x8 v; unsigned u[4]; } pb;
#pragma unroll
        for (int j = 0; j < 4; ++j) pb.u[j] = pack2bf(st[kt][8 * s + 2 * j], st[kt][8 * s + 2 * j + 1]);
#pragma unroll
        for (int d = 0; d < 2; ++d) {
          const char* vp = Vs + (d * 32 + lq) * VROW + (kt * 32 + 16 * s + 4 * lh) * 2;
          union { bf16x8 v; uint2 h[2]; } va; va.h[0] = *(const uint2*)vp; va.h[1] = *(const uint2*)(vp + 16);
          ot[d] = __builtin_amdgcn_mfma_f32_32x32x16_bf16(va.v, pb.v, ot[d], 0, 0, 0);
        }
      }
  }
  float ltot = lrun + __shfl_xor(lrun, 32); float inv = 1.f / ltot;
  bf16_t* orow = mixall + qrow * DM + ooff + head * 64;
#pragma unroll
  for (int d = 0; d < 2; ++d)
#pragma unroll
    for (int g = 0; g < 4; ++g) {
      uint2 pk; pk.x = pack2bf(ot[d][4 * g] * inv, ot[d][4 * g + 1] * inv); pk.y = pack2bf(ot[d][4 * g + 2] * inv, ot[d][4 * g + 3] * inv);
      *(uint2*)(orow + d * 32 + 8 * g + 4 * lh) = pk;
    }
}
__global__ void __launch_bounds__(256) ok_attn(const bf16_t* mq, const bf16_t* mk, const bf16_t* mvT, const bf16_t* gq, const bf16_t* gk, const bf16_t* gvT, bf16_t* mixall, int nqt) {
  __shared__ __attribute__((aligned(16))) char smem[ATTN_LDS_BYTES];
  const int n_mla = BATCH * 4 * nqt, n_gqa = BATCH * 6 * nqt;
  for (int w = blockIdx.x; w < n_mla + n_gqa; w += gridDim.x) {
    if (w < n_mla) { int qt = w % nqt, head = (w / nqt) % 4, b = w / (nqt * 4); attn_block<96>(mq, 4, mk, 4, mvT, 1, mixall, 0, b, head, qt, smem); }
    else { int v = w - n_mla; int qt = v % nqt, head = (v / nqt) % 6, b = v / (nqt * 6); attn_block<64>(gq, 6, gk, 2, gvT, 3, mixall, 640, b, head, qt, smem); }
    __syncthreads();
  }
}
__global__ void ok_adapt_rows(const float* src, int sld, int scol, int ncols, float scale, bf16_t* dst, int dld, int nrows) {
  long i = (long)blockIdx.x * blockDim.x + threadIdx.x; if (i >= (long)nrows * ncols) return;
  int c = i % ncols; long r = i / ncols; dst[r * dld + c] = f2bf(src[r * sld + scol + c] * scale);
}
__global__ void ok_adapt_vT(const float* src, int sld, int scol, int hstride, int H, bf16_t* dst) {
  long i = (long)blockIdx.x * blockDim.x + threadIdx.x; if (i >= (long)H * 64 * RB) return;
  int lr = i % RB; int d = (i / RB) % 64; int h = i / ((long)RB * 64);
  dst[i] = f2bf(src[(long)lr * sld + scol + h * hstride + d]);
}

typedef __attribute__((ext_vector_type(2))) float f32x2;
#define SCAN_TS 16
#define SCAN_LDS_BYTES (2 * SCAN_TS * 1536 + 2 * SCAN_TS * 32 * 4)
__device__ __forceinline__ float reduce8(float x) {
  x += __builtin_bit_cast(float, __builtin_amdgcn_update_dpp(0, __builtin_bit_cast(int, x), 0xB1, 0xf, 0xf, true));
  x += __builtin_bit_cast(float, __builtin_amdgcn_update_dpp(0, __builtin_bit_cast(int, x), 0x4E, 0xf, 0xf, true));
  x += __builtin_bit_cast(float, __builtin_amdgcn_update_dpp(0, __builtin_bit_cast(int, x), 0x141, 0xf, 0xf, true));
  return x;
}
__device__ __forceinline__ int scan_row(int dir, int s) {
  if (s < CTX_LEN) return SEQ + (dir == 0 ? s : CTX_LEN - 1 - s);
  return dir == 0 ? s - CTX_LEN : SEQ - 1 - (s - CTX_LEN);
}
__device__ __forceinline__ void rw_scan_block(const bf16_t* __restrict__ r_, const bf16_t* __restrict__ v_, const bf16_t* __restrict__ kk_, const bf16_t* __restrict__ kd_,
                                              const bf16_t* __restrict__ bd_, const float* __restrict__ w_, float* __restrict__ y_, int item, long dstride, char* smem) {
  const int t = tid_opaque(), lane = t & 63, wave = t >> 6, cg = lane & 7, il = wave * 8 + (lane >> 3);
  const int half = item & 1, dir = (item >> 1) & 1, h = (item >> 2) % 6, b = item / 24;
  const long rowbase = (long)b * RB; const int col0 = h * 64;
  float* ybuf = (float*)(smem + 2 * SCAN_TS * 1536);
  const int st_ld = t >> 4, part = t & 15;
  u32x4 la, lb, lc, lw;
  auto issue = [&](int c) {
    long row = rowbase + scan_row(dir, c * SCAN_TS + st_ld); long o = row * 384 + col0;
    const int ch = (part & 7) * 8;
    la = *(const u32x4*)((part < 8 ? kk_ + o : bd_ + dir * dstride + o) + ch);
    lb = *(const u32x4*)((part < 8 ? kd_ + dir * dstride + o : r_ + o) + ch);
    lc = *(const u32x4*)(v_ + o + ch);
    lw = *(const u32x4*)(w_ + dir * dstride + o + part * 4);
  };
  auto stash = [&](int buf) {
    float* base = (float*)(smem + buf * SCAN_TS * 1536 + st_ld * 1536);
    const int ch = (part & 7) * 8;
    float* pa = base + (part < 8 ? 64 : 128) + ch; float* pb = base + (part < 8 ? 192 : 256) + ch;
    f32x4 x0, x1;
#pragma unroll
    for (int e = 0; e < 2; ++e) { x0[2*e] = __uint_as_float(la[e] << 16); x0[2*e+1] = __uint_as_float(la[e] & 0xffff0000u); x1[2*e] = __uint_as_float(la[2+e] << 16); x1[2*e+1] = __uint_as_float(la[2+e] & 0xffff0000u); }
    *(f32x4*)pa = x0; *(f32x4*)(pa + 4) = x1;
#pragma unroll
    for (int e = 0; e < 2; ++e) { x0[2*e] = __uint_as_float(lb[e] << 16); x0[2*e+1] = __uint_as_float(lb[e] & 0xffff0000u); x1[2*e] = __uint_as_float(lb[2+e] << 16); x1[2*e+1] = __uint_as_float(lb[2+e] & 0xffff0000u); }
    *(f32x4*)pb = x0; *(f32x4*)(pb + 4) = x1;
    if (part < 8) {
      float* pc = base + 320 + ch;
#pragma unroll
      for (int e = 0; e < 2; ++e) { x0[2*e] = __uint_as_float(lc[e] << 16); x0[2*e+1] = __uint_as_float(lc[e] & 0xffff0000u); x1[2*e] = __uint_as_float(lc[2+e] << 16); x1[2*e+1] = __uint_as_float(lc[2+e] & 0xffff0000u); }
      *(f32x4*)pc = x0; *(f32x4*)(pc + 4) = x1;
    }
    *(u32x4*)(base + part * 4) = lw;
  };
  f32x2 S[4];
#pragma unroll
  for (int j = 0; j < 4; ++j) S[j] = (f32x2){0.f, 0.f};
  const int NCH = RB / SCAN_TS;
  issue(0);
  for (int c = 0; c < NCH; ++c) {
    const int buf = c & 1;
    stash(buf);
    __syncthreads();
    if (c > 0 && t < 128) {
      int st = t >> 3, i4 = (t & 7) * 4; long row = rowbase + scan_row(dir, (c - 1) * SCAN_TS + st);
      *(f32x4*)(y_ + dir * dstride + row * 384 + col0 + half * 32 + i4) = *(const f32x4*)(ybuf + (buf ^ 1) * SCAN_TS * 32 + st * 32 + i4);
    }
    if (c + 1 < NCH) issue(c + 1);
    const float* ob = (const float*)(smem + buf * SCAN_TS * 1536) + cg * 8;
    float yk[SCAN_TS];
#pragma unroll
    for (int st = 0; st < SCAN_TS; ++st) {
      const float* o = ob + st * 384;
      f32x4 w0 = *(const f32x4*)(o), w1 = *(const f32x4*)(o + 4), k0 = *(const f32x4*)(o + 64), k1 = *(const f32x4*)(o + 68);
      f32x4 b0 = *(const f32x4*)(o + 128), b1 = *(const f32x4*)(o + 132), d0 = *(const f32x4*)(o + 192), d1 = *(const f32x4*)(o + 196);
      f32x4 r0 = *(const f32x4*)(o + 256), r1 = *(const f32x4*)(o + 260);
      float vi = ob[st * 384 + 320 - cg * 8 + half * 32 + il];
      f32x2 a2 = S[0] * (f32x2){k0[0], k0[1]}; a2 += S[1] * (f32x2){k0[2], k0[3]}; a2 += S[2] * (f32x2){k1[0], k1[1]}; a2 += S[3] * (f32x2){k1[2], k1[3]};
      float skk = reduce8(a2[0] + a2[1]);
      f32x2 vv = (f32x2){vi, vi}, ns = (f32x2){-skk, -skk};
      S[0] = S[0] * (f32x2){w0[0], w0[1]} + (vv * (f32x2){d0[0], d0[1]} + ns * (f32x2){b0[0], b0[1]});
      S[1] = S[1] * (f32x2){w0[2], w0[3]} + (vv * (f32x2){d0[2], d0[3]} + ns * (f32x2){b0[2], b0[3]});
      S[2] = S[2] * (f32x2){w1[0], w1[1]} + (vv * (f32x2){d1[0], d1[1]} + ns * (f32x2){b1[0], b1[1]});
      S[3] = S[3] * (f32x2){w1[2], w1[3]} + (vv * (f32x2){d1[2], d1[3]} + ns * (f32x2){b1[2], b1[3]});
      f32x2 y2 = S[0] * (f32x2){r0[0], r0[1]}; y2 += S[1] * (f32x2){r0[2], r0[3]}; y2 += S[2] * (f32x2){r1[0], r1[1]}; y2 += S[3] * (f32x2){r1[2], r1[3]};
      yk[st] = reduce8(y2[0] + y2[1]);
    }
    if (cg == 0) {
#pragma unroll
      for (int st = 0; st < SCAN_TS; ++st) ybuf[buf * SCAN_TS * 32 + st * 32 + il] = yk[st];
    }
  }
  __syncthreads();
  if (t < 128) {
    int st = t >> 3, i4 = (t & 7) * 4; long row = rowbase + scan_row(dir, (NCH - 1) * SCAN_TS + st);
    *(f32x4*)(y_ + dir * dstride + row * 384 + col0 + half * 32 + i4) = *(const f32x4*)(ybuf + ((NCH - 1) & 1) * SCAN_TS * 32 + st * 32 + i4);
  }
}
__global__ void __launch_bounds__(256) ok_rw_scan(const bf16_t* r_, const bf16_t* v_, const bf16_t* kk_, const bf16_t* kd_, const bf16_t* bd_, const float* w_, float* y_, int item0, int nitems, long dstride) {
  __shared__ __attribute__((aligned(16))) char smem[SCAN_LDS_BYTES];
  for (int it = item0 + blockIdx.x; it < item0 + nitems; it += gridDim.x) { rw_scan_block(r_, v_, kk_, kd_, bd_, w_, y_, it, dstride, smem); __syncthreads(); }
}
__global__ void ok_copy_rows_f32(const float* src, int sld, int scol, int ncols, float* dst, int dld, int nrows) {
  long i = (long)blockIdx.x * blockDim.x + threadIdx.x; if (i >= (long)nrows * ncols) return;
  int c = i % ncols; long r = i / ncols; dst[r * dld + c] = src[r * sld + scol + c];
}

__global__ void ok_cvt_wT_g(const float* W, const float* g, bf16_t* Wt, int K, int N, int Kpad) {
  long i = (long)blockIdx.x * blockDim.x + threadIdx.x;
  if (i >= (long)N * Kpad) return;
  int k = i % Kpad; int n = i / Kpad;
  Wt[i] = k < K ? f2bf(W[(long)k * N + n] * (g ? g[k] : 1.f)) : (bf16_t)0;
}
struct ALoadShift { const bf16_t* P; const float* mu; int col0; int mucol0; int act; int kvalid;
  __device__ __forceinline__ u32x4 operator()(int row, int k) const {
    u32x4 z = {0u, 0u, 0u, 0u};
    if (k >= kvalid) return z;
    int lr = row % RB; bool first = (lr == 0) || (lr == SEQ), last = (lr == SEQ - 1) || (lr == RB - 1);
    const bf16_t* p = P + (long)row * IN_COLS + col0 + k;
    u32x4 c = *(const u32x4*)p; u32x4 pv = first ? z : *(const u32x4*)(p - IN_COLS); u32x4 nx = last ? z : *(const u32x4*)(p + IN_COLS);
    const float* m0 = mu + mucol0 + k; const float* m1 = m0 + RWC;
    u32x4 o;
#pragma unroll
    for (int e = 0; e < 4; ++e) {
      float c0 = __uint_as_float(c[e] << 16), c1 = __uint_as_float(c[e] & 0xffff0000u);
      float p0 = __uint_as_float(pv[e] << 16), p1 = __uint_as_float(pv[e] & 0xffff0000u);
      float n0 = __uint_as_float(nx[e] << 16), n1 = __uint_as_float(nx[e] & 0xffff0000u);
      float x0 = c0 + m0[2*e] * (p0 - c0) + m1[2*e] * (n0 - c0), x1 = c1 + m0[2*e+1] * (p1 - c1) + m1[2*e+1] * (n1 - c1);
      if (act == 1) { x0 = tanhf(x0); x1 = tanhf(x1); } else if (act == 2) { x0 = sigmoidf_(x0); x1 = sigmoidf_(x1); }
      o[e] = pack2bf(x0, x1);
    }
    return o;
  } };
struct EpiDecay { float* w; const float* w0; int pad0; int pad1;
  __device__ __forceinline__ void operator()(int m, int n0, f32x4 v) const {
    f32x4 o;
#pragma unroll
    for (int e = 0; e < 4; ++e) o[e] = expf(-expf(-softplusf_(-(w0[n0 + e] + v[e])) - 0.5f));
    *(f32x4*)(w + (long)m * 384 + n0) = o; } };
struct EpiSigA { bf16_t* a; const float* a0;
  __device__ __forceinline__ void operator()(int m, int n0, f32x4 v) const {
    uint2 pk; pk.x = pack2bf(sigmoidf_(a0[n0] + v[0]), sigmoidf_(a0[n0+1] + v[1])); pk.y = pack2bf(sigmoidf_(a0[n0+2] + v[2]), sigmoidf_(a0[n0+3] + v[3]));
    *(uint2*)(a + (long)m * 384 + n0) = pk; } };

struct PrepW { const bf16_t *wqbT, *wkvbT, *w2T, *a2T, *g2T; const float *mu, *w0, *a0; };
struct PrepBuf { const bf16_t* P; bf16_t *tq, *tkv, *a_b, *g_b; float* w_f; };
__device__ __forceinline__ void prep_gemm_tile(const PrepW& W, const PrepBuf& B, int tm, int ct, char* smem) {
  const long MA = NROWS;
  if (ct < 3) gemm_tile_128(ALoadPlain{B.P, IN_COLS}, W.wqbT, 256, 256, tm, ct, smem, EpiStoreBf16{B.tq, 384, 384});
  else if (ct < 7) gemm_tile_128(ALoadPlain{B.P + 256, IN_COLS}, W.wkvbT, 128, 128, tm, ct - 3, smem, EpiStoreBf16{B.tkv, 512, 512});
  else if (ct < 13) { int d = (ct - 7) / 3, tn = (ct - 7) % 3;
    gemm_tile_128(ALoadShift{B.P, W.mu, RW_OFF + 1152 + d * 64, 1152 + d * 64, 1, 64}, W.w2T + d * 384 * 64, 64, 64, tm, tn, smem, EpiDecay{B.w_f + d * MA * 384, W.w0 + d * 384, 0, 0}); }
  else if (ct < 19) { int d = (ct - 13) / 3, tn = (ct - 13) % 3;
    gemm_tile_128(ALoadShift{B.P, W.mu, RW_OFF + 1280 + d * 64, 1280 + d * 64, 0, 64}, W.a2T + d * 384 * 64, 64, 64, tm, tn, smem, EpiSigA{B.a_b + d * MA * 384, W.a0 + d * 384}); }
  else gemm_tile_128(ALoadShift{B.P, W.mu, RW_OFF + 1408, 1408, 2, 160}, W.g2T, 192, 192, tm, ct - 19, smem, EpiStoreBf16{B.g_b, 384, 384});
}
__global__ void __launch_bounds__(256) ok_prep_gemm(PrepW W, PrepBuf B) {
  __shared__ __attribute__((aligned(16))) char smem[GEMM_LDS_BYTES];
  for (int tile = blockIdx.x; tile < (NROWS / 128) * 22; tile += gridDim.x) prep_gemm_tile(W, B, tile / 22, tile % 22, smem);
}

__device__ __forceinline__ float wave_sum(float x) {
#pragma unroll
  for (int o = 32; o > 0; o >>= 1) x += __shfl_xor(x, o);
  return x;
}
__device__ __forceinline__ float ldbf(const bf16_t* p) { return bf2f(*p); }
struct FinW { const float *mla_qk_g, *gqa_qk_g, *mu, *k_k, *k_a; };
struct FinBuf { const bf16_t *P, *tq, *tkv, *a_b; bf16_t *mq, *mk, *mvT, *gq, *gk, *gvT, *r_b, *v_b, *kk_b, *kd_b, *bd_b; };
#define FIN_LDS_BYTES (384 * 132)
__device__ __forceinline__ void prep_finish_tile(const FinW& W, const FinBuf& B, int tile, char* smem) {
  const int t = tid_opaque(), lane = t & 63, wave = t >> 6; const long MA = NROWS;
  bf16_t* vbuf = (bf16_t*)smem;
  const long row0 = (long)tile * 64; const int b = row0 / RB; const int lr0 = row0 % RB;
  for (int it = 0; it < 16; ++it) {
    const int rl = it * 4 + wave; const long row = row0 + rl; const int lr = lr0 + rl; const bool lat = lr < SEQ;
    const bf16_t* Pr = B.P + row * IN_COLS;
    float sq = 0.f;
#pragma unroll
    for (int i = 0; i < 4; ++i) { float x = ldbf(Pr + i * 64 + lane); sq += x * x; }
    float skv = 0.f;
#pragma unroll
    for (int i = 0; i < 2; ++i) { float x = ldbf(Pr + 256 + i * 64 + lane); skv += x * x; }
    const float cq = 1.f / sqrtf(wave_sum(sq) / 256.f + EPSN), ckv = 1.f / sqrtf(wave_sum(skv) / 128.f + EPSN);
    const float krope = lane < 32 ? ldbf(Pr + 384 + lane) : 0.f;
    float cs_m = 1.f, sn_m = 0.f;
    { int j = lane & 15; int pos = j < 8 ? lr / 64 : lr % 64; float ang = (float)pos * powf(10000.f, -(float)(j & 7) / 8.f); if (lat) { cs_m = cosf(ang); sn_m = sinf(ang); } }
    const float* gq_ = W.mla_qk_g; const float* gk_ = W.mla_qk_g + 96;
#pragma unroll
    for (int h = 0; h < 4; ++h) {
      float qa = cq * ldbf(B.tq + row * 384 + h * 96 + lane); float qb = lane < 32 ? cq * ldbf(B.tq + row * 384 + h * 96 + 64 + lane) : 0.f;
      float inv = 1.f / sqrtf(wave_sum(qa * qa + qb * qb) / 96.f + EPSN);
      qa *= inv * gq_[lane]; qb *= inv * (lane < 32 ? gq_[64 + lane] : 0.f);
      { float other = __shfl_xor(qb, 16); float rr = (lane & 16) ? (other * sn_m + qb * cs_m) : (qb * cs_m - other * sn_m); qb = rr; }
      const float qs = 0.14724445f;
      B.mq[row * 384 + h * 96 + lane] = f2bf(qa * qs); if (lane < 32) B.mq[row * 384 + h * 96 + 64 + lane] = f2bf(qb * qs);
      float ka = ckv * ldbf(B.tkv + row * 512 + h * 128 + lane); float kb = krope;
      float invk = 1.f / sqrtf(wave_sum(ka * ka + kb * kb) / 96.f + EPSN);
      ka *= invk * gk_[lane]; kb *= invk * (lane < 32 ? gk_[64 + lane] : 0.f);
      { float other = __shfl_xor(kb, 16); float rr = (lane & 16) ? (other * sn_m + kb * cs_m) : (kb * cs_m - other * sn_m); kb = rr; }
      B.mk[row * 384 + h * 96 + lane] = f2bf(ka); if (lane < 32) B.mk[row * 384 + h * 96 + 64 + lane] = f2bf(kb);
      vbuf[(h * 64 + lane) * 66 + rl] = f2bf(ckv * ldbf(B.tkv + row * 512 + h * 128 + 64 + lane));
    }
    float cs_g = 1.f, sn_g = 0.f;
    { int j = lane & 31; int pos = j < 16 ? lr / 64 : lr % 64; float ang = (float)pos * powf(10000.f, -(float)(j & 15) / 16.f); if (lat) { cs_g = cosf(ang); sn_g = sinf(ang); } }
#pragma unroll
    for (int h = 0; h < 8; ++h) {
      float x = ldbf(Pr + GQA_OFF + h * 64 + lane);
      float inv = 1.f / sqrtf(wave_sum(x * x) / 64.f + EPSN);
      x *= inv * W.gqa_qk_g[(h < 6 ? 0 : 64) + lane];
      float other = __shfl_xor(x, 32); float rr = (lane & 32) ? (other * sn_g + x * cs_g) : (x * cs_g - other * sn_g);
      if (h < 6) B.gq[row * 384 + h * 64 + lane] = f2bf(rr * 0.18033688f); else B.gk[row * 128 + (h - 6) * 64 + lane] = f2bf(rr);
    }
#pragma unroll
    for (int hk = 0; hk < 2; ++hk) vbuf[((4 + hk) * 64 + lane) * 66 + rl] = Pr[GQA_OFF + 512 + hk * 64 + lane];
    const bool first = (lr == 0) || (lr == SEQ), last = (lr == SEQ - 1) || (lr == RB - 1);
#pragma unroll
    for (int h = 0; h < 6; ++h) {
      float xs3[3];
#pragma unroll
      for (int part = 0; part < 3; ++part) {
        int c = part * 384 + h * 64 + lane; const bf16_t* pp = Pr + RW_OFF + c;
        float p = ldbf(pp), pv = first ? 0.f : ldbf(pp - IN_COLS), nx = last ? 0.f : ldbf(pp + IN_COLS);
        xs3[part] = p + W.mu[c] * (pv - p) + W.mu[RWC + c] * (nx - p);
      }
      const int c = h * 64 + lane; const long o = row * 384 + c;
      float kv = xs3[1]; float tk = kv * W.k_k[c]; float kkv = tk / sqrtf(wave_sum(tk * tk) + 1e-12f);
      B.r_b[o] = f2bf(xs3[0]); B.v_b[o] = f2bf(xs3[2]); B.kk_b[o] = f2bf(kkv);
#pragma unroll
      for (int d = 0; d < 2; ++d) { float a = ldbf(B.a_b + d * MA * 384 + o); B.kd_b[d * MA * 384 + o] = f2bf(kv * (1.f + (a - 1.f) * W.k_a[c])); B.bd_b[d * MA * 384 + o] = f2bf(kkv * a); }
    }
  }
  __syncthreads();
  for (int i = t; i < 384 * 32; i += 256) {
    int rr = i >> 5, w2 = i & 31; int slot = rr >> 6, d = rr & 63;
    unsigned val = *(const unsigned*)(vbuf + rr * 66 + w2 * 2);
    bf16_t* dst = slot < 4 ? B.mvT + ((long)(b * 4 + slot) * 64 + d) * RB : B.gvT + ((long)(b * 2 + (slot - 4)) * 64 + d) * RB;
    *(unsigned*)(dst + lr0 + w2 * 2) = val;
  }
  __syncthreads();
}
__global__ void __launch_bounds__(256) ok_prep_finish(FinW W, FinBuf B) {
  __shared__ __attribute__((aligned(16))) char smem[FIN_LDS_BYTES];
  for (int tile = blockIdx.x; tile < NROWS / 64; tile += gridDim.x) prep_finish_tile(W, B, tile, smem);
}
struct RdW { const float *r_k, *ln_g, *ln_b; };
__device__ __forceinline__ void rw_readout_row(const RdW& W, const float* __restrict__ y, const bf16_t* __restrict__ r_b, const bf16_t* __restrict__ v_b, const bf16_t* __restrict__ kd_b,
                                               const bf16_t* __restrict__ g_b, bf16_t* __restrict__ mixall, long row, int lane) {
  const long MA = NROWS;
#pragma unroll
  for (int h = 0; h < 6; ++h) {
    const int c = h * 64 + lane; const long o = row * 384 + c;
    float yy = y[o] + y[MA * 384 + o];
    float mean = wave_sum(yy) * (1.f / 64.f); float dv = yy - mean; float var = wave_sum(dv * dv) * (1.f / 64.f);
    float coef = wave_sum(ldbf(r_b + o) * (ldbf(kd_b + o) + ldbf(kd_b + MA * 384 + o)) * W.r_k[c]);
    float yn = dv / sqrtf(var + 64e-5f) * W.ln_g[c] + W.ln_b[c];
    mixall[row * DM + 256 + c] = f2bf((yn + coef * ldbf(v_b + o)) * ldbf(g_b + o));
  }
}
__global__ void __launch_bounds__(256) ok_rw_readout(RdW W, const float* y, const bf16_t* r_b, const bf16_t* v_b, const bf16_t* kd_b, const bf16_t* g_b, bf16_t* mixall) {
  for (long row = blockIdx.x * 4 + (threadIdx.x >> 6); row < NROWS; row += gridDim.x * 4) rw_readout_row(W, y, r_b, v_b, kd_b, g_b, mixall, row, threadIdx.x & 63);
}

typedef __attribute__((ext_vector_type(2))) float f32v2;
__device__ __forceinline__ void ph_cvt_fp8_rows(const float* __restrict__ tab, unsigned char* __restrict__ q, float* __restrict__ scale) {
  const int t = tid_opaque(); const int lane = t & 63;
  for (int row = blockIdx.x * 4 + (t >> 6); row < 16384; row += gridDim.x * 4) {
    const float* src = tab + (long)row * DM + lane * 16;
    f32x4 a[4]; float m = 0.f;
#pragma unroll
    for (int i = 0; i < 4; ++i) { a[i] = *(const f32x4*)(src + 4 * i); m = fmaxf(m, fmaxf(fmaxf(fabsf(a[i][0]), fabsf(a[i][1])), fmaxf(fabsf(a[i][2]), fabsf(a[i][3])))); }
#pragma unroll
    for (int o = 32; o > 0; o >>= 1) m = fmaxf(m, __shfl_xor(m, o));
    const float sc = m > 0.f ? m * (1.f / 440.f) : 1.f; const float inv = 1.f / sc;
    u32x4 p;
#pragma unroll
    for (int i = 0; i < 4; ++i) { int w = __builtin_amdgcn_cvt_pk_fp8_f32(a[i][0] * inv, a[i][1] * inv, 0, false); w = __builtin_amdgcn_cvt_pk_fp8_f32(a[i][2] * inv, a[i][3] * inv, w, true); p[i] = (unsigned)w; }
    *(u32x4*)(q + (long)row * DM + lane * 16) = p;
    if (lane == 0) scale[row] = sc;
  }
}
__device__ __forceinline__ float dot16_fp8(const float (&h)[16], u32x4 q) {
  float a = 0.f;
#pragma unroll
  for (int d = 0; d < 4; ++d) {
    f32v2 lo = __builtin_amdgcn_cvt_pk_f32_fp8((int)q[d], false), hi = __builtin_amdgcn_cvt_pk_f32_fp8((int)q[d], true);
    a += h[4*d] * lo[0]; a += h[4*d+1] * lo[1]; a += h[4*d+2] * hi[0]; a += h[4*d+3] * hi[1];
  }
  return a;
}
__device__ __forceinline__ void axpy16_fp8(float (&o)[16], float w, u32x4 q) {
#pragma unroll
  for (int d = 0; d < 4; ++d) {
    f32v2 lo = __builtin_amdgcn_cvt_pk_f32_fp8((int)q[d], false), hi = __builtin_amdgcn_cvt_pk_f32_fp8((int)q[d], true);
    o[4*d] += w * lo[0]; o[4*d+1] += w * lo[1]; o[4*d+2] += w * hi[0]; o[4*d+3] += w * hi[1];
  }
}
__device__ __forceinline__ void peer_gather_group_fp8(const bf16_t* __restrict__ xn, const unsigned* __restrict__ top1, const unsigned char* __restrict__ ub, const float* __restrict__ su,
                                                      const unsigned char* __restrict__ vb, const float* __restrict__ sv, const float* __restrict__ modl, float* __restrict__ xs, int grp, char* smem) {
  const int t = tid_opaque(), lane = t & 63, wave = t >> 6;
  int* pe_l = (int*)smem; float* pg_l = (float*)(smem + 32 * 128 * 4); float* pw_l = (float*)(smem + 2 * 32 * 128 * 4);
  {
    int tl = t >> 3, p = t & 7; long row = (long)grp * 32 + tl;
    peer_combine(top1 + (row * 16 + p * 2) * 16, top1 + (row * 16 + p * 2 + 1) * 16, pe_l + tl * 128 + p * 16, pg_l + tl * 128 + p * 16);
  }
  __syncthreads();
  for (int ti = 0; ti < 8; ++ti) {
    const int tl = wave * 8 + ti; const long row = (long)grp * 32 + tl;
    const int* pe = pe_l + tl * 128; float* pw = pw_l + tl * 128;
    float h[16];
    { u32x4 h0 = *(const u32x4*)(xn + row * DM + lane * 16), h1 = *(const u32x4*)(xn + row * DM + lane * 16 + 8);
#pragma unroll
      for (int e = 0; e < 4; ++e) { h[2*e] = __uint_as_float(h0[e] << 16); h[2*e+1] = __uint_as_float(h0[e] & 0xffff0000u); h[8+2*e] = __uint_as_float(h1[e] << 16); h[8+2*e+1] = __uint_as_float(h1[e] & 0xffff0000u); } }
    u32x4 u[8];
#pragma unroll
    for (int j = 0; j < 8; ++j) u[j] = *(const u32x4*)(ub + (long)pe[j] * DM + lane * 16);
    for (int b = 0; b < 16; ++b) {
      float pd[8];
#pragma unroll
      for (int j = 0; j < 8; ++j) pd[j] = dot16_fp8(h, u[j]);
      if (b + 1 < 16) {
#pragma unroll
        for (int j = 0; j < 8; ++j) u[j] = *(const u32x4*)(ub + (long)pe[(b + 1) * 8 + j] * DM + lane * 16);
      }
      float q4[4], q2[2], q1;
#pragma unroll
      for (int j = 0; j < 4; ++j) { bool hi = lane & 1; float keep = hi ? pd[2*j+1] : pd[2*j], send = hi ? pd[2*j] : pd[2*j+1]; q4[j] = keep + __shfl_xor(send, 1); }
#pragma unroll
      for (int j = 0; j < 2; ++j) { bool hi = lane & 2; float keep = hi ? q4[2*j+1] : q4[2*j], send = hi ? q4[2*j] : q4[2*j+1]; q2[j] = keep + __shfl_xor(send, 2); }
      { bool hi = lane & 4; float keep = hi ? q2[1] : q2[0], send = hi ? q2[0] : q2[1]; q1 = keep + __shfl_xor(send, 4); }
      q1 += __shfl_xor(q1, 8); q1 += __shfl_xor(q1, 16); q1 += __shfl_xor(q1, 32);
      if (lane < 8) pw[b * 8 + lane] = q1 * su[pe[b * 8 + lane]];
    }
    u32x4 v[8];
#pragma unroll
    for (int j = 0; j < 8; ++j) v[j] = *(const u32x4*)(vb + (long)pe[j] * DM + lane * 16);
    {
      float d0 = pw[lane], d1 = pw[64 + lane];
      pw[lane] = pg_l[tl * 128 + lane] * geluf_(d0) * sv[pe[lane]]; pw[64 + lane] = pg_l[tl * 128 + 64 + lane] * geluf_(d1) * sv[pe[64 + lane]];
    }
    float o[16];
#pragma unroll
    for (int e = 0; e < 16; ++e) o[e] = 0.f;
    for (int b = 0; b < 16; ++b) {
      u32x4 vc[8];
#pragma unroll
      for (int j = 0; j < 8; ++j) vc[j] = v[j];
      if (b + 1 < 16) {
#pragma unroll
        for (int j = 0; j < 8; ++j) v[j] = *(const u32x4*)(vb + (long)pe[(b + 1) * 8 + j] * DM + lane * 16);
      }
#pragma unroll
      for (int j = 0; j < 8; ++j) axpy16_fp8(o, pw[b * 8 + j], vc[j]);
    }
    {
      int b = row / RB, lr = row % RB; int bb = lr < SEQ ? b : BATCH; const float* g5 = modl + ((long)bb * 6 + 5) * DM + lane * 16;
      float* xr = xs + row * DM + lane * 16;
#pragma unroll
      for (int i = 0; i < 4; ++i) {
        f32x4 x = *(f32x4*)(xr + 4 * i); f32x4 g = *(const f32x4*)(g5 + 4 * i);
        x[0] += g[0] * o[4*i]; x[1] += g[1] * o[4*i+1]; x[2] += g[2] * o[4*i+2]; x[3] += g[3] * o[4*i+3];
        *(f32x4*)(xr + 4 * i) = x;
      }
    }
  }
}
#include <hip/hip_cooperative_groups.h>
namespace cg = cooperative_groups;

#define XB_TMO      128
#define XB_XCNT(j)  (256  + 64 * (j))
#define XB_XSUB(j)  (1280 + 64 * (j))
#define XB_XGEN(j)  (2304 + 64 * (j))
#define XB_TOP      3328
#define XB_TOPGEN   3392
#define XB_QUEUE(i) (3456 + 64 * (i))
#define XCD_BAR_WORDS 4096
#define XB_SPIN_CAP (1u << 22)
#define LAS __attribute__((address_space(3)))
__device__ __forceinline__ unsigned xb_ld(unsigned* p)              { return __hip_atomic_load(p, __ATOMIC_RELAXED, __HIP_MEMORY_SCOPE_AGENT); }
__device__ __forceinline__ unsigned xb_add(unsigned* p, unsigned v) { return __hip_atomic_fetch_add(p, v, __ATOMIC_RELAXED, __HIP_MEMORY_SCOPE_AGENT); }
__device__ __forceinline__ unsigned xb_xcc_id() { return (unsigned)__builtin_amdgcn_s_getreg((3 << 11) | 20) & 0xFu; }
#define XB_SPIN(cond, bar) do { unsigned _sp = 0; while (cond) { __builtin_amdgcn_s_sleep(1); \
    if ((++_sp & 255u) == 0u) { if (xb_ld(&(bar)[XB_TMO])) break; if (_sp > XB_SPIN_CAP) { atomicAdd(&(bar)[XB_TMO], 1u); break; } } } } while (0)
struct XcdBarrier { unsigned* bar; unsigned x; volatile LAS unsigned* st; };
__device__ __forceinline__ XcdBarrier xcd_barrier_post(unsigned* bar, volatile LAS unsigned* st) {
  XcdBarrier b; b.bar = bar; b.x = xb_xcc_id(); b.st = st;
  if (threadIdx.x == 0) (void)xb_add(&bar[XB_XCNT(b.x)], 1u);
  return b;
}
__device__ __forceinline__ void xcd_barrier_complete(unsigned* bar, unsigned x, unsigned& nloc, unsigned& nx) {
  const unsigned G = gridDim.x; unsigned sum, cnt, mine, sp = 0u;
  for (;;) {
    sum = 0u; cnt = 0u; mine = 0u;
#pragma unroll
    for (unsigned j = 0; j < 16; ++j) { const unsigned c = xb_ld(&bar[XB_XCNT(j)]); sum += c; cnt += (c > 0u) ? 1u : 0u; mine = (j == x) ? c : mine; }
    if (sum == G) break;
    __builtin_amdgcn_s_sleep(1);
    if ((++sp & 255u) == 0u) { if (xb_ld(&bar[XB_TMO])) break; if (sp > XB_SPIN_CAP) { atomicAdd(&bar[XB_TMO], 1u); break; } }
  }
  nloc = mine > 0u ? mine : 1u; nx = cnt > 0u ? cnt : 1u;
}
__device__ __forceinline__ void xcd_barrier(const XcdBarrier& b) {
  asm volatile("s_waitcnt vmcnt(0)" ::: "memory");
  __syncthreads();
  if (threadIdx.x == 0) {
    unsigned* bar = b.bar;
    __builtin_amdgcn_s_waitcnt(0);
    unsigned nloc = b.st[0], nx = b.st[1];
    if (nloc == 0u) { xcd_barrier_complete(bar, b.x, nloc, nx); b.st[0] = nloc; b.st[1] = nx; }
    const unsigned old = xb_add(&bar[XB_XSUB(b.x)], 1u);
    const unsigned gen = old / nloc;
    if (old + 1u == (gen + 1u) * nloc) {
      __builtin_amdgcn_fence(__ATOMIC_RELEASE, "agent");
      asm volatile("s_waitcnt vmcnt(0)" ::: "memory");
      const unsigned og = xb_add(&bar[XB_TOP], 1u);
      const unsigned tg = og / nx;
      if (og + 1u == (tg + 1u) * nx) xb_add(&bar[XB_TOPGEN], 1u);
      else XB_SPIN(xb_ld(&bar[XB_TOPGEN]) == tg, bar);
      __builtin_amdgcn_fence(__ATOMIC_ACQUIRE, "agent");
      xb_add(&bar[XB_XGEN(b.x)], 1u);
      asm volatile("s_waitcnt vmcnt(0)" ::: "memory");
    } else {
      XB_SPIN(xb_ld(&bar[XB_XGEN(b.x)]) == gen, bar);
      __builtin_amdgcn_fence(__ATOMIC_ACQUIRE, "agent");
      asm volatile("s_waitcnt vmcnt(0)" ::: "memory");
    }
  }
  __syncthreads();
}


constexpr size_t al256(size_t x) { return (x + 255) & ~(size_t)255; }
struct WsOff { size_t xs, mod, xn, Pb, tq, tkv, a_b, g_b, w_f, mq, mk, mvT, gq, gk, gvT, r_b, v_b, kk_b, kd_b, bd_b, w_inT, w_outT, wqT, keysb, wqbT, wkvbT, w2T, a2T, g2T, total; };
constexpr WsOff make_wsoff() {
  WsOff o{}; size_t p = 16384; const size_t MA = NROWS;
  o.xs = p; p += al256(MA * DM * 4); o.mod = p; p += al256(2 * (BATCH + 1) * 6144 * 4); o.xn = p; p += al256(MA * DM * 2);
  o.Pb = p; p += al256(MA * IN_COLS * 2);
  o.tq = p; p += al256(MA * 384 * 2); o.tkv = p; p += al256(MA * 512 * 2); o.a_b = p; p += al256(2 * MA * 384 * 2);
  o.g_b = p; p += al256(MA * 384 * 2); o.w_f = p; p += al256(2 * MA * 384 * 4);
  o.mq = p; p += al256(MA * 384 * 2); o.mk = p; p += al256(MA * 384 * 2); o.mvT = p; p += al256((size_t)BATCH * 4 * 64 * RB * 2);
  o.gq = p; p += al256(MA * 384 * 2); o.gk = p; p += al256(MA * 128 * 2); o.gvT = p; p += al256((size_t)BATCH * 2 * 64 * RB * 2);
  o.r_b = p; p += al256(MA * 384 * 2); o.v_b = p; p += al256(MA * 384 * 2); o.kk_b = p; p += al256(MA * 384 * 2);
  o.kd_b = p; p += al256(2 * MA * 384 * 2); o.bd_b = p; p += al256(2 * MA * 384 * 2);
  o.w_inT = p; p += al256((size_t)2 * 2688 * 1024 * 2); o.w_outT = p; p += al256((size_t)2 * 1024 * 1024 * 2); o.wqT = p; p += al256((size_t)2 * 2048 * 1024 * 2);
  o.keysb = p; p += al256((size_t)2 * 16 * 128 * 128 * 2); o.wqbT = p; p += al256((size_t)2 * 384 * 256 * 2); o.wkvbT = p; p += al256((size_t)2 * 512 * 128 * 2);
  o.w2T = p; p += al256((size_t)2 * 2 * 384 * 64 * 2); o.a2T = p; p += al256((size_t)2 * 2 * 384 * 64 * 2); o.g2T = p; p += al256((size_t)2 * 384 * 192 * 2);
  o.total = p; return o;
}
constexpr WsOff WO = make_wsoff();
#define WS_PTR(T, off) ((T*)(ws + (off)))
#define LAUNDER_S(x) asm volatile("" : "+s"(x))

struct NaiveIn {
  const float *x, *c, *ctx, *c_ctx, *ada_w, *ada_b, *norm_mix_g, *norm_ffn_g, *w_in, *w_out, *mla_q_norm_g, *mla_w_qb, *mla_kv_norm_g,
      *mla_w_kvb, *mla_qk_g, *rw_mu, *rw_w0, *rw_w2, *rw_a0, *rw_a2, *rw_g2, *rw_k_k, *rw_k_a, *rw_r_k, *rw_ln_g, *rw_ln_b, *gqa_qk_g,
      *pe_wq, *pe_keys, *pe_u, *pe_v;
};
struct MegaP { NaiveIn in; char* ws; float* out; };

#ifndef MEGA_CG
#define MEGA_CG 0
#endif
#if MEGA_CG
#define GRID_BARRIER() cg::this_grid().sync()
#else
#define GRID_BARRIER() xcd_barrier(xb)
#endif
#define MEGA_LDS_BYTES 65536
#ifndef PHASE_MASK
#define PHASE_MASK 0xFFFF
#endif
#define PH(k) if (PHASE_MASK & (1 << (k)))
#ifndef DIL_PH
#define DIL_PH -1
#endif
#ifndef DIL_MULT
#define DIL_MULT 4
#endif
#define DIL_BEGIN(k) unsigned long long dil_t0 = 0; if (DIL_PH == (k)) dil_t0 = __builtin_amdgcn_s_memrealtime();
#define DIL_END(k) if (DIL_PH == (k)) { GRID_BARRIER(); if (blockIdx.x == 0 && threadIdx.x == 0) { unsigned long long t1 = __builtin_amdgcn_s_memrealtime(); unsigned long long dt = (t1 - dil_t0) * DIL_MULT; \
    while (__builtin_amdgcn_s_memrealtime() - t1 < dt) __builtin_amdgcn_s_sleep(32); } }

__device__ __forceinline__ void ph_norm_mod(const float* xs, const float* g, const float* modl, int shift_idx, bf16_t* xn) {
  const int tt_ = tid_opaque(); const int lane = tt_ & 63;
  for (long row = blockIdx.x * 4 + (tt_ >> 6); row < NROWS; row += (long)gridDim.x * 4) {
    int b = row / RB, lr = row % RB; int bb = lr < SEQ ? b : BATCH;
    const float* sh = modl + ((long)bb * 6 + shift_idx) * DM; const float* sc = sh + DM;
    const float* xr = xs + row * DM; f32x4 v[4]; float ss = 0.f;
#pragma unroll
    for (int i = 0; i < 4; ++i) { v[i] = *(const f32x4*)(xr + i * 256 + lane * 4); ss += v[i][0]*v[i][0] + v[i][1]*v[i][1] + v[i][2]*v[i][2] + v[i][3]*v[i][3]; }
    ss = wave_sum(ss);
    float inv = 1.f / sqrtf(ss / DM + EPSN);
#pragma unroll
    for (int i = 0; i < 4; ++i) {
      int d = i * 256 + lane * 4; float o[4];
#pragma unroll
      for (int e = 0; e < 4; ++e) o[e] = v[i][e] * inv * g[d+e] * (1.f + sc[d+e]) + sh[d+e];
      uint2 pk; pk.x = pack2bf(o[0], o[1]); pk.y = pack2bf(o[2], o[3]);
      *(uint2*)(xn + row * DM + d) = pk;
    }
  }
}
__device__ __forceinline__ void ph_cvt_wT(const float* W, const float* g, bf16_t* Wt, int K, int N, int Npad, int Kpad) {
  const long n_el = (long)Npad * Kpad;
  const int tt_ = tid_opaque();
  for (long i = (long)blockIdx.x * 256 + tt_; i < n_el; i += (long)gridDim.x * 256) {
    int k = i % Kpad; int n = i / Kpad;
    Wt[i] = (k < K && n < N) ? f2bf(W[(long)k * N + n] * (g ? g[k] : 1.f)) : (bf16_t)0;
  }
}
__device__ __forceinline__ void ph_cvt_bf16(const float* s, bf16_t* d, long n8) {
  const int tt_ = tid_opaque();
  for (long i = (long)blockIdx.x * 256 + tt_; i < n8; i += (long)gridDim.x * 256) {
    f32x4 a = *(const f32x4*)(s + i * 8), b = *(const f32x4*)(s + i * 8 + 4);
    u32x4 o; o[0] = pack2bf(a[0], a[1]); o[1] = pack2bf(a[2], a[3]); o[2] = pack2bf(b[0], b[1]); o[3] = pack2bf(b[2], b[3]);
    *(u32x4*)(d + i * 8) = o;
  }
}

__global__ void __launch_bounds__(256, 2) mega_kernel(MegaP p) {
  __shared__ __attribute__((aligned(16))) char smem[MEGA_LDS_BYTES];
  __shared__ uint4 xb_words;
  const int t0 = threadIdx.x;
#if !MEGA_CG
  if (t0 == 0) xb_words = make_uint4(0u, 0u, 0u, 0u);
  __syncthreads();
  XcdBarrier xb = xcd_barrier_post((unsigned*)p.ws, (volatile LAS unsigned*)&xb_words);
#endif
  const NaiveIn& I = p.in; const long MA = NROWS; const int TM = NROWS / 128;
  { DIL_BEGIN(0)
  PH(0) {
    char* ws = p.ws; LAUNDER_S(ws); const int t = tid_opaque();
    float* xs = WS_PTR(float, WO.xs); float* mod = WS_PTR(float, WO.mod);
    for (long i = (long)blockIdx.x * 256 + t; i < MA * DM / 4; i += (long)gridDim.x * 256) {
      long e = i * 4; int d = e % DM; long row = e / DM; int b = row / RB, lr = row % RB;
      const float* src = lr < SEQ ? I.x + ((long)b * SEQ + lr) * DM + d : I.ctx + ((long)b * CTX_LEN + (lr - SEQ)) * DM + d;
      *(f32x4*)(xs + e) = *(const f32x4*)src;
    }
    for (long i = (long)blockIdx.x * 256 + t; i < 2L * (BATCH + 1) * 6144; i += (long)gridDim.x * 256) {
      int j = i % 6144; int bb = (i / 6144) % (BATCH + 1); int l = i / (6144 * (BATCH + 1));
      const float* cv = bb < BATCH ? I.c + (long)bb * DM : I.c_ctx; const float* wp = I.ada_w + (long)l * DM * 6144 + j;
      float acc = 0.f;
#pragma unroll 4
      for (int k = 0; k < DM; ++k) acc += siluf_(cv[k]) * wp[(long)k * 6144];
      mod[i] = acc + I.ada_b[l * 6144 + j];
    }
    for (int l = 0; l < 2; ++l) {
      ph_cvt_wT(I.w_in + (long)l * DM * IN_COLS, nullptr, WS_PTR(bf16_t, WO.w_inT) + (long)l * 2688 * 1024, 1024, IN_COLS, 2688, 1024);
      ph_cvt_wT(I.w_out + (long)l * DM * DM, nullptr, WS_PTR(bf16_t, WO.w_outT) + (long)l * 1024 * 1024, 1024, 1024, 1024, 1024);
      ph_cvt_wT(I.pe_wq + (long)l * DM * 2048, nullptr, WS_PTR(bf16_t, WO.wqT) + (long)l * 2048 * 1024, 1024, 2048, 2048, 1024);
      ph_cvt_wT(I.mla_w_qb + (long)l * 256 * 384, I.mla_q_norm_g + l * 256, WS_PTR(bf16_t, WO.wqbT) + (long)l * 384 * 256, 256, 384, 384, 256);
      ph_cvt_wT(I.mla_w_kvb + (long)l * 128 * 512, I.mla_kv_norm_g + l * 128, WS_PTR(bf16_t, WO.wkvbT) + (long)l * 512 * 128, 128, 512, 512, 128);
      for (int d = 0; d < 2; ++d) {
        ph_cvt_wT(I.rw_w2 + ((long)l * 2 + d) * 64 * 384, nullptr, WS_PTR(bf16_t, WO.w2T) + ((long)l * 2 + d) * 384 * 64, 64, 384, 384, 64);
        ph_cvt_wT(I.rw_a2 + ((long)l * 2 + d) * 64 * 384, nullptr, WS_PTR(bf16_t, WO.a2T) + ((long)l * 2 + d) * 384 * 64, 64, 384, 384, 64);
      }
      ph_cvt_wT(I.rw_g2 + (long)l * 160 * 384, nullptr, WS_PTR(bf16_t, WO.g2T) + (long)l * 384 * 192, 160, 384, 384, 192);
    }
    ph_cvt_bf16(I.pe_keys, WS_PTR(bf16_t, WO.keysb), 2L * 16 * 128 * 128 / 8);
  }
  DIL_END(0) }
  GRID_BARRIER();
  for (int lq = 0; lq < 2; ++lq) {
    int l = lq; LAUNDER_S(l);
    { DIL_BEGIN(1)
    PH(1) {
      char* ws = p.ws; LAUNDER_S(ws); const int t = tid_opaque(); (void)t;
      ph_norm_mod(WS_PTR(float, WO.xs), I.norm_mix_g + l * DM, WS_PTR(float, WO.mod) + (long)l * (BATCH + 1) * 6144, 0, WS_PTR(bf16_t, WO.xn));
    }
    DIL_END(1) }
    GRID_BARRIER();
    { DIL_BEGIN(2)
    PH(2) {
      char* ws = p.ws; LAUNDER_S(ws); const int t = tid_opaque(); (void)t;
      const bf16_t* xn = WS_PTR(bf16_t, WO.xn); const bf16_t* wT = WS_PTR(bf16_t, WO.w_inT) + (long)l * 2688 * 1024; bf16_t* Pb = WS_PTR(bf16_t, WO.Pb);
      for (int tile = blockIdx.x; tile < TM * 21; tile += gridDim.x)
        gemm_tile_128(ALoadPlain{xn, DM}, wT, 1024, 1024, tile / 21, tile % 21, smem, EpiStoreBf16{Pb, IN_COLS, IN_COLS});
    }
    DIL_END(2) }
    GRID_BARRIER();
    { DIL_BEGIN(3)
    PH(3) {
      char* ws = p.ws; LAUNDER_S(ws); const int t = tid_opaque(); (void)t;
      PrepW pw{WS_PTR(bf16_t, WO.wqbT) + (long)l * 384 * 256, WS_PTR(bf16_t, WO.wkvbT) + (long)l * 512 * 128, WS_PTR(bf16_t, WO.w2T) + (long)l * 2 * 384 * 64,
               WS_PTR(bf16_t, WO.a2T) + (long)l * 2 * 384 * 64, WS_PTR(bf16_t, WO.g2T) + (long)l * 384 * 192, I.rw_mu + (long)l * 2 * RWC, I.rw_w0 + l * 768, I.rw_a0 + l * 768};
      PrepBuf pb{WS_PTR(bf16_t, WO.Pb), WS_PTR(bf16_t, WO.tq), WS_PTR(bf16_t, WO.tkv), WS_PTR(bf16_t, WO.a_b), WS_PTR(bf16_t, WO.g_b), WS_PTR(float, WO.w_f)};
      for (int tile = blockIdx.x; tile < TM * 22; tile += gridDim.x) prep_gemm_tile(pw, pb, tile / 22, tile % 22, smem);
    }
    DIL_END(3) }
    GRID_BARRIER();
    { DIL_BEGIN(4)
    PH(4) {
      char* ws = p.ws; LAUNDER_S(ws); const int t = tid_opaque(); (void)t;
      FinW fw{I.mla_qk_g + l * 192, I.gqa_qk_g + l * 128, I.rw_mu + (long)l * 2 * RWC, I.rw_k_k + l * 384, I.rw_k_a + l * 384};
      FinBuf fb{WS_PTR(bf16_t, WO.Pb), WS_PTR(bf16_t, WO.tq), WS_PTR(bf16_t, WO.tkv), WS_PTR(bf16_t, WO.a_b), WS_PTR(bf16_t, WO.mq), WS_PTR(bf16_t, WO.mk), WS_PTR(bf16_t, WO.mvT),
                WS_PTR(bf16_t, WO.gq), WS_PTR(bf16_t, WO.gk), WS_PTR(bf16_t, WO.gvT), WS_PTR(bf16_t, WO.r_b), WS_PTR(bf16_t, WO.v_b), WS_PTR(bf16_t, WO.kk_b), WS_PTR(bf16_t, WO.kd_b), WS_PTR(bf16_t, WO.bd_b)};
      for (int tile = blockIdx.x; tile < NROWS / 64; tile += gridDim.x) prep_finish_tile(fw, fb, tile, smem);
    }
    DIL_END(4) }
    GRID_BARRIER();
    { DIL_BEGIN(5)
    PH(5) {
      char* ws = p.ws; LAUNDER_S(ws); const int t = tid_opaque(); (void)t;
      if (blockIdx.x < BATCH * 24) {
        rw_scan_block(WS_PTR(bf16_t, WO.r_b), WS_PTR(bf16_t, WO.v_b), WS_PTR(bf16_t, WO.kk_b), WS_PTR(bf16_t, WO.kd_b), WS_PTR(bf16_t, WO.bd_b), WS_PTR(float, WO.w_f), WS_PTR(float, WO.Pb),
                      blockIdx.x, (long)MA * 384, smem);
        __syncthreads();
      }
      const int nqt = l == 0 ? 18 : 16; const int n_mla = BATCH * 4 * nqt, n_all = BATCH * 10 * nqt;
      unsigned* qctr = (unsigned*)ws + XB_QUEUE(l);
      int* s_item = (int*)(smem + MEGA_LDS_BYTES - 16);
      for (;;) {
        __syncthreads();
        if (t == 0) *s_item = (int)xb_add(qctr, 1u);
        __syncthreads();
        const int it = *s_item;
        if (it >= n_all) break;
        char* ws2 = p.ws; LAUNDER_S(ws2);
        if (it < n_mla) { int qt = it / (BATCH * 4), r = it % (BATCH * 4);
          attn_block<96>((const bf16_t*)(ws2 + WO.mq), 4, (const bf16_t*)(ws2 + WO.mk), 4, (const bf16_t*)(ws2 + WO.mvT), 1, (bf16_t*)(ws2 + WO.tq), 0, r / 4, r % 4, qt, smem); }
        else { int v = it - n_mla; int qt = v / (BATCH * 6), r = v % (BATCH * 6);
          attn_block<64>((const bf16_t*)(ws2 + WO.gq), 6, (const bf16_t*)(ws2 + WO.gk), 2, (const bf16_t*)(ws2 + WO.gvT), 3, (bf16_t*)(ws2 + WO.tq), 640, r / 6, r % 6, qt, smem); }
      }
    }
    DIL_END(5) }
    GRID_BARRIER();
    { DIL_BEGIN(6)
    PH(6) {
      char* ws = p.ws; LAUNDER_S(ws); const int t = tid_opaque(); (void)t;
      RdW rw{I.rw_r_k + l * 384, I.rw_ln_g + l * 384, I.rw_ln_b + l * 384};
      for (long row = blockIdx.x * 4 + (t >> 6); row < NROWS; row += (long)gridDim.x * 4)
        rw_readout_row(rw, WS_PTR(float, WO.Pb), WS_PTR(bf16_t, WO.r_b), WS_PTR(bf16_t, WO.v_b), WS_PTR(bf16_t, WO.kd_b), WS_PTR(bf16_t, WO.g_b), WS_PTR(bf16_t, WO.tq), row, t & 63);
    }
    DIL_END(6) }
    GRID_BARRIER();
    { DIL_BEGIN(7)
    PH(7) {
      char* ws = p.ws; LAUNDER_S(ws); const int t = tid_opaque(); (void)t;
      const bf16_t* mix = WS_PTR(bf16_t, WO.tq); const bf16_t* wT = WS_PTR(bf16_t, WO.w_outT) + (long)l * 1024 * 1024; float* xs = WS_PTR(float, WO.xs);
      const float* modl = WS_PTR(float, WO.mod) + (long)l * (BATCH + 1) * 6144;
      for (int tile = blockIdx.x; tile < TM * 8; tile += gridDim.x)
        gemm_tile_128(ALoadPlain{mix, DM}, wT, 1024, 1024, tile / 8, tile % 8, smem, EpiResid{xs, modl, 2, 0});
    }
    DIL_END(7) }
    GRID_BARRIER();
    { DIL_BEGIN(8)
    PH(8) {
      char* ws = p.ws; LAUNDER_S(ws); const int t = tid_opaque(); (void)t;
      ph_norm_mod(WS_PTR(float, WO.xs), I.norm_ffn_g + l * DM, WS_PTR(float, WO.mod) + (long)l * (BATCH + 1) * 6144, 3, WS_PTR(bf16_t, WO.xn));
      ph_cvt_fp8_rows(I.pe_u + (long)l * 16384 * DM, WS_PTR(unsigned char, WO.Pb), WS_PTR(float, WO.Pb + 2 * 16384 * 1024));
      ph_cvt_fp8_rows(I.pe_v + (long)l * 16384 * DM, WS_PTR(unsigned char, WO.Pb + 16384 * 1024), WS_PTR(float, WO.Pb + 2 * 16384 * 1024 + 65536));
    }
    DIL_END(8) }
    GRID_BARRIER();
    { DIL_BEGIN(9)
    PH(9) {
      char* ws = p.ws; LAUNDER_S(ws); const int t = tid_opaque(); (void)t;
      const bf16_t* xn = WS_PTR(bf16_t, WO.xn); const bf16_t* wT = WS_PTR(bf16_t, WO.wqT) + (long)l * 2048 * 1024; const bf16_t* kb = WS_PTR(bf16_t, WO.keysb) + (long)l * 16 * 128 * 128;
      unsigned* top1 = WS_PTR(unsigned, WO.tq);
      for (int tile = blockIdx.x; tile < TM * 16; tile += gridDim.x) { peer_q_top1_tile(xn, wT, kb, top1, tile / 16, tile % 16, smem); __syncthreads(); }
    }
    DIL_END(9) }
    GRID_BARRIER();
    { DIL_BEGIN(10)
    PH(10) {
      char* ws = p.ws; LAUNDER_S(ws); const int t = tid_opaque(); (void)t;
      const float* modl = WS_PTR(float, WO.mod) + (long)l * (BATCH + 1) * 6144;
      for (int g = blockIdx.x; g < NROWS / 32; g += gridDim.x) {
        peer_gather_group_fp8(WS_PTR(bf16_t, WO.xn), WS_PTR(unsigned, WO.tq), WS_PTR(unsigned char, WO.Pb), WS_PTR(float, WO.Pb + 2 * 16384 * 1024),
                              WS_PTR(unsigned char, WO.Pb + 16384 * 1024), WS_PTR(float, WO.Pb + 2 * 16384 * 1024 + 65536), modl, WS_PTR(float, WO.xs), g, smem);
        __syncthreads();
      }
    }
    DIL_END(10) }
    GRID_BARRIER();
  }
  {
    char* ws = p.ws; LAUNDER_S(ws); const int t = tid_opaque(); const float* xs = WS_PTR(float, WO.xs);
    for (long i = (long)blockIdx.x * 256 + t; i < (long)BATCH * SEQ * DM / 4; i += (long)gridDim.x * 256) {
      long e = i * 4; int d = e % DM; long row = e / DM; int b = row / SEQ, tt = row % SEQ;
      *(f32x4*)(p.out + e) = *(const f32x4*)(xs + ((long)b * RB + tt) * DM + d);
    }
  }
}

extern "C" void kernel_launch(void* const* d_in, const int* in_sizes, int n_in, void* d_out, int out_size, void* d_ws, size_t ws_size,
                              hipStream_t stream) {
  MegaP p{};
  const float** pp = (const float**)&p.in;
  for (int i = 0; i < 31; ++i) pp[i] = (const float*)d_in[i];
  p.ws = (char*)d_ws; p.out = (float*)d_out;
  if (WO.total > ws_size) return;
  static int grid_blocks = 0;
  if (!grid_blocks) {
    int dev = 0, cus = 0, per_cu = 0;
    hipGetDevice(&dev);
    hipDeviceGetAttribute(&cus, hipDeviceAttributeMultiprocessorCount, dev);
    hipOccupancyMaxActiveBlocksPerMultiprocessor(&per_cu, mega_kernel, 256, 0);
    if (per_cu > 2) per_cu = 2;
    if (per_cu < 1) per_cu = 1;
    grid_blocks = cus * per_cu;
  }
  hipMemsetAsync(d_ws, 0, 16384, stream);
  void* args[] = {&p};
  hipLaunchCooperativeKernel((void*)mega_kernel, dim3(grid_blocks), dim3(256), args, 0, stream);
}
```

```cpp
#include <hip/hip_runtime.h>
#ifndef BATCH
#define BATCH 8
#endif
#ifndef SEQ
#define SEQ 2048
#endif
#ifndef CTX_LEN
#define CTX_LEN 256
#endif
#define DM 1024
#define RB (SEQ + CTX_LEN)
#define NROWS (BATCH * RB)
#define IN_COLS 2624
#define MLA_OFF 0
#define RW_OFF 416
#define GQA_OFF 1984
#define RWC 1568
#define EPSN 1e-6f

__device__ inline float sigmoidf_(float x) { return 1.f / (1.f + expf(-x)); }
__device__ inline float siluf_(float x) { return x * sigmoidf_(x); }
__device__ inline float softplusf_(float x) { return fmaxf(x, 0.f) + log1pf(expf(-fabsf(x))); }
__device__ inline float geluf_(float x) { return 0.5f * x * (1.f + tanhf(0.7978845608028654f * (x + 0.044715f * x * x * x))); }

__global__ void nk_copy_in(const float* x, const float* ctx, float* xs) {
  long i = (long)blockIdx.x * blockDim.x + threadIdx.x;
  if (i >= (long)NROWS * DM) return;
  int d = i % DM; long row = i / DM; int b = row / RB, lr = row % RB;
  xs[i] = lr < SEQ ? x[((long)b * SEQ + lr) * DM + d] : ctx[((long)b * CTX_LEN + (lr - SEQ)) * DM + d];
}
__global__ void nk_copy_out(const float* xs, float* out) {
  long i = (long)blockIdx.x * blockDim.x + threadIdx.x;
  if (i >= (long)BATCH * SEQ * DM) return;
  int d = i % DM; long row = i / DM; int b = row / SEQ, t = row % SEQ;
  out[i] = xs[((long)b * RB + t) * DM + d];
}
__global__ void nk_mod(const float* c, const float* c_ctx, const float* ada_w, const float* ada_b, float* mod) {
  long i = (long)blockIdx.x * blockDim.x + threadIdx.x;
  if (i >= 2L * (BATCH + 1) * 6144) return;
  int j = i % 6144; int bb = (i / 6144) % (BATCH + 1); int l = i / (6144 * (BATCH + 1));
  const float* cv = bb < BATCH ? c + (long)bb * DM : c_ctx;
  const float* w = ada_w + (long)l * DM * 6144;
  float acc = 0.f;
  for (int k = 0; k < DM; ++k) acc += siluf_(cv[k]) * w[(long)k * 6144 + j];
  mod[i] = acc + ada_b[l * 6144 + j];
}
__global__ void nk_norm_mod(const float* xs, const float* g, const float* modl, int shift_idx, float* xn, int M, int bidx) {
  long row = (long)blockIdx.x * blockDim.x + threadIdx.x;
  if (row >= M) return;
  int lr = row % RB; int bb = lr < SEQ ? bidx : BATCH;
  const float* sh = modl + ((long)bb * 6 + shift_idx) * DM; const float* sc = sh + DM;
  const float* xr = xs + row * DM; float ss = 0.f;
  for (int d = 0; d < DM; ++d) ss += xr[d] * xr[d];
  float inv = 1.f / sqrtf(ss / DM + EPSN);
  for (int d = 0; d < DM; ++d) xn[row * DM + d] = xr[d] * inv * g[d] * (1.f + sc[d]) + sh[d];
}
__global__ void nk_gemm(const float* A, const float* W, float* C, int M, int N, int K) {
  long i = (long)blockIdx.x * blockDim.x + threadIdx.x;
  if (i >= (long)M * N) return;
  int n = i % N; long m = i / N; float acc = 0.f;
  for (int k = 0; k < K; ++k) acc += A[m * K + k] * W[(long)k * N + n];
  C[i] = acc;
}
__global__ void nk_mla_q1(const float* P, const float* qng, const float* wqb, float* tq, int M) {
  long i = (long)blockIdx.x * blockDim.x + threadIdx.x;
  if (i >= (long)M * 384) return;
  int j = i % 384; long r = i / 384; const float* cq = P + r * IN_COLS;
  float ss = 0.f; for (int k = 0; k < 256; ++k) ss += cq[k] * cq[k];
  float inv = 1.f / sqrtf(ss / 256 + EPSN), acc = 0.f;
  for (int k = 0; k < 256; ++k) acc += cq[k] * inv * qng[k] * wqb[k * 384 + j];
  tq[i] = acc;
}
__global__ void nk_mla_kv1(const float* P, const float* kvng, const float* wkvb, float* tkv, int M) {
  long i = (long)blockIdx.x * blockDim.x + threadIdx.x;
  if (i >= (long)M * 512) return;
  int j = i % 512; long r = i / 512; const float* ck = P + r * IN_COLS + 256;
  float ss = 0.f; for (int k = 0; k < 128; ++k) ss += ck[k] * ck[k];
  float inv = 1.f / sqrtf(ss / 128 + EPSN), acc = 0.f;
  for (int k = 0; k < 128; ++k) acc += ck[k] * inv * kvng[k] * wkvb[k * 512 + j];
  tkv[i] = acc;
}
__global__ void nk_mla_qk2(const float* P, const float* tq, const float* tkv, const float* qkg, float* mq, float* mk, int M) {
  long i = (long)blockIdx.x * blockDim.x + threadIdx.x;
  if (i >= (long)M * 8) return;
  int which = i % 2, h = (i / 2) % 4; long r = i / 8; int lr = r % RB;
  float ss = 0.f;
  for (int e = 0; e < 96; ++e) {
    float v = which == 0 ? tq[r * 384 + h * 96 + e] : (e < 64 ? tkv[r * 512 + h * 128 + e] : P[r * IN_COLS + 384 + (e - 64)]);
    ss += v * v;
  }
  float inv = 1.f / sqrtf(ss / 96 + EPSN);
  const float* g = qkg + which * 96; float* o = (which == 0 ? mq : mk) + r * 384 + h * 96;
  for (int e = 0; e < 64; ++e) {
    float v = which == 0 ? tq[r * 384 + h * 96 + e] : tkv[r * 512 + h * 128 + e];
    o[e] = v * inv * g[e];
  }
  for (int j = 0; j < 16; ++j) {
    float va = which == 0 ? tq[r * 384 + h * 96 + 64 + j] : P[r * IN_COLS + 384 + j];
    float vb = which == 0 ? tq[r * 384 + h * 96 + 80 + j] : P[r * IN_COLS + 384 + 16 + j];
    va *= inv * g[64 + j]; vb *= inv * g[80 + j];
    if (lr < SEQ) {
      int pos = j < 8 ? lr / 64 : lr % 64; float fr = powf(10000.f, -(float)(j & 7) / 8.f);
      float ang = (float)pos * fr, cs = cosf(ang), sn = sinf(ang);
      o[64 + j] = va * cs - vb * sn; o[80 + j] = va * sn + vb * cs;
    } else { o[64 + j] = va; o[80 + j] = vb; }
  }
}
__global__ void nk_gqa_prep(const float* P, const float* qkg, float* gq, float* gk, int M) {
  long i = (long)blockIdx.x * blockDim.x + threadIdx.x;
  if (i >= (long)M * 8) return;
  int h = i % 8; long r = i / 8; int lr = r % RB;
  const float* src = P + r * IN_COLS + GQA_OFF + h * 64;
  const float* g = qkg + (h < 6 ? 0 : 64);
  float* o = h < 6 ? gq + r * 384 + h * 64 : gk + r * 128 + (h - 6) * 64;
  float ss = 0.f; for (int e = 0; e < 64; ++e) ss += src[e] * src[e];
  float inv = 1.f / sqrtf(ss / 64 + EPSN);
  for (int j = 0; j < 32; ++j) {
    float va = src[j] * inv * g[j], vb = src[32 + j] * inv * g[32 + j];
    if (lr < SEQ) {
      int pos = j < 16 ? lr / 64 : lr % 64; float fr = powf(10000.f, -(float)(j & 15) / 16.f);
      float ang = (float)pos * fr, cs = cosf(ang), sn = sinf(ang);
      o[j] = va * cs - vb * sn; o[32 + j] = va * sn + vb * cs;
    } else { o[j] = va; o[32 + j] = vb; }
  }
}
template <int DQ>
__global__ void __launch_bounds__(256) nk_attn(const float* q, int qs, const float* k, int ks, const float* v, int vs, int vhs, int H, int G, float* mix, int ooff, int M) {
  long i = (long)blockIdx.x * blockDim.x + threadIdx.x;
  if (i >= (long)M * H) return;
  int h = i % H; long r = i / H; int b = r / RB, lr = r % RB; int kh = h / G;
  float qv[DQ];
#pragma unroll
  for (int e = 0; e < DQ; ++e) qv[e] = q[r * qs + h * DQ + e];
  float acc[64];
#pragma unroll
  for (int e = 0; e < 64; ++e) acc[e] = 0.f;
  float mx = -1e30f, l = 0.f; const float scale = 1.f / sqrtf((float)DQ);
  int k0 = lr < SEQ ? 0 : SEQ, k1 = RB;
  for (int kr = k0; kr < k1; ++kr) {
    long rr = (long)b * RB + kr; const float* kp = k + rr * ks + kh * DQ; float s = 0.f;
#pragma unroll
    for (int e = 0; e < DQ; ++e) s += qv[e] * kp[e];
    s *= scale;
    float mn = fmaxf(mx, s), al = expf(mx - mn), pp = expf(s - mn);
    l = l * al + pp; mx = mn; const float* vp = v + rr * vs + kh * vhs;
#pragma unroll
    for (int e = 0; e < 64; ++e) acc[e] = acc[e] * al + pp * vp[e];
  }
#pragma unroll
  for (int e = 0; e < 64; ++e) mix[r * DM + ooff + h * 64 + e] = acc[e] / l;
}
__global__ void nk_rw_shift(const float* P, const float* mu, float* rwx, int M) {
  long i = (long)blockIdx.x * blockDim.x + threadIdx.x;
  if (i >= (long)M * RWC) return;
  int c = i % RWC; long r = i / RWC; int lr = r % RB;
  bool first = (lr == 0) || (lr == SEQ), last = (lr == SEQ - 1) || (lr == RB - 1);
  float p = P[r * IN_COLS + RW_OFF + c];
  float pv = first ? 0.f : P[(r - 1) * IN_COLS + RW_OFF + c], nx = last ? 0.f : P[(r + 1) * IN_COLS + RW_OFF + c];
  rwx[i] = p + mu[c] * (pv - p) + mu[RWC + c] * (nx - p);
}
__global__ void nk_rw_prep(const float* rwx, const float* w0, const float* w2, const float* a0, const float* a2, const float* g2,
                           const float* k_k, const float* k_a, float* dec, float* kd, float* bd, float* kk, float* gg, int M) {
  long i = (long)blockIdx.x * blockDim.x + threadIdx.x;
  if (i >= (long)M * 384) return;
  int c = i % 384; long r = i / 384; int h = c / 64; const float* xr = rwx + r * RWC;
  float kv = xr[384 + c];
  float ss = 0.f; for (int n = 0; n < 64; ++n) { float t = xr[384 + h * 64 + n] * k_k[h * 64 + n]; ss += t * t; }
  float kkv = kv * k_k[c] / sqrtf(ss + 1e-12f);
  kk[i] = kkv;
  for (int d = 0; d < 2; ++d) {
    float wr = w0[d * 384 + c], ar = a0[d * 384 + c];
    for (int j = 0; j < 64; ++j) { wr += tanhf(xr[1152 + d * 64 + j]) * w2[(d * 64 + j) * 384 + c]; ar += xr[1280 + d * 64 + j] * a2[(d * 64 + j) * 384 + c]; }
    float dc = expf(-expf(-softplusf_(-wr) - 0.5f)); float a = sigmoidf_(ar);
    dec[(long)d * M * 384 + i] = dc; kd[(long)d * M * 384 + i] = kv * (1.f + (a - 1.f) * k_a[c]); bd[(long)d * M * 384 + i] = kkv * a;
  }
  float g = 0.f; for (int j = 0; j < 160; ++j) g += sigmoidf_(xr[1408 + j]) * g2[j * 384 + c];
  gg[i] = g;
}
__global__ void __launch_bounds__(256) nk_rw_scan(const float* rwx, const float* dec, const float* kd, const float* bd, const float* kk, float* y, int M, int nb) {
  long t = (long)blockIdx.x * blockDim.x + threadIdx.x;
  if (t >= (long)nb * 2 * 6 * 64) return;
  int i = t % 64, h = (t / 64) % 6, d = (t / 384) % 2, b = t / 768;
  float S[64];
#pragma unroll
  for (int j = 0; j < 64; ++j) S[j] = 0.f;
  for (int step = 0; step < RB; ++step) {
    int lr;
    if (step < CTX_LEN) lr = SEQ + (d == 0 ? step : CTX_LEN - 1 - step);
    else lr = d == 0 ? step - CTX_LEN : SEQ - 1 - (step - CTX_LEN);
    long r = (long)b * RB + lr; long o = (long)d * M * 384 + r * 384 + h * 64;
    const float* rp = rwx + r * RWC + h * 64; const float* wp = dec + o; const float* kp = kd + o; const float* bp = bd + o; const float* kkp = kk + r * 384 + h * 64;
    float vi = rwx[r * RWC + 768 + h * 64 + i];
    float skk = 0.f;
#pragma unroll
    for (int j = 0; j < 64; ++j) skk += S[j] * kkp[j];
    float yy = 0.f;
#pragma unroll
    for (int j = 0; j < 64; ++j) { S[j] = S[j] * wp[j] - skk * bp[j] + vi * kp[j]; yy += S[j] * rp[j]; }
    y[o + i] = yy;
  }
}
__global__ void nk_rw_readout(const float* rwx, const float* y, const float* kd, const float* gg, const float* r_k, const float* ln_g, const float* ln_b, float* mix, int M, long yds) {
  long i = (long)blockIdx.x * blockDim.x + threadIdx.x;
  if (i >= (long)M * 6) return;
  int h = i % 6; long r = i / 6; long o = r * 384 + h * 64; long ds = (long)M * 384;
  float mean = 0.f; for (int n = 0; n < 64; ++n) mean += y[o + n] + y[yds + o + n];
  mean /= 64.f;
  float var = 0.f, coef = 0.f;
  for (int n = 0; n < 64; ++n) {
    float yy = y[o + n] + y[yds + o + n] - mean; var += yy * yy;
    coef += rwx[r * RWC + h * 64 + n] * (kd[o + n] + kd[ds + o + n]) * r_k[h * 64 + n];
  }
  var /= 64.f; float inv = 1.f / sqrtf(var + 64e-5f);
  for (int n = 0; n < 64; ++n) {
    float yn = (y[o + n] + y[yds + o + n] - mean) * inv * ln_g[h * 64 + n] + ln_b[h * 64 + n];
    mix[r * DM + 256 + h * 64 + n] = (yn + coef * rwx[r * RWC + 768 + h * 64 + n]) * gg[o + n];
  }
}
__global__ void nk_gemm_res(const float* A, const float* W, const float* modl, int gi, float* xs, int M, int bidx) {
  long i = (long)blockIdx.x * blockDim.x + threadIdx.x;
  if (i >= (long)M * DM) return;
  int j = i % DM; long r = i / DM; int lr = r % RB; int bb = lr < SEQ ? bidx : BATCH;
  float acc = 0.f; for (int k = 0; k < DM; ++k) acc += A[r * DM + k] * W[(long)k * DM + j];
  xs[i] += modl[((long)bb * 6 + gi) * DM + j] * acc;
}
__global__ void nk_peer_score(const float* pq, const float* keys, float* sc, int M) {
  long i = (long)blockIdx.x * blockDim.x + threadIdx.x;
  if (i >= (long)M * 2048) return;
  int k = i % 128, ps = (i / 128) % 16; long r = i / 2048;
  const float* q = pq + r * 2048 + ps * 128; const float* ky = keys + ((long)ps * 128 + k) * 128;
  float acc = 0.f; for (int d = 0; d < 128; ++d) acc += q[d] * ky[d];
  sc[i] = acc;
}
__global__ void nk_peer_top1(const float* sc, float* ts, int* ti, int M) {
  long i = (long)blockIdx.x * blockDim.x + threadIdx.x;
  if (i >= (long)M * 16) return;
  const float* s = sc + i * 128; float pv = 3e38f; int pi = -1;
  for (int t = 0; t < 16; ++t) {
    float bv = -3e38f; int bi = -1;
    for (int k = 0; k < 128; ++k) {
      float v = s[k]; bool ok = (v < pv) || (v == pv && k > pi);
      if (ok && (bi < 0 || v > bv)) { bv = v; bi = k; }
    }
    ts[i * 16 + t] = bv; ti[i * 16 + t] = bi; pv = bv; pi = bi;
  }
}
__global__ void nk_peer_top2(const float* ts, const int* ti, int* pe, float* pg, int M) {
  long i = (long)blockIdx.x * blockDim.x + threadIdx.x;
  if (i >= (long)M * 8) return;
  const float* s1 = ts + i * 32; const float* s2 = s1 + 16; const int* i1 = ti + i * 32; const int* i2 = i1 + 16;
  float pv = 3e38f; int pi = -1; float mx = 0.f, sum = 0.f;
  for (int t = 0; t < 16; ++t) {
    float bv = -3e38f; int bi = -1;
    for (int c = 0; c < 256; ++c) {
      float v = s1[c / 16] + s2[c % 16]; bool ok = (v < pv) || (v == pv && c > pi);
      if (ok && (bi < 0 || v > bv)) { bv = v; bi = c; }
    }
    if (t == 0) mx = bv;
    float e = expf(bv - mx); sum += e;
    pe[i * 16 + t] = i1[bi / 16] * 128 + i2[bi % 16]; pg[i * 16 + t] = e; pv = bv; pi = bi;
  }
  for (int t = 0; t < 16; ++t) pg[i * 16 + t] /= sum;
}
__global__ void nk_peer_act(const float* xn, const float* u, const int* pe, const float* pg, float* pw, int M) {
  long i = (long)blockIdx.x * blockDim.x + threadIdx.x;
  if (i >= (long)M * 128) return;
  long r = i / 128; const float* ur = u + (long)pe[i] * DM; const float* xr = xn + r * DM;
  float acc = 0.f; for (int d = 0; d < DM; ++d) acc += xr[d] * ur[d];
  pw[i] = pg[i] * geluf_(acc);
}
__global__ void nk_peer_out(const float* v, const int* pe, const float* pw, const float* modl, float* xs, int M, int bidx) {
  long i = (long)blockIdx.x * blockDim.x + threadIdx.x;
  if (i >= (long)M * DM) return;
  int j = i % DM; long r = i / DM; int lr = r % RB; int bb = lr < SEQ ? bidx : BATCH;
  float acc = 0.f; for (int k = 0; k < 128; ++k) acc += pw[r * 128 + k] * v[(long)pe[r * 128 + k] * DM + j];
  xs[i] += modl[((long)bb * 6 + 5) * DM + j] * acc;
}


__device__ __forceinline__ unsigned f2sortable(float s) { unsigned f = __float_as_uint(s); return (f & 0x80000000u) ? ~f : (f | 0x80000000u); }
__device__ __forceinline__ float sortable2f(unsigned o) { unsigned f = (o & 0x80000000u) ? (o & 0x7fffffffu) : ~o; return __uint_as_float(f); }
__device__ __forceinline__ unsigned enc_key(float s, int idx) { return (f2sortable(s) & ~127u) | (unsigned)(127 - idx); }
__device__ __forceinline__ void dec_key(unsigned k, float& s, int& idx) { idx = 127 - (int)(k & 127u); s = sortable2f(k & ~127u); }
__device__ __forceinline__ unsigned umax_(unsigned a, unsigned b) { return a > b ? a : b; }
__device__ __forceinline__ unsigned umin_(unsigned a, unsigned b) { return a < b ? a : b; }
__device__ __forceinline__ void ins16(unsigned (&l)[16], unsigned x) {
#pragma unroll
  for (int i = 0; i < 16; ++i) { unsigned mx = umax_(l[i], x); x = umin_(l[i], x); l[i] = mx; }
}
__device__ __forceinline__ void merge16(unsigned (&a)[16], const unsigned (&brev)[16]) {
#pragma unroll
  for (int i = 0; i < 16; ++i) a[i] = umax_(a[i], brev[i]);
#pragma unroll
  for (int d = 8; d >= 1; d >>= 1)
#pragma unroll
    for (int i = 0; i < 16; ++i) if ((i & d) == 0) { unsigned hi = umax_(a[i], a[i + d]), lo = umin_(a[i], a[i + d]); a[i] = hi; a[i + d] = lo; }
}
__device__ __forceinline__ void peer_combine(const unsigned* L0, const unsigned* L1, int* e_out, float* g_out) {
  float s0[16], s1[16];
#pragma unroll
  for (int i = 0; i < 16; ++i) { int ix; dec_key(L0[i], s0[i], ix); dec_key(L1[i], s1[i], ix); }
  unsigned sel[16];
#pragma unroll
  for (int i = 0; i < 16; ++i) sel[i] = 0u;
#pragma unroll
  for (int i = 0; i < 16; ++i)
#pragma unroll
    for (int j = 0; j < 16; ++j)
      if ((i + 1) * (j + 1) <= 16) { unsigned k = (f2sortable(s0[i] + s1[j]) & ~255u) | (unsigned)(255 - (i * 16 + j)); ins16(sel, k); }
  float mx = -3e38f;
#pragma unroll
  for (int t = 0; t < 16; ++t) {
    int c = 255 - (int)(sel[t] & 255u); int i = c >> 4, j = c & 15;
    float a, b; int ia, ib; dec_key(L0[i], a, ia); dec_key(L1[j], b, ib);
    float s = a + b; e_out[t] = ia * 128 + ib; g_out[t] = s; mx = fmaxf(mx, s);
  }
  float sum = 0.f;
#pragma unroll
  for (int t = 0; t < 16; ++t) { float e = expf(g_out[t] - mx); g_out[t] = e; sum += e; }
  float inv = 1.f / sum;
#pragma unroll
  for (int t = 0; t < 16; ++t) g_out[t] *= inv;
}
__global__ void hk_peer_top1(const float* pq, const float* keys, unsigned* top1, int M) {
  long i = (long)blockIdx.x * blockDim.x + threadIdx.x;
  if (i >= (long)M * 16) return;
  int ps = i % 16; long r = i / 16; const float* q = pq + r * 2048 + ps * 128;
  unsigned la[16], lb[16], lbr[16];
#pragma unroll
  for (int t = 0; t < 16; ++t) { la[t] = 0u; lb[t] = 0u; }
  for (int k = 0; k < 128; ++k) {
    const float* ky = keys + ((long)ps * 128 + k) * 128; float acc = 0.f;
    for (int d = 0; d < 128; ++d) acc += q[d] * ky[d];
    unsigned key = enc_key(acc, k);
    if (k < 64) ins16(la, key); else ins16(lb, key);
  }
#pragma unroll
  for (int t = 0; t < 16; ++t) lbr[t] = lb[15 - t];
  merge16(la, lbr);
#pragma unroll
  for (int t = 0; t < 16; ++t) top1[i * 16 + t] = la[t];
}
__global__ void hk_peer_combine(const unsigned* top1, int* pe, float* pg, int M) {
  long i = (long)blockIdx.x * blockDim.x + threadIdx.x;
  if (i >= (long)M * 8) return;
  peer_combine(top1 + i * 32, top1 + i * 32 + 16, pe + i * 16, pg + i * 16);
}
typedef unsigned short bf16_t;
__device__ __forceinline__ int tid_opaque() { int t = threadIdx.x; asm volatile("" : "+v"(t)); return t; }
typedef __attribute__((ext_vector_type(8))) short bf16x8;
typedef __attribute__((ext_vector_type(4))) float f32x4;
typedef __attribute__((ext_vector_type(16))) float f32x16;
typedef __attribute__((ext_vector_type(4))) unsigned u32x4;

typedef __attribute__((ext_vector_type(2))) __bf16 bf16v2;
typedef __attribute__((ext_vector_type(2))) float f32v2;
__device__ __forceinline__ unsigned pack2bf(float a, float b) { f32v2 v = {a, b}; bf16v2 r = __builtin_convertvector(v, bf16v2); return __builtin_bit_cast(unsigned, r); }
__device__ __forceinline__ bf16_t f2bf(float f) { return (bf16_t)(pack2bf(f, 0.f) & 0xffffu); }
__device__ __forceinline__ float bf2f(bf16_t h) { return __uint_as_float(((unsigned)h) << 16); }

#define GEMM_LDS_BYTES 32768
struct ALoadPlain { const bf16_t* A; int lda;
  __device__ __forceinline__ u32x4 operator()(int row, int k) const { return *(const u32x4*)(A + (long)row * lda + k); } };
template <class ALoad, class Epi>
__device__ __forceinline__ void gemm_tile_128(ALoad aload, const bf16_t* __restrict__ Bt, int ldb, int K,
                                              int tile_m, int tile_n, char* smem, Epi epi) {
  const int t = tid_opaque(), lane = t & 63, wave = t >> 6;
  const int wm = wave >> 1, wn = wave & 1;
  char* As = smem; char* Bs = smem + 16384;
  const int lrow = t >> 3, lchunk = t & 7;
  const int arow = tile_m * 128 + lrow;
  const bf16_t* bg = Bt + (long)(tile_n * 128 + lrow) * ldb + lchunk * 8;
  u32x4 ra[4], rb[4];
#pragma unroll
  for (int i = 0; i < 4; ++i) {
    ra[i] = aload(arow + 32 * i, lchunk * 8);
    rb[i] = *(const u32x4*)(bg + (long)(32 * i) * ldb);
  }
  f32x4 acc[4][4];
#pragma unroll
  for (int i = 0; i < 4; ++i)
#pragma unroll
    for (int j = 0; j < 4; ++j) acc[i][j] = (f32x4){0.f, 0.f, 0.f, 0.f};
  const int fr = lane & 15, fq = lane >> 4;
  for (int k0 = 0; k0 < K; k0 += 64) {
    __syncthreads();
#pragma unroll
    for (int i = 0; i < 4; ++i) {
      int r = lrow + 32 * i; int off = r * 128 + ((lchunk ^ (r & 7)) << 4);
      *(u32x4*)(As + off) = ra[i]; *(u32x4*)(Bs + off) = rb[i];
    }
    __syncthreads();
    if (k0 + 64 < K) {
#pragma unroll
      for (int i = 0; i < 4; ++i) {
        ra[i] = aload(arow + 32 * i, k0 + 64 + lchunk * 8);
        rb[i] = *(const u32x4*)(bg + (long)(32 * i) * ldb + k0 + 64);
      }
    }
#pragma unroll
    for (int ks = 0; ks < 2; ++ks) {
      bf16x8 af[4], bfr[4];
#pragma unroll
      for (int i = 0; i < 4; ++i) {
        int r = wm * 64 + i * 16 + fr; af[i] = *(const bf16x8*)(As + r * 128 + (((ks * 4 + fq) ^ (r & 7)) << 4));
        int rn = wn * 64 + i * 16 + fr; bfr[i] = *(const bf16x8*)(Bs + rn * 128 + (((ks * 4 + fq) ^ (rn & 7)) << 4));
      }
#pragma unroll
      for (int i = 0; i < 4; ++i)
#pragma unroll
        for (int j = 0; j < 4; ++j) acc[i][j] = __builtin_amdgcn_mfma_f32_16x16x32_bf16(bfr[j], af[i], acc[i][j], 0, 0, 0);
    }
  }
#pragma unroll
  for (int i = 0; i < 4; ++i)
#pragma unroll
    for (int j = 0; j < 4; ++j) {
      int m = tile_m * 128 + wm * 64 + i * 16 + fr; int n0 = tile_n * 128 + wn * 64 + j * 16 + fq * 4;
      epi(m, n0, acc[i][j]);
    }
}

__global__ void ok_cvt_wT(const float* W, bf16_t* Wt, int K, int N, int Npad) {
  long i = (long)blockIdx.x * blockDim.x + threadIdx.x;
  if (i >= (long)Npad * K) return;
  int k = i % K; int n = i / K;
  Wt[i] = n < N ? f2bf(W[(long)k * N + n]) : (bf16_t)0;
}
__global__ void ok_f32_to_bf16(const float* s, bf16_t* d, long n) {
  long i = (long)blockIdx.x * blockDim.x + threadIdx.x; if (i < n) d[i] = f2bf(s[i]);
}
__global__ void ok_bf16_to_f32(const bf16_t* s, float* d, long n) {
  long i = (long)blockIdx.x * blockDim.x + threadIdx.x; if (i < n) d[i] = bf2f(s[i]);
}
__global__ void ok_norm_mod_bf16(const float* xs, const float* g, const float* modl, int shift_idx, bf16_t* xn, int M) {
  int row = blockIdx.x * 4 + (threadIdx.x >> 6); int lane = threadIdx.x & 63;
  if (row >= M) return;
  int b = row / RB, lr = row % RB; int bb = lr < SEQ ? b : BATCH;
  const float* sh = modl + ((long)bb * 6 + shift_idx) * DM; const float* sc = sh + DM;
  const float* xr = xs + (long)row * DM; float v[16]; float ss = 0.f;
#pragma unroll
  for (int i = 0; i < 4; ++i) { float4 q = *(const float4*)(xr + i * 256 + lane * 4); v[i*4]=q.x; v[i*4+1]=q.y; v[i*4+2]=q.z; v[i*4+3]=q.w; ss += q.x*q.x+q.y*q.y+q.z*q.z+q.w*q.w; }
#pragma unroll
  for (int o = 32; o > 0; o >>= 1) ss += __shfl_xor(ss, o);
  float inv = 1.f / sqrtf(ss / DM + EPSN);
#pragma unroll
  for (int i = 0; i < 4; ++i) {
    int d = i * 256 + lane * 4; float o[4];
#pragma unroll
    for (int e = 0; e < 4; ++e) o[e] = v[i*4+e] * inv * g[d+e] * (1.f + sc[d+e]) + sh[d+e];
    uint2 pk; pk.x = pack2bf(o[0], o[1]); pk.y = pack2bf(o[2], o[3]);
    *(uint2*)(xn + (long)row * DM + d) = pk;
  }
}

struct EpiStoreBf16 { bf16_t* C; int ldc; int N;
  __device__ __forceinline__ void operator()(int m, int n0, f32x4 v) const {
    if (n0 < N) { uint2 pk; pk.x = pack2bf(v[0], v[1]); pk.y = pack2bf(v[2], v[3]); *(uint2*)(C + (long)m * ldc + n0) = pk; } } };
struct EpiStoreF32 { float* C; int ldc; int N;
  __device__ __forceinline__ void operator()(int m, int n0, f32x4 v) const {
    if (n0 < N) *(float4*)(C + (long)m * ldc + n0) = make_float4(v[0], v[1], v[2], v[3]); } };
struct EpiResid { float* xs; const float* modl; int gi; int pad;
  __device__ __forceinline__ void operator()(int m, int n0, f32x4 v) const {
    int b = m / RB, lr = m % RB; int bb = lr < SEQ ? b : BATCH; const float* g = modl + ((long)bb * 6 + gi) * DM + n0;
    float4 x = *(float4*)(xs + (long)m * DM + n0);
    x.x += g[0] * v[0]; x.y += g[1] * v[1]; x.z += g[2] * v[2]; x.w += g[3] * v[3];
    *(float4*)(xs + (long)m * DM + n0) = x; } };

template <class Epi>
__global__ void __launch_bounds__(256) ok_gemm(const bf16_t* A, int lda, const bf16_t* Bt, int ldb, int K, int tiles_m, int tiles_n, Epi epi) {
  __shared__ __attribute__((aligned(16))) char smem[GEMM_LDS_BYTES];
  for (int tile = blockIdx.x; tile < tiles_m * tiles_n; tile += gridDim.x) {
    int tm = tile / tiles_n, tn = tile % tiles_n;
    gemm_tile_128(ALoadPlain{A, lda}, Bt, ldb, K, tm, tn, smem, epi);
  }
}

__device__ __forceinline__ float dot2bf(unsigned a, unsigned b, float c) {
  return __builtin_amdgcn_fdot2_f32_bf16(*(bf16v2*)&a, *(bf16v2*)&b, c, false);
}
__global__ void ok_cvt_bf16_v8(const float* s, bf16_t* d, long n8) {
  long i = (long)blockIdx.x * blockDim.x + threadIdx.x; if (i >= n8) return;
  float4 a = *(const float4*)(s + i * 8), b = *(const float4*)(s + i * 8 + 4);
  u32x4 o; o[0] = pack2bf(a.x, a.y); o[1] = pack2bf(a.z, a.w); o[2] = pack2bf(b.x, b.y); o[3] = pack2bf(b.z, b.w);
  *(u32x4*)(d + i * 8) = o;
}

#define P5_LDS_BYTES (128 * 128 * 4)
__device__ __forceinline__ void peer_q_top1_tile(const bf16_t* __restrict__ A, const bf16_t* __restrict__ WqT, const bf16_t* __restrict__ keysb,
                                                 unsigned* __restrict__ top1, int tm, int ps, char* smem) {
  const int t = tid_opaque(), lane = t & 63, wave = t >> 6, wm = wave >> 1, wn = wave & 1, fr = lane & 15, fq = lane >> 4;
  f32x4 acc[4][4];
  {
    char* As = smem; char* Bs = smem + 16384;
    const int lrow = t >> 3, lchunk = t & 7;
    const bf16_t* ag = A + (long)(tm * 128 + lrow) * DM + lchunk * 8;
    const bf16_t* bg = WqT + (long)(ps * 128 + lrow) * DM + lchunk * 8;
    u32x4 ra[4], rb[4];
#pragma unroll
    for (int i = 0; i < 4; ++i) { ra[i] = *(const u32x4*)(ag + (long)(32 * i) * DM); rb[i] = *(const u32x4*)(bg + (long)(32 * i) * DM); }
#pragma unroll
    for (int i = 0; i < 4; ++i)
#pragma unroll
      for (int j = 0; j < 4; ++j) acc[i][j] = (f32x4){0.f, 0.f, 0.f, 0.f};
    for (int k0 = 0; k0 < DM; k0 += 64) {
      __syncthreads();
#pragma unroll
      for (int i = 0; i < 4; ++i) { int r = lrow + 32 * i; int off = r * 128 + ((lchunk ^ (r & 7)) << 4); *(u32x4*)(As + off) = ra[i]; *(u32x4*)(Bs + off) = rb[i]; }
      __syncthreads();
      if (k0 + 64 < DM) {
#pragma unroll
        for (int i = 0; i < 4; ++i) { ra[i] = *(const u32x4*)(ag + (long)(32 * i) * DM + k0 + 64); rb[i] = *(const u32x4*)(bg + (long)(32 * i) * DM + k0 + 64); }
      }
#pragma unroll
      for (int ks = 0; ks < 2; ++ks) {
        bf16x8 af[4], bfr[4];
#pragma unroll
        for (int i = 0; i < 4; ++i) {
          int r = wm * 64 + i * 16 + fr; af[i] = *(const bf16x8*)(As + r * 128 + (((ks * 4 + fq) ^ (r & 7)) << 4));
          int rn = wn * 64 + i * 16 + fr; bfr[i] = *(const bf16x8*)(Bs + rn * 128 + (((ks * 4 + fq) ^ (rn & 7)) << 4));
        }
#pragma unroll
        for (int i = 0; i < 4; ++i)
#pragma unroll
          for (int j = 0; j < 4; ++j) acc[i][j] = __builtin_amdgcn_mfma_f32_16x16x32_bf16(bfr[j], af[i], acc[i][j], 0, 0, 0);
      }
    }
  }
  __syncthreads();
  char* Qs = smem; char* Ks = smem + 32768;
#pragma unroll
  for (int i = 0; i < 4; ++i)
#pragma unroll
    for (int j = 0; j < 4; ++j) {
      int m = wm * 64 + i * 16 + fr; int n0 = wn * 64 + j * 16 + fq * 4;
      uint2 pk; pk.x = pack2bf(acc[i][j][0], acc[i][j][1]); pk.y = pack2bf(acc[i][j][2], acc[i][j][3]);
      *(uint2*)(Qs + m * 256 + ((((n0 >> 3) ^ (m & 15)) << 4) | ((n0 & 7) << 1))) = pk;
    }
  {
    const bf16_t* kg = keysb + (long)ps * 128 * 128;
#pragma unroll
    for (int i = 0; i < 8; ++i) { int idx = t + 256 * i; int r = idx >> 4, c = idx & 15; *(u32x4*)(Ks + r * 256 + ((c ^ (r & 15)) << 4)) = *(const u32x4*)(kg + r * 128 + c * 8); }
  }
  __syncthreads();
#pragma unroll
  for (int i = 0; i < 4; ++i)
#pragma unroll
    for (int j = 0; j < 4; ++j) acc[i][j] = (f32x4){0.f, 0.f, 0.f, 0.f};
#pragma unroll
  for (int ks = 0; ks < 4; ++ks) {
    bf16x8 af[4], bfr[4];
#pragma unroll
    for (int i = 0; i < 4; ++i) {
      int r = wm * 64 + i * 16 + fr; af[i] = *(const bf16x8*)(Qs + r * 256 + (((ks * 4 + fq) ^ (r & 15)) << 4));
      int rn = wn * 64 + i * 16 + fr; bfr[i] = *(const bf16x8*)(Ks + rn * 256 + (((ks * 4 + fq) ^ (rn & 15)) << 4));
    }
#pragma unroll
    for (int i = 0; i < 4; ++i)
#pragma unroll
      for (int j = 0; j < 4; ++j) acc[i][j] = __builtin_amdgcn_mfma_f32_16x16x32_bf16(bfr[j], af[i], acc[i][j], 0, 0, 0);
  }
  __syncthreads();
  unsigned* Sc = (unsigned*)smem;
#pragma unroll
  for (int i = 0; i < 4; ++i)
#pragma unroll
    for (int j = 0; j < 4; ++j) {
      int m = wm * 64 + i * 16 + fr; int n0 = wn * 64 + j * 16 + fq * 4;
#pragma unroll
      for (int e = 0; e < 4; ++e) Sc[(n0 + e) * 128 + (m ^ ((((n0 + e) >> 2) & 1) << 4))] = enc_key(acc[i][j][e], n0 + e);
    }
  __syncthreads();
  {
    const int r = t & 127, half = t >> 7;
    unsigned l[16];
#pragma unroll
    for (int i = 0; i < 16; ++i) l[i] = 0u;
    for (int k = 0; k < 64; ++k) ins16(l, Sc[(half * 64 + k) * 128 + (r ^ (((k >> 2) & 1) << 4))]);
    __syncthreads();
    unsigned* Ls = (unsigned*)smem;
    if (half == 1) {
#pragma unroll
      for (int i = 0; i < 16; ++i) Ls[r * 17 + i] = l[15 - i];
    }
    __syncthreads();
    if (half == 0) {
      unsigned br[16];
#pragma unroll
      for (int i = 0; i < 16; ++i) br[i] = Ls[r * 17 + i];
      merge16(l, br);
      unsigned* o = top1 + ((long)(tm * 128 + r) * 16 + ps) * 16;
#pragma unroll
      for (int i = 0; i < 4; ++i) { u32x4 v; v[0] = l[4*i]; v[1] = l[4*i+1]; v[2] = l[4*i+2]; v[3] = l[4*i+3]; *(u32x4*)(o + 4 * i) = v; }
    }
  }
}
__global__ void __launch_bounds__(256) ok_peer_q_top1(const bf16_t* A, const bf16_t* WqT, const bf16_t* keysb, unsigned* top1, int tiles_m) {
  __shared__ __attribute__((aligned(16))) char smem[P5_LDS_BYTES];
  for (int tile = blockIdx.x; tile < tiles_m * 16; tile += gridDim.x) { peer_q_top1_tile(A, WqT, keysb, top1, tile / 16, tile % 16, smem); __syncthreads(); }
}

#define P6_LDS_BYTES (32 * 128 * 4 * 3)
__device__ __forceinline__ void peer_gather_group(const bf16_t* __restrict__ xn, const unsigned* __restrict__ top1, const bf16_t* __restrict__ ub,
                                                  const bf16_t* __restrict__ vb, const float* __restrict__ modl, float* __restrict__ xs, int grp, char* smem) {
  const int t = tid_opaque(), lane = t & 63, wave = t >> 6;
  int* pe_l = (int*)smem; float* pg_l = (float*)(smem + 32 * 128 * 4); float* pw_l = (float*)(smem + 2 * 32 * 128 * 4);
  {
    int tl = t >> 3, p = t & 7; long row = (long)grp * 32 + tl;
    peer_combine(top1 + (row * 16 + p * 2) * 16, top1 + (row * 16 + p * 2 + 1) * 16, pe_l + tl * 128 + p * 16, pg_l + tl * 128 + p * 16);
  }
  __syncthreads();
  for (int ti = 0; ti < 8; ++ti) {
    const int tl = wave * 8 + ti; const long row = (long)grp * 32 + tl;
    const int* pe = pe_l + tl * 128; float* pw = pw_l + tl * 128;
    u32x4 h0 = *(const u32x4*)(xn + row * DM + lane * 8), h1 = *(const u32x4*)(xn + row * DM + 512 + lane * 8);
    for (int b = 0; b < 16; ++b) {
      u32x4 u0[8], u1[8];
#pragma unroll
      for (int j = 0; j < 8; ++j) { const bf16_t* ur = ub + (long)pe[b * 8 + j] * DM + lane * 8; u0[j] = *(const u32x4*)ur; u1[j] = *(const u32x4*)(ur + 512); }
      float pd[8];
#pragma unroll
      for (int j = 0; j < 8; ++j) {
        float a = 0.f;
#pragma unroll
        for (int e = 0; e < 4; ++e) { a = dot2bf(h0[e], u0[j][e], a); a = dot2bf(h1[e], u1[j][e], a); }
        pd[j] = a;
      }
      float q4[4], q2[2], q1;
#pragma unroll
      for (int j = 0; j < 4; ++j) { bool hi = lane & 1; float keep = hi ? pd[2*j+1] : pd[2*j], send = hi ? pd[2*j] : pd[2*j+1]; q4[j] = keep + __shfl_xor(send, 1); }
#pragma unroll
      for (int j = 0; j < 2; ++j) { bool hi = lane & 2; float keep = hi ? q4[2*j+1] : q4[2*j], send = hi ? q4[2*j] : q4[2*j+1]; q2[j] = keep + __shfl_xor(send, 2); }
      { bool hi = lane & 4; float keep = hi ? q2[1] : q2[0], send = hi ? q2[0] : q2[1]; q1 = keep + __shfl_xor(send, 4); }
      q1 += __shfl_xor(q1, 8); q1 += __shfl_xor(q1, 16); q1 += __shfl_xor(q1, 32);
      if (lane < 8) { int j = lane & 7; pw[b * 8 + j] = q1; }
    }
    {
      float d0 = pw[lane], d1 = pw[64 + lane];
      pw[lane] = pg_l[tl * 128 + lane] * geluf_(d0); pw[64 + lane] = pg_l[tl * 128 + 64 + lane] * geluf_(d1);
    }
    float o[16];
#pragma unroll
    for (int e = 0; e < 16; ++e) o[e] = 0.f;
    for (int b = 0; b < 16; ++b) {
      u32x4 v0[8], v1[8];
#pragma unroll
      for (int j = 0; j < 8; ++j) { const bf16_t* vr = vb + (long)pe[b * 8 + j] * DM + lane * 8; v0[j] = *(const u32x4*)vr; v1[j] = *(const u32x4*)(vr + 512); }
#pragma unroll
      for (int j = 0; j < 8; ++j) {
        float w = pw[b * 8 + j];
#pragma unroll
        for (int e = 0; e < 4; ++e) {
          o[2*e]     += w * __uint_as_float(v0[j][e] << 16); o[2*e+1]     += w * __uint_as_float(v0[j][e] & 0xffff0000u);
          o[8 + 2*e] += w * __uint_as_float(v1[j][e] << 16); o[8 + 2*e+1] += w * __uint_as_float(v1[j][e] & 0xffff0000u);
        }
      }
    }
    {
      int b = row / RB, lr = row % RB; int bb = lr < SEQ ? b : BATCH; const float* g5 = modl + ((long)bb * 6 + 5) * DM;
      float* xr = xs + row * DM;
#pragma unroll
      for (int hf = 0; hf < 2; ++hf) {
        int d = hf * 512 + lane * 8;
        float4 x0 = *(float4*)(xr + d), x1 = *(float4*)(xr + d + 4); float4 g0 = *(const float4*)(g5 + d), g1 = *(const float4*)(g5 + d + 4);
        x0.x += g0.x * o[hf*8+0]; x0.y += g0.y * o[hf*8+1]; x0.z += g0.z * o[hf*8+2]; x0.w += g0.w * o[hf*8+3];
        x1.x += g1.x * o[hf*8+4]; x1.y += g1.y * o[hf*8+5]; x1.z += g1.z * o[hf*8+6]; x1.w += g1.w * o[hf*8+7];
        *(float4*)(xr + d) = x0; *(float4*)(xr + d + 4) = x1;
      }
    }
  }
}
__global__ void __launch_bounds__(256) ok_peer_gather(const bf16_t* xn, const unsigned* top1, const bf16_t* ub, const bf16_t* vb, const float* modl, float* xs, int ngroups) {
  __shared__ __attribute__((aligned(16))) char smem[P6_LDS_BYTES];
  for (int g = blockIdx.x; g < ngroups; g += gridDim.x) { peer_gather_group(xn, top1, ub, vb, modl, xs, g, smem); __syncthreads(); }
}

template <int DQ> struct AttnCfg { static constexpr int KROW = DQ * 2 + 16; static constexpr int VROW = 136; static constexpr int KBYTES = 64 * KROW; static constexpr int LDS = 64 * KROW + 64 * VROW; };
#define ATTN_LDS_BYTES (64 * 208 + 64 * 136)
template <int DQ>
__device__ __forceinline__ void attn_block(const bf16_t* __restrict__ qb, int HQ, const bf16_t* __restrict__ kb, int HK, const bf16_t* __restrict__ vT, int G,
                                           bf16_t* __restrict__ mixall, int ooff, int b, int head, int qt, char* smem) {
  constexpr int KROW = AttnCfg<DQ>::KROW, VROW = 136, NKK = DQ / 16, KCH = DQ / 8;
  constexpr int KLD = (64 * KCH) / 256;
  const int t = tid_opaque(), lane = t & 63, wave = t >> 6, lq = lane & 31, lh = lane >> 5;
  const int hk = head / G;
  char* Ks = smem; char* Vs = smem + 64 * KROW;
  const long qrow = (long)b * RB + qt * 128 + wave * 32 + lq;
  bf16x8 qf[NKK];
#pragma unroll
  for (int kk = 0; kk < NKK; ++kk) qf[kk] = *(const bf16x8*)(qb + (qrow * HQ + head) * DQ + kk * 16 + lh * 8);
  const int key0 = qt < 16 ? 0 : SEQ; const int nt = qt < 16 ? RB / 64 : CTX_LEN / 64;
  const bf16_t* kbase = kb + ((long)b * RB * HK + hk) * DQ; const bf16_t* vbase = vT + ((long)(b * HK + hk) * 64) * RB;
  u32x4 rk[KLD], rv[2];
  auto issue = [&](int tile) {
    int k0 = key0 + tile * 64;
#pragma unroll
    for (int i = 0; i < KLD; ++i) { int c = t + 256 * i; int r = c / KCH, cc = c % KCH; rk[i] = *(const u32x4*)(kbase + (long)(k0 + r) * HK * DQ + cc * 8); }
#pragma unroll
    for (int i = 0; i < 2; ++i) { int c = t + 256 * i; int r = c >> 3, cc = c & 7; rv[i] = *(const u32x4*)(vbase + (long)r * RB + k0 + cc * 8); }
  };
  issue(0);
  f32x16 ot[2];
#pragma unroll
  for (int d = 0; d < 2; ++d)
#pragma unroll
    for (int r = 0; r < 16; ++r) ot[d][r] = 0.f;
  float mrun = -1e30f, lrun = 0.f;
  for (int tile = 0; tile < nt; ++tile) {
    __syncthreads();
#pragma unroll
    for (int i = 0; i < KLD; ++i) { int c = t + 256 * i; int r = c / KCH, cc = c % KCH; *(u32x4*)(Ks + r * KROW + cc * 16) = rk[i]; }
#pragma unroll
    for (int i = 0; i < 2; ++i) { int c = t + 256 * i; int r = c >> 3, cc = c & 7; *(uint2*)(Vs + r * VROW + cc * 16) = make_uint2(rv[i][0], rv[i][1]); *(uint2*)(Vs + r * VROW + cc * 16 + 8) = make_uint2(rv[i][2], rv[i][3]); }
    __syncthreads();
    if (tile + 1 < nt) issue(tile + 1);
    f32x16 st[2];
#pragma unroll
    for (int kt = 0; kt < 2; ++kt) {
#pragma unroll
      for (int r = 0; r < 16; ++r) st[kt][r] = 0.f;
#pragma unroll
      for (int kk = 0; kk < NKK; ++kk) {
        bf16x8 ka = *(const bf16x8*)(Ks + (kt * 32 + lq) * KROW + kk * 32 + lh * 16);
        st[kt] = __builtin_amdgcn_mfma_f32_32x32x16_bf16(ka, qf[kk], st[kt], 0, 0, 0);
      }
    }
    float mt = st[0][0];
#pragma unroll
    for (int kt = 0; kt < 2; ++kt)
#pragma unroll
      for (int r = 0; r < 16; ++r) mt = fmaxf(mt, st[kt][r]);
    mt = fmaxf(mt, __shfl_xor(mt, 32));
    float mnew = fmaxf(mrun, mt); float alpha = __builtin_amdgcn_exp2f(mrun - mnew); mrun = mnew;
    float ps = 0.f;
#pragma unroll
    for (int kt = 0; kt < 2; ++kt)
#pragma unroll
      for (int r = 0; r < 16; ++r) { float p = __builtin_amdgcn_exp2f(st[kt][r] - mnew); st[kt][r] = p; ps += p; }
    lrun = lrun * alpha + ps;
#pragma unroll
    for (int d = 0; d < 2; ++d)
#pragma unroll
      for (int r = 0; r < 16; ++r) ot[d][r] *= alpha;
#pragma unroll
    for (int kt = 0; kt < 2; ++kt)
#pragma unroll
      for (int s = 0; s < 2; ++s) {
        union { bf16x8 v; unsigned u[4]; } pb;
#pragma unroll
        for (int j = 0; j < 4; ++j) pb.u[j] = pack2bf(st[kt][8 * s + 2 * j], st[kt][8 * s + 2 * j + 1]);
#pragma unroll
        for (int d = 0; d < 2; ++d) {
          const char* vp = Vs + (d * 32 + lq) * VROW + (kt * 32 + 16 * s + 4 * lh) * 2;
          union { bf16x8 v; uint2 h[2]; } va; va.h[0] = *(const uint2*)vp; va.h[1] = *(const uint2*)(vp + 16);
          ot[d] = __builtin_amdgcn_mfma_f32_32x32x16_bf16(va.v, pb.v, ot[d], 0, 0, 0);
        }
      }
  }
  float ltot = lrun + __shfl_xor(lrun, 32); float inv = 1.f / ltot;
  bf16_t* orow = mixall + qrow * DM + ooff + head * 64;
#pragma unroll
  for (int d = 0; d < 2; ++d)
#pragma unroll
    for (int g = 0; g < 4; ++g) {
      uint2 pk; pk.x = pack2bf(ot[d][4 * g] * inv, ot[d][4 * g + 1] * inv); pk.y = pack2bf(ot[d][4 * g + 2] * inv, ot[d][4 * g + 3] * inv);
      *(uint2*)(orow + d * 32 + 8 * g + 4 * lh) = pk;
    }
}
__global__ void __launch_bounds__(256) ok_attn(const bf16_t* mq, const bf16_t* mk, const bf16_t* mvT, const bf16_t* gq, const bf16_t* gk, const bf16_t* gvT, bf16_t* mixall, int nqt) {
  __shared__ __attribute__((aligned(16))) char smem[ATTN_LDS_BYTES];
  const int n_mla = BATCH * 4 * nqt, n_gqa = BATCH * 6 * nqt;
  for (int w = blockIdx.x; w < n_mla + n_gqa; w += gridDim.x) {
    if (w < n_mla) { int qt = w % nqt, head = (w / nqt) % 4, b = w / (nqt * 4); attn_block<96>(mq, 4, mk, 4, mvT, 1, mixall, 0, b, head, qt, smem); }
    else { int v = w - n_mla; int qt = v % nqt, head = (v / nqt) % 6, b = v / (nqt * 6); attn_block<64>(gq, 6, gk, 2, gvT, 3, mixall, 640, b, head, qt, smem); }
    __syncthreads();
  }
}
__global__ void ok_adapt_rows(const float* src, int sld, int scol, int ncols, float scale, bf16_t* dst, int dld, int nrows) {
  long i = (long)blockIdx.x * blockDim.x + threadIdx.x; if (i >= (long)nrows * ncols) return;
  int c = i % ncols; long r = i / ncols; dst[r * dld + c] = f2bf(src[r * sld + scol + c] * scale);
}
__global__ void ok_adapt_vT(const float* src, int sld, int scol, int hstride, int H, bf16_t* dst) {
  long i = (long)blockIdx.x * blockDim.x + threadIdx.x; if (i >= (long)H * 64 * RB) return;
  int lr = i % RB; int d = (i / RB) % 64; int h = i / ((long)RB * 64);
  dst[i] = f2bf(src[(long)lr * sld + scol + h * hstride + d]);
}

typedef __attribute__((ext_vector_type(2))) float f32x2;
#define SCAN_TS 16
#define SCAN_LDS_BYTES (2 * SCAN_TS * 1536 + 2 * SCAN_TS * 32 * 4)
template <int CTRL> __device__ __forceinline__ float dpp_get(float x) { return __builtin_bit_cast(float, __builtin_amdgcn_update_dpp(0, __builtin_bit_cast(int, x), CTRL, 0xf, 0xf, true)); }
__device__ __forceinline__ float swz_xor4(float x) { return __builtin_bit_cast(float, __builtin_amdgcn_ds_swizzle(__builtin_bit_cast(int, x), 0x101F)); }
__device__ __forceinline__ float reduce8(float x) {
  x += __builtin_bit_cast(float, __builtin_amdgcn_update_dpp(0, __builtin_bit_cast(int, x), 0xB1, 0xf, 0xf, true));
  x += __builtin_bit_cast(float, __builtin_amdgcn_update_dpp(0, __builtin_bit_cast(int, x), 0x4E, 0xf, 0xf, true));
  x += __builtin_bit_cast(float, __builtin_amdgcn_update_dpp(0, __builtin_bit_cast(int, x), 0x141, 0xf, 0xf, true));
  return x;
}
__device__ __forceinline__ int scan_row(int dir, int s) {
  if (s < CTX_LEN) return SEQ + (dir == 0 ? s : CTX_LEN - 1 - s);
  return dir == 0 ? s - CTX_LEN : SEQ - 1 - (s - CTX_LEN);
}
__device__ __forceinline__ void rw_scan_block(const bf16_t* __restrict__ r_, const bf16_t* __restrict__ v_, const bf16_t* __restrict__ kk_, const bf16_t* __restrict__ kd_,
                                              const bf16_t* __restrict__ bd_, const float* __restrict__ w_, float* __restrict__ y_, int item, long dstride, char* smem) {
  const int t = tid_opaque(), lane = t & 63, wave = t >> 6, cg = lane & 7, il = wave * 8 + (lane >> 3);
  const int half = item & 1, dir = (item >> 1) & 1, h = (item >> 2) % 6, b = item / 24;
  const long rowbase = (long)b * RB; const int col0 = h * 64;
  float* ybuf = (float*)(smem + 2 * SCAN_TS * 1536);
  const int st_ld = t >> 4, part = t & 15;
  u32x4 la, lb, lc, lw;
  auto issue = [&](int c) {
    long row = rowbase + scan_row(dir, c * SCAN_TS + st_ld); long o = row * 384 + col0;
    const int ch = (part & 7) * 8;
    la = *(const u32x4*)((part < 8 ? kk_ + o : bd_ + dir * dstride + o) + ch);
    lb = *(const u32x4*)((part < 8 ? kd_ + dir * dstride + o : r_ + o) + ch);
    lc = *(const u32x4*)(v_ + o + ch);
    lw = *(const u32x4*)(w_ + dir * dstride + o + part * 4);
  };
  auto stash = [&](int buf) {
    float* base = (float*)(smem + buf * SCAN_TS * 1536 + st_ld * 1536);
    const int ch = (part & 7) * 8;
    float* pa = base + (part < 8 ? 64 : 128) + ch; float* pb = base + (part < 8 ? 192 : 256) + ch;
    f32x4 x0, x1;
#pragma unroll
    for (int e = 0; e < 2; ++e) { x0[2*e] = __uint_as_float(la[e] << 16); x0[2*e+1] = __uint_as_float(la[e] & 0xffff0000u); x1[2*e] = __uint_as_float(la[2+e] << 16); x1[2*e+1] = __uint_as_float(la[2+e] & 0xffff0000u); }
    *(f32x4*)pa = x0; *(f32x4*)(pa + 4) = x1;
#pragma unroll
    for (int e = 0; e < 2; ++e) { x0[2*e] = __uint_as_float(lb[e] << 16); x0[2*e+1] = __uint_as_float(lb[e] & 0xffff0000u); x1[2*e] = __uint_as_float(lb[2+e] << 16); x1[2*e+1] = __uint_as_float(lb[2+e] & 0xffff0000u); }
    *(f32x4*)pb = x0; *(f32x4*)(pb + 4) = x1;
    if (part < 8) {
      float* pc = base + 320 + ch;
#pragma unroll
      for (int e = 0; e < 2; ++e) { x0[2*e] = __uint_as_float(lc[e] << 16); x0[2*e+1] = __uint_as_float(lc[e] & 0xffff0000u); x1[2*e] = __uint_as_float(lc[2+e] << 16); x1[2*e+1] = __uint_as_float(lc[2+e] & 0xffff0000u); }
      *(f32x4*)pc = x0; *(f32x4*)(pc + 4) = x1;
    }
    *(u32x4*)(base + part * 4) = lw;
  };
  f32x2 S[4];
#pragma unroll
  for (int j = 0; j < 4; ++j) S[j] = (f32x2){0.f, 0.f};
  const int NCH = RB / SCAN_TS;
  __builtin_amdgcn_s_setprio(3);
  issue(0);
  for (int c = 0; c < NCH; ++c) {
    const int buf = c & 1;
    stash(buf);
    __syncthreads();
    if (c > 0 && t < 128) {
      int st = t >> 3, i4 = (t & 7) * 4; long row = rowbase + scan_row(dir, (c - 1) * SCAN_TS + st);
      *(f32x4*)(y_ + dir * dstride + row * 384 + col0 + half * 32 + i4) = *(const f32x4*)(ybuf + (buf ^ 1) * SCAN_TS * 32 + st * 32 + i4);
    }
    if (c + 1 < NCH) issue(c + 1);
    const float* ob = (const float*)(smem + buf * SCAN_TS * 1536) + cg * 8;
    const float* vb_ = (const float*)(smem + buf * SCAN_TS * 1536) + 320 + half * 32 + il;
    float yk[SCAN_TS];
    f32x4 nw0 = *(const f32x4*)(ob), nw1 = *(const f32x4*)(ob + 4), nk0 = *(const f32x4*)(ob + 64), nk1 = *(const f32x4*)(ob + 68);
    f32x4 nb0 = *(const f32x4*)(ob + 128), nb1 = *(const f32x4*)(ob + 132), nd0 = *(const f32x4*)(ob + 192), nd1 = *(const f32x4*)(ob + 196);
    f32x4 nr0 = *(const f32x4*)(ob + 256), nr1 = *(const f32x4*)(ob + 260); float nvi = vb_[0];
#pragma unroll
    for (int st = 0; st < SCAN_TS; ++st) {
      const f32x4 w0 = nw0, w1 = nw1, k0 = nk0, k1 = nk1, b0 = nb0, b1 = nb1, d0 = nd0, d1 = nd1, r0 = nr0, r1 = nr1; const float vi = nvi;
      if (st + 1 < SCAN_TS) {
        const float* o = ob + (st + 1) * 384;
        nw0 = *(const f32x4*)(o); nw1 = *(const f32x4*)(o + 4); nk0 = *(const f32x4*)(o + 64); nk1 = *(const f32x4*)(o + 68);
        nb0 = *(const f32x4*)(o + 128); nb1 = *(const f32x4*)(o + 132); nd0 = *(const f32x4*)(o + 192); nd1 = *(const f32x4*)(o + 196);
        nr0 = *(const f32x4*)(o + 256); nr1 = *(const f32x4*)(o + 260); nvi = vb_[(st + 1) * 384];
      }
      __builtin_amdgcn_sched_barrier(0);
      f32x2 a2 = S[0] * (f32x2){k0[0], k0[1]}, c2 = S[2] * (f32x2){k1[0], k1[1]};
      a2 += S[1] * (f32x2){k0[2], k0[3]}; c2 += S[3] * (f32x2){k1[2], k1[3]};
      a2 += c2;
      const f32x2 vv = (f32x2){vi, vi};
      f32x2 t0 = vv * (f32x2){d0[0], d0[1]}, t1 = vv * (f32x2){d0[2], d0[3]}, t2 = vv * (f32x2){d1[0], d1[1]}, t3 = vv * (f32x2){d1[2], d1[3]};
      float skk = reduce8(a2[0] + a2[1]);
      const f32x2 ns = (f32x2){-skk, -skk};
      t0 += ns * (f32x2){b0[0], b0[1]}; t1 += ns * (f32x2){b0[2], b0[3]}; t2 += ns * (f32x2){b1[0], b1[1]}; t3 += ns * (f32x2){b1[2], b1[3]};
      S[0] = S[0] * (f32x2){w0[0], w0[1]} + t0; S[1] = S[1] * (f32x2){w0[2], w0[3]} + t1; S[2] = S[2] * (f32x2){w1[0], w1[1]} + t2; S[3] = S[3] * (f32x2){w1[2], w1[3]} + t3;
      f32x2 y2 = S[0] * (f32x2){r0[0], r0[1]}, z2 = S[2] * (f32x2){r1[0], r1[1]};
      y2 += S[1] * (f32x2){r0[2], r0[3]}; z2 += S[3] * (f32x2){r1[2], r1[3]};
      y2 += z2;
      yk[st] = y2[0] + y2[1];
      __builtin_amdgcn_sched_barrier(0);
    }
#pragma unroll
    for (int g = 0; g < 2; ++g) {
      float q4[4], q2[2], q1;
#pragma unroll
      for (int j = 0; j < 4; ++j) { bool hi = cg & 1; float keep = hi ? yk[g*8 + 2*j+1] : yk[g*8 + 2*j], send = hi ? yk[g*8 + 2*j] : yk[g*8 + 2*j+1]; q4[j] = keep + dpp_get<0xB1>(send); }
#pragma unroll
      for (int j = 0; j < 2; ++j) { bool hi = cg & 2; float keep = hi ? q4[2*j+1] : q4[2*j], send = hi ? q4[2*j] : q4[2*j+1]; q2[j] = keep + dpp_get<0x4E>(send); }
      { bool hi = cg & 4; float keep = hi ? q2[1] : q2[0], send = hi ? q2[0] : q2[1]; q1 = keep + swz_xor4(send); }
      ybuf[buf * SCAN_TS * 32 + (g * 8 + cg) * 32 + il] = q1;
    }
  }
  __builtin_amdgcn_s_setprio(0);
  __syncthreads();
  if (t < 128) {
    int st = t >> 3, i4 = (t & 7) * 4; long row = rowbase + scan_row(dir, (NCH - 1) * SCAN_TS + st);
    *(f32x4*)(y_ + dir * dstride + row * 384 + col0 + half * 32 + i4) = *(const f32x4*)(ybuf + ((NCH - 1) & 1) * SCAN_TS * 32 + st * 32 + i4);
  }
}
__global__ void __launch_bounds__(256) ok_rw_scan(const bf16_t* r_, const bf16_t* v_, const bf16_t* kk_, const bf16_t* kd_, const bf16_t* bd_, const float* w_, float* y_, int item0, int nitems, long dstride) {
  __shared__ __attribute__((aligned(16))) char smem[SCAN_LDS_BYTES];
  for (int it = item0 + blockIdx.x; it < item0 + nitems; it += gridDim.x) { rw_scan_block(r_, v_, kk_, kd_, bd_, w_, y_, it, dstride, smem); __syncthreads(); }
}
__global__ void ok_copy_rows_f32(const float* src, int sld, int scol, int ncols, float* dst, int dld, int nrows) {
  long i = (long)blockIdx.x * blockDim.x + threadIdx.x; if (i >= (long)nrows * ncols) return;
  int c = i % ncols; long r = i / ncols; dst[r * dld + c] = src[r * sld + scol + c];
}

__global__ void ok_cvt_wT_g(const float* W, const float* g, bf16_t* Wt, int K, int N, int Kpad) {
  long i = (long)blockIdx.x * blockDim.x + threadIdx.x;
  if (i >= (long)N * Kpad) return;
  int k = i % Kpad; int n = i / Kpad;
  Wt[i] = k < K ? f2bf(W[(long)k * N + n] * (g ? g[k] : 1.f)) : (bf16_t)0;
}
struct ALoadShift { const bf16_t* P; const float* mu; int col0; int mucol0; int act; int kvalid;
  __device__ __forceinline__ u32x4 operator()(int row, int k) const {
    u32x4 z = {0u, 0u, 0u, 0u};
    if (k >= kvalid) return z;
    int lr = row % RB; bool first = (lr == 0) || (lr == SEQ), last = (lr == SEQ - 1) || (lr == RB - 1);
    const bf16_t* p = P + (long)row * IN_COLS + col0 + k;
    u32x4 c = *(const u32x4*)p; u32x4 pv = first ? z : *(const u32x4*)(p - IN_COLS); u32x4 nx = last ? z : *(const u32x4*)(p + IN_COLS);
    const float* m0 = mu + mucol0 + k; const float* m1 = m0 + RWC;
    u32x4 o;
#pragma unroll
    for (int e = 0; e < 4; ++e) {
      float c0 = __uint_as_float(c[e] << 16), c1 = __uint_as_float(c[e] & 0xffff0000u);
      float p0 = __uint_as_float(pv[e] << 16), p1 = __uint_as_float(pv[e] & 0xffff0000u);
      float n0 = __uint_as_float(nx[e] << 16), n1 = __uint_as_float(nx[e] & 0xffff0000u);
      float x0 = c0 + m0[2*e] * (p0 - c0) + m1[2*e] * (n0 - c0), x1 = c1 + m0[2*e+1] * (p1 - c1) + m1[2*e+1] * (n1 - c1);
      if (act == 1) { x0 = tanhf(x0); x1 = tanhf(x1); } else if (act == 2) { x0 = sigmoidf_(x0); x1 = sigmoidf_(x1); }
      o[e] = pack2bf(x0, x1);
    }
    return o;
  } };
struct EpiDecay { float* w; const float* w0; int pad0; int pad1;
  __device__ __forceinline__ void operator()(int m, int n0, f32x4 v) const {
    f32x4 o;
#pragma unroll
    for (int e = 0; e < 4; ++e) o[e] = expf(-expf(-softplusf_(-(w0[n0 + e] + v[e])) - 0.5f));
    *(f32x4*)(w + (long)m * 384 + n0) = o; } };
struct EpiSigA { bf16_t* a; const float* a0;
  __device__ __forceinline__ void operator()(int m, int n0, f32x4 v) const {
    uint2 pk; pk.x = pack2bf(sigmoidf_(a0[n0] + v[0]), sigmoidf_(a0[n0+1] + v[1])); pk.y = pack2bf(sigmoidf_(a0[n0+2] + v[2]), sigmoidf_(a0[n0+3] + v[3]));
    *(uint2*)(a + (long)m * 384 + n0) = pk; } };

struct PrepW { const bf16_t *wqbT, *wkvbT, *w2T, *a2T, *g2T; const float *mu, *w0, *a0; };
struct PrepBuf { const bf16_t* P; bf16_t *tq, *tkv, *a_b, *g_b; float* w_f; };
__device__ __forceinline__ void prep_gemm_tile(const PrepW& W, const PrepBuf& B, int tm, int ct, char* smem) {
  const long MA = NROWS;
  if (ct < 3) gemm_tile_128(ALoadPlain{B.P, IN_COLS}, W.wqbT, 256, 256, tm, ct, smem, EpiStoreBf16{B.tq, 384, 384});
  else if (ct < 7) gemm_tile_128(ALoadPlain{B.P + 256, IN_COLS}, W.wkvbT, 128, 128, tm, ct - 3, smem, EpiStoreBf16{B.tkv, 512, 512});
  else if (ct < 13) { int d = (ct - 7) / 3, tn = (ct - 7) % 3;
    gemm_tile_128(ALoadShift{B.P, W.mu, RW_OFF + 1152 + d * 64, 1152 + d * 64, 1, 64}, W.w2T + d * 384 * 64, 64, 64, tm, tn, smem, EpiDecay{B.w_f + d * MA * 384, W.w0 + d * 384, 0, 0}); }
  else if (ct < 19) { int d = (ct - 13) / 3, tn = (ct - 13) % 3;
    gemm_tile_128(ALoadShift{B.P, W.mu, RW_OFF + 1280 + d * 64, 1280 + d * 64, 0, 64}, W.a2T + d * 384 * 64, 64, 64, tm, tn, smem, EpiSigA{B.a_b + d * MA * 384, W.a0 + d * 384}); }
  else gemm_tile_128(ALoadShift{B.P, W.mu, RW_OFF + 1408, 1408, 2, 160}, W.g2T, 192, 192, tm, ct - 19, smem, EpiStoreBf16{B.g_b, 384, 384});
}
__global__ void __launch_bounds__(256) ok_prep_gemm(PrepW W, PrepBuf B) {
  __shared__ __attribute__((aligned(16))) char smem[GEMM_LDS_BYTES];
  for (int tile = blockIdx.x; tile < (NROWS / 128) * 22; tile += gridDim.x) prep_gemm_tile(W, B, tile / 22, tile % 22, smem);
}

__device__ __forceinline__ float wave_sum(float x) {
#pragma unroll
  for (int o = 32; o > 0; o >>= 1) x += __shfl_xor(x, o);
  return x;
}
__device__ __forceinline__ float ldbf(const bf16_t* p) { return bf2f(*p); }
struct FinW { const float *mla_qk_g, *gqa_qk_g, *mu, *k_k, *k_a; };
struct FinBuf { const bf16_t *P, *tq, *tkv, *a_b; bf16_t *mq, *mk, *mvT, *gq, *gk, *gvT, *r_b, *v_b, *kk_b, *kd_b, *bd_b; };
#define FIN_LDS_BYTES (384 * 132)
__device__ __forceinline__ void prep_finish_tile(const FinW& W, const FinBuf& B, int tile, char* smem) {
  const int t = tid_opaque(), lane = t & 63, wave = t >> 6; const long MA = NROWS;
  bf16_t* vbuf = (bf16_t*)smem;
  const long row0 = (long)tile * 64; const int b = row0 / RB; const int lr0 = row0 % RB;
  for (int it = 0; it < 16; ++it) {
    const int rl = it * 4 + wave; const long row = row0 + rl; const int lr = lr0 + rl; const bool lat = lr < SEQ;
    const bf16_t* Pr = B.P + row * IN_COLS;
    float sq = 0.f;
#pragma unroll
    for (int i = 0; i < 4; ++i) { float x = ldbf(Pr + i * 64 + lane); sq += x * x; }
    float skv = 0.f;
#pragma unroll
    for (int i = 0; i < 2; ++i) { float x = ldbf(Pr + 256 + i * 64 + lane); skv += x * x; }
    const float cq = 1.f / sqrtf(wave_sum(sq) / 256.f + EPSN), ckv = 1.f / sqrtf(wave_sum(skv) / 128.f + EPSN);
    const float krope = lane < 32 ? ldbf(Pr + 384 + lane) : 0.f;
    float cs_m = 1.f, sn_m = 0.f;
    { int j = lane & 15; int pos = j < 8 ? lr / 64 : lr % 64; float ang = (float)pos * powf(10000.f, -(float)(j & 7) / 8.f); if (lat) { cs_m = cosf(ang); sn_m = sinf(ang); } }
    const float* gq_ = W.mla_qk_g; const float* gk_ = W.mla_qk_g + 96;
#pragma unroll
    for (int h = 0; h < 4; ++h) {
      float qa = cq * ldbf(B.tq + row * 384 + h * 96 + lane); float qb = lane < 32 ? cq * ldbf(B.tq + row * 384 + h * 96 + 64 + lane) : 0.f;
      float inv = 1.f / sqrtf(wave_sum(qa * qa + qb * qb) / 96.f + EPSN);
      qa *= inv * gq_[lane]; qb *= inv * (lane < 32 ? gq_[64 + lane] : 0.f);
      { float other = __shfl_xor(qb, 16); float rr = (lane & 16) ? (other * sn_m + qb * cs_m) : (qb * cs_m - other * sn_m); qb = rr; }
      const float qs = 0.14724445f;
      B.mq[row * 384 + h * 96 + lane] = f2bf(qa * qs); if (lane < 32) B.mq[row * 384 + h * 96 + 64 + lane] = f2bf(qb * qs);
      float ka = ckv * ldbf(B.tkv + row * 512 + h * 128 + lane); float kb = krope;
      float invk = 1.f / sqrtf(wave_sum(ka * ka + kb * kb) / 96.f + EPSN);
      ka *= invk * gk_[lane]; kb *= invk * (lane < 32 ? gk_[64 + lane] : 0.f);
      { float other = __shfl_xor(kb, 16); float rr = (lane & 16) ? (other * sn_m + kb * cs_m) : (kb * cs_m - other * sn_m); kb = rr; }
      B.mk[row * 384 + h * 96 + lane] = f2bf(ka); if (lane < 32) B.mk[row * 384 + h * 96 + 64 + lane] = f2bf(kb);
      vbuf[(h * 64 + lane) * 66 + rl] = f2bf(ckv * ldbf(B.tkv + row * 512 + h * 128 + 64 + lane));
    }
    float cs_g = 1.f, sn_g = 0.f;
    { int j = lane & 31; int pos = j < 16 ? lr / 64 : lr % 64; float ang = (float)pos * powf(10000.f, -(float)(j & 15) / 16.f); if (lat) { cs_g = cosf(ang); sn_g = sinf(ang); } }
#pragma unroll
    for (int h = 0; h < 8; ++h) {
      float x = ldbf(Pr + GQA_OFF + h * 64 + lane);
      float inv = 1.f / sqrtf(wave_sum(x * x) / 64.f + EPSN);
      x *= inv * W.gqa_qk_g[(h < 6 ? 0 : 64) + lane];
      float other = __shfl_xor(x, 32); float rr = (lane & 32) ? (other * sn_g + x * cs_g) : (x * cs_g - other * sn_g);
      if (h < 6) B.gq[row * 384 + h * 64 + lane] = f2bf(rr * 0.18033688f); else B.gk[row * 128 + (h - 6) * 64 + lane] = f2bf(rr);
    }
#pragma unroll
    for (int hk = 0; hk < 2; ++hk) vbuf[((4 + hk) * 64 + lane) * 66 + rl] = Pr[GQA_OFF + 512 + hk * 64 + lane];
    const bool first = (lr == 0) || (lr == SEQ), last = (lr == SEQ - 1) || (lr == RB - 1);
#pragma unroll
    for (int h = 0; h < 6; ++h) {
      float xs3[3];
#pragma unroll
      for (int part = 0; part < 3; ++part) {
        int c = part * 384 + h * 64 + lane; const bf16_t* pp = Pr + RW_OFF + c;
        float p = ldbf(pp), pv = first ? 0.f : ldbf(pp - IN_COLS), nx = last ? 0.f : ldbf(pp + IN_COLS);
        xs3[part] = p + W.mu[c] * (pv - p) + W.mu[RWC + c] * (nx - p);
      }
      const int c = h * 64 + lane; const long o = row * 384 + c;
      float kv = xs3[1]; float tk = kv * W.k_k[c]; float kkv = tk / sqrtf(wave_sum(tk * tk) + 1e-12f);
      B.r_b[o] = f2bf(xs3[0]); B.v_b[o] = f2bf(xs3[2]); B.kk_b[o] = f2bf(kkv);
#pragma unroll
      for (int d = 0; d < 2; ++d) { float a = ldbf(B.a_b + d * MA * 384 + o); B.kd_b[d * MA * 384 + o] = f2bf(kv * (1.f + (a - 1.f) * W.k_a[c])); B.bd_b[d * MA * 384 + o] = f2bf(kkv * a); }
    }
  }
  __syncthreads();
  for (int i = t; i < 384 * 32; i += 256) {
    int rr = i >> 5, w2 = i & 31; int slot = rr >> 6, d = rr & 63;
    unsigned val = *(const unsigned*)(vbuf + rr * 66 + w2 * 2);
    bf16_t* dst = slot < 4 ? B.mvT + ((long)(b * 4 + slot) * 64 + d) * RB : B.gvT + ((long)(b * 2 + (slot - 4)) * 64 + d) * RB;
    *(unsigned*)(dst + lr0 + w2 * 2) = val;
  }
  __syncthreads();
}
__global__ void __launch_bounds__(256) ok_prep_finish(FinW W, FinBuf B) {
  __shared__ __attribute__((aligned(16))) char smem[FIN_LDS_BYTES];
  for (int tile = blockIdx.x; tile < NROWS / 64; tile += gridDim.x) prep_finish_tile(W, B, tile, smem);
}
struct RdW { const float *r_k, *ln_g, *ln_b; };
__device__ __forceinline__ void rw_readout_row(const RdW& W, const float* __restrict__ y, const bf16_t* __restrict__ r_b, const bf16_t* __restrict__ v_b, const bf16_t* __restrict__ kd_b,
                                               const bf16_t* __restrict__ g_b, bf16_t* __restrict__ mixall, long row, int lane) {
  const long MA = NROWS;
#pragma unroll
  for (int h = 0; h < 6; ++h) {
    const int c = h * 64 + lane; const long o = row * 384 + c;
    float yy = y[o] + y[MA * 384 + o];
    float mean = wave_sum(yy) * (1.f / 64.f); float dv = yy - mean; float var = wave_sum(dv * dv) * (1.f / 64.f);
    float coef = wave_sum(ldbf(r_b + o) * (ldbf(kd_b + o) + ldbf(kd_b + MA * 384 + o)) * W.r_k[c]);
    float yn = dv / sqrtf(var + 64e-5f) * W.ln_g[c] + W.ln_b[c];
    mixall[row * DM + 256 + c] = f2bf((yn + coef * ldbf(v_b + o)) * ldbf(g_b + o));
  }
}
__global__ void __launch_bounds__(256) ok_rw_readout(RdW W, const float* y, const bf16_t* r_b, const bf16_t* v_b, const bf16_t* kd_b, const bf16_t* g_b, bf16_t* mixall) {
  for (long row = blockIdx.x * 4 + (threadIdx.x >> 6); row < NROWS; row += gridDim.x * 4) rw_readout_row(W, y, r_b, v_b, kd_b, g_b, mixall, row, threadIdx.x & 63);
}

__device__ __forceinline__ void ph_cvt_fp8_rows(const float* __restrict__ tab, unsigned char* __restrict__ q, float* __restrict__ scale) {
  const int t = tid_opaque(); const int lane = t & 63;
  for (int row = blockIdx.x * 4 + (t >> 6); row < 16384; row += gridDim.x * 4) {
    const float* src = tab + (long)row * DM + lane * 16;
    f32x4 a[4]; float m = 0.f;
#pragma unroll
    for (int i = 0; i < 4; ++i) { a[i] = *(const f32x4*)(src + 4 * i); m = fmaxf(m, fmaxf(fmaxf(fabsf(a[i][0]), fabsf(a[i][1])), fmaxf(fabsf(a[i][2]), fabsf(a[i][3])))); }
#pragma unroll
    for (int o = 32; o > 0; o >>= 1) m = fmaxf(m, __shfl_xor(m, o));
    const float sc = m > 0.f ? m * (1.f / 440.f) : 1.f; const float inv = 1.f / sc;
    u32x4 p;
#pragma unroll
    for (int i = 0; i < 4; ++i) { int w = __builtin_amdgcn_cvt_pk_fp8_f32(a[i][0] * inv, a[i][1] * inv, 0, false); w = __builtin_amdgcn_cvt_pk_fp8_f32(a[i][2] * inv, a[i][3] * inv, w, true); p[i] = (unsigned)w; }
    *(u32x4*)(q + (long)row * DM + lane * 16) = p;
    if (lane == 0) scale[row] = sc;
  }
}
__device__ __forceinline__ float dot16_fp8(const float (&h)[16], u32x4 q) {
  float a = 0.f;
#pragma unroll
  for (int d = 0; d < 4; ++d) {
    f32v2 lo = __builtin_amdgcn_cvt_pk_f32_fp8((int)q[d], false), hi = __builtin_amdgcn_cvt_pk_f32_fp8((int)q[d], true);
    a += h[4*d] * lo[0]; a += h[4*d+1] * lo[1]; a += h[4*d+2] * hi[0]; a += h[4*d+3] * hi[1];
  }
  return a;
}
__device__ __forceinline__ void axpy16_fp8(float (&o)[16], float w, u32x4 q) {
#pragma unroll
  for (int d = 0; d < 4; ++d) {
    f32v2 lo = __builtin_amdgcn_cvt_pk_f32_fp8((int)q[d], false), hi = __builtin_amdgcn_cvt_pk_f32_fp8((int)q[d], true);
    o[4*d] += w * lo[0]; o[4*d+1] += w * lo[1]; o[4*d+2] += w * hi[0]; o[4*d+3] += w * hi[1];
  }
}
__device__ __forceinline__ void peer_gather_group_fp8(const bf16_t* __restrict__ xn, const unsigned* __restrict__ top1, const unsigned char* __restrict__ ub, const float* __restrict__ su,
                                                      const unsigned char* __restrict__ vb, const float* __restrict__ sv, const float* __restrict__ modl, float* __restrict__ xs, int grp, char* smem) {
  const int t = tid_opaque(), lane = t & 63, wave = t >> 6;
  int* pe_l = (int*)smem; float* pg_l = (float*)(smem + 32 * 128 * 4); float* pw_l = (float*)(smem + 2 * 32 * 128 * 4);
  {
    int tl = t >> 3, p = t & 7; long row = (long)grp * 32 + tl;
    peer_combine(top1 + (row * 16 + p * 2) * 16, top1 + (row * 16 + p * 2 + 1) * 16, pe_l + tl * 128 + p * 16, pg_l + tl * 128 + p * 16);
  }
  __syncthreads();
  for (int ti = 0; ti < 8; ++ti) {
    const int tl = wave * 8 + ti; const long row = (long)grp * 32 + tl;
    const int* pe = pe_l + tl * 128; float* pw = pw_l + tl * 128;
    float h[16];
    { u32x4 h0 = *(const u32x4*)(xn + row * DM + lane * 16), h1 = *(const u32x4*)(xn + row * DM + lane * 16 + 8);
#pragma unroll
      for (int e = 0; e < 4; ++e) { h[2*e] = __uint_as_float(h0[e] << 16); h[2*e+1] = __uint_as_float(h0[e] & 0xffff0000u); h[8+2*e] = __uint_as_float(h1[e] << 16); h[8+2*e+1] = __uint_as_float(h1[e] & 0xffff0000u); } }
    u32x4 u[8];
#pragma unroll
    for (int j = 0; j < 8; ++j) u[j] = *(const u32x4*)(ub + (long)pe[j] * DM + lane * 16);
    for (int b = 0; b < 16; ++b) {
      float pd[8];
#pragma unroll
      for (int j = 0; j < 8; ++j) pd[j] = dot16_fp8(h, u[j]);
      if (b + 1 < 16) {
#pragma unroll
        for (int j = 0; j < 8; ++j) u[j] = *(const u32x4*)(ub + (long)pe[(b + 1) * 8 + j] * DM + lane * 16);
      }
      float q4[4], q2[2], q1;
#pragma unroll
      for (int j = 0; j < 4; ++j) { bool hi = lane & 1; float keep = hi ? pd[2*j+1] : pd[2*j], send = hi ? pd[2*j] : pd[2*j+1]; q4[j] = keep + __shfl_xor(send, 1); }
#pragma unroll
      for (int j = 0; j < 2; ++j) { bool hi = lane & 2; float keep = hi ? q4[2*j+1] : q4[2*j], send = hi ? q4[2*j] : q4[2*j+1]; q2[j] = keep + __shfl_xor(send, 2); }
      { bool hi = lane & 4; float keep = hi ? q2[1] : q2[0], send = hi ? q2[0] : q2[1]; q1 = keep + __shfl_xor(send, 4); }
      q1 += __shfl_xor(q1, 8); q1 += __shfl_xor(q1, 16); q1 += __shfl_xor(q1, 32);
      if (lane < 8) pw[b * 8 + lane] = q1 * su[pe[b * 8 + lane]];
    }
    u32x4 v[8];
#pragma unroll
    for (int j = 0; j < 8; ++j) v[j] = *(const u32x4*)(vb + (long)pe[j] * DM + lane * 16);
    {
      float d0 = pw[lane], d1 = pw[64 + lane];
      pw[lane] = pg_l[tl * 128 + lane] * geluf_(d0) * sv[pe[lane]]; pw[64 + lane] = pg_l[tl * 128 + 64 + lane] * geluf_(d1) * sv[pe[64 + lane]];
    }
    float o[16];
#pragma unroll
    for (int e = 0; e < 16; ++e) o[e] = 0.f;
    for (int b = 0; b < 16; ++b) {
      u32x4 vc[8];
#pragma unroll
      for (int j = 0; j < 8; ++j) vc[j] = v[j];
      if (b + 1 < 16) {
#pragma unroll
        for (int j = 0; j < 8; ++j) v[j] = *(const u32x4*)(vb + (long)pe[(b + 1) * 8 + j] * DM + lane * 16);
      }
#pragma unroll
      for (int j = 0; j < 8; ++j) axpy16_fp8(o, pw[b * 8 + j], vc[j]);
    }
    {
      int b = row / RB, lr = row % RB; int bb = lr < SEQ ? b : BATCH; const float* g5 = modl + ((long)bb * 6 + 5) * DM + lane * 16;
      float* xr = xs + row * DM + lane * 16;
#pragma unroll
      for (int i = 0; i < 4; ++i) {
        f32x4 x = *(f32x4*)(xr + 4 * i); f32x4 g = *(const f32x4*)(g5 + 4 * i);
        x[0] += g[0] * o[4*i]; x[1] += g[1] * o[4*i+1]; x[2] += g[2] * o[4*i+2]; x[3] += g[3] * o[4*i+3];
        *(f32x4*)(xr + 4 * i) = x;
      }
    }
  }
}

__device__ __forceinline__ float reduce16(float x) { x = reduce8(x); x += dpp_get<0x140>(x); return x; }
__device__ __forceinline__ void unpack8(u32x4 v, float (&f)[8]) {
#pragma unroll
  for (int e = 0; e < 4; ++e) { f[2*e] = __uint_as_float(v[e] << 16); f[2*e+1] = __uint_as_float(v[e] & 0xffff0000u); }
}
__device__ __forceinline__ u32x4 pack8(const float (&f)[8]) { u32x4 o;
#pragma unroll
  for (int e = 0; e < 4; ++e) o[e] = pack2bf(f[2*e], f[2*e+1]);
  return o; }
__device__ __forceinline__ void ph_rope_tables(float* rope_g, float* rope_m) {
  const int t = tid_opaque();
  for (int i = blockIdx.x * 256 + t; i < SEQ * 48; i += gridDim.x * 256) {
    int lr = i / 48, j = i % 48;
    if (j < 32) { int pos = j < 16 ? lr / 64 : lr % 64; float ang = (float)pos * powf(10000.f, -(float)(j & 15) / 16.f); rope_g[(lr * 32 + j) * 2] = cosf(ang); rope_g[(lr * 32 + j) * 2 + 1] = sinf(ang); }
    else { int jj = j - 32; int pos = jj < 8 ? lr / 64 : lr % 64; float ang = (float)pos * powf(10000.f, -(float)(jj & 7) / 8.f); rope_m[(lr * 16 + jj) * 2] = cosf(ang); rope_m[(lr * 16 + jj) * 2 + 1] = sinf(ang); }
  }
}
struct FinW2 { const float *mla_qk_g, *gqa_qk_g, *mu, *k_k, *k_a, *rope_g, *rope_m; };
#define FIN2_LDS_BYTES (64 * 384 * 2)
__device__ __forceinline__ void prep_finish_tile2(const FinW2& W, const FinBuf& B, int tile, char* smem) {
  const int t = tid_opaque(), lane = t & 63, wave = t >> 6; const long MA = NROWS;
  bf16_t* vbuf = (bf16_t*)smem;
  const long row0 = (long)tile * 64; const int b = row0 / RB; const int lr0 = row0 % RB;
  const int g8 = lane & 7, h8 = lane >> 3, s16 = lane & 15, h16 = lane >> 4;
  for (int it = 0; it < 16; ++it) {
    const int rl = it * 4 + wave; const long row = row0 + rl; const int lr = lr0 + rl; const bool lat = lr < SEQ;
    const bf16_t* Pr = B.P + row * IN_COLS;
    {
      float x[8]; unpack8(*(const u32x4*)(Pr + GQA_OFF + lane * 8), x);
      float ss = 0.f;
#pragma unroll
      for (int e = 0; e < 8; ++e) ss += x[e] * x[e];
      ss = reduce8(ss); const float inv = 1.f / sqrtf(ss * (1.f / 64.f) + EPSN);
      const float* gp = W.gqa_qk_g + (h8 < 6 ? 0 : 64) + g8 * 8; f32x4 ga = *(const f32x4*)gp, gb = *(const f32x4*)(gp + 4);
#pragma unroll
      for (int e = 0; e < 4; ++e) { x[e] *= inv * ga[e]; x[4 + e] *= inv * gb[e]; }
      float o[8];
      if (lat) {
        const float* rt = W.rope_g + ((long)lr * 32 + (g8 & 3) * 8) * 2;
#pragma unroll
        for (int e = 0; e < 8; ++e) { float ot = swz_xor4(x[e]); float cs = rt[2 * e], sn = rt[2 * e + 1]; o[e] = (g8 & 4) ? (ot * sn + x[e] * cs) : (x[e] * cs - ot * sn); }
      } else {
#pragma unroll
        for (int e = 0; e < 8; ++e) o[e] = x[e];
      }
      if (h8 < 6) {
#pragma unroll
        for (int e = 0; e < 8; ++e) o[e] *= 0.18033688f;
        *(u32x4*)(B.gq + row * 384 + lane * 8) = pack8(o);
      } else *(u32x4*)(B.gk + row * 128 + (lane - 48) * 8) = pack8(o);
    }
    float cq, ckv;
    {
      float ss = 0.f;
      if (lane < 48) { float x[8]; unpack8(*(const u32x4*)(Pr + lane * 8), x);
#pragma unroll
        for (int e = 0; e < 8; ++e) ss += x[e] * x[e]; }
      float sq = wave_sum(lane < 32 ? ss : 0.f), skv = wave_sum(lane >= 32 ? ss : 0.f);
      cq = 1.f / sqrtf(sq * (1.f / 256.f) + EPSN); ckv = 1.f / sqrtf(skv * (1.f / 128.f) + EPSN);
    }
    {
      float cs0 = 1.f, sn0 = 0.f, cs1 = 1.f, sn1 = 0.f;
      if (lat) { f32x4 r4 = *(const f32x4*)(W.rope_m + ((long)lr * 16 + (s16 & 7) * 2) * 2); cs0 = r4[0]; sn0 = r4[1]; cs1 = r4[2]; sn1 = r4[3]; }
      const float kr0 = bf2f(Pr[384 + s16 * 2]), kr1 = bf2f(Pr[384 + s16 * 2 + 1]);
#pragma unroll
      for (int which = 0; which < 2; ++which) {
        float n[4], r0, r1;
        if (which == 0) {
          uint2 a = *(const uint2*)(B.tq + row * 384 + h16 * 96 + s16 * 4); unsigned rr = *(const unsigned*)(B.tq + row * 384 + h16 * 96 + 64 + s16 * 2);
          n[0] = cq * __uint_as_float(a.x << 16); n[1] = cq * __uint_as_float(a.x & 0xffff0000u); n[2] = cq * __uint_as_float(a.y << 16); n[3] = cq * __uint_as_float(a.y & 0xffff0000u);
          r0 = cq * __uint_as_float(rr << 16); r1 = cq * __uint_as_float(rr & 0xffff0000u);
        } else {
          uint2 a = *(const uint2*)(B.tkv + row * 512 + h16 * 128 + s16 * 4);
          n[0] = ckv * __uint_as_float(a.x << 16); n[1] = ckv * __uint_as_float(a.x & 0xffff0000u); n[2] = ckv * __uint_as_float(a.y << 16); n[3] = ckv * __uint_as_float(a.y & 0xffff0000u);
          r0 = kr0; r1 = kr1;
        }
        float ss = n[0]*n[0] + n[1]*n[1] + n[2]*n[2] + n[3]*n[3] + r0*r0 + r1*r1;
        ss = reduce16(ss); const float inv = 1.f / sqrtf(ss * (1.f / 96.f) + EPSN);
        const float* gp = W.mla_qk_g + which * 96; f32x4 gn = *(const f32x4*)(gp + s16 * 4); const float g0 = gp[64 + s16 * 2], g1 = gp[64 + s16 * 2 + 1];
#pragma unroll
        for (int e = 0; e < 4; ++e) n[e] *= inv * gn[e];
        r0 *= inv * g0; r1 *= inv * g1;
        float o0 = dpp_get<0x128>(r0), o1 = dpp_get<0x128>(r1);
        float q0, q1;
        if (s16 & 8) { q0 = o0 * sn0 + r0 * cs0; q1 = o1 * sn1 + r1 * cs1; } else { q0 = r0 * cs0 - o0 * sn0; q1 = r1 * cs1 - o1 * sn1; }
        const float sc = which == 0 ? 0.14724445f : 1.f;
        bf16_t* dst = (which == 0 ? B.mq : B.mk) + row * 384 + h16 * 96;
        uint2 pk; pk.x = pack2bf(n[0] * sc, n[1] * sc); pk.y = pack2bf(n[2] * sc, n[3] * sc);
        *(uint2*)(dst + s16 * 4) = pk; *(unsigned*)(dst + 64 + s16 * 2) = pack2bf(q0 * sc, q1 * sc);
      }
      if (lane < 32) { float x[8]; unpack8(*(const u32x4*)(B.tkv + row * 512 + h8 * 128 + 64 + g8 * 8), x);
#pragma unroll
        for (int e = 0; e < 8; ++e) x[e] *= ckv;
        *(u32x4*)(vbuf + rl * 384 + h8 * 64 + g8 * 8) = pack8(x); }
      else if (lane < 48) *(u32x4*)(vbuf + rl * 384 + 256 + (lane - 32) * 8) = *(const u32x4*)(Pr + GQA_OFF + 512 + (lane - 32) * 8);
    }
    if (lane < 48) {
      const bool first = (lr == 0) || (lr == SEQ), last = (lr == SEQ - 1) || (lr == RB - 1);
      const long o = row * 384 + lane * 8;
      float xs3[3][8];
#pragma unroll
      for (int part = 0; part < 3; ++part) {
        const int c = part * 384 + lane * 8; const bf16_t* pp = Pr + RW_OFF + c;
        float p[8], pv[8], nx[8]; unpack8(*(const u32x4*)pp, p);
        u32x4 z = {0u, 0u, 0u, 0u}; unpack8(first ? z : *(const u32x4*)(pp - IN_COLS), pv); unpack8(last ? z : *(const u32x4*)(pp + IN_COLS), nx);
        f32x4 m0a = *(const f32x4*)(W.mu + c), m0b = *(const f32x4*)(W.mu + c + 4), m1a = *(const f32x4*)(W.mu + RWC + c), m1b = *(const f32x4*)(W.mu + RWC + c + 4);
#pragma unroll
        for (int e = 0; e < 4; ++e) { xs3[part][e] = p[e] + m0a[e] * (pv[e] - p[e]) + m1a[e] * (nx[e] - p[e]); xs3[part][4+e] = p[4+e] + m0b[e] * (pv[4+e] - p[4+e]) + m1b[e] * (nx[4+e] - p[4+e]); }
      }
      *(u32x4*)(B.r_b + o) = pack8(xs3[0]); *(u32x4*)(B.v_b + o) = pack8(xs3[2]);
      f32x4 kka = *(const f32x4*)(W.k_k + lane * 8), kkb = *(const f32x4*)(W.k_k + lane * 8 + 4), kaa = *(const f32x4*)(W.k_a + lane * 8), kab = *(const f32x4*)(W.k_a + lane * 8 + 4);
      float tk[8], ss = 0.f;
#pragma unroll
      for (int e = 0; e < 4; ++e) { tk[e] = xs3[1][e] * kka[e]; tk[4+e] = xs3[1][4+e] * kkb[e]; }
#pragma unroll
      for (int e = 0; e < 8; ++e) ss += tk[e] * tk[e];
      ss = reduce8(ss); const float invk = 1.f / sqrtf(ss + 1e-12f);
#pragma unroll
      for (int e = 0; e < 8; ++e) tk[e] *= invk;
      *(u32x4*)(B.kk_b + o) = pack8(tk);
#pragma unroll
      for (int d = 0; d < 2; ++d) {
        float a[8], kd[8], bd[8]; unpack8(*(const u32x4*)(B.a_b + d * MA * 384 + o), a);
#pragma unroll
        for (int e = 0; e < 8; ++e) { float ka = e < 4 ? kaa[e] : kab[e - 4]; kd[e] = xs3[1][e] * (1.f + (a[e] - 1.f) * ka); bd[e] = tk[e] * a[e]; }
        *(u32x4*)(B.kd_b + d * MA * 384 + o) = pack8(kd); *(u32x4*)(B.bd_b + d * MA * 384 + o) = pack8(bd);
      }
    } else { (void)reduce8(0.f); }
  }
  __syncthreads();
  for (int i = t; i < 384 * 8; i += 256) {
    int c = i % 384, rc = i / 384;
    unsigned short v8[8];
#pragma unroll
    for (int e = 0; e < 8; ++e) v8[e] = vbuf[(rc * 8 + e) * 384 + c];
    u32x4 o; o[0] = v8[0] | ((unsigned)v8[1] << 16); o[1] = v8[2] | ((unsigned)v8[3] << 16); o[2] = v8[4] | ((unsigned)v8[5] << 16); o[3] = v8[6] | ((unsigned)v8[7] << 16);
    bf16_t* dst = c < 256 ? B.mvT + ((long)(b * 4 + (c >> 6)) * 64 + (c & 63)) * RB : B.gvT + ((long)(b * 2 + ((c - 256) >> 6)) * 64 + (c & 63)) * RB;
    *(u32x4*)(dst + lr0 + rc * 8) = o;
  }
  __syncthreads();
}
__device__ __forceinline__ void rw_readout_row2(const RdW& W, const float* __restrict__ y, const bf16_t* __restrict__ r_b, const bf16_t* __restrict__ v_b, const bf16_t* __restrict__ kd_b,
                                                const bf16_t* __restrict__ g_b, bf16_t* __restrict__ mixall, long row, int lane) {
  const long MA = NROWS;
  float yy[8], s = 0.f; float r[8], k0[8], k1[8], vv[8], gg[8];
  const int c = lane * 8; const long o = row * 384 + c;
  if (lane < 48) {
    f32x4 a0 = *(const f32x4*)(y + o), a1 = *(const f32x4*)(y + o + 4), b0 = *(const f32x4*)(y + MA * 384 + o), b1 = *(const f32x4*)(y + MA * 384 + o + 4);
#pragma unroll
    for (int e = 0; e < 4; ++e) { yy[e] = a0[e] + b0[e]; yy[4+e] = a1[e] + b1[e]; }
    unpack8(*(const u32x4*)(r_b + o), r); unpack8(*(const u32x4*)(kd_b + o), k0); unpack8(*(const u32x4*)(kd_b + MA * 384 + o), k1);
    unpack8(*(const u32x4*)(v_b + o), vv); unpack8(*(const u32x4*)(g_b + o), gg);
  } else {
#pragma unroll
    for (int e = 0; e < 8; ++e) { yy[e] = 0.f; r[e] = 0.f; k0[e] = 0.f; k1[e] = 0.f; vv[e] = 0.f; gg[e] = 0.f; }
  }
#pragma unroll
  for (int e = 0; e < 8; ++e) s += yy[e];
  const float mean = reduce8(s) * (1.f / 64.f);
  float vs = 0.f, cf = 0.f;
  const int cc = lane < 48 ? c : 0;
  f32x4 rk0 = *(const f32x4*)(W.r_k + cc), rk1 = *(const f32x4*)(W.r_k + cc + 4);
#pragma unroll
  for (int e = 0; e < 8; ++e) { float d = yy[e] - mean; vs += d * d; cf += r[e] * (k0[e] + k1[e]) * (e < 4 ? rk0[e] : rk1[e - 4]); }
  const float var = reduce8(vs) * (1.f / 64.f), coef = reduce8(cf);
  const float inv = 1.f / sqrtf(var + 64e-5f);
  if (lane < 48) {
    f32x4 lg0 = *(const f32x4*)(W.ln_g + c), lg1 = *(const f32x4*)(W.ln_g + c + 4), lb0 = *(const f32x4*)(W.ln_b + c), lb1 = *(const f32x4*)(W.ln_b + c + 4);
    float out[8];
#pragma unroll
    for (int e = 0; e < 8; ++e) { float yn = (yy[e] - mean) * inv * (e < 4 ? lg0[e] : lg1[e - 4]) + (e < 4 ? lb0[e] : lb1[e - 4]); out[e] = (yn + coef * vv[e]) * gg[e]; }
    *(u32x4*)(mixall + row * DM + 256 + c) = pack8(out);
  }
}
#include <hip/hip_cooperative_groups.h>
namespace cg = cooperative_groups;

#define XB_TMO      128
#define XB_XCNT(j)  (256  + 64 * (j))
#define XB_XSUB(j)  (1280 + 64 * (j))
#define XB_XGEN(j)  (2304 + 64 * (j))
#define XB_TOP      3328
#define XB_TOPGEN   3392
#define XB_QUEUE(i) (3456 + 64 * (i))
#define XCD_BAR_WORDS 4096
#define XB_SPIN_CAP (1u << 22)
#define LAS __attribute__((address_space(3)))
__device__ __forceinline__ unsigned xb_ld(unsigned* p)              { return __hip_atomic_load(p, __ATOMIC_RELAXED, __HIP_MEMORY_SCOPE_AGENT); }
__device__ __forceinline__ unsigned xb_add(unsigned* p, unsigned v) { return __hip_atomic_fetch_add(p, v, __ATOMIC_RELAXED, __HIP_MEMORY_SCOPE_AGENT); }
__device__ __forceinline__ unsigned xb_xcc_id() { return (unsigned)__builtin_amdgcn_s_getreg((3 << 11) | 20) & 0xFu; }
#define XB_SPIN(cond, bar) do { unsigned _sp = 0; while (cond) { __builtin_amdgcn_s_sleep(1); \
    if ((++_sp & 255u) == 0u) { if (xb_ld(&(bar)[XB_TMO])) break; if (_sp > XB_SPIN_CAP) { atomicAdd(&(bar)[XB_TMO], 1u); break; } } } } while (0)
struct XcdBarrier { unsigned* bar; unsigned x; volatile LAS unsigned* st; };
__device__ __forceinline__ XcdBarrier xcd_barrier_post(unsigned* bar, volatile LAS unsigned* st) {
  XcdBarrier b; b.bar = bar; b.x = xb_xcc_id(); b.st = st;
  if (threadIdx.x == 0) (void)xb_add(&bar[XB_XCNT(b.x)], 1u);
  return b;
}
__device__ __forceinline__ void xcd_barrier_complete(unsigned* bar, unsigned x, unsigned& nloc, unsigned& nx) {
  const unsigned G = gridDim.x; unsigned sum, cnt, mine, sp = 0u;
  for (;;) {
    sum = 0u; cnt = 0u; mine = 0u;
#pragma unroll
    for (unsigned j = 0; j < 16; ++j) { const unsigned c = xb_ld(&bar[XB_XCNT(j)]); sum += c; cnt += (c > 0u) ? 1u : 0u; mine = (j == x) ? c : mine; }
    if (sum == G) break;
    __builtin_amdgcn_s_sleep(1);
    if ((++sp & 255u) == 0u) { if (xb_ld(&bar[XB_TMO])) break; if (sp > XB_SPIN_CAP) { atomicAdd(&bar[XB_TMO], 1u); break; } }
  }
  nloc = mine > 0u ? mine : 1u; nx = cnt > 0u ? cnt : 1u;
}
__device__ __forceinline__ void xcd_barrier(const XcdBarrier& b) {
  asm volatile("s_waitcnt vmcnt(0)" ::: "memory");
  __syncthreads();
  if (threadIdx.x == 0) {
    unsigned* bar = b.bar;
    __builtin_amdgcn_s_waitcnt(0);
    unsigned nloc = b.st[0], nx = b.st[1];
    if (nloc == 0u) { xcd_barrier_complete(bar, b.x, nloc, nx); b.st[0] = nloc; b.st[1] = nx; }
    const unsigned old = xb_add(&bar[XB_XSUB(b.x)], 1u);
    const unsigned gen = old / nloc;
    if (old + 1u == (gen + 1u) * nloc) {
      __builtin_amdgcn_fence(__ATOMIC_RELEASE, "agent");
      asm volatile("s_waitcnt vmcnt(0)" ::: "memory");
      const unsigned og = xb_add(&bar[XB_TOP], 1u);
      const unsigned tg = og / nx;
      if (og + 1u == (tg + 1u) * nx) xb_add(&bar[XB_TOPGEN], 1u);
      else XB_SPIN(xb_ld(&bar[XB_TOPGEN]) == tg, bar);
      __builtin_amdgcn_fence(__ATOMIC_ACQUIRE, "agent");
      xb_add(&bar[XB_XGEN(b.x)], 1u);
      asm volatile("s_waitcnt vmcnt(0)" ::: "memory");
    } else {
      XB_SPIN(xb_ld(&bar[XB_XGEN(b.x)]) == gen, bar);
      __builtin_amdgcn_fence(__ATOMIC_ACQUIRE, "agent");
      asm volatile("s_waitcnt vmcnt(0)" ::: "memory");
    }
  }
  __syncthreads();
}


constexpr size_t al256(size_t x) { return (x + 255) & ~(size_t)255; }
struct WsOff { size_t xs, mod, xn, Pb, tq, tkv, a_b, g_b, w_f, mq, mk, mvT, gq, gk, gvT, r_b, v_b, kk_b, kd_b, bd_b, w_inT, w_outT, wqT, keysb, wqbT, wkvbT, w2T, a2T, g2T, rope_g, rope_m, total; };
constexpr WsOff make_wsoff() {
  WsOff o{}; size_t p = 32768; const size_t MA = NROWS;
  o.mod = p; p += al256(2 * (BATCH + 1) * 6144 * 4); o.xs = p; p += al256(MA * DM * 4); o.xn = p; p += al256(MA * DM * 2);
  o.Pb = p; p += al256(MA * IN_COLS * 2);
  o.tq = p; p += al256(MA * 384 * 2); o.tkv = p; p += al256(MA * 512 * 2); o.a_b = p; p += al256(2 * MA * 384 * 2);
  o.g_b = p; p += al256(MA * 384 * 2); o.w_f = p; p += al256(2 * MA * 384 * 4);
  o.mq = p; p += al256(MA * 384 * 2); o.mk = p; p += al256(MA * 384 * 2); o.mvT = p; p += al256((size_t)BATCH * 4 * 64 * RB * 2);
  o.gq = p; p += al256(MA * 384 * 2); o.gk = p; p += al256(MA * 128 * 2); o.gvT = p; p += al256((size_t)BATCH * 2 * 64 * RB * 2);
  o.r_b = p; p += al256(MA * 384 * 2); o.v_b = p; p += al256(MA * 384 * 2); o.kk_b = p; p += al256(MA * 384 * 2);
  o.kd_b = p; p += al256(2 * MA * 384 * 2); o.bd_b = p; p += al256(2 * MA * 384 * 2);
  o.w_inT = p; p += al256((size_t)2 * 2688 * 1024 * 2); o.w_outT = p; p += al256((size_t)2 * 1024 * 1024 * 2); o.wqT = p; p += al256((size_t)2 * 2048 * 1024 * 2);
  o.keysb = p; p += al256((size_t)2 * 16 * 128 * 128 * 2); o.wqbT = p; p += al256((size_t)2 * 384 * 256 * 2); o.wkvbT = p; p += al256((size_t)2 * 512 * 128 * 2);
  o.w2T = p; p += al256((size_t)2 * 2 * 384 * 64 * 2); o.a2T = p; p += al256((size_t)2 * 2 * 384 * 64 * 2); o.g2T = p; p += al256((size_t)2 * 384 * 192 * 2);
  o.rope_g = p; p += al256((size_t)SEQ * 64 * 4); o.rope_m = p; p += al256((size_t)SEQ * 32 * 4);
  o.total = p; return o;
}
constexpr WsOff WO = make_wsoff();
#define WS_PTR(T, off) ((T*)(ws + (off)))
#define LAUNDER_S(x) asm volatile("" : "+s"(x))

struct NaiveIn {
  const float *x, *c, *ctx, *c_ctx, *ada_w, *ada_b, *norm_mix_g, *norm_ffn_g, *w_in, *w_out, *mla_q_norm_g, *mla_w_qb, *mla_kv_norm_g,
      *mla_w_kvb, *mla_qk_g, *rw_mu, *rw_w0, *rw_w2, *rw_a0, *rw_a2, *rw_g2, *rw_k_k, *rw_k_a, *rw_r_k, *rw_ln_g, *rw_ln_b, *gqa_qk_g,
      *pe_wq, *pe_keys, *pe_u, *pe_v;
};
struct MegaP { NaiveIn in; char* ws; float* out; };

#ifndef MEGA_CG
#define MEGA_CG 0
#endif
#if MEGA_CG
#define GRID_BARRIER() cg::this_grid().sync()
#else
#define GRID_BARRIER() xcd_barrier(xb)
#endif
#define MEGA_LDS_BYTES 65536
#ifndef PHASE_MASK
#define PHASE_MASK 0xFFFF
#endif
#define PH(k) if (PHASE_MASK & (1 << (k)))
#ifndef DIL_PH
#define DIL_PH -1
#endif
#ifndef DIL_MULT
#define DIL_MULT 4
#endif
#define DIL_BEGIN(k) unsigned long long dil_t0 = 0; if (DIL_PH == (k)) dil_t0 = __builtin_amdgcn_s_memrealtime();
#define DIL_END(k) if (DIL_PH == (k)) { GRID_BARRIER(); if (blockIdx.x == 0 && threadIdx.x == 0) { unsigned long long t1 = __builtin_amdgcn_s_memrealtime(); unsigned long long dt = (t1 - dil_t0) * DIL_MULT; \
    while (__builtin_amdgcn_s_memrealtime() - t1 < dt) __builtin_amdgcn_s_sleep(32); } }

__device__ __forceinline__ void ph_norm_mod(const float* xs, const float* g, const float* modl, int shift_idx, bf16_t* xn) {
  const int tt_ = tid_opaque(); const int lane = tt_ & 63;
  for (long row = blockIdx.x * 4 + (tt_ >> 6); row < NROWS; row += (long)gridDim.x * 4) {
    int b = row / RB, lr = row % RB; int bb = lr < SEQ ? b : BATCH;
    const float* sh = modl + ((long)bb * 6 + shift_idx) * DM; const float* sc = sh + DM;
    const float* xr = xs + row * DM; f32x4 v[4]; float ss = 0.f;
#pragma unroll
    for (int i = 0; i < 4; ++i) { v[i] = *(const f32x4*)(xr + i * 256 + lane * 4); ss += v[i][0]*v[i][0] + v[i][1]*v[i][1] + v[i][2]*v[i][2] + v[i][3]*v[i][3]; }
    ss = wave_sum(ss);
    float inv = 1.f / sqrtf(ss / DM + EPSN);
#pragma unroll
    for (int i = 0; i < 4; ++i) {
      int d = i * 256 + lane * 4; float o[4];
#pragma unroll
      for (int e = 0; e < 4; ++e) o[e] = v[i][e] * inv * g[d+e] * (1.f + sc[d+e]) + sh[d+e];
      uint2 pk; pk.x = pack2bf(o[0], o[1]); pk.y = pack2bf(o[2], o[3]);
      *(uint2*)(xn + row * DM + d) = pk;
    }
  }
}
__device__ __forceinline__ void ph_cvt_wT(const float* W, const float* g, bf16_t* Wt, int K, int N, int Npad, int Kpad) {
  const long n_el = (long)Npad * Kpad;
  const int tt_ = tid_opaque();
  for (long i = (long)blockIdx.x * 256 + tt_; i < n_el; i += (long)gridDim.x * 256) {
    int k = i % Kpad; int n = i / Kpad;
    Wt[i] = (k < K && n < N) ? f2bf(W[(long)k * N + n] * (g ? g[k] : 1.f)) : (bf16_t)0;
  }
}
__device__ __forceinline__ void ph_cvt_bf16(const float* s, bf16_t* d, long n8) {
  const int tt_ = tid_opaque();
  for (long i = (long)blockIdx.x * 256 + tt_; i < n8; i += (long)gridDim.x * 256) {
    f32x4 a = *(const f32x4*)(s + i * 8), b = *(const f32x4*)(s + i * 8 + 4);
    u32x4 o; o[0] = pack2bf(a[0], a[1]); o[1] = pack2bf(a[2], a[3]); o[2] = pack2bf(b[0], b[1]); o[3] = pack2bf(b[2], b[3]);
    *(u32x4*)(d + i * 8) = o;
  }
}


__device__ __forceinline__ void ph_cvt_wT_tiled(const float* __restrict__ W, const float* __restrict__ g, bf16_t* __restrict__ Wt, int K, int N, int Npad, int Kpad, char* smem) {
  const int t = tid_opaque(); float* s = (float*)smem;
  const int tk = Kpad / 64, tn = Npad / 64;
  for (int tile = blockIdx.x; tile < tk * tn; tile += gridDim.x) {
    const int k0 = (tile % tk) * 64, n0 = (tile / tk) * 64;
    __syncthreads();
#pragma unroll
    for (int i = 0; i < 4; ++i) {
      int kk = (t >> 4) + 16 * i, nn = (t & 15) * 4; int k = k0 + kk;
      f32x4 v = {0.f, 0.f, 0.f, 0.f};
      if (k < K) {
        const float* src = W + (long)k * N + n0 + nn; float gs = g ? g[k] : 1.f;
        if (n0 + nn + 3 < N) v = *(const f32x4*)src; else { for (int e = 0; e < 4; ++e) if (n0 + nn + e < N) v[e] = src[e]; }
        v *= gs;
      }
#pragma unroll
      for (int e = 0; e < 4; ++e) s[kk * 65 + nn + e] = v[e];
    }
    __syncthreads();
    {
      int nn = t >> 2, kq = (t & 3) * 16; u32x4 o0, o1;
#pragma unroll
      for (int e = 0; e < 4; ++e) { o0[e] = pack2bf(s[(kq + 2*e) * 65 + nn], s[(kq + 2*e + 1) * 65 + nn]); o1[e] = pack2bf(s[(kq + 8 + 2*e) * 65 + nn], s[(kq + 8 + 2*e + 1) * 65 + nn]); }
      bf16_t* dst = Wt + (long)(n0 + nn) * Kpad + k0 + kq;
      *(u32x4*)dst = o0; *(u32x4*)(dst + 8) = o1;
    }
  }
}
__device__ __forceinline__ void ph_mod_gemv(const float* __restrict__ c, const float* __restrict__ c_ctx, const float* __restrict__ ada_w, const float* __restrict__ ada_b, float* __restrict__ mod, char* smem) {
  const int t = tid_opaque(); float* s = (float*)smem;
  if ((int)blockIdx.x >= 2 * 24) return;
  for (int i = t; i < 9 * 1024; i += 256) { int bb = i >> 10, k = i & 1023; float v = bb < BATCH ? c[bb * DM + k] : c_ctx[k]; s[i] = siluf_(v); }
  __syncthreads();
  for (int item = blockIdx.x; item < 2 * 24; item += gridDim.x) {
    const int cb = item % 24, l = item / 24;
    const int j = cb * 256 + t; const float* wp = ada_w + (long)l * DM * 6144 + j;
    float acc[9];
#pragma unroll
    for (int bb = 0; bb < 9; ++bb) acc[bb] = 0.f;
#pragma unroll 8
    for (int k = 0; k < 1024; ++k) { float w = wp[(long)k * 6144];
#pragma unroll
      for (int bb = 0; bb < 9; ++bb) acc[bb] += s[bb * 1024 + k] * w; }
    const float bias = ada_b[l * 6144 + j];
#pragma unroll
    for (int bb = 0; bb < 9; ++bb) mod[((long)l * (BATCH + 1) + bb) * 6144 + j] = acc[bb] + bias;
  }
  __syncthreads();
}

__global__ void __launch_bounds__(256, 2) mega_kernel(MegaP p) {
  __shared__ __attribute__((aligned(16))) char smem[MEGA_LDS_BYTES];
  __shared__ uint4 xb_words;
  const int t0 = threadIdx.x;
#if !MEGA_CG
  if (t0 == 0) xb_words = make_uint4(0u, 0u, 0u, 0u);
  __syncthreads();
  XcdBarrier xb = xcd_barrier_post((unsigned*)p.ws, (volatile LAS unsigned*)&xb_words);
#endif
  const NaiveIn& I = p.in; const long MA = NROWS; const int TM = NROWS / 128;
  const int scan_role = (int)blockIdx.x < BATCH * 24 ? 1 : 0;
  { DIL_BEGIN(0)
  PH(0) {
    size_t wz_ = 0; LAUNDER_S(wz_); char* ws = p.ws + wz_; const int t = tid_opaque();
    float* xs = WS_PTR(float, WO.xs); float* mod = WS_PTR(float, WO.mod);
    for (long i = (long)blockIdx.x * 256 + t; i < MA * DM / 4; i += (long)gridDim.x * 256) {
      long e = i * 4; int d = e % DM; long row = e / DM; int b = row / RB, lr = row % RB;
      const float* src = lr < SEQ ? I.x + ((long)b * SEQ + lr) * DM + d : I.ctx + ((long)b * CTX_LEN + (lr - SEQ)) * DM + d;
      *(f32x4*)(xs + e) = *(const f32x4*)src;
    }
    ph_mod_gemv(I.c, I.c_ctx, I.ada_w, I.ada_b, mod, smem);
    for (int l = 0; l < 2; ++l) {
      ph_cvt_wT_tiled(I.w_in + (long)l * DM * IN_COLS, nullptr, WS_PTR(bf16_t, WO.w_inT) + (long)l * 2688 * 1024, 1024, IN_COLS, 2688, 1024, smem);
      ph_cvt_wT_tiled(I.w_out + (long)l * DM * DM, nullptr, WS_PTR(bf16_t, WO.w_outT) + (long)l * 1024 * 1024, 1024, 1024, 1024, 1024, smem);
      ph_cvt_wT_tiled(I.pe_wq + (long)l * DM * 2048, nullptr, WS_PTR(bf16_t, WO.wqT) + (long)l * 2048 * 1024, 1024, 2048, 2048, 1024, smem);
      ph_cvt_wT_tiled(I.mla_w_qb + (long)l * 256 * 384, I.mla_q_norm_g + l * 256, WS_PTR(bf16_t, WO.wqbT) + (long)l * 384 * 256, 256, 384, 384, 256, smem);
      ph_cvt_wT_tiled(I.mla_w_kvb + (long)l * 128 * 512, I.mla_kv_norm_g + l * 128, WS_PTR(bf16_t, WO.wkvbT) + (long)l * 512 * 128, 128, 512, 512, 128, smem);
      for (int d = 0; d < 2; ++d) {
        ph_cvt_wT_tiled(I.rw_w2 + ((long)l * 2 + d) * 64 * 384, nullptr, WS_PTR(bf16_t, WO.w2T) + ((long)l * 2 + d) * 384 * 64, 64, 384, 384, 64, smem);
        ph_cvt_wT_tiled(I.rw_a2 + ((long)l * 2 + d) * 64 * 384, nullptr, WS_PTR(bf16_t, WO.a2T) + ((long)l * 2 + d) * 384 * 64, 64, 384, 384, 64, smem);
      }
      ph_cvt_wT_tiled(I.rw_g2 + (long)l * 160 * 384, nullptr, WS_PTR(bf16_t, WO.g2T) + (long)l * 384 * 192, 160, 384, 384, 192, smem);
    }
    ph_cvt_bf16(I.pe_keys, WS_PTR(bf16_t, WO.keysb), 2L * 16 * 128 * 128 / 8);
    ph_rope_tables(WS_PTR(float, WO.rope_g), WS_PTR(float, WO.rope_m));
  }
  DIL_END(0) }
  GRID_BARRIER();
  for (int lq = 0; lq < 2; ++lq) {
    int l = lq; LAUNDER_S(l);
    { DIL_BEGIN(1)
    PH(1) {
      size_t wz_ = 0; LAUNDER_S(wz_); char* ws = p.ws + wz_; const int t = tid_opaque(); (void)t;
      ph_norm_mod(WS_PTR(float, WO.xs), I.norm_mix_g + l * DM, WS_PTR(float, WO.mod) + (long)l * (BATCH + 1) * 6144, 0, WS_PTR(bf16_t, WO.xn));
    }
    DIL_END(1) }
    GRID_BARRIER();
    { DIL_BEGIN(2)
    PH(2) {
      size_t wz_ = 0; LAUNDER_S(wz_); char* ws = p.ws + wz_; const int t = tid_opaque(); (void)t;
      const bf16_t* xn = WS_PTR(bf16_t, WO.xn); const bf16_t* wT = WS_PTR(bf16_t, WO.w_inT) + (long)l * 2688 * 1024; bf16_t* Pb = WS_PTR(bf16_t, WO.Pb);
      for (int tile = blockIdx.x; tile < TM * 21; tile += gridDim.x)
        gemm_tile_128(ALoadPlain{xn, DM}, wT, 1024, 1024, tile / 21, tile % 21, smem, EpiStoreBf16{Pb, IN_COLS, IN_COLS});
    }
    DIL_END(2) }
    GRID_BARRIER();
    { DIL_BEGIN(3)
    PH(3) {
      size_t wz_ = 0; LAUNDER_S(wz_); char* ws = p.ws + wz_; const int t = tid_opaque(); (void)t;
      PrepW pw{WS_PTR(bf16_t, WO.wqbT) + (long)l * 384 * 256, WS_PTR(bf16_t, WO.wkvbT) + (long)l * 512 * 128, WS_PTR(bf16_t, WO.w2T) + (long)l * 2 * 384 * 64,
               WS_PTR(bf16_t, WO.a2T) + (long)l * 2 * 384 * 64, WS_PTR(bf16_t, WO.g2T) + (long)l * 384 * 192, I.rw_mu + (long)l * 2 * RWC, I.rw_w0 + l * 768, I.rw_a0 + l * 768};
      PrepBuf pb{WS_PTR(bf16_t, WO.Pb), WS_PTR(bf16_t, WO.tq), WS_PTR(bf16_t, WO.tkv), WS_PTR(bf16_t, WO.a_b), WS_PTR(bf16_t, WO.g_b), WS_PTR(float, WO.w_f)};
      for (int tile = blockIdx.x; tile < TM * 22; tile += gridDim.x) prep_gemm_tile(pw, pb, tile / 22, tile % 22, smem);
    }
    DIL_END(3) }
    GRID_BARRIER();
    { DIL_BEGIN(4)
    PH(4) {
      size_t wz_ = 0; LAUNDER_S(wz_); char* ws = p.ws + wz_; const int t = tid_opaque(); (void)t;
      FinW2 fw{I.mla_qk_g + l * 192, I.gqa_qk_g + l * 128, I.rw_mu + (long)l * 2 * RWC, I.rw_k_k + l * 384, I.rw_k_a + l * 384, WS_PTR(float, WO.rope_g), WS_PTR(float, WO.rope_m)};
      FinBuf fb{WS_PTR(bf16_t, WO.Pb), WS_PTR(bf16_t, WO.tq), WS_PTR(bf16_t, WO.tkv), WS_PTR(bf16_t, WO.a_b), WS_PTR(bf16_t, WO.mq), WS_PTR(bf16_t, WO.mk), WS_PTR(bf16_t, WO.mvT),
                WS_PTR(bf16_t, WO.gq), WS_PTR(bf16_t, WO.gk), WS_PTR(bf16_t, WO.gvT), WS_PTR(bf16_t, WO.r_b), WS_PTR(bf16_t, WO.v_b), WS_PTR(bf16_t, WO.kk_b), WS_PTR(bf16_t, WO.kd_b), WS_PTR(bf16_t, WO.bd_b)};
      for (int tile = blockIdx.x; tile < NROWS / 64; tile += gridDim.x) prep_finish_tile2(fw, fb, tile, smem);
    }
    DIL_END(4) }
    GRID_BARRIER();
    { unsigned long long dil_t0 = 0, dil_scan = 0; if (DIL_PH == 5 || DIL_PH == 11) dil_t0 = __builtin_amdgcn_s_memrealtime();
    PH(5) {
      size_t wz_ = 0; LAUNDER_S(wz_); char* ws = p.ws + wz_; const int t = tid_opaque(); (void)t;
      int* s_item = (int*)(smem + MEGA_LDS_BYTES - 16);
      unsigned* sctr = (unsigned*)ws + XB_QUEUE(4 + l);
      auto scan_loop = [&]() {
        for (;;) {
          __syncthreads();
          if (t == 0) *s_item = (int)xb_add(sctr, 1u);
          __syncthreads();
          const int it = *s_item;
          if (it >= BATCH * 24) break;
          rw_scan_block(WS_PTR(bf16_t, WO.r_b), WS_PTR(bf16_t, WO.v_b), WS_PTR(bf16_t, WO.kk_b), WS_PTR(bf16_t, WO.kd_b), WS_PTR(bf16_t, WO.bd_b), WS_PTR(float, WO.w_f), WS_PTR(float, WO.Pb),
                        it, (long)MA * 384, smem);
        }
      };
      if (scan_role) scan_loop();
      const int nqt = l == 0 ? 18 : 16; const int n_mla = BATCH * 4 * nqt, n_all = BATCH * 10 * nqt;
      unsigned* qctr = (unsigned*)ws + XB_QUEUE(l);
      for (;;) {
        __syncthreads();
        if (t == 0) *s_item = (int)xb_add(qctr, 1u);
        __syncthreads();
        const int it = *s_item;
        if (it >= n_all) break;
        size_t wz2_ = 0; LAUNDER_S(wz2_); char* ws2 = p.ws + wz2_;
        if (it < n_mla) { int qt = it / (BATCH * 4), r = it % (BATCH * 4);
          attn_block<96>((const bf16_t*)(ws2 + WO.mq), 4, (const bf16_t*)(ws2 + WO.mk), 4, (const bf16_t*)(ws2 + WO.mvT), 1, (bf16_t*)(ws2 + WO.tq), 0, r / 4, r % 4, qt, smem); }
        else { int v = it - n_mla; int qt = v / (BATCH * 6), r = v % (BATCH * 6);
          attn_block<64>((const bf16_t*)(ws2 + WO.gq), 6, (const bf16_t*)(ws2 + WO.gk), 2, (const bf16_t*)(ws2 + WO.gvT), 3, (bf16_t*)(ws2 + WO.tq), 640, r / 6, r % 6, qt, smem); }
      }
      if (!scan_role) scan_loop();
    }
#if DIL_PH == 11
    GRID_BARRIER(); if (blockIdx.x == 0 && threadIdx.x == 0) { unsigned long long t1 = __builtin_amdgcn_s_memrealtime(); unsigned long long dt = dil_scan * DIL_MULT; while (__builtin_amdgcn_s_memrealtime() - t1 < dt) __builtin_amdgcn_s_sleep(32); }
#endif
    (void)dil_scan;
    DIL_END(5) }
    GRID_BARRIER();
    { DIL_BEGIN(6)
    PH(6) {
      size_t wz_ = 0; LAUNDER_S(wz_); char* ws = p.ws + wz_; const int t = tid_opaque(); (void)t;
      RdW rw{I.rw_r_k + l * 384, I.rw_ln_g + l * 384, I.rw_ln_b + l * 384};
      for (long row = blockIdx.x * 4 + (t >> 6); row < NROWS; row += (long)gridDim.x * 4)
        rw_readout_row2(rw, WS_PTR(float, WO.Pb), WS_PTR(bf16_t, WO.r_b), WS_PTR(bf16_t, WO.v_b), WS_PTR(bf16_t, WO.kd_b), WS_PTR(bf16_t, WO.g_b), WS_PTR(bf16_t, WO.tq), row, t & 63);
    }
    DIL_END(6) }
    GRID_BARRIER();
    { DIL_BEGIN(7)
    PH(7) {
      size_t wz_ = 0; LAUNDER_S(wz_); char* ws = p.ws + wz_; const int t = tid_opaque(); (void)t;
      const bf16_t* mix = WS_PTR(bf16_t, WO.tq); const bf16_t* wT = WS_PTR(bf16_t, WO.w_outT) + (long)l * 1024 * 1024; float* xs = WS_PTR(float, WO.xs);
      const float* modl = WS_PTR(float, WO.mod) + (long)l * (BATCH + 1) * 6144;
      for (int tile = blockIdx.x; tile < TM * 8; tile += gridDim.x)
        gemm_tile_128(ALoadPlain{mix, DM}, wT, 1024, 1024, tile / 8, tile % 8, smem, EpiResid{xs, modl, 2, 0});
    }
    DIL_END(7) }
    GRID_BARRIER();
    { DIL_BEGIN(8)
    PH(8) {
      size_t wz_ = 0; LAUNDER_S(wz_); char* ws = p.ws + wz_; const int t = tid_opaque(); (void)t;
      ph_norm_mod(WS_PTR(float, WO.xs), I.norm_ffn_g + l * DM, WS_PTR(float, WO.mod) + (long)l * (BATCH + 1) * 6144, 3, WS_PTR(bf16_t, WO.xn));
      ph_cvt_fp8_rows(I.pe_u + (long)l * 16384 * DM, WS_PTR(unsigned char, WO.Pb), WS_PTR(float, WO.Pb + 2 * 16384 * 1024));
      ph_cvt_fp8_rows(I.pe_v + (long)l * 16384 * DM, WS_PTR(unsigned char, WO.Pb + 16384 * 1024), WS_PTR(float, WO.Pb + 2 * 16384 * 1024 + 65536));
    }
    DIL_END(8) }
    GRID_BARRIER();
    { DIL_BEGIN(9)
    PH(9) {
      size_t wz_ = 0; LAUNDER_S(wz_); char* ws = p.ws + wz_; const int t = tid_opaque(); (void)t;
      const bf16_t* xn = WS_PTR(bf16_t, WO.xn); const bf16_t* wT = WS_PTR(bf16_t, WO.wqT) + (long)l * 2048 * 1024; const bf16_t* kb = WS_PTR(bf16_t, WO.keysb) + (long)l * 16 * 128 * 128;
      unsigned* top1 = WS_PTR(unsigned, WO.tq);
      for (int tile = blockIdx.x; tile < TM * 16; tile += gridDim.x) { peer_q_top1_tile(xn, wT, kb, top1, tile / 16, tile % 16, smem); __syncthreads(); }
    }
    DIL_END(9) }
    GRID_BARRIER();
    { DIL_BEGIN(10)
    PH(10) {
      size_t wz_ = 0; LAUNDER_S(wz_); char* ws = p.ws + wz_; const int t = tid_opaque(); (void)t;
      const float* modl = WS_PTR(float, WO.mod) + (long)l * (BATCH + 1) * 6144;
      for (int g = blockIdx.x; g < NROWS / 32; g += gridDim.x) {
        peer_gather_group_fp8(WS_PTR(bf16_t, WO.xn), WS_PTR(unsigned, WO.tq), WS_PTR(unsigned char, WO.Pb), WS_PTR(float, WO.Pb + 2 * 16384 * 1024),
                              WS_PTR(unsigned char, WO.Pb + 16384 * 1024), WS_PTR(float, WO.Pb + 2 * 16384 * 1024 + 65536), modl, WS_PTR(float, WO.xs), g, smem);
        __syncthreads();
      }
    }
    DIL_END(10) }
    GRID_BARRIER();
  }
  {
    size_t wz_ = 0; LAUNDER_S(wz_); char* ws = p.ws + wz_; const int t = tid_opaque(); const float* xs = WS_PTR(float, WO.xs);
    for (long i = (long)blockIdx.x * 256 + t; i < (long)BATCH * SEQ * DM / 4; i += (long)gridDim.x * 256) {
      long e = i * 4; int d = e % DM; long row = e / DM; int b = row / SEQ, tt = row % SEQ;
      *(f32x4*)(p.out + e) = *(const f32x4*)(xs + ((long)b * RB + tt) * DM + d);
    }
  }
}

extern "C" void kernel_launch(void* const* d_in, const int* in_sizes, int n_in, void* d_out, int out_size, void* d_ws, size_t ws_size,
                              hipStream_t stream) {
  MegaP p{};
  const float** pp = (const float**)&p.in;
  for (int i = 0; i < 31; ++i) pp[i] = (const float*)d_in[i];
  p.ws = (char*)d_ws; p.out = (float*)d_out;
  if (WO.total > ws_size) return;
  static int grid_blocks = 0;
  if (!grid_blocks) {
    int dev = 0, cus = 0, per_cu = 0;
    hipGetDevice(&dev);
    hipDeviceGetAttribute(&cus, hipDeviceAttributeMultiprocessorCount, dev);
    hipOccupancyMaxActiveBlocksPerMultiprocessor(&per_cu, mega_kernel, 256, 0);
    if (per_cu > 2) per_cu = 2;
    if (per_cu < 1) per_cu = 1;
    grid_blocks = cus * per_cu;
  }
  hipMemsetAsync(d_ws, 0, 32768, stream);
  void* args[] = {&p};
  hipLaunchCooperativeKernel((void*)mega_kernel, dim3(grid_blocks), dim3(256), args, 0, stream);
}
```

```cpp
#include <hip/hip_runtime.h>
#ifndef BATCH
#define BATCH 8
#endif
#ifndef SEQ
#define SEQ 2048
#endif
#ifndef CTX_LEN
#define CTX_LEN 256
#endif
#define DM 1024
#define RB (SEQ + CTX_LEN)
#define NROWS (BATCH * RB)
#define IN_COLS 2624
#define MLA_OFF 0
#define RW_OFF 416
#define GQA_OFF 1984
#define RWC 1568
#define EPSN 1e-6f

__device__ inline float sigmoidf_(float x) { return 1.f / (1.f + expf(-x)); }
__device__ inline float siluf_(float x) { return x * sigmoidf_(x); }
__device__ inline float softplusf_(float x) { return fmaxf(x, 0.f) + log1pf(expf(-fabsf(x))); }
__device__ inline float geluf_(float x) { return 0.5f * x * (1.f + tanhf(0.7978845608028654f * (x + 0.044715f * x * x * x))); }

__global__ void nk_copy_in(const float* x, const float* ctx, float* xs) {
  long i = (long)blockIdx.x * blockDim.x + threadIdx.x;
  if (i >= (long)NROWS * DM) return;
  int d = i % DM; long row = i / DM; int b = row / RB, lr = row % RB;
  xs[i] = lr < SEQ ? x[((long)b * SEQ + lr) * DM + d] : ctx[((long)b * CTX_LEN + (lr - SEQ)) * DM + d];
}
__global__ void nk_copy_out(const float* xs, float* out) {
  long i = (long)blockIdx.x * blockDim.x + threadIdx.x;
  if (i >= (long)BATCH * SEQ * DM) return;
  int d = i % DM; long row = i / DM; int b = row / SEQ, t = row % SEQ;
  out[i] = xs[((long)b * RB + t) * DM + d];
}
__global__ void nk_mod(const float* c, const float* c_ctx, const float* ada_w, const float* ada_b, float* mod) {
  long i = (long)blockIdx.x * blockDim.x + threadIdx.x;
  if (i >= 2L * (BATCH + 1) * 6144) return;
  int j = i % 6144; int bb = (i / 6144) % (BATCH + 1); int l = i / (6144 * (BATCH + 1));
  const float* cv = bb < BATCH ? c + (long)bb * DM : c_ctx;
  const float* w = ada_w + (long)l * DM * 6144;
  float acc = 0.f;
  for (int k = 0; k < DM; ++k) acc += siluf_(cv[k]) * w[(long)k * 6144 + j];
  mod[i] = acc + ada_b[l * 6144 + j];
}
__global__ void nk_norm_mod(const float* xs, const float* g, const float* modl, int shift_idx, float* xn, int M, int bidx) {
  long row = (long)blockIdx.x * blockDim.x + threadIdx.x;
  if (row >= M) return;
  int lr = row % RB; int bb = lr < SEQ ? bidx : BATCH;
  const float* sh = modl + ((long)bb * 6 + shift_idx) * DM; const float* sc = sh + DM;
  const float* xr = xs + row * DM; float ss = 0.f;
  for (int d = 0; d < DM; ++d) ss += xr[d] * xr[d];
  float inv = 1.f / sqrtf(ss / DM + EPSN);
  for (int d = 0; d < DM; ++d) xn[row * DM + d] = xr[d] * inv * g[d] * (1.f + sc[d]) + sh[d];
}
__global__ void nk_gemm(const float* A, const float* W, float* C, int M, int N, int K) {
  long i = (long)blockIdx.x * blockDim.x + threadIdx.x;
  if (i >= (long)M * N) return;
  int n = i % N; long m = i / N; float acc = 0.f;
  for (int k = 0; k < K; ++k) acc += A[m * K + k] * W[(long)k * N + n];
  C[i] = acc;
}
__global__ void nk_mla_q1(const float* P, const float* qng, const float* wqb, float* tq, int M) {
  long i = (long)blockIdx.x * blockDim.x + threadIdx.x;
  if (i >= (long)M * 384) return;
  int j = i % 384; long r = i / 384; const float* cq = P + r * IN_COLS;
  float ss = 0.f; for (int k = 0; k < 256; ++k) ss += cq[k] * cq[k];
  float inv = 1.f / sqrtf(ss / 256 + EPSN), acc = 0.f;
  for (int k = 0; k < 256; ++k) acc += cq[k] * inv * qng[k] * wqb[k * 384 + j];
  tq[i] = acc;
}
__global__ void nk_mla_kv1(const float* P, const float* kvng, const float* wkvb, float* tkv, int M) {
  long i = (long)blockIdx.x * blockDim.x + threadIdx.x;
  if (i >= (long)M * 512) return;
  int j = i % 512; long r = i / 512; const float* ck = P + r * IN_COLS + 256;
  float ss = 0.f; for (int k = 0; k < 128; ++k) ss += ck[k] * ck[k];
  float inv = 1.f / sqrtf(ss / 128 + EPSN), acc = 0.f;
  for (int k = 0; k < 128; ++k) acc += ck[k] * inv * kvng[k] * wkvb[k * 512 + j];
  tkv[i] = acc;
}
__global__ void nk_mla_qk2(const float* P, const float* tq, const float* tkv, const float* qkg, float* mq, float* mk, int M) {
  long i = (long)blockIdx.x * blockDim.x + threadIdx.x;
  if (i >= (long)M * 8) return;
  int which = i % 2, h = (i / 2) % 4; long r = i / 8; int lr = r % RB;
  float ss = 0.f;
  for (int e = 0; e < 96; ++e) {
    float v = which == 0 ? tq[r * 384 + h * 96 + e] : (e < 64 ? tkv[r * 512 + h * 128 + e] : P[r * IN_COLS + 384 + (e - 64)]);
    ss += v * v;
  }
  float inv = 1.f / sqrtf(ss / 96 + EPSN);
  const float* g = qkg + which * 96; float* o = (which == 0 ? mq : mk) + r * 384 + h * 96;
  for (int e = 0; e < 64; ++e) {
    float v = which == 0 ? tq[r * 384 + h * 96 + e] : tkv[r * 512 + h * 128 + e];
    o[e] = v * inv * g[e];
  }
  for (int j = 0; j < 16; ++j) {
    float va = which == 0 ? tq[r * 384 + h * 96 + 64 + j] : P[r * IN_COLS + 384 + j];
    float vb = which == 0 ? tq[r * 384 + h * 96 + 80 + j] : P[r * IN_COLS + 384 + 16 + j];
    va *= inv * g[64 + j]; vb *= inv * g[80 + j];
    if (lr < SEQ) {
      int pos = j < 8 ? lr / 64 : lr % 64; float fr = powf(10000.f, -(float)(j & 7) / 8.f);
      float ang = (float)pos * fr, cs = cosf(ang), sn = sinf(ang);
      o[64 + j] = va * cs - vb * sn; o[80 + j] = va * sn + vb * cs;
    } else { o[64 + j] = va; o[80 + j] = vb; }
  }
}
__global__ void nk_gqa_prep(const float* P, const float* qkg, float* gq, float* gk, int M) {
  long i = (long)blockIdx.x * blockDim.x + threadIdx.x;
  if (i >= (long)M * 8) return;
  int h = i % 8; long r = i / 8; int lr = r % RB;
  const float* src = P + r * IN_COLS + GQA_OFF + h * 64;
  const float* g = qkg + (h < 6 ? 0 : 64);
  float* o = h < 6 ? gq + r * 384 + h * 64 : gk + r * 128 + (h - 6) * 64;
  float ss = 0.f; for (int e = 0; e < 64; ++e) ss += src[e] * src[e];
  float inv = 1.f / sqrtf(ss / 64 + EPSN);
  for (int j = 0; j < 32; ++j) {
    float va = src[j] * inv * g[j], vb = src[32 + j] * inv * g[32 + j];
    if (lr < SEQ) {
      int pos = j < 16 ? lr / 64 : lr % 64; float fr = powf(10000.f, -(float)(j & 15) / 16.f);
      float ang = (float)pos * fr, cs = cosf(ang), sn = sinf(ang);
      o[j] = va * cs - vb * sn; o[32 + j] = va * sn + vb * cs;
    } else { o[j] = va; o[32 + j] = vb; }
  }
}
template <int DQ>
__global__ void __launch_bounds__(256) nk_attn(const float* q, int qs, const float* k, int ks, const float* v, int vs, int vhs, int H, int G, float* mix, int ooff, int M) {
  long i = (long)blockIdx.x * blockDim.x + threadIdx.x;
  if (i >= (long)M * H) return;
  int h = i % H; long r = i / H; int b = r / RB, lr = r % RB; int kh = h / G;
  float qv[DQ];
#pragma unroll
  for (int e = 0; e < DQ; ++e) qv[e] = q[r * qs + h * DQ + e];
  float acc[64];
#pragma unroll
  for (int e = 0; e < 64; ++e) acc[e] = 0.f;
  float mx = -1e30f, l = 0.f; const float scale = 1.f / sqrtf((float)DQ);
  int k0 = lr < SEQ ? 0 : SEQ, k1 = RB;
  for (int kr = k0; kr < k1; ++kr) {
    long rr = (long)b * RB + kr; const float* kp = k + rr * ks + kh * DQ; float s = 0.f;
#pragma unroll
    for (int e = 0; e < DQ; ++e) s += qv[e] * kp[e];
    s *= scale;
    float mn = fmaxf(mx, s), al = expf(mx - mn), pp = expf(s - mn);
    l = l * al + pp; mx = mn; const float* vp = v + rr * vs + kh * vhs;
#pragma unroll
    for (int e = 0; e < 64; ++e) acc[e] = acc[e] * al + pp * vp[e];
  }
#pragma unroll
  for (int e = 0; e < 64; ++e) mix[r * DM + ooff + h * 64 + e] = acc[e] / l;
}
__global__ void nk_rw_shift(const float* P, const float* mu, float* rwx, int M) {
  long i = (long)blockIdx.x * blockDim.x + threadIdx.x;
  if (i >= (long)M * RWC) return;
  int c = i % RWC; long r = i / RWC; int lr = r % RB;
  bool first = (lr == 0) || (lr == SEQ), last = (lr == SEQ - 1) || (lr == RB - 1);
  float p = P[r * IN_COLS + RW_OFF + c];
  float pv = first ? 0.f : P[(r - 1) * IN_COLS + RW_OFF + c], nx = last ? 0.f : P[(r + 1) * IN_COLS + RW_OFF + c];
  rwx[i] = p + mu[c] * (pv - p) + mu[RWC + c] * (nx - p);
}
__global__ void nk_rw_prep(const float* rwx, const float* w0, const float* w2, const float* a0, const float* a2, const float* g2,
                           const float* k_k, const float* k_a, float* dec, float* kd, float* bd, float* kk, float* gg, int M) {
  long i = (long)blockIdx.x * blockDim.x + threadIdx.x;
  if (i >= (long)M * 384) return;
  int c = i % 384; long r = i / 384; int h = c / 64; const float* xr = rwx + r * RWC;
  float kv = xr[384 + c];
  float ss = 0.f; for (int n = 0; n < 64; ++n) { float t = xr[384 + h * 64 + n] * k_k[h * 64 + n]; ss += t * t; }
  float kkv = kv * k_k[c] / sqrtf(ss + 1e-12f);
  kk[i] = kkv;
  for (int d = 0; d < 2; ++d) {
    float wr = w0[d * 384 + c], ar = a0[d * 384 + c];
    for (int j = 0; j < 64; ++j) { wr += tanhf(xr[1152 + d * 64 + j]) * w2[(d * 64 + j) * 384 + c]; ar += xr[1280 + d * 64 + j] * a2[(d * 64 + j) * 384 + c]; }
    float dc = expf(-expf(-softplusf_(-wr) - 0.5f)); float a = sigmoidf_(ar);
    dec[(long)d * M * 384 + i] = dc; kd[(long)d * M * 384 + i] = kv * (1.f + (a - 1.f) * k_a[c]); bd[(long)d * M * 384 + i] = kkv * a;
  }
  float g = 0.f; for (int j = 0; j < 160; ++j) g += sigmoidf_(xr[1408 + j]) * g2[j * 384 + c];
  gg[i] = g;
}
__global__ void __launch_bounds__(256) nk_rw_scan(const float* rwx, const float* dec, const float* kd, const float* bd, const float* kk, float* y, int M, int nb) {
  long t = (long)blockIdx.x * blockDim.x + threadIdx.x;
  if (t >= (long)nb * 2 * 6 * 64) return;
  int i = t % 64, h = (t / 64) % 6, d = (t / 384) % 2, b = t / 768;
  float S[64];
#pragma unroll
  for (int j = 0; j < 64; ++j) S[j] = 0.f;
  for (int step = 0; step < RB; ++step) {
    int lr;
    if (step < CTX_LEN) lr = SEQ + (d == 0 ? step : CTX_LEN - 1 - step);
    else lr = d == 0 ? step - CTX_LEN : SEQ - 1 - (step - CTX_LEN);
    long r = (long)b * RB + lr; long o = (long)d * M * 384 + r * 384 + h * 64;
    const float* rp = rwx + r * RWC + h * 64; const float* wp = dec + o; const float* kp = kd + o; const float* bp = bd + o; const float* kkp = kk + r * 384 + h * 64;
    float vi = rwx[r * RWC + 768 + h * 64 + i];
    float skk = 0.f;
#pragma unroll
    for (int j = 0; j < 64; ++j) skk += S[j] * kkp[j];
    float yy = 0.f;
#pragma unroll
    for (int j = 0; j < 64; ++j) { S[j] = S[j] * wp[j] - skk * bp[j] + vi * kp[j]; yy += S[j] * rp[j]; }
    y[o + i] = yy;
  }
}
__global__ void nk_rw_readout(const float* rwx, const float* y, const float* kd, const float* gg, const float* r_k, const float* ln_g, const float* ln_b, float* mix, int M, long yds) {
  long i = (long)blockIdx.x * blockDim.x + threadIdx.x;
  if (i >= (long)M * 6) return;
  int h = i % 6; long r = i / 6; long o = r * 384 + h * 64; long ds = (long)M * 384;
  float mean = 0.f; for (int n = 0; n < 64; ++n) mean += y[o + n] + y[yds + o + n];
  mean /= 64.f;
  float var = 0.f, coef = 0.f;
  for (int n = 0; n < 64; ++n) {
    float yy = y[o + n] + y[yds + o + n] - mean; var += yy * yy;
    coef += rwx[r * RWC + h * 64 + n] * (kd[o + n] + kd[ds + o + n]) * r_k[h * 64 + n];
  }
  var /= 64.f; float inv = 1.f / sqrtf(var + 64e-5f);
  for (int n = 0; n < 64; ++n) {
    float yn = (y[o + n] + y[yds + o + n] - mean) * inv * ln_g[h * 64 + n] + ln_b[h * 64 + n];
    mix[r * DM + 256 + h * 64 + n] = (yn + coef * rwx[r * RWC + 768 + h * 64 + n]) * gg[o + n];
  }
}
__global__ void nk_gemm_res(const float* A, const float* W, const float* modl, int gi, float* xs, int M, int bidx) {
  long i = (long)blockIdx.x * blockDim.x + threadIdx.x;
  if (i >= (long)M * DM) return;
  int j = i % DM; long r = i / DM; int lr = r % RB; int bb = lr < SEQ ? bidx : BATCH;
  float acc = 0.f; for (int k = 0; k < DM; ++k) acc += A[r * DM + k] * W[(long)k * DM + j];
  xs[i] += modl[((long)bb * 6 + gi) * DM + j] * acc;
}
__global__ void nk_peer_score(const float* pq, const float* keys, float* sc, int M) {
  long i = (long)blockIdx.x * blockDim.x + threadIdx.x;
  if (i >= (long)M * 2048) return;
  int k = i % 128, ps = (i / 128) % 16; long r = i / 2048;
  const float* q = pq + r * 2048 + ps * 128; const float* ky = keys + ((long)ps * 128 + k) * 128;
  float acc = 0.f; for (int d = 0; d < 128; ++d) acc += q[d] * ky[d];
  sc[i] = acc;
}
__global__ void nk_peer_top1(const float* sc, float* ts, int* ti, int M) {
  long i = (long)blockIdx.x * blockDim.x + threadIdx.x;
  if (i >= (long)M * 16) return;
  const float* s = sc + i * 128; float pv = 3e38f; int pi = -1;
  for (int t = 0; t < 16; ++t) {
    float bv = -3e38f; int bi = -1;
    for (int k = 0; k < 128; ++k) {
      float v = s[k]; bool ok = (v < pv) || (v == pv && k > pi);
      if (ok && (bi < 0 || v > bv)) { bv = v; bi = k; }
    }
    ts[i * 16 + t] = bv; ti[i * 16 + t] = bi; pv = bv; pi = bi;
  }
}
__global__ void nk_peer_top2(const float* ts, const int* ti, int* pe, float* pg, int M) {
  long i = (long)blockIdx.x * blockDim.x + threadIdx.x;
  if (i >= (long)M * 8) return;
  const float* s1 = ts + i * 32; const float* s2 = s1 + 16; const int* i1 = ti + i * 32; const int* i2 = i1 + 16;
  float pv = 3e38f; int pi = -1; float mx = 0.f, sum = 0.f;
  for (int t = 0; t < 16; ++t) {
    float bv = -3e38f; int bi = -1;
    for (int c = 0; c < 256; ++c) {
      float v = s1[c / 16] + s2[c % 16]; bool ok = (v < pv) || (v == pv && c > pi);
      if (ok && (bi < 0 || v > bv)) { bv = v; bi = c; }
    }
    if (t == 0) mx = bv;
    float e = expf(bv - mx); sum += e;
    pe[i * 16 + t] = i1[bi / 16] * 128 + i2[bi % 16]; pg[i * 16 + t] = e; pv = bv; pi = bi;
  }
  for (int t = 0; t < 16; ++t) pg[i * 16 + t] /= sum;
}
__global__ void nk_peer_act(const float* xn, const float* u, const int* pe, const float* pg, float* pw, int M) {
  long i = (long)blockIdx.x * blockDim.x + threadIdx.x;
  if (i >= (long)M * 128) return;
  long r = i / 128; const float* ur = u + (long)pe[i] * DM; const float* xr = xn + r * DM;
  float acc = 0.f; for (int d = 0; d < DM; ++d) acc += xr[d] * ur[d];
  pw[i] = pg[i] * geluf_(acc);
}
__global__ void nk_peer_out(const float* v, const int* pe, const float* pw, const float* modl, float* xs, int M, int bidx) {
  long i = (long)blockIdx.x * blockDim.x + threadIdx.x;
  if (i >= (long)M * DM) return;
  int j = i % DM; long r = i / DM; int lr = r % RB; int bb = lr < SEQ ? bidx : BATCH;
  float acc = 0.f; for (int k = 0; k < 128; ++k) acc += pw[r * 128 + k] * v[(long)pe[r * 128 + k] * DM + j];
  xs[i] += modl[((long)bb * 6 + 5) * DM + j] * acc;
}


__device__ __forceinline__ unsigned f2sortable(float s) { unsigned f = __float_as_uint(s); return (f & 0x80000000u) ? ~f : (f | 0x80000000u); }
__device__ __forceinline__ float sortable2f(unsigned o) { unsigned f = (o & 0x80000000u) ? (o & 0x7fffffffu) : ~o; return __uint_as_float(f); }
__device__ __forceinline__ unsigned enc_key(float s, int idx) { return (f2sortable(s) & ~127u) | (unsigned)(127 - idx); }
__device__ __forceinline__ void dec_key(unsigned k, float& s, int& idx) { idx = 127 - (int)(k & 127u); s = sortable2f(k & ~127u); }
__device__ __forceinline__ unsigned umax_(unsigned a, unsigned b) { return a > b ? a : b; }
__device__ __forceinline__ unsigned umin_(unsigned a, unsigned b) { return a < b ? a : b; }
__device__ __forceinline__ void ins16(unsigned (&l)[16], unsigned x) {
#pragma unroll
  for (int i = 0; i < 16; ++i) { unsigned mx = umax_(l[i], x); x = umin_(l[i], x); l[i] = mx; }
}
__device__ __forceinline__ void merge16(unsigned (&a)[16], const unsigned (&brev)[16]) {
#pragma unroll
  for (int i = 0; i < 16; ++i) a[i] = umax_(a[i], brev[i]);
#pragma unroll
  for (int d = 8; d >= 1; d >>= 1)
#pragma unroll
    for (int i = 0; i < 16; ++i) if ((i & d) == 0) { unsigned hi = umax_(a[i], a[i + d]), lo = umin_(a[i], a[i + d]); a[i] = hi; a[i + d] = lo; }
}
__device__ __forceinline__ void peer_combine(const unsigned* L0, const unsigned* L1, int* e_out, float* g_out) {
  float s0[16], s1[16];
#pragma unroll
  for (int i = 0; i < 16; ++i) { int ix; dec_key(L0[i], s0[i], ix); dec_key(L1[i], s1[i], ix); }
  unsigned sel[16];
#pragma unroll
  for (int i = 0; i < 16; ++i) sel[i] = 0u;
#pragma unroll
  for (int i = 0; i < 16; ++i)
#pragma unroll
    for (int j = 0; j < 16; ++j)
      if ((i + 1) * (j + 1) <= 16) { unsigned k = (f2sortable(s0[i] + s1[j]) & ~255u) | (unsigned)(255 - (i * 16 + j)); ins16(sel, k); }
  float mx = -3e38f;
#pragma unroll
  for (int t = 0; t < 16; ++t) {
    int c = 255 - (int)(sel[t] & 255u); int i = c >> 4, j = c & 15;
    float a, b; int ia, ib; dec_key(L0[i], a, ia); dec_key(L1[j], b, ib);
    float s = a + b; e_out[t] = ia * 128 + ib; g_out[t] = s; mx = fmaxf(mx, s);
  }
  float sum = 0.f;
#pragma unroll
  for (int t = 0; t < 16; ++t) { float e = expf(g_out[t] - mx); g_out[t] = e; sum += e; }
  float inv = 1.f / sum;
#pragma unroll
  for (int t = 0; t < 16; ++t) g_out[t] *= inv;
}
__global__ void hk_peer_top1(const float* pq, const float* keys, unsigned* top1, int M) {
  long i = (long)blockIdx.x * blockDim.x + threadIdx.x;
  if (i >= (long)M * 16) return;
  int ps = i % 16; long r = i / 16; const float* q = pq + r * 2048 + ps * 128;
  unsigned la[16], lb[16], lbr[16];
#pragma unroll
  for (int t = 0; t < 16; ++t) { la[t] = 0u; lb[t] = 0u; }
  for (int k = 0; k < 128; ++k) {
    const float* ky = keys + ((long)ps * 128 + k) * 128; float acc = 0.f;
    for (int d = 0; d < 128; ++d) acc += q[d] * ky[d];
    unsigned key = enc_key(acc, k);
    if (k < 64) ins16(la, key); else ins16(lb, key);
  }
#pragma unroll
  for (int t = 0; t < 16; ++t) lbr[t] = lb[15 - t];
  merge16(la, lbr);
#pragma unroll
  for (int t = 0; t < 16; ++t) top1[i * 16 + t] = la[t];
}
__global__ void hk_peer_combine(const unsigned* top1, int* pe, float* pg, int M) {
  long i = (long)blockIdx.x * blockDim.x + threadIdx.x;
  if (i >= (long)M * 8) return;
  peer_combine(top1 + i * 32, top1 + i * 32 + 16, pe + i * 16, pg + i * 16);
}
typedef unsigned short bf16_t;
__device__ __forceinline__ int tid_opaque() { int t = threadIdx.x; asm volatile("" : "+v"(t)); return t; }
typedef __attribute__((ext_vector_type(8))) short bf16x8;
typedef __attribute__((ext_vector_type(4))) float f32x4;
typedef __attribute__((ext_vector_type(16))) float f32x16;
typedef __attribute__((ext_vector_type(4))) unsigned u32x4;

typedef __attribute__((ext_vector_type(2))) __bf16 bf16v2;
typedef __attribute__((ext_vector_type(2))) float f32v2;
__device__ __forceinline__ unsigned pack2bf(float a, float b) { f32v2 v = {a, b}; bf16v2 r = __builtin_convertvector(v, bf16v2); return __builtin_bit_cast(unsigned, r); }
__device__ __forceinline__ bf16_t f2bf(float f) { return (bf16_t)(pack2bf(f, 0.f) & 0xffffu); }
__device__ __forceinline__ float bf2f(bf16_t h) { return __uint_as_float(((unsigned)h) << 16); }

#define GEMM_LDS_BYTES 32768
struct ALoadPlain { const bf16_t* A; int lda;
  __device__ __forceinline__ u32x4 operator()(int row, int k) const { return *(const u32x4*)(A + (long)row * lda + k); } };
#define GEMM_STAGE_WRITE(RA, RB) do { _Pragma("unroll") for (int i = 0; i < 4; ++i) { int r = lrow + 32 * i; int off = r * 128 + ((lchunk ^ (r & 7)) << 4); *(u32x4*)(As + off) = RA[i]; *(u32x4*)(Bs + off) = RB[i]; } } while (0)
#define GEMM_COMPUTE_TILE() do { _Pragma("unroll") for (int ks = 0; ks < 2; ++ks) { bf16x8 af[4], bfr[4]; \
    _Pragma("unroll") for (int i = 0; i < 4; ++i) { int r = wm * 64 + i * 16 + fr; af[i] = *(const bf16x8*)(As + r * 128 + (((ks * 4 + fq) ^ (r & 7)) << 4)); \
      int rn = wn * 64 + i * 16 + fr; bfr[i] = *(const bf16x8*)(Bs + rn * 128 + (((ks * 4 + fq) ^ (rn & 7)) << 4)); } \
    _Pragma("unroll") for (int i = 0; i < 4; ++i) _Pragma("unroll") for (int j = 0; j < 4; ++j) acc[i][j] = __builtin_amdgcn_mfma_f32_16x16x32_bf16(bfr[j], af[i], acc[i][j], 0, 0, 0); } } while (0)
template <class ALoad, class Epi>
__device__ __forceinline__ void gemm_tile_128(ALoad aload, const bf16_t* __restrict__ Bt, int ldb, int K,
                                              int tile_m, int tile_n, char* smem, Epi epi) {
  const int t = tid_opaque(), lane = t & 63, wave = t >> 6;
  const int wm = wave >> 1, wn = wave & 1;
  char* As = smem; char* Bs = smem + 16384;
  const int lrow = t >> 3, lchunk = t & 7;
  const int arow = tile_m * 128 + lrow;
  const bf16_t* bg = Bt + (long)(tile_n * 128 + lrow) * ldb + lchunk * 8;
  u32x4 ra0[4], rb0[4], ra1[4], rb1[4];
#pragma unroll
  for (int i = 0; i < 4; ++i) { ra0[i] = aload(arow + 32 * i, lchunk * 8); rb0[i] = *(const u32x4*)(bg + (long)(32 * i) * ldb); }
  if (K > 64) {
#pragma unroll
    for (int i = 0; i < 4; ++i) { ra1[i] = aload(arow + 32 * i, 64 + lchunk * 8); rb1[i] = *(const u32x4*)(bg + (long)(32 * i) * ldb + 64); }
  }
  f32x4 acc[4][4];
#pragma unroll
  for (int i = 0; i < 4; ++i)
#pragma unroll
    for (int j = 0; j < 4; ++j) acc[i][j] = (f32x4){0.f, 0.f, 0.f, 0.f};
  const int fr = lane & 15, fq = lane >> 4;
  for (int k0 = 0; k0 < K; k0 += 128) {
    __syncthreads();
    GEMM_STAGE_WRITE(ra0, rb0);
    __syncthreads();
    if (k0 + 128 < K) {
#pragma unroll
      for (int i = 0; i < 4; ++i) { ra0[i] = aload(arow + 32 * i, k0 + 128 + lchunk * 8); rb0[i] = *(const u32x4*)(bg + (long)(32 * i) * ldb + k0 + 128); }
    }
    GEMM_COMPUTE_TILE();
    if (k0 + 64 < K) {
      __syncthreads();
      GEMM_STAGE_WRITE(ra1, rb1);
      __syncthreads();
      if (k0 + 192 < K) {
#pragma unroll
        for (int i = 0; i < 4; ++i) { ra1[i] = aload(arow + 32 * i, k0 + 192 + lchunk * 8); rb1[i] = *(const u32x4*)(bg + (long)(32 * i) * ldb + k0 + 192); }
      }
      GEMM_COMPUTE_TILE();
    }
  }
#pragma unroll
  for (int i = 0; i < 4; ++i)
#pragma unroll
    for (int j = 0; j < 4; ++j) {
      int m = tile_m * 128 + wm * 64 + i * 16 + fr; int n0 = tile_n * 128 + wn * 64 + j * 16 + fq * 4;
      epi(m, n0, acc[i][j]);
    }
}

typedef __attribute__((address_space(3))) void lds_void_t;
typedef __attribute__((address_space(1))) const void glb_cvoid_t;
#define GEMM_GLDS_BYTES 65536
__device__ __forceinline__ void gemm_mainloop_glds(const bf16_t* __restrict__ A, int lda, const bf16_t* __restrict__ Bt, int ldb, int K,
                                                   int tile_m, int tile_n, char* smem, f32x4 (&acc)[4][4]) {
  const int t = tid_opaque(), lane = t & 63, wave = t >> 6;
  const int wm = wave >> 1, wn = wave & 1, fr = lane & 15, fq = lane >> 4;
  const int lrow = t >> 3, cl = (t & 7) ^ (lrow & 7);
  const bf16_t* ag = A + (long)(tile_m * 128 + lrow) * lda + cl * 8;
  const bf16_t* bg = Bt + (long)(tile_n * 128 + lrow) * ldb + cl * 8;
  const int wbase = __builtin_amdgcn_readfirstlane(wave) * 1024;
#pragma unroll
  for (int i = 0; i < 4; ++i)
#pragma unroll
    for (int j = 0; j < 4; ++j) acc[i][j] = (f32x4){0.f, 0.f, 0.f, 0.f};
  __syncthreads();
#pragma unroll
  for (int i = 0; i < 4; ++i) {
    __builtin_amdgcn_global_load_lds((glb_cvoid_t*)(ag + (long)(32 * i) * lda), (lds_void_t*)(smem + i * 4096 + wbase), 16, 0, 0);
    __builtin_amdgcn_global_load_lds((glb_cvoid_t*)(bg + (long)(32 * i) * ldb), (lds_void_t*)(smem + 16384 + i * 4096 + wbase), 16, 0, 0);
  }
  int buf = 0;
  for (int k0 = 0; k0 < K; k0 += 64, buf ^= 1) {
    __syncthreads();
    if (k0 + 64 < K) {
      char* nb = smem + (buf ^ 1) * 32768;
#pragma unroll
      for (int i = 0; i < 4; ++i) {
        __builtin_amdgcn_global_load_lds((glb_cvoid_t*)(ag + (long)(32 * i) * lda + k0 + 64), (lds_void_t*)(nb + i * 4096 + wbase), 16, 0, 0);
        __builtin_amdgcn_global_load_lds((glb_cvoid_t*)(bg + (long)(32 * i) * ldb + k0 + 64), (lds_void_t*)(nb + 16384 + i * 4096 + wbase), 16, 0, 0);
      }
    }
    const char* As = smem + buf * 32768; const char* Bs = As + 16384;
    GEMM_COMPUTE_TILE();
  }
}
template <class Epi>
__device__ __forceinline__ void gemm_tile_128_glds(const bf16_t* __restrict__ A, int lda, const bf16_t* __restrict__ Bt, int ldb, int K,
                                                   int tile_m, int tile_n, char* smem, Epi epi) {
  f32x4 acc[4][4];
  gemm_mainloop_glds(A, lda, Bt, ldb, K, tile_m, tile_n, smem, acc);
  const int t = tid_opaque(), lane = t & 63, wave = t >> 6, wm = wave >> 1, wn = wave & 1, fr = lane & 15, fq = lane >> 4;
#pragma unroll
  for (int i = 0; i < 4; ++i)
#pragma unroll
    for (int j = 0; j < 4; ++j) {
      int m = tile_m * 128 + wm * 64 + i * 16 + fr; int n0 = tile_n * 128 + wn * 64 + j * 16 + fq * 4;
      epi(m, n0, acc[i][j]);
    }
}

__global__ void ok_cvt_wT(const float* W, bf16_t* Wt, int K, int N, int Npad) {
  long i = (long)blockIdx.x * blockDim.x + threadIdx.x;
  if (i >= (long)Npad * K) return;
  int k = i % K; int n = i / K;
  Wt[i] = n < N ? f2bf(W[(long)k * N + n]) : (bf16_t)0;
}
__global__ void ok_f32_to_bf16(const float* s, bf16_t* d, long n) {
  long i = (long)blockIdx.x * blockDim.x + threadIdx.x; if (i < n) d[i] = f2bf(s[i]);
}
__global__ void ok_bf16_to_f32(const bf16_t* s, float* d, long n) {
  long i = (long)blockIdx.x * blockDim.x + threadIdx.x; if (i < n) d[i] = bf2f(s[i]);
}
__global__ void ok_norm_mod_bf16(const float* xs, const float* g, const float* modl, int shift_idx, bf16_t* xn, int M) {
  int row = blockIdx.x * 4 + (threadIdx.x >> 6); int lane = threadIdx.x & 63;
  if (row >= M) return;
  int b = row / RB, lr = row % RB; int bb = lr < SEQ ? b : BATCH;
  const float* sh = modl + ((long)bb * 6 + shift_idx) * DM; const float* sc = sh + DM;
  const float* xr = xs + (long)row * DM; float v[16]; float ss = 0.f;
#pragma unroll
  for (int i = 0; i < 4; ++i) { float4 q = *(const float4*)(xr + i * 256 + lane * 4); v[i*4]=q.x; v[i*4+1]=q.y; v[i*4+2]=q.z; v[i*4+3]=q.w; ss += q.x*q.x+q.y*q.y+q.z*q.z+q.w*q.w; }
#pragma unroll
  for (int o = 32; o > 0; o >>= 1) ss += __shfl_xor(ss, o);
  float inv = 1.f / sqrtf(ss / DM + EPSN);
#pragma unroll
  for (int i = 0; i < 4; ++i) {
    int d = i * 256 + lane * 4; float o[4];
#pragma unroll
    for (int e = 0; e < 4; ++e) o[e] = v[i*4+e] * inv * g[d+e] * (1.f + sc[d+e]) + sh[d+e];
    uint2 pk; pk.x = pack2bf(o[0], o[1]); pk.y = pack2bf(o[2], o[3]);
    *(uint2*)(xn + (long)row * DM + d) = pk;
  }
}

struct EpiStoreBf16 { bf16_t* C; int ldc; int N;
  __device__ __forceinline__ void operator()(int m, int n0, f32x4 v) const {
    if (n0 < N) { uint2 pk; pk.x = pack2bf(v[0], v[1]); pk.y = pack2bf(v[2], v[3]); *(uint2*)(C + (long)m * ldc + n0) = pk; } } };
struct EpiStoreF32 { float* C; int ldc; int N;
  __device__ __forceinline__ void operator()(int m, int n0, f32x4 v) const {
    if (n0 < N) *(float4*)(C + (long)m * ldc + n0) = make_float4(v[0], v[1], v[2], v[3]); } };
struct EpiResid { float* xs; const float* modl; int gi; int pad;
  __device__ __forceinline__ void operator()(int m, int n0, f32x4 v) const {
    int b = m / RB, lr = m % RB; int bb = lr < SEQ ? b : BATCH; const float* g = modl + ((long)bb * 6 + gi) * DM + n0;
    float4 x = *(float4*)(xs + (long)m * DM + n0);
    x.x += g[0] * v[0]; x.y += g[1] * v[1]; x.z += g[2] * v[2]; x.w += g[3] * v[3];
    *(float4*)(xs + (long)m * DM + n0) = x; } };

template <class Epi>
__global__ void __launch_bounds__(256) ok_gemm(const bf16_t* A, int lda, const bf16_t* Bt, int ldb, int K, int tiles_m, int tiles_n, Epi epi) {
  __shared__ __attribute__((aligned(16))) char smem[GEMM_LDS_BYTES];
  for (int tile = blockIdx.x; tile < tiles_m * tiles_n; tile += gridDim.x) {
    int tm = tile / tiles_n, tn = tile % tiles_n;
    gemm_tile_128(ALoadPlain{A, lda}, Bt, ldb, K, tm, tn, smem, epi);
  }
}

__device__ __forceinline__ float dot2bf(unsigned a, unsigned b, float c) {
  return __builtin_amdgcn_fdot2_f32_bf16(*(bf16v2*)&a, *(bf16v2*)&b, c, false);
}
__global__ void ok_cvt_bf16_v8(const float* s, bf16_t* d, long n8) {
  long i = (long)blockIdx.x * blockDim.x + threadIdx.x; if (i >= n8) return;
  float4 a = *(const float4*)(s + i * 8), b = *(const float4*)(s + i * 8 + 4);
  u32x4 o; o[0] = pack2bf(a.x, a.y); o[1] = pack2bf(a.z, a.w); o[2] = pack2bf(b.x, b.y); o[3] = pack2bf(b.z, b.w);
  *(u32x4*)(d + i * 8) = o;
}

#define P5_LDS_BYTES (128 * 128 * 4)
__device__ __forceinline__ void peer_q_top1_tile(const bf16_t* __restrict__ A, const bf16_t* __restrict__ WqT, const bf16_t* __restrict__ keysb,
                                                 unsigned* __restrict__ top1, int tm, int ps, char* smem) {
  const int t = tid_opaque(), lane = t & 63, wave = t >> 6, wm = wave >> 1, wn = wave & 1, fr = lane & 15, fq = lane >> 4;
  f32x4 acc[4][4];
  gemm_mainloop_glds(A, DM, WqT, DM, DM, tm, ps, smem, acc);
  __syncthreads();
  char* Qs = smem; char* Ks = smem + 32768;
#pragma unroll
  for (int i = 0; i < 4; ++i)
#pragma unroll
    for (int j = 0; j < 4; ++j) {
      int m = wm * 64 + i * 16 + fr; int n0 = wn * 64 + j * 16 + fq * 4;
      uint2 pk; pk.x = pack2bf(acc[i][j][0], acc[i][j][1]); pk.y = pack2bf(acc[i][j][2], acc[i][j][3]);
      *(uint2*)(Qs + m * 256 + ((((n0 >> 3) ^ (m & 15)) << 4) | ((n0 & 7) << 1))) = pk;
    }
  {
    const bf16_t* kg = keysb + (long)ps * 128 * 128;
#pragma unroll
    for (int i = 0; i < 8; ++i) { int idx = t + 256 * i; int r = idx >> 4, c = idx & 15; *(u32x4*)(Ks + r * 256 + ((c ^ (r & 15)) << 4)) = *(const u32x4*)(kg + r * 128 + c * 8); }
  }
  __syncthreads();
#pragma unroll
  for (int i = 0; i < 4; ++i)
#pragma unroll
    for (int j = 0; j < 4; ++j) acc[i][j] = (f32x4){0.f, 0.f, 0.f, 0.f};
#pragma unroll
  for (int ks = 0; ks < 4; ++ks) {
    bf16x8 af[4], bfr[4];
#pragma unroll
    for (int i = 0; i < 4; ++i) {
      int r = wm * 64 + i * 16 + fr; af[i] = *(const bf16x8*)(Qs + r * 256 + (((ks * 4 + fq) ^ (r & 15)) << 4));
      int rn = wn * 64 + i * 16 + fr; bfr[i] = *(const bf16x8*)(Ks + rn * 256 + (((ks * 4 + fq) ^ (rn & 15)) << 4));
    }
#pragma unroll
    for (int i = 0; i < 4; ++i)
#pragma unroll
      for (int j = 0; j < 4; ++j) acc[i][j] = __builtin_amdgcn_mfma_f32_16x16x32_bf16(bfr[j], af[i], acc[i][j], 0, 0, 0);
  }
  __syncthreads();
  unsigned* Sc = (unsigned*)smem;
#pragma unroll
  for (int i = 0; i < 4; ++i)
#pragma unroll
    for (int j = 0; j < 4; ++j) {
      int m = wm * 64 + i * 16 + fr; int n0 = wn * 64 + j * 16 + fq * 4;
#pragma unroll
      for (int e = 0; e < 4; ++e) Sc[(n0 + e) * 128 + (m ^ ((((n0 + e) >> 2) & 1) << 4))] = enc_key(acc[i][j][e], n0 + e);
    }
  __syncthreads();
  {
    const int r = t & 127, half = t >> 7;
    unsigned l[16];
#pragma unroll
    for (int i = 0; i < 16; ++i) l[i] = 0u;
    for (int k = 0; k < 64; ++k) ins16(l, Sc[(half * 64 + k) * 128 + (r ^ (((k >> 2) & 1) << 4))]);
    __syncthreads();
    unsigned* Ls = (unsigned*)smem;
    if (half == 1) {
#pragma unroll
      for (int i = 0; i < 16; ++i) Ls[r * 17 + i] = l[15 - i];
    }
    __syncthreads();
    if (half == 0) {
      unsigned br[16];
#pragma unroll
      for (int i = 0; i < 16; ++i) br[i] = Ls[r * 17 + i];
      merge16(l, br);
      unsigned* o = top1 + ((long)(tm * 128 + r) * 16 + ps) * 16;
#pragma unroll
      for (int i = 0; i < 4; ++i) { u32x4 v; v[0] = l[4*i]; v[1] = l[4*i+1]; v[2] = l[4*i+2]; v[3] = l[4*i+3]; *(u32x4*)(o + 4 * i) = v; }
    }
  }
}
__global__ void __launch_bounds__(256) ok_peer_q_top1(const bf16_t* A, const bf16_t* WqT, const bf16_t* keysb, unsigned* top1, int tiles_m) {
  __shared__ __attribute__((aligned(16))) char smem[P5_LDS_BYTES];
  for (int tile = blockIdx.x; tile < tiles_m * 16; tile += gridDim.x) { peer_q_top1_tile(A, WqT, keysb, top1, tile / 16, tile % 16, smem); __syncthreads(); }
}

#define P6_LDS_BYTES (32 * 128 * 4 * 3)
__device__ __forceinline__ void peer_gather_group(const bf16_t* __restrict__ xn, const unsigned* __restrict__ top1, const bf16_t* __restrict__ ub,
                                                  const bf16_t* __restrict__ vb, const float* __restrict__ modl, float* __restrict__ xs, int grp, char* smem) {
  const int t = tid_opaque(), lane = t & 63, wave = t >> 6;
  int* pe_l = (int*)smem; float* pg_l = (float*)(smem + 32 * 128 * 4); float* pw_l = (float*)(smem + 2 * 32 * 128 * 4);
  {
    int tl = t >> 3, p = t & 7; long row = (long)grp * 32 + tl;
    peer_combine(top1 + (row * 16 + p * 2) * 16, top1 + (row * 16 + p * 2 + 1) * 16, pe_l + tl * 128 + p * 16, pg_l + tl * 128 + p * 16);
  }
  __syncthreads();
  for (int ti = 0; ti < 8; ++ti) {
    const int tl = wave * 8 + ti; const long row = (long)grp * 32 + tl;
    const int* pe = pe_l + tl * 128; float* pw = pw_l + tl * 128;
    u32x4 h0 = *(const u32x4*)(xn + row * DM + lane * 8), h1 = *(const u32x4*)(xn + row * DM + 512 + lane * 8);
    for (int b = 0; b < 16; ++b) {
      u32x4 u0[8], u1[8];
#pragma unroll
      for (int j = 0; j < 8; ++j) { const bf16_t* ur = ub + (long)pe[b * 8 + j] * DM + lane * 8; u0[j] = *(const u32x4*)ur; u1[j] = *(const u32x4*)(ur + 512); }
      float pd[8];
#pragma unroll
      for (int j = 0; j < 8; ++j) {
        float a = 0.f;
#pragma unroll
        for (int e = 0; e < 4; ++e) { a = dot2bf(h0[e], u0[j][e], a); a = dot2bf(h1[e], u1[j][e], a); }
        pd[j] = a;
      }
      float q4[4], q2[2], q1;
#pragma unroll
      for (int j = 0; j < 4; ++j) { bool hi = lane & 1; float keep = hi ? pd[2*j+1] : pd[2*j], send = hi ? pd[2*j] : pd[2*j+1]; q4[j] = keep + __shfl_xor(send, 1); }
#pragma unroll
      for (int j = 0; j < 2; ++j) { bool hi = lane & 2; float keep = hi ? q4[2*j+1] : q4[2*j], send = hi ? q4[2*j] : q4[2*j+1]; q2[j] = keep + __shfl_xor(send, 2); }
      { bool hi = lane & 4; float keep = hi ? q2[1] : q2[0], send = hi ? q2[0] : q2[1]; q1 = keep + __shfl_xor(send, 4); }
      q1 += __shfl_xor(q1, 8); q1 += __shfl_xor(q1, 16); q1 += __shfl_xor(q1, 32);
      if (lane < 8) { int j = lane & 7; pw[b * 8 + j] = q1; }
    }
    {
      float d0 = pw[lane], d1 = pw[64 + lane];
      pw[lane] = pg_l[tl * 128 + lane] * geluf_(d0); pw[64 + lane] = pg_l[tl * 128 + 64 + lane] * geluf_(d1);
    }
    float o[16];
#pragma unroll
    for (int e = 0; e < 16; ++e) o[e] = 0.f;
    for (int b = 0; b < 16; ++b) {
      u32x4 v0[8], v1[8];
#pragma unroll
      for (int j = 0; j < 8; ++j) { const bf16_t* vr = vb + (long)pe[b * 8 + j] * DM + lane * 8; v0[j] = *(const u32x4*)vr; v1[j] = *(const u32x4*)(vr + 512); }
#pragma unroll
      for (int j = 0; j < 8; ++j) {
        float w = pw[b * 8 + j];
#pragma unroll
        for (int e = 0; e < 4; ++e) {
          o[2*e]     += w * __uint_as_float(v0[j][e] << 16); o[2*e+1]     += w * __uint_as_float(v0[j][e] & 0xffff0000u);
          o[8 + 2*e] += w * __uint_as_float(v1[j][e] << 16); o[8 + 2*e+1] += w * __uint_as_float(v1[j][e] & 0xffff0000u);
        }
      }
    }
    {
      int b = row / RB, lr = row % RB; int bb = lr < SEQ ? b : BATCH; const float* g5 = modl + ((long)bb * 6 + 5) * DM;
      float* xr = xs + row * DM;
#pragma unroll
      for (int hf = 0; hf < 2; ++hf) {
        int d = hf * 512 + lane * 8;
        float4 x0 = *(float4*)(xr + d), x1 = *(float4*)(xr + d + 4); float4 g0 = *(const float4*)(g5 + d), g1 = *(const float4*)(g5 + d + 4);
        x0.x += g0.x * o[hf*8+0]; x0.y += g0.y * o[hf*8+1]; x0.z += g0.z * o[hf*8+2]; x0.w += g0.w * o[hf*8+3];
        x1.x += g1.x * o[hf*8+4]; x1.y += g1.y * o[hf*8+5]; x1.z += g1.z * o[hf*8+6]; x1.w += g1.w * o[hf*8+7];
        *(float4*)(xr + d) = x0; *(float4*)(xr + d + 4) = x1;
      }
    }
  }
}
__global__ void __launch_bounds__(256) ok_peer_gather(const bf16_t* xn, const unsigned* top1, const bf16_t* ub, const bf16_t* vb, const float* modl, float* xs, int ngroups) {
  __shared__ __attribute__((aligned(16))) char smem[P6_LDS_BYTES];
  for (int g = blockIdx.x; g < ngroups; g += gridDim.x) { peer_gather_group(xn, top1, ub, vb, modl, xs, g, smem); __syncthreads(); }
}

template <int DQ> struct AttnCfg { static constexpr int KROW = DQ * 2 + 16; static constexpr int VROW = 136; static constexpr int KBYTES = 64 * KROW; static constexpr int LDS = 64 * KROW + 64 * VROW; };
#define ATTN_LDS_BYTES (64 * 208 + 64 * 136)
template <int DQ>
__device__ __forceinline__ void attn_block(const bf16_t* __restrict__ qb, int HQ, const bf16_t* __restrict__ kb, int HK, const bf16_t* __restrict__ vT, int G,
                                           bf16_t* __restrict__ mixall, int ooff, int b, int head, int qt, char* smem) {
  constexpr int KROW = AttnCfg<DQ>::KROW, VROW = 136, NKK = DQ / 16, KCH = DQ / 8;
  constexpr int KLD = (64 * KCH) / 256;
  const int t = tid_opaque(), lane = t & 63, wave = t >> 6, lq = lane & 31, lh = lane >> 5;
  const int hk = head / G;
  char* Ks = smem; char* Vs = smem + 64 * KROW;
  const long qrow = (long)b * RB + qt * 128 + wave * 32 + lq;
  bf16x8 qf[NKK];
#pragma unroll
  for (int kk = 0; kk < NKK; ++kk) qf[kk] = *(const bf16x8*)(qb + (qrow * HQ + head) * DQ + kk * 16 + lh * 8);
  const int key0 = qt < 16 ? 0 : SEQ; const int nt = qt < 16 ? RB / 64 : CTX_LEN / 64;
  const bf16_t* kbase = kb + ((long)b * RB * HK + hk) * DQ; const bf16_t* vbase = vT + ((long)(b * HK + hk) * 64) * RB;
  u32x4 rk[KLD], rv[2];
  auto issue = [&](int tile) {
    int k0 = key0 + tile * 64;
#pragma unroll
    for (int i = 0; i < KLD; ++i) { int c = t + 256 * i; int r = c / KCH, cc = c % KCH; rk[i] = *(const u32x4*)(kbase + (long)(k0 + r) * HK * DQ + cc * 8); }
#pragma unroll
    for (int i = 0; i < 2; ++i) { int c = t + 256 * i; int r = c >> 3, cc = c & 7; rv[i] = *(const u32x4*)(vbase + (long)r * RB + k0 + cc * 8); }
  };
  issue(0);
  f32x16 ot[2];
#pragma unroll
  for (int d = 0; d < 2; ++d)
#pragma unroll
    for (int r = 0; r < 16; ++r) ot[d][r] = 0.f;
  float mrun = -1e30f, lrun = 0.f;
  for (int tile = 0; tile < nt; ++tile) {
    __syncthreads();
#pragma unroll
    for (int i = 0; i < KLD; ++i) { int c = t + 256 * i; int r = c / KCH, cc = c % KCH; *(u32x4*)(Ks + r * KROW + cc * 16) = rk[i]; }
#pragma unroll
    for (int i = 0; i < 2; ++i) { int c = t + 256 * i; int r = c >> 3, cc = c & 7; *(uint2*)(Vs + r * VROW + cc * 16) = make_uint2(rv[i][0], rv[i][1]); *(uint2*)(Vs + r * VROW + cc * 16 + 8) = make_uint2(rv[i][2], rv[i][3]); }
    __syncthreads();
    if (tile + 1 < nt) issue(tile + 1);
    f32x16 st[2];
#pragma unroll
    for (int kt = 0; kt < 2; ++kt) {
#pragma unroll
      for (int r = 0; r < 16; ++r) st[kt][r] = 0.f;
#pragma unroll
      for (int kk = 0; kk < NKK; ++kk) {
        bf16x8 ka = *(const bf16x8*)(Ks + (kt * 32 + lq) * KROW + kk * 32 + lh * 16);
        st[kt] = __builtin_amdgcn_mfma_f32_32x32x16_bf16(ka, qf[kk], st[kt], 0, 0, 0);
      }
    }
    float mt = st[0][0];
#pragma unroll
    for (int kt = 0; kt < 2; ++kt)
#pragma unroll
      for (int r = 0; r < 16; ++r) mt = fmaxf(mt, st[kt][r]);
    mt = fmaxf(mt, __shfl_xor(mt, 32));
    float mnew = fmaxf(mrun, mt); float alpha = __builtin_amdgcn_exp2f(mrun - mnew); mrun = mnew;
    float ps = 0.f;
#pragma unroll
    for (int kt = 0; kt < 2; ++kt)
#pragma unroll
      for (int r = 0; r < 16; ++r) { float p = __builtin_amdgcn_exp2f(st[kt][r] - mnew); st[kt][r] = p; ps += p; }
    lrun = lrun * alpha + ps;
#pragma unroll
    for (int d = 0; d < 2; ++d)
#pragma unroll
      for (int r = 0; r < 16; ++r) ot[d][r] *= alpha;
#pragma unroll
    for (int kt = 0; kt < 2; ++kt)
#pragma unroll
      for (int s = 0; s < 2; ++s) {
        union { bf16x8 v; unsigned u[4]; } pb;
#pragma unroll
        for (int j = 0; j < 4; ++j) pb.u[j] = pack2bf(st[kt][8 * s + 2 * j], st[kt][8 * s + 2 * j + 1]);
#pragma unroll
        for (int d = 0; d < 2; ++d) {
          const char* vp = Vs + (d * 32 + lq) * VROW + (kt * 32 + 16 * s + 4 * lh) * 2;
          union { bf16x8 v; uint2 h[2]; } va; va.h[0] = *(const uint2*)vp; va.h[1] = *(const uint2*)(vp + 16);
          ot[d] = __builtin_amdgcn_mfma_f32_32x32x16_bf16(va.v, pb.v, ot[d], 0, 0, 0);
        }
      }
  }
  float ltot = lrun + __shfl_xor(lrun, 32); float inv = 1.f / ltot;
  bf16_t* orow = mixall + qrow * DM + ooff + head * 64;
#pragma unroll
  for (int d = 0; d < 2; ++d)
#pragma unroll
    for (int g = 0; g < 4; ++g) {
      uint2 pk; pk.x = pack2bf(ot[d][4 * g] * inv, ot[d][4 * g + 1] * inv); pk.y = pack2bf(ot[d][4 * g + 2] * inv, ot[d][4 * g + 3] * inv);
      *(uint2*)(orow + d * 32 + 8 * g + 4 * lh) = pk;
    }
}
__global__ void __launch_bounds__(256) ok_attn(const bf16_t* mq, const bf16_t* mk, const bf16_t* mvT, const bf16_t* gq, const bf16_t* gk, const bf16_t* gvT, bf16_t* mixall, int nqt) {
  __shared__ __attribute__((aligned(16))) char smem[ATTN_LDS_BYTES];
  const int n_mla = BATCH * 4 * nqt, n_gqa = BATCH * 6 * nqt;
  for (int w = blockIdx.x; w < n_mla + n_gqa; w += gridDim.x) {
    if (w < n_mla) { int qt = w % nqt, head = (w / nqt) % 4, b = w / (nqt * 4); attn_block<96>(mq, 4, mk, 4, mvT, 1, mixall, 0, b, head, qt, smem); }
    else { int v = w - n_mla; int qt = v % nqt, head = (v / nqt) % 6, b = v / (nqt * 6); attn_block<64>(gq, 6, gk, 2, gvT, 3, mixall, 640, b, head, qt, smem); }
    __syncthreads();
  }
}
__global__ void ok_adapt_rows(const float* src, int sld, int scol, int ncols, float scale, bf16_t* dst, int dld, int nrows) {
  long i = (long)blockIdx.x * blockDim.x + threadIdx.x; if (i >= (long)nrows * ncols) return;
  int c = i % ncols; long r = i / ncols; dst[r * dld + c] = f2bf(src[r * sld + scol + c] * scale);
}
__global__ void ok_adapt_vT(const float* src, int sld, int scol, int hstride, int H, bf16_t* dst) {
  long i = (long)blockIdx.x * blockDim.x + threadIdx.x; if (i >= (long)H * 64 * RB) return;
  int lr = i % RB; int d = (i / RB) % 64; int h = i / ((long)RB * 64);
  dst[i] = f2bf(src[(long)lr * sld + scol + h * hstride + d]);
}

typedef __attribute__((ext_vector_type(2))) float f32x2;
#define SCAN_TS 16
#define SCAN_LDS_BYTES (2 * SCAN_TS * 1536 + 2 * SCAN_TS * 32 * 4)
template <int CTRL> __device__ __forceinline__ float dpp_get(float x) { return __builtin_bit_cast(float, __builtin_amdgcn_update_dpp(0, __builtin_bit_cast(int, x), CTRL, 0xf, 0xf, true)); }
__device__ __forceinline__ float swz_xor4(float x) { return __builtin_bit_cast(float, __builtin_amdgcn_ds_swizzle(__builtin_bit_cast(int, x), 0x101F)); }
__device__ __forceinline__ float reduce8(float x) {
  x += __builtin_bit_cast(float, __builtin_amdgcn_update_dpp(0, __builtin_bit_cast(int, x), 0xB1, 0xf, 0xf, true));
  x += __builtin_bit_cast(float, __builtin_amdgcn_update_dpp(0, __builtin_bit_cast(int, x), 0x4E, 0xf, 0xf, true));
  x += __builtin_bit_cast(float, __builtin_amdgcn_update_dpp(0, __builtin_bit_cast(int, x), 0x141, 0xf, 0xf, true));
  return x;
}
__device__ __forceinline__ int scan_row(int dir, int s) {
  if (s < CTX_LEN) return SEQ + (dir == 0 ? s : CTX_LEN - 1 - s);
  return dir == 0 ? s - CTX_LEN : SEQ - 1 - (s - CTX_LEN);
}
__device__ __forceinline__ void rw_scan_block(const bf16_t* __restrict__ r_, const bf16_t* __restrict__ v_, const bf16_t* __restrict__ kk_, const bf16_t* __restrict__ kd_,
                                              const bf16_t* __restrict__ bd_, const float* __restrict__ w_, float* __restrict__ y_, int item, long dstride, char* smem) {
  const int t = tid_opaque(), lane = t & 63, wave = t >> 6, cg = lane & 7, il = wave * 8 + (lane >> 3);
  const int half = item & 1, dir = (item >> 1) & 1, h = (item >> 2) % 6, b = item / 24;
  const long rowbase = (long)b * RB; const int col0 = h * 64;
  float* ybuf = (float*)(smem + 2 * SCAN_TS * 1536);
  const int st_ld = t >> 4, part = t & 15;
  u32x4 la, lb, lc, lw;
  auto issue = [&](int c) {
    long row = rowbase + scan_row(dir, c * SCAN_TS + st_ld); long o = row * 384 + col0;
    const int ch = (part & 7) * 8;
    la = *(const u32x4*)((part < 8 ? kk_ + o : bd_ + dir * dstride + o) + ch);
    lb = *(const u32x4*)((part < 8 ? kd_ + dir * dstride + o : r_ + o) + ch);
    lc = *(const u32x4*)(v_ + o + ch);
    lw = *(const u32x4*)(w_ + dir * dstride + o + part * 4);
  };
  auto stash = [&](int buf) {
    float* base = (float*)(smem + buf * SCAN_TS * 1536 + st_ld * 1536);
    const int ch = (part & 7) * 8;
    float* pa = base + (part < 8 ? 64 : 128) + ch; float* pb = base + (part < 8 ? 192 : 256) + ch;
    f32x4 x0, x1;
#pragma unroll
    for (int e = 0; e < 2; ++e) { x0[2*e] = __uint_as_float(la[e] << 16); x0[2*e+1] = __uint_as_float(la[e] & 0xffff0000u); x1[2*e] = __uint_as_float(la[2+e] << 16); x1[2*e+1] = __uint_as_float(la[2+e] & 0xffff0000u); }
    *(f32x4*)pa = x0; *(f32x4*)(pa + 4) = x1;
#pragma unroll
    for (int e = 0; e < 2; ++e) { x0[2*e] = __uint_as_float(lb[e] << 16); x0[2*e+1] = __uint_as_float(lb[e] & 0xffff0000u); x1[2*e] = __uint_as_float(lb[2+e] << 16); x1[2*e+1] = __uint_as_float(lb[2+e] & 0xffff0000u); }
    *(f32x4*)pb = x0; *(f32x4*)(pb + 4) = x1;
    if (part < 8) {
      float* pc = base + 320 + ch;
#pragma unroll
      for (int e = 0; e < 2; ++e) { x0[2*e] = __uint_as_float(lc[e] << 16); x0[2*e+1] = __uint_as_float(lc[e] & 0xffff0000u); x1[2*e] = __uint_as_float(lc[2+e] << 16); x1[2*e+1] = __uint_as_float(lc[2+e] & 0xffff0000u); }
      *(f32x4*)pc = x0; *(f32x4*)(pc + 4) = x1;
    }
    *(u32x4*)(base + part * 4) = lw;
  };
  f32x2 S[4];
#pragma unroll
  for (int j = 0; j < 4; ++j) S[j] = (f32x2){0.f, 0.f};
  const int NCH = RB / SCAN_TS;
  __builtin_amdgcn_s_setprio(3);
  issue(0);
  for (int c = 0; c < NCH; ++c) {
    const int buf = c & 1;
    stash(buf);
    __syncthreads();
    if (c > 0 && t < 128) {
      int st = t >> 3, i4 = (t & 7) * 4; long row = rowbase + scan_row(dir, (c - 1) * SCAN_TS + st);
      *(f32x4*)(y_ + dir * dstride + row * 384 + col0 + half * 32 + i4) = *(const f32x4*)(ybuf + (buf ^ 1) * SCAN_TS * 32 + st * 32 + i4);
    }
    if (c + 1 < NCH) issue(c + 1);
    const float* ob = (const float*)(smem + buf * SCAN_TS * 1536) + cg * 8;
    const float* vb_ = (const float*)(smem + buf * SCAN_TS * 1536) + 320 + half * 32 + il;
    float yk[SCAN_TS];
    f32x4 nw0 = *(const f32x4*)(ob), nw1 = *(const f32x4*)(ob + 4), nk0 = *(const f32x4*)(ob + 64), nk1 = *(const f32x4*)(ob + 68);
    f32x4 nb0 = *(const f32x4*)(ob + 128), nb1 = *(const f32x4*)(ob + 132), nd0 = *(const f32x4*)(ob + 192), nd1 = *(const f32x4*)(ob + 196);
    f32x4 nr0 = *(const f32x4*)(ob + 256), nr1 = *(const f32x4*)(ob + 260); float nvi = vb_[0];
#pragma unroll
    for (int st = 0; st < SCAN_TS; ++st) {
      const f32x4 w0 = nw0, w1 = nw1, k0 = nk0, k1 = nk1, b0 = nb0, b1 = nb1, d0 = nd0, d1 = nd1, r0 = nr0, r1 = nr1; const float vi = nvi;
      if (st + 1 < SCAN_TS) {
        const float* o = ob + (st + 1) * 384;
        nw0 = *(const f32x4*)(o); nw1 = *(const f32x4*)(o + 4); nk0 = *(const f32x4*)(o + 64); nk1 = *(const f32x4*)(o + 68);
        nb0 = *(const f32x4*)(o + 128); nb1 = *(const f32x4*)(o + 132); nd0 = *(const f32x4*)(o + 192); nd1 = *(const f32x4*)(o + 196);
        nr0 = *(const f32x4*)(o + 256); nr1 = *(const f32x4*)(o + 260); nvi = vb_[(st + 1) * 384];
      }
      __builtin_amdgcn_sched_barrier(0);
      f32x2 a2 = S[0] * (f32x2){k0[0], k0[1]}, c2 = S[2] * (f32x2){k1[0], k1[1]};
      a2 += S[1] * (f32x2){k0[2], k0[3]}; c2 += S[3] * (f32x2){k1[2], k1[3]};
      a2 += c2;
      const f32x2 vv = (f32x2){vi, vi};
      f32x2 t0 = vv * (f32x2){d0[0], d0[1]}, t1 = vv * (f32x2){d0[2], d0[3]}, t2 = vv * (f32x2){d1[0], d1[1]}, t3 = vv * (f32x2){d1[2], d1[3]};
      float skk = reduce8(a2[0] + a2[1]);
      const f32x2 ns = (f32x2){-skk, -skk};
      t0 += ns * (f32x2){b0[0], b0[1]}; t1 += ns * (f32x2){b0[2], b0[3]}; t2 += ns * (f32x2){b1[0], b1[1]}; t3 += ns * (f32x2){b1[2], b1[3]};
      S[0] = S[0] * (f32x2){w0[0], w0[1]} + t0; S[1] = S[1] * (f32x2){w0[2], w0[3]} + t1; S[2] = S[2] * (f32x2){w1[0], w1[1]} + t2; S[3] = S[3] * (f32x2){w1[2], w1[3]} + t3;
      f32x2 y2 = S[0] * (f32x2){r0[0], r0[1]}, z2 = S[2] * (f32x2){r1[0], r1[1]};
      y2 += S[1] * (f32x2){r0[2], r0[3]}; z2 += S[3] * (f32x2){r1[2], r1[3]};
      y2 += z2;
      yk[st] = y2[0] + y2[1];
      __builtin_amdgcn_sched_barrier(0);
    }
#pragma unroll
    for (int g = 0; g < 2; ++g) {
      float q4[4], q2[2], q1;
#pragma unroll
      for (int j = 0; j < 4; ++j) { bool hi = cg & 1; float keep = hi ? yk[g*8 + 2*j+1] : yk[g*8 + 2*j], send = hi ? yk[g*8 + 2*j] : yk[g*8 + 2*j+1]; q4[j] = keep + dpp_get<0xB1>(send); }
#pragma unroll
      for (int j = 0; j < 2; ++j) { bool hi = cg & 2; float keep = hi ? q4[2*j+1] : q4[2*j], send = hi ? q4[2*j] : q4[2*j+1]; q2[j] = keep + dpp_get<0x4E>(send); }
      { bool hi = cg & 4; float keep = hi ? q2[1] : q2[0], send = hi ? q2[0] : q2[1]; q1 = keep + swz_xor4(send); }
      ybuf[buf * SCAN_TS * 32 + (g * 8 + cg) * 32 + il] = q1;
    }
  }
  __builtin_amdgcn_s_setprio(0);
  __syncthreads();
  if (t < 128) {
    int st = t >> 3, i4 = (t & 7) * 4; long row = rowbase + scan_row(dir, (NCH - 1) * SCAN_TS + st);
    *(f32x4*)(y_ + dir * dstride + row * 384 + col0 + half * 32 + i4) = *(const f32x4*)(ybuf + ((NCH - 1) & 1) * SCAN_TS * 32 + st * 32 + i4);
  }
}
__global__ void __launch_bounds__(256) ok_rw_scan(const bf16_t* r_, const bf16_t* v_, const bf16_t* kk_, const bf16_t* kd_, const bf16_t* bd_, const float* w_, float* y_, int item0, int nitems, long dstride) {
  __shared__ __attribute__((aligned(16))) char smem[SCAN_LDS_BYTES];
  for (int it = item0 + blockIdx.x; it < item0 + nitems; it += gridDim.x) { rw_scan_block(r_, v_, kk_, kd_, bd_, w_, y_, it, dstride, smem); __syncthreads(); }
}
__global__ void ok_copy_rows_f32(const float* src, int sld, int scol, int ncols, float* dst, int dld, int nrows) {
  long i = (long)blockIdx.x * blockDim.x + threadIdx.x; if (i >= (long)nrows * ncols) return;
  int c = i % ncols; long r = i / ncols; dst[r * dld + c] = src[r * sld + scol + c];
}

__global__ void ok_cvt_wT_g(const float* W, const float* g, bf16_t* Wt, int K, int N, int Kpad) {
  long i = (long)blockIdx.x * blockDim.x + threadIdx.x;
  if (i >= (long)N * Kpad) return;
  int k = i % Kpad; int n = i / Kpad;
  Wt[i] = k < K ? f2bf(W[(long)k * N + n] * (g ? g[k] : 1.f)) : (bf16_t)0;
}
struct ALoadShift { const bf16_t* P; const float* mu; int col0; int mucol0; int act; int kvalid;
  __device__ __forceinline__ u32x4 operator()(int row, int k) const {
    u32x4 z = {0u, 0u, 0u, 0u};
    if (k >= kvalid) return z;
    int lr = row % RB; bool first = (lr == 0) || (lr == SEQ), last = (lr == SEQ - 1) || (lr == RB - 1);
    const bf16_t* p = P + (long)row * IN_COLS + col0 + k;
    u32x4 c = *(const u32x4*)p; u32x4 pv = first ? z : *(const u32x4*)(p - IN_COLS); u32x4 nx = last ? z : *(const u32x4*)(p + IN_COLS);
    const float* m0 = mu + mucol0 + k; const float* m1 = m0 + RWC;
    u32x4 o;
#pragma unroll
    for (int e = 0; e < 4; ++e) {
      float c0 = __uint_as_float(c[e] << 16), c1 = __uint_as_float(c[e] & 0xffff0000u);
      float p0 = __uint_as_float(pv[e] << 16), p1 = __uint_as_float(pv[e] & 0xffff0000u);
      float n0 = __uint_as_float(nx[e] << 16), n1 = __uint_as_float(nx[e] & 0xffff0000u);
      float x0 = c0 + m0[2*e] * (p0 - c0) + m1[2*e] * (n0 - c0), x1 = c1 + m0[2*e+1] * (p1 - c1) + m1[2*e+1] * (n1 - c1);
      if (act == 1) { x0 = tanhf(x0); x1 = tanhf(x1); } else if (act == 2) { x0 = sigmoidf_(x0); x1 = sigmoidf_(x1); }
      o[e] = pack2bf(x0, x1);
    }
    return o;
  } };
struct EpiDecay { float* w; const float* w0; int pad0; int pad1;
  __device__ __forceinline__ void operator()(int m, int n0, f32x4 v) const {
    f32x4 o;
#pragma unroll
    for (int e = 0; e < 4; ++e) o[e] = expf(-expf(-softplusf_(-(w0[n0 + e] + v[e])) - 0.5f));
    *(f32x4*)(w + (long)m * 384 + n0) = o; } };
struct EpiSigA { bf16_t* a; const float* a0;
  __device__ __forceinline__ void operator()(int m, int n0, f32x4 v) const {
    uint2 pk; pk.x = pack2bf(sigmoidf_(a0[n0] + v[0]), sigmoidf_(a0[n0+1] + v[1])); pk.y = pack2bf(sigmoidf_(a0[n0+2] + v[2]), sigmoidf_(a0[n0+3] + v[3]));
    *(uint2*)(a + (long)m * 384 + n0) = pk; } };

struct PrepW { const bf16_t *wqbT, *wkvbT, *w2T, *a2T, *g2T; const float *mu, *w0, *a0; };
struct PrepBuf { const bf16_t* P; bf16_t *tq, *tkv, *a_b, *g_b; float* w_f; };
__device__ __forceinline__ void prep_gemm_tile(const PrepW& W, const PrepBuf& B, int tm, int ct, char* smem) {
  const long MA = NROWS;
  if (ct < 3) gemm_tile_128(ALoadPlain{B.P, IN_COLS}, W.wqbT, 256, 256, tm, ct, smem, EpiStoreBf16{B.tq, 384, 384});
  else if (ct < 7) gemm_tile_128(ALoadPlain{B.P + 256, IN_COLS}, W.wkvbT, 128, 128, tm, ct - 3, smem, EpiStoreBf16{B.tkv, 512, 512});
  else if (ct < 13) { int d = (ct - 7) / 3, tn = (ct - 7) % 3;
    gemm_tile_128(ALoadShift{B.P, W.mu, RW_OFF + 1152 + d * 64, 1152 + d * 64, 1, 64}, W.w2T + d * 384 * 64, 64, 64, tm, tn, smem, EpiDecay{B.w_f + d * MA * 384, W.w0 + d * 384, 0, 0}); }
  else if (ct < 19) { int d = (ct - 13) / 3, tn = (ct - 13) % 3;
    gemm_tile_128(ALoadShift{B.P, W.mu, RW_OFF + 1280 + d * 64, 1280 + d * 64, 0, 64}, W.a2T + d * 384 * 64, 64, 64, tm, tn, smem, EpiSigA{B.a_b + d * MA * 384, W.a0 + d * 384}); }
  else gemm_tile_128(ALoadShift{B.P, W.mu, RW_OFF + 1408, 1408, 2, 160}, W.g2T, 192, 192, tm, ct - 19, smem, EpiStoreBf16{B.g_b, 384, 384});
}
__global__ void __launch_bounds__(256) ok_prep_gemm(PrepW W, PrepBuf B) {
  __shared__ __attribute__((aligned(16))) char smem[GEMM_LDS_BYTES];
  for (int tile = blockIdx.x; tile < (NROWS / 128) * 22; tile += gridDim.x) prep_gemm_tile(W, B, tile / 22, tile % 22, smem);
}

__device__ __forceinline__ float wave_sum(float x) {
#pragma unroll
  for (int o = 32; o > 0; o >>= 1) x += __shfl_xor(x, o);
  return x;
}
__device__ __forceinline__ float ldbf(const bf16_t* p) { return bf2f(*p); }
struct FinW { const float *mla_qk_g, *gqa_qk_g, *mu, *k_k, *k_a; };
struct FinBuf { const bf16_t *P, *tq, *tkv, *a_b; bf16_t *mq, *mk, *mvT, *gq, *gk, *gvT, *r_b, *v_b, *kk_b, *kd_b, *bd_b; };
#define FIN_LDS_BYTES (384 * 132)
__device__ __forceinline__ void prep_finish_tile(const FinW& W, const FinBuf& B, int tile, char* smem) {
  const int t = tid_opaque(), lane = t & 63, wave = t >> 6; const long MA = NROWS;
  bf16_t* vbuf = (bf16_t*)smem;
  const long row0 = (long)tile * 64; const int b = row0 / RB; const int lr0 = row0 % RB;
  for (int it = 0; it < 16; ++it) {
    const int rl = it * 4 + wave; const long row = row0 + rl; const int lr = lr0 + rl; const bool lat = lr < SEQ;
    const bf16_t* Pr = B.P + row * IN_COLS;
    float sq = 0.f;
#pragma unroll
    for (int i = 0; i < 4; ++i) { float x = ldbf(Pr + i * 64 + lane); sq += x * x; }
    float skv = 0.f;
#pragma unroll
    for (int i = 0; i < 2; ++i) { float x = ldbf(Pr + 256 + i * 64 + lane); skv += x * x; }
    const float cq = 1.f / sqrtf(wave_sum(sq) / 256.f + EPSN), ckv = 1.f / sqrtf(wave_sum(skv) / 128.f + EPSN);
    const float krope = lane < 32 ? ldbf(Pr + 384 + lane) : 0.f;
    float cs_m = 1.f, sn_m = 0.f;
    { int j = lane & 15; int pos = j < 8 ? lr / 64 : lr % 64; float ang = (float)pos * powf(10000.f, -(float)(j & 7) / 8.f); if (lat) { cs_m = cosf(ang); sn_m = sinf(ang); } }
    const float* gq_ = W.mla_qk_g; const float* gk_ = W.mla_qk_g + 96;
#pragma unroll
    for (int h = 0; h < 4; ++h) {
      float qa = cq * ldbf(B.tq + row * 384 + h * 96 + lane); float qb = lane < 32 ? cq * ldbf(B.tq + row * 384 + h * 96 + 64 + lane) : 0.f;
      float inv = 1.f / sqrtf(wave_sum(qa * qa + qb * qb) / 96.f + EPSN);
      qa *= inv * gq_[lane]; qb *= inv * (lane < 32 ? gq_[64 + lane] : 0.f);
      { float other = __shfl_xor(qb, 16); float rr = (lane & 16) ? (other * sn_m + qb * cs_m) : (qb * cs_m - other * sn_m); qb = rr; }
      const float qs = 0.14724445f;
      B.mq[row * 384 + h * 96 + lane] = f2bf(qa * qs); if (lane < 32) B.mq[row * 384 + h * 96 + 64 + lane] = f2bf(qb * qs);
      float ka = ckv * ldbf(B.tkv + row * 512 + h * 128 + lane); float kb = krope;
      float invk = 1.f / sqrtf(wave_sum(ka * ka + kb * kb) / 96.f + EPSN);
      ka *= invk * gk_[lane]; kb *= invk * (lane < 32 ? gk_[64 + lane] : 0.f);
      { float other = __shfl_xor(kb, 16); float rr = (lane & 16) ? (other * sn_m + kb * cs_m) : (kb * cs_m - other * sn_m); kb = rr; }
      B.mk[row * 384 + h * 96 + lane] = f2bf(ka); if (lane < 32) B.mk[row * 384 + h * 96 + 64 + lane] = f2bf(kb);
      vbuf[(h * 64 + lane) * 66 + rl] = f2bf(ckv * ldbf(B.tkv + row * 512 + h * 128 + 64 + lane));
    }
    float cs_g = 1.f, sn_g = 0.f;
    { int j = lane & 31; int pos = j < 16 ? lr / 64 : lr % 64; float ang = (float)pos * powf(10000.f, -(float)(j & 15) / 16.f); if (lat) { cs_g = cosf(ang); sn_g = sinf(ang); } }
#pragma unroll
    for (int h = 0; h < 8; ++h) {
      float x = ldbf(Pr + GQA_OFF + h * 64 + lane);
      float inv = 1.f / sqrtf(wave_sum(x * x) / 64.f + EPSN);
      x *= inv * W.gqa_qk_g[(h < 6 ? 0 : 64) + lane];
      float other = __shfl_xor(x, 32); float rr = (lane & 32) ? (other * sn_g + x * cs_g) : (x * cs_g - other * sn_g);
      if (h < 6) B.gq[row * 384 + h * 64 + lane] = f2bf(rr * 0.18033688f); else B.gk[row * 128 + (h - 6) * 64 + lane] = f2bf(rr);
    }
#pragma unroll
    for (int hk = 0; hk < 2; ++hk) vbuf[((4 + hk) * 64 + lane) * 66 + rl] = Pr[GQA_OFF + 512 + hk * 64 + lane];
    const bool first = (lr == 0) || (lr == SEQ), last = (lr == SEQ - 1) || (lr == RB - 1);
#pragma unroll
    for (int h = 0; h < 6; ++h) {
      float xs3[3];
#pragma unroll
      for (int part = 0; part < 3; ++part) {
        int c = part * 384 + h * 64 + lane; const bf16_t* pp = Pr + RW_OFF + c;
        float p = ldbf(pp), pv = first ? 0.f : ldbf(pp - IN_COLS), nx = last ? 0.f : ldbf(pp + IN_COLS);
        xs3[part] = p + W.mu[c] * (pv - p) + W.mu[RWC + c] * (nx - p);
      }
      const int c = h * 64 + lane; const long o = row * 384 + c;
      float kv = xs3[1]; float tk = kv * W.k_k[c]; float kkv = tk / sqrtf(wave_sum(tk * tk) + 1e-12f);
      B.r_b[o] = f2bf(xs3[0]); B.v_b[o] = f2bf(xs3[2]); B.kk_b[o] = f2bf(kkv);
#pragma unroll
      for (int d = 0; d < 2; ++d) { float a = ldbf(B.a_b + d * MA * 384 + o); B.kd_b[d * MA * 384 + o] = f2bf(kv * (1.f + (a - 1.f) * W.k_a[c])); B.bd_b[d * MA * 384 + o] = f2bf(kkv * a); }
    }
  }
  __syncthreads();
  for (int i = t; i < 384 * 32; i += 256) {
    int rr = i >> 5, w2 = i & 31; int slot = rr >> 6, d = rr & 63;
    unsigned val = *(const unsigned*)(vbuf + rr * 66 + w2 * 2);
    bf16_t* dst = slot < 4 ? B.mvT + ((long)(b * 4 + slot) * 64 + d) * RB : B.gvT + ((long)(b * 2 + (slot - 4)) * 64 + d) * RB;
    *(unsigned*)(dst + lr0 + w2 * 2) = val;
  }
  __syncthreads();
}
__global__ void __launch_bounds__(256) ok_prep_finish(FinW W, FinBuf B) {
  __shared__ __attribute__((aligned(16))) char smem[FIN_LDS_BYTES];
  for (int tile = blockIdx.x; tile < NROWS / 64; tile += gridDim.x) prep_finish_tile(W, B, tile, smem);
}
struct RdW { const float *r_k, *ln_g, *ln_b; };
__device__ __forceinline__ void rw_readout_row(const RdW& W, const float* __restrict__ y, const bf16_t* __restrict__ r_b, const bf16_t* __restrict__ v_b, const bf16_t* __restrict__ kd_b,
                                               const bf16_t* __restrict__ g_b, bf16_t* __restrict__ mixall, long row, int lane) {
  const long MA = NROWS;
#pragma unroll
  for (int h = 0; h < 6; ++h) {
    const int c = h * 64 + lane; const long o = row * 384 + c;
    float yy = y[o] + y[MA * 384 + o];
    float mean = wave_sum(yy) * (1.f / 64.f); float dv = yy - mean; float var = wave_sum(dv * dv) * (1.f / 64.f);
    float coef = wave_sum(ldbf(r_b + o) * (ldbf(kd_b + o) + ldbf(kd_b + MA * 384 + o)) * W.r_k[c]);
    float yn = dv / sqrtf(var + 64e-5f) * W.ln_g[c] + W.ln_b[c];
    mixall[row * DM + 256 + c] = f2bf((yn + coef * ldbf(v_b + o)) * ldbf(g_b + o));
  }
}
__global__ void __launch_bounds__(256) ok_rw_readout(RdW W, const float* y, const bf16_t* r_b, const bf16_t* v_b, const bf16_t* kd_b, const bf16_t* g_b, bf16_t* mixall) {
  for (long row = blockIdx.x * 4 + (threadIdx.x >> 6); row < NROWS; row += gridDim.x * 4) rw_readout_row(W, y, r_b, v_b, kd_b, g_b, mixall, row, threadIdx.x & 63);
}

__device__ __forceinline__ void ph_cvt_fp8_rows(const float* __restrict__ tab, unsigned char* __restrict__ q, float* __restrict__ scale, int r0 = -1, int r1 = 0) {
  const int t = tid_opaque(); const int lane = t & 63;
  const int rbeg = r0 < 0 ? (int)blockIdx.x * 4 + (t >> 6) : r0 + (t >> 6), rend = r0 < 0 ? 16384 : r1, rstep = r0 < 0 ? (int)gridDim.x * 4 : 4;
  for (int row = rbeg; row < rend; row += rstep) {
    const float* src = tab + (long)row * DM + lane * 16;
    f32x4 a[4]; float m = 0.f;
#pragma unroll
    for (int i = 0; i < 4; ++i) { a[i] = *(const f32x4*)(src + 4 * i); m = fmaxf(m, fmaxf(fmaxf(fabsf(a[i][0]), fabsf(a[i][1])), fmaxf(fabsf(a[i][2]), fabsf(a[i][3])))); }
#pragma unroll
    for (int o = 32; o > 0; o >>= 1) m = fmaxf(m, __shfl_xor(m, o));
    const float sc = m > 0.f ? m * (1.f / 440.f) : 1.f; const float inv = 1.f / sc;
    u32x4 p;
#pragma unroll
    for (int i = 0; i < 4; ++i) { int w = __builtin_amdgcn_cvt_pk_fp8_f32(a[i][0] * inv, a[i][1] * inv, 0, false); w = __builtin_amdgcn_cvt_pk_fp8_f32(a[i][2] * inv, a[i][3] * inv, w, true); p[i] = (unsigned)w; }
    *(u32x4*)(q + (long)row * DM + lane * 16) = p;
    if (lane == 0) scale[row] = sc;
  }
}
__device__ __forceinline__ float dot16_fp8(const float (&h)[16], u32x4 q) {
  float a = 0.f;
#pragma unroll
  for (int d = 0; d < 4; ++d) {
    f32v2 lo = __builtin_amdgcn_cvt_pk_f32_fp8((int)q[d], false), hi = __builtin_amdgcn_cvt_pk_f32_fp8((int)q[d], true);
    a += h[4*d] * lo[0]; a += h[4*d+1] * lo[1]; a += h[4*d+2] * hi[0]; a += h[4*d+3] * hi[1];
  }
  return a;
}
__device__ __forceinline__ void axpy16_fp8(float (&o)[16], float w, u32x4 q) {
#pragma unroll
  for (int d = 0; d < 4; ++d) {
    f32v2 lo = __builtin_amdgcn_cvt_pk_f32_fp8((int)q[d], false), hi = __builtin_amdgcn_cvt_pk_f32_fp8((int)q[d], true);
    o[4*d] += w * lo[0]; o[4*d+1] += w * lo[1]; o[4*d+2] += w * hi[0]; o[4*d+3] += w * hi[1];
  }
}
__device__ __forceinline__ void peer_gather_group_fp8(const bf16_t* __restrict__ xn, const unsigned* __restrict__ top1, const unsigned char* __restrict__ ub, const float* __restrict__ su,
                                                      const unsigned char* __restrict__ vb, const float* __restrict__ sv, const float* __restrict__ modl, float* __restrict__ xs, int grp, char* smem) {
  const int t = tid_opaque(), lane = t & 63, wave = t >> 6;
  int* pe_l = (int*)smem; float* pg_l = (float*)(smem + 32 * 128 * 4); float* pw_l = (float*)(smem + 2 * 32 * 128 * 4);
  {
    int tl = t >> 3, p = t & 7; long row = (long)grp * 32 + tl;
    peer_combine(top1 + (row * 16 + p * 2) * 16, top1 + (row * 16 + p * 2 + 1) * 16, pe_l + tl * 128 + p * 16, pg_l + tl * 128 + p * 16);
  }
  __syncthreads();
  for (int ti = 0; ti < 8; ++ti) {
    const int tl = wave * 8 + ti; const long row = (long)grp * 32 + tl;
    const int* pe = pe_l + tl * 128; float* pw = pw_l + tl * 128;
    float h[16];
    { u32x4 h0 = *(const u32x4*)(xn + row * DM + lane * 16), h1 = *(const u32x4*)(xn + row * DM + lane * 16 + 8);
#pragma unroll
      for (int e = 0; e < 4; ++e) { h[2*e] = __uint_as_float(h0[e] << 16); h[2*e+1] = __uint_as_float(h0[e] & 0xffff0000u); h[8+2*e] = __uint_as_float(h1[e] << 16); h[8+2*e+1] = __uint_as_float(h1[e] & 0xffff0000u); } }
    u32x4 u[8];
#pragma unroll
    for (int j = 0; j < 8; ++j) u[j] = *(const u32x4*)(ub + (long)pe[j] * DM + lane * 16);
    for (int b = 0; b < 16; ++b) {
      float pd[8];
#pragma unroll
      for (int j = 0; j < 8; ++j) pd[j] = dot16_fp8(h, u[j]);
      if (b + 1 < 16) {
#pragma unroll
        for (int j = 0; j < 8; ++j) u[j] = *(const u32x4*)(ub + (long)pe[(b + 1) * 8 + j] * DM + lane * 16);
      }
      float q4[4], q2[2], q1;
#pragma unroll
      for (int j = 0; j < 4; ++j) { bool hi = lane & 1; float keep = hi ? pd[2*j+1] : pd[2*j], send = hi ? pd[2*j] : pd[2*j+1]; q4[j] = keep + __shfl_xor(send, 1); }
#pragma unroll
      for (int j = 0; j < 2; ++j) { bool hi = lane & 2; float keep = hi ? q4[2*j+1] : q4[2*j], send = hi ? q4[2*j] : q4[2*j+1]; q2[j] = keep + __shfl_xor(send, 2); }
      { bool hi = lane & 4; float keep = hi ? q2[1] : q2[0], send = hi ? q2[0] : q2[1]; q1 = keep + __shfl_xor(send, 4); }
      q1 += __shfl_xor(q1, 8); q1 += __shfl_xor(q1, 16); q1 += __shfl_xor(q1, 32);
      if (lane < 8) pw[b * 8 + lane] = q1 * su[pe[b * 8 + lane]];
    }
    u32x4 v[8];
#pragma unroll
    for (int j = 0; j < 8; ++j) v[j] = *(const u32x4*)(vb + (long)pe[j] * DM + lane * 16);
    {
      float d0 = pw[lane], d1 = pw[64 + lane];
      pw[lane] = pg_l[tl * 128 + lane] * geluf_(d0) * sv[pe[lane]]; pw[64 + lane] = pg_l[tl * 128 + 64 + lane] * geluf_(d1) * sv[pe[64 + lane]];
    }
    float o[16];
#pragma unroll
    for (int e = 0; e < 16; ++e) o[e] = 0.f;
    for (int b = 0; b < 16; ++b) {
      u32x4 vc[8];
#pragma unroll
      for (int j = 0; j < 8; ++j) vc[j] = v[j];
      if (b + 1 < 16) {
#pragma unroll
        for (int j = 0; j < 8; ++j) v[j] = *(const u32x4*)(vb + (long)pe[(b + 1) * 8 + j] * DM + lane * 16);
      }
#pragma unroll
      for (int j = 0; j < 8; ++j) axpy16_fp8(o, pw[b * 8 + j], vc[j]);
    }
    {
      int b = row / RB, lr = row % RB; int bb = lr < SEQ ? b : BATCH; const float* g5 = modl + ((long)bb * 6 + 5) * DM + lane * 16;
      float* xr = xs + row * DM + lane * 16;
#pragma unroll
      for (int i = 0; i < 4; ++i) {
        f32x4 x = *(f32x4*)(xr + 4 * i); f32x4 g = *(const f32x4*)(g5 + 4 * i);
        x[0] += g[0] * o[4*i]; x[1] += g[1] * o[4*i+1]; x[2] += g[2] * o[4*i+2]; x[3] += g[3] * o[4*i+3];
        *(f32x4*)(xr + 4 * i) = x;
      }
    }
  }
}

__device__ __forceinline__ float reduce16(float x) { x = reduce8(x); x += dpp_get<0x140>(x); return x; }
__device__ __forceinline__ void unpack8(u32x4 v, float (&f)[8]) {
#pragma unroll
  for (int e = 0; e < 4; ++e) { f[2*e] = __uint_as_float(v[e] << 16); f[2*e+1] = __uint_as_float(v[e] & 0xffff0000u); }
}
__device__ __forceinline__ u32x4 pack8(const float (&f)[8]) { u32x4 o;
#pragma unroll
  for (int e = 0; e < 4; ++e) o[e] = pack2bf(f[2*e], f[2*e+1]);
  return o; }
__device__ __forceinline__ void ph_rope_tables(float* rope_g, float* rope_m) {
  const int t = tid_opaque();
  for (int i = blockIdx.x * 256 + t; i < SEQ * 48; i += gridDim.x * 256) {
    int lr = i / 48, j = i % 48;
    if (j < 32) { int pos = j < 16 ? lr / 64 : lr % 64; float ang = (float)pos * powf(10000.f, -(float)(j & 15) / 16.f); rope_g[(lr * 32 + j) * 2] = cosf(ang); rope_g[(lr * 32 + j) * 2 + 1] = sinf(ang); }
    else { int jj = j - 32; int pos = jj < 8 ? lr / 64 : lr % 64; float ang = (float)pos * powf(10000.f, -(float)(jj & 7) / 8.f); rope_m[(lr * 16 + jj) * 2] = cosf(ang); rope_m[(lr * 16 + jj) * 2 + 1] = sinf(ang); }
  }
}
struct FinW2 { const float *mla_qk_g, *gqa_qk_g, *mu, *k_k, *k_a, *rope_g, *rope_m; };
#define FIN2_LDS_BYTES (64 * 384 * 2)
__device__ __forceinline__ void prep_finish_tile2(const FinW2& W, const FinBuf& B, int tile, char* smem) {
  const int t = tid_opaque(), lane = t & 63, wave = t >> 6; const long MA = NROWS;
  bf16_t* vbuf = (bf16_t*)smem;
  const long row0 = (long)tile * 32; const int b = row0 / RB; const int lr0 = row0 % RB;
  const int g8 = lane & 7, h8 = lane >> 3, s16 = lane & 15, h16 = lane >> 4;
  for (int it = 0; it < 8; ++it) {
    const int rl = it * 4 + wave; const long row = row0 + rl; const int lr = lr0 + rl; const bool lat = lr < SEQ;
    const bf16_t* Pr = B.P + row * IN_COLS;
    {
      float x[8]; unpack8(*(const u32x4*)(Pr + GQA_OFF + lane * 8), x);
      float ss = 0.f;
#pragma unroll
      for (int e = 0; e < 8; ++e) ss += x[e] * x[e];
      ss = reduce8(ss); const float inv = 1.f / sqrtf(ss * (1.f / 64.f) + EPSN);
      const float* gp = W.gqa_qk_g + (h8 < 6 ? 0 : 64) + g8 * 8; f32x4 ga = *(const f32x4*)gp, gb = *(const f32x4*)(gp + 4);
#pragma unroll
      for (int e = 0; e < 4; ++e) { x[e] *= inv * ga[e]; x[4 + e] *= inv * gb[e]; }
      float o[8];
      if (lat) {
        const float* rt = W.rope_g + ((long)lr * 32 + (g8 & 3) * 8) * 2;
#pragma unroll
        for (int e = 0; e < 8; ++e) { float ot = swz_xor4(x[e]); float cs = rt[2 * e], sn = rt[2 * e + 1]; o[e] = (g8 & 4) ? (ot * sn + x[e] * cs) : (x[e] * cs - ot * sn); }
      } else {
#pragma unroll
        for (int e = 0; e < 8; ++e) o[e] = x[e];
      }
      if (h8 < 6) {
#pragma unroll
        for (int e = 0; e < 8; ++e) o[e] *= 0.18033688f;
        *(u32x4*)(B.gq + row * 384 + lane * 8) = pack8(o);
      } else *(u32x4*)(B.gk + row * 128 + (lane - 48) * 8) = pack8(o);
    }
    float cq, ckv;
    {
      float ss = 0.f;
      if (lane < 48) { float x[8]; unpack8(*(const u32x4*)(Pr + lane * 8), x);
#pragma unroll
        for (int e = 0; e < 8; ++e) ss += x[e] * x[e]; }
      float sq = wave_sum(lane < 32 ? ss : 0.f), skv = wave_sum(lane >= 32 ? ss : 0.f);
      cq = 1.f / sqrtf(sq * (1.f / 256.f) + EPSN); ckv = 1.f / sqrtf(skv * (1.f / 128.f) + EPSN);
    }
    {
      float cs0 = 1.f, sn0 = 0.f, cs1 = 1.f, sn1 = 0.f;
      if (lat) { f32x4 r4 = *(const f32x4*)(W.rope_m + ((long)lr * 16 + (s16 & 7) * 2) * 2); cs0 = r4[0]; sn0 = r4[1]; cs1 = r4[2]; sn1 = r4[3]; }
      const float kr0 = bf2f(Pr[384 + s16 * 2]), kr1 = bf2f(Pr[384 + s16 * 2 + 1]);
#pragma unroll
      for (int which = 0; which < 2; ++which) {
        float n[4], r0, r1;
        if (which == 0) {
          uint2 a = *(const uint2*)(B.tq + row * 384 + h16 * 96 + s16 * 4); unsigned rr = *(const unsigned*)(B.tq + row * 384 + h16 * 96 + 64 + s16 * 2);
          n[0] = cq * __uint_as_float(a.x << 16); n[1] = cq * __uint_as_float(a.x & 0xffff0000u); n[2] = cq * __uint_as_float(a.y << 16); n[3] = cq * __uint_as_float(a.y & 0xffff0000u);
          r0 = cq * __uint_as_float(rr << 16); r1 = cq * __uint_as_float(rr & 0xffff0000u);
        } else {
          uint2 a = *(const uint2*)(B.tkv + row * 512 + h16 * 128 + s16 * 4);
          n[0] = ckv * __uint_as_float(a.x << 16); n[1] = ckv * __uint_as_float(a.x & 0xffff0000u); n[2] = ckv * __uint_as_float(a.y << 16); n[3] = ckv * __uint_as_float(a.y & 0xffff0000u);
          r0 = kr0; r1 = kr1;
        }
        float ss = n[0]*n[0] + n[1]*n[1] + n[2]*n[2] + n[3]*n[3] + r0*r0 + r1*r1;
        ss = reduce16(ss); const float inv = 1.f / sqrtf(ss * (1.f / 96.f) + EPSN);
        const float* gp = W.mla_qk_g + which * 96; f32x4 gn = *(const f32x4*)(gp + s16 * 4); const float g0 = gp[64 + s16 * 2], g1 = gp[64 + s16 * 2 + 1];
#pragma unroll
        for (int e = 0; e < 4; ++e) n[e] *= inv * gn[e];
        r0 *= inv * g0; r1 *= inv * g1;
        float o0 = dpp_get<0x128>(r0), o1 = dpp_get<0x128>(r1);
        float q0, q1;
        if (s16 & 8) { q0 = o0 * sn0 + r0 * cs0; q1 = o1 * sn1 + r1 * cs1; } else { q0 = r0 * cs0 - o0 * sn0; q1 = r1 * cs1 - o1 * sn1; }
        const float sc = which == 0 ? 0.14724445f : 1.f;
        bf16_t* dst = (which == 0 ? B.mq : B.mk) + row * 384 + h16 * 96;
        uint2 pk; pk.x = pack2bf(n[0] * sc, n[1] * sc); pk.y = pack2bf(n[2] * sc, n[3] * sc);
        *(uint2*)(dst + s16 * 4) = pk; *(unsigned*)(dst + 64 + s16 * 2) = pack2bf(q0 * sc, q1 * sc);
      }
      if (lane < 32) { float x[8]; unpack8(*(const u32x4*)(B.tkv + row * 512 + h8 * 128 + 64 + g8 * 8), x);
#pragma unroll
        for (int e = 0; e < 8; ++e) x[e] *= ckv;
        *(u32x4*)(vbuf + rl * 384 + h8 * 64 + g8 * 8) = pack8(x); }
      else if (lane < 48) *(u32x4*)(vbuf + rl * 384 + 256 + (lane - 32) * 8) = *(const u32x4*)(Pr + GQA_OFF + 512 + (lane - 32) * 8);
    }
    if (lane < 48) {
      const bool first = (lr == 0) || (lr == SEQ), last = (lr == SEQ - 1) || (lr == RB - 1);
      const long o = row * 384 + lane * 8;
      float xs3[3][8];
#pragma unroll
      for (int part = 0; part < 3; ++part) {
        const int c = part * 384 + lane * 8; const bf16_t* pp = Pr + RW_OFF + c;
        float p[8], pv[8], nx[8]; unpack8(*(const u32x4*)pp, p);
        u32x4 z = {0u, 0u, 0u, 0u}; unpack8(first ? z : *(const u32x4*)(pp - IN_COLS), pv); unpack8(last ? z : *(const u32x4*)(pp + IN_COLS), nx);
        f32x4 m0a = *(const f32x4*)(W.mu + c), m0b = *(const f32x4*)(W.mu + c + 4), m1a = *(const f32x4*)(W.mu + RWC + c), m1b = *(const f32x4*)(W.mu + RWC + c + 4);
#pragma unroll
        for (int e = 0; e < 4; ++e) { xs3[part][e] = p[e] + m0a[e] * (pv[e] - p[e]) + m1a[e] * (nx[e] - p[e]); xs3[part][4+e] = p[4+e] + m0b[e] * (pv[4+e] - p[4+e]) + m1b[e] * (nx[4+e] - p[4+e]); }
      }
      *(u32x4*)(B.r_b + o) = pack8(xs3[0]); *(u32x4*)(B.v_b + o) = pack8(xs3[2]);
      f32x4 kka = *(const f32x4*)(W.k_k + lane * 8), kkb = *(const f32x4*)(W.k_k + lane * 8 + 4), kaa = *(const f32x4*)(W.k_a + lane * 8), kab = *(const f32x4*)(W.k_a + lane * 8 + 4);
      float tk[8], ss = 0.f;
#pragma unroll
      for (int e = 0; e < 4; ++e) { tk[e] = xs3[1][e] * kka[e]; tk[4+e] = xs3[1][4+e] * kkb[e]; }
#pragma unroll
      for (int e = 0; e < 8; ++e) ss += tk[e] * tk[e];
      ss = reduce8(ss); const float invk = 1.f / sqrtf(ss + 1e-12f);
#pragma unroll
      for (int e = 0; e < 8; ++e) tk[e] *= invk;
      *(u32x4*)(B.kk_b + o) = pack8(tk);
#pragma unroll
      for (int d = 0; d < 2; ++d) {
        float a[8], kd[8], bd[8]; unpack8(*(const u32x4*)(B.a_b + d * MA * 384 + o), a);
#pragma unroll
        for (int e = 0; e < 8; ++e) { float ka = e < 4 ? kaa[e] : kab[e - 4]; kd[e] = xs3[1][e] * (1.f + (a[e] - 1.f) * ka); bd[e] = tk[e] * a[e]; }
        *(u32x4*)(B.kd_b + d * MA * 384 + o) = pack8(kd); *(u32x4*)(B.bd_b + d * MA * 384 + o) = pack8(bd);
      }
    } else { (void)reduce8(0.f); }
  }
  __syncthreads();
  for (int i = t; i < 384 * 4; i += 256) {
    int c = i % 384, rc = i / 384;
    unsigned short v8[8];
#pragma unroll
    for (int e = 0; e < 8; ++e) v8[e] = vbuf[(rc * 8 + e) * 384 + c];
    u32x4 o; o[0] = v8[0] | ((unsigned)v8[1] << 16); o[1] = v8[2] | ((unsigned)v8[3] << 16); o[2] = v8[4] | ((unsigned)v8[5] << 16); o[3] = v8[6] | ((unsigned)v8[7] << 16);
    bf16_t* dst = c < 256 ? B.mvT + ((long)(b * 4 + (c >> 6)) * 64 + (c & 63)) * RB : B.gvT + ((long)(b * 2 + ((c - 256) >> 6)) * 64 + (c & 63)) * RB;
    *(u32x4*)(dst + lr0 + rc * 8) = o;
  }
  __syncthreads();
}
__device__ __forceinline__ void rw_readout_row2(const RdW& W, const float* __restrict__ y, const bf16_t* __restrict__ r_b, const bf16_t* __restrict__ v_b, const bf16_t* __restrict__ kd_b,
                                                const bf16_t* __restrict__ g_b, bf16_t* __restrict__ mixall, long row, int lane) {
  const long MA = NROWS;
  float yy[8], s = 0.f; float r[8], k0[8], k1[8], vv[8], gg[8];
  const int c = lane * 8; const long o = row * 384 + c;
  if (lane < 48) {
    f32x4 a0 = *(const f32x4*)(y + o), a1 = *(const f32x4*)(y + o + 4), b0 = *(const f32x4*)(y + MA * 384 + o), b1 = *(const f32x4*)(y + MA * 384 + o + 4);
#pragma unroll
    for (int e = 0; e < 4; ++e) { yy[e] = a0[e] + b0[e]; yy[4+e] = a1[e] + b1[e]; }
    unpack8(*(const u32x4*)(r_b + o), r); unpack8(*(const u32x4*)(kd_b + o), k0); unpack8(*(const u32x4*)(kd_b + MA * 384 + o), k1);
    unpack8(*(const u32x4*)(v_b + o), vv); unpack8(*(const u32x4*)(g_b + o), gg);
  } else {
#pragma unroll
    for (int e = 0; e < 8; ++e) { yy[e] = 0.f; r[e] = 0.f; k0[e] = 0.f; k1[e] = 0.f; vv[e] = 0.f; gg[e] = 0.f; }
  }
#pragma unroll
  for (int e = 0; e < 8; ++e) s += yy[e];
  const float mean = reduce8(s) * (1.f / 64.f);
  float vs = 0.f, cf = 0.f;
  const int cc = lane < 48 ? c : 0;
  f32x4 rk0 = *(const f32x4*)(W.r_k + cc), rk1 = *(const f32x4*)(W.r_k + cc + 4);
#pragma unroll
  for (int e = 0; e < 8; ++e) { float d = yy[e] - mean; vs += d * d; cf += r[e] * (k0[e] + k1[e]) * (e < 4 ? rk0[e] : rk1[e - 4]); }
  const float var = reduce8(vs) * (1.f / 64.f), coef = reduce8(cf);
  const float inv = 1.f / sqrtf(var + 64e-5f);
  if (lane < 48) {
    f32x4 lg0 = *(const f32x4*)(W.ln_g + c), lg1 = *(const f32x4*)(W.ln_g + c + 4), lb0 = *(const f32x4*)(W.ln_b + c), lb1 = *(const f32x4*)(W.ln_b + c + 4);
    float out[8];
#pragma unroll
    for (int e = 0; e < 8; ++e) { float yn = (yy[e] - mean) * inv * (e < 4 ? lg0[e] : lg1[e - 4]) + (e < 4 ? lb0[e] : lb1[e - 4]); out[e] = (yn + coef * vv[e]) * gg[e]; }
    *(u32x4*)(mixall + row * DM + 256 + c) = pack8(out);
  }
}

#define PG_NT 4
#define PG_TOK (4 * PG_NT)
#define PG_OFF_H 0
#define PG_OFF_E (PG_TOK * 2048)
#define PG_OFF_G (PG_OFF_E + PG_TOK * 128 * 2)
#define PG_OFF_ST (PG_OFF_G + PG_TOK * 128 * 4)
#define PG_OFF_CNT (PG_OFF_ST + PG_TOK * 18 * 2)
#define PG_LDS_BYTES (PG_OFF_CNT + PG_TOK * 8 * 16 * 2)
__device__ __forceinline__ long pg_row(int g, int ntok) { return ntok == NROWS ? (long)g : (long)(g / SEQ) * RB + (g % SEQ); }
__device__ __forceinline__ void peer_gather_sliced(const bf16_t* __restrict__ xn, const unsigned* __restrict__ top1, const unsigned char* __restrict__ ub, const float* __restrict__ su,
                                                   const unsigned char* __restrict__ vb, const float* __restrict__ sv, const float* __restrict__ modl, float* __restrict__ xs,
                                                   int ntok, char* smem, const float* __restrict__ ng, const float* __restrict__ nmod, bf16_t* __restrict__ xn_next, float* __restrict__ out) {
  bf16_t* hs = (bf16_t*)(smem + PG_OFF_H); unsigned short* se = (unsigned short*)(smem + PG_OFF_E); float* sg = (float*)(smem + PG_OFF_G);
  unsigned short* sst = (unsigned short*)(smem + PG_OFF_ST); unsigned short* cnt = (unsigned short*)(smem + PG_OFF_CNT);
  const int per_block = (ntok + (int)gridDim.x - 1) / (int)gridDim.x;
  const int npass = (per_block + PG_TOK - 1) / PG_TOK; const int tpp = (per_block + npass - 1) / npass;
  for (int pass = 0; pass < npass; ++pass) {
    const int t = tid_opaque(), lane = t & 63, wave = t >> 6;
    __syncthreads();
    for (int i = t; i < PG_TOK * 8 * 16; i += 256) cnt[i] = 0;
    for (int i = t; i < PG_TOK * 128; i += 256) {
      int tl = i >> 7, ch = i & 127; int q = (tl % PG_NT) * 4 + tl / PG_NT; int idx = pass * tpp + q; int g = (int)blockIdx.x + idx * (int)gridDim.x;
      u32x4 v = {0u, 0u, 0u, 0u};
      if (q < tpp && idx < per_block && g < ntok) v = *(const u32x4*)(xn + pg_row(g, ntok) * DM + ch * 8);
      *(u32x4*)(hs + tl * 1024 + ch * 8) = v;
    }
    __syncthreads();
    int my_e[16]; float my_g[16];
    const int ctl = t >> 3, cp = t & 7;
    bool cact = false;
    if (ctl < PG_TOK) {
      int q = (ctl % PG_NT) * 4 + ctl / PG_NT; int idx = pass * tpp + q; int g = (int)blockIdx.x + idx * (int)gridDim.x;
      cact = q < tpp && idx < per_block && g < ntok;
      if (cact) {
        long row = pg_row(g, ntok);
        peer_combine(top1 + (row * 16 + cp * 2) * 16, top1 + (row * 16 + cp * 2 + 1) * 16, my_e, my_g);
#pragma unroll
        for (int k = 0; k < 16; ++k) cnt[(ctl * 8 + cp) * 16 + (my_e[k] >> 10)] += 1;
      }
    }
    __syncthreads();
    if (t < PG_TOK) {
      int run = 0;
      for (int s = 0; s < 16; ++s) {
        sst[t * 18 + s] = (unsigned short)run;
        for (int h = 0; h < 8; ++h) { int c = cnt[(t * 8 + h) * 16 + s]; cnt[(t * 8 + h) * 16 + s] = (unsigned short)run; run += c; }
      }
      sst[t * 18 + 16] = (unsigned short)run;
    }
    __syncthreads();
    if (cact) {
#pragma unroll
      for (int k = 0; k < 16; ++k) { int s = my_e[k] >> 10; int pos = cnt[(ctl * 8 + cp) * 16 + s]; cnt[(ctl * 8 + cp) * 16 + s] = (unsigned short)(pos + 1); se[ctl * 128 + pos] = (unsigned short)my_e[k]; sg[ctl * 128 + pos] = my_g[k]; }
    }
    __syncthreads();
    float acc[PG_NT][16];
#pragma unroll
    for (int tk = 0; tk < PG_NT; ++tk)
#pragma unroll
      for (int e = 0; e < 16; ++e) acc[tk][e] = 0.f;
    for (int s = 0; s < 16; ++s) {
#pragma unroll
      for (int tk = 0; tk < PG_NT; ++tk) {
        const int tl = wave * PG_NT + tk;
        const int st = sst[tl * 18 + s], en = sst[tl * 18 + s + 1];
        for (int base = st; base < en; base += 8) {
          const int nb = en - base < 8 ? en - base : 8;
          u32x4 u[8], v[8];
#pragma unroll
          for (int j = 0; j < 8; ++j) if (j < nb) { const unsigned off = (unsigned)se[tl * 128 + base + j] * 1024u + (unsigned)lane * 16u; u[j] = *(const u32x4*)(ub + off); v[j] = *(const u32x4*)(vb + off); }
          float h[16];
          { u32x4 h0 = *(const u32x4*)(hs + tl * 1024 + lane * 16), h1 = *(const u32x4*)(hs + tl * 1024 + lane * 16 + 8);
#pragma unroll
            for (int e = 0; e < 4; ++e) { h[2*e] = __uint_as_float(h0[e] << 16); h[2*e+1] = __uint_as_float(h0[e] & 0xffff0000u); h[8+2*e] = __uint_as_float(h1[e] << 16); h[8+2*e+1] = __uint_as_float(h1[e] & 0xffff0000u); } }
          float pd[8];
#pragma unroll
          for (int j = 0; j < 8; ++j) pd[j] = j < nb ? dot16_fp8(h, u[j]) : 0.f;
          float q4[4], q2[2], q1;
#pragma unroll
          for (int j = 0; j < 4; ++j) { bool hi = lane & 1; float keep = hi ? pd[2*j+1] : pd[2*j], send = hi ? pd[2*j] : pd[2*j+1]; q4[j] = keep + dpp_get<0xB1>(send); }
#pragma unroll
          for (int j = 0; j < 2; ++j) { bool hi = lane & 2; float keep = hi ? q4[2*j+1] : q4[2*j], send = hi ? q4[2*j] : q4[2*j+1]; q2[j] = keep + dpp_get<0x4E>(send); }
          { bool hi = lane & 4; float keep = hi ? q2[1] : q2[0], send = hi ? q2[0] : q2[1]; q1 = keep + swz_xor4(send); }
          q1 += dpp_get<0x128>(q1);
          q1 += __builtin_bit_cast(float, __builtin_amdgcn_ds_swizzle(__builtin_bit_cast(int, q1), 0x401F));
          q1 += __shfl_xor(q1, 32);
          float w = 0.f;
          { const int jj = lane & 7; if (jj < nb) { int e = se[tl * 128 + base + jj]; w = sg[tl * 128 + base + jj] * geluf_(q1 * su[e]) * sv[e]; } }
#pragma unroll
          for (int j = 0; j < 8; ++j) { float wj = __builtin_bit_cast(float, __builtin_amdgcn_readlane(__builtin_bit_cast(int, w), j)); if (j < nb) axpy16_fp8(acc[tk], wj, v[j]); }
        }
      }
    }
#pragma unroll
    for (int tk = 0; tk < PG_NT; ++tk) {
      int q = tk * 4 + wave; int idx = pass * tpp + q; int g = (int)blockIdx.x + idx * (int)gridDim.x;
      if (q < tpp && idx < per_block && g < ntok) {
        long row = pg_row(g, ntok); int b = row / RB, lr = row % RB; int bb = lr < SEQ ? b : BATCH; const float* g5 = modl + ((long)bb * 6 + 5) * DM + lane * 16;
        float* xr = xs + row * DM + lane * 16;
        f32x4 xv[4]; float ss = 0.f;
#pragma unroll
        for (int i = 0; i < 4; ++i) {
          f32x4 x = *(f32x4*)(xr + 4 * i); f32x4 gg = *(const f32x4*)(g5 + 4 * i);
          x[0] += gg[0] * acc[tk][4*i]; x[1] += gg[1] * acc[tk][4*i+1]; x[2] += gg[2] * acc[tk][4*i+2]; x[3] += gg[3] * acc[tk][4*i+3];
          xv[i] = x; ss += x[0] * x[0] + x[1] * x[1] + x[2] * x[2] + x[3] * x[3];
        }
        if (out) {
          float* orow = out + ((long)b * SEQ + lr) * DM + lane * 16;
#pragma unroll
          for (int i = 0; i < 4; ++i) *(f32x4*)(orow + 4 * i) = xv[i];
        } else {
#pragma unroll
          for (int i = 0; i < 4; ++i) *(f32x4*)(xr + 4 * i) = xv[i];
          ss = wave_sum(ss); const float inv = 1.f / sqrtf(ss * (1.f / DM) + EPSN);
          const float* sh = nmod + ((long)bb * 6 + 0) * DM + lane * 16; const float* sc = sh + DM; const float* gp = ng + lane * 16;
          u32x4 p0, p1;
#pragma unroll
          for (int i = 0; i < 4; ++i) { f32x4 g4 = *(const f32x4*)(gp + 4 * i), s4 = *(const f32x4*)(sc + 4 * i), h4 = *(const f32x4*)(sh + 4 * i);
            const float a0 = xv[i][0] * inv * g4[0] * (1.f + s4[0]) + h4[0], a1 = xv[i][1] * inv * g4[1] * (1.f + s4[1]) + h4[1];
            const float a2 = xv[i][2] * inv * g4[2] * (1.f + s4[2]) + h4[2], a3 = xv[i][3] * inv * g4[3] * (1.f + s4[3]) + h4[3];
            if (i < 2) { p0[2 * i] = pack2bf(a0, a1); p0[2 * i + 1] = pack2bf(a2, a3); } else { p1[2 * (i - 2)] = pack2bf(a0, a1); p1[2 * (i - 2) + 1] = pack2bf(a2, a3); } }
          *(u32x4*)(xn_next + row * DM + lane * 16) = p0; *(u32x4*)(xn_next + row * DM + lane * 16 + 8) = p1;
        }
      }
    }
  }
}

#define PG2_OFF_H 0
#define PG2_OFF_FE (12 * 2048)
#define PG2_OFF_FG (PG2_OFF_FE + 4 * 512 * 2)
#define PG2_OFF_FS (PG2_OFF_FG + 4 * 512 * 4)
#define PG2_OFF_FT (PG2_OFF_FS + 4 * 512 * 4)
#define PG2_OFF_CNT (PG2_OFF_FT + 4 * 512)
#define PG2_OFF_TOT (PG2_OFF_CNT + 4 * 512 * 2)
#define PG2_LDS_BYTES (PG2_OFF_TOT + 4 * 16 * 2 + 16)

#define PG2_BS 4
#ifndef PG2_EMASK
#define PG2_EMASK 0x3FFFu
#endif
__device__ __forceinline__ void pg2_issue(u32x4 (&B)[PG2_BS], const unsigned char* __restrict__ tab, const unsigned short* we, int k, int lane, unsigned emask = PG2_EMASK) {
#pragma unroll
  for (int j = 0; j < PG2_BS; ++j) { const unsigned off = ((unsigned)we[k * PG2_BS + j] & emask) * 1024u + (unsigned)lane * 16u; B[j] = *(const u32x4*)(tab + off); }
}
__device__ __forceinline__ void pg2_step(u32x4 (&U)[PG2_BS], u32x4 (&V)[PG2_BS], u32x4 (&F)[PG2_BS], int k, int nbat, float (&acc)[3][16], float (&h)[16], int& cur_tk,
                                         const unsigned char* __restrict__ ub, const unsigned char* __restrict__ vb, const float* wsc,
                                         const unsigned short* we, const float* wg, const unsigned char* wt, const bf16_t* hw, int lane, unsigned emask = PG2_EMASK) {
  const bool more = k + 1 < nbat;
  if (more) pg2_issue(F, ub, we, k + 1, lane, emask);
  float pd[PG2_BS];
#pragma unroll
  for (int j = 0; j < PG2_BS; ++j) {
    const int tkj = __builtin_amdgcn_readfirstlane((int)wt[k * PG2_BS + j]);
    { const bf16_t* hp = hw + tkj * 1024 + lane * 16; u32x4 h0 = *(const u32x4*)hp, h1 = *(const u32x4*)(hp + 8);
#pragma unroll
      for (int e = 0; e < 4; ++e) { h[2*e] = __uint_as_float(h0[e] << 16); h[2*e+1] = __uint_as_float(h0[e] & 0xffff0000u); h[8+2*e] = __uint_as_float(h1[e] << 16); h[8+2*e+1] = __uint_as_float(h1[e] & 0xffff0000u); } }
    u32x4 uu = U[j]; asm volatile("" : "+v"(uu));
    pd[j] = dot16_fp8(h, uu);
  }
  if (more) pg2_issue(U, vb, we, k + 1, lane, emask);
  float q2[2], q1;
#pragma unroll
  for (int j = 0; j < 2; ++j) { bool hi = lane & 1; float keep = hi ? pd[2*j+1] : pd[2*j], send = hi ? pd[2*j] : pd[2*j+1]; q2[j] = keep + dpp_get<0xB1>(send); }
  { bool hi = lane & 2; float keep = hi ? q2[1] : q2[0], send = hi ? q2[0] : q2[1]; q1 = keep + dpp_get<0x4E>(send); }
  q1 += swz_xor4(q1);
  q1 += dpp_get<0x128>(q1);
  q1 += __builtin_bit_cast(float, __builtin_amdgcn_ds_swizzle(__builtin_bit_cast(int, q1), 0x401F));
  q1 += __shfl_xor(q1, 32);
  float w;
  { const int jj = lane & 3; w = wg[k * PG2_BS + jj] * geluf_(q1 * wsc[k * PG2_BS + jj]); }
#pragma unroll
  for (int j = 0; j < PG2_BS; ++j) {
    const float wj = __builtin_bit_cast(float, __builtin_amdgcn_readlane(__builtin_bit_cast(int, w), j));
    const int tkj = __builtin_amdgcn_readfirstlane((int)wt[k * PG2_BS + j]);
    u32x4 vv = V[j]; asm volatile("" : "+v"(vv));
    if (tkj == 0) axpy16_fp8(acc[0], wj, vv); else if (tkj == 1) axpy16_fp8(acc[1], wj, vv); else axpy16_fp8(acc[2], wj, vv);
  }
}
#define PG2_REC_BYTES (512 * 2 + 512 * 4 + 512 * 4 + 512 + 16)
__device__ __forceinline__ void peer_lists_build(const unsigned* __restrict__ top1, const float* __restrict__ su, const float* __restrict__ sv, char* __restrict__ gl, int ntok, char* smem) {
  unsigned short* fe = (unsigned short*)(smem + PG2_OFF_FE); float* fg = (float*)(smem + PG2_OFF_FG); float* fs = (float*)(smem + PG2_OFF_FS);
  unsigned char* ft = (unsigned char*)(smem + PG2_OFF_FT); unsigned short* cnt = (unsigned short*)(smem + PG2_OFF_CNT); unsigned short* tot = (unsigned short*)(smem + PG2_OFF_TOT);
  const int per_block = (ntok + (int)gridDim.x - 1) / (int)gridDim.x;
  const int npass = (per_block + 11) / 12; const int tpp = (per_block + npass - 1) / npass;
  for (int pass = 0; pass < npass; ++pass) {
    const int t = tid_opaque();
    __syncthreads();
    for (int i = t; i < 4 * 512; i += 256) cnt[i] = 0;
    __syncthreads();
    int my_e[16]; float my_g[16];
    const int ctl = t >> 3, cp = t & 7; const int cw = ctl / 3, ctk = ctl % 3;
    bool cact = false;
    if (ctl < 12) {
      int q = ctk * 4 + cw; int idx = pass * tpp + q; int g = (int)blockIdx.x + idx * (int)gridDim.x;
      cact = q < tpp && idx < per_block && g < ntok;
      if (cact) {
        long row = pg_row(g, ntok);
        peer_combine(top1 + (row * 16 + cp * 2) * 16, top1 + (row * 16 + cp * 2 + 1) * 16, my_e, my_g);
#pragma unroll
        for (int k = 0; k < 16; ++k) cnt[((cw * 16 + (my_e[k] >> 10)) * 4 + ctk) * 8 + cp] += 1;
      }
    }
    __syncthreads();
    if (t < 64) { int w_ = t >> 4, s = t & 15; int sum = 0; for (int i = 0; i < 32; ++i) sum += cnt[(w_ * 16 + s) * 32 + i]; tot[w_ * 16 + s] = (unsigned short)sum; }
    __syncthreads();
    if (t < 64) {
      int w_ = t >> 4, s = t & 15; int run = 0; for (int i = 0; i < s; ++i) run += tot[w_ * 16 + i];
      for (int i = 0; i < 32; ++i) { int c = cnt[(w_ * 16 + s) * 32 + i]; cnt[(w_ * 16 + s) * 32 + i] = (unsigned short)run; run += c; }
      if (s == 15) tot[64 + w_] = (unsigned short)run;
    }
    __syncthreads();
    if (cact) {
#pragma unroll
      for (int k = 0; k < 16; ++k) { int ci = ((cw * 16 + (my_e[k] >> 10)) * 4 + ctk) * 8 + cp; int pos = cnt[ci]; cnt[ci] = (unsigned short)(pos + 1);
        fe[cw * 512 + pos] = (unsigned short)my_e[k]; fg[cw * 512 + pos] = my_g[k] * sv[my_e[k]]; fs[cw * 512 + pos] = su[my_e[k]]; ft[cw * 512 + pos] = (unsigned char)ctk; }
    }
    __syncthreads();
    char* rec = gl + ((long)blockIdx.x * 4 + pass) * 4 * PG2_REC_BYTES;
    for (int i = t; i < 4 * 64; i += 256) { int w_ = i >> 6, c = i & 63; *(u32x4*)(rec + w_ * PG2_REC_BYTES + c * 16) = *(const u32x4*)((const char*)fe + w_ * 1024 + c * 16); }
    for (int i = t; i < 4 * 128; i += 256) { int w_ = i >> 7, c = i & 127; *(u32x4*)(rec + w_ * PG2_REC_BYTES + 1024 + c * 16) = *(const u32x4*)((const char*)fg + w_ * 2048 + c * 16); }
    for (int i = t; i < 4 * 128; i += 256) { int w_ = i >> 7, c = i & 127; *(u32x4*)(rec + w_ * PG2_REC_BYTES + 3072 + c * 16) = *(const u32x4*)((const char*)fs + w_ * 2048 + c * 16); }
    for (int i = t; i < 4 * 32; i += 256) { int w_ = i >> 5, c = i & 31; *(u32x4*)(rec + w_ * PG2_REC_BYTES + 5120 + c * 16) = *(const u32x4*)((const char*)ft + w_ * 512 + c * 16); }
    if (t < 4) *(int*)(rec + t * PG2_REC_BYTES + 5632) = (int)tot[64 + t];
  }
  __syncthreads();
}
__device__ __forceinline__ void peer_gather_sweep(const bf16_t* __restrict__ xn, const char* __restrict__ gl, const unsigned char* __restrict__ ub,
                                                  const unsigned char* __restrict__ vb, const float* __restrict__ modl, float* __restrict__ xs,
                                                  int ntok, char* smem, bool dry = false, unsigned emask = PG2_EMASK) {
  bf16_t* hs = (bf16_t*)(smem + PG2_OFF_H); unsigned short* fe = (unsigned short*)(smem + PG2_OFF_FE); float* fg = (float*)(smem + PG2_OFF_FG); float* fs = (float*)(smem + PG2_OFF_FS);
  unsigned char* ft = (unsigned char*)(smem + PG2_OFF_FT); int* nent = (int*)(smem + PG2_OFF_TOT);
  const int per_block = (ntok + (int)gridDim.x - 1) / (int)gridDim.x;
  const int npass = (per_block + 11) / 12; const int tpp = (per_block + npass - 1) / npass;
  for (int pass = 0; pass < npass; ++pass) {
    {
      const int t = tid_opaque();
      __syncthreads();
      const char* rec = gl + ((long)blockIdx.x * 4 + pass) * 4 * PG2_REC_BYTES;
      for (int i = t; i < 4 * 64; i += 256) { int w_ = i >> 6, c = i & 63; *(u32x4*)((char*)fe + w_ * 1024 + c * 16) = *(const u32x4*)(rec + w_ * PG2_REC_BYTES + c * 16); }
      for (int i = t; i < 4 * 128; i += 256) { int w_ = i >> 7, c = i & 127; *(u32x4*)((char*)fg + w_ * 2048 + c * 16) = *(const u32x4*)(rec + w_ * PG2_REC_BYTES + 1024 + c * 16); }
      for (int i = t; i < 4 * 128; i += 256) { int w_ = i >> 7, c = i & 127; *(u32x4*)((char*)fs + w_ * 2048 + c * 16) = *(const u32x4*)(rec + w_ * PG2_REC_BYTES + 3072 + c * 16); }
      for (int i = t; i < 4 * 32; i += 256) { int w_ = i >> 5, c = i & 31; *(u32x4*)((char*)ft + w_ * 512 + c * 16) = *(const u32x4*)(rec + w_ * PG2_REC_BYTES + 5120 + c * 16); }
      if (t < 4) nent[t] = *(const int*)(rec + t * PG2_REC_BYTES + 5632);
      for (int i = t; i < 12 * 128; i += 256) {
        int tl = i >> 7, ch = i & 127; int q = (tl % 3) * 4 + (tl / 3); int idx = pass * tpp + q; int g = (int)blockIdx.x + idx * (int)gridDim.x;
        u32x4 v = {0u, 0u, 0u, 0u};
        if (q < tpp && idx < per_block && g < ntok) v = *(const u32x4*)(xn + pg_row(g, ntok) * DM + ch * 8);
        *(u32x4*)(hs + tl * 1024 + ch * 8) = v;
      }
      __syncthreads();
    }
    const int t_s = tid_opaque(); const int lane = t_s & 63, wave = t_s >> 6;
    float acc[3][16];
#pragma unroll
    for (int tk = 0; tk < 3; ++tk)
#pragma unroll
      for (int e = 0; e < 16; ++e) acc[tk][e] = 0.f;
    const int nbat = nent[wave] / PG2_BS;
    const unsigned short* we = fe + wave * 512; const float* wg = fg + wave * 512; const float* wsc = fs + wave * 512; const unsigned char* wt = ft + wave * 512;
    float h[16]; int cur_tk = -1;
    u32x4 X[PG2_BS], Y[PG2_BS], Z[PG2_BS];
    if (nbat > 0) { pg2_issue(X, ub, we, 0, lane, emask); pg2_issue(Y, vb, we, 0, lane, emask); }
    for (int k = 0; k < nbat; k += 3) {
      pg2_step(X, Y, Z, k, nbat, acc, h, cur_tk, ub, vb, wsc, we, wg, wt, hs + wave * 3 * 1024, lane, emask);
      if (k + 1 < nbat) pg2_step(Z, X, Y, k + 1, nbat, acc, h, cur_tk, ub, vb, wsc, we, wg, wt, hs + wave * 3 * 1024, lane, emask);
      if (k + 2 < nbat) pg2_step(Y, Z, X, k + 2, nbat, acc, h, cur_tk, ub, vb, wsc, we, wg, wt, hs + wave * 3 * 1024, lane, emask);
    }
#pragma unroll
    for (int tk = 0; tk < 3; ++tk) {
      int q = tk * 4 + wave; int idx = pass * tpp + q; int g = (int)blockIdx.x + idx * (int)gridDim.x;
      if (q < tpp && idx < per_block && g < ntok) {
        long row = pg_row(g, ntok); int b = row / RB, lr = row % RB; int bb = lr < SEQ ? b : BATCH; const float* g5 = modl + ((long)bb * 6 + 5) * DM + lane * 16;
        float* xr = xs + row * DM + lane * 16;
#pragma unroll
        for (int i = 0; i < 4; ++i) {
          f32x4 x = *(f32x4*)(xr + 4 * i); f32x4 gg = *(const f32x4*)(g5 + 4 * i);
          x[0] += gg[0] * acc[tk][4*i]; x[1] += gg[1] * acc[tk][4*i+1]; x[2] += gg[2] * acc[tk][4*i+2]; x[3] += gg[3] * acc[tk][4*i+3];
          if (!dry) *(f32x4*)(xr + 4 * i) = x; else if (x[0] == 1.2345e33f) *(f32x4*)(xr + 4 * i) = x;
        }
      }
    }
  }
}
#include <hip/hip_cooperative_groups.h>
namespace cg = cooperative_groups;

#define XB_TMO      128
#define XB_XCNT(j)  (256  + 64 * (j))
#define XB_XSUB(j)  (1280 + 64 * (j))
#define XB_XGEN(j)  (2304 + 64 * (j))
#define XB_TOP      3328
#define XB_TOPGEN   3392
#define XB_QUEUE(i) (3456 + 64 * (i))
#define XCD_BAR_WORDS 4096
#define XB_SPIN_CAP (1u << 22)
#define LAS __attribute__((address_space(3)))
__device__ __forceinline__ unsigned xb_ld(unsigned* p)              { return __hip_atomic_load(p, __ATOMIC_RELAXED, __HIP_MEMORY_SCOPE_AGENT); }
__device__ __forceinline__ unsigned xb_add(unsigned* p, unsigned v) { return __hip_atomic_fetch_add(p, v, __ATOMIC_RELAXED, __HIP_MEMORY_SCOPE_AGENT); }
__device__ __forceinline__ unsigned xb_xcc_id() { return (unsigned)__builtin_amdgcn_s_getreg((3 << 11) | 20) & 0xFu; }
#define XB_SPIN(cond, bar) do { unsigned _sp = 0; while (cond) { __builtin_amdgcn_s_sleep(1); \
    if ((++_sp & 255u) == 0u) { if (xb_ld(&(bar)[XB_TMO])) break; if (_sp > XB_SPIN_CAP) { atomicAdd(&(bar)[XB_TMO], 1u); break; } } } } while (0)
struct XcdBarrier { unsigned* bar; unsigned x; volatile LAS unsigned* st; };
__device__ __forceinline__ XcdBarrier xcd_barrier_post(unsigned* bar, volatile LAS unsigned* st) {
  XcdBarrier b; b.bar = bar; b.x = xb_xcc_id(); b.st = st;
  if (threadIdx.x == 0) (void)xb_add(&bar[XB_XCNT(b.x)], 1u);
  return b;
}
__device__ __forceinline__ void xcd_barrier_complete(unsigned* bar, unsigned x, unsigned& nloc, unsigned& nx) {
  const unsigned G = gridDim.x; unsigned sum, cnt, mine, sp = 0u;
  for (;;) {
    sum = 0u; cnt = 0u; mine = 0u;
#pragma unroll
    for (unsigned j = 0; j < 16; ++j) { const unsigned c = xb_ld(&bar[XB_XCNT(j)]); sum += c; cnt += (c > 0u) ? 1u : 0u; mine = (j == x) ? c : mine; }
    if (sum == G) break;
    __builtin_amdgcn_s_sleep(1);
    if ((++sp & 255u) == 0u) { if (xb_ld(&bar[XB_TMO])) break; if (sp > XB_SPIN_CAP) { atomicAdd(&bar[XB_TMO], 1u); break; } }
  }
  nloc = mine > 0u ? mine : 1u; nx = cnt > 0u ? cnt : 1u;
}
__device__ __forceinline__ void xcd_barrier(const XcdBarrier& b) {
  asm volatile("s_waitcnt vmcnt(0)" ::: "memory");
  __syncthreads();
  if (threadIdx.x == 0) {
    unsigned* bar = b.bar;
    __builtin_amdgcn_s_waitcnt(0);
    unsigned nloc = b.st[0], nx = b.st[1];
    if (nloc == 0u) { xcd_barrier_complete(bar, b.x, nloc, nx); b.st[0] = nloc; b.st[1] = nx; }
    const unsigned old = xb_add(&bar[XB_XSUB(b.x)], 1u);
    const unsigned gen = old / nloc;
    if (old + 1u == (gen + 1u) * nloc) {
      __builtin_amdgcn_fence(__ATOMIC_RELEASE, "agent");
      asm volatile("s_waitcnt vmcnt(0)" ::: "memory");
      const unsigned og = xb_add(&bar[XB_TOP], 1u);
      const unsigned tg = og / nx;
      if (og + 1u == (tg + 1u) * nx) xb_add(&bar[XB_TOPGEN], 1u);
      else XB_SPIN(xb_ld(&bar[XB_TOPGEN]) == tg, bar);
      __builtin_amdgcn_fence(__ATOMIC_ACQUIRE, "agent");
      xb_add(&bar[XB_XGEN(b.x)], 1u);
      asm volatile("s_waitcnt vmcnt(0)" ::: "memory");
    } else {
      XB_SPIN(xb_ld(&bar[XB_XGEN(b.x)]) == gen, bar);
      __builtin_amdgcn_fence(__ATOMIC_ACQUIRE, "agent");
      asm volatile("s_waitcnt vmcnt(0)" ::: "memory");
    }
  }
  __syncthreads();
}


constexpr size_t al256(size_t x) { return (x + 255) & ~(size_t)255; }
struct WsOff { size_t xs, mod, xn, Pb, tq, tkv, a_b, g_b, w_f, mq, mk, mvT, gq, gk, gvT, r_b, v_b, kk_b, kd_b, bd_b, w_inT, w_outT, wqT, keysb, wqbT, wkvbT, w2T, a2T, g2T, rope_g, rope_m, total; };
constexpr WsOff make_wsoff() {
  WsOff o{}; size_t p = 32768; const size_t MA = NROWS;
  o.mod = p; p += al256(2 * (BATCH + 1) * 6144 * 4); o.xs = p; p += al256(MA * DM * 4); o.xn = p; p += al256(MA * DM * 2);
  o.Pb = p; p += al256(MA * IN_COLS * 2);
  o.tq = p; p += al256(MA * 384 * 2); o.tkv = p; p += al256(MA * 512 * 2); o.a_b = p; p += al256(2 * MA * 384 * 2);
  o.g_b = p; p += al256(MA * 384 * 2); o.w_f = p; p += al256(2 * MA * 384 * 4);
  o.mq = p; p += al256(MA * 384 * 2); o.mk = p; p += al256(MA * 384 * 2); o.mvT = p; p += al256((size_t)BATCH * 4 * 64 * RB * 2);
  o.gq = p; p += al256(MA * 384 * 2); o.gk = p; p += al256(MA * 128 * 2); o.gvT = p; p += al256((size_t)BATCH * 2 * 64 * RB * 2);
  o.r_b = p; p += al256(MA * 384 * 2); o.v_b = p; p += al256(MA * 384 * 2); o.kk_b = p; p += al256(MA * 384 * 2);
  o.kd_b = p; p += al256(2 * MA * 384 * 2); o.bd_b = p; p += al256(2 * MA * 384 * 2);
  o.w_inT = p; p += al256((size_t)2 * 2688 * 1024 * 2); o.w_outT = p; p += al256((size_t)2 * 1024 * 1024 * 2); o.wqT = p; p += al256((size_t)2 * 2048 * 1024 * 2);
  o.keysb = p; p += al256((size_t)2 * 16 * 128 * 128 * 2); o.wqbT = p; p += al256((size_t)2 * 384 * 256 * 2); o.wkvbT = p; p += al256((size_t)2 * 512 * 128 * 2);
  o.w2T = p; p += al256((size_t)2 * 2 * 384 * 64 * 2); o.a2T = p; p += al256((size_t)2 * 2 * 384 * 64 * 2); o.g2T = p; p += al256((size_t)2 * 384 * 192 * 2);
  o.rope_g = p; p += al256((size_t)SEQ * 64 * 4); o.rope_m = p; p += al256((size_t)SEQ * 32 * 4);
  o.total = p; return o;
}
constexpr WsOff WO = make_wsoff();
#define WS_PTR(T, off) ((T*)(ws + (off)))
#define TAB_OFF (WO.Pb + ((size_t)2 * NROWS * 384 * 4 + 1048576 & ~(size_t)255))
#define TAB_U (TAB_OFF)
#define TAB_V (TAB_OFF + (size_t)16384 * 1024)
#define TAB_SU (TAB_OFF + (size_t)2 * 16384 * 1024)
#define TAB_SV (TAB_OFF + (size_t)2 * 16384 * 1024 + 65536)
#define LAUNDER_S(x) asm volatile("" : "+s"(x))
#define KARG_AS __attribute__((address_space(4)))
#define KP_DECL const KARG_AS MegaP* kp_ = (const KARG_AS MegaP*)__builtin_amdgcn_kernarg_segment_ptr(); LAUNDER_S(kp_)

struct NaiveIn {
  const float *x, *c, *ctx, *c_ctx, *ada_w, *ada_b, *norm_mix_g, *norm_ffn_g, *w_in, *w_out, *mla_q_norm_g, *mla_w_qb, *mla_kv_norm_g,
      *mla_w_kvb, *mla_qk_g, *rw_mu, *rw_w0, *rw_w2, *rw_a0, *rw_a2, *rw_g2, *rw_k_k, *rw_k_a, *rw_r_k, *rw_ln_g, *rw_ln_b, *gqa_qk_g,
      *pe_wq, *pe_keys, *pe_u, *pe_v;
};
struct MegaP { NaiveIn in; char* ws; float* out; };

#ifndef MEGA_CG
#define MEGA_CG 0
#endif
#if MEGA_CG
#define GRID_BARRIER() cg::this_grid().sync()
#else
#define GRID_BARRIER() do { XcdBarrier xb_; xb_.bar = (unsigned*)((const KARG_AS MegaP*)__builtin_amdgcn_kernarg_segment_ptr())->ws; xb_.x = xb_xcc_id(); xb_.st = (volatile LAS unsigned*)&xb_words; xcd_barrier(xb_); } while (0)
#endif
#define MEGA_LDS_BYTES 65536
#ifndef PHASE_MASK
#define PHASE_MASK 0xFFFF
#endif
#define PH(k) if (PHASE_MASK & (1 << (k)))
#define XCD_TILE_LOOP(tile, T) for (int xt_base_ = (int)(((long)(T) * (blockIdx.x & 7)) >> 3), xt_cnt_ = (int)(((long)(T) * ((blockIdx.x & 7) + 1)) >> 3) - xt_base_, xt_q_ = blockIdx.x >> 3, tile = xt_base_ + xt_q_; xt_q_ < xt_cnt_; xt_q_ += gridDim.x >> 3, tile = xt_base_ + xt_q_)
#ifndef DIL_PH
#define DIL_PH -1
#endif
#ifndef DIL_MULT
#define DIL_MULT 4
#endif
#define DIL_BEGIN(k) unsigned long long dil_t0 = 0; if (DIL_PH == (k)) dil_t0 = __builtin_amdgcn_s_memrealtime();
#define DIL_END(k) if (DIL_PH == (k)) { GRID_BARRIER(); if (blockIdx.x == 0 && threadIdx.x == 0) { unsigned long long t1 = __builtin_amdgcn_s_memrealtime(); unsigned long long dt = (t1 - dil_t0) * DIL_MULT; \
    while (__builtin_amdgcn_s_memrealtime() - t1 < dt) __builtin_amdgcn_s_sleep(32); } }

__device__ __forceinline__ void ph_norm_mod(const float* xs, const float* g, const float* modl, int shift_idx, bf16_t* xn) {
  const int tt_ = tid_opaque(); const int lane = tt_ & 63;
  for (long row = blockIdx.x * 4 + (tt_ >> 6); row < NROWS; row += (long)gridDim.x * 4) {
    int b = row / RB, lr = row % RB; int bb = lr < SEQ ? b : BATCH;
    const float* sh = modl + ((long)bb * 6 + shift_idx) * DM; const float* sc = sh + DM;
    const float* xr = xs + row * DM; f32x4 v[4]; float ss = 0.f;
#pragma unroll
    for (int i = 0; i < 4; ++i) { v[i] = *(const f32x4*)(xr + i * 256 + lane * 4); ss += v[i][0]*v[i][0] + v[i][1]*v[i][1] + v[i][2]*v[i][2] + v[i][3]*v[i][3]; }
    ss = wave_sum(ss);
    float inv = 1.f / sqrtf(ss / DM + EPSN);
#pragma unroll
    for (int i = 0; i < 4; ++i) {
      int d = i * 256 + lane * 4; float o[4];
#pragma unroll
      for (int e = 0; e < 4; ++e) o[e] = v[i][e] * inv * g[d+e] * (1.f + sc[d+e]) + sh[d+e];
      uint2 pk; pk.x = pack2bf(o[0], o[1]); pk.y = pack2bf(o[2], o[3]);
      *(uint2*)(xn + row * DM + d) = pk;
    }
  }
}
__device__ __forceinline__ void ph_cvt_wT(const float* W, const float* g, bf16_t* Wt, int K, int N, int Npad, int Kpad) {
  const long n_el = (long)Npad * Kpad;
  const int tt_ = tid_opaque();
  for (long i = (long)blockIdx.x * 256 + tt_; i < n_el; i += (long)gridDim.x * 256) {
    int k = i % Kpad; int n = i / Kpad;
    Wt[i] = (k < K && n < N) ? f2bf(W[(long)k * N + n] * (g ? g[k] : 1.f)) : (bf16_t)0;
  }
}
__device__ __forceinline__ void ph_cvt_bf16(const float* s, bf16_t* d, long n8) {
  const int tt_ = tid_opaque();
  for (long i = (long)blockIdx.x * 256 + tt_; i < n8; i += (long)gridDim.x * 256) {
    f32x4 a = *(const f32x4*)(s + i * 8), b = *(const f32x4*)(s + i * 8 + 4);
    u32x4 o; o[0] = pack2bf(a[0], a[1]); o[1] = pack2bf(a[2], a[3]); o[2] = pack2bf(b[0], b[1]); o[3] = pack2bf(b[2], b[3]);
    *(u32x4*)(d + i * 8) = o;
  }
}


__device__ __forceinline__ void ph_cvt_wT_tiled(const float* __restrict__ W, const float* __restrict__ g, bf16_t* __restrict__ Wt, int K, int N, int Npad, int Kpad, char* smem) {
  const int t = tid_opaque(); float* s = (float*)smem;
  const int tk = Kpad / 64, tn = Npad / 64;
  for (int tile = blockIdx.x; tile < tk * tn; tile += gridDim.x) {
    const int k0 = (tile % tk) * 64, n0 = (tile / tk) * 64;
    __syncthreads();
#pragma unroll
    for (int i = 0; i < 4; ++i) {
      int kk = (t >> 4) + 16 * i, nn = (t & 15) * 4; int k = k0 + kk;
      f32x4 v = {0.f, 0.f, 0.f, 0.f};
      if (k < K) {
        const float* src = W + (long)k * N + n0 + nn; float gs = g ? g[k] : 1.f;
        if (n0 + nn + 3 < N) v = *(const f32x4*)src; else { for (int e = 0; e < 4; ++e) if (n0 + nn + e < N) v[e] = src[e]; }
        v *= gs;
      }
#pragma unroll
      for (int e = 0; e < 4; ++e) s[kk * 65 + nn + e] = v[e];
    }
    __syncthreads();
    {
      int nn = t >> 2, kq = (t & 3) * 16; u32x4 o0, o1;
#pragma unroll
      for (int e = 0; e < 4; ++e) { o0[e] = pack2bf(s[(kq + 2*e) * 65 + nn], s[(kq + 2*e + 1) * 65 + nn]); o1[e] = pack2bf(s[(kq + 8 + 2*e) * 65 + nn], s[(kq + 8 + 2*e + 1) * 65 + nn]); }
      bf16_t* dst = Wt + (long)(n0 + nn) * Kpad + k0 + kq;
      *(u32x4*)dst = o0; *(u32x4*)(dst + 8) = o1;
    }
  }
}
__device__ __forceinline__ void ph_mod_gemv(const float* __restrict__ c, const float* __restrict__ c_ctx, const float* __restrict__ ada_w, const float* __restrict__ ada_b, float* __restrict__ mod, char* smem) {
  const int t = tid_opaque(); float* s = (float*)smem;
  if ((int)blockIdx.x >= 2 * 24) return;
  for (int i = t; i < 9 * 1024; i += 256) { int bb = i >> 10, k = i & 1023; float v = bb < BATCH ? c[bb * DM + k] : c_ctx[k]; s[i] = siluf_(v); }
  __syncthreads();
  for (int item = blockIdx.x; item < 2 * 24; item += gridDim.x) {
    const int cb = item % 24, l = item / 24;
    const int j = cb * 256 + t; const float* wp = ada_w + (long)l * DM * 6144 + j;
    float acc[9];
#pragma unroll
    for (int bb = 0; bb < 9; ++bb) acc[bb] = 0.f;
#pragma unroll 8
    for (int k = 0; k < 1024; ++k) { float w = wp[(long)k * 6144];
#pragma unroll
      for (int bb = 0; bb < 9; ++bb) acc[bb] += s[bb * 1024 + k] * w; }
    const float bias = ada_b[l * 6144 + j];
#pragma unroll
    for (int bb = 0; bb < 9; ++bb) mod[((long)l * (BATCH + 1) + bb) * 6144 + j] = acc[bb] + bias;
  }
  __syncthreads();
}

__global__ void __launch_bounds__(256, 2) mega_kernel(MegaP p) {
  __shared__ __attribute__((aligned(16))) char smem[MEGA_LDS_BYTES];
  __shared__ uint4 xb_words;
  const int t0 = threadIdx.x;
#if !MEGA_CG
  if (t0 == 0) xb_words = make_uint4(0u, 0u, 0u, 0u);
  __syncthreads();
  (void)xcd_barrier_post((unsigned*)p.ws, (volatile LAS unsigned*)&xb_words);
#endif
  const long MA = NROWS; const int TM = NROWS / 128;
#define I (kp_->in)
  const int scan_role = (int)blockIdx.x < BATCH * 24 ? 1 : 0;
  { DIL_BEGIN(0)
  PH(0) {
    KP_DECL; char* ws = kp_->ws; const int t = tid_opaque();
    float* xs = WS_PTR(float, WO.xs); float* mod = WS_PTR(float, WO.mod);
    for (long i = (long)blockIdx.x * 256 + t; i < MA * DM / 4; i += (long)gridDim.x * 256) {
      long e = i * 4; int d = e % DM; long row = e / DM; int b = row / RB, lr = row % RB;
      const float* src = lr < SEQ ? I.x + ((long)b * SEQ + lr) * DM + d : I.ctx + ((long)b * CTX_LEN + (lr - SEQ)) * DM + d;
      *(f32x4*)(xs + e) = *(const f32x4*)src;
    }
    ph_mod_gemv(I.c, I.c_ctx, I.ada_w, I.ada_b, mod, smem);
    for (int l = 0; l < 2; ++l) {
      ph_cvt_wT_tiled(I.w_in + (long)l * DM * IN_COLS, nullptr, WS_PTR(bf16_t, WO.w_inT) + (long)l * 2688 * 1024, 1024, IN_COLS, 2688, 1024, smem);
      ph_cvt_wT_tiled(I.w_out + (long)l * DM * DM, nullptr, WS_PTR(bf16_t, WO.w_outT) + (long)l * 1024 * 1024, 1024, 1024, 1024, 1024, smem);
      ph_cvt_wT_tiled(I.pe_wq + (long)l * DM * 2048, nullptr, WS_PTR(bf16_t, WO.wqT) + (long)l * 2048 * 1024, 1024, 2048, 2048, 1024, smem);
      ph_cvt_wT_tiled(I.mla_w_qb + (long)l * 256 * 384, I.mla_q_norm_g + l * 256, WS_PTR(bf16_t, WO.wqbT) + (long)l * 384 * 256, 256, 384, 384, 256, smem);
      ph_cvt_wT_tiled(I.mla_w_kvb + (long)l * 128 * 512, I.mla_kv_norm_g + l * 128, WS_PTR(bf16_t, WO.wkvbT) + (long)l * 512 * 128, 128, 512, 512, 128, smem);
      for (int d = 0; d < 2; ++d) {
        ph_cvt_wT_tiled(I.rw_w2 + ((long)l * 2 + d) * 64 * 384, nullptr, WS_PTR(bf16_t, WO.w2T) + ((long)l * 2 + d) * 384 * 64, 64, 384, 384, 64, smem);
        ph_cvt_wT_tiled(I.rw_a2 + ((long)l * 2 + d) * 64 * 384, nullptr, WS_PTR(bf16_t, WO.a2T) + ((long)l * 2 + d) * 384 * 64, 64, 384, 384, 64, smem);
      }
      ph_cvt_wT_tiled(I.rw_g2 + (long)l * 160 * 384, nullptr, WS_PTR(bf16_t, WO.g2T) + (long)l * 384 * 192, 160, 384, 384, 192, smem);
    }
    ph_cvt_bf16(I.pe_keys, WS_PTR(bf16_t, WO.keysb), 2L * 16 * 128 * 128 / 8);
    ph_rope_tables(WS_PTR(float, WO.rope_g), WS_PTR(float, WO.rope_m));
  }
  DIL_END(0) }
  GRID_BARRIER();
  for (int lq = 0; lq < 2; ++lq) {
    int l = lq; LAUNDER_S(l);
    { DIL_BEGIN(1)
    PH(1) if (l == 0) {
      KP_DECL; char* ws = kp_->ws; const int t = tid_opaque(); (void)t;
      ph_norm_mod(WS_PTR(float, WO.xs), I.norm_mix_g + l * DM, WS_PTR(float, WO.mod) + (long)l * (BATCH + 1) * 6144, 0, WS_PTR(bf16_t, WO.xn));
    }
    DIL_END(1) }
    GRID_BARRIER();
    { DIL_BEGIN(2)
    PH(2) {
      KP_DECL; char* ws = kp_->ws; const int t = tid_opaque(); (void)t;
      const bf16_t* xn = WS_PTR(bf16_t, WO.xn); const bf16_t* wT = WS_PTR(bf16_t, WO.w_inT) + (long)l * 2688 * 1024; bf16_t* Pb = WS_PTR(bf16_t, WO.Pb);
      XCD_TILE_LOOP(tile, TM * 21)
        gemm_tile_128_glds(xn, DM, wT, 1024, 1024, tile / 21, tile % 21, smem, EpiStoreBf16{Pb, IN_COLS, IN_COLS});
    }
    DIL_END(2) }
    GRID_BARRIER();
    { DIL_BEGIN(3)
    PH(3) {
      KP_DECL; char* ws = kp_->ws; const int t = tid_opaque(); (void)t;
      PrepW pw{WS_PTR(bf16_t, WO.wqbT) + (long)l * 384 * 256, WS_PTR(bf16_t, WO.wkvbT) + (long)l * 512 * 128, WS_PTR(bf16_t, WO.w2T) + (long)l * 2 * 384 * 64,
               WS_PTR(bf16_t, WO.a2T) + (long)l * 2 * 384 * 64, WS_PTR(bf16_t, WO.g2T) + (long)l * 384 * 192, I.rw_mu + (long)l * 2 * RWC, I.rw_w0 + l * 768, I.rw_a0 + l * 768};
      PrepBuf pb{WS_PTR(bf16_t, WO.Pb), WS_PTR(bf16_t, WO.tq), WS_PTR(bf16_t, WO.tkv), WS_PTR(bf16_t, WO.a_b), WS_PTR(bf16_t, WO.g_b), WS_PTR(float, WO.w_f)};
      XCD_TILE_LOOP(tile, TM * 22) prep_gemm_tile(pw, pb, tile / 22, tile % 22, smem);
    }
    DIL_END(3) }
    GRID_BARRIER();
    { DIL_BEGIN(4)
    PH(4) {
      KP_DECL; char* ws = kp_->ws; const int t = tid_opaque(); (void)t;
      FinW2 fw{I.mla_qk_g + l * 192, I.gqa_qk_g + l * 128, I.rw_mu + (long)l * 2 * RWC, I.rw_k_k + l * 384, I.rw_k_a + l * 384, WS_PTR(float, WO.rope_g), WS_PTR(float, WO.rope_m)};
      FinBuf fb{WS_PTR(bf16_t, WO.Pb), WS_PTR(bf16_t, WO.tq), WS_PTR(bf16_t, WO.tkv), WS_PTR(bf16_t, WO.a_b), WS_PTR(bf16_t, WO.mq), WS_PTR(bf16_t, WO.mk), WS_PTR(bf16_t, WO.mvT),
                WS_PTR(bf16_t, WO.gq), WS_PTR(bf16_t, WO.gk), WS_PTR(bf16_t, WO.gvT), WS_PTR(bf16_t, WO.r_b), WS_PTR(bf16_t, WO.v_b), WS_PTR(bf16_t, WO.kk_b), WS_PTR(bf16_t, WO.kd_b), WS_PTR(bf16_t, WO.bd_b)};
      for (int tile = blockIdx.x; tile < NROWS / 32; tile += gridDim.x) prep_finish_tile2(fw, fb, tile, smem);
    }
    DIL_END(4) }
    GRID_BARRIER();
    { unsigned long long dil_t0 = 0, dil_scan = 0; if (DIL_PH == 5 || DIL_PH == 11) dil_t0 = __builtin_amdgcn_s_memrealtime();
    PH(5) {
      KP_DECL; char* ws = kp_->ws; const int t = tid_opaque(); (void)t;
      int* s_item = (int*)(smem + MEGA_LDS_BYTES - 16);
      unsigned* sctr = (unsigned*)ws + XB_QUEUE(4 + l);
      auto scan_loop = [&]() {
        for (;;) {
          __syncthreads();
          if (t == 0) *s_item = (int)xb_add(sctr, 1u);
          __syncthreads();
          const int it = *s_item;
          if (it >= BATCH * 24) break;
          rw_scan_block(WS_PTR(bf16_t, WO.r_b), WS_PTR(bf16_t, WO.v_b), WS_PTR(bf16_t, WO.kk_b), WS_PTR(bf16_t, WO.kd_b), WS_PTR(bf16_t, WO.bd_b), WS_PTR(float, WO.w_f), WS_PTR(float, WO.Pb),
                        it, (long)MA * 384, smem);
        }
      };
      if (scan_role) scan_loop();
      const int nqt = l == 0 ? 18 : 16; const int n_mla = BATCH * 4 * nqt, n_all = BATCH * 10 * nqt;
      unsigned* qctr = (unsigned*)ws + XB_QUEUE(l);
      for (;;) {
        __syncthreads();
        if (t == 0) *s_item = (int)xb_add(qctr, 1u);
        __syncthreads();
        const int it = *s_item;
        if (it >= n_all) break;
        const KARG_AS MegaP* kp2_ = (const KARG_AS MegaP*)__builtin_amdgcn_kernarg_segment_ptr(); LAUNDER_S(kp2_); char* ws2 = kp2_->ws;
        if (it < n_mla) { int qt = it / (BATCH * 4), r = it % (BATCH * 4);
          attn_block<96>((const bf16_t*)(ws2 + WO.mq), 4, (const bf16_t*)(ws2 + WO.mk), 4, (const bf16_t*)(ws2 + WO.mvT), 1, (bf16_t*)(ws2 + WO.tq), 0, r / 4, r % 4, qt, smem); }
        else { int v = it - n_mla; int qt = v / (BATCH * 6), r = v % (BATCH * 6);
          attn_block<64>((const bf16_t*)(ws2 + WO.gq), 6, (const bf16_t*)(ws2 + WO.gk), 2, (const bf16_t*)(ws2 + WO.gvT), 3, (bf16_t*)(ws2 + WO.tq), 640, r / 6, r % 6, qt, smem); }
      }
      if (!scan_role) scan_loop();
      {
        unsigned* cctr = (unsigned*)ws + XB_QUEUE(2 + l);
        for (;;) {
          __syncthreads();
          if (t == 0) *s_item = (int)xb_add(cctr, 1u);
          __syncthreads();
          const int it = *s_item;
          if (it >= 512) break;
          const int tab = it >> 8, r0 = (it & 255) * 64;
          if (tab == 0) ph_cvt_fp8_rows(I.pe_u + (long)l * 16384 * DM, WS_PTR(unsigned char, TAB_U), WS_PTR(float, TAB_SU), r0, r0 + 64);
          else ph_cvt_fp8_rows(I.pe_v + (long)l * 16384 * DM, WS_PTR(unsigned char, TAB_V), WS_PTR(float, TAB_SV), r0, r0 + 64);
        }
      }
    }
#if DIL_PH == 11
    GRID_BARRIER(); if (blockIdx.x == 0 && threadIdx.x == 0) { unsigned long long t1 = __builtin_amdgcn_s_memrealtime(); unsigned long long dt = dil_scan * DIL_MULT; while (__builtin_amdgcn_s_memrealtime() - t1 < dt) __builtin_amdgcn_s_sleep(32); }
#endif
    (void)dil_scan;
    DIL_END(5) }
    GRID_BARRIER();
    { DIL_BEGIN(6)
    PH(6) {
      KP_DECL; char* ws = kp_->ws; const int t = tid_opaque(); (void)t;
      RdW rw{I.rw_r_k + l * 384, I.rw_ln_g + l * 384, I.rw_ln_b + l * 384};
      for (long row = blockIdx.x * 4 + (t >> 6); row < NROWS; row += (long)gridDim.x * 4)
        rw_readout_row2(rw, WS_PTR(float, WO.Pb), WS_PTR(bf16_t, WO.r_b), WS_PTR(bf16_t, WO.v_b), WS_PTR(bf16_t, WO.kd_b), WS_PTR(bf16_t, WO.g_b), WS_PTR(bf16_t, WO.tq), row, t & 63);
    }
    DIL_END(6) }
    GRID_BARRIER();
    { DIL_BEGIN(7)
    PH(7) {
      KP_DECL; char* ws = kp_->ws; const int t = tid_opaque(); (void)t;
      const bf16_t* mix = WS_PTR(bf16_t, WO.tq); const bf16_t* wT = WS_PTR(bf16_t, WO.w_outT) + (long)l * 1024 * 1024; float* xs = WS_PTR(float, WO.xs);
      const float* modl = WS_PTR(float, WO.mod) + (long)l * (BATCH + 1) * 6144;
      XCD_TILE_LOOP(tile, TM * 8)
        gemm_tile_128_glds(mix, DM, wT, 1024, 1024, tile / 8, tile % 8, smem, EpiResid{xs, modl, 2, 0});
    }
    DIL_END(7) }
    GRID_BARRIER();
    { DIL_BEGIN(8)
    PH(8) {
      KP_DECL; char* ws = kp_->ws; const int t = tid_opaque(); (void)t;
      ph_norm_mod(WS_PTR(float, WO.xs), I.norm_ffn_g + l * DM, WS_PTR(float, WO.mod) + (long)l * (BATCH + 1) * 6144, 3, WS_PTR(bf16_t, WO.xn));
    }
    DIL_END(8) }
    GRID_BARRIER();
    { DIL_BEGIN(9)
    PH(9) {
      KP_DECL; char* ws = kp_->ws; const int t = tid_opaque(); (void)t;
      const bf16_t* xn = WS_PTR(bf16_t, WO.xn); const bf16_t* wT = WS_PTR(bf16_t, WO.wqT) + (long)l * 2048 * 1024; const bf16_t* kb = WS_PTR(bf16_t, WO.keysb) + (long)l * 16 * 128 * 128;
      unsigned* top1 = WS_PTR(unsigned, WO.tq);
      XCD_TILE_LOOP(tile, TM * 16) { peer_q_top1_tile(xn, wT, kb, top1, tile / 16, tile % 16, smem); __syncthreads(); }
    }
    DIL_END(9) }
    GRID_BARRIER();
    { DIL_BEGIN(10)
    PH(10) {
      KP_DECL; char* ws = kp_->ws; const int t = tid_opaque(); (void)t;
      const float* modl = WS_PTR(float, WO.mod) + (long)l * (BATCH + 1) * 6144;
      peer_gather_sliced(WS_PTR(bf16_t, WO.xn), WS_PTR(unsigned, WO.tq), WS_PTR(unsigned char, TAB_U), WS_PTR(float, TAB_SU),
                         WS_PTR(unsigned char, TAB_V), WS_PTR(float, TAB_SV), modl, WS_PTR(float, WO.xs), l == 0 ? NROWS : BATCH * SEQ, smem,
                         I.norm_mix_g + (l == 0 ? DM : 0), WS_PTR(float, WO.mod) + (long)(l == 0 ? 1 : 0) * (BATCH + 1) * 6144, WS_PTR(bf16_t, WO.xn), l == 0 ? (float*)nullptr : kp_->out);
    }
    DIL_END(10) }
    GRID_BARRIER();
  }
}

extern "C" void kernel_launch(void* const* d_in, const int* in_sizes, int n_in, void* d_out, int out_size, void* d_ws, size_t ws_size,
                              hipStream_t stream) {
  MegaP p{};
  const float** pp = (const float**)&p.in;
  for (int i = 0; i < 31; ++i) pp[i] = (const float*)d_in[i];
  p.ws = (char*)d_ws; p.out = (float*)d_out;
  if (WO.total > ws_size) return;
  static int grid_blocks = 0;
  if (!grid_blocks) {
    int dev = 0, cus = 0, per_cu = 0;
    hipGetDevice(&dev);
    hipDeviceGetAttribute(&cus, hipDeviceAttributeMultiprocessorCount, dev);
    hipOccupancyMaxActiveBlocksPerMultiprocessor(&per_cu, mega_kernel, 256, 0);
    if (per_cu > 2) per_cu = 2;
    if (per_cu < 1) per_cu = 1;
    grid_blocks = cus * per_cu;
  }
  hipMemsetAsync(d_ws, 0, 32768, stream);
  void* args[] = {&p};
  hipLaunchCooperativeKernel((void*)mega_kernel, dim3(grid_blocks), dim3(256), args, 0, stream);
}
```

```cpp
#include <hip/hip_runtime.h>
#define PEER_EXP(x) __builtin_amdgcn_exp2f((x) * 1.4426950408889634f)
#ifndef BATCH
#define BATCH 8
#endif
#ifndef SEQ
#define SEQ 2048
#endif
#ifndef CTX_LEN
#define CTX_LEN 256
#endif
#define DM 1024
#define RB (SEQ + CTX_LEN)
#define NROWS (BATCH * RB)
#define IN_COLS 2624
#define MLA_OFF 0
#define RW_OFF 416
#define GQA_OFF 1984
#define RWC 1568
#define EPSN 1e-6f

__device__ inline float sigmoidf_(float x) { return 1.f / (1.f + expf(-x)); }
__device__ inline float siluf_(float x) { return x * sigmoidf_(x); }
__device__ inline float softplusf_(float x) { return fmaxf(x, 0.f) + log1pf(expf(-fabsf(x))); }
__device__ inline float geluf_(float x) { return 0.5f * x * (1.f + tanhf(0.7978845608028654f * (x + 0.044715f * x * x * x))); }

__global__ void nk_copy_in(const float* x, const float* ctx, float* xs) {
  long i = (long)blockIdx.x * blockDim.x + threadIdx.x;
  if (i >= (long)NROWS * DM) return;
  int d = i % DM; long row = i / DM; int b = row / RB, lr = row % RB;
  xs[i] = lr < SEQ ? x[((long)b * SEQ + lr) * DM + d] : ctx[((long)b * CTX_LEN + (lr - SEQ)) * DM + d];
}
__global__ void nk_copy_out(const float* xs, float* out) {
  long i = (long)blockIdx.x * blockDim.x + threadIdx.x;
  if (i >= (long)BATCH * SEQ * DM) return;
  int d = i % DM; long row = i / DM; int b = row / SEQ, t = row % SEQ;
  out[i] = xs[((long)b * RB + t) * DM + d];
}
__global__ void nk_mod(const float* c, const float* c_ctx, const float* ada_w, const float* ada_b, float* mod) {
  long i = (long)blockIdx.x * blockDim.x + threadIdx.x;
  if (i >= 2L * (BATCH + 1) * 6144) return;
  int j = i % 6144; int bb = (i / 6144) % (BATCH + 1); int l = i / (6144 * (BATCH + 1));
  const float* cv = bb < BATCH ? c + (long)bb * DM : c_ctx;
  const float* w = ada_w + (long)l * DM * 6144;
  float acc = 0.f;
  for (int k = 0; k < DM; ++k) acc += siluf_(cv[k]) * w[(long)k * 6144 + j];
  mod[i] = acc + ada_b[l * 6144 + j];
}
__global__ void nk_norm_mod(const float* xs, const float* g, const float* modl, int shift_idx, float* xn, int M, int bidx) {
  long row = (long)blockIdx.x * blockDim.x + threadIdx.x;
  if (row >= M) return;
  int lr = row % RB; int bb = lr < SEQ ? bidx : BATCH;
  const float* sh = modl + ((long)bb * 6 + shift_idx) * DM; const float* sc = sh + DM;
  const float* xr = xs + row * DM; float ss = 0.f;
  for (int d = 0; d < DM; ++d) ss += xr[d] * xr[d];
  float inv = 1.f / sqrtf(ss / DM + EPSN);
  for (int d = 0; d < DM; ++d) xn[row * DM + d] = xr[d] * inv * g[d] * (1.f + sc[d]) + sh[d];
}
__global__ void nk_gemm(const float* A, const float* W, float* C, int M, int N, int K) {
  long i = (long)blockIdx.x * blockDim.x + threadIdx.x;
  if (i >= (long)M * N) return;
  int n = i % N; long m = i / N; float acc = 0.f;
  for (int k = 0; k < K; ++k) acc += A[m * K + k] * W[(long)k * N + n];
  C[i] = acc;
}
__global__ void nk_mla_q1(const float* P, const float* qng, const float* wqb, float* tq, int M) {
  long i = (long)blockIdx.x * blockDim.x + threadIdx.x;
  if (i >= (long)M * 384) return;
  int j = i % 384; long r = i / 384; const float* cq = P + r * IN_COLS;
  float ss = 0.f; for (int k = 0; k < 256; ++k) ss += cq[k] * cq[k];
  float inv = 1.f / sqrtf(ss / 256 + EPSN), acc = 0.f;
  for (int k = 0; k < 256; ++k) acc += cq[k] * inv * qng[k] * wqb[k * 384 + j];
  tq[i] = acc;
}
__global__ void nk_mla_kv1(const float* P, const float* kvng, const float* wkvb, float* tkv, int M) {
  long i = (long)blockIdx.x * blockDim.x + threadIdx.x;
  if (i >= (long)M * 512) return;
  int j = i % 512; long r = i / 512; const float* ck = P + r * IN_COLS + 256;
  float ss = 0.f; for (int k = 0; k < 128; ++k) ss += ck[k] * ck[k];
  float inv = 1.f / sqrtf(ss / 128 + EPSN), acc = 0.f;
  for (int k = 0; k < 128; ++k) acc += ck[k] * inv * kvng[k] * wkvb[k * 512 + j];
  tkv[i] = acc;
}
__global__ void nk_mla_qk2(const float* P, const float* tq, const float* tkv, const float* qkg, float* mq, float* mk, int M) {
  long i = (long)blockIdx.x * blockDim.x + threadIdx.x;
  if (i >= (long)M * 8) return;
  int which = i % 2, h = (i / 2) % 4; long r = i / 8; int lr = r % RB;
  float ss = 0.f;
  for (int e = 0; e < 96; ++e) {
    float v = which == 0 ? tq[r * 384 + h * 96 + e] : (e < 64 ? tkv[r * 512 + h * 128 + e] : P[r * IN_COLS + 384 + (e - 64)]);
    ss += v * v;
  }
  float inv = 1.f / sqrtf(ss / 96 + EPSN);
  const float* g = qkg + which * 96; float* o = (which == 0 ? mq : mk) + r * 384 + h * 96;
  for (int e = 0; e < 64; ++e) {
    float v = which == 0 ? tq[r * 384 + h * 96 + e] : tkv[r * 512 + h * 128 + e];
    o[e] = v * inv * g[e];
  }
  for (int j = 0; j < 16; ++j) {
    float va = which == 0 ? tq[r * 384 + h * 96 + 64 + j] : P[r * IN_COLS + 384 + j];
    float vb = which == 0 ? tq[r * 384 + h * 96 + 80 + j] : P[r * IN_COLS + 384 + 16 + j];
    va *= inv * g[64 + j]; vb *= inv * g[80 + j];
    if (lr < SEQ) {
      int pos = j < 8 ? lr / 64 : lr % 64; float fr = powf(10000.f, -(float)(j & 7) / 8.f);
      float ang = (float)pos * fr, cs = cosf(ang), sn = sinf(ang);
      o[64 + j] = va * cs - vb * sn; o[80 + j] = va * sn + vb * cs;
    } else { o[64 + j] = va; o[80 + j] = vb; }
  }
}
__global__ void nk_gqa_prep(const float* P, const float* qkg, float* gq, float* gk, int M) {
  long i = (long)blockIdx.x * blockDim.x + threadIdx.x;
  if (i >= (long)M * 8) return;
  int h = i % 8; long r = i / 8; int lr = r % RB;
  const float* src = P + r * IN_COLS + GQA_OFF + h * 64;
  const float* g = qkg + (h < 6 ? 0 : 64);
  float* o = h < 6 ? gq + r * 384 + h * 64 : gk + r * 128 + (h - 6) * 64;
  float ss = 0.f; for (int e = 0; e < 64; ++e) ss += src[e] * src[e];
  float inv = 1.f / sqrtf(ss / 64 + EPSN);
  for (int j = 0; j < 32; ++j) {
    float va = src[j] * inv * g[j], vb = src[32 + j] * inv * g[32 + j];
    if (lr < SEQ) {
      int pos = j < 16 ? lr / 64 : lr % 64; float fr = powf(10000.f, -(float)(j & 15) / 16.f);
      float ang = (float)pos * fr, cs = cosf(ang), sn = sinf(ang);
      o[j] = va * cs - vb * sn; o[32 + j] = va * sn + vb * cs;
    } else { o[j] = va; o[32 + j] = vb; }
  }
}
template <int DQ>
__global__ void __launch_bounds__(256) nk_attn(const float* q, int qs, const float* k, int ks, const float* v, int vs, int vhs, int H, int G, float* mix, int ooff, int M) {
  long i = (long)blockIdx.x * blockDim.x + threadIdx.x;
  if (i >= (long)M * H) return;
  int h = i % H; long r = i / H; int b = r / RB, lr = r % RB; int kh = h / G;
  float qv[DQ];
#pragma unroll
  for (int e = 0; e < DQ; ++e) qv[e] = q[r * qs + h * DQ + e];
  float acc[64];
#pragma unroll
  for (int e = 0; e < 64; ++e) acc[e] = 0.f;
  float mx = -1e30f, l = 0.f; const float scale = 1.f / sqrtf((float)DQ);
  int k0 = lr < SEQ ? 0 : SEQ, k1 = RB;
  for (int kr = k0; kr < k1; ++kr) {
    long rr = (long)b * RB + kr; const float* kp = k + rr * ks + kh * DQ; float s = 0.f;
#pragma unroll
    for (int e = 0; e < DQ; ++e) s += qv[e] * kp[e];
    s *= scale;
    float mn = fmaxf(mx, s), al = expf(mx - mn), pp = expf(s - mn);
    l = l * al + pp; mx = mn; const float* vp = v + rr * vs + kh * vhs;
#pragma unroll
    for (int e = 0; e < 64; ++e) acc[e] = acc[e] * al + pp * vp[e];
  }
#pragma unroll
  for (int e = 0; e < 64; ++e) mix[r * DM + ooff + h * 64 + e] = acc[e] / l;
}
__global__ void nk_rw_shift(const float* P, const float* mu, float* rwx, int M) {
  long i = (long)blockIdx.x * blockDim.x + threadIdx.x;
  if (i >= (long)M * RWC) return;
  int c = i % RWC; long r = i / RWC; int lr = r % RB;
  bool first = (lr == 0) || (lr == SEQ), last = (lr == SEQ - 1) || (lr == RB - 1);
  float p = P[r * IN_COLS + RW_OFF + c];
  float pv = first ? 0.f : P[(r - 1) * IN_COLS + RW_OFF + c], nx = last ? 0.f : P[(r + 1) * IN_COLS + RW_OFF + c];
  rwx[i] = p + mu[c] * (pv - p) + mu[RWC + c] * (nx - p);
}
__global__ void nk_rw_prep(const float* rwx, const float* w0, const float* w2, const float* a0, const float* a2, const float* g2,
                           const float* k_k, const float* k_a, float* dec, float* kd, float* bd, float* kk, float* gg, int M) {
  long i = (long)blockIdx.x * blockDim.x + threadIdx.x;
  if (i >= (long)M * 384) return;
  int c = i % 384; long r = i / 384; int h = c / 64; const float* xr = rwx + r * RWC;
  float kv = xr[384 + c];
  float ss = 0.f; for (int n = 0; n < 64; ++n) { float t = xr[384 + h * 64 + n] * k_k[h * 64 + n]; ss += t * t; }
  float kkv = kv * k_k[c] / sqrtf(ss + 1e-12f);
  kk[i] = kkv;
  for (int d = 0; d < 2; ++d) {
    float wr = w0[d * 384 + c], ar = a0[d * 384 + c];
    for (int j = 0; j < 64; ++j) { wr += tanhf(xr[1152 + d * 64 + j]) * w2[(d * 64 + j) * 384 + c]; ar += xr[1280 + d * 64 + j] * a2[(d * 64 + j) * 384 + c]; }
    float dc = expf(-expf(-softplusf_(-wr) - 0.5f)); float a = sigmoidf_(ar);
    dec[(long)d * M * 384 + i] = dc; kd[(long)d * M * 384 + i] = kv * (1.f + (a - 1.f) * k_a[c]); bd[(long)d * M * 384 + i] = kkv * a;
  }
  float g = 0.f; for (int j = 0; j < 160; ++j) g += sigmoidf_(xr[1408 + j]) * g2[j * 384 + c];
  gg[i] = g;
}
__global__ void __launch_bounds__(256) nk_rw_scan(const float* rwx, const float* dec, const float* kd, const float* bd, const float* kk, float* y, int M, int nb) {
  long t = (long)blockIdx.x * blockDim.x + threadIdx.x;
  if (t >= (long)nb * 2 * 6 * 64) return;
  int i = t % 64, h = (t / 64) % 6, d = (t / 384) % 2, b = t / 768;
  float S[64];
#pragma unroll
  for (int j = 0; j < 64; ++j) S[j] = 0.f;
  for (int step = 0; step < RB; ++step) {
    int lr;
    if (step < CTX_LEN) lr = SEQ + (d == 0 ? step : CTX_LEN - 1 - step);
    else lr = d == 0 ? step - CTX_LEN : SEQ - 1 - (step - CTX_LEN);
    long r = (long)b * RB + lr; long o = (long)d * M * 384 + r * 384 + h * 64;
    const float* rp = rwx + r * RWC + h * 64; const float* wp = dec + o; const float* kp = kd + o; const float* bp = bd + o; const float* kkp = kk + r * 384 + h * 64;
    float vi = rwx[r * RWC + 768 + h * 64 + i];
    float skk = 0.f;
#pragma unroll
    for (int j = 0; j < 64; ++j) skk += S[j] * kkp[j];
    float yy = 0.f;
#pragma unroll
    for (int j = 0; j < 64; ++j) { S[j] = S[j] * wp[j] - skk * bp[j] + vi * kp[j]; yy += S[j] * rp[j]; }
    y[o + i] = yy;
  }
}
__global__ void nk_rw_readout(const float* rwx, const float* y, const float* kd, const float* gg, const float* r_k, const float* ln_g, const float* ln_b, float* mix, int M, long yds) {
  long i = (long)blockIdx.x * blockDim.x + threadIdx.x;
  if (i >= (long)M * 6) return;
  int h = i % 6; long r = i / 6; long o = r * 384 + h * 64; long ds = (long)M * 384;
  float mean = 0.f; for (int n = 0; n < 64; ++n) mean += y[o + n] + y[yds + o + n];
  mean /= 64.f;
  float var = 0.f, coef = 0.f;
  for (int n = 0; n < 64; ++n) {
    float yy = y[o + n] + y[yds + o + n] - mean; var += yy * yy;
    coef += rwx[r * RWC + h * 64 + n] * (kd[o + n] + kd[ds + o + n]) * r_k[h * 64 + n];
  }
  var /= 64.f; float inv = 1.f / sqrtf(var + 64e-5f);
  for (int n = 0; n < 64; ++n) {
    float yn = (y[o + n] + y[yds + o + n] - mean) * inv * ln_g[h * 64 + n] + ln_b[h * 64 + n];
    mix[r * DM + 256 + h * 64 + n] = (yn + coef * rwx[r * RWC + 768 + h * 64 + n]) * gg[o + n];
  }
}
__global__ void nk_gemm_res(const float* A, const float* W, const float* modl, int gi, float* xs, int M, int bidx) {
  long i = (long)blockIdx.x * blockDim.x + threadIdx.x;
  if (i >= (long)M * DM) return;
  int j = i % DM; long r = i / DM; int lr = r % RB; int bb = lr < SEQ ? bidx : BATCH;
  float acc = 0.f; for (int k = 0; k < DM; ++k) acc += A[r * DM + k] * W[(long)k * DM + j];
  xs[i] += modl[((long)bb * 6 + gi) * DM + j] * acc;
}
__global__ void nk_peer_score(const float* pq, const float* keys, float* sc, int M) {
  long i = (long)blockIdx.x * blockDim.x + threadIdx.x;
  if (i >= (long)M * 2048) return;
  int k = i % 128, ps = (i / 128) % 16; long r = i / 2048;
  const float* q = pq + r * 2048 + ps * 128; const float* ky = keys + ((long)ps * 128 + k) * 128;
  float acc = 0.f; for (int d = 0; d < 128; ++d) acc += q[d] * ky[d];
  sc[i] = acc;
}
__global__ void nk_peer_top1(const float* sc, float* ts, int* ti, int M) {
  long i = (long)blockIdx.x * blockDim.x + threadIdx.x;
  if (i >= (long)M * 16) return;
  const float* s = sc + i * 128; float pv = 3e38f; int pi = -1;
  for (int t = 0; t < 16; ++t) {
    float bv = -3e38f; int bi = -1;
    for (int k = 0; k < 128; ++k) {
      float v = s[k]; bool ok = (v < pv) || (v == pv && k > pi);
      if (ok && (bi < 0 || v > bv)) { bv = v; bi = k; }
    }
    ts[i * 16 + t] = bv; ti[i * 16 + t] = bi; pv = bv; pi = bi;
  }
}
__global__ void nk_peer_top2(const float* ts, const int* ti, int* pe, float* pg, int M) {
  long i = (long)blockIdx.x * blockDim.x + threadIdx.x;
  if (i >= (long)M * 8) return;
  const float* s1 = ts + i * 32; const float* s2 = s1 + 16; const int* i1 = ti + i * 32; const int* i2 = i1 + 16;
  float pv = 3e38f; int pi = -1; float mx = 0.f, sum = 0.f;
  for (int t = 0; t < 16; ++t) {
    float bv = -3e38f; int bi = -1;
    for (int c = 0; c < 256; ++c) {
      float v = s1[c / 16] + s2[c % 16]; bool ok = (v < pv) || (v == pv && c > pi);
      if (ok && (bi < 0 || v > bv)) { bv = v; bi = c; }
    }
    if (t == 0) mx = bv;
    float e = expf(bv - mx); sum += e;
    pe[i * 16 + t] = i1[bi / 16] * 128 + i2[bi % 16]; pg[i * 16 + t] = e; pv = bv; pi = bi;
  }
  for (int t = 0; t < 16; ++t) pg[i * 16 + t] /= sum;
}
__global__ void nk_peer_act(const float* xn, const float* u, const int* pe, const float* pg, float* pw, int M) {
  long i = (long)blockIdx.x * blockDim.x + threadIdx.x;
  if (i >= (long)M * 128) return;
  long r = i / 128; const float* ur = u + (long)pe[i] * DM; const float* xr = xn + r * DM;
  float acc = 0.f; for (int d = 0; d < DM; ++d) acc += xr[d] * ur[d];
  pw[i] = pg[i] * geluf_(acc);
}
__global__ void nk_peer_out(const float* v, const int* pe, const float* pw, const float* modl, float* xs, int M, int bidx) {
  long i = (long)blockIdx.x * blockDim.x + threadIdx.x;
  if (i >= (long)M * DM) return;
  int j = i % DM; long r = i / DM; int lr = r % RB; int bb = lr < SEQ ? bidx : BATCH;
  float acc = 0.f; for (int k = 0; k < 128; ++k) acc += pw[r * 128 + k] * v[(long)pe[r * 128 + k] * DM + j];
  xs[i] += modl[((long)bb * 6 + 5) * DM + j] * acc;
}


#ifndef PEER_EXP
#define PEER_EXP(x) expf(x)
#endif
__device__ __forceinline__ unsigned f2sortable(float s) { unsigned f = __float_as_uint(s); return (f & 0x80000000u) ? ~f : (f | 0x80000000u); }
__device__ __forceinline__ float sortable2f(unsigned o) { unsigned f = (o & 0x80000000u) ? (o & 0x7fffffffu) : ~o; return __uint_as_float(f); }
__device__ __forceinline__ unsigned enc_key(float s, int idx) { return (f2sortable(s) & ~127u) | (unsigned)(127 - idx); }
__device__ __forceinline__ void dec_key(unsigned k, float& s, int& idx) { idx = 127 - (int)(k & 127u); s = sortable2f(k & ~127u); }
__device__ __forceinline__ unsigned umax_(unsigned a, unsigned b) { return a > b ? a : b; }
__device__ __forceinline__ unsigned umin_(unsigned a, unsigned b) { return a < b ? a : b; }
__device__ __forceinline__ void ins16(unsigned (&l)[16], unsigned x) {
#pragma unroll
  for (int i = 0; i < 16; ++i) { unsigned mx = umax_(l[i], x); x = umin_(l[i], x); l[i] = mx; }
}
__device__ __forceinline__ void merge16(unsigned (&a)[16], const unsigned (&brev)[16]) {
#pragma unroll
  for (int i = 0; i < 16; ++i) a[i] = umax_(a[i], brev[i]);
#pragma unroll
  for (int d = 8; d >= 1; d >>= 1)
#pragma unroll
    for (int i = 0; i < 16; ++i) if ((i & d) == 0) { unsigned hi = umax_(a[i], a[i + d]), lo = umin_(a[i], a[i + d]); a[i] = hi; a[i + d] = lo; }
}
__device__ __forceinline__ void peer_combine(const unsigned* L0, const unsigned* L1, int* e_out, float* g_out) {
  float s0[16], s1[16];
#pragma unroll
  for (int i = 0; i < 16; ++i) { int ix; dec_key(L0[i], s0[i], ix); dec_key(L1[i], s1[i], ix); }
  unsigned sel[16];
#pragma unroll
  for (int i = 0; i < 16; ++i) sel[i] = 0u;
#pragma unroll
  for (int i = 0; i < 16; ++i)
#pragma unroll
    for (int j = 0; j < 16; ++j)
      if ((i + 1) * (j + 1) <= 16) { unsigned k = (f2sortable(s0[i] + s1[j]) & ~255u) | (unsigned)(255 - (i * 16 + j)); ins16(sel, k); }
  float mx = -3e38f;
#pragma unroll
  for (int t = 0; t < 16; ++t) {
    int c = 255 - (int)(sel[t] & 255u); int i = c >> 4, j = c & 15;
    float a, b; int ia, ib; dec_key(L0[i], a, ia); dec_key(L1[j], b, ib);
    float s = a + b; e_out[t] = ia * 128 + ib; g_out[t] = s; mx = fmaxf(mx, s);
  }
  float sum = 0.f;
#pragma unroll
  for (int t = 0; t < 16; ++t) { float e = PEER_EXP(g_out[t] - mx); g_out[t] = e; sum += e; }
  float inv = 1.f / sum;
#pragma unroll
  for (int t = 0; t < 16; ++t) g_out[t] *= inv;
}
__global__ void hk_peer_top1(const float* pq, const float* keys, unsigned* top1, int M) {
  long i = (long)blockIdx.x * blockDim.x + threadIdx.x;
  if (i >= (long)M * 16) return;
  int ps = i % 16; long r = i / 16; const float* q = pq + r * 2048 + ps * 128;
  unsigned la[16], lb[16], lbr[16];
#pragma unroll
  for (int t = 0; t < 16; ++t) { la[t] = 0u; lb[t] = 0u; }
  for (int k = 0; k < 128; ++k) {
    const float* ky = keys + ((long)ps * 128 + k) * 128; float acc = 0.f;
    for (int d = 0; d < 128; ++d) acc += q[d] * ky[d];
    unsigned key = enc_key(acc, k);
    if (k < 64) ins16(la, key); else ins16(lb, key);
  }
#pragma unroll
  for (int t = 0; t < 16; ++t) lbr[t] = lb[15 - t];
  merge16(la, lbr);
#pragma unroll
  for (int t = 0; t < 16; ++t) top1[i * 16 + t] = la[t];
}
__global__ void hk_peer_combine(const unsigned* top1, int* pe, float* pg, int M) {
  long i = (long)blockIdx.x * blockDim.x + threadIdx.x;
  if (i >= (long)M * 8) return;
  peer_combine(top1 + i * 32, top1 + i * 32 + 16, pe + i * 16, pg + i * 16);
}
typedef unsigned short bf16_t;
__device__ __forceinline__ int tid_opaque() { int t = threadIdx.x; asm volatile("" : "+v"(t)); return t; }
typedef __attribute__((ext_vector_type(8))) short bf16x8;
typedef __attribute__((ext_vector_type(4))) float f32x4;
typedef __attribute__((ext_vector_type(16))) float f32x16;
typedef __attribute__((ext_vector_type(4))) unsigned u32x4;

typedef __attribute__((ext_vector_type(2))) __bf16 bf16v2;
typedef __attribute__((ext_vector_type(2))) float f32v2;
__device__ __forceinline__ unsigned pack2bf(float a, float b) { f32v2 v = {a, b}; bf16v2 r = __builtin_convertvector(v, bf16v2); return __builtin_bit_cast(unsigned, r); }
__device__ __forceinline__ bf16_t f2bf(float f) { return (bf16_t)(pack2bf(f, 0.f) & 0xffffu); }
__device__ __forceinline__ float bf2f(bf16_t h) { return __uint_as_float(((unsigned)h) << 16); }

__device__ __forceinline__ float fexp_(float x) { return __builtin_amdgcn_exp2f(x * 1.4426950408889634f); }
__device__ __forceinline__ float frcp_(float x) { return __builtin_amdgcn_rcpf(x); }
__device__ __forceinline__ float fsigmoid_(float x) { return frcp_(1.f + fexp_(-x)); }
__device__ __forceinline__ float ftanh_(float x) { return 1.f - 2.f * frcp_(fexp_(2.f * x) + 1.f); }
__device__ __forceinline__ float fgelu_(float x) { return x * fsigmoid_(1.5957691216057308f * (x + 0.044715f * x * x * x)); }
__device__ __forceinline__ float fdecay_(float w) { return fexp_(-0.6065306597126334f * fsigmoid_(w)); }
#define GEMM_LDS_BYTES 32768
struct ALoadPlain { const bf16_t* A; int lda;
  __device__ __forceinline__ u32x4 operator()(int row, int k) const { return *(const u32x4*)(A + (long)row * lda + k); } };
#define GEMM_STAGE_WRITE(RA, RB) do { _Pragma("unroll") for (int i = 0; i < 4; ++i) { int r = lrow + 32 * i; int off = r * 128 + ((lchunk ^ (r & 7)) << 4); *(u32x4*)(As + off) = RA[i]; *(u32x4*)(Bs + off) = RB[i]; } } while (0)
#define GEMM_COMPUTE_TILE() do { _Pragma("unroll") for (int ks = 0; ks < 2; ++ks) { bf16x8 af[4], bfr[4]; \
    _Pragma("unroll") for (int i = 0; i < 4; ++i) { int r = wm * 64 + i * 16 + fr; af[i] = *(const bf16x8*)(As + r * 128 + (((ks * 4 + fq) ^ (r & 7)) << 4)); \
      int rn = wn * 64 + i * 16 + fr; bfr[i] = *(const bf16x8*)(Bs + rn * 128 + (((ks * 4 + fq) ^ (rn & 7)) << 4)); } \
    _Pragma("unroll") for (int i = 0; i < 4; ++i) _Pragma("unroll") for (int j = 0; j < 4; ++j) acc[i][j] = __builtin_amdgcn_mfma_f32_16x16x32_bf16(bfr[j], af[i], acc[i][j], 0, 0, 0); } } while (0)
template <class ALoad, class Epi>
__device__ __forceinline__ void gemm_tile_128(ALoad aload, const bf16_t* __restrict__ Bt, int ldb, int K,
                                              int tile_m, int tile_n, char* smem, Epi epi) {
  const int t = tid_opaque(), lane = t & 63, wave = t >> 6;
  const int wm = wave >> 1, wn = wave & 1;
  char* As = smem; char* Bs = smem + 16384;
  const int lrow = t >> 3, lchunk = t & 7;
  const int arow = tile_m * 128 + lrow;
  const bf16_t* bg = Bt + (long)(tile_n * 128 + lrow) * ldb + lchunk * 8;
  u32x4 ra0[4], rb0[4], ra1[4], rb1[4];
#pragma unroll
  for (int i = 0; i < 4; ++i) { ra0[i] = aload(arow + 32 * i, lchunk * 8); rb0[i] = *(const u32x4*)(bg + (long)(32 * i) * ldb); }
  if (K > 64) {
#pragma unroll
    for (int i = 0; i < 4; ++i) { ra1[i] = aload(arow + 32 * i, 64 + lchunk * 8); rb1[i] = *(const u32x4*)(bg + (long)(32 * i) * ldb + 64); }
  }
  f32x4 acc[4][4];
#pragma unroll
  for (int i = 0; i < 4; ++i)
#pragma unroll
    for (int j = 0; j < 4; ++j) acc[i][j] = (f32x4){0.f, 0.f, 0.f, 0.f};
  const int fr = lane & 15, fq = lane >> 4;
  for (int k0 = 0; k0 < K; k0 += 128) {
    __syncthreads();
    GEMM_STAGE_WRITE(ra0, rb0);
    __syncthreads();
    if (k0 + 128 < K) {
#pragma unroll
      for (int i = 0; i < 4; ++i) { ra0[i] = aload(arow + 32 * i, k0 + 128 + lchunk * 8); rb0[i] = *(const u32x4*)(bg + (long)(32 * i) * ldb + k0 + 128); }
    }
    GEMM_COMPUTE_TILE();
    if (k0 + 64 < K) {
      __syncthreads();
      GEMM_STAGE_WRITE(ra1, rb1);
      __syncthreads();
      if (k0 + 192 < K) {
#pragma unroll
        for (int i = 0; i < 4; ++i) { ra1[i] = aload(arow + 32 * i, k0 + 192 + lchunk * 8); rb1[i] = *(const u32x4*)(bg + (long)(32 * i) * ldb + k0 + 192); }
      }
      GEMM_COMPUTE_TILE();
    }
  }
#pragma unroll
  for (int i = 0; i < 4; ++i)
#pragma unroll
    for (int j = 0; j < 4; ++j) {
      int m = tile_m * 128 + wm * 64 + i * 16 + fr; int n0 = tile_n * 128 + wn * 64 + j * 16 + fq * 4;
      epi(m, n0, acc[i][j]);
    }
}

typedef __attribute__((address_space(3))) void lds_void_t;
typedef __attribute__((address_space(1))) const void glb_cvoid_t;
#define GEMM_GLDS_BYTES 65536
__device__ __forceinline__ void gemm_mainloop_glds(const bf16_t* __restrict__ A, int lda, const bf16_t* __restrict__ Bt, int ldb, int K,
                                                   int tile_m, int tile_n, char* smem, f32x4 (&acc)[4][4]) {
  const int t = tid_opaque(), lane = t & 63, wave = t >> 6;
  const int wm = wave >> 1, wn = wave & 1, fr = lane & 15, fq = lane >> 4;
  const int lrow = t >> 3, cl = (t & 7) ^ (lrow & 7);
  const bf16_t* ag = A + (long)(tile_m * 128 + lrow) * lda + cl * 8;
  const bf16_t* bg = Bt + (long)(tile_n * 128 + lrow) * ldb + cl * 8;
  const int wbase = __builtin_amdgcn_readfirstlane(wave) * 1024;
#pragma unroll
  for (int i = 0; i < 4; ++i)
#pragma unroll
    for (int j = 0; j < 4; ++j) acc[i][j] = (f32x4){0.f, 0.f, 0.f, 0.f};
  __syncthreads();
#pragma unroll
  for (int i = 0; i < 4; ++i) {
    __builtin_amdgcn_global_load_lds((glb_cvoid_t*)(ag + (long)(32 * i) * lda), (lds_void_t*)(smem + i * 4096 + wbase), 16, 0, 0);
    __builtin_amdgcn_global_load_lds((glb_cvoid_t*)(bg + (long)(32 * i) * ldb), (lds_void_t*)(smem + 16384 + i * 4096 + wbase), 16, 0, 0);
  }
  int buf = 0;
  for (int k0 = 0; k0 < K; k0 += 64, buf ^= 1) {
    __syncthreads();
    if (k0 + 64 < K) {
      char* nb = smem + (buf ^ 1) * 32768;
#pragma unroll
      for (int i = 0; i < 4; ++i) {
        __builtin_amdgcn_global_load_lds((glb_cvoid_t*)(ag + (long)(32 * i) * lda + k0 + 64), (lds_void_t*)(nb + i * 4096 + wbase), 16, 0, 0);
        __builtin_amdgcn_global_load_lds((glb_cvoid_t*)(bg + (long)(32 * i) * ldb + k0 + 64), (lds_void_t*)(nb + 16384 + i * 4096 + wbase), 16, 0, 0);
      }
    }
    const char* As = smem + buf * 32768; const char* Bs = As + 16384;
    GEMM_COMPUTE_TILE();
  }
}
template <class Epi>
__device__ __forceinline__ void gemm_tile_128_glds(const bf16_t* __restrict__ A, int lda, const bf16_t* __restrict__ Bt, int ldb, int K,
                                                   int tile_m, int tile_n, char* smem, Epi epi) {
  f32x4 acc[4][4];
  gemm_mainloop_glds(A, lda, Bt, ldb, K, tile_m, tile_n, smem, acc);
  const int t = tid_opaque(), lane = t & 63, wave = t >> 6, wm = wave >> 1, wn = wave & 1, fr = lane & 15, fq = lane >> 4;
#pragma unroll
  for (int i = 0; i < 4; ++i)
#pragma unroll
    for (int j = 0; j < 4; ++j) {
      int m = tile_m * 128 + wm * 64 + i * 16 + fr; int n0 = tile_n * 128 + wn * 64 + j * 16 + fq * 4;
      epi(m, n0, acc[i][j]);
    }
}

__global__ void ok_cvt_wT(const float* W, bf16_t* Wt, int K, int N, int Npad) {
  long i = (long)blockIdx.x * blockDim.x + threadIdx.x;
  if (i >= (long)Npad * K) return;
  int k = i % K; int n = i / K;
  Wt[i] = n < N ? f2bf(W[(long)k * N + n]) : (bf16_t)0;
}
__global__ void ok_f32_to_bf16(const float* s, bf16_t* d, long n) {
  long i = (long)blockIdx.x * blockDim.x + threadIdx.x; if (i < n) d[i] = f2bf(s[i]);
}
__global__ void ok_bf16_to_f32(const bf16_t* s, float* d, long n) {
  long i = (long)blockIdx.x * blockDim.x + threadIdx.x; if (i < n) d[i] = bf2f(s[i]);
}
__global__ void ok_norm_mod_bf16(const float* xs, const float* g, const float* modl, int shift_idx, bf16_t* xn, int M) {
  int row = blockIdx.x * 4 + (threadIdx.x >> 6); int lane = threadIdx.x & 63;
  if (row >= M) return;
  int b = row / RB, lr = row % RB; int bb = lr < SEQ ? b : BATCH;
  const float* sh = modl + ((long)bb * 6 + shift_idx) * DM; const float* sc = sh + DM;
  const float* xr = xs + (long)row * DM; float v[16]; float ss = 0.f;
#pragma unroll
  for (int i = 0; i < 4; ++i) { float4 q = *(const float4*)(xr + i * 256 + lane * 4); v[i*4]=q.x; v[i*4+1]=q.y; v[i*4+2]=q.z; v[i*4+3]=q.w; ss += q.x*q.x+q.y*q.y+q.z*q.z+q.w*q.w; }
#pragma unroll
  for (int o = 32; o > 0; o >>= 1) ss += __shfl_xor(ss, o);
  float inv = __builtin_amdgcn_rsqf(ss / DM + EPSN);
#pragma unroll
  for (int i = 0; i < 4; ++i) {
    int d = i * 256 + lane * 4; float o[4];
#pragma unroll
    for (int e = 0; e < 4; ++e) o[e] = v[i*4+e] * inv * g[d+e] * (1.f + sc[d+e]) + sh[d+e];
    uint2 pk; pk.x = pack2bf(o[0], o[1]); pk.y = pack2bf(o[2], o[3]);
    *(uint2*)(xn + (long)row * DM + d) = pk;
  }
}

struct EpiStoreBf16 { bf16_t* C; int ldc; int N;
  __device__ __forceinline__ void operator()(int m, int n0, f32x4 v) const {
    if (n0 < N) { uint2 pk; pk.x = pack2bf(v[0], v[1]); pk.y = pack2bf(v[2], v[3]); *(uint2*)(C + (long)m * ldc + n0) = pk; } } };
struct EpiStoreF32 { float* C; int ldc; int N;
  __device__ __forceinline__ void operator()(int m, int n0, f32x4 v) const {
    if (n0 < N) *(float4*)(C + (long)m * ldc + n0) = make_float4(v[0], v[1], v[2], v[3]); } };
struct EpiResid { float* xs; const float* modl; int gi; int pad;
  __device__ __forceinline__ void operator()(int m, int n0, f32x4 v) const {
    int b = m / RB, lr = m % RB; int bb = lr < SEQ ? b : BATCH; const float* g = modl + ((long)bb * 6 + gi) * DM + n0;
    float4 x = *(float4*)(xs + (long)m * DM + n0);
    x.x += g[0] * v[0]; x.y += g[1] * v[1]; x.z += g[2] * v[2]; x.w += g[3] * v[3];
    *(float4*)(xs + (long)m * DM + n0) = x; } };

template <class Epi>
__global__ void __launch_bounds__(256) ok_gemm(const bf16_t* A, int lda, const bf16_t* Bt, int ldb, int K, int tiles_m, int tiles_n, Epi epi) {
  __shared__ __attribute__((aligned(16))) char smem[GEMM_LDS_BYTES];
  for (int tile = blockIdx.x; tile < tiles_m * tiles_n; tile += gridDim.x) {
    int tm = tile / tiles_n, tn = tile % tiles_n;
    gemm_tile_128(ALoadPlain{A, lda}, Bt, ldb, K, tm, tn, smem, epi);
  }
}

__device__ __forceinline__ float dot2bf(unsigned a, unsigned b, float c) {
  return __builtin_amdgcn_fdot2_f32_bf16(*(bf16v2*)&a, *(bf16v2*)&b, c, false);
}
__global__ void ok_cvt_bf16_v8(const float* s, bf16_t* d, long n8) {
  long i = (long)blockIdx.x * blockDim.x + threadIdx.x; if (i >= n8) return;
  float4 a = *(const float4*)(s + i * 8), b = *(const float4*)(s + i * 8 + 4);
  u32x4 o; o[0] = pack2bf(a.x, a.y); o[1] = pack2bf(a.z, a.w); o[2] = pack2bf(b.x, b.y); o[3] = pack2bf(b.z, b.w);
  *(u32x4*)(d + i * 8) = o;
}

#define P5_LDS_BYTES (128 * 128 * 4)
__device__ __forceinline__ void peer_q_top1_tile(const bf16_t* __restrict__ A, const bf16_t* __restrict__ WqT, const bf16_t* __restrict__ keysb,
                                                 unsigned* __restrict__ top1, int tm, int ps, char* smem) {
  const int t = tid_opaque(), lane = t & 63, wave = t >> 6, wm = wave >> 1, wn = wave & 1, fr = lane & 15, fq = lane >> 4;
  f32x4 acc[4][4];
  gemm_mainloop_glds(A, DM, WqT, DM, DM, tm, ps, smem, acc);
  __syncthreads();
  char* Qs = smem; char* Ks = smem + 32768;
#pragma unroll
  for (int i = 0; i < 4; ++i)
#pragma unroll
    for (int j = 0; j < 4; ++j) {
      int m = wm * 64 + i * 16 + fr; int n0 = wn * 64 + j * 16 + fq * 4;
      uint2 pk; pk.x = pack2bf(acc[i][j][0], acc[i][j][1]); pk.y = pack2bf(acc[i][j][2], acc[i][j][3]);
      *(uint2*)(Qs + m * 256 + ((((n0 >> 3) ^ (m & 15)) << 4) | ((n0 & 7) << 1))) = pk;
    }
  {
    const bf16_t* kg = keysb + (long)ps * 128 * 128;
#pragma unroll
    for (int i = 0; i < 8; ++i) { int idx = t + 256 * i; int r = idx >> 4, c = idx & 15; *(u32x4*)(Ks + r * 256 + ((c ^ (r & 15)) << 4)) = *(const u32x4*)(kg + r * 128 + c * 8); }
  }
  __syncthreads();
#pragma unroll
  for (int i = 0; i < 4; ++i)
#pragma unroll
    for (int j = 0; j < 4; ++j) acc[i][j] = (f32x4){0.f, 0.f, 0.f, 0.f};
#pragma unroll
  for (int ks = 0; ks < 4; ++ks) {
    bf16x8 af[4], bfr[4];
#pragma unroll
    for (int i = 0; i < 4; ++i) {
      int r = wm * 64 + i * 16 + fr; af[i] = *(const bf16x8*)(Qs + r * 256 + (((ks * 4 + fq) ^ (r & 15)) << 4));
      int rn = wn * 64 + i * 16 + fr; bfr[i] = *(const bf16x8*)(Ks + rn * 256 + (((ks * 4 + fq) ^ (rn & 15)) << 4));
    }
#pragma unroll
    for (int i = 0; i < 4; ++i)
#pragma unroll
      for (int j = 0; j < 4; ++j) acc[i][j] = __builtin_amdgcn_mfma_f32_16x16x32_bf16(bfr[j], af[i], acc[i][j], 0, 0, 0);
  }
  __syncthreads();
  unsigned* Sc = (unsigned*)smem;
#pragma unroll
  for (int i = 0; i < 4; ++i)
#pragma unroll
    for (int j = 0; j < 4; ++j) {
      int m = wm * 64 + i * 16 + fr; int n0 = wn * 64 + j * 16 + fq * 4;
#pragma unroll
      for (int e = 0; e < 4; ++e) Sc[(n0 + e) * 128 + (m ^ ((((n0 + e) >> 2) & 1) << 4))] = enc_key(acc[i][j][e], n0 + e);
    }
  __syncthreads();
  {
    const int r = t & 127, half = t >> 7;
    unsigned l[16];
#pragma unroll
    for (int i = 0; i < 16; ++i) l[i] = 0u;
    for (int k = 0; k < 64; ++k) ins16(l, Sc[(half * 64 + k) * 128 + (r ^ (((k >> 2) & 1) << 4))]);
    __syncthreads();
    unsigned* Ls = (unsigned*)smem;
    if (half == 1) {
#pragma unroll
      for (int i = 0; i < 16; ++i) Ls[r * 17 + i] = l[15 - i];
    }
    __syncthreads();
    if (half == 0) {
      unsigned br[16];
#pragma unroll
      for (int i = 0; i < 16; ++i) br[i] = Ls[r * 17 + i];
      merge16(l, br);
      unsigned* o = top1 + ((long)(tm * 128 + r) * 16 + ps) * 16;
#pragma unroll
      for (int i = 0; i < 4; ++i) { u32x4 v; v[0] = l[4*i]; v[1] = l[4*i+1]; v[2] = l[4*i+2]; v[3] = l[4*i+3]; *(u32x4*)(o + 4 * i) = v; }
    }
  }
}
__global__ void __launch_bounds__(256) ok_peer_q_top1(const bf16_t* A, const bf16_t* WqT, const bf16_t* keysb, unsigned* top1, int tiles_m) {
  __shared__ __attribute__((aligned(16))) char smem[P5_LDS_BYTES];
  for (int tile = blockIdx.x; tile < tiles_m * 16; tile += gridDim.x) { peer_q_top1_tile(A, WqT, keysb, top1, tile / 16, tile % 16, smem); __syncthreads(); }
}

#define P6_LDS_BYTES (32 * 128 * 4 * 3)
__device__ __forceinline__ void peer_gather_group(const bf16_t* __restrict__ xn, const unsigned* __restrict__ top1, const bf16_t* __restrict__ ub,
                                                  const bf16_t* __restrict__ vb, const float* __restrict__ modl, float* __restrict__ xs, int grp, char* smem) {
  const int t = tid_opaque(), lane = t & 63, wave = t >> 6;
  int* pe_l = (int*)smem; float* pg_l = (float*)(smem + 32 * 128 * 4); float* pw_l = (float*)(smem + 2 * 32 * 128 * 4);
  {
    int tl = t >> 3, p = t & 7; long row = (long)grp * 32 + tl;
    peer_combine(top1 + (row * 16 + p * 2) * 16, top1 + (row * 16 + p * 2 + 1) * 16, pe_l + tl * 128 + p * 16, pg_l + tl * 128 + p * 16);
  }
  __syncthreads();
  for (int ti = 0; ti < 8; ++ti) {
    const int tl = wave * 8 + ti; const long row = (long)grp * 32 + tl;
    const int* pe = pe_l + tl * 128; float* pw = pw_l + tl * 128;
    u32x4 h0 = *(const u32x4*)(xn + row * DM + lane * 8), h1 = *(const u32x4*)(xn + row * DM + 512 + lane * 8);
    for (int b = 0; b < 16; ++b) {
      u32x4 u0[8], u1[8];
#pragma unroll
      for (int j = 0; j < 8; ++j) { const bf16_t* ur = ub + (long)pe[b * 8 + j] * DM + lane * 8; u0[j] = *(const u32x4*)ur; u1[j] = *(const u32x4*)(ur + 512); }
      float pd[8];
#pragma unroll
      for (int j = 0; j < 8; ++j) {
        float a = 0.f;
#pragma unroll
        for (int e = 0; e < 4; ++e) { a = dot2bf(h0[e], u0[j][e], a); a = dot2bf(h1[e], u1[j][e], a); }
        pd[j] = a;
      }
      float q4[4], q2[2], q1;
#pragma unroll
      for (int j = 0; j < 4; ++j) { bool hi = lane & 1; float keep = hi ? pd[2*j+1] : pd[2*j], send = hi ? pd[2*j] : pd[2*j+1]; q4[j] = keep + __shfl_xor(send, 1); }
#pragma unroll
      for (int j = 0; j < 2; ++j) { bool hi = lane & 2; float keep = hi ? q4[2*j+1] : q4[2*j], send = hi ? q4[2*j] : q4[2*j+1]; q2[j] = keep + __shfl_xor(send, 2); }
      { bool hi = lane & 4; float keep = hi ? q2[1] : q2[0], send = hi ? q2[0] : q2[1]; q1 = keep + __shfl_xor(send, 4); }
      q1 += __shfl_xor(q1, 8); q1 += __shfl_xor(q1, 16); q1 += __shfl_xor(q1, 32);
      if (lane < 8) { int j = lane & 7; pw[b * 8 + j] = q1; }
    }
    {
      float d0 = pw[lane], d1 = pw[64 + lane];
      pw[lane] = pg_l[tl * 128 + lane] * fgelu_(d0); pw[64 + lane] = pg_l[tl * 128 + 64 + lane] * fgelu_(d1);
    }
    float o[16];
#pragma unroll
    for (int e = 0; e < 16; ++e) o[e] = 0.f;
    for (int b = 0; b < 16; ++b) {
      u32x4 v0[8], v1[8];
#pragma unroll
      for (int j = 0; j < 8; ++j) { const bf16_t* vr = vb + (long)pe[b * 8 + j] * DM + lane * 8; v0[j] = *(const u32x4*)vr; v1[j] = *(const u32x4*)(vr + 512); }
#pragma unroll
      for (int j = 0; j < 8; ++j) {
        float w = pw[b * 8 + j];
#pragma unroll
        for (int e = 0; e < 4; ++e) {
          o[2*e]     += w * __uint_as_float(v0[j][e] << 16); o[2*e+1]     += w * __uint_as_float(v0[j][e] & 0xffff0000u);
          o[8 + 2*e] += w * __uint_as_float(v1[j][e] << 16); o[8 + 2*e+1] += w * __uint_as_float(v1[j][e] & 0xffff0000u);
        }
      }
    }
    {
      int b = row / RB, lr = row % RB; int bb = lr < SEQ ? b : BATCH; const float* g5 = modl + ((long)bb * 6 + 5) * DM;
      float* xr = xs + row * DM;
#pragma unroll
      for (int hf = 0; hf < 2; ++hf) {
        int d = hf * 512 + lane * 8;
        float4 x0 = *(float4*)(xr + d), x1 = *(float4*)(xr + d + 4); float4 g0 = *(const float4*)(g5 + d), g1 = *(const float4*)(g5 + d + 4);
        x0.x += g0.x * o[hf*8+0]; x0.y += g0.y * o[hf*8+1]; x0.z += g0.z * o[hf*8+2]; x0.w += g0.w * o[hf*8+3];
        x1.x += g1.x * o[hf*8+4]; x1.y += g1.y * o[hf*8+5]; x1.z += g1.z * o[hf*8+6]; x1.w += g1.w * o[hf*8+7];
        *(float4*)(xr + d) = x0; *(float4*)(xr + d + 4) = x1;
      }
    }
  }
}
__global__ void __launch_bounds__(256) ok_peer_gather(const bf16_t* xn, const unsigned* top1, const bf16_t* ub, const bf16_t* vb, const float* modl, float* xs, int ngroups) {
  __shared__ __attribute__((aligned(16))) char smem[P6_LDS_BYTES];
  for (int g = blockIdx.x; g < ngroups; g += gridDim.x) { peer_gather_group(xn, top1, ub, vb, modl, xs, g, smem); __syncthreads(); }
}

template <int DQ> struct AttnCfg { static constexpr int KROW = DQ * 2 + 16; static constexpr int VROW = 136; static constexpr int KBYTES = 64 * KROW; static constexpr int LDS = 64 * KROW + 64 * VROW; };
#define ATTN_LDS_BYTES (64 * 208 + 64 * 136)
template <int DQ>
__device__ __forceinline__ void attn_block(const bf16_t* __restrict__ qb, int HQ, const bf16_t* __restrict__ kb, int HK, const bf16_t* __restrict__ vT, int G,
                                           bf16_t* __restrict__ mixall, int ooff, int b, int head, int qt, char* smem) {
  constexpr int KROW = AttnCfg<DQ>::KROW, VROW = 136, NKK = DQ / 16, KCH = DQ / 8;
  constexpr int KLD = (64 * KCH) / 256;
  const int t = tid_opaque(), lane = t & 63, wave = t >> 6, lq = lane & 31, lh = lane >> 5;
  const int hk = head / G;
  char* Ks = smem; char* Vs = smem + 64 * KROW;
  const long qrow = (long)b * RB + qt * 128 + wave * 32 + lq;
  bf16x8 qf[NKK];
#pragma unroll
  for (int kk = 0; kk < NKK; ++kk) qf[kk] = *(const bf16x8*)(qb + (qrow * HQ + head) * DQ + kk * 16 + lh * 8);
  const int key0 = qt < 16 ? 0 : SEQ; const int nt = qt < 16 ? RB / 64 : CTX_LEN / 64;
  const bf16_t* kbase = kb + ((long)b * RB * HK + hk) * DQ; const bf16_t* vbase = vT + ((long)(b * HK + hk) * 64) * RB;
  u32x4 rk[KLD], rv[2];
  auto issue = [&](int tile) {
    int k0 = key0 + tile * 64;
#pragma unroll
    for (int i = 0; i < KLD; ++i) { int c = t + 256 * i; int r = c / KCH, cc = c % KCH; rk[i] = *(const u32x4*)(kbase + (long)(k0 + r) * HK * DQ + cc * 8); }
#pragma unroll
    for (int i = 0; i < 2; ++i) { int c = t + 256 * i; int r = c >> 3, cc = c & 7; rv[i] = *(const u32x4*)(vbase + (long)r * RB + k0 + cc * 8); }
  };
  issue(0);
  f32x16 ot[2];
#pragma unroll
  for (int d = 0; d < 2; ++d)
#pragma unroll
    for (int r = 0; r < 16; ++r) ot[d][r] = 0.f;
  float mrun = -1e30f, lrun = 0.f;
  for (int tile = 0; tile < nt; ++tile) {
    __syncthreads();
#pragma unroll
    for (int i = 0; i < KLD; ++i) { int c = t + 256 * i; int r = c / KCH, cc = c % KCH; *(u32x4*)(Ks + r * KROW + cc * 16) = rk[i]; }
#pragma unroll
    for (int i = 0; i < 2; ++i) { int c = t + 256 * i; int r = c >> 3, cc = c & 7; *(uint2*)(Vs + r * VROW + cc * 16) = make_uint2(rv[i][0], rv[i][1]); *(uint2*)(Vs + r * VROW + cc * 16 + 8) = make_uint2(rv[i][2], rv[i][3]); }
    __syncthreads();
    if (tile + 1 < nt) issue(tile + 1);
    f32x16 st[2];
#pragma unroll
    for (int kt = 0; kt < 2; ++kt) {
#pragma unroll
      for (int r = 0; r < 16; ++r) st[kt][r] = 0.f;
#pragma unroll
      for (int kk = 0; kk < NKK; ++kk) {
        bf16x8 ka = *(const bf16x8*)(Ks + (kt * 32 + lq) * KROW + kk * 32 + lh * 16);
        st[kt] = __builtin_amdgcn_mfma_f32_32x32x16_bf16(ka, qf[kk], st[kt], 0, 0, 0);
      }
    }
    float mt = st[0][0];
#pragma unroll
    for (int kt = 0; kt < 2; ++kt)
#pragma unroll
      for (int r = 0; r < 16; ++r) mt = fmaxf(mt, st[kt][r]);
    mt = fmaxf(mt, __shfl_xor(mt, 32));
    float mnew = fmaxf(mrun, mt); float alpha = __builtin_amdgcn_exp2f(mrun - mnew); mrun = mnew;
    float ps = 0.f;
#pragma unroll
    for (int kt = 0; kt < 2; ++kt)
#pragma unroll
      for (int r = 0; r < 16; ++r) { float p = __builtin_amdgcn_exp2f(st[kt][r] - mnew); st[kt][r] = p; ps += p; }
    lrun = lrun * alpha + ps;
#pragma unroll
    for (int d = 0; d < 2; ++d)
#pragma unroll
      for (int r = 0; r < 16; ++r) ot[d][r] *= alpha;
#pragma unroll
    for (int kt = 0; kt < 2; ++kt)
#pragma unroll
      for (int s = 0; s < 2; ++s) {
        union { bf16x8 v; unsigned u[4]; } pb;
#pragma unroll
        for (int j = 0; j < 4; ++j) pb.u[j] = pack2bf(st[kt][8 * s + 2 * j], st[kt][8 * s + 2 * j + 1]);
#pragma unroll
        for (int d = 0; d < 2; ++d) {
          const char* vp = Vs + (d * 32 + lq) * VROW + (kt * 32 + 16 * s + 4 * lh) * 2;
          union { bf16x8 v; uint2 h[2]; } va; va.h[0] = *(const uint2*)vp; va.h[1] = *(const uint2*)(vp + 16);
          ot[d] = __builtin_amdgcn_mfma_f32_32x32x16_bf16(va.v, pb.v, ot[d], 0, 0, 0);
        }
      }
  }
  float ltot = lrun + __shfl_xor(lrun, 32); float inv = 1.f / ltot;
  bf16_t* orow = mixall + qrow * DM + ooff + head * 64;
#pragma unroll
  for (int d = 0; d < 2; ++d)
#pragma unroll
    for (int g = 0; g < 4; ++g) {
      uint2 pk; pk.x = pack2bf(ot[d][4 * g] * inv, ot[d][4 * g + 1] * inv); pk.y = pack2bf(ot[d][4 * g + 2] * inv, ot[d][4 * g + 3] * inv);
      *(uint2*)(orow + d * 32 + 8 * g + 4 * lh) = pk;
    }
}
__global__ void __launch_bounds__(256) ok_attn(const bf16_t* mq, const bf16_t* mk, const bf16_t* mvT, const bf16_t* gq, const bf16_t* gk, const bf16_t* gvT, bf16_t* mixall, int nqt) {
  __shared__ __attribute__((aligned(16))) char smem[ATTN_LDS_BYTES];
  const int n_mla = BATCH * 4 * nqt, n_gqa = BATCH * 6 * nqt;
  for (int w = blockIdx.x; w < n_mla + n_gqa; w += gridDim.x) {
    if (w < n_mla) { int qt = w % nqt, head = (w / nqt) % 4, b = w / (nqt * 4); attn_block<96>(mq, 4, mk, 4, mvT, 1, mixall, 0, b, head, qt, smem); }
    else { int v = w - n_mla; int qt = v % nqt, head = (v / nqt) % 6, b = v / (nqt * 6); attn_block<64>(gq, 6, gk, 2, gvT, 3, mixall, 640, b, head, qt, smem); }
    __syncthreads();
  }
}
__global__ void ok_adapt_rows(const float* src, int sld, int scol, int ncols, float scale, bf16_t* dst, int dld, int nrows) {
  long i = (long)blockIdx.x * blockDim.x + threadIdx.x; if (i >= (long)nrows * ncols) return;
  int c = i % ncols; long r = i / ncols; dst[r * dld + c] = f2bf(src[r * sld + scol + c] * scale);
}
__global__ void ok_adapt_vT(const float* src, int sld, int scol, int hstride, int H, bf16_t* dst) {
  long i = (long)blockIdx.x * blockDim.x + threadIdx.x; if (i >= (long)H * 64 * RB) return;
  int lr = i % RB; int d = (i / RB) % 64; int h = i / ((long)RB * 64);
  dst[i] = f2bf(src[(long)lr * sld + scol + h * hstride + d]);
}

typedef __attribute__((ext_vector_type(2))) float f32x2;
#define SCAN_TS 16
#define SCAN_LDS_BYTES (2 * SCAN_TS * 1536 + 2 * SCAN_TS * 32 * 4)
template <int CTRL> __device__ __forceinline__ float dpp_get(float x) { return __builtin_bit_cast(float, __builtin_amdgcn_update_dpp(0, __builtin_bit_cast(int, x), CTRL, 0xf, 0xf, true)); }
__device__ __forceinline__ float swz_xor4(float x) { return __builtin_bit_cast(float, __builtin_amdgcn_ds_swizzle(__builtin_bit_cast(int, x), 0x101F)); }
__device__ __forceinline__ float reduce8(float x) {
  x += __builtin_bit_cast(float, __builtin_amdgcn_update_dpp(0, __builtin_bit_cast(int, x), 0xB1, 0xf, 0xf, true));
  x += __builtin_bit_cast(float, __builtin_amdgcn_update_dpp(0, __builtin_bit_cast(int, x), 0x4E, 0xf, 0xf, true));
  x += __builtin_bit_cast(float, __builtin_amdgcn_update_dpp(0, __builtin_bit_cast(int, x), 0x141, 0xf, 0xf, true));
  return x;
}
__device__ __forceinline__ int scan_row(int dir, int s) {
  if (s < CTX_LEN) return SEQ + (dir == 0 ? s : CTX_LEN - 1 - s);
  return dir == 0 ? s - CTX_LEN : SEQ - 1 - (s - CTX_LEN);
}
__device__ __forceinline__ void rw_scan_block(const bf16_t* __restrict__ r_, const bf16_t* __restrict__ v_, const bf16_t* __restrict__ kk_, const bf16_t* __restrict__ kd_,
                                              const bf16_t* __restrict__ bd_, const float* __restrict__ w_, float* __restrict__ y_, int item, long dstride, char* smem) {
  const int t = tid_opaque(), lane = t & 63, wave = t >> 6, cg = lane & 7, il = wave * 8 + (lane >> 3);
  const int half = item & 1, dir = (item >> 1) & 1, h = (item >> 2) % 6, b = item / 24;
  const long rowbase = (long)b * RB; const int col0 = h * 64;
  float* ybuf = (float*)(smem + 2 * SCAN_TS * 1536);
  const int st_ld = t >> 4, part = t & 15;
  u32x4 la, lb, lc, lw;
  auto issue = [&](int c) {
    long row = rowbase + scan_row(dir, c * SCAN_TS + st_ld); long o = row * 384 + col0;
    const int ch = (part & 7) * 8;
    la = *(const u32x4*)((part < 8 ? kk_ + o : bd_ + dir * dstride + o) + ch);
    lb = *(const u32x4*)((part < 8 ? kd_ + dir * dstride + o : r_ + o) + ch);
    lc = *(const u32x4*)(v_ + o + ch);
    lw = *(const u32x4*)(w_ + dir * dstride + o + part * 4);
  };
  auto stash = [&](int buf) {
    float* base = (float*)(smem + buf * SCAN_TS * 1536 + st_ld * 1536);
    const int ch = (part & 7) * 8;
    float* pa = base + (part < 8 ? 64 : 128) + ch; float* pb = base + (part < 8 ? 192 : 256) + ch;
    f32x4 x0, x1;
#pragma unroll
    for (int e = 0; e < 2; ++e) { x0[2*e] = __uint_as_float(la[e] << 16); x0[2*e+1] = __uint_as_float(la[e] & 0xffff0000u); x1[2*e] = __uint_as_float(la[2+e] << 16); x1[2*e+1] = __uint_as_float(la[2+e] & 0xffff0000u); }
    *(f32x4*)pa = x0; *(f32x4*)(pa + 4) = x1;
#pragma unroll
    for (int e = 0; e < 2; ++e) { x0[2*e] = __uint_as_float(lb[e] << 16); x0[2*e+1] = __uint_as_float(lb[e] & 0xffff0000u); x1[2*e] = __uint_as_float(lb[2+e] << 16); x1[2*e+1] = __uint_as_float(lb[2+e] & 0xffff0000u); }
    *(f32x4*)pb = x0; *(f32x4*)(pb + 4) = x1;
    if (part < 8) {
      float* pc = base + 320 + ch;
#pragma unroll
      for (int e = 0; e < 2; ++e) { x0[2*e] = __uint_as_float(lc[e] << 16); x0[2*e+1] = __uint_as_float(lc[e] & 0xffff0000u); x1[2*e] = __uint_as_float(lc[2+e] << 16); x1[2*e+1] = __uint_as_float(lc[2+e] & 0xffff0000u); }
      *(f32x4*)pc = x0; *(f32x4*)(pc + 4) = x1;
    }
    *(u32x4*)(base + part * 4) = lw;
  };
  f32x2 S[4];
#pragma unroll
  for (int j = 0; j < 4; ++j) S[j] = (f32x2){0.f, 0.f};
  const int NCH = RB / SCAN_TS;
  __builtin_amdgcn_s_setprio(3);
  issue(0);
  for (int c = 0; c < NCH; ++c) {
    const int buf = c & 1;
    stash(buf);
    __syncthreads();
    if (c > 0 && t < 128) {
      int st = t >> 3, i4 = (t & 7) * 4; long row = rowbase + scan_row(dir, (c - 1) * SCAN_TS + st);
      *(f32x4*)(y_ + dir * dstride + row * 384 + col0 + half * 32 + i4) = *(const f32x4*)(ybuf + (buf ^ 1) * SCAN_TS * 32 + st * 32 + i4);
    }
    if (c + 1 < NCH) issue(c + 1);
    const float* ob = (const float*)(smem + buf * SCAN_TS * 1536) + cg * 8;
    const float* vb_ = (const float*)(smem + buf * SCAN_TS * 1536) + 320 + half * 32 + il;
    float yk[SCAN_TS];
    f32x4 nw0 = *(const f32x4*)(ob), nw1 = *(const f32x4*)(ob + 4), nk0 = *(const f32x4*)(ob + 64), nk1 = *(const f32x4*)(ob + 68);
    f32x4 nb0 = *(const f32x4*)(ob + 128), nb1 = *(const f32x4*)(ob + 132), nd0 = *(const f32x4*)(ob + 192), nd1 = *(const f32x4*)(ob + 196);
    f32x4 nr0 = *(const f32x4*)(ob + 256), nr1 = *(const f32x4*)(ob + 260); float nvi = vb_[0];
#pragma unroll
    for (int st = 0; st < SCAN_TS; ++st) {
      const f32x4 w0 = nw0, w1 = nw1, k0 = nk0, k1 = nk1, b0 = nb0, b1 = nb1, d0 = nd0, d1 = nd1, r0 = nr0, r1 = nr1; const float vi = nvi;
      if (st + 1 < SCAN_TS) {
        const float* o = ob + (st + 1) * 384;
        nw0 = *(const f32x4*)(o); nw1 = *(const f32x4*)(o + 4); nk0 = *(const f32x4*)(o + 64); nk1 = *(const f32x4*)(o + 68);
        nb0 = *(const f32x4*)(o + 128); nb1 = *(const f32x4*)(o + 132); nd0 = *(const f32x4*)(o + 192); nd1 = *(const f32x4*)(o + 196);
        nr0 = *(const f32x4*)(o + 256); nr1 = *(const f32x4*)(o + 260); nvi = vb_[(st + 1) * 384];
      }
      __builtin_amdgcn_sched_barrier(0);
      f32x2 a2 = S[0] * (f32x2){k0[0], k0[1]}, c2 = S[2] * (f32x2){k1[0], k1[1]};
      a2 += S[1] * (f32x2){k0[2], k0[3]}; c2 += S[3] * (f32x2){k1[2], k1[3]};
      a2 += c2;
      const f32x2 vv = (f32x2){vi, vi};
      f32x2 t0 = vv * (f32x2){d0[0], d0[1]}, t1 = vv * (f32x2){d0[2], d0[3]}, t2 = vv * (f32x2){d1[0], d1[1]}, t3 = vv * (f32x2){d1[2], d1[3]};
      float skk = reduce8(a2[0] + a2[1]);
      const f32x2 ns = (f32x2){-skk, -skk};
      t0 += ns * (f32x2){b0[0], b0[1]}; t1 += ns * (f32x2){b0[2], b0[3]}; t2 += ns * (f32x2){b1[0], b1[1]}; t3 += ns * (f32x2){b1[2], b1[3]};
      S[0] = S[0] * (f32x2){w0[0], w0[1]} + t0; S[1] = S[1] * (f32x2){w0[2], w0[3]} + t1; S[2] = S[2] * (f32x2){w1[0], w1[1]} + t2; S[3] = S[3] * (f32x2){w1[2], w1[3]} + t3;
      f32x2 y2 = S[0] * (f32x2){r0[0], r0[1]}, z2 = S[2] * (f32x2){r1[0], r1[1]};
      y2 += S[1] * (f32x2){r0[2], r0[3]}; z2 += S[3] * (f32x2){r1[2], r1[3]};
      y2 += z2;
      yk[st] = y2[0] + y2[1];
      __builtin_amdgcn_sched_barrier(0);
    }
#pragma unroll
    for (int g = 0; g < 2; ++g) {
      float q4[4], q2[2], q1;
#pragma unroll
      for (int j = 0; j < 4; ++j) { bool hi = cg & 1; float keep = hi ? yk[g*8 + 2*j+1] : yk[g*8 + 2*j], send = hi ? yk[g*8 + 2*j] : yk[g*8 + 2*j+1]; q4[j] = keep + dpp_get<0xB1>(send); }
#pragma unroll
      for (int j = 0; j < 2; ++j) { bool hi = cg & 2; float keep = hi ? q4[2*j+1] : q4[2*j], send = hi ? q4[2*j] : q4[2*j+1]; q2[j] = keep + dpp_get<0x4E>(send); }
      { bool hi = cg & 4; float keep = hi ? q2[1] : q2[0], send = hi ? q2[0] : q2[1]; q1 = keep + swz_xor4(send); }
      ybuf[buf * SCAN_TS * 32 + (g * 8 + cg) * 32 + il] = q1;
    }
  }
  __builtin_amdgcn_s_setprio(0);
  __syncthreads();
  if (t < 128) {
    int st = t >> 3, i4 = (t & 7) * 4; long row = rowbase + scan_row(dir, (NCH - 1) * SCAN_TS + st);
    *(f32x4*)(y_ + dir * dstride + row * 384 + col0 + half * 32 + i4) = *(const f32x4*)(ybuf + ((NCH - 1) & 1) * SCAN_TS * 32 + st * 32 + i4);
  }
}
__global__ void __launch_bounds__(256) ok_rw_scan(const bf16_t* r_, const bf16_t* v_, const bf16_t* kk_, const bf16_t* kd_, const bf16_t* bd_, const float* w_, float* y_, int item0, int nitems, long dstride) {
  __shared__ __attribute__((aligned(16))) char smem[SCAN_LDS_BYTES];
  for (int it = item0 + blockIdx.x; it < item0 + nitems; it += gridDim.x) { rw_scan_block(r_, v_, kk_, kd_, bd_, w_, y_, it, dstride, smem); __syncthreads(); }
}
__global__ void ok_copy_rows_f32(const float* src, int sld, int scol, int ncols, float* dst, int dld, int nrows) {
  long i = (long)blockIdx.x * blockDim.x + threadIdx.x; if (i >= (long)nrows * ncols) return;
  int c = i % ncols; long r = i / ncols; dst[r * dld + c] = src[r * sld + scol + c];
}

__global__ void ok_cvt_wT_g(const float* W, const float* g, bf16_t* Wt, int K, int N, int Kpad) {
  long i = (long)blockIdx.x * blockDim.x + threadIdx.x;
  if (i >= (long)N * Kpad) return;
  int k = i % Kpad; int n = i / Kpad;
  Wt[i] = k < K ? f2bf(W[(long)k * N + n] * (g ? g[k] : 1.f)) : (bf16_t)0;
}
struct ALoadShift { const bf16_t* P; const float* mu; int col0; int mucol0; int act; int kvalid;
  __device__ __forceinline__ u32x4 operator()(int row, int k) const {
    u32x4 z = {0u, 0u, 0u, 0u};
    if (k >= kvalid) return z;
    int lr = row % RB; bool first = (lr == 0) || (lr == SEQ), last = (lr == SEQ - 1) || (lr == RB - 1);
    const bf16_t* p = P + (long)row * IN_COLS + col0 + k;
    u32x4 c = *(const u32x4*)p; u32x4 pv = first ? z : *(const u32x4*)(p - IN_COLS); u32x4 nx = last ? z : *(const u32x4*)(p + IN_COLS);
    const float* m0 = mu + mucol0 + k; const float* m1 = m0 + RWC;
    u32x4 o;
#pragma unroll
    for (int e = 0; e < 4; ++e) {
      float c0 = __uint_as_float(c[e] << 16), c1 = __uint_as_float(c[e] & 0xffff0000u);
      float p0 = __uint_as_float(pv[e] << 16), p1 = __uint_as_float(pv[e] & 0xffff0000u);
      float n0 = __uint_as_float(nx[e] << 16), n1 = __uint_as_float(nx[e] & 0xffff0000u);
      float x0 = c0 + m0[2*e] * (p0 - c0) + m1[2*e] * (n0 - c0), x1 = c1 + m0[2*e+1] * (p1 - c1) + m1[2*e+1] * (n1 - c1);
      if (act == 1) { x0 = ftanh_(x0); x1 = ftanh_(x1); } else if (act == 2) { x0 = fsigmoid_(x0); x1 = fsigmoid_(x1); }
      o[e] = pack2bf(x0, x1);
    }
    return o;
  } };
struct EpiDecay { float* w; const float* w0; int pad0; int pad1;
  __device__ __forceinline__ void operator()(int m, int n0, f32x4 v) const {
    f32x4 o;
#pragma unroll
    for (int e = 0; e < 4; ++e) o[e] = fdecay_(w0[n0 + e] + v[e]);
    *(f32x4*)(w + (long)m * 384 + n0) = o; } };
struct EpiSigA { bf16_t* a; const float* a0;
  __device__ __forceinline__ void operator()(int m, int n0, f32x4 v) const {
    uint2 pk; pk.x = pack2bf(fsigmoid_(a0[n0] + v[0]), fsigmoid_(a0[n0+1] + v[1])); pk.y = pack2bf(fsigmoid_(a0[n0+2] + v[2]), fsigmoid_(a0[n0+3] + v[3]));
    *(uint2*)(a + (long)m * 384 + n0) = pk; } };

struct PrepW { const bf16_t *wqbT, *wkvbT, *w2T, *a2T, *g2T; const float *mu, *w0, *a0; };
struct PrepBuf { const bf16_t* P; bf16_t *tq, *tkv, *a_b, *g_b; float* w_f; };
__device__ __forceinline__ void prep_gemm_tile(const PrepW& W, const PrepBuf& B, int tm, int ct, char* smem) {
  const long MA = NROWS;
  if (ct < 3) gemm_tile_128(ALoadPlain{B.P, IN_COLS}, W.wqbT, 256, 256, tm, ct, smem, EpiStoreBf16{B.tq, 384, 384});
  else if (ct < 7) gemm_tile_128(ALoadPlain{B.P + 256, IN_COLS}, W.wkvbT, 128, 128, tm, ct - 3, smem, EpiStoreBf16{B.tkv, 512, 512});
  else if (ct < 13) { int d = (ct - 7) / 3, tn = (ct - 7) % 3;
    gemm_tile_128(ALoadShift{B.P, W.mu, RW_OFF + 1152 + d * 64, 1152 + d * 64, 1, 64}, W.w2T + d * 384 * 64, 64, 64, tm, tn, smem, EpiDecay{B.w_f + d * MA * 384, W.w0 + d * 384, 0, 0}); }
  else if (ct < 19) { int d = (ct - 13) / 3, tn = (ct - 13) % 3;
    gemm_tile_128(ALoadShift{B.P, W.mu, RW_OFF + 1280 + d * 64, 1280 + d * 64, 0, 64}, W.a2T + d * 384 * 64, 64, 64, tm, tn, smem, EpiSigA{B.a_b + d * MA * 384, W.a0 + d * 384}); }
  else gemm_tile_128(ALoadShift{B.P, W.mu, RW_OFF + 1408, 1408, 2, 160}, W.g2T, 192, 192, tm, ct - 19, smem, EpiStoreBf16{B.g_b, 384, 384});
}
__global__ void __launch_bounds__(256) ok_prep_gemm(PrepW W, PrepBuf B) {
  __shared__ __attribute__((aligned(16))) char smem[GEMM_LDS_BYTES];
  for (int tile = blockIdx.x; tile < (NROWS / 128) * 22; tile += gridDim.x) prep_gemm_tile(W, B, tile / 22, tile % 22, smem);
}

__device__ __forceinline__ float wave_sum(float x) {
#pragma unroll
  for (int o = 32; o > 0; o >>= 1) x += __shfl_xor(x, o);
  return x;
}
__device__ __forceinline__ float ldbf(const bf16_t* p) { return bf2f(*p); }
struct FinW { const float *mla_qk_g, *gqa_qk_g, *mu, *k_k, *k_a; };
struct FinBuf { const bf16_t *P, *tq, *tkv, *a_b; bf16_t *mq, *mk, *mvT, *gq, *gk, *gvT, *r_b, *v_b, *kk_b, *kd_b, *bd_b; };
#define FIN_LDS_BYTES (384 * 132)
__device__ __forceinline__ void prep_finish_tile(const FinW& W, const FinBuf& B, int tile, char* smem) {
  const int t = tid_opaque(), lane = t & 63, wave = t >> 6; const long MA = NROWS;
  bf16_t* vbuf = (bf16_t*)smem;
  const long row0 = (long)tile * 64; const int b = row0 / RB; const int lr0 = row0 % RB;
  for (int it = 0; it < 16; ++it) {
    const int rl = it * 4 + wave; const long row = row0 + rl; const int lr = lr0 + rl; const bool lat = lr < SEQ;
    const bf16_t* Pr = B.P + row * IN_COLS;
    float sq = 0.f;
#pragma unroll
    for (int i = 0; i < 4; ++i) { float x = ldbf(Pr + i * 64 + lane); sq += x * x; }
    float skv = 0.f;
#pragma unroll
    for (int i = 0; i < 2; ++i) { float x = ldbf(Pr + 256 + i * 64 + lane); skv += x * x; }
    const float cq = __builtin_amdgcn_rsqf(wave_sum(sq) / 256.f + EPSN), ckv = __builtin_amdgcn_rsqf(wave_sum(skv) / 128.f + EPSN);
    const float krope = lane < 32 ? ldbf(Pr + 384 + lane) : 0.f;
    float cs_m = 1.f, sn_m = 0.f;
    { int j = lane & 15; int pos = j < 8 ? lr / 64 : lr % 64; float ang = (float)pos * powf(10000.f, -(float)(j & 7) / 8.f); if (lat) { cs_m = cosf(ang); sn_m = sinf(ang); } }
    const float* gq_ = W.mla_qk_g; const float* gk_ = W.mla_qk_g + 96;
#pragma unroll
    for (int h = 0; h < 4; ++h) {
      float qa = cq * ldbf(B.tq + row * 384 + h * 96 + lane); float qb = lane < 32 ? cq * ldbf(B.tq + row * 384 + h * 96 + 64 + lane) : 0.f;
      float inv = __builtin_amdgcn_rsqf(wave_sum(qa * qa + qb * qb) / 96.f + EPSN);
      qa *= inv * gq_[lane]; qb *= inv * (lane < 32 ? gq_[64 + lane] : 0.f);
      { float other = __shfl_xor(qb, 16); float rr = (lane & 16) ? (other * sn_m + qb * cs_m) : (qb * cs_m - other * sn_m); qb = rr; }
      const float qs = 0.14724445f;
      B.mq[row * 384 + h * 96 + lane] = f2bf(qa * qs); if (lane < 32) B.mq[row * 384 + h * 96 + 64 + lane] = f2bf(qb * qs);
      float ka = ckv * ldbf(B.tkv + row * 512 + h * 128 + lane); float kb = krope;
      float invk = __builtin_amdgcn_rsqf(wave_sum(ka * ka + kb * kb) / 96.f + EPSN);
      ka *= invk * gk_[lane]; kb *= invk * (lane < 32 ? gk_[64 + lane] : 0.f);
      { float other = __shfl_xor(kb, 16); float rr = (lane & 16) ? (other * sn_m + kb * cs_m) : (kb * cs_m - other * sn_m); kb = rr; }
      B.mk[row * 384 + h * 96 + lane] = f2bf(ka); if (lane < 32) B.mk[row * 384 + h * 96 + 64 + lane] = f2bf(kb);
      vbuf[(h * 64 + lane) * 66 + rl] = f2bf(ckv * ldbf(B.tkv + row * 512 + h * 128 + 64 + lane));
    }
    float cs_g = 1.f, sn_g = 0.f;
    { int j = lane & 31; int pos = j < 16 ? lr / 64 : lr % 64; float ang = (float)pos * powf(10000.f, -(float)(j & 15) / 16.f); if (lat) { cs_g = cosf(ang); sn_g = sinf(ang); } }
#pragma unroll
    for (int h = 0; h < 8; ++h) {
      float x = ldbf(Pr + GQA_OFF + h * 64 + lane);
      float inv = __builtin_amdgcn_rsqf(wave_sum(x * x) / 64.f + EPSN);
      x *= inv * W.gqa_qk_g[(h < 6 ? 0 : 64) + lane];
      float other = __shfl_xor(x, 32); float rr = (lane & 32) ? (other * sn_g + x * cs_g) : (x * cs_g - other * sn_g);
      if (h < 6) B.gq[row * 384 + h * 64 + lane] = f2bf(rr * 0.18033688f); else B.gk[row * 128 + (h - 6) * 64 + lane] = f2bf(rr);
    }
#pragma unroll
    for (int hk = 0; hk < 2; ++hk) vbuf[((4 + hk) * 64 + lane) * 66 + rl] = Pr[GQA_OFF + 512 + hk * 64 + lane];
    const bool first = (lr == 0) || (lr == SEQ), last = (lr == SEQ - 1) || (lr == RB - 1);
#pragma unroll
    for (int h = 0; h < 6; ++h) {
      float xs3[3];
#pragma unroll
      for (int part = 0; part < 3; ++part) {
        int c = part * 384 + h * 64 + lane; const bf16_t* pp = Pr + RW_OFF + c;
        float p = ldbf(pp), pv = first ? 0.f : ldbf(pp - IN_COLS), nx = last ? 0.f : ldbf(pp + IN_COLS);
        xs3[part] = p + W.mu[c] * (pv - p) + W.mu[RWC + c] * (nx - p);
      }
      const int c = h * 64 + lane; const long o = row * 384 + c;
      float kv = xs3[1]; float tk = kv * W.k_k[c]; float kkv = tk * __builtin_amdgcn_rsqf(wave_sum(tk * tk) + 1e-12f);
      B.r_b[o] = f2bf(xs3[0]); B.v_b[o] = f2bf(xs3[2]); B.kk_b[o] = f2bf(kkv);
#pragma unroll
      for (int d = 0; d < 2; ++d) { float a = ldbf(B.a_b + d * MA * 384 + o); B.kd_b[d * MA * 384 + o] = f2bf(kv * (1.f + (a - 1.f) * W.k_a[c])); B.bd_b[d * MA * 384 + o] = f2bf(kkv * a); }
    }
  }
  __syncthreads();
  for (int i = t; i < 384 * 32; i += 256) {
    int rr = i >> 5, w2 = i & 31; int slot = rr >> 6, d = rr & 63;
    unsigned val = *(const unsigned*)(vbuf + rr * 66 + w2 * 2);
    bf16_t* dst = slot < 4 ? B.mvT + ((long)(b * 4 + slot) * 64 + d) * RB : B.gvT + ((long)(b * 2 + (slot - 4)) * 64 + d) * RB;
    *(unsigned*)(dst + lr0 + w2 * 2) = val;
  }
  __syncthreads();
}
__global__ void __launch_bounds__(256) ok_prep_finish(FinW W, FinBuf B) {
  __shared__ __attribute__((aligned(16))) char smem[FIN_LDS_BYTES];
  for (int tile = blockIdx.x; tile < NROWS / 64; tile += gridDim.x) prep_finish_tile(W, B, tile, smem);
}
struct RdW { const float *r_k, *ln_g, *ln_b; };
__device__ __forceinline__ void rw_readout_row(const RdW& W, const float* __restrict__ y, const bf16_t* __restrict__ r_b, const bf16_t* __restrict__ v_b, const bf16_t* __restrict__ kd_b,
                                               const bf16_t* __restrict__ g_b, bf16_t* __restrict__ mixall, long row, int lane) {
  const long MA = NROWS;
#pragma unroll
  for (int h = 0; h < 6; ++h) {
    const int c = h * 64 + lane; const long o = row * 384 + c;
    float yy = y[o] + y[MA * 384 + o];
    float mean = wave_sum(yy) * (1.f / 64.f); float dv = yy - mean; float var = wave_sum(dv * dv) * (1.f / 64.f);
    float coef = wave_sum(ldbf(r_b + o) * (ldbf(kd_b + o) + ldbf(kd_b + MA * 384 + o)) * W.r_k[c]);
    float yn = dv * __builtin_amdgcn_rsqf(var + 64e-5f) * W.ln_g[c] + W.ln_b[c];
    mixall[row * DM + 256 + c] = f2bf((yn + coef * ldbf(v_b + o)) * ldbf(g_b + o));
  }
}
__global__ void __launch_bounds__(256) ok_rw_readout(RdW W, const float* y, const bf16_t* r_b, const bf16_t* v_b, const bf16_t* kd_b, const bf16_t* g_b, bf16_t* mixall) {
  for (long row = blockIdx.x * 4 + (threadIdx.x >> 6); row < NROWS; row += gridDim.x * 4) rw_readout_row(W, y, r_b, v_b, kd_b, g_b, mixall, row, threadIdx.x & 63);
}

__device__ __forceinline__ void ph_cvt_fp8_rows(const float* __restrict__ tab, unsigned char* __restrict__ q, float* __restrict__ scale, int r0 = -1, int r1 = 0) {
  const int t = tid_opaque(); const int lane = t & 63;
  const int rbeg = r0 < 0 ? (int)blockIdx.x * 4 + (t >> 6) : r0 + (t >> 6), rend = r0 < 0 ? 16384 : r1, rstep = r0 < 0 ? (int)gridDim.x * 4 : 4;
  for (int row = rbeg; row < rend; row += rstep) {
    const float* src = tab + (long)row * DM + lane * 16;
    f32x4 a[4]; float m = 0.f;
#pragma unroll
    for (int i = 0; i < 4; ++i) { a[i] = *(const f32x4*)(src + 4 * i); m = fmaxf(m, fmaxf(fmaxf(fabsf(a[i][0]), fabsf(a[i][1])), fmaxf(fabsf(a[i][2]), fabsf(a[i][3])))); }
#pragma unroll
    for (int o = 32; o > 0; o >>= 1) m = fmaxf(m, __shfl_xor(m, o));
    const float sc = m > 0.f ? m * (1.f / 440.f) : 1.f; const float inv = 1.f / sc;
    u32x4 p;
#pragma unroll
    for (int i = 0; i < 4; ++i) { int w = __builtin_amdgcn_cvt_pk_fp8_f32(a[i][0] * inv, a[i][1] * inv, 0, false); w = __builtin_amdgcn_cvt_pk_fp8_f32(a[i][2] * inv, a[i][3] * inv, w, true); p[i] = (unsigned)w; }
    *(u32x4*)(q + (long)row * DM + lane * 16) = p;
    if (lane == 0) scale[row] = sc;
  }
}
__device__ __forceinline__ float dot16_fp8(const float (&h)[16], u32x4 q) {
  float a = 0.f;
#pragma unroll
  for (int d = 0; d < 4; ++d) {
    f32v2 lo = __builtin_amdgcn_cvt_pk_f32_fp8((int)q[d], false), hi = __builtin_amdgcn_cvt_pk_f32_fp8((int)q[d], true);
    a += h[4*d] * lo[0]; a += h[4*d+1] * lo[1]; a += h[4*d+2] * hi[0]; a += h[4*d+3] * hi[1];
  }
  return a;
}
__device__ __forceinline__ void axpy16_fp8(float (&o)[16], float w, u32x4 q) {
#pragma unroll
  for (int d = 0; d < 4; ++d) {
    f32v2 lo = __builtin_amdgcn_cvt_pk_f32_fp8((int)q[d], false), hi = __builtin_amdgcn_cvt_pk_f32_fp8((int)q[d], true);
    o[4*d] += w * lo[0]; o[4*d+1] += w * lo[1]; o[4*d+2] += w * hi[0]; o[4*d+3] += w * hi[1];
  }
}
__device__ __forceinline__ void peer_gather_group_fp8(const bf16_t* __restrict__ xn, const unsigned* __restrict__ top1, const unsigned char* __restrict__ ub, const float* __restrict__ su,
                                                      const unsigned char* __restrict__ vb, const float* __restrict__ sv, const float* __restrict__ modl, float* __restrict__ xs, int grp, char* smem) {
  const int t = tid_opaque(), lane = t & 63, wave = t >> 6;
  int* pe_l = (int*)smem; float* pg_l = (float*)(smem + 32 * 128 * 4); float* pw_l = (float*)(smem + 2 * 32 * 128 * 4);
  {
    int tl = t >> 3, p = t & 7; long row = (long)grp * 32 + tl;
    peer_combine(top1 + (row * 16 + p * 2) * 16, top1 + (row * 16 + p * 2 + 1) * 16, pe_l + tl * 128 + p * 16, pg_l + tl * 128 + p * 16);
  }
  __syncthreads();
  for (int ti = 0; ti < 8; ++ti) {
    const int tl = wave * 8 + ti; const long row = (long)grp * 32 + tl;
    const int* pe = pe_l + tl * 128; float* pw = pw_l + tl * 128;
    float h[16];
    { u32x4 h0 = *(const u32x4*)(xn + row * DM + lane * 16), h1 = *(const u32x4*)(xn + row * DM + lane * 16 + 8);
#pragma unroll
      for (int e = 0; e < 4; ++e) { h[2*e] = __uint_as_float(h0[e] << 16); h[2*e+1] = __uint_as_float(h0[e] & 0xffff0000u); h[8+2*e] = __uint_as_float(h1[e] << 16); h[8+2*e+1] = __uint_as_float(h1[e] & 0xffff0000u); } }
    u32x4 u[8];
#pragma unroll
    for (int j = 0; j < 8; ++j) u[j] = *(const u32x4*)(ub + (long)pe[j] * DM + lane * 16);
    for (int b = 0; b < 16; ++b) {
      float pd[8];
#pragma unroll
      for (int j = 0; j < 8; ++j) pd[j] = dot16_fp8(h, u[j]);
      if (b + 1 < 16) {
#pragma unroll
        for (int j = 0; j < 8; ++j) u[j] = *(const u32x4*)(ub + (long)pe[(b + 1) * 8 + j] * DM + lane * 16);
      }
      float q4[4], q2[2], q1;
#pragma unroll
      for (int j = 0; j < 4; ++j) { bool hi = lane & 1; float keep = hi ? pd[2*j+1] : pd[2*j], send = hi ? pd[2*j] : pd[2*j+1]; q4[j] = keep + __shfl_xor(send, 1); }
#pragma unroll
      for (int j = 0; j < 2; ++j) { bool hi = lane & 2; float keep = hi ? q4[2*j+1] : q4[2*j], send = hi ? q4[2*j] : q4[2*j+1]; q2[j] = keep + __shfl_xor(send, 2); }
      { bool hi = lane & 4; float keep = hi ? q2[1] : q2[0], send = hi ? q2[0] : q2[1]; q1 = keep + __shfl_xor(send, 4); }
      q1 += __shfl_xor(q1, 8); q1 += __shfl_xor(q1, 16); q1 += __shfl_xor(q1, 32);
      if (lane < 8) pw[b * 8 + lane] = q1 * su[pe[b * 8 + lane]];
    }
    u32x4 v[8];
#pragma unroll
    for (int j = 0; j < 8; ++j) v[j] = *(const u32x4*)(vb + (long)pe[j] * DM + lane * 16);
    {
      float d0 = pw[lane], d1 = pw[64 + lane];
      pw[lane] = pg_l[tl * 128 + lane] * fgelu_(d0) * sv[pe[lane]]; pw[64 + lane] = pg_l[tl * 128 + 64 + lane] * fgelu_(d1) * sv[pe[64 + lane]];
    }
    float o[16];
#pragma unroll
    for (int e = 0; e < 16; ++e) o[e] = 0.f;
    for (int b = 0; b < 16; ++b) {
      u32x4 vc[8];
#pragma unroll
      for (int j = 0; j < 8; ++j) vc[j] = v[j];
      if (b + 1 < 16) {
#pragma unroll
        for (int j = 0; j < 8; ++j) v[j] = *(const u32x4*)(vb + (long)pe[(b + 1) * 8 + j] * DM + lane * 16);
      }
#pragma unroll
      for (int j = 0; j < 8; ++j) axpy16_fp8(o, pw[b * 8 + j], vc[j]);
    }
    {
      int b = row / RB, lr = row % RB; int bb = lr < SEQ ? b : BATCH; const float* g5 = modl + ((long)bb * 6 + 5) * DM + lane * 16;
      float* xr = xs + row * DM + lane * 16;
#pragma unroll
      for (int i = 0; i < 4; ++i) {
        f32x4 x = *(f32x4*)(xr + 4 * i); f32x4 g = *(const f32x4*)(g5 + 4 * i);
        x[0] += g[0] * o[4*i]; x[1] += g[1] * o[4*i+1]; x[2] += g[2] * o[4*i+2]; x[3] += g[3] * o[4*i+3];
        *(f32x4*)(xr + 4 * i) = x;
      }
    }
  }
}

__device__ __forceinline__ float reduce16(float x) { x = reduce8(x); x += dpp_get<0x140>(x); return x; }
__device__ __forceinline__ void unpack8(u32x4 v, float (&f)[8]) {
#pragma unroll
  for (int e = 0; e < 4; ++e) { f[2*e] = __uint_as_float(v[e] << 16); f[2*e+1] = __uint_as_float(v[e] & 0xffff0000u); }
}
__device__ __forceinline__ u32x4 pack8(const float (&f)[8]) { u32x4 o;
#pragma unroll
  for (int e = 0; e < 4; ++e) o[e] = pack2bf(f[2*e], f[2*e+1]);
  return o; }
__device__ __forceinline__ void ph_rope_tables(float* rope_g, float* rope_m) {
  const int t = tid_opaque();
  for (int i = blockIdx.x * 256 + t; i < SEQ * 48; i += gridDim.x * 256) {
    int lr = i / 48, j = i % 48;
    if (j < 32) { int pos = j < 16 ? lr / 64 : lr % 64; float ang = (float)pos * powf(10000.f, -(float)(j & 15) / 16.f); rope_g[(lr * 32 + j) * 2] = cosf(ang); rope_g[(lr * 32 + j) * 2 + 1] = sinf(ang); }
    else { int jj = j - 32; int pos = jj < 8 ? lr / 64 : lr % 64; float ang = (float)pos * powf(10000.f, -(float)(jj & 7) / 8.f); rope_m[(lr * 16 + jj) * 2] = cosf(ang); rope_m[(lr * 16 + jj) * 2 + 1] = sinf(ang); }
  }
}
struct FinW2 { const float *mla_qk_g, *gqa_qk_g, *mu, *k_k, *k_a, *rope_g, *rope_m; };
#define FIN2_LDS_BYTES (64 * 384 * 2)
__device__ __forceinline__ void prep_finish_tile2(const FinW2& W, const FinBuf& B, int tile, char* smem) {
  const int t = tid_opaque(), lane = t & 63, wave = t >> 6; const long MA = NROWS;
  bf16_t* vbuf = (bf16_t*)smem;
  const long row0 = (long)tile * 32; const int b = row0 / RB; const int lr0 = row0 % RB;
  const int g8 = lane & 7, h8 = lane >> 3, s16 = lane & 15, h16 = lane >> 4;
  for (int it = 0; it < 8; ++it) {
    const int rl = it * 4 + wave; const long row = row0 + rl; const int lr = lr0 + rl; const bool lat = lr < SEQ;
    const bf16_t* Pr = B.P + row * IN_COLS;
    {
      float x[8]; unpack8(*(const u32x4*)(Pr + GQA_OFF + lane * 8), x);
      float ss = 0.f;
#pragma unroll
      for (int e = 0; e < 8; ++e) ss += x[e] * x[e];
      ss = reduce8(ss); const float inv = __builtin_amdgcn_rsqf(ss * (1.f / 64.f) + EPSN);
      const float* gp = W.gqa_qk_g + (h8 < 6 ? 0 : 64) + g8 * 8; f32x4 ga = *(const f32x4*)gp, gb = *(const f32x4*)(gp + 4);
#pragma unroll
      for (int e = 0; e < 4; ++e) { x[e] *= inv * ga[e]; x[4 + e] *= inv * gb[e]; }
      float o[8];
      if (lat) {
        const float* rt = W.rope_g + ((long)lr * 32 + (g8 & 3) * 8) * 2;
#pragma unroll
        for (int e = 0; e < 8; ++e) { float ot = swz_xor4(x[e]); float cs = rt[2 * e], sn = rt[2 * e + 1]; o[e] = (g8 & 4) ? (ot * sn + x[e] * cs) : (x[e] * cs - ot * sn); }
      } else {
#pragma unroll
        for (int e = 0; e < 8; ++e) o[e] = x[e];
      }
      if (h8 < 6) {
#pragma unroll
        for (int e = 0; e < 8; ++e) o[e] *= 0.18033688f;
        *(u32x4*)(B.gq + row * 384 + lane * 8) = pack8(o);
      } else *(u32x4*)(B.gk + row * 128 + (lane - 48) * 8) = pack8(o);
    }
    float cq, ckv;
    {
      float ss = 0.f;
      if (lane < 48) { float x[8]; unpack8(*(const u32x4*)(Pr + lane * 8), x);
#pragma unroll
        for (int e = 0; e < 8; ++e) ss += x[e] * x[e]; }
      float sq = wave_sum(lane < 32 ? ss : 0.f), skv = wave_sum(lane >= 32 ? ss : 0.f);
      cq = __builtin_amdgcn_rsqf(sq * (1.f / 256.f) + EPSN); ckv = __builtin_amdgcn_rsqf(skv * (1.f / 128.f) + EPSN);
    }
    {
      float cs0 = 1.f, sn0 = 0.f, cs1 = 1.f, sn1 = 0.f;
      if (lat) { f32x4 r4 = *(const f32x4*)(W.rope_m + ((long)lr * 16 + (s16 & 7) * 2) * 2); cs0 = r4[0]; sn0 = r4[1]; cs1 = r4[2]; sn1 = r4[3]; }
      const float kr0 = bf2f(Pr[384 + s16 * 2]), kr1 = bf2f(Pr[384 + s16 * 2 + 1]);
#pragma unroll
      for (int which = 0; which < 2; ++which) {
        float n[4], r0, r1;
        if (which == 0) {
          uint2 a = *(const uint2*)(B.tq + row * 384 + h16 * 96 + s16 * 4); unsigned rr = *(const unsigned*)(B.tq + row * 384 + h16 * 96 + 64 + s16 * 2);
          n[0] = cq * __uint_as_float(a.x << 16); n[1] = cq * __uint_as_float(a.x & 0xffff0000u); n[2] = cq * __uint_as_float(a.y << 16); n[3] = cq * __uint_as_float(a.y & 0xffff0000u);
          r0 = cq * __uint_as_float(rr << 16); r1 = cq * __uint_as_float(rr & 0xffff0000u);
        } else {
          uint2 a = *(const uint2*)(B.tkv + row * 512 + h16 * 128 + s16 * 4);
          n[0] = ckv * __uint_as_float(a.x << 16); n[1] = ckv * __uint_as_float(a.x & 0xffff0000u); n[2] = ckv * __uint_as_float(a.y << 16); n[3] = ckv * __uint_as_float(a.y & 0xffff0000u);
          r0 = kr0; r1 = kr1;
        }
        float ss = n[0]*n[0] + n[1]*n[1] + n[2]*n[2] + n[3]*n[3] + r0*r0 + r1*r1;
        ss = reduce16(ss); const float inv = __builtin_amdgcn_rsqf(ss * (1.f / 96.f) + EPSN);
        const float* gp = W.mla_qk_g + which * 96; f32x4 gn = *(const f32x4*)(gp + s16 * 4); const float g0 = gp[64 + s16 * 2], g1 = gp[64 + s16 * 2 + 1];
#pragma unroll
        for (int e = 0; e < 4; ++e) n[e] *= inv * gn[e];
        r0 *= inv * g0; r1 *= inv * g1;
        float o0 = dpp_get<0x128>(r0), o1 = dpp_get<0x128>(r1);
        float q0, q1;
        if (s16 & 8) { q0 = o0 * sn0 + r0 * cs0; q1 = o1 * sn1 + r1 * cs1; } else { q0 = r0 * cs0 - o0 * sn0; q1 = r1 * cs1 - o1 * sn1; }
        const float sc = which == 0 ? 0.14724445f : 1.f;
        bf16_t* dst = (which == 0 ? B.mq : B.mk) + row * 384 + h16 * 96;
        uint2 pk; pk.x = pack2bf(n[0] * sc, n[1] * sc); pk.y = pack2bf(n[2] * sc, n[3] * sc);
        *(uint2*)(dst + s16 * 4) = pk; *(unsigned*)(dst + 64 + s16 * 2) = pack2bf(q0 * sc, q1 * sc);
      }
      if (lane < 32) { float x[8]; unpack8(*(const u32x4*)(B.tkv + row * 512 + h8 * 128 + 64 + g8 * 8), x);
#pragma unroll
        for (int e = 0; e < 8; ++e) x[e] *= ckv;
        *(u32x4*)(vbuf + rl * 384 + h8 * 64 + g8 * 8) = pack8(x); }
      else if (lane < 48) *(u32x4*)(vbuf + rl * 384 + 256 + (lane - 32) * 8) = *(const u32x4*)(Pr + GQA_OFF + 512 + (lane - 32) * 8);
    }
    if (lane < 48) {
      const bool first = (lr == 0) || (lr == SEQ), last = (lr == SEQ - 1) || (lr == RB - 1);
      const long o = row * 384 + lane * 8;
      float xs3[3][8];
#pragma unroll
      for (int part = 0; part < 3; ++part) {
        const int c = part * 384 + lane * 8; const bf16_t* pp = Pr + RW_OFF + c;
        float p[8], pv[8], nx[8]; unpack8(*(const u32x4*)pp, p);
        u32x4 z = {0u, 0u, 0u, 0u}; unpack8(first ? z : *(const u32x4*)(pp - IN_COLS), pv); unpack8(last ? z : *(const u32x4*)(pp + IN_COLS), nx);
        f32x4 m0a = *(const f32x4*)(W.mu + c), m0b = *(const f32x4*)(W.mu + c + 4), m1a = *(const f32x4*)(W.mu + RWC + c), m1b = *(const f32x4*)(W.mu + RWC + c + 4);
#pragma unroll
        for (int e = 0; e < 4; ++e) { xs3[part][e] = p[e] + m0a[e] * (pv[e] - p[e]) + m1a[e] * (nx[e] - p[e]); xs3[part][4+e] = p[4+e] + m0b[e] * (pv[4+e] - p[4+e]) + m1b[e] * (nx[4+e] - p[4+e]); }
      }
      *(u32x4*)(B.r_b + o) = pack8(xs3[0]); *(u32x4*)(B.v_b + o) = pack8(xs3[2]);
      f32x4 kka = *(const f32x4*)(W.k_k + lane * 8), kkb = *(const f32x4*)(W.k_k + lane * 8 + 4), kaa = *(const f32x4*)(W.k_a + lane * 8), kab = *(const f32x4*)(W.k_a + lane * 8 + 4);
      float tk[8], ss = 0.f;
#pragma unroll
      for (int e = 0; e < 4; ++e) { tk[e] = xs3[1][e] * kka[e]; tk[4+e] = xs3[1][4+e] * kkb[e]; }
#pragma unroll
      for (int e = 0; e < 8; ++e) ss += tk[e] * tk[e];
      ss = reduce8(ss); const float invk = __builtin_amdgcn_rsqf(ss + 1e-12f);
#pragma unroll
      for (int e = 0; e < 8; ++e) tk[e] *= invk;
      *(u32x4*)(B.kk_b + o) = pack8(tk);
#pragma unroll
      for (int d = 0; d < 2; ++d) {
        float a[8], kd[8], bd[8]; unpack8(*(const u32x4*)(B.a_b + d * MA * 384 + o), a);
#pragma unroll
        for (int e = 0; e < 8; ++e) { float ka = e < 4 ? kaa[e] : kab[e - 4]; kd[e] = xs3[1][e] * (1.f + (a[e] - 1.f) * ka); bd[e] = tk[e] * a[e]; }
        *(u32x4*)(B.kd_b + d * MA * 384 + o) = pack8(kd); *(u32x4*)(B.bd_b + d * MA * 384 + o) = pack8(bd);
      }
    } else { (void)reduce8(0.f); }
  }
  __syncthreads();
  for (int i = t; i < 384 * 4; i += 256) {
    int c = i % 384, rc = i / 384;
    unsigned short v8[8];
#pragma unroll
    for (int e = 0; e < 8; ++e) v8[e] = vbuf[(rc * 8 + e) * 384 + c];
    u32x4 o; o[0] = v8[0] | ((unsigned)v8[1] << 16); o[1] = v8[2] | ((unsigned)v8[3] << 16); o[2] = v8[4] | ((unsigned)v8[5] << 16); o[3] = v8[6] | ((unsigned)v8[7] << 16);
    bf16_t* dst = c < 256 ? B.mvT + ((long)(b * 4 + (c >> 6)) * 64 + (c & 63)) * RB : B.gvT + ((long)(b * 2 + ((c - 256) >> 6)) * 64 + (c & 63)) * RB;
    *(u32x4*)(dst + lr0 + rc * 8) = o;
  }
  __syncthreads();
}
__device__ __forceinline__ void rw_readout_row2(const RdW& W, const float* __restrict__ y, const bf16_t* __restrict__ r_b, const bf16_t* __restrict__ v_b, const bf16_t* __restrict__ kd_b,
                                                const bf16_t* __restrict__ g_b, bf16_t* __restrict__ mixall, long row, int lane) {
  const long MA = NROWS;
  float yy[8], s = 0.f; float r[8], k0[8], k1[8], vv[8], gg[8];
  const int c = lane * 8; const long o = row * 384 + c;
  if (lane < 48) {
    f32x4 a0 = *(const f32x4*)(y + o), a1 = *(const f32x4*)(y + o + 4), b0 = *(const f32x4*)(y + MA * 384 + o), b1 = *(const f32x4*)(y + MA * 384 + o + 4);
#pragma unroll
    for (int e = 0; e < 4; ++e) { yy[e] = a0[e] + b0[e]; yy[4+e] = a1[e] + b1[e]; }
    unpack8(*(const u32x4*)(r_b + o), r); unpack8(*(const u32x4*)(kd_b + o), k0); unpack8(*(const u32x4*)(kd_b + MA * 384 + o), k1);
    unpack8(*(const u32x4*)(v_b + o), vv); unpack8(*(const u32x4*)(g_b + o), gg);
  } else {
#pragma unroll
    for (int e = 0; e < 8; ++e) { yy[e] = 0.f; r[e] = 0.f; k0[e] = 0.f; k1[e] = 0.f; vv[e] = 0.f; gg[e] = 0.f; }
  }
#pragma unroll
  for (int e = 0; e < 8; ++e) s += yy[e];
  const float mean = reduce8(s) * (1.f / 64.f);
  float vs = 0.f, cf = 0.f;
  const int cc = lane < 48 ? c : 0;
  f32x4 rk0 = *(const f32x4*)(W.r_k + cc), rk1 = *(const f32x4*)(W.r_k + cc + 4);
#pragma unroll
  for (int e = 0; e < 8; ++e) { float d = yy[e] - mean; vs += d * d; cf += r[e] * (k0[e] + k1[e]) * (e < 4 ? rk0[e] : rk1[e - 4]); }
  const float var = reduce8(vs) * (1.f / 64.f), coef = reduce8(cf);
  const float inv = __builtin_amdgcn_rsqf(var + 64e-5f);
  if (lane < 48) {
    f32x4 lg0 = *(const f32x4*)(W.ln_g + c), lg1 = *(const f32x4*)(W.ln_g + c + 4), lb0 = *(const f32x4*)(W.ln_b + c), lb1 = *(const f32x4*)(W.ln_b + c + 4);
    float out[8];
#pragma unroll
    for (int e = 0; e < 8; ++e) { float yn = (yy[e] - mean) * inv * (e < 4 ? lg0[e] : lg1[e - 4]) + (e < 4 ? lb0[e] : lb1[e - 4]); out[e] = (yn + coef * vv[e]) * gg[e]; }
    *(u32x4*)(mixall + row * DM + 256 + c) = pack8(out);
  }
}

#define PG_NT 4
#define PG_TOK (4 * PG_NT)
#define PG_OFF_H 0
#define PG_OFF_E (PG_TOK * 2048)
#define PG_OFF_G (PG_OFF_E + PG_TOK * 128 * 2)
#define PG_OFF_ST (PG_OFF_G + PG_TOK * 128 * 4)
#define PG_OFF_CNT (PG_OFF_ST + PG_TOK * 18 * 2)
#define PG_LDS_BYTES (PG_OFF_CNT + PG_TOK * 8 * 16 * 2)
__device__ __forceinline__ long pg_row(int g, int ntok) { return ntok == NROWS ? (long)g : (long)(g / SEQ) * RB + (g % SEQ); }
__device__ __forceinline__ void peer_gather_sliced(const bf16_t* __restrict__ xn, const unsigned* __restrict__ top1, const unsigned char* __restrict__ ub, const float* __restrict__ su,
                                                   const unsigned char* __restrict__ vb, const float* __restrict__ sv, const float* __restrict__ modl, float* __restrict__ xs,
                                                   int ntok, char* smem, const float* __restrict__ ng, const float* __restrict__ nmod, bf16_t* __restrict__ xn_next, float* __restrict__ out, bool dry = false, unsigned emask = 0x3FFFu) {
  bf16_t* hs = (bf16_t*)(smem + PG_OFF_H); unsigned short* se = (unsigned short*)(smem + PG_OFF_E); float* sg = (float*)(smem + PG_OFF_G);
  unsigned short* sst = (unsigned short*)(smem + PG_OFF_ST); unsigned short* cnt = (unsigned short*)(smem + PG_OFF_CNT);
  const int per_block = (ntok + (int)gridDim.x - 1) / (int)gridDim.x;
  const int npass = (per_block + PG_TOK - 1) / PG_TOK; const int tpp = (per_block + npass - 1) / npass;
  for (int pass = 0; pass < npass; ++pass) {
    const int t = tid_opaque(), lane = t & 63, wave = t >> 6;
    __syncthreads();
    for (int i = t; i < PG_TOK * 8 * 16; i += 256) cnt[i] = 0;
    for (int i = t; i < PG_TOK * 128; i += 256) {
      int tl = i >> 7, ch = i & 127; int q = (tl % PG_NT) * 4 + tl / PG_NT; int idx = pass * tpp + q; int g = (int)blockIdx.x + idx * (int)gridDim.x;
      u32x4 v = {0u, 0u, 0u, 0u};
      if (q < tpp && idx < per_block && g < ntok) v = *(const u32x4*)(xn + pg_row(g, ntok) * DM + ch * 8);
      *(u32x4*)(hs + tl * 1024 + ch * 8) = v;
    }
    __syncthreads();
    int my_e[16]; float my_g[16];
    const int ctl = t >> 3, cp = t & 7;
    bool cact = false;
    if (ctl < PG_TOK) {
      int q = (ctl % PG_NT) * 4 + ctl / PG_NT; int idx = pass * tpp + q; int g = (int)blockIdx.x + idx * (int)gridDim.x;
      cact = q < tpp && idx < per_block && g < ntok;
      if (cact) {
        long row = pg_row(g, ntok);
        peer_combine(top1 + (row * 16 + cp * 2) * 16, top1 + (row * 16 + cp * 2 + 1) * 16, my_e, my_g);
#pragma unroll
        for (int k = 0; k < 16; ++k) cnt[(ctl * 8 + cp) * 16 + (my_e[k] >> 10)] += 1;
      }
    }
    __syncthreads();
    if (t < PG_TOK) {
      int run = 0;
      for (int s = 0; s < 16; ++s) {
        sst[t * 18 + s] = (unsigned short)run;
        for (int h = 0; h < 8; ++h) { int c = cnt[(t * 8 + h) * 16 + s]; cnt[(t * 8 + h) * 16 + s] = (unsigned short)run; run += c; }
      }
      sst[t * 18 + 16] = (unsigned short)run;
    }
    __syncthreads();
    if (cact) {
#pragma unroll
      for (int k = 0; k < 16; ++k) { int s = my_e[k] >> 10; int pos = cnt[(ctl * 8 + cp) * 16 + s]; cnt[(ctl * 8 + cp) * 16 + s] = (unsigned short)(pos + 1); se[ctl * 128 + pos] = (unsigned short)my_e[k]; sg[ctl * 128 + pos] = my_g[k]; }
    }
    __syncthreads();
    float acc[PG_NT][16];
#pragma unroll
    for (int tk = 0; tk < PG_NT; ++tk)
#pragma unroll
      for (int e = 0; e < 16; ++e) acc[tk][e] = 0.f;
    for (int s = 0; s < 16; ++s) {
#pragma unroll
      for (int tk = 0; tk < PG_NT; ++tk) {
        const int tl = wave * PG_NT + tk;
        const int st = sst[tl * 18 + s], en = sst[tl * 18 + s + 1];
        for (int base = st; base < en; base += 8) {
          const int nb = en - base < 8 ? en - base : 8;
          u32x4 u[8], v[8];
#pragma unroll
          for (int j = 0; j < 8; ++j) if (j < nb) { const unsigned off = ((unsigned)se[tl * 128 + base + j] & emask) * 1024u + (unsigned)lane * 16u; u[j] = *(const u32x4*)(ub + off); v[j] = *(const u32x4*)(vb + off); }
          float h[16];
          { u32x4 h0 = *(const u32x4*)(hs + tl * 1024 + lane * 16), h1 = *(const u32x4*)(hs + tl * 1024 + lane * 16 + 8);
#pragma unroll
            for (int e = 0; e < 4; ++e) { h[2*e] = __uint_as_float(h0[e] << 16); h[2*e+1] = __uint_as_float(h0[e] & 0xffff0000u); h[8+2*e] = __uint_as_float(h1[e] << 16); h[8+2*e+1] = __uint_as_float(h1[e] & 0xffff0000u); } }
          float pd[8];
#pragma unroll
          for (int j = 0; j < 8; ++j) pd[j] = j < nb ? dot16_fp8(h, u[j]) : 0.f;
          float q4[4], q2[2], q1;
#pragma unroll
          for (int j = 0; j < 4; ++j) { bool hi = lane & 1; float keep = hi ? pd[2*j+1] : pd[2*j], send = hi ? pd[2*j] : pd[2*j+1]; q4[j] = keep + dpp_get<0xB1>(send); }
#pragma unroll
          for (int j = 0; j < 2; ++j) { bool hi = lane & 2; float keep = hi ? q4[2*j+1] : q4[2*j], send = hi ? q4[2*j] : q4[2*j+1]; q2[j] = keep + dpp_get<0x4E>(send); }
          { bool hi = lane & 4; float keep = hi ? q2[1] : q2[0], send = hi ? q2[0] : q2[1]; q1 = keep + swz_xor4(send); }
          q1 += dpp_get<0x128>(q1);
          q1 += __builtin_bit_cast(float, __builtin_amdgcn_ds_swizzle(__builtin_bit_cast(int, q1), 0x401F));
          q1 += __shfl_xor(q1, 32);
          float w = 0.f;
          { const int jj = lane & 7; if (jj < nb) { int e = se[tl * 128 + base + jj]; w = sg[tl * 128 + base + jj] * fgelu_(q1 * su[e]) * sv[e]; } }
#pragma unroll
          for (int j = 0; j < 8; ++j) { float wj = __builtin_bit_cast(float, __builtin_amdgcn_readlane(__builtin_bit_cast(int, w), j)); if (j < nb) axpy16_fp8(acc[tk], wj, v[j]); }
        }
      }
    }
    if (dry) {
#pragma unroll
      for (int tk = 0; tk < PG_NT; ++tk)
#pragma unroll
        for (int e = 0; e < 16; ++e) asm volatile("" :: "v"(acc[tk][e]));
    }
#pragma unroll
    for (int tk = 0; tk < PG_NT; ++tk) {
      int q = tk * 4 + wave; int idx = pass * tpp + q; int g = (int)blockIdx.x + idx * (int)gridDim.x;
      if (!dry && q < tpp && idx < per_block && g < ntok) {
        long row = pg_row(g, ntok); int b = row / RB, lr = row % RB; int bb = lr < SEQ ? b : BATCH; const float* g5 = modl + ((long)bb * 6 + 5) * DM + lane * 16;
        float* xr = xs + row * DM + lane * 16;
        f32x4 xv[4]; float ss = 0.f;
#pragma unroll
        for (int i = 0; i < 4; ++i) {
          f32x4 x = *(f32x4*)(xr + 4 * i); f32x4 gg = *(const f32x4*)(g5 + 4 * i);
          x[0] += gg[0] * acc[tk][4*i]; x[1] += gg[1] * acc[tk][4*i+1]; x[2] += gg[2] * acc[tk][4*i+2]; x[3] += gg[3] * acc[tk][4*i+3];
          xv[i] = x; ss += x[0] * x[0] + x[1] * x[1] + x[2] * x[2] + x[3] * x[3];
        }
        if (out) {
          float* orow = out + ((long)b * SEQ + lr) * DM + lane * 16;
#pragma unroll
          for (int i = 0; i < 4; ++i) *(f32x4*)(orow + 4 * i) = xv[i];
        } else {
#pragma unroll
          for (int i = 0; i < 4; ++i) *(f32x4*)(xr + 4 * i) = xv[i];
          ss = wave_sum(ss); const float inv = __builtin_amdgcn_rsqf(ss * (1.f / DM) + EPSN);
          const float* sh = nmod + ((long)bb * 6 + 0) * DM + lane * 16; const float* sc = sh + DM; const float* gp = ng + lane * 16;
          u32x4 p0, p1;
#pragma unroll
          for (int i = 0; i < 4; ++i) { f32x4 g4 = *(const f32x4*)(gp + 4 * i), s4 = *(const f32x4*)(sc + 4 * i), h4 = *(const f32x4*)(sh + 4 * i);
            const float a0 = xv[i][0] * inv * g4[0] * (1.f + s4[0]) + h4[0], a1 = xv[i][1] * inv * g4[1] * (1.f + s4[1]) + h4[1];
            const float a2 = xv[i][2] * inv * g4[2] * (1.f + s4[2]) + h4[2], a3 = xv[i][3] * inv * g4[3] * (1.f + s4[3]) + h4[3];
            if (i < 2) { p0[2 * i] = pack2bf(a0, a1); p0[2 * i + 1] = pack2bf(a2, a3); } else { p1[2 * (i - 2)] = pack2bf(a0, a1); p1[2 * (i - 2) + 1] = pack2bf(a2, a3); } }
          *(u32x4*)(xn_next + row * DM + lane * 16) = p0; *(u32x4*)(xn_next + row * DM + lane * 16 + 8) = p1;
        }
      }
    }
  }
}

#include <hip/hip_cooperative_groups.h>
namespace cg = cooperative_groups;

#define XB_TMO      128
#define XB_XCNT(j)  (256  + 64 * (j))
#define XB_XSUB(j)  (1280 + 64 * (j))
#define XB_XGEN(j)  (2304 + 64 * (j))
#define XB_TOP      3328
#define XB_TOPGEN   3392
#define XB_QUEUE(i) (3456 + 64 * (i))
#define XCD_BAR_WORDS 4096
#define XB_SPIN_CAP (1u << 22)
#define LAS __attribute__((address_space(3)))
__device__ __forceinline__ unsigned xb_ld(unsigned* p)              { return __hip_atomic_load(p, __ATOMIC_RELAXED, __HIP_MEMORY_SCOPE_AGENT); }
__device__ __forceinline__ unsigned xb_add(unsigned* p, unsigned v) { return __hip_atomic_fetch_add(p, v, __ATOMIC_RELAXED, __HIP_MEMORY_SCOPE_AGENT); }
__device__ __forceinline__ unsigned xb_xcc_id() { return (unsigned)__builtin_amdgcn_s_getreg((3 << 11) | 20) & 0xFu; }
#define XB_SPIN(cond, bar) do { unsigned _sp = 0; while (cond) { __builtin_amdgcn_s_sleep(1); \
    if ((++_sp & 255u) == 0u) { if (xb_ld(&(bar)[XB_TMO])) break; if (_sp > XB_SPIN_CAP) { atomicAdd(&(bar)[XB_TMO], 1u); break; } } } } while (0)
struct XcdBarrier { unsigned* bar; unsigned x; volatile LAS unsigned* st; };
__device__ __forceinline__ XcdBarrier xcd_barrier_post(unsigned* bar, volatile LAS unsigned* st) {
  XcdBarrier b; b.bar = bar; b.x = xb_xcc_id(); b.st = st;
  if (threadIdx.x == 0) (void)xb_add(&bar[XB_XCNT(b.x)], 1u);
  return b;
}
__device__ __forceinline__ void xcd_barrier_complete(unsigned* bar, unsigned x, unsigned& nloc, unsigned& nx) {
  const unsigned G = gridDim.x; unsigned sum, cnt, mine, sp = 0u;
  for (;;) {
    sum = 0u; cnt = 0u; mine = 0u;
#pragma unroll
    for (unsigned j = 0; j < 16; ++j) { const unsigned c = xb_ld(&bar[XB_XCNT(j)]); sum += c; cnt += (c > 0u) ? 1u : 0u; mine = (j == x) ? c : mine; }
    if (sum == G) break;
    __builtin_amdgcn_s_sleep(1);
    if ((++sp & 255u) == 0u) { if (xb_ld(&bar[XB_TMO])) break; if (sp > XB_SPIN_CAP) { atomicAdd(&bar[XB_TMO], 1u); break; } }
  }
  nloc = mine > 0u ? mine : 1u; nx = cnt > 0u ? cnt : 1u;
}
__device__ __forceinline__ void xcd_barrier(const XcdBarrier& b) {
  asm volatile("s_waitcnt vmcnt(0)" ::: "memory");
  __syncthreads();
  if (threadIdx.x == 0) {
    unsigned* bar = b.bar;
    __builtin_amdgcn_s_waitcnt(0);
    unsigned nloc = b.st[0], nx = b.st[1];
    if (nloc == 0u) { xcd_barrier_complete(bar, b.x, nloc, nx); b.st[0] = nloc; b.st[1] = nx; }
    const unsigned old = xb_add(&bar[XB_XSUB(b.x)], 1u);
    const unsigned gen = old / nloc;
    if (old + 1u == (gen + 1u) * nloc) {
      __builtin_amdgcn_fence(__ATOMIC_RELEASE, "agent");
      asm volatile("s_waitcnt vmcnt(0)" ::: "memory");
      const unsigned og = xb_add(&bar[XB_TOP], 1u);
      const unsigned tg = og / nx;
      if (og + 1u == (tg + 1u) * nx) xb_add(&bar[XB_TOPGEN], 1u);
      else XB_SPIN(xb_ld(&bar[XB_TOPGEN]) == tg, bar);
      __builtin_amdgcn_fence(__ATOMIC_ACQUIRE, "agent");
      xb_add(&bar[XB_XGEN(b.x)], 1u);
      asm volatile("s_waitcnt vmcnt(0)" ::: "memory");
    } else {
      XB_SPIN(xb_ld(&bar[XB_XGEN(b.x)]) == gen, bar);
      __builtin_amdgcn_fence(__ATOMIC_ACQUIRE, "agent");
      asm volatile("s_waitcnt vmcnt(0)" ::: "memory");
    }
  }
  __syncthreads();
}


constexpr size_t al256(size_t x) { return (x + 255) & ~(size_t)255; }
struct WsOff { size_t xs, mod, xn, Pb, tq, tkv, a_b, g_b, w_f, mq, mk, mvT, gq, gk, gvT, r_b, v_b, kk_b, kd_b, bd_b, w_inT, w_outT, wqT, keysb, wqbT, wkvbT, w2T, a2T, g2T, rope_g, rope_m, total; };
constexpr WsOff make_wsoff() {
  WsOff o{}; size_t p = 32768; const size_t MA = NROWS;
  o.mod = p; p += al256(2 * (BATCH + 1) * 6144 * 4); o.xs = p; p += al256(MA * DM * 4); o.xn = p; p += al256(MA * DM * 2);
  o.Pb = p; p += al256(MA * IN_COLS * 2);
  o.tq = p; p += al256(MA * 384 * 2); o.tkv = p; p += al256(MA * 512 * 2); o.a_b = p; p += al256(2 * MA * 384 * 2);
  o.g_b = p; p += al256(MA * 384 * 2); o.w_f = p; p += al256(2 * MA * 384 * 4);
  o.mq = p; p += al256(MA * 384 * 2); o.mk = p; p += al256(MA * 384 * 2); o.mvT = p; p += al256((size_t)BATCH * 4 * 64 * RB * 2);
  o.gq = p; p += al256(MA * 384 * 2); o.gk = p; p += al256(MA * 128 * 2); o.gvT = p; p += al256((size_t)BATCH * 2 * 64 * RB * 2);
  o.r_b = p; p += al256(MA * 384 * 2); o.v_b = p; p += al256(MA * 384 * 2); o.kk_b = p; p += al256(MA * 384 * 2);
  o.kd_b = p; p += al256(2 * MA * 384 * 2); o.bd_b = p; p += al256(2 * MA * 384 * 2);
  o.w_inT = p; p += al256((size_t)2 * 2688 * 1024 * 2); o.w_outT = p; p += al256((size_t)2 * 1024 * 1024 * 2); o.wqT = p; p += al256((size_t)2 * 2048 * 1024 * 2);
  o.keysb = p; p += al256((size_t)2 * 16 * 128 * 128 * 2); o.wqbT = p; p += al256((size_t)2 * 384 * 256 * 2); o.wkvbT = p; p += al256((size_t)2 * 512 * 128 * 2);
  o.w2T = p; p += al256((size_t)2 * 2 * 384 * 64 * 2); o.a2T = p; p += al256((size_t)2 * 2 * 384 * 64 * 2); o.g2T = p; p += al256((size_t)2 * 384 * 192 * 2);
  o.rope_g = p; p += al256((size_t)SEQ * 64 * 4); o.rope_m = p; p += al256((size_t)SEQ * 32 * 4);
  o.total = p; return o;
}
constexpr WsOff WO = make_wsoff();
#define WS_PTR(T, off) ((T*)(ws + (off)))
#define TAB_OFF (WO.Pb + ((size_t)2 * NROWS * 384 * 4 + 1048576 & ~(size_t)255))
#define TAB_U (TAB_OFF)
#define TAB_V (TAB_OFF + (size_t)16384 * 1024)
#define TAB_SU (TAB_OFF + (size_t)2 * 16384 * 1024)
#define TAB_SV (TAB_OFF + (size_t)2 * 16384 * 1024 + 65536)
#define LAUNDER_S(x) asm volatile("" : "+s"(x))
#define KARG_AS __attribute__((address_space(4)))
#define KP_DECL const KARG_AS MegaP* kp_ = (const KARG_AS MegaP*)__builtin_amdgcn_kernarg_segment_ptr(); LAUNDER_S(kp_)

struct NaiveIn {
  const float *x, *c, *ctx, *c_ctx, *ada_w, *ada_b, *norm_mix_g, *norm_ffn_g, *w_in, *w_out, *mla_q_norm_g, *mla_w_qb, *mla_kv_norm_g,
      *mla_w_kvb, *mla_qk_g, *rw_mu, *rw_w0, *rw_w2, *rw_a0, *rw_a2, *rw_g2, *rw_k_k, *rw_k_a, *rw_r_k, *rw_ln_g, *rw_ln_b, *gqa_qk_g,
      *pe_wq, *pe_keys, *pe_u, *pe_v;
};
struct MegaP { NaiveIn in; char* ws; float* out; };

#ifndef MEGA_CG
#define MEGA_CG 0
#endif
#if MEGA_CG
#define GRID_BARRIER() cg::this_grid().sync()
#else
#define GRID_BARRIER() do { XcdBarrier xb_; xb_.bar = (unsigned*)((const KARG_AS MegaP*)__builtin_amdgcn_kernarg_segment_ptr())->ws; xb_.x = xb_xcc_id(); xb_.st = (volatile LAS unsigned*)&xb_words; xcd_barrier(xb_); } while (0)
#endif
#define MEGA_LDS_BYTES 65536
#ifndef PHASE_MASK
#define PHASE_MASK 0xFFFF
#endif
#define PH(k) if (PHASE_MASK & (1 << (k)))
#define LAT_TM(i) (((i) >> 4) * 18 + ((i) & 15))
#define XCD_TILE_LOOP(tile, T) for (int xt_base_ = (int)(((long)(T) * (blockIdx.x & 7)) >> 3), xt_cnt_ = (int)(((long)(T) * ((blockIdx.x & 7) + 1)) >> 3) - xt_base_, xt_q_ = blockIdx.x >> 3, tile = xt_base_ + xt_q_; xt_q_ < xt_cnt_; xt_q_ += gridDim.x >> 3, tile = xt_base_ + xt_q_)
#ifndef DIL_PH
#define DIL_PH -1
#endif
#ifndef DIL_MULT
#define DIL_MULT 4
#endif
#define DIL_BEGIN(k) unsigned long long dil_t0 = 0; if (DIL_PH == (k)) dil_t0 = __builtin_amdgcn_s_memrealtime();
#define DIL_END(k) if (DIL_PH == (k)) { GRID_BARRIER(); if (blockIdx.x == 0 && threadIdx.x == 0) { unsigned long long t1 = __builtin_amdgcn_s_memrealtime(); unsigned long long dt = (t1 - dil_t0) * DIL_MULT; \
    while (__builtin_amdgcn_s_memrealtime() - t1 < dt) __builtin_amdgcn_s_sleep(32); } }

__device__ __forceinline__ void ph_norm_mod(const float* xs, const float* g, const float* modl, int shift_idx, bf16_t* xn, bool skip_ctx = false) {
  const int tt_ = tid_opaque(); const int lane = tt_ & 63;
  for (long row = blockIdx.x * 4 + (tt_ >> 6); row < NROWS; row += (long)gridDim.x * 4) {
    int b = row / RB, lr = row % RB; int bb = lr < SEQ ? b : BATCH;
    if (skip_ctx && lr >= SEQ) continue;
    const float* sh = modl + ((long)bb * 6 + shift_idx) * DM; const float* sc = sh + DM;
    const float* xr = xs + row * DM; f32x4 v[4]; float ss = 0.f;
#pragma unroll
    for (int i = 0; i < 4; ++i) { v[i] = *(const f32x4*)(xr + i * 256 + lane * 4); ss += v[i][0]*v[i][0] + v[i][1]*v[i][1] + v[i][2]*v[i][2] + v[i][3]*v[i][3]; }
    ss = wave_sum(ss);
    float inv = __builtin_amdgcn_rsqf(ss / DM + EPSN);
#pragma unroll
    for (int i = 0; i < 4; ++i) {
      int d = i * 256 + lane * 4; float o[4];
#pragma unroll
      for (int e = 0; e < 4; ++e) o[e] = v[i][e] * inv * g[d+e] * (1.f + sc[d+e]) + sh[d+e];
      uint2 pk; pk.x = pack2bf(o[0], o[1]); pk.y = pack2bf(o[2], o[3]);
      *(uint2*)(xn + row * DM + d) = pk;
    }
  }
}
__device__ __forceinline__ void ph_cvt_wT(const float* W, const float* g, bf16_t* Wt, int K, int N, int Npad, int Kpad) {
  const long n_el = (long)Npad * Kpad;
  const int tt_ = tid_opaque();
  for (long i = (long)blockIdx.x * 256 + tt_; i < n_el; i += (long)gridDim.x * 256) {
    int k = i % Kpad; int n = i / Kpad;
    Wt[i] = (k < K && n < N) ? f2bf(W[(long)k * N + n] * (g ? g[k] : 1.f)) : (bf16_t)0;
  }
}
__device__ __forceinline__ void ph_cvt_bf16(const float* s, bf16_t* d, long n8) {
  const int tt_ = tid_opaque();
  for (long i = (long)blockIdx.x * 256 + tt_; i < n8; i += (long)gridDim.x * 256) {
    f32x4 a = *(const f32x4*)(s + i * 8), b = *(const f32x4*)(s + i * 8 + 4);
    u32x4 o; o[0] = pack2bf(a[0], a[1]); o[1] = pack2bf(a[2], a[3]); o[2] = pack2bf(b[0], b[1]); o[3] = pack2bf(b[2], b[3]);
    *(u32x4*)(d + i * 8) = o;
  }
}


__device__ __forceinline__ void ph_cvt_wT_tiled(const float* __restrict__ W, const float* __restrict__ g, bf16_t* __restrict__ Wt, int K, int N, int Npad, int Kpad, char* smem) {
  const int t = tid_opaque(); float* s = (float*)smem;
  const int tk = Kpad / 64, tn = Npad / 64;
  for (int tile = blockIdx.x; tile < tk * tn; tile += gridDim.x) {
    const int k0 = (tile % tk) * 64, n0 = (tile / tk) * 64;
    __syncthreads();
#pragma unroll
    for (int i = 0; i < 4; ++i) {
      int kk = (t >> 4) + 16 * i, nn = (t & 15) * 4; int k = k0 + kk;
      f32x4 v = {0.f, 0.f, 0.f, 0.f};
      if (k < K) {
        const float* src = W + (long)k * N + n0 + nn; float gs = g ? g[k] : 1.f;
        if (n0 + nn + 3 < N) v = *(const f32x4*)src; else { for (int e = 0; e < 4; ++e) if (n0 + nn + e < N) v[e] = src[e]; }
        v *= gs;
      }
#pragma unroll
      for (int e = 0; e < 4; ++e) s[kk * 65 + nn + e] = v[e];
    }
    __syncthreads();
    {
      int nn = t >> 2, kq = (t & 3) * 16; u32x4 o0, o1;
#pragma unroll
      for (int e = 0; e < 4; ++e) { o0[e] = pack2bf(s[(kq + 2*e) * 65 + nn], s[(kq + 2*e + 1) * 65 + nn]); o1[e] = pack2bf(s[(kq + 8 + 2*e) * 65 + nn], s[(kq + 8 + 2*e + 1) * 65 + nn]); }
      bf16_t* dst = Wt + (long)(n0 + nn) * Kpad + k0 + kq;
      *(u32x4*)dst = o0; *(u32x4*)(dst + 8) = o1;
    }
  }
}
__device__ __forceinline__ void ph_mod_gemv(const float* __restrict__ c, const float* __restrict__ c_ctx, const float* __restrict__ ada_w, const float* __restrict__ ada_b, float* __restrict__ mod, char* smem) {
  const int t = tid_opaque(); float* s = (float*)smem;
  if ((int)blockIdx.x >= 2 * 24) return;
  for (int i = t; i < 9 * 1024; i += 256) { int bb = i >> 10, k = i & 1023; float v = bb < BATCH ? c[bb * DM + k] : c_ctx[k]; s[i] = v * __builtin_amdgcn_rcpf(1.f + __builtin_amdgcn_exp2f(-v * 1.4426950408889634f)); }
  __syncthreads();
  for (int item = blockIdx.x; item < 2 * 24; item += gridDim.x) {
    const int cb = item % 24, l = item / 24;
    const int j = cb * 256 + t; const float* wp = ada_w + (long)l * DM * 6144 + j;
    float acc[9];
#pragma unroll
    for (int bb = 0; bb < 9; ++bb) acc[bb] = 0.f;
#pragma unroll 8
    for (int k = 0; k < 1024; ++k) { float w = wp[(long)k * 6144];
#pragma unroll
      for (int bb = 0; bb < 9; ++bb) acc[bb] += s[bb * 1024 + k] * w; }
    const float bias = ada_b[l * 6144 + j];
#pragma unroll
    for (int bb = 0; bb < 9; ++bb) mod[((long)l * (BATCH + 1) + bb) * 6144 + j] = acc[bb] + bias;
  }
  __syncthreads();
}

__global__ void __launch_bounds__(256, 2) mega_kernel(MegaP p) {
  __shared__ __attribute__((aligned(16))) char smem[MEGA_LDS_BYTES];
  __shared__ uint4 xb_words;
  const int t0 = threadIdx.x;
#if !MEGA_CG
  if (t0 == 0) xb_words = make_uint4(0u, 0u, 0u, 0u);
  __syncthreads();
  (void)xcd_barrier_post((unsigned*)p.ws, (volatile LAS unsigned*)&xb_words);
#endif
  const long MA = NROWS; const int TM = NROWS / 128;
#define I (kp_->in)
  const int scan_role = (int)blockIdx.x < BATCH * 24 ? 1 : 0;
  { DIL_BEGIN(0)
  PH(0) {
    KP_DECL; char* ws = kp_->ws; const int t = tid_opaque();
    float* xs = WS_PTR(float, WO.xs); float* mod = WS_PTR(float, WO.mod);
    for (long i = (long)blockIdx.x * 256 + t; i < MA * DM / 4; i += (long)gridDim.x * 256) {
      long e = i * 4; int d = e % DM; long row = e / DM; int b = row / RB, lr = row % RB;
      const float* src = lr < SEQ ? I.x + ((long)b * SEQ + lr) * DM + d : I.ctx + ((long)b * CTX_LEN + (lr - SEQ)) * DM + d;
      *(f32x4*)(xs + e) = *(const f32x4*)src;
    }
    ph_mod_gemv(I.c, I.c_ctx, I.ada_w, I.ada_b, mod, smem);
    for (int l = 0; l < 2; ++l) {
      ph_cvt_wT_tiled(I.w_in + (long)l * DM * IN_COLS, nullptr, WS_PTR(bf16_t, WO.w_inT) + (long)l * 2688 * 1024, 1024, IN_COLS, 2688, 1024, smem);
      ph_cvt_wT_tiled(I.w_out + (long)l * DM * DM, nullptr, WS_PTR(bf16_t, WO.w_outT) + (long)l * 1024 * 1024, 1024, 1024, 1024, 1024, smem);
      ph_cvt_wT_tiled(I.pe_wq + (long)l * DM * 2048, nullptr, WS_PTR(bf16_t, WO.wqT) + (long)l * 2048 * 1024, 1024, 2048, 2048, 1024, smem);
      ph_cvt_wT_tiled(I.mla_w_qb + (long)l * 256 * 384, I.mla_q_norm_g + l * 256, WS_PTR(bf16_t, WO.wqbT) + (long)l * 384 * 256, 256, 384, 384, 256, smem);
      ph_cvt_wT_tiled(I.mla_w_kvb + (long)l * 128 * 512, I.mla_kv_norm_g + l * 128, WS_PTR(bf16_t, WO.wkvbT) + (long)l * 512 * 128, 128, 512, 512, 128, smem);
      for (int d = 0; d < 2; ++d) {
        ph_cvt_wT_tiled(I.rw_w2 + ((long)l * 2 + d) * 64 * 384, nullptr, WS_PTR(bf16_t, WO.w2T) + ((long)l * 2 + d) * 384 * 64, 64, 384, 384, 64, smem);
        ph_cvt_wT_tiled(I.rw_a2 + ((long)l * 2 + d) * 64 * 384, nullptr, WS_PTR(bf16_t, WO.a2T) + ((long)l * 2 + d) * 384 * 64, 64, 384, 384, 64, smem);
      }
      ph_cvt_wT_tiled(I.rw_g2 + (long)l * 160 * 384, nullptr, WS_PTR(bf16_t, WO.g2T) + (long)l * 384 * 192, 160, 384, 384, 192, smem);
    }
    ph_cvt_bf16(I.pe_keys, WS_PTR(bf16_t, WO.keysb), 2L * 16 * 128 * 128 / 8);
    ph_rope_tables(WS_PTR(float, WO.rope_g), WS_PTR(float, WO.rope_m));
  }
  DIL_END(0) }
  GRID_BARRIER();
  for (int lq = 0; lq < 2; ++lq) {
    int l = lq; LAUNDER_S(l);
    { DIL_BEGIN(1)
    PH(1) if (l == 0) {
      KP_DECL; char* ws = kp_->ws; const int t = tid_opaque(); (void)t;
      ph_norm_mod(WS_PTR(float, WO.xs), I.norm_mix_g + l * DM, WS_PTR(float, WO.mod) + (long)l * (BATCH + 1) * 6144, 0, WS_PTR(bf16_t, WO.xn));
    }
    DIL_END(1) }
    GRID_BARRIER();
    { DIL_BEGIN(2)
    PH(2) {
      KP_DECL; char* ws = kp_->ws; const int t = tid_opaque(); (void)t;
      const bf16_t* xn = WS_PTR(bf16_t, WO.xn); const bf16_t* wT = WS_PTR(bf16_t, WO.w_inT) + (long)l * 2688 * 1024; bf16_t* Pb = WS_PTR(bf16_t, WO.Pb);
      XCD_TILE_LOOP(tile, TM * 21)
        gemm_tile_128_glds(xn, DM, wT, 1024, 1024, tile / 21, tile % 21, smem, EpiStoreBf16{Pb, IN_COLS, IN_COLS});
    }
    DIL_END(2) }
    GRID_BARRIER();
    { DIL_BEGIN(3)
    PH(3) {
      KP_DECL; char* ws = kp_->ws; const int t = tid_opaque(); (void)t;
      PrepW pw{WS_PTR(bf16_t, WO.wqbT) + (long)l * 384 * 256, WS_PTR(bf16_t, WO.wkvbT) + (long)l * 512 * 128, WS_PTR(bf16_t, WO.w2T) + (long)l * 2 * 384 * 64,
               WS_PTR(bf16_t, WO.a2T) + (long)l * 2 * 384 * 64, WS_PTR(bf16_t, WO.g2T) + (long)l * 384 * 192, I.rw_mu + (long)l * 2 * RWC, I.rw_w0 + l * 768, I.rw_a0 + l * 768};
      PrepBuf pb{WS_PTR(bf16_t, WO.Pb), WS_PTR(bf16_t, WO.tq), WS_PTR(bf16_t, WO.tkv), WS_PTR(bf16_t, WO.a_b), WS_PTR(bf16_t, WO.g_b), WS_PTR(float, WO.w_f)};
      XCD_TILE_LOOP(tile, TM * 22) prep_gemm_tile(pw, pb, tile / 22, tile % 22, smem);
    }
    DIL_END(3) }
    GRID_BARRIER();
    { DIL_BEGIN(4)
    PH(4) {
      KP_DECL; char* ws = kp_->ws; const int t = tid_opaque(); (void)t;
      FinW2 fw{I.mla_qk_g + l * 192, I.gqa_qk_g + l * 128, I.rw_mu + (long)l * 2 * RWC, I.rw_k_k + l * 384, I.rw_k_a + l * 384, WS_PTR(float, WO.rope_g), WS_PTR(float, WO.rope_m)};
      FinBuf fb{WS_PTR(bf16_t, WO.Pb), WS_PTR(bf16_t, WO.tq), WS_PTR(bf16_t, WO.tkv), WS_PTR(bf16_t, WO.a_b), WS_PTR(bf16_t, WO.mq), WS_PTR(bf16_t, WO.mk), WS_PTR(bf16_t, WO.mvT),
                WS_PTR(bf16_t, WO.gq), WS_PTR(bf16_t, WO.gk), WS_PTR(bf16_t, WO.gvT), WS_PTR(bf16_t, WO.r_b), WS_PTR(bf16_t, WO.v_b), WS_PTR(bf16_t, WO.kk_b), WS_PTR(bf16_t, WO.kd_b), WS_PTR(bf16_t, WO.bd_b)};
      for (int tile = blockIdx.x; tile < NROWS / 32; tile += gridDim.x) prep_finish_tile2(fw, fb, tile, smem);
    }
    DIL_END(4) }
    GRID_BARRIER();
    { unsigned long long dil_t0 = 0, dil_scan = 0; if (DIL_PH == 5 || DIL_PH == 11) dil_t0 = __builtin_amdgcn_s_memrealtime();
    PH(5) {
      KP_DECL; char* ws = kp_->ws; const int t = tid_opaque(); (void)t;
      int* s_item = (int*)(smem + MEGA_LDS_BYTES - 16);
      unsigned* sctr = (unsigned*)ws + XB_QUEUE(4 + l);
      auto scan_loop = [&]() {
        for (;;) {
          __syncthreads();
          if (t == 0) *s_item = (int)xb_add(sctr, 1u);
          __syncthreads();
          const int it = *s_item;
          if (it >= BATCH * 24) break;
          rw_scan_block(WS_PTR(bf16_t, WO.r_b), WS_PTR(bf16_t, WO.v_b), WS_PTR(bf16_t, WO.kk_b), WS_PTR(bf16_t, WO.kd_b), WS_PTR(bf16_t, WO.bd_b), WS_PTR(float, WO.w_f), WS_PTR(float, WO.Pb),
                        it, (long)MA * 384, smem);
        }
      };
      if (scan_role) scan_loop();
      const int nqt = l == 0 ? 18 : 16; const int n_mla = BATCH * 4 * nqt, n_all = BATCH * 10 * nqt;
      unsigned* qctr = (unsigned*)ws + XB_QUEUE(l);
      for (;;) {
        __syncthreads();
        if (t == 0) *s_item = (int)xb_add(qctr, 1u);
        __syncthreads();
        const int it = *s_item;
        if (it >= n_all) break;
        const KARG_AS MegaP* kp2_ = (const KARG_AS MegaP*)__builtin_amdgcn_kernarg_segment_ptr(); LAUNDER_S(kp2_); char* ws2 = kp2_->ws;
        if (it < n_mla) { int qt = it / (BATCH * 4), r = it % (BATCH * 4);
          attn_block<96>((const bf16_t*)(ws2 + WO.mq), 4, (const bf16_t*)(ws2 + WO.mk), 4, (const bf16_t*)(ws2 + WO.mvT), 1, (bf16_t*)(ws2 + WO.tq), 0, r / 4, r % 4, qt, smem); }
        else { int v = it - n_mla; int qt = v / (BATCH * 6), r = v % (BATCH * 6);
          attn_block<64>((const bf16_t*)(ws2 + WO.gq), 6, (const bf16_t*)(ws2 + WO.gk), 2, (const bf16_t*)(ws2 + WO.gvT), 3, (bf16_t*)(ws2 + WO.tq), 640, r / 6, r % 6, qt, smem); }
      }
      if (!scan_role) scan_loop();
      {
        unsigned* cctr = (unsigned*)ws + XB_QUEUE(2 + l);
        for (;;) {
          __syncthreads();
          if (t == 0) *s_item = (int)xb_add(cctr, 1u);
          __syncthreads();
          const int it = *s_item;
          if (it >= 512) break;
          const int tab = it >> 8, r0 = (it & 255) * 64;
          if (tab == 0) ph_cvt_fp8_rows(I.pe_u + (long)l * 16384 * DM, WS_PTR(unsigned char, TAB_U), WS_PTR(float, TAB_SU), r0, r0 + 64);
          else ph_cvt_fp8_rows(I.pe_v + (long)l * 16384 * DM, WS_PTR(unsigned char, TAB_V), WS_PTR(float, TAB_SV), r0, r0 + 64);
        }
      }
    }
#if DIL_PH == 11
    GRID_BARRIER(); if (blockIdx.x == 0 && threadIdx.x == 0) { unsigned long long t1 = __builtin_amdgcn_s_memrealtime(); unsigned long long dt = dil_scan * DIL_MULT; while (__builtin_amdgcn_s_memrealtime() - t1 < dt) __builtin_amdgcn_s_sleep(32); }
#endif
    (void)dil_scan;
    DIL_END(5) }
    GRID_BARRIER();
    { DIL_BEGIN(6)
    PH(6) {
      KP_DECL; char* ws = kp_->ws; const int t = tid_opaque(); (void)t;
      RdW rw{I.rw_r_k + l * 384, I.rw_ln_g + l * 384, I.rw_ln_b + l * 384};
      for (long row = blockIdx.x * 4 + (t >> 6); row < NROWS; row += (long)gridDim.x * 4)
        if (l == 0 || (row % RB) < SEQ) rw_readout_row2(rw, WS_PTR(float, WO.Pb), WS_PTR(bf16_t, WO.r_b), WS_PTR(bf16_t, WO.v_b), WS_PTR(bf16_t, WO.kd_b), WS_PTR(bf16_t, WO.g_b), WS_PTR(bf16_t, WO.tq), row, t & 63);
    }
    DIL_END(6) }
    GRID_BARRIER();
    { DIL_BEGIN(7)
    PH(7) {
      KP_DECL; char* ws = kp_->ws; const int t = tid_opaque(); (void)t;
      const bf16_t* mix = WS_PTR(bf16_t, WO.tq); const bf16_t* wT = WS_PTR(bf16_t, WO.w_outT) + (long)l * 1024 * 1024; float* xs = WS_PTR(float, WO.xs);
      const float* modl = WS_PTR(float, WO.mod) + (long)l * (BATCH + 1) * 6144;
      const int TM7 = l == 0 ? TM : BATCH * 16;
      XCD_TILE_LOOP(tile, TM7 * 8)
        gemm_tile_128_glds(mix, DM, wT, 1024, 1024, l == 0 ? tile / 8 : LAT_TM(tile / 8), tile % 8, smem, EpiResid{xs, modl, 2, 0});
    }
    DIL_END(7) }
    GRID_BARRIER();
    { DIL_BEGIN(8)
    PH(8) {
      KP_DECL; char* ws = kp_->ws; const int t = tid_opaque(); (void)t;
      ph_norm_mod(WS_PTR(float, WO.xs), I.norm_ffn_g + l * DM, WS_PTR(float, WO.mod) + (long)l * (BATCH + 1) * 6144, 3, WS_PTR(bf16_t, WO.xn), l != 0);
    }
    DIL_END(8) }
    GRID_BARRIER();
    { DIL_BEGIN(9)
    PH(9) {
      KP_DECL; char* ws = kp_->ws; const int t = tid_opaque(); (void)t;
      const bf16_t* xn = WS_PTR(bf16_t, WO.xn); const bf16_t* wT = WS_PTR(bf16_t, WO.wqT) + (long)l * 2048 * 1024; const bf16_t* kb = WS_PTR(bf16_t, WO.keysb) + (long)l * 16 * 128 * 128;
      unsigned* top1 = WS_PTR(unsigned, WO.tq);
      const int TM9 = l == 0 ? TM : BATCH * 16;
      XCD_TILE_LOOP(tile, TM9 * 16) { peer_q_top1_tile(xn, wT, kb, top1, l == 0 ? tile / 16 : LAT_TM(tile / 16), tile % 16, smem); __syncthreads(); }
    }
    DIL_END(9) }
    GRID_BARRIER();
    { DIL_BEGIN(10)
    PH(10) {
      KP_DECL; char* ws = kp_->ws; const int t = tid_opaque(); (void)t;
      const float* modl = WS_PTR(float, WO.mod) + (long)l * (BATCH + 1) * 6144;
      peer_gather_sliced(WS_PTR(bf16_t, WO.xn), WS_PTR(unsigned, WO.tq), WS_PTR(unsigned char, TAB_U), WS_PTR(float, TAB_SU),
                         WS_PTR(unsigned char, TAB_V), WS_PTR(float, TAB_SV), modl, WS_PTR(float, WO.xs), l == 0 ? NROWS : BATCH * SEQ, smem,
                         I.norm_mix_g + (l == 0 ? DM : 0), WS_PTR(float, WO.mod) + (long)(l == 0 ? 1 : 0) * (BATCH + 1) * 6144, WS_PTR(bf16_t, WO.xn), l == 0 ? (float*)nullptr : kp_->out);
    }
    DIL_END(10) }
    GRID_BARRIER();
  }
}

extern "C" void kernel_launch(void* const* d_in, const int* in_sizes, int n_in, void* d_out, int out_size, void* d_ws, size_t ws_size,
                              hipStream_t stream) {
  MegaP p{};
  const float** pp = (const float**)&p.in;
  for (int i = 0; i < 31; ++i) pp[i] = (const float*)d_in[i];
  p.ws = (char*)d_ws; p.out = (float*)d_out;
  if (WO.total > ws_size) return;
  static int grid_blocks = 0;
  if (!grid_blocks) {
    int dev = 0, cus = 0, per_cu = 0;
    hipGetDevice(&dev);
    hipDeviceGetAttribute(&cus, hipDeviceAttributeMultiprocessorCount, dev);
    hipOccupancyMaxActiveBlocksPerMultiprocessor(&per_cu, mega_kernel, 256, 0);
    if (per_cu > 2) per_cu = 2;
    if (per_cu < 1) per_cu = 1;
    grid_blocks = cus * per_cu;
  }
  hipMemsetAsync(d_ws, 0, 32768, stream);
  void* args[] = {&p};
  hipLaunchCooperativeKernel((void*)mega_kernel, dim3(grid_blocks), dim3(256), args, 0, stream);
}
```

```cpp
#include <hip/hip_runtime.h>
#define PEER_EXP(x) __builtin_amdgcn_exp2f((x) * 1.4426950408889634f)
#ifndef BATCH
#define BATCH 8
#endif
#ifndef SEQ
#define SEQ 2048
#endif
#ifndef CTX_LEN
#define CTX_LEN 256
#endif
#define DM 1024
#define RB (SEQ + CTX_LEN)
#define NROWS (BATCH * RB)
#define IN_COLS 2624
#define MLA_OFF 0
#define RW_OFF 416
#define GQA_OFF 1984
#define RWC 1568
#define EPSN 1e-6f

__device__ inline float sigmoidf_(float x) { return 1.f / (1.f + expf(-x)); }
__device__ inline float siluf_(float x) { return x * sigmoidf_(x); }
__device__ inline float softplusf_(float x) { return fmaxf(x, 0.f) + log1pf(expf(-fabsf(x))); }
__device__ inline float geluf_(float x) { return 0.5f * x * (1.f + tanhf(0.7978845608028654f * (x + 0.044715f * x * x * x))); }

__global__ void nk_copy_in(const float* x, const float* ctx, float* xs) {
  long i = (long)blockIdx.x * blockDim.x + threadIdx.x;
  if (i >= (long)NROWS * DM) return;
  int d = i % DM; long row = i / DM; int b = row / RB, lr = row % RB;
  xs[i] = lr < SEQ ? x[((long)b * SEQ + lr) * DM + d] : ctx[((long)b * CTX_LEN + (lr - SEQ)) * DM + d];
}
__global__ void nk_copy_out(const float* xs, float* out) {
  long i = (long)blockIdx.x * blockDim.x + threadIdx.x;
  if (i >= (long)BATCH * SEQ * DM) return;
  int d = i % DM; long row = i / DM; int b = row / SEQ, t = row % SEQ;
  out[i] = xs[((long)b * RB + t) * DM + d];
}
__global__ void nk_mod(const float* c, const float* c_ctx, const float* ada_w, const float* ada_b, float* mod) {
  long i = (long)blockIdx.x * blockDim.x + threadIdx.x;
  if (i >= 2L * (BATCH + 1) * 6144) return;
  int j = i % 6144; int bb = (i / 6144) % (BATCH + 1); int l = i / (6144 * (BATCH + 1));
  const float* cv = bb < BATCH ? c + (long)bb * DM : c_ctx;
  const float* w = ada_w + (long)l * DM * 6144;
  float acc = 0.f;
  for (int k = 0; k < DM; ++k) acc += siluf_(cv[k]) * w[(long)k * 6144 + j];
  mod[i] = acc + ada_b[l * 6144 + j];
}
__global__ void nk_norm_mod(const float* xs, const float* g, const float* modl, int shift_idx, float* xn, int M, int bidx) {
  long row = (long)blockIdx.x * blockDim.x + threadIdx.x;
  if (row >= M) return;
  int lr = row % RB; int bb = lr < SEQ ? bidx : BATCH;
  const float* sh = modl + ((long)bb * 6 + shift_idx) * DM; const float* sc = sh + DM;
  const float* xr = xs + row * DM; float ss = 0.f;
  for (int d = 0; d < DM; ++d) ss += xr[d] * xr[d];
  float inv = 1.f / sqrtf(ss / DM + EPSN);
  for (int d = 0; d < DM; ++d) xn[row * DM + d] = xr[d] * inv * g[d] * (1.f + sc[d]) + sh[d];
}
__global__ void nk_gemm(const float* A, const float* W, float* C, int M, int N, int K) {
  long i = (long)blockIdx.x * blockDim.x + threadIdx.x;
  if (i >= (long)M * N) return;
  int n = i % N; long m = i / N; float acc = 0.f;
  for (int k = 0; k < K; ++k) acc += A[m * K + k] * W[(long)k * N + n];
  C[i] = acc;
}
__global__ void nk_mla_q1(const float* P, const float* qng, const float* wqb, float* tq, int M) {
  long i = (long)blockIdx.x * blockDim.x + threadIdx.x;
  if (i >= (long)M * 384) return;
  int j = i % 384; long r = i / 384; const float* cq = P + r * IN_COLS;
  float ss = 0.f; for (int k = 0; k < 256; ++k) ss += cq[k] * cq[k];
  float inv = 1.f / sqrtf(ss / 256 + EPSN), acc = 0.f;
  for (int k = 0; k < 256; ++k) acc += cq[k] * inv * qng[k] * wqb[k * 384 + j];
  tq[i] = acc;
}
__global__ void nk_mla_kv1(const float* P, const float* kvng, const float* wkvb, float* tkv, int M) {
  long i = (long)blockIdx.x * blockDim.x + threadIdx.x;
  if (i >= (long)M * 512) return;
  int j = i % 512; long r = i / 512; const float* ck = P + r * IN_COLS + 256;
  float ss = 0.f; for (int k = 0; k < 128; ++k) ss += ck[k] * ck[k];
  float inv = 1.f / sqrtf(ss / 128 + EPSN), acc = 0.f;
  for (int k = 0; k < 128; ++k) acc += ck[k] * inv * kvng[k] * wkvb[k * 512 + j];
  tkv[i] = acc;
}
__global__ void nk_mla_qk2(const float* P, const float* tq, const float* tkv, const float* qkg, float* mq, float* mk, int M) {
  long i = (long)blockIdx.x * blockDim.x + threadIdx.x;
  if (i >= (long)M * 8) return;
  int which = i % 2, h = (i / 2) % 4; long r = i / 8; int lr = r % RB;
  float ss = 0.f;
  for (int e = 0; e < 96; ++e) {
    float v = which == 0 ? tq[r * 384 + h * 96 + e] : (e < 64 ? tkv[r * 512 + h * 128 + e] : P[r * IN_COLS + 384 + (e - 64)]);
    ss += v * v;
  }
  float inv = 1.f / sqrtf(ss / 96 + EPSN);
  const float* g = qkg + which * 96; float* o = (which == 0 ? mq : mk) + r * 384 + h * 96;
  for (int e = 0; e < 64; ++e) {
    float v = which == 0 ? tq[r * 384 + h * 96 + e] : tkv[r * 512 + h * 128 + e];
    o[e] = v * inv * g[e];
  }
  for (int j = 0; j < 16; ++j) {
    float va = which == 0 ? tq[r * 384 + h * 96 + 64 + j] : P[r * IN_COLS + 384 + j];
    float vb = which == 0 ? tq[r * 384 + h * 96 + 80 + j] : P[r * IN_COLS + 384 + 16 + j];
    va *= inv * g[64 + j]; vb *= inv * g[80 + j];
    if (lr < SEQ) {
      int pos = j < 8 ? lr / 64 : lr % 64; float fr = powf(10000.f, -(float)(j & 7) / 8.f);
      float ang = (float)pos * fr, cs = cosf(ang), sn = sinf(ang);
      o[64 + j] = va * cs - vb * sn; o[80 + j] = va * sn + vb * cs;
    } else { o[64 + j] = va; o[80 + j] = vb; }
  }
}
__global__ void nk_gqa_prep(const float* P, const float* qkg, float* gq, float* gk, int M) {
  long i = (long)blockIdx.x * blockDim.x + threadIdx.x;
  if (i >= (long)M * 8) return;
  int h = i % 8; long r = i / 8; int lr = r % RB;
  const float* src = P + r * IN_COLS + GQA_OFF + h * 64;
  const float* g = qkg + (h < 6 ? 0 : 64);
  float* o = h < 6 ? gq + r * 384 + h * 64 : gk + r * 128 + (h - 6) * 64;
  float ss = 0.f; for (int e = 0; e < 64; ++e) ss += src[e] * src[e];
  float inv = 1.f / sqrtf(ss / 64 + EPSN);
  for (int j = 0; j < 32; ++j) {
    float va = src[j] * inv * g[j], vb = src[32 + j] * inv * g[32 + j];
    if (lr < SEQ) {
      int pos = j < 16 ? lr / 64 : lr % 64; float fr = powf(10000.f, -(float)(j & 15) / 16.f);
      float ang = (float)pos * fr, cs = cosf(ang), sn = sinf(ang);
      o[j] = va * cs - vb * sn; o[32 + j] = va * sn + vb * cs;
    } else { o[j] = va; o[32 + j] = vb; }
  }
}
template <int DQ>
__global__ void __launch_bounds__(256) nk_attn(const float* q, int qs, const float* k, int ks, const float* v, int vs, int vhs, int H, int G, float* mix, int ooff, int M) {
  long i = (long)blockIdx.x * blockDim.x + threadIdx.x;
  if (i >= (long)M * H) return;
  int h = i % H; long r = i / H; int b = r / RB, lr = r % RB; int kh = h / G;
  float qv[DQ];
#pragma unroll
  for (int e = 0; e < DQ; ++e) qv[e] = q[r * qs + h * DQ + e];
  float acc[64];
#pragma unroll
  for (int e = 0; e < 64; ++e) acc[e] = 0.f;
  float mx = -1e30f, l = 0.f; const float scale = 1.f / sqrtf((float)DQ);
  int k0 = lr < SEQ ? 0 : SEQ, k1 = RB;
  for (int kr = k0; kr < k1; ++kr) {
    long rr = (long)b * RB + kr; const float* kp = k + rr * ks + kh * DQ; float s = 0.f;
#pragma unroll
    for (int e = 0; e < DQ; ++e) s += qv[e] * kp[e];
    s *= scale;
    float mn = fmaxf(mx, s), al = expf(mx - mn), pp = expf(s - mn);
    l = l * al + pp; mx = mn; const float* vp = v + rr * vs + kh * vhs;
#pragma unroll
    for (int e = 0; e < 64; ++e) acc[e] = acc[e] * al + pp * vp[e];
  }
#pragma unroll
  for (int e = 0; e < 64; ++e) mix[r * DM + ooff + h * 64 + e] = acc[e] / l;
}
__global__ void nk_rw_shift(const float* P, const float* mu, float* rwx, int M) {
  long i = (long)blockIdx.x * blockDim.x + threadIdx.x;
  if (i >= (long)M * RWC) return;
  int c = i % RWC; long r = i / RWC; int lr = r % RB;
  bool first = (lr == 0) || (lr == SEQ), last = (lr == SEQ - 1) || (lr == RB - 1);
  float p = P[r * IN_COLS + RW_OFF + c];
  float pv = first ? 0.f : P[(r - 1) * IN_COLS + RW_OFF + c], nx = last ? 0.f : P[(r + 1) * IN_COLS + RW_OFF + c];
  rwx[i] = p + mu[c] * (pv - p) + mu[RWC + c] * (nx - p);
}
__global__ void nk_rw_prep(const float* rwx, const float* w0, const float* w2, const float* a0, const float* a2, const float* g2,
                           const float* k_k, const float* k_a, float* dec, float* kd, float* bd, float* kk, float* gg, int M) {
  long i = (long)blockIdx.x * blockDim.x + threadIdx.x;
  if (i >= (long)M * 384) return;
  int c = i % 384; long r = i / 384; int h = c / 64; const float* xr = rwx + r * RWC;
  float kv = xr[384 + c];
  float ss = 0.f; for (int n = 0; n < 64; ++n) { float t = xr[384 + h * 64 + n] * k_k[h * 64 + n]; ss += t * t; }
  float kkv = kv * k_k[c] / sqrtf(ss + 1e-12f);
  kk[i] = kkv;
  for (int d = 0; d < 2; ++d) {
    float wr = w0[d * 384 + c], ar = a0[d * 384 + c];
    for (int j = 0; j < 64; ++j) { wr += tanhf(xr[1152 + d * 64 + j]) * w2[(d * 64 + j) * 384 + c]; ar += xr[1280 + d * 64 + j] * a2[(d * 64 + j) * 384 + c]; }
    float dc = expf(-expf(-softplusf_(-wr) - 0.5f)); float a = sigmoidf_(ar);
    dec[(long)d * M * 384 + i] = dc; kd[(long)d * M * 384 + i] = kv * (1.f + (a - 1.f) * k_a[c]); bd[(long)d * M * 384 + i] = kkv * a;
  }
  float g = 0.f; for (int j = 0; j < 160; ++j) g += sigmoidf_(xr[1408 + j]) * g2[j * 384 + c];
  gg[i] = g;
}
__global__ void __launch_bounds__(256) nk_rw_scan(const float* rwx, const float* dec, const float* kd, const float* bd, const float* kk, float* y, int M, int nb) {
  long t = (long)blockIdx.x * blockDim.x + threadIdx.x;
  if (t >= (long)nb * 2 * 6 * 64) return;
  int i = t % 64, h = (t / 64) % 6, d = (t / 384) % 2, b = t / 768;
  float S[64];
#pragma unroll
  for (int j = 0; j < 64; ++j) S[j] = 0.f;
  for (int step = 0; step < RB; ++step) {
    int lr;
    if (step < CTX_LEN) lr = SEQ + (d == 0 ? step : CTX_LEN - 1 - step);
    else lr = d == 0 ? step - CTX_LEN : SEQ - 1 - (step - CTX_LEN);
    long r = (long)b * RB + lr; long o = (long)d * M * 384 + r * 384 + h * 64;
    const float* rp = rwx + r * RWC + h * 64; const float* wp = dec + o; const float* kp = kd + o; const float* bp = bd + o; const float* kkp = kk + r * 384 + h * 64;
    float vi = rwx[r * RWC + 768 + h * 64 + i];
    float skk = 0.f;
#pragma unroll
    for (int j = 0; j < 64; ++j) skk += S[j] * kkp[j];
    float yy = 0.f;
#pragma unroll
    for (int j = 0; j < 64; ++j) { S[j] = S[j] * wp[j] - skk * bp[j] + vi * kp[j]; yy += S[j] * rp[j]; }
    y[o + i] = yy;
  }
}
__global__ void nk_rw_readout(const float* rwx, const float* y, const float* kd, const float* gg, const float* r_k, const float* ln_g, const float* ln_b, float* mix, int M, long yds) {
  long i = (long)blockIdx.x * blockDim.x + threadIdx.x;
  if (i >= (long)M * 6) return;
  int h = i % 6; long r = i / 6; long o = r * 384 + h * 64; long ds = (long)M * 384;
  float mean = 0.f; for (int n = 0; n < 64; ++n) mean += y[o + n] + y[yds + o + n];
  mean /= 64.f;
  float var = 0.f, coef = 0.f;
  for (int n = 0; n < 64; ++n) {
    float yy = y[o + n] + y[yds + o + n] - mean; var += yy * yy;
    coef += rwx[r * RWC + h * 64 + n] * (kd[o + n] + kd[ds + o + n]) * r_k[h * 64 + n];
  }
  var /= 64.f; float inv = 1.f / sqrtf(var + 64e-5f);
  for (int n = 0; n < 64; ++n) {
    float yn = (y[o + n] + y[yds + o + n] - mean) * inv * ln_g[h * 64 + n] + ln_b[h * 64 + n];
    mix[r * DM + 256 + h * 64 + n] = (yn + coef * rwx[r * RWC + 768 + h * 64 + n]) * gg[o + n];
  }
}
__global__ void nk_gemm_res(const float* A, const float* W, const float* modl, int gi, float* xs, int M, int bidx) {
  long i = (long)blockIdx.x * blockDim.x + threadIdx.x;
  if (i >= (long)M * DM) return;
  int j = i % DM; long r = i / DM; int lr = r % RB; int bb = lr < SEQ ? bidx : BATCH;
  float acc = 0.f; for (int k = 0; k < DM; ++k) acc += A[r * DM + k] * W[(long)k * DM + j];
  xs[i] += modl[((long)bb * 6 + gi) * DM + j] * acc;
}
__global__ void nk_peer_score(const float* pq, const float* keys, float* sc, int M) {
  long i = (long)blockIdx.x * blockDim.x + threadIdx.x;
  if (i >= (long)M * 2048) return;
  int k = i % 128, ps = (i / 128) % 16; long r = i / 2048;
  const float* q = pq + r * 2048 + ps * 128; const float* ky = keys + ((long)ps * 128 + k) * 128;
  float acc = 0.f; for (int d = 0; d < 128; ++d) acc += q[d] * ky[d];
  sc[i] = acc;
}
__global__ void nk_peer_top1(const float* sc, float* ts, int* ti, int M) {
  long i = (long)blockIdx.x * blockDim.x + threadIdx.x;
  if (i >= (long)M * 16) return;
  const float* s = sc + i * 128; float pv = 3e38f; int pi = -1;
  for (int t = 0; t < 16; ++t) {
    float bv = -3e38f; int bi = -1;
    for (int k = 0; k < 128; ++k) {
      float v = s[k]; bool ok = (v < pv) || (v == pv && k > pi);
      if (ok && (bi < 0 || v > bv)) { bv = v; bi = k; }
    }
    ts[i * 16 + t] = bv; ti[i * 16 + t] = bi; pv = bv; pi = bi;
  }
}
__global__ void nk_peer_top2(const float* ts, const int* ti, int* pe, float* pg, int M) {
  long i = (long)blockIdx.x * blockDim.x + threadIdx.x;
  if (i >= (long)M * 8) return;
  const float* s1 = ts + i * 32; const float* s2 = s1 + 16; const int* i1 = ti + i * 32; const int* i2 = i1 + 16;
  float pv = 3e38f; int pi = -1; float mx = 0.f, sum = 0.f;
  for (int t = 0; t < 16; ++t) {
    float bv = -3e38f; int bi = -1;
    for (int c = 0; c < 256; ++c) {
      float v = s1[c / 16] + s2[c % 16]; bool ok = (v < pv) || (v == pv && c > pi);
      if (ok && (bi < 0 || v > bv)) { bv = v; bi = c; }
    }
    if (t == 0) mx = bv;
    float e = expf(bv - mx); sum += e;
    pe[i * 16 + t] = i1[bi / 16] * 128 + i2[bi % 16]; pg[i * 16 + t] = e; pv = bv; pi = bi;
  }
  for (int t = 0; t < 16; ++t) pg[i * 16 + t] /= sum;
}
__global__ void nk_peer_act(const float* xn, const float* u, const int* pe, const float* pg, float* pw, int M) {
  long i = (long)blockIdx.x * blockDim.x + threadIdx.x;
  if (i >= (long)M * 128) return;
  long r = i / 128; const float* ur = u + (long)pe[i] * DM; const float* xr = xn + r * DM;
  float acc = 0.f; for (int d = 0; d < DM; ++d) acc += xr[d] * ur[d];
  pw[i] = pg[i] * geluf_(acc);
}
__global__ void nk_peer_out(const float* v, const int* pe, const float* pw, const float* modl, float* xs, int M, int bidx) {
  long i = (long)blockIdx.x * blockDim.x + threadIdx.x;
  if (i >= (long)M * DM) return;
  int j = i % DM; long r = i / DM; int lr = r % RB; int bb = lr < SEQ ? bidx : BATCH;
  float acc = 0.f; for (int k = 0; k < 128; ++k) acc += pw[r * 128 + k] * v[(long)pe[r * 128 + k] * DM + j];
  xs[i] += modl[((long)bb * 6 + 5) * DM + j] * acc;
}


#ifndef PEER_EXP
#define PEER_EXP(x) expf(x)
#endif
__device__ __forceinline__ unsigned f2sortable(float s) { unsigned f = __float_as_uint(s); return (f & 0x80000000u) ? ~f : (f | 0x80000000u); }
__device__ __forceinline__ float sortable2f(unsigned o) { unsigned f = (o & 0x80000000u) ? (o & 0x7fffffffu) : ~o; return __uint_as_float(f); }
__device__ __forceinline__ unsigned enc_key(float s, int idx) { return (f2sortable(s) & ~127u) | (unsigned)(127 - idx); }
__device__ __forceinline__ void dec_key(unsigned k, float& s, int& idx) { idx = 127 - (int)(k & 127u); s = sortable2f(k & ~127u); }
__device__ __forceinline__ unsigned umax_(unsigned a, unsigned b) { return a > b ? a : b; }
__device__ __forceinline__ unsigned umin_(unsigned a, unsigned b) { return a < b ? a : b; }
__device__ __forceinline__ void ins16(unsigned (&l)[16], unsigned x) {
#pragma unroll
  for (int i = 0; i < 16; ++i) { unsigned mx = umax_(l[i], x); x = umin_(l[i], x); l[i] = mx; }
}
__device__ __forceinline__ void merge16(unsigned (&a)[16], const unsigned (&brev)[16]) {
#pragma unroll
  for (int i = 0; i < 16; ++i) a[i] = umax_(a[i], brev[i]);
#pragma unroll
  for (int d = 8; d >= 1; d >>= 1)
#pragma unroll
    for (int i = 0; i < 16; ++i) if ((i & d) == 0) { unsigned hi = umax_(a[i], a[i + d]), lo = umin_(a[i], a[i + d]); a[i] = hi; a[i + d] = lo; }
}
__device__ __forceinline__ void peer_combine(const unsigned* L0, const unsigned* L1, int* e_out, float* g_out) {
  float s0[16], s1[16];
#pragma unroll
  for (int i = 0; i < 16; ++i) { int ix; dec_key(L0[i], s0[i], ix); dec_key(L1[i], s1[i], ix); }
  unsigned sel[16];
#pragma unroll
  for (int i = 0; i < 16; ++i) sel[i] = 0u;
#pragma unroll
  for (int i = 0; i < 16; ++i)
#pragma unroll
    for (int j = 0; j < 16; ++j)
      if ((i + 1) * (j + 1) <= 16) { unsigned k = (f2sortable(s0[i] + s1[j]) & ~255u) | (unsigned)(255 - (i * 16 + j)); ins16(sel, k); }
  float mx = -3e38f;
#pragma unroll
  for (int t = 0; t < 16; ++t) {
    int c = 255 - (int)(sel[t] & 255u); int i = c >> 4, j = c & 15;
    float a, b; int ia, ib; dec_key(L0[i], a, ia); dec_key(L1[j], b, ib);
    float s = a + b; e_out[t] = ia * 128 + ib; g_out[t] = s; mx = fmaxf(mx, s);
  }
  float sum = 0.f;
#pragma unroll
  for (int t = 0; t < 16; ++t) { float e = PEER_EXP(g_out[t] - mx); g_out[t] = e; sum += e; }
  float inv = 1.f / sum;
#pragma unroll
  for (int t = 0; t < 16; ++t) g_out[t] *= inv;
}
__global__ void hk_peer_top1(const float* pq, const float* keys, unsigned* top1, int M) {
  long i = (long)blockIdx.x * blockDim.x + threadIdx.x;
  if (i >= (long)M * 16) return;
  int ps = i % 16; long r = i / 16; const float* q = pq + r * 2048 + ps * 128;
  unsigned la[16], lb[16], lbr[16];
#pragma unroll
  for (int t = 0; t < 16; ++t) { la[t] = 0u; lb[t] = 0u; }
  for (int k = 0; k < 128; ++k) {
    const float* ky = keys + ((long)ps * 128 + k) * 128; float acc = 0.f;
    for (int d = 0; d < 128; ++d) acc += q[d] * ky[d];
    unsigned key = enc_key(acc, k);
    if (k < 64) ins16(la, key); else ins16(lb, key);
  }
#pragma unroll
  for (int t = 0; t < 16; ++t) lbr[t] = lb[15 - t];
  merge16(la, lbr);
#pragma unroll
  for (int t = 0; t < 16; ++t) top1[i * 16 + t] = la[t];
}
__global__ void hk_peer_combine(const unsigned* top1, int* pe, float* pg, int M) {
  long i = (long)blockIdx.x * blockDim.x + threadIdx.x;
  if (i >= (long)M * 8) return;
  peer_combine(top1 + i * 32, top1 + i * 32 + 16, pe + i * 16, pg + i * 16);
}
typedef unsigned short bf16_t;
__device__ __forceinline__ int tid_opaque() { int t = threadIdx.x; asm volatile("" : "+v"(t)); return t; }
typedef __attribute__((ext_vector_type(8))) short bf16x8;
typedef __attribute__((ext_vector_type(4))) float f32x4;
typedef __attribute__((ext_vector_type(16))) float f32x16;
typedef __attribute__((ext_vector_type(4))) unsigned u32x4;

typedef __attribute__((ext_vector_type(2))) __bf16 bf16v2;
typedef __attribute__((ext_vector_type(2))) float f32v2;
template <int CTRL> __device__ __forceinline__ float dpp_get(float x) { return __builtin_bit_cast(float, __builtin_amdgcn_update_dpp(0, __builtin_bit_cast(int, x), CTRL, 0xf, 0xf, true)); }
__device__ __forceinline__ float swz_xor4(float x) { return __builtin_bit_cast(float, __builtin_amdgcn_ds_swizzle(__builtin_bit_cast(int, x), 0x101F)); }
__device__ __forceinline__ float xor4_get(float x) { const int xi = __builtin_bit_cast(int, x);
  int r = __builtin_amdgcn_update_dpp(xi, xi, 0x114, 0xf, 0xA, false); r = __builtin_amdgcn_update_dpp(r, xi, 0x104, 0xf, 0x5, false); return __builtin_bit_cast(float, r); }
__device__ __forceinline__ float xor16_sum(float x) { const unsigned xi = __builtin_bit_cast(unsigned, x); auto q = __builtin_amdgcn_permlane16_swap(xi, xi, false, false);
  return __builtin_bit_cast(float, (unsigned)q[0]) + __builtin_bit_cast(float, (unsigned)q[1]); }
__device__ __forceinline__ float xor32_sum(float x) { const unsigned xi = __builtin_bit_cast(unsigned, x); auto q = __builtin_amdgcn_permlane32_swap(xi, xi, false, false);
  return __builtin_bit_cast(float, (unsigned)q[0]) + __builtin_bit_cast(float, (unsigned)q[1]); }
__device__ __forceinline__ float xor32_max(float x) { const unsigned xi = __builtin_bit_cast(unsigned, x); auto q = __builtin_amdgcn_permlane32_swap(xi, xi, false, false);
  return fmaxf(__builtin_bit_cast(float, (unsigned)q[0]), __builtin_bit_cast(float, (unsigned)q[1])); }
__device__ __forceinline__ unsigned pack2bf(float a, float b) { f32v2 v = {a, b}; bf16v2 r = __builtin_convertvector(v, bf16v2); return __builtin_bit_cast(unsigned, r); }
__device__ __forceinline__ bf16_t f2bf(float f) { return (bf16_t)(pack2bf(f, 0.f) & 0xffffu); }
__device__ __forceinline__ float bf2f(bf16_t h) { return __uint_as_float(((unsigned)h) << 16); }

__device__ __forceinline__ float fexp_(float x) { return __builtin_amdgcn_exp2f(x * 1.4426950408889634f); }
__device__ __forceinline__ float frcp_(float x) { return __builtin_amdgcn_rcpf(x); }
__device__ __forceinline__ float fsigmoid_(float x) { return frcp_(1.f + fexp_(-x)); }
__device__ __forceinline__ float ftanh_(float x) { return 1.f - 2.f * frcp_(fexp_(2.f * x) + 1.f); }
__device__ __forceinline__ float fgelu_(float x) { return x * fsigmoid_(1.5957691216057308f * (x + 0.044715f * x * x * x)); }
__device__ __forceinline__ float fdecay_(float w) { return fexp_(-0.6065306597126334f * fsigmoid_(w)); }
#define GEMM_LDS_BYTES 32768
struct ALoadPlain { const bf16_t* A; int lda;
  __device__ __forceinline__ u32x4 operator()(int row, int k) const { return *(const u32x4*)(A + (long)row * lda + k); } };
#define GEMM_STAGE_WRITE(RA, RB) do { _Pragma("unroll") for (int i = 0; i < 4; ++i) { int r = lrow + 32 * i; int off = r * 128 + ((lchunk ^ (r & 7)) << 4); *(u32x4*)(As + off) = RA[i]; *(u32x4*)(Bs + off) = RB[i]; } } while (0)
#define GEMM_COMPUTE_TILE() do { _Pragma("unroll") for (int ks = 0; ks < 2; ++ks) { bf16x8 af[4], bfr[4]; \
    _Pragma("unroll") for (int i = 0; i < 4; ++i) { int r = wm * 64 + i * 16 + fr; af[i] = *(const bf16x8*)(As + r * 128 + (((ks * 4 + fq) ^ (r & 7)) << 4)); \
      int rn = wn * 64 + i * 16 + fr; bfr[i] = *(const bf16x8*)(Bs + rn * 128 + (((ks * 4 + fq) ^ (rn & 7)) << 4)); } \
    _Pragma("unroll") for (int i = 0; i < 4; ++i) _Pragma("unroll") for (int j = 0; j < 4; ++j) acc[i][j] = __builtin_amdgcn_mfma_f32_16x16x32_bf16(bfr[j], af[i], acc[i][j], 0, 0, 0); } } while (0)
template <class ALoad, class Epi>
__device__ __forceinline__ void gemm_tile_128(ALoad aload, const bf16_t* __restrict__ Bt, int ldb, int K,
                                              int tile_m, int tile_n, char* smem, Epi epi) {
  const int t = tid_opaque(), lane = t & 63, wave = t >> 6;
  const int wm = wave >> 1, wn = wave & 1;
  char* As = smem; char* Bs = smem + 16384;
  const int lrow = t >> 3, lchunk = t & 7;
  const int arow = tile_m * 128 + lrow;
  const bf16_t* bg = Bt + (long)(tile_n * 128 + lrow) * ldb + lchunk * 8;
  u32x4 ra0[4], rb0[4], ra1[4], rb1[4];
#pragma unroll
  for (int i = 0; i < 4; ++i) { ra0[i] = aload(arow + 32 * i, lchunk * 8); rb0[i] = *(const u32x4*)(bg + (long)(32 * i) * ldb); }
  if (K > 64) {
#pragma unroll
    for (int i = 0; i < 4; ++i) { ra1[i] = aload(arow + 32 * i, 64 + lchunk * 8); rb1[i] = *(const u32x4*)(bg + (long)(32 * i) * ldb + 64); }
  }
  f32x4 acc[4][4];
#pragma unroll
  for (int i = 0; i < 4; ++i)
#pragma unroll
    for (int j = 0; j < 4; ++j) acc[i][j] = (f32x4){0.f, 0.f, 0.f, 0.f};
  const int fr = lane & 15, fq = lane >> 4;
  for (int k0 = 0; k0 < K; k0 += 128) {
    __syncthreads();
    GEMM_STAGE_WRITE(ra0, rb0);
    __syncthreads();
    if (k0 + 128 < K) {
#pragma unroll
      for (int i = 0; i < 4; ++i) { ra0[i] = aload(arow + 32 * i, k0 + 128 + lchunk * 8); rb0[i] = *(const u32x4*)(bg + (long)(32 * i) * ldb + k0 + 128); }
    }
    GEMM_COMPUTE_TILE();
    if (k0 + 64 < K) {
      __syncthreads();
      GEMM_STAGE_WRITE(ra1, rb1);
      __syncthreads();
      if (k0 + 192 < K) {
#pragma unroll
        for (int i = 0; i < 4; ++i) { ra1[i] = aload(arow + 32 * i, k0 + 192 + lchunk * 8); rb1[i] = *(const u32x4*)(bg + (long)(32 * i) * ldb + k0 + 192); }
      }
      GEMM_COMPUTE_TILE();
    }
  }
#pragma unroll
  for (int i = 0; i < 4; ++i)
#pragma unroll
    for (int j = 0; j < 4; ++j) {
      int m = tile_m * 128 + wm * 64 + i * 16 + fr; int n0 = tile_n * 128 + wn * 64 + j * 16 + fq * 4;
      epi(m, n0, acc[i][j]);
    }
}

typedef __attribute__((address_space(3))) void lds_void_t;
typedef __attribute__((address_space(1))) const void glb_cvoid_t;
#define GEMM_GLDS_BYTES 65536
__device__ __forceinline__ void gemm_mainloop_glds(const bf16_t* __restrict__ A, int lda, const bf16_t* __restrict__ Bt, int ldb, int K,
                                                   int tile_m, int tile_n, char* smem, f32x4 (&acc)[4][4]) {
  const int t = tid_opaque(), lane = t & 63, wave = t >> 6;
  const int wm = wave >> 1, wn = wave & 1, fr = lane & 15, fq = lane >> 4;
  const int lrow = t >> 3, cl = (t & 7) ^ (lrow & 7);
  const bf16_t* ag = A + (long)(tile_m * 128 + lrow) * lda + cl * 8;
  const bf16_t* bg = Bt + (long)(tile_n * 128 + lrow) * ldb + cl * 8;
  const int wbase = __builtin_amdgcn_readfirstlane(wave) * 1024;
#pragma unroll
  for (int i = 0; i < 4; ++i)
#pragma unroll
    for (int j = 0; j < 4; ++j) acc[i][j] = (f32x4){0.f, 0.f, 0.f, 0.f};
  __syncthreads();
#pragma unroll
  for (int i = 0; i < 4; ++i) {
    __builtin_amdgcn_global_load_lds((glb_cvoid_t*)(ag + (long)(32 * i) * lda), (lds_void_t*)(smem + i * 4096 + wbase), 16, 0, 0);
    __builtin_amdgcn_global_load_lds((glb_cvoid_t*)(bg + (long)(32 * i) * ldb), (lds_void_t*)(smem + 16384 + i * 4096 + wbase), 16, 0, 0);
  }
  int buf = 0;
  for (int k0 = 0; k0 < K; k0 += 64, buf ^= 1) {
    __syncthreads();
    if (k0 + 64 < K) {
      char* nb = smem + (buf ^ 1) * 32768;
#pragma unroll
      for (int i = 0; i < 4; ++i) {
        __builtin_amdgcn_global_load_lds((glb_cvoid_t*)(ag + (long)(32 * i) * lda + k0 + 64), (lds_void_t*)(nb + i * 4096 + wbase), 16, 0, 0);
        __builtin_amdgcn_global_load_lds((glb_cvoid_t*)(bg + (long)(32 * i) * ldb + k0 + 64), (lds_void_t*)(nb + 16384 + i * 4096 + wbase), 16, 0, 0);
      }
    }
    const char* As = smem + buf * 32768; const char* Bs = As + 16384;
    GEMM_COMPUTE_TILE();
  }
}
template <class Epi>
__device__ __forceinline__ void gemm_tile_128_glds(const bf16_t* __restrict__ A, int lda, const bf16_t* __restrict__ Bt, int ldb, int K,
                                                   int tile_m, int tile_n, char* smem, Epi epi) {
  f32x4 acc[4][4];
  gemm_mainloop_glds(A, lda, Bt, ldb, K, tile_m, tile_n, smem, acc);
  const int t = tid_opaque(), lane = t & 63, wave = t >> 6, wm = wave >> 1, wn = wave & 1, fr = lane & 15, fq = lane >> 4;
#pragma unroll
  for (int i = 0; i < 4; ++i)
#pragma unroll
    for (int j = 0; j < 4; ++j) {
      int m = tile_m * 128 + wm * 64 + i * 16 + fr; int n0 = tile_n * 128 + wn * 64 + j * 16 + fq * 4;
      epi(m, n0, acc[i][j]);
    }
}

__global__ void ok_cvt_wT(const float* W, bf16_t* Wt, int K, int N, int Npad) {
  long i = (long)blockIdx.x * blockDim.x + threadIdx.x;
  if (i >= (long)Npad * K) return;
  int k = i % K; int n = i / K;
  Wt[i] = n < N ? f2bf(W[(long)k * N + n]) : (bf16_t)0;
}
__global__ void ok_f32_to_bf16(const float* s, bf16_t* d, long n) {
  long i = (long)blockIdx.x * blockDim.x + threadIdx.x; if (i < n) d[i] = f2bf(s[i]);
}
__global__ void ok_bf16_to_f32(const bf16_t* s, float* d, long n) {
  long i = (long)blockIdx.x * blockDim.x + threadIdx.x; if (i < n) d[i] = bf2f(s[i]);
}
__global__ void ok_norm_mod_bf16(const float* xs, const float* g, const float* modl, int shift_idx, bf16_t* xn, int M) {
  int row = blockIdx.x * 4 + (threadIdx.x >> 6); int lane = threadIdx.x & 63;
  if (row >= M) return;
  int b = row / RB, lr = row % RB; int bb = lr < SEQ ? b : BATCH;
  const float* sh = modl + ((long)bb * 6 + shift_idx) * DM; const float* sc = sh + DM;
  const float* xr = xs + (long)row * DM; float v[16]; float ss = 0.f;
#pragma unroll
  for (int i = 0; i < 4; ++i) { float4 q = *(const float4*)(xr + i * 256 + lane * 4); v[i*4]=q.x; v[i*4+1]=q.y; v[i*4+2]=q.z; v[i*4+3]=q.w; ss += q.x*q.x+q.y*q.y+q.z*q.z+q.w*q.w; }
#pragma unroll
  for (int o = 32; o > 0; o >>= 1) ss += __shfl_xor(ss, o);
  float inv = __builtin_amdgcn_rsqf(ss / DM + EPSN);
#pragma unroll
  for (int i = 0; i < 4; ++i) {
    int d = i * 256 + lane * 4; float o[4];
#pragma unroll
    for (int e = 0; e < 4; ++e) o[e] = v[i*4+e] * inv * g[d+e] * (1.f + sc[d+e]) + sh[d+e];
    uint2 pk; pk.x = pack2bf(o[0], o[1]); pk.y = pack2bf(o[2], o[3]);
    *(uint2*)(xn + (long)row * DM + d) = pk;
  }
}

struct EpiStoreBf16 { bf16_t* C; int ldc; int N;
  __device__ __forceinline__ void operator()(int m, int n0, f32x4 v) const {
    if (n0 < N) { uint2 pk; pk.x = pack2bf(v[0], v[1]); pk.y = pack2bf(v[2], v[3]); *(uint2*)(C + (long)m * ldc + n0) = pk; } } };
struct EpiStoreF32 { float* C; int ldc; int N;
  __device__ __forceinline__ void operator()(int m, int n0, f32x4 v) const {
    if (n0 < N) *(float4*)(C + (long)m * ldc + n0) = make_float4(v[0], v[1], v[2], v[3]); } };
struct EpiResid { float* xs; const float* modl; int gi; int pad;
  __device__ __forceinline__ void operator()(int m, int n0, f32x4 v) const {
    int b = m / RB, lr = m % RB; int bb = lr < SEQ ? b : BATCH; const float* g = modl + ((long)bb * 6 + gi) * DM + n0;
    float4 x = *(float4*)(xs + (long)m * DM + n0);
    x.x += g[0] * v[0]; x.y += g[1] * v[1]; x.z += g[2] * v[2]; x.w += g[3] * v[3];
    *(float4*)(xs + (long)m * DM + n0) = x; } };

template <class Epi>
__global__ void __launch_bounds__(256) ok_gemm(const bf16_t* A, int lda, const bf16_t* Bt, int ldb, int K, int tiles_m, int tiles_n, Epi epi) {
  __shared__ __attribute__((aligned(16))) char smem[GEMM_LDS_BYTES];
  for (int tile = blockIdx.x; tile < tiles_m * tiles_n; tile += gridDim.x) {
    int tm = tile / tiles_n, tn = tile % tiles_n;
    gemm_tile_128(ALoadPlain{A, lda}, Bt, ldb, K, tm, tn, smem, epi);
  }
}

__device__ __forceinline__ float dot2bf(unsigned a, unsigned b, float c) {
  return __builtin_amdgcn_fdot2_f32_bf16(*(bf16v2*)&a, *(bf16v2*)&b, c, false);
}
__global__ void ok_cvt_bf16_v8(const float* s, bf16_t* d, long n8) {
  long i = (long)blockIdx.x * blockDim.x + threadIdx.x; if (i >= n8) return;
  float4 a = *(const float4*)(s + i * 8), b = *(const float4*)(s + i * 8 + 4);
  u32x4 o; o[0] = pack2bf(a.x, a.y); o[1] = pack2bf(a.z, a.w); o[2] = pack2bf(b.x, b.y); o[3] = pack2bf(b.z, b.w);
  *(u32x4*)(d + i * 8) = o;
}

#define P5_LDS_BYTES (128 * 128 * 4)
__device__ __forceinline__ void peer_q_top1_tile(const bf16_t* __restrict__ A, const bf16_t* __restrict__ WqT, const bf16_t* __restrict__ keysb,
                                                 unsigned* __restrict__ top1, int tm, int ps, char* smem) {
  const int t = tid_opaque(), lane = t & 63, wave = t >> 6, wm = wave >> 1, wn = wave & 1, fr = lane & 15, fq = lane >> 4;
  f32x4 acc[4][4];
  gemm_mainloop_glds(A, DM, WqT, DM, DM, tm, ps, smem, acc);
  __syncthreads();
  char* Qs = smem; char* Ks = smem + 32768;
#pragma unroll
  for (int i = 0; i < 4; ++i)
#pragma unroll
    for (int j = 0; j < 4; ++j) {
      int m = wm * 64 + i * 16 + fr; int n0 = wn * 64 + j * 16 + fq * 4;
      uint2 pk; pk.x = pack2bf(acc[i][j][0], acc[i][j][1]); pk.y = pack2bf(acc[i][j][2], acc[i][j][3]);
      *(uint2*)(Qs + m * 256 + ((((n0 >> 3) ^ (m & 15)) << 4) | ((n0 & 7) << 1))) = pk;
    }
  {
    const bf16_t* kg = keysb + (long)ps * 128 * 128;
#pragma unroll
    for (int i = 0; i < 8; ++i) { int idx = t + 256 * i; int r = idx >> 4, c = idx & 15; *(u32x4*)(Ks + r * 256 + ((c ^ (r & 15)) << 4)) = *(const u32x4*)(kg + r * 128 + c * 8); }
  }
  __syncthreads();
#pragma unroll
  for (int i = 0; i < 4; ++i)
#pragma unroll
    for (int j = 0; j < 4; ++j) acc[i][j] = (f32x4){0.f, 0.f, 0.f, 0.f};
#pragma unroll
  for (int ks = 0; ks < 4; ++ks) {
    bf16x8 af[4], bfr[4];
#pragma unroll
    for (int i = 0; i < 4; ++i) {
      int r = wm * 64 + i * 16 + fr; af[i] = *(const bf16x8*)(Qs + r * 256 + (((ks * 4 + fq) ^ (r & 15)) << 4));
      int rn = wn * 64 + i * 16 + fr; bfr[i] = *(const bf16x8*)(Ks + rn * 256 + (((ks * 4 + fq) ^ (rn & 15)) << 4));
    }
#pragma unroll
    for (int i = 0; i < 4; ++i)
#pragma unroll
      for (int j = 0; j < 4; ++j) acc[i][j] = __builtin_amdgcn_mfma_f32_16x16x32_bf16(bfr[j], af[i], acc[i][j], 0, 0, 0);
  }
  __syncthreads();
  unsigned* Sc = (unsigned*)smem;
#pragma unroll
  for (int i = 0; i < 4; ++i)
#pragma unroll
    for (int j = 0; j < 4; ++j) {
      int m = wm * 64 + i * 16 + fr; int n0 = wn * 64 + j * 16 + fq * 4;
#pragma unroll
      for (int e = 0; e < 4; ++e) Sc[(n0 + e) * 128 + (m ^ ((((n0 + e) >> 2) & 1) << 4))] = enc_key(acc[i][j][e], n0 + e);
    }
  __syncthreads();
  {
    const int r = t & 127, half = t >> 7;
    unsigned l[16];
#pragma unroll
    for (int i = 0; i < 16; ++i) l[i] = 0u;
    for (int k = 0; k < 64; ++k) ins16(l, Sc[(half * 64 + k) * 128 + (r ^ (((k >> 2) & 1) << 4))]);
    __syncthreads();
    unsigned* Ls = (unsigned*)smem;
    if (half == 1) {
#pragma unroll
      for (int i = 0; i < 16; ++i) Ls[r * 17 + i] = l[15 - i];
    }
    __syncthreads();
    if (half == 0) {
      unsigned br[16];
#pragma unroll
      for (int i = 0; i < 16; ++i) br[i] = Ls[r * 17 + i];
      merge16(l, br);
      unsigned* o = top1 + ((long)(tm * 128 + r) * 16 + ps) * 16;
#pragma unroll
      for (int i = 0; i < 4; ++i) { u32x4 v; v[0] = l[4*i]; v[1] = l[4*i+1]; v[2] = l[4*i+2]; v[3] = l[4*i+3]; *(u32x4*)(o + 4 * i) = v; }
    }
  }
}
__global__ void __launch_bounds__(256) ok_peer_q_top1(const bf16_t* A, const bf16_t* WqT, const bf16_t* keysb, unsigned* top1, int tiles_m) {
  __shared__ __attribute__((aligned(16))) char smem[P5_LDS_BYTES];
  for (int tile = blockIdx.x; tile < tiles_m * 16; tile += gridDim.x) { peer_q_top1_tile(A, WqT, keysb, top1, tile / 16, tile % 16, smem); __syncthreads(); }
}

#define P6_LDS_BYTES (32 * 128 * 4 * 3)
__device__ __forceinline__ void peer_gather_group(const bf16_t* __restrict__ xn, const unsigned* __restrict__ top1, const bf16_t* __restrict__ ub,
                                                  const bf16_t* __restrict__ vb, const float* __restrict__ modl, float* __restrict__ xs, int grp, char* smem) {
  const int t = tid_opaque(), lane = t & 63, wave = t >> 6;
  int* pe_l = (int*)smem; float* pg_l = (float*)(smem + 32 * 128 * 4); float* pw_l = (float*)(smem + 2 * 32 * 128 * 4);
  {
    int tl = t >> 3, p = t & 7; long row = (long)grp * 32 + tl;
    peer_combine(top1 + (row * 16 + p * 2) * 16, top1 + (row * 16 + p * 2 + 1) * 16, pe_l + tl * 128 + p * 16, pg_l + tl * 128 + p * 16);
  }
  __syncthreads();
  for (int ti = 0; ti < 8; ++ti) {
    const int tl = wave * 8 + ti; const long row = (long)grp * 32 + tl;
    const int* pe = pe_l + tl * 128; float* pw = pw_l + tl * 128;
    u32x4 h0 = *(const u32x4*)(xn + row * DM + lane * 8), h1 = *(const u32x4*)(xn + row * DM + 512 + lane * 8);
    for (int b = 0; b < 16; ++b) {
      u32x4 u0[8], u1[8];
#pragma unroll
      for (int j = 0; j < 8; ++j) { const bf16_t* ur = ub + (long)pe[b * 8 + j] * DM + lane * 8; u0[j] = *(const u32x4*)ur; u1[j] = *(const u32x4*)(ur + 512); }
      float pd[8];
#pragma unroll
      for (int j = 0; j < 8; ++j) {
        float a = 0.f;
#pragma unroll
        for (int e = 0; e < 4; ++e) { a = dot2bf(h0[e], u0[j][e], a); a = dot2bf(h1[e], u1[j][e], a); }
        pd[j] = a;
      }
      float q4[4], q2[2], q1;
#pragma unroll
      for (int j = 0; j < 4; ++j) { bool hi = lane & 1; float keep = hi ? pd[2*j+1] : pd[2*j], send = hi ? pd[2*j] : pd[2*j+1]; q4[j] = keep + __shfl_xor(send, 1); }
#pragma unroll
      for (int j = 0; j < 2; ++j) { bool hi = lane & 2; float keep = hi ? q4[2*j+1] : q4[2*j], send = hi ? q4[2*j] : q4[2*j+1]; q2[j] = keep + __shfl_xor(send, 2); }
      { bool hi = lane & 4; float keep = hi ? q2[1] : q2[0], send = hi ? q2[0] : q2[1]; q1 = keep + __shfl_xor(send, 4); }
      q1 += __shfl_xor(q1, 8); q1 += __shfl_xor(q1, 16); q1 += __shfl_xor(q1, 32);
      if (lane < 8) { int j = lane & 7; pw[b * 8 + j] = q1; }
    }
    {
      float d0 = pw[lane], d1 = pw[64 + lane];
      pw[lane] = pg_l[tl * 128 + lane] * fgelu_(d0); pw[64 + lane] = pg_l[tl * 128 + 64 + lane] * fgelu_(d1);
    }
    float o[16];
#pragma unroll
    for (int e = 0; e < 16; ++e) o[e] = 0.f;
    for (int b = 0; b < 16; ++b) {
      u32x4 v0[8], v1[8];
#pragma unroll
      for (int j = 0; j < 8; ++j) { const bf16_t* vr = vb + (long)pe[b * 8 + j] * DM + lane * 8; v0[j] = *(const u32x4*)vr; v1[j] = *(const u32x4*)(vr + 512); }
#pragma unroll
      for (int j = 0; j < 8; ++j) {
        float w = pw[b * 8 + j];
#pragma unroll
        for (int e = 0; e < 4; ++e) {
          o[2*e]     += w * __uint_as_float(v0[j][e] << 16); o[2*e+1]     += w * __uint_as_float(v0[j][e] & 0xffff0000u);
          o[8 + 2*e] += w * __uint_as_float(v1[j][e] << 16); o[8 + 2*e+1] += w * __uint_as_float(v1[j][e] & 0xffff0000u);
        }
      }
    }
    {
      int b = row / RB, lr = row % RB; int bb = lr < SEQ ? b : BATCH; const float* g5 = modl + ((long)bb * 6 + 5) * DM;
      float* xr = xs + row * DM;
#pragma unroll
      for (int hf = 0; hf < 2; ++hf) {
        int d = hf * 512 + lane * 8;
        float4 x0 = *(float4*)(xr + d), x1 = *(float4*)(xr + d + 4); float4 g0 = *(const float4*)(g5 + d), g1 = *(const float4*)(g5 + d + 4);
        x0.x += g0.x * o[hf*8+0]; x0.y += g0.y * o[hf*8+1]; x0.z += g0.z * o[hf*8+2]; x0.w += g0.w * o[hf*8+3];
        x1.x += g1.x * o[hf*8+4]; x1.y += g1.y * o[hf*8+5]; x1.z += g1.z * o[hf*8+6]; x1.w += g1.w * o[hf*8+7];
        *(float4*)(xr + d) = x0; *(float4*)(xr + d + 4) = x1;
      }
    }
  }
}
__global__ void __launch_bounds__(256) ok_peer_gather(const bf16_t* xn, const unsigned* top1, const bf16_t* ub, const bf16_t* vb, const float* modl, float* xs, int ngroups) {
  __shared__ __attribute__((aligned(16))) char smem[P6_LDS_BYTES];
  for (int g = blockIdx.x; g < ngroups; g += gridDim.x) { peer_gather_group(xn, top1, ub, vb, modl, xs, g, smem); __syncthreads(); }
}

template <int DQ> struct AttnCfg { static constexpr int KROW = DQ * 2 + 16; static constexpr int VROW = 136; static constexpr int KBYTES = 64 * KROW; static constexpr int LDS = 64 * KROW + 64 * VROW; };
#define ATTN_LDS_BYTES (64 * 208 + 64 * 136)
template <int DQ>
__device__ __forceinline__ void attn_block(const bf16_t* __restrict__ qb, int HQ, const bf16_t* __restrict__ kb, int HK, const bf16_t* __restrict__ vT, int G,
                                           bf16_t* __restrict__ mixall, int ooff, int b, int head, int qt, char* smem, const float* __restrict__ qk_g) {
  constexpr int KROW = AttnCfg<DQ>::KROW, VROW = 136, NKK = DQ / 16, KCH = DQ / 8;
  constexpr int KLD = (64 * KCH) / 256;
  const int t = tid_opaque(), lane = t & 63, wave = t >> 6, lq = lane & 31, lh = lane >> 5;
  const int hk = head / G;
  char* Ks = smem; char* Vs = smem + 64 * KROW;
  float negC;
  { float gq = 0.f, gk = 0.f;
    for (int i = lane; i < DQ; i += 64) { gq = fmaxf(gq, fabsf(qk_g[i])); gk = fmaxf(gk, fabsf(qk_g[DQ + i])); }
#pragma unroll
    for (int o_ = 32; o_ > 0; o_ >>= 1) { gq = fmaxf(gq, __shfl_xor(gq, o_)); gk = fmaxf(gk, __shfl_xor(gk, o_)); }
    negC = -fminf(1.02f * 1.4426950408889634f * __builtin_amdgcn_sqrtf((float)DQ) * gq * gk, 60.f); }
  const long qrow = (long)b * RB + qt * 128 + wave * 32 + lq;
  bf16x8 qf[NKK];
#pragma unroll
  for (int kk = 0; kk < NKK; ++kk) qf[kk] = *(const bf16x8*)(qb + (qrow * HQ + head) * DQ + kk * 16 + lh * 8);
  const int key0 = qt < 16 ? 0 : SEQ; const int nt = qt < 16 ? RB / 64 : CTX_LEN / 64;
  const bf16_t* kp[KLD]; const bf16_t* vp_[2];
#pragma unroll
  for (int i = 0; i < KLD; ++i) { int c = t + 256 * i; int r = c / KCH, cc = c % KCH; kp[i] = kb + ((long)b * RB * HK + hk) * DQ + (long)(key0 + r) * HK * DQ + cc * 8; }
#pragma unroll
  for (int i = 0; i < 2; ++i) { int c = t + 256 * i; int r = c >> 3, cc = c & 7; vp_[i] = vT + ((long)(b * HK + hk) * 64 + r) * RB + key0 + cc * 8; }
  u32x4 rk[KLD], rv[2];
#pragma unroll
  for (int i = 0; i < KLD; ++i) { rk[i] = *(const u32x4*)kp[i]; kp[i] += 64 * HK * DQ; }
#pragma unroll
  for (int i = 0; i < 2; ++i) { rv[i] = *(const u32x4*)vp_[i]; vp_[i] += 64; }
  f32x16 ot[2];
#pragma unroll
  for (int d = 0; d < 2; ++d)
#pragma unroll
    for (int r = 0; r < 16; ++r) ot[d][r] = 0.f;
  float lrun = 0.f;
  for (int tile = 0; tile < nt; ++tile) {
    __syncthreads();
#pragma unroll
    for (int i = 0; i < KLD; ++i) { int c = t + 256 * i; int r = c / KCH, cc = c % KCH; *(u32x4*)(Ks + r * KROW + cc * 16) = rk[i]; }
#pragma unroll
    for (int i = 0; i < 2; ++i) { int c = t + 256 * i; int r = c >> 3, cc = c & 7; *(uint2*)(Vs + r * VROW + cc * 16) = make_uint2(rv[i][0], rv[i][1]); *(uint2*)(Vs + r * VROW + cc * 16 + 8) = make_uint2(rv[i][2], rv[i][3]); }
    __syncthreads();
    if (tile + 1 < nt) {
#pragma unroll
      for (int i = 0; i < KLD; ++i) { rk[i] = *(const u32x4*)kp[i]; kp[i] += 64 * HK * DQ; }
#pragma unroll
      for (int i = 0; i < 2; ++i) { rv[i] = *(const u32x4*)vp_[i]; vp_[i] += 64; }
    }
    f32x16 st[2];
#pragma unroll
    for (int kt = 0; kt < 2; ++kt) {
#pragma unroll
      for (int r = 0; r < 16; ++r) st[kt][r] = negC;
#pragma unroll
      for (int kk = 0; kk < NKK; ++kk) {
        bf16x8 ka = *(const bf16x8*)(Ks + (kt * 32 + lq) * KROW + kk * 32 + lh * 16);
        st[kt] = __builtin_amdgcn_mfma_f32_32x32x16_bf16(ka, qf[kk], st[kt], 0, 0, 0);
      }
    }
    float ps = 0.f;
#pragma unroll
    for (int kt = 0; kt < 2; ++kt)
#pragma unroll
      for (int r = 0; r < 16; ++r) { float p = __builtin_amdgcn_exp2f(st[kt][r]); st[kt][r] = p; ps += p; }
    lrun += ps;
#pragma unroll
    for (int kt = 0; kt < 2; ++kt)
#pragma unroll
      for (int s = 0; s < 2; ++s) {
        union { bf16x8 v; unsigned u[4]; } pb;
#pragma unroll
        for (int j = 0; j < 4; ++j) pb.u[j] = pack2bf(st[kt][8 * s + 2 * j], st[kt][8 * s + 2 * j + 1]);
#pragma unroll
        for (int d = 0; d < 2; ++d) {
          const char* vp = Vs + (d * 32 + lq) * VROW + (kt * 32 + 16 * s + 4 * lh) * 2;
          union { bf16x8 v; uint2 h[2]; } va; va.h[0] = *(const uint2*)vp; va.h[1] = *(const uint2*)(vp + 16);
          ot[d] = __builtin_amdgcn_mfma_f32_32x32x16_bf16(va.v, pb.v, ot[d], 0, 0, 0);
        }
      }
  }
  float ltot = xor32_sum(lrun); float inv = 1.f / ltot;
  bf16_t* orow = mixall + qrow * DM + ooff + head * 64;
#pragma unroll
  for (int d = 0; d < 2; ++d)
#pragma unroll
    for (int g = 0; g < 4; ++g) {
      uint2 pk; pk.x = pack2bf(ot[d][4 * g] * inv, ot[d][4 * g + 1] * inv); pk.y = pack2bf(ot[d][4 * g + 2] * inv, ot[d][4 * g + 3] * inv);
      *(uint2*)(orow + d * 32 + 8 * g + 4 * lh) = pk;
    }
}
__global__ void ok_adapt_rows(const float* src, int sld, int scol, int ncols, float scale, bf16_t* dst, int dld, int nrows) {
  long i = (long)blockIdx.x * blockDim.x + threadIdx.x; if (i >= (long)nrows * ncols) return;
  int c = i % ncols; long r = i / ncols; dst[r * dld + c] = f2bf(src[r * sld + scol + c] * scale);
}
__global__ void ok_adapt_vT(const float* src, int sld, int scol, int hstride, int H, bf16_t* dst) {
  long i = (long)blockIdx.x * blockDim.x + threadIdx.x; if (i >= (long)H * 64 * RB) return;
  int lr = i % RB; int d = (i / RB) % 64; int h = i / ((long)RB * 64);
  dst[i] = f2bf(src[(long)lr * sld + scol + h * hstride + d]);
}

typedef __attribute__((ext_vector_type(2))) float f32x2;
#define SCAN_TS 16
#define SCAN_LDS_BYTES (2 * SCAN_TS * 1536 + 2 * SCAN_TS * 32 * 4)
__device__ __forceinline__ float reduce8(float x) {
  x += __builtin_bit_cast(float, __builtin_amdgcn_update_dpp(0, __builtin_bit_cast(int, x), 0xB1, 0xf, 0xf, true));
  x += __builtin_bit_cast(float, __builtin_amdgcn_update_dpp(0, __builtin_bit_cast(int, x), 0x4E, 0xf, 0xf, true));
  x += __builtin_bit_cast(float, __builtin_amdgcn_update_dpp(0, __builtin_bit_cast(int, x), 0x141, 0xf, 0xf, true));
  return x;
}
__device__ __forceinline__ int scan_row(int dir, int s) {
  if (s < CTX_LEN) return SEQ + (dir == 0 ? s : CTX_LEN - 1 - s);
  return dir == 0 ? s - CTX_LEN : SEQ - 1 - (s - CTX_LEN);
}
__device__ __forceinline__ void rw_scan_block(const bf16_t* __restrict__ r_, const bf16_t* __restrict__ v_, const bf16_t* __restrict__ kk_, const bf16_t* __restrict__ kd_,
                                              const bf16_t* __restrict__ bd_, const float* __restrict__ w_, float* __restrict__ y_, int item, long dstride, char* smem) {
  const int t = tid_opaque(), lane = t & 63, wave = t >> 6, cg = lane & 7, il = wave * 8 + (lane >> 3);
  const int half = item & 1, dir = (item >> 1) & 1, h = (item >> 2) % 6, b = item / 24;
  const long rowbase = (long)b * RB; const int col0 = h * 64;
  float* ybuf = (float*)(smem + 2 * SCAN_TS * 1536);
  const int st_ld = t >> 4, part = t & 15;
  u32x4 la, lb, lc, lw;
  auto issue = [&](int c) {
    long row = rowbase + scan_row(dir, c * SCAN_TS + st_ld); long o = row * 384 + col0;
    const int ch = (part & 7) * 8;
    la = *(const u32x4*)((part < 8 ? kk_ + o : bd_ + dir * dstride + o) + ch);
    lb = *(const u32x4*)((part < 8 ? kd_ + dir * dstride + o : r_ + o) + ch);
    lc = *(const u32x4*)(v_ + o + ch);
    lw = *(const u32x4*)(w_ + dir * dstride + o + part * 4);
  };
  auto stash = [&](int buf) {
    float* base = (float*)(smem + buf * SCAN_TS * 1536 + st_ld * 1536);
    const int ch = (part & 7) * 8;
    float* pa = base + (part < 8 ? 64 : 128) + ch; float* pb = base + (part < 8 ? 192 : 256) + ch;
    f32x4 x0, x1;
#pragma unroll
    for (int e = 0; e < 2; ++e) { x0[2*e] = __uint_as_float(la[e] << 16); x0[2*e+1] = __uint_as_float(la[e] & 0xffff0000u); x1[2*e] = __uint_as_float(la[2+e] << 16); x1[2*e+1] = __uint_as_float(la[2+e] & 0xffff0000u); }
    *(f32x4*)pa = x0; *(f32x4*)(pa + 4) = x1;
#pragma unroll
    for (int e = 0; e < 2; ++e) { x0[2*e] = __uint_as_float(lb[e] << 16); x0[2*e+1] = __uint_as_float(lb[e] & 0xffff0000u); x1[2*e] = __uint_as_float(lb[2+e] << 16); x1[2*e+1] = __uint_as_float(lb[2+e] & 0xffff0000u); }
    *(f32x4*)pb = x0; *(f32x4*)(pb + 4) = x1;
    if (part < 8) {
      float* pc = base + 320 + ch;
#pragma unroll
      for (int e = 0; e < 2; ++e) { x0[2*e] = __uint_as_float(lc[e] << 16); x0[2*e+1] = __uint_as_float(lc[e] & 0xffff0000u); x1[2*e] = __uint_as_float(lc[2+e] << 16); x1[2*e+1] = __uint_as_float(lc[2+e] & 0xffff0000u); }
      *(f32x4*)pc = x0; *(f32x4*)(pc + 4) = x1;
    }
    *(u32x4*)(base + part * 4) = lw;
  };
  f32x2 S[4];
#pragma unroll
  for (int j = 0; j < 4; ++j) S[j] = (f32x2){0.f, 0.f};
  const int NCH = RB / SCAN_TS;
  __builtin_amdgcn_s_setprio(3);
  issue(0);
  for (int c = 0; c < NCH; ++c) {
    const int buf = c & 1;
    stash(buf);
    __syncthreads();
    if (c > 0 && t < 128) {
      int st = t >> 3, i4 = (t & 7) * 4; long row = rowbase + scan_row(dir, (c - 1) * SCAN_TS + st);
      *(f32x4*)(y_ + dir * dstride + row * 384 + col0 + half * 32 + i4) = *(const f32x4*)(ybuf + (buf ^ 1) * SCAN_TS * 32 + st * 32 + i4);
    }
    if (c + 1 < NCH) issue(c + 1);
    const float* ob = (const float*)(smem + buf * SCAN_TS * 1536) + cg * 8;
    const float* vb_ = (const float*)(smem + buf * SCAN_TS * 1536) + 320 + half * 32 + il;
    float yk[SCAN_TS];
    f32x4 nw0 = *(const f32x4*)(ob), nw1 = *(const f32x4*)(ob + 4), nk0 = *(const f32x4*)(ob + 64), nk1 = *(const f32x4*)(ob + 68);
    f32x4 nb0 = *(const f32x4*)(ob + 128), nb1 = *(const f32x4*)(ob + 132), nd0 = *(const f32x4*)(ob + 192), nd1 = *(const f32x4*)(ob + 196);
    f32x4 nr0 = *(const f32x4*)(ob + 256), nr1 = *(const f32x4*)(ob + 260); float nvi = vb_[0];
#pragma unroll
    for (int st = 0; st < SCAN_TS; ++st) {
      const f32x4 w0 = nw0, w1 = nw1, k0 = nk0, k1 = nk1, b0 = nb0, b1 = nb1, d0 = nd0, d1 = nd1, r0 = nr0, r1 = nr1; const float vi = nvi;
      if (st + 1 < SCAN_TS) {
        const float* o = ob + (st + 1) * 384;
        nw0 = *(const f32x4*)(o); nw1 = *(const f32x4*)(o + 4); nk0 = *(const f32x4*)(o + 64); nk1 = *(const f32x4*)(o + 68);
        nb0 = *(const f32x4*)(o + 128); nb1 = *(const f32x4*)(o + 132); nd0 = *(const f32x4*)(o + 192); nd1 = *(const f32x4*)(o + 196);
        nr0 = *(const f32x4*)(o + 256); nr1 = *(const f32x4*)(o + 260); nvi = vb_[(st + 1) * 384];
      }
      __builtin_amdgcn_sched_barrier(0);
      f32x2 a2 = S[0] * (f32x2){k0[0], k0[1]}, c2 = S[2] * (f32x2){k1[0], k1[1]};
      a2 += S[1] * (f32x2){k0[2], k0[3]}; c2 += S[3] * (f32x2){k1[2], k1[3]};
      a2 += c2;
      const f32x2 vv = (f32x2){vi, vi};
      f32x2 t0 = vv * (f32x2){d0[0], d0[1]}, t1 = vv * (f32x2){d0[2], d0[3]}, t2 = vv * (f32x2){d1[0], d1[1]}, t3 = vv * (f32x2){d1[2], d1[3]};
      float skk = reduce8(a2[0] + a2[1]);
      const f32x2 ns = (f32x2){-skk, -skk};
      t0 += ns * (f32x2){b0[0], b0[1]}; t1 += ns * (f32x2){b0[2], b0[3]}; t2 += ns * (f32x2){b1[0], b1[1]}; t3 += ns * (f32x2){b1[2], b1[3]};
      S[0] = S[0] * (f32x2){w0[0], w0[1]} + t0; S[1] = S[1] * (f32x2){w0[2], w0[3]} + t1; S[2] = S[2] * (f32x2){w1[0], w1[1]} + t2; S[3] = S[3] * (f32x2){w1[2], w1[3]} + t3;
      f32x2 y2 = S[0] * (f32x2){r0[0], r0[1]}, z2 = S[2] * (f32x2){r1[0], r1[1]};
      y2 += S[1] * (f32x2){r0[2], r0[3]}; z2 += S[3] * (f32x2){r1[2], r1[3]};
      y2 += z2;
      yk[st] = y2[0] + y2[1];
      __builtin_amdgcn_sched_barrier(0);
    }
#pragma unroll
    for (int g = 0; g < 2; ++g) {
      float q4[4], q2[2], q1;
#pragma unroll
      for (int j = 0; j < 4; ++j) { bool hi = cg & 1; float keep = hi ? yk[g*8 + 2*j+1] : yk[g*8 + 2*j], send = hi ? yk[g*8 + 2*j] : yk[g*8 + 2*j+1]; q4[j] = keep + dpp_get<0xB1>(send); }
#pragma unroll
      for (int j = 0; j < 2; ++j) { bool hi = cg & 2; float keep = hi ? q4[2*j+1] : q4[2*j], send = hi ? q4[2*j] : q4[2*j+1]; q2[j] = keep + dpp_get<0x4E>(send); }
      { bool hi = cg & 4; float keep = hi ? q2[1] : q2[0], send = hi ? q2[0] : q2[1]; q1 = keep + xor4_get(send); }
      ybuf[buf * SCAN_TS * 32 + (g * 8 + cg) * 32 + il] = q1;
    }
  }
  __builtin_amdgcn_s_setprio(0);
  __syncthreads();
  if (t < 128) {
    int st = t >> 3, i4 = (t & 7) * 4; long row = rowbase + scan_row(dir, (NCH - 1) * SCAN_TS + st);
    *(f32x4*)(y_ + dir * dstride + row * 384 + col0 + half * 32 + i4) = *(const f32x4*)(ybuf + ((NCH - 1) & 1) * SCAN_TS * 32 + st * 32 + i4);
  }
}
__global__ void __launch_bounds__(256) ok_rw_scan(const bf16_t* r_, const bf16_t* v_, const bf16_t* kk_, const bf16_t* kd_, const bf16_t* bd_, const float* w_, float* y_, int item0, int nitems, long dstride) {
  __shared__ __attribute__((aligned(16))) char smem[SCAN_LDS_BYTES];
  for (int it = item0 + blockIdx.x; it < item0 + nitems; it += gridDim.x) { rw_scan_block(r_, v_, kk_, kd_, bd_, w_, y_, it, dstride, smem); __syncthreads(); }
}
__global__ void ok_copy_rows_f32(const float* src, int sld, int scol, int ncols, float* dst, int dld, int nrows) {
  long i = (long)blockIdx.x * blockDim.x + threadIdx.x; if (i >= (long)nrows * ncols) return;
  int c = i % ncols; long r = i / ncols; dst[r * dld + c] = src[r * sld + scol + c];
}

__global__ void ok_cvt_wT_g(const float* W, const float* g, bf16_t* Wt, int K, int N, int Kpad) {
  long i = (long)blockIdx.x * blockDim.x + threadIdx.x;
  if (i >= (long)N * Kpad) return;
  int k = i % Kpad; int n = i / Kpad;
  Wt[i] = k < K ? f2bf(W[(long)k * N + n] * (g ? g[k] : 1.f)) : (bf16_t)0;
}
struct ALoadShift { const bf16_t* P; const float* mu; int col0; int mucol0; int act; int kvalid;
  __device__ __forceinline__ u32x4 operator()(int row, int k) const {
    u32x4 z = {0u, 0u, 0u, 0u};
    if (k >= kvalid) return z;
    int lr = row % RB; bool first = (lr == 0) || (lr == SEQ), last = (lr == SEQ - 1) || (lr == RB - 1);
    const bf16_t* p = P + (long)row * IN_COLS + col0 + k;
    u32x4 c = *(const u32x4*)p; u32x4 pv = first ? z : *(const u32x4*)(p - IN_COLS); u32x4 nx = last ? z : *(const u32x4*)(p + IN_COLS);
    const float* m0 = mu + mucol0 + k; const float* m1 = m0 + RWC;
    u32x4 o;
#pragma unroll
    for (int e = 0; e < 4; ++e) {
      float c0 = __uint_as_float(c[e] << 16), c1 = __uint_as_float(c[e] & 0xffff0000u);
      float p0 = __uint_as_float(pv[e] << 16), p1 = __uint_as_float(pv[e] & 0xffff0000u);
      float n0 = __uint_as_float(nx[e] << 16), n1 = __uint_as_float(nx[e] & 0xffff0000u);
      float x0 = c0 + m0[2*e] * (p0 - c0) + m1[2*e] * (n0 - c0), x1 = c1 + m0[2*e+1] * (p1 - c1) + m1[2*e+1] * (n1 - c1);
      if (act == 1) { x0 = ftanh_(x0); x1 = ftanh_(x1); } else if (act == 2) { x0 = fsigmoid_(x0); x1 = fsigmoid_(x1); }
      o[e] = pack2bf(x0, x1);
    }
    return o;
  } };
struct EpiDecay { float* w; const float* w0; int pad0; int pad1;
  __device__ __forceinline__ void operator()(int m, int n0, f32x4 v) const {
    f32x4 o;
#pragma unroll
    for (int e = 0; e < 4; ++e) o[e] = fdecay_(w0[n0 + e] + v[e]);
    *(f32x4*)(w + (long)m * 384 + n0) = o; } };
struct EpiSigA { bf16_t* a; const float* a0;
  __device__ __forceinline__ void operator()(int m, int n0, f32x4 v) const {
    uint2 pk; pk.x = pack2bf(fsigmoid_(a0[n0] + v[0]), fsigmoid_(a0[n0+1] + v[1])); pk.y = pack2bf(fsigmoid_(a0[n0+2] + v[2]), fsigmoid_(a0[n0+3] + v[3]));
    *(uint2*)(a + (long)m * 384 + n0) = pk; } };

struct PrepW { const bf16_t *wqbT, *wkvbT, *w2T, *a2T, *g2T; const float *mu, *w0, *a0; };
struct PrepBuf { const bf16_t* P; bf16_t *tq, *tkv, *a_b, *g_b; float* w_f; };
__device__ __forceinline__ void prep_gemm_tile(const PrepW& W, const PrepBuf& B, int tm, int ct, char* smem) {
  const long MA = NROWS;
  if (ct < 3) gemm_tile_128(ALoadPlain{B.P, IN_COLS}, W.wqbT, 256, 256, tm, ct, smem, EpiStoreBf16{B.tq, 384, 384});
  else if (ct < 7) gemm_tile_128(ALoadPlain{B.P + 256, IN_COLS}, W.wkvbT, 128, 128, tm, ct - 3, smem, EpiStoreBf16{B.tkv, 512, 512});
  else if (ct < 13) { int d = (ct - 7) / 3, tn = (ct - 7) % 3;
    gemm_tile_128(ALoadShift{B.P, W.mu, RW_OFF + 1152 + d * 64, 1152 + d * 64, 1, 64}, W.w2T + d * 384 * 64, 64, 64, tm, tn, smem, EpiDecay{B.w_f + d * MA * 384, W.w0 + d * 384, 0, 0}); }
  else if (ct < 19) { int d = (ct - 13) / 3, tn = (ct - 13) % 3;
    gemm_tile_128(ALoadShift{B.P, W.mu, RW_OFF + 1280 + d * 64, 1280 + d * 64, 0, 64}, W.a2T + d * 384 * 64, 64, 64, tm, tn, smem, EpiSigA{B.a_b + d * MA * 384, W.a0 + d * 384}); }
  else gemm_tile_128(ALoadShift{B.P, W.mu, RW_OFF + 1408, 1408, 2, 160}, W.g2T, 192, 192, tm, ct - 19, smem, EpiStoreBf16{B.g_b, 384, 384});
}
__global__ void __launch_bounds__(256) ok_prep_gemm(PrepW W, PrepBuf B) {
  __shared__ __attribute__((aligned(16))) char smem[GEMM_LDS_BYTES];
  for (int tile = blockIdx.x; tile < (NROWS / 128) * 22; tile += gridDim.x) prep_gemm_tile(W, B, tile / 22, tile % 22, smem);
}

__device__ __forceinline__ float wave_sum(float x) {
#pragma unroll
  for (int o = 32; o > 0; o >>= 1) x += __shfl_xor(x, o);
  return x;
}
__device__ __forceinline__ float ldbf(const bf16_t* p) { return bf2f(*p); }
struct FinW { const float *mla_qk_g, *gqa_qk_g, *mu, *k_k, *k_a; };
struct FinBuf { const bf16_t *P, *tq, *tkv, *a_b; bf16_t *mq, *mk, *mvT, *gq, *gk, *gvT, *r_b, *v_b, *kk_b, *kd_b, *bd_b; };
#define FIN_LDS_BYTES (384 * 132)
__device__ __forceinline__ void prep_finish_tile(const FinW& W, const FinBuf& B, int tile, char* smem) {
  const int t = tid_opaque(), lane = t & 63, wave = t >> 6; const long MA = NROWS;
  bf16_t* vbuf = (bf16_t*)smem;
  const long row0 = (long)tile * 64; const int b = row0 / RB; const int lr0 = row0 % RB;
  for (int it = 0; it < 16; ++it) {
    const int rl = it * 4 + wave; const long row = row0 + rl; const int lr = lr0 + rl; const bool lat = lr < SEQ;
    const bf16_t* Pr = B.P + row * IN_COLS;
    float sq = 0.f;
#pragma unroll
    for (int i = 0; i < 4; ++i) { float x = ldbf(Pr + i * 64 + lane); sq += x * x; }
    float skv = 0.f;
#pragma unroll
    for (int i = 0; i < 2; ++i) { float x = ldbf(Pr + 256 + i * 64 + lane); skv += x * x; }
    const float cq = __builtin_amdgcn_rsqf(wave_sum(sq) / 256.f + EPSN), ckv = __builtin_amdgcn_rsqf(wave_sum(skv) / 128.f + EPSN);
    const float krope = lane < 32 ? ldbf(Pr + 384 + lane) : 0.f;
    float cs_m = 1.f, sn_m = 0.f;
    { int j = lane & 15; int pos = j < 8 ? lr / 64 : lr % 64; float ang = (float)pos * powf(10000.f, -(float)(j & 7) / 8.f); if (lat) { cs_m = cosf(ang); sn_m = sinf(ang); } }
    const float* gq_ = W.mla_qk_g; const float* gk_ = W.mla_qk_g + 96;
#pragma unroll
    for (int h = 0; h < 4; ++h) {
      float qa = cq * ldbf(B.tq + row * 384 + h * 96 + lane); float qb = lane < 32 ? cq * ldbf(B.tq + row * 384 + h * 96 + 64 + lane) : 0.f;
      float inv = __builtin_amdgcn_rsqf(wave_sum(qa * qa + qb * qb) / 96.f + EPSN);
      qa *= inv * gq_[lane]; qb *= inv * (lane < 32 ? gq_[64 + lane] : 0.f);
      { float other = __shfl_xor(qb, 16); float rr = (lane & 16) ? (other * sn_m + qb * cs_m) : (qb * cs_m - other * sn_m); qb = rr; }
      const float qs = 0.14724445f;
      B.mq[row * 384 + h * 96 + lane] = f2bf(qa * qs); if (lane < 32) B.mq[row * 384 + h * 96 + 64 + lane] = f2bf(qb * qs);
      float ka = ckv * ldbf(B.tkv + row * 512 + h * 128 + lane); float kb = krope;
      float invk = __builtin_amdgcn_rsqf(wave_sum(ka * ka + kb * kb) / 96.f + EPSN);
      ka *= invk * gk_[lane]; kb *= invk * (lane < 32 ? gk_[64 + lane] : 0.f);
      { float other = __shfl_xor(kb, 16); float rr = (lane & 16) ? (other * sn_m + kb * cs_m) : (kb * cs_m - other * sn_m); kb = rr; }
      B.mk[row * 384 + h * 96 + lane] = f2bf(ka); if (lane < 32) B.mk[row * 384 + h * 96 + 64 + lane] = f2bf(kb);
      vbuf[(h * 64 + lane) * 66 + rl] = f2bf(ckv * ldbf(B.tkv + row * 512 + h * 128 + 64 + lane));
    }
    float cs_g = 1.f, sn_g = 0.f;
    { int j = lane & 31; int pos = j < 16 ? lr / 64 : lr % 64; float ang = (float)pos * powf(10000.f, -(float)(j & 15) / 16.f); if (lat) { cs_g = cosf(ang); sn_g = sinf(ang); } }
#pragma unroll
    for (int h = 0; h < 8; ++h) {
      float x = ldbf(Pr + GQA_OFF + h * 64 + lane);
      float inv = __builtin_amdgcn_rsqf(wave_sum(x * x) / 64.f + EPSN);
      x *= inv * W.gqa_qk_g[(h < 6 ? 0 : 64) + lane];
      float other = __shfl_xor(x, 32); float rr = (lane & 32) ? (other * sn_g + x * cs_g) : (x * cs_g - other * sn_g);
      if (h < 6) B.gq[row * 384 + h * 64 + lane] = f2bf(rr * 0.18033688f); else B.gk[row * 128 + (h - 6) * 64 + lane] = f2bf(rr);
    }
#pragma unroll
    for (int hk = 0; hk < 2; ++hk) vbuf[((4 + hk) * 64 + lane) * 66 + rl] = Pr[GQA_OFF + 512 + hk * 64 + lane];
    const bool first = (lr == 0) || (lr == SEQ), last = (lr == SEQ - 1) || (lr == RB - 1);
#pragma unroll
    for (int h = 0; h < 6; ++h) {
      float xs3[3];
#pragma unroll
      for (int part = 0; part < 3; ++part) {
        int c = part * 384 + h * 64 + lane; const bf16_t* pp = Pr + RW_OFF + c;
        float p = ldbf(pp), pv = first ? 0.f : ldbf(pp - IN_COLS), nx = last ? 0.f : ldbf(pp + IN_COLS);
        xs3[part] = p + W.mu[c] * (pv - p) + W.mu[RWC + c] * (nx - p);
      }
      const int c = h * 64 + lane; const long o = row * 384 + c;
      float kv = xs3[1]; float tk = kv * W.k_k[c]; float kkv = tk * __builtin_amdgcn_rsqf(wave_sum(tk * tk) + 1e-12f);
      B.r_b[o] = f2bf(xs3[0]); B.v_b[o] = f2bf(xs3[2]); B.kk_b[o] = f2bf(kkv);
#pragma unroll
      for (int d = 0; d < 2; ++d) { float a = ldbf(B.a_b + d * MA * 384 + o); B.kd_b[d * MA * 384 + o] = f2bf(kv * (1.f + (a - 1.f) * W.k_a[c])); B.bd_b[d * MA * 384 + o] = f2bf(kkv * a); }
    }
  }
  __syncthreads();
  for (int i = t; i < 384 * 32; i += 256) {
    int rr = i >> 5, w2 = i & 31; int slot = rr >> 6, d = rr & 63;
    unsigned val = *(const unsigned*)(vbuf + rr * 66 + w2 * 2);
    bf16_t* dst = slot < 4 ? B.mvT + ((long)(b * 4 + slot) * 64 + d) * RB : B.gvT + ((long)(b * 2 + (slot - 4)) * 64 + d) * RB;
    *(unsigned*)(dst + lr0 + w2 * 2) = val;
  }
  __syncthreads();
}
__global__ void __launch_bounds__(256) ok_prep_finish(FinW W, FinBuf B) {
  __shared__ __attribute__((aligned(16))) char smem[FIN_LDS_BYTES];
  for (int tile = blockIdx.x; tile < NROWS / 64; tile += gridDim.x) prep_finish_tile(W, B, tile, smem);
}
struct RdW { const float *r_k, *ln_g, *ln_b; };
__device__ __forceinline__ void rw_readout_row(const RdW& W, const float* __restrict__ y, const bf16_t* __restrict__ r_b, const bf16_t* __restrict__ v_b, const bf16_t* __restrict__ kd_b,
                                               const bf16_t* __restrict__ g_b, bf16_t* __restrict__ mixall, long row, int lane) {
  const long MA = NROWS;
#pragma unroll
  for (int h = 0; h < 6; ++h) {
    const int c = h * 64 + lane; const long o = row * 384 + c;
    float yy = y[o] + y[MA * 384 + o];
    float mean = wave_sum(yy) * (1.f / 64.f); float dv = yy - mean; float var = wave_sum(dv * dv) * (1.f / 64.f);
    float coef = wave_sum(ldbf(r_b + o) * (ldbf(kd_b + o) + ldbf(kd_b + MA * 384 + o)) * W.r_k[c]);
    float yn = dv * __builtin_amdgcn_rsqf(var + 64e-5f) * W.ln_g[c] + W.ln_b[c];
    mixall[row * DM + 256 + c] = f2bf((yn + coef * ldbf(v_b + o)) * ldbf(g_b + o));
  }
}
__global__ void __launch_bounds__(256) ok_rw_readout(RdW W, const float* y, const bf16_t* r_b, const bf16_t* v_b, const bf16_t* kd_b, const bf16_t* g_b, bf16_t* mixall) {
  for (long row = blockIdx.x * 4 + (threadIdx.x >> 6); row < NROWS; row += gridDim.x * 4) rw_readout_row(W, y, r_b, v_b, kd_b, g_b, mixall, row, threadIdx.x & 63);
}

__device__ __forceinline__ void ph_cvt_fp8_rows(const float* __restrict__ tab, unsigned char* __restrict__ q, float* __restrict__ scale, int r0 = -1, int r1 = 0) {
  const int t = tid_opaque(); const int lane = t & 63;
  const int rbeg = r0 < 0 ? (int)blockIdx.x * 4 + (t >> 6) : r0 + (t >> 6), rend = r0 < 0 ? 16384 : r1, rstep = r0 < 0 ? (int)gridDim.x * 4 : 4;
  for (int row = rbeg; row < rend; row += rstep) {
    const float* src = tab + (long)row * DM + lane * 16;
    f32x4 a[4]; float m = 0.f;
#pragma unroll
    for (int i = 0; i < 4; ++i) { a[i] = *(const f32x4*)(src + 4 * i); m = fmaxf(m, fmaxf(fmaxf(fabsf(a[i][0]), fabsf(a[i][1])), fmaxf(fabsf(a[i][2]), fabsf(a[i][3])))); }
#pragma unroll
    for (int o = 32; o > 0; o >>= 1) m = fmaxf(m, __shfl_xor(m, o));
    const float sc = m > 0.f ? m * (1.f / 440.f) : 1.f; const float inv = 1.f / sc;
    u32x4 p;
#pragma unroll
    for (int i = 0; i < 4; ++i) { int w = __builtin_amdgcn_cvt_pk_fp8_f32(a[i][0] * inv, a[i][1] * inv, 0, false); w = __builtin_amdgcn_cvt_pk_fp8_f32(a[i][2] * inv, a[i][3] * inv, w, true); p[i] = (unsigned)w; }
    *(u32x4*)(q + (long)row * DM + lane * 16) = p;
    if (lane == 0) scale[row] = sc;
  }
}
__device__ __forceinline__ float dot16_fp8(const float (&h)[16], u32x4 q) {
  float a = 0.f;
#pragma unroll
  for (int d = 0; d < 4; ++d) {
    f32v2 lo = __builtin_amdgcn_cvt_pk_f32_fp8((int)q[d], false), hi = __builtin_amdgcn_cvt_pk_f32_fp8((int)q[d], true);
    a += h[4*d] * lo[0]; a += h[4*d+1] * lo[1]; a += h[4*d+2] * hi[0]; a += h[4*d+3] * hi[1];
  }
  return a;
}
__device__ __forceinline__ void axpy16_fp8(float (&o)[16], float w, u32x4 q) {
#pragma unroll
  for (int d = 0; d < 4; ++d) {
    f32v2 lo = __builtin_amdgcn_cvt_pk_f32_fp8((int)q[d], false), hi = __builtin_amdgcn_cvt_pk_f32_fp8((int)q[d], true);
    o[4*d] += w * lo[0]; o[4*d+1] += w * lo[1]; o[4*d+2] += w * hi[0]; o[4*d+3] += w * hi[1];
  }
}
__device__ __forceinline__ void peer_gather_group_fp8(const bf16_t* __restrict__ xn, const unsigned* __restrict__ top1, const unsigned char* __restrict__ ub, const float* __restrict__ su,
                                                      const unsigned char* __restrict__ vb, const float* __restrict__ sv, const float* __restrict__ modl, float* __restrict__ xs, int grp, char* smem) {
  const int t = tid_opaque(), lane = t & 63, wave = t >> 6;
  int* pe_l = (int*)smem; float* pg_l = (float*)(smem + 32 * 128 * 4); float* pw_l = (float*)(smem + 2 * 32 * 128 * 4);
  {
    int tl = t >> 3, p = t & 7; long row = (long)grp * 32 + tl;
    peer_combine(top1 + (row * 16 + p * 2) * 16, top1 + (row * 16 + p * 2 + 1) * 16, pe_l + tl * 128 + p * 16, pg_l + tl * 128 + p * 16);
  }
  __syncthreads();
  for (int ti = 0; ti < 8; ++ti) {
    const int tl = wave * 8 + ti; const long row = (long)grp * 32 + tl;
    const int* pe = pe_l + tl * 128; float* pw = pw_l + tl * 128;
    float h[16];
    { u32x4 h0 = *(const u32x4*)(xn + row * DM + lane * 16), h1 = *(const u32x4*)(xn + row * DM + lane * 16 + 8);
#pragma unroll
      for (int e = 0; e < 4; ++e) { h[2*e] = __uint_as_float(h0[e] << 16); h[2*e+1] = __uint_as_float(h0[e] & 0xffff0000u); h[8+2*e] = __uint_as_float(h1[e] << 16); h[8+2*e+1] = __uint_as_float(h1[e] & 0xffff0000u); } }
    u32x4 u[8];
#pragma unroll
    for (int j = 0; j < 8; ++j) u[j] = *(const u32x4*)(ub + (long)pe[j] * DM + lane * 16);
    for (int b = 0; b < 16; ++b) {
      float pd[8];
#pragma unroll
      for (int j = 0; j < 8; ++j) pd[j] = dot16_fp8(h, u[j]);
      if (b + 1 < 16) {
#pragma unroll
        for (int j = 0; j < 8; ++j) u[j] = *(const u32x4*)(ub + (long)pe[(b + 1) * 8 + j] * DM + lane * 16);
      }
      float q4[4], q2[2], q1;
#pragma unroll
      for (int j = 0; j < 4; ++j) { bool hi = lane & 1; float keep = hi ? pd[2*j+1] : pd[2*j], send = hi ? pd[2*j] : pd[2*j+1]; q4[j] = keep + __shfl_xor(send, 1); }
#pragma unroll
      for (int j = 0; j < 2; ++j) { bool hi = lane & 2; float keep = hi ? q4[2*j+1] : q4[2*j], send = hi ? q4[2*j] : q4[2*j+1]; q2[j] = keep + __shfl_xor(send, 2); }
      { bool hi = lane & 4; float keep = hi ? q2[1] : q2[0], send = hi ? q2[0] : q2[1]; q1 = keep + __shfl_xor(send, 4); }
      q1 += __shfl_xor(q1, 8); q1 += __shfl_xor(q1, 16); q1 += __shfl_xor(q1, 32);
      if (lane < 8) pw[b * 8 + lane] = q1 * su[pe[b * 8 + lane]];
    }
    u32x4 v[8];
#pragma unroll
    for (int j = 0; j < 8; ++j) v[j] = *(const u32x4*)(vb + (long)pe[j] * DM + lane * 16);
    {
      float d0 = pw[lane], d1 = pw[64 + lane];
      pw[lane] = pg_l[tl * 128 + lane] * fgelu_(d0) * sv[pe[lane]]; pw[64 + lane] = pg_l[tl * 128 + 64 + lane] * fgelu_(d1) * sv[pe[64 + lane]];
    }
    float o[16];
#pragma unroll
    for (int e = 0; e < 16; ++e) o[e] = 0.f;
    for (int b = 0; b < 16; ++b) {
      u32x4 vc[8];
#pragma unroll
      for (int j = 0; j < 8; ++j) vc[j] = v[j];
      if (b + 1 < 16) {
#pragma unroll
        for (int j = 0; j < 8; ++j) v[j] = *(const u32x4*)(vb + (long)pe[(b + 1) * 8 + j] * DM + lane * 16);
      }
#pragma unroll
      for (int j = 0; j < 8; ++j) axpy16_fp8(o, pw[b * 8 + j], vc[j]);
    }
    {
      int b = row / RB, lr = row % RB; int bb = lr < SEQ ? b : BATCH; const float* g5 = modl + ((long)bb * 6 + 5) * DM + lane * 16;
      float* xr = xs + row * DM + lane * 16;
#pragma unroll
      for (int i = 0; i < 4; ++i) {
        f32x4 x = *(f32x4*)(xr + 4 * i); f32x4 g = *(const f32x4*)(g5 + 4 * i);
        x[0] += g[0] * o[4*i]; x[1] += g[1] * o[4*i+1]; x[2] += g[2] * o[4*i+2]; x[3] += g[3] * o[4*i+3];
        *(f32x4*)(xr + 4 * i) = x;
      }
    }
  }
}

__device__ __forceinline__ float reduce16(float x) { x = reduce8(x); x += dpp_get<0x140>(x); return x; }
__device__ __forceinline__ void unpack8(u32x4 v, float (&f)[8]) {
#pragma unroll
  for (int e = 0; e < 4; ++e) { f[2*e] = __uint_as_float(v[e] << 16); f[2*e+1] = __uint_as_float(v[e] & 0xffff0000u); }
}
__device__ __forceinline__ u32x4 pack8(const float (&f)[8]) { u32x4 o;
#pragma unroll
  for (int e = 0; e < 4; ++e) o[e] = pack2bf(f[2*e], f[2*e+1]);
  return o; }
__device__ __forceinline__ void ph_rope_tables(float* rope_g, float* rope_m) {
  const int t = tid_opaque();
  for (int i = blockIdx.x * 256 + t; i < SEQ * 48; i += gridDim.x * 256) {
    int lr = i / 48, j = i % 48;
    if (j < 32) { int pos = j < 16 ? lr / 64 : lr % 64; float ang = (float)pos * powf(10000.f, -(float)(j & 15) / 16.f); rope_g[(lr * 32 + j) * 2] = cosf(ang); rope_g[(lr * 32 + j) * 2 + 1] = sinf(ang); }
    else { int jj = j - 32; int pos = jj < 8 ? lr / 64 : lr % 64; float ang = (float)pos * powf(10000.f, -(float)(jj & 7) / 8.f); rope_m[(lr * 16 + jj) * 2] = cosf(ang); rope_m[(lr * 16 + jj) * 2 + 1] = sinf(ang); }
  }
}
struct FinW2 { const float *mla_qk_g, *gqa_qk_g, *mu, *k_k, *k_a, *rope_g, *rope_m; };
#define FIN2_LDS_BYTES (64 * 384 * 2)
__device__ __forceinline__ void prep_finish_tile2(const FinW2& W, const FinBuf& B, int tile, char* smem) {
  const int t = tid_opaque(), lane = t & 63, wave = t >> 6; const long MA = NROWS;
  bf16_t* vbuf = (bf16_t*)smem;
  const long row0 = (long)tile * 8; const int b = row0 / RB; const int lr0 = row0 % RB;
  const int g8 = lane & 7, h8 = lane >> 3, s16 = lane & 15, h16 = lane >> 4;
  for (int it = 0; it < 2; ++it) {
    const int rl = it * 4 + wave; const long row = row0 + rl; const int lr = lr0 + rl; const bool lat = lr < SEQ;
    const bf16_t* Pr = B.P + row * IN_COLS;
    {
      float x[8]; unpack8(*(const u32x4*)(Pr + GQA_OFF + lane * 8), x);
      float ss = 0.f;
#pragma unroll
      for (int e = 0; e < 8; ++e) ss += x[e] * x[e];
      ss = reduce8(ss); const float inv = __builtin_amdgcn_rsqf(ss * (1.f / 64.f) + EPSN);
      const float* gp = W.gqa_qk_g + (h8 < 6 ? 0 : 64) + g8 * 8; f32x4 ga = *(const f32x4*)gp, gb = *(const f32x4*)(gp + 4);
#pragma unroll
      for (int e = 0; e < 4; ++e) { x[e] *= inv * ga[e]; x[4 + e] *= inv * gb[e]; }
      float o[8];
      if (lat) {
        const float* rt = W.rope_g + ((long)lr * 32 + (g8 & 3) * 8) * 2;
#pragma unroll
        for (int e = 0; e < 8; ++e) { float ot = swz_xor4(x[e]); float cs = rt[2 * e], sn = rt[2 * e + 1]; o[e] = (g8 & 4) ? (ot * sn + x[e] * cs) : (x[e] * cs - ot * sn); }
      } else {
#pragma unroll
        for (int e = 0; e < 8; ++e) o[e] = x[e];
      }
      if (h8 < 6) {
#pragma unroll
        for (int e = 0; e < 8; ++e) o[e] *= 0.18033688f;
        *(u32x4*)(B.gq + row * 384 + lane * 8) = pack8(o);
      } else *(u32x4*)(B.gk + row * 128 + (lane - 48) * 8) = pack8(o);
    }
    float cq, ckv;
    {
      float ss = 0.f;
      if (lane < 48) { float x[8]; unpack8(*(const u32x4*)(Pr + lane * 8), x);
#pragma unroll
        for (int e = 0; e < 8; ++e) ss += x[e] * x[e]; }
      float sq = wave_sum(lane < 32 ? ss : 0.f), skv = wave_sum(lane >= 32 ? ss : 0.f);
      cq = __builtin_amdgcn_rsqf(sq * (1.f / 256.f) + EPSN); ckv = __builtin_amdgcn_rsqf(skv * (1.f / 128.f) + EPSN);
    }
    {
      float cs0 = 1.f, sn0 = 0.f, cs1 = 1.f, sn1 = 0.f;
      if (lat) { f32x4 r4 = *(const f32x4*)(W.rope_m + ((long)lr * 16 + (s16 & 7) * 2) * 2); cs0 = r4[0]; sn0 = r4[1]; cs1 = r4[2]; sn1 = r4[3]; }
      const float kr0 = bf2f(Pr[384 + s16 * 2]), kr1 = bf2f(Pr[384 + s16 * 2 + 1]);
#pragma unroll
      for (int which = 0; which < 2; ++which) {
        float n[4], r0, r1;
        if (which == 0) {
          uint2 a = *(const uint2*)(B.tq + row * 384 + h16 * 96 + s16 * 4); unsigned rr = *(const unsigned*)(B.tq + row * 384 + h16 * 96 + 64 + s16 * 2);
          n[0] = cq * __uint_as_float(a.x << 16); n[1] = cq * __uint_as_float(a.x & 0xffff0000u); n[2] = cq * __uint_as_float(a.y << 16); n[3] = cq * __uint_as_float(a.y & 0xffff0000u);
          r0 = cq * __uint_as_float(rr << 16); r1 = cq * __uint_as_float(rr & 0xffff0000u);
        } else {
          uint2 a = *(const uint2*)(B.tkv + row * 512 + h16 * 128 + s16 * 4);
          n[0] = ckv * __uint_as_float(a.x << 16); n[1] = ckv * __uint_as_float(a.x & 0xffff0000u); n[2] = ckv * __uint_as_float(a.y << 16); n[3] = ckv * __uint_as_float(a.y & 0xffff0000u);
          r0 = kr0; r1 = kr1;
        }
        float ss = n[0]*n[0] + n[1]*n[1] + n[2]*n[2] + n[3]*n[3] + r0*r0 + r1*r1;
        ss = reduce16(ss); const float inv = __builtin_amdgcn_rsqf(ss * (1.f / 96.f) + EPSN);
        const float* gp = W.mla_qk_g + which * 96; f32x4 gn = *(const f32x4*)(gp + s16 * 4); const float g0 = gp[64 + s16 * 2], g1 = gp[64 + s16 * 2 + 1];
#pragma unroll
        for (int e = 0; e < 4; ++e) n[e] *= inv * gn[e];
        r0 *= inv * g0; r1 *= inv * g1;
        float o0 = dpp_get<0x128>(r0), o1 = dpp_get<0x128>(r1);
        float q0, q1;
        if (s16 & 8) { q0 = o0 * sn0 + r0 * cs0; q1 = o1 * sn1 + r1 * cs1; } else { q0 = r0 * cs0 - o0 * sn0; q1 = r1 * cs1 - o1 * sn1; }
        const float sc = which == 0 ? 0.14724445f : 1.f;
        bf16_t* dst = (which == 0 ? B.mq : B.mk) + row * 384 + h16 * 96;
        uint2 pk; pk.x = pack2bf(n[0] * sc, n[1] * sc); pk.y = pack2bf(n[2] * sc, n[3] * sc);
        *(uint2*)(dst + s16 * 4) = pk; *(unsigned*)(dst + 64 + s16 * 2) = pack2bf(q0 * sc, q1 * sc);
      }
      if (lane < 32) { float x[8]; unpack8(*(const u32x4*)(B.tkv + row * 512 + h8 * 128 + 64 + g8 * 8), x);
#pragma unroll
        for (int e = 0; e < 8; ++e) x[e] *= ckv;
        *(u32x4*)(vbuf + rl * 384 + h8 * 64 + g8 * 8) = pack8(x); }
      else if (lane < 48) *(u32x4*)(vbuf + rl * 384 + 256 + (lane - 32) * 8) = *(const u32x4*)(Pr + GQA_OFF + 512 + (lane - 32) * 8);
    }
    if (lane < 48) {
      const bool first = (lr == 0) || (lr == SEQ), last = (lr == SEQ - 1) || (lr == RB - 1);
      const long o = row * 384 + lane * 8;
      float xs3[3][8];
#pragma unroll
      for (int part = 0; part < 3; ++part) {
        const int c = part * 384 + lane * 8; const bf16_t* pp = Pr + RW_OFF + c;
        float p[8], pv[8], nx[8]; unpack8(*(const u32x4*)pp, p);
        u32x4 z = {0u, 0u, 0u, 0u}; unpack8(first ? z : *(const u32x4*)(pp - IN_COLS), pv); unpack8(last ? z : *(const u32x4*)(pp + IN_COLS), nx);
        f32x4 m0a = *(const f32x4*)(W.mu + c), m0b = *(const f32x4*)(W.mu + c + 4), m1a = *(const f32x4*)(W.mu + RWC + c), m1b = *(const f32x4*)(W.mu + RWC + c + 4);
#pragma unroll
        for (int e = 0; e < 4; ++e) { xs3[part][e] = p[e] + m0a[e] * (pv[e] - p[e]) + m1a[e] * (nx[e] - p[e]); xs3[part][4+e] = p[4+e] + m0b[e] * (pv[4+e] - p[4+e]) + m1b[e] * (nx[4+e] - p[4+e]); }
      }
      *(u32x4*)(B.r_b + o) = pack8(xs3[0]); *(u32x4*)(B.v_b + o) = pack8(xs3[2]);
      f32x4 kka = *(const f32x4*)(W.k_k + lane * 8), kkb = *(const f32x4*)(W.k_k + lane * 8 + 4), kaa = *(const f32x4*)(W.k_a + lane * 8), kab = *(const f32x4*)(W.k_a + lane * 8 + 4);
      float tk[8], ss = 0.f;
#pragma unroll
      for (int e = 0; e < 4; ++e) { tk[e] = xs3[1][e] * kka[e]; tk[4+e] = xs3[1][4+e] * kkb[e]; }
#pragma unroll
      for (int e = 0; e < 8; ++e) ss += tk[e] * tk[e];
      ss = reduce8(ss); const float invk = __builtin_amdgcn_rsqf(ss + 1e-12f);
#pragma unroll
      for (int e = 0; e < 8; ++e) tk[e] *= invk;
      *(u32x4*)(B.kk_b + o) = pack8(tk);
#pragma unroll
      for (int d = 0; d < 2; ++d) {
        float a[8], kd[8], bd[8]; unpack8(*(const u32x4*)(B.a_b + d * MA * 384 + o), a);
#pragma unroll
        for (int e = 0; e < 8; ++e) { float ka = e < 4 ? kaa[e] : kab[e - 4]; kd[e] = xs3[1][e] * (1.f + (a[e] - 1.f) * ka); bd[e] = tk[e] * a[e]; }
        *(u32x4*)(B.kd_b + d * MA * 384 + o) = pack8(kd); *(u32x4*)(B.bd_b + d * MA * 384 + o) = pack8(bd);
      }
    } else { (void)reduce8(0.f); }
  }
  __syncthreads();
  for (int i = t; i < 384; i += 256) {
    int c = i % 384, rc = i / 384;
    unsigned short v8[8];
#pragma unroll
    for (int e = 0; e < 8; ++e) v8[e] = vbuf[(rc * 8 + e) * 384 + c];
    u32x4 o; o[0] = v8[0] | ((unsigned)v8[1] << 16); o[1] = v8[2] | ((unsigned)v8[3] << 16); o[2] = v8[4] | ((unsigned)v8[5] << 16); o[3] = v8[6] | ((unsigned)v8[7] << 16);
    bf16_t* dst = c < 256 ? B.mvT + ((long)(b * 4 + (c >> 6)) * 64 + (c & 63)) * RB : B.gvT + ((long)(b * 2 + ((c - 256) >> 6)) * 64 + (c & 63)) * RB;
    *(u32x4*)(dst + lr0 + rc * 8) = o;
  }
  __syncthreads();
}
__device__ __forceinline__ void rw_readout_row2(const RdW& W, const float* __restrict__ y, const bf16_t* __restrict__ r_b, const bf16_t* __restrict__ v_b, const bf16_t* __restrict__ kd_b,
                                                const bf16_t* __restrict__ g_b, bf16_t* __restrict__ mixall, long row, int lane) {
  const long MA = NROWS;
  float yy[8], s = 0.f; float r[8], k0[8], k1[8], vv[8], gg[8];
  const int c = lane * 8; const long o = row * 384 + c;
  if (lane < 48) {
    f32x4 a0 = *(const f32x4*)(y + o), a1 = *(const f32x4*)(y + o + 4), b0 = *(const f32x4*)(y + MA * 384 + o), b1 = *(const f32x4*)(y + MA * 384 + o + 4);
#pragma unroll
    for (int e = 0; e < 4; ++e) { yy[e] = a0[e] + b0[e]; yy[4+e] = a1[e] + b1[e]; }
    unpack8(*(const u32x4*)(r_b + o), r); unpack8(*(const u32x4*)(kd_b + o), k0); unpack8(*(const u32x4*)(kd_b + MA * 384 + o), k1);
    unpack8(*(const u32x4*)(v_b + o), vv); unpack8(*(const u32x4*)(g_b + o), gg);
  } else {
#pragma unroll
    for (int e = 0; e < 8; ++e) { yy[e] = 0.f; r[e] = 0.f; k0[e] = 0.f; k1[e] = 0.f; vv[e] = 0.f; gg[e] = 0.f; }
  }
#pragma unroll
  for (int e = 0; e < 8; ++e) s += yy[e];
  const float mean = reduce8(s) * (1.f / 64.f);
  float vs = 0.f, cf = 0.f;
  const int cc = lane < 48 ? c : 0;
  f32x4 rk0 = *(const f32x4*)(W.r_k + cc), rk1 = *(const f32x4*)(W.r_k + cc + 4);
#pragma unroll
  for (int e = 0; e < 8; ++e) { float d = yy[e] - mean; vs += d * d; cf += r[e] * (k0[e] + k1[e]) * (e < 4 ? rk0[e] : rk1[e - 4]); }
  const float var = reduce8(vs) * (1.f / 64.f), coef = reduce8(cf);
  const float inv = __builtin_amdgcn_rsqf(var + 64e-5f);
  if (lane < 48) {
    f32x4 lg0 = *(const f32x4*)(W.ln_g + c), lg1 = *(const f32x4*)(W.ln_g + c + 4), lb0 = *(const f32x4*)(W.ln_b + c), lb1 = *(const f32x4*)(W.ln_b + c + 4);
    float out[8];
#pragma unroll
    for (int e = 0; e < 8; ++e) { float yn = (yy[e] - mean) * inv * (e < 4 ? lg0[e] : lg1[e - 4]) + (e < 4 ? lb0[e] : lb1[e - 4]); out[e] = (yn + coef * vv[e]) * gg[e]; }
    *(u32x4*)(mixall + row * DM + 256 + c) = pack8(out);
  }
}

#define PG_NT 4
#define PG_TOK (4 * PG_NT)
#define PG_OFF_H 0
#define PG_OFF_E (PG_TOK * 2048)
#define PG_OFF_G (PG_OFF_E + PG_TOK * 128 * 2)
#define PG_OFF_ST (PG_OFF_G + PG_TOK * 128 * 4)
#define PG_OFF_CNT (PG_OFF_ST + PG_TOK * 18 * 2)
#define PG_LDS_BYTES (PG_OFF_CNT + PG_TOK * 8 * 16 * 2)
__device__ __forceinline__ long pg_row(int g, int ntok) { return ntok == NROWS ? (long)g : (long)(g / SEQ) * RB + (g % SEQ); }
__device__ __forceinline__ void peer_gather_sliced(const bf16_t* __restrict__ xn, const unsigned* __restrict__ top1, const unsigned char* __restrict__ ub, const float* __restrict__ su,
                                                   const unsigned char* __restrict__ vb, const float* __restrict__ sv, const float* __restrict__ modl, float* __restrict__ xs,
                                                   int ntok, char* smem, const float* __restrict__ ng, const float* __restrict__ nmod, bf16_t* __restrict__ xn_next, float* __restrict__ out, bool dry = false, unsigned emask = 0x3FFFu) {
  bf16_t* hs = (bf16_t*)(smem + PG_OFF_H); unsigned short* se = (unsigned short*)(smem + PG_OFF_E); float* sg = (float*)(smem + PG_OFF_G);
  unsigned short* sst = (unsigned short*)(smem + PG_OFF_ST); unsigned short* cnt = (unsigned short*)(smem + PG_OFF_CNT);
  const int per_block = (ntok + (int)gridDim.x - 1) / (int)gridDim.x;
  const int npass = (per_block + PG_TOK - 1) / PG_TOK; const int tpp = (per_block + npass - 1) / npass;
  for (int pass = 0; pass < npass; ++pass) {
    const int t = tid_opaque(), lane = t & 63, wave = t >> 6;
    __syncthreads();
    for (int i = t; i < PG_TOK * 8 * 16; i += 256) cnt[i] = 0;
    for (int i = t; i < PG_TOK * 128; i += 256) {
      int tl = i >> 7, ch = i & 127; int q = (tl % PG_NT) * 4 + tl / PG_NT; int idx = pass * tpp + q; int g = (int)blockIdx.x + idx * (int)gridDim.x;
      u32x4 v = {0u, 0u, 0u, 0u};
      if (q < tpp && idx < per_block && g < ntok) v = *(const u32x4*)(xn + pg_row(g, ntok) * DM + ch * 8);
      *(u32x4*)(hs + tl * 1024 + ch * 8) = v;
    }
    __syncthreads();
    int my_e[16]; float my_g[16];
    const int ctl = t >> 3, cp = t & 7;
    bool cact = false;
    if (ctl < PG_TOK) {
      int q = (ctl % PG_NT) * 4 + ctl / PG_NT; int idx = pass * tpp + q; int g = (int)blockIdx.x + idx * (int)gridDim.x;
      cact = q < tpp && idx < per_block && g < ntok;
      if (cact) {
        long row = pg_row(g, ntok);
        peer_combine(top1 + (row * 16 + cp * 2) * 16, top1 + (row * 16 + cp * 2 + 1) * 16, my_e, my_g);
#pragma unroll
        for (int k = 0; k < 16; ++k) cnt[(ctl * 8 + cp) * 16 + (my_e[k] >> 10)] += 1;
      }
    }
    __syncthreads();
    if (t < PG_TOK) {
      int run = 0;
      for (int s = 0; s < 16; ++s) {
        sst[t * 18 + s] = (unsigned short)run;
        for (int h = 0; h < 8; ++h) { int c = cnt[(t * 8 + h) * 16 + s]; cnt[(t * 8 + h) * 16 + s] = (unsigned short)run; run += c; }
      }
      sst[t * 18 + 16] = (unsigned short)run;
    }
    __syncthreads();
    if (cact) {
#pragma unroll
      for (int k = 0; k < 16; ++k) { int s = my_e[k] >> 10; int pos = cnt[(ctl * 8 + cp) * 16 + s]; cnt[(ctl * 8 + cp) * 16 + s] = (unsigned short)(pos + 1); se[ctl * 128 + pos] = (unsigned short)my_e[k]; sg[ctl * 128 + pos] = my_g[k]; }
    }
    __syncthreads();
    float acc[PG_NT][16];
#pragma unroll
    for (int tk = 0; tk < PG_NT; ++tk)
#pragma unroll
      for (int e = 0; e < 16; ++e) acc[tk][e] = 0.f;
    for (int s = 0; s < 16; ++s) {
#pragma unroll
      for (int tk = 0; tk < PG_NT; ++tk) {
        const int tl = wave * PG_NT + tk;
        const int st = sst[tl * 18 + s], en = sst[tl * 18 + s + 1];
        for (int base = st; base < en; base += 8) {
          const int nb = en - base < 8 ? en - base : 8;
          u32x4 u[8], v[8];
#pragma unroll
          for (int j = 0; j < 8; ++j) if (j < nb) { const unsigned off = ((unsigned)se[tl * 128 + base + j] & emask) * 1024u + (unsigned)lane * 16u; u[j] = *(const u32x4*)(ub + off); v[j] = *(const u32x4*)(vb + off); }
          float h[16];
          { u32x4 h0 = *(const u32x4*)(hs + tl * 1024 + lane * 16), h1 = *(const u32x4*)(hs + tl * 1024 + lane * 16 + 8);
#pragma unroll
            for (int e = 0; e < 4; ++e) { h[2*e] = __uint_as_float(h0[e] << 16); h[2*e+1] = __uint_as_float(h0[e] & 0xffff0000u); h[8+2*e] = __uint_as_float(h1[e] << 16); h[8+2*e+1] = __uint_as_float(h1[e] & 0xffff0000u); } }
          float pd[8];
#pragma unroll
          for (int j = 0; j < 8; ++j) pd[j] = j < nb ? dot16_fp8(h, u[j]) : 0.f;
          float q4[4], q2[2], q1;
#pragma unroll
          for (int j = 0; j < 4; ++j) { bool hi = lane & 1; float keep = hi ? pd[2*j+1] : pd[2*j], send = hi ? pd[2*j] : pd[2*j+1]; q4[j] = keep + dpp_get<0xB1>(send); }
#pragma unroll
          for (int j = 0; j < 2; ++j) { bool hi = lane & 2; float keep = hi ? q4[2*j+1] : q4[2*j], send = hi ? q4[2*j] : q4[2*j+1]; q2[j] = keep + dpp_get<0x4E>(send); }
          { bool hi = lane & 4; float keep = hi ? q2[1] : q2[0], send = hi ? q2[0] : q2[1]; q1 = keep + xor4_get(send); }
          q1 += dpp_get<0x128>(q1);
          q1 = xor16_sum(q1);
          q1 = xor32_sum(q1);
          float w = 0.f;
          { const int jj = lane & 7; if (jj < nb) { int e = se[tl * 128 + base + jj]; w = sg[tl * 128 + base + jj] * fgelu_(q1 * su[e]) * sv[e]; } }
#pragma unroll
          for (int j = 0; j < 8; ++j) { float wj = __builtin_bit_cast(float, __builtin_amdgcn_readlane(__builtin_bit_cast(int, w), j)); if (j < nb) axpy16_fp8(acc[tk], wj, v[j]); }
        }
      }
    }
    if (dry) {
#pragma unroll
      for (int tk = 0; tk < PG_NT; ++tk)
#pragma unroll
        for (int e = 0; e < 16; ++e) asm volatile("" :: "v"(acc[tk][e]));
    }
#pragma unroll
    for (int tk = 0; tk < PG_NT; ++tk) {
      int q = tk * 4 + wave; int idx = pass * tpp + q; int g = (int)blockIdx.x + idx * (int)gridDim.x;
      if (!dry && q < tpp && idx < per_block && g < ntok) {
        long row = pg_row(g, ntok); int b = row / RB, lr = row % RB; int bb = lr < SEQ ? b : BATCH; const float* g5 = modl + ((long)bb * 6 + 5) * DM + lane * 16;
        float* xr = xs + row * DM + lane * 16;
        f32x4 xv[4]; float ss = 0.f;
#pragma unroll
        for (int i = 0; i < 4; ++i) {
          f32x4 x = *(f32x4*)(xr + 4 * i); f32x4 gg = *(const f32x4*)(g5 + 4 * i);
          x[0] += gg[0] * acc[tk][4*i]; x[1] += gg[1] * acc[tk][4*i+1]; x[2] += gg[2] * acc[tk][4*i+2]; x[3] += gg[3] * acc[tk][4*i+3];
          xv[i] = x; ss += x[0] * x[0] + x[1] * x[1] + x[2] * x[2] + x[3] * x[3];
        }
        if (out) {
          float* orow = out + ((long)b * SEQ + lr) * DM + lane * 16;
#pragma unroll
          for (int i = 0; i < 4; ++i) *(f32x4*)(orow + 4 * i) = xv[i];
        } else {
#pragma unroll
          for (int i = 0; i < 4; ++i) *(f32x4*)(xr + 4 * i) = xv[i];
          ss = wave_sum(ss); const float inv = __builtin_amdgcn_rsqf(ss * (1.f / DM) + EPSN);
          const float* sh = nmod + ((long)bb * 6 + 0) * DM + lane * 16; const float* sc = sh + DM; const float* gp = ng + lane * 16;
          u32x4 p0, p1;
#pragma unroll
          for (int i = 0; i < 4; ++i) { f32x4 g4 = *(const f32x4*)(gp + 4 * i), s4 = *(const f32x4*)(sc + 4 * i), h4 = *(const f32x4*)(sh + 4 * i);
            const float a0 = xv[i][0] * inv * g4[0] * (1.f + s4[0]) + h4[0], a1 = xv[i][1] * inv * g4[1] * (1.f + s4[1]) + h4[1];
            const float a2 = xv[i][2] * inv * g4[2] * (1.f + s4[2]) + h4[2], a3 = xv[i][3] * inv * g4[3] * (1.f + s4[3]) + h4[3];
            if (i < 2) { p0[2 * i] = pack2bf(a0, a1); p0[2 * i + 1] = pack2bf(a2, a3); } else { p1[2 * (i - 2)] = pack2bf(a0, a1); p1[2 * (i - 2) + 1] = pack2bf(a2, a3); } }
          *(u32x4*)(xn_next + row * DM + lane * 16) = p0; *(u32x4*)(xn_next + row * DM + lane * 16 + 8) = p1;
        }
      }
    }
  }
}

#define PG3_OFF_H 0
#define PG3_OFF_FE (12 * 2048)
#define PG3_OFF_FG (PG3_OFF_FE + 4 * 384 * 2)
#define PG3_OFF_FS (PG3_OFF_FG + 4 * 384 * 4)
#define PG3_OFF_BT (PG3_OFF_FS + 4 * 384 * 4)
#define PG3_OFF_CNT (PG3_OFF_BT + 4 * 160 * 4)
#define PG3_OFF_TOT (PG3_OFF_CNT + 4 * 512 * 2)
#define PG3_LDS_BYTES (PG3_OFF_TOT + 512)
#define PG3_REC_BYTES (384 * 2 + 384 * 4 + 384 * 4 + 160 * 4 + 16)
__device__ __forceinline__ void peer_lists_build3(const unsigned* __restrict__ top1, const float* __restrict__ su, const float* __restrict__ sv, char* __restrict__ gl, int ntok, char* smem) {
  unsigned short* fe = (unsigned short*)(smem + PG3_OFF_FE); float* fg = (float*)(smem + PG3_OFF_FG); float* fs = (float*)(smem + PG3_OFF_FS);
  unsigned* bt = (unsigned*)(smem + PG3_OFF_BT); unsigned short* cnt = (unsigned short*)(smem + PG3_OFF_CNT); unsigned short* tot = (unsigned short*)(smem + PG3_OFF_TOT);
  int* nbt = (int*)(smem + PG3_OFF_TOT + 320);
  const int per_block = (ntok + (int)gridDim.x - 1) / (int)gridDim.x;
  const int npass = (per_block + 11) / 12; const int tpp = (per_block + npass - 1) / npass;
  for (int pass = 0; pass < npass; ++pass) {
    const int t = tid_opaque();
    __syncthreads();
    for (int i = t; i < 4 * 512; i += 256) cnt[i] = 0;
    __syncthreads();
    int my_e[16]; float my_g[16];
    const int ctl = t >> 3, cp = t & 7; const int cw = ctl / 3, ctk = ctl % 3;
    bool cact = false;
    if (ctl < 12) {
      int q = ctk * 4 + cw; int idx = pass * tpp + q; int g = (int)blockIdx.x + idx * (int)gridDim.x;
      cact = q < tpp && idx < per_block && g < ntok;
      if (cact) {
        long row = pg_row(g, ntok);
        peer_combine(top1 + (row * 16 + cp * 2) * 16, top1 + (row * 16 + cp * 2 + 1) * 16, my_e, my_g);
#pragma unroll
        for (int k = 0; k < 16; ++k) cnt[((cw * 16 + (my_e[k] >> 10)) * 4 + ctk) * 8 + cp] += 1;
      }
    }
    __syncthreads();
    unsigned short* tot2 = tot + 80;
    if (t < 64) {
      int w_ = t >> 4, s = t & 15; int ne = 0, nbk = 0;
      for (int tk = 0; tk < 3; ++tk) { int n = 0; for (int h = 0; h < 8; ++h) n += cnt[((w_ * 16 + s) * 4 + tk) * 8 + h]; ne += n; nbk += (n + 7) >> 3; }
      tot[w_ * 16 + s] = (unsigned short)ne; tot2[w_ * 16 + s] = (unsigned short)nbk;
    }
    __syncthreads();
    if (t < 64) {
      int w_ = t >> 4, s = t & 15; int run = 0, nb_ = 0;
      for (int i = 0; i < s; ++i) { run += tot[w_ * 16 + i]; nb_ += tot2[w_ * 16 + i]; }
      for (int tk = 0; tk < 3; ++tk) {
        int gstart = run;
        for (int h = 0; h < 8; ++h) { int ci = ((w_ * 16 + s) * 4 + tk) * 8 + h; int c = cnt[ci]; cnt[ci] = (unsigned short)run; run += c; }
        for (int b0 = gstart; b0 < run; b0 += 8) { int n = run - b0 < 8 ? run - b0 : 8; bt[w_ * 160 + nb_] = (unsigned)tk | ((unsigned)b0 << 4) | ((unsigned)n << 16); ++nb_; }
      }
      if (s == 15) { while (nb_ % 3) { bt[w_ * 160 + nb_] = 0u; ++nb_; } nbt[w_] = nb_; }
    }
    __syncthreads();
    if (cact) {
#pragma unroll
      for (int k = 0; k < 16; ++k) { int ci = ((cw * 16 + (my_e[k] >> 10)) * 4 + ctk) * 8 + cp; int pos = cnt[ci]; cnt[ci] = (unsigned short)(pos + 1);
        fe[cw * 384 + pos] = (unsigned short)my_e[k]; fg[cw * 384 + pos] = my_g[k] * sv[my_e[k]]; fs[cw * 384 + pos] = su[my_e[k]]; }
    }
    __syncthreads();
    char* rec = gl + ((long)blockIdx.x * 4 + pass) * 4 * PG3_REC_BYTES;
    for (int i = t; i < 4 * 48; i += 256) { int w_ = i / 48, c = i % 48; *(u32x4*)(rec + w_ * PG3_REC_BYTES + c * 16) = *(const u32x4*)((const char*)fe + w_ * 768 + c * 16); }
    for (int i = t; i < 4 * 96; i += 256) { int w_ = i / 96, c = i % 96; *(u32x4*)(rec + w_ * PG3_REC_BYTES + 768 + c * 16) = *(const u32x4*)((const char*)fg + w_ * 1536 + c * 16); }
    for (int i = t; i < 4 * 96; i += 256) { int w_ = i / 96, c = i % 96; *(u32x4*)(rec + w_ * PG3_REC_BYTES + 2304 + c * 16) = *(const u32x4*)((const char*)fs + w_ * 1536 + c * 16); }
    for (int i = t; i < 4 * 40; i += 256) { int w_ = i / 40, c = i % 40; *(u32x4*)(rec + w_ * PG3_REC_BYTES + 3840 + c * 16) = *(const u32x4*)((const char*)bt + w_ * 640 + c * 16); }
    if (t < 4) *(int*)(rec + t * PG3_REC_BYTES + 4480) = nbt[t];
  }
  __syncthreads();
}
__device__ __forceinline__ void pg3_issue(u32x4 (&B)[8], const unsigned char* __restrict__ tab, const unsigned short* we, unsigned desc, int lane) {
  const int base = (desc >> 4) & 0xFFF, nb = desc >> 16;
#pragma unroll
  for (int j = 0; j < 8; ++j) { const int jj = j < nb ? j : (nb > 0 ? nb - 1 : 0); const unsigned off = (unsigned)we[base + jj] * 1024u + (unsigned)lane * 16u; B[j] = *(const u32x4*)(tab + off); }
}
__device__ __forceinline__ void pg3_axpy8(float (&a)[16], const u32x4 (&V)[8], float w, int nb) {
#pragma unroll
  for (int j = 0; j < 8; ++j) { const float wj = __builtin_bit_cast(float, __builtin_amdgcn_readlane(__builtin_bit_cast(int, w), j)); if (j < nb) axpy16_fp8(a, wj, V[j]); }
}
__device__ __forceinline__ void pg3_step(u32x4 (&U)[8], u32x4 (&V)[8], u32x4 (&F)[8], int k, int nbat, float (&acc)[3][16],
                                         const unsigned char* __restrict__ ub, const unsigned char* __restrict__ vb,
                                         const unsigned short* we, const float* wg, const float* wsc, const unsigned* wb, const bf16_t* hw, int lane) {
  const unsigned desc = __builtin_amdgcn_readfirstlane(wb[k]);
  const int tk = desc & 15, base = (desc >> 4) & 0xFFF, nb = desc >> 16;
  const unsigned dnext = __builtin_amdgcn_readfirstlane(wb[k + 1 < nbat ? k + 1 : k]);
  pg3_issue(F, ub, we, dnext, lane);
  float h[16];
  { const bf16_t* hp = hw + tk * 1024 + lane * 16; u32x4 h0 = *(const u32x4*)hp, h1 = *(const u32x4*)(hp + 8);
#pragma unroll
    for (int e = 0; e < 4; ++e) { h[2*e] = __uint_as_float(h0[e] << 16); h[2*e+1] = __uint_as_float(h0[e] & 0xffff0000u); h[8+2*e] = __uint_as_float(h1[e] << 16); h[8+2*e+1] = __uint_as_float(h1[e] & 0xffff0000u); } }
  float pd[8];
#pragma unroll
  for (int j = 0; j < 8; ++j) pd[j] = j < nb ? dot16_fp8(h, U[j]) : 0.f;
  pg3_issue(U, vb, we, dnext, lane);
  float q4[4], q2[2], q1;
#pragma unroll
  for (int j = 0; j < 4; ++j) { bool hi = lane & 1; float keep = hi ? pd[2*j+1] : pd[2*j], send = hi ? pd[2*j] : pd[2*j+1]; q4[j] = keep + dpp_get<0xB1>(send); }
#pragma unroll
  for (int j = 0; j < 2; ++j) { bool hi = lane & 2; float keep = hi ? q4[2*j+1] : q4[2*j], send = hi ? q4[2*j] : q4[2*j+1]; q2[j] = keep + dpp_get<0x4E>(send); }
  { bool hi = lane & 4; float keep = hi ? q2[1] : q2[0], send = hi ? q2[0] : q2[1]; q1 = keep + xor4_get(send); }
  q1 += dpp_get<0x128>(q1);
  q1 = xor16_sum(q1);
  q1 = xor32_sum(q1);
  float w = 0.f;
  { const int jj = lane & 7; if (jj < nb) w = wg[base + jj] * fgelu_(q1 * wsc[base + jj]); }
  if (tk == 0) pg3_axpy8(acc[0], V, w, nb); else if (tk == 1) pg3_axpy8(acc[1], V, w, nb); else pg3_axpy8(acc[2], V, w, nb);
}
__device__ __forceinline__ void peer_gather_sweep3(const bf16_t* __restrict__ xn, const char* __restrict__ gl, const unsigned char* __restrict__ ub,
                                                   const unsigned char* __restrict__ vb, const float* __restrict__ modl, float* __restrict__ xs, int ntok, char* smem,
                                                   const float* __restrict__ ng, const float* __restrict__ nmod, bf16_t* __restrict__ xn_next, float* __restrict__ out) {
  bf16_t* hs = (bf16_t*)(smem + PG3_OFF_H); unsigned short* fe = (unsigned short*)(smem + PG3_OFF_FE); float* fg = (float*)(smem + PG3_OFF_FG); float* fs = (float*)(smem + PG3_OFF_FS);
  unsigned* bt = (unsigned*)(smem + PG3_OFF_BT); int* nbt = (int*)(smem + PG3_OFF_TOT + 320);
  const int per_block = (ntok + (int)gridDim.x - 1) / (int)gridDim.x;
  const int npass = (per_block + 11) / 12; const int tpp = (per_block + npass - 1) / npass;
  for (int pass = 0; pass < npass; ++pass) {
    {
      const int t = tid_opaque();
      __syncthreads();
      const char* rec = gl + ((long)blockIdx.x * 4 + pass) * 4 * PG3_REC_BYTES;
      for (int i = t; i < 4 * 48; i += 256) { int w_ = i / 48, c = i % 48; *(u32x4*)((char*)fe + w_ * 768 + c * 16) = *(const u32x4*)(rec + w_ * PG3_REC_BYTES + c * 16); }
      for (int i = t; i < 4 * 96; i += 256) { int w_ = i / 96, c = i % 96; *(u32x4*)((char*)fg + w_ * 1536 + c * 16) = *(const u32x4*)(rec + w_ * PG3_REC_BYTES + 768 + c * 16); }
      for (int i = t; i < 4 * 96; i += 256) { int w_ = i / 96, c = i % 96; *(u32x4*)((char*)fs + w_ * 1536 + c * 16) = *(const u32x4*)(rec + w_ * PG3_REC_BYTES + 2304 + c * 16); }
      for (int i = t; i < 4 * 40; i += 256) { int w_ = i / 40, c = i % 40; *(u32x4*)((char*)bt + w_ * 640 + c * 16) = *(const u32x4*)(rec + w_ * PG3_REC_BYTES + 3840 + c * 16); }
      if (t < 4) nbt[t] = *(const int*)(rec + t * PG3_REC_BYTES + 4480);
      for (int i = t; i < 12 * 128; i += 256) {
        int tl = i >> 7, ch = i & 127; int q = (tl % 3) * 4 + (tl / 3); int idx = pass * tpp + q; int g = (int)blockIdx.x + idx * (int)gridDim.x;
        u32x4 v = {0u, 0u, 0u, 0u};
        if (q < tpp && idx < per_block && g < ntok) v = *(const u32x4*)(xn + pg_row(g, ntok) * DM + ch * 8);
        *(u32x4*)(hs + tl * 1024 + ch * 8) = v;
      }
      __syncthreads();
    }
    const int t_s = tid_opaque(); const int lane = t_s & 63, wave = t_s >> 6;
    float acc[3][16];
#pragma unroll
    for (int tk = 0; tk < 3; ++tk)
#pragma unroll
      for (int e = 0; e < 16; ++e) acc[tk][e] = 0.f;
    const int nbat = nbt[wave];
    const unsigned short* we = fe + wave * 384; const float* wg = fg + wave * 384; const float* wsc = fs + wave * 384; const unsigned* wb = bt + wave * 160;
    const bf16_t* hw = hs + wave * 3 * 1024;
    u32x4 X[8], Y[8], Z[8];
    if (nbat > 0) { const unsigned d0 = __builtin_amdgcn_readfirstlane(wb[0]); pg3_issue(X, ub, we, d0, lane); pg3_issue(Y, vb, we, d0, lane); }
    for (int k = 0; k < nbat; k += 3) {
      pg3_step(X, Y, Z, k, nbat, acc, ub, vb, we, wg, wsc, wb, hw, lane);
      pg3_step(Z, X, Y, k + 1, nbat, acc, ub, vb, we, wg, wsc, wb, hw, lane);
      pg3_step(Y, Z, X, k + 2, nbat, acc, ub, vb, we, wg, wsc, wb, hw, lane);
    }
#pragma unroll
    for (int tk = 0; tk < 3; ++tk) {
      int q = tk * 4 + wave; int idx = pass * tpp + q; int g = (int)blockIdx.x + idx * (int)gridDim.x;
      if (q < tpp && idx < per_block && g < ntok) {
        long row = pg_row(g, ntok); int b = row / RB, lr = row % RB; int bb = lr < SEQ ? b : BATCH; const float* g5 = modl + ((long)bb * 6 + 5) * DM + lane * 16;
        float* xr = xs + row * DM + lane * 16;
        f32x4 xv[4]; float ss = 0.f;
#pragma unroll
        for (int i = 0; i < 4; ++i) {
          f32x4 x = *(f32x4*)(xr + 4 * i); f32x4 gg = *(const f32x4*)(g5 + 4 * i);
          x[0] += gg[0] * acc[tk][4*i]; x[1] += gg[1] * acc[tk][4*i+1]; x[2] += gg[2] * acc[tk][4*i+2]; x[3] += gg[3] * acc[tk][4*i+3];
          xv[i] = x; ss += x[0] * x[0] + x[1] * x[1] + x[2] * x[2] + x[3] * x[3];
        }
        if (out) {
          float* orow = out + ((long)b * SEQ + lr) * DM + lane * 16;
#pragma unroll
          for (int i = 0; i < 4; ++i) *(f32x4*)(orow + 4 * i) = xv[i];
        } else {
#pragma unroll
          for (int i = 0; i < 4; ++i) *(f32x4*)(xr + 4 * i) = xv[i];
          ss = wave_sum(ss); const float inv = __builtin_amdgcn_rsqf(ss * (1.f / DM) + EPSN);
          const float* sh = nmod + ((long)bb * 6 + 0) * DM + lane * 16; const float* sc = sh + DM; const float* gp = ng + lane * 16;
          u32x4 p0, p1;
#pragma unroll
          for (int i = 0; i < 4; ++i) { f32x4 g4 = *(const f32x4*)(gp + 4 * i), s4 = *(const f32x4*)(sc + 4 * i), h4 = *(const f32x4*)(sh + 4 * i);
            const float a0 = xv[i][0] * inv * g4[0] * (1.f + s4[0]) + h4[0], a1 = xv[i][1] * inv * g4[1] * (1.f + s4[1]) + h4[1];
            const float a2 = xv[i][2] * inv * g4[2] * (1.f + s4[2]) + h4[2], a3 = xv[i][3] * inv * g4[3] * (1.f + s4[3]) + h4[3];
            if (i < 2) { p0[2 * i] = pack2bf(a0, a1); p0[2 * i + 1] = pack2bf(a2, a3); } else { p1[2 * (i - 2)] = pack2bf(a0, a1); p1[2 * (i - 2) + 1] = pack2bf(a2, a3); } }
          *(u32x4*)(xn_next + row * DM + lane * 16) = p0; *(u32x4*)(xn_next + row * DM + lane * 16 + 8) = p1;
        }
      }
    }
  }
}
#include <hip/hip_cooperative_groups.h>
namespace cg = cooperative_groups;

#define XB_TMO      128
#define XB_XCNT(j)  (256  + 64 * (j))
#define XB_XSUB(j)  (1280 + 64 * (j))
#define XB_XGEN(j)  (2304 + 64 * (j))
#define XB_TOP      3328
#define XB_TOPGEN   3392
#define XB_QUEUE(i) (3456 + 64 * (i))
#define XCD_BAR_WORDS 4096
#define XB_SPIN_CAP (1u << 22)
#define LAS __attribute__((address_space(3)))
__device__ __forceinline__ unsigned xb_ld(unsigned* p)              { return __hip_atomic_load(p, __ATOMIC_RELAXED, __HIP_MEMORY_SCOPE_AGENT); }
__device__ __forceinline__ unsigned xb_add(unsigned* p, unsigned v) { return __hip_atomic_fetch_add(p, v, __ATOMIC_RELAXED, __HIP_MEMORY_SCOPE_AGENT); }
__device__ __forceinline__ unsigned xb_xcc_id() { return (unsigned)__builtin_amdgcn_s_getreg((3 << 11) | 20) & 0xFu; }
#define XB_SPIN(cond, bar) do { unsigned _sp = 0; while (cond) { __builtin_amdgcn_s_sleep(1); \
    if ((++_sp & 255u) == 0u) { if (xb_ld(&(bar)[XB_TMO])) break; if (_sp > XB_SPIN_CAP) { atomicAdd(&(bar)[XB_TMO], 1u); break; } } } } while (0)
struct XcdBarrier { unsigned* bar; unsigned x; volatile LAS unsigned* st; };
__device__ __forceinline__ XcdBarrier xcd_barrier_post(unsigned* bar, volatile LAS unsigned* st) {
  XcdBarrier b; b.bar = bar; b.x = xb_xcc_id(); b.st = st;
  if (threadIdx.x == 0) (void)xb_add(&bar[XB_XCNT(b.x)], 1u);
  return b;
}
__device__ __forceinline__ void xcd_barrier_complete(unsigned* bar, unsigned x, unsigned& nloc, unsigned& nx) {
  const unsigned G = gridDim.x; unsigned sum, cnt, mine, sp = 0u;
  for (;;) {
    sum = 0u; cnt = 0u; mine = 0u;
#pragma unroll
    for (unsigned j = 0; j < 16; ++j) { const unsigned c = xb_ld(&bar[XB_XCNT(j)]); sum += c; cnt += (c > 0u) ? 1u : 0u; mine = (j == x) ? c : mine; }
    if (sum == G) break;
    __builtin_amdgcn_s_sleep(1);
    if ((++sp & 255u) == 0u) { if (xb_ld(&bar[XB_TMO])) break; if (sp > XB_SPIN_CAP) { atomicAdd(&bar[XB_TMO], 1u); break; } }
  }
  nloc = mine > 0u ? mine : 1u; nx = cnt > 0u ? cnt : 1u;
}
__device__ __forceinline__ void xcd_barrier(const XcdBarrier& b) {
  asm volatile("s_waitcnt vmcnt(0)" ::: "memory");
  __syncthreads();
  if (threadIdx.x == 0) {
    unsigned* bar = b.bar;
    __builtin_amdgcn_s_waitcnt(0);
    unsigned nloc = b.st[0], nx = b.st[1];
    if (nloc == 0u) { xcd_barrier_complete(bar, b.x, nloc, nx); b.st[0] = nloc; b.st[1] = nx; }
    const unsigned old = xb_add(&bar[XB_XSUB(b.x)], 1u);
    const unsigned gen = old / nloc;
    if (old + 1u == (gen + 1u) * nloc) {
      __builtin_amdgcn_fence(__ATOMIC_RELEASE, "agent");
      asm volatile("s_waitcnt vmcnt(0)" ::: "memory");
      const unsigned og = xb_add(&bar[XB_TOP], 1u);
      const unsigned tg = og / nx;
      if (og + 1u == (tg + 1u) * nx) xb_add(&bar[XB_TOPGEN], 1u);
      else XB_SPIN(xb_ld(&bar[XB_TOPGEN]) == tg, bar);
      __builtin_amdgcn_fence(__ATOMIC_ACQUIRE, "agent");
      xb_add(&bar[XB_XGEN(b.x)], 1u);
      asm volatile("s_waitcnt vmcnt(0)" ::: "memory");
    } else {
      XB_SPIN(xb_ld(&bar[XB_XGEN(b.x)]) == gen, bar);
      __builtin_amdgcn_fence(__ATOMIC_ACQUIRE, "agent");
      asm volatile("s_waitcnt vmcnt(0)" ::: "memory");
    }
  }
  __syncthreads();
}


constexpr size_t al256(size_t x) { return (x + 255) & ~(size_t)255; }
struct WsOff { size_t xs, mod, xn, Pb, tq, tkv, a_b, g_b, w_f, mq, mk, mvT, gq, gk, gvT, r_b, v_b, kk_b, kd_b, bd_b, w_inT, w_outT, wqT, keysb, wqbT, wkvbT, w2T, a2T, g2T, rope_g, rope_m, total; };
constexpr WsOff make_wsoff() {
  WsOff o{}; size_t p = 32768; const size_t MA = NROWS;
  o.mod = p; p += al256(2 * (BATCH + 1) * 6144 * 4); o.xs = p; p += al256(MA * DM * 4); o.xn = p; p += al256(MA * DM * 2);
  o.Pb = p; p += al256(MA * IN_COLS * 2);
  o.tq = p; p += al256(MA * 384 * 2); o.tkv = p; p += al256(MA * 512 * 2); o.a_b = p; p += al256(2 * MA * 384 * 2);
  o.g_b = p; p += al256(MA * 384 * 2); o.w_f = p; p += al256(2 * MA * 384 * 4);
  o.mq = p; p += al256(MA * 384 * 2); o.mk = p; p += al256(MA * 384 * 2); o.mvT = p; p += al256((size_t)BATCH * 4 * 64 * RB * 2);
  o.gq = p; p += al256(MA * 384 * 2); o.gk = p; p += al256(MA * 128 * 2); o.gvT = p; p += al256((size_t)BATCH * 2 * 64 * RB * 2);
  o.r_b = p; p += al256(MA * 384 * 2); o.v_b = p; p += al256(MA * 384 * 2); o.kk_b = p; p += al256(MA * 384 * 2);
  o.kd_b = p; p += al256(2 * MA * 384 * 2); o.bd_b = p; p += al256(2 * MA * 384 * 2);
  o.w_inT = p; p += al256((size_t)2 * 2688 * 1024 * 2); o.w_outT = p; p += al256((size_t)2 * 1024 * 1024 * 2); o.wqT = p; p += al256((size_t)2 * 2048 * 1024 * 2);
  o.keysb = p; p += al256((size_t)2 * 16 * 128 * 128 * 2); o.wqbT = p; p += al256((size_t)2 * 384 * 256 * 2); o.wkvbT = p; p += al256((size_t)2 * 512 * 128 * 2);
  o.w2T = p; p += al256((size_t)2 * 2 * 384 * 64 * 2); o.a2T = p; p += al256((size_t)2 * 2 * 384 * 64 * 2); o.g2T = p; p += al256((size_t)2 * 384 * 192 * 2);
  o.rope_g = p; p += al256((size_t)SEQ * 64 * 4); o.rope_m = p; p += al256((size_t)SEQ * 32 * 4);
  o.total = p; return o;
}
constexpr WsOff WO = make_wsoff();
#define WS_PTR(T, off) ((T*)(ws + (off)))
#define TAB_OFF (WO.Pb + ((size_t)2 * NROWS * 384 * 4 + 1048576 & ~(size_t)255))
#define TAB_U (TAB_OFF)
#define TAB_V (TAB_OFF + (size_t)16384 * 1024)
#define TAB_SU (TAB_OFF + (size_t)2 * 16384 * 1024)
#define TAB_SV (TAB_OFF + (size_t)2 * 16384 * 1024 + 65536)
#define LAUNDER_S(x) asm volatile("" : "+s"(x))
#define KARG_AS __attribute__((address_space(4)))
#define KP_DECL const KARG_AS MegaP* kp_ = (const KARG_AS MegaP*)__builtin_amdgcn_kernarg_segment_ptr(); LAUNDER_S(kp_)

struct NaiveIn {
  const float *x, *c, *ctx, *c_ctx, *ada_w, *ada_b, *norm_mix_g, *norm_ffn_g, *w_in, *w_out, *mla_q_norm_g, *mla_w_qb, *mla_kv_norm_g,
      *mla_w_kvb, *mla_qk_g, *rw_mu, *rw_w0, *rw_w2, *rw_a0, *rw_a2, *rw_g2, *rw_k_k, *rw_k_a, *rw_r_k, *rw_ln_g, *rw_ln_b, *gqa_qk_g,
      *pe_wq, *pe_keys, *pe_u, *pe_v;
};
struct MegaP { NaiveIn in; char* ws; float* out; };

#ifndef MEGA_CG
#define MEGA_CG 0
#endif
#if MEGA_CG
#define GRID_BARRIER() cg::this_grid().sync()
#else
#ifdef BAR_TWICE
#define GRID_BARRIER() do { GRID_BARRIER1(); GRID_BARRIER1(); } while (0)
#else
#define GRID_BARRIER() GRID_BARRIER1()
#endif
#define GRID_BARRIER1() do { XcdBarrier xb_; xb_.bar = (unsigned*)((const KARG_AS MegaP*)__builtin_amdgcn_kernarg_segment_ptr())->ws; xb_.x = xb_xcc_id(); xb_.st = (volatile LAS unsigned*)&xb_words; xcd_barrier(xb_); } while (0)
#endif
#define MEGA_LDS_BYTES 65536
#ifndef PHASE_MASK
#define PHASE_MASK 0xFFFF
#endif
#define PH(k) if (PHASE_MASK & (1 << (k)))
#define LAT_TM(i) (((i) >> 4) * 18 + ((i) & 15))
#define XCD_TILE_LOOP(tile, T) for (int xt_base_ = (int)(((long)(T) * (blockIdx.x & 7)) >> 3), xt_cnt_ = (int)(((long)(T) * ((blockIdx.x & 7) + 1)) >> 3) - xt_base_, xt_q_ = blockIdx.x >> 3, tile = xt_base_ + xt_q_; xt_q_ < xt_cnt_; xt_q_ += gridDim.x >> 3, tile = xt_base_ + xt_q_)
#ifndef DIL_PH
#define DIL_PH -1
#endif
#ifndef DIL_MULT
#define DIL_MULT 4
#endif
#define DIL_BEGIN(k) unsigned long long dil_t0 = 0; if (DIL_PH == (k)) dil_t0 = __builtin_amdgcn_s_memrealtime();
#define DIL_END(k) if (DIL_PH == (k)) { GRID_BARRIER(); if (blockIdx.x == 0 && threadIdx.x == 0) { unsigned long long t1 = __builtin_amdgcn_s_memrealtime(); unsigned long long dt = (t1 - dil_t0) * DIL_MULT; \
    while (__builtin_amdgcn_s_memrealtime() - t1 < dt) __builtin_amdgcn_s_sleep(32); } }

__device__ __forceinline__ void ph_norm_mod(const float* xs, const float* g, const float* modl, int shift_idx, bf16_t* xn, bool skip_ctx = false) {
  const int tt_ = tid_opaque(); const int lane = tt_ & 63;
  for (long row = blockIdx.x * 4 + (tt_ >> 6); row < NROWS; row += (long)gridDim.x * 4) {
    int b = row / RB, lr = row % RB; int bb = lr < SEQ ? b : BATCH;
    if (skip_ctx && lr >= SEQ) continue;
    const float* sh = modl + ((long)bb * 6 + shift_idx) * DM; const float* sc = sh + DM;
    const float* xr = xs + row * DM; f32x4 v[4]; float ss = 0.f;
#pragma unroll
    for (int i = 0; i < 4; ++i) { v[i] = *(const f32x4*)(xr + i * 256 + lane * 4); ss += v[i][0]*v[i][0] + v[i][1]*v[i][1] + v[i][2]*v[i][2] + v[i][3]*v[i][3]; }
    ss = wave_sum(ss);
    float inv = __builtin_amdgcn_rsqf(ss / DM + EPSN);
#pragma unroll
    for (int i = 0; i < 4; ++i) {
      int d = i * 256 + lane * 4; float o[4];
#pragma unroll
      for (int e = 0; e < 4; ++e) o[e] = v[i][e] * inv * g[d+e] * (1.f + sc[d+e]) + sh[d+e];
      uint2 pk; pk.x = pack2bf(o[0], o[1]); pk.y = pack2bf(o[2], o[3]);
      *(uint2*)(xn + row * DM + d) = pk;
    }
  }
}
__device__ __forceinline__ void ph_cvt_wT(const float* W, const float* g, bf16_t* Wt, int K, int N, int Npad, int Kpad) {
  const long n_el = (long)Npad * Kpad;
  const int tt_ = tid_opaque();
  for (long i = (long)blockIdx.x * 256 + tt_; i < n_el; i += (long)gridDim.x * 256) {
    int k = i % Kpad; int n = i / Kpad;
    Wt[i] = (k < K && n < N) ? f2bf(W[(long)k * N + n] * (g ? g[k] : 1.f)) : (bf16_t)0;
  }
}
__device__ __forceinline__ void ph_cvt_bf16(const float* s, bf16_t* d, long n8) {
  const int tt_ = tid_opaque();
  for (long i = (long)blockIdx.x * 256 + tt_; i < n8; i += (long)gridDim.x * 256) {
    f32x4 a = *(const f32x4*)(s + i * 8), b = *(const f32x4*)(s + i * 8 + 4);
    u32x4 o; o[0] = pack2bf(a[0], a[1]); o[1] = pack2bf(a[2], a[3]); o[2] = pack2bf(b[0], b[1]); o[3] = pack2bf(b[2], b[3]);
    *(u32x4*)(d + i * 8) = o;
  }
}


__device__ __forceinline__ void ph_cvt_wT_tiled(const float* __restrict__ W, const float* __restrict__ g, bf16_t* __restrict__ Wt, int K, int N, int Npad, int Kpad, char* smem) {
  const int t = tid_opaque(); float* s = (float*)smem;
  const int tk = Kpad / 64, tn = Npad / 64;
  for (int tile = blockIdx.x; tile < tk * tn; tile += gridDim.x) {
    const int k0 = (tile % tk) * 64, n0 = (tile / tk) * 64;
    __syncthreads();
#pragma unroll
    for (int i = 0; i < 4; ++i) {
      int kk = (t >> 4) + 16 * i, nn = (t & 15) * 4; int k = k0 + kk;
      f32x4 v = {0.f, 0.f, 0.f, 0.f};
      if (k < K) {
        const float* src = W + (long)k * N + n0 + nn; float gs = g ? g[k] : 1.f;
        if (n0 + nn + 3 < N) v = *(const f32x4*)src; else { for (int e = 0; e < 4; ++e) if (n0 + nn + e < N) v[e] = src[e]; }
        v *= gs;
      }
#pragma unroll
      for (int e = 0; e < 4; ++e) s[kk * 65 + nn + e] = v[e];
    }
    __syncthreads();
    {
      int nn = t >> 2, kq = (t & 3) * 16; u32x4 o0, o1;
#pragma unroll
      for (int e = 0; e < 4; ++e) { o0[e] = pack2bf(s[(kq + 2*e) * 65 + nn], s[(kq + 2*e + 1) * 65 + nn]); o1[e] = pack2bf(s[(kq + 8 + 2*e) * 65 + nn], s[(kq + 8 + 2*e + 1) * 65 + nn]); }
      bf16_t* dst = Wt + (long)(n0 + nn) * Kpad + k0 + kq;
      *(u32x4*)dst = o0; *(u32x4*)(dst + 8) = o1;
    }
  }
}
__device__ __forceinline__ void ph_mod_gemv(const float* __restrict__ c, const float* __restrict__ c_ctx, const float* __restrict__ ada_w, const float* __restrict__ ada_b, float* __restrict__ mod, char* smem) {
  const int t = tid_opaque(); float* s = (float*)smem;
  if ((int)blockIdx.x >= 2 * 96) return;
  for (int i = t; i < 9 * 1024; i += 256) { int bb = i >> 10, k = i & 1023; float v = bb < BATCH ? c[bb * DM + k] : c_ctx[k]; s[i] = v * __builtin_amdgcn_rcpf(1.f + __builtin_amdgcn_exp2f(-v * 1.4426950408889634f)); }
  __syncthreads();
  float* part = s + 9 * 1024;
  for (int item = blockIdx.x; item < 2 * 96; item += gridDim.x) {
    const int cb = item % 96, l = item / 96; const int kq = t >> 6, col = t & 63;
    const int j = cb * 64 + col; const float* wp = ada_w + ((long)l * DM + kq * 256) * 6144 + j;
    float acc[9];
#pragma unroll
    for (int bb = 0; bb < 9; ++bb) acc[bb] = 0.f;
#pragma unroll 16
    for (int k = 0; k < 256; ++k) { float w = wp[(long)k * 6144];
#pragma unroll
      for (int bb = 0; bb < 9; ++bb) acc[bb] += s[bb * 1024 + kq * 256 + k] * w; }
#pragma unroll
    for (int bb = 0; bb < 9; ++bb) part[(kq * 9 + bb) * 64 + col] = acc[bb];
    __syncthreads();
    for (int i = t; i < 9 * 64; i += 256) { int bb = i >> 6, cc = i & 63;
      float v = ((part[(0 * 9 + bb) * 64 + cc] + part[(1 * 9 + bb) * 64 + cc]) + part[(2 * 9 + bb) * 64 + cc]) + part[(3 * 9 + bb) * 64 + cc];
      mod[((long)l * (BATCH + 1) + bb) * 6144 + cb * 64 + cc] = v + ada_b[l * 6144 + cb * 64 + cc]; }
    __syncthreads();
  }
}

__global__ void __launch_bounds__(256, 2) mega_kernel(MegaP p) {
  __shared__ __attribute__((aligned(16))) char smem[MEGA_LDS_BYTES];
  __shared__ uint4 xb_words;
  const int t0 = threadIdx.x;
#if !MEGA_CG
  if (t0 == 0) xb_words = make_uint4(0u, 0u, 0u, 0u);
  __syncthreads();
  (void)xcd_barrier_post((unsigned*)p.ws, (volatile LAS unsigned*)&xb_words);
#endif
  const long MA = NROWS; const int TM = NROWS / 128;
#define I (kp_->in)
  const int scan_role = (int)blockIdx.x < BATCH * 24 ? 1 : 0;
  { DIL_BEGIN(0)
  PH(0) {
    KP_DECL; char* ws = kp_->ws; const int t = tid_opaque();
    float* xs = WS_PTR(float, WO.xs); float* mod = WS_PTR(float, WO.mod);
    for (long i = (long)blockIdx.x * 256 + t; i < MA * DM / 4; i += (long)gridDim.x * 256) {
      long e = i * 4; int d = e % DM; long row = e / DM; int b = row / RB, lr = row % RB;
      const float* src = lr < SEQ ? I.x + ((long)b * SEQ + lr) * DM + d : I.ctx + ((long)b * CTX_LEN + (lr - SEQ)) * DM + d;
      *(f32x4*)(xs + e) = *(const f32x4*)src;
    }
    ph_mod_gemv(I.c, I.c_ctx, I.ada_w, I.ada_b, mod, smem);
    for (int l = 0; l < 2; ++l) {
      ph_cvt_wT_tiled(I.w_in + (long)l * DM * IN_COLS, nullptr, WS_PTR(bf16_t, WO.w_inT) + (long)l * 2688 * 1024, 1024, IN_COLS, 2688, 1024, smem);
      ph_cvt_wT_tiled(I.w_out + (long)l * DM * DM, nullptr, WS_PTR(bf16_t, WO.w_outT) + (long)l * 1024 * 1024, 1024, 1024, 1024, 1024, smem);
      ph_cvt_wT_tiled(I.pe_wq + (long)l * DM * 2048, nullptr, WS_PTR(bf16_t, WO.wqT) + (long)l * 2048 * 1024, 1024, 2048, 2048, 1024, smem);
      ph_cvt_wT_tiled(I.mla_w_qb + (long)l * 256 * 384, I.mla_q_norm_g + l * 256, WS_PTR(bf16_t, WO.wqbT) + (long)l * 384 * 256, 256, 384, 384, 256, smem);
      ph_cvt_wT_tiled(I.mla_w_kvb + (long)l * 128 * 512, I.mla_kv_norm_g + l * 128, WS_PTR(bf16_t, WO.wkvbT) + (long)l * 512 * 128, 128, 512, 512, 128, smem);
      for (int d = 0; d < 2; ++d) {
        ph_cvt_wT_tiled(I.rw_w2 + ((long)l * 2 + d) * 64 * 384, nullptr, WS_PTR(bf16_t, WO.w2T) + ((long)l * 2 + d) * 384 * 64, 64, 384, 384, 64, smem);
        ph_cvt_wT_tiled(I.rw_a2 + ((long)l * 2 + d) * 64 * 384, nullptr, WS_PTR(bf16_t, WO.a2T) + ((long)l * 2 + d) * 384 * 64, 64, 384, 384, 64, smem);
      }
      ph_cvt_wT_tiled(I.rw_g2 + (long)l * 160 * 384, nullptr, WS_PTR(bf16_t, WO.g2T) + (long)l * 384 * 192, 160, 384, 384, 192, smem);
    }
    ph_cvt_bf16(I.pe_keys, WS_PTR(bf16_t, WO.keysb), 2L * 16 * 128 * 128 / 8);
    ph_rope_tables(WS_PTR(float, WO.rope_g), WS_PTR(float, WO.rope_m));
  }
  DIL_END(0) }
  GRID_BARRIER();
  for (int lq = 0; lq < 2; ++lq) {
    int l = lq; LAUNDER_S(l);
    { DIL_BEGIN(1)
    PH(1) if (l == 0) {
      KP_DECL; char* ws = kp_->ws; const int t = tid_opaque(); (void)t;
      ph_norm_mod(WS_PTR(float, WO.xs), I.norm_mix_g + l * DM, WS_PTR(float, WO.mod) + (long)l * (BATCH + 1) * 6144, 0, WS_PTR(bf16_t, WO.xn));
    }
    DIL_END(1) }
    GRID_BARRIER();
    { DIL_BEGIN(2)
    PH(2) {
      KP_DECL; char* ws = kp_->ws; const int t = tid_opaque(); (void)t;
      const bf16_t* xn = WS_PTR(bf16_t, WO.xn); const bf16_t* wT = WS_PTR(bf16_t, WO.w_inT) + (long)l * 2688 * 1024; bf16_t* Pb = WS_PTR(bf16_t, WO.Pb);
      XCD_TILE_LOOP(tile, TM * 21)
        gemm_tile_128_glds(xn, DM, wT, 1024, 1024, tile / 21, tile % 21, smem, EpiStoreBf16{Pb, IN_COLS, IN_COLS});
    }
    DIL_END(2) }
    GRID_BARRIER();
    { DIL_BEGIN(3)
    PH(3) {
      KP_DECL; char* ws = kp_->ws; const int t = tid_opaque(); (void)t;
      PrepW pw{WS_PTR(bf16_t, WO.wqbT) + (long)l * 384 * 256, WS_PTR(bf16_t, WO.wkvbT) + (long)l * 512 * 128, WS_PTR(bf16_t, WO.w2T) + (long)l * 2 * 384 * 64,
               WS_PTR(bf16_t, WO.a2T) + (long)l * 2 * 384 * 64, WS_PTR(bf16_t, WO.g2T) + (long)l * 384 * 192, I.rw_mu + (long)l * 2 * RWC, I.rw_w0 + l * 768, I.rw_a0 + l * 768};
      PrepBuf pb{WS_PTR(bf16_t, WO.Pb), WS_PTR(bf16_t, WO.tq), WS_PTR(bf16_t, WO.tkv), WS_PTR(bf16_t, WO.a_b), WS_PTR(bf16_t, WO.g_b), WS_PTR(float, WO.w_f)};
      XCD_TILE_LOOP(tile, TM * 22) prep_gemm_tile(pw, pb, tile / 22, tile % 22, smem);
    }
    DIL_END(3) }
    GRID_BARRIER();
    { DIL_BEGIN(4)
    PH(4) {
      KP_DECL; char* ws = kp_->ws; const int t = tid_opaque(); (void)t;
      FinW2 fw{I.mla_qk_g + l * 192, I.gqa_qk_g + l * 128, I.rw_mu + (long)l * 2 * RWC, I.rw_k_k + l * 384, I.rw_k_a + l * 384, WS_PTR(float, WO.rope_g), WS_PTR(float, WO.rope_m)};
      FinBuf fb{WS_PTR(bf16_t, WO.Pb), WS_PTR(bf16_t, WO.tq), WS_PTR(bf16_t, WO.tkv), WS_PTR(bf16_t, WO.a_b), WS_PTR(bf16_t, WO.mq), WS_PTR(bf16_t, WO.mk), WS_PTR(bf16_t, WO.mvT),
                WS_PTR(bf16_t, WO.gq), WS_PTR(bf16_t, WO.gk), WS_PTR(bf16_t, WO.gvT), WS_PTR(bf16_t, WO.r_b), WS_PTR(bf16_t, WO.v_b), WS_PTR(bf16_t, WO.kk_b), WS_PTR(bf16_t, WO.kd_b), WS_PTR(bf16_t, WO.bd_b)};
      for (int tile = blockIdx.x; tile < NROWS / 8; tile += gridDim.x) prep_finish_tile2(fw, fb, tile, smem);
    }
    DIL_END(4) }
    GRID_BARRIER();
    { unsigned long long dil_t0 = 0, dil_scan = 0; if (DIL_PH == 5 || DIL_PH == 11) dil_t0 = __builtin_amdgcn_s_memrealtime();
    PH(5) {
      KP_DECL; char* ws = kp_->ws; const int t = tid_opaque(); (void)t;
      int* s_item = (int*)(smem + MEGA_LDS_BYTES - 16);
      unsigned* sctr = (unsigned*)ws + XB_QUEUE(4 + l);
      auto scan_loop = [&]() {
        for (;;) {
          __syncthreads();
          if (t == 0) *s_item = (int)xb_add(sctr, 1u);
          __syncthreads();
          const int it = *s_item;
          if (it >= BATCH * 24) break;
          rw_scan_block(WS_PTR(bf16_t, WO.r_b), WS_PTR(bf16_t, WO.v_b), WS_PTR(bf16_t, WO.kk_b), WS_PTR(bf16_t, WO.kd_b), WS_PTR(bf16_t, WO.bd_b), WS_PTR(float, WO.w_f), WS_PTR(float, WO.Pb),
                        it, (long)MA * 384, smem);
        }
      };
      if (scan_role) scan_loop();
      const int nqt = l == 0 ? 18 : 16; const int n_mla = BATCH * 4 * nqt, n_all = BATCH * 10 * nqt;
      unsigned* qctr = (unsigned*)ws + XB_QUEUE(l);
      for (;;) {
        __syncthreads();
        if (t == 0) *s_item = (int)xb_add(qctr, 1u);
        __syncthreads();
        const int it = *s_item;
        if (it >= n_all) break;
        const KARG_AS MegaP* kp2_ = (const KARG_AS MegaP*)__builtin_amdgcn_kernarg_segment_ptr(); LAUNDER_S(kp2_); char* ws2 = kp2_->ws;
        if (it < n_mla) { int qt = it / (BATCH * 4), r = it % (BATCH * 4);
          attn_block<96>((const bf16_t*)(ws2 + WO.mq), 4, (const bf16_t*)(ws2 + WO.mk), 4, (const bf16_t*)(ws2 + WO.mvT), 1, (bf16_t*)(ws2 + WO.tq), 0, r / 4, r % 4, qt, smem, kp2_->in.mla_qk_g + l * 192); }
        else { int v = it - n_mla; int qt = v / (BATCH * 6), r = v % (BATCH * 6);
          attn_block<64>((const bf16_t*)(ws2 + WO.gq), 6, (const bf16_t*)(ws2 + WO.gk), 2, (const bf16_t*)(ws2 + WO.gvT), 3, (bf16_t*)(ws2 + WO.tq), 640, r / 6, r % 6, qt, smem, kp2_->in.gqa_qk_g + l * 128); }
      }
      if (!scan_role) scan_loop();
      {
        unsigned* cctr = (unsigned*)ws + XB_QUEUE(2 + l);
        for (;;) {
          __syncthreads();
          if (t == 0) *s_item = (int)xb_add(cctr, 1u);
          __syncthreads();
          const int it = *s_item;
          if (it >= 512) break;
          const int tab = it >> 8, r0 = (it & 255) * 64;
          if (tab == 0) ph_cvt_fp8_rows(I.pe_u + (long)l * 16384 * DM, WS_PTR(unsigned char, TAB_U), WS_PTR(float, TAB_SU), r0, r0 + 64);
          else ph_cvt_fp8_rows(I.pe_v + (long)l * 16384 * DM, WS_PTR(unsigned char, TAB_V), WS_PTR(float, TAB_SV), r0, r0 + 64);
        }
      }
    }
#if DIL_PH == 11
    GRID_BARRIER(); if (blockIdx.x == 0 && threadIdx.x == 0) { unsigned long long t1 = __builtin_amdgcn_s_memrealtime(); unsigned long long dt = dil_scan * DIL_MULT; while (__builtin_amdgcn_s_memrealtime() - t1 < dt) __builtin_amdgcn_s_sleep(32); }
#endif
    (void)dil_scan;
    DIL_END(5) }
    GRID_BARRIER();
    { DIL_BEGIN(6)
    PH(6) {
      KP_DECL; char* ws = kp_->ws; const int t = tid_opaque(); (void)t;
      RdW rw{I.rw_r_k + l * 384, I.rw_ln_g + l * 384, I.rw_ln_b + l * 384};
      for (long row = blockIdx.x * 4 + (t >> 6); row < NROWS; row += (long)gridDim.x * 4)
        if (l == 0 || (row % RB) < SEQ) rw_readout_row2(rw, WS_PTR(float, WO.Pb), WS_PTR(bf16_t, WO.r_b), WS_PTR(bf16_t, WO.v_b), WS_PTR(bf16_t, WO.kd_b), WS_PTR(bf16_t, WO.g_b), WS_PTR(bf16_t, WO.tq), row, t & 63);
    }
    DIL_END(6) }
    GRID_BARRIER();
    { DIL_BEGIN(7)
    PH(7) {
      KP_DECL; char* ws = kp_->ws; const int t = tid_opaque(); (void)t;
      const bf16_t* mix = WS_PTR(bf16_t, WO.tq); const bf16_t* wT = WS_PTR(bf16_t, WO.w_outT) + (long)l * 1024 * 1024; float* xs = WS_PTR(float, WO.xs);
      const float* modl = WS_PTR(float, WO.mod) + (long)l * (BATCH + 1) * 6144;
      const int TM7 = l == 0 ? TM : BATCH * 16;
      XCD_TILE_LOOP(tile, TM7 * 8)
        gemm_tile_128_glds(mix, DM, wT, 1024, 1024, l == 0 ? tile / 8 : LAT_TM(tile / 8), tile % 8, smem, EpiResid{xs, modl, 2, 0});
    }
    DIL_END(7) }
    GRID_BARRIER();
    { DIL_BEGIN(8)
    PH(8) {
      KP_DECL; char* ws = kp_->ws; const int t = tid_opaque(); (void)t;
      ph_norm_mod(WS_PTR(float, WO.xs), I.norm_ffn_g + l * DM, WS_PTR(float, WO.mod) + (long)l * (BATCH + 1) * 6144, 3, WS_PTR(bf16_t, WO.xn), l != 0);
    }
    DIL_END(8) }
    GRID_BARRIER();
    { DIL_BEGIN(9)
    PH(9) {
      KP_DECL; char* ws = kp_->ws; const int t = tid_opaque(); (void)t;
      const bf16_t* xn = WS_PTR(bf16_t, WO.xn); const bf16_t* wT = WS_PTR(bf16_t, WO.wqT) + (long)l * 2048 * 1024; const bf16_t* kb = WS_PTR(bf16_t, WO.keysb) + (long)l * 16 * 128 * 128;
      unsigned* top1 = WS_PTR(unsigned, WO.tq);
      const int TM9 = l == 0 ? TM : BATCH * 16;
      XCD_TILE_LOOP(tile, TM9 * 16) { peer_q_top1_tile(xn, wT, kb, top1, l == 0 ? tile / 16 : LAT_TM(tile / 16), tile % 16, smem); __syncthreads(); }
    }
    DIL_END(9) }
    GRID_BARRIER();
    { DIL_BEGIN(10)
    PH(10) {
      KP_DECL; char* ws = kp_->ws; const int t = tid_opaque(); (void)t;
      const float* modl = WS_PTR(float, WO.mod) + (long)l * (BATCH + 1) * 6144;
      const int ntok10 = l == 0 ? NROWS : BATCH * SEQ;
      peer_lists_build3(WS_PTR(unsigned, WO.tq), WS_PTR(float, TAB_SU), WS_PTR(float, TAB_SV), WS_PTR(char, WO.mq), ntok10, smem);
#ifdef BUILD_TWICE
      peer_lists_build3(WS_PTR(unsigned, WO.tq), WS_PTR(float, TAB_SU), WS_PTR(float, TAB_SV), WS_PTR(char, WO.mq), ntok10, smem);
#endif
      peer_gather_sweep3(WS_PTR(bf16_t, WO.xn), WS_PTR(char, WO.mq), WS_PTR(unsigned char, TAB_U), WS_PTR(unsigned char, TAB_V), modl, WS_PTR(float, WO.xs), ntok10, smem,
                         I.norm_mix_g + (l == 0 ? DM : 0), WS_PTR(float, WO.mod) + (long)(l == 0 ? 1 : 0) * (BATCH + 1) * 6144, WS_PTR(bf16_t, WO.xn), l == 0 ? (float*)nullptr : kp_->out);
    }
    DIL_END(10) }
    GRID_BARRIER();
  }
}

extern "C" void kernel_launch(void* const* d_in, const int* in_sizes, int n_in, void* d_out, int out_size, void* d_ws, size_t ws_size,
                              hipStream_t stream) {
  MegaP p{};
  const float** pp = (const float**)&p.in;
  for (int i = 0; i < 31; ++i) pp[i] = (const float*)d_in[i];
  p.ws = (char*)d_ws; p.out = (float*)d_out;
  if (WO.total > ws_size) return;
  static int grid_blocks = 0;
  if (!grid_blocks) {
    int dev = 0, cus = 0, per_cu = 0;
    hipGetDevice(&dev);
    hipDeviceGetAttribute(&cus, hipDeviceAttributeMultiprocessorCount, dev);
    hipOccupancyMaxActiveBlocksPerMultiprocessor(&per_cu, mega_kernel, 256, 0);
    if (per_cu > 2) per_cu = 2;
    if (per_cu < 1) per_cu = 1;
    grid_blocks = cus * per_cu;
  }
  hipMemsetAsync(d_ws, 0, 32768, stream);
  void* args[] = {&p};
  hipLaunchCooperativeKernel((void*)mega_kernel, dim3(grid_blocks), dim3(256), args, 0, stream);
}
```

```cpp
#include <hip/hip_runtime.h>
#define PEER_EXP(x) __builtin_amdgcn_exp2f((x) * 1.4426950408889634f)
#ifndef BATCH
#define BATCH 8
#endif
#ifndef SEQ
#define SEQ 2048
#endif
#ifndef CTX_LEN
#define CTX_LEN 256
#endif
#define DM 1024
#define RB (SEQ + CTX_LEN)
#define NROWS (BATCH * RB)
#define IN_COLS 2624
#define MLA_OFF 0
#define RW_OFF 416
#define GQA_OFF 1984
#define RWC 1568
#define EPSN 1e-6f

__device__ inline float sigmoidf_(float x) { return 1.f / (1.f + expf(-x)); }
__device__ inline float siluf_(float x) { return x * sigmoidf_(x); }
__device__ inline float softplusf_(float x) { return fmaxf(x, 0.f) + log1pf(expf(-fabsf(x))); }
__device__ inline float geluf_(float x) { return 0.5f * x * (1.f + tanhf(0.7978845608028654f * (x + 0.044715f * x * x * x))); }

__global__ void nk_copy_in(const float* x, const float* ctx, float* xs) {
  long i = (long)blockIdx.x * blockDim.x + threadIdx.x;
  if (i >= (long)NROWS * DM) return;
  int d = i % DM; long row = i / DM; int b = row / RB, lr = row % RB;
  xs[i] = lr < SEQ ? x[((long)b * SEQ + lr) * DM + d] : ctx[((long)b * CTX_LEN + (lr - SEQ)) * DM + d];
}
__global__ void nk_copy_out(const float* xs, float* out) {
  long i = (long)blockIdx.x * blockDim.x + threadIdx.x;
  if (i >= (long)BATCH * SEQ * DM) return;
  int d = i % DM; long row = i / DM; int b = row / SEQ, t = row % SEQ;
  out[i] = xs[((long)b * RB + t) * DM + d];
}
__global__ void nk_mod(const float* c, const float* c_ctx, const float* ada_w, const float* ada_b, float* mod) {
  long i = (long)blockIdx.x * blockDim.x + threadIdx.x;
  if (i >= 2L * (BATCH + 1) * 6144) return;
  int j = i % 6144; int bb = (i / 6144) % (BATCH + 1); int l = i / (6144 * (BATCH + 1));
  const float* cv = bb < BATCH ? c + (long)bb * DM : c_ctx;
  const float* w = ada_w + (long)l * DM * 6144;
  float acc = 0.f;
  for (int k = 0; k < DM; ++k) acc += siluf_(cv[k]) * w[(long)k * 6144 + j];
  mod[i] = acc + ada_b[l * 6144 + j];
}
__global__ void nk_norm_mod(const float* xs, const float* g, const float* modl, int shift_idx, float* xn, int M, int bidx) {
  long row = (long)blockIdx.x * blockDim.x + threadIdx.x;
  if (row >= M) return;
  int lr = row % RB; int bb = lr < SEQ ? bidx : BATCH;
  const float* sh = modl + ((long)bb * 6 + shift_idx) * DM; const float* sc = sh + DM;
  const float* xr = xs + row * DM; float ss = 0.f;
  for (int d = 0; d < DM; ++d) ss += xr[d] * xr[d];
  float inv = 1.f / sqrtf(ss / DM + EPSN);
  for (int d = 0; d < DM; ++d) xn[row * DM + d] = xr[d] * inv * g[d] * (1.f + sc[d]) + sh[d];
}
__global__ void nk_gemm(const float* A, const float* W, float* C, int M, int N, int K) {
  long i = (long)blockIdx.x * blockDim.x + threadIdx.x;
  if (i >= (long)M * N) return;
  int n = i % N; long m = i / N; float acc = 0.f;
  for (int k = 0; k < K; ++k) acc += A[m * K + k] * W[(long)k * N + n];
  C[i] = acc;
}
__global__ void nk_mla_q1(const float* P, const float* qng, const float* wqb, float* tq, int M) {
  long i = (long)blockIdx.x * blockDim.x + threadIdx.x;
  if (i >= (long)M * 384) return;
  int j = i % 384; long r = i / 384; const float* cq = P + r * IN_COLS;
  float ss = 0.f; for (int k = 0; k < 256; ++k) ss += cq[k] * cq[k];
  float inv = 1.f / sqrtf(ss / 256 + EPSN), acc = 0.f;
  for (int k = 0; k < 256; ++k) acc += cq[k] * inv * qng[k] * wqb[k * 384 + j];
  tq[i] = acc;
}
__global__ void nk_mla_kv1(const float* P, const float* kvng, const float* wkvb, float* tkv, int M) {
  long i = (long)blockIdx.x * blockDim.x + threadIdx.x;
  if (i >= (long)M * 512) return;
  int j = i % 512; long r = i / 512; const float* ck = P + r * IN_COLS + 256;
  float ss = 0.f; for (int k = 0; k < 128; ++k) ss += ck[k] * ck[k];
  float inv = 1.f / sqrtf(ss / 128 + EPSN), acc = 0.f;
  for (int k = 0; k < 128; ++k) acc += ck[k] * inv * kvng[k] * wkvb[k * 512 + j];
  tkv[i] = acc;
}
__global__ void nk_mla_qk2(const float* P, const float* tq, const float* tkv, const float* qkg, float* mq, float* mk, int M) {
  long i = (long)blockIdx.x * blockDim.x + threadIdx.x;
  if (i >= (long)M * 8) return;
  int which = i % 2, h = (i / 2) % 4; long r = i / 8; int lr = r % RB;
  float ss = 0.f;
  for (int e = 0; e < 96; ++e) {
    float v = which == 0 ? tq[r * 384 + h * 96 + e] : (e < 64 ? tkv[r * 512 + h * 128 + e] : P[r * IN_COLS + 384 + (e - 64)]);
    ss += v * v;
  }
  float inv = 1.f / sqrtf(ss / 96 + EPSN);
  const float* g = qkg + which * 96; float* o = (which == 0 ? mq : mk) + r * 384 + h * 96;
  for (int e = 0; e < 64; ++e) {
    float v = which == 0 ? tq[r * 384 + h * 96 + e] : tkv[r * 512 + h * 128 + e];
    o[e] = v * inv * g[e];
  }
  for (int j = 0; j < 16; ++j) {
    float va = which == 0 ? tq[r * 384 + h * 96 + 64 + j] : P[r * IN_COLS + 384 + j];
    float vb = which == 0 ? tq[r * 384 + h * 96 + 80 + j] : P[r * IN_COLS + 384 + 16 + j];
    va *= inv * g[64 + j]; vb *= inv * g[80 + j];
    if (lr < SEQ) {
      int pos = j < 8 ? lr / 64 : lr % 64; float fr = powf(10000.f, -(float)(j & 7) / 8.f);
      float ang = (float)pos * fr, cs = cosf(ang), sn = sinf(ang);
      o[64 + j] = va * cs - vb * sn; o[80 + j] = va * sn + vb * cs;
    } else { o[64 + j] = va; o[80 + j] = vb; }
  }
}
__global__ void nk_gqa_prep(const float* P, const float* qkg, float* gq, float* gk, int M) {
  long i = (long)blockIdx.x * blockDim.x + threadIdx.x;
  if (i >= (long)M * 8) return;
  int h = i % 8; long r = i / 8; int lr = r % RB;
  const float* src = P + r * IN_COLS + GQA_OFF + h * 64;
  const float* g = qkg + (h < 6 ? 0 : 64);
  float* o = h < 6 ? gq + r * 384 + h * 64 : gk + r * 128 + (h - 6) * 64;
  float ss = 0.f; for (int e = 0; e < 64; ++e) ss += src[e] * src[e];
  float inv = 1.f / sqrtf(ss / 64 + EPSN);
  for (int j = 0; j < 32; ++j) {
    float va = src[j] * inv * g[j], vb = src[32 + j] * inv * g[32 + j];
    if (lr < SEQ) {
      int pos = j < 16 ? lr / 64 : lr % 64; float fr = powf(10000.f, -(float)(j & 15) / 16.f);
      float ang = (float)pos * fr, cs = cosf(ang), sn = sinf(ang);
      o[j] = va * cs - vb * sn; o[32 + j] = va * sn + vb * cs;
    } else { o[j] = va; o[32 + j] = vb; }
  }
}
template <int DQ>
__global__ void __launch_bounds__(256) nk_attn(const float* q, int qs, const float* k, int ks, const float* v, int vs, int vhs, int H, int G, float* mix, int ooff, int M) {
  long i = (long)blockIdx.x * blockDim.x + threadIdx.x;
  if (i >= (long)M * H) return;
  int h = i % H; long r = i / H; int b = r / RB, lr = r % RB; int kh = h / G;
  float qv[DQ];
#pragma unroll
  for (int e = 0; e < DQ; ++e) qv[e] = q[r * qs + h * DQ + e];
  float acc[64];
#pragma unroll
  for (int e = 0; e < 64; ++e) acc[e] = 0.f;
  float mx = -1e30f, l = 0.f; const float scale = 1.f / sqrtf((float)DQ);
  int k0 = lr < SEQ ? 0 : SEQ, k1 = RB;
  for (int kr = k0; kr < k1; ++kr) {
    long rr = (long)b * RB + kr; const float* kp = k + rr * ks + kh * DQ; float s = 0.f;
#pragma unroll
    for (int e = 0; e < DQ; ++e) s += qv[e] * kp[e];
    s *= scale;
    float mn = fmaxf(mx, s), al = expf(mx - mn), pp = expf(s - mn);
    l = l * al + pp; mx = mn; const float* vp = v + rr * vs + kh * vhs;
#pragma unroll
    for (int e = 0; e < 64; ++e) acc[e] = acc[e] * al + pp * vp[e];
  }
#pragma unroll
  for (int e = 0; e < 64; ++e) mix[r * DM + ooff + h * 64 + e] = acc[e] / l;
}
__global__ void nk_rw_shift(const float* P, const float* mu, float* rwx, int M) {
  long i = (long)blockIdx.x * blockDim.x + threadIdx.x;
  if (i >= (long)M * RWC) return;
  int c = i % RWC; long r = i / RWC; int lr = r % RB;
  bool first = (lr == 0) || (lr == SEQ), last = (lr == SEQ - 1) || (lr == RB - 1);
  float p = P[r * IN_COLS + RW_OFF + c];
  float pv = first ? 0.f : P[(r - 1) * IN_COLS + RW_OFF + c], nx = last ? 0.f : P[(r + 1) * IN_COLS + RW_OFF + c];
  rwx[i] = p + mu[c] * (pv - p) + mu[RWC + c] * (nx - p);
}
__global__ void nk_rw_prep(const float* rwx, const float* w0, const float* w2, const float* a0, const float* a2, const float* g2,
                           const float* k_k, const float* k_a, float* dec, float* kd, float* bd, float* kk, float* gg, int M) {
  long i = (long)blockIdx.x * blockDim.x + threadIdx.x;
  if (i >= (long)M * 384) return;
  int c = i % 384; long r = i / 384; int h = c / 64; const float* xr = rwx + r * RWC;
  float kv = xr[384 + c];
  float ss = 0.f; for (int n = 0; n < 64; ++n) { float t = xr[384 + h * 64 + n] * k_k[h * 64 + n]; ss += t * t; }
  float kkv = kv * k_k[c] / sqrtf(ss + 1e-12f);
  kk[i] = kkv;
  for (int d = 0; d < 2; ++d) {
    float wr = w0[d * 384 + c], ar = a0[d * 384 + c];
    for (int j = 0; j < 64; ++j) { wr += tanhf(xr[1152 + d * 64 + j]) * w2[(d * 64 + j) * 384 + c]; ar += xr[1280 + d * 64 + j] * a2[(d * 64 + j) * 384 + c]; }
    float dc = expf(-expf(-softplusf_(-wr) - 0.5f)); float a = sigmoidf_(ar);
    dec[(long)d * M * 384 + i] = dc; kd[(long)d * M * 384 + i] = kv * (1.f + (a - 1.f) * k_a[c]); bd[(long)d * M * 384 + i] = kkv * a;
  }
  float g = 0.f; for (int j = 0; j < 160; ++j) g += sigmoidf_(xr[1408 + j]) * g2[j * 384 + c];
  gg[i] = g;
}
__global__ void __launch_bounds__(256) nk_rw_scan(const float* rwx, const float* dec, const float* kd, const float* bd, const float* kk, float* y, int M, int nb) {
  long t = (long)blockIdx.x * blockDim.x + threadIdx.x;
  if (t >= (long)nb * 2 * 6 * 64) return;
  int i = t % 64, h = (t / 64) % 6, d = (t / 384) % 2, b = t / 768;
  float S[64];
#pragma unroll
  for (int j = 0; j < 64; ++j) S[j] = 0.f;
  for (int step = 0; step < RB; ++step) {
    int lr;
    if (step < CTX_LEN) lr = SEQ + (d == 0 ? step : CTX_LEN - 1 - step);
    else lr = d == 0 ? step - CTX_LEN : SEQ - 1 - (step - CTX_LEN);
    long r = (long)b * RB + lr; long o = (long)d * M * 384 + r * 384 + h * 64;
    const float* rp = rwx + r * RWC + h * 64; const float* wp = dec + o; const float* kp = kd + o; const float* bp = bd + o; const float* kkp = kk + r * 384 + h * 64;
    float vi = rwx[r * RWC + 768 + h * 64 + i];
    float skk = 0.f;
#pragma unroll
    for (int j = 0; j < 64; ++j) skk += S[j] * kkp[j];
    float yy = 0.f;
#pragma unroll
    for (int j = 0; j < 64; ++j) { S[j] = S[j] * wp[j] - skk * bp[j] + vi * kp[j]; yy += S[j] * rp[j]; }
    y[o + i] = yy;
  }
}
__global__ void nk_rw_readout(const float* rwx, const float* y, const float* kd, const float* gg, const float* r_k, const float* ln_g, const float* ln_b, float* mix, int M, long yds) {
  long i = (long)blockIdx.x * blockDim.x + threadIdx.x;
  if (i >= (long)M * 6) return;
  int h = i % 6; long r = i / 6; long o = r * 384 + h * 64; long ds = (long)M * 384;
  float mean = 0.f; for (int n = 0; n < 64; ++n) mean += y[o + n] + y[yds + o + n];
  mean /= 64.f;
  float var = 0.f, coef = 0.f;
  for (int n = 0; n < 64; ++n) {
    float yy = y[o + n] + y[yds + o + n] - mean; var += yy * yy;
    coef += rwx[r * RWC + h * 64 + n] * (kd[o + n] + kd[ds + o + n]) * r_k[h * 64 + n];
  }
  var /= 64.f; float inv = 1.f / sqrtf(var + 64e-5f);
  for (int n = 0; n < 64; ++n) {
    float yn = (y[o + n] + y[yds + o + n] - mean) * inv * ln_g[h * 64 + n] + ln_b[h * 64 + n];
    mix[r * DM + 256 + h * 64 + n] = (yn + coef * rwx[r * RWC + 768 + h * 64 + n]) * gg[o + n];
  }
}
__global__ void nk_gemm_res(const float* A, const float* W, const float* modl, int gi, float* xs, int M, int bidx) {
  long i = (long)blockIdx.x * blockDim.x + threadIdx.x;
  if (i >= (long)M * DM) return;
  int j = i % DM; long r = i / DM; int lr = r % RB; int bb = lr < SEQ ? bidx : BATCH;
  float acc = 0.f; for (int k = 0; k < DM; ++k) acc += A[r * DM + k] * W[(long)k * DM + j];
  xs[i] += modl[((long)bb * 6 + gi) * DM + j] * acc;
}
__global__ void nk_peer_score(const float* pq, const float* keys, float* sc, int M) {
  long i = (long)blockIdx.x * blockDim.x + threadIdx.x;
  if (i >= (long)M * 2048) return;
  int k = i % 128, ps = (i / 128) % 16; long r = i / 2048;
  const float* q = pq + r * 2048 + ps * 128; const float* ky = keys + ((long)ps * 128 + k) * 128;
  float acc = 0.f; for (int d = 0; d < 128; ++d) acc += q[d] * ky[d];
  sc[i] = acc;
}
__global__ void nk_peer_top1(const float* sc, float* ts, int* ti, int M) {
  long i = (long)blockIdx.x * blockDim.x + threadIdx.x;
  if (i >= (long)M * 16) return;
  const float* s = sc + i * 128; float pv = 3e38f; int pi = -1;
  for (int t = 0; t < 16; ++t) {
    float bv = -3e38f; int bi = -1;
    for (int k = 0; k < 128; ++k) {
      float v = s[k]; bool ok = (v < pv) || (v == pv && k > pi);
      if (ok && (bi < 0 || v > bv)) { bv = v; bi = k; }
    }
    ts[i * 16 + t] = bv; ti[i * 16 + t] = bi; pv = bv; pi = bi;
  }
}
__global__ void nk_peer_top2(const float* ts, const int* ti, int* pe, float* pg, int M) {
  long i = (long)blockIdx.x * blockDim.x + threadIdx.x;
  if (i >= (long)M * 8) return;
  const float* s1 = ts + i * 32; const float* s2 = s1 + 16; const int* i1 = ti + i * 32; const int* i2 = i1 + 16;
  float pv = 3e38f; int pi = -1; float mx = 0.f, sum = 0.f;
  for (int t = 0; t < 16; ++t) {
    float bv = -3e38f; int bi = -1;
    for (int c = 0; c < 256; ++c) {
      float v = s1[c / 16] + s2[c % 16]; bool ok = (v < pv) || (v == pv && c > pi);
      if (ok && (bi < 0 || v > bv)) { bv = v; bi = c; }
    }
    if (t == 0) mx = bv;
    float e = expf(bv - mx); sum += e;
    pe[i * 16 + t] = i1[bi / 16] * 128 + i2[bi % 16]; pg[i * 16 + t] = e; pv = bv; pi = bi;
  }
  for (int t = 0; t < 16; ++t) pg[i * 16 + t] /= sum;
}
__global__ void nk_peer_act(const float* xn, const float* u, const int* pe, const float* pg, float* pw, int M) {
  long i = (long)blockIdx.x * blockDim.x + threadIdx.x;
  if (i >= (long)M * 128) return;
  long r = i / 128; const float* ur = u + (long)pe[i] * DM; const float* xr = xn + r * DM;
  float acc = 0.f; for (int d = 0; d < DM; ++d) acc += xr[d] * ur[d];
  pw[i] = pg[i] * geluf_(acc);
}
__global__ void nk_peer_out(const float* v, const int* pe, const float* pw, const float* modl, float* xs, int M, int bidx) {
  long i = (long)blockIdx.x * blockDim.x + threadIdx.x;
  if (i >= (long)M * DM) return;
  int j = i % DM; long r = i / DM; int lr = r % RB; int bb = lr < SEQ ? bidx : BATCH;
  float acc = 0.f; for (int k = 0; k < 128; ++k) acc += pw[r * 128 + k] * v[(long)pe[r * 128 + k] * DM + j];
  xs[i] += modl[((long)bb * 6 + 5) * DM + j] * acc;
}


#ifndef PEER_EXP
#define PEER_EXP(x) expf(x)
#endif
__device__ __forceinline__ unsigned f2sortable(float s) { unsigned f = __float_as_uint(s); return (f & 0x80000000u) ? ~f : (f | 0x80000000u); }
__device__ __forceinline__ float sortable2f(unsigned o) { unsigned f = (o & 0x80000000u) ? (o & 0x7fffffffu) : ~o; return __uint_as_float(f); }
__device__ __forceinline__ unsigned enc_key(float s, int idx) { return (f2sortable(s) & ~127u) | (unsigned)(127 - idx); }
__device__ __forceinline__ void dec_key(unsigned k, float& s, int& idx) { idx = 127 - (int)(k & 127u); s = sortable2f(k & ~127u); }
__device__ __forceinline__ unsigned umax_(unsigned a, unsigned b) { return a > b ? a : b; }
__device__ __forceinline__ unsigned umin_(unsigned a, unsigned b) { return a < b ? a : b; }
__device__ __forceinline__ void ins16(unsigned (&l)[16], unsigned x) {
#pragma unroll
  for (int i = 0; i < 16; ++i) { unsigned mx = umax_(l[i], x); x = umin_(l[i], x); l[i] = mx; }
}
__device__ __forceinline__ void merge16(unsigned (&a)[16], const unsigned (&brev)[16]) {
#pragma unroll
  for (int i = 0; i < 16; ++i) a[i] = umax_(a[i], brev[i]);
#pragma unroll
  for (int d = 8; d >= 1; d >>= 1)
#pragma unroll
    for (int i = 0; i < 16; ++i) if ((i & d) == 0) { unsigned hi = umax_(a[i], a[i + d]), lo = umin_(a[i], a[i + d]); a[i] = hi; a[i + d] = lo; }
}
__device__ __forceinline__ void peer_combine(const unsigned* L0, const unsigned* L1, int* e_out, float* g_out) {
  float s0[16], s1[16];
#pragma unroll
  for (int i = 0; i < 16; ++i) { int ix; dec_key(L0[i], s0[i], ix); dec_key(L1[i], s1[i], ix); }
  unsigned sel[16];
#pragma unroll
  for (int i = 0; i < 16; ++i) sel[i] = 0u;
#pragma unroll
  for (int i = 0; i < 16; ++i)
#pragma unroll
    for (int j = 0; j < 16; ++j)
      if ((i + 1) * (j + 1) <= 16) { unsigned k = (f2sortable(s0[i] + s1[j]) & ~255u) | (unsigned)(255 - (i * 16 + j)); ins16(sel, k); }
  float mx = -3e38f;
#pragma unroll
  for (int t = 0; t < 16; ++t) {
    int c = 255 - (int)(sel[t] & 255u); int i = c >> 4, j = c & 15;
    float a, b; int ia, ib; dec_key(L0[i], a, ia); dec_key(L1[j], b, ib);
    float s = a + b; e_out[t] = ia * 128 + ib; g_out[t] = s; mx = fmaxf(mx, s);
  }
  float sum = 0.f;
#pragma unroll
  for (int t = 0; t < 16; ++t) { float e = PEER_EXP(g_out[t] - mx); g_out[t] = e; sum += e; }
  float inv = 1.f / sum;
#pragma unroll
  for (int t = 0; t < 16; ++t) g_out[t] *= inv;
}
__global__ void hk_peer_top1(const float* pq, const float* keys, unsigned* top1, int M) {
  long i = (long)blockIdx.x * blockDim.x + threadIdx.x;
  if (i >= (long)M * 16) return;
  int ps = i % 16; long r = i / 16; const float* q = pq + r * 2048 + ps * 128;
  unsigned la[16], lb[16], lbr[16];
#pragma unroll
  for (int t = 0; t < 16; ++t) { la[t] = 0u; lb[t] = 0u; }
  for (int k = 0; k < 128; ++k) {
    const float* ky = keys + ((long)ps * 128 + k) * 128; float acc = 0.f;
    for (int d = 0; d < 128; ++d) acc += q[d] * ky[d];
    unsigned key = enc_key(acc, k);
    if (k < 64) ins16(la, key); else ins16(lb, key);
  }
#pragma unroll
  for (int t = 0; t < 16; ++t) lbr[t] = lb[15 - t];
  merge16(la, lbr);
#pragma unroll
  for (int t = 0; t < 16; ++t) top1[i * 16 + t] = la[t];
}
__global__ void hk_peer_combine(const unsigned* top1, int* pe, float* pg, int M) {
  long i = (long)blockIdx.x * blockDim.x + threadIdx.x;
  if (i >= (long)M * 8) return;
  peer_combine(top1 + i * 32, top1 + i * 32 + 16, pe + i * 16, pg + i * 16);
}
typedef unsigned short bf16_t;
__device__ __forceinline__ int tid_opaque() { int t = threadIdx.x; asm volatile("" : "+v"(t)); return t; }
typedef __attribute__((ext_vector_type(8))) short bf16x8;
typedef __attribute__((ext_vector_type(4))) float f32x4;
typedef __attribute__((ext_vector_type(16))) float f32x16;
typedef __attribute__((ext_vector_type(4))) unsigned u32x4;

typedef __attribute__((ext_vector_type(2))) __bf16 bf16v2;
typedef __attribute__((ext_vector_type(2))) float f32v2;
template <int CTRL> __device__ __forceinline__ float dpp_get(float x) { return __builtin_bit_cast(float, __builtin_amdgcn_update_dpp(0, __builtin_bit_cast(int, x), CTRL, 0xf, 0xf, true)); }
__device__ __forceinline__ float swz_xor4(float x) { return __builtin_bit_cast(float, __builtin_amdgcn_ds_swizzle(__builtin_bit_cast(int, x), 0x101F)); }
__device__ __forceinline__ float xor4_get(float x) { const int xi = __builtin_bit_cast(int, x);
  int r = __builtin_amdgcn_update_dpp(xi, xi, 0x114, 0xf, 0xA, false); r = __builtin_amdgcn_update_dpp(r, xi, 0x104, 0xf, 0x5, false); return __builtin_bit_cast(float, r); }
__device__ __forceinline__ float xor16_sum(float x) { const unsigned xi = __builtin_bit_cast(unsigned, x); auto q = __builtin_amdgcn_permlane16_swap(xi, xi, false, false);
  return __builtin_bit_cast(float, (unsigned)q[0]) + __builtin_bit_cast(float, (unsigned)q[1]); }
__device__ __forceinline__ float xor32_sum(float x) { const unsigned xi = __builtin_bit_cast(unsigned, x); auto q = __builtin_amdgcn_permlane32_swap(xi, xi, false, false);
  return __builtin_bit_cast(float, (unsigned)q[0]) + __builtin_bit_cast(float, (unsigned)q[1]); }
__device__ __forceinline__ float xor32_max(float x) { const unsigned xi = __builtin_bit_cast(unsigned, x); auto q = __builtin_amdgcn_permlane32_swap(xi, xi, false, false);
  return fmaxf(__builtin_bit_cast(float, (unsigned)q[0]), __builtin_bit_cast(float, (unsigned)q[1])); }
__device__ __forceinline__ unsigned pack2bf(float a, float b) { f32v2 v = {a, b}; bf16v2 r = __builtin_convertvector(v, bf16v2); return __builtin_bit_cast(unsigned, r); }
__device__ __forceinline__ bf16_t f2bf(float f) { return (bf16_t)(pack2bf(f, 0.f) & 0xffffu); }
__device__ __forceinline__ float bf2f(bf16_t h) { return __uint_as_float(((unsigned)h) << 16); }

__device__ __forceinline__ float fexp_(float x) { return __builtin_amdgcn_exp2f(x * 1.4426950408889634f); }
__device__ __forceinline__ float frcp_(float x) { return __builtin_amdgcn_rcpf(x); }
__device__ __forceinline__ float fsigmoid_(float x) { return frcp_(1.f + fexp_(-x)); }
__device__ __forceinline__ float ftanh_(float x) { return 1.f - 2.f * frcp_(fexp_(2.f * x) + 1.f); }
__device__ __forceinline__ float fgelu_(float x) { return x * fsigmoid_(1.5957691216057308f * (x + 0.044715f * x * x * x)); }
__device__ __forceinline__ float fdecay_(float w) { return fexp_(-0.6065306597126334f * fsigmoid_(w)); }
#define GEMM_LDS_BYTES 32768
struct ALoadPlain { const bf16_t* A; int lda;
  __device__ __forceinline__ u32x4 operator()(int row, int k) const { return *(const u32x4*)(A + (long)row * lda + k); } };
#define GEMM_STAGE_WRITE(RA, RB) do { _Pragma("unroll") for (int i = 0; i < 4; ++i) { int r = lrow + 32 * i; int off = r * 128 + ((lchunk ^ (r & 7)) << 4); *(u32x4*)(As + off) = RA[i]; *(u32x4*)(Bs + off) = RB[i]; } } while (0)
#define GEMM_COMPUTE_TILE() do { _Pragma("unroll") for (int ks = 0; ks < 2; ++ks) { bf16x8 af[4], bfr[4]; \
    _Pragma("unroll") for (int i = 0; i < 4; ++i) { int r = wm * 64 + i * 16 + fr; af[i] = *(const bf16x8*)(As + r * 128 + (((ks * 4 + fq) ^ (r & 7)) << 4)); \
      int rn = wn * 64 + i * 16 + fr; bfr[i] = *(const bf16x8*)(Bs + rn * 128 + (((ks * 4 + fq) ^ (rn & 7)) << 4)); } \
    _Pragma("unroll") for (int i = 0; i < 4; ++i) _Pragma("unroll") for (int j = 0; j < 4; ++j) acc[i][j] = __builtin_amdgcn_mfma_f32_16x16x32_bf16(bfr[j], af[i], acc[i][j], 0, 0, 0); } } while (0)
template <class ALoad, class Epi>
__device__ __forceinline__ void gemm_tile_128(ALoad aload, const bf16_t* __restrict__ Bt, int ldb, int K,
                                              int tile_m, int tile_n, char* smem, Epi epi) {
  const int t = tid_opaque(), lane = t & 63, wave = t >> 6;
  const int wm = wave >> 1, wn = wave & 1;
  char* As = smem; char* Bs = smem + 16384;
  const int lrow = t >> 3, lchunk = t & 7;
  const int arow = tile_m * 128 + lrow;
  const bf16_t* bg = Bt + (long)(tile_n * 128 + lrow) * ldb + lchunk * 8;
  u32x4 ra0[4], rb0[4], ra1[4], rb1[4];
#pragma unroll
  for (int i = 0; i < 4; ++i) { ra0[i] = aload(arow + 32 * i, lchunk * 8); rb0[i] = *(const u32x4*)(bg + (long)(32 * i) * ldb); }
  if (K > 64) {
#pragma unroll
    for (int i = 0; i < 4; ++i) { ra1[i] = aload(arow + 32 * i, 64 + lchunk * 8); rb1[i] = *(const u32x4*)(bg + (long)(32 * i) * ldb + 64); }
  }
  f32x4 acc[4][4];
#pragma unroll
  for (int i = 0; i < 4; ++i)
#pragma unroll
    for (int j = 0; j < 4; ++j) acc[i][j] = (f32x4){0.f, 0.f, 0.f, 0.f};
  const int fr = lane & 15, fq = lane >> 4;
  for (int k0 = 0; k0 < K; k0 += 128) {
    __syncthreads();
    GEMM_STAGE_WRITE(ra0, rb0);
    __syncthreads();
    if (k0 + 128 < K) {
#pragma unroll
      for (int i = 0; i < 4; ++i) { ra0[i] = aload(arow + 32 * i, k0 + 128 + lchunk * 8); rb0[i] = *(const u32x4*)(bg + (long)(32 * i) * ldb + k0 + 128); }
    }
    GEMM_COMPUTE_TILE();
    if (k0 + 64 < K) {
      __syncthreads();
      GEMM_STAGE_WRITE(ra1, rb1);
      __syncthreads();
      if (k0 + 192 < K) {
#pragma unroll
        for (int i = 0; i < 4; ++i) { ra1[i] = aload(arow + 32 * i, k0 + 192 + lchunk * 8); rb1[i] = *(const u32x4*)(bg + (long)(32 * i) * ldb + k0 + 192); }
      }
      GEMM_COMPUTE_TILE();
    }
  }
#pragma unroll
  for (int i = 0; i < 4; ++i)
#pragma unroll
    for (int j = 0; j < 4; ++j) {
      int m = tile_m * 128 + wm * 64 + i * 16 + fr; int n0 = tile_n * 128 + wn * 64 + j * 16 + fq * 4;
      epi(m, n0, acc[i][j]);
    }
}

typedef __attribute__((address_space(3))) void lds_void_t;
typedef __attribute__((address_space(1))) const void glb_cvoid_t;
#define GEMM_GLDS_BYTES 65536
__device__ __forceinline__ void gemm_mainloop_glds(const bf16_t* __restrict__ A, int lda, const bf16_t* __restrict__ Bt, int ldb, int K,
                                                   int tile_m, int tile_n, char* smem, f32x4 (&acc)[4][4]) {
  const int t = tid_opaque(), lane = t & 63, wave = t >> 6;
  const int wm = wave >> 1, wn = wave & 1, fr = lane & 15, fq = lane >> 4;
  const int lrow = t >> 3, cl = (t & 7) ^ (lrow & 7);
  const bf16_t* ag = A + (long)(tile_m * 128 + lrow) * lda + cl * 8;
  const bf16_t* bg = Bt + (long)(tile_n * 128 + lrow) * ldb + cl * 8;
  const int wbase = __builtin_amdgcn_readfirstlane(wave) * 1024;
#pragma unroll
  for (int i = 0; i < 4; ++i)
#pragma unroll
    for (int j = 0; j < 4; ++j) acc[i][j] = (f32x4){0.f, 0.f, 0.f, 0.f};
  __syncthreads();
#pragma unroll
  for (int i = 0; i < 4; ++i) {
    __builtin_amdgcn_global_load_lds((glb_cvoid_t*)(ag + (long)(32 * i) * lda), (lds_void_t*)(smem + i * 4096 + wbase), 16, 0, 0);
    __builtin_amdgcn_global_load_lds((glb_cvoid_t*)(bg + (long)(32 * i) * ldb), (lds_void_t*)(smem + 16384 + i * 4096 + wbase), 16, 0, 0);
  }
  int buf = 0;
  for (int k0 = 0; k0 < K; k0 += 64, buf ^= 1) {
    __syncthreads();
    if (k0 + 64 < K) {
      char* nb = smem + (buf ^ 1) * 32768;
#pragma unroll
      for (int i = 0; i < 4; ++i) {
        __builtin_amdgcn_global_load_lds((glb_cvoid_t*)(ag + (long)(32 * i) * lda + k0 + 64), (lds_void_t*)(nb + i * 4096 + wbase), 16, 0, 0);
        __builtin_amdgcn_global_load_lds((glb_cvoid_t*)(bg + (long)(32 * i) * ldb + k0 + 64), (lds_void_t*)(nb + 16384 + i * 4096 + wbase), 16, 0, 0);
      }
    }
    const char* As = smem + buf * 32768; const char* Bs = As + 16384;
    GEMM_COMPUTE_TILE();
  }
}
template <class Epi>
__device__ __forceinline__ void gemm_tile_128_glds(const bf16_t* __restrict__ A, int lda, const bf16_t* __restrict__ Bt, int ldb, int K,
                                                   int tile_m, int tile_n, char* smem, Epi epi) {
  f32x4 acc[4][4];
  gemm_mainloop_glds(A, lda, Bt, ldb, K, tile_m, tile_n, smem, acc);
  const int t = tid_opaque(), lane = t & 63, wave = t >> 6, wm = wave >> 1, wn = wave & 1, fr = lane & 15, fq = lane >> 4;
#pragma unroll
  for (int i = 0; i < 4; ++i)
#pragma unroll
    for (int j = 0; j < 4; ++j) {
      int m = tile_m * 128 + wm * 64 + i * 16 + fr; int n0 = tile_n * 128 + wn * 64 + j * 16 + fq * 4;
      epi(m, n0, acc[i][j]);
    }
}

__global__ void ok_cvt_wT(const float* W, bf16_t* Wt, int K, int N, int Npad) {
  long i = (long)blockIdx.x * blockDim.x + threadIdx.x;
  if (i >= (long)Npad * K) return;
  int k = i % K; int n = i / K;
  Wt[i] = n < N ? f2bf(W[(long)k * N + n]) : (bf16_t)0;
}
__global__ void ok_f32_to_bf16(const float* s, bf16_t* d, long n) {
  long i = (long)blockIdx.x * blockDim.x + threadIdx.x; if (i < n) d[i] = f2bf(s[i]);
}
__global__ void ok_bf16_to_f32(const bf16_t* s, float* d, long n) {
  long i = (long)blockIdx.x * blockDim.x + threadIdx.x; if (i < n) d[i] = bf2f(s[i]);
}
__global__ void ok_norm_mod_bf16(const float* xs, const float* g, const float* modl, int shift_idx, bf16_t* xn, int M) {
  int row = blockIdx.x * 4 + (threadIdx.x >> 6); int lane = threadIdx.x & 63;
  if (row >= M) return;
  int b = row / RB, lr = row % RB; int bb = lr < SEQ ? b : BATCH;
  const float* sh = modl + ((long)bb * 6 + shift_idx) * DM; const float* sc = sh + DM;
  const float* xr = xs + (long)row * DM; float v[16]; float ss = 0.f;
#pragma unroll
  for (int i = 0; i < 4; ++i) { float4 q = *(const float4*)(xr + i * 256 + lane * 4); v[i*4]=q.x; v[i*4+1]=q.y; v[i*4+2]=q.z; v[i*4+3]=q.w; ss += q.x*q.x+q.y*q.y+q.z*q.z+q.w*q.w; }
#pragma unroll
  for (int o = 32; o > 0; o >>= 1) ss += __shfl_xor(ss, o);
  float inv = __builtin_amdgcn_rsqf(ss / DM + EPSN);
#pragma unroll
  for (int i = 0; i < 4; ++i) {
    int d = i * 256 + lane * 4; float o[4];
#pragma unroll
    for (int e = 0; e < 4; ++e) o[e] = v[i*4+e] * inv * g[d+e] * (1.f + sc[d+e]) + sh[d+e];
    uint2 pk; pk.x = pack2bf(o[0], o[1]); pk.y = pack2bf(o[2], o[3]);
    *(uint2*)(xn + (long)row * DM + d) = pk;
  }
}

struct EpiStoreBf16 { bf16_t* C; int ldc; int N;
  __device__ __forceinline__ void operator()(int m, int n0, f32x4 v) const {
    if (n0 < N) { uint2 pk; pk.x = pack2bf(v[0], v[1]); pk.y = pack2bf(v[2], v[3]); *(uint2*)(C + (long)m * ldc + n0) = pk; } } };
struct EpiStoreF32 { float* C; int ldc; int N;
  __device__ __forceinline__ void operator()(int m, int n0, f32x4 v) const {
    if (n0 < N) *(float4*)(C + (long)m * ldc + n0) = make_float4(v[0], v[1], v[2], v[3]); } };
struct EpiResid { float* xs; const float* modl; int gi; int pad; const float* x_in; const float* ctx_in;
  __device__ __forceinline__ void operator()(int m, int n0, f32x4 v) const {
    int b = m / RB, lr = m % RB; int bb = lr < SEQ ? b : BATCH; const float* g = modl + ((long)bb * 6 + gi) * DM + n0;
    const float* src = x_in ? (lr < SEQ ? x_in + ((long)b * SEQ + lr) * DM + n0 : ctx_in + ((long)b * CTX_LEN + (lr - SEQ)) * DM + n0) : xs + (long)m * DM + n0;
    f32x4 x = *(const f32x4*)src;
    x[0] += g[0] * v[0]; x[1] += g[1] * v[1]; x[2] += g[2] * v[2]; x[3] += g[3] * v[3];
    *(f32x4*)(xs + (long)m * DM + n0) = x; } };

template <class Epi>
__global__ void __launch_bounds__(256) ok_gemm(const bf16_t* A, int lda, const bf16_t* Bt, int ldb, int K, int tiles_m, int tiles_n, Epi epi) {
  __shared__ __attribute__((aligned(16))) char smem[GEMM_LDS_BYTES];
  for (int tile = blockIdx.x; tile < tiles_m * tiles_n; tile += gridDim.x) {
    int tm = tile / tiles_n, tn = tile % tiles_n;
    gemm_tile_128(ALoadPlain{A, lda}, Bt, ldb, K, tm, tn, smem, epi);
  }
}

__device__ __forceinline__ float dot2bf(unsigned a, unsigned b, float c) {
  return __builtin_amdgcn_fdot2_f32_bf16(*(bf16v2*)&a, *(bf16v2*)&b, c, false);
}
__global__ void ok_cvt_bf16_v8(const float* s, bf16_t* d, long n8) {
  long i = (long)blockIdx.x * blockDim.x + threadIdx.x; if (i >= n8) return;
  float4 a = *(const float4*)(s + i * 8), b = *(const float4*)(s + i * 8 + 4);
  u32x4 o; o[0] = pack2bf(a.x, a.y); o[1] = pack2bf(a.z, a.w); o[2] = pack2bf(b.x, b.y); o[3] = pack2bf(b.z, b.w);
  *(u32x4*)(d + i * 8) = o;
}

#define P5_LDS_BYTES (128 * 128 * 4)
__device__ __forceinline__ void peer_q_top1_tile(const bf16_t* __restrict__ A, const bf16_t* __restrict__ WqT, const bf16_t* __restrict__ keysb,
                                                 unsigned* __restrict__ top1, int tm, int ps, char* smem) {
  const int t = tid_opaque(), lane = t & 63, wave = t >> 6, wm = wave >> 1, wn = wave & 1, fr = lane & 15, fq = lane >> 4;
  f32x4 acc[4][4];
  gemm_mainloop_glds(A, DM, WqT, DM, DM, tm, ps, smem, acc);
  __syncthreads();
  char* Qs = smem; char* Ks = smem + 32768;
#pragma unroll
  for (int i = 0; i < 4; ++i)
#pragma unroll
    for (int j = 0; j < 4; ++j) {
      int m = wm * 64 + i * 16 + fr; int n0 = wn * 64 + j * 16 + fq * 4;
      uint2 pk; pk.x = pack2bf(acc[i][j][0], acc[i][j][1]); pk.y = pack2bf(acc[i][j][2], acc[i][j][3]);
      *(uint2*)(Qs + m * 256 + ((((n0 >> 3) ^ (m & 15)) << 4) | ((n0 & 7) << 1))) = pk;
    }
  {
    const bf16_t* kg = keysb + (long)ps * 128 * 128;
#pragma unroll
    for (int i = 0; i < 8; ++i) { int idx = t + 256 * i; int r = idx >> 4, c = idx & 15; *(u32x4*)(Ks + r * 256 + ((c ^ (r & 15)) << 4)) = *(const u32x4*)(kg + r * 128 + c * 8); }
  }
  __syncthreads();
#pragma unroll
  for (int i = 0; i < 4; ++i)
#pragma unroll
    for (int j = 0; j < 4; ++j) acc[i][j] = (f32x4){0.f, 0.f, 0.f, 0.f};
#pragma unroll
  for (int ks = 0; ks < 4; ++ks) {
    bf16x8 af[4], bfr[4];
#pragma unroll
    for (int i = 0; i < 4; ++i) {
      int r = wm * 64 + i * 16 + fr; af[i] = *(const bf16x8*)(Qs + r * 256 + (((ks * 4 + fq) ^ (r & 15)) << 4));
      int rn = wn * 64 + i * 16 + fr; bfr[i] = *(const bf16x8*)(Ks + rn * 256 + (((ks * 4 + fq) ^ (rn & 15)) << 4));
    }
#pragma unroll
    for (int i = 0; i < 4; ++i)
#pragma unroll
      for (int j = 0; j < 4; ++j) acc[i][j] = __builtin_amdgcn_mfma_f32_16x16x32_bf16(bfr[j], af[i], acc[i][j], 0, 0, 0);
  }
  __syncthreads();
  unsigned* Sc = (unsigned*)smem;
#pragma unroll
  for (int i = 0; i < 4; ++i)
#pragma unroll
    for (int j = 0; j < 4; ++j) {
      int m = wm * 64 + i * 16 + fr; int n0 = wn * 64 + j * 16 + fq * 4;
#pragma unroll
      for (int e = 0; e < 4; ++e) Sc[(n0 + e) * 128 + (m ^ ((((n0 + e) >> 2) & 1) << 4))] = enc_key(acc[i][j][e], n0 + e);
    }
  __syncthreads();
  {
    const int r = t & 127, half = t >> 7;
    unsigned l[16];
#pragma unroll
    for (int i = 0; i < 16; ++i) l[i] = 0u;
    for (int k = 0; k < 64; ++k) ins16(l, Sc[(half * 64 + k) * 128 + (r ^ (((k >> 2) & 1) << 4))]);
    __syncthreads();
    unsigned* Ls = (unsigned*)smem;
    if (half == 1) {
#pragma unroll
      for (int i = 0; i < 16; ++i) Ls[r * 17 + i] = l[15 - i];
    }
    __syncthreads();
    if (half == 0) {
      unsigned br[16];
#pragma unroll
      for (int i = 0; i < 16; ++i) br[i] = Ls[r * 17 + i];
      merge16(l, br);
      unsigned* o = top1 + ((long)(tm * 128 + r) * 16 + ps) * 16;
#pragma unroll
      for (int i = 0; i < 4; ++i) { u32x4 v; v[0] = l[4*i]; v[1] = l[4*i+1]; v[2] = l[4*i+2]; v[3] = l[4*i+3]; *(u32x4*)(o + 4 * i) = v; }
    }
  }
}
__global__ void __launch_bounds__(256) ok_peer_q_top1(const bf16_t* A, const bf16_t* WqT, const bf16_t* keysb, unsigned* top1, int tiles_m) {
  __shared__ __attribute__((aligned(16))) char smem[P5_LDS_BYTES];
  for (int tile = blockIdx.x; tile < tiles_m * 16; tile += gridDim.x) { peer_q_top1_tile(A, WqT, keysb, top1, tile / 16, tile % 16, smem); __syncthreads(); }
}

#define P6_LDS_BYTES (32 * 128 * 4 * 3)
__device__ __forceinline__ void peer_gather_group(const bf16_t* __restrict__ xn, const unsigned* __restrict__ top1, const bf16_t* __restrict__ ub,
                                                  const bf16_t* __restrict__ vb, const float* __restrict__ modl, float* __restrict__ xs, int grp, char* smem) {
  const int t = tid_opaque(), lane = t & 63, wave = t >> 6;
  int* pe_l = (int*)smem; float* pg_l = (float*)(smem + 32 * 128 * 4); float* pw_l = (float*)(smem + 2 * 32 * 128 * 4);
  {
    int tl = t >> 3, p = t & 7; long row = (long)grp * 32 + tl;
    peer_combine(top1 + (row * 16 + p * 2) * 16, top1 + (row * 16 + p * 2 + 1) * 16, pe_l + tl * 128 + p * 16, pg_l + tl * 128 + p * 16);
  }
  __syncthreads();
  for (int ti = 0; ti < 8; ++ti) {
    const int tl = wave * 8 + ti; const long row = (long)grp * 32 + tl;
    const int* pe = pe_l + tl * 128; float* pw = pw_l + tl * 128;
    u32x4 h0 = *(const u32x4*)(xn + row * DM + lane * 8), h1 = *(const u32x4*)(xn + row * DM + 512 + lane * 8);
    for (int b = 0; b < 16; ++b) {
      u32x4 u0[8], u1[8];
#pragma unroll
      for (int j = 0; j < 8; ++j) { const bf16_t* ur = ub + (long)pe[b * 8 + j] * DM + lane * 8; u0[j] = *(const u32x4*)ur; u1[j] = *(const u32x4*)(ur + 512); }
      float pd[8];
#pragma unroll
      for (int j = 0; j < 8; ++j) {
        float a = 0.f;
#pragma unroll
        for (int e = 0; e < 4; ++e) { a = dot2bf(h0[e], u0[j][e], a); a = dot2bf(h1[e], u1[j][e], a); }
        pd[j] = a;
      }
      float q4[4], q2[2], q1;
#pragma unroll
      for (int j = 0; j < 4; ++j) { bool hi = lane & 1; float keep = hi ? pd[2*j+1] : pd[2*j], send = hi ? pd[2*j] : pd[2*j+1]; q4[j] = keep + __shfl_xor(send, 1); }
#pragma unroll
      for (int j = 0; j < 2; ++j) { bool hi = lane & 2; float keep = hi ? q4[2*j+1] : q4[2*j], send = hi ? q4[2*j] : q4[2*j+1]; q2[j] = keep + __shfl_xor(send, 2); }
      { bool hi = lane & 4; float keep = hi ? q2[1] : q2[0], send = hi ? q2[0] : q2[1]; q1 = keep + __shfl_xor(send, 4); }
      q1 += __shfl_xor(q1, 8); q1 += __shfl_xor(q1, 16); q1 += __shfl_xor(q1, 32);
      if (lane < 8) { int j = lane & 7; pw[b * 8 + j] = q1; }
    }
    {
      float d0 = pw[lane], d1 = pw[64 + lane];
      pw[lane] = pg_l[tl * 128 + lane] * fgelu_(d0); pw[64 + lane] = pg_l[tl * 128 + 64 + lane] * fgelu_(d1);
    }
    float o[16];
#pragma unroll
    for (int e = 0; e < 16; ++e) o[e] = 0.f;
    for (int b = 0; b < 16; ++b) {
      u32x4 v0[8], v1[8];
#pragma unroll
      for (int j = 0; j < 8; ++j) { const bf16_t* vr = vb + (long)pe[b * 8 + j] * DM + lane * 8; v0[j] = *(const u32x4*)vr; v1[j] = *(const u32x4*)(vr + 512); }
#pragma unroll
      for (int j = 0; j < 8; ++j) {
        float w = pw[b * 8 + j];
#pragma unroll
        for (int e = 0; e < 4; ++e) {
          o[2*e]     += w * __uint_as_float(v0[j][e] << 16); o[2*e+1]     += w * __uint_as_float(v0[j][e] & 0xffff0000u);
          o[8 + 2*e] += w * __uint_as_float(v1[j][e] << 16); o[8 + 2*e+1] += w * __uint_as_float(v1[j][e] & 0xffff0000u);
        }
      }
    }
    {
      int b = row / RB, lr = row % RB; int bb = lr < SEQ ? b : BATCH; const float* g5 = modl + ((long)bb * 6 + 5) * DM;
      float* xr = xs + row * DM;
#pragma unroll
      for (int hf = 0; hf < 2; ++hf) {
        int d = hf * 512 + lane * 8;
        float4 x0 = *(float4*)(xr + d), x1 = *(float4*)(xr + d + 4); float4 g0 = *(const float4*)(g5 + d), g1 = *(const float4*)(g5 + d + 4);
        x0.x += g0.x * o[hf*8+0]; x0.y += g0.y * o[hf*8+1]; x0.z += g0.z * o[hf*8+2]; x0.w += g0.w * o[hf*8+3];
        x1.x += g1.x * o[hf*8+4]; x1.y += g1.y * o[hf*8+5]; x1.z += g1.z * o[hf*8+6]; x1.w += g1.w * o[hf*8+7];
        *(float4*)(xr + d) = x0; *(float4*)(xr + d + 4) = x1;
      }
    }
  }
}
__global__ void __launch_bounds__(256) ok_peer_gather(const bf16_t* xn, const unsigned* top1, const bf16_t* ub, const bf16_t* vb, const float* modl, float* xs, int ngroups) {
  __shared__ __attribute__((aligned(16))) char smem[P6_LDS_BYTES];
  for (int g = blockIdx.x; g < ngroups; g += gridDim.x) { peer_gather_group(xn, top1, ub, vb, modl, xs, g, smem); __syncthreads(); }
}

template <int DQ> struct AttnCfg { static constexpr int KROW = DQ * 2 + 16; static constexpr int VROW = 136; static constexpr int KBYTES = 64 * KROW; static constexpr int LDS = 64 * KROW + 64 * VROW; };
#define ATTN_LDS_BYTES (64 * 208 + 64 * 136)
__device__ __forceinline__ void attn_score_bound(const float* __restrict__ qk_g, int DQ, float sqrt_dq, float* __restrict__ dst, int lane) {
  float gq = 0.f, gk = 0.f;
  for (int i = lane; i < DQ; i += 64) { gq = fmaxf(gq, fabsf(qk_g[i])); gk = fmaxf(gk, fabsf(qk_g[DQ + i])); }
#pragma unroll
  for (int o_ = 32; o_ > 0; o_ >>= 1) { gq = fmaxf(gq, __shfl_xor(gq, o_)); gk = fmaxf(gk, __shfl_xor(gk, o_)); }
  if (lane == 0) *dst = -fminf(1.02f * 1.4426950408889634f * sqrt_dq * gq * gk, 60.f);
}
template <int DQ>
__device__ __forceinline__ void attn_block(const bf16_t* __restrict__ qb, int HQ, const bf16_t* __restrict__ kb, int HK, const bf16_t* __restrict__ vT, int G,
                                           bf16_t* __restrict__ mixall, int ooff, int b, int head, int qt, char* smem, const float* __restrict__ negC_p) {
  constexpr int KROW = AttnCfg<DQ>::KROW, VROW = 136, NKK = DQ / 16, KCH = DQ / 8;
  constexpr int KLD = (64 * KCH) / 256;
  const int t = tid_opaque(), lane = t & 63, wave = t >> 6, lq = lane & 31, lh = lane >> 5;
  const int hk = head / G;
  char* Ks = smem; char* Vs = smem + 64 * KROW;
  const float negC = *negC_p;
  const long qrow = (long)b * RB + qt * 128 + wave * 32 + lq;
  bf16x8 qf[NKK];
#pragma unroll
  for (int kk = 0; kk < NKK; ++kk) qf[kk] = *(const bf16x8*)(qb + (qrow * HQ + head) * DQ + kk * 16 + lh * 8);
  const int key0 = qt < 16 ? 0 : SEQ; const int nt = qt < 16 ? RB / 64 : CTX_LEN / 64;
  const bf16_t* kp[KLD]; const bf16_t* vp_[2];
#pragma unroll
  for (int i = 0; i < KLD; ++i) { int c = t + 256 * i; int r = c / KCH, cc = c % KCH; kp[i] = kb + ((long)b * RB * HK + hk) * DQ + (long)(key0 + r) * HK * DQ + cc * 8; }
#pragma unroll
  for (int i = 0; i < 2; ++i) { int c = t + 256 * i; int r = c >> 3, cc = c & 7; vp_[i] = vT + ((long)(b * HK + hk) * 64 + r) * RB + key0 + cc * 8; }
  u32x4 rk[KLD], rv[2];
#pragma unroll
  for (int i = 0; i < KLD; ++i) { rk[i] = *(const u32x4*)kp[i]; kp[i] += 64 * HK * DQ; }
#pragma unroll
  for (int i = 0; i < 2; ++i) { rv[i] = *(const u32x4*)vp_[i]; vp_[i] += 64; }
  f32x16 ot[2];
#pragma unroll
  for (int d = 0; d < 2; ++d)
#pragma unroll
    for (int r = 0; r < 16; ++r) ot[d][r] = 0.f;
  float lrun = 0.f;
  for (int tile = 0; tile < nt; ++tile) {
    __syncthreads();
#pragma unroll
    for (int i = 0; i < KLD; ++i) { int c = t + 256 * i; int r = c / KCH, cc = c % KCH; *(u32x4*)(Ks + r * KROW + cc * 16) = rk[i]; }
#pragma unroll
    for (int i = 0; i < 2; ++i) { int c = t + 256 * i; int r = c >> 3, cc = c & 7; *(uint2*)(Vs + r * VROW + cc * 16) = make_uint2(rv[i][0], rv[i][1]); *(uint2*)(Vs + r * VROW + cc * 16 + 8) = make_uint2(rv[i][2], rv[i][3]); }
    __syncthreads();
    if (tile + 1 < nt) {
#pragma unroll
      for (int i = 0; i < KLD; ++i) { rk[i] = *(const u32x4*)kp[i]; kp[i] += 64 * HK * DQ; }
#pragma unroll
      for (int i = 0; i < 2; ++i) { rv[i] = *(const u32x4*)vp_[i]; vp_[i] += 64; }
    }
    f32x16 st[2];
#pragma unroll
    for (int kt = 0; kt < 2; ++kt) {
#pragma unroll
      for (int r = 0; r < 16; ++r) st[kt][r] = negC;
#pragma unroll
      for (int kk = 0; kk < NKK; ++kk) {
        bf16x8 ka = *(const bf16x8*)(Ks + (kt * 32 + lq) * KROW + kk * 32 + lh * 16);
        st[kt] = __builtin_amdgcn_mfma_f32_32x32x16_bf16(ka, qf[kk], st[kt], 0, 0, 0);
      }
    }
    float ps = 0.f;
#pragma unroll
    for (int kt = 0; kt < 2; ++kt)
#pragma unroll
      for (int r = 0; r < 16; ++r) { float p = __builtin_amdgcn_exp2f(st[kt][r]); st[kt][r] = p; ps += p; }
    lrun += ps;
#pragma unroll
    for (int kt = 0; kt < 2; ++kt)
#pragma unroll
      for (int s = 0; s < 2; ++s) {
        union { bf16x8 v; unsigned u[4]; } pb;
#pragma unroll
        for (int j = 0; j < 4; ++j) pb.u[j] = pack2bf(st[kt][8 * s + 2 * j], st[kt][8 * s + 2 * j + 1]);
#pragma unroll
        for (int d = 0; d < 2; ++d) {
          const char* vp = Vs + (d * 32 + lq) * VROW + (kt * 32 + 16 * s + 4 * lh) * 2;
          union { bf16x8 v; uint2 h[2]; } va; va.h[0] = *(const uint2*)vp; va.h[1] = *(const uint2*)(vp + 16);
          ot[d] = __builtin_amdgcn_mfma_f32_32x32x16_bf16(va.v, pb.v, ot[d], 0, 0, 0);
        }
      }
  }
  float ltot = xor32_sum(lrun); float inv = 1.f / ltot;
  bf16_t* orow = mixall + qrow * DM + ooff + head * 64;
#pragma unroll
  for (int d = 0; d < 2; ++d)
#pragma unroll
    for (int g = 0; g < 4; ++g) {
      uint2 pk; pk.x = pack2bf(ot[d][4 * g] * inv, ot[d][4 * g + 1] * inv); pk.y = pack2bf(ot[d][4 * g + 2] * inv, ot[d][4 * g + 3] * inv);
      *(uint2*)(orow + d * 32 + 8 * g + 4 * lh) = pk;
    }
}
__global__ void ok_adapt_rows(const float* src, int sld, int scol, int ncols, float scale, bf16_t* dst, int dld, int nrows) {
  long i = (long)blockIdx.x * blockDim.x + threadIdx.x; if (i >= (long)nrows * ncols) return;
  int c = i % ncols; long r = i / ncols; dst[r * dld + c] = f2bf(src[r * sld + scol + c] * scale);
}
__global__ void ok_adapt_vT(const float* src, int sld, int scol, int hstride, int H, bf16_t* dst) {
  long i = (long)blockIdx.x * blockDim.x + threadIdx.x; if (i >= (long)H * 64 * RB) return;
  int lr = i % RB; int d = (i / RB) % 64; int h = i / ((long)RB * 64);
  dst[i] = f2bf(src[(long)lr * sld + scol + h * hstride + d]);
}

typedef __attribute__((ext_vector_type(2))) float f32x2;
#define SCAN_TS 16
#define SCAN_LDS_BYTES (2 * SCAN_TS * 1536 + 2 * SCAN_TS * 32 * 4)
__device__ __forceinline__ float reduce8(float x) {
  x += __builtin_bit_cast(float, __builtin_amdgcn_update_dpp(0, __builtin_bit_cast(int, x), 0xB1, 0xf, 0xf, true));
  x += __builtin_bit_cast(float, __builtin_amdgcn_update_dpp(0, __builtin_bit_cast(int, x), 0x4E, 0xf, 0xf, true));
  x += __builtin_bit_cast(float, __builtin_amdgcn_update_dpp(0, __builtin_bit_cast(int, x), 0x141, 0xf, 0xf, true));
  return x;
}
__device__ __forceinline__ int scan_row(int dir, int s) {
  if (s < CTX_LEN) return SEQ + (dir == 0 ? s : CTX_LEN - 1 - s);
  return dir == 0 ? s - CTX_LEN : SEQ - 1 - (s - CTX_LEN);
}
__device__ __forceinline__ void rw_scan_block(const bf16_t* __restrict__ r_, const bf16_t* __restrict__ v_, const bf16_t* __restrict__ kk_, const bf16_t* __restrict__ kd_,
                                              const bf16_t* __restrict__ bd_, const float* __restrict__ w_, float* __restrict__ y_, int item, long dstride, char* smem) {
  const int t = tid_opaque(), lane = t & 63, wave = t >> 6, cg = lane & 7, il = wave * 8 + (lane >> 3);
  const int half = item & 1, dir = (item >> 1) & 1, h = (item >> 2) % 6, b = item / 24;
  const long rowbase = (long)b * RB; const int col0 = h * 64;
  float* ybuf = (float*)(smem + 2 * SCAN_TS * 1536);
  const int st_ld = t >> 4, part = t & 15;
  u32x4 la, lb, lc, lw;
  auto issue = [&](int c) {
    long row = rowbase + scan_row(dir, c * SCAN_TS + st_ld); long o = row * 384 + col0;
    const int ch = (part & 7) * 8;
    la = *(const u32x4*)((part < 8 ? kk_ + o : bd_ + dir * dstride + o) + ch);
    lb = *(const u32x4*)((part < 8 ? kd_ + dir * dstride + o : r_ + o) + ch);
    lc = *(const u32x4*)(v_ + o + ch);
    lw = *(const u32x4*)(w_ + dir * dstride + o + part * 4);
  };
  auto stash = [&](int buf) {
    float* base = (float*)(smem + buf * SCAN_TS * 1536 + st_ld * 1536);
    const int ch = (part & 7) * 8;
    float* pa = base + (part < 8 ? 64 : 128) + ch; float* pb = base + (part < 8 ? 192 : 256) + ch;
    f32x4 x0, x1;
#pragma unroll
    for (int e = 0; e < 2; ++e) { x0[2*e] = __uint_as_float(la[e] << 16); x0[2*e+1] = __uint_as_float(la[e] & 0xffff0000u); x1[2*e] = __uint_as_float(la[2+e] << 16); x1[2*e+1] = __uint_as_float(la[2+e] & 0xffff0000u); }
    *(f32x4*)pa = x0; *(f32x4*)(pa + 4) = x1;
#pragma unroll
    for (int e = 0; e < 2; ++e) { x0[2*e] = __uint_as_float(lb[e] << 16); x0[2*e+1] = __uint_as_float(lb[e] & 0xffff0000u); x1[2*e] = __uint_as_float(lb[2+e] << 16); x1[2*e+1] = __uint_as_float(lb[2+e] & 0xffff0000u); }
    *(f32x4*)pb = x0; *(f32x4*)(pb + 4) = x1;
    if (part < 8) {
      float* pc = base + 320 + ch;
#pragma unroll
      for (int e = 0; e < 2; ++e) { x0[2*e] = __uint_as_float(lc[e] << 16); x0[2*e+1] = __uint_as_float(lc[e] & 0xffff0000u); x1[2*e] = __uint_as_float(lc[2+e] << 16); x1[2*e+1] = __uint_as_float(lc[2+e] & 0xffff0000u); }
      *(f32x4*)pc = x0; *(f32x4*)(pc + 4) = x1;
    }
    *(u32x4*)(base + part * 4) = lw;
  };
  f32x2 S[4];
#pragma unroll
  for (int j = 0; j < 4; ++j) S[j] = (f32x2){0.f, 0.f};
  const int NCH = RB / SCAN_TS;
  __builtin_amdgcn_s_setprio(3);
  issue(0);
  for (int c = 0; c < NCH; ++c) {
    const int buf = c & 1;
    stash(buf);
    __syncthreads();
    if (c > 0 && t < 128) {
      int st = t >> 3, i4 = (t & 7) * 4; long row = rowbase + scan_row(dir, (c - 1) * SCAN_TS + st);
      *(f32x4*)(y_ + dir * dstride + row * 384 + col0 + half * 32 + i4) = *(const f32x4*)(ybuf + (buf ^ 1) * SCAN_TS * 32 + st * 32 + i4);
    }
    if (c + 1 < NCH) issue(c + 1);
    const float* ob = (const float*)(smem + buf * SCAN_TS * 1536) + cg * 8;
    const float* vb_ = (const float*)(smem + buf * SCAN_TS * 1536) + 320 + half * 32 + il;
    float yk[SCAN_TS];
    f32x4 nw0 = *(const f32x4*)(ob), nw1 = *(const f32x4*)(ob + 4), nk0 = *(const f32x4*)(ob + 64), nk1 = *(const f32x4*)(ob + 68);
    f32x4 nb0 = *(const f32x4*)(ob + 128), nb1 = *(const f32x4*)(ob + 132), nd0 = *(const f32x4*)(ob + 192), nd1 = *(const f32x4*)(ob + 196);
    f32x4 nr0 = *(const f32x4*)(ob + 256), nr1 = *(const f32x4*)(ob + 260); float nvi = vb_[0];
#pragma unroll
    for (int st = 0; st < SCAN_TS; ++st) {
      const f32x4 w0 = nw0, w1 = nw1, k0 = nk0, k1 = nk1, b0 = nb0, b1 = nb1, d0 = nd0, d1 = nd1, r0 = nr0, r1 = nr1; const float vi = nvi;
      if (st + 1 < SCAN_TS) {
        const float* o = ob + (st + 1) * 384;
        nw0 = *(const f32x4*)(o); nw1 = *(const f32x4*)(o + 4); nk0 = *(const f32x4*)(o + 64); nk1 = *(const f32x4*)(o + 68);
        nb0 = *(const f32x4*)(o + 128); nb1 = *(const f32x4*)(o + 132); nd0 = *(const f32x4*)(o + 192); nd1 = *(const f32x4*)(o + 196);
        nr0 = *(const f32x4*)(o + 256); nr1 = *(const f32x4*)(o + 260); nvi = vb_[(st + 1) * 384];
      }
      __builtin_amdgcn_sched_barrier(0);
      f32x2 a2 = S[0] * (f32x2){k0[0], k0[1]}, c2 = S[2] * (f32x2){k1[0], k1[1]};
      a2 += S[1] * (f32x2){k0[2], k0[3]}; c2 += S[3] * (f32x2){k1[2], k1[3]};
      a2 += c2;
      const f32x2 vv = (f32x2){vi, vi};
      f32x2 t0 = vv * (f32x2){d0[0], d0[1]}, t1 = vv * (f32x2){d0[2], d0[3]}, t2 = vv * (f32x2){d1[0], d1[1]}, t3 = vv * (f32x2){d1[2], d1[3]};
      float skk = reduce8(a2[0] + a2[1]);
      const f32x2 ns = (f32x2){-skk, -skk};
      t0 += ns * (f32x2){b0[0], b0[1]}; t1 += ns * (f32x2){b0[2], b0[3]}; t2 += ns * (f32x2){b1[0], b1[1]}; t3 += ns * (f32x2){b1[2], b1[3]};
      S[0] = S[0] * (f32x2){w0[0], w0[1]} + t0; S[1] = S[1] * (f32x2){w0[2], w0[3]} + t1; S[2] = S[2] * (f32x2){w1[0], w1[1]} + t2; S[3] = S[3] * (f32x2){w1[2], w1[3]} + t3;
      f32x2 y2 = S[0] * (f32x2){r0[0], r0[1]}, z2 = S[2] * (f32x2){r1[0], r1[1]};
      y2 += S[1] * (f32x2){r0[2], r0[3]}; z2 += S[3] * (f32x2){r1[2], r1[3]};
      y2 += z2;
      yk[st] = y2[0] + y2[1];
      __builtin_amdgcn_sched_barrier(0);
    }
#pragma unroll
    for (int g = 0; g < 2; ++g) {
      float q4[4], q2[2], q1;
#pragma unroll
      for (int j = 0; j < 4; ++j) { bool hi = cg & 1; float keep = hi ? yk[g*8 + 2*j+1] : yk[g*8 + 2*j], send = hi ? yk[g*8 + 2*j] : yk[g*8 + 2*j+1]; q4[j] = keep + dpp_get<0xB1>(send); }
#pragma unroll
      for (int j = 0; j < 2; ++j) { bool hi = cg & 2; float keep = hi ? q4[2*j+1] : q4[2*j], send = hi ? q4[2*j] : q4[2*j+1]; q2[j] = keep + dpp_get<0x4E>(send); }
      { bool hi = cg & 4; float keep = hi ? q2[1] : q2[0], send = hi ? q2[0] : q2[1]; q1 = keep + xor4_get(send); }
      ybuf[buf * SCAN_TS * 32 + (g * 8 + cg) * 32 + il] = q1;
    }
  }
  __builtin_amdgcn_s_setprio(0);
  __syncthreads();
  if (t < 128) {
    int st = t >> 3, i4 = (t & 7) * 4; long row = rowbase + scan_row(dir, (NCH - 1) * SCAN_TS + st);
    *(f32x4*)(y_ + dir * dstride + row * 384 + col0 + half * 32 + i4) = *(const f32x4*)(ybuf + ((NCH - 1) & 1) * SCAN_TS * 32 + st * 32 + i4);
  }
}
__global__ void __launch_bounds__(256) ok_rw_scan(const bf16_t* r_, const bf16_t* v_, const bf16_t* kk_, const bf16_t* kd_, const bf16_t* bd_, const float* w_, float* y_, int item0, int nitems, long dstride) {
  __shared__ __attribute__((aligned(16))) char smem[SCAN_LDS_BYTES];
  for (int it = item0 + blockIdx.x; it < item0 + nitems; it += gridDim.x) { rw_scan_block(r_, v_, kk_, kd_, bd_, w_, y_, it, dstride, smem); __syncthreads(); }
}
__global__ void ok_copy_rows_f32(const float* src, int sld, int scol, int ncols, float* dst, int dld, int nrows) {
  long i = (long)blockIdx.x * blockDim.x + threadIdx.x; if (i >= (long)nrows * ncols) return;
  int c = i % ncols; long r = i / ncols; dst[r * dld + c] = src[r * sld + scol + c];
}

__global__ void ok_cvt_wT_g(const float* W, const float* g, bf16_t* Wt, int K, int N, int Kpad) {
  long i = (long)blockIdx.x * blockDim.x + threadIdx.x;
  if (i >= (long)N * Kpad) return;
  int k = i % Kpad; int n = i / Kpad;
  Wt[i] = k < K ? f2bf(W[(long)k * N + n] * (g ? g[k] : 1.f)) : (bf16_t)0;
}
struct ALoadShift { const bf16_t* P; const float* mu; int col0; int mucol0; int act; int kvalid;
  __device__ __forceinline__ u32x4 operator()(int row, int k) const {
    u32x4 z = {0u, 0u, 0u, 0u};
    if (k >= kvalid) return z;
    int lr = row % RB; bool first = (lr == 0) || (lr == SEQ), last = (lr == SEQ - 1) || (lr == RB - 1);
    const bf16_t* p = P + (long)row * IN_COLS + col0 + k;
    u32x4 c = *(const u32x4*)p; u32x4 pv = first ? z : *(const u32x4*)(p - IN_COLS); u32x4 nx = last ? z : *(const u32x4*)(p + IN_COLS);
    const float* m0 = mu + mucol0 + k; const float* m1 = m0 + RWC;
    u32x4 o;
#pragma unroll
    for (int e = 0; e < 4; ++e) {
      float c0 = __uint_as_float(c[e] << 16), c1 = __uint_as_float(c[e] & 0xffff0000u);
      float p0 = __uint_as_float(pv[e] << 16), p1 = __uint_as_float(pv[e] & 0xffff0000u);
      float n0 = __uint_as_float(nx[e] << 16), n1 = __uint_as_float(nx[e] & 0xffff0000u);
      float x0 = c0 + m0[2*e] * (p0 - c0) + m1[2*e] * (n0 - c0), x1 = c1 + m0[2*e+1] * (p1 - c1) + m1[2*e+1] * (n1 - c1);
      if (act == 1) { x0 = ftanh_(x0); x1 = ftanh_(x1); } else if (act == 2) { x0 = fsigmoid_(x0); x1 = fsigmoid_(x1); }
      o[e] = pack2bf(x0, x1);
    }
    return o;
  } };
struct EpiDecay { float* w; const float* w0; int pad0; int pad1;
  __device__ __forceinline__ void operator()(int m, int n0, f32x4 v) const {
    f32x4 o;
#pragma unroll
    for (int e = 0; e < 4; ++e) o[e] = fdecay_(w0[n0 + e] + v[e]);
    *(f32x4*)(w + (long)m * 384 + n0) = o; } };
struct EpiSigA { bf16_t* a; const float* a0;
  __device__ __forceinline__ void operator()(int m, int n0, f32x4 v) const {
    uint2 pk; pk.x = pack2bf(fsigmoid_(a0[n0] + v[0]), fsigmoid_(a0[n0+1] + v[1])); pk.y = pack2bf(fsigmoid_(a0[n0+2] + v[2]), fsigmoid_(a0[n0+3] + v[3]));
    *(uint2*)(a + (long)m * 384 + n0) = pk; } };

struct PrepW { const bf16_t *wqbT, *wkvbT, *w2T, *a2T, *g2T; const float *mu, *w0, *a0; };
struct PrepBuf { const bf16_t* P; bf16_t *tq, *tkv, *a_b, *g_b; float* w_f; };
__device__ __forceinline__ void prep_gemm_tile(const PrepW& W, const PrepBuf& B, int tm, int ct, char* smem) {
  const long MA = NROWS;
  if (ct < 3) gemm_tile_128(ALoadPlain{B.P, IN_COLS}, W.wqbT, 256, 256, tm, ct, smem, EpiStoreBf16{B.tq, 384, 384});
  else if (ct < 7) gemm_tile_128(ALoadPlain{B.P + 256, IN_COLS}, W.wkvbT, 128, 128, tm, ct - 3, smem, EpiStoreBf16{B.tkv, 512, 512});
  else if (ct < 13) { int d = (ct - 7) / 3, tn = (ct - 7) % 3;
    gemm_tile_128(ALoadShift{B.P, W.mu, RW_OFF + 1152 + d * 64, 1152 + d * 64, 1, 64}, W.w2T + d * 384 * 64, 64, 64, tm, tn, smem, EpiDecay{B.w_f + d * MA * 384, W.w0 + d * 384, 0, 0}); }
  else if (ct < 19) { int d = (ct - 13) / 3, tn = (ct - 13) % 3;
    gemm_tile_128(ALoadShift{B.P, W.mu, RW_OFF + 1280 + d * 64, 1280 + d * 64, 0, 64}, W.a2T + d * 384 * 64, 64, 64, tm, tn, smem, EpiSigA{B.a_b + d * MA * 384, W.a0 + d * 384}); }
  else gemm_tile_128(ALoadShift{B.P, W.mu, RW_OFF + 1408, 1408, 2, 160}, W.g2T, 192, 192, tm, ct - 19, smem, EpiStoreBf16{B.g_b, 384, 384});
}
__global__ void __launch_bounds__(256) ok_prep_gemm(PrepW W, PrepBuf B) {
  __shared__ __attribute__((aligned(16))) char smem[GEMM_LDS_BYTES];
  for (int tile = blockIdx.x; tile < (NROWS / 128) * 22; tile += gridDim.x) prep_gemm_tile(W, B, tile / 22, tile % 22, smem);
}

__device__ __forceinline__ float wave_sum(float x) {
#pragma unroll
  for (int o = 32; o > 0; o >>= 1) x += __shfl_xor(x, o);
  return x;
}
__device__ __forceinline__ float ldbf(const bf16_t* p) { return bf2f(*p); }
struct FinW { const float *mla_qk_g, *gqa_qk_g, *mu, *k_k, *k_a; };
struct FinBuf { const bf16_t *P, *tq, *tkv, *a_b; bf16_t *mq, *mk, *mvT, *gq, *gk, *gvT, *r_b, *v_b, *kk_b, *kd_b, *bd_b; };
#define FIN_LDS_BYTES (384 * 132)
__device__ __forceinline__ void prep_finish_tile(const FinW& W, const FinBuf& B, int tile, char* smem) {
  const int t = tid_opaque(), lane = t & 63, wave = t >> 6; const long MA = NROWS;
  bf16_t* vbuf = (bf16_t*)smem;
  const long row0 = (long)tile * 64; const int b = row0 / RB; const int lr0 = row0 % RB;
  for (int it = 0; it < 16; ++it) {
    const int rl = it * 4 + wave; const long row = row0 + rl; const int lr = lr0 + rl; const bool lat = lr < SEQ;
    const bf16_t* Pr = B.P + row * IN_COLS;
    float sq = 0.f;
#pragma unroll
    for (int i = 0; i < 4; ++i) { float x = ldbf(Pr + i * 64 + lane); sq += x * x; }
    float skv = 0.f;
#pragma unroll
    for (int i = 0; i < 2; ++i) { float x = ldbf(Pr + 256 + i * 64 + lane); skv += x * x; }
    const float cq = __builtin_amdgcn_rsqf(wave_sum(sq) / 256.f + EPSN), ckv = __builtin_amdgcn_rsqf(wave_sum(skv) / 128.f + EPSN);
    const float krope = lane < 32 ? ldbf(Pr + 384 + lane) : 0.f;
    float cs_m = 1.f, sn_m = 0.f;
    { int j = lane & 15; int pos = j < 8 ? lr / 64 : lr % 64; float ang = (float)pos * powf(10000.f, -(float)(j & 7) / 8.f); if (lat) { cs_m = cosf(ang); sn_m = sinf(ang); } }
    const float* gq_ = W.mla_qk_g; const float* gk_ = W.mla_qk_g + 96;
#pragma unroll
    for (int h = 0; h < 4; ++h) {
      float qa = cq * ldbf(B.tq + row * 384 + h * 96 + lane); float qb = lane < 32 ? cq * ldbf(B.tq + row * 384 + h * 96 + 64 + lane) : 0.f;
      float inv = __builtin_amdgcn_rsqf(wave_sum(qa * qa + qb * qb) / 96.f + EPSN);
      qa *= inv * gq_[lane]; qb *= inv * (lane < 32 ? gq_[64 + lane] : 0.f);
      { float other = __shfl_xor(qb, 16); float rr = (lane & 16) ? (other * sn_m + qb * cs_m) : (qb * cs_m - other * sn_m); qb = rr; }
      const float qs = 0.14724445f;
      B.mq[row * 384 + h * 96 + lane] = f2bf(qa * qs); if (lane < 32) B.mq[row * 384 + h * 96 + 64 + lane] = f2bf(qb * qs);
      float ka = ckv * ldbf(B.tkv + row * 512 + h * 128 + lane); float kb = krope;
      float invk = __builtin_amdgcn_rsqf(wave_sum(ka * ka + kb * kb) / 96.f + EPSN);
      ka *= invk * gk_[lane]; kb *= invk * (lane < 32 ? gk_[64 + lane] : 0.f);
      { float other = __shfl_xor(kb, 16); float rr = (lane & 16) ? (other * sn_m + kb * cs_m) : (kb * cs_m - other * sn_m); kb = rr; }
      B.mk[row * 384 + h * 96 + lane] = f2bf(ka); if (lane < 32) B.mk[row * 384 + h * 96 + 64 + lane] = f2bf(kb);
      vbuf[(h * 64 + lane) * 66 + rl] = f2bf(ckv * ldbf(B.tkv + row * 512 + h * 128 + 64 + lane));
    }
    float cs_g = 1.f, sn_g = 0.f;
    { int j = lane & 31; int pos = j < 16 ? lr / 64 : lr % 64; float ang = (float)pos * powf(10000.f, -(float)(j & 15) / 16.f); if (lat) { cs_g = cosf(ang); sn_g = sinf(ang); } }
#pragma unroll
    for (int h = 0; h < 8; ++h) {
      float x = ldbf(Pr + GQA_OFF + h * 64 + lane);
      float inv = __builtin_amdgcn_rsqf(wave_sum(x * x) / 64.f + EPSN);
      x *= inv * W.gqa_qk_g[(h < 6 ? 0 : 64) + lane];
      float other = __shfl_xor(x, 32); float rr = (lane & 32) ? (other * sn_g + x * cs_g) : (x * cs_g - other * sn_g);
      if (h < 6) B.gq[row * 384 + h * 64 + lane] = f2bf(rr * 0.18033688f); else B.gk[row * 128 + (h - 6) * 64 + lane] = f2bf(rr);
    }
#pragma unroll
    for (int hk = 0; hk < 2; ++hk) vbuf[((4 + hk) * 64 + lane) * 66 + rl] = Pr[GQA_OFF + 512 + hk * 64 + lane];
    const bool first = (lr == 0) || (lr == SEQ), last = (lr == SEQ - 1) || (lr == RB - 1);
#pragma unroll
    for (int h = 0; h < 6; ++h) {
      float xs3[3];
#pragma unroll
      for (int part = 0; part < 3; ++part) {
        int c = part * 384 + h * 64 + lane; const bf16_t* pp = Pr + RW_OFF + c;
        float p = ldbf(pp), pv = first ? 0.f : ldbf(pp - IN_COLS), nx = last ? 0.f : ldbf(pp + IN_COLS);
        xs3[part] = p + W.mu[c] * (pv - p) + W.mu[RWC + c] * (nx - p);
      }
      const int c = h * 64 + lane; const long o = row * 384 + c;
      float kv = xs3[1]; float tk = kv * W.k_k[c]; float kkv = tk * __builtin_amdgcn_rsqf(wave_sum(tk * tk) + 1e-12f);
      B.r_b[o] = f2bf(xs3[0]); B.v_b[o] = f2bf(xs3[2]); B.kk_b[o] = f2bf(kkv);
#pragma unroll
      for (int d = 0; d < 2; ++d) { float a = ldbf(B.a_b + d * MA * 384 + o); B.kd_b[d * MA * 384 + o] = f2bf(kv * (1.f + (a - 1.f) * W.k_a[c])); B.bd_b[d * MA * 384 + o] = f2bf(kkv * a); }
    }
  }
  __syncthreads();
  for (int i = t; i < 384 * 32; i += 256) {
    int rr = i >> 5, w2 = i & 31; int slot = rr >> 6, d = rr & 63;
    unsigned val = *(const unsigned*)(vbuf + rr * 66 + w2 * 2);
    bf16_t* dst = slot < 4 ? B.mvT + ((long)(b * 4 + slot) * 64 + d) * RB : B.gvT + ((long)(b * 2 + (slot - 4)) * 64 + d) * RB;
    *(unsigned*)(dst + lr0 + w2 * 2) = val;
  }
  __syncthreads();
}
__global__ void __launch_bounds__(256) ok_prep_finish(FinW W, FinBuf B) {
  __shared__ __attribute__((aligned(16))) char smem[FIN_LDS_BYTES];
  for (int tile = blockIdx.x; tile < NROWS / 64; tile += gridDim.x) prep_finish_tile(W, B, tile, smem);
}
struct RdW { const float *r_k, *ln_g, *ln_b; };
__device__ __forceinline__ void rw_readout_row(const RdW& W, const float* __restrict__ y, const bf16_t* __restrict__ r_b, const bf16_t* __restrict__ v_b, const bf16_t* __restrict__ kd_b,
                                               const bf16_t* __restrict__ g_b, bf16_t* __restrict__ mixall, long row, int lane) {
  const long MA = NROWS;
#pragma unroll
  for (int h = 0; h < 6; ++h) {
    const int c = h * 64 + lane; const long o = row * 384 + c;
    float yy = y[o] + y[MA * 384 + o];
    float mean = wave_sum(yy) * (1.f / 64.f); float dv = yy - mean; float var = wave_sum(dv * dv) * (1.f / 64.f);
    float coef = wave_sum(ldbf(r_b + o) * (ldbf(kd_b + o) + ldbf(kd_b + MA * 384 + o)) * W.r_k[c]);
    float yn = dv * __builtin_amdgcn_rsqf(var + 64e-5f) * W.ln_g[c] + W.ln_b[c];
    mixall[row * DM + 256 + c] = f2bf((yn + coef * ldbf(v_b + o)) * ldbf(g_b + o));
  }
}
__global__ void __launch_bounds__(256) ok_rw_readout(RdW W, const float* y, const bf16_t* r_b, const bf16_t* v_b, const bf16_t* kd_b, const bf16_t* g_b, bf16_t* mixall) {
  for (long row = blockIdx.x * 4 + (threadIdx.x >> 6); row < NROWS; row += gridDim.x * 4) rw_readout_row(W, y, r_b, v_b, kd_b, g_b, mixall, row, threadIdx.x & 63);
}

__device__ __forceinline__ void ph_cvt_fp8_rows(const float* __restrict__ tab, unsigned char* __restrict__ q, float* __restrict__ scale, int r0 = -1, int r1 = 0) {
  const int t = tid_opaque(); const int lane = t & 63;
  const int rbeg = r0 < 0 ? (int)blockIdx.x * 4 + (t >> 6) : r0 + (t >> 6), rend = r0 < 0 ? 16384 : r1, rstep = r0 < 0 ? (int)gridDim.x * 4 : 4;
  for (int row = rbeg; row < rend; row += rstep) {
    const float* src = tab + (long)row * DM + lane * 16;
    f32x4 a[4]; float m = 0.f;
#pragma unroll
    for (int i = 0; i < 4; ++i) { a[i] = *(const f32x4*)(src + 4 * i); m = fmaxf(m, fmaxf(fmaxf(fabsf(a[i][0]), fabsf(a[i][1])), fmaxf(fabsf(a[i][2]), fabsf(a[i][3])))); }
#pragma unroll
    for (int o = 32; o > 0; o >>= 1) m = fmaxf(m, __shfl_xor(m, o));
    const float sc = m > 0.f ? m * (1.f / 440.f) : 1.f; const float inv = 1.f / sc;
    u32x4 p;
#pragma unroll
    for (int i = 0; i < 4; ++i) { int w = __builtin_amdgcn_cvt_pk_fp8_f32(a[i][0] * inv, a[i][1] * inv, 0, false); w = __builtin_amdgcn_cvt_pk_fp8_f32(a[i][2] * inv, a[i][3] * inv, w, true); p[i] = (unsigned)w; }
    *(u32x4*)(q + (long)row * DM + lane * 16) = p;
    if (lane == 0) scale[row] = sc;
  }
}
__device__ __forceinline__ float dot16_fp8(const float (&h)[16], u32x4 q) {
  float a = 0.f;
#pragma unroll
  for (int d = 0; d < 4; ++d) {
    f32v2 lo = __builtin_amdgcn_cvt_pk_f32_fp8((int)q[d], false), hi = __builtin_amdgcn_cvt_pk_f32_fp8((int)q[d], true);
    a += h[4*d] * lo[0]; a += h[4*d+1] * lo[1]; a += h[4*d+2] * hi[0]; a += h[4*d+3] * hi[1];
  }
  return a;
}
__device__ __forceinline__ void axpy16_fp8(float (&o)[16], float w, u32x4 q) {
#pragma unroll
  for (int d = 0; d < 4; ++d) {
    f32v2 lo = __builtin_amdgcn_cvt_pk_f32_fp8((int)q[d], false), hi = __builtin_amdgcn_cvt_pk_f32_fp8((int)q[d], true);
    o[4*d] += w * lo[0]; o[4*d+1] += w * lo[1]; o[4*d+2] += w * hi[0]; o[4*d+3] += w * hi[1];
  }
}
__device__ __forceinline__ void peer_gather_group_fp8(const bf16_t* __restrict__ xn, const unsigned* __restrict__ top1, const unsigned char* __restrict__ ub, const float* __restrict__ su,
                                                      const unsigned char* __restrict__ vb, const float* __restrict__ sv, const float* __restrict__ modl, float* __restrict__ xs, int grp, char* smem) {
  const int t = tid_opaque(), lane = t & 63, wave = t >> 6;
  int* pe_l = (int*)smem; float* pg_l = (float*)(smem + 32 * 128 * 4); float* pw_l = (float*)(smem + 2 * 32 * 128 * 4);
  {
    int tl = t >> 3, p = t & 7; long row = (long)grp * 32 + tl;
    peer_combine(top1 + (row * 16 + p * 2) * 16, top1 + (row * 16 + p * 2 + 1) * 16, pe_l + tl * 128 + p * 16, pg_l + tl * 128 + p * 16);
  }
  __syncthreads();
  for (int ti = 0; ti < 8; ++ti) {
    const int tl = wave * 8 + ti; const long row = (long)grp * 32 + tl;
    const int* pe = pe_l + tl * 128; float* pw = pw_l + tl * 128;
    float h[16];
    { u32x4 h0 = *(const u32x4*)(xn + row * DM + lane * 16), h1 = *(const u32x4*)(xn + row * DM + lane * 16 + 8);
#pragma unroll
      for (int e = 0; e < 4; ++e) { h[2*e] = __uint_as_float(h0[e] << 16); h[2*e+1] = __uint_as_float(h0[e] & 0xffff0000u); h[8+2*e] = __uint_as_float(h1[e] << 16); h[8+2*e+1] = __uint_as_float(h1[e] & 0xffff0000u); } }
    u32x4 u[8];
#pragma unroll
    for (int j = 0; j < 8; ++j) u[j] = *(const u32x4*)(ub + (long)pe[j] * DM + lane * 16);
    for (int b = 0; b < 16; ++b) {
      float pd[8];
#pragma unroll
      for (int j = 0; j < 8; ++j) pd[j] = dot16_fp8(h, u[j]);
      if (b + 1 < 16) {
#pragma unroll
        for (int j = 0; j < 8; ++j) u[j] = *(const u32x4*)(ub + (long)pe[(b + 1) * 8 + j] * DM + lane * 16);
      }
      float q4[4], q2[2], q1;
#pragma unroll
      for (int j = 0; j < 4; ++j) { bool hi = lane & 1; float keep = hi ? pd[2*j+1] : pd[2*j], send = hi ? pd[2*j] : pd[2*j+1]; q4[j] = keep + __shfl_xor(send, 1); }
#pragma unroll
      for (int j = 0; j < 2; ++j) { bool hi = lane & 2; float keep = hi ? q4[2*j+1] : q4[2*j], send = hi ? q4[2*j] : q4[2*j+1]; q2[j] = keep + __shfl_xor(send, 2); }
      { bool hi = lane & 4; float keep = hi ? q2[1] : q2[0], send = hi ? q2[0] : q2[1]; q1 = keep + __shfl_xor(send, 4); }
      q1 += __shfl_xor(q1, 8); q1 += __shfl_xor(q1, 16); q1 += __shfl_xor(q1, 32);
      if (lane < 8) pw[b * 8 + lane] = q1 * su[pe[b * 8 + lane]];
    }
    u32x4 v[8];
#pragma unroll
    for (int j = 0; j < 8; ++j) v[j] = *(const u32x4*)(vb + (long)pe[j] * DM + lane * 16);
    {
      float d0 = pw[lane], d1 = pw[64 + lane];
      pw[lane] = pg_l[tl * 128 + lane] * fgelu_(d0) * sv[pe[lane]]; pw[64 + lane] = pg_l[tl * 128 + 64 + lane] * fgelu_(d1) * sv[pe[64 + lane]];
    }
    float o[16];
#pragma unroll
    for (int e = 0; e < 16; ++e) o[e] = 0.f;
    for (int b = 0; b < 16; ++b) {
      u32x4 vc[8];
#pragma unroll
      for (int j = 0; j < 8; ++j) vc[j] = v[j];
      if (b + 1 < 16) {
#pragma unroll
        for (int j = 0; j < 8; ++j) v[j] = *(const u32x4*)(vb + (long)pe[(b + 1) * 8 + j] * DM + lane * 16);
      }
#pragma unroll
      for (int j = 0; j < 8; ++j) axpy16_fp8(o, pw[b * 8 + j], vc[j]);
    }
    {
      int b = row / RB, lr = row % RB; int bb = lr < SEQ ? b : BATCH; const float* g5 = modl + ((long)bb * 6 + 5) * DM + lane * 16;
      float* xr = xs + row * DM + lane * 16;
#pragma unroll
      for (int i = 0; i < 4; ++i) {
        f32x4 x = *(f32x4*)(xr + 4 * i); f32x4 g = *(const f32x4*)(g5 + 4 * i);
        x[0] += g[0] * o[4*i]; x[1] += g[1] * o[4*i+1]; x[2] += g[2] * o[4*i+2]; x[3] += g[3] * o[4*i+3];
        *(f32x4*)(xr + 4 * i) = x;
      }
    }
  }
}

__device__ __forceinline__ float reduce16(float x) { x = reduce8(x); x += dpp_get<0x140>(x); return x; }
__device__ __forceinline__ void unpack8(u32x4 v, float (&f)[8]) {
#pragma unroll
  for (int e = 0; e < 4; ++e) { f[2*e] = __uint_as_float(v[e] << 16); f[2*e+1] = __uint_as_float(v[e] & 0xffff0000u); }
}
__device__ __forceinline__ u32x4 pack8(const float (&f)[8]) { u32x4 o;
#pragma unroll
  for (int e = 0; e < 4; ++e) o[e] = pack2bf(f[2*e], f[2*e+1]);
  return o; }
__device__ __forceinline__ void ph_rope_tables(float* rope_g, float* rope_m) {
  const int t = tid_opaque();
  for (int i = blockIdx.x * 256 + t; i < SEQ * 48; i += gridDim.x * 256) {
    int lr = i / 48, j = i % 48;
    if (j < 32) { int pos = j < 16 ? lr / 64 : lr % 64; float ang = (float)pos * powf(10000.f, -(float)(j & 15) / 16.f); rope_g[(lr * 32 + j) * 2] = cosf(ang); rope_g[(lr * 32 + j) * 2 + 1] = sinf(ang); }
    else { int jj = j - 32; int pos = jj < 8 ? lr / 64 : lr % 64; float ang = (float)pos * powf(10000.f, -(float)(jj & 7) / 8.f); rope_m[(lr * 16 + jj) * 2] = cosf(ang); rope_m[(lr * 16 + jj) * 2 + 1] = sinf(ang); }
  }
}
struct FinW2 { const float *mla_qk_g, *gqa_qk_g, *mu, *k_k, *k_a, *rope_g, *rope_m; };
#define FIN2_LDS_BYTES (64 * 384 * 2)
__device__ __forceinline__ void prep_finish_tile2(const FinW2& W, const FinBuf& B, int tile, char* smem) {
  const int t = tid_opaque(), lane = t & 63, wave = t >> 6; const long MA = NROWS;
  bf16_t* vbuf = (bf16_t*)smem;
  const long row0 = (long)tile * 8; const int b = row0 / RB; const int lr0 = row0 % RB;
  const int g8 = lane & 7, h8 = lane >> 3, s16 = lane & 15, h16 = lane >> 4;
  for (int it = 0; it < 2; ++it) {
    const int rl = it * 4 + wave; const long row = row0 + rl; const int lr = lr0 + rl; const bool lat = lr < SEQ;
    const bf16_t* Pr = B.P + row * IN_COLS;
    {
      float x[8]; unpack8(*(const u32x4*)(Pr + GQA_OFF + lane * 8), x);
      float ss = 0.f;
#pragma unroll
      for (int e = 0; e < 8; ++e) ss += x[e] * x[e];
      ss = reduce8(ss); const float inv = __builtin_amdgcn_rsqf(ss * (1.f / 64.f) + EPSN);
      const float* gp = W.gqa_qk_g + (h8 < 6 ? 0 : 64) + g8 * 8; f32x4 ga = *(const f32x4*)gp, gb = *(const f32x4*)(gp + 4);
#pragma unroll
      for (int e = 0; e < 4; ++e) { x[e] *= inv * ga[e]; x[4 + e] *= inv * gb[e]; }
      float o[8];
      if (lat) {
        const float* rt = W.rope_g + ((long)lr * 32 + (g8 & 3) * 8) * 2;
#pragma unroll
        for (int e = 0; e < 8; ++e) { float ot = swz_xor4(x[e]); float cs = rt[2 * e], sn = rt[2 * e + 1]; o[e] = (g8 & 4) ? (ot * sn + x[e] * cs) : (x[e] * cs - ot * sn); }
      } else {
#pragma unroll
        for (int e = 0; e < 8; ++e) o[e] = x[e];
      }
      if (h8 < 6) {
#pragma unroll
        for (int e = 0; e < 8; ++e) o[e] *= 0.18033688f;
        *(u32x4*)(B.gq + row * 384 + lane * 8) = pack8(o);
      } else *(u32x4*)(B.gk + row * 128 + (lane - 48) * 8) = pack8(o);
    }
    float cq, ckv;
    {
      float ss = 0.f;
      if (lane < 48) { float x[8]; unpack8(*(const u32x4*)(Pr + lane * 8), x);
#pragma unroll
        for (int e = 0; e < 8; ++e) ss += x[e] * x[e]; }
      float sq = wave_sum(lane < 32 ? ss : 0.f), skv = wave_sum(lane >= 32 ? ss : 0.f);
      cq = __builtin_amdgcn_rsqf(sq * (1.f / 256.f) + EPSN); ckv = __builtin_amdgcn_rsqf(skv * (1.f / 128.f) + EPSN);
    }
    {
      float cs0 = 1.f, sn0 = 0.f, cs1 = 1.f, sn1 = 0.f;
      if (lat) { f32x4 r4 = *(const f32x4*)(W.rope_m + ((long)lr * 16 + (s16 & 7) * 2) * 2); cs0 = r4[0]; sn0 = r4[1]; cs1 = r4[2]; sn1 = r4[3]; }
      const float kr0 = bf2f(Pr[384 + s16 * 2]), kr1 = bf2f(Pr[384 + s16 * 2 + 1]);
#pragma unroll
      for (int which = 0; which < 2; ++which) {
        float n[4], r0, r1;
        if (which == 0) {
          uint2 a = *(const uint2*)(B.tq + row * 384 + h16 * 96 + s16 * 4); unsigned rr = *(const unsigned*)(B.tq + row * 384 + h16 * 96 + 64 + s16 * 2);
          n[0] = cq * __uint_as_float(a.x << 16); n[1] = cq * __uint_as_float(a.x & 0xffff0000u); n[2] = cq * __uint_as_float(a.y << 16); n[3] = cq * __uint_as_float(a.y & 0xffff0000u);
          r0 = cq * __uint_as_float(rr << 16); r1 = cq * __uint_as_float(rr & 0xffff0000u);
        } else {
          uint2 a = *(const uint2*)(B.tkv + row * 512 + h16 * 128 + s16 * 4);
          n[0] = ckv * __uint_as_float(a.x << 16); n[1] = ckv * __uint_as_float(a.x & 0xffff0000u); n[2] = ckv * __uint_as_float(a.y << 16); n[3] = ckv * __uint_as_float(a.y & 0xffff0000u);
          r0 = kr0; r1 = kr1;
        }
        float ss = n[0]*n[0] + n[1]*n[1] + n[2]*n[2] + n[3]*n[3] + r0*r0 + r1*r1;
        ss = reduce16(ss); const float inv = __builtin_amdgcn_rsqf(ss * (1.f / 96.f) + EPSN);
        const float* gp = W.mla_qk_g + which * 96; f32x4 gn = *(const f32x4*)(gp + s16 * 4); const float g0 = gp[64 + s16 * 2], g1 = gp[64 + s16 * 2 + 1];
#pragma unroll
        for (int e = 0; e < 4; ++e) n[e] *= inv * gn[e];
        r0 *= inv * g0; r1 *= inv * g1;
        float o0 = dpp_get<0x128>(r0), o1 = dpp_get<0x128>(r1);
        float q0, q1;
        if (s16 & 8) { q0 = o0 * sn0 + r0 * cs0; q1 = o1 * sn1 + r1 * cs1; } else { q0 = r0 * cs0 - o0 * sn0; q1 = r1 * cs1 - o1 * sn1; }
        const float sc = which == 0 ? 0.14724445f : 1.f;
        bf16_t* dst = (which == 0 ? B.mq : B.mk) + row * 384 + h16 * 96;
        uint2 pk; pk.x = pack2bf(n[0] * sc, n[1] * sc); pk.y = pack2bf(n[2] * sc, n[3] * sc);
        *(uint2*)(dst + s16 * 4) = pk; *(unsigned*)(dst + 64 + s16 * 2) = pack2bf(q0 * sc, q1 * sc);
      }
      if (lane < 32) { float x[8]; unpack8(*(const u32x4*)(B.tkv + row * 512 + h8 * 128 + 64 + g8 * 8), x);
#pragma unroll
        for (int e = 0; e < 8; ++e) x[e] *= ckv;
        *(u32x4*)(vbuf + rl * 384 + h8 * 64 + g8 * 8) = pack8(x); }
      else if (lane < 48) *(u32x4*)(vbuf + rl * 384 + 256 + (lane - 32) * 8) = *(const u32x4*)(Pr + GQA_OFF + 512 + (lane - 32) * 8);
    }
    if (lane < 48) {
      const bool first = (lr == 0) || (lr == SEQ), last = (lr == SEQ - 1) || (lr == RB - 1);
      const long o = row * 384 + lane * 8;
      float xs3[3][8];
#pragma unroll
      for (int part = 0; part < 3; ++part) {
        const int c = part * 384 + lane * 8; const bf16_t* pp = Pr + RW_OFF + c;
        float p[8], pv[8], nx[8]; unpack8(*(const u32x4*)pp, p);
        u32x4 z = {0u, 0u, 0u, 0u}; unpack8(first ? z : *(const u32x4*)(pp - IN_COLS), pv); unpack8(last ? z : *(const u32x4*)(pp + IN_COLS), nx);
        f32x4 m0a = *(const f32x4*)(W.mu + c), m0b = *(const f32x4*)(W.mu + c + 4), m1a = *(const f32x4*)(W.mu + RWC + c), m1b = *(const f32x4*)(W.mu + RWC + c + 4);
#pragma unroll
        for (int e = 0; e < 4; ++e) { xs3[part][e] = p[e] + m0a[e] * (pv[e] - p[e]) + m1a[e] * (nx[e] - p[e]); xs3[part][4+e] = p[4+e] + m0b[e] * (pv[4+e] - p[4+e]) + m1b[e] * (nx[4+e] - p[4+e]); }
      }
      *(u32x4*)(B.r_b + o) = pack8(xs3[0]); *(u32x4*)(B.v_b + o) = pack8(xs3[2]);
      f32x4 kka = *(const f32x4*)(W.k_k + lane * 8), kkb = *(const f32x4*)(W.k_k + lane * 8 + 4), kaa = *(const f32x4*)(W.k_a + lane * 8), kab = *(const f32x4*)(W.k_a + lane * 8 + 4);
      float tk[8], ss = 0.f;
#pragma unroll
      for (int e = 0; e < 4; ++e) { tk[e] = xs3[1][e] * kka[e]; tk[4+e] = xs3[1][4+e] * kkb[e]; }
#pragma unroll
      for (int e = 0; e < 8; ++e) ss += tk[e] * tk[e];
      ss = reduce8(ss); const float invk = __builtin_amdgcn_rsqf(ss + 1e-12f);
#pragma unroll
      for (int e = 0; e < 8; ++e) tk[e] *= invk;
      *(u32x4*)(B.kk_b + o) = pack8(tk);
#pragma unroll
      for (int d = 0; d < 2; ++d) {
        float a[8], kd[8], bd[8]; unpack8(*(const u32x4*)(B.a_b + d * MA * 384 + o), a);
#pragma unroll
        for (int e = 0; e < 8; ++e) { float ka = e < 4 ? kaa[e] : kab[e - 4]; kd[e] = xs3[1][e] * (1.f + (a[e] - 1.f) * ka); bd[e] = tk[e] * a[e]; }
        *(u32x4*)(B.kd_b + d * MA * 384 + o) = pack8(kd); *(u32x4*)(B.bd_b + d * MA * 384 + o) = pack8(bd);
      }
    } else { (void)reduce8(0.f); }
  }
  __syncthreads();
  for (int i = t; i < 384; i += 256) {
    int c = i % 384, rc = i / 384;
    unsigned short v8[8];
#pragma unroll
    for (int e = 0; e < 8; ++e) v8[e] = vbuf[(rc * 8 + e) * 384 + c];
    u32x4 o; o[0] = v8[0] | ((unsigned)v8[1] << 16); o[1] = v8[2] | ((unsigned)v8[3] << 16); o[2] = v8[4] | ((unsigned)v8[5] << 16); o[3] = v8[6] | ((unsigned)v8[7] << 16);
    bf16_t* dst = c < 256 ? B.mvT + ((long)(b * 4 + (c >> 6)) * 64 + (c & 63)) * RB : B.gvT + ((long)(b * 2 + ((c - 256) >> 6)) * 64 + (c & 63)) * RB;
    *(u32x4*)(dst + lr0 + rc * 8) = o;
  }
  __syncthreads();
}
__device__ __forceinline__ void rw_readout_row2(const RdW& W, const float* __restrict__ y, const bf16_t* __restrict__ r_b, const bf16_t* __restrict__ v_b, const bf16_t* __restrict__ kd_b,
                                                const bf16_t* __restrict__ g_b, bf16_t* __restrict__ mixall, long row, int lane) {
  const long MA = NROWS;
  float yy[8], s = 0.f; float r[8], k0[8], k1[8], vv[8], gg[8];
  const int c = lane * 8; const long o = row * 384 + c;
  if (lane < 48) {
    f32x4 a0 = *(const f32x4*)(y + o), a1 = *(const f32x4*)(y + o + 4), b0 = *(const f32x4*)(y + MA * 384 + o), b1 = *(const f32x4*)(y + MA * 384 + o + 4);
#pragma unroll
    for (int e = 0; e < 4; ++e) { yy[e] = a0[e] + b0[e]; yy[4+e] = a1[e] + b1[e]; }
    unpack8(*(const u32x4*)(r_b + o), r); unpack8(*(const u32x4*)(kd_b + o), k0); unpack8(*(const u32x4*)(kd_b + MA * 384 + o), k1);
    unpack8(*(const u32x4*)(v_b + o), vv); unpack8(*(const u32x4*)(g_b + o), gg);
  } else {
#pragma unroll
    for (int e = 0; e < 8; ++e) { yy[e] = 0.f; r[e] = 0.f; k0[e] = 0.f; k1[e] = 0.f; vv[e] = 0.f; gg[e] = 0.f; }
  }
#pragma unroll
  for (int e = 0; e < 8; ++e) s += yy[e];
  const float mean = reduce8(s) * (1.f / 64.f);
  float vs = 0.f, cf = 0.f;
  const int cc = lane < 48 ? c : 0;
  f32x4 rk0 = *(const f32x4*)(W.r_k + cc), rk1 = *(const f32x4*)(W.r_k + cc + 4);
#pragma unroll
  for (int e = 0; e < 8; ++e) { float d = yy[e] - mean; vs += d * d; cf += r[e] * (k0[e] + k1[e]) * (e < 4 ? rk0[e] : rk1[e - 4]); }
  const float var = reduce8(vs) * (1.f / 64.f), coef = reduce8(cf);
  const float inv = __builtin_amdgcn_rsqf(var + 64e-5f);
  if (lane < 48) {
    f32x4 lg0 = *(const f32x4*)(W.ln_g + c), lg1 = *(const f32x4*)(W.ln_g + c + 4), lb0 = *(const f32x4*)(W.ln_b + c), lb1 = *(const f32x4*)(W.ln_b + c + 4);
    float out[8];
#pragma unroll
    for (int e = 0; e < 8; ++e) { float yn = (yy[e] - mean) * inv * (e < 4 ? lg0[e] : lg1[e - 4]) + (e < 4 ? lb0[e] : lb1[e - 4]); out[e] = (yn + coef * vv[e]) * gg[e]; }
    *(u32x4*)(mixall + row * DM + 256 + c) = pack8(out);
  }
}

#define PG_NT 4
#define PG_TOK (4 * PG_NT)
#define PG_OFF_H 0
#define PG_OFF_E (PG_TOK * 2048)
#define PG_OFF_G (PG_OFF_E + PG_TOK * 128 * 2)
#define PG_OFF_ST (PG_OFF_G + PG_TOK * 128 * 4)
#define PG_OFF_CNT (PG_OFF_ST + PG_TOK * 18 * 2)
#define PG_LDS_BYTES (PG_OFF_CNT + PG_TOK * 8 * 16 * 2)
__device__ __forceinline__ long pg_row(int g, int ntok) { return ntok == NROWS ? (long)g : (long)(g / SEQ) * RB + (g % SEQ); }
__device__ __forceinline__ void peer_gather_sliced(const bf16_t* __restrict__ xn, const unsigned* __restrict__ top1, const unsigned char* __restrict__ ub, const float* __restrict__ su,
                                                   const unsigned char* __restrict__ vb, const float* __restrict__ sv, const float* __restrict__ modl, float* __restrict__ xs,
                                                   int ntok, char* smem, const float* __restrict__ ng, const float* __restrict__ nmod, bf16_t* __restrict__ xn_next, float* __restrict__ out, bool dry = false, unsigned emask = 0x3FFFu) {
  bf16_t* hs = (bf16_t*)(smem + PG_OFF_H); unsigned short* se = (unsigned short*)(smem + PG_OFF_E); float* sg = (float*)(smem + PG_OFF_G);
  unsigned short* sst = (unsigned short*)(smem + PG_OFF_ST); unsigned short* cnt = (unsigned short*)(smem + PG_OFF_CNT);
  const int per_block = (ntok + (int)gridDim.x - 1) / (int)gridDim.x;
  const int npass = (per_block + PG_TOK - 1) / PG_TOK; const int tpp = (per_block + npass - 1) / npass;
  for (int pass = 0; pass < npass; ++pass) {
    const int t = tid_opaque(), lane = t & 63, wave = t >> 6;
    __syncthreads();
    for (int i = t; i < PG_TOK * 8 * 16; i += 256) cnt[i] = 0;
    for (int i = t; i < PG_TOK * 128; i += 256) {
      int tl = i >> 7, ch = i & 127; int q = (tl % PG_NT) * 4 + tl / PG_NT; int idx = pass * tpp + q; int g = (int)blockIdx.x + idx * (int)gridDim.x;
      u32x4 v = {0u, 0u, 0u, 0u};
      if (q < tpp && idx < per_block && g < ntok) v = *(const u32x4*)(xn + pg_row(g, ntok) * DM + ch * 8);
      *(u32x4*)(hs + tl * 1024 + ch * 8) = v;
    }
    __syncthreads();
    int my_e[16]; float my_g[16];
    const int ctl = t >> 3, cp = t & 7;
    bool cact = false;
    if (ctl < PG_TOK) {
      int q = (ctl % PG_NT) * 4 + ctl / PG_NT; int idx = pass * tpp + q; int g = (int)blockIdx.x + idx * (int)gridDim.x;
      cact = q < tpp && idx < per_block && g < ntok;
      if (cact) {
        long row = pg_row(g, ntok);
        peer_combine(top1 + (row * 16 + cp * 2) * 16, top1 + (row * 16 + cp * 2 + 1) * 16, my_e, my_g);
#pragma unroll
        for (int k = 0; k < 16; ++k) cnt[(ctl * 8 + cp) * 16 + (my_e[k] >> 10)] += 1;
      }
    }
    __syncthreads();
    if (t < PG_TOK) {
      int run = 0;
      for (int s = 0; s < 16; ++s) {
        sst[t * 18 + s] = (unsigned short)run;
        for (int h = 0; h < 8; ++h) { int c = cnt[(t * 8 + h) * 16 + s]; cnt[(t * 8 + h) * 16 + s] = (unsigned short)run; run += c; }
      }
      sst[t * 18 + 16] = (unsigned short)run;
    }
    __syncthreads();
    if (cact) {
#pragma unroll
      for (int k = 0; k < 16; ++k) { int s = my_e[k] >> 10; int pos = cnt[(ctl * 8 + cp) * 16 + s]; cnt[(ctl * 8 + cp) * 16 + s] = (unsigned short)(pos + 1); se[ctl * 128 + pos] = (unsigned short)my_e[k]; sg[ctl * 128 + pos] = my_g[k]; }
    }
    __syncthreads();
    float acc[PG_NT][16];
#pragma unroll
    for (int tk = 0; tk < PG_NT; ++tk)
#pragma unroll
      for (int e = 0; e < 16; ++e) acc[tk][e] = 0.f;
    for (int s = 0; s < 16; ++s) {
#pragma unroll
      for (int tk = 0; tk < PG_NT; ++tk) {
        const int tl = wave * PG_NT + tk;
        const int st = sst[tl * 18 + s], en = sst[tl * 18 + s + 1];
        for (int base = st; base < en; base += 8) {
          const int nb = en - base < 8 ? en - base : 8;
          u32x4 u[8], v[8];
#pragma unroll
          for (int j = 0; j < 8; ++j) if (j < nb) { const unsigned off = ((unsigned)se[tl * 128 + base + j] & emask) * 1024u + (unsigned)lane * 16u; u[j] = *(const u32x4*)(ub + off); v[j] = *(const u32x4*)(vb + off); }
          float h[16];
          { u32x4 h0 = *(const u32x4*)(hs + tl * 1024 + lane * 16), h1 = *(const u32x4*)(hs + tl * 1024 + lane * 16 + 8);
#pragma unroll
            for (int e = 0; e < 4; ++e) { h[2*e] = __uint_as_float(h0[e] << 16); h[2*e+1] = __uint_as_float(h0[e] & 0xffff0000u); h[8+2*e] = __uint_as_float(h1[e] << 16); h[8+2*e+1] = __uint_as_float(h1[e] & 0xffff0000u); } }
          float pd[8];
#pragma unroll
          for (int j = 0; j < 8; ++j) pd[j] = j < nb ? dot16_fp8(h, u[j]) : 0.f;
          float q4[4], q2[2], q1;
#pragma unroll
          for (int j = 0; j < 4; ++j) { bool hi = lane & 1; float keep = hi ? pd[2*j+1] : pd[2*j], send = hi ? pd[2*j] : pd[2*j+1]; q4[j] = keep + dpp_get<0xB1>(send); }
#pragma unroll
          for (int j = 0; j < 2; ++j) { bool hi = lane & 2; float keep = hi ? q4[2*j+1] : q4[2*j], send = hi ? q4[2*j] : q4[2*j+1]; q2[j] = keep + dpp_get<0x4E>(send); }
          { bool hi = lane & 4; float keep = hi ? q2[1] : q2[0], send = hi ? q2[0] : q2[1]; q1 = keep + xor4_get(send); }
          q1 += dpp_get<0x128>(q1);
          q1 = xor16_sum(q1);
          q1 = xor32_sum(q1);
          float w = 0.f;
          { const int jj = lane & 7; if (jj < nb) { int e = se[tl * 128 + base + jj]; w = sg[tl * 128 + base + jj] * fgelu_(q1 * su[e]) * sv[e]; } }
#pragma unroll
          for (int j = 0; j < 8; ++j) { float wj = __builtin_bit_cast(float, __builtin_amdgcn_readlane(__builtin_bit_cast(int, w), j)); if (j < nb) axpy16_fp8(acc[tk], wj, v[j]); }
        }
      }
    }
    if (dry) {
#pragma unroll
      for (int tk = 0; tk < PG_NT; ++tk)
#pragma unroll
        for (int e = 0; e < 16; ++e) asm volatile("" :: "v"(acc[tk][e]));
    }
#pragma unroll
    for (int tk = 0; tk < PG_NT; ++tk) {
      int q = tk * 4 + wave; int idx = pass * tpp + q; int g = (int)blockIdx.x + idx * (int)gridDim.x;
      if (!dry && q < tpp && idx < per_block && g < ntok) {
        long row = pg_row(g, ntok); int b = row / RB, lr = row % RB; int bb = lr < SEQ ? b : BATCH; const float* g5 = modl + ((long)bb * 6 + 5) * DM + lane * 16;
        float* xr = xs + row * DM + lane * 16;
        f32x4 xv[4]; float ss = 0.f;
#pragma unroll
        for (int i = 0; i < 4; ++i) {
          f32x4 x = *(f32x4*)(xr + 4 * i); f32x4 gg = *(const f32x4*)(g5 + 4 * i);
          x[0] += gg[0] * acc[tk][4*i]; x[1] += gg[1] * acc[tk][4*i+1]; x[2] += gg[2] * acc[tk][4*i+2]; x[3] += gg[3] * acc[tk][4*i+3];
          xv[i] = x; ss += x[0] * x[0] + x[1] * x[1] + x[2] * x[2] + x[3] * x[3];
        }
        if (out) {
          float* orow = out + ((long)b * SEQ + lr) * DM + lane * 16;
#pragma unroll
          for (int i = 0; i < 4; ++i) *(f32x4*)(orow + 4 * i) = xv[i];
        } else {
#pragma unroll
          for (int i = 0; i < 4; ++i) *(f32x4*)(xr + 4 * i) = xv[i];
          ss = wave_sum(ss); const float inv = __builtin_amdgcn_rsqf(ss * (1.f / DM) + EPSN);
          const float* sh = nmod + ((long)bb * 6 + 0) * DM + lane * 16; const float* sc = sh + DM; const float* gp = ng + lane * 16;
          u32x4 p0, p1;
#pragma unroll
          for (int i = 0; i < 4; ++i) { f32x4 g4 = *(const f32x4*)(gp + 4 * i), s4 = *(const f32x4*)(sc + 4 * i), h4 = *(const f32x4*)(sh + 4 * i);
            const float a0 = xv[i][0] * inv * g4[0] * (1.f + s4[0]) + h4[0], a1 = xv[i][1] * inv * g4[1] * (1.f + s4[1]) + h4[1];
            const float a2 = xv[i][2] * inv * g4[2] * (1.f + s4[2]) + h4[2], a3 = xv[i][3] * inv * g4[3] * (1.f + s4[3]) + h4[3];
            if (i < 2) { p0[2 * i] = pack2bf(a0, a1); p0[2 * i + 1] = pack2bf(a2, a3); } else { p1[2 * (i - 2)] = pack2bf(a0, a1); p1[2 * (i - 2) + 1] = pack2bf(a2, a3); } }
          *(u32x4*)(xn_next + row * DM + lane * 16) = p0; *(u32x4*)(xn_next + row * DM + lane * 16 + 8) = p1;
        }
      }
    }
  }
}

#define PG3_OFF_H 0
#define PG3_OFF_FE (12 * 2048)
#define PG3_OFF_FG (PG3_OFF_FE + 4 * 384 * 2)
#define PG3_OFF_FS (PG3_OFF_FG + 4 * 384 * 4)
#define PG3_OFF_BT (PG3_OFF_FS + 4 * 384 * 4)
#define PG3_OFF_CNT (PG3_OFF_BT + 4 * 160 * 4)
#define PG3_OFF_TOT (PG3_OFF_CNT + 4 * 512 * 2)
#define PG3_LDS_BYTES (PG3_OFF_TOT + 512)
#define PG3_REC_BYTES (384 * 2 + 384 * 4 + 384 * 4 + 160 * 4 + 16)
__device__ __forceinline__ void peer_lists_build3(const unsigned* __restrict__ top1, const float* __restrict__ su, const float* __restrict__ sv, char* __restrict__ gl, int ntok, char* smem) {
  unsigned short* fe = (unsigned short*)(smem + PG3_OFF_FE); float* fg = (float*)(smem + PG3_OFF_FG); float* fs = (float*)(smem + PG3_OFF_FS);
  unsigned* bt = (unsigned*)(smem + PG3_OFF_BT); unsigned short* cnt = (unsigned short*)(smem + PG3_OFF_CNT); unsigned short* tot = (unsigned short*)(smem + PG3_OFF_TOT);
  int* nbt = (int*)(smem + PG3_OFF_TOT + 320);
  const int per_block = (ntok + (int)gridDim.x - 1) / (int)gridDim.x;
  const int npass = (per_block + 11) / 12; const int tpp = (per_block + npass - 1) / npass;
  for (int pass = 0; pass < npass; ++pass) {
    const int t = tid_opaque();
    __syncthreads();
    for (int i = t; i < 4 * 512; i += 256) cnt[i] = 0;
    __syncthreads();
    int my_e[16]; float my_g[16];
    const int ctl = t >> 3, cp = t & 7; const int cw = ctl / 3, ctk = ctl % 3;
    bool cact = false;
    if (ctl < 12) {
      int q = ctk * 4 + cw; int idx = pass * tpp + q; int g = (int)blockIdx.x + idx * (int)gridDim.x;
      cact = q < tpp && idx < per_block && g < ntok;
      if (cact) {
        long row = pg_row(g, ntok);
        peer_combine(top1 + (row * 16 + cp * 2) * 16, top1 + (row * 16 + cp * 2 + 1) * 16, my_e, my_g);
#pragma unroll
        for (int k = 0; k < 16; ++k) cnt[((cw * 16 + (my_e[k] >> 10)) * 4 + ctk) * 8 + cp] += 1;
      }
    }
    __syncthreads();
    unsigned short* tot2 = tot + 80;
    if (t < 64) {
      int w_ = t >> 4, s = t & 15; int ne = 0, nbk = 0;
      for (int tk = 0; tk < 3; ++tk) { int n = 0; for (int h = 0; h < 8; ++h) n += cnt[((w_ * 16 + s) * 4 + tk) * 8 + h]; ne += n; nbk += (n + 7) >> 3; }
      tot[w_ * 16 + s] = (unsigned short)ne; tot2[w_ * 16 + s] = (unsigned short)nbk;
    }
    __syncthreads();
    if (t < 64) {
      int w_ = t >> 4, s = t & 15; int run = 0, nb_ = 0;
      for (int i = 0; i < s; ++i) { run += tot[w_ * 16 + i]; nb_ += tot2[w_ * 16 + i]; }
      for (int tk = 0; tk < 3; ++tk) {
        int gstart = run;
        for (int h = 0; h < 8; ++h) { int ci = ((w_ * 16 + s) * 4 + tk) * 8 + h; int c = cnt[ci]; cnt[ci] = (unsigned short)run; run += c; }
        for (int b0 = gstart; b0 < run; b0 += 8) { int n = run - b0 < 8 ? run - b0 : 8; bt[w_ * 160 + nb_] = (unsigned)tk | ((unsigned)b0 << 4) | ((unsigned)n << 16); ++nb_; }
      }
      if (s == 15) { while (nb_ % 3) { bt[w_ * 160 + nb_] = 0u; ++nb_; } nbt[w_] = nb_; }
    }
    __syncthreads();
    if (cact) {
#pragma unroll
      for (int k = 0; k < 16; ++k) { int ci = ((cw * 16 + (my_e[k] >> 10)) * 4 + ctk) * 8 + cp; int pos = cnt[ci]; cnt[ci] = (unsigned short)(pos + 1);
        fe[cw * 384 + pos] = (unsigned short)my_e[k]; fg[cw * 384 + pos] = my_g[k] * sv[my_e[k]]; fs[cw * 384 + pos] = su[my_e[k]]; }
    }
    __syncthreads();
    char* rec = gl + ((long)blockIdx.x * 4 + pass) * 4 * PG3_REC_BYTES;
    for (int i = t; i < 4 * 48; i += 256) { int w_ = i / 48, c = i % 48; *(u32x4*)(rec + w_ * PG3_REC_BYTES + c * 16) = *(const u32x4*)((const char*)fe + w_ * 768 + c * 16); }
    for (int i = t; i < 4 * 96; i += 256) { int w_ = i / 96, c = i % 96; *(u32x4*)(rec + w_ * PG3_REC_BYTES + 768 + c * 16) = *(const u32x4*)((const char*)fg + w_ * 1536 + c * 16); }
    for (int i = t; i < 4 * 96; i += 256) { int w_ = i / 96, c = i % 96; *(u32x4*)(rec + w_ * PG3_REC_BYTES + 2304 + c * 16) = *(const u32x4*)((const char*)fs + w_ * 1536 + c * 16); }
    for (int i = t; i < 4 * 40; i += 256) { int w_ = i / 40, c = i % 40; *(u32x4*)(rec + w_ * PG3_REC_BYTES + 3840 + c * 16) = *(const u32x4*)((const char*)bt + w_ * 640 + c * 16); }
    if (t < 4) *(int*)(rec + t * PG3_REC_BYTES + 4480) = nbt[t];
  }
  __syncthreads();
}
__device__ __forceinline__ void pg3_issue(u32x4 (&B)[8], const unsigned char* __restrict__ tab, const unsigned short* we, unsigned desc, int lane) {
  const int base = (desc >> 4) & 0xFFF, nb = desc >> 16;
#pragma unroll
  for (int j = 0; j < 8; ++j) { const int jj = j < nb ? j : (nb > 0 ? nb - 1 : 0); const unsigned off = (unsigned)we[base + jj] * 1024u + (unsigned)lane * 16u; B[j] = *(const u32x4*)(tab + off); }
}
__device__ __forceinline__ void pg3_axpy8(float (&a)[16], const u32x4 (&V)[8], float w, int nb) {
#pragma unroll
  for (int j = 0; j < 8; ++j) { const float wj = __builtin_bit_cast(float, __builtin_amdgcn_readlane(__builtin_bit_cast(int, w), j)); if (j < nb) axpy16_fp8(a, wj, V[j]); }
}
__device__ __forceinline__ void pg3_step(u32x4 (&U)[8], u32x4 (&V)[8], u32x4 (&F)[8], int k, int nbat, float (&acc)[3][16],
                                         const unsigned char* __restrict__ ub, const unsigned char* __restrict__ vb,
                                         const unsigned short* we, const float* wg, const float* wsc, const unsigned* wb, const bf16_t* hw, int lane) {
  const unsigned desc = __builtin_amdgcn_readfirstlane(wb[k]);
  const int tk = desc & 15, base = (desc >> 4) & 0xFFF, nb = desc >> 16;
  const unsigned dnext = __builtin_amdgcn_readfirstlane(wb[k + 1 < nbat ? k + 1 : k]);
  pg3_issue(F, ub, we, dnext, lane);
  float h[16];
  { const bf16_t* hp = hw + tk * 1024 + lane * 16; u32x4 h0 = *(const u32x4*)hp, h1 = *(const u32x4*)(hp + 8);
#pragma unroll
    for (int e = 0; e < 4; ++e) { h[2*e] = __uint_as_float(h0[e] << 16); h[2*e+1] = __uint_as_float(h0[e] & 0xffff0000u); h[8+2*e] = __uint_as_float(h1[e] << 16); h[8+2*e+1] = __uint_as_float(h1[e] & 0xffff0000u); } }
  float pd[8];
#pragma unroll
  for (int j = 0; j < 8; ++j) pd[j] = j < nb ? dot16_fp8(h, U[j]) : 0.f;
  pg3_issue(U, vb, we, dnext, lane);
  float q4[4], q2[2], q1;
#pragma unroll
  for (int j = 0; j < 4; ++j) { bool hi = lane & 1; float keep = hi ? pd[2*j+1] : pd[2*j], send = hi ? pd[2*j] : pd[2*j+1]; q4[j] = keep + dpp_get<0xB1>(send); }
#pragma unroll
  for (int j = 0; j < 2; ++j) { bool hi = lane & 2; float keep = hi ? q4[2*j+1] : q4[2*j], send = hi ? q4[2*j] : q4[2*j+1]; q2[j] = keep + dpp_get<0x4E>(send); }
  { bool hi = lane & 4; float keep = hi ? q2[1] : q2[0], send = hi ? q2[0] : q2[1]; q1 = keep + xor4_get(send); }
  q1 += dpp_get<0x128>(q1);
  q1 = xor16_sum(q1);
  q1 = xor32_sum(q1);
  float w = 0.f;
  { const int jj = lane & 7; if (jj < nb) w = wg[base + jj] * fgelu_(q1 * wsc[base + jj]); }
  if (tk == 0) pg3_axpy8(acc[0], V, w, nb); else if (tk == 1) pg3_axpy8(acc[1], V, w, nb); else pg3_axpy8(acc[2], V, w, nb);
}
__device__ __forceinline__ void peer_gather_sweep3(const bf16_t* __restrict__ xn, const char* __restrict__ gl, const unsigned char* __restrict__ ub,
                                                   const unsigned char* __restrict__ vb, const float* __restrict__ modl, float* __restrict__ xs, int ntok, char* smem,
                                                   const float* __restrict__ ng, const float* __restrict__ nmod, bf16_t* __restrict__ xn_next, float* __restrict__ out) {
  bf16_t* hs = (bf16_t*)(smem + PG3_OFF_H); unsigned short* fe = (unsigned short*)(smem + PG3_OFF_FE); float* fg = (float*)(smem + PG3_OFF_FG); float* fs = (float*)(smem + PG3_OFF_FS);
  unsigned* bt = (unsigned*)(smem + PG3_OFF_BT); int* nbt = (int*)(smem + PG3_OFF_TOT + 320);
  const int per_block = (ntok + (int)gridDim.x - 1) / (int)gridDim.x;
  const int npass = (per_block + 11) / 12; const int tpp = (per_block + npass - 1) / npass;
  for (int pass = 0; pass < npass; ++pass) {
    {
      const int t = tid_opaque();
      __syncthreads();
      const char* rec = gl + ((long)blockIdx.x * 4 + pass) * 4 * PG3_REC_BYTES;
      for (int i = t; i < 4 * 48; i += 256) { int w_ = i / 48, c = i % 48; *(u32x4*)((char*)fe + w_ * 768 + c * 16) = *(const u32x4*)(rec + w_ * PG3_REC_BYTES + c * 16); }
      for (int i = t; i < 4 * 96; i += 256) { int w_ = i / 96, c = i % 96; *(u32x4*)((char*)fg + w_ * 1536 + c * 16) = *(const u32x4*)(rec + w_ * PG3_REC_BYTES + 768 + c * 16); }
      for (int i = t; i < 4 * 96; i += 256) { int w_ = i / 96, c = i % 96; *(u32x4*)((char*)fs + w_ * 1536 + c * 16) = *(const u32x4*)(rec + w_ * PG3_REC_BYTES + 2304 + c * 16); }
      for (int i = t; i < 4 * 40; i += 256) { int w_ = i / 40, c = i % 40; *(u32x4*)((char*)bt + w_ * 640 + c * 16) = *(const u32x4*)(rec + w_ * PG3_REC_BYTES + 3840 + c * 16); }
      if (t < 4) nbt[t] = *(const int*)(rec + t * PG3_REC_BYTES + 4480);
      for (int i = t; i < 12 * 128; i += 256) {
        int tl = i >> 7, ch = i & 127; int q = (tl % 3) * 4 + (tl / 3); int idx = pass * tpp + q; int g = (int)blockIdx.x + idx * (int)gridDim.x;
        u32x4 v = {0u, 0u, 0u, 0u};
        if (q < tpp && idx < per_block && g < ntok) v = *(const u32x4*)(xn + pg_row(g, ntok) * DM + ch * 8);
        *(u32x4*)(hs + tl * 1024 + ch * 8) = v;
      }
      __syncthreads();
    }
    const int t_s = tid_opaque(); const int lane = t_s & 63, wave = t_s >> 6;
    float acc[3][16];
#pragma unroll
    for (int tk = 0; tk < 3; ++tk)
#pragma unroll
      for (int e = 0; e < 16; ++e) acc[tk][e] = 0.f;
    const int nbat = nbt[wave];
    const unsigned short* we = fe + wave * 384; const float* wg = fg + wave * 384; const float* wsc = fs + wave * 384; const unsigned* wb = bt + wave * 160;
    const bf16_t* hw = hs + wave * 3 * 1024;
    u32x4 X[8], Y[8], Z[8];
    if (nbat > 0) { const unsigned d0 = __builtin_amdgcn_readfirstlane(wb[0]); pg3_issue(X, ub, we, d0, lane); pg3_issue(Y, vb, we, d0, lane); }
    for (int k = 0; k < nbat; k += 3) {
      pg3_step(X, Y, Z, k, nbat, acc, ub, vb, we, wg, wsc, wb, hw, lane);
      pg3_step(Z, X, Y, k + 1, nbat, acc, ub, vb, we, wg, wsc, wb, hw, lane);
      pg3_step(Y, Z, X, k + 2, nbat, acc, ub, vb, we, wg, wsc, wb, hw, lane);
    }
#pragma unroll
    for (int tk = 0; tk < 3; ++tk) {
      int q = tk * 4 + wave; int idx = pass * tpp + q; int g = (int)blockIdx.x + idx * (int)gridDim.x;
      if (q < tpp && idx < per_block && g < ntok) {
        long row = pg_row(g, ntok); int b = row / RB, lr = row % RB; int bb = lr < SEQ ? b : BATCH; const float* g5 = modl + ((long)bb * 6 + 5) * DM + lane * 16;
        float* xr = xs + row * DM + lane * 16;
        f32x4 xv[4]; float ss = 0.f;
#pragma unroll
        for (int i = 0; i < 4; ++i) {
          f32x4 x = *(f32x4*)(xr + 4 * i); f32x4 gg = *(const f32x4*)(g5 + 4 * i);
          x[0] += gg[0] * acc[tk][4*i]; x[1] += gg[1] * acc[tk][4*i+1]; x[2] += gg[2] * acc[tk][4*i+2]; x[3] += gg[3] * acc[tk][4*i+3];
          xv[i] = x; ss += x[0] * x[0] + x[1] * x[1] + x[2] * x[2] + x[3] * x[3];
        }
        if (out) {
          float* orow = out + ((long)b * SEQ + lr) * DM + lane * 16;
#pragma unroll
          for (int i = 0; i < 4; ++i) *(f32x4*)(orow + 4 * i) = xv[i];
        } else {
#pragma unroll
          for (int i = 0; i < 4; ++i) *(f32x4*)(xr + 4 * i) = xv[i];
          ss = wave_sum(ss); const float inv = __builtin_amdgcn_rsqf(ss * (1.f / DM) + EPSN);
          const float* sh = nmod + ((long)bb * 6 + 0) * DM + lane * 16; const float* sc = sh + DM; const float* gp = ng + lane * 16;
          u32x4 p0, p1;
#pragma unroll
          for (int i = 0; i < 4; ++i) { f32x4 g4 = *(const f32x4*)(gp + 4 * i), s4 = *(const f32x4*)(sc + 4 * i), h4 = *(const f32x4*)(sh + 4 * i);
            const float a0 = xv[i][0] * inv * g4[0] * (1.f + s4[0]) + h4[0], a1 = xv[i][1] * inv * g4[1] * (1.f + s4[1]) + h4[1];
            const float a2 = xv[i][2] * inv * g4[2] * (1.f + s4[2]) + h4[2], a3 = xv[i][3] * inv * g4[3] * (1.f + s4[3]) + h4[3];
            if (i < 2) { p0[2 * i] = pack2bf(a0, a1); p0[2 * i + 1] = pack2bf(a2, a3); } else { p1[2 * (i - 2)] = pack2bf(a0, a1); p1[2 * (i - 2) + 1] = pack2bf(a2, a3); } }
          *(u32x4*)(xn_next + row * DM + lane * 16) = p0; *(u32x4*)(xn_next + row * DM + lane * 16 + 8) = p1;
        }
      }
    }
  }
}

#define CS_L 32
#define CS_LDA 72
#define CS_LDS_ 40
#define CS_OFF_KK 0
#define CS_OFF_R  (CS_OFF_KK + 32 * CS_LDA * 2)
#define CS_OFF_K  (CS_OFF_R + 32 * CS_LDA * 2)
#define CS_OFF_B  (CS_OFF_K + 32 * CS_LDA * 2)
#define CS_OFF_S  (CS_OFF_B + 32 * CS_LDA * 2)
#define CS_OFF_VT (CS_OFF_S + 64 * CS_LDA * 2)
#define CS_OFF_UT (CS_OFF_VT + 64 * CS_LDS_ * 2)
#define CS_OFF_KP (CS_OFF_UT + 64 * CS_LDS_ * 2)
#define CS_OFF_BP (CS_OFF_KP + 64 * CS_LDS_ * 2)
#define CS_OFF_A  (CS_OFF_BP + 64 * CS_LDS_ * 2)
#define CS_OFF_P1 (CS_OFF_A + 32 * CS_LDS_ * 2)
#define CS_OFF_P2 (CS_OFF_P1 + 32 * CS_LDS_ * 2)
#define CS_OFF_C  (CS_OFF_P2 + 32 * CS_LDS_ * 2)
#define CS_OFF_G  (CS_OFF_C + 32 * 36 * 4)
#define CS_LDS_BYTES (CS_OFF_G + 5 * 64 * 4)
template <int KS>
__device__ __forceinline__ void cs_mma(const bf16_t* A, int lda, int m0, const bf16_t* Bt, int ldb, int n0, int lane, f32x4& acc) {
  const int fr = lane & 15, fq = lane >> 4;
#pragma unroll
  for (int ks = 0; ks < KS; ++ks) {
    bf16x8 af = *(const bf16x8*)(A + (m0 + fr) * lda + ks * 32 + fq * 8);
    bf16x8 bfr = *(const bf16x8*)(Bt + (n0 + fr) * ldb + ks * 32 + fq * 8);
    acc = __builtin_amdgcn_mfma_f32_16x16x32_bf16(bfr, af, acc, 0, 0, 0);
  }
}
#define CSP_WAVE_BYTES (2 * 32 * CS_LDA * 2 + 32 * 36 * 4)
__device__ __forceinline__ void rw_chunk_inverse(const bf16_t* __restrict__ kk_, const bf16_t* __restrict__ bd_, const float* __restrict__ w_, bf16_t* __restrict__ Mg,
                                                 int job, long dstride, char* smem_wave, int lane) {
  const int c = job % (RB / CS_L), item = job / (RB / CS_L);
  const int dir = item & 1, h = (item >> 1) % 6, b = item / 12;
  const long rowbase = (long)b * RB; const int col0 = h * 64;
  bf16_t* KKs = (bf16_t*)smem_wave; bf16_t* Bs_ = KKs + 32 * CS_LDA; float* Cf = (float*)(smem_wave + 2 * 32 * CS_LDA * 2);
  const int fr = lane & 15, fq = lane >> 4;
  float G = 1.f;
#pragma unroll 8
  for (int tt = 0; tt < 32; ++tt) {
    const long row = rowbase + scan_row(dir, c * CS_L + tt); const long o_ = row * 384 + col0 + lane;
    const float w = w_[dir * dstride + o_], kkv = bf2f(kk_[o_]), bv = bf2f(bd_[dir * dstride + o_]);
    KKs[tt * CS_LDA + lane] = f2bf(kkv * G);
    G *= w;
    Bs_[tt * CS_LDA + lane] = f2bf(bv * __builtin_amdgcn_rcpf(G));
  }
#pragma unroll
  for (int mt = 0; mt < 2; ++mt)
#pragma unroll
    for (int nt = 0; nt < 2; ++nt) {
      f32x4 a = {0.f, 0.f, 0.f, 0.f};
      cs_mma<2>(KKs, CS_LDA, mt * 16, Bs_, CS_LDA, nt * 16, lane, a);
      const int tt = mt * 16 + fr, s0 = nt * 16 + fq * 4;
      f32x4 o4;
#pragma unroll
      for (int e = 0; e < 4; ++e) o4[e] = (s0 + e < tt) ? a[e] : 0.f;
      *(f32x4*)(Cf + tt * 36 + s0) = o4;
    }
  float* Mt = (float*)smem_wave;
  if (lane < 32) {
    for (int tt = 0; tt < 32; ++tt) {
      float acc = (tt == lane) ? 1.f : 0.f;
#pragma unroll 4
      for (int s = 0; s < tt; ++s) acc -= Cf[tt * 36 + s] * Mt[lane * 33 + s];
      Mt[lane * 33 + tt] = acc;
    }
    bf16_t* dst = Mg + (long)job * 1024;
    for (int tt = 0; tt < 32; ++tt) dst[tt * 32 + lane] = f2bf(Mt[lane * 33 + tt]);
  }
}
#define CS_FETCH(c_) do { _Pragma("unroll") for (int e = 0; e < 8; ++e) { \
      const long row_ = rowbase + scan_row(dir, (c_) * CS_L + cq * 8 + e); const long o_ = row_ * 384 + col0 + cj; \
      pw[e] = w_[dir * dstride + o_]; pkk[e] = kk_[o_]; pb[e] = bd_[dir * dstride + o_]; pk[e] = kd_[dir * dstride + o_]; pr[e] = r_[o_]; pv[e] = v_[o_]; } } while (0)
__device__ __forceinline__ void rw_scan_chunked(const bf16_t* __restrict__ r_, const bf16_t* __restrict__ v_, const bf16_t* __restrict__ kk_, const bf16_t* __restrict__ kd_,
                                                const bf16_t* __restrict__ bd_, const float* __restrict__ w_, float* __restrict__ y_, int item, long dstride, char* smem, const bf16_t* __restrict__ Mg) {
  const int t = tid_opaque(), lane = t & 63, wave = t >> 6, fr = lane & 15, fq = lane >> 4;
  const int dir = item & 1, h = (item >> 1) % 6, b = item / 12;
  const long rowbase = (long)b * RB; const int col0 = h * 64;
  bf16_t* KKs = (bf16_t*)(smem + CS_OFF_KK); bf16_t* Rs = (bf16_t*)(smem + CS_OFF_R); bf16_t* Ks_ = (bf16_t*)(smem + CS_OFF_K); bf16_t* Bs_ = (bf16_t*)(smem + CS_OFF_B);
  bf16_t* Ss = (bf16_t*)(smem + CS_OFF_S); bf16_t* Vt = (bf16_t*)(smem + CS_OFF_VT); bf16_t* Ut = (bf16_t*)(smem + CS_OFF_UT);
  bf16_t* KpT = (bf16_t*)(smem + CS_OFF_KP); bf16_t* BpT = (bf16_t*)(smem + CS_OFF_BP);
  bf16_t* As_ = (bf16_t*)(smem + CS_OFF_A); bf16_t* P1s = (bf16_t*)(smem + CS_OFF_P1); bf16_t* P2s = (bf16_t*)(smem + CS_OFF_P2);
  bf16_t* Ms = (bf16_t*)(smem + CS_OFF_C);
  float* Gq = (float*)(smem + CS_OFF_G); float* GL = Gq + 256;
  bf16_t* rhsT = (bf16_t*)(smem + CS_OFF_K);
  const int cj = t & 63, cq = t >> 6;
  __syncthreads();
  for (int i = t; i < 64 * CS_LDA; i += 256) Ss[i] = 0;
  f32x4 Sacc[4];
#pragma unroll
  for (int it = 0; it < 4; ++it) Sacc[it] = (f32x4){0.f, 0.f, 0.f, 0.f};
  float pw[8]; bf16_t pkk[8], pb[8], pk[8], pr[8], pv[8]; uint2 pm;
  const bf16_t* Mitem = Mg + (long)item * (RB / CS_L) * 1024 + t * 4;
  CS_FETCH(0); pm = *(const uint2*)Mitem;
  __builtin_amdgcn_s_setprio(3);
  const int NCH = RB / CS_L;
  for (int c = 0; c < NCH; ++c) {
    float g[8]; float run = 1.f;
#pragma unroll
    for (int e = 0; e < 8; ++e) { run *= pw[e]; g[e] = run; }
    Gq[cq * 64 + cj] = run;
    float kkv[8], bv[8], kv[8], rv[8]; bf16_t vv[8];
#pragma unroll
    for (int e = 0; e < 8; ++e) { kkv[e] = bf2f(pkk[e]); bv[e] = bf2f(pb[e]); kv[e] = bf2f(pk[e]); rv[e] = bf2f(pr[e]); vv[e] = pv[e]; }
    __syncthreads();
    const uint2 pm_cur = pm;
    if (c + 1 < NCH) { CS_FETCH(c + 1); pm = *(const uint2*)(Mitem + (long)(c + 1) * 1024); }
    float base = 1.f, tot = 1.f;
#pragma unroll
    for (int q = 0; q < 4; ++q) { float pq = Gq[q * 64 + cj]; if (q < cq) base *= pq; tot *= pq; }
    if (cq == 0) GL[cj] = tot;
    {
      u32x4 kp4, bp4, vt4;
#pragma unroll
      for (int e = 0; e < 8; ++e) {
        const float G = base * g[e], Gp = e == 0 ? base : base * g[e - 1], iG = __builtin_amdgcn_rcpf(G);
        const int tt = cq * 8 + e;
        KKs[tt * CS_LDA + cj] = f2bf(kkv[e] * Gp); Rs[tt * CS_LDA + cj] = f2bf(rv[e] * G);
        const float kt = kv[e] * iG, bt = bv[e] * iG;
        Ks_[tt * CS_LDA + cj] = f2bf(kt); Bs_[tt * CS_LDA + cj] = f2bf(bt);
        kv[e] = kt * tot; bv[e] = -bt * tot;
      }
#pragma unroll
      for (int e = 0; e < 4; ++e) { kp4[e] = pack2bf(kv[2 * e], kv[2 * e + 1]); bp4[e] = pack2bf(bv[2 * e], bv[2 * e + 1]); vt4[e] = (unsigned)vv[2 * e] | ((unsigned)vv[2 * e + 1] << 16); }
      *(uint2*)(Ms + (t >> 3) * CS_LDS_ + (t & 7) * 4) = pm_cur;
      *(u32x4*)(KpT + cj * CS_LDS_ + cq * 8) = kp4; *(u32x4*)(BpT + cj * CS_LDS_ + cq * 8) = bp4; *(u32x4*)(Vt + cj * CS_LDS_ + cq * 8) = vt4;
    }
    __syncthreads();
    if (wave == 1) {
    } else {
      const bf16_t* X = wave == 0 ? KKs : Rs; const bf16_t* Y = wave == 3 ? Bs_ : Ks_;
#pragma unroll
      for (int mt = 0; mt < 2; ++mt)
#pragma unroll
        for (int nt = 0; nt < 2; ++nt) {
          f32x4 a = {0.f, 0.f, 0.f, 0.f};
          cs_mma<2>(X, CS_LDA, mt * 16, Y, CS_LDA, nt * 16, lane, a);
          const int tt = mt * 16 + fr, s0 = nt * 16 + fq * 4;
          float o[4];
#pragma unroll
          for (int e = 0; e < 4; ++e) { const int s = s0 + e; const bool keep = wave == 0 ? (s < tt) : (s <= tt); o[e] = keep ? a[e] : 0.f; }
          bf16_t* dst = wave == 0 ? As_ : (wave == 2 ? P1s : P2s); const float sg = wave == 3 ? -1.f : 1.f;
          uint2 pk2; pk2.x = pack2bf(sg * o[0], sg * o[1]); pk2.y = pack2bf(sg * o[2], sg * o[3]);
          *(uint2*)(dst + tt * CS_LDS_ + s0) = pk2;
        }
    }
    __syncthreads();
    f32x4 yp[2];
    {
      const bf16x8 sb0 = *(const bf16x8*)(Ss + (wave * 16 + fr) * CS_LDA + fq * 8), sb1 = *(const bf16x8*)(Ss + (wave * 16 + fr) * CS_LDA + 32 + fq * 8);
      const bf16x8 vb = *(const bf16x8*)(Vt + (wave * 16 + fr) * CS_LDS_ + fq * 8);
      bf16x8 ak[2][2], ar[2][2], aa[2], ap[2];
#pragma unroll
      for (int mt = 0; mt < 2; ++mt) {
        ak[mt][0] = *(const bf16x8*)(KKs + (mt * 16 + fr) * CS_LDA + fq * 8); ak[mt][1] = *(const bf16x8*)(KKs + (mt * 16 + fr) * CS_LDA + 32 + fq * 8);
        ar[mt][0] = *(const bf16x8*)(Rs + (mt * 16 + fr) * CS_LDA + fq * 8);  ar[mt][1] = *(const bf16x8*)(Rs + (mt * 16 + fr) * CS_LDA + 32 + fq * 8);
        aa[mt] = *(const bf16x8*)(As_ + (mt * 16 + fr) * CS_LDS_ + fq * 8);   ap[mt] = *(const bf16x8*)(P1s + (mt * 16 + fr) * CS_LDS_ + fq * 8);
      }
#pragma unroll
      for (int mt = 0; mt < 2; ++mt) {
        f32x4 a = {0.f, 0.f, 0.f, 0.f}, y2 = {0.f, 0.f, 0.f, 0.f};
        a = __builtin_amdgcn_mfma_f32_16x16x32_bf16(sb0, ak[mt][0], a, 0, 0, 0);   y2 = __builtin_amdgcn_mfma_f32_16x16x32_bf16(sb0, ar[mt][0], y2, 0, 0, 0);
        a = __builtin_amdgcn_mfma_f32_16x16x32_bf16(sb1, ak[mt][1], a, 0, 0, 0);   y2 = __builtin_amdgcn_mfma_f32_16x16x32_bf16(sb1, ar[mt][1], y2, 0, 0, 0);
        a = __builtin_amdgcn_mfma_f32_16x16x32_bf16(vb, aa[mt], a, 0, 0, 0);       y2 = __builtin_amdgcn_mfma_f32_16x16x32_bf16(vb, ap[mt], y2, 0, 0, 0);
#pragma unroll
        for (int e = 0; e < 4; ++e) rhsT[(wave * 16 + fq * 4 + e) * CS_LDS_ + mt * 16 + fr] = f2bf(a[e]);
        yp[mt] = y2;
      }
    }
    __syncthreads();
#pragma unroll
    for (int nt = 0; nt < 2; ++nt) {
      f32x4 a = {0.f, 0.f, 0.f, 0.f};
      cs_mma<1>(rhsT, CS_LDS_, wave * 16, Ms, CS_LDS_, nt * 16, lane, a);
      uint2 pk2; pk2.x = pack2bf(a[0], a[1]); pk2.y = pack2bf(a[2], a[3]);
      *(uint2*)(Ut + (wave * 16 + fr) * CS_LDS_ + nt * 16 + fq * 4) = pk2;
    }
    __syncthreads();
    {
      const bf16x8 ub_ = *(const bf16x8*)(Ut + (wave * 16 + fr) * CS_LDS_ + fq * 8);
      const bf16x8 kpb = *(const bf16x8*)(KpT + (wave * 16 + fr) * CS_LDS_ + fq * 8), bpb = *(const bf16x8*)(BpT + (wave * 16 + fr) * CS_LDS_ + fq * 8);
      bf16x8 p2a[2], va[4], ua[4];
#pragma unroll
      for (int mt = 0; mt < 2; ++mt) p2a[mt] = *(const bf16x8*)(P2s + (mt * 16 + fr) * CS_LDS_ + fq * 8);
#pragma unroll
      for (int it = 0; it < 4; ++it) { va[it] = *(const bf16x8*)(Vt + (it * 16 + fr) * CS_LDS_ + fq * 8); ua[it] = *(const bf16x8*)(Ut + (it * 16 + fr) * CS_LDS_ + fq * 8); }
      const f32x4 gl = *(const f32x4*)(GL + wave * 16 + fq * 4);
#pragma unroll
      for (int mt = 0; mt < 2; ++mt) {
        yp[mt] = __builtin_amdgcn_mfma_f32_16x16x32_bf16(ub_, p2a[mt], yp[mt], 0, 0, 0);
        const long row = rowbase + scan_row(dir, c * CS_L + mt * 16 + fr);
        *(f32x4*)(y_ + dir * dstride + row * 384 + col0 + wave * 16 + fq * 4) = yp[mt];
      }
#pragma unroll
      for (int it = 0; it < 4; ++it) {
        f32x4 a = Sacc[it]; a[0] *= gl[0]; a[1] *= gl[1]; a[2] *= gl[2]; a[3] *= gl[3];
        a = __builtin_amdgcn_mfma_f32_16x16x32_bf16(kpb, va[it], a, 0, 0, 0);
        a = __builtin_amdgcn_mfma_f32_16x16x32_bf16(bpb, ua[it], a, 0, 0, 0);
        Sacc[it] = a;
      }
    }
    __syncthreads();
#pragma unroll
    for (int it = 0; it < 4; ++it) { uint2 pk2; pk2.x = pack2bf(Sacc[it][0], Sacc[it][1]); pk2.y = pack2bf(Sacc[it][2], Sacc[it][3]); *(uint2*)(Ss + (it * 16 + fr) * CS_LDA + wave * 16 + fq * 4) = pk2; }
  }
  __builtin_amdgcn_s_setprio(0);
  __syncthreads();
}
#include <hip/hip_cooperative_groups.h>
namespace cg = cooperative_groups;

#define XB_TMO      128
#define XB_XCNT(j)  (256  + 64 * (j))
#define XB_XSUB(j)  (1280 + 64 * (j))
#define XB_XGEN(j)  (2304 + 64 * (j))
#define XB_TOP      3328
#define XB_TOPGEN   3392
#define XB_QUEUE(i) (3456 + 64 * (i))
#define XCD_BAR_WORDS 4096
#define XB_SPIN_CAP (1u << 22)
#define LAS __attribute__((address_space(3)))
__device__ __forceinline__ unsigned xb_ld(unsigned* p)              { return __hip_atomic_load(p, __ATOMIC_RELAXED, __HIP_MEMORY_SCOPE_AGENT); }
__device__ __forceinline__ unsigned xb_add(unsigned* p, unsigned v) { return __hip_atomic_fetch_add(p, v, __ATOMIC_RELAXED, __HIP_MEMORY_SCOPE_AGENT); }
__device__ __forceinline__ unsigned xb_xcc_id() { return (unsigned)__builtin_amdgcn_s_getreg((3 << 11) | 20) & 0xFu; }
#define XB_SPIN(cond, bar) do { unsigned _sp = 0; while (cond) { __builtin_amdgcn_s_sleep(1); \
    if ((++_sp & 255u) == 0u) { if (xb_ld(&(bar)[XB_TMO])) break; if (_sp > XB_SPIN_CAP) { atomicAdd(&(bar)[XB_TMO], 1u); break; } } } } while (0)
struct XcdBarrier { unsigned* bar; unsigned x; volatile LAS unsigned* st; };
__device__ __forceinline__ XcdBarrier xcd_barrier_post(unsigned* bar, volatile LAS unsigned* st) {
  XcdBarrier b; b.bar = bar; b.x = xb_xcc_id(); b.st = st;
  if (threadIdx.x == 0) (void)xb_add(&bar[XB_XCNT(b.x)], 1u);
  return b;
}
__device__ __forceinline__ void xcd_barrier_complete(unsigned* bar, unsigned x, unsigned& nloc, unsigned& nx) {
  const unsigned G = gridDim.x; unsigned sum, cnt, mine, sp = 0u;
  for (;;) {
    sum = 0u; cnt = 0u; mine = 0u;
#pragma unroll
    for (unsigned j = 0; j < 16; ++j) { const unsigned c = xb_ld(&bar[XB_XCNT(j)]); sum += c; cnt += (c > 0u) ? 1u : 0u; mine = (j == x) ? c : mine; }
    if (sum == G) break;
    __builtin_amdgcn_s_sleep(1);
    if ((++sp & 255u) == 0u) { if (xb_ld(&bar[XB_TMO])) break; if (sp > XB_SPIN_CAP) { atomicAdd(&bar[XB_TMO], 1u); break; } }
  }
  nloc = mine > 0u ? mine : 1u; nx = cnt > 0u ? cnt : 1u;
}
__device__ __forceinline__ void xcd_barrier(const XcdBarrier& b) {
  asm volatile("s_waitcnt vmcnt(0)" ::: "memory");
  __syncthreads();
  if (threadIdx.x == 0) {
    unsigned* bar = b.bar;
    __builtin_amdgcn_s_waitcnt(0);
    unsigned nloc = b.st[0], nx = b.st[1];
    if (nloc == 0u) { xcd_barrier_complete(bar, b.x, nloc, nx); b.st[0] = nloc; b.st[1] = nx; }
    const unsigned old = xb_add(&bar[XB_XSUB(b.x)], 1u);
    const unsigned gen = old / nloc;
    if (old + 1u == (gen + 1u) * nloc) {
      __builtin_amdgcn_fence(__ATOMIC_RELEASE, "agent");
      asm volatile("s_waitcnt vmcnt(0)" ::: "memory");
      const unsigned og = xb_add(&bar[XB_TOP], 1u);
      const unsigned tg = og / nx;
      if (og + 1u == (tg + 1u) * nx) xb_add(&bar[XB_TOPGEN], 1u);
      else XB_SPIN(xb_ld(&bar[XB_TOPGEN]) == tg, bar);
      __builtin_amdgcn_fence(__ATOMIC_ACQUIRE, "agent");
      xb_add(&bar[XB_XGEN(b.x)], 1u);
      asm volatile("s_waitcnt vmcnt(0)" ::: "memory");
    } else {
      XB_SPIN(xb_ld(&bar[XB_XGEN(b.x)]) == gen, bar);
      __builtin_amdgcn_fence(__ATOMIC_ACQUIRE, "agent");
      asm volatile("s_waitcnt vmcnt(0)" ::: "memory");
    }
  }
  __syncthreads();
}


constexpr size_t al256(size_t x) { return (x + 255) & ~(size_t)255; }
struct WsOff { size_t xs, mod, xn, Pb, tq, tkv, a_b, g_b, w_f, mq, mk, mvT, gq, gk, gvT, r_b, v_b, kk_b, kd_b, bd_b, w_inT, w_outT, wqT, keysb, wqbT, wkvbT, w2T, a2T, g2T, rope_g, rope_m, total; };
constexpr WsOff make_wsoff() {
  WsOff o{}; size_t p = 32768; const size_t MA = NROWS;
  o.mod = p; p += al256(2 * (BATCH + 1) * 6144 * 4); o.xs = p; p += al256(MA * DM * 4); o.xn = p; p += al256(MA * DM * 2);
  o.Pb = p; p += al256(MA * IN_COLS * 2);
  o.tq = p; p += al256(MA * 384 * 2); o.tkv = p; p += al256(MA * 512 * 2); o.a_b = p; p += al256(2 * MA * 384 * 2);
  o.g_b = p; p += al256(MA * 384 * 2); o.w_f = p; p += al256(2 * MA * 384 * 4);
  o.mq = p; p += al256(MA * 384 * 2); o.mk = p; p += al256(MA * 384 * 2); o.mvT = p; p += al256((size_t)BATCH * 4 * 64 * RB * 2);
  o.gq = p; p += al256(MA * 384 * 2); o.gk = p; p += al256(MA * 128 * 2); o.gvT = p; p += al256((size_t)BATCH * 2 * 64 * RB * 2);
  o.r_b = p; p += al256(MA * 384 * 2); o.v_b = p; p += al256(MA * 384 * 2); o.kk_b = p; p += al256(MA * 384 * 2);
  o.kd_b = p; p += al256(2 * MA * 384 * 2); o.bd_b = p; p += al256(2 * MA * 384 * 2);
  o.w_inT = p; p += al256((size_t)2 * 2688 * 1024 * 2); o.w_outT = p; p += al256((size_t)2 * 1024 * 1024 * 2); o.wqT = p; p += al256((size_t)2 * 2048 * 1024 * 2);
  o.keysb = p; p += al256((size_t)2 * 16 * 128 * 128 * 2); o.wqbT = p; p += al256((size_t)2 * 384 * 256 * 2); o.wkvbT = p; p += al256((size_t)2 * 512 * 128 * 2);
  o.w2T = p; p += al256((size_t)2 * 2 * 384 * 64 * 2); o.a2T = p; p += al256((size_t)2 * 2 * 384 * 64 * 2); o.g2T = p; p += al256((size_t)2 * 384 * 192 * 2);
  o.rope_g = p; p += al256((size_t)SEQ * 64 * 4); o.rope_m = p; p += al256((size_t)SEQ * 32 * 4);
  o.total = p; return o;
}
constexpr WsOff WO = make_wsoff();
#define WS_PTR(T, off) ((T*)(ws + (off)))
#define MINV_OFF (WO.tq + (size_t)40 * 1024 * 1024)
#define TAB_OFF (WO.Pb + ((size_t)2 * NROWS * 384 * 4 + 1048576 & ~(size_t)255))
#define TAB_U (TAB_OFF)
#define TAB_V (TAB_OFF + (size_t)16384 * 1024)
#define TAB_SU (TAB_OFF + (size_t)2 * 16384 * 1024)
#define TAB_SV (TAB_OFF + (size_t)2 * 16384 * 1024 + 65536)
#define LAUNDER_S(x) asm volatile("" : "+s"(x))
#define KARG_AS __attribute__((address_space(4)))
#define KP_DECL const KARG_AS MegaP* kp_ = (const KARG_AS MegaP*)__builtin_amdgcn_kernarg_segment_ptr(); LAUNDER_S(kp_)

struct NaiveIn {
  const float *x, *c, *ctx, *c_ctx, *ada_w, *ada_b, *norm_mix_g, *norm_ffn_g, *w_in, *w_out, *mla_q_norm_g, *mla_w_qb, *mla_kv_norm_g,
      *mla_w_kvb, *mla_qk_g, *rw_mu, *rw_w0, *rw_w2, *rw_a0, *rw_a2, *rw_g2, *rw_k_k, *rw_k_a, *rw_r_k, *rw_ln_g, *rw_ln_b, *gqa_qk_g,
      *pe_wq, *pe_keys, *pe_u, *pe_v;
};
struct MegaP { NaiveIn in; char* ws; float* out; };

#ifndef MEGA_CG
#define MEGA_CG 0
#endif
#if MEGA_CG
#define GRID_BARRIER() cg::this_grid().sync()
#else
#ifdef BAR_TWICE
#define GRID_BARRIER() do { GRID_BARRIER1(); GRID_BARRIER1(); } while (0)
#else
#define GRID_BARRIER() GRID_BARRIER1()
#endif
#define GRID_BARRIER1() do { XcdBarrier xb_; xb_.bar = (unsigned*)((const KARG_AS MegaP*)__builtin_amdgcn_kernarg_segment_ptr())->ws; xb_.x = xb_xcc_id(); xb_.st = (volatile LAS unsigned*)&xb_words; xcd_barrier(xb_); } while (0)
#endif
#define MEGA_LDS_BYTES 65536
#ifndef PHASE_MASK
#define PHASE_MASK 0xFFFF
#endif
#define PH(k) if (PHASE_MASK & (1 << (k)))
#define LAT_TM(i) (((i) >> 4) * 18 + ((i) & 15))
#define XCD_TILE_LOOP(tile, T) for (int xt_base_ = (int)(((long)(T) * (blockIdx.x & 7)) >> 3), xt_cnt_ = (int)(((long)(T) * ((blockIdx.x & 7) + 1)) >> 3) - xt_base_, xt_q_ = blockIdx.x >> 3, tile = xt_base_ + xt_q_; xt_q_ < xt_cnt_; xt_q_ += gridDim.x >> 3, tile = xt_base_ + xt_q_)
#ifndef DIL_PH
#define DIL_PH -1
#endif
#ifndef DIL_MULT
#define DIL_MULT 4
#endif
#define DIL_BEGIN(k) unsigned long long dil_t0 = 0; if (DIL_PH == (k)) dil_t0 = __builtin_amdgcn_s_memrealtime();
#define DIL_END(k) if (DIL_PH == (k)) { GRID_BARRIER(); if (blockIdx.x == 0 && threadIdx.x == 0) { unsigned long long t1 = __builtin_amdgcn_s_memrealtime(); unsigned long long dt = (t1 - dil_t0) * DIL_MULT; \
    while (__builtin_amdgcn_s_memrealtime() - t1 < dt) __builtin_amdgcn_s_sleep(32); } }

__device__ __forceinline__ void ph_norm_mod(const float* xs, const float* g, const float* modl, int shift_idx, bf16_t* xn, bool skip_ctx = false, const float* x_in = nullptr, const float* ctx_in = nullptr) {
  const int tt_ = tid_opaque(); const int lane = tt_ & 63;
  for (long row = blockIdx.x * 4 + (tt_ >> 6); row < NROWS; row += (long)gridDim.x * 4) {
    int b = row / RB, lr = row % RB; int bb = lr < SEQ ? b : BATCH;
    if (skip_ctx && lr >= SEQ) continue;
    const float* sh = modl + ((long)bb * 6 + shift_idx) * DM; const float* sc = sh + DM;
    const float* xr = x_in ? (lr < SEQ ? x_in + ((long)b * SEQ + lr) * DM : ctx_in + ((long)b * CTX_LEN + (lr - SEQ)) * DM) : xs + row * DM; f32x4 v[4]; float ss = 0.f;
#pragma unroll
    for (int i = 0; i < 4; ++i) { v[i] = *(const f32x4*)(xr + i * 256 + lane * 4); ss += v[i][0]*v[i][0] + v[i][1]*v[i][1] + v[i][2]*v[i][2] + v[i][3]*v[i][3]; }
    ss = wave_sum(ss);
    float inv = __builtin_amdgcn_rsqf(ss / DM + EPSN);
#pragma unroll
    for (int i = 0; i < 4; ++i) {
      int d = i * 256 + lane * 4; float o[4];
#pragma unroll
      for (int e = 0; e < 4; ++e) o[e] = v[i][e] * inv * g[d+e] * (1.f + sc[d+e]) + sh[d+e];
      uint2 pk; pk.x = pack2bf(o[0], o[1]); pk.y = pack2bf(o[2], o[3]);
      *(uint2*)(xn + row * DM + d) = pk;
    }
  }
}
__device__ __forceinline__ void ph_cvt_wT(const float* W, const float* g, bf16_t* Wt, int K, int N, int Npad, int Kpad) {
  const long n_el = (long)Npad * Kpad;
  const int tt_ = tid_opaque();
  for (long i = (long)blockIdx.x * 256 + tt_; i < n_el; i += (long)gridDim.x * 256) {
    int k = i % Kpad; int n = i / Kpad;
    Wt[i] = (k < K && n < N) ? f2bf(W[(long)k * N + n] * (g ? g[k] : 1.f)) : (bf16_t)0;
  }
}
__device__ __forceinline__ void ph_cvt_bf16(const float* s, bf16_t* d, long n8) {
  const int tt_ = tid_opaque();
  for (long i = (long)blockIdx.x * 256 + tt_; i < n8; i += (long)gridDim.x * 256) {
    f32x4 a = *(const f32x4*)(s + i * 8), b = *(const f32x4*)(s + i * 8 + 4);
    u32x4 o; o[0] = pack2bf(a[0], a[1]); o[1] = pack2bf(a[2], a[3]); o[2] = pack2bf(b[0], b[1]); o[3] = pack2bf(b[2], b[3]);
    *(u32x4*)(d + i * 8) = o;
  }
}


__device__ __forceinline__ void ph_cvt_wT_tiled(const float* __restrict__ W, const float* __restrict__ g, bf16_t* __restrict__ Wt, int K, int N, int Npad, int Kpad, char* smem) {
  const int t = tid_opaque(); float* s = (float*)smem;
  const int tk = Kpad / 64, tn = Npad / 64;
  for (int tile = blockIdx.x; tile < tk * tn; tile += gridDim.x) {
    const int k0 = (tile % tk) * 64, n0 = (tile / tk) * 64;
    __syncthreads();
#pragma unroll
    for (int i = 0; i < 4; ++i) {
      int kk = (t >> 4) + 16 * i, nn = (t & 15) * 4; int k = k0 + kk;
      f32x4 v = {0.f, 0.f, 0.f, 0.f};
      if (k < K) {
        const float* src = W + (long)k * N + n0 + nn; float gs = g ? g[k] : 1.f;
        if (n0 + nn + 3 < N) v = *(const f32x4*)src; else { for (int e = 0; e < 4; ++e) if (n0 + nn + e < N) v[e] = src[e]; }
        v *= gs;
      }
#pragma unroll
      for (int e = 0; e < 4; ++e) s[kk * 65 + nn + e] = v[e];
    }
    __syncthreads();
    {
      int nn = t >> 2, kq = (t & 3) * 16; u32x4 o0, o1;
#pragma unroll
      for (int e = 0; e < 4; ++e) { o0[e] = pack2bf(s[(kq + 2*e) * 65 + nn], s[(kq + 2*e + 1) * 65 + nn]); o1[e] = pack2bf(s[(kq + 8 + 2*e) * 65 + nn], s[(kq + 8 + 2*e + 1) * 65 + nn]); }
      bf16_t* dst = Wt + (long)(n0 + nn) * Kpad + k0 + kq;
      *(u32x4*)dst = o0; *(u32x4*)(dst + 8) = o1;
    }
  }
}
__device__ __forceinline__ void ph_mod_gemv(const float* __restrict__ c, const float* __restrict__ c_ctx, const float* __restrict__ ada_w, const float* __restrict__ ada_b, float* __restrict__ mod, char* smem) {
  const int t = tid_opaque(); float* s = (float*)smem;
  if ((int)blockIdx.x >= 2 * 96) return;
  for (int i = t; i < 9 * 1024; i += 256) { int bb = i >> 10, k = i & 1023; float v = bb < BATCH ? c[bb * DM + k] : c_ctx[k]; s[i] = v * __builtin_amdgcn_rcpf(1.f + __builtin_amdgcn_exp2f(-v * 1.4426950408889634f)); }
  __syncthreads();
  float* part = s + 9 * 1024;
  for (int item = blockIdx.x; item < 2 * 96; item += gridDim.x) {
    const int cb = item % 96, l = item / 96; const int kq = t >> 6, col = t & 63;
    const int j = cb * 64 + col; const float* wp = ada_w + ((long)l * DM + kq * 256) * 6144 + j;
    float acc[9];
#pragma unroll
    for (int bb = 0; bb < 9; ++bb) acc[bb] = 0.f;
#pragma unroll 16
    for (int k = 0; k < 256; ++k) { float w = wp[(long)k * 6144];
#pragma unroll
      for (int bb = 0; bb < 9; ++bb) acc[bb] += s[bb * 1024 + kq * 256 + k] * w; }
#pragma unroll
    for (int bb = 0; bb < 9; ++bb) part[(kq * 9 + bb) * 64 + col] = acc[bb];
    __syncthreads();
    for (int i = t; i < 9 * 64; i += 256) { int bb = i >> 6, cc = i & 63;
      float v = ((part[(0 * 9 + bb) * 64 + cc] + part[(1 * 9 + bb) * 64 + cc]) + part[(2 * 9 + bb) * 64 + cc]) + part[(3 * 9 + bb) * 64 + cc];
      mod[((long)l * (BATCH + 1) + bb) * 6144 + cb * 64 + cc] = v + ada_b[l * 6144 + cb * 64 + cc]; }
    __syncthreads();
  }
}

__global__ void __launch_bounds__(256, 2) mega_kernel(MegaP p) {
  __shared__ __attribute__((aligned(16))) char smem[MEGA_LDS_BYTES];
  __shared__ uint4 xb_words;
  const int t0 = threadIdx.x;
#if !MEGA_CG
  if (t0 == 0) xb_words = make_uint4(0u, 0u, 0u, 0u);
  __syncthreads();
  (void)xcd_barrier_post((unsigned*)p.ws, (volatile LAS unsigned*)&xb_words);
#endif
  const long MA = NROWS; const int TM = NROWS / 128;
#define I (kp_->in)
  const int scan_role = (int)blockIdx.x < BATCH * 12 ? 1 : 0;
  { DIL_BEGIN(0)
  PH(0) {
    KP_DECL; char* ws = kp_->ws; const int t = tid_opaque();
    float* xs = WS_PTR(float, WO.xs); float* mod = WS_PTR(float, WO.mod);
    ph_mod_gemv(I.c, I.c_ctx, I.ada_w, I.ada_b, mod, smem);
    for (int l = 0; l < 2; ++l) {
      ph_cvt_wT_tiled(I.w_in + (long)l * DM * IN_COLS, nullptr, WS_PTR(bf16_t, WO.w_inT) + (long)l * 2688 * 1024, 1024, IN_COLS, 2688, 1024, smem);
      ph_cvt_wT_tiled(I.w_out + (long)l * DM * DM, nullptr, WS_PTR(bf16_t, WO.w_outT) + (long)l * 1024 * 1024, 1024, 1024, 1024, 1024, smem);
      ph_cvt_wT_tiled(I.pe_wq + (long)l * DM * 2048, nullptr, WS_PTR(bf16_t, WO.wqT) + (long)l * 2048 * 1024, 1024, 2048, 2048, 1024, smem);
      ph_cvt_wT_tiled(I.mla_w_qb + (long)l * 256 * 384, I.mla_q_norm_g + l * 256, WS_PTR(bf16_t, WO.wqbT) + (long)l * 384 * 256, 256, 384, 384, 256, smem);
      ph_cvt_wT_tiled(I.mla_w_kvb + (long)l * 128 * 512, I.mla_kv_norm_g + l * 128, WS_PTR(bf16_t, WO.wkvbT) + (long)l * 512 * 128, 128, 512, 512, 128, smem);
      for (int d = 0; d < 2; ++d) {
        ph_cvt_wT_tiled(I.rw_w2 + ((long)l * 2 + d) * 64 * 384, nullptr, WS_PTR(bf16_t, WO.w2T) + ((long)l * 2 + d) * 384 * 64, 64, 384, 384, 64, smem);
        ph_cvt_wT_tiled(I.rw_a2 + ((long)l * 2 + d) * 64 * 384, nullptr, WS_PTR(bf16_t, WO.a2T) + ((long)l * 2 + d) * 384 * 64, 64, 384, 384, 64, smem);
      }
      ph_cvt_wT_tiled(I.rw_g2 + (long)l * 160 * 384, nullptr, WS_PTR(bf16_t, WO.g2T) + (long)l * 384 * 192, 160, 384, 384, 192, smem);
    }
    ph_cvt_bf16(I.pe_keys, WS_PTR(bf16_t, WO.keysb), 2L * 16 * 128 * 128 / 8);
    ph_rope_tables(WS_PTR(float, WO.rope_g), WS_PTR(float, WO.rope_m));
  }
  DIL_END(0) }
  GRID_BARRIER();
  for (int lq = 0; lq < 2; ++lq) {
    int l = lq; LAUNDER_S(l);
    { DIL_BEGIN(1)
    PH(1) if (l == 0) {
      KP_DECL; char* ws = kp_->ws; const int t = tid_opaque(); (void)t;
      ph_norm_mod(WS_PTR(float, WO.xs), I.norm_mix_g + l * DM, WS_PTR(float, WO.mod) + (long)l * (BATCH + 1) * 6144, 0, WS_PTR(bf16_t, WO.xn), false, I.x, I.ctx);
    }
    DIL_END(1) }
    GRID_BARRIER();
    { DIL_BEGIN(2)
    PH(2) {
      KP_DECL; char* ws = kp_->ws; const int t = tid_opaque(); (void)t;
      const bf16_t* xn = WS_PTR(bf16_t, WO.xn); const bf16_t* wT = WS_PTR(bf16_t, WO.w_inT) + (long)l * 2688 * 1024; bf16_t* Pb = WS_PTR(bf16_t, WO.Pb);
      XCD_TILE_LOOP(tile, TM * 21)
        gemm_tile_128_glds(xn, DM, wT, 1024, 1024, tile / 21, tile % 21, smem, EpiStoreBf16{Pb, IN_COLS, IN_COLS});
    }
    DIL_END(2) }
    GRID_BARRIER();
    { DIL_BEGIN(3)
    PH(3) {
      KP_DECL; char* ws = kp_->ws; const int t = tid_opaque(); (void)t;
      PrepW pw{WS_PTR(bf16_t, WO.wqbT) + (long)l * 384 * 256, WS_PTR(bf16_t, WO.wkvbT) + (long)l * 512 * 128, WS_PTR(bf16_t, WO.w2T) + (long)l * 2 * 384 * 64,
               WS_PTR(bf16_t, WO.a2T) + (long)l * 2 * 384 * 64, WS_PTR(bf16_t, WO.g2T) + (long)l * 384 * 192, I.rw_mu + (long)l * 2 * RWC, I.rw_w0 + l * 768, I.rw_a0 + l * 768};
      PrepBuf pb{WS_PTR(bf16_t, WO.Pb), WS_PTR(bf16_t, WO.tq), WS_PTR(bf16_t, WO.tkv), WS_PTR(bf16_t, WO.a_b), WS_PTR(bf16_t, WO.g_b), WS_PTR(float, WO.w_f)};
      XCD_TILE_LOOP(tile, TM * 22) prep_gemm_tile(pw, pb, tile / 22, tile % 22, smem);
    }
    DIL_END(3) }
    GRID_BARRIER();
    { DIL_BEGIN(4)
    PH(4) {
      KP_DECL; char* ws = kp_->ws; const int t = tid_opaque(); (void)t;
      FinW2 fw{I.mla_qk_g + l * 192, I.gqa_qk_g + l * 128, I.rw_mu + (long)l * 2 * RWC, I.rw_k_k + l * 384, I.rw_k_a + l * 384, WS_PTR(float, WO.rope_g), WS_PTR(float, WO.rope_m)};
      FinBuf fb{WS_PTR(bf16_t, WO.Pb), WS_PTR(bf16_t, WO.tq), WS_PTR(bf16_t, WO.tkv), WS_PTR(bf16_t, WO.a_b), WS_PTR(bf16_t, WO.mq), WS_PTR(bf16_t, WO.mk), WS_PTR(bf16_t, WO.mvT),
                WS_PTR(bf16_t, WO.gq), WS_PTR(bf16_t, WO.gk), WS_PTR(bf16_t, WO.gvT), WS_PTR(bf16_t, WO.r_b), WS_PTR(bf16_t, WO.v_b), WS_PTR(bf16_t, WO.kk_b), WS_PTR(bf16_t, WO.kd_b), WS_PTR(bf16_t, WO.bd_b)};
      for (int tile = blockIdx.x; tile < NROWS / 8; tile += gridDim.x) prep_finish_tile2(fw, fb, tile, smem);
      if (blockIdx.x == gridDim.x - 1 && t < 64) { attn_score_bound(I.mla_qk_g + l * 192, 96, 9.79795897f, (float*)(ws + 16384) + l * 4, t); attn_score_bound(I.gqa_qk_g + l * 128, 64, 8.f, (float*)(ws + 16384) + l * 4 + 1, t); }
    }
    DIL_END(4) }
    GRID_BARRIER();
    { unsigned long long dil_t0 = 0, dil_scan = 0; if (DIL_PH == 5 || DIL_PH == 11) dil_t0 = __builtin_amdgcn_s_memrealtime();
    PH(5) {
      {
        KP_DECL; char* ws = kp_->ws; const int tp = tid_opaque();
        const int njobs = BATCH * 12 * (RB / CS_L);
        for (int job = (int)blockIdx.x * 4 + (tp >> 6); job < njobs; job += (int)gridDim.x * 4)
          rw_chunk_inverse(WS_PTR(bf16_t, WO.kk_b), WS_PTR(bf16_t, WO.bd_b), WS_PTR(float, WO.w_f), WS_PTR(bf16_t, MINV_OFF), job, (long)MA * 384, smem + (tp >> 6) * CSP_WAVE_BYTES, tp & 63);
      }
      GRID_BARRIER();
      KP_DECL; char* ws = kp_->ws; const int t = tid_opaque(); (void)t;
      int* s_item = (int*)(smem + MEGA_LDS_BYTES - 16);
      unsigned* sctr = (unsigned*)ws + XB_QUEUE(4 + l);
      auto scan_loop = [&]() __attribute__((always_inline)) {
        for (;;) {
          __syncthreads();
          if (tid_opaque() == 0) *s_item = (int)xb_add(sctr, 1u);
          __syncthreads();
          const int it = *s_item;
          if (it >= BATCH * 12) break;
          rw_scan_chunked(WS_PTR(bf16_t, WO.r_b), WS_PTR(bf16_t, WO.v_b), WS_PTR(bf16_t, WO.kk_b), WS_PTR(bf16_t, WO.kd_b), WS_PTR(bf16_t, WO.bd_b), WS_PTR(float, WO.w_f), WS_PTR(float, WO.Pb),
                          it, (long)MA * 384, smem, WS_PTR(bf16_t, MINV_OFF));
        }
      };
      if (scan_role) scan_loop();
#if DIL_PH == 11
      dil_scan = __builtin_amdgcn_s_memrealtime() - dil_t0;
#endif
#ifdef SPLIT5
      GRID_BARRIER();
#endif
      const int nqt = l == 0 ? 18 : 16; const int n_mla = BATCH * 4 * nqt, n_all = BATCH * 10 * nqt;
      unsigned* qctr = (unsigned*)ws + XB_QUEUE(l);
      for (;;) {
        __syncthreads();
        if (tid_opaque() == 0) *s_item = (int)xb_add(qctr, 1u);
        __syncthreads();
        const int it = *s_item;
        if (it >= n_all) break;
        const KARG_AS MegaP* kp2_ = (const KARG_AS MegaP*)__builtin_amdgcn_kernarg_segment_ptr(); LAUNDER_S(kp2_); char* ws2 = kp2_->ws;
        if (it < n_mla) { int qt = it / (BATCH * 4), r = it % (BATCH * 4);
          attn_block<96>((const bf16_t*)(ws2 + WO.mq), 4, (const bf16_t*)(ws2 + WO.mk), 4, (const bf16_t*)(ws2 + WO.mvT), 1, (bf16_t*)(ws2 + WO.tq), 0, r / 4, r % 4, qt, smem, (const float*)(ws2 + 16384) + l * 4); }
        else { int v = it - n_mla; int qt = v / (BATCH * 6), r = v % (BATCH * 6);
          attn_block<64>((const bf16_t*)(ws2 + WO.gq), 6, (const bf16_t*)(ws2 + WO.gk), 2, (const bf16_t*)(ws2 + WO.gvT), 3, (bf16_t*)(ws2 + WO.tq), 640, r / 6, r % 6, qt, smem, (const float*)(ws2 + 16384) + l * 4 + 1); }
      }
      if (!scan_role) scan_loop();
      {
        unsigned* cctr = (unsigned*)ws + XB_QUEUE(2 + l);
        for (;;) {
          __syncthreads();
          if (tid_opaque() == 0) *s_item = (int)xb_add(cctr, 1u);
          __syncthreads();
          const int it = *s_item;
          if (it >= 512) break;
          const int tab = it >> 8, r0 = (it & 255) * 64;
          if (tab == 0) ph_cvt_fp8_rows(I.pe_u + (long)l * 16384 * DM, WS_PTR(unsigned char, TAB_U), WS_PTR(float, TAB_SU), r0, r0 + 64);
          else ph_cvt_fp8_rows(I.pe_v + (long)l * 16384 * DM, WS_PTR(unsigned char, TAB_V), WS_PTR(float, TAB_SV), r0, r0 + 64);
        }
      }
    }
#if DIL_PH == 11
    GRID_BARRIER(); if (blockIdx.x == 0 && threadIdx.x == 0) { unsigned long long t1 = __builtin_amdgcn_s_memrealtime(); unsigned long long dt = dil_scan * DIL_MULT; while (__builtin_amdgcn_s_memrealtime() - t1 < dt) __builtin_amdgcn_s_sleep(32); }
#endif
    (void)dil_scan;
    DIL_END(5) }
    GRID_BARRIER();
    { DIL_BEGIN(6)
    PH(6) {
      KP_DECL; char* ws = kp_->ws; const int t = tid_opaque(); (void)t;
      RdW rw{I.rw_r_k + l * 384, I.rw_ln_g + l * 384, I.rw_ln_b + l * 384};
      for (long row = blockIdx.x * 4 + (t >> 6); row < NROWS; row += (long)gridDim.x * 4)
        if (l == 0 || (row % RB) < SEQ) rw_readout_row2(rw, WS_PTR(float, WO.Pb), WS_PTR(bf16_t, WO.r_b), WS_PTR(bf16_t, WO.v_b), WS_PTR(bf16_t, WO.kd_b), WS_PTR(bf16_t, WO.g_b), WS_PTR(bf16_t, WO.tq), row, t & 63);
    }
    DIL_END(6) }
    GRID_BARRIER();
    { DIL_BEGIN(7)
    PH(7) {
      KP_DECL; char* ws = kp_->ws; const int t = tid_opaque(); (void)t;
      const bf16_t* mix = WS_PTR(bf16_t, WO.tq); const bf16_t* wT = WS_PTR(bf16_t, WO.w_outT) + (long)l * 1024 * 1024; float* xs = WS_PTR(float, WO.xs);
      const float* modl = WS_PTR(float, WO.mod) + (long)l * (BATCH + 1) * 6144;
      const int TM7 = l == 0 ? TM : BATCH * 16;
      XCD_TILE_LOOP(tile, TM7 * 8)
        gemm_tile_128_glds(mix, DM, wT, 1024, 1024, l == 0 ? tile / 8 : LAT_TM(tile / 8), tile % 8, smem, EpiResid{xs, modl, 2, 0, l == 0 ? I.x : (const float*)nullptr, I.ctx});
    }
    DIL_END(7) }
    GRID_BARRIER();
    { DIL_BEGIN(8)
    PH(8) {
      KP_DECL; char* ws = kp_->ws; const int t = tid_opaque(); (void)t;
      ph_norm_mod(WS_PTR(float, WO.xs), I.norm_ffn_g + l * DM, WS_PTR(float, WO.mod) + (long)l * (BATCH + 1) * 6144, 3, WS_PTR(bf16_t, WO.xn), l != 0);
    }
    DIL_END(8) }
    GRID_BARRIER();
    { DIL_BEGIN(9)
    PH(9) {
      KP_DECL; char* ws = kp_->ws; const int t = tid_opaque(); (void)t;
      const bf16_t* xn = WS_PTR(bf16_t, WO.xn); const bf16_t* wT = WS_PTR(bf16_t, WO.wqT) + (long)l * 2048 * 1024; const bf16_t* kb = WS_PTR(bf16_t, WO.keysb) + (long)l * 16 * 128 * 128;
      unsigned* top1 = WS_PTR(unsigned, WO.tq);
      const int TM9 = l == 0 ? TM : BATCH * 16;
      XCD_TILE_LOOP(tile, TM9 * 16) { peer_q_top1_tile(xn, wT, kb, top1, l == 0 ? tile / 16 : LAT_TM(tile / 16), tile % 16, smem); __syncthreads(); }
    }
    DIL_END(9) }
    GRID_BARRIER();
    { DIL_BEGIN(10)
    PH(10) {
      KP_DECL; char* ws = kp_->ws; const int t = tid_opaque(); (void)t;
      const float* modl = WS_PTR(float, WO.mod) + (long)l * (BATCH + 1) * 6144;
      const int ntok10 = l == 0 ? NROWS : BATCH * SEQ;
      peer_lists_build3(WS_PTR(unsigned, WO.tq), WS_PTR(float, TAB_SU), WS_PTR(float, TAB_SV), WS_PTR(char, WO.mq), ntok10, smem);
#ifdef BUILD_TWICE
      peer_lists_build3(WS_PTR(unsigned, WO.tq), WS_PTR(float, TAB_SU), WS_PTR(float, TAB_SV), WS_PTR(char, WO.mq), ntok10, smem);
#endif
      peer_gather_sweep3(WS_PTR(bf16_t, WO.xn), WS_PTR(char, WO.mq), WS_PTR(unsigned char, TAB_U), WS_PTR(unsigned char, TAB_V), modl, WS_PTR(float, WO.xs), ntok10, smem,
                         I.norm_mix_g + (l == 0 ? DM : 0), WS_PTR(float, WO.mod) + (long)(l == 0 ? 1 : 0) * (BATCH + 1) * 6144, WS_PTR(bf16_t, WO.xn), l == 0 ? (float*)nullptr : kp_->out);
    }
    DIL_END(10) }
    GRID_BARRIER();
  }
}

extern "C" void kernel_launch(void* const* d_in, const int* in_sizes, int n_in, void* d_out, int out_size, void* d_ws, size_t ws_size,
                              hipStream_t stream) {
  MegaP p{};
  const float** pp = (const float**)&p.in;
  for (int i = 0; i < 31; ++i) pp[i] = (const float*)d_in[i];
  p.ws = (char*)d_ws; p.out = (float*)d_out;
  if (WO.total > ws_size) return;
  static int grid_blocks = 0;
  if (!grid_blocks) {
    int dev = 0, cus = 0, per_cu = 0;
    hipGetDevice(&dev);
    hipDeviceGetAttribute(&cus, hipDeviceAttributeMultiprocessorCount, dev);
    hipOccupancyMaxActiveBlocksPerMultiprocessor(&per_cu, mega_kernel, 256, 0);
    if (per_cu > 2) per_cu = 2;
    if (per_cu < 1) per_cu = 1;
    grid_blocks = cus * per_cu;
  }
  hipMemsetAsync(d_ws, 0, 32768, stream);
  void* args[] = {&p};
  hipLaunchCooperativeKernel((void*)mega_kernel, dim3(grid_blocks), dim3(256), args, 0, stream);
}
```

```cpp
#include <hip/hip_runtime.h>
#define PEER_EXP(x) __builtin_amdgcn_exp2f((x) * 1.4426950408889634f)
#ifndef BATCH
#define BATCH 8
#endif
#ifndef SEQ
#define SEQ 2048
#endif
#ifndef CTX_LEN
#define CTX_LEN 256
#endif
#define DM 1024
#define RB (SEQ + CTX_LEN)
#define NROWS (BATCH * RB)
#define IN_COLS 2624
#define MLA_OFF 0
#define RW_OFF 416
#define GQA_OFF 1984
#define RWC 1568
#define EPSN 1e-6f

__device__ inline float sigmoidf_(float x) { return 1.f / (1.f + expf(-x)); }
__device__ inline float siluf_(float x) { return x * sigmoidf_(x); }
__device__ inline float softplusf_(float x) { return fmaxf(x, 0.f) + log1pf(expf(-fabsf(x))); }
__device__ inline float geluf_(float x) { return 0.5f * x * (1.f + tanhf(0.7978845608028654f * (x + 0.044715f * x * x * x))); }

__global__ void nk_copy_in(const float* x, const float* ctx, float* xs) {
  long i = (long)blockIdx.x * blockDim.x + threadIdx.x;
  if (i >= (long)NROWS * DM) return;
  int d = i % DM; long row = i / DM; int b = row / RB, lr = row % RB;
  xs[i] = lr < SEQ ? x[((long)b * SEQ + lr) * DM + d] : ctx[((long)b * CTX_LEN + (lr - SEQ)) * DM + d];
}
__global__ void nk_copy_out(const float* xs, float* out) {
  long i = (long)blockIdx.x * blockDim.x + threadIdx.x;
  if (i >= (long)BATCH * SEQ * DM) return;
  int d = i % DM; long row = i / DM; int b = row / SEQ, t = row % SEQ;
  out[i] = xs[((long)b * RB + t) * DM + d];
}
__global__ void nk_mod(const float* c, const float* c_ctx, const float* ada_w, const float* ada_b, float* mod) {
  long i = (long)blockIdx.x * blockDim.x + threadIdx.x;
  if (i >= 2L * (BATCH + 1) * 6144) return;
  int j = i % 6144; int bb = (i / 6144) % (BATCH + 1); int l = i / (6144 * (BATCH + 1));
  const float* cv = bb < BATCH ? c + (long)bb * DM : c_ctx;
  const float* w = ada_w + (long)l * DM * 6144;
  float acc = 0.f;
  for (int k = 0; k < DM; ++k) acc += siluf_(cv[k]) * w[(long)k * 6144 + j];
  mod[i] = acc + ada_b[l * 6144 + j];
}
__global__ void nk_norm_mod(const float* xs, const float* g, const float* modl, int shift_idx, float* xn, int M, int bidx) {
  long row = (long)blockIdx.x * blockDim.x + threadIdx.x;
  if (row >= M) return;
  int lr = row % RB; int bb = lr < SEQ ? bidx : BATCH;
  const float* sh = modl + ((long)bb * 6 + shift_idx) * DM; const float* sc = sh + DM;
  const float* xr = xs + row * DM; float ss = 0.f;
  for (int d = 0; d < DM; ++d) ss += xr[d] * xr[d];
  float inv = 1.f / sqrtf(ss / DM + EPSN);
  for (int d = 0; d < DM; ++d) xn[row * DM + d] = xr[d] * inv * g[d] * (1.f + sc[d]) + sh[d];
}
__global__ void nk_gemm(const float* A, const float* W, float* C, int M, int N, int K) {
  long i = (long)blockIdx.x * blockDim.x + threadIdx.x;
  if (i >= (long)M * N) return;
  int n = i % N; long m = i / N; float acc = 0.f;
  for (int k = 0; k < K; ++k) acc += A[m * K + k] * W[(long)k * N + n];
  C[i] = acc;
}
__global__ void nk_mla_q1(const float* P, const float* qng, const float* wqb, float* tq, int M) {
  long i = (long)blockIdx.x * blockDim.x + threadIdx.x;
  if (i >= (long)M * 384) return;
  int j = i % 384; long r = i / 384; const float* cq = P + r * IN_COLS;
  float ss = 0.f; for (int k = 0; k < 256; ++k) ss += cq[k] * cq[k];
  float inv = 1.f / sqrtf(ss / 256 + EPSN), acc = 0.f;
  for (int k = 0; k < 256; ++k) acc += cq[k] * inv * qng[k] * wqb[k * 384 + j];
  tq[i] = acc;
}
__global__ void nk_mla_kv1(const float* P, const float* kvng, const float* wkvb, float* tkv, int M) {
  long i = (long)blockIdx.x * blockDim.x + threadIdx.x;
  if (i >= (long)M * 512) return;
  int j = i % 512; long r = i / 512; const float* ck = P + r * IN_COLS + 256;
  float ss = 0.f; for (int k = 0; k < 128; ++k) ss += ck[k] * ck[k];
  float inv = 1.f / sqrtf(ss / 128 + EPSN), acc = 0.f;
  for (int k = 0; k < 128; ++k) acc += ck[k] * inv * kvng[k] * wkvb[k * 512 + j];
  tkv[i] = acc;
}
__global__ void nk_mla_qk2(const float* P, const float* tq, const float* tkv, const float* qkg, float* mq, float* mk, int M) {
  long i = (long)blockIdx.x * blockDim.x + threadIdx.x;
  if (i >= (long)M * 8) return;
  int which = i % 2, h = (i / 2) % 4; long r = i / 8; int lr = r % RB;
  float ss = 0.f;
  for (int e = 0; e < 96; ++e) {
    float v = which == 0 ? tq[r * 384 + h * 96 + e] : (e < 64 ? tkv[r * 512 + h * 128 + e] : P[r * IN_COLS + 384 + (e - 64)]);
    ss += v * v;
  }
  float inv = 1.f / sqrtf(ss / 96 + EPSN);
  const float* g = qkg + which * 96; float* o = (which == 0 ? mq : mk) + r * 384 + h * 96;
  for (int e = 0; e < 64; ++e) {
    float v = which == 0 ? tq[r * 384 + h * 96 + e] : tkv[r * 512 + h * 128 + e];
    o[e] = v * inv * g[e];
  }
  for (int j = 0; j < 16; ++j) {
    float va = which == 0 ? tq[r * 384 + h * 96 + 64 + j] : P[r * IN_COLS + 384 + j];
    float vb = which == 0 ? tq[r * 384 + h * 96 + 80 + j] : P[r * IN_COLS + 384 + 16 + j];
    va *= inv * g[64 + j]; vb *= inv * g[80 + j];
    if (lr < SEQ) {
      int pos = j < 8 ? lr / 64 : lr % 64; float fr = powf(10000.f, -(float)(j & 7) / 8.f);
      float ang = (float)pos * fr, cs = cosf(ang), sn = sinf(ang);
      o[64 + j] = va * cs - vb * sn; o[80 + j] = va * sn + vb * cs;
    } else { o[64 + j] = va; o[80 + j] = vb; }
  }
}
__global__ void nk_gqa_prep(const float* P, const float* qkg, float* gq, float* gk, int M) {
  long i = (long)blockIdx.x * blockDim.x + threadIdx.x;
  if (i >= (long)M * 8) return;
  int h = i % 8; long r = i / 8; int lr = r % RB;
  const float* src = P + r * IN_COLS + GQA_OFF + h * 64;
  const float* g = qkg + (h < 6 ? 0 : 64);
  float* o = h < 6 ? gq + r * 384 + h * 64 : gk + r * 128 + (h - 6) * 64;
  float ss = 0.f; for (int e = 0; e < 64; ++e) ss += src[e] * src[e];
  float inv = 1.f / sqrtf(ss / 64 + EPSN);
  for (int j = 0; j < 32; ++j) {
    float va = src[j] * inv * g[j], vb = src[32 + j] * inv * g[32 + j];
    if (lr < SEQ) {
      int pos = j < 16 ? lr / 64 : lr % 64; float fr = powf(10000.f, -(float)(j & 15) / 16.f);
      float ang = (float)pos * fr, cs = cosf(ang), sn = sinf(ang);
      o[j] = va * cs - vb * sn; o[32 + j] = va * sn + vb * cs;
    } else { o[j] = va; o[32 + j] = vb; }
  }
}
template <int DQ>
__global__ void __launch_bounds__(256) nk_attn(const float* q, int qs, const float* k, int ks, const float* v, int vs, int vhs, int H, int G, float* mix, int ooff, int M) {
  long i = (long)blockIdx.x * blockDim.x + threadIdx.x;
  if (i >= (long)M * H) return;
  int h = i % H; long r = i / H; int b = r / RB, lr = r % RB; int kh = h / G;
  float qv[DQ];
#pragma unroll
  for (int e = 0; e < DQ; ++e) qv[e] = q[r * qs + h * DQ + e];
  float acc[64];
#pragma unroll
  for (int e = 0; e < 64; ++e) acc[e] = 0.f;
  float mx = -1e30f, l = 0.f; const float scale = 1.f / sqrtf((float)DQ);
  int k0 = lr < SEQ ? 0 : SEQ, k1 = RB;
  for (int kr = k0; kr < k1; ++kr) {
    long rr = (long)b * RB + kr; const float* kp = k + rr * ks + kh * DQ; float s = 0.f;
#pragma unroll
    for (int e = 0; e < DQ; ++e) s += qv[e] * kp[e];
    s *= scale;
    float mn = fmaxf(mx, s), al = expf(mx - mn), pp = expf(s - mn);
    l = l * al + pp; mx = mn; const float* vp = v + rr * vs + kh * vhs;
#pragma unroll
    for (int e = 0; e < 64; ++e) acc[e] = acc[e] * al + pp * vp[e];
  }
#pragma unroll
  for (int e = 0; e < 64; ++e) mix[r * DM + ooff + h * 64 + e] = acc[e] / l;
}
__global__ void nk_rw_shift(const float* P, const float* mu, float* rwx, int M) {
  long i = (long)blockIdx.x * blockDim.x + threadIdx.x;
  if (i >= (long)M * RWC) return;
  int c = i % RWC; long r = i / RWC; int lr = r % RB;
  bool first = (lr == 0) || (lr == SEQ), last = (lr == SEQ - 1) || (lr == RB - 1);
  float p = P[r * IN_COLS + RW_OFF + c];
  float pv = first ? 0.f : P[(r - 1) * IN_COLS + RW_OFF + c], nx = last ? 0.f : P[(r + 1) * IN_COLS + RW_OFF + c];
  rwx[i] = p + mu[c] * (pv - p) + mu[RWC + c] * (nx - p);
}
__global__ void nk_rw_prep(const float* rwx, const float* w0, const float* w2, const float* a0, const float* a2, const float* g2,
                           const float* k_k, const float* k_a, float* dec, float* kd, float* bd, float* kk, float* gg, int M) {
  long i = (long)blockIdx.x * blockDim.x + threadIdx.x;
  if (i >= (long)M * 384) return;
  int c = i % 384; long r = i / 384; int h = c / 64; const float* xr = rwx + r * RWC;
  float kv = xr[384 + c];
  float ss = 0.f; for (int n = 0; n < 64; ++n) { float t = xr[384 + h * 64 + n] * k_k[h * 64 + n]; ss += t * t; }
  float kkv = kv * k_k[c] / sqrtf(ss + 1e-12f);
  kk[i] = kkv;
  for (int d = 0; d < 2; ++d) {
    float wr = w0[d * 384 + c], ar = a0[d * 384 + c];
    for (int j = 0; j < 64; ++j) { wr += tanhf(xr[1152 + d * 64 + j]) * w2[(d * 64 + j) * 384 + c]; ar += xr[1280 + d * 64 + j] * a2[(d * 64 + j) * 384 + c]; }
    float dc = expf(-expf(-softplusf_(-wr) - 0.5f)); float a = sigmoidf_(ar);
    dec[(long)d * M * 384 + i] = dc; kd[(long)d * M * 384 + i] = kv * (1.f + (a - 1.f) * k_a[c]); bd[(long)d * M * 384 + i] = kkv * a;
  }
  float g = 0.f; for (int j = 0; j < 160; ++j) g += sigmoidf_(xr[1408 + j]) * g2[j * 384 + c];
  gg[i] = g;
}
__global__ void __launch_bounds__(256) nk_rw_scan(const float* rwx, const float* dec, const float* kd, const float* bd, const float* kk, float* y, int M, int nb) {
  long t = (long)blockIdx.x * blockDim.x + threadIdx.x;
  if (t >= (long)nb * 2 * 6 * 64) return;
  int i = t % 64, h = (t / 64) % 6, d = (t / 384) % 2, b = t / 768;
  float S[64];
#pragma unroll
  for (int j = 0; j < 64; ++j) S[j] = 0.f;
  for (int step = 0; step < RB; ++step) {
    int lr;
    if (step < CTX_LEN) lr = SEQ + (d == 0 ? step : CTX_LEN - 1 - step);
    else lr = d == 0 ? step - CTX_LEN : SEQ - 1 - (step - CTX_LEN);
    long r = (long)b * RB + lr; long o = (long)d * M * 384 + r * 384 + h * 64;
    const float* rp = rwx + r * RWC + h * 64; const float* wp = dec + o; const float* kp = kd + o; const float* bp = bd + o; const float* kkp = kk + r * 384 + h * 64;
    float vi = rwx[r * RWC + 768 + h * 64 + i];
    float skk = 0.f;
#pragma unroll
    for (int j = 0; j < 64; ++j) skk += S[j] * kkp[j];
    float yy = 0.f;
#pragma unroll
    for (int j = 0; j < 64; ++j) { S[j] = S[j] * wp[j] - skk * bp[j] + vi * kp[j]; yy += S[j] * rp[j]; }
    y[o + i] = yy;
  }
}
__global__ void nk_rw_readout(const float* rwx, const float* y, const float* kd, const float* gg, const float* r_k, const float* ln_g, const float* ln_b, float* mix, int M, long yds) {
  long i = (long)blockIdx.x * blockDim.x + threadIdx.x;
  if (i >= (long)M * 6) return;
  int h = i % 6; long r = i / 6; long o = r * 384 + h * 64; long ds = (long)M * 384;
  float mean = 0.f; for (int n = 0; n < 64; ++n) mean += y[o + n] + y[yds + o + n];
  mean /= 64.f;
  float var = 0.f, coef = 0.f;
  for (int n = 0; n < 64; ++n) {
    float yy = y[o + n] + y[yds + o + n] - mean; var += yy * yy;
    coef += rwx[r * RWC + h * 64 + n] * (kd[o + n] + kd[ds + o + n]) * r_k[h * 64 + n];
  }
  var /= 64.f; float inv = 1.f / sqrtf(var + 64e-5f);
  for (int n = 0; n < 64; ++n) {
    float yn = (y[o + n] + y[yds + o + n] - mean) * inv * ln_g[h * 64 + n] + ln_b[h * 64 + n];
    mix[r * DM + 256 + h * 64 + n] = (yn + coef * rwx[r * RWC + 768 + h * 64 + n]) * gg[o + n];
  }
}
__global__ void nk_gemm_res(const float* A, const float* W, const float* modl, int gi, float* xs, int M, int bidx) {
  long i = (long)blockIdx.x * blockDim.x + threadIdx.x;
  if (i >= (long)M * DM) return;
  int j = i % DM; long r = i / DM; int lr = r % RB; int bb = lr < SEQ ? bidx : BATCH;
  float acc = 0.f; for (int k = 0; k < DM; ++k) acc += A[r * DM + k] * W[(long)k * DM + j];
  xs[i] += modl[((long)bb * 6 + gi) * DM + j] * acc;
}
__global__ void nk_peer_score(const float* pq, const float* keys, float* sc, int M) {
  long i = (long)blockIdx.x * blockDim.x + threadIdx.x;
  if (i >= (long)M * 2048) return;
  int k = i % 128, ps = (i / 128) % 16; long r = i / 2048;
  const float* q = pq + r * 2048 + ps * 128; const float* ky = keys + ((long)ps * 128 + k) * 128;
  float acc = 0.f; for (int d = 0; d < 128; ++d) acc += q[d] * ky[d];
  sc[i] = acc;
}
__global__ void nk_peer_top1(const float* sc, float* ts, int* ti, int M) {
  long i = (long)blockIdx.x * blockDim.x + threadIdx.x;
  if (i >= (long)M * 16) return;
  const float* s = sc + i * 128; float pv = 3e38f; int pi = -1;
  for (int t = 0; t < 16; ++t) {
    float bv = -3e38f; int bi = -1;
    for (int k = 0; k < 128; ++k) {
      float v = s[k]; bool ok = (v < pv) || (v == pv && k > pi);
      if (ok && (bi < 0 || v > bv)) { bv = v; bi = k; }
    }
    ts[i * 16 + t] = bv; ti[i * 16 + t] = bi; pv = bv; pi = bi;
  }
}
__global__ void nk_peer_top2(const float* ts, const int* ti, int* pe, float* pg, int M) {
  long i = (long)blockIdx.x * blockDim.x + threadIdx.x;
  if (i >= (long)M * 8) return;
  const float* s1 = ts + i * 32; const float* s2 = s1 + 16; const int* i1 = ti + i * 32; const int* i2 = i1 + 16;
  float pv = 3e38f; int pi = -1; float mx = 0.f, sum = 0.f;
  for (int t = 0; t < 16; ++t) {
    float bv = -3e38f; int bi = -1;
    for (int c = 0; c < 256; ++c) {
      float v = s1[c / 16] + s2[c % 16]; bool ok = (v < pv) || (v == pv && c > pi);
      if (ok && (bi < 0 || v > bv)) { bv = v; bi = c; }
    }
    if (t == 0) mx = bv;
    float e = expf(bv - mx); sum += e;
    pe[i * 16 + t] = i1[bi / 16] * 128 + i2[bi % 16]; pg[i * 16 + t] = e; pv = bv; pi = bi;
  }
  for (int t = 0; t < 16; ++t) pg[i * 16 + t] /= sum;
}
__global__ void nk_peer_act(const float* xn, const float* u, const int* pe, const float* pg, float* pw, int M) {
  long i = (long)blockIdx.x * blockDim.x + threadIdx.x;
  if (i >= (long)M * 128) return;
  long r = i / 128; const float* ur = u + (long)pe[i] * DM; const float* xr = xn + r * DM;
  float acc = 0.f; for (int d = 0; d < DM; ++d) acc += xr[d] * ur[d];
  pw[i] = pg[i] * geluf_(acc);
}
__global__ void nk_peer_out(const float* v, const int* pe, const float* pw, const float* modl, float* xs, int M, int bidx) {
  long i = (long)blockIdx.x * blockDim.x + threadIdx.x;
  if (i >= (long)M * DM) return;
  int j = i % DM; long r = i / DM; int lr = r % RB; int bb = lr < SEQ ? bidx : BATCH;
  float acc = 0.f; for (int k = 0; k < 128; ++k) acc += pw[r * 128 + k] * v[(long)pe[r * 128 + k] * DM + j];
  xs[i] += modl[((long)bb * 6 + 5) * DM + j] * acc;
}


#ifndef PEER_EXP
#define PEER_EXP(x) expf(x)
#endif
__device__ __forceinline__ unsigned f2sortable(float s) { unsigned f = __float_as_uint(s); return (f & 0x80000000u) ? ~f : (f | 0x80000000u); }
__device__ __forceinline__ float sortable2f(unsigned o) { unsigned f = (o & 0x80000000u) ? (o & 0x7fffffffu) : ~o; return __uint_as_float(f); }
__device__ __forceinline__ unsigned enc_key(float s, int idx) { return (f2sortable(s) & ~127u) | (unsigned)(127 - idx); }
__device__ __forceinline__ void dec_key(unsigned k, float& s, int& idx) { idx = 127 - (int)(k & 127u); s = sortable2f(k & ~127u); }
__device__ __forceinline__ unsigned umax_(unsigned a, unsigned b) { return a > b ? a : b; }
__device__ __forceinline__ unsigned umin_(unsigned a, unsigned b) { return a < b ? a : b; }
__device__ __forceinline__ void ins16(unsigned (&l)[16], unsigned x) {
#pragma unroll
  for (int i = 0; i < 16; ++i) { unsigned mx = umax_(l[i], x); x = umin_(l[i], x); l[i] = mx; }
}
__device__ __forceinline__ void merge16(unsigned (&a)[16], const unsigned (&brev)[16]) {
#pragma unroll
  for (int i = 0; i < 16; ++i) a[i] = umax_(a[i], brev[i]);
#pragma unroll
  for (int d = 8; d >= 1; d >>= 1)
#pragma unroll
    for (int i = 0; i < 16; ++i) if ((i & d) == 0) { unsigned hi = umax_(a[i], a[i + d]), lo = umin_(a[i], a[i + d]); a[i] = hi; a[i + d] = lo; }
}
__device__ __forceinline__ void peer_combine(const unsigned* L0, const unsigned* L1, int* e_out, float* g_out) {
  float s0[16], s1[16];
#pragma unroll
  for (int i = 0; i < 16; ++i) { int ix; dec_key(L0[i], s0[i], ix); dec_key(L1[i], s1[i], ix); }
  unsigned sel[16];
#pragma unroll
  for (int i = 0; i < 16; ++i) sel[i] = 0u;
#pragma unroll
  for (int i = 0; i < 16; ++i)
#pragma unroll
    for (int j = 0; j < 16; ++j)
      if ((i + 1) * (j + 1) <= 16) { unsigned k = (f2sortable(s0[i] + s1[j]) & ~255u) | (unsigned)(255 - (i * 16 + j)); ins16(sel, k); }
  float mx = -3e38f;
#pragma unroll
  for (int t = 0; t < 16; ++t) {
    int c = 255 - (int)(sel[t] & 255u); int i = c >> 4, j = c & 15;
    float a, b; int ia, ib; dec_key(L0[i], a, ia); dec_key(L1[j], b, ib);
    float s = a + b; e_out[t] = ia * 128 + ib; g_out[t] = s; mx = fmaxf(mx, s);
  }
  float sum = 0.f;
#pragma unroll
  for (int t = 0; t < 16; ++t) { float e = PEER_EXP(g_out[t] - mx); g_out[t] = e; sum += e; }
  float inv = 1.f / sum;
#pragma unroll
  for (int t = 0; t < 16; ++t) g_out[t] *= inv;
}
__global__ void hk_peer_top1(const float* pq, const float* keys, unsigned* top1, int M) {
  long i = (long)blockIdx.x * blockDim.x + threadIdx.x;
  if (i >= (long)M * 16) return;
  int ps = i % 16; long r = i / 16; const float* q = pq + r * 2048 + ps * 128;
  unsigned la[16], lb[16], lbr[16];
#pragma unroll
  for (int t = 0; t < 16; ++t) { la[t] = 0u; lb[t] = 0u; }
  for (int k = 0; k < 128; ++k) {
    const float* ky = keys + ((long)ps * 128 + k) * 128; float acc = 0.f;
    for (int d = 0; d < 128; ++d) acc += q[d] * ky[d];
    unsigned key = enc_key(acc, k);
    if (k < 64) ins16(la, key); else ins16(lb, key);
  }
#pragma unroll
  for (int t = 0; t < 16; ++t) lbr[t] = lb[15 - t];
  merge16(la, lbr);
#pragma unroll
  for (int t = 0; t < 16; ++t) top1[i * 16 + t] = la[t];
}
__global__ void hk_peer_combine(const unsigned* top1, int* pe, float* pg, int M) {
  long i = (long)blockIdx.x * blockDim.x + threadIdx.x;
  if (i >= (long)M * 8) return;
  peer_combine(top1 + i * 32, top1 + i * 32 + 16, pe + i * 16, pg + i * 16);
}
typedef unsigned short bf16_t;
__device__ __forceinline__ int tid_opaque() { int t = threadIdx.x; asm volatile("" : "+v"(t)); return t; }
typedef __attribute__((ext_vector_type(8))) short bf16x8;
typedef __attribute__((ext_vector_type(4))) float f32x4;
typedef __attribute__((ext_vector_type(16))) float f32x16;
typedef __attribute__((ext_vector_type(4))) unsigned u32x4;

typedef __attribute__((ext_vector_type(2))) __bf16 bf16v2;
typedef __attribute__((ext_vector_type(2))) float f32v2;
template <int CTRL> __device__ __forceinline__ float dpp_get(float x) { return __builtin_bit_cast(float, __builtin_amdgcn_update_dpp(0, __builtin_bit_cast(int, x), CTRL, 0xf, 0xf, true)); }
__device__ __forceinline__ float swz_xor4(float x) { return __builtin_bit_cast(float, __builtin_amdgcn_ds_swizzle(__builtin_bit_cast(int, x), 0x101F)); }
__device__ __forceinline__ float xor4_get(float x) { const int xi = __builtin_bit_cast(int, x);
  int r = __builtin_amdgcn_update_dpp(xi, xi, 0x114, 0xf, 0xA, false); r = __builtin_amdgcn_update_dpp(r, xi, 0x104, 0xf, 0x5, false); return __builtin_bit_cast(float, r); }
__device__ __forceinline__ float xor16_sum(float x) { const unsigned xi = __builtin_bit_cast(unsigned, x); auto q = __builtin_amdgcn_permlane16_swap(xi, xi, false, false);
  return __builtin_bit_cast(float, (unsigned)q[0]) + __builtin_bit_cast(float, (unsigned)q[1]); }
__device__ __forceinline__ float xor32_sum(float x) { const unsigned xi = __builtin_bit_cast(unsigned, x); auto q = __builtin_amdgcn_permlane32_swap(xi, xi, false, false);
  return __builtin_bit_cast(float, (unsigned)q[0]) + __builtin_bit_cast(float, (unsigned)q[1]); }
__device__ __forceinline__ float xor32_max(float x) { const unsigned xi = __builtin_bit_cast(unsigned, x); auto q = __builtin_amdgcn_permlane32_swap(xi, xi, false, false);
  return fmaxf(__builtin_bit_cast(float, (unsigned)q[0]), __builtin_bit_cast(float, (unsigned)q[1])); }
__device__ __forceinline__ unsigned pack2bf(float a, float b) { f32v2 v = {a, b}; bf16v2 r = __builtin_convertvector(v, bf16v2); return __builtin_bit_cast(unsigned, r); }
__device__ __forceinline__ bf16_t f2bf(float f) { return (bf16_t)(pack2bf(f, 0.f) & 0xffffu); }
__device__ __forceinline__ float bf2f(bf16_t h) { return __uint_as_float(((unsigned)h) << 16); }

__device__ __forceinline__ float fexp_(float x) { return __builtin_amdgcn_exp2f(x * 1.4426950408889634f); }
__device__ __forceinline__ float frcp_(float x) { return __builtin_amdgcn_rcpf(x); }
__device__ __forceinline__ float fsigmoid_(float x) { return frcp_(1.f + fexp_(-x)); }
__device__ __forceinline__ float ftanh_(float x) { return 1.f - 2.f * frcp_(fexp_(2.f * x) + 1.f); }
__device__ __forceinline__ float fgelu_(float x) { return x * fsigmoid_(1.5957691216057308f * (x + 0.044715f * x * x * x)); }
__device__ __forceinline__ float fdecay_(float w) { return fexp_(-0.6065306597126334f * fsigmoid_(w)); }
#define GEMM_LDS_BYTES 32768
struct ALoadPlain { const bf16_t* A; int lda;
  __device__ __forceinline__ u32x4 operator()(int row, int k) const { return *(const u32x4*)(A + (long)row * lda + k); } };
#define GEMM_STAGE_WRITE(RA, RB) do { _Pragma("unroll") for (int i = 0; i < 4; ++i) { int r = lrow + 32 * i; int off = r * 128 + ((lchunk ^ (r & 7)) << 4); *(u32x4*)(As + off) = RA[i]; *(u32x4*)(Bs + off) = RB[i]; } } while (0)
#define GEMM_COMPUTE_TILE() do { _Pragma("unroll") for (int ks = 0; ks < 2; ++ks) { bf16x8 af[4], bfr[4]; \
    _Pragma("unroll") for (int i = 0; i < 4; ++i) { int r = wm * 64 + i * 16 + fr; af[i] = *(const bf16x8*)(As + r * 128 + (((ks * 4 + fq) ^ (r & 7)) << 4)); \
      int rn = wn * 64 + i * 16 + fr; bfr[i] = *(const bf16x8*)(Bs + rn * 128 + (((ks * 4 + fq) ^ (rn & 7)) << 4)); } \
    _Pragma("unroll") for (int i = 0; i < 4; ++i) _Pragma("unroll") for (int j = 0; j < 4; ++j) acc[i][j] = __builtin_amdgcn_mfma_f32_16x16x32_bf16(bfr[j], af[i], acc[i][j], 0, 0, 0); } } while (0)
template <class ALoad, class Epi>
__device__ __forceinline__ void gemm_tile_128(ALoad aload, const bf16_t* __restrict__ Bt, int ldb, int K,
                                              int tile_m, int tile_n, char* smem, Epi epi) {
  const int t = tid_opaque(), lane = t & 63, wave = t >> 6;
  const int wm = wave >> 1, wn = wave & 1;
  char* As = smem; char* Bs = smem + 16384;
  const int lrow = t >> 3, lchunk = t & 7;
  const int arow = tile_m * 128 + lrow;
  const bf16_t* bg = Bt + (long)(tile_n * 128 + lrow) * ldb + lchunk * 8;
  u32x4 ra0[4], rb0[4], ra1[4], rb1[4];
#pragma unroll
  for (int i = 0; i < 4; ++i) { ra0[i] = aload(arow + 32 * i, lchunk * 8); rb0[i] = *(const u32x4*)(bg + (long)(32 * i) * ldb); }
  if (K > 64) {
#pragma unroll
    for (int i = 0; i < 4; ++i) { ra1[i] = aload(arow + 32 * i, 64 + lchunk * 8); rb1[i] = *(const u32x4*)(bg + (long)(32 * i) * ldb + 64); }
  }
  f32x4 acc[4][4];
#pragma unroll
  for (int i = 0; i < 4; ++i)
#pragma unroll
    for (int j = 0; j < 4; ++j) acc[i][j] = (f32x4){0.f, 0.f, 0.f, 0.f};
  const int fr = lane & 15, fq = lane >> 4;
  for (int k0 = 0; k0 < K; k0 += 128) {
    __syncthreads();
    GEMM_STAGE_WRITE(ra0, rb0);
    __syncthreads();
    if (k0 + 128 < K) {
#pragma unroll
      for (int i = 0; i < 4; ++i) { ra0[i] = aload(arow + 32 * i, k0 + 128 + lchunk * 8); rb0[i] = *(const u32x4*)(bg + (long)(32 * i) * ldb + k0 + 128); }
    }
    GEMM_COMPUTE_TILE();
    if (k0 + 64 < K) {
      __syncthreads();
      GEMM_STAGE_WRITE(ra1, rb1);
      __syncthreads();
      if (k0 + 192 < K) {
#pragma unroll
        for (int i = 0; i < 4; ++i) { ra1[i] = aload(arow + 32 * i, k0 + 192 + lchunk * 8); rb1[i] = *(const u32x4*)(bg + (long)(32 * i) * ldb + k0 + 192); }
      }
      GEMM_COMPUTE_TILE();
    }
  }
#pragma unroll
  for (int i = 0; i < 4; ++i)
#pragma unroll
    for (int j = 0; j < 4; ++j) {
      int m = tile_m * 128 + wm * 64 + i * 16 + fr; int n0 = tile_n * 128 + wn * 64 + j * 16 + fq * 4;
      epi(m, n0, acc[i][j]);
    }
}

typedef __attribute__((address_space(3))) void lds_void_t;
typedef __attribute__((address_space(1))) const void glb_cvoid_t;
#define GEMM_GLDS_BYTES 65536
__device__ __forceinline__ void gemm_mainloop_glds(const bf16_t* __restrict__ A, int lda, const bf16_t* __restrict__ Bt, int ldb, int K,
                                                   int tile_m, int tile_n, char* smem, f32x4 (&acc)[4][4]) {
  const int t = tid_opaque(), lane = t & 63, wave = t >> 6;
  const int wm = wave >> 1, wn = wave & 1, fr = lane & 15, fq = lane >> 4;
  const int lrow = t >> 3, cl = (t & 7) ^ (lrow & 7);
  const bf16_t* ag = A + (long)(tile_m * 128 + lrow) * lda + cl * 8;
  const bf16_t* bg = Bt + (long)(tile_n * 128 + lrow) * ldb + cl * 8;
  const int wbase = __builtin_amdgcn_readfirstlane(wave) * 1024;
#pragma unroll
  for (int i = 0; i < 4; ++i)
#pragma unroll
    for (int j = 0; j < 4; ++j) acc[i][j] = (f32x4){0.f, 0.f, 0.f, 0.f};
  __syncthreads();
#pragma unroll
  for (int i = 0; i < 4; ++i) {
    __builtin_amdgcn_global_load_lds((glb_cvoid_t*)(ag + (long)(32 * i) * lda), (lds_void_t*)(smem + i * 4096 + wbase), 16, 0, 0);
    __builtin_amdgcn_global_load_lds((glb_cvoid_t*)(bg + (long)(32 * i) * ldb), (lds_void_t*)(smem + 16384 + i * 4096 + wbase), 16, 0, 0);
  }
  int buf = 0;
  for (int k0 = 0; k0 < K; k0 += 64, buf ^= 1) {
    __syncthreads();
    if (k0 + 64 < K) {
      char* nb = smem + (buf ^ 1) * 32768;
#pragma unroll
      for (int i = 0; i < 4; ++i) {
        __builtin_amdgcn_global_load_lds((glb_cvoid_t*)(ag + (long)(32 * i) * lda + k0 + 64), (lds_void_t*)(nb + i * 4096 + wbase), 16, 0, 0);
        __builtin_amdgcn_global_load_lds((glb_cvoid_t*)(bg + (long)(32 * i) * ldb + k0 + 64), (lds_void_t*)(nb + 16384 + i * 4096 + wbase), 16, 0, 0);
      }
    }
    const char* As = smem + buf * 32768; const char* Bs = As + 16384;
    GEMM_COMPUTE_TILE();
  }
}
template <class Epi>
__device__ __forceinline__ void gemm_tile_128_glds(const bf16_t* __restrict__ A, int lda, const bf16_t* __restrict__ Bt, int ldb, int K,
                                                   int tile_m, int tile_n, char* smem, Epi epi) {
  f32x4 acc[4][4];
  gemm_mainloop_glds(A, lda, Bt, ldb, K, tile_m, tile_n, smem, acc);
  const int t = tid_opaque(), lane = t & 63, wave = t >> 6, wm = wave >> 1, wn = wave & 1, fr = lane & 15, fq = lane >> 4;
#pragma unroll
  for (int i = 0; i < 4; ++i)
#pragma unroll
    for (int j = 0; j < 4; ++j) {
      int m = tile_m * 128 + wm * 64 + i * 16 + fr; int n0 = tile_n * 128 + wn * 64 + j * 16 + fq * 4;
      epi(m, n0, acc[i][j]);
    }
}

__global__ void ok_cvt_wT(const float* W, bf16_t* Wt, int K, int N, int Npad) {
  long i = (long)blockIdx.x * blockDim.x + threadIdx.x;
  if (i >= (long)Npad * K) return;
  int k = i % K; int n = i / K;
  Wt[i] = n < N ? f2bf(W[(long)k * N + n]) : (bf16_t)0;
}
__global__ void ok_f32_to_bf16(const float* s, bf16_t* d, long n) {
  long i = (long)blockIdx.x * blockDim.x + threadIdx.x; if (i < n) d[i] = f2bf(s[i]);
}
__global__ void ok_bf16_to_f32(const bf16_t* s, float* d, long n) {
  long i = (long)blockIdx.x * blockDim.x + threadIdx.x; if (i < n) d[i] = bf2f(s[i]);
}
__global__ void ok_norm_mod_bf16(const float* xs, const float* g, const float* modl, int shift_idx, bf16_t* xn, int M) {
  int row = blockIdx.x * 4 + (threadIdx.x >> 6); int lane = threadIdx.x & 63;
  if (row >= M) return;
  int b = row / RB, lr = row % RB; int bb = lr < SEQ ? b : BATCH;
  const float* sh = modl + ((long)bb * 6 + shift_idx) * DM; const float* sc = sh + DM;
  const float* xr = xs + (long)row * DM; float v[16]; float ss = 0.f;
#pragma unroll
  for (int i = 0; i < 4; ++i) { float4 q = *(const float4*)(xr + i * 256 + lane * 4); v[i*4]=q.x; v[i*4+1]=q.y; v[i*4+2]=q.z; v[i*4+3]=q.w; ss += q.x*q.x+q.y*q.y+q.z*q.z+q.w*q.w; }
#pragma unroll
  for (int o = 32; o > 0; o >>= 1) ss += __shfl_xor(ss, o);
  float inv = __builtin_amdgcn_rsqf(ss / DM + EPSN);
#pragma unroll
  for (int i = 0; i < 4; ++i) {
    int d = i * 256 + lane * 4; float o[4];
#pragma unroll
    for (int e = 0; e < 4; ++e) o[e] = v[i*4+e] * inv * g[d+e] * (1.f + sc[d+e]) + sh[d+e];
    uint2 pk; pk.x = pack2bf(o[0], o[1]); pk.y = pack2bf(o[2], o[3]);
    *(uint2*)(xn + (long)row * DM + d) = pk;
  }
}

struct EpiStoreBf16 { bf16_t* C; int ldc; int N;
  __device__ __forceinline__ void operator()(int m, int n0, f32x4 v) const {
    if (n0 < N) { uint2 pk; pk.x = pack2bf(v[0], v[1]); pk.y = pack2bf(v[2], v[3]); *(uint2*)(C + (long)m * ldc + n0) = pk; } } };
struct EpiStoreF32 { float* C; int ldc; int N;
  __device__ __forceinline__ void operator()(int m, int n0, f32x4 v) const {
    if (n0 < N) *(float4*)(C + (long)m * ldc + n0) = make_float4(v[0], v[1], v[2], v[3]); } };
struct EpiResid { float* xs; const float* modl; int gi; int pad; const float* x_in; const float* ctx_in;
  __device__ __forceinline__ void operator()(int m, int n0, f32x4 v) const {
    int b = m / RB, lr = m % RB; int bb = lr < SEQ ? b : BATCH; const float* g = modl + ((long)bb * 6 + gi) * DM + n0;
    const float* src = x_in ? (lr < SEQ ? x_in + ((long)b * SEQ + lr) * DM + n0 : ctx_in + ((long)b * CTX_LEN + (lr - SEQ)) * DM + n0) : xs + (long)m * DM + n0;
    f32x4 x = *(const f32x4*)src;
    x[0] += g[0] * v[0]; x[1] += g[1] * v[1]; x[2] += g[2] * v[2]; x[3] += g[3] * v[3];
    *(f32x4*)(xs + (long)m * DM + n0) = x; } };

template <class Epi>
__global__ void __launch_bounds__(256) ok_gemm(const bf16_t* A, int lda, const bf16_t* Bt, int ldb, int K, int tiles_m, int tiles_n, Epi epi) {
  __shared__ __attribute__((aligned(16))) char smem[GEMM_LDS_BYTES];
  for (int tile = blockIdx.x; tile < tiles_m * tiles_n; tile += gridDim.x) {
    int tm = tile / tiles_n, tn = tile % tiles_n;
    gemm_tile_128(ALoadPlain{A, lda}, Bt, ldb, K, tm, tn, smem, epi);
  }
}

__device__ __forceinline__ float dot2bf(unsigned a, unsigned b, float c) {
  return __builtin_amdgcn_fdot2_f32_bf16(*(bf16v2*)&a, *(bf16v2*)&b, c, false);
}
__global__ void ok_cvt_bf16_v8(const float* s, bf16_t* d, long n8) {
  long i = (long)blockIdx.x * blockDim.x + threadIdx.x; if (i >= n8) return;
  float4 a = *(const float4*)(s + i * 8), b = *(const float4*)(s + i * 8 + 4);
  u32x4 o; o[0] = pack2bf(a.x, a.y); o[1] = pack2bf(a.z, a.w); o[2] = pack2bf(b.x, b.y); o[3] = pack2bf(b.z, b.w);
  *(u32x4*)(d + i * 8) = o;
}

#define P5_LDS_BYTES (128 * 128 * 4)
__device__ __forceinline__ void peer_q_top1_tile(const bf16_t* __restrict__ A, const bf16_t* __restrict__ WqT, const bf16_t* __restrict__ keysb,
                                                 unsigned* __restrict__ top1, int tm, int ps, char* smem) {
  const int t = tid_opaque(), lane = t & 63, wave = t >> 6, wm = wave >> 1, wn = wave & 1, fr = lane & 15, fq = lane >> 4;
  f32x4 acc[4][4];
  gemm_mainloop_glds(A, DM, WqT, DM, DM, tm, ps, smem, acc);
  __syncthreads();
  char* Qs = smem; char* Ks = smem + 32768;
#pragma unroll
  for (int i = 0; i < 4; ++i)
#pragma unroll
    for (int j = 0; j < 4; ++j) {
      int m = wm * 64 + i * 16 + fr; int n0 = wn * 64 + j * 16 + fq * 4;
      uint2 pk; pk.x = pack2bf(acc[i][j][0], acc[i][j][1]); pk.y = pack2bf(acc[i][j][2], acc[i][j][3]);
      *(uint2*)(Qs + m * 256 + ((((n0 >> 3) ^ (m & 15)) << 4) | ((n0 & 7) << 1))) = pk;
    }
  {
    const bf16_t* kg = keysb + (long)ps * 128 * 128;
#pragma unroll
    for (int i = 0; i < 8; ++i) { int idx = t + 256 * i; int r = idx >> 4, c = idx & 15; *(u32x4*)(Ks + r * 256 + ((c ^ (r & 15)) << 4)) = *(const u32x4*)(kg + r * 128 + c * 8); }
  }
  __syncthreads();
#pragma unroll
  for (int i = 0; i < 4; ++i)
#pragma unroll
    for (int j = 0; j < 4; ++j) acc[i][j] = (f32x4){0.f, 0.f, 0.f, 0.f};
#pragma unroll
  for (int ks = 0; ks < 4; ++ks) {
    bf16x8 af[4], bfr[4];
#pragma unroll
    for (int i = 0; i < 4; ++i) {
      int r = wm * 64 + i * 16 + fr; af[i] = *(const bf16x8*)(Qs + r * 256 + (((ks * 4 + fq) ^ (r & 15)) << 4));
      int rn = wn * 64 + i * 16 + fr; bfr[i] = *(const bf16x8*)(Ks + rn * 256 + (((ks * 4 + fq) ^ (rn & 15)) << 4));
    }
#pragma unroll
    for (int i = 0; i < 4; ++i)
#pragma unroll
      for (int j = 0; j < 4; ++j) acc[i][j] = __builtin_amdgcn_mfma_f32_16x16x32_bf16(bfr[j], af[i], acc[i][j], 0, 0, 0);
  }
  __syncthreads();
  unsigned* Sc = (unsigned*)smem;
#pragma unroll
  for (int i = 0; i < 4; ++i)
#pragma unroll
    for (int j = 0; j < 4; ++j) {
      int m = wm * 64 + i * 16 + fr; int n0 = wn * 64 + j * 16 + fq * 4;
#pragma unroll
      for (int e = 0; e < 4; ++e) Sc[(n0 + e) * 128 + (m ^ ((((n0 + e) >> 2) & 1) << 4))] = enc_key(acc[i][j][e], n0 + e);
    }
  __syncthreads();
  {
    const int r = t & 127, half = t >> 7;
    unsigned l[16];
#pragma unroll
    for (int i = 0; i < 16; ++i) l[i] = 0u;
    for (int k = 0; k < 64; ++k) ins16(l, Sc[(half * 64 + k) * 128 + (r ^ (((k >> 2) & 1) << 4))]);
    __syncthreads();
    unsigned* Ls = (unsigned*)smem;
    if (half == 1) {
#pragma unroll
      for (int i = 0; i < 16; ++i) Ls[r * 17 + i] = l[15 - i];
    }
    __syncthreads();
    if (half == 0) {
      unsigned br[16];
#pragma unroll
      for (int i = 0; i < 16; ++i) br[i] = Ls[r * 17 + i];
      merge16(l, br);
      unsigned* o = top1 + ((long)(tm * 128 + r) * 16 + ps) * 16;
#pragma unroll
      for (int i = 0; i < 4; ++i) { u32x4 v; v[0] = l[4*i]; v[1] = l[4*i+1]; v[2] = l[4*i+2]; v[3] = l[4*i+3]; *(u32x4*)(o + 4 * i) = v; }
    }
  }
}
__global__ void __launch_bounds__(256) ok_peer_q_top1(const bf16_t* A, const bf16_t* WqT, const bf16_t* keysb, unsigned* top1, int tiles_m) {
  __shared__ __attribute__((aligned(16))) char smem[P5_LDS_BYTES];
  for (int tile = blockIdx.x; tile < tiles_m * 16; tile += gridDim.x) { peer_q_top1_tile(A, WqT, keysb, top1, tile / 16, tile % 16, smem); __syncthreads(); }
}

#define P6_LDS_BYTES (32 * 128 * 4 * 3)
__device__ __forceinline__ void peer_gather_group(const bf16_t* __restrict__ xn, const unsigned* __restrict__ top1, const bf16_t* __restrict__ ub,
                                                  const bf16_t* __restrict__ vb, const float* __restrict__ modl, float* __restrict__ xs, int grp, char* smem) {
  const int t = tid_opaque(), lane = t & 63, wave = t >> 6;
  int* pe_l = (int*)smem; float* pg_l = (float*)(smem + 32 * 128 * 4); float* pw_l = (float*)(smem + 2 * 32 * 128 * 4);
  {
    int tl = t >> 3, p = t & 7; long row = (long)grp * 32 + tl;
    peer_combine(top1 + (row * 16 + p * 2) * 16, top1 + (row * 16 + p * 2 + 1) * 16, pe_l + tl * 128 + p * 16, pg_l + tl * 128 + p * 16);
  }
  __syncthreads();
  for (int ti = 0; ti < 8; ++ti) {
    const int tl = wave * 8 + ti; const long row = (long)grp * 32 + tl;
    const int* pe = pe_l + tl * 128; float* pw = pw_l + tl * 128;
    u32x4 h0 = *(const u32x4*)(xn + row * DM + lane * 8), h1 = *(const u32x4*)(xn + row * DM + 512 + lane * 8);
    for (int b = 0; b < 16; ++b) {
      u32x4 u0[8], u1[8];
#pragma unroll
      for (int j = 0; j < 8; ++j) { const bf16_t* ur = ub + (long)pe[b * 8 + j] * DM + lane * 8; u0[j] = *(const u32x4*)ur; u1[j] = *(const u32x4*)(ur + 512); }
      float pd[8];
#pragma unroll
      for (int j = 0; j < 8; ++j) {
        float a = 0.f;
#pragma unroll
        for (int e = 0; e < 4; ++e) { a = dot2bf(h0[e], u0[j][e], a); a = dot2bf(h1[e], u1[j][e], a); }
        pd[j] = a;
      }
      float q4[4], q2[2], q1;
#pragma unroll
      for (int j = 0; j < 4; ++j) { bool hi = lane & 1; float keep = hi ? pd[2*j+1] : pd[2*j], send = hi ? pd[2*j] : pd[2*j+1]; q4[j] = keep + __shfl_xor(send, 1); }
#pragma unroll
      for (int j = 0; j < 2; ++j) { bool hi = lane & 2; float keep = hi ? q4[2*j+1] : q4[2*j], send = hi ? q4[2*j] : q4[2*j+1]; q2[j] = keep + __shfl_xor(send, 2); }
      { bool hi = lane & 4; float keep = hi ? q2[1] : q2[0], send = hi ? q2[0] : q2[1]; q1 = keep + __shfl_xor(send, 4); }
      q1 += __shfl_xor(q1, 8); q1 += __shfl_xor(q1, 16); q1 += __shfl_xor(q1, 32);
      if (lane < 8) { int j = lane & 7; pw[b * 8 + j] = q1; }
    }
    {
      float d0 = pw[lane], d1 = pw[64 + lane];
      pw[lane] = pg_l[tl * 128 + lane] * fgelu_(d0); pw[64 + lane] = pg_l[tl * 128 + 64 + lane] * fgelu_(d1);
    }
    float o[16];
#pragma unroll
    for (int e = 0; e < 16; ++e) o[e] = 0.f;
    for (int b = 0; b < 16; ++b) {
      u32x4 v0[8], v1[8];
#pragma unroll
      for (int j = 0; j < 8; ++j) { const bf16_t* vr = vb + (long)pe[b * 8 + j] * DM + lane * 8; v0[j] = *(const u32x4*)vr; v1[j] = *(const u32x4*)(vr + 512); }
#pragma unroll
      for (int j = 0; j < 8; ++j) {
        float w = pw[b * 8 + j];
#pragma unroll
        for (int e = 0; e < 4; ++e) {
          o[2*e]     += w * __uint_as_float(v0[j][e] << 16); o[2*e+1]     += w * __uint_as_float(v0[j][e] & 0xffff0000u);
          o[8 + 2*e] += w * __uint_as_float(v1[j][e] << 16); o[8 + 2*e+1] += w * __uint_as_float(v1[j][e] & 0xffff0000u);
        }
      }
    }
    {
      int b = row / RB, lr = row % RB; int bb = lr < SEQ ? b : BATCH; const float* g5 = modl + ((long)bb * 6 + 5) * DM;
      float* xr = xs + row * DM;
#pragma unroll
      for (int hf = 0; hf < 2; ++hf) {
        int d = hf * 512 + lane * 8;
        float4 x0 = *(float4*)(xr + d), x1 = *(float4*)(xr + d + 4); float4 g0 = *(const float4*)(g5 + d), g1 = *(const float4*)(g5 + d + 4);
        x0.x += g0.x * o[hf*8+0]; x0.y += g0.y * o[hf*8+1]; x0.z += g0.z * o[hf*8+2]; x0.w += g0.w * o[hf*8+3];
        x1.x += g1.x * o[hf*8+4]; x1.y += g1.y * o[hf*8+5]; x1.z += g1.z * o[hf*8+6]; x1.w += g1.w * o[hf*8+7];
        *(float4*)(xr + d) = x0; *(float4*)(xr + d + 4) = x1;
      }
    }
  }
}
__global__ void __launch_bounds__(256) ok_peer_gather(const bf16_t* xn, const unsigned* top1, const bf16_t* ub, const bf16_t* vb, const float* modl, float* xs, int ngroups) {
  __shared__ __attribute__((aligned(16))) char smem[P6_LDS_BYTES];
  for (int g = blockIdx.x; g < ngroups; g += gridDim.x) { peer_gather_group(xn, top1, ub, vb, modl, xs, g, smem); __syncthreads(); }
}

template <int DQ> struct AttnCfg { static constexpr int KROW = DQ * 2 + 16; static constexpr int VROW = 136; static constexpr int KBYTES = 64 * KROW; static constexpr int LDS = 64 * KROW + 64 * VROW; };
#define ATTN_LDS_BYTES (64 * 208 + 64 * 136)
__device__ __forceinline__ void attn_score_bound(const float* __restrict__ qk_g, int DQ, float sqrt_dq, float* __restrict__ dst, int lane) {
  float gq = 0.f, gk = 0.f;
  for (int i = lane; i < DQ; i += 64) { gq = fmaxf(gq, fabsf(qk_g[i])); gk = fmaxf(gk, fabsf(qk_g[DQ + i])); }
#pragma unroll
  for (int o_ = 32; o_ > 0; o_ >>= 1) { gq = fmaxf(gq, __shfl_xor(gq, o_)); gk = fmaxf(gk, __shfl_xor(gk, o_)); }
  if (lane == 0) *dst = -fminf(1.02f * 1.4426950408889634f * sqrt_dq * gq * gk, 60.f);
}
template <int DQ>
__device__ __forceinline__ void attn_block(const bf16_t* __restrict__ qb, int HQ, const bf16_t* __restrict__ kb, int HK, const bf16_t* __restrict__ vT, int G,
                                           bf16_t* __restrict__ mixall, int ooff, int b, int head, int qt, char* smem, const float* __restrict__ negC_p) {
  constexpr int KROW = AttnCfg<DQ>::KROW, VROW = 136, NKK = DQ / 16, KCH = DQ / 8;
  constexpr int KLD = (64 * KCH) / 256;
  const int t = tid_opaque(), lane = t & 63, wave = t >> 6, lq = lane & 31, lh = lane >> 5;
  const int hk = head / G;
  char* Ks = smem; char* Vs = smem + 64 * KROW;
  const float negC = *negC_p;
  const long qrow = (long)b * RB + qt * 128 + wave * 32 + lq;
  bf16x8 qf[NKK];
#pragma unroll
  for (int kk = 0; kk < NKK; ++kk) qf[kk] = *(const bf16x8*)(qb + (qrow * HQ + head) * DQ + kk * 16 + lh * 8);
  const int key0 = qt < 16 ? 0 : SEQ; const int nt = qt < 16 ? RB / 64 : CTX_LEN / 64;
  const bf16_t* kp[KLD]; const bf16_t* vp_[2];
#pragma unroll
  for (int i = 0; i < KLD; ++i) { int c = t + 256 * i; int r = c / KCH, cc = c % KCH; kp[i] = kb + ((long)b * RB * HK + hk) * DQ + (long)(key0 + r) * HK * DQ + cc * 8; }
#pragma unroll
  for (int i = 0; i < 2; ++i) { int c = t + 256 * i; int r = c >> 3, cc = c & 7; vp_[i] = vT + ((long)(b * HK + hk) * 64 + r) * RB + key0 + cc * 8; }
  u32x4 rk[KLD], rv[2];
#pragma unroll
  for (int i = 0; i < KLD; ++i) { rk[i] = *(const u32x4*)kp[i]; kp[i] += 64 * HK * DQ; }
#pragma unroll
  for (int i = 0; i < 2; ++i) { rv[i] = *(const u32x4*)vp_[i]; vp_[i] += 64; }
  f32x16 ot[2];
#pragma unroll
  for (int d = 0; d < 2; ++d)
#pragma unroll
    for (int r = 0; r < 16; ++r) ot[d][r] = 0.f;
  float lrun = 0.f;
  for (int tile = 0; tile < nt; ++tile) {
    __syncthreads();
#pragma unroll
    for (int i = 0; i < KLD; ++i) { int c = t + 256 * i; int r = c / KCH, cc = c % KCH; *(u32x4*)(Ks + r * KROW + cc * 16) = rk[i]; }
#pragma unroll
    for (int i = 0; i < 2; ++i) { int c = t + 256 * i; int r = c >> 3, cc = c & 7; *(uint2*)(Vs + r * VROW + cc * 16) = make_uint2(rv[i][0], rv[i][1]); *(uint2*)(Vs + r * VROW + cc * 16 + 8) = make_uint2(rv[i][2], rv[i][3]); }
    __syncthreads();
    if (tile + 1 < nt) {
#pragma unroll
      for (int i = 0; i < KLD; ++i) { rk[i] = *(const u32x4*)kp[i]; kp[i] += 64 * HK * DQ; }
#pragma unroll
      for (int i = 0; i < 2; ++i) { rv[i] = *(const u32x4*)vp_[i]; vp_[i] += 64; }
    }
    f32x16 st[2];
#pragma unroll
    for (int kt = 0; kt < 2; ++kt) {
#pragma unroll
      for (int r = 0; r < 16; ++r) st[kt][r] = negC;
#pragma unroll
      for (int kk = 0; kk < NKK; ++kk) {
        bf16x8 ka = *(const bf16x8*)(Ks + (kt * 32 + lq) * KROW + kk * 32 + lh * 16);
        st[kt] = __builtin_amdgcn_mfma_f32_32x32x16_bf16(ka, qf[kk], st[kt], 0, 0, 0);
      }
    }
    float ps = 0.f;
#pragma unroll
    for (int kt = 0; kt < 2; ++kt)
#pragma unroll
      for (int r = 0; r < 16; ++r) { float p = __builtin_amdgcn_exp2f(st[kt][r]); st[kt][r] = p; ps += p; }
    lrun += ps;
#pragma unroll
    for (int kt = 0; kt < 2; ++kt)
#pragma unroll
      for (int s = 0; s < 2; ++s) {
        union { bf16x8 v; unsigned u[4]; } pb;
#pragma unroll
        for (int j = 0; j < 4; ++j) pb.u[j] = pack2bf(st[kt][8 * s + 2 * j], st[kt][8 * s + 2 * j + 1]);
#pragma unroll
        for (int d = 0; d < 2; ++d) {
          const char* vp = Vs + (d * 32 + lq) * VROW + (kt * 32 + 16 * s + 4 * lh) * 2;
          union { bf16x8 v; uint2 h[2]; } va; va.h[0] = *(const uint2*)vp; va.h[1] = *(const uint2*)(vp + 16);
          ot[d] = __builtin_amdgcn_mfma_f32_32x32x16_bf16(va.v, pb.v, ot[d], 0, 0, 0);
        }
      }
  }
  float ltot = xor32_sum(lrun); float inv = 1.f / ltot;
  bf16_t* orow = mixall + qrow * DM + ooff + head * 64;
#pragma unroll
  for (int d = 0; d < 2; ++d)
#pragma unroll
    for (int g = 0; g < 4; ++g) {
      uint2 pk; pk.x = pack2bf(ot[d][4 * g] * inv, ot[d][4 * g + 1] * inv); pk.y = pack2bf(ot[d][4 * g + 2] * inv, ot[d][4 * g + 3] * inv);
      *(uint2*)(orow + d * 32 + 8 * g + 4 * lh) = pk;
    }
}
__global__ void ok_adapt_rows(const float* src, int sld, int scol, int ncols, float scale, bf16_t* dst, int dld, int nrows) {
  long i = (long)blockIdx.x * blockDim.x + threadIdx.x; if (i >= (long)nrows * ncols) return;
  int c = i % ncols; long r = i / ncols; dst[r * dld + c] = f2bf(src[r * sld + scol + c] * scale);
}
__global__ void ok_adapt_vT(const float* src, int sld, int scol, int hstride, int H, bf16_t* dst) {
  long i = (long)blockIdx.x * blockDim.x + threadIdx.x; if (i >= (long)H * 64 * RB) return;
  int lr = i % RB; int d = (i / RB) % 64; int h = i / ((long)RB * 64);
  dst[i] = f2bf(src[(long)lr * sld + scol + h * hstride + d]);
}

typedef __attribute__((ext_vector_type(2))) float f32x2;
#define SCAN_TS 16
#define SCAN_LDS_BYTES (2 * SCAN_TS * 1536 + 2 * SCAN_TS * 32 * 4)
__device__ __forceinline__ float reduce8(float x) {
  x += __builtin_bit_cast(float, __builtin_amdgcn_update_dpp(0, __builtin_bit_cast(int, x), 0xB1, 0xf, 0xf, true));
  x += __builtin_bit_cast(float, __builtin_amdgcn_update_dpp(0, __builtin_bit_cast(int, x), 0x4E, 0xf, 0xf, true));
  x += __builtin_bit_cast(float, __builtin_amdgcn_update_dpp(0, __builtin_bit_cast(int, x), 0x141, 0xf, 0xf, true));
  return x;
}
__device__ __forceinline__ int scan_row(int dir, int s) {
  if (s < CTX_LEN) return SEQ + (dir == 0 ? s : CTX_LEN - 1 - s);
  return dir == 0 ? s - CTX_LEN : SEQ - 1 - (s - CTX_LEN);
}
__device__ __forceinline__ void rw_scan_block(const bf16_t* __restrict__ r_, const bf16_t* __restrict__ v_, const bf16_t* __restrict__ kk_, const bf16_t* __restrict__ kd_,
                                              const bf16_t* __restrict__ bd_, const float* __restrict__ w_, float* __restrict__ y_, int item, long dstride, char* smem) {
  const int t = tid_opaque(), lane = t & 63, wave = t >> 6, cg = lane & 7, il = wave * 8 + (lane >> 3);
  const int half = item & 1, dir = (item >> 1) & 1, h = (item >> 2) % 6, b = item / 24;
  const long rowbase = (long)b * RB; const int col0 = h * 64;
  float* ybuf = (float*)(smem + 2 * SCAN_TS * 1536);
  const int st_ld = t >> 4, part = t & 15;
  u32x4 la, lb, lc, lw;
  auto issue = [&](int c) {
    long row = rowbase + scan_row(dir, c * SCAN_TS + st_ld); long o = row * 384 + col0;
    const int ch = (part & 7) * 8;
    la = *(const u32x4*)((part < 8 ? kk_ + o : bd_ + dir * dstride + o) + ch);
    lb = *(const u32x4*)((part < 8 ? kd_ + dir * dstride + o : r_ + o) + ch);
    lc = *(const u32x4*)(v_ + o + ch);
    lw = *(const u32x4*)(w_ + dir * dstride + o + part * 4);
  };
  auto stash = [&](int buf) {
    float* base = (float*)(smem + buf * SCAN_TS * 1536 + st_ld * 1536);
    const int ch = (part & 7) * 8;
    float* pa = base + (part < 8 ? 64 : 128) + ch; float* pb = base + (part < 8 ? 192 : 256) + ch;
    f32x4 x0, x1;
#pragma unroll
    for (int e = 0; e < 2; ++e) { x0[2*e] = __uint_as_float(la[e] << 16); x0[2*e+1] = __uint_as_float(la[e] & 0xffff0000u); x1[2*e] = __uint_as_float(la[2+e] << 16); x1[2*e+1] = __uint_as_float(la[2+e] & 0xffff0000u); }
    *(f32x4*)pa = x0; *(f32x4*)(pa + 4) = x1;
#pragma unroll
    for (int e = 0; e < 2; ++e) { x0[2*e] = __uint_as_float(lb[e] << 16); x0[2*e+1] = __uint_as_float(lb[e] & 0xffff0000u); x1[2*e] = __uint_as_float(lb[2+e] << 16); x1[2*e+1] = __uint_as_float(lb[2+e] & 0xffff0000u); }
    *(f32x4*)pb = x0; *(f32x4*)(pb + 4) = x1;
    if (part < 8) {
      float* pc = base + 320 + ch;
#pragma unroll
      for (int e = 0; e < 2; ++e) { x0[2*e] = __uint_as_float(lc[e] << 16); x0[2*e+1] = __uint_as_float(lc[e] & 0xffff0000u); x1[2*e] = __uint_as_float(lc[2+e] << 16); x1[2*e+1] = __uint_as_float(lc[2+e] & 0xffff0000u); }
      *(f32x4*)pc = x0; *(f32x4*)(pc + 4) = x1;
    }
    *(u32x4*)(base + part * 4) = lw;
  };
  f32x2 S[4];
#pragma unroll
  for (int j = 0; j < 4; ++j) S[j] = (f32x2){0.f, 0.f};
  const int NCH = RB / SCAN_TS;
  __builtin_amdgcn_s_setprio(3);
  issue(0);
  for (int c = 0; c < NCH; ++c) {
    const int buf = c & 1;
    stash(buf);
    __syncthreads();
    if (c > 0 && t < 128) {
      int st = t >> 3, i4 = (t & 7) * 4; long row = rowbase + scan_row(dir, (c - 1) * SCAN_TS + st);
      *(f32x4*)(y_ + dir * dstride + row * 384 + col0 + half * 32 + i4) = *(const f32x4*)(ybuf + (buf ^ 1) * SCAN_TS * 32 + st * 32 + i4);
    }
    if (c + 1 < NCH) issue(c + 1);
    const float* ob = (const float*)(smem + buf * SCAN_TS * 1536) + cg * 8;
    const float* vb_ = (const float*)(smem + buf * SCAN_TS * 1536) + 320 + half * 32 + il;
    float yk[SCAN_TS];
    f32x4 nw0 = *(const f32x4*)(ob), nw1 = *(const f32x4*)(ob + 4), nk0 = *(const f32x4*)(ob + 64), nk1 = *(const f32x4*)(ob + 68);
    f32x4 nb0 = *(const f32x4*)(ob + 128), nb1 = *(const f32x4*)(ob + 132), nd0 = *(const f32x4*)(ob + 192), nd1 = *(const f32x4*)(ob + 196);
    f32x4 nr0 = *(const f32x4*)(ob + 256), nr1 = *(const f32x4*)(ob + 260); float nvi = vb_[0];
#pragma unroll
    for (int st = 0; st < SCAN_TS; ++st) {
      const f32x4 w0 = nw0, w1 = nw1, k0 = nk0, k1 = nk1, b0 = nb0, b1 = nb1, d0 = nd0, d1 = nd1, r0 = nr0, r1 = nr1; const float vi = nvi;
      if (st + 1 < SCAN_TS) {
        const float* o = ob + (st + 1) * 384;
        nw0 = *(const f32x4*)(o); nw1 = *(const f32x4*)(o + 4); nk0 = *(const f32x4*)(o + 64); nk1 = *(const f32x4*)(o + 68);
        nb0 = *(const f32x4*)(o + 128); nb1 = *(const f32x4*)(o + 132); nd0 = *(const f32x4*)(o + 192); nd1 = *(const f32x4*)(o + 196);
        nr0 = *(const f32x4*)(o + 256); nr1 = *(const f32x4*)(o + 260); nvi = vb_[(st + 1) * 384];
      }
      __builtin_amdgcn_sched_barrier(0);
      f32x2 a2 = S[0] * (f32x2){k0[0], k0[1]}, c2 = S[2] * (f32x2){k1[0], k1[1]};
      a2 += S[1] * (f32x2){k0[2], k0[3]}; c2 += S[3] * (f32x2){k1[2], k1[3]};
      a2 += c2;
      const f32x2 vv = (f32x2){vi, vi};
      f32x2 t0 = vv * (f32x2){d0[0], d0[1]}, t1 = vv * (f32x2){d0[2], d0[3]}, t2 = vv * (f32x2){d1[0], d1[1]}, t3 = vv * (f32x2){d1[2], d1[3]};
      float skk = reduce8(a2[0] + a2[1]);
      const f32x2 ns = (f32x2){-skk, -skk};
      t0 += ns * (f32x2){b0[0], b0[1]}; t1 += ns * (f32x2){b0[2], b0[3]}; t2 += ns * (f32x2){b1[0], b1[1]}; t3 += ns * (f32x2){b1[2], b1[3]};
      S[0] = S[0] * (f32x2){w0[0], w0[1]} + t0; S[1] = S[1] * (f32x2){w0[2], w0[3]} + t1; S[2] = S[2] * (f32x2){w1[0], w1[1]} + t2; S[3] = S[3] * (f32x2){w1[2], w1[3]} + t3;
      f32x2 y2 = S[0] * (f32x2){r0[0], r0[1]}, z2 = S[2] * (f32x2){r1[0], r1[1]};
      y2 += S[1] * (f32x2){r0[2], r0[3]}; z2 += S[3] * (f32x2){r1[2], r1[3]};
      y2 += z2;
      yk[st] = y2[0] + y2[1];
      __builtin_amdgcn_sched_barrier(0);
    }
#pragma unroll
    for (int g = 0; g < 2; ++g) {
      float q4[4], q2[2], q1;
#pragma unroll
      for (int j = 0; j < 4; ++j) { bool hi = cg & 1; float keep = hi ? yk[g*8 + 2*j+1] : yk[g*8 + 2*j], send = hi ? yk[g*8 + 2*j] : yk[g*8 + 2*j+1]; q4[j] = keep + dpp_get<0xB1>(send); }
#pragma unroll
      for (int j = 0; j < 2; ++j) { bool hi = cg & 2; float keep = hi ? q4[2*j+1] : q4[2*j], send = hi ? q4[2*j] : q4[2*j+1]; q2[j] = keep + dpp_get<0x4E>(send); }
      { bool hi = cg & 4; float keep = hi ? q2[1] : q2[0], send = hi ? q2[0] : q2[1]; q1 = keep + xor4_get(send); }
      ybuf[buf * SCAN_TS * 32 + (g * 8 + cg) * 32 + il] = q1;
    }
  }
  __builtin_amdgcn_s_setprio(0);
  __syncthreads();
  if (t < 128) {
    int st = t >> 3, i4 = (t & 7) * 4; long row = rowbase + scan_row(dir, (NCH - 1) * SCAN_TS + st);
    *(f32x4*)(y_ + dir * dstride + row * 384 + col0 + half * 32 + i4) = *(const f32x4*)(ybuf + ((NCH - 1) & 1) * SCAN_TS * 32 + st * 32 + i4);
  }
}
__global__ void __launch_bounds__(256) ok_rw_scan(const bf16_t* r_, const bf16_t* v_, const bf16_t* kk_, const bf16_t* kd_, const bf16_t* bd_, const float* w_, float* y_, int item0, int nitems, long dstride) {
  __shared__ __attribute__((aligned(16))) char smem[SCAN_LDS_BYTES];
  for (int it = item0 + blockIdx.x; it < item0 + nitems; it += gridDim.x) { rw_scan_block(r_, v_, kk_, kd_, bd_, w_, y_, it, dstride, smem); __syncthreads(); }
}
__global__ void ok_copy_rows_f32(const float* src, int sld, int scol, int ncols, float* dst, int dld, int nrows) {
  long i = (long)blockIdx.x * blockDim.x + threadIdx.x; if (i >= (long)nrows * ncols) return;
  int c = i % ncols; long r = i / ncols; dst[r * dld + c] = src[r * sld + scol + c];
}

__global__ void ok_cvt_wT_g(const float* W, const float* g, bf16_t* Wt, int K, int N, int Kpad) {
  long i = (long)blockIdx.x * blockDim.x + threadIdx.x;
  if (i >= (long)N * Kpad) return;
  int k = i % Kpad; int n = i / Kpad;
  Wt[i] = k < K ? f2bf(W[(long)k * N + n] * (g ? g[k] : 1.f)) : (bf16_t)0;
}
struct ALoadShift { const bf16_t* P; const float* mu; int col0; int mucol0; int act; int kvalid;
  __device__ __forceinline__ u32x4 operator()(int row, int k) const {
    u32x4 z = {0u, 0u, 0u, 0u};
    if (k >= kvalid) return z;
    int lr = row % RB; bool first = (lr == 0) || (lr == SEQ), last = (lr == SEQ - 1) || (lr == RB - 1);
    const bf16_t* p = P + (long)row * IN_COLS + col0 + k;
    u32x4 c = *(const u32x4*)p; u32x4 pv = first ? z : *(const u32x4*)(p - IN_COLS); u32x4 nx = last ? z : *(const u32x4*)(p + IN_COLS);
    const float* m0 = mu + mucol0 + k; const float* m1 = m0 + RWC;
    u32x4 o;
#pragma unroll
    for (int e = 0; e < 4; ++e) {
      float c0 = __uint_as_float(c[e] << 16), c1 = __uint_as_float(c[e] & 0xffff0000u);
      float p0 = __uint_as_float(pv[e] << 16), p1 = __uint_as_float(pv[e] & 0xffff0000u);
      float n0 = __uint_as_float(nx[e] << 16), n1 = __uint_as_float(nx[e] & 0xffff0000u);
      float x0 = c0 + m0[2*e] * (p0 - c0) + m1[2*e] * (n0 - c0), x1 = c1 + m0[2*e+1] * (p1 - c1) + m1[2*e+1] * (n1 - c1);
      if (act == 1) { x0 = ftanh_(x0); x1 = ftanh_(x1); } else if (act == 2) { x0 = fsigmoid_(x0); x1 = fsigmoid_(x1); }
      o[e] = pack2bf(x0, x1);
    }
    return o;
  } };
struct EpiDecay { float* w; const float* w0; int pad0; int pad1;
  __device__ __forceinline__ void operator()(int m, int n0, f32x4 v) const {
    f32x4 o;
#pragma unroll
    for (int e = 0; e < 4; ++e) o[e] = fdecay_(w0[n0 + e] + v[e]);
    *(f32x4*)(w + (long)m * 384 + n0) = o; } };
struct EpiSigA { bf16_t* a; const float* a0;
  __device__ __forceinline__ void operator()(int m, int n0, f32x4 v) const {
    uint2 pk; pk.x = pack2bf(fsigmoid_(a0[n0] + v[0]), fsigmoid_(a0[n0+1] + v[1])); pk.y = pack2bf(fsigmoid_(a0[n0+2] + v[2]), fsigmoid_(a0[n0+3] + v[3]));
    *(uint2*)(a + (long)m * 384 + n0) = pk; } };

struct PrepW { const bf16_t *wqbT, *wkvbT, *w2T, *a2T, *g2T; const float *mu, *w0, *a0; };
struct PrepBuf { const bf16_t* P; bf16_t *tq, *tkv, *a_b, *g_b; float* w_f; };
__device__ __forceinline__ void prep_gemm_tile(const PrepW& W, const PrepBuf& B, int tm, int ct, char* smem) {
  const long MA = NROWS;
  if (ct < 3) gemm_tile_128(ALoadPlain{B.P, IN_COLS}, W.wqbT, 256, 256, tm, ct, smem, EpiStoreBf16{B.tq, 384, 384});
  else if (ct < 7) gemm_tile_128(ALoadPlain{B.P + 256, IN_COLS}, W.wkvbT, 128, 128, tm, ct - 3, smem, EpiStoreBf16{B.tkv, 512, 512});
  else if (ct < 13) { int d = (ct - 7) / 3, tn = (ct - 7) % 3;
    gemm_tile_128(ALoadShift{B.P, W.mu, RW_OFF + 1152 + d * 64, 1152 + d * 64, 1, 64}, W.w2T + d * 384 * 64, 64, 64, tm, tn, smem, EpiDecay{B.w_f + d * MA * 384, W.w0 + d * 384, 0, 0}); }
  else if (ct < 19) { int d = (ct - 13) / 3, tn = (ct - 13) % 3;
    gemm_tile_128(ALoadShift{B.P, W.mu, RW_OFF + 1280 + d * 64, 1280 + d * 64, 0, 64}, W.a2T + d * 384 * 64, 64, 64, tm, tn, smem, EpiSigA{B.a_b + d * MA * 384, W.a0 + d * 384}); }
  else gemm_tile_128(ALoadShift{B.P, W.mu, RW_OFF + 1408, 1408, 2, 160}, W.g2T, 192, 192, tm, ct - 19, smem, EpiStoreBf16{B.g_b, 384, 384});
}
__global__ void __launch_bounds__(256) ok_prep_gemm(PrepW W, PrepBuf B) {
  __shared__ __attribute__((aligned(16))) char smem[GEMM_LDS_BYTES];
  for (int tile = blockIdx.x; tile < (NROWS / 128) * 22; tile += gridDim.x) prep_gemm_tile(W, B, tile / 22, tile % 22, smem);
}

__device__ __forceinline__ float wave_sum(float x) {
#pragma unroll
  for (int o = 32; o > 0; o >>= 1) x += __shfl_xor(x, o);
  return x;
}
__device__ __forceinline__ float ldbf(const bf16_t* p) { return bf2f(*p); }
struct FinW { const float *mla_qk_g, *gqa_qk_g, *mu, *k_k, *k_a; };
struct FinBuf { const bf16_t *P, *tq, *tkv, *a_b; bf16_t *mq, *mk, *mvT, *gq, *gk, *gvT, *r_b, *v_b, *kk_b, *kd_b, *bd_b; };
#define FIN_LDS_BYTES (384 * 132)
__device__ __forceinline__ void prep_finish_tile(const FinW& W, const FinBuf& B, int tile, char* smem) {
  const int t = tid_opaque(), lane = t & 63, wave = t >> 6; const long MA = NROWS;
  bf16_t* vbuf = (bf16_t*)smem;
  const long row0 = (long)tile * 64; const int b = row0 / RB; const int lr0 = row0 % RB;
  for (int it = 0; it < 16; ++it) {
    const int rl = it * 4 + wave; const long row = row0 + rl; const int lr = lr0 + rl; const bool lat = lr < SEQ;
    const bf16_t* Pr = B.P + row * IN_COLS;
    float sq = 0.f;
#pragma unroll
    for (int i = 0; i < 4; ++i) { float x = ldbf(Pr + i * 64 + lane); sq += x * x; }
    float skv = 0.f;
#pragma unroll
    for (int i = 0; i < 2; ++i) { float x = ldbf(Pr + 256 + i * 64 + lane); skv += x * x; }
    const float cq = __builtin_amdgcn_rsqf(wave_sum(sq) / 256.f + EPSN), ckv = __builtin_amdgcn_rsqf(wave_sum(skv) / 128.f + EPSN);
    const float krope = lane < 32 ? ldbf(Pr + 384 + lane) : 0.f;
    float cs_m = 1.f, sn_m = 0.f;
    { int j = lane & 15; int pos = j < 8 ? lr / 64 : lr % 64; float ang = (float)pos * powf(10000.f, -(float)(j & 7) / 8.f); if (lat) { cs_m = cosf(ang); sn_m = sinf(ang); } }
    const float* gq_ = W.mla_qk_g; const float* gk_ = W.mla_qk_g + 96;
#pragma unroll
    for (int h = 0; h < 4; ++h) {
      float qa = cq * ldbf(B.tq + row * 384 + h * 96 + lane); float qb = lane < 32 ? cq * ldbf(B.tq + row * 384 + h * 96 + 64 + lane) : 0.f;
      float inv = __builtin_amdgcn_rsqf(wave_sum(qa * qa + qb * qb) / 96.f + EPSN);
      qa *= inv * gq_[lane]; qb *= inv * (lane < 32 ? gq_[64 + lane] : 0.f);
      { float other = __shfl_xor(qb, 16); float rr = (lane & 16) ? (other * sn_m + qb * cs_m) : (qb * cs_m - other * sn_m); qb = rr; }
      const float qs = 0.14724445f;
      B.mq[row * 384 + h * 96 + lane] = f2bf(qa * qs); if (lane < 32) B.mq[row * 384 + h * 96 + 64 + lane] = f2bf(qb * qs);
      float ka = ckv * ldbf(B.tkv + row * 512 + h * 128 + lane); float kb = krope;
      float invk = __builtin_amdgcn_rsqf(wave_sum(ka * ka + kb * kb) / 96.f + EPSN);
      ka *= invk * gk_[lane]; kb *= invk * (lane < 32 ? gk_[64 + lane] : 0.f);
      { float other = __shfl_xor(kb, 16); float rr = (lane & 16) ? (other * sn_m + kb * cs_m) : (kb * cs_m - other * sn_m); kb = rr; }
      B.mk[row * 384 + h * 96 + lane] = f2bf(ka); if (lane < 32) B.mk[row * 384 + h * 96 + 64 + lane] = f2bf(kb);
      vbuf[(h * 64 + lane) * 66 + rl] = f2bf(ckv * ldbf(B.tkv + row * 512 + h * 128 + 64 + lane));
    }
    float cs_g = 1.f, sn_g = 0.f;
    { int j = lane & 31; int pos = j < 16 ? lr / 64 : lr % 64; float ang = (float)pos * powf(10000.f, -(float)(j & 15) / 16.f); if (lat) { cs_g = cosf(ang); sn_g = sinf(ang); } }
#pragma unroll
    for (int h = 0; h < 8; ++h) {
      float x = ldbf(Pr + GQA_OFF + h * 64 + lane);
      float inv = __builtin_amdgcn_rsqf(wave_sum(x * x) / 64.f + EPSN);
      x *= inv * W.gqa_qk_g[(h < 6 ? 0 : 64) + lane];
      float other = __shfl_xor(x, 32); float rr = (lane & 32) ? (other * sn_g + x * cs_g) : (x * cs_g - other * sn_g);
      if (h < 6) B.gq[row * 384 + h * 64 + lane] = f2bf(rr * 0.18033688f); else B.gk[row * 128 + (h - 6) * 64 + lane] = f2bf(rr);
    }
#pragma unroll
    for (int hk = 0; hk < 2; ++hk) vbuf[((4 + hk) * 64 + lane) * 66 + rl] = Pr[GQA_OFF + 512 + hk * 64 + lane];
    const bool first = (lr == 0) || (lr == SEQ), last = (lr == SEQ - 1) || (lr == RB - 1);
#pragma unroll
    for (int h = 0; h < 6; ++h) {
      float xs3[3];
#pragma unroll
      for (int part = 0; part < 3; ++part) {
        int c = part * 384 + h * 64 + lane; const bf16_t* pp = Pr + RW_OFF + c;
        float p = ldbf(pp), pv = first ? 0.f : ldbf(pp - IN_COLS), nx = last ? 0.f : ldbf(pp + IN_COLS);
        xs3[part] = p + W.mu[c] * (pv - p) + W.mu[RWC + c] * (nx - p);
      }
      const int c = h * 64 + lane; const long o = row * 384 + c;
      float kv = xs3[1]; float tk = kv * W.k_k[c]; float kkv = tk * __builtin_amdgcn_rsqf(wave_sum(tk * tk) + 1e-12f);
      B.r_b[o] = f2bf(xs3[0]); B.v_b[o] = f2bf(xs3[2]); B.kk_b[o] = f2bf(kkv);
#pragma unroll
      for (int d = 0; d < 2; ++d) { float a = ldbf(B.a_b + d * MA * 384 + o); B.kd_b[d * MA * 384 + o] = f2bf(kv * (1.f + (a - 1.f) * W.k_a[c])); B.bd_b[d * MA * 384 + o] = f2bf(kkv * a); }
    }
  }
  __syncthreads();
  for (int i = t; i < 384 * 32; i += 256) {
    int rr = i >> 5, w2 = i & 31; int slot = rr >> 6, d = rr & 63;
    unsigned val = *(const unsigned*)(vbuf + rr * 66 + w2 * 2);
    bf16_t* dst = slot < 4 ? B.mvT + ((long)(b * 4 + slot) * 64 + d) * RB : B.gvT + ((long)(b * 2 + (slot - 4)) * 64 + d) * RB;
    *(unsigned*)(dst + lr0 + w2 * 2) = val;
  }
  __syncthreads();
}
__global__ void __launch_bounds__(256) ok_prep_finish(FinW W, FinBuf B) {
  __shared__ __attribute__((aligned(16))) char smem[FIN_LDS_BYTES];
  for (int tile = blockIdx.x; tile < NROWS / 64; tile += gridDim.x) prep_finish_tile(W, B, tile, smem);
}
struct RdW { const float *r_k, *ln_g, *ln_b; };
__device__ __forceinline__ void rw_readout_row(const RdW& W, const float* __restrict__ y, const bf16_t* __restrict__ r_b, const bf16_t* __restrict__ v_b, const bf16_t* __restrict__ kd_b,
                                               const bf16_t* __restrict__ g_b, bf16_t* __restrict__ mixall, long row, int lane) {
  const long MA = NROWS;
#pragma unroll
  for (int h = 0; h < 6; ++h) {
    const int c = h * 64 + lane; const long o = row * 384 + c;
    float yy = y[o] + y[MA * 384 + o];
    float mean = wave_sum(yy) * (1.f / 64.f); float dv = yy - mean; float var = wave_sum(dv * dv) * (1.f / 64.f);
    float coef = wave_sum(ldbf(r_b + o) * (ldbf(kd_b + o) + ldbf(kd_b + MA * 384 + o)) * W.r_k[c]);
    float yn = dv * __builtin_amdgcn_rsqf(var + 64e-5f) * W.ln_g[c] + W.ln_b[c];
    mixall[row * DM + 256 + c] = f2bf((yn + coef * ldbf(v_b + o)) * ldbf(g_b + o));
  }
}
__global__ void __launch_bounds__(256) ok_rw_readout(RdW W, const float* y, const bf16_t* r_b, const bf16_t* v_b, const bf16_t* kd_b, const bf16_t* g_b, bf16_t* mixall) {
  for (long row = blockIdx.x * 4 + (threadIdx.x >> 6); row < NROWS; row += gridDim.x * 4) rw_readout_row(W, y, r_b, v_b, kd_b, g_b, mixall, row, threadIdx.x & 63);
}

__device__ __forceinline__ void ph_cvt_fp8_rows(const float* __restrict__ tab, unsigned char* __restrict__ q, float* __restrict__ scale, int r0 = -1, int r1 = 0) {
  const int t = tid_opaque(); const int lane = t & 63;
  const int rbeg = r0 < 0 ? (int)blockIdx.x * 4 + (t >> 6) : r0 + (t >> 6), rend = r0 < 0 ? 16384 : r1, rstep = r0 < 0 ? (int)gridDim.x * 4 : 4;
  for (int row = rbeg; row < rend; row += rstep) {
    const float* src = tab + (long)row * DM + lane * 16;
    f32x4 a[4]; float m = 0.f;
#pragma unroll
    for (int i = 0; i < 4; ++i) { a[i] = *(const f32x4*)(src + 4 * i); m = fmaxf(m, fmaxf(fmaxf(fabsf(a[i][0]), fabsf(a[i][1])), fmaxf(fabsf(a[i][2]), fabsf(a[i][3])))); }
#pragma unroll
    for (int o = 32; o > 0; o >>= 1) m = fmaxf(m, __shfl_xor(m, o));
    const float sc = m > 0.f ? m * (1.f / 440.f) : 1.f; const float inv = 1.f / sc;
    u32x4 p;
#pragma unroll
    for (int i = 0; i < 4; ++i) { int w = __builtin_amdgcn_cvt_pk_fp8_f32(a[i][0] * inv, a[i][1] * inv, 0, false); w = __builtin_amdgcn_cvt_pk_fp8_f32(a[i][2] * inv, a[i][3] * inv, w, true); p[i] = (unsigned)w; }
    *(u32x4*)(q + (long)row * DM + lane * 16) = p;
    if (lane == 0) scale[row] = sc;
  }
}
__device__ __forceinline__ float dot16_fp8(const float (&h)[16], u32x4 q) {
  float a = 0.f;
#pragma unroll
  for (int d = 0; d < 4; ++d) {
    f32v2 lo = __builtin_amdgcn_cvt_pk_f32_fp8((int)q[d], false), hi = __builtin_amdgcn_cvt_pk_f32_fp8((int)q[d], true);
    a += h[4*d] * lo[0]; a += h[4*d+1] * lo[1]; a += h[4*d+2] * hi[0]; a += h[4*d+3] * hi[1];
  }
  return a;
}
__device__ __forceinline__ void axpy16_fp8(float (&o)[16], float w, u32x4 q) {
#pragma unroll
  for (int d = 0; d < 4; ++d) {
    f32v2 lo = __builtin_amdgcn_cvt_pk_f32_fp8((int)q[d], false), hi = __builtin_amdgcn_cvt_pk_f32_fp8((int)q[d], true);
    o[4*d] += w * lo[0]; o[4*d+1] += w * lo[1]; o[4*d+2] += w * hi[0]; o[4*d+3] += w * hi[1];
  }
}
__device__ __forceinline__ void peer_gather_group_fp8(const bf16_t* __restrict__ xn, const unsigned* __restrict__ top1, const unsigned char* __restrict__ ub, const float* __restrict__ su,
                                                      const unsigned char* __restrict__ vb, const float* __restrict__ sv, const float* __restrict__ modl, float* __restrict__ xs, int grp, char* smem) {
  const int t = tid_opaque(), lane = t & 63, wave = t >> 6;
  int* pe_l = (int*)smem; float* pg_l = (float*)(smem + 32 * 128 * 4); float* pw_l = (float*)(smem + 2 * 32 * 128 * 4);
  {
    int tl = t >> 3, p = t & 7; long row = (long)grp * 32 + tl;
    peer_combine(top1 + (row * 16 + p * 2) * 16, top1 + (row * 16 + p * 2 + 1) * 16, pe_l + tl * 128 + p * 16, pg_l + tl * 128 + p * 16);
  }
  __syncthreads();
  for (int ti = 0; ti < 8; ++ti) {
    const int tl = wave * 8 + ti; const long row = (long)grp * 32 + tl;
    const int* pe = pe_l + tl * 128; float* pw = pw_l + tl * 128;
    float h[16];
    { u32x4 h0 = *(const u32x4*)(xn + row * DM + lane * 16), h1 = *(const u32x4*)(xn + row * DM + lane * 16 + 8);
#pragma unroll
      for (int e = 0; e < 4; ++e) { h[2*e] = __uint_as_float(h0[e] << 16); h[2*e+1] = __uint_as_float(h0[e] & 0xffff0000u); h[8+2*e] = __uint_as_float(h1[e] << 16); h[8+2*e+1] = __uint_as_float(h1[e] & 0xffff0000u); } }
    u32x4 u[8];
#pragma unroll
    for (int j = 0; j < 8; ++j) u[j] = *(const u32x4*)(ub + (long)pe[j] * DM + lane * 16);
    for (int b = 0; b < 16; ++b) {
      float pd[8];
#pragma unroll
      for (int j = 0; j < 8; ++j) pd[j] = dot16_fp8(h, u[j]);
      if (b + 1 < 16) {
#pragma unroll
        for (int j = 0; j < 8; ++j) u[j] = *(const u32x4*)(ub + (long)pe[(b + 1) * 8 + j] * DM + lane * 16);
      }
      float q4[4], q2[2], q1;
#pragma unroll
      for (int j = 0; j < 4; ++j) { bool hi = lane & 1; float keep = hi ? pd[2*j+1] : pd[2*j], send = hi ? pd[2*j] : pd[2*j+1]; q4[j] = keep + __shfl_xor(send, 1); }
#pragma unroll
      for (int j = 0; j < 2; ++j) { bool hi = lane & 2; float keep = hi ? q4[2*j+1] : q4[2*j], send = hi ? q4[2*j] : q4[2*j+1]; q2[j] = keep + __shfl_xor(send, 2); }
      { bool hi = lane & 4; float keep = hi ? q2[1] : q2[0], send = hi ? q2[0] : q2[1]; q1 = keep + __shfl_xor(send, 4); }
      q1 += __shfl_xor(q1, 8); q1 += __shfl_xor(q1, 16); q1 += __shfl_xor(q1, 32);
      if (lane < 8) pw[b * 8 + lane] = q1 * su[pe[b * 8 + lane]];
    }
    u32x4 v[8];
#pragma unroll
    for (int j = 0; j < 8; ++j) v[j] = *(const u32x4*)(vb + (long)pe[j] * DM + lane * 16);
    {
      float d0 = pw[lane], d1 = pw[64 + lane];
      pw[lane] = pg_l[tl * 128 + lane] * fgelu_(d0) * sv[pe[lane]]; pw[64 + lane] = pg_l[tl * 128 + 64 + lane] * fgelu_(d1) * sv[pe[64 + lane]];
    }
    float o[16];
#pragma unroll
    for (int e = 0; e < 16; ++e) o[e] = 0.f;
    for (int b = 0; b < 16; ++b) {
      u32x4 vc[8];
#pragma unroll
      for (int j = 0; j < 8; ++j) vc[j] = v[j];
      if (b + 1 < 16) {
#pragma unroll
        for (int j = 0; j < 8; ++j) v[j] = *(const u32x4*)(vb + (long)pe[(b + 1) * 8 + j] * DM + lane * 16);
      }
#pragma unroll
      for (int j = 0; j < 8; ++j) axpy16_fp8(o, pw[b * 8 + j], vc[j]);
    }
    {
      int b = row / RB, lr = row % RB; int bb = lr < SEQ ? b : BATCH; const float* g5 = modl + ((long)bb * 6 + 5) * DM + lane * 16;
      float* xr = xs + row * DM + lane * 16;
#pragma unroll
      for (int i = 0; i < 4; ++i) {
        f32x4 x = *(f32x4*)(xr + 4 * i); f32x4 g = *(const f32x4*)(g5 + 4 * i);
        x[0] += g[0] * o[4*i]; x[1] += g[1] * o[4*i+1]; x[2] += g[2] * o[4*i+2]; x[3] += g[3] * o[4*i+3];
        *(f32x4*)(xr + 4 * i) = x;
      }
    }
  }
}

__device__ __forceinline__ float reduce16(float x) { x = reduce8(x); x += dpp_get<0x140>(x); return x; }
__device__ __forceinline__ void unpack8(u32x4 v, float (&f)[8]) {
#pragma unroll
  for (int e = 0; e < 4; ++e) { f[2*e] = __uint_as_float(v[e] << 16); f[2*e+1] = __uint_as_float(v[e] & 0xffff0000u); }
}
__device__ __forceinline__ u32x4 pack8(const float (&f)[8]) { u32x4 o;
#pragma unroll
  for (int e = 0; e < 4; ++e) o[e] = pack2bf(f[2*e], f[2*e+1]);
  return o; }
__device__ __forceinline__ void ph_rope_tables(float* rope_g, float* rope_m) {
  const int t = tid_opaque();
  for (int i = blockIdx.x * 256 + t; i < SEQ * 48; i += gridDim.x * 256) {
    int lr = i / 48, j = i % 48;
    if (j < 32) { int pos = j < 16 ? lr / 64 : lr % 64; float ang = (float)pos * powf(10000.f, -(float)(j & 15) / 16.f); rope_g[(lr * 32 + j) * 2] = cosf(ang); rope_g[(lr * 32 + j) * 2 + 1] = sinf(ang); }
    else { int jj = j - 32; int pos = jj < 8 ? lr / 64 : lr % 64; float ang = (float)pos * powf(10000.f, -(float)(jj & 7) / 8.f); rope_m[(lr * 16 + jj) * 2] = cosf(ang); rope_m[(lr * 16 + jj) * 2 + 1] = sinf(ang); }
  }
}
struct FinW2 { const float *mla_qk_g, *gqa_qk_g, *mu, *k_k, *k_a, *rope_g, *rope_m; };
#define FIN2_LDS_BYTES (64 * 384 * 2)
__device__ __forceinline__ void prep_finish_tile2(const FinW2& W, const FinBuf& B, int tile, char* smem) {
  const int t = tid_opaque(), lane = t & 63, wave = t >> 6; const long MA = NROWS;
  bf16_t* vbuf = (bf16_t*)smem;
  const long row0 = (long)tile * 8; const int b = row0 / RB; const int lr0 = row0 % RB;
  const int g8 = lane & 7, h8 = lane >> 3, s16 = lane & 15, h16 = lane >> 4;
  for (int it = 0; it < 2; ++it) {
    const int rl = it * 4 + wave; const long row = row0 + rl; const int lr = lr0 + rl; const bool lat = lr < SEQ;
    const bf16_t* Pr = B.P + row * IN_COLS;
    {
      float x[8]; unpack8(*(const u32x4*)(Pr + GQA_OFF + lane * 8), x);
      float ss = 0.f;
#pragma unroll
      for (int e = 0; e < 8; ++e) ss += x[e] * x[e];
      ss = reduce8(ss); const float inv = __builtin_amdgcn_rsqf(ss * (1.f / 64.f) + EPSN);
      const float* gp = W.gqa_qk_g + (h8 < 6 ? 0 : 64) + g8 * 8; f32x4 ga = *(const f32x4*)gp, gb = *(const f32x4*)(gp + 4);
#pragma unroll
      for (int e = 0; e < 4; ++e) { x[e] *= inv * ga[e]; x[4 + e] *= inv * gb[e]; }
      float o[8];
      if (lat) {
        const float* rt = W.rope_g + ((long)lr * 32 + (g8 & 3) * 8) * 2;
#pragma unroll
        for (int e = 0; e < 8; ++e) { float ot = swz_xor4(x[e]); float cs = rt[2 * e], sn = rt[2 * e + 1]; o[e] = (g8 & 4) ? (ot * sn + x[e] * cs) : (x[e] * cs - ot * sn); }
      } else {
#pragma unroll
        for (int e = 0; e < 8; ++e) o[e] = x[e];
      }
      if (h8 < 6) {
#pragma unroll
        for (int e = 0; e < 8; ++e) o[e] *= 0.18033688f;
        *(u32x4*)(B.gq + row * 384 + lane * 8) = pack8(o);
      } else *(u32x4*)(B.gk + row * 128 + (lane - 48) * 8) = pack8(o);
    }
    float cq, ckv;
    {
      float ss = 0.f;
      if (lane < 48) { float x[8]; unpack8(*(const u32x4*)(Pr + lane * 8), x);
#pragma unroll
        for (int e = 0; e < 8; ++e) ss += x[e] * x[e]; }
      float sq = wave_sum(lane < 32 ? ss : 0.f), skv = wave_sum(lane >= 32 ? ss : 0.f);
      cq = __builtin_amdgcn_rsqf(sq * (1.f / 256.f) + EPSN); ckv = __builtin_amdgcn_rsqf(skv * (1.f / 128.f) + EPSN);
    }
    {
      float cs0 = 1.f, sn0 = 0.f, cs1 = 1.f, sn1 = 0.f;
      if (lat) { f32x4 r4 = *(const f32x4*)(W.rope_m + ((long)lr * 16 + (s16 & 7) * 2) * 2); cs0 = r4[0]; sn0 = r4[1]; cs1 = r4[2]; sn1 = r4[3]; }
      const float kr0 = bf2f(Pr[384 + s16 * 2]), kr1 = bf2f(Pr[384 + s16 * 2 + 1]);
#pragma unroll
      for (int which = 0; which < 2; ++which) {
        float n[4], r0, r1;
        if (which == 0) {
          uint2 a = *(const uint2*)(B.tq + row * 384 + h16 * 96 + s16 * 4); unsigned rr = *(const unsigned*)(B.tq + row * 384 + h16 * 96 + 64 + s16 * 2);
          n[0] = cq * __uint_as_float(a.x << 16); n[1] = cq * __uint_as_float(a.x & 0xffff0000u); n[2] = cq * __uint_as_float(a.y << 16); n[3] = cq * __uint_as_float(a.y & 0xffff0000u);
          r0 = cq * __uint_as_float(rr << 16); r1 = cq * __uint_as_float(rr & 0xffff0000u);
        } else {
          uint2 a = *(const uint2*)(B.tkv + row * 512 + h16 * 128 + s16 * 4);
          n[0] = ckv * __uint_as_float(a.x << 16); n[1] = ckv * __uint_as_float(a.x & 0xffff0000u); n[2] = ckv * __uint_as_float(a.y << 16); n[3] = ckv * __uint_as_float(a.y & 0xffff0000u);
          r0 = kr0; r1 = kr1;
        }
        float ss = n[0]*n[0] + n[1]*n[1] + n[2]*n[2] + n[3]*n[3] + r0*r0 + r1*r1;
        ss = reduce16(ss); const float inv = __builtin_amdgcn_rsqf(ss * (1.f / 96.f) + EPSN);
        const float* gp = W.mla_qk_g + which * 96; f32x4 gn = *(const f32x4*)(gp + s16 * 4); const float g0 = gp[64 + s16 * 2], g1 = gp[64 + s16 * 2 + 1];
#pragma unroll
        for (int e = 0; e < 4; ++e) n[e] *= inv * gn[e];
        r0 *= inv * g0; r1 *= inv * g1;
        float o0 = dpp_get<0x128>(r0), o1 = dpp_get<0x128>(r1);
        float q0, q1;
        if (s16 & 8) { q0 = o0 * sn0 + r0 * cs0; q1 = o1 * sn1 + r1 * cs1; } else { q0 = r0 * cs0 - o0 * sn0; q1 = r1 * cs1 - o1 * sn1; }
        const float sc = which == 0 ? 0.14724445f : 1.f;
        bf16_t* dst = (which == 0 ? B.mq : B.mk) + row * 384 + h16 * 96;
        uint2 pk; pk.x = pack2bf(n[0] * sc, n[1] * sc); pk.y = pack2bf(n[2] * sc, n[3] * sc);
        *(uint2*)(dst + s16 * 4) = pk; *(unsigned*)(dst + 64 + s16 * 2) = pack2bf(q0 * sc, q1 * sc);
      }
      if (lane < 32) { float x[8]; unpack8(*(const u32x4*)(B.tkv + row * 512 + h8 * 128 + 64 + g8 * 8), x);
#pragma unroll
        for (int e = 0; e < 8; ++e) x[e] *= ckv;
        *(u32x4*)(vbuf + rl * 384 + h8 * 64 + g8 * 8) = pack8(x); }
      else if (lane < 48) *(u32x4*)(vbuf + rl * 384 + 256 + (lane - 32) * 8) = *(const u32x4*)(Pr + GQA_OFF + 512 + (lane - 32) * 8);
    }
    if (lane < 48) {
      const bool first = (lr == 0) || (lr == SEQ), last = (lr == SEQ - 1) || (lr == RB - 1);
      const long o = row * 384 + lane * 8;
      float xs3[3][8];
#pragma unroll
      for (int part = 0; part < 3; ++part) {
        const int c = part * 384 + lane * 8; const bf16_t* pp = Pr + RW_OFF + c;
        float p[8], pv[8], nx[8]; unpack8(*(const u32x4*)pp, p);
        u32x4 z = {0u, 0u, 0u, 0u}; unpack8(first ? z : *(const u32x4*)(pp - IN_COLS), pv); unpack8(last ? z : *(const u32x4*)(pp + IN_COLS), nx);
        f32x4 m0a = *(const f32x4*)(W.mu + c), m0b = *(const f32x4*)(W.mu + c + 4), m1a = *(const f32x4*)(W.mu + RWC + c), m1b = *(const f32x4*)(W.mu + RWC + c + 4);
#pragma unroll
        for (int e = 0; e < 4; ++e) { xs3[part][e] = p[e] + m0a[e] * (pv[e] - p[e]) + m1a[e] * (nx[e] - p[e]); xs3[part][4+e] = p[4+e] + m0b[e] * (pv[4+e] - p[4+e]) + m1b[e] * (nx[4+e] - p[4+e]); }
      }
      *(u32x4*)(B.r_b + o) = pack8(xs3[0]); *(u32x4*)(B.v_b + o) = pack8(xs3[2]);
      f32x4 kka = *(const f32x4*)(W.k_k + lane * 8), kkb = *(const f32x4*)(W.k_k + lane * 8 + 4), kaa = *(const f32x4*)(W.k_a + lane * 8), kab = *(const f32x4*)(W.k_a + lane * 8 + 4);
      float tk[8], ss = 0.f;
#pragma unroll
      for (int e = 0; e < 4; ++e) { tk[e] = xs3[1][e] * kka[e]; tk[4+e] = xs3[1][4+e] * kkb[e]; }
#pragma unroll
      for (int e = 0; e < 8; ++e) ss += tk[e] * tk[e];
      ss = reduce8(ss); const float invk = __builtin_amdgcn_rsqf(ss + 1e-12f);
#pragma unroll
      for (int e = 0; e < 8; ++e) tk[e] *= invk;
      *(u32x4*)(B.kk_b + o) = pack8(tk);
#pragma unroll
      for (int d = 0; d < 2; ++d) {
        float a[8], kd[8], bd[8]; unpack8(*(const u32x4*)(B.a_b + d * MA * 384 + o), a);
#pragma unroll
        for (int e = 0; e < 8; ++e) { float ka = e < 4 ? kaa[e] : kab[e - 4]; kd[e] = xs3[1][e] * (1.f + (a[e] - 1.f) * ka); bd[e] = tk[e] * a[e]; }
        *(u32x4*)(B.kd_b + d * MA * 384 + o) = pack8(kd); *(u32x4*)(B.bd_b + d * MA * 384 + o) = pack8(bd);
      }
    } else { (void)reduce8(0.f); }
  }
  __syncthreads();
  for (int i = t; i < 384; i += 256) {
    int c = i % 384, rc = i / 384;
    unsigned short v8[8];
#pragma unroll
    for (int e = 0; e < 8; ++e) v8[e] = vbuf[(rc * 8 + e) * 384 + c];
    u32x4 o; o[0] = v8[0] | ((unsigned)v8[1] << 16); o[1] = v8[2] | ((unsigned)v8[3] << 16); o[2] = v8[4] | ((unsigned)v8[5] << 16); o[3] = v8[6] | ((unsigned)v8[7] << 16);
    bf16_t* dst = c < 256 ? B.mvT + ((long)(b * 4 + (c >> 6)) * 64 + (c & 63)) * RB : B.gvT + ((long)(b * 2 + ((c - 256) >> 6)) * 64 + (c & 63)) * RB;
    *(u32x4*)(dst + lr0 + rc * 8) = o;
  }
  __syncthreads();
}
__device__ __forceinline__ void rw_readout_row2(const RdW& W, const float* __restrict__ y, const bf16_t* __restrict__ r_b, const bf16_t* __restrict__ v_b, const bf16_t* __restrict__ kd_b,
                                                const bf16_t* __restrict__ g_b, bf16_t* __restrict__ mixall, long row, int lane) {
  const long MA = NROWS;
  float yy[8], s = 0.f; float r[8], k0[8], k1[8], vv[8], gg[8];
  const int c = lane * 8; const long o = row * 384 + c;
  if (lane < 48) {
    f32x4 a0 = *(const f32x4*)(y + o), a1 = *(const f32x4*)(y + o + 4), b0 = *(const f32x4*)(y + MA * 384 + o), b1 = *(const f32x4*)(y + MA * 384 + o + 4);
#pragma unroll
    for (int e = 0; e < 4; ++e) { yy[e] = a0[e] + b0[e]; yy[4+e] = a1[e] + b1[e]; }
    unpack8(*(const u32x4*)(r_b + o), r); unpack8(*(const u32x4*)(kd_b + o), k0); unpack8(*(const u32x4*)(kd_b + MA * 384 + o), k1);
    unpack8(*(const u32x4*)(v_b + o), vv); unpack8(*(const u32x4*)(g_b + o), gg);
  } else {
#pragma unroll
    for (int e = 0; e < 8; ++e) { yy[e] = 0.f; r[e] = 0.f; k0[e] = 0.f; k1[e] = 0.f; vv[e] = 0.f; gg[e] = 0.f; }
  }
#pragma unroll
  for (int e = 0; e < 8; ++e) s += yy[e];
  const float mean = reduce8(s) * (1.f / 64.f);
  float vs = 0.f, cf = 0.f;
  const int cc = lane < 48 ? c : 0;
  f32x4 rk0 = *(const f32x4*)(W.r_k + cc), rk1 = *(const f32x4*)(W.r_k + cc + 4);
#pragma unroll
  for (int e = 0; e < 8; ++e) { float d = yy[e] - mean; vs += d * d; cf += r[e] * (k0[e] + k1[e]) * (e < 4 ? rk0[e] : rk1[e - 4]); }
  const float var = reduce8(vs) * (1.f / 64.f), coef = reduce8(cf);
  const float inv = __builtin_amdgcn_rsqf(var + 64e-5f);
  if (lane < 48) {
    f32x4 lg0 = *(const f32x4*)(W.ln_g + c), lg1 = *(const f32x4*)(W.ln_g + c + 4), lb0 = *(const f32x4*)(W.ln_b + c), lb1 = *(const f32x4*)(W.ln_b + c + 4);
    float out[8];
#pragma unroll
    for (int e = 0; e < 8; ++e) { float yn = (yy[e] - mean) * inv * (e < 4 ? lg0[e] : lg1[e - 4]) + (e < 4 ? lb0[e] : lb1[e - 4]); out[e] = (yn + coef * vv[e]) * gg[e]; }
    *(u32x4*)(mixall + row * DM + 256 + c) = pack8(out);
  }
}

#define PG_NT 4
#define PG_TOK (4 * PG_NT)
#define PG_OFF_H 0
#define PG_OFF_E (PG_TOK * 2048)
#define PG_OFF_G (PG_OFF_E + PG_TOK * 128 * 2)
#define PG_OFF_ST (PG_OFF_G + PG_TOK * 128 * 4)
#define PG_OFF_CNT (PG_OFF_ST + PG_TOK * 18 * 2)
#define PG_LDS_BYTES (PG_OFF_CNT + PG_TOK * 8 * 16 * 2)
__device__ __forceinline__ long pg_row(int g, int ntok) { return ntok == NROWS ? (long)g : (long)(g / SEQ) * RB + (g % SEQ); }
__device__ __forceinline__ void peer_gather_sliced(const bf16_t* __restrict__ xn, const unsigned* __restrict__ top1, const unsigned char* __restrict__ ub, const float* __restrict__ su,
                                                   const unsigned char* __restrict__ vb, const float* __restrict__ sv, const float* __restrict__ modl, float* __restrict__ xs,
                                                   int ntok, char* smem, const float* __restrict__ ng, const float* __restrict__ nmod, bf16_t* __restrict__ xn_next, float* __restrict__ out, bool dry = false, unsigned emask = 0x3FFFu) {
  bf16_t* hs = (bf16_t*)(smem + PG_OFF_H); unsigned short* se = (unsigned short*)(smem + PG_OFF_E); float* sg = (float*)(smem + PG_OFF_G);
  unsigned short* sst = (unsigned short*)(smem + PG_OFF_ST); unsigned short* cnt = (unsigned short*)(smem + PG_OFF_CNT);
  const int per_block = (ntok + (int)gridDim.x - 1) / (int)gridDim.x;
  const int npass = (per_block + PG_TOK - 1) / PG_TOK; const int tpp = (per_block + npass - 1) / npass;
  for (int pass = 0; pass < npass; ++pass) {
    const int t = tid_opaque(), lane = t & 63, wave = t >> 6;
    __syncthreads();
    for (int i = t; i < PG_TOK * 8 * 16; i += 256) cnt[i] = 0;
    for (int i = t; i < PG_TOK * 128; i += 256) {
      int tl = i >> 7, ch = i & 127; int q = (tl % PG_NT) * 4 + tl / PG_NT; int idx = pass * tpp + q; int g = (int)blockIdx.x + idx * (int)gridDim.x;
      u32x4 v = {0u, 0u, 0u, 0u};
      if (q < tpp && idx < per_block && g < ntok) v = *(const u32x4*)(xn + pg_row(g, ntok) * DM + ch * 8);
      *(u32x4*)(hs + tl * 1024 + ch * 8) = v;
    }
    __syncthreads();
    int my_e[16]; float my_g[16];
    const int ctl = t >> 3, cp = t & 7;
    bool cact = false;
    if (ctl < PG_TOK) {
      int q = (ctl % PG_NT) * 4 + ctl / PG_NT; int idx = pass * tpp + q; int g = (int)blockIdx.x + idx * (int)gridDim.x;
      cact = q < tpp && idx < per_block && g < ntok;
      if (cact) {
        long row = pg_row(g, ntok);
        peer_combine(top1 + (row * 16 + cp * 2) * 16, top1 + (row * 16 + cp * 2 + 1) * 16, my_e, my_g);
#pragma unroll
        for (int k = 0; k < 16; ++k) cnt[(ctl * 8 + cp) * 16 + (my_e[k] >> 10)] += 1;
      }
    }
    __syncthreads();
    if (t < PG_TOK) {
      int run = 0;
      for (int s = 0; s < 16; ++s) {
        sst[t * 18 + s] = (unsigned short)run;
        for (int h = 0; h < 8; ++h) { int c = cnt[(t * 8 + h) * 16 + s]; cnt[(t * 8 + h) * 16 + s] = (unsigned short)run; run += c; }
      }
      sst[t * 18 + 16] = (unsigned short)run;
    }
    __syncthreads();
    if (cact) {
#pragma unroll
      for (int k = 0; k < 16; ++k) { int s = my_e[k] >> 10; int pos = cnt[(ctl * 8 + cp) * 16 + s]; cnt[(ctl * 8 + cp) * 16 + s] = (unsigned short)(pos + 1); se[ctl * 128 + pos] = (unsigned short)my_e[k]; sg[ctl * 128 + pos] = my_g[k]; }
    }
    __syncthreads();
    float acc[PG_NT][16];
#pragma unroll
    for (int tk = 0; tk < PG_NT; ++tk)
#pragma unroll
      for (int e = 0; e < 16; ++e) acc[tk][e] = 0.f;
    for (int s = 0; s < 16; ++s) {
#pragma unroll
      for (int tk = 0; tk < PG_NT; ++tk) {
        const int tl = wave * PG_NT + tk;
        const int st = sst[tl * 18 + s], en = sst[tl * 18 + s + 1];
        for (int base = st; base < en; base += 8) {
          const int nb = en - base < 8 ? en - base : 8;
          u32x4 u[8], v[8];
#pragma unroll
          for (int j = 0; j < 8; ++j) if (j < nb) { const unsigned off = ((unsigned)se[tl * 128 + base + j] & emask) * 1024u + (unsigned)lane * 16u; u[j] = *(const u32x4*)(ub + off); v[j] = *(const u32x4*)(vb + off); }
          float h[16];
          { u32x4 h0 = *(const u32x4*)(hs + tl * 1024 + lane * 16), h1 = *(const u32x4*)(hs + tl * 1024 + lane * 16 + 8);
#pragma unroll
            for (int e = 0; e < 4; ++e) { h[2*e] = __uint_as_float(h0[e] << 16); h[2*e+1] = __uint_as_float(h0[e] & 0xffff0000u); h[8+2*e] = __uint_as_float(h1[e] << 16); h[8+2*e+1] = __uint_as_float(h1[e] & 0xffff0000u); } }
          float pd[8];
#pragma unroll
          for (int j = 0; j < 8; ++j) pd[j] = j < nb ? dot16_fp8(h, u[j]) : 0.f;
          float q4[4], q2[2], q1;
#pragma unroll
          for (int j = 0; j < 4; ++j) { bool hi = lane & 1; float keep = hi ? pd[2*j+1] : pd[2*j], send = hi ? pd[2*j] : pd[2*j+1]; q4[j] = keep + dpp_get<0xB1>(send); }
#pragma unroll
          for (int j = 0; j < 2; ++j) { bool hi = lane & 2; float keep = hi ? q4[2*j+1] : q4[2*j], send = hi ? q4[2*j] : q4[2*j+1]; q2[j] = keep + dpp_get<0x4E>(send); }
          { bool hi = lane & 4; float keep = hi ? q2[1] : q2[0], send = hi ? q2[0] : q2[1]; q1 = keep + xor4_get(send); }
          q1 += dpp_get<0x128>(q1);
          q1 = xor16_sum(q1);
          q1 = xor32_sum(q1);
          float w = 0.f;
          { const int jj = lane & 7; if (jj < nb) { int e = se[tl * 128 + base + jj]; w = sg[tl * 128 + base + jj] * fgelu_(q1 * su[e]) * sv[e]; } }
#pragma unroll
          for (int j = 0; j < 8; ++j) { float wj = __builtin_bit_cast(float, __builtin_amdgcn_readlane(__builtin_bit_cast(int, w), j)); if (j < nb) axpy16_fp8(acc[tk], wj, v[j]); }
        }
      }
    }
    if (dry) {
#pragma unroll
      for (int tk = 0; tk < PG_NT; ++tk)
#pragma unroll
        for (int e = 0; e < 16; ++e) asm volatile("" :: "v"(acc[tk][e]));
    }
#pragma unroll
    for (int tk = 0; tk < PG_NT; ++tk) {
      int q = tk * 4 + wave; int idx = pass * tpp + q; int g = (int)blockIdx.x + idx * (int)gridDim.x;
      if (!dry && q < tpp && idx < per_block && g < ntok) {
        long row = pg_row(g, ntok); int b = row / RB, lr = row % RB; int bb = lr < SEQ ? b : BATCH; const float* g5 = modl + ((long)bb * 6 + 5) * DM + lane * 16;
        float* xr = xs + row * DM + lane * 16;
        f32x4 xv[4]; float ss = 0.f;
#pragma unroll
        for (int i = 0; i < 4; ++i) {
          f32x4 x = *(f32x4*)(xr + 4 * i); f32x4 gg = *(const f32x4*)(g5 + 4 * i);
          x[0] += gg[0] * acc[tk][4*i]; x[1] += gg[1] * acc[tk][4*i+1]; x[2] += gg[2] * acc[tk][4*i+2]; x[3] += gg[3] * acc[tk][4*i+3];
          xv[i] = x; ss += x[0] * x[0] + x[1] * x[1] + x[2] * x[2] + x[3] * x[3];
        }
        if (out) {
          float* orow = out + ((long)b * SEQ + lr) * DM + lane * 16;
#pragma unroll
          for (int i = 0; i < 4; ++i) *(f32x4*)(orow + 4 * i) = xv[i];
        } else {
#pragma unroll
          for (int i = 0; i < 4; ++i) *(f32x4*)(xr + 4 * i) = xv[i];
          ss = wave_sum(ss); const float inv = __builtin_amdgcn_rsqf(ss * (1.f / DM) + EPSN);
          const float* sh = nmod + ((long)bb * 6 + 0) * DM + lane * 16; const float* sc = sh + DM; const float* gp = ng + lane * 16;
          u32x4 p0, p1;
#pragma unroll
          for (int i = 0; i < 4; ++i) { f32x4 g4 = *(const f32x4*)(gp + 4 * i), s4 = *(const f32x4*)(sc + 4 * i), h4 = *(const f32x4*)(sh + 4 * i);
            const float a0 = xv[i][0] * inv * g4[0] * (1.f + s4[0]) + h4[0], a1 = xv[i][1] * inv * g4[1] * (1.f + s4[1]) + h4[1];
            const float a2 = xv[i][2] * inv * g4[2] * (1.f + s4[2]) + h4[2], a3 = xv[i][3] * inv * g4[3] * (1.f + s4[3]) + h4[3];
            if (i < 2) { p0[2 * i] = pack2bf(a0, a1); p0[2 * i + 1] = pack2bf(a2, a3); } else { p1[2 * (i - 2)] = pack2bf(a0, a1); p1[2 * (i - 2) + 1] = pack2bf(a2, a3); } }
          *(u32x4*)(xn_next + row * DM + lane * 16) = p0; *(u32x4*)(xn_next + row * DM + lane * 16 + 8) = p1;
        }
      }
    }
  }
}

#define PG3_OFF_H 0
#define PG3_OFF_FE (12 * 2048)
#define PG3_OFF_FG (PG3_OFF_FE + 4 * 384 * 2)
#define PG3_OFF_FS (PG3_OFF_FG + 4 * 384 * 4)
#define PG3_OFF_BT (PG3_OFF_FS + 4 * 384 * 4)
#define PG3_OFF_CNT (PG3_OFF_BT + 4 * 160 * 4)
#define PG3_OFF_TOT (PG3_OFF_CNT + 4 * 512 * 2)
#define PG3_LDS_BYTES (PG3_OFF_TOT + 512)
#define PG3_REC_BYTES (384 * 2 + 384 * 4 + 384 * 4 + 160 * 4 + 16)
__device__ __forceinline__ void peer_lists_build3(const unsigned* __restrict__ top1, const float* __restrict__ su, const float* __restrict__ sv, char* __restrict__ gl, int ntok, char* smem) {
  unsigned short* fe = (unsigned short*)(smem + PG3_OFF_FE); float* fg = (float*)(smem + PG3_OFF_FG); float* fs = (float*)(smem + PG3_OFF_FS);
  unsigned* bt = (unsigned*)(smem + PG3_OFF_BT); unsigned short* cnt = (unsigned short*)(smem + PG3_OFF_CNT); unsigned short* tot = (unsigned short*)(smem + PG3_OFF_TOT);
  int* nbt = (int*)(smem + PG3_OFF_TOT + 320);
  const int per_block = (ntok + (int)gridDim.x - 1) / (int)gridDim.x;
  const int npass = (per_block + 11) / 12; const int tpp = (per_block + npass - 1) / npass;
  for (int pass = 0; pass < npass; ++pass) {
    const int t = tid_opaque();
    __syncthreads();
    for (int i = t; i < 4 * 512; i += 256) cnt[i] = 0;
    __syncthreads();
    int my_e[16]; float my_g[16];
    const int ctl = t >> 3, cp = t & 7; const int cw = ctl / 3, ctk = ctl % 3;
    bool cact = false;
    if (ctl < 12) {
      int q = ctk * 4 + cw; int idx = pass * tpp + q; int g = (int)blockIdx.x + idx * (int)gridDim.x;
      cact = q < tpp && idx < per_block && g < ntok;
      if (cact) {
        long row = pg_row(g, ntok);
        peer_combine(top1 + (row * 16 + cp * 2) * 16, top1 + (row * 16 + cp * 2 + 1) * 16, my_e, my_g);
#pragma unroll
        for (int k = 0; k < 16; ++k) cnt[((cw * 16 + (my_e[k] >> 10)) * 4 + ctk) * 8 + cp] += 1;
      }
    }
    __syncthreads();
    unsigned short* tot2 = tot + 80;
    if (t < 64) {
      int w_ = t >> 4, s = t & 15; int ne = 0, nbk = 0;
      for (int tk = 0; tk < 3; ++tk) { int n = 0; for (int h = 0; h < 8; ++h) n += cnt[((w_ * 16 + s) * 4 + tk) * 8 + h]; ne += n; nbk += (n + 7) >> 3; }
      tot[w_ * 16 + s] = (unsigned short)ne; tot2[w_ * 16 + s] = (unsigned short)nbk;
    }
    __syncthreads();
    if (t < 64) {
      int w_ = t >> 4, s = t & 15; int run = 0, nb_ = 0;
      for (int i = 0; i < s; ++i) { run += tot[w_ * 16 + i]; nb_ += tot2[w_ * 16 + i]; }
      for (int tk = 0; tk < 3; ++tk) {
        int gstart = run;
        for (int h = 0; h < 8; ++h) { int ci = ((w_ * 16 + s) * 4 + tk) * 8 + h; int c = cnt[ci]; cnt[ci] = (unsigned short)run; run += c; }
        for (int b0 = gstart; b0 < run; b0 += 8) { int n = run - b0 < 8 ? run - b0 : 8; bt[w_ * 160 + nb_] = (unsigned)tk | ((unsigned)b0 << 4) | ((unsigned)n << 16); ++nb_; }
      }
      if (s == 15) { while (nb_ % 3) { bt[w_ * 160 + nb_] = 0u; ++nb_; } nbt[w_] = nb_; }
    }
    __syncthreads();
    if (cact) {
#pragma unroll
      for (int k = 0; k < 16; ++k) { int ci = ((cw * 16 + (my_e[k] >> 10)) * 4 + ctk) * 8 + cp; int pos = cnt[ci]; cnt[ci] = (unsigned short)(pos + 1);
        fe[cw * 384 + pos] = (unsigned short)my_e[k]; fg[cw * 384 + pos] = my_g[k] * sv[my_e[k]]; fs[cw * 384 + pos] = su[my_e[k]]; }
    }
    __syncthreads();
    char* rec = gl + ((long)blockIdx.x * 4 + pass) * 4 * PG3_REC_BYTES;
    for (int i = t; i < 4 * 48; i += 256) { int w_ = i / 48, c = i % 48; *(u32x4*)(rec + w_ * PG3_REC_BYTES + c * 16) = *(const u32x4*)((const char*)fe + w_ * 768 + c * 16); }
    for (int i = t; i < 4 * 96; i += 256) { int w_ = i / 96, c = i % 96; *(u32x4*)(rec + w_ * PG3_REC_BYTES + 768 + c * 16) = *(const u32x4*)((const char*)fg + w_ * 1536 + c * 16); }
    for (int i = t; i < 4 * 96; i += 256) { int w_ = i / 96, c = i % 96; *(u32x4*)(rec + w_ * PG3_REC_BYTES + 2304 + c * 16) = *(const u32x4*)((const char*)fs + w_ * 1536 + c * 16); }
    for (int i = t; i < 4 * 40; i += 256) { int w_ = i / 40, c = i % 40; *(u32x4*)(rec + w_ * PG3_REC_BYTES + 3840 + c * 16) = *(const u32x4*)((const char*)bt + w_ * 640 + c * 16); }
    if (t < 4) *(int*)(rec + t * PG3_REC_BYTES + 4480) = nbt[t];
  }
  __syncthreads();
}
__device__ __forceinline__ void pg3_issue(u32x4 (&B)[8], const unsigned char* __restrict__ tab, const unsigned short* we, unsigned desc, int lane) {
  const int base = (desc >> 4) & 0xFFF, nb = desc >> 16;
#pragma unroll
  for (int j = 0; j < 8; ++j) { const int jj = j < nb ? j : (nb > 0 ? nb - 1 : 0); const unsigned off = (unsigned)we[base + jj] * 1024u + (unsigned)lane * 16u; B[j] = *(const u32x4*)(tab + off); }
}
__device__ __forceinline__ void pg3_axpy8(float (&a)[16], const u32x4 (&V)[8], float w, int nb) {
#pragma unroll
  for (int j = 0; j < 8; ++j) { const float wj = __builtin_bit_cast(float, __builtin_amdgcn_readlane(__builtin_bit_cast(int, w), j)); if (j < nb) axpy16_fp8(a, wj, V[j]); }
}
__device__ __forceinline__ void pg3_step(u32x4 (&U)[8], u32x4 (&V)[8], u32x4 (&F)[8], int k, int nbat, float (&acc)[3][16],
                                         const unsigned char* __restrict__ ub, const unsigned char* __restrict__ vb,
                                         const unsigned short* we, const float* wg, const float* wsc, const unsigned* wb, const bf16_t* hw, int lane) {
  const unsigned desc = __builtin_amdgcn_readfirstlane(wb[k]);
  const int tk = desc & 15, base = (desc >> 4) & 0xFFF, nb = desc >> 16;
  const unsigned dnext = __builtin_amdgcn_readfirstlane(wb[k + 1 < nbat ? k + 1 : k]);
  pg3_issue(F, ub, we, dnext, lane);
  float h[16];
  { const bf16_t* hp = hw + tk * 1024 + lane * 16; u32x4 h0 = *(const u32x4*)hp, h1 = *(const u32x4*)(hp + 8);
#pragma unroll
    for (int e = 0; e < 4; ++e) { h[2*e] = __uint_as_float(h0[e] << 16); h[2*e+1] = __uint_as_float(h0[e] & 0xffff0000u); h[8+2*e] = __uint_as_float(h1[e] << 16); h[8+2*e+1] = __uint_as_float(h1[e] & 0xffff0000u); } }
  float pd[8];
#pragma unroll
  for (int j = 0; j < 8; ++j) pd[j] = j < nb ? dot16_fp8(h, U[j]) : 0.f;
  pg3_issue(U, vb, we, dnext, lane);
  float q4[4], q2[2], q1;
#pragma unroll
  for (int j = 0; j < 4; ++j) { bool hi = lane & 1; float keep = hi ? pd[2*j+1] : pd[2*j], send = hi ? pd[2*j] : pd[2*j+1]; q4[j] = keep + dpp_get<0xB1>(send); }
#pragma unroll
  for (int j = 0; j < 2; ++j) { bool hi = lane & 2; float keep = hi ? q4[2*j+1] : q4[2*j], send = hi ? q4[2*j] : q4[2*j+1]; q2[j] = keep + dpp_get<0x4E>(send); }
  { bool hi = lane & 4; float keep = hi ? q2[1] : q2[0], send = hi ? q2[0] : q2[1]; q1 = keep + xor4_get(send); }
  q1 += dpp_get<0x128>(q1);
  q1 = xor16_sum(q1);
  q1 = xor32_sum(q1);
  float w = 0.f;
  { const int jj = lane & 7; if (jj < nb) w = wg[base + jj] * fgelu_(q1 * wsc[base + jj]); }
  if (tk == 0) pg3_axpy8(acc[0], V, w, nb); else if (tk == 1) pg3_axpy8(acc[1], V, w, nb); else pg3_axpy8(acc[2], V, w, nb);
}
__device__ __forceinline__ void peer_gather_sweep3(const bf16_t* __restrict__ xn, const char* __restrict__ gl, const unsigned char* __restrict__ ub,
                                                   const unsigned char* __restrict__ vb, const float* __restrict__ modl, float* __restrict__ xs, int ntok, char* smem,
                                                   const float* __restrict__ ng, const float* __restrict__ nmod, bf16_t* __restrict__ xn_next, float* __restrict__ out) {
  bf16_t* hs = (bf16_t*)(smem + PG3_OFF_H); unsigned short* fe = (unsigned short*)(smem + PG3_OFF_FE); float* fg = (float*)(smem + PG3_OFF_FG); float* fs = (float*)(smem + PG3_OFF_FS);
  unsigned* bt = (unsigned*)(smem + PG3_OFF_BT); int* nbt = (int*)(smem + PG3_OFF_TOT + 320);
  const int per_block = (ntok + (int)gridDim.x - 1) / (int)gridDim.x;
  const int npass = (per_block + 11) / 12; const int tpp = (per_block + npass - 1) / npass;
  for (int pass = 0; pass < npass; ++pass) {
    {
      const int t = tid_opaque();
      __syncthreads();
      const char* rec = gl + ((long)blockIdx.x * 4 + pass) * 4 * PG3_REC_BYTES;
      for (int i = t; i < 4 * 48; i += 256) { int w_ = i / 48, c = i % 48; *(u32x4*)((char*)fe + w_ * 768 + c * 16) = *(const u32x4*)(rec + w_ * PG3_REC_BYTES + c * 16); }
      for (int i = t; i < 4 * 96; i += 256) { int w_ = i / 96, c = i % 96; *(u32x4*)((char*)fg + w_ * 1536 + c * 16) = *(const u32x4*)(rec + w_ * PG3_REC_BYTES + 768 + c * 16); }
      for (int i = t; i < 4 * 96; i += 256) { int w_ = i / 96, c = i % 96; *(u32x4*)((char*)fs + w_ * 1536 + c * 16) = *(const u32x4*)(rec + w_ * PG3_REC_BYTES + 2304 + c * 16); }
      for (int i = t; i < 4 * 40; i += 256) { int w_ = i / 40, c = i % 40; *(u32x4*)((char*)bt + w_ * 640 + c * 16) = *(const u32x4*)(rec + w_ * PG3_REC_BYTES + 3840 + c * 16); }
      if (t < 4) nbt[t] = *(const int*)(rec + t * PG3_REC_BYTES + 4480);
      for (int i = t; i < 12 * 128; i += 256) {
        int tl = i >> 7, ch = i & 127; int q = (tl % 3) * 4 + (tl / 3); int idx = pass * tpp + q; int g = (int)blockIdx.x + idx * (int)gridDim.x;
        u32x4 v = {0u, 0u, 0u, 0u};
        if (q < tpp && idx < per_block && g < ntok) v = *(const u32x4*)(xn + pg_row(g, ntok) * DM + ch * 8);
        *(u32x4*)(hs + tl * 1024 + ch * 8) = v;
      }
      __syncthreads();
    }
    const int t_s = tid_opaque(); const int lane = t_s & 63, wave = t_s >> 6;
    float acc[3][16];
#pragma unroll
    for (int tk = 0; tk < 3; ++tk)
#pragma unroll
      for (int e = 0; e < 16; ++e) acc[tk][e] = 0.f;
    const int nbat = nbt[wave];
    const unsigned short* we = fe + wave * 384; const float* wg = fg + wave * 384; const float* wsc = fs + wave * 384; const unsigned* wb = bt + wave * 160;
    const bf16_t* hw = hs + wave * 3 * 1024;
    u32x4 X[8], Y[8], Z[8];
    if (nbat > 0) { const unsigned d0 = __builtin_amdgcn_readfirstlane(wb[0]); pg3_issue(X, ub, we, d0, lane); pg3_issue(Y, vb, we, d0, lane); }
    for (int k = 0; k < nbat; k += 3) {
      pg3_step(X, Y, Z, k, nbat, acc, ub, vb, we, wg, wsc, wb, hw, lane);
      pg3_step(Z, X, Y, k + 1, nbat, acc, ub, vb, we, wg, wsc, wb, hw, lane);
      pg3_step(Y, Z, X, k + 2, nbat, acc, ub, vb, we, wg, wsc, wb, hw, lane);
    }
#pragma unroll
    for (int tk = 0; tk < 3; ++tk) {
      int q = tk * 4 + wave; int idx = pass * tpp + q; int g = (int)blockIdx.x + idx * (int)gridDim.x;
      if (q < tpp && idx < per_block && g < ntok) {
        long row = pg_row(g, ntok); int b = row / RB, lr = row % RB; int bb = lr < SEQ ? b : BATCH; const float* g5 = modl + ((long)bb * 6 + 5) * DM + lane * 16;
        float* xr = xs + row * DM + lane * 16;
        f32x4 xv[4]; float ss = 0.f;
#pragma unroll
        for (int i = 0; i < 4; ++i) {
          f32x4 x = *(f32x4*)(xr + 4 * i); f32x4 gg = *(const f32x4*)(g5 + 4 * i);
          x[0] += gg[0] * acc[tk][4*i]; x[1] += gg[1] * acc[tk][4*i+1]; x[2] += gg[2] * acc[tk][4*i+2]; x[3] += gg[3] * acc[tk][4*i+3];
          xv[i] = x; ss += x[0] * x[0] + x[1] * x[1] + x[2] * x[2] + x[3] * x[3];
        }
        if (out) {
          float* orow = out + ((long)b * SEQ + lr) * DM + lane * 16;
#pragma unroll
          for (int i = 0; i < 4; ++i) *(f32x4*)(orow + 4 * i) = xv[i];
        } else {
#pragma unroll
          for (int i = 0; i < 4; ++i) *(f32x4*)(xr + 4 * i) = xv[i];
          ss = wave_sum(ss); const float inv = __builtin_amdgcn_rsqf(ss * (1.f / DM) + EPSN);
          const float* sh = nmod + ((long)bb * 6 + 0) * DM + lane * 16; const float* sc = sh + DM; const float* gp = ng + lane * 16;
          u32x4 p0, p1;
#pragma unroll
          for (int i = 0; i < 4; ++i) { f32x4 g4 = *(const f32x4*)(gp + 4 * i), s4 = *(const f32x4*)(sc + 4 * i), h4 = *(const f32x4*)(sh + 4 * i);
            const float a0 = xv[i][0] * inv * g4[0] * (1.f + s4[0]) + h4[0], a1 = xv[i][1] * inv * g4[1] * (1.f + s4[1]) + h4[1];
            const float a2 = xv[i][2] * inv * g4[2] * (1.f + s4[2]) + h4[2], a3 = xv[i][3] * inv * g4[3] * (1.f + s4[3]) + h4[3];
            if (i < 2) { p0[2 * i] = pack2bf(a0, a1); p0[2 * i + 1] = pack2bf(a2, a3); } else { p1[2 * (i - 2)] = pack2bf(a0, a1); p1[2 * (i - 2) + 1] = pack2bf(a2, a3); } }
          *(u32x4*)(xn_next + row * DM + lane * 16) = p0; *(u32x4*)(xn_next + row * DM + lane * 16 + 8) = p1;
        }
      }
    }
  }
}

#define CS_L 32
#define CS_LDA 72
#define CS_LDS_ 40
#define CS_OFF_KK 0
#define CS_OFF_R  (CS_OFF_KK + 32 * CS_LDA * 2)
#define CS_OFF_K  (CS_OFF_R + 32 * CS_LDA * 2)
#define CS_OFF_B  (CS_OFF_K + 32 * CS_LDA * 2)
#define CS_OFF_S  (CS_OFF_B + 32 * CS_LDA * 2)
#define CS_OFF_VT (CS_OFF_S + 64 * CS_LDA * 2)
#define CS_OFF_UT (CS_OFF_VT + 64 * CS_LDS_ * 2)
#define CS_OFF_KP (CS_OFF_UT + 64 * CS_LDS_ * 2)
#define CS_OFF_BP (CS_OFF_KP + 64 * CS_LDS_ * 2)
#define CS_OFF_A  (CS_OFF_BP + 64 * CS_LDS_ * 2)
#define CS_OFF_P1 (CS_OFF_A + 32 * CS_LDS_ * 2)
#define CS_OFF_P2 (CS_OFF_P1 + 32 * CS_LDS_ * 2)
#define CS_OFF_C  (CS_OFF_P2 + 32 * CS_LDS_ * 2)
#define CS_OFF_G  (CS_OFF_C + 32 * 36 * 4)
#define CS_LDS_BYTES (CS_OFF_G + 5 * 64 * 4)
template <int KS>
__device__ __forceinline__ void cs_mma(const bf16_t* A, int lda, int m0, const bf16_t* Bt, int ldb, int n0, int lane, f32x4& acc) {
  const int fr = lane & 15, fq = lane >> 4;
#pragma unroll
  for (int ks = 0; ks < KS; ++ks) {
    bf16x8 af = *(const bf16x8*)(A + (m0 + fr) * lda + ks * 32 + fq * 8);
    bf16x8 bfr = *(const bf16x8*)(Bt + (n0 + fr) * ldb + ks * 32 + fq * 8);
    acc = __builtin_amdgcn_mfma_f32_16x16x32_bf16(bfr, af, acc, 0, 0, 0);
  }
}
#define CSP_WAVE_BYTES (2 * 32 * CS_LDA * 2 + 32 * 36 * 4)
__device__ __forceinline__ void rw_chunk_inverse(const bf16_t* __restrict__ kk_, const bf16_t* __restrict__ bd_, const float* __restrict__ w_, bf16_t* __restrict__ Mg,
                                                 int job, long dstride, char* smem_wave, int lane) {
  const int job_u = __builtin_amdgcn_readfirstlane(job);
  const int c = job_u % (RB / CS_L), item = job_u / (RB / CS_L);
  const int dir = item & 1, h = (item >> 1) % 6, b = item / 12;
  const long rowbase = (long)b * RB; const int col0 = h * 64;
  bf16_t* KKs = (bf16_t*)smem_wave; bf16_t* Bs_ = KKs + 32 * CS_LDA; float* Cf = (float*)(smem_wave + 2 * 32 * CS_LDA * 2);
  const int fr = lane & 15, fq = lane >> 4;
  const int rlo = dir ? scan_row(1, c * CS_L + 31) : scan_row(0, c * CS_L);
  const long ub_ = (rowbase + rlo) * 384 + col0;
  const char* sw_ = (const char*)(w_ + dir * dstride + ub_); const char* skk_ = (const char*)(kk_ + ub_); const char* sb_ = (const char*)(bd_ + dir * dstride + ub_);
  float wv[32]; unsigned kkr[32], br[32];
#pragma unroll
  for (int tt = 0; tt < 32; ++tt) {
    const unsigned m_ = dir ? 31 - tt : tt;
    wv[tt] = *(const float*)(sw_ + (size_t)((unsigned)lane * 4u + m_ * 1536u)); kkr[tt] = *(const bf16_t*)(skk_ + (size_t)((unsigned)lane * 2u + m_ * 768u)); br[tt] = *(const bf16_t*)(sb_ + (size_t)((unsigned)lane * 2u + m_ * 768u));
  }
  float G = 1.f;
#pragma unroll
  for (int tt = 0; tt < 32; ++tt) {
    KKs[tt * CS_LDA + lane] = f2bf(bf2f((bf16_t)kkr[tt]) * G);
    G *= wv[tt];
    Bs_[tt * CS_LDA + lane] = f2bf(bf2f((bf16_t)br[tt]) * __builtin_amdgcn_rcpf(G));
  }
#pragma unroll
  for (int mt = 0; mt < 2; ++mt)
#pragma unroll
    for (int nt = 0; nt < 2; ++nt) {
      f32x4 a = {0.f, 0.f, 0.f, 0.f};
      cs_mma<2>(KKs, CS_LDA, mt * 16, Bs_, CS_LDA, nt * 16, lane, a);
      const int tt = mt * 16 + fr, s0 = nt * 16 + fq * 4;
      f32x4 o4;
#pragma unroll
      for (int e = 0; e < 4; ++e) o4[e] = (s0 + e < tt) ? a[e] : 0.f;
      *(f32x4*)(Cf + tt * 36 + s0) = o4;
    }
  float m[32];
#pragma unroll
  for (int tt = 0; tt < 32; ++tt) {
    float acc = (tt == lane) ? 1.f : 0.f;
#pragma unroll
    for (int s4 = 0; s4 < tt; s4 += 4) {
      const f32x4 cv = *(const f32x4*)(Cf + tt * 36 + s4);
#pragma unroll
      for (int e = 0; e < 4; ++e) if (s4 + e < tt) acc -= cv[e] * m[s4 + e];
    }
    m[tt] = acc;
  }
  if (lane < 32) {
    bf16_t* dst = Mg + (long)job_u * 1024;
#pragma unroll
    for (int tt = 0; tt < 32; ++tt) dst[tt * 32 + lane] = f2bf(m[tt]);
  }
}
#define CS_FETCH(c_) do { const int s0_ = (c_) * CS_L + cq * 8; const int rlo_ = dir ? scan_row(1, s0_ + 7) : scan_row(0, s0_); \
      const char* fw_ = s_w + (long)rlo_ * 1536; const char* fkk_ = s_kk + (long)rlo_ * 768; const char* fb_ = s_b + (long)rlo_ * 768; \
      const char* fk_ = s_k + (long)rlo_ * 768; const char* fr_ = s_r + (long)rlo_ * 768; const char* fv_ = s_v + (long)rlo_ * 768; \
      _Pragma("unroll") for (int e = 0; e < 8; ++e) { asm volatile("" : "+v"(vo2e[e]), "+v"(vo4e[e]));   \
        pw[e] = *(const float*)(fw_ + (size_t)vo4e[e]); pkk[e] = *(const bf16_t*)(fkk_ + (size_t)vo2e[e]); pb[e] = *(const bf16_t*)(fb_ + (size_t)vo2e[e]); \
        pk[e] = *(const bf16_t*)(fk_ + (size_t)vo2e[e]); pr[e] = *(const bf16_t*)(fr_ + (size_t)vo2e[e]); pv[e] = *(const bf16_t*)(fv_ + (size_t)vo2e[e]); } } while (0)
__device__ __forceinline__ void rw_scan_chunked(const bf16_t* __restrict__ r_, const bf16_t* __restrict__ v_, const bf16_t* __restrict__ kk_, const bf16_t* __restrict__ kd_,
                                                const bf16_t* __restrict__ bd_, const float* __restrict__ w_, float* __restrict__ y_, int item, long dstride, char* smem, const bf16_t* __restrict__ Mg) {
  const int t = tid_opaque(), lane = t & 63, wave = t >> 6, fr = lane & 15, fq = lane >> 4;
  const int item_u = __builtin_amdgcn_readfirstlane(item);
  const int dir = item_u & 1, h = (item_u >> 1) % 6, b = item_u / 12;
  const long rowbase = (long)b * RB; const int col0 = h * 64;
  bf16_t* KKs = (bf16_t*)(smem + CS_OFF_KK); bf16_t* Rs = (bf16_t*)(smem + CS_OFF_R); bf16_t* Ks_ = (bf16_t*)(smem + CS_OFF_K); bf16_t* Bs_ = (bf16_t*)(smem + CS_OFF_B);
  bf16_t* Ss = (bf16_t*)(smem + CS_OFF_S); bf16_t* Vt = (bf16_t*)(smem + CS_OFF_VT); bf16_t* Ut = (bf16_t*)(smem + CS_OFF_UT);
  bf16_t* KpT = (bf16_t*)(smem + CS_OFF_KP); bf16_t* BpT = (bf16_t*)(smem + CS_OFF_BP);
  bf16_t* As_ = (bf16_t*)(smem + CS_OFF_A); bf16_t* P1s = (bf16_t*)(smem + CS_OFF_P1); bf16_t* P2s = (bf16_t*)(smem + CS_OFF_P2);
  bf16_t* Ms = (bf16_t*)(smem + CS_OFF_C);
  float* Gq = (float*)(smem + CS_OFF_G); float* GL = Gq + 256;
  bf16_t* rhsT = (bf16_t*)(smem + CS_OFF_K);
  const int cj = t & 63, cq = __builtin_amdgcn_readfirstlane(t >> 6);
  unsigned vo2e[8], vo4e[8];
#pragma unroll
  for (int e = 0; e < 8; ++e) { const int m_ = dir ? 7 - e : e; vo2e[e] = (unsigned)cj * 2u + (unsigned)m_ * 768u; vo4e[e] = (unsigned)cj * 4u + (unsigned)m_ * 1536u; }
  const long ubase_ = rowbase * 384 + col0;
  const char* s_w = (const char*)(w_ + dir * dstride + ubase_); const char* s_kk = (const char*)(kk_ + ubase_); const char* s_b = (const char*)(bd_ + dir * dstride + ubase_);
  const char* s_k = (const char*)(kd_ + dir * dstride + ubase_); const char* s_r = (const char*)(r_ + ubase_); const char* s_v = (const char*)(v_ + ubase_);
  __syncthreads();
  for (int i = t; i < 64 * CS_LDA; i += 256) Ss[i] = 0;
  f32x4 Sacc[4];
#pragma unroll
  for (int it = 0; it < 4; ++it) Sacc[it] = (f32x4){0.f, 0.f, 0.f, 0.f};
  float pw[8]; unsigned pkk[8], pb[8], pk[8], pr[8], pv[8]; uint2 pm;
  const bf16_t* Mitem = Mg + (long)item * (RB / CS_L) * 1024 + t * 4;
  CS_FETCH(0); pm = *(const uint2*)Mitem;
  __builtin_amdgcn_s_setprio(3);
  const int NCH = RB / CS_L;
  for (int c = 0; c < NCH; ++c) {
#pragma unroll
    for (int e = 0; e < 8; ++e) asm volatile("" : "+v"(pw[e]), "+v"(pkk[e]), "+v"(pb[e]), "+v"(pk[e]), "+v"(pr[e]), "+v"(pv[e]));
    asm volatile("" : "+v"(pm.x), "+v"(pm.y));
    float g[8]; float run = 1.f;
#pragma unroll
    for (int e = 0; e < 8; ++e) { run *= pw[e]; g[e] = run; }
    Gq[cq * 64 + cj] = run;
    float kkv[8], bv[8], kv[8], rv[8]; bf16_t vv[8];
#pragma unroll
    for (int e = 0; e < 8; ++e) { kkv[e] = bf2f((bf16_t)pkk[e]); bv[e] = bf2f((bf16_t)pb[e]); kv[e] = bf2f((bf16_t)pk[e]); rv[e] = bf2f((bf16_t)pr[e]); vv[e] = (bf16_t)pv[e]; }
    __syncthreads();
    const uint2 pm_cur = pm;
    if (c + 1 < NCH) { CS_FETCH(c + 1); pm = *(const uint2*)(Mitem + (long)(c + 1) * 1024); }
    float base = 1.f, tot = 1.f;
#pragma unroll
    for (int q = 0; q < 4; ++q) { float pq = Gq[q * 64 + cj]; if (q < cq) base *= pq; tot *= pq; }
    if (cq == 0) GL[cj] = tot;
    {
      u32x4 kp4, bp4, vt4;
#pragma unroll
      for (int e = 0; e < 8; ++e) {
        const float G = base * g[e], Gp = e == 0 ? base : base * g[e - 1], iG = __builtin_amdgcn_rcpf(G);
        const int tt = cq * 8 + e;
        KKs[tt * CS_LDA + cj] = f2bf(kkv[e] * Gp); Rs[tt * CS_LDA + cj] = f2bf(rv[e] * G);
        const float kt = kv[e] * iG, bt = bv[e] * iG;
        Ks_[tt * CS_LDA + cj] = f2bf(kt); Bs_[tt * CS_LDA + cj] = f2bf(bt);
        kv[e] = kt * tot; bv[e] = -bt * tot;
      }
#pragma unroll
      for (int e = 0; e < 4; ++e) { kp4[e] = pack2bf(kv[2 * e], kv[2 * e + 1]); bp4[e] = pack2bf(bv[2 * e], bv[2 * e + 1]); vt4[e] = (unsigned)vv[2 * e] | ((unsigned)vv[2 * e + 1] << 16); }
      *(uint2*)(Ms + (t >> 3) * CS_LDS_ + (t & 7) * 4) = pm_cur;
      *(u32x4*)(KpT + cj * CS_LDS_ + cq * 8) = kp4; *(u32x4*)(BpT + cj * CS_LDS_ + cq * 8) = bp4; *(u32x4*)(Vt + cj * CS_LDS_ + cq * 8) = vt4;
    }
    __syncthreads();
    if (wave == 1) {
    } else {
      const bf16_t* X = wave == 0 ? KKs : Rs; const bf16_t* Y = wave == 3 ? Bs_ : Ks_;
#pragma unroll
      for (int mt = 0; mt < 2; ++mt)
#pragma unroll
        for (int nt = 0; nt < 2; ++nt) {
          f32x4 a = {0.f, 0.f, 0.f, 0.f};
          cs_mma<2>(X, CS_LDA, mt * 16, Y, CS_LDA, nt * 16, lane, a);
          const int tt = mt * 16 + fr, s0 = nt * 16 + fq * 4;
          float o[4];
#pragma unroll
          for (int e = 0; e < 4; ++e) { const int s = s0 + e; const bool keep = wave == 0 ? (s < tt) : (s <= tt); o[e] = keep ? a[e] : 0.f; }
          bf16_t* dst = wave == 0 ? As_ : (wave == 2 ? P1s : P2s); const float sg = wave == 3 ? -1.f : 1.f;
          uint2 pk2; pk2.x = pack2bf(sg * o[0], sg * o[1]); pk2.y = pack2bf(sg * o[2], sg * o[3]);
          *(uint2*)(dst + tt * CS_LDS_ + s0) = pk2;
        }
    }
    __syncthreads();
    f32x4 yp[2];
    {
      const bf16x8 sb0 = *(const bf16x8*)(Ss + (wave * 16 + fr) * CS_LDA + fq * 8), sb1 = *(const bf16x8*)(Ss + (wave * 16 + fr) * CS_LDA + 32 + fq * 8);
      const bf16x8 vb = *(const bf16x8*)(Vt + (wave * 16 + fr) * CS_LDS_ + fq * 8);
      bf16x8 ak[2][2], ar[2][2], aa[2], ap[2];
#pragma unroll
      for (int mt = 0; mt < 2; ++mt) {
        ak[mt][0] = *(const bf16x8*)(KKs + (mt * 16 + fr) * CS_LDA + fq * 8); ak[mt][1] = *(const bf16x8*)(KKs + (mt * 16 + fr) * CS_LDA + 32 + fq * 8);
        ar[mt][0] = *(const bf16x8*)(Rs + (mt * 16 + fr) * CS_LDA + fq * 8);  ar[mt][1] = *(const bf16x8*)(Rs + (mt * 16 + fr) * CS_LDA + 32 + fq * 8);
        aa[mt] = *(const bf16x8*)(As_ + (mt * 16 + fr) * CS_LDS_ + fq * 8);   ap[mt] = *(const bf16x8*)(P1s + (mt * 16 + fr) * CS_LDS_ + fq * 8);
      }
#pragma unroll
      for (int mt = 0; mt < 2; ++mt) {
        f32x4 a = {0.f, 0.f, 0.f, 0.f}, y2 = {0.f, 0.f, 0.f, 0.f};
        a = __builtin_amdgcn_mfma_f32_16x16x32_bf16(sb0, ak[mt][0], a, 0, 0, 0);   y2 = __builtin_amdgcn_mfma_f32_16x16x32_bf16(sb0, ar[mt][0], y2, 0, 0, 0);
        a = __builtin_amdgcn_mfma_f32_16x16x32_bf16(sb1, ak[mt][1], a, 0, 0, 0);   y2 = __builtin_amdgcn_mfma_f32_16x16x32_bf16(sb1, ar[mt][1], y2, 0, 0, 0);
        a = __builtin_amdgcn_mfma_f32_16x16x32_bf16(vb, aa[mt], a, 0, 0, 0);       y2 = __builtin_amdgcn_mfma_f32_16x16x32_bf16(vb, ap[mt], y2, 0, 0, 0);
#pragma unroll
        for (int e = 0; e < 4; ++e) rhsT[(wave * 16 + fq * 4 + e) * CS_LDS_ + mt * 16 + fr] = f2bf(a[e]);
        yp[mt] = y2;
      }
    }
    __syncthreads();
#pragma unroll
    for (int nt = 0; nt < 2; ++nt) {
      f32x4 a = {0.f, 0.f, 0.f, 0.f};
      cs_mma<1>(rhsT, CS_LDS_, wave * 16, Ms, CS_LDS_, nt * 16, lane, a);
      uint2 pk2; pk2.x = pack2bf(a[0], a[1]); pk2.y = pack2bf(a[2], a[3]);
      *(uint2*)(Ut + (wave * 16 + fr) * CS_LDS_ + nt * 16 + fq * 4) = pk2;
    }
    __syncthreads();
    {
      const bf16x8 ub_ = *(const bf16x8*)(Ut + (wave * 16 + fr) * CS_LDS_ + fq * 8);
      const bf16x8 kpb = *(const bf16x8*)(KpT + (wave * 16 + fr) * CS_LDS_ + fq * 8), bpb = *(const bf16x8*)(BpT + (wave * 16 + fr) * CS_LDS_ + fq * 8);
      bf16x8 p2a[2], va[4], ua[4];
#pragma unroll
      for (int mt = 0; mt < 2; ++mt) p2a[mt] = *(const bf16x8*)(P2s + (mt * 16 + fr) * CS_LDS_ + fq * 8);
#pragma unroll
      for (int it = 0; it < 4; ++it) { va[it] = *(const bf16x8*)(Vt + (it * 16 + fr) * CS_LDS_ + fq * 8); ua[it] = *(const bf16x8*)(Ut + (it * 16 + fr) * CS_LDS_ + fq * 8); }
      const f32x4 gl = *(const f32x4*)(GL + wave * 16 + fq * 4);
#pragma unroll
      for (int mt = 0; mt < 2; ++mt) {
        yp[mt] = __builtin_amdgcn_mfma_f32_16x16x32_bf16(ub_, p2a[mt], yp[mt], 0, 0, 0);
        const long row = rowbase + scan_row(dir, c * CS_L) + (dir ? -(mt * 16 + fr) : (mt * 16 + fr));
        *(f32x4*)(y_ + dir * dstride + row * 384 + col0 + wave * 16 + fq * 4) = yp[mt];
      }
#pragma unroll
      for (int it = 0; it < 4; ++it) {
        f32x4 a = Sacc[it]; a[0] *= gl[0]; a[1] *= gl[1]; a[2] *= gl[2]; a[3] *= gl[3];
        a = __builtin_amdgcn_mfma_f32_16x16x32_bf16(kpb, va[it], a, 0, 0, 0);
        a = __builtin_amdgcn_mfma_f32_16x16x32_bf16(bpb, ua[it], a, 0, 0, 0);
        Sacc[it] = a;
      }
    }
    __syncthreads();
#pragma unroll
    for (int it = 0; it < 4; ++it) { uint2 pk2; pk2.x = pack2bf(Sacc[it][0], Sacc[it][1]); pk2.y = pack2bf(Sacc[it][2], Sacc[it][3]); *(uint2*)(Ss + (it * 16 + fr) * CS_LDA + wave * 16 + fq * 4) = pk2; }
  }
  __builtin_amdgcn_s_setprio(0);
  __syncthreads();
}
#include <hip/hip_cooperative_groups.h>
namespace cg = cooperative_groups;

#define XB_TMO      128
#define XB_XCNT(j)  (256  + 64 * (j))
#define XB_XSUB(j)  (1280 + 64 * (j))
#define XB_XGEN(j)  (2304 + 64 * (j))
#define XB_TOP      3328
#define XB_TOPGEN   3392
#define XB_QUEUE(i) (3456 + 64 * (i))
#define XCD_BAR_WORDS 4096
#define XB_SPIN_CAP (1u << 22)
#define LAS __attribute__((address_space(3)))
__device__ __forceinline__ unsigned xb_ld(unsigned* p)              { return __hip_atomic_load(p, __ATOMIC_RELAXED, __HIP_MEMORY_SCOPE_AGENT); }
__device__ __forceinline__ unsigned xb_add(unsigned* p, unsigned v) { return __hip_atomic_fetch_add(p, v, __ATOMIC_RELAXED, __HIP_MEMORY_SCOPE_AGENT); }
__device__ __forceinline__ unsigned xb_xcc_id() { return (unsigned)__builtin_amdgcn_s_getreg((3 << 11) | 20) & 0xFu; }
#define XB_SPIN(cond, bar) do { unsigned _sp = 0; while (cond) { __builtin_amdgcn_s_sleep(1); \
    if ((++_sp & 255u) == 0u) { if (xb_ld(&(bar)[XB_TMO])) break; if (_sp > XB_SPIN_CAP) { atomicAdd(&(bar)[XB_TMO], 1u); break; } } } } while (0)
struct XcdBarrier { unsigned* bar; unsigned x; volatile LAS unsigned* st; };
__device__ __forceinline__ XcdBarrier xcd_barrier_post(unsigned* bar, volatile LAS unsigned* st) {
  XcdBarrier b; b.bar = bar; b.x = xb_xcc_id(); b.st = st;
  if (threadIdx.x == 0) (void)xb_add(&bar[XB_XCNT(b.x)], 1u);
  return b;
}
__device__ __forceinline__ void xcd_barrier_complete(unsigned* bar, unsigned x, unsigned& nloc, unsigned& nx) {
  const unsigned G = gridDim.x; unsigned sum, cnt, mine, sp = 0u;
  for (;;) {
    sum = 0u; cnt = 0u; mine = 0u;
#pragma unroll
    for (unsigned j = 0; j < 16; ++j) { const unsigned c = xb_ld(&bar[XB_XCNT(j)]); sum += c; cnt += (c > 0u) ? 1u : 0u; mine = (j == x) ? c : mine; }
    if (sum == G) break;
    __builtin_amdgcn_s_sleep(1);
    if ((++sp & 255u) == 0u) { if (xb_ld(&bar[XB_TMO])) break; if (sp > XB_SPIN_CAP) { atomicAdd(&bar[XB_TMO], 1u); break; } }
  }
  nloc = mine > 0u ? mine : 1u; nx = cnt > 0u ? cnt : 1u;
}
__device__ __forceinline__ void xcd_barrier(const XcdBarrier& b) {
  asm volatile("s_waitcnt vmcnt(0)" ::: "memory");
  __syncthreads();
  if (threadIdx.x == 0) {
    unsigned* bar = b.bar;
    __builtin_amdgcn_s_waitcnt(0);
    unsigned nloc = b.st[0], nx = b.st[1];
    if (nloc == 0u) { xcd_barrier_complete(bar, b.x, nloc, nx); b.st[0] = nloc; b.st[1] = nx; }
    const unsigned old = xb_add(&bar[XB_XSUB(b.x)], 1u);
    const unsigned gen = old / nloc;
    if (old + 1u == (gen + 1u) * nloc) {
      __builtin_amdgcn_fence(__ATOMIC_RELEASE, "agent");
      asm volatile("s_waitcnt vmcnt(0)" ::: "memory");
      const unsigned og = xb_add(&bar[XB_TOP], 1u);
      const unsigned tg = og / nx;
      if (og + 1u == (tg + 1u) * nx) xb_add(&bar[XB_TOPGEN], 1u);
      else XB_SPIN(xb_ld(&bar[XB_TOPGEN]) == tg, bar);
      __builtin_amdgcn_fence(__ATOMIC_ACQUIRE, "agent");
      xb_add(&bar[XB_XGEN(b.x)], 1u);
      asm volatile("s_waitcnt vmcnt(0)" ::: "memory");
    } else {
      XB_SPIN(xb_ld(&bar[XB_XGEN(b.x)]) == gen, bar);
      __builtin_amdgcn_fence(__ATOMIC_ACQUIRE, "agent");
      asm volatile("s_waitcnt vmcnt(0)" ::: "memory");
    }
  }
  __syncthreads();
}


constexpr size_t al256(size_t x) { return (x + 255) & ~(size_t)255; }
struct WsOff { size_t xs, mod, xn, Pb, tq, tkv, a_b, g_b, w_f, mq, mk, mvT, gq, gk, gvT, r_b, v_b, kk_b, kd_b, bd_b, w_inT, w_outT, wqT, keysb, wqbT, wkvbT, w2T, a2T, g2T, rope_g, rope_m, total; };
constexpr WsOff make_wsoff() {
  WsOff o{}; size_t p = 32768; const size_t MA = NROWS;
  o.mod = p; p += al256(2 * (BATCH + 1) * 6144 * 4); o.xs = p; p += al256(MA * DM * 4); o.xn = p; p += al256(MA * DM * 2);
  o.Pb = p; p += al256(MA * IN_COLS * 2);
  o.tq = p; p += al256(MA * 384 * 2); o.tkv = p; p += al256(MA * 512 * 2); o.a_b = p; p += al256(2 * MA * 384 * 2);
  o.g_b = p; p += al256(MA * 384 * 2); o.w_f = p; p += al256(2 * MA * 384 * 4);
  o.mq = p; p += al256(MA * 384 * 2); o.mk = p; p += al256(MA * 384 * 2); o.mvT = p; p += al256((size_t)BATCH * 4 * 64 * RB * 2);
  o.gq = p; p += al256(MA * 384 * 2); o.gk = p; p += al256(MA * 128 * 2); o.gvT = p; p += al256((size_t)BATCH * 2 * 64 * RB * 2);
  o.r_b = p; p += al256(MA * 384 * 2); o.v_b = p; p += al256(MA * 384 * 2); o.kk_b = p; p += al256(MA * 384 * 2);
  o.kd_b = p; p += al256(2 * MA * 384 * 2); o.bd_b = p; p += al256(2 * MA * 384 * 2);
  o.w_inT = p; p += al256((size_t)2 * 2688 * 1024 * 2); o.w_outT = p; p += al256((size_t)2 * 1024 * 1024 * 2); o.wqT = p; p += al256((size_t)2 * 2048 * 1024 * 2);
  o.keysb = p; p += al256((size_t)2 * 16 * 128 * 128 * 2); o.wqbT = p; p += al256((size_t)2 * 384 * 256 * 2); o.wkvbT = p; p += al256((size_t)2 * 512 * 128 * 2);
  o.w2T = p; p += al256((size_t)2 * 2 * 384 * 64 * 2); o.a2T = p; p += al256((size_t)2 * 2 * 384 * 64 * 2); o.g2T = p; p += al256((size_t)2 * 384 * 192 * 2);
  o.rope_g = p; p += al256((size_t)SEQ * 64 * 4); o.rope_m = p; p += al256((size_t)SEQ * 32 * 4);
  o.total = p; return o;
}
constexpr WsOff WO = make_wsoff();
#define WS_PTR(T, off) ((T*)(ws + (off)))
#define MINV_OFF (WO.tq + (size_t)40 * 1024 * 1024)
#define TAB_OFF (WO.Pb + ((size_t)2 * NROWS * 384 * 4 + 1048576 & ~(size_t)255))
#define TAB_U (TAB_OFF)
#define TAB_V (TAB_OFF + (size_t)16384 * 1024)
#define TAB_SU (TAB_OFF + (size_t)2 * 16384 * 1024)
#define TAB_SV (TAB_OFF + (size_t)2 * 16384 * 1024 + 65536)
#define LAUNDER_S(x) asm volatile("" : "+s"(x))
#define KARG_AS __attribute__((address_space(4)))
#define KP_DECL const KARG_AS MegaP* kp_ = (const KARG_AS MegaP*)__builtin_amdgcn_kernarg_segment_ptr(); LAUNDER_S(kp_)

struct NaiveIn {
  const float *x, *c, *ctx, *c_ctx, *ada_w, *ada_b, *norm_mix_g, *norm_ffn_g, *w_in, *w_out, *mla_q_norm_g, *mla_w_qb, *mla_kv_norm_g,
      *mla_w_kvb, *mla_qk_g, *rw_mu, *rw_w0, *rw_w2, *rw_a0, *rw_a2, *rw_g2, *rw_k_k, *rw_k_a, *rw_r_k, *rw_ln_g, *rw_ln_b, *gqa_qk_g,
      *pe_wq, *pe_keys, *pe_u, *pe_v;
};
struct MegaP { NaiveIn in; char* ws; float* out; };

#ifndef MEGA_CG
#define MEGA_CG 0
#endif
#if MEGA_CG
#define GRID_BARRIER() cg::this_grid().sync()
#else
#ifdef BAR_TWICE
#define GRID_BARRIER() do { GRID_BARRIER1(); GRID_BARRIER1(); } while (0)
#else
#define GRID_BARRIER() GRID_BARRIER1()
#endif
#define GRID_BARRIER1() do { XcdBarrier xb_; xb_.bar = (unsigned*)((const KARG_AS MegaP*)__builtin_amdgcn_kernarg_segment_ptr())->ws; xb_.x = xb_xcc_id(); xb_.st = (volatile LAS unsigned*)&xb_words; xcd_barrier(xb_); } while (0)
#endif
#define MEGA_LDS_BYTES 65536
#ifndef PHASE_MASK
#define PHASE_MASK 0xFFFF
#endif
#define PH(k) if (PHASE_MASK & (1 << (k)))
#define LAT_TM(i) (((i) >> 4) * 18 + ((i) & 15))
#define XCD_TILE_LOOP(tile, T) for (int xt_base_ = (int)(((long)(T) * (blockIdx.x & 7)) >> 3), xt_cnt_ = (int)(((long)(T) * ((blockIdx.x & 7) + 1)) >> 3) - xt_base_, xt_q_ = blockIdx.x >> 3, tile = xt_base_ + xt_q_; xt_q_ < xt_cnt_; xt_q_ += gridDim.x >> 3, tile = xt_base_ + xt_q_)
#ifndef DIL_PH
#define DIL_PH -1
#endif
#ifndef DIL_MULT
#define DIL_MULT 4
#endif
#define DIL_BEGIN(k) unsigned long long dil_t0 = 0; if (DIL_PH == (k)) dil_t0 = __builtin_amdgcn_s_memrealtime();
#define DIL_END(k) if (DIL_PH == (k)) { GRID_BARRIER(); if (blockIdx.x == 0 && threadIdx.x == 0) { unsigned long long t1 = __builtin_amdgcn_s_memrealtime(); unsigned long long dt = (t1 - dil_t0) * DIL_MULT; \
    while (__builtin_amdgcn_s_memrealtime() - t1 < dt) __builtin_amdgcn_s_sleep(32); } }

__device__ __forceinline__ void ph_norm_mod(const float* xs, const float* g, const float* modl, int shift_idx, bf16_t* xn, bool skip_ctx = false, const float* x_in = nullptr, const float* ctx_in = nullptr) {
  const int tt_ = tid_opaque(); const int lane = tt_ & 63;
  for (long row = blockIdx.x * 4 + (tt_ >> 6); row < NROWS; row += (long)gridDim.x * 4) {
    int b = row / RB, lr = row % RB; int bb = lr < SEQ ? b : BATCH;
    if (skip_ctx && lr >= SEQ) continue;
    const float* sh = modl + ((long)bb * 6 + shift_idx) * DM; const float* sc = sh + DM;
    const float* xr = x_in ? (lr < SEQ ? x_in + ((long)b * SEQ + lr) * DM : ctx_in + ((long)b * CTX_LEN + (lr - SEQ)) * DM) : xs + row * DM; f32x4 v[4]; float ss = 0.f;
#pragma unroll
    for (int i = 0; i < 4; ++i) { v[i] = *(const f32x4*)(xr + i * 256 + lane * 4); ss += v[i][0]*v[i][0] + v[i][1]*v[i][1] + v[i][2]*v[i][2] + v[i][3]*v[i][3]; }
    ss = wave_sum(ss);
    float inv = __builtin_amdgcn_rsqf(ss / DM + EPSN);
#pragma unroll
    for (int i = 0; i < 4; ++i) {
      int d = i * 256 + lane * 4; float o[4];
#pragma unroll
      for (int e = 0; e < 4; ++e) o[e] = v[i][e] * inv * g[d+e] * (1.f + sc[d+e]) + sh[d+e];
      uint2 pk; pk.x = pack2bf(o[0], o[1]); pk.y = pack2bf(o[2], o[3]);
      *(uint2*)(xn + row * DM + d) = pk;
    }
  }
}
__device__ __forceinline__ void ph_cvt_wT(const float* W, const float* g, bf16_t* Wt, int K, int N, int Npad, int Kpad) {
  const long n_el = (long)Npad * Kpad;
  const int tt_ = tid_opaque();
  for (long i = (long)blockIdx.x * 256 + tt_; i < n_el; i += (long)gridDim.x * 256) {
    int k = i % Kpad; int n = i / Kpad;
    Wt[i] = (k < K && n < N) ? f2bf(W[(long)k * N + n] * (g ? g[k] : 1.f)) : (bf16_t)0;
  }
}
__device__ __forceinline__ void ph_cvt_bf16(const float* s, bf16_t* d, long n8) {
  const int tt_ = tid_opaque();
  for (long i = (long)blockIdx.x * 256 + tt_; i < n8; i += (long)gridDim.x * 256) {
    f32x4 a = *(const f32x4*)(s + i * 8), b = *(const f32x4*)(s + i * 8 + 4);
    u32x4 o; o[0] = pack2bf(a[0], a[1]); o[1] = pack2bf(a[2], a[3]); o[2] = pack2bf(b[0], b[1]); o[3] = pack2bf(b[2], b[3]);
    *(u32x4*)(d + i * 8) = o;
  }
}


__device__ __forceinline__ void ph_cvt_wT_tiled(const float* __restrict__ W, const float* __restrict__ g, bf16_t* __restrict__ Wt, int K, int N, int Npad, int Kpad, char* smem) {
  const int t = tid_opaque(); float* s = (float*)smem;
  const int tk = Kpad / 64, tn = Npad / 64;
  for (int tile = blockIdx.x; tile < tk * tn; tile += gridDim.x) {
    const int k0 = (tile % tk) * 64, n0 = (tile / tk) * 64;
    __syncthreads();
#pragma unroll
    for (int i = 0; i < 4; ++i) {
      int kk = (t >> 4) + 16 * i, nn = (t & 15) * 4; int k = k0 + kk;
      f32x4 v = {0.f, 0.f, 0.f, 0.f};
      if (k < K) {
        const float* src = W + (long)k * N + n0 + nn; float gs = g ? g[k] : 1.f;
        if (n0 + nn + 3 < N) v = *(const f32x4*)src; else { for (int e = 0; e < 4; ++e) if (n0 + nn + e < N) v[e] = src[e]; }
        v *= gs;
      }
#pragma unroll
      for (int e = 0; e < 4; ++e) s[kk * 65 + nn + e] = v[e];
    }
    __syncthreads();
    {
      int nn = t >> 2, kq = (t & 3) * 16; u32x4 o0, o1;
#pragma unroll
      for (int e = 0; e < 4; ++e) { o0[e] = pack2bf(s[(kq + 2*e) * 65 + nn], s[(kq + 2*e + 1) * 65 + nn]); o1[e] = pack2bf(s[(kq + 8 + 2*e) * 65 + nn], s[(kq + 8 + 2*e + 1) * 65 + nn]); }
      bf16_t* dst = Wt + (long)(n0 + nn) * Kpad + k0 + kq;
      *(u32x4*)dst = o0; *(u32x4*)(dst + 8) = o1;
    }
  }
}
__device__ __forceinline__ void ph_mod_gemv(const float* __restrict__ c, const float* __restrict__ c_ctx, const float* __restrict__ ada_w, const float* __restrict__ ada_b, float* __restrict__ mod, char* smem) {
  const int t = tid_opaque(); float* s = (float*)smem;
  if ((int)blockIdx.x >= 2 * 96) return;
  for (int i = t; i < 9 * 1024; i += 256) { int bb = i >> 10, k = i & 1023; float v = bb < BATCH ? c[bb * DM + k] : c_ctx[k]; s[i] = v * __builtin_amdgcn_rcpf(1.f + __builtin_amdgcn_exp2f(-v * 1.4426950408889634f)); }
  __syncthreads();
  float* part = s + 9 * 1024;
  for (int item = blockIdx.x; item < 2 * 96; item += gridDim.x) {
    const int cb = item % 96, l = item / 96; const int kq = t >> 6, col = t & 63;
    const int j = cb * 64 + col; const float* wp = ada_w + ((long)l * DM + kq * 256) * 6144 + j;
    float acc[9];
#pragma unroll
    for (int bb = 0; bb < 9; ++bb) acc[bb] = 0.f;
#pragma unroll 16
    for (int k = 0; k < 256; ++k) { float w = wp[(long)k * 6144];
#pragma unroll
      for (int bb = 0; bb < 9; ++bb) acc[bb] += s[bb * 1024 + kq * 256 + k] * w; }
#pragma unroll
    for (int bb = 0; bb < 9; ++bb) part[(kq * 9 + bb) * 64 + col] = acc[bb];
    __syncthreads();
    for (int i = t; i < 9 * 64; i += 256) { int bb = i >> 6, cc = i & 63;
      float v = ((part[(0 * 9 + bb) * 64 + cc] + part[(1 * 9 + bb) * 64 + cc]) + part[(2 * 9 + bb) * 64 + cc]) + part[(3 * 9 + bb) * 64 + cc];
      mod[((long)l * (BATCH + 1) + bb) * 6144 + cb * 64 + cc] = v + ada_b[l * 6144 + cb * 64 + cc]; }
    __syncthreads();
  }
}

__global__ void __launch_bounds__(256, 2) mega_kernel(MegaP p) {
  __shared__ __attribute__((aligned(16))) char smem[MEGA_LDS_BYTES];
  __shared__ uint4 xb_words;
  const int t0 = threadIdx.x;
#if !MEGA_CG
  if (t0 == 0) xb_words = make_uint4(0u, 0u, 0u, 0u);
  __syncthreads();
  (void)xcd_barrier_post((unsigned*)p.ws, (volatile LAS unsigned*)&xb_words);
#endif
  const long MA = NROWS; const int TM = NROWS / 128;
#define I (kp_->in)
  const int scan_role = (int)blockIdx.x < BATCH * 12 ? 1 : 0;
  { DIL_BEGIN(0)
  PH(0) {
    KP_DECL; char* ws = kp_->ws; const int t = tid_opaque();
    float* xs = WS_PTR(float, WO.xs); float* mod = WS_PTR(float, WO.mod);
    ph_mod_gemv(I.c, I.c_ctx, I.ada_w, I.ada_b, mod, smem);
    for (int l = 0; l < 2; ++l) {
      ph_cvt_wT_tiled(I.w_in + (long)l * DM * IN_COLS, nullptr, WS_PTR(bf16_t, WO.w_inT) + (long)l * 2688 * 1024, 1024, IN_COLS, 2688, 1024, smem);
      ph_cvt_wT_tiled(I.w_out + (long)l * DM * DM, nullptr, WS_PTR(bf16_t, WO.w_outT) + (long)l * 1024 * 1024, 1024, 1024, 1024, 1024, smem);
      ph_cvt_wT_tiled(I.pe_wq + (long)l * DM * 2048, nullptr, WS_PTR(bf16_t, WO.wqT) + (long)l * 2048 * 1024, 1024, 2048, 2048, 1024, smem);
      ph_cvt_wT_tiled(I.mla_w_qb + (long)l * 256 * 384, I.mla_q_norm_g + l * 256, WS_PTR(bf16_t, WO.wqbT) + (long)l * 384 * 256, 256, 384, 384, 256, smem);
      ph_cvt_wT_tiled(I.mla_w_kvb + (long)l * 128 * 512, I.mla_kv_norm_g + l * 128, WS_PTR(bf16_t, WO.wkvbT) + (long)l * 512 * 128, 128, 512, 512, 128, smem);
      for (int d = 0; d < 2; ++d) {
        ph_cvt_wT_tiled(I.rw_w2 + ((long)l * 2 + d) * 64 * 384, nullptr, WS_PTR(bf16_t, WO.w2T) + ((long)l * 2 + d) * 384 * 64, 64, 384, 384, 64, smem);
        ph_cvt_wT_tiled(I.rw_a2 + ((long)l * 2 + d) * 64 * 384, nullptr, WS_PTR(bf16_t, WO.a2T) + ((long)l * 2 + d) * 384 * 64, 64, 384, 384, 64, smem);
      }
      ph_cvt_wT_tiled(I.rw_g2 + (long)l * 160 * 384, nullptr, WS_PTR(bf16_t, WO.g2T) + (long)l * 384 * 192, 160, 384, 384, 192, smem);
    }
    ph_cvt_bf16(I.pe_keys, WS_PTR(bf16_t, WO.keysb), 2L * 16 * 128 * 128 / 8);
    ph_rope_tables(WS_PTR(float, WO.rope_g), WS_PTR(float, WO.rope_m));
  }
  DIL_END(0) }
  GRID_BARRIER();
  for (int lq = 0; lq < 2; ++lq) {
    int l = lq; LAUNDER_S(l);
    { DIL_BEGIN(1)
    PH(1) if (l == 0) {
      KP_DECL; char* ws = kp_->ws; const int t = tid_opaque(); (void)t;
      ph_norm_mod(WS_PTR(float, WO.xs), I.norm_mix_g + l * DM, WS_PTR(float, WO.mod) + (long)l * (BATCH + 1) * 6144, 0, WS_PTR(bf16_t, WO.xn), false, I.x, I.ctx);
    }
    DIL_END(1) }
    GRID_BARRIER();
    { DIL_BEGIN(2)
    PH(2) {
      KP_DECL; char* ws = kp_->ws; const int t = tid_opaque(); (void)t;
      const bf16_t* xn = WS_PTR(bf16_t, WO.xn); const bf16_t* wT = WS_PTR(bf16_t, WO.w_inT) + (long)l * 2688 * 1024; bf16_t* Pb = WS_PTR(bf16_t, WO.Pb);
      XCD_TILE_LOOP(tile, TM * 21)
        gemm_tile_128_glds(xn, DM, wT, 1024, 1024, tile / 21, tile % 21, smem, EpiStoreBf16{Pb, IN_COLS, IN_COLS});
    }
    DIL_END(2) }
    GRID_BARRIER();
    { DIL_BEGIN(3)
    PH(3) {
      KP_DECL; char* ws = kp_->ws; const int t = tid_opaque(); (void)t;
      PrepW pw{WS_PTR(bf16_t, WO.wqbT) + (long)l * 384 * 256, WS_PTR(bf16_t, WO.wkvbT) + (long)l * 512 * 128, WS_PTR(bf16_t, WO.w2T) + (long)l * 2 * 384 * 64,
               WS_PTR(bf16_t, WO.a2T) + (long)l * 2 * 384 * 64, WS_PTR(bf16_t, WO.g2T) + (long)l * 384 * 192, I.rw_mu + (long)l * 2 * RWC, I.rw_w0 + l * 768, I.rw_a0 + l * 768};
      PrepBuf pb{WS_PTR(bf16_t, WO.Pb), WS_PTR(bf16_t, WO.tq), WS_PTR(bf16_t, WO.tkv), WS_PTR(bf16_t, WO.a_b), WS_PTR(bf16_t, WO.g_b), WS_PTR(float, WO.w_f)};
      XCD_TILE_LOOP(tile, TM * 22) prep_gemm_tile(pw, pb, tile / 22, tile % 22, smem);
    }
    DIL_END(3) }
    GRID_BARRIER();
    { DIL_BEGIN(4)
    PH(4) {
      KP_DECL; char* ws = kp_->ws; const int t = tid_opaque(); (void)t;
      FinW2 fw{I.mla_qk_g + l * 192, I.gqa_qk_g + l * 128, I.rw_mu + (long)l * 2 * RWC, I.rw_k_k + l * 384, I.rw_k_a + l * 384, WS_PTR(float, WO.rope_g), WS_PTR(float, WO.rope_m)};
      FinBuf fb{WS_PTR(bf16_t, WO.Pb), WS_PTR(bf16_t, WO.tq), WS_PTR(bf16_t, WO.tkv), WS_PTR(bf16_t, WO.a_b), WS_PTR(bf16_t, WO.mq), WS_PTR(bf16_t, WO.mk), WS_PTR(bf16_t, WO.mvT),
                WS_PTR(bf16_t, WO.gq), WS_PTR(bf16_t, WO.gk), WS_PTR(bf16_t, WO.gvT), WS_PTR(bf16_t, WO.r_b), WS_PTR(bf16_t, WO.v_b), WS_PTR(bf16_t, WO.kk_b), WS_PTR(bf16_t, WO.kd_b), WS_PTR(bf16_t, WO.bd_b)};
      for (int tile = blockIdx.x; tile < NROWS / 8; tile += gridDim.x) prep_finish_tile2(fw, fb, tile, smem);
      if (blockIdx.x == gridDim.x - 1 && t < 64) { attn_score_bound(I.mla_qk_g + l * 192, 96, 9.79795897f, (float*)(ws + 16384) + l * 4, t); attn_score_bound(I.gqa_qk_g + l * 128, 64, 8.f, (float*)(ws + 16384) + l * 4 + 1, t); }
    }
    DIL_END(4) }
    GRID_BARRIER();
    { unsigned long long dil_t0 = 0, dil_scan = 0; if (DIL_PH == 5 || DIL_PH == 11) dil_t0 = __builtin_amdgcn_s_memrealtime();
    PH(5) {
      {
        KP_DECL; char* ws = kp_->ws; const int tp = tid_opaque();
        const int njobs = BATCH * 12 * (RB / CS_L);
        for (int job = (int)blockIdx.x * 4 + (tp >> 6); job < njobs; job += (int)gridDim.x * 4)
          rw_chunk_inverse(WS_PTR(bf16_t, WO.kk_b), WS_PTR(bf16_t, WO.bd_b), WS_PTR(float, WO.w_f), WS_PTR(bf16_t, MINV_OFF), job, (long)MA * 384, smem + (tp >> 6) * CSP_WAVE_BYTES, tp & 63);
      }
      GRID_BARRIER();
      KP_DECL; char* ws = kp_->ws; const int t = tid_opaque(); (void)t;
      int* s_item = (int*)(smem + MEGA_LDS_BYTES - 16);
      unsigned* sctr = (unsigned*)ws + XB_QUEUE(4 + l);
      auto scan_loop = [&]() __attribute__((always_inline)) {
        for (;;) {
          __syncthreads();
          if (tid_opaque() == 0) *s_item = (int)xb_add(sctr, 1u);
          __syncthreads();
          const int it = *s_item;
          if (it >= BATCH * 12) break;
          rw_scan_chunked(WS_PTR(bf16_t, WO.r_b), WS_PTR(bf16_t, WO.v_b), WS_PTR(bf16_t, WO.kk_b), WS_PTR(bf16_t, WO.kd_b), WS_PTR(bf16_t, WO.bd_b), WS_PTR(float, WO.w_f), WS_PTR(float, WO.Pb),
                          it, (long)MA * 384, smem, WS_PTR(bf16_t, MINV_OFF));
        }
      };
      if (scan_role) scan_loop();
#if DIL_PH == 11
      dil_scan = __builtin_amdgcn_s_memrealtime() - dil_t0;
#endif
#ifdef SPLIT5
      GRID_BARRIER();
#endif
      const int nqt = l == 0 ? 18 : 16; const int n_mla = BATCH * 4 * nqt, n_all = BATCH * 10 * nqt;
      unsigned* qctr = (unsigned*)ws + XB_QUEUE(l);
      for (;;) {
        __syncthreads();
        if (tid_opaque() == 0) *s_item = (int)xb_add(qctr, 1u);
        __syncthreads();
        const int it = *s_item;
        if (it >= n_all) break;
        const KARG_AS MegaP* kp2_ = (const KARG_AS MegaP*)__builtin_amdgcn_kernarg_segment_ptr(); LAUNDER_S(kp2_); char* ws2 = kp2_->ws;
        if (it < n_mla) { int qt = it / (BATCH * 4), r = it % (BATCH * 4);
          attn_block<96>((const bf16_t*)(ws2 + WO.mq), 4, (const bf16_t*)(ws2 + WO.mk), 4, (const bf16_t*)(ws2 + WO.mvT), 1, (bf16_t*)(ws2 + WO.tq), 0, r / 4, r % 4, qt, smem, (const float*)(ws2 + 16384) + l * 4); }
        else { int v = it - n_mla; int qt = v / (BATCH * 6), r = v % (BATCH * 6);
          attn_block<64>((const bf16_t*)(ws2 + WO.gq), 6, (const bf16_t*)(ws2 + WO.gk), 2, (const bf16_t*)(ws2 + WO.gvT), 3, (bf16_t*)(ws2 + WO.tq), 640, r / 6, r % 6, qt, smem, (const float*)(ws2 + 16384) + l * 4 + 1); }
      }
      if (!scan_role) scan_loop();
      {
        unsigned* cctr = (unsigned*)ws + XB_QUEUE(2 + l);
        for (;;) {
          __syncthreads();
          if (tid_opaque() == 0) *s_item = (int)xb_add(cctr, 1u);
          __syncthreads();
          const int it = *s_item;
          if (it >= 512) break;
          const int tab = it >> 8, r0 = (it & 255) * 64;
          if (tab == 0) ph_cvt_fp8_rows(I.pe_u + (long)l * 16384 * DM, WS_PTR(unsigned char, TAB_U), WS_PTR(float, TAB_SU), r0, r0 + 64);
          else ph_cvt_fp8_rows(I.pe_v + (long)l * 16384 * DM, WS_PTR(unsigned char, TAB_V), WS_PTR(float, TAB_SV), r0, r0 + 64);
        }
      }
    }
#if DIL_PH == 11
    GRID_BARRIER(); if (blockIdx.x == 0 && threadIdx.x == 0) { unsigned long long t1 = __builtin_amdgcn_s_memrealtime(); unsigned long long dt = dil_scan * DIL_MULT; while (__builtin_amdgcn_s_memrealtime() - t1 < dt) __builtin_amdgcn_s_sleep(32); }
#endif
    (void)dil_scan;
    DIL_END(5) }
    GRID_BARRIER();
    { DIL_BEGIN(6)
    PH(6) {
      KP_DECL; char* ws = kp_->ws; const int t = tid_opaque(); (void)t;
      RdW rw{I.rw_r_k + l * 384, I.rw_ln_g + l * 384, I.rw_ln_b + l * 384};
      for (long row = blockIdx.x * 4 + (t >> 6); row < NROWS; row += (long)gridDim.x * 4)
        if (l == 0 || (row % RB) < SEQ) rw_readout_row2(rw, WS_PTR(float, WO.Pb), WS_PTR(bf16_t, WO.r_b), WS_PTR(bf16_t, WO.v_b), WS_PTR(bf16_t, WO.kd_b), WS_PTR(bf16_t, WO.g_b), WS_PTR(bf16_t, WO.tq), row, t & 63);
    }
    DIL_END(6) }
    GRID_BARRIER();
    { DIL_BEGIN(7)
    PH(7) {
      KP_DECL; char* ws = kp_->ws; const int t = tid_opaque(); (void)t;
      const bf16_t* mix = WS_PTR(bf16_t, WO.tq); const bf16_t* wT = WS_PTR(bf16_t, WO.w_outT) + (long)l * 1024 * 1024; float* xs = WS_PTR(float, WO.xs);
      const float* modl = WS_PTR(float, WO.mod) + (long)l * (BATCH + 1) * 6144;
      const int TM7 = l == 0 ? TM : BATCH * 16;
      XCD_TILE_LOOP(tile, TM7 * 8)
        gemm_tile_128_glds(mix, DM, wT, 1024, 1024, l == 0 ? tile / 8 : LAT_TM(tile / 8), tile % 8, smem, EpiResid{xs, modl, 2, 0, l == 0 ? I.x : (const float*)nullptr, I.ctx});
    }
    DIL_END(7) }
    GRID_BARRIER();
    { DIL_BEGIN(8)
    PH(8) {
      KP_DECL; char* ws = kp_->ws; const int t = tid_opaque(); (void)t;
      ph_norm_mod(WS_PTR(float, WO.xs), I.norm_ffn_g + l * DM, WS_PTR(float, WO.mod) + (long)l * (BATCH + 1) * 6144, 3, WS_PTR(bf16_t, WO.xn), l != 0);
    }
    DIL_END(8) }
    GRID_BARRIER();
    { DIL_BEGIN(9)
    PH(9) {
      KP_DECL; char* ws = kp_->ws; const int t = tid_opaque(); (void)t;
      const bf16_t* xn = WS_PTR(bf16_t, WO.xn); const bf16_t* wT = WS_PTR(bf16_t, WO.wqT) + (long)l * 2048 * 1024; const bf16_t* kb = WS_PTR(bf16_t, WO.keysb) + (long)l * 16 * 128 * 128;
      unsigned* top1 = WS_PTR(unsigned, WO.tq);
      const int TM9 = l == 0 ? TM : BATCH * 16;
      XCD_TILE_LOOP(tile, TM9 * 16) { peer_q_top1_tile(xn, wT, kb, top1, l == 0 ? tile / 16 : LAT_TM(tile / 16), tile % 16, smem); __syncthreads(); }
    }
    DIL_END(9) }
    GRID_BARRIER();
    { DIL_BEGIN(10)
    PH(10) {
      KP_DECL; char* ws = kp_->ws; const int t = tid_opaque(); (void)t;
      const float* modl = WS_PTR(float, WO.mod) + (long)l * (BATCH + 1) * 6144;
      const int ntok10 = l == 0 ? NROWS : BATCH * SEQ;
      peer_lists_build3(WS_PTR(unsigned, WO.tq), WS_PTR(float, TAB_SU), WS_PTR(float, TAB_SV), WS_PTR(char, WO.mq), ntok10, smem);
#ifdef BUILD_TWICE
      peer_lists_build3(WS_PTR(unsigned, WO.tq), WS_PTR(float, TAB_SU), WS_PTR(float, TAB_SV), WS_PTR(char, WO.mq), ntok10, smem);
#endif
      peer_gather_sweep3(WS_PTR(bf16_t, WO.xn), WS_PTR(char, WO.mq), WS_PTR(unsigned char, TAB_U), WS_PTR(unsigned char, TAB_V), modl, WS_PTR(float, WO.xs), ntok10, smem,
                         I.norm_mix_g + (l == 0 ? DM : 0), WS_PTR(float, WO.mod) + (long)(l == 0 ? 1 : 0) * (BATCH + 1) * 6144, WS_PTR(bf16_t, WO.xn), l == 0 ? (float*)nullptr : kp_->out);
    }
    DIL_END(10) }
    GRID_BARRIER();
  }
}

extern "C" void kernel_launch(void* const* d_in, const int* in_sizes, int n_in, void* d_out, int out_size, void* d_ws, size_t ws_size,
                              hipStream_t stream) {
  MegaP p{};
  const float** pp = (const float**)&p.in;
  for (int i = 0; i < 31; ++i) pp[i] = (const float*)d_in[i];
  p.ws = (char*)d_ws; p.out = (float*)d_out;
  if (WO.total > ws_size) return;
  static int grid_blocks = 0;
  if (!grid_blocks) {
    int dev = 0, cus = 0, per_cu = 0;
    hipGetDevice(&dev);
    hipDeviceGetAttribute(&cus, hipDeviceAttributeMultiprocessorCount, dev);
    hipOccupancyMaxActiveBlocksPerMultiprocessor(&per_cu, mega_kernel, 256, 0);
    if (per_cu > 2) per_cu = 2;
    if (per_cu < 1) per_cu = 1;
    grid_blocks = cus * per_cu;
  }
  hipMemsetAsync(d_ws, 0, 32768, stream);
  void* args[] = {&p};
  hipLaunchCooperativeKernel((void*)mega_kernel, dim3(grid_blocks), dim3(256), args, 0, stream);
}
```

```cpp
#include <hip/hip_runtime.h>
#define PEER_EXP(x) __builtin_amdgcn_exp2f((x) * 1.4426950408889634f)
#ifndef BATCH
#define BATCH 8
#endif
#ifndef SEQ
#define SEQ 2048
#endif
#ifndef CTX_LEN
#define CTX_LEN 256
#endif
#define DM 1024
#define RB (SEQ + CTX_LEN)
#define NROWS (BATCH * RB)
#define IN_COLS 2624
#define MLA_OFF 0
#define RW_OFF 416
#define GQA_OFF 1984
#define RWC 1568
#define EPSN 1e-6f

__device__ inline float sigmoidf_(float x) { return 1.f / (1.f + expf(-x)); }
__device__ inline float siluf_(float x) { return x * sigmoidf_(x); }
__device__ inline float softplusf_(float x) { return fmaxf(x, 0.f) + log1pf(expf(-fabsf(x))); }
__device__ inline float geluf_(float x) { return 0.5f * x * (1.f + tanhf(0.7978845608028654f * (x + 0.044715f * x * x * x))); }

__global__ void nk_copy_in(const float* x, const float* ctx, float* xs) {
  long i = (long)blockIdx.x * blockDim.x + threadIdx.x;
  if (i >= (long)NROWS * DM) return;
  int d = i % DM; long row = i / DM; int b = row / RB, lr = row % RB;
  xs[i] = lr < SEQ ? x[((long)b * SEQ + lr) * DM + d] : ctx[((long)b * CTX_LEN + (lr - SEQ)) * DM + d];
}
__global__ void nk_copy_out(const float* xs, float* out) {
  long i = (long)blockIdx.x * blockDim.x + threadIdx.x;
  if (i >= (long)BATCH * SEQ * DM) return;
  int d = i % DM; long row = i / DM; int b = row / SEQ, t = row % SEQ;
  out[i] = xs[((long)b * RB + t) * DM + d];
}
__global__ void nk_mod(const float* c, const float* c_ctx, const float* ada_w, const float* ada_b, float* mod) {
  long i = (long)blockIdx.x * blockDim.x + threadIdx.x;
  if (i >= 2L * (BATCH + 1) * 6144) return;
  int j = i % 6144; int bb = (i / 6144) % (BATCH + 1); int l = i / (6144 * (BATCH + 1));
  const float* cv = bb < BATCH ? c + (long)bb * DM : c_ctx;
  const float* w = ada_w + (long)l * DM * 6144;
  float acc = 0.f;
  for (int k = 0; k < DM; ++k) acc += siluf_(cv[k]) * w[(long)k * 6144 + j];
  mod[i] = acc + ada_b[l * 6144 + j];
}
__global__ void nk_norm_mod(const float* xs, const float* g, const float* modl, int shift_idx, float* xn, int M, int bidx) {
  long row = (long)blockIdx.x * blockDim.x + threadIdx.x;
  if (row >= M) return;
  int lr = row % RB; int bb = lr < SEQ ? bidx : BATCH;
  const float* sh = modl + ((long)bb * 6 + shift_idx) * DM; const float* sc = sh + DM;
  const float* xr = xs + row * DM; float ss = 0.f;
  for (int d = 0; d < DM; ++d) ss += xr[d] * xr[d];
  float inv = 1.f / sqrtf(ss / DM + EPSN);
  for (int d = 0; d < DM; ++d) xn[row * DM + d] = xr[d] * inv * g[d] * (1.f + sc[d]) + sh[d];
}
__global__ void nk_gemm(const float* A, const float* W, float* C, int M, int N, int K) {
  long i = (long)blockIdx.x * blockDim.x + threadIdx.x;
  if (i >= (long)M * N) return;
  int n = i % N; long m = i / N; float acc = 0.f;
  for (int k = 0; k < K; ++k) acc += A[m * K + k] * W[(long)k * N + n];
  C[i] = acc;
}
__global__ void nk_mla_q1(const float* P, const float* qng, const float* wqb, float* tq, int M) {
  long i = (long)blockIdx.x * blockDim.x + threadIdx.x;
  if (i >= (long)M * 384) return;
  int j = i % 384; long r = i / 384; const float* cq = P + r * IN_COLS;
  float ss = 0.f; for (int k = 0; k < 256; ++k) ss += cq[k] * cq[k];
  float inv = 1.f / sqrtf(ss / 256 + EPSN), acc = 0.f;
  for (int k = 0; k < 256; ++k) acc += cq[k] * inv * qng[k] * wqb[k * 384 + j];
  tq[i] = acc;
}
__global__ void nk_mla_kv1(const float* P, const float* kvng, const float* wkvb, float* tkv, int M) {
  long i = (long)blockIdx.x * blockDim.x + threadIdx.x;
  if (i >= (long)M * 512) return;
  int j = i % 512; long r = i / 512; const float* ck = P + r * IN_COLS + 256;
  float ss = 0.f; for (int k = 0; k < 128; ++k) ss += ck[k] * ck[k];
  float inv = 1.f / sqrtf(ss / 128 + EPSN), acc = 0.f;
  for (int k = 0; k < 128; ++k) acc += ck[k] * inv * kvng[k] * wkvb[k * 512 + j];
  tkv[i] = acc;
}
__global__ void nk_mla_qk2(const float* P, const float* tq, const float* tkv, const float* qkg, float* mq, float* mk, int M) {
  long i = (long)blockIdx.x * blockDim.x + threadIdx.x;
  if (i >= (long)M * 8) return;
  int which = i % 2, h = (i / 2) % 4; long r = i / 8; int lr = r % RB;
  float ss = 0.f;
  for (int e = 0; e < 96; ++e) {
    float v = which == 0 ? tq[r * 384 + h * 96 + e] : (e < 64 ? tkv[r * 512 + h * 128 + e] : P[r * IN_COLS + 384 + (e - 64)]);
    ss += v * v;
  }
  float inv = 1.f / sqrtf(ss / 96 + EPSN);
  const float* g = qkg + which * 96; float* o = (which == 0 ? mq : mk) + r * 384 + h * 96;
  for (int e = 0; e < 64; ++e) {
    float v = which == 0 ? tq[r * 384 + h * 96 + e] : tkv[r * 512 + h * 128 + e];
    o[e] = v * inv * g[e];
  }
  for (int j = 0; j < 16; ++j) {
    float va = which == 0 ? tq[r * 384 + h * 96 + 64 + j] : P[r * IN_COLS + 384 + j];
    float vb = which == 0 ? tq[r * 384 + h * 96 + 80 + j] : P[r * IN_COLS + 384 + 16 + j];
    va *= inv * g[64 + j]; vb *= inv * g[80 + j];
    if (lr < SEQ) {
      int pos = j < 8 ? lr / 64 : lr % 64; float fr = powf(10000.f, -(float)(j & 7) / 8.f);
      float ang = (float)pos * fr, cs = cosf(ang), sn = sinf(ang);
      o[64 + j] = va * cs - vb * sn; o[80 + j] = va * sn + vb * cs;
    } else { o[64 + j] = va; o[80 + j] = vb; }
  }
}
__global__ void nk_gqa_prep(const float* P, const float* qkg, float* gq, float* gk, int M) {
  long i = (long)blockIdx.x * blockDim.x + threadIdx.x;
  if (i >= (long)M * 8) return;
  int h = i % 8; long r = i / 8; int lr = r % RB;
  const float* src = P + r * IN_COLS + GQA_OFF + h * 64;
  const float* g = qkg + (h < 6 ? 0 : 64);
  float* o = h < 6 ? gq + r * 384 + h * 64 : gk + r * 128 + (h - 6) * 64;
  float ss = 0.f; for (int e = 0; e < 64; ++e) ss += src[e] * src[e];
  float inv = 1.f / sqrtf(ss / 64 + EPSN);
  for (int j = 0; j < 32; ++j) {
    float va = src[j] * inv * g[j], vb = src[32 + j] * inv * g[32 + j];
    if (lr < SEQ) {
      int pos = j < 16 ? lr / 64 : lr % 64; float fr = powf(10000.f, -(float)(j & 15) / 16.f);
      float ang = (float)pos * fr, cs = cosf(ang), sn = sinf(ang);
      o[j] = va * cs - vb * sn; o[32 + j] = va * sn + vb * cs;
    } else { o[j] = va; o[32 + j] = vb; }
  }
}
template <int DQ>
__global__ void __launch_bounds__(256) nk_attn(const float* q, int qs, const float* k, int ks, const float* v, int vs, int vhs, int H, int G, float* mix, int ooff, int M) {
  long i = (long)blockIdx.x * blockDim.x + threadIdx.x;
  if (i >= (long)M * H) return;
  int h = i % H; long r = i / H; int b = r / RB, lr = r % RB; int kh = h / G;
  float qv[DQ];
#pragma unroll
  for (int e = 0; e < DQ; ++e) qv[e] = q[r * qs + h * DQ + e];
  float acc[64];
#pragma unroll
  for (int e = 0; e < 64; ++e) acc[e] = 0.f;
  float mx = -1e30f, l = 0.f; const float scale = 1.f / sqrtf((float)DQ);
  int k0 = lr < SEQ ? 0 : SEQ, k1 = RB;
  for (int kr = k0; kr < k1; ++kr) {
    long rr = (long)b * RB + kr; const float* kp = k + rr * ks + kh * DQ; float s = 0.f;
#pragma unroll
    for (int e = 0; e < DQ; ++e) s += qv[e] * kp[e];
    s *= scale;
    float mn = fmaxf(mx, s), al = expf(mx - mn), pp = expf(s - mn);
    l = l * al + pp; mx = mn; const float* vp = v + rr * vs + kh * vhs;
#pragma unroll
    for (int e = 0; e < 64; ++e) acc[e] = acc[e] * al + pp * vp[e];
  }
#pragma unroll
  for (int e = 0; e < 64; ++e) mix[r * DM + ooff + h * 64 + e] = acc[e] / l;
}
__global__ void nk_rw_shift(const float* P, const float* mu, float* rwx, int M) {
  long i = (long)blockIdx.x * blockDim.x + threadIdx.x;
  if (i >= (long)M * RWC) return;
  int c = i % RWC; long r = i / RWC; int lr = r % RB;
  bool first = (lr == 0) || (lr == SEQ), last = (lr == SEQ - 1) || (lr == RB - 1);
  float p = P[r * IN_COLS + RW_OFF + c];
  float pv = first ? 0.f : P[(r - 1) * IN_COLS + RW_OFF + c], nx = last ? 0.f : P[(r + 1) * IN_COLS + RW_OFF + c];
  rwx[i] = p + mu[c] * (pv - p) + mu[RWC + c] * (nx - p);
}
__global__ void nk_rw_prep(const float* rwx, const float* w0, const float* w2, const float* a0, const float* a2, const float* g2,
                           const float* k_k, const float* k_a, float* dec, float* kd, float* bd, float* kk, float* gg, int M) {
  long i = (long)blockIdx.x * blockDim.x + threadIdx.x;
  if (i >= (long)M * 384) return;
  int c = i % 384; long r = i / 384; int h = c / 64; const float* xr = rwx + r * RWC;
  float kv = xr[384 + c];
  float ss = 0.f; for (int n = 0; n < 64; ++n) { float t = xr[384 + h * 64 + n] * k_k[h * 64 + n]; ss += t * t; }
  float kkv = kv * k_k[c] / sqrtf(ss + 1e-12f);
  kk[i] = kkv;
  for (int d = 0; d < 2; ++d) {
    float wr = w0[d * 384 + c], ar = a0[d * 384 + c];
    for (int j = 0; j < 64; ++j) { wr += tanhf(xr[1152 + d * 64 + j]) * w2[(d * 64 + j) * 384 + c]; ar += xr[1280 + d * 64 + j] * a2[(d * 64 + j) * 384 + c]; }
    float dc = expf(-expf(-softplusf_(-wr) - 0.5f)); float a = sigmoidf_(ar);
    dec[(long)d * M * 384 + i] = dc; kd[(long)d * M * 384 + i] = kv * (1.f + (a - 1.f) * k_a[c]); bd[(long)d * M * 384 + i] = kkv * a;
  }
  float g = 0.f; for (int j = 0; j < 160; ++j) g += sigmoidf_(xr[1408 + j]) * g2[j * 384 + c];
  gg[i] = g;
}
__global__ void __launch_bounds__(256) nk_rw_scan(const float* rwx, const float* dec, const float* kd, const float* bd, const float* kk, float* y, int M, int nb) {
  long t = (long)blockIdx.x * blockDim.x + threadIdx.x;
  if (t >= (long)nb * 2 * 6 * 64) return;
  int i = t % 64, h = (t / 64) % 6, d = (t / 384) % 2, b = t / 768;
  float S[64];
#pragma unroll
  for (int j = 0; j < 64; ++j) S[j] = 0.f;
  for (int step = 0; step < RB; ++step) {
    int lr;
    if (step < CTX_LEN) lr = SEQ + (d == 0 ? step : CTX_LEN - 1 - step);
    else lr = d == 0 ? step - CTX_LEN : SEQ - 1 - (step - CTX_LEN);
    long r = (long)b * RB + lr; long o = (long)d * M * 384 + r * 384 + h * 64;
    const float* rp = rwx + r * RWC + h * 64; const float* wp = dec + o; const float* kp = kd + o; const float* bp = bd + o; const float* kkp = kk + r * 384 + h * 64;
    float vi = rwx[r * RWC + 768 + h * 64 + i];
    float skk = 0.f;
#pragma unroll
    for (int j = 0; j < 64; ++j) skk += S[j] * kkp[j];
    float yy = 0.f;
#pragma unroll
    for (int j = 0; j < 64; ++j) { S[j] = S[j] * wp[j] - skk * bp[j] + vi * kp[j]; yy += S[j] * rp[j]; }
    y[o + i] = yy;
  }
}
__global__ void nk_rw_readout(const float* rwx, const float* y, const float* kd, const float* gg, const float* r_k, const float* ln_g, const float* ln_b, float* mix, int M, long yds) {
  long i = (long)blockIdx.x * blockDim.x + threadIdx.x;
  if (i >= (long)M * 6) return;
  int h = i % 6; long r = i / 6; long o = r * 384 + h * 64; long ds = (long)M * 384;
  float mean = 0.f; for (int n = 0; n < 64; ++n) mean += y[o + n] + y[yds + o + n];
  mean /= 64.f;
  float var = 0.f, coef = 0.f;
  for (int n = 0; n < 64; ++n) {
    float yy = y[o + n] + y[yds + o + n] - mean; var += yy * yy;
    coef += rwx[r * RWC + h * 64 + n] * (kd[o + n] + kd[ds + o + n]) * r_k[h * 64 + n];
  }
  var /= 64.f; float inv = 1.f / sqrtf(var + 64e-5f);
  for (int n = 0; n < 64; ++n) {
    float yn = (y[o + n] + y[yds + o + n] - mean) * inv * ln_g[h * 64 + n] + ln_b[h * 64 + n];
    mix[r * DM + 256 + h * 64 + n] = (yn + coef * rwx[r * RWC + 768 + h * 64 + n]) * gg[o + n];
  }
}
__global__ void nk_gemm_res(const float* A, const float* W, const float* modl, int gi, float* xs, int M, int bidx) {
  long i = (long)blockIdx.x * blockDim.x + threadIdx.x;
  if (i >= (long)M * DM) return;
  int j = i % DM; long r = i / DM; int lr = r % RB; int bb = lr < SEQ ? bidx : BATCH;
  float acc = 0.f; for (int k = 0; k < DM; ++k) acc += A[r * DM + k] * W[(long)k * DM + j];
  xs[i] += modl[((long)bb * 6 + gi) * DM + j] * acc;
}
__global__ void nk_peer_score(const float* pq, const float* keys, float* sc, int M) {
  long i = (long)blockIdx.x * blockDim.x + threadIdx.x;
  if (i >= (long)M * 2048) return;
  int k = i % 128, ps = (i / 128) % 16; long r = i / 2048;
  const float* q = pq + r * 2048 + ps * 128; const float* ky = keys + ((long)ps * 128 + k) * 128;
  float acc = 0.f; for (int d = 0; d < 128; ++d) acc += q[d] * ky[d];
  sc[i] = acc;
}
__global__ void nk_peer_top1(const float* sc, float* ts, int* ti, int M) {
  long i = (long)blockIdx.x * blockDim.x + threadIdx.x;
  if (i >= (long)M * 16) return;
  const float* s = sc + i * 128; float pv = 3e38f; int pi = -1;
  for (int t = 0; t < 16; ++t) {
    float bv = -3e38f; int bi = -1;
    for (int k = 0; k < 128; ++k) {
      float v = s[k]; bool ok = (v < pv) || (v == pv && k > pi);
      if (ok && (bi < 0 || v > bv)) { bv = v; bi = k; }
    }
    ts[i * 16 + t] = bv; ti[i * 16 + t] = bi; pv = bv; pi = bi;
  }
}
__global__ void nk_peer_top2(const float* ts, const int* ti, int* pe, float* pg, int M) {
  long i = (long)blockIdx.x * blockDim.x + threadIdx.x;
  if (i >= (long)M * 8) return;
  const float* s1 = ts + i * 32; const float* s2 = s1 + 16; const int* i1 = ti + i * 32; const int* i2 = i1 + 16;
  float pv = 3e38f; int pi = -1; float mx = 0.f, sum = 0.f;
  for (int t = 0; t < 16; ++t) {
    float bv = -3e38f; int bi = -1;
    for (int c = 0; c < 256; ++c) {
      float v = s1[c / 16] + s2[c % 16]; bool ok = (v < pv) || (v == pv && c > pi);
      if (ok && (bi < 0 || v > bv)) { bv = v; bi = c; }
    }
    if (t == 0) mx = bv;
    float e = expf(bv - mx); sum += e;
    pe[i * 16 + t] = i1[bi / 16] * 128 + i2[bi % 16]; pg[i * 16 + t] = e; pv = bv; pi = bi;
  }
  for (int t = 0; t < 16; ++t) pg[i * 16 + t] /= sum;
}
__global__ void nk_peer_act(const float* xn, const float* u, const int* pe, const float* pg, float* pw, int M) {
  long i = (long)blockIdx.x * blockDim.x + threadIdx.x;
  if (i >= (long)M * 128) return;
  long r = i / 128; const float* ur = u + (long)pe[i] * DM; const float* xr = xn + r * DM;
  float acc = 0.f; for (int d = 0; d < DM; ++d) acc += xr[d] * ur[d];
  pw[i] = pg[i] * geluf_(acc);
}
__global__ void nk_peer_out(const float* v, const int* pe, const float* pw, const float* modl, float* xs, int M, int bidx) {
  long i = (long)blockIdx.x * blockDim.x + threadIdx.x;
  if (i >= (long)M * DM) return;
  int j = i % DM; long r = i / DM; int lr = r % RB; int bb = lr < SEQ ? bidx : BATCH;
  float acc = 0.f; for (int k = 0; k < 128; ++k) acc += pw[r * 128 + k] * v[(long)pe[r * 128 + k] * DM + j];
  xs[i] += modl[((long)bb * 6 + 5) * DM + j] * acc;
}


#ifndef PEER_EXP
#define PEER_EXP(x) expf(x)
#endif
__device__ __forceinline__ unsigned f2sortable(float s) { unsigned f = __float_as_uint(s); return (f & 0x80000000u) ? ~f : (f | 0x80000000u); }
__device__ __forceinline__ float sortable2f(unsigned o) { unsigned f = (o & 0x80000000u) ? (o & 0x7fffffffu) : ~o; return __uint_as_float(f); }
__device__ __forceinline__ unsigned enc_key(float s, int idx) { return (f2sortable(s) & ~127u) | (unsigned)(127 - idx); }
__device__ __forceinline__ void dec_key(unsigned k, float& s, int& idx) { idx = 127 - (int)(k & 127u); s = sortable2f(k & ~127u); }
__device__ __forceinline__ unsigned umax_(unsigned a, unsigned b) { return a > b ? a : b; }
__device__ __forceinline__ unsigned umin_(unsigned a, unsigned b) { return a < b ? a : b; }
__device__ __forceinline__ void ins16(unsigned (&l)[16], unsigned x) {
#pragma unroll
  for (int i = 0; i < 16; ++i) { unsigned mx = umax_(l[i], x); x = umin_(l[i], x); l[i] = mx; }
}
__device__ __forceinline__ void merge16(unsigned (&a)[16], const unsigned (&brev)[16]) {
#pragma unroll
  for (int i = 0; i < 16; ++i) a[i] = umax_(a[i], brev[i]);
#pragma unroll
  for (int d = 8; d >= 1; d >>= 1)
#pragma unroll
    for (int i = 0; i < 16; ++i) if ((i & d) == 0) { unsigned hi = umax_(a[i], a[i + d]), lo = umin_(a[i], a[i + d]); a[i] = hi; a[i + d] = lo; }
}
__device__ __forceinline__ void peer_combine(const unsigned* L0, const unsigned* L1, int* e_out, float* g_out) {
  float s0[16], s1[16];
#pragma unroll
  for (int i = 0; i < 16; ++i) { int ix; dec_key(L0[i], s0[i], ix); dec_key(L1[i], s1[i], ix); }
  unsigned sel[16];
#pragma unroll
  for (int i = 0; i < 16; ++i) sel[i] = 0u;
#pragma unroll
  for (int i = 0; i < 16; ++i)
#pragma unroll
    for (int j = 0; j < 16; ++j)
      if ((i + 1) * (j + 1) <= 16) { unsigned k = (f2sortable(s0[i] + s1[j]) & ~255u) | (unsigned)(255 - (i * 16 + j)); ins16(sel, k); }
  float mx = -3e38f;
#pragma unroll
  for (int t = 0; t < 16; ++t) {
    int c = 255 - (int)(sel[t] & 255u); int i = c >> 4, j = c & 15;
    float a, b; int ia, ib; dec_key(L0[i], a, ia); dec_key(L1[j], b, ib);
    float s = a + b; e_out[t] = ia * 128 + ib; g_out[t] = s; mx = fmaxf(mx, s);
  }
  float sum = 0.f;
#pragma unroll
  for (int t = 0; t < 16; ++t) { float e = PEER_EXP(g_out[t] - mx); g_out[t] = e; sum += e; }
  float inv = 1.f / sum;
#pragma unroll
  for (int t = 0; t < 16; ++t) g_out[t] *= inv;
}
__global__ void hk_peer_top1(const float* pq, const float* keys, unsigned* top1, int M) {
  long i = (long)blockIdx.x * blockDim.x + threadIdx.x;
  if (i >= (long)M * 16) return;
  int ps = i % 16; long r = i / 16; const float* q = pq + r * 2048 + ps * 128;
  unsigned la[16], lb[16], lbr[16];
#pragma unroll
  for (int t = 0; t < 16; ++t) { la[t] = 0u; lb[t] = 0u; }
  for (int k = 0; k < 128; ++k) {
    const float* ky = keys + ((long)ps * 128 + k) * 128; float acc = 0.f;
    for (int d = 0; d < 128; ++d) acc += q[d] * ky[d];
    unsigned key = enc_key(acc, k);
    if (k < 64) ins16(la, key); else ins16(lb, key);
  }
#pragma unroll
  for (int t = 0; t < 16; ++t) lbr[t] = lb[15 - t];
  merge16(la, lbr);
#pragma unroll
  for (int t = 0; t < 16; ++t) top1[i * 16 + t] = la[t];
}
__global__ void hk_peer_combine(const unsigned* top1, int* pe, float* pg, int M) {
  long i = (long)blockIdx.x * blockDim.x + threadIdx.x;
  if (i >= (long)M * 8) return;
  peer_combine(top1 + i * 32, top1 + i * 32 + 16, pe + i * 16, pg + i * 16);
}
typedef unsigned short bf16_t;
__device__ __forceinline__ int tid_opaque() { int t = threadIdx.x; asm volatile("" : "+v"(t)); return t; }
typedef __attribute__((ext_vector_type(8))) short bf16x8;
typedef __attribute__((ext_vector_type(4))) float f32x4;
typedef __attribute__((ext_vector_type(16))) float f32x16;
typedef __attribute__((ext_vector_type(4))) unsigned u32x4;

typedef __attribute__((ext_vector_type(2))) __bf16 bf16v2;
typedef __attribute__((ext_vector_type(2))) float f32v2;
template <int CTRL> __device__ __forceinline__ float dpp_get(float x) { return __builtin_bit_cast(float, __builtin_amdgcn_update_dpp(0, __builtin_bit_cast(int, x), CTRL, 0xf, 0xf, true)); }
__device__ __forceinline__ float swz_xor4(float x) { return __builtin_bit_cast(float, __builtin_amdgcn_ds_swizzle(__builtin_bit_cast(int, x), 0x101F)); }
__device__ __forceinline__ float xor4_get(float x) { const int xi = __builtin_bit_cast(int, x);
  int r = __builtin_amdgcn_update_dpp(xi, xi, 0x114, 0xf, 0xA, false); r = __builtin_amdgcn_update_dpp(r, xi, 0x104, 0xf, 0x5, false); return __builtin_bit_cast(float, r); }
__device__ __forceinline__ float xor16_sum(float x) { const unsigned xi = __builtin_bit_cast(unsigned, x); auto q = __builtin_amdgcn_permlane16_swap(xi, xi, false, false);
  return __builtin_bit_cast(float, (unsigned)q[0]) + __builtin_bit_cast(float, (unsigned)q[1]); }
__device__ __forceinline__ float xor32_sum(float x) { const unsigned xi = __builtin_bit_cast(unsigned, x); auto q = __builtin_amdgcn_permlane32_swap(xi, xi, false, false);
  return __builtin_bit_cast(float, (unsigned)q[0]) + __builtin_bit_cast(float, (unsigned)q[1]); }
__device__ __forceinline__ float xor32_max(float x) { const unsigned xi = __builtin_bit_cast(unsigned, x); auto q = __builtin_amdgcn_permlane32_swap(xi, xi, false, false);
  return fmaxf(__builtin_bit_cast(float, (unsigned)q[0]), __builtin_bit_cast(float, (unsigned)q[1])); }
__device__ __forceinline__ unsigned pack2bf(float a, float b) { f32v2 v = {a, b}; bf16v2 r = __builtin_convertvector(v, bf16v2); return __builtin_bit_cast(unsigned, r); }
__device__ __forceinline__ bf16_t f2bf(float f) { return (bf16_t)(pack2bf(f, 0.f) & 0xffffu); }
__device__ __forceinline__ float bf2f(bf16_t h) { return __uint_as_float(((unsigned)h) << 16); }

__device__ __forceinline__ float fexp_(float x) { return __builtin_amdgcn_exp2f(x * 1.4426950408889634f); }
__device__ __forceinline__ float frcp_(float x) { return __builtin_amdgcn_rcpf(x); }
__device__ __forceinline__ float fsigmoid_(float x) { return frcp_(1.f + fexp_(-x)); }
__device__ __forceinline__ float ftanh_(float x) { return 1.f - 2.f * frcp_(fexp_(2.f * x) + 1.f); }
__device__ __forceinline__ float fgelu_(float x) { return x * fsigmoid_(1.5957691216057308f * (x + 0.044715f * x * x * x)); }
__device__ __forceinline__ float fdecay_(float w) { return fexp_(-0.6065306597126334f * fsigmoid_(w)); }
#define GEMM_LDS_BYTES 32768
struct ALoadPlain { const bf16_t* A; int lda;
  __device__ __forceinline__ u32x4 operator()(int row, int k) const { return *(const u32x4*)(A + (long)row * lda + k); } };
#define GEMM_STAGE_WRITE(RA, RB) do { _Pragma("unroll") for (int i = 0; i < 4; ++i) { int r = lrow + 32 * i; int off = r * 128 + ((lchunk ^ (r & 7)) << 4); *(u32x4*)(As + off) = RA[i]; *(u32x4*)(Bs + off) = RB[i]; } } while (0)
#define GEMM_COMPUTE_TILE() do { _Pragma("unroll") for (int ks = 0; ks < 2; ++ks) { bf16x8 af[4], bfr[4]; \
    _Pragma("unroll") for (int i = 0; i < 4; ++i) { int r = wm * 64 + i * 16 + fr; af[i] = *(const bf16x8*)(As + r * 128 + (((ks * 4 + fq) ^ (r & 7)) << 4)); \
      int rn = wn * 64 + i * 16 + fr; bfr[i] = *(const bf16x8*)(Bs + rn * 128 + (((ks * 4 + fq) ^ (rn & 7)) << 4)); } \
    _Pragma("unroll") for (int i = 0; i < 4; ++i) _Pragma("unroll") for (int j = 0; j < 4; ++j) acc[i][j] = __builtin_amdgcn_mfma_f32_16x16x32_bf16(bfr[j], af[i], acc[i][j], 0, 0, 0); } } while (0)
template <class ALoad, class Epi>
__device__ __forceinline__ void gemm_tile_128(ALoad aload, const bf16_t* __restrict__ Bt, int ldb, int K,
                                              int tile_m, int tile_n, char* smem, Epi epi) {
  const int t = tid_opaque(), lane = t & 63, wave = t >> 6;
  const int wm = wave >> 1, wn = wave & 1;
  char* As = smem; char* Bs = smem + 16384;
  const int lrow = t >> 3, lchunk = t & 7;
  const int arow = tile_m * 128 + lrow;
  const bf16_t* bg = Bt + (long)(tile_n * 128 + lrow) * ldb + lchunk * 8;
  u32x4 ra0[4], rb0[4], ra1[4], rb1[4];
#pragma unroll
  for (int i = 0; i < 4; ++i) { ra0[i] = aload(arow + 32 * i, lchunk * 8); rb0[i] = *(const u32x4*)(bg + (long)(32 * i) * ldb); }
  if (K > 64) {
#pragma unroll
    for (int i = 0; i < 4; ++i) { ra1[i] = aload(arow + 32 * i, 64 + lchunk * 8); rb1[i] = *(const u32x4*)(bg + (long)(32 * i) * ldb + 64); }
  }
  f32x4 acc[4][4];
#pragma unroll
  for (int i = 0; i < 4; ++i)
#pragma unroll
    for (int j = 0; j < 4; ++j) acc[i][j] = (f32x4){0.f, 0.f, 0.f, 0.f};
  const int fr = lane & 15, fq = lane >> 4;
  for (int k0 = 0; k0 < K; k0 += 128) {
    __syncthreads();
    GEMM_STAGE_WRITE(ra0, rb0);
    __syncthreads();
    if (k0 + 128 < K) {
#pragma unroll
      for (int i = 0; i < 4; ++i) { ra0[i] = aload(arow + 32 * i, k0 + 128 + lchunk * 8); rb0[i] = *(const u32x4*)(bg + (long)(32 * i) * ldb + k0 + 128); }
    }
    GEMM_COMPUTE_TILE();
    if (k0 + 64 < K) {
      __syncthreads();
      GEMM_STAGE_WRITE(ra1, rb1);
      __syncthreads();
      if (k0 + 192 < K) {
#pragma unroll
        for (int i = 0; i < 4; ++i) { ra1[i] = aload(arow + 32 * i, k0 + 192 + lchunk * 8); rb1[i] = *(const u32x4*)(bg + (long)(32 * i) * ldb + k0 + 192); }
      }
      GEMM_COMPUTE_TILE();
    }
  }
#pragma unroll
  for (int i = 0; i < 4; ++i)
#pragma unroll
    for (int j = 0; j < 4; ++j) {
      int m = tile_m * 128 + wm * 64 + i * 16 + fr; int n0 = tile_n * 128 + wn * 64 + j * 16 + fq * 4;
      epi(m, n0, acc[i][j]);
    }
}

typedef __attribute__((address_space(3))) void lds_void_t;
typedef __attribute__((address_space(1))) const void glb_cvoid_t;
#define GEMM_GLDS_BYTES 65536
__device__ __forceinline__ void gemm_mainloop_glds(const bf16_t* __restrict__ A, int lda, const bf16_t* __restrict__ Bt, int ldb, int K,
                                                   int tile_m, int tile_n, char* smem, f32x4 (&acc)[4][4]) {
  const int t = tid_opaque(), lane = t & 63, wave = t >> 6;
  const int wm = wave >> 1, wn = wave & 1, fr = lane & 15, fq = lane >> 4;
  const int lrow = t >> 3, cl = (t & 7) ^ (lrow & 7);
  const bf16_t* ag = A + (long)(tile_m * 128 + lrow) * lda + cl * 8;
  const bf16_t* bg = Bt + (long)(tile_n * 128 + lrow) * ldb + cl * 8;
  const int wbase = __builtin_amdgcn_readfirstlane(wave) * 1024;
#pragma unroll
  for (int i = 0; i < 4; ++i)
#pragma unroll
    for (int j = 0; j < 4; ++j) acc[i][j] = (f32x4){0.f, 0.f, 0.f, 0.f};
  __syncthreads();
#pragma unroll
  for (int i = 0; i < 4; ++i) {
    __builtin_amdgcn_global_load_lds((glb_cvoid_t*)(ag + (long)(32 * i) * lda), (lds_void_t*)(smem + i * 4096 + wbase), 16, 0, 0);
    __builtin_amdgcn_global_load_lds((glb_cvoid_t*)(bg + (long)(32 * i) * ldb), (lds_void_t*)(smem + 16384 + i * 4096 + wbase), 16, 0, 0);
  }
  int buf = 0;
  for (int k0 = 0; k0 < K; k0 += 64, buf ^= 1) {
    __syncthreads();
    if (k0 + 64 < K) {
      char* nb = smem + (buf ^ 1) * 32768;
#pragma unroll
      for (int i = 0; i < 4; ++i) {
        __builtin_amdgcn_global_load_lds((glb_cvoid_t*)(ag + (long)(32 * i) * lda + k0 + 64), (lds_void_t*)(nb + i * 4096 + wbase), 16, 0, 0);
        __builtin_amdgcn_global_load_lds((glb_cvoid_t*)(bg + (long)(32 * i) * ldb + k0 + 64), (lds_void_t*)(nb + 16384 + i * 4096 + wbase), 16, 0, 0);
      }
    }
    const char* As = smem + buf * 32768; const char* Bs = As + 16384;
    GEMM_COMPUTE_TILE();
  }
}
template <class Epi>
__device__ __forceinline__ void gemm_tile_128_glds(const bf16_t* __restrict__ A, int lda, const bf16_t* __restrict__ Bt, int ldb, int K,
                                                   int tile_m, int tile_n, char* smem, Epi epi) {
  f32x4 acc[4][4];
  gemm_mainloop_glds(A, lda, Bt, ldb, K, tile_m, tile_n, smem, acc);
  const int t = tid_opaque(), lane = t & 63, wave = t >> 6, wm = wave >> 1, wn = wave & 1, fr = lane & 15, fq = lane >> 4;
#pragma unroll
  for (int i = 0; i < 4; ++i)
#pragma unroll
    for (int j = 0; j < 4; ++j) {
      int m = tile_m * 128 + wm * 64 + i * 16 + fr; int n0 = tile_n * 128 + wn * 64 + j * 16 + fq * 4;
      epi(m, n0, acc[i][j]);
    }
}

__global__ void ok_cvt_wT(const float* W, bf16_t* Wt, int K, int N, int Npad) {
  long i = (long)blockIdx.x * blockDim.x + threadIdx.x;
  if (i >= (long)Npad * K) return;
  int k = i % K; int n = i / K;
  Wt[i] = n < N ? f2bf(W[(long)k * N + n]) : (bf16_t)0;
}
__global__ void ok_f32_to_bf16(const float* s, bf16_t* d, long n) {
  long i = (long)blockIdx.x * blockDim.x + threadIdx.x; if (i < n) d[i] = f2bf(s[i]);
}
__global__ void ok_bf16_to_f32(const bf16_t* s, float* d, long n) {
  long i = (long)blockIdx.x * blockDim.x + threadIdx.x; if (i < n) d[i] = bf2f(s[i]);
}
__global__ void ok_norm_mod_bf16(const float* xs, const float* g, const float* modl, int shift_idx, bf16_t* xn, int M) {
  int row = blockIdx.x * 4 + (threadIdx.x >> 6); int lane = threadIdx.x & 63;
  if (row >= M) return;
  int b = row / RB, lr = row % RB; int bb = lr < SEQ ? b : BATCH;
  const float* sh = modl + ((long)bb * 6 + shift_idx) * DM; const float* sc = sh + DM;
  const float* xr = xs + (long)row * DM; float v[16]; float ss = 0.f;
#pragma unroll
  for (int i = 0; i < 4; ++i) { float4 q = *(const float4*)(xr + i * 256 + lane * 4); v[i*4]=q.x; v[i*4+1]=q.y; v[i*4+2]=q.z; v[i*4+3]=q.w; ss += q.x*q.x+q.y*q.y+q.z*q.z+q.w*q.w; }
#pragma unroll
  for (int o = 32; o > 0; o >>= 1) ss += __shfl_xor(ss, o);
  float inv = __builtin_amdgcn_rsqf(ss / DM + EPSN);
#pragma unroll
  for (int i = 0; i < 4; ++i) {
    int d = i * 256 + lane * 4; float o[4];
#pragma unroll
    for (int e = 0; e < 4; ++e) o[e] = v[i*4+e] * inv * g[d+e] * (1.f + sc[d+e]) + sh[d+e];
    uint2 pk; pk.x = pack2bf(o[0], o[1]); pk.y = pack2bf(o[2], o[3]);
    *(uint2*)(xn + (long)row * DM + d) = pk;
  }
}

struct EpiStoreBf16 { bf16_t* C; int ldc; int N;
  __device__ __forceinline__ void operator()(int m, int n0, f32x4 v) const {
    if (n0 < N) { uint2 pk; pk.x = pack2bf(v[0], v[1]); pk.y = pack2bf(v[2], v[3]); *(uint2*)(C + (long)m * ldc + n0) = pk; } } };
struct EpiStoreF32 { float* C; int ldc; int N;
  __device__ __forceinline__ void operator()(int m, int n0, f32x4 v) const {
    if (n0 < N) *(float4*)(C + (long)m * ldc + n0) = make_float4(v[0], v[1], v[2], v[3]); } };
struct EpiResid { float* xs; const float* modl; int gi; int pad; const float* x_in; const float* ctx_in;
  __device__ __forceinline__ void operator()(int m, int n0, f32x4 v) const {
    int b = m / RB, lr = m % RB; int bb = lr < SEQ ? b : BATCH; const float* g = modl + ((long)bb * 6 + gi) * DM + n0;
    const float* src = x_in ? (lr < SEQ ? x_in + ((long)b * SEQ + lr) * DM + n0 : ctx_in + ((long)b * CTX_LEN + (lr - SEQ)) * DM + n0) : xs + (long)m * DM + n0;
    f32x4 x = *(const f32x4*)src;
    x[0] += g[0] * v[0]; x[1] += g[1] * v[1]; x[2] += g[2] * v[2]; x[3] += g[3] * v[3];
    *(f32x4*)(xs + (long)m * DM + n0) = x; } };

template <class Epi>
__global__ void __launch_bounds__(256) ok_gemm(const bf16_t* A, int lda, const bf16_t* Bt, int ldb, int K, int tiles_m, int tiles_n, Epi epi) {
  __shared__ __attribute__((aligned(16))) char smem[GEMM_LDS_BYTES];
  for (int tile = blockIdx.x; tile < tiles_m * tiles_n; tile += gridDim.x) {
    int tm = tile / tiles_n, tn = tile % tiles_n;
    gemm_tile_128(ALoadPlain{A, lda}, Bt, ldb, K, tm, tn, smem, epi);
  }
}

__device__ __forceinline__ float dot2bf(unsigned a, unsigned b, float c) {
  return __builtin_amdgcn_fdot2_f32_bf16(*(bf16v2*)&a, *(bf16v2*)&b, c, false);
}
__global__ void ok_cvt_bf16_v8(const float* s, bf16_t* d, long n8) {
  long i = (long)blockIdx.x * blockDim.x + threadIdx.x; if (i >= n8) return;
  float4 a = *(const float4*)(s + i * 8), b = *(const float4*)(s + i * 8 + 4);
  u32x4 o; o[0] = pack2bf(a.x, a.y); o[1] = pack2bf(a.z, a.w); o[2] = pack2bf(b.x, b.y); o[3] = pack2bf(b.z, b.w);
  *(u32x4*)(d + i * 8) = o;
}

#define P5_LDS_BYTES (128 * 128 * 4)
__device__ __forceinline__ void peer_q_top1_tile(const bf16_t* __restrict__ A, const bf16_t* __restrict__ WqT, const bf16_t* __restrict__ keysb,
                                                 unsigned* __restrict__ top1, int tm, int ps, char* smem) {
  const int t = tid_opaque(), lane = t & 63, wave = t >> 6, wm = wave >> 1, wn = wave & 1, fr = lane & 15, fq = lane >> 4;
  f32x4 acc[4][4];
  gemm_mainloop_glds(A, DM, WqT, DM, DM, tm, ps, smem, acc);
  __syncthreads();
  char* Qs = smem; char* Ks = smem + 32768;
#pragma unroll
  for (int i = 0; i < 4; ++i)
#pragma unroll
    for (int j = 0; j < 4; ++j) {
      int m = wm * 64 + i * 16 + fr; int n0 = wn * 64 + j * 16 + fq * 4;
      uint2 pk; pk.x = pack2bf(acc[i][j][0], acc[i][j][1]); pk.y = pack2bf(acc[i][j][2], acc[i][j][3]);
      *(uint2*)(Qs + m * 256 + ((((n0 >> 3) ^ (m & 15)) << 4) | ((n0 & 7) << 1))) = pk;
    }
  {
    const bf16_t* kg = keysb + (long)ps * 128 * 128;
#pragma unroll
    for (int i = 0; i < 8; ++i) { int idx = t + 256 * i; int r = idx >> 4, c = idx & 15; *(u32x4*)(Ks + r * 256 + ((c ^ (r & 15)) << 4)) = *(const u32x4*)(kg + r * 128 + c * 8); }
  }
  __syncthreads();
#pragma unroll
  for (int i = 0; i < 4; ++i)
#pragma unroll
    for (int j = 0; j < 4; ++j) acc[i][j] = (f32x4){0.f, 0.f, 0.f, 0.f};
#pragma unroll
  for (int ks = 0; ks < 4; ++ks) {
    bf16x8 af[4], bfr[4];
#pragma unroll
    for (int i = 0; i < 4; ++i) {
      int r = wm * 64 + i * 16 + fr; af[i] = *(const bf16x8*)(Qs + r * 256 + (((ks * 4 + fq) ^ (r & 15)) << 4));
      int rn = wn * 64 + i * 16 + fr; bfr[i] = *(const bf16x8*)(Ks + rn * 256 + (((ks * 4 + fq) ^ (rn & 15)) << 4));
    }
#pragma unroll
    for (int i = 0; i < 4; ++i)
#pragma unroll
      for (int j = 0; j < 4; ++j) acc[i][j] = __builtin_amdgcn_mfma_f32_16x16x32_bf16(bfr[j], af[i], acc[i][j], 0, 0, 0);
  }
  __syncthreads();
  unsigned* Sc = (unsigned*)smem;
#pragma unroll
  for (int i = 0; i < 4; ++i)
#pragma unroll
    for (int j = 0; j < 4; ++j) {
      int m = wm * 64 + i * 16 + fr; int n0 = wn * 64 + j * 16 + fq * 4;
#pragma unroll
      for (int e = 0; e < 4; ++e) Sc[(n0 + e) * 128 + (m ^ ((((n0 + e) >> 2) & 1) << 4))] = enc_key(acc[i][j][e], n0 + e);
    }
  __syncthreads();
  {
    const int r = t & 127, half = t >> 7;
    unsigned l[16];
#pragma unroll
    for (int i = 0; i < 16; ++i) l[i] = 0u;
    for (int k = 0; k < 64; ++k) ins16(l, Sc[(half * 64 + k) * 128 + (r ^ (((k >> 2) & 1) << 4))]);
    __syncthreads();
    unsigned* Ls = (unsigned*)smem;
    if (half == 1) {
#pragma unroll
      for (int i = 0; i < 16; ++i) Ls[r * 17 + i] = l[15 - i];
    }
    __syncthreads();
    if (half == 0) {
      unsigned br[16];
#pragma unroll
      for (int i = 0; i < 16; ++i) br[i] = Ls[r * 17 + i];
      merge16(l, br);
      unsigned* o = top1 + ((long)(tm * 128 + r) * 16 + ps) * 16;
#pragma unroll
      for (int i = 0; i < 4; ++i) { u32x4 v; v[0] = l[4*i]; v[1] = l[4*i+1]; v[2] = l[4*i+2]; v[3] = l[4*i+3]; *(u32x4*)(o + 4 * i) = v; }
    }
  }
}
__global__ void __launch_bounds__(256) ok_peer_q_top1(const bf16_t* A, const bf16_t* WqT, const bf16_t* keysb, unsigned* top1, int tiles_m) {
  __shared__ __attribute__((aligned(16))) char smem[P5_LDS_BYTES];
  for (int tile = blockIdx.x; tile < tiles_m * 16; tile += gridDim.x) { peer_q_top1_tile(A, WqT, keysb, top1, tile / 16, tile % 16, smem); __syncthreads(); }
}

#define P6_LDS_BYTES (32 * 128 * 4 * 3)
__device__ __forceinline__ void peer_gather_group(const bf16_t* __restrict__ xn, const unsigned* __restrict__ top1, const bf16_t* __restrict__ ub,
                                                  const bf16_t* __restrict__ vb, const float* __restrict__ modl, float* __restrict__ xs, int grp, char* smem) {
  const int t = tid_opaque(), lane = t & 63, wave = t >> 6;
  int* pe_l = (int*)smem; float* pg_l = (float*)(smem + 32 * 128 * 4); float* pw_l = (float*)(smem + 2 * 32 * 128 * 4);
  {
    int tl = t >> 3, p = t & 7; long row = (long)grp * 32 + tl;
    peer_combine(top1 + (row * 16 + p * 2) * 16, top1 + (row * 16 + p * 2 + 1) * 16, pe_l + tl * 128 + p * 16, pg_l + tl * 128 + p * 16);
  }
  __syncthreads();
  for (int ti = 0; ti < 8; ++ti) {
    const int tl = wave * 8 + ti; const long row = (long)grp * 32 + tl;
    const int* pe = pe_l + tl * 128; float* pw = pw_l + tl * 128;
    u32x4 h0 = *(const u32x4*)(xn + row * DM + lane * 8), h1 = *(const u32x4*)(xn + row * DM + 512 + lane * 8);
    for (int b = 0; b < 16; ++b) {
      u32x4 u0[8], u1[8];
#pragma unroll
      for (int j = 0; j < 8; ++j) { const bf16_t* ur = ub + (long)pe[b * 8 + j] * DM + lane * 8; u0[j] = *(const u32x4*)ur; u1[j] = *(const u32x4*)(ur + 512); }
      float pd[8];
#pragma unroll
      for (int j = 0; j < 8; ++j) {
        float a = 0.f;
#pragma unroll
        for (int e = 0; e < 4; ++e) { a = dot2bf(h0[e], u0[j][e], a); a = dot2bf(h1[e], u1[j][e], a); }
        pd[j] = a;
      }
      float q4[4], q2[2], q1;
#pragma unroll
      for (int j = 0; j < 4; ++j) { bool hi = lane & 1; float keep = hi ? pd[2*j+1] : pd[2*j], send = hi ? pd[2*j] : pd[2*j+1]; q4[j] = keep + __shfl_xor(send, 1); }
#pragma unroll
      for (int j = 0; j < 2; ++j) { bool hi = lane & 2; float keep = hi ? q4[2*j+1] : q4[2*j], send = hi ? q4[2*j] : q4[2*j+1]; q2[j] = keep + __shfl_xor(send, 2); }
      { bool hi = lane & 4; float keep = hi ? q2[1] : q2[0], send = hi ? q2[0] : q2[1]; q1 = keep + __shfl_xor(send, 4); }
      q1 += __shfl_xor(q1, 8); q1 += __shfl_xor(q1, 16); q1 += __shfl_xor(q1, 32);
      if (lane < 8) { int j = lane & 7; pw[b * 8 + j] = q1; }
    }
    {
      float d0 = pw[lane], d1 = pw[64 + lane];
      pw[lane] = pg_l[tl * 128 + lane] * fgelu_(d0); pw[64 + lane] = pg_l[tl * 128 + 64 + lane] * fgelu_(d1);
    }
    float o[16];
#pragma unroll
    for (int e = 0; e < 16; ++e) o[e] = 0.f;
    for (int b = 0; b < 16; ++b) {
      u32x4 v0[8], v1[8];
#pragma unroll
      for (int j = 0; j < 8; ++j) { const bf16_t* vr = vb + (long)pe[b * 8 + j] * DM + lane * 8; v0[j] = *(const u32x4*)vr; v1[j] = *(const u32x4*)(vr + 512); }
#pragma unroll
      for (int j = 0; j < 8; ++j) {
        float w = pw[b * 8 + j];
#pragma unroll
        for (int e = 0; e < 4; ++e) {
          o[2*e]     += w * __uint_as_float(v0[j][e] << 16); o[2*e+1]     += w * __uint_as_float(v0[j][e] & 0xffff0000u);
          o[8 + 2*e] += w * __uint_as_float(v1[j][e] << 16); o[8 + 2*e+1] += w * __uint_as_float(v1[j][e] & 0xffff0000u);
        }
      }
    }
    {
      int b = row / RB, lr = row % RB; int bb = lr < SEQ ? b : BATCH; const float* g5 = modl + ((long)bb * 6 + 5) * DM;
      float* xr = xs + row * DM;
#pragma unroll
      for (int hf = 0; hf < 2; ++hf) {
        int d = hf * 512 + lane * 8;
        float4 x0 = *(float4*)(xr + d), x1 = *(float4*)(xr + d + 4); float4 g0 = *(const float4*)(g5 + d), g1 = *(const float4*)(g5 + d + 4);
        x0.x += g0.x * o[hf*8+0]; x0.y += g0.y * o[hf*8+1]; x0.z += g0.z * o[hf*8+2]; x0.w += g0.w * o[hf*8+3];
        x1.x += g1.x * o[hf*8+4]; x1.y += g1.y * o[hf*8+5]; x1.z += g1.z * o[hf*8+6]; x1.w += g1.w * o[hf*8+7];
        *(float4*)(xr + d) = x0; *(float4*)(xr + d + 4) = x1;
      }
    }
  }
}
__global__ void __launch_bounds__(256) ok_peer_gather(const bf16_t* xn, const unsigned* top1, const bf16_t* ub, const bf16_t* vb, const float* modl, float* xs, int ngroups) {
  __shared__ __attribute__((aligned(16))) char smem[P6_LDS_BYTES];
  for (int g = blockIdx.x; g < ngroups; g += gridDim.x) { peer_gather_group(xn, top1, ub, vb, modl, xs, g, smem); __syncthreads(); }
}

template <int DQ> struct AttnCfg { static constexpr int KROW = DQ * 2 + 16; static constexpr int VROW = 136; static constexpr int KBYTES = 64 * KROW; static constexpr int LDS = 64 * KROW + 64 * VROW; };
#define ATTN_LDS_BYTES (64 * 208 + 64 * 136)
__device__ __forceinline__ void attn_score_bound(const float* __restrict__ qk_g, int DQ, float sqrt_dq, float* __restrict__ dst, int lane) {
  float gq = 0.f, gk = 0.f;
  for (int i = lane; i < DQ; i += 64) { gq = fmaxf(gq, fabsf(qk_g[i])); gk = fmaxf(gk, fabsf(qk_g[DQ + i])); }
#pragma unroll
  for (int o_ = 32; o_ > 0; o_ >>= 1) { gq = fmaxf(gq, __shfl_xor(gq, o_)); gk = fmaxf(gk, __shfl_xor(gk, o_)); }
  if (lane == 0) *dst = -fminf(1.02f * 1.4426950408889634f * sqrt_dq * gq * gk, 60.f);
}
template <int DQ>
__device__ __forceinline__ void attn_block(const bf16_t* __restrict__ qb, int HQ, const bf16_t* __restrict__ kb, int HK, const bf16_t* __restrict__ vT, int G,
                                           bf16_t* __restrict__ mixall, int ooff, int b, int head, int qt, char* smem, const float* __restrict__ negC_p) {
  constexpr int KROW = AttnCfg<DQ>::KROW, VROW = 136, NKK = DQ / 16, KCH = DQ / 8;
  constexpr int KLD = (64 * KCH) / 256;
  const int t = tid_opaque(), lane = t & 63, wave = t >> 6, lq = lane & 31, lh = lane >> 5;
  const int hk = head / G;
  char* Ks = smem; char* Vs = smem + 64 * KROW;
  const float negC = *negC_p;
  const long qrow = (long)b * RB + qt * 128 + wave * 32 + lq;
  bf16x8 qf[NKK];
#pragma unroll
  for (int kk = 0; kk < NKK; ++kk) qf[kk] = *(const bf16x8*)(qb + (qrow * HQ + head) * DQ + kk * 16 + lh * 8);
  const int key0 = qt < 16 ? 0 : SEQ; const int nt = qt < 16 ? RB / 64 : CTX_LEN / 64;
  const bf16_t* kp[KLD]; const bf16_t* vp_[2];
#pragma unroll
  for (int i = 0; i < KLD; ++i) { int c = t + 256 * i; int r = c / KCH, cc = c % KCH; kp[i] = kb + ((long)b * RB * HK + hk) * DQ + (long)(key0 + r) * HK * DQ + cc * 8; }
#pragma unroll
  for (int i = 0; i < 2; ++i) { int c = t + 256 * i; int r = c >> 3, cc = c & 7; vp_[i] = vT + ((long)(b * HK + hk) * 64 + r) * RB + key0 + cc * 8; }
  u32x4 rk[KLD], rv[2];
#pragma unroll
  for (int i = 0; i < KLD; ++i) { rk[i] = *(const u32x4*)kp[i]; kp[i] += 64 * HK * DQ; }
#pragma unroll
  for (int i = 0; i < 2; ++i) { rv[i] = *(const u32x4*)vp_[i]; vp_[i] += 64; }
  f32x16 ot[2];
#pragma unroll
  for (int d = 0; d < 2; ++d)
#pragma unroll
    for (int r = 0; r < 16; ++r) ot[d][r] = 0.f;
  float lrun = 0.f;
  for (int tile = 0; tile < nt; ++tile) {
    __syncthreads();
#pragma unroll
    for (int i = 0; i < KLD; ++i) { int c = t + 256 * i; int r = c / KCH, cc = c % KCH; *(u32x4*)(Ks + r * KROW + cc * 16) = rk[i]; }
#pragma unroll
    for (int i = 0; i < 2; ++i) { int c = t + 256 * i; int r = c >> 3, cc = c & 7; *(uint2*)(Vs + r * VROW + cc * 16) = make_uint2(rv[i][0], rv[i][1]); *(uint2*)(Vs + r * VROW + cc * 16 + 8) = make_uint2(rv[i][2], rv[i][3]); }
    __syncthreads();
    if (tile + 1 < nt) {
#pragma unroll
      for (int i = 0; i < KLD; ++i) { rk[i] = *(const u32x4*)kp[i]; kp[i] += 64 * HK * DQ; }
#pragma unroll
      for (int i = 0; i < 2; ++i) { rv[i] = *(const u32x4*)vp_[i]; vp_[i] += 64; }
    }
    f32x16 st[2];
#pragma unroll
    for (int kt = 0; kt < 2; ++kt) {
#pragma unroll
      for (int r = 0; r < 16; ++r) st[kt][r] = negC;
#pragma unroll
      for (int kk = 0; kk < NKK; ++kk) {
        bf16x8 ka = *(const bf16x8*)(Ks + (kt * 32 + lq) * KROW + kk * 32 + lh * 16);
        st[kt] = __builtin_amdgcn_mfma_f32_32x32x16_bf16(ka, qf[kk], st[kt], 0, 0, 0);
      }
    }
    float ps = 0.f;
#pragma unroll
    for (int kt = 0; kt < 2; ++kt)
#pragma unroll
      for (int r = 0; r < 16; ++r) { float p = __builtin_amdgcn_exp2f(st[kt][r]); st[kt][r] = p; ps += p; }
    lrun += ps;
#pragma unroll
    for (int kt = 0; kt < 2; ++kt)
#pragma unroll
      for (int s = 0; s < 2; ++s) {
        union { bf16x8 v; unsigned u[4]; } pb;
#pragma unroll
        for (int j = 0; j < 4; ++j) pb.u[j] = pack2bf(st[kt][8 * s + 2 * j], st[kt][8 * s + 2 * j + 1]);
#pragma unroll
        for (int d = 0; d < 2; ++d) {
          const char* vp = Vs + (d * 32 + lq) * VROW + (kt * 32 + 16 * s + 4 * lh) * 2;
          union { bf16x8 v; uint2 h[2]; } va; va.h[0] = *(const uint2*)vp; va.h[1] = *(const uint2*)(vp + 16);
          ot[d] = __builtin_amdgcn_mfma_f32_32x32x16_bf16(va.v, pb.v, ot[d], 0, 0, 0);
        }
      }
  }
  float ltot = xor32_sum(lrun); float inv = 1.f / ltot;
  bf16_t* orow = mixall + qrow * DM + ooff + head * 64;
#pragma unroll
  for (int d = 0; d < 2; ++d)
#pragma unroll
    for (int g = 0; g < 4; ++g) {
      uint2 pk; pk.x = pack2bf(ot[d][4 * g] * inv, ot[d][4 * g + 1] * inv); pk.y = pack2bf(ot[d][4 * g + 2] * inv, ot[d][4 * g + 3] * inv);
      *(uint2*)(orow + d * 32 + 8 * g + 4 * lh) = pk;
    }
}
__global__ void ok_adapt_rows(const float* src, int sld, int scol, int ncols, float scale, bf16_t* dst, int dld, int nrows) {
  long i = (long)blockIdx.x * blockDim.x + threadIdx.x; if (i >= (long)nrows * ncols) return;
  int c = i % ncols; long r = i / ncols; dst[r * dld + c] = f2bf(src[r * sld + scol + c] * scale);
}
__global__ void ok_adapt_vT(const float* src, int sld, int scol, int hstride, int H, bf16_t* dst) {
  long i = (long)blockIdx.x * blockDim.x + threadIdx.x; if (i >= (long)H * 64 * RB) return;
  int lr = i % RB; int d = (i / RB) % 64; int h = i / ((long)RB * 64);
  dst[i] = f2bf(src[(long)lr * sld + scol + h * hstride + d]);
}

typedef __attribute__((ext_vector_type(2))) float f32x2;
#define SCAN_TS 16
#define SCAN_LDS_BYTES (2 * SCAN_TS * 1536 + 2 * SCAN_TS * 32 * 4)
__device__ __forceinline__ float reduce8(float x) {
  x += __builtin_bit_cast(float, __builtin_amdgcn_update_dpp(0, __builtin_bit_cast(int, x), 0xB1, 0xf, 0xf, true));
  x += __builtin_bit_cast(float, __builtin_amdgcn_update_dpp(0, __builtin_bit_cast(int, x), 0x4E, 0xf, 0xf, true));
  x += __builtin_bit_cast(float, __builtin_amdgcn_update_dpp(0, __builtin_bit_cast(int, x), 0x141, 0xf, 0xf, true));
  return x;
}
__device__ __forceinline__ int scan_row(int dir, int s) {
  if (s < CTX_LEN) return SEQ + (dir == 0 ? s : CTX_LEN - 1 - s);
  return dir == 0 ? s - CTX_LEN : SEQ - 1 - (s - CTX_LEN);
}
__device__ __forceinline__ void rw_scan_block(const bf16_t* __restrict__ r_, const bf16_t* __restrict__ v_, const bf16_t* __restrict__ kk_, const bf16_t* __restrict__ kd_,
                                              const bf16_t* __restrict__ bd_, const float* __restrict__ w_, float* __restrict__ y_, int item, long dstride, char* smem) {
  const int t = tid_opaque(), lane = t & 63, wave = t >> 6, cg = lane & 7, il = wave * 8 + (lane >> 3);
  const int half = item & 1, dir = (item >> 1) & 1, h = (item >> 2) % 6, b = item / 24;
  const long rowbase = (long)b * RB; const int col0 = h * 64;
  float* ybuf = (float*)(smem + 2 * SCAN_TS * 1536);
  const int st_ld = t >> 4, part = t & 15;
  u32x4 la, lb, lc, lw;
  auto issue = [&](int c) {
    long row = rowbase + scan_row(dir, c * SCAN_TS + st_ld); long o = row * 384 + col0;
    const int ch = (part & 7) * 8;
    la = *(const u32x4*)((part < 8 ? kk_ + o : bd_ + dir * dstride + o) + ch);
    lb = *(const u32x4*)((part < 8 ? kd_ + dir * dstride + o : r_ + o) + ch);
    lc = *(const u32x4*)(v_ + o + ch);
    lw = *(const u32x4*)(w_ + dir * dstride + o + part * 4);
  };
  auto stash = [&](int buf) {
    float* base = (float*)(smem + buf * SCAN_TS * 1536 + st_ld * 1536);
    const int ch = (part & 7) * 8;
    float* pa = base + (part < 8 ? 64 : 128) + ch; float* pb = base + (part < 8 ? 192 : 256) + ch;
    f32x4 x0, x1;
#pragma unroll
    for (int e = 0; e < 2; ++e) { x0[2*e] = __uint_as_float(la[e] << 16); x0[2*e+1] = __uint_as_float(la[e] & 0xffff0000u); x1[2*e] = __uint_as_float(la[2+e] << 16); x1[2*e+1] = __uint_as_float(la[2+e] & 0xffff0000u); }
    *(f32x4*)pa = x0; *(f32x4*)(pa + 4) = x1;
#pragma unroll
    for (int e = 0; e < 2; ++e) { x0[2*e] = __uint_as_float(lb[e] << 16); x0[2*e+1] = __uint_as_float(lb[e] & 0xffff0000u); x1[2*e] = __uint_as_float(lb[2+e] << 16); x1[2*e+1] = __uint_as_float(lb[2+e] & 0xffff0000u); }
    *(f32x4*)pb = x0; *(f32x4*)(pb + 4) = x1;
    if (part < 8) {
      float* pc = base + 320 + ch;
#pragma unroll
      for (int e = 0; e < 2; ++e) { x0[2*e] = __uint_as_float(lc[e] << 16); x0[2*e+1] = __uint_as_float(lc[e] & 0xffff0000u); x1[2*e] = __uint_as_float(lc[2+e] << 16); x1[2*e+1] = __uint_as_float(lc[2+e] & 0xffff0000u); }
      *(f32x4*)pc = x0; *(f32x4*)(pc + 4) = x1;
    }
    *(u32x4*)(base + part * 4) = lw;
  };
  f32x2 S[4];
#pragma unroll
  for (int j = 0; j < 4; ++j) S[j] = (f32x2){0.f, 0.f};
  const int NCH = RB / SCAN_TS;
  __builtin_amdgcn_s_setprio(3);
  issue(0);
  for (int c = 0; c < NCH; ++c) {
    const int buf = c & 1;
    stash(buf);
    __syncthreads();
    if (c > 0 && t < 128) {
      int st = t >> 3, i4 = (t & 7) * 4; long row = rowbase + scan_row(dir, (c - 1) * SCAN_TS + st);
      *(f32x4*)(y_ + dir * dstride + row * 384 + col0 + half * 32 + i4) = *(const f32x4*)(ybuf + (buf ^ 1) * SCAN_TS * 32 + st * 32 + i4);
    }
    if (c + 1 < NCH) issue(c + 1);
    const float* ob = (const float*)(smem + buf * SCAN_TS * 1536) + cg * 8;
    const float* vb_ = (const float*)(smem + buf * SCAN_TS * 1536) + 320 + half * 32 + il;
    float yk[SCAN_TS];
    f32x4 nw0 = *(const f32x4*)(ob), nw1 = *(const f32x4*)(ob + 4), nk0 = *(const f32x4*)(ob + 64), nk1 = *(const f32x4*)(ob + 68);
    f32x4 nb0 = *(const f32x4*)(ob + 128), nb1 = *(const f32x4*)(ob + 132), nd0 = *(const f32x4*)(ob + 192), nd1 = *(const f32x4*)(ob + 196);
    f32x4 nr0 = *(const f32x4*)(ob + 256), nr1 = *(const f32x4*)(ob + 260); float nvi = vb_[0];
#pragma unroll
    for (int st = 0; st < SCAN_TS; ++st) {
      const f32x4 w0 = nw0, w1 = nw1, k0 = nk0, k1 = nk1, b0 = nb0, b1 = nb1, d0 = nd0, d1 = nd1, r0 = nr0, r1 = nr1; const float vi = nvi;
      if (st + 1 < SCAN_TS) {
        const float* o = ob + (st + 1) * 384;
        nw0 = *(const f32x4*)(o); nw1 = *(const f32x4*)(o + 4); nk0 = *(const f32x4*)(o + 64); nk1 = *(const f32x4*)(o + 68);
        nb0 = *(const f32x4*)(o + 128); nb1 = *(const f32x4*)(o + 132); nd0 = *(const f32x4*)(o + 192); nd1 = *(const f32x4*)(o + 196);
        nr0 = *(const f32x4*)(o + 256); nr1 = *(const f32x4*)(o + 260); nvi = vb_[(st + 1) * 384];
      }
      __builtin_amdgcn_sched_barrier(0);
      f32x2 a2 = S[0] * (f32x2){k0[0], k0[1]}, c2 = S[2] * (f32x2){k1[0], k1[1]};
      a2 += S[1] * (f32x2){k0[2], k0[3]}; c2 += S[3] * (f32x2){k1[2], k1[3]};
      a2 += c2;
      const f32x2 vv = (f32x2){vi, vi};
      f32x2 t0 = vv * (f32x2){d0[0], d0[1]}, t1 = vv * (f32x2){d0[2], d0[3]}, t2 = vv * (f32x2){d1[0], d1[1]}, t3 = vv * (f32x2){d1[2], d1[3]};
      float skk = reduce8(a2[0] + a2[1]);
      const f32x2 ns = (f32x2){-skk, -skk};
      t0 += ns * (f32x2){b0[0], b0[1]}; t1 += ns * (f32x2){b0[2], b0[3]}; t2 += ns * (f32x2){b1[0], b1[1]}; t3 += ns * (f32x2){b1[2], b1[3]};
      S[0] = S[0] * (f32x2){w0[0], w0[1]} + t0; S[1] = S[1] * (f32x2){w0[2], w0[3]} + t1; S[2] = S[2] * (f32x2){w1[0], w1[1]} + t2; S[3] = S[3] * (f32x2){w1[2], w1[3]} + t3;
      f32x2 y2 = S[0] * (f32x2){r0[0], r0[1]}, z2 = S[2] * (f32x2){r1[0], r1[1]};
      y2 += S[1] * (f32x2){r0[2], r0[3]}; z2 += S[3] * (f32x2){r1[2], r1[3]};
      y2 += z2;
      yk[st] = y2[0] + y2[1];
      __builtin_amdgcn_sched_barrier(0);
    }
#pragma unroll
    for (int g = 0; g < 2; ++g) {
      float q4[4], q2[2], q1;
#pragma unroll
      for (int j = 0; j < 4; ++j) { bool hi = cg & 1; float keep = hi ? yk[g*8 + 2*j+1] : yk[g*8 + 2*j], send = hi ? yk[g*8 + 2*j] : yk[g*8 + 2*j+1]; q4[j] = keep + dpp_get<0xB1>(send); }
#pragma unroll
      for (int j = 0; j < 2; ++j) { bool hi = cg & 2; float keep = hi ? q4[2*j+1] : q4[2*j], send = hi ? q4[2*j] : q4[2*j+1]; q2[j] = keep + dpp_get<0x4E>(send); }
      { bool hi = cg & 4; float keep = hi ? q2[1] : q2[0], send = hi ? q2[0] : q2[1]; q1 = keep + xor4_get(send); }
      ybuf[buf * SCAN_TS * 32 + (g * 8 + cg) * 32 + il] = q1;
    }
  }
  __builtin_amdgcn_s_setprio(0);
  __syncthreads();
  if (t < 128) {
    int st = t >> 3, i4 = (t & 7) * 4; long row = rowbase + scan_row(dir, (NCH - 1) * SCAN_TS + st);
    *(f32x4*)(y_ + dir * dstride + row * 384 + col0 + half * 32 + i4) = *(const f32x4*)(ybuf + ((NCH - 1) & 1) * SCAN_TS * 32 + st * 32 + i4);
  }
}
__global__ void __launch_bounds__(256) ok_rw_scan(const bf16_t* r_, const bf16_t* v_, const bf16_t* kk_, const bf16_t* kd_, const bf16_t* bd_, const float* w_, float* y_, int item0, int nitems, long dstride) {
  __shared__ __attribute__((aligned(16))) char smem[SCAN_LDS_BYTES];
  for (int it = item0 + blockIdx.x; it < item0 + nitems; it += gridDim.x) { rw_scan_block(r_, v_, kk_, kd_, bd_, w_, y_, it, dstride, smem); __syncthreads(); }
}
__global__ void ok_copy_rows_f32(const float* src, int sld, int scol, int ncols, float* dst, int dld, int nrows) {
  long i = (long)blockIdx.x * blockDim.x + threadIdx.x; if (i >= (long)nrows * ncols) return;
  int c = i % ncols; long r = i / ncols; dst[r * dld + c] = src[r * sld + scol + c];
}

__global__ void ok_cvt_wT_g(const float* W, const float* g, bf16_t* Wt, int K, int N, int Kpad) {
  long i = (long)blockIdx.x * blockDim.x + threadIdx.x;
  if (i >= (long)N * Kpad) return;
  int k = i % Kpad; int n = i / Kpad;
  Wt[i] = k < K ? f2bf(W[(long)k * N + n] * (g ? g[k] : 1.f)) : (bf16_t)0;
}
struct ALoadShift { const bf16_t* P; const float* mu; int col0; int mucol0; int act; int kvalid;
  __device__ __forceinline__ u32x4 operator()(int row, int k) const {
    u32x4 z = {0u, 0u, 0u, 0u};
    if (k >= kvalid) return z;
    int lr = row % RB; bool first = (lr == 0) || (lr == SEQ), last = (lr == SEQ - 1) || (lr == RB - 1);
    const bf16_t* p = P + (long)row * IN_COLS + col0 + k;
    u32x4 c = *(const u32x4*)p; u32x4 pv = first ? z : *(const u32x4*)(p - IN_COLS); u32x4 nx = last ? z : *(const u32x4*)(p + IN_COLS);
    const float* m0 = mu + mucol0 + k; const float* m1 = m0 + RWC;
    u32x4 o;
#pragma unroll
    for (int e = 0; e < 4; ++e) {
      float c0 = __uint_as_float(c[e] << 16), c1 = __uint_as_float(c[e] & 0xffff0000u);
      float p0 = __uint_as_float(pv[e] << 16), p1 = __uint_as_float(pv[e] & 0xffff0000u);
      float n0 = __uint_as_float(nx[e] << 16), n1 = __uint_as_float(nx[e] & 0xffff0000u);
      float x0 = c0 + m0[2*e] * (p0 - c0) + m1[2*e] * (n0 - c0), x1 = c1 + m0[2*e+1] * (p1 - c1) + m1[2*e+1] * (n1 - c1);
      if (act == 1) { x0 = ftanh_(x0); x1 = ftanh_(x1); } else if (act == 2) { x0 = fsigmoid_(x0); x1 = fsigmoid_(x1); }
      o[e] = pack2bf(x0, x1);
    }
    return o;
  } };
struct EpiDecay { float* w; const float* w0; int pad0; int pad1;
  __device__ __forceinline__ void operator()(int m, int n0, f32x4 v) const {
    f32x4 o;
#pragma unroll
    for (int e = 0; e < 4; ++e) o[e] = fdecay_(w0[n0 + e] + v[e]);
    *(f32x4*)(w + (long)m * 384 + n0) = o; } };
struct EpiSigA { bf16_t* a; const float* a0;
  __device__ __forceinline__ void operator()(int m, int n0, f32x4 v) const {
    uint2 pk; pk.x = pack2bf(fsigmoid_(a0[n0] + v[0]), fsigmoid_(a0[n0+1] + v[1])); pk.y = pack2bf(fsigmoid_(a0[n0+2] + v[2]), fsigmoid_(a0[n0+3] + v[3]));
    *(uint2*)(a + (long)m * 384 + n0) = pk; } };

struct PrepW { const bf16_t *wqbT, *wkvbT, *w2T, *a2T, *g2T; const float *mu, *w0, *a0; };
struct PrepBuf { const bf16_t* P; bf16_t *tq, *tkv, *a_b, *g_b; float* w_f; };
__device__ __forceinline__ void prep_gemm_tile(const PrepW& W, const PrepBuf& B, int tm, int ct, char* smem) {
  const long MA = NROWS;
  if (ct < 3) gemm_tile_128(ALoadPlain{B.P, IN_COLS}, W.wqbT, 256, 256, tm, ct, smem, EpiStoreBf16{B.tq, 384, 384});
  else if (ct < 7) gemm_tile_128(ALoadPlain{B.P + 256, IN_COLS}, W.wkvbT, 128, 128, tm, ct - 3, smem, EpiStoreBf16{B.tkv, 512, 512});
  else if (ct < 13) { int d = (ct - 7) / 3, tn = (ct - 7) % 3;
    gemm_tile_128(ALoadShift{B.P, W.mu, RW_OFF + 1152 + d * 64, 1152 + d * 64, 1, 64}, W.w2T + d * 384 * 64, 64, 64, tm, tn, smem, EpiDecay{B.w_f + d * MA * 384, W.w0 + d * 384, 0, 0}); }
  else if (ct < 19) { int d = (ct - 13) / 3, tn = (ct - 13) % 3;
    gemm_tile_128(ALoadShift{B.P, W.mu, RW_OFF + 1280 + d * 64, 1280 + d * 64, 0, 64}, W.a2T + d * 384 * 64, 64, 64, tm, tn, smem, EpiSigA{B.a_b + d * MA * 384, W.a0 + d * 384}); }
  else gemm_tile_128(ALoadShift{B.P, W.mu, RW_OFF + 1408, 1408, 2, 160}, W.g2T, 192, 192, tm, ct - 19, smem, EpiStoreBf16{B.g_b, 384, 384});
}
__global__ void __launch_bounds__(256) ok_prep_gemm(PrepW W, PrepBuf B) {
  __shared__ __attribute__((aligned(16))) char smem[GEMM_LDS_BYTES];
  for (int tile = blockIdx.x; tile < (NROWS / 128) * 22; tile += gridDim.x) prep_gemm_tile(W, B, tile / 22, tile % 22, smem);
}

__device__ __forceinline__ float wave_sum(float x) {
#pragma unroll
  for (int o = 32; o > 0; o >>= 1) x += __shfl_xor(x, o);
  return x;
}
__device__ __forceinline__ float ldbf(const bf16_t* p) { return bf2f(*p); }
struct FinW { const float *mla_qk_g, *gqa_qk_g, *mu, *k_k, *k_a; };
struct FinBuf { const bf16_t *P, *tq, *tkv, *a_b; bf16_t *mq, *mk, *mvT, *gq, *gk, *gvT, *r_b, *v_b, *kk_b, *kd_b, *bd_b; };
#define FIN_LDS_BYTES (384 * 132)
__device__ __forceinline__ void prep_finish_tile(const FinW& W, const FinBuf& B, int tile, char* smem) {
  const int t = tid_opaque(), lane = t & 63, wave = t >> 6; const long MA = NROWS;
  bf16_t* vbuf = (bf16_t*)smem;
  const long row0 = (long)tile * 64; const int b = row0 / RB; const int lr0 = row0 % RB;
  for (int it = 0; it < 16; ++it) {
    const int rl = it * 4 + wave; const long row = row0 + rl; const int lr = lr0 + rl; const bool lat = lr < SEQ;
    const bf16_t* Pr = B.P + row * IN_COLS;
    float sq = 0.f;
#pragma unroll
    for (int i = 0; i < 4; ++i) { float x = ldbf(Pr + i * 64 + lane); sq += x * x; }
    float skv = 0.f;
#pragma unroll
    for (int i = 0; i < 2; ++i) { float x = ldbf(Pr + 256 + i * 64 + lane); skv += x * x; }
    const float cq = __builtin_amdgcn_rsqf(wave_sum(sq) / 256.f + EPSN), ckv = __builtin_amdgcn_rsqf(wave_sum(skv) / 128.f + EPSN);
    const float krope = lane < 32 ? ldbf(Pr + 384 + lane) : 0.f;
    float cs_m = 1.f, sn_m = 0.f;
    { int j = lane & 15; int pos = j < 8 ? lr / 64 : lr % 64; float ang = (float)pos * powf(10000.f, -(float)(j & 7) / 8.f); if (lat) { cs_m = cosf(ang); sn_m = sinf(ang); } }
    const float* gq_ = W.mla_qk_g; const float* gk_ = W.mla_qk_g + 96;
#pragma unroll
    for (int h = 0; h < 4; ++h) {
      float qa = cq * ldbf(B.tq + row * 384 + h * 96 + lane); float qb = lane < 32 ? cq * ldbf(B.tq + row * 384 + h * 96 + 64 + lane) : 0.f;
      float inv = __builtin_amdgcn_rsqf(wave_sum(qa * qa + qb * qb) / 96.f + EPSN);
      qa *= inv * gq_[lane]; qb *= inv * (lane < 32 ? gq_[64 + lane] : 0.f);
      { float other = __shfl_xor(qb, 16); float rr = (lane & 16) ? (other * sn_m + qb * cs_m) : (qb * cs_m - other * sn_m); qb = rr; }
      const float qs = 0.14724445f;
      B.mq[row * 384 + h * 96 + lane] = f2bf(qa * qs); if (lane < 32) B.mq[row * 384 + h * 96 + 64 + lane] = f2bf(qb * qs);
      float ka = ckv * ldbf(B.tkv + row * 512 + h * 128 + lane); float kb = krope;
      float invk = __builtin_amdgcn_rsqf(wave_sum(ka * ka + kb * kb) / 96.f + EPSN);
      ka *= invk * gk_[lane]; kb *= invk * (lane < 32 ? gk_[64 + lane] : 0.f);
      { float other = __shfl_xor(kb, 16); float rr = (lane & 16) ? (other * sn_m + kb * cs_m) : (kb * cs_m - other * sn_m); kb = rr; }
      B.mk[row * 384 + h * 96 + lane] = f2bf(ka); if (lane < 32) B.mk[row * 384 + h * 96 + 64 + lane] = f2bf(kb);
      vbuf[(h * 64 + lane) * 66 + rl] = f2bf(ckv * ldbf(B.tkv + row * 512 + h * 128 + 64 + lane));
    }
    float cs_g = 1.f, sn_g = 0.f;
    { int j = lane & 31; int pos = j < 16 ? lr / 64 : lr % 64; float ang = (float)pos * powf(10000.f, -(float)(j & 15) / 16.f); if (lat) { cs_g = cosf(ang); sn_g = sinf(ang); } }
#pragma unroll
    for (int h = 0; h < 8; ++h) {
      float x = ldbf(Pr + GQA_OFF + h * 64 + lane);
      float inv = __builtin_amdgcn_rsqf(wave_sum(x * x) / 64.f + EPSN);
      x *= inv * W.gqa_qk_g[(h < 6 ? 0 : 64) + lane];
      float other = __shfl_xor(x, 32); float rr = (lane & 32) ? (other * sn_g + x * cs_g) : (x * cs_g - other * sn_g);
      if (h < 6) B.gq[row * 384 + h * 64 + lane] = f2bf(rr * 0.18033688f); else B.gk[row * 128 + (h - 6) * 64 + lane] = f2bf(rr);
    }
#pragma unroll
    for (int hk = 0; hk < 2; ++hk) vbuf[((4 + hk) * 64 + lane) * 66 + rl] = Pr[GQA_OFF + 512 + hk * 64 + lane];
    const bool first = (lr == 0) || (lr == SEQ), last = (lr == SEQ - 1) || (lr == RB - 1);
#pragma unroll
    for (int h = 0; h < 6; ++h) {
      float xs3[3];
#pragma unroll
      for (int part = 0; part < 3; ++part) {
        int c = part * 384 + h * 64 + lane; const bf16_t* pp = Pr + RW_OFF + c;
        float p = ldbf(pp), pv = first ? 0.f : ldbf(pp - IN_COLS), nx = last ? 0.f : ldbf(pp + IN_COLS);
        xs3[part] = p + W.mu[c] * (pv - p) + W.mu[RWC + c] * (nx - p);
      }
      const int c = h * 64 + lane; const long o = row * 384 + c;
      float kv = xs3[1]; float tk = kv * W.k_k[c]; float kkv = tk * __builtin_amdgcn_rsqf(wave_sum(tk * tk) + 1e-12f);
      B.r_b[o] = f2bf(xs3[0]); B.v_b[o] = f2bf(xs3[2]); B.kk_b[o] = f2bf(kkv);
#pragma unroll
      for (int d = 0; d < 2; ++d) { float a = ldbf(B.a_b + d * MA * 384 + o); B.kd_b[d * MA * 384 + o] = f2bf(kv * (1.f + (a - 1.f) * W.k_a[c])); B.bd_b[d * MA * 384 + o] = f2bf(kkv * a); }
    }
  }
  __syncthreads();
  for (int i = t; i < 384 * 32; i += 256) {
    int rr = i >> 5, w2 = i & 31; int slot = rr >> 6, d = rr & 63;
    unsigned val = *(const unsigned*)(vbuf + rr * 66 + w2 * 2);
    bf16_t* dst = slot < 4 ? B.mvT + ((long)(b * 4 + slot) * 64 + d) * RB : B.gvT + ((long)(b * 2 + (slot - 4)) * 64 + d) * RB;
    *(unsigned*)(dst + lr0 + w2 * 2) = val;
  }
  __syncthreads();
}
__global__ void __launch_bounds__(256) ok_prep_finish(FinW W, FinBuf B) {
  __shared__ __attribute__((aligned(16))) char smem[FIN_LDS_BYTES];
  for (int tile = blockIdx.x; tile < NROWS / 64; tile += gridDim.x) prep_finish_tile(W, B, tile, smem);
}
struct RdW { const float *r_k, *ln_g, *ln_b; };
__device__ __forceinline__ void rw_readout_row(const RdW& W, const float* __restrict__ y, const bf16_t* __restrict__ r_b, const bf16_t* __restrict__ v_b, const bf16_t* __restrict__ kd_b,
                                               const bf16_t* __restrict__ g_b, bf16_t* __restrict__ mixall, long row, int lane) {
  const long MA = NROWS;
#pragma unroll
  for (int h = 0; h < 6; ++h) {
    const int c = h * 64 + lane; const long o = row * 384 + c;
    float yy = y[o] + y[MA * 384 + o];
    float mean = wave_sum(yy) * (1.f / 64.f); float dv = yy - mean; float var = wave_sum(dv * dv) * (1.f / 64.f);
    float coef = wave_sum(ldbf(r_b + o) * (ldbf(kd_b + o) + ldbf(kd_b + MA * 384 + o)) * W.r_k[c]);
    float yn = dv * __builtin_amdgcn_rsqf(var + 64e-5f) * W.ln_g[c] + W.ln_b[c];
    mixall[row * DM + 256 + c] = f2bf((yn + coef * ldbf(v_b + o)) * ldbf(g_b + o));
  }
}
__global__ void __launch_bounds__(256) ok_rw_readout(RdW W, const float* y, const bf16_t* r_b, const bf16_t* v_b, const bf16_t* kd_b, const bf16_t* g_b, bf16_t* mixall) {
  for (long row = blockIdx.x * 4 + (threadIdx.x >> 6); row < NROWS; row += gridDim.x * 4) rw_readout_row(W, y, r_b, v_b, kd_b, g_b, mixall, row, threadIdx.x & 63);
}

__device__ __forceinline__ void ph_cvt_fp8_rows(const float* __restrict__ tab, unsigned char* __restrict__ q, float* __restrict__ scale, int r0 = -1, int r1 = 0) {
  const int t = tid_opaque(); const int lane = t & 63;
  const int rbeg = r0 < 0 ? (int)blockIdx.x * 4 + (t >> 6) : r0 + (t >> 6), rend = r0 < 0 ? 16384 : r1, rstep = r0 < 0 ? (int)gridDim.x * 4 : 4;
  for (int row = rbeg; row < rend; row += rstep) {
    const float* src = tab + (long)row * DM + lane * 16;
    f32x4 a[4]; float m = 0.f;
#pragma unroll
    for (int i = 0; i < 4; ++i) { a[i] = *(const f32x4*)(src + 4 * i); m = fmaxf(m, fmaxf(fmaxf(fabsf(a[i][0]), fabsf(a[i][1])), fmaxf(fabsf(a[i][2]), fabsf(a[i][3])))); }
#pragma unroll
    for (int o = 32; o > 0; o >>= 1) m = fmaxf(m, __shfl_xor(m, o));
    const float sc = m > 0.f ? m * (1.f / 440.f) : 1.f; const float inv = 1.f / sc;
    u32x4 p;
#pragma unroll
    for (int i = 0; i < 4; ++i) { int w = __builtin_amdgcn_cvt_pk_fp8_f32(a[i][0] * inv, a[i][1] * inv, 0, false); w = __builtin_amdgcn_cvt_pk_fp8_f32(a[i][2] * inv, a[i][3] * inv, w, true); p[i] = (unsigned)w; }
    *(u32x4*)(q + (long)row * DM + lane * 16) = p;
    if (lane == 0) scale[row] = sc;
  }
}
__device__ __forceinline__ float dot16_fp8(const float (&h)[16], u32x4 q) {
  float a = 0.f;
#pragma unroll
  for (int d = 0; d < 4; ++d) {
    f32v2 lo = __builtin_amdgcn_cvt_pk_f32_fp8((int)q[d], false), hi = __builtin_amdgcn_cvt_pk_f32_fp8((int)q[d], true);
    a += h[4*d] * lo[0]; a += h[4*d+1] * lo[1]; a += h[4*d+2] * hi[0]; a += h[4*d+3] * hi[1];
  }
  return a;
}
__device__ __forceinline__ void axpy16_fp8(float (&o)[16], float w, u32x4 q) {
#pragma unroll
  for (int d = 0; d < 4; ++d) {
    f32v2 lo = __builtin_amdgcn_cvt_pk_f32_fp8((int)q[d], false), hi = __builtin_amdgcn_cvt_pk_f32_fp8((int)q[d], true);
    o[4*d] += w * lo[0]; o[4*d+1] += w * lo[1]; o[4*d+2] += w * hi[0]; o[4*d+3] += w * hi[1];
  }
}
__device__ __forceinline__ void peer_gather_group_fp8(const bf16_t* __restrict__ xn, const unsigned* __restrict__ top1, const unsigned char* __restrict__ ub, const float* __restrict__ su,
                                                      const unsigned char* __restrict__ vb, const float* __restrict__ sv, const float* __restrict__ modl, float* __restrict__ xs, int grp, char* smem) {
  const int t = tid_opaque(), lane = t & 63, wave = t >> 6;
  int* pe_l = (int*)smem; float* pg_l = (float*)(smem + 32 * 128 * 4); float* pw_l = (float*)(smem + 2 * 32 * 128 * 4);
  {
    int tl = t >> 3, p = t & 7; long row = (long)grp * 32 + tl;
    peer_combine(top1 + (row * 16 + p * 2) * 16, top1 + (row * 16 + p * 2 + 1) * 16, pe_l + tl * 128 + p * 16, pg_l + tl * 128 + p * 16);
  }
  __syncthreads();
  for (int ti = 0; ti < 8; ++ti) {
    const int tl = wave * 8 + ti; const long row = (long)grp * 32 + tl;
    const int* pe = pe_l + tl * 128; float* pw = pw_l + tl * 128;
    float h[16];
    { u32x4 h0 = *(const u32x4*)(xn + row * DM + lane * 16), h1 = *(const u32x4*)(xn + row * DM + lane * 16 + 8);
#pragma unroll
      for (int e = 0; e < 4; ++e) { h[2*e] = __uint_as_float(h0[e] << 16); h[2*e+1] = __uint_as_float(h0[e] & 0xffff0000u); h[8+2*e] = __uint_as_float(h1[e] << 16); h[8+2*e+1] = __uint_as_float(h1[e] & 0xffff0000u); } }
    u32x4 u[8];
#pragma unroll
    for (int j = 0; j < 8; ++j) u[j] = *(const u32x4*)(ub + (long)pe[j] * DM + lane * 16);
    for (int b = 0; b < 16; ++b) {
      float pd[8];
#pragma unroll
      for (int j = 0; j < 8; ++j) pd[j] = dot16_fp8(h, u[j]);
      if (b + 1 < 16) {
#pragma unroll
        for (int j = 0; j < 8; ++j) u[j] = *(const u32x4*)(ub + (long)pe[(b + 1) * 8 + j] * DM + lane * 16);
      }
      float q4[4], q2[2], q1;
#pragma unroll
      for (int j = 0; j < 4; ++j) { bool hi = lane & 1; float keep = hi ? pd[2*j+1] : pd[2*j], send = hi ? pd[2*j] : pd[2*j+1]; q4[j] = keep + __shfl_xor(send, 1); }
#pragma unroll
      for (int j = 0; j < 2; ++j) { bool hi = lane & 2; float keep = hi ? q4[2*j+1] : q4[2*j], send = hi ? q4[2*j] : q4[2*j+1]; q2[j] = keep + __shfl_xor(send, 2); }
      { bool hi = lane & 4; float keep = hi ? q2[1] : q2[0], send = hi ? q2[0] : q2[1]; q1 = keep + __shfl_xor(send, 4); }
      q1 += __shfl_xor(q1, 8); q1 += __shfl_xor(q1, 16); q1 += __shfl_xor(q1, 32);
      if (lane < 8) pw[b * 8 + lane] = q1 * su[pe[b * 8 + lane]];
    }
    u32x4 v[8];
#pragma unroll
    for (int j = 0; j < 8; ++j) v[j] = *(const u32x4*)(vb + (long)pe[j] * DM + lane * 16);
    {
      float d0 = pw[lane], d1 = pw[64 + lane];
      pw[lane] = pg_l[tl * 128 + lane] * fgelu_(d0) * sv[pe[lane]]; pw[64 + lane] = pg_l[tl * 128 + 64 + lane] * fgelu_(d1) * sv[pe[64 + lane]];
    }
    float o[16];
#pragma unroll
    for (int e = 0; e < 16; ++e) o[e] = 0.f;
    for (int b = 0; b < 16; ++b) {
      u32x4 vc[8];
#pragma unroll
      for (int j = 0; j < 8; ++j) vc[j] = v[j];
      if (b + 1 < 16) {
#pragma unroll
        for (int j = 0; j < 8; ++j) v[j] = *(const u32x4*)(vb + (long)pe[(b + 1) * 8 + j] * DM + lane * 16);
      }
#pragma unroll
      for (int j = 0; j < 8; ++j) axpy16_fp8(o, pw[b * 8 + j], vc[j]);
    }
    {
      int b = row / RB, lr = row % RB; int bb = lr < SEQ ? b : BATCH; const float* g5 = modl + ((long)bb * 6 + 5) * DM + lane * 16;
      float* xr = xs + row * DM + lane * 16;
#pragma unroll
      for (int i = 0; i < 4; ++i) {
        f32x4 x = *(f32x4*)(xr + 4 * i); f32x4 g = *(const f32x4*)(g5 + 4 * i);
        x[0] += g[0] * o[4*i]; x[1] += g[1] * o[4*i+1]; x[2] += g[2] * o[4*i+2]; x[3] += g[3] * o[4*i+3];
        *(f32x4*)(xr + 4 * i) = x;
      }
    }
  }
}

__device__ __forceinline__ float reduce16(float x) { x = reduce8(x); x += dpp_get<0x140>(x); return x; }
__device__ __forceinline__ void unpack8(u32x4 v, float (&f)[8]) {
#pragma unroll
  for (int e = 0; e < 4; ++e) { f[2*e] = __uint_as_float(v[e] << 16); f[2*e+1] = __uint_as_float(v[e] & 0xffff0000u); }
}
__device__ __forceinline__ u32x4 pack8(const float (&f)[8]) { u32x4 o;
#pragma unroll
  for (int e = 0; e < 4; ++e) o[e] = pack2bf(f[2*e], f[2*e+1]);
  return o; }
__device__ __forceinline__ void ph_rope_tables(float* rope_g, float* rope_m) {
  const int t = tid_opaque();
  for (int i = blockIdx.x * 256 + t; i < SEQ * 48; i += gridDim.x * 256) {
    int lr = i / 48, j = i % 48;
    if (j < 32) { int pos = j < 16 ? lr / 64 : lr % 64; float ang = (float)pos * powf(10000.f, -(float)(j & 15) / 16.f); rope_g[(lr * 32 + j) * 2] = cosf(ang); rope_g[(lr * 32 + j) * 2 + 1] = sinf(ang); }
    else { int jj = j - 32; int pos = jj < 8 ? lr / 64 : lr % 64; float ang = (float)pos * powf(10000.f, -(float)(jj & 7) / 8.f); rope_m[(lr * 16 + jj) * 2] = cosf(ang); rope_m[(lr * 16 + jj) * 2 + 1] = sinf(ang); }
  }
}
struct FinW2 { const float *mla_qk_g, *gqa_qk_g, *mu, *k_k, *k_a, *rope_g, *rope_m; };
#define FIN2_LDS_BYTES (64 * 384 * 2)
__device__ __forceinline__ void prep_finish_tile2(const FinW2& W, const FinBuf& B, int tile, char* smem) {
  const int t = tid_opaque(), lane = t & 63, wave = t >> 6; const long MA = NROWS;
  bf16_t* vbuf = (bf16_t*)smem;
  const long row0 = (long)tile * 8; const int b = row0 / RB; const int lr0 = row0 % RB;
  const int g8 = lane & 7, h8 = lane >> 3, s16 = lane & 15, h16 = lane >> 4;
  for (int it = 0; it < 2; ++it) {
    const int rl = it * 4 + wave; const long row = row0 + rl; const int lr = lr0 + rl; const bool lat = lr < SEQ;
    const bf16_t* Pr = B.P + row * IN_COLS;
    {
      float x[8]; unpack8(*(const u32x4*)(Pr + GQA_OFF + lane * 8), x);
      float ss = 0.f;
#pragma unroll
      for (int e = 0; e < 8; ++e) ss += x[e] * x[e];
      ss = reduce8(ss); const float inv = __builtin_amdgcn_rsqf(ss * (1.f / 64.f) + EPSN);
      const float* gp = W.gqa_qk_g + (h8 < 6 ? 0 : 64) + g8 * 8; f32x4 ga = *(const f32x4*)gp, gb = *(const f32x4*)(gp + 4);
#pragma unroll
      for (int e = 0; e < 4; ++e) { x[e] *= inv * ga[e]; x[4 + e] *= inv * gb[e]; }
      float o[8];
      if (lat) {
        const float* rt = W.rope_g + ((long)lr * 32 + (g8 & 3) * 8) * 2;
#pragma unroll
        for (int e = 0; e < 8; ++e) { float ot = swz_xor4(x[e]); float cs = rt[2 * e], sn = rt[2 * e + 1]; o[e] = (g8 & 4) ? (ot * sn + x[e] * cs) : (x[e] * cs - ot * sn); }
      } else {
#pragma unroll
        for (int e = 0; e < 8; ++e) o[e] = x[e];
      }
      if (h8 < 6) {
#pragma unroll
        for (int e = 0; e < 8; ++e) o[e] *= 0.18033688f;
        *(u32x4*)(B.gq + row * 384 + lane * 8) = pack8(o);
      } else *(u32x4*)(B.gk + row * 128 + (lane - 48) * 8) = pack8(o);
    }
    float cq, ckv;
    {
      float ss = 0.f;
      if (lane < 48) { float x[8]; unpack8(*(const u32x4*)(Pr + lane * 8), x);
#pragma unroll
        for (int e = 0; e < 8; ++e) ss += x[e] * x[e]; }
      float sq = wave_sum(lane < 32 ? ss : 0.f), skv = wave_sum(lane >= 32 ? ss : 0.f);
      cq = __builtin_amdgcn_rsqf(sq * (1.f / 256.f) + EPSN); ckv = __builtin_amdgcn_rsqf(skv * (1.f / 128.f) + EPSN);
    }
    {
      float cs0 = 1.f, sn0 = 0.f, cs1 = 1.f, sn1 = 0.f;
      if (lat) { f32x4 r4 = *(const f32x4*)(W.rope_m + ((long)lr * 16 + (s16 & 7) * 2) * 2); cs0 = r4[0]; sn0 = r4[1]; cs1 = r4[2]; sn1 = r4[3]; }
      const float kr0 = bf2f(Pr[384 + s16 * 2]), kr1 = bf2f(Pr[384 + s16 * 2 + 1]);
#pragma unroll
      for (int which = 0; which < 2; ++which) {
        float n[4], r0, r1;
        if (which == 0) {
          uint2 a = *(const uint2*)(B.tq + row * 384 + h16 * 96 + s16 * 4); unsigned rr = *(const unsigned*)(B.tq + row * 384 + h16 * 96 + 64 + s16 * 2);
          n[0] = cq * __uint_as_float(a.x << 16); n[1] = cq * __uint_as_float(a.x & 0xffff0000u); n[2] = cq * __uint_as_float(a.y << 16); n[3] = cq * __uint_as_float(a.y & 0xffff0000u);
          r0 = cq * __uint_as_float(rr << 16); r1 = cq * __uint_as_float(rr & 0xffff0000u);
        } else {
          uint2 a = *(const uint2*)(B.tkv + row * 512 + h16 * 128 + s16 * 4);
          n[0] = ckv * __uint_as_float(a.x << 16); n[1] = ckv * __uint_as_float(a.x & 0xffff0000u); n[2] = ckv * __uint_as_float(a.y << 16); n[3] = ckv * __uint_as_float(a.y & 0xffff0000u);
          r0 = kr0; r1 = kr1;
        }
        float ss = n[0]*n[0] + n[1]*n[1] + n[2]*n[2] + n[3]*n[3] + r0*r0 + r1*r1;
        ss = reduce16(ss); const float inv = __builtin_amdgcn_rsqf(ss * (1.f / 96.f) + EPSN);
        const float* gp = W.mla_qk_g + which * 96; f32x4 gn = *(const f32x4*)(gp + s16 * 4); const float g0 = gp[64 + s16 * 2], g1 = gp[64 + s16 * 2 + 1];
#pragma unroll
        for (int e = 0; e < 4; ++e) n[e] *= inv * gn[e];
        r0 *= inv * g0; r1 *= inv * g1;
        float o0 = dpp_get<0x128>(r0), o1 = dpp_get<0x128>(r1);
        float q0, q1;
        if (s16 & 8) { q0 = o0 * sn0 + r0 * cs0; q1 = o1 * sn1 + r1 * cs1; } else { q0 = r0 * cs0 - o0 * sn0; q1 = r1 * cs1 - o1 * sn1; }
        const float sc = which == 0 ? 0.14724445f : 1.f;
        bf16_t* dst = (which == 0 ? B.mq : B.mk) + row * 384 + h16 * 96;
        uint2 pk; pk.x = pack2bf(n[0] * sc, n[1] * sc); pk.y = pack2bf(n[2] * sc, n[3] * sc);
        *(uint2*)(dst + s16 * 4) = pk; *(unsigned*)(dst + 64 + s16 * 2) = pack2bf(q0 * sc, q1 * sc);
      }
      if (lane < 32) { float x[8]; unpack8(*(const u32x4*)(B.tkv + row * 512 + h8 * 128 + 64 + g8 * 8), x);
#pragma unroll
        for (int e = 0; e < 8; ++e) x[e] *= ckv;
        *(u32x4*)(vbuf + rl * 384 + h8 * 64 + g8 * 8) = pack8(x); }
      else if (lane < 48) *(u32x4*)(vbuf + rl * 384 + 256 + (lane - 32) * 8) = *(const u32x4*)(Pr + GQA_OFF + 512 + (lane - 32) * 8);
    }
    if (lane < 48) {
      const bool first = (lr == 0) || (lr == SEQ), last = (lr == SEQ - 1) || (lr == RB - 1);
      const long o = row * 384 + lane * 8;
      float xs3[3][8];
#pragma unroll
      for (int part = 0; part < 3; ++part) {
        const int c = part * 384 + lane * 8; const bf16_t* pp = Pr + RW_OFF + c;
        float p[8], pv[8], nx[8]; unpack8(*(const u32x4*)pp, p);
        u32x4 z = {0u, 0u, 0u, 0u}; unpack8(first ? z : *(const u32x4*)(pp - IN_COLS), pv); unpack8(last ? z : *(const u32x4*)(pp + IN_COLS), nx);
        f32x4 m0a = *(const f32x4*)(W.mu + c), m0b = *(const f32x4*)(W.mu + c + 4), m1a = *(const f32x4*)(W.mu + RWC + c), m1b = *(const f32x4*)(W.mu + RWC + c + 4);
#pragma unroll
        for (int e = 0; e < 4; ++e) { xs3[part][e] = p[e] + m0a[e] * (pv[e] - p[e]) + m1a[e] * (nx[e] - p[e]); xs3[part][4+e] = p[4+e] + m0b[e] * (pv[4+e] - p[4+e]) + m1b[e] * (nx[4+e] - p[4+e]); }
      }
      *(u32x4*)(B.r_b + o) = pack8(xs3[0]); *(u32x4*)(B.v_b + o) = pack8(xs3[2]);
      f32x4 kka = *(const f32x4*)(W.k_k + lane * 8), kkb = *(const f32x4*)(W.k_k + lane * 8 + 4), kaa = *(const f32x4*)(W.k_a + lane * 8), kab = *(const f32x4*)(W.k_a + lane * 8 + 4);
      float tk[8], ss = 0.f;
#pragma unroll
      for (int e = 0; e < 4; ++e) { tk[e] = xs3[1][e] * kka[e]; tk[4+e] = xs3[1][4+e] * kkb[e]; }
#pragma unroll
      for (int e = 0; e < 8; ++e) ss += tk[e] * tk[e];
      ss = reduce8(ss); const float invk = __builtin_amdgcn_rsqf(ss + 1e-12f);
#pragma unroll
      for (int e = 0; e < 8; ++e) tk[e] *= invk;
      *(u32x4*)(B.kk_b + o) = pack8(tk);
#pragma unroll
      for (int d = 0; d < 2; ++d) {
        float a[8], kd[8], bd[8]; unpack8(*(const u32x4*)(B.a_b + d * MA * 384 + o), a);
#pragma unroll
        for (int e = 0; e < 8; ++e) { float ka = e < 4 ? kaa[e] : kab[e - 4]; kd[e] = xs3[1][e] * (1.f + (a[e] - 1.f) * ka); bd[e] = tk[e] * a[e]; }
        *(u32x4*)(B.kd_b + d * MA * 384 + o) = pack8(kd); *(u32x4*)(B.bd_b + d * MA * 384 + o) = pack8(bd);
      }
    } else { (void)reduce8(0.f); }
  }
  __syncthreads();
  for (int i = t; i < 384; i += 256) {
    int c = i % 384, rc = i / 384;
    unsigned short v8[8];
#pragma unroll
    for (int e = 0; e < 8; ++e) v8[e] = vbuf[(rc * 8 + e) * 384 + c];
    u32x4 o; o[0] = v8[0] | ((unsigned)v8[1] << 16); o[1] = v8[2] | ((unsigned)v8[3] << 16); o[2] = v8[4] | ((unsigned)v8[5] << 16); o[3] = v8[6] | ((unsigned)v8[7] << 16);
    bf16_t* dst = c < 256 ? B.mvT + ((long)(b * 4 + (c >> 6)) * 64 + (c & 63)) * RB : B.gvT + ((long)(b * 2 + ((c - 256) >> 6)) * 64 + (c & 63)) * RB;
    *(u32x4*)(dst + lr0 + rc * 8) = o;
  }
  __syncthreads();
}
__device__ __forceinline__ void rw_readout_row2(const RdW& W, const float* __restrict__ y, const bf16_t* __restrict__ r_b, const bf16_t* __restrict__ v_b, const bf16_t* __restrict__ kd_b,
                                                const bf16_t* __restrict__ g_b, bf16_t* __restrict__ mixall, long row, int lane) {
  const long MA = NROWS;
  float yy[8], s = 0.f; float r[8], k0[8], k1[8], vv[8], gg[8];
  const int c = lane * 8; const long o = row * 384 + c;
  if (lane < 48) {
    f32x4 a0 = *(const f32x4*)(y + o), a1 = *(const f32x4*)(y + o + 4), b0 = *(const f32x4*)(y + MA * 384 + o), b1 = *(const f32x4*)(y + MA * 384 + o + 4);
#pragma unroll
    for (int e = 0; e < 4; ++e) { yy[e] = a0[e] + b0[e]; yy[4+e] = a1[e] + b1[e]; }
    unpack8(*(const u32x4*)(r_b + o), r); unpack8(*(const u32x4*)(kd_b + o), k0); unpack8(*(const u32x4*)(kd_b + MA * 384 + o), k1);
    unpack8(*(const u32x4*)(v_b + o), vv); unpack8(*(const u32x4*)(g_b + o), gg);
  } else {
#pragma unroll
    for (int e = 0; e < 8; ++e) { yy[e] = 0.f; r[e] = 0.f; k0[e] = 0.f; k1[e] = 0.f; vv[e] = 0.f; gg[e] = 0.f; }
  }
#pragma unroll
  for (int e = 0; e < 8; ++e) s += yy[e];
  const float mean = reduce8(s) * (1.f / 64.f);
  float vs = 0.f, cf = 0.f;
  const int cc = lane < 48 ? c : 0;
  f32x4 rk0 = *(const f32x4*)(W.r_k + cc), rk1 = *(const f32x4*)(W.r_k + cc + 4);
#pragma unroll
  for (int e = 0; e < 8; ++e) { float d = yy[e] - mean; vs += d * d; cf += r[e] * (k0[e] + k1[e]) * (e < 4 ? rk0[e] : rk1[e - 4]); }
  const float var = reduce8(vs) * (1.f / 64.f), coef = reduce8(cf);
  const float inv = __builtin_amdgcn_rsqf(var + 64e-5f);
  if (lane < 48) {
    f32x4 lg0 = *(const f32x4*)(W.ln_g + c), lg1 = *(const f32x4*)(W.ln_g + c + 4), lb0 = *(const f32x4*)(W.ln_b + c), lb1 = *(const f32x4*)(W.ln_b + c + 4);
    float out[8];
#pragma unroll
    for (int e = 0; e < 8; ++e) { float yn = (yy[e] - mean) * inv * (e < 4 ? lg0[e] : lg1[e - 4]) + (e < 4 ? lb0[e] : lb1[e - 4]); out[e] = (yn + coef * vv[e]) * gg[e]; }
    *(u32x4*)(mixall + row * DM + 256 + c) = pack8(out);
  }
}

#define PG_NT 4
#define PG_TOK (4 * PG_NT)
#define PG_OFF_H 0
#define PG_OFF_E (PG_TOK * 2048)
#define PG_OFF_G (PG_OFF_E + PG_TOK * 128 * 2)
#define PG_OFF_ST (PG_OFF_G + PG_TOK * 128 * 4)
#define PG_OFF_CNT (PG_OFF_ST + PG_TOK * 18 * 2)
#define PG_LDS_BYTES (PG_OFF_CNT + PG_TOK * 8 * 16 * 2)
__device__ __forceinline__ long pg_row(int g, int ntok) { return ntok == NROWS ? (long)g : (long)(g / SEQ) * RB + (g % SEQ); }
__device__ __forceinline__ void peer_gather_sliced(const bf16_t* __restrict__ xn, const unsigned* __restrict__ top1, const unsigned char* __restrict__ ub, const float* __restrict__ su,
                                                   const unsigned char* __restrict__ vb, const float* __restrict__ sv, const float* __restrict__ modl, float* __restrict__ xs,
                                                   int ntok, char* smem, const float* __restrict__ ng, const float* __restrict__ nmod, bf16_t* __restrict__ xn_next, float* __restrict__ out, bool dry = false, unsigned emask = 0x3FFFu) {
  bf16_t* hs = (bf16_t*)(smem + PG_OFF_H); unsigned short* se = (unsigned short*)(smem + PG_OFF_E); float* sg = (float*)(smem + PG_OFF_G);
  unsigned short* sst = (unsigned short*)(smem + PG_OFF_ST); unsigned short* cnt = (unsigned short*)(smem + PG_OFF_CNT);
  const int per_block = (ntok + (int)gridDim.x - 1) / (int)gridDim.x;
  const int npass = (per_block + PG_TOK - 1) / PG_TOK; const int tpp = (per_block + npass - 1) / npass;
  for (int pass = 0; pass < npass; ++pass) {
    const int t = tid_opaque(), lane = t & 63, wave = t >> 6;
    __syncthreads();
    for (int i = t; i < PG_TOK * 8 * 16; i += 256) cnt[i] = 0;
    for (int i = t; i < PG_TOK * 128; i += 256) {
      int tl = i >> 7, ch = i & 127; int q = (tl % PG_NT) * 4 + tl / PG_NT; int idx = pass * tpp + q; int g = (int)blockIdx.x + idx * (int)gridDim.x;
      u32x4 v = {0u, 0u, 0u, 0u};
      if (q < tpp && idx < per_block && g < ntok) v = *(const u32x4*)(xn + pg_row(g, ntok) * DM + ch * 8);
      *(u32x4*)(hs + tl * 1024 + ch * 8) = v;
    }
    __syncthreads();
    int my_e[16]; float my_g[16];
    const int ctl = t >> 3, cp = t & 7;
    bool cact = false;
    if (ctl < PG_TOK) {
      int q = (ctl % PG_NT) * 4 + ctl / PG_NT; int idx = pass * tpp + q; int g = (int)blockIdx.x + idx * (int)gridDim.x;
      cact = q < tpp && idx < per_block && g < ntok;
      if (cact) {
        long row = pg_row(g, ntok);
        peer_combine(top1 + (row * 16 + cp * 2) * 16, top1 + (row * 16 + cp * 2 + 1) * 16, my_e, my_g);
#pragma unroll
        for (int k = 0; k < 16; ++k) cnt[(ctl * 8 + cp) * 16 + (my_e[k] >> 10)] += 1;
      }
    }
    __syncthreads();
    if (t < PG_TOK) {
      int run = 0;
      for (int s = 0; s < 16; ++s) {
        sst[t * 18 + s] = (unsigned short)run;
        for (int h = 0; h < 8; ++h) { int c = cnt[(t * 8 + h) * 16 + s]; cnt[(t * 8 + h) * 16 + s] = (unsigned short)run; run += c; }
      }
      sst[t * 18 + 16] = (unsigned short)run;
    }
    __syncthreads();
    if (cact) {
#pragma unroll
      for (int k = 0; k < 16; ++k) { int s = my_e[k] >> 10; int pos = cnt[(ctl * 8 + cp) * 16 + s]; cnt[(ctl * 8 + cp) * 16 + s] = (unsigned short)(pos + 1); se[ctl * 128 + pos] = (unsigned short)my_e[k]; sg[ctl * 128 + pos] = my_g[k]; }
    }
    __syncthreads();
    float acc[PG_NT][16];
#pragma unroll
    for (int tk = 0; tk < PG_NT; ++tk)
#pragma unroll
      for (int e = 0; e < 16; ++e) acc[tk][e] = 0.f;
    for (int s = 0; s < 16; ++s) {
#pragma unroll
      for (int tk = 0; tk < PG_NT; ++tk) {
        const int tl = wave * PG_NT + tk;
        const int st = sst[tl * 18 + s], en = sst[tl * 18 + s + 1];
        for (int base = st; base < en; base += 8) {
          const int nb = en - base < 8 ? en - base : 8;
          u32x4 u[8], v[8];
#pragma unroll
          for (int j = 0; j < 8; ++j) if (j < nb) { const unsigned off = ((unsigned)se[tl * 128 + base + j] & emask) * 1024u + (unsigned)lane * 16u; u[j] = *(const u32x4*)(ub + off); v[j] = *(const u32x4*)(vb + off); }
          float h[16];
          { u32x4 h0 = *(const u32x4*)(hs + tl * 1024 + lane * 16), h1 = *(const u32x4*)(hs + tl * 1024 + lane * 16 + 8);
#pragma unroll
            for (int e = 0; e < 4; ++e) { h[2*e] = __uint_as_float(h0[e] << 16); h[2*e+1] = __uint_as_float(h0[e] & 0xffff0000u); h[8+2*e] = __uint_as_float(h1[e] << 16); h[8+2*e+1] = __uint_as_float(h1[e] & 0xffff0000u); } }
          float pd[8];
#pragma unroll
          for (int j = 0; j < 8; ++j) pd[j] = j < nb ? dot16_fp8(h, u[j]) : 0.f;
          float q4[4], q2[2], q1;
#pragma unroll
          for (int j = 0; j < 4; ++j) { bool hi = lane & 1; float keep = hi ? pd[2*j+1] : pd[2*j], send = hi ? pd[2*j] : pd[2*j+1]; q4[j] = keep + dpp_get<0xB1>(send); }
#pragma unroll
          for (int j = 0; j < 2; ++j) { bool hi = lane & 2; float keep = hi ? q4[2*j+1] : q4[2*j], send = hi ? q4[2*j] : q4[2*j+1]; q2[j] = keep + dpp_get<0x4E>(send); }
          { bool hi = lane & 4; float keep = hi ? q2[1] : q2[0], send = hi ? q2[0] : q2[1]; q1 = keep + xor4_get(send); }
          q1 += dpp_get<0x128>(q1);
          q1 = xor16_sum(q1);
          q1 = xor32_sum(q1);
          float w = 0.f;
          { const int jj = lane & 7; if (jj < nb) { int e = se[tl * 128 + base + jj]; w = sg[tl * 128 + base + jj] * fgelu_(q1 * su[e]) * sv[e]; } }
#pragma unroll
          for (int j = 0; j < 8; ++j) { float wj = __builtin_bit_cast(float, __builtin_amdgcn_readlane(__builtin_bit_cast(int, w), j)); if (j < nb) axpy16_fp8(acc[tk], wj, v[j]); }
        }
      }
    }
    if (dry) {
#pragma unroll
      for (int tk = 0; tk < PG_NT; ++tk)
#pragma unroll
        for (int e = 0; e < 16; ++e) asm volatile("" :: "v"(acc[tk][e]));
    }
#pragma unroll
    for (int tk = 0; tk < PG_NT; ++tk) {
      int q = tk * 4 + wave; int idx = pass * tpp + q; int g = (int)blockIdx.x + idx * (int)gridDim.x;
      if (!dry && q < tpp && idx < per_block && g < ntok) {
        long row = pg_row(g, ntok); int b = row / RB, lr = row % RB; int bb = lr < SEQ ? b : BATCH; const float* g5 = modl + ((long)bb * 6 + 5) * DM + lane * 16;
        float* xr = xs + row * DM + lane * 16;
        f32x4 xv[4]; float ss = 0.f;
#pragma unroll
        for (int i = 0; i < 4; ++i) {
          f32x4 x = *(f32x4*)(xr + 4 * i); f32x4 gg = *(const f32x4*)(g5 + 4 * i);
          x[0] += gg[0] * acc[tk][4*i]; x[1] += gg[1] * acc[tk][4*i+1]; x[2] += gg[2] * acc[tk][4*i+2]; x[3] += gg[3] * acc[tk][4*i+3];
          xv[i] = x; ss += x[0] * x[0] + x[1] * x[1] + x[2] * x[2] + x[3] * x[3];
        }
        if (out) {
          float* orow = out + ((long)b * SEQ + lr) * DM + lane * 16;
#pragma unroll
          for (int i = 0; i < 4; ++i) *(f32x4*)(orow + 4 * i) = xv[i];
        } else {
#pragma unroll
          for (int i = 0; i < 4; ++i) *(f32x4*)(xr + 4 * i) = xv[i];
          ss = wave_sum(ss); const float inv = __builtin_amdgcn_rsqf(ss * (1.f / DM) + EPSN);
          const float* sh = nmod + ((long)bb * 6 + 0) * DM + lane * 16; const float* sc = sh + DM; const float* gp = ng + lane * 16;
          u32x4 p0, p1;
#pragma unroll
          for (int i = 0; i < 4; ++i) { f32x4 g4 = *(const f32x4*)(gp + 4 * i), s4 = *(const f32x4*)(sc + 4 * i), h4 = *(const f32x4*)(sh + 4 * i);
            const float a0 = xv[i][0] * inv * g4[0] * (1.f + s4[0]) + h4[0], a1 = xv[i][1] * inv * g4[1] * (1.f + s4[1]) + h4[1];
            const float a2 = xv[i][2] * inv * g4[2] * (1.f + s4[2]) + h4[2], a3 = xv[i][3] * inv * g4[3] * (1.f + s4[3]) + h4[3];
            if (i < 2) { p0[2 * i] = pack2bf(a0, a1); p0[2 * i + 1] = pack2bf(a2, a3); } else { p1[2 * (i - 2)] = pack2bf(a0, a1); p1[2 * (i - 2) + 1] = pack2bf(a2, a3); } }
          *(u32x4*)(xn_next + row * DM + lane * 16) = p0; *(u32x4*)(xn_next + row * DM + lane * 16 + 8) = p1;
        }
      }
    }
  }
}

#define PG3_OFF_H 0
#define PG3_OFF_FE (12 * 2048)
#define PG3_OFF_FG (PG3_OFF_FE + 4 * 384 * 2)
#define PG3_OFF_FS (PG3_OFF_FG + 4 * 384 * 4)
#define PG3_OFF_BT (PG3_OFF_FS + 4 * 384 * 4)
#define PG3_OFF_CNT (PG3_OFF_BT + 4 * 160 * 4)
#define PG3_OFF_TOT (PG3_OFF_CNT + 4 * 512 * 2)
#define PG3_LDS_BYTES (PG3_OFF_TOT + 512)
#define PG3_REC_BYTES (384 * 2 + 384 * 4 + 384 * 4 + 160 * 4 + 16)
__device__ __forceinline__ void peer_lists_build3(const unsigned* __restrict__ top1, const float* __restrict__ su, const float* __restrict__ sv, char* __restrict__ gl, int ntok, char* smem) {
  unsigned short* fe = (unsigned short*)(smem + PG3_OFF_FE); float* fg = (float*)(smem + PG3_OFF_FG); float* fs = (float*)(smem + PG3_OFF_FS);
  unsigned* bt = (unsigned*)(smem + PG3_OFF_BT); unsigned short* cnt = (unsigned short*)(smem + PG3_OFF_CNT); unsigned short* tot = (unsigned short*)(smem + PG3_OFF_TOT);
  int* nbt = (int*)(smem + PG3_OFF_TOT + 320);
  const int per_block = (ntok + (int)gridDim.x - 1) / (int)gridDim.x;
  const int npass = (per_block + 11) / 12; const int tpp = (per_block + npass - 1) / npass;
  unsigned short* st_e = (unsigned short*)(smem + PG3_OFF_H); float* st_g = (float*)(smem + PG3_OFF_H + 2 * 96 * 16 * 2);
  const bool pre = npass <= 3;
  int my_e[16]; float my_g[16];
#pragma unroll
  for (int k = 0; k < 16; ++k) { my_e[k] = 0; my_g[k] = 0.f; }
  if (pre) {
    const int t = tid_opaque();
    __syncthreads();
    for (int j = t; j < npass * 96; j += 256) {
      const int pj = j / 96, rem = j % 96; const int ctl = rem >> 3, cp = rem & 7; const int cw = ctl / 3, ctk = ctl % 3;
      const int q = ctk * 4 + cw; const int idx = pj * tpp + q; const int g = (int)blockIdx.x + idx * (int)gridDim.x;
      if (q < tpp && idx < per_block && g < ntok) {
        int e_[16]; float g_[16];
        const long row = pg_row(g, ntok);
        peer_combine(top1 + (row * 16 + cp * 2) * 16, top1 + (row * 16 + cp * 2 + 1) * 16, e_, g_);
        if (pj == 0) {
#pragma unroll
          for (int k = 0; k < 16; ++k) { my_e[k] = e_[k]; my_g[k] = g_[k]; }
        } else {
          const int sj = (pj - 1) * 96 + rem;
#pragma unroll
          for (int k = 0; k < 16; ++k) { st_e[sj * 16 + k] = (unsigned short)e_[k]; st_g[sj * 16 + k] = g_[k]; }
        }
      }
    }
  }
  for (int pass = 0; pass < npass; ++pass) {
    const int t = tid_opaque();
    __syncthreads();
    for (int i = t; i < 4 * 512; i += 256) cnt[i] = 0;
    __syncthreads();
    const int ctl = t >> 3, cp = t & 7; const int cw = ctl / 3, ctk = ctl % 3;
    bool cact = false;
    float my_su[16], my_sv[16];
    if (ctl < 12) {
      int q = ctk * 4 + cw; int idx = pass * tpp + q; int g = (int)blockIdx.x + idx * (int)gridDim.x;
      cact = q < tpp && idx < per_block && g < ntok;
      if (cact) {
        if (!pre) {
          long row = pg_row(g, ntok);
          peer_combine(top1 + (row * 16 + cp * 2) * 16, top1 + (row * 16 + cp * 2 + 1) * 16, my_e, my_g);
        } else if (pass > 0) {
          const int sj = (pass - 1) * 96 + t;
#pragma unroll
          for (int k = 0; k < 16; ++k) { my_e[k] = st_e[sj * 16 + k]; my_g[k] = st_g[sj * 16 + k]; }
        }
#pragma unroll
        for (int k = 0; k < 16; ++k) { my_su[k] = su[my_e[k]]; my_sv[k] = sv[my_e[k]]; }
#pragma unroll
        for (int k = 0; k < 16; ++k) cnt[((cw * 16 + (my_e[k] >> 10)) * 4 + ctk) * 8 + cp] += 1;
      }
    }
    __syncthreads();
    unsigned short* tot2 = tot + 80;
    if (t < 64) {
      int w_ = t >> 4, s = t & 15; int ne = 0, nbk = 0;
      for (int tk = 0; tk < 3; ++tk) { int n = 0; for (int h = 0; h < 8; ++h) n += cnt[((w_ * 16 + s) * 4 + tk) * 8 + h]; ne += n; nbk += (n + 7) >> 3; }
      tot[w_ * 16 + s] = (unsigned short)ne; tot2[w_ * 16 + s] = (unsigned short)nbk;
    }
    __syncthreads();
    if (t < 64) {
      int w_ = t >> 4, s = t & 15; int run = 0, nb_ = 0;
      for (int i = 0; i < s; ++i) { run += tot[w_ * 16 + i]; nb_ += tot2[w_ * 16 + i]; }
      for (int tk = 0; tk < 3; ++tk) {
        int gstart = run;
        for (int h = 0; h < 8; ++h) { int ci = ((w_ * 16 + s) * 4 + tk) * 8 + h; int c = cnt[ci]; cnt[ci] = (unsigned short)run; run += c; }
        for (int b0 = gstart; b0 < run; b0 += 8) { int n = run - b0 < 8 ? run - b0 : 8; bt[w_ * 160 + nb_] = (unsigned)tk | ((unsigned)b0 << 4) | ((unsigned)n << 16); ++nb_; }
      }
      if (s == 15) { while (nb_ % 3) { bt[w_ * 160 + nb_] = 0u; ++nb_; } nbt[w_] = nb_; }
    }
    __syncthreads();
    if (cact) {
#pragma unroll
      for (int k = 0; k < 16; ++k) { int ci = ((cw * 16 + (my_e[k] >> 10)) * 4 + ctk) * 8 + cp; int pos = cnt[ci]; cnt[ci] = (unsigned short)(pos + 1);
        fe[cw * 384 + pos] = (unsigned short)my_e[k]; fg[cw * 384 + pos] = my_g[k] * my_sv[k]; fs[cw * 384 + pos] = my_su[k]; }
    }
    __syncthreads();
    char* rec = gl + ((long)blockIdx.x * 4 + pass) * 4 * PG3_REC_BYTES;
    for (int i = t; i < 4 * 48; i += 256) { int w_ = i / 48, c = i % 48; *(u32x4*)(rec + w_ * PG3_REC_BYTES + c * 16) = *(const u32x4*)((const char*)fe + w_ * 768 + c * 16); }
    for (int i = t; i < 4 * 96; i += 256) { int w_ = i / 96, c = i % 96; *(u32x4*)(rec + w_ * PG3_REC_BYTES + 768 + c * 16) = *(const u32x4*)((const char*)fg + w_ * 1536 + c * 16); }
    for (int i = t; i < 4 * 96; i += 256) { int w_ = i / 96, c = i % 96; *(u32x4*)(rec + w_ * PG3_REC_BYTES + 2304 + c * 16) = *(const u32x4*)((const char*)fs + w_ * 1536 + c * 16); }
    for (int i = t; i < 4 * 40; i += 256) { int w_ = i / 40, c = i % 40; *(u32x4*)(rec + w_ * PG3_REC_BYTES + 3840 + c * 16) = *(const u32x4*)((const char*)bt + w_ * 640 + c * 16); }
    if (t < 4) *(int*)(rec + t * PG3_REC_BYTES + 4480) = nbt[t];
  }
  __syncthreads();
}
__device__ __forceinline__ void pg3_issue(u32x4 (&B)[8], const unsigned char* __restrict__ tab, const unsigned short* we, unsigned desc, int lane) {
  const int base = (desc >> 4) & 0xFFF, nb = desc >> 16;
#pragma unroll
  for (int j = 0; j < 8; ++j) { const int jj = j < nb ? j : (nb > 0 ? nb - 1 : 0); const unsigned off = (unsigned)we[base + jj] * 1024u + (unsigned)lane * 16u; B[j] = *(const u32x4*)(tab + off); }
}
__device__ __forceinline__ void pg3_axpy8(float (&a)[16], const u32x4 (&V)[8], float w, int nb) {
#pragma unroll
  for (int j = 0; j < 8; ++j) { const float wj = __builtin_bit_cast(float, __builtin_amdgcn_readlane(__builtin_bit_cast(int, w), j)); if (j < nb) axpy16_fp8(a, wj, V[j]); }
}
__device__ __forceinline__ void pg3_step(u32x4 (&U)[8], u32x4 (&V)[8], u32x4 (&F)[8], int k, int nbat, float (&acc)[3][16],
                                         const unsigned char* __restrict__ ub, const unsigned char* __restrict__ vb,
                                         const unsigned short* we, const float* wg, const float* wsc, const unsigned* wb, const bf16_t* hw, int lane) {
  const unsigned desc = __builtin_amdgcn_readfirstlane(wb[k]);
  const int tk = desc & 15, base = (desc >> 4) & 0xFFF, nb = desc >> 16;
  const unsigned dnext = __builtin_amdgcn_readfirstlane(wb[k + 1 < nbat ? k + 1 : k]);
  pg3_issue(F, ub, we, dnext, lane);
  float h[16];
  { const bf16_t* hp = hw + tk * 1024 + lane * 16; u32x4 h0 = *(const u32x4*)hp, h1 = *(const u32x4*)(hp + 8);
#pragma unroll
    for (int e = 0; e < 4; ++e) { h[2*e] = __uint_as_float(h0[e] << 16); h[2*e+1] = __uint_as_float(h0[e] & 0xffff0000u); h[8+2*e] = __uint_as_float(h1[e] << 16); h[8+2*e+1] = __uint_as_float(h1[e] & 0xffff0000u); } }
  float pd[8];
#pragma unroll
  for (int j = 0; j < 8; ++j) pd[j] = j < nb ? dot16_fp8(h, U[j]) : 0.f;
  pg3_issue(U, vb, we, dnext, lane);
  float q4[4], q2[2], q1;
#pragma unroll
  for (int j = 0; j < 4; ++j) { bool hi = lane & 1; float keep = hi ? pd[2*j+1] : pd[2*j], send = hi ? pd[2*j] : pd[2*j+1]; q4[j] = keep + dpp_get<0xB1>(send); }
#pragma unroll
  for (int j = 0; j < 2; ++j) { bool hi = lane & 2; float keep = hi ? q4[2*j+1] : q4[2*j], send = hi ? q4[2*j] : q4[2*j+1]; q2[j] = keep + dpp_get<0x4E>(send); }
  { bool hi = lane & 4; float keep = hi ? q2[1] : q2[0], send = hi ? q2[0] : q2[1]; q1 = keep + xor4_get(send); }
  q1 += dpp_get<0x128>(q1);
  q1 = xor16_sum(q1);
  q1 = xor32_sum(q1);
  float w = 0.f;
  { const int jj = lane & 7; if (jj < nb) w = wg[base + jj] * fgelu_(q1 * wsc[base + jj]); }
  if (tk == 0) pg3_axpy8(acc[0], V, w, nb); else if (tk == 1) pg3_axpy8(acc[1], V, w, nb); else pg3_axpy8(acc[2], V, w, nb);
}
__device__ __forceinline__ void peer_gather_sweep3(const bf16_t* __restrict__ xn, const char* __restrict__ gl, const unsigned char* __restrict__ ub,
                                                   const unsigned char* __restrict__ vb, const float* __restrict__ modl, float* __restrict__ xs, int ntok, char* smem,
                                                   const float* __restrict__ ng, const float* __restrict__ nmod, bf16_t* __restrict__ xn_next, float* __restrict__ out) {
  bf16_t* hs = (bf16_t*)(smem + PG3_OFF_H); unsigned short* fe = (unsigned short*)(smem + PG3_OFF_FE); float* fg = (float*)(smem + PG3_OFF_FG); float* fs = (float*)(smem + PG3_OFF_FS);
  unsigned* bt = (unsigned*)(smem + PG3_OFF_BT); int* nbt = (int*)(smem + PG3_OFF_TOT + 320);
  const int per_block = (ntok + (int)gridDim.x - 1) / (int)gridDim.x;
  const int npass = (per_block + 11) / 12; const int tpp = (per_block + npass - 1) / npass;
  for (int pass = 0; pass < npass; ++pass) {
    {
      const int t = tid_opaque();
      __syncthreads();
      const char* rec = gl + ((long)blockIdx.x * 4 + pass) * 4 * PG3_REC_BYTES;
      for (int i = t; i < 4 * 48; i += 256) { int w_ = i / 48, c = i % 48; *(u32x4*)((char*)fe + w_ * 768 + c * 16) = *(const u32x4*)(rec + w_ * PG3_REC_BYTES + c * 16); }
      for (int i = t; i < 4 * 96; i += 256) { int w_ = i / 96, c = i % 96; *(u32x4*)((char*)fg + w_ * 1536 + c * 16) = *(const u32x4*)(rec + w_ * PG3_REC_BYTES + 768 + c * 16); }
      for (int i = t; i < 4 * 96; i += 256) { int w_ = i / 96, c = i % 96; *(u32x4*)((char*)fs + w_ * 1536 + c * 16) = *(const u32x4*)(rec + w_ * PG3_REC_BYTES + 2304 + c * 16); }
      for (int i = t; i < 4 * 40; i += 256) { int w_ = i / 40, c = i % 40; *(u32x4*)((char*)bt + w_ * 640 + c * 16) = *(const u32x4*)(rec + w_ * PG3_REC_BYTES + 3840 + c * 16); }
      if (t < 4) nbt[t] = *(const int*)(rec + t * PG3_REC_BYTES + 4480);
      for (int i = t; i < 12 * 128; i += 256) {
        int tl = i >> 7, ch = i & 127; int q = (tl % 3) * 4 + (tl / 3); int idx = pass * tpp + q; int g = (int)blockIdx.x + idx * (int)gridDim.x;
        u32x4 v = {0u, 0u, 0u, 0u};
        if (q < tpp && idx < per_block && g < ntok) v = *(const u32x4*)(xn + pg_row(g, ntok) * DM + ch * 8);
        *(u32x4*)(hs + tl * 1024 + ch * 8) = v;
      }
      __syncthreads();
    }
    const int t_s = tid_opaque(); const int lane = t_s & 63, wave = t_s >> 6;
    float acc[3][16];
#pragma unroll
    for (int tk = 0; tk < 3; ++tk)
#pragma unroll
      for (int e = 0; e < 16; ++e) acc[tk][e] = 0.f;
    const int nbat = nbt[wave];
    const unsigned short* we = fe + wave * 384; const float* wg = fg + wave * 384; const float* wsc = fs + wave * 384; const unsigned* wb = bt + wave * 160;
    const bf16_t* hw = hs + wave * 3 * 1024;
    u32x4 X[8], Y[8], Z[8];
    if (nbat > 0) { const unsigned d0 = __builtin_amdgcn_readfirstlane(wb[0]); pg3_issue(X, ub, we, d0, lane); pg3_issue(Y, vb, we, d0, lane); }
    for (int k = 0; k < nbat; k += 3) {
      pg3_step(X, Y, Z, k, nbat, acc, ub, vb, we, wg, wsc, wb, hw, lane);
      pg3_step(Z, X, Y, k + 1, nbat, acc, ub, vb, we, wg, wsc, wb, hw, lane);
      pg3_step(Y, Z, X, k + 2, nbat, acc, ub, vb, we, wg, wsc, wb, hw, lane);
    }
#pragma unroll
    for (int tk = 0; tk < 3; ++tk) {
      int q = tk * 4 + wave; int idx = pass * tpp + q; int g = (int)blockIdx.x + idx * (int)gridDim.x;
      if (q < tpp && idx < per_block && g < ntok) {
        long row = pg_row(g, ntok); int b = row / RB, lr = row % RB; int bb = lr < SEQ ? b : BATCH; const float* g5 = modl + ((long)bb * 6 + 5) * DM + lane * 16;
        float* xr = xs + row * DM + lane * 16;
        f32x4 xv[4]; float ss = 0.f;
#pragma unroll
        for (int i = 0; i < 4; ++i) {
          f32x4 x = *(f32x4*)(xr + 4 * i); f32x4 gg = *(const f32x4*)(g5 + 4 * i);
          x[0] += gg[0] * acc[tk][4*i]; x[1] += gg[1] * acc[tk][4*i+1]; x[2] += gg[2] * acc[tk][4*i+2]; x[3] += gg[3] * acc[tk][4*i+3];
          xv[i] = x; ss += x[0] * x[0] + x[1] * x[1] + x[2] * x[2] + x[3] * x[3];
        }
        if (out) {
          float* orow = out + ((long)b * SEQ + lr) * DM + lane * 16;
#pragma unroll
          for (int i = 0; i < 4; ++i) *(f32x4*)(orow + 4 * i) = xv[i];
        } else {
#pragma unroll
          for (int i = 0; i < 4; ++i) *(f32x4*)(xr + 4 * i) = xv[i];
          ss = wave_sum(ss); const float inv = __builtin_amdgcn_rsqf(ss * (1.f / DM) + EPSN);
          const float* sh = nmod + ((long)bb * 6 + 0) * DM + lane * 16; const float* sc = sh + DM; const float* gp = ng + lane * 16;
          u32x4 p0, p1;
#pragma unroll
          for (int i = 0; i < 4; ++i) { f32x4 g4 = *(const f32x4*)(gp + 4 * i), s4 = *(const f32x4*)(sc + 4 * i), h4 = *(const f32x4*)(sh + 4 * i);
            const float a0 = xv[i][0] * inv * g4[0] * (1.f + s4[0]) + h4[0], a1 = xv[i][1] * inv * g4[1] * (1.f + s4[1]) + h4[1];
            const float a2 = xv[i][2] * inv * g4[2] * (1.f + s4[2]) + h4[2], a3 = xv[i][3] * inv * g4[3] * (1.f + s4[3]) + h4[3];
            if (i < 2) { p0[2 * i] = pack2bf(a0, a1); p0[2 * i + 1] = pack2bf(a2, a3); } else { p1[2 * (i - 2)] = pack2bf(a0, a1); p1[2 * (i - 2) + 1] = pack2bf(a2, a3); } }
          *(u32x4*)(xn_next + row * DM + lane * 16) = p0; *(u32x4*)(xn_next + row * DM + lane * 16 + 8) = p1;
        }
      }
    }
  }
}

#define CS_L 32
#define CS_LDA 72
#define CS_LDS_ 40
#define CS_OFF_KK 0
#define CS_OFF_R  (CS_OFF_KK + 32 * CS_LDA * 2)
#define CS_OFF_K  (CS_OFF_R + 32 * CS_LDA * 2)
#define CS_OFF_B  (CS_OFF_K + 32 * CS_LDA * 2)
#define CS_OFF_S  (CS_OFF_B + 32 * CS_LDA * 2)
#define CS_OFF_VT (CS_OFF_S + 64 * CS_LDA * 2)
#define CS_OFF_UT (CS_OFF_VT + 64 * CS_LDS_ * 2)
#define CS_OFF_KP (CS_OFF_UT + 64 * CS_LDS_ * 2)
#define CS_OFF_BP (CS_OFF_KP + 64 * CS_LDS_ * 2)
#define CS_OFF_A  (CS_OFF_BP + 64 * CS_LDS_ * 2)
#define CS_OFF_P1 (CS_OFF_A + 32 * CS_LDS_ * 2)
#define CS_OFF_P2 (CS_OFF_P1 + 32 * CS_LDS_ * 2)
#define CS_OFF_C  (CS_OFF_P2 + 32 * CS_LDS_ * 2)
#define CS_OFF_G  (CS_OFF_C + 32 * 36 * 4)
#define CS_LDS_BYTES (CS_OFF_G + 5 * 64 * 4)
template <int KS>
__device__ __forceinline__ void cs_mma(const bf16_t* A, int lda, int m0, const bf16_t* Bt, int ldb, int n0, int lane, f32x4& acc) {
  const int fr = lane & 15, fq = lane >> 4;
#pragma unroll
  for (int ks = 0; ks < KS; ++ks) {
    bf16x8 af = *(const bf16x8*)(A + (m0 + fr) * lda + ks * 32 + fq * 8);
    bf16x8 bfr = *(const bf16x8*)(Bt + (n0 + fr) * ldb + ks * 32 + fq * 8);
    acc = __builtin_amdgcn_mfma_f32_16x16x32_bf16(bfr, af, acc, 0, 0, 0);
  }
}
#define CSP_WAVE_BYTES (2 * 32 * CS_LDA * 2 + 32 * 36 * 4)
__device__ __forceinline__ void rw_chunk_inverse(const bf16_t* __restrict__ kk_, const bf16_t* __restrict__ bd_, const float* __restrict__ w_, bf16_t* __restrict__ Mg,
                                                 int job, long dstride, char* smem_wave, int lane) {
  const int job_u = __builtin_amdgcn_readfirstlane(job);
  const int c = job_u % (RB / CS_L), item = job_u / (RB / CS_L);
  const int dir = item & 1, h = (item >> 1) % 6, b = item / 12;
  const long rowbase = (long)b * RB; const int col0 = h * 64;
  bf16_t* KKs = (bf16_t*)smem_wave; bf16_t* Bs_ = KKs + 32 * CS_LDA; float* Cf = (float*)(smem_wave + 2 * 32 * CS_LDA * 2);
  const int fr = lane & 15, fq = lane >> 4;
  const int rlo = dir ? scan_row(1, c * CS_L + 31) : scan_row(0, c * CS_L);
  const long ub_ = (rowbase + rlo) * 384 + col0;
  const char* sw_ = (const char*)(w_ + dir * dstride + ub_); const char* skk_ = (const char*)(kk_ + ub_); const char* sb_ = (const char*)(bd_ + dir * dstride + ub_);
  float wv[32]; unsigned kkr[32], br[32];
#pragma unroll
  for (int tt = 0; tt < 32; ++tt) {
    const unsigned m_ = dir ? 31 - tt : tt;
    wv[tt] = *(const float*)(sw_ + (size_t)((unsigned)lane * 4u + m_ * 1536u)); kkr[tt] = *(const bf16_t*)(skk_ + (size_t)((unsigned)lane * 2u + m_ * 768u)); br[tt] = *(const bf16_t*)(sb_ + (size_t)((unsigned)lane * 2u + m_ * 768u));
  }
  float G = 1.f;
#pragma unroll
  for (int tt = 0; tt < 32; ++tt) {
    KKs[tt * CS_LDA + lane] = f2bf(bf2f((bf16_t)kkr[tt]) * G);
    G *= wv[tt];
    Bs_[tt * CS_LDA + lane] = f2bf(bf2f((bf16_t)br[tt]) * __builtin_amdgcn_rcpf(G));
  }
#pragma unroll
  for (int mt = 0; mt < 2; ++mt)
#pragma unroll
    for (int nt = 0; nt < 2; ++nt) {
      f32x4 a = {0.f, 0.f, 0.f, 0.f};
      cs_mma<2>(KKs, CS_LDA, mt * 16, Bs_, CS_LDA, nt * 16, lane, a);
      const int tt = mt * 16 + fr, s0 = nt * 16 + fq * 4;
      f32x4 o4;
#pragma unroll
      for (int e = 0; e < 4; ++e) o4[e] = (s0 + e < tt) ? a[e] : 0.f;
      *(f32x4*)(Cf + tt * 36 + s0) = o4;
    }
  float m[32];
#pragma unroll
  for (int tt = 0; tt < 32; ++tt) {
    float acc = (tt == lane) ? 1.f : 0.f;
#pragma unroll
    for (int s4 = 0; s4 < tt; s4 += 4) {
      const f32x4 cv = *(const f32x4*)(Cf + tt * 36 + s4);
#pragma unroll
      for (int e = 0; e < 4; ++e) if (s4 + e < tt) acc -= cv[e] * m[s4 + e];
    }
    m[tt] = acc;
  }
  if (lane < 32) {
    bf16_t* dst = Mg + (long)job_u * 1024;
#pragma unroll
    for (int tt = 0; tt < 32; ++tt) dst[tt * 32 + lane] = f2bf(m[tt]);
  }
}
#define CS_FETCH(c_) do { const int s0_ = (c_) * CS_L + cq * 8; const int rlo_ = dir ? scan_row(1, s0_ + 7) : scan_row(0, s0_); \
      const char* fw_ = s_w + (long)rlo_ * 1536; const char* fkk_ = s_kk + (long)rlo_ * 768; const char* fb_ = s_b + (long)rlo_ * 768; \
      const char* fk_ = s_k + (long)rlo_ * 768; const char* fr_ = s_r + (long)rlo_ * 768; const char* fv_ = s_v + (long)rlo_ * 768; \
      _Pragma("unroll") for (int e = 0; e < 8; ++e) { asm volatile("" : "+v"(vo2e[e]), "+v"(vo4e[e]));   \
        pw[e] = *(const float*)(fw_ + (size_t)vo4e[e]); pkk[e] = *(const bf16_t*)(fkk_ + (size_t)vo2e[e]); pb[e] = *(const bf16_t*)(fb_ + (size_t)vo2e[e]); \
        pk[e] = *(const bf16_t*)(fk_ + (size_t)vo2e[e]); pr[e] = *(const bf16_t*)(fr_ + (size_t)vo2e[e]); pv[e] = *(const bf16_t*)(fv_ + (size_t)vo2e[e]); } } while (0)
__device__ __forceinline__ void rw_scan_chunked(const bf16_t* __restrict__ r_, const bf16_t* __restrict__ v_, const bf16_t* __restrict__ kk_, const bf16_t* __restrict__ kd_,
                                                const bf16_t* __restrict__ bd_, const float* __restrict__ w_, float* __restrict__ y_, int item, long dstride, char* smem, const bf16_t* __restrict__ Mg) {
  const int t = tid_opaque(), lane = t & 63, wave = t >> 6, fr = lane & 15, fq = lane >> 4;
  const int item_u = __builtin_amdgcn_readfirstlane(item);
  const int dir = item_u & 1, h = (item_u >> 1) % 6, b = item_u / 12;
  const long rowbase = (long)b * RB; const int col0 = h * 64;
  bf16_t* KKs = (bf16_t*)(smem + CS_OFF_KK); bf16_t* Rs = (bf16_t*)(smem + CS_OFF_R); bf16_t* Ks_ = (bf16_t*)(smem + CS_OFF_K); bf16_t* Bs_ = (bf16_t*)(smem + CS_OFF_B);
  bf16_t* Ss = (bf16_t*)(smem + CS_OFF_S); bf16_t* Vt = (bf16_t*)(smem + CS_OFF_VT); bf16_t* Ut = (bf16_t*)(smem + CS_OFF_UT);
  bf16_t* KpT = (bf16_t*)(smem + CS_OFF_KP); bf16_t* BpT = (bf16_t*)(smem + CS_OFF_BP);
  bf16_t* As_ = (bf16_t*)(smem + CS_OFF_A); bf16_t* P1s = (bf16_t*)(smem + CS_OFF_P1); bf16_t* P2s = (bf16_t*)(smem + CS_OFF_P2);
  bf16_t* Ms = (bf16_t*)(smem + CS_OFF_C);
  float* Gq = (float*)(smem + CS_OFF_G); float* GL = Gq + 256;
  bf16_t* rhsT = (bf16_t*)(smem + CS_OFF_K);
  const int cj = t & 63, cq = __builtin_amdgcn_readfirstlane(t >> 6);
  unsigned vo2e[8], vo4e[8];
#pragma unroll
  for (int e = 0; e < 8; ++e) { const int m_ = dir ? 7 - e : e; vo2e[e] = (unsigned)cj * 2u + (unsigned)m_ * 768u; vo4e[e] = (unsigned)cj * 4u + (unsigned)m_ * 1536u; }
  const long ubase_ = rowbase * 384 + col0;
  const char* s_w = (const char*)(w_ + dir * dstride + ubase_); const char* s_kk = (const char*)(kk_ + ubase_); const char* s_b = (const char*)(bd_ + dir * dstride + ubase_);
  const char* s_k = (const char*)(kd_ + dir * dstride + ubase_); const char* s_r = (const char*)(r_ + ubase_); const char* s_v = (const char*)(v_ + ubase_);
  __syncthreads();
  for (int i = t; i < 64 * CS_LDA; i += 256) Ss[i] = 0;
  f32x4 Sacc[4];
#pragma unroll
  for (int it = 0; it < 4; ++it) Sacc[it] = (f32x4){0.f, 0.f, 0.f, 0.f};
  float pw[8]; unsigned pkk[8], pb[8], pk[8], pr[8], pv[8]; uint2 pm;
  const bf16_t* Mitem = Mg + (long)item * (RB / CS_L) * 1024 + t * 4;
  CS_FETCH(0); pm = *(const uint2*)Mitem;
  __builtin_amdgcn_s_setprio(3);
  const int NCH = RB / CS_L;
  for (int c = 0; c < NCH; ++c) {
#pragma unroll
    for (int e = 0; e < 8; ++e) asm volatile("" : "+v"(pw[e]), "+v"(pkk[e]), "+v"(pb[e]), "+v"(pk[e]), "+v"(pr[e]), "+v"(pv[e]));
    asm volatile("" : "+v"(pm.x), "+v"(pm.y));
    float g[8]; float run = 1.f;
#pragma unroll
    for (int e = 0; e < 8; ++e) { run *= pw[e]; g[e] = run; }
    Gq[cq * 64 + cj] = run;
    float kkv[8], bv[8], kv[8], rv[8]; bf16_t vv[8];
#pragma unroll
    for (int e = 0; e < 8; ++e) { kkv[e] = bf2f((bf16_t)pkk[e]); bv[e] = bf2f((bf16_t)pb[e]); kv[e] = bf2f((bf16_t)pk[e]); rv[e] = bf2f((bf16_t)pr[e]); vv[e] = (bf16_t)pv[e]; }
    __syncthreads();
    const uint2 pm_cur = pm;
    if (c + 1 < NCH) { CS_FETCH(c + 1); pm = *(const uint2*)(Mitem + (long)(c + 1) * 1024); }
    float base = 1.f, tot = 1.f;
#pragma unroll
    for (int q = 0; q < 4; ++q) { float pq = Gq[q * 64 + cj]; if (q < cq) base *= pq; tot *= pq; }
    if (cq == 0) GL[cj] = tot;
    {
      u32x4 kp4, bp4, vt4;
#pragma unroll
      for (int e = 0; e < 8; ++e) {
        const float G = base * g[e], Gp = e == 0 ? base : base * g[e - 1], iG = __builtin_amdgcn_rcpf(G);
        const int tt = cq * 8 + e;
        KKs[tt * CS_LDA + cj] = f2bf(kkv[e] * Gp); Rs[tt * CS_LDA + cj] = f2bf(rv[e] * G);
        const float kt = kv[e] * iG, bt = bv[e] * iG;
        Ks_[tt * CS_LDA + cj] = f2bf(kt); Bs_[tt * CS_LDA + cj] = f2bf(bt);
        kv[e] = kt * tot; bv[e] = -bt * tot;
      }
#pragma unroll
      for (int e = 0; e < 4; ++e) { kp4[e] = pack2bf(kv[2 * e], kv[2 * e + 1]); bp4[e] = pack2bf(bv[2 * e], bv[2 * e + 1]); vt4[e] = (unsigned)vv[2 * e] | ((unsigned)vv[2 * e + 1] << 16); }
      *(uint2*)(Ms + (t >> 3) * CS_LDS_ + (t & 7) * 4) = pm_cur;
      *(u32x4*)(KpT + cj * CS_LDS_ + cq * 8) = kp4; *(u32x4*)(BpT + cj * CS_LDS_ + cq * 8) = bp4; *(u32x4*)(Vt + cj * CS_LDS_ + cq * 8) = vt4;
    }
    __syncthreads();
    if (wave == 1) {
    } else {
      const bf16_t* X = wave == 0 ? KKs : Rs; const bf16_t* Y = wave == 3 ? Bs_ : Ks_;
#pragma unroll
      for (int mt = 0; mt < 2; ++mt)
#pragma unroll
        for (int nt = 0; nt < 2; ++nt) {
          f32x4 a = {0.f, 0.f, 0.f, 0.f};
          cs_mma<2>(X, CS_LDA, mt * 16, Y, CS_LDA, nt * 16, lane, a);
          const int tt = mt * 16 + fr, s0 = nt * 16 + fq * 4;
          float o[4];
#pragma unroll
          for (int e = 0; e < 4; ++e) { const int s = s0 + e; const bool keep = wave == 0 ? (s < tt) : (s <= tt); o[e] = keep ? a[e] : 0.f; }
          bf16_t* dst = wave == 0 ? As_ : (wave == 2 ? P1s : P2s); const float sg = wave == 3 ? -1.f : 1.f;
          uint2 pk2; pk2.x = pack2bf(sg * o[0], sg * o[1]); pk2.y = pack2bf(sg * o[2], sg * o[3]);
          *(uint2*)(dst + tt * CS_LDS_ + s0) = pk2;
        }
    }
    __syncthreads();
    f32x4 yp[2];
    {
      const bf16x8 sb0 = *(const bf16x8*)(Ss + (wave * 16 + fr) * CS_LDA + fq * 8), sb1 = *(const bf16x8*)(Ss + (wave * 16 + fr) * CS_LDA + 32 + fq * 8);
      const bf16x8 vb = *(const bf16x8*)(Vt + (wave * 16 + fr) * CS_LDS_ + fq * 8);
      bf16x8 ak[2][2], ar[2][2], aa[2], ap[2];
#pragma unroll
      for (int mt = 0; mt < 2; ++mt) {
        ak[mt][0] = *(const bf16x8*)(KKs + (mt * 16 + fr) * CS_LDA + fq * 8); ak[mt][1] = *(const bf16x8*)(KKs + (mt * 16 + fr) * CS_LDA + 32 + fq * 8);
        ar[mt][0] = *(const bf16x8*)(Rs + (mt * 16 + fr) * CS_LDA + fq * 8);  ar[mt][1] = *(const bf16x8*)(Rs + (mt * 16 + fr) * CS_LDA + 32 + fq * 8);
        aa[mt] = *(const bf16x8*)(As_ + (mt * 16 + fr) * CS_LDS_ + fq * 8);   ap[mt] = *(const bf16x8*)(P1s + (mt * 16 + fr) * CS_LDS_ + fq * 8);
      }
#pragma unroll
      for (int mt = 0; mt < 2; ++mt) {
        f32x4 a = {0.f, 0.f, 0.f, 0.f}, y2 = {0.f, 0.f, 0.f, 0.f};
        a = __builtin_amdgcn_mfma_f32_16x16x32_bf16(sb0, ak[mt][0], a, 0, 0, 0);   y2 = __builtin_amdgcn_mfma_f32_16x16x32_bf16(sb0, ar[mt][0], y2, 0, 0, 0);
        a = __builtin_amdgcn_mfma_f32_16x16x32_bf16(sb1, ak[mt][1], a, 0, 0, 0);   y2 = __builtin_amdgcn_mfma_f32_16x16x32_bf16(sb1, ar[mt][1], y2, 0, 0, 0);
        a = __builtin_amdgcn_mfma_f32_16x16x32_bf16(vb, aa[mt], a, 0, 0, 0);       y2 = __builtin_amdgcn_mfma_f32_16x16x32_bf16(vb, ap[mt], y2, 0, 0, 0);
#pragma unroll
        for (int e = 0; e < 4; ++e) rhsT[(wave * 16 + fq * 4 + e) * CS_LDS_ + mt * 16 + fr] = f2bf(a[e]);
        yp[mt] = y2;
      }
    }
    __syncthreads();
#pragma unroll
    for (int nt = 0; nt < 2; ++nt) {
      f32x4 a = {0.f, 0.f, 0.f, 0.f};
      cs_mma<1>(rhsT, CS_LDS_, wave * 16, Ms, CS_LDS_, nt * 16, lane, a);
      uint2 pk2; pk2.x = pack2bf(a[0], a[1]); pk2.y = pack2bf(a[2], a[3]);
      *(uint2*)(Ut + (wave * 16 + fr) * CS_LDS_ + nt * 16 + fq * 4) = pk2;
    }
    __syncthreads();
    {
      const bf16x8 ub_ = *(const bf16x8*)(Ut + (wave * 16 + fr) * CS_LDS_ + fq * 8);
      const bf16x8 kpb = *(const bf16x8*)(KpT + (wave * 16 + fr) * CS_LDS_ + fq * 8), bpb = *(const bf16x8*)(BpT + (wave * 16 + fr) * CS_LDS_ + fq * 8);
      bf16x8 p2a[2], va[4], ua[4];
#pragma unroll
      for (int mt = 0; mt < 2; ++mt) p2a[mt] = *(const bf16x8*)(P2s + (mt * 16 + fr) * CS_LDS_ + fq * 8);
#pragma unroll
      for (int it = 0; it < 4; ++it) { va[it] = *(const bf16x8*)(Vt + (it * 16 + fr) * CS_LDS_ + fq * 8); ua[it] = *(const bf16x8*)(Ut + (it * 16 + fr) * CS_LDS_ + fq * 8); }
      const f32x4 gl = *(const f32x4*)(GL + wave * 16 + fq * 4);
#pragma unroll
      for (int mt = 0; mt < 2; ++mt) {
        yp[mt] = __builtin_amdgcn_mfma_f32_16x16x32_bf16(ub_, p2a[mt], yp[mt], 0, 0, 0);
        const long row = rowbase + scan_row(dir, c * CS_L) + (dir ? -(mt * 16 + fr) : (mt * 16 + fr));
        *(f32x4*)(y_ + dir * dstride + row * 384 + col0 + wave * 16 + fq * 4) = yp[mt];
      }
#pragma unroll
      for (int it = 0; it < 4; ++it) {
        f32x4 a = Sacc[it]; a[0] *= gl[0]; a[1] *= gl[1]; a[2] *= gl[2]; a[3] *= gl[3];
        a = __builtin_amdgcn_mfma_f32_16x16x32_bf16(kpb, va[it], a, 0, 0, 0);
        a = __builtin_amdgcn_mfma_f32_16x16x32_bf16(bpb, ua[it], a, 0, 0, 0);
        Sacc[it] = a;
      }
    }
    __syncthreads();
#pragma unroll
    for (int it = 0; it < 4; ++it) { uint2 pk2; pk2.x = pack2bf(Sacc[it][0], Sacc[it][1]); pk2.y = pack2bf(Sacc[it][2], Sacc[it][3]); *(uint2*)(Ss + (it * 16 + fr) * CS_LDA + wave * 16 + fq * 4) = pk2; }
  }
  __builtin_amdgcn_s_setprio(0);
  __syncthreads();
}
#include <hip/hip_cooperative_groups.h>
namespace cg = cooperative_groups;

#define XB_TMO      128
#define XB_XCNT(j)  (256  + 64 * (j))
#define XB_XSUB(j)  (1280 + 64 * (j))
#define XB_XGEN(j)  (2304 + 64 * (j))
#define XB_TOP      3328
#define XB_TOPGEN   3392
#define XB_QUEUE(i) (3456 + 64 * (i))
#define XCD_BAR_WORDS 4096
#define XB_SPIN_CAP (1u << 22)
#define LAS __attribute__((address_space(3)))
__device__ __forceinline__ unsigned xb_ld(unsigned* p)              { return __hip_atomic_load(p, __ATOMIC_RELAXED, __HIP_MEMORY_SCOPE_AGENT); }
__device__ __forceinline__ unsigned xb_add(unsigned* p, unsigned v) { return __hip_atomic_fetch_add(p, v, __ATOMIC_RELAXED, __HIP_MEMORY_SCOPE_AGENT); }
__device__ __forceinline__ unsigned xb_xcc_id() { return (unsigned)__builtin_amdgcn_s_getreg((3 << 11) | 20) & 0xFu; }
#define XB_SPIN(cond, bar) do { unsigned _sp = 0; while (cond) { __builtin_amdgcn_s_sleep(1); \
    if ((++_sp & 255u) == 0u) { if (xb_ld(&(bar)[XB_TMO])) break; if (_sp > XB_SPIN_CAP) { atomicAdd(&(bar)[XB_TMO], 1u); break; } } } } while (0)
struct XcdBarrier { unsigned* bar; unsigned x; volatile LAS unsigned* st; };
__device__ __forceinline__ XcdBarrier xcd_barrier_post(unsigned* bar, volatile LAS unsigned* st) {
  XcdBarrier b; b.bar = bar; b.x = xb_xcc_id(); b.st = st;
  if (threadIdx.x == 0) (void)xb_add(&bar[XB_XCNT(b.x)], 1u);
  return b;
}
__device__ __forceinline__ void xcd_barrier_complete(unsigned* bar, unsigned x, unsigned& nloc, unsigned& nx) {
  const unsigned G = gridDim.x; unsigned sum, cnt, mine, sp = 0u;
  for (;;) {
    sum = 0u; cnt = 0u; mine = 0u;
#pragma unroll
    for (unsigned j = 0; j < 16; ++j) { const unsigned c = xb_ld(&bar[XB_XCNT(j)]); sum += c; cnt += (c > 0u) ? 1u : 0u; mine = (j == x) ? c : mine; }
    if (sum == G) break;
    __builtin_amdgcn_s_sleep(1);
    if ((++sp & 255u) == 0u) { if (xb_ld(&bar[XB_TMO])) break; if (sp > XB_SPIN_CAP) { atomicAdd(&bar[XB_TMO], 1u); break; } }
  }
  nloc = mine > 0u ? mine : 1u; nx = cnt > 0u ? cnt : 1u;
}
__device__ __forceinline__ void xcd_barrier(const XcdBarrier& b) {
  asm volatile("s_waitcnt vmcnt(0)" ::: "memory");
  __syncthreads();
  if (threadIdx.x == 0) {
    unsigned* bar = b.bar;
    __builtin_amdgcn_s_waitcnt(0);
    unsigned nloc = b.st[0], nx = b.st[1];
    if (nloc == 0u) { xcd_barrier_complete(bar, b.x, nloc, nx); b.st[0] = nloc; b.st[1] = nx; }
    const unsigned old = xb_add(&bar[XB_XSUB(b.x)], 1u);
    const unsigned gen = old / nloc;
    if (old + 1u == (gen + 1u) * nloc) {
      __builtin_amdgcn_fence(__ATOMIC_RELEASE, "agent");
      asm volatile("s_waitcnt vmcnt(0)" ::: "memory");
      const unsigned og = xb_add(&bar[XB_TOP], 1u);
      const unsigned tg = og / nx;
      if (og + 1u == (tg + 1u) * nx) xb_add(&bar[XB_TOPGEN], 1u);
      else XB_SPIN(xb_ld(&bar[XB_TOPGEN]) == tg, bar);
      __builtin_amdgcn_fence(__ATOMIC_ACQUIRE, "agent");
      xb_add(&bar[XB_XGEN(b.x)], 1u);
      asm volatile("s_waitcnt vmcnt(0)" ::: "memory");
    } else {
      XB_SPIN(xb_ld(&bar[XB_XGEN(b.x)]) == gen, bar);
      __builtin_amdgcn_fence(__ATOMIC_ACQUIRE, "agent");
      asm volatile("s_waitcnt vmcnt(0)" ::: "memory");
    }
  }
  __syncthreads();
}


constexpr size_t al256(size_t x) { return (x + 255) & ~(size_t)255; }
struct WsOff { size_t xs, mod, xn, Pb, tq, tkv, a_b, g_b, w_f, mq, mk, mvT, gq, gk, gvT, r_b, v_b, kk_b, kd_b, bd_b, w_inT, w_outT, wqT, keysb, wqbT, wkvbT, w2T, a2T, g2T, rope_g, rope_m, total; };
constexpr WsOff make_wsoff() {
  WsOff o{}; size_t p = 32768; const size_t MA = NROWS;
  o.mod = p; p += al256(2 * (BATCH + 1) * 6144 * 4); o.xs = p; p += al256(MA * DM * 4); o.xn = p; p += al256(MA * DM * 2);
  o.Pb = p; p += al256(MA * IN_COLS * 2);
  o.tq = p; p += al256(MA * 384 * 2); o.tkv = p; p += al256(MA * 512 * 2); o.a_b = p; p += al256(2 * MA * 384 * 2);
  o.g_b = p; p += al256(MA * 384 * 2); o.w_f = p; p += al256(2 * MA * 384 * 4);
  o.mq = p; p += al256(MA * 384 * 2); o.mk = p; p += al256(MA * 384 * 2); o.mvT = p; p += al256((size_t)BATCH * 4 * 64 * RB * 2);
  o.gq = p; p += al256(MA * 384 * 2); o.gk = p; p += al256(MA * 128 * 2); o.gvT = p; p += al256((size_t)BATCH * 2 * 64 * RB * 2);
  o.r_b = p; p += al256(MA * 384 * 2); o.v_b = p; p += al256(MA * 384 * 2); o.kk_b = p; p += al256(MA * 384 * 2);
  o.kd_b = p; p += al256(2 * MA * 384 * 2); o.bd_b = p; p += al256(2 * MA * 384 * 2);
  o.w_inT = p; p += al256((size_t)2 * 2688 * 1024 * 2); o.w_outT = p; p += al256((size_t)2 * 1024 * 1024 * 2); o.wqT = p; p += al256((size_t)2 * 2048 * 1024 * 2);
  o.keysb = p; p += al256((size_t)2 * 16 * 128 * 128 * 2); o.wqbT = p; p += al256((size_t)2 * 384 * 256 * 2); o.wkvbT = p; p += al256((size_t)2 * 512 * 128 * 2);
  o.w2T = p; p += al256((size_t)2 * 2 * 384 * 64 * 2); o.a2T = p; p += al256((size_t)2 * 2 * 384 * 64 * 2); o.g2T = p; p += al256((size_t)2 * 384 * 192 * 2);
  o.rope_g = p; p += al256((size_t)SEQ * 64 * 4); o.rope_m = p; p += al256((size_t)SEQ * 32 * 4);
  o.total = p; return o;
}
constexpr WsOff WO = make_wsoff();
#define WS_PTR(T, off) ((T*)(ws + (off)))
#define MINV_OFF (WO.tq + (size_t)40 * 1024 * 1024)
#define TAB_OFF (WO.Pb + ((size_t)2 * NROWS * 384 * 4 + 1048576 & ~(size_t)255))
#define TAB_U (TAB_OFF)
#define TAB_V (TAB_OFF + (size_t)16384 * 1024)
#define TAB_SU (TAB_OFF + (size_t)2 * 16384 * 1024)
#define TAB_SV (TAB_OFF + (size_t)2 * 16384 * 1024 + 65536)
#define LAUNDER_S(x) asm volatile("" : "+s"(x))
#define KARG_AS __attribute__((address_space(4)))
#define KP_DECL const KARG_AS MegaP* kp_ = (const KARG_AS MegaP*)__builtin_amdgcn_kernarg_segment_ptr(); LAUNDER_S(kp_)

struct NaiveIn {
  const float *x, *c, *ctx, *c_ctx, *ada_w, *ada_b, *norm_mix_g, *norm_ffn_g, *w_in, *w_out, *mla_q_norm_g, *mla_w_qb, *mla_kv_norm_g,
      *mla_w_kvb, *mla_qk_g, *rw_mu, *rw_w0, *rw_w2, *rw_a0, *rw_a2, *rw_g2, *rw_k_k, *rw_k_a, *rw_r_k, *rw_ln_g, *rw_ln_b, *gqa_qk_g,
      *pe_wq, *pe_keys, *pe_u, *pe_v;
};
struct MegaP { NaiveIn in; char* ws; float* out; };

#ifndef MEGA_CG
#define MEGA_CG 0
#endif
#if MEGA_CG
#define GRID_BARRIER() cg::this_grid().sync()
#else
#ifdef BAR_TWICE
#define GRID_BARRIER() do { GRID_BARRIER1(); GRID_BARRIER1(); } while (0)
#else
#define GRID_BARRIER() GRID_BARRIER1()
#endif
#define GRID_BARRIER1() do { XcdBarrier xb_; xb_.bar = (unsigned*)((const KARG_AS MegaP*)__builtin_amdgcn_kernarg_segment_ptr())->ws; xb_.x = xb_xcc_id(); xb_.st = (volatile LAS unsigned*)&xb_words; xcd_barrier(xb_); } while (0)
#endif
#define MEGA_LDS_BYTES 65536
#ifndef PHASE_MASK
#define PHASE_MASK 0xFFFF
#endif
#define PH(k) if (PHASE_MASK & (1 << (k)))
#define LAT_TM(i) (((i) >> 4) * 18 + ((i) & 15))
#define XCD_TILE_LOOP(tile, T) for (int xt_base_ = (int)(((long)(T) * (blockIdx.x & 7)) >> 3), xt_cnt_ = (int)(((long)(T) * ((blockIdx.x & 7) + 1)) >> 3) - xt_base_, xt_q_ = blockIdx.x >> 3, tile = xt_base_ + xt_q_; xt_q_ < xt_cnt_; xt_q_ += gridDim.x >> 3, tile = xt_base_ + xt_q_)
#ifndef DIL_PH
#define DIL_PH -1
#endif
#ifndef DIL_MULT
#define DIL_MULT 4
#endif
#define DIL_BEGIN(k) unsigned long long dil_t0 = 0; if (DIL_PH == (k)) dil_t0 = __builtin_amdgcn_s_memrealtime();
#define DIL_END(k) if (DIL_PH == (k)) { GRID_BARRIER(); if (blockIdx.x == 0 && threadIdx.x == 0) { unsigned long long t1 = __builtin_amdgcn_s_memrealtime(); unsigned long long dt = (t1 - dil_t0) * DIL_MULT; \
    while (__builtin_amdgcn_s_memrealtime() - t1 < dt) __builtin_amdgcn_s_sleep(32); } }

__device__ __forceinline__ void ph_norm_mod(const float* xs, const float* g, const float* modl, int shift_idx, bf16_t* xn, bool skip_ctx = false, const float* x_in = nullptr, const float* ctx_in = nullptr) {
  const int tt_ = tid_opaque(); const int lane = tt_ & 63;
  for (long row = blockIdx.x * 4 + (tt_ >> 6); row < NROWS; row += (long)gridDim.x * 4) {
    int b = row / RB, lr = row % RB; int bb = lr < SEQ ? b : BATCH;
    if (skip_ctx && lr >= SEQ) continue;
    const float* sh = modl + ((long)bb * 6 + shift_idx) * DM; const float* sc = sh + DM;
    const float* xr = x_in ? (lr < SEQ ? x_in + ((long)b * SEQ + lr) * DM : ctx_in + ((long)b * CTX_LEN + (lr - SEQ)) * DM) : xs + row * DM; f32x4 v[4]; float ss = 0.f;
#pragma unroll
    for (int i = 0; i < 4; ++i) { v[i] = *(const f32x4*)(xr + i * 256 + lane * 4); ss += v[i][0]*v[i][0] + v[i][1]*v[i][1] + v[i][2]*v[i][2] + v[i][3]*v[i][3]; }
    ss = wave_sum(ss);
    float inv = __builtin_amdgcn_rsqf(ss / DM + EPSN);
#pragma unroll
    for (int i = 0; i < 4; ++i) {
      int d = i * 256 + lane * 4; float o[4];
#pragma unroll
      for (int e = 0; e < 4; ++e) o[e] = v[i][e] * inv * g[d+e] * (1.f + sc[d+e]) + sh[d+e];
      uint2 pk; pk.x = pack2bf(o[0], o[1]); pk.y = pack2bf(o[2], o[3]);
      *(uint2*)(xn + row * DM + d) = pk;
    }
  }
}
__device__ __forceinline__ void ph_cvt_wT(const float* W, const float* g, bf16_t* Wt, int K, int N, int Npad, int Kpad) {
  const long n_el = (long)Npad * Kpad;
  const int tt_ = tid_opaque();
  for (long i = (long)blockIdx.x * 256 + tt_; i < n_el; i += (long)gridDim.x * 256) {
    int k = i % Kpad; int n = i / Kpad;
    Wt[i] = (k < K && n < N) ? f2bf(W[(long)k * N + n] * (g ? g[k] : 1.f)) : (bf16_t)0;
  }
}
__device__ __forceinline__ void ph_cvt_bf16(const float* s, bf16_t* d, long n8) {
  const int tt_ = tid_opaque();
  for (long i = (long)blockIdx.x * 256 + tt_; i < n8; i += (long)gridDim.x * 256) {
    f32x4 a = *(const f32x4*)(s + i * 8), b = *(const f32x4*)(s + i * 8 + 4);
    u32x4 o; o[0] = pack2bf(a[0], a[1]); o[1] = pack2bf(a[2], a[3]); o[2] = pack2bf(b[0], b[1]); o[3] = pack2bf(b[2], b[3]);
    *(u32x4*)(d + i * 8) = o;
  }
}


__device__ __forceinline__ void ph_cvt_wT_tiled(const float* __restrict__ W, const float* __restrict__ g, bf16_t* __restrict__ Wt, int K, int N, int Npad, int Kpad, char* smem) {
  const int t = tid_opaque(); float* s = (float*)smem;
  const int tk = Kpad / 64, tn = Npad / 64;
  for (int tile = blockIdx.x; tile < tk * tn; tile += gridDim.x) {
    const int k0 = (tile % tk) * 64, n0 = (tile / tk) * 64;
    __syncthreads();
#pragma unroll
    for (int i = 0; i < 4; ++i) {
      int kk = (t >> 4) + 16 * i, nn = (t & 15) * 4; int k = k0 + kk;
      f32x4 v = {0.f, 0.f, 0.f, 0.f};
      if (k < K) {
        const float* src = W + (long)k * N + n0 + nn; float gs = g ? g[k] : 1.f;
        if (n0 + nn + 3 < N) v = *(const f32x4*)src; else { for (int e = 0; e < 4; ++e) if (n0 + nn + e < N) v[e] = src[e]; }
        v *= gs;
      }
#pragma unroll
      for (int e = 0; e < 4; ++e) s[kk * 65 + nn + e] = v[e];
    }
    __syncthreads();
    {
      int nn = t >> 2, kq = (t & 3) * 16; u32x4 o0, o1;
#pragma unroll
      for (int e = 0; e < 4; ++e) { o0[e] = pack2bf(s[(kq + 2*e) * 65 + nn], s[(kq + 2*e + 1) * 65 + nn]); o1[e] = pack2bf(s[(kq + 8 + 2*e) * 65 + nn], s[(kq + 8 + 2*e + 1) * 65 + nn]); }
      bf16_t* dst = Wt + (long)(n0 + nn) * Kpad + k0 + kq;
      *(u32x4*)dst = o0; *(u32x4*)(dst + 8) = o1;
    }
  }
}
__device__ __forceinline__ void ph_mod_gemv(const float* __restrict__ c, const float* __restrict__ c_ctx, const float* __restrict__ ada_w, const float* __restrict__ ada_b, float* __restrict__ mod, char* smem) {
  const int t = tid_opaque(); float* s = (float*)smem;
  if ((int)blockIdx.x >= 2 * 96) return;
  for (int i = t; i < 9 * 1024; i += 256) { int bb = i >> 10, k = i & 1023; float v = bb < BATCH ? c[bb * DM + k] : c_ctx[k]; s[i] = v * __builtin_amdgcn_rcpf(1.f + __builtin_amdgcn_exp2f(-v * 1.4426950408889634f)); }
  __syncthreads();
  float* part = s + 9 * 1024;
  for (int item = blockIdx.x; item < 2 * 96; item += gridDim.x) {
    const int cb = item % 96, l = item / 96; const int kq = t >> 6, col = t & 63;
    const int j = cb * 64 + col; const float* wp = ada_w + ((long)l * DM + kq * 256) * 6144 + j;
    float acc[9];
#pragma unroll
    for (int bb = 0; bb < 9; ++bb) acc[bb] = 0.f;
#pragma unroll 16
    for (int k = 0; k < 256; ++k) { float w = wp[(long)k * 6144];
#pragma unroll
      for (int bb = 0; bb < 9; ++bb) acc[bb] += s[bb * 1024 + kq * 256 + k] * w; }
#pragma unroll
    for (int bb = 0; bb < 9; ++bb) part[(kq * 9 + bb) * 64 + col] = acc[bb];
    __syncthreads();
    for (int i = t; i < 9 * 64; i += 256) { int bb = i >> 6, cc = i & 63;
      float v = ((part[(0 * 9 + bb) * 64 + cc] + part[(1 * 9 + bb) * 64 + cc]) + part[(2 * 9 + bb) * 64 + cc]) + part[(3 * 9 + bb) * 64 + cc];
      mod[((long)l * (BATCH + 1) + bb) * 6144 + cb * 64 + cc] = v + ada_b[l * 6144 + cb * 64 + cc]; }
    __syncthreads();
  }
}

__global__ void __launch_bounds__(256, 2) mega_kernel(MegaP p) {
  __shared__ __attribute__((aligned(16))) char smem[MEGA_LDS_BYTES];
  __shared__ uint4 xb_words;
  const int t0 = threadIdx.x;
#if !MEGA_CG
  if (t0 == 0) xb_words = make_uint4(0u, 0u, 0u, 0u);
  __syncthreads();
  (void)xcd_barrier_post((unsigned*)p.ws, (volatile LAS unsigned*)&xb_words);
#endif
  const long MA = NROWS; const int TM = NROWS / 128;
#define I (kp_->in)
  const int scan_role = (int)blockIdx.x < BATCH * 12 ? 1 : 0;
  { DIL_BEGIN(0)
  PH(0) {
    KP_DECL; char* ws = kp_->ws; const int t = tid_opaque();
    float* xs = WS_PTR(float, WO.xs); float* mod = WS_PTR(float, WO.mod);
    ph_mod_gemv(I.c, I.c_ctx, I.ada_w, I.ada_b, mod, smem);
    for (int l = 0; l < 2; ++l) {
      ph_cvt_wT_tiled(I.w_in + (long)l * DM * IN_COLS, nullptr, WS_PTR(bf16_t, WO.w_inT) + (long)l * 2688 * 1024, 1024, IN_COLS, 2688, 1024, smem);
      ph_cvt_wT_tiled(I.w_out + (long)l * DM * DM, nullptr, WS_PTR(bf16_t, WO.w_outT) + (long)l * 1024 * 1024, 1024, 1024, 1024, 1024, smem);
      ph_cvt_wT_tiled(I.pe_wq + (long)l * DM * 2048, nullptr, WS_PTR(bf16_t, WO.wqT) + (long)l * 2048 * 1024, 1024, 2048, 2048, 1024, smem);
      ph_cvt_wT_tiled(I.mla_w_qb + (long)l * 256 * 384, I.mla_q_norm_g + l * 256, WS_PTR(bf16_t, WO.wqbT) + (long)l * 384 * 256, 256, 384, 384, 256, smem);
      ph_cvt_wT_tiled(I.mla_w_kvb + (long)l * 128 * 512, I.mla_kv_norm_g + l * 128, WS_PTR(bf16_t, WO.wkvbT) + (long)l * 512 * 128, 128, 512, 512, 128, smem);
      for (int d = 0; d < 2; ++d) {
        ph_cvt_wT_tiled(I.rw_w2 + ((long)l * 2 + d) * 64 * 384, nullptr, WS_PTR(bf16_t, WO.w2T) + ((long)l * 2 + d) * 384 * 64, 64, 384, 384, 64, smem);
        ph_cvt_wT_tiled(I.rw_a2 + ((long)l * 2 + d) * 64 * 384, nullptr, WS_PTR(bf16_t, WO.a2T) + ((long)l * 2 + d) * 384 * 64, 64, 384, 384, 64, smem);
      }
      ph_cvt_wT_tiled(I.rw_g2 + (long)l * 160 * 384, nullptr, WS_PTR(bf16_t, WO.g2T) + (long)l * 384 * 192, 160, 384, 384, 192, smem);
    }
    ph_cvt_bf16(I.pe_keys, WS_PTR(bf16_t, WO.keysb), 2L * 16 * 128 * 128 / 8);
    ph_rope_tables(WS_PTR(float, WO.rope_g), WS_PTR(float, WO.rope_m));
  }
  DIL_END(0) }
  GRID_BARRIER();
  for (int lq = 0; lq < 2; ++lq) {
    int l = lq; LAUNDER_S(l);
    { DIL_BEGIN(1)
    PH(1) if (l == 0) {
      KP_DECL; char* ws = kp_->ws; const int t = tid_opaque(); (void)t;
      ph_norm_mod(WS_PTR(float, WO.xs), I.norm_mix_g + l * DM, WS_PTR(float, WO.mod) + (long)l * (BATCH + 1) * 6144, 0, WS_PTR(bf16_t, WO.xn), false, I.x, I.ctx);
    }
    DIL_END(1) }
    GRID_BARRIER();
    { DIL_BEGIN(2)
    PH(2) {
      KP_DECL; char* ws = kp_->ws; const int t = tid_opaque(); (void)t;
      const bf16_t* xn = WS_PTR(bf16_t, WO.xn); const bf16_t* wT = WS_PTR(bf16_t, WO.w_inT) + (long)l * 2688 * 1024; bf16_t* Pb = WS_PTR(bf16_t, WO.Pb);
      XCD_TILE_LOOP(tile, TM * 21)
        gemm_tile_128_glds(xn, DM, wT, 1024, 1024, tile / 21, tile % 21, smem, EpiStoreBf16{Pb, IN_COLS, IN_COLS});
    }
    DIL_END(2) }
    GRID_BARRIER();
    { DIL_BEGIN(3)
    PH(3) {
      KP_DECL; char* ws = kp_->ws; const int t = tid_opaque(); (void)t;
      PrepW pw{WS_PTR(bf16_t, WO.wqbT) + (long)l * 384 * 256, WS_PTR(bf16_t, WO.wkvbT) + (long)l * 512 * 128, WS_PTR(bf16_t, WO.w2T) + (long)l * 2 * 384 * 64,
               WS_PTR(bf16_t, WO.a2T) + (long)l * 2 * 384 * 64, WS_PTR(bf16_t, WO.g2T) + (long)l * 384 * 192, I.rw_mu + (long)l * 2 * RWC, I.rw_w0 + l * 768, I.rw_a0 + l * 768};
      PrepBuf pb{WS_PTR(bf16_t, WO.Pb), WS_PTR(bf16_t, WO.tq), WS_PTR(bf16_t, WO.tkv), WS_PTR(bf16_t, WO.a_b), WS_PTR(bf16_t, WO.g_b), WS_PTR(float, WO.w_f)};
      XCD_TILE_LOOP(tile, TM * 22) prep_gemm_tile(pw, pb, tile / 22, tile % 22, smem);
    }
    DIL_END(3) }
    GRID_BARRIER();
    { DIL_BEGIN(4)
    PH(4) {
      KP_DECL; char* ws = kp_->ws; const int t = tid_opaque(); (void)t;
      FinW2 fw{I.mla_qk_g + l * 192, I.gqa_qk_g + l * 128, I.rw_mu + (long)l * 2 * RWC, I.rw_k_k + l * 384, I.rw_k_a + l * 384, WS_PTR(float, WO.rope_g), WS_PTR(float, WO.rope_m)};
      FinBuf fb{WS_PTR(bf16_t, WO.Pb), WS_PTR(bf16_t, WO.tq), WS_PTR(bf16_t, WO.tkv), WS_PTR(bf16_t, WO.a_b), WS_PTR(bf16_t, WO.mq), WS_PTR(bf16_t, WO.mk), WS_PTR(bf16_t, WO.mvT),
                WS_PTR(bf16_t, WO.gq), WS_PTR(bf16_t, WO.gk), WS_PTR(bf16_t, WO.gvT), WS_PTR(bf16_t, WO.r_b), WS_PTR(bf16_t, WO.v_b), WS_PTR(bf16_t, WO.kk_b), WS_PTR(bf16_t, WO.kd_b), WS_PTR(bf16_t, WO.bd_b)};
      for (int tile = blockIdx.x; tile < NROWS / 8; tile += gridDim.x) prep_finish_tile2(fw, fb, tile, smem);
      if (blockIdx.x == gridDim.x - 1 && t < 64) { attn_score_bound(I.mla_qk_g + l * 192, 96, 9.79795897f, (float*)(ws + 16384) + l * 4, t); attn_score_bound(I.gqa_qk_g + l * 128, 64, 8.f, (float*)(ws + 16384) + l * 4 + 1, t); }
    }
    DIL_END(4) }
    GRID_BARRIER();
    { unsigned long long dil_t0 = 0, dil_scan = 0; if (DIL_PH == 5 || DIL_PH == 11) dil_t0 = __builtin_amdgcn_s_memrealtime();
    PH(5) {
      {
        KP_DECL; char* ws = kp_->ws; const int tp = tid_opaque();
        const int njobs = BATCH * 12 * (RB / CS_L);
        for (int job = (int)blockIdx.x * 4 + (tp >> 6); job < njobs; job += (int)gridDim.x * 4)
          rw_chunk_inverse(WS_PTR(bf16_t, WO.kk_b), WS_PTR(bf16_t, WO.bd_b), WS_PTR(float, WO.w_f), WS_PTR(bf16_t, MINV_OFF), job, (long)MA * 384, smem + (tp >> 6) * CSP_WAVE_BYTES, tp & 63);
      }
      GRID_BARRIER();
      KP_DECL; char* ws = kp_->ws; const int t = tid_opaque(); (void)t;
      int* s_item = (int*)(smem + MEGA_LDS_BYTES - 16);
      unsigned* sctr = (unsigned*)ws + XB_QUEUE(4 + l);
      auto scan_loop = [&]() __attribute__((always_inline)) {
        for (;;) {
          __syncthreads();
          if (tid_opaque() == 0) *s_item = (int)xb_add(sctr, 1u);
          __syncthreads();
          const int it = *s_item;
          if (it >= BATCH * 12) break;
          rw_scan_chunked(WS_PTR(bf16_t, WO.r_b), WS_PTR(bf16_t, WO.v_b), WS_PTR(bf16_t, WO.kk_b), WS_PTR(bf16_t, WO.kd_b), WS_PTR(bf16_t, WO.bd_b), WS_PTR(float, WO.w_f), WS_PTR(float, WO.Pb),
                          it, (long)MA * 384, smem, WS_PTR(bf16_t, MINV_OFF));
        }
      };
      if (scan_role) scan_loop();
#if DIL_PH == 11
      dil_scan = __builtin_amdgcn_s_memrealtime() - dil_t0;
#endif
#ifdef SPLIT5
      GRID_BARRIER();
#endif
      const int nqt = l == 0 ? 18 : 16; const int n_mla = BATCH * 4 * nqt, n_all = BATCH * 10 * nqt;
      unsigned* qctr = (unsigned*)ws + XB_QUEUE(l);
      for (;;) {
        __syncthreads();
        if (tid_opaque() == 0) *s_item = (int)xb_add(qctr, 1u);
        __syncthreads();
        const int it = *s_item;
        if (it >= n_all) break;
        const KARG_AS MegaP* kp2_ = (const KARG_AS MegaP*)__builtin_amdgcn_kernarg_segment_ptr(); LAUNDER_S(kp2_); char* ws2 = kp2_->ws;
        if (it < n_mla) { int qt = it / (BATCH * 4), r = it % (BATCH * 4);
          attn_block<96>((const bf16_t*)(ws2 + WO.mq), 4, (const bf16_t*)(ws2 + WO.mk), 4, (const bf16_t*)(ws2 + WO.mvT), 1, (bf16_t*)(ws2 + WO.tq), 0, r / 4, r % 4, qt, smem, (const float*)(ws2 + 16384) + l * 4); }
        else { int v = it - n_mla; int qt = v / (BATCH * 6), r = v % (BATCH * 6);
          attn_block<64>((const bf16_t*)(ws2 + WO.gq), 6, (const bf16_t*)(ws2 + WO.gk), 2, (const bf16_t*)(ws2 + WO.gvT), 3, (bf16_t*)(ws2 + WO.tq), 640, r / 6, r % 6, qt, smem, (const float*)(ws2 + 16384) + l * 4 + 1); }
      }
      if (!scan_role) scan_loop();
      {
        unsigned* cctr = (unsigned*)ws + XB_QUEUE(2 + l);
        for (;;) {
          __syncthreads();
          if (tid_opaque() == 0) *s_item = (int)xb_add(cctr, 1u);
          __syncthreads();
          const int it = *s_item;
          if (it >= 512) break;
          const int tab = it >> 8, r0 = (it & 255) * 64;
          if (tab == 0) ph_cvt_fp8_rows(I.pe_u + (long)l * 16384 * DM, WS_PTR(unsigned char, TAB_U), WS_PTR(float, TAB_SU), r0, r0 + 64);
          else ph_cvt_fp8_rows(I.pe_v + (long)l * 16384 * DM, WS_PTR(unsigned char, TAB_V), WS_PTR(float, TAB_SV), r0, r0 + 64);
        }
      }
    }
#if DIL_PH == 11
    GRID_BARRIER(); if (blockIdx.x == 0 && threadIdx.x == 0) { unsigned long long t1 = __builtin_amdgcn_s_memrealtime(); unsigned long long dt = dil_scan * DIL_MULT; while (__builtin_amdgcn_s_memrealtime() - t1 < dt) __builtin_amdgcn_s_sleep(32); }
#endif
    (void)dil_scan;
    DIL_END(5) }
    GRID_BARRIER();
    { DIL_BEGIN(6)
    PH(6) {
      KP_DECL; char* ws = kp_->ws; const int t = tid_opaque(); (void)t;
      RdW rw{I.rw_r_k + l * 384, I.rw_ln_g + l * 384, I.rw_ln_b + l * 384};
      for (long row = blockIdx.x * 4 + (t >> 6); row < NROWS; row += (long)gridDim.x * 4)
        if (l == 0 || (row % RB) < SEQ) rw_readout_row2(rw, WS_PTR(float, WO.Pb), WS_PTR(bf16_t, WO.r_b), WS_PTR(bf16_t, WO.v_b), WS_PTR(bf16_t, WO.kd_b), WS_PTR(bf16_t, WO.g_b), WS_PTR(bf16_t, WO.tq), row, t & 63);
    }
    DIL_END(6) }
    GRID_BARRIER();
    { DIL_BEGIN(7)
    PH(7) {
      KP_DECL; char* ws = kp_->ws; const int t = tid_opaque(); (void)t;
      const bf16_t* mix = WS_PTR(bf16_t, WO.tq); const bf16_t* wT = WS_PTR(bf16_t, WO.w_outT) + (long)l * 1024 * 1024; float* xs = WS_PTR(float, WO.xs);
      const float* modl = WS_PTR(float, WO.mod) + (long)l * (BATCH + 1) * 6144;
      const int TM7 = l == 0 ? TM : BATCH * 16;
      XCD_TILE_LOOP(tile, TM7 * 8)
        gemm_tile_128_glds(mix, DM, wT, 1024, 1024, l == 0 ? tile / 8 : LAT_TM(tile / 8), tile % 8, smem, EpiResid{xs, modl, 2, 0, l == 0 ? I.x : (const float*)nullptr, I.ctx});
    }
    DIL_END(7) }
    GRID_BARRIER();
    { DIL_BEGIN(8)
    PH(8) {
      KP_DECL; char* ws = kp_->ws; const int t = tid_opaque(); (void)t;
      ph_norm_mod(WS_PTR(float, WO.xs), I.norm_ffn_g + l * DM, WS_PTR(float, WO.mod) + (long)l * (BATCH + 1) * 6144, 3, WS_PTR(bf16_t, WO.xn), l != 0);
    }
    DIL_END(8) }
    GRID_BARRIER();
    { DIL_BEGIN(9)
    PH(9) {
      KP_DECL; char* ws = kp_->ws; const int t = tid_opaque(); (void)t;
      const bf16_t* xn = WS_PTR(bf16_t, WO.xn); const bf16_t* wT = WS_PTR(bf16_t, WO.wqT) + (long)l * 2048 * 1024; const bf16_t* kb = WS_PTR(bf16_t, WO.keysb) + (long)l * 16 * 128 * 128;
      unsigned* top1 = WS_PTR(unsigned, WO.tq);
      const int TM9 = l == 0 ? TM : BATCH * 16;
      XCD_TILE_LOOP(tile, TM9 * 16) { peer_q_top1_tile(xn, wT, kb, top1, l == 0 ? tile / 16 : LAT_TM(tile / 16), tile % 16, smem); __syncthreads(); }
    }
    DIL_END(9) }
    GRID_BARRIER();
    { DIL_BEGIN(10)
    PH(10) {
      KP_DECL; char* ws = kp_->ws; const int t = tid_opaque(); (void)t;
      const float* modl = WS_PTR(float, WO.mod) + (long)l * (BATCH + 1) * 6144;
      const int ntok10 = l == 0 ? NROWS : BATCH * SEQ;
      peer_lists_build3(WS_PTR(unsigned, WO.tq), WS_PTR(float, TAB_SU), WS_PTR(float, TAB_SV), WS_PTR(char, WO.mq), ntok10, smem);
#ifdef BUILD_TWICE
      peer_lists_build3(WS_PTR(unsigned, WO.tq), WS_PTR(float, TAB_SU), WS_PTR(float, TAB_SV), WS_PTR(char, WO.mq), ntok10, smem);
#endif
      peer_gather_sweep3(WS_PTR(bf16_t, WO.xn), WS_PTR(char, WO.mq), WS_PTR(unsigned char, TAB_U), WS_PTR(unsigned char, TAB_V), modl, WS_PTR(float, WO.xs), ntok10, smem,
                         I.norm_mix_g + (l == 0 ? DM : 0), WS_PTR(float, WO.mod) + (long)(l == 0 ? 1 : 0) * (BATCH + 1) * 6144, WS_PTR(bf16_t, WO.xn), l == 0 ? (float*)nullptr : kp_->out);
    }
    DIL_END(10) }
    GRID_BARRIER();
  }
}

extern "C" void kernel_launch(void* const* d_in, const int* in_sizes, int n_in, void* d_out, int out_size, void* d_ws, size_t ws_size,
                              hipStream_t stream) {
  MegaP p{};
  const float** pp = (const float**)&p.in;
  for (int i = 0; i < 31; ++i) pp[i] = (const float*)d_in[i];
  p.ws = (char*)d_ws; p.out = (float*)d_out;
  if (WO.total > ws_size) return;
  static int grid_blocks = 0;
  if (!grid_blocks) {
    int dev = 0, cus = 0, per_cu = 0;
    hipGetDevice(&dev);
    hipDeviceGetAttribute(&cus, hipDeviceAttributeMultiprocessorCount, dev);
    hipOccupancyMaxActiveBlocksPerMultiprocessor(&per_cu, mega_kernel, 256, 0);
    if (per_cu > 2) per_cu = 2;
    if (per_cu < 1) per_cu = 1;
    grid_blocks = cus * per_cu;
  }
  hipMemsetAsync(d_ws, 0, 32768, stream);
  void* args[] = {&p};
  hipLaunchCooperativeKernel((void*)mega_kernel, dim3(grid_blocks), dim3(256), args, 0, stream);
}
```

```cpp
#include <hip/hip_runtime.h>
#define PEER_EXP(x) __builtin_amdgcn_exp2f((x) * 1.4426950408889634f)
#ifndef BATCH
#define BATCH 8
#endif
#ifndef SEQ
#define SEQ 2048
#endif
#ifndef CTX_LEN
#define CTX_LEN 256
#endif
#define DM 1024
#define RB (SEQ + CTX_LEN)
#define NROWS (BATCH * RB)
#define IN_COLS 2624
#define MLA_OFF 0
#define RW_OFF 416
#define GQA_OFF 1984
#define RWC 1568
#define EPSN 1e-6f

__device__ inline float sigmoidf_(float x) { return 1.f / (1.f + expf(-x)); }
__device__ inline float siluf_(float x) { return x * sigmoidf_(x); }
__device__ inline float softplusf_(float x) { return fmaxf(x, 0.f) + log1pf(expf(-fabsf(x))); }
__device__ inline float geluf_(float x) { return 0.5f * x * (1.f + tanhf(0.7978845608028654f * (x + 0.044715f * x * x * x))); }

__global__ void nk_copy_in(const float* x, const float* ctx, float* xs) {
  long i = (long)blockIdx.x * blockDim.x + threadIdx.x;
  if (i >= (long)NROWS * DM) return;
  int d = i % DM; long row = i / DM; int b = row / RB, lr = row % RB;
  xs[i] = lr < SEQ ? x[((long)b * SEQ + lr) * DM + d] : ctx[((long)b * CTX_LEN + (lr - SEQ)) * DM + d];
}
__global__ void nk_copy_out(const float* xs, float* out) {
  long i = (long)blockIdx.x * blockDim.x + threadIdx.x;
  if (i >= (long)BATCH * SEQ * DM) return;
  int d = i % DM; long row = i / DM; int b = row / SEQ, t = row % SEQ;
  out[i] = xs[((long)b * RB + t) * DM + d];
}
__global__ void nk_mod(const float* c, const float* c_ctx, const float* ada_w, const float* ada_b, float* mod) {
  long i = (long)blockIdx.x * blockDim.x + threadIdx.x;
  if (i >= 2L * (BATCH + 1) * 6144) return;
  int j = i % 6144; int bb = (i / 6144) % (BATCH + 1); int l = i / (6144 * (BATCH + 1));
  const float* cv = bb < BATCH ? c + (long)bb * DM : c_ctx;
  const float* w = ada_w + (long)l * DM * 6144;
  float acc = 0.f;
  for (int k = 0; k < DM; ++k) acc += siluf_(cv[k]) * w[(long)k * 6144 + j];
  mod[i] = acc + ada_b[l * 6144 + j];
}
__global__ void nk_norm_mod(const float* xs, const float* g, const float* modl, int shift_idx, float* xn, int M, int bidx) {
  long row = (long)blockIdx.x * blockDim.x + threadIdx.x;
  if (row >= M) return;
  int lr = row % RB; int bb = lr < SEQ ? bidx : BATCH;
  const float* sh = modl + ((long)bb * 6 + shift_idx) * DM; const float* sc = sh + DM;
  const float* xr = xs + row * DM; float ss = 0.f;
  for (int d = 0; d < DM; ++d) ss += xr[d] * xr[d];
  float inv = 1.f / sqrtf(ss / DM + EPSN);
  for (int d = 0; d < DM; ++d) xn[row * DM + d] = xr[d] * inv * g[d] * (1.f + sc[d]) + sh[d];
}
__global__ void nk_gemm(const float* A, const float* W, float* C, int M, int N, int K) {
  long i = (long)blockIdx.x * blockDim.x + threadIdx.x;
  if (i >= (long)M * N) return;
  int n = i % N; long m = i / N; float acc = 0.f;
  for (int k = 0; k < K; ++k) acc += A[m * K + k] * W[(long)k * N + n];
  C[i] = acc;
}
__global__ void nk_mla_q1(const float* P, const float* qng, const float* wqb, float* tq, int M) {
  long i = (long)blockIdx.x * blockDim.x + threadIdx.x;
  if (i >= (long)M * 384) return;
  int j = i % 384; long r = i / 384; const float* cq = P + r * IN_COLS;
  float ss = 0.f; for (int k = 0; k < 256; ++k) ss += cq[k] * cq[k];
  float inv = 1.f / sqrtf(ss / 256 + EPSN), acc = 0.f;
  for (int k = 0; k < 256; ++k) acc += cq[k] * inv * qng[k] * wqb[k * 384 + j];
  tq[i] = acc;
}
__global__ void nk_mla_kv1(const float* P, const float* kvng, const float* wkvb, float* tkv, int M) {
  long i = (long)blockIdx.x * blockDim.x + threadIdx.x;
  if (i >= (long)M * 512) return;
  int j = i % 512; long r = i / 512; const float* ck = P + r * IN_COLS + 256;
  float ss = 0.f; for (int k = 0; k < 128; ++k) ss += ck[k] * ck[k];
  float inv = 1.f / sqrtf(ss / 128 + EPSN), acc = 0.f;
  for (int k = 0; k < 128; ++k) acc += ck[k] * inv * kvng[k] * wkvb[k * 512 + j];
  tkv[i] = acc;
}
__global__ void nk_mla_qk2(const float* P, const float* tq, const float* tkv, const float* qkg, float* mq, float* mk, int M) {
  long i = (long)blockIdx.x * blockDim.x + threadIdx.x;
  if (i >= (long)M * 8) return;
  int which = i % 2, h = (i / 2) % 4; long r = i / 8; int lr = r % RB;
  float ss = 0.f;
  for (int e = 0; e < 96; ++e) {
    float v = which == 0 ? tq[r * 384 + h * 96 + e] : (e < 64 ? tkv[r * 512 + h * 128 + e] : P[r * IN_COLS + 384 + (e - 64)]);
    ss += v * v;
  }
  float inv = 1.f / sqrtf(ss / 96 + EPSN);
  const float* g = qkg + which * 96; float* o = (which == 0 ? mq : mk) + r * 384 + h * 96;
  for (int e = 0; e < 64; ++e) {
    float v = which == 0 ? tq[r * 384 + h * 96 + e] : tkv[r * 512 + h * 128 + e];
    o[e] = v * inv * g[e];
  }
  for (int j = 0; j < 16; ++j) {
    float va = which == 0 ? tq[r * 384 + h * 96 + 64 + j] : P[r * IN_COLS + 384 + j];
    float vb = which == 0 ? tq[r * 384 + h * 96 + 80 + j] : P[r * IN_COLS + 384 + 16 + j];
    va *= inv * g[64 + j]; vb *= inv * g[80 + j];
    if (lr < SEQ) {
      int pos = j < 8 ? lr / 64 : lr % 64; float fr = powf(10000.f, -(float)(j & 7) / 8.f);
      float ang = (float)pos * fr, cs = cosf(ang), sn = sinf(ang);
      o[64 + j] = va * cs - vb * sn; o[80 + j] = va * sn + vb * cs;
    } else { o[64 + j] = va; o[80 + j] = vb; }
  }
}
__global__ void nk_gqa_prep(const float* P, const float* qkg, float* gq, float* gk, int M) {
  long i = (long)blockIdx.x * blockDim.x + threadIdx.x;
  if (i >= (long)M * 8) return;
  int h = i % 8; long r = i / 8; int lr = r % RB;
  const float* src = P + r * IN_COLS + GQA_OFF + h * 64;
  const float* g = qkg + (h < 6 ? 0 : 64);
  float* o = h < 6 ? gq + r * 384 + h * 64 : gk + r * 128 + (h - 6) * 64;
  float ss = 0.f; for (int e = 0; e < 64; ++e) ss += src[e] * src[e];
  float inv = 1.f / sqrtf(ss / 64 + EPSN);
  for (int j = 0; j < 32; ++j) {
    float va = src[j] * inv * g[j], vb = src[32 + j] * inv * g[32 + j];
    if (lr < SEQ) {
      int pos = j < 16 ? lr / 64 : lr % 64; float fr = powf(10000.f, -(float)(j & 15) / 16.f);
      float ang = (float)pos * fr, cs = cosf(ang), sn = sinf(ang);
      o[j] = va * cs - vb * sn; o[32 + j] = va * sn + vb * cs;
    } else { o[j] = va; o[32 + j] = vb; }
  }
}
template <int DQ>
__global__ void __launch_bounds__(256) nk_attn(const float* q, int qs, const float* k, int ks, const float* v, int vs, int vhs, int H, int G, float* mix, int ooff, int M) {
  long i = (long)blockIdx.x * blockDim.x + threadIdx.x;
  if (i >= (long)M * H) return;
  int h = i % H; long r = i / H; int b = r / RB, lr = r % RB; int kh = h / G;
  float qv[DQ];
#pragma unroll
  for (int e = 0; e < DQ; ++e) qv[e] = q[r * qs + h * DQ + e];
  float acc[64];
#pragma unroll
  for (int e = 0; e < 64; ++e) acc[e] = 0.f;
  float mx = -1e30f, l = 0.f; const float scale = 1.f / sqrtf((float)DQ);
  int k0 = lr < SEQ ? 0 : SEQ, k1 = RB;
  for (int kr = k0; kr < k1; ++kr) {
    long rr = (long)b * RB + kr; const float* kp = k + rr * ks + kh * DQ; float s = 0.f;
#pragma unroll
    for (int e = 0; e < DQ; ++e) s += qv[e] * kp[e];
    s *= scale;
    float mn = fmaxf(mx, s), al = expf(mx - mn), pp = expf(s - mn);
    l = l * al + pp; mx = mn; const float* vp = v + rr * vs + kh * vhs;
#pragma unroll
    for (int e = 0; e < 64; ++e) acc[e] = acc[e] * al + pp * vp[e];
  }
#pragma unroll
  for (int e = 0; e < 64; ++e) mix[r * DM + ooff + h * 64 + e] = acc[e] / l;
}
__global__ void nk_rw_shift(const float* P, const float* mu, float* rwx, int M) {
  long i = (long)blockIdx.x * blockDim.x + threadIdx.x;
  if (i >= (long)M * RWC) return;
  int c = i % RWC; long r = i / RWC; int lr = r % RB;
  bool first = (lr == 0) || (lr == SEQ), last = (lr == SEQ - 1) || (lr == RB - 1);
  float p = P[r * IN_COLS + RW_OFF + c];
  float pv = first ? 0.f : P[(r - 1) * IN_COLS + RW_OFF + c], nx = last ? 0.f : P[(r + 1) * IN_COLS + RW_OFF + c];
  rwx[i] = p + mu[c] * (pv - p) + mu[RWC + c] * (nx - p);
}
__global__ void nk_rw_prep(const float* rwx, const float* w0, const float* w2, const float* a0, const float* a2, const float* g2,
                           const float* k_k, const float* k_a, float* dec, float* kd, float* bd, float* kk, float* gg, int M) {
  long i = (long)blockIdx.x * blockDim.x + threadIdx.x;
  if (i >= (long)M * 384) return;
  int c = i % 384; long r = i / 384; int h = c / 64; const float* xr = rwx + r * RWC;
  float kv = xr[384 + c];
  float ss = 0.f; for (int n = 0; n < 64; ++n) { float t = xr[384 + h * 64 + n] * k_k[h * 64 + n]; ss += t * t; }
  float kkv = kv * k_k[c] / sqrtf(ss + 1e-12f);
  kk[i] = kkv;
  for (int d = 0; d < 2; ++d) {
    float wr = w0[d * 384 + c], ar = a0[d * 384 + c];
    for (int j = 0; j < 64; ++j) { wr += tanhf(xr[1152 + d * 64 + j]) * w2[(d * 64 + j) * 384 + c]; ar += xr[1280 + d * 64 + j] * a2[(d * 64 + j) * 384 + c]; }
    float dc = expf(-expf(-softplusf_(-wr) - 0.5f)); float a = sigmoidf_(ar);
    dec[(long)d * M * 384 + i] = dc; kd[(long)d * M * 384 + i] = kv * (1.f + (a - 1.f) * k_a[c]); bd[(long)d * M * 384 + i] = kkv * a;
  }
  float g = 0.f; for (int j = 0; j < 160; ++j) g += sigmoidf_(xr[1408 + j]) * g2[j * 384 + c];
  gg[i] = g;
}
__global__ void __launch_bounds__(256) nk_rw_scan(const float* rwx, const float* dec, const float* kd, const float* bd, const float* kk, float* y, int M, int nb) {
  long t = (long)blockIdx.x * blockDim.x + threadIdx.x;
  if (t >= (long)nb * 2 * 6 * 64) return;
  int i = t % 64, h = (t / 64) % 6, d = (t / 384) % 2, b = t / 768;
  float S[64];
#pragma unroll
  for (int j = 0; j < 64; ++j) S[j] = 0.f;
  for (int step = 0; step < RB; ++step) {
    int lr;
    if (step < CTX_LEN) lr = SEQ + (d == 0 ? step : CTX_LEN - 1 - step);
    else lr = d == 0 ? step - CTX_LEN : SEQ - 1 - (step - CTX_LEN);
    long r = (long)b * RB + lr; long o = (long)d * M * 384 + r * 384 + h * 64;
    const float* rp = rwx + r * RWC + h * 64; const float* wp = dec + o; const float* kp = kd + o; const float* bp = bd + o; const float* kkp = kk + r * 384 + h * 64;
    float vi = rwx[r * RWC + 768 + h * 64 + i];
    float skk = 0.f;
#pragma unroll
    for (int j = 0; j < 64; ++j) skk += S[j] * kkp[j];
    float yy = 0.f;
#pragma unroll
    for (int j = 0; j < 64; ++j) { S[j] = S[j] * wp[j] - skk * bp[j] + vi * kp[j]; yy += S[j] * rp[j]; }
    y[o + i] = yy;
  }
}
__global__ void nk_rw_readout(const float* rwx, const float* y, const float* kd, const float* gg, const float* r_k, const float* ln_g, const float* ln_b, float* mix, int M, long yds) {
  long i = (long)blockIdx.x * blockDim.x + threadIdx.x;
  if (i >= (long)M * 6) return;
  int h = i % 6; long r = i / 6; long o = r * 384 + h * 64; long ds = (long)M * 384;
  float mean = 0.f; for (int n = 0; n < 64; ++n) mean += y[o + n] + y[yds + o + n];
  mean /= 64.f;
  float var = 0.f, coef = 0.f;
  for (int n = 0; n < 64; ++n) {
    float yy = y[o + n] + y[yds + o + n] - mean; var += yy * yy;
    coef += rwx[r * RWC + h * 64 + n] * (kd[o + n] + kd[ds + o + n]) * r_k[h * 64 + n];
  }
  var /= 64.f; float inv = 1.f / sqrtf(var + 64e-5f);
  for (int n = 0; n < 64; ++n) {
    float yn = (y[o + n] + y[yds + o + n] - mean) * inv * ln_g[h * 64 + n] + ln_b[h * 64 + n];
    mix[r * DM + 256 + h * 64 + n] = (yn + coef * rwx[r * RWC + 768 + h * 64 + n]) * gg[o + n];
  }
}
__global__ void nk_gemm_res(const float* A, const float* W, const float* modl, int gi, float* xs, int M, int bidx) {
  long i = (long)blockIdx.x * blockDim.x + threadIdx.x;
  if (i >= (long)M * DM) return;
  int j = i % DM; long r = i / DM; int lr = r % RB; int bb = lr < SEQ ? bidx : BATCH;
  float acc = 0.f; for (int k = 0; k < DM; ++k) acc += A[r * DM + k] * W[(long)k * DM + j];
  xs[i] += modl[((long)bb * 6 + gi) * DM + j] * acc;
}
__global__ void nk_peer_score(const float* pq, const float* keys, float* sc, int M) {
  long i = (long)blockIdx.x * blockDim.x + threadIdx.x;
  if (i >= (long)M * 2048) return;
  int k = i % 128, ps = (i / 128) % 16; long r = i / 2048;
  const float* q = pq + r * 2048 + ps * 128; const float* ky = keys + ((long)ps * 128 + k) * 128;
  float acc = 0.f; for (int d = 0; d < 128; ++d) acc += q[d] * ky[d];
  sc[i] = acc;
}
__global__ void nk_peer_top1(const float* sc, float* ts, int* ti, int M) {
  long i = (long)blockIdx.x * blockDim.x + threadIdx.x;
  if (i >= (long)M * 16) return;
  const float* s = sc + i * 128; float pv = 3e38f; int pi = -1;
  for (int t = 0; t < 16; ++t) {
    float bv = -3e38f; int bi = -1;
    for (int k = 0; k < 128; ++k) {
      float v = s[k]; bool ok = (v < pv) || (v == pv && k > pi);
      if (ok && (bi < 0 || v > bv)) { bv = v; bi = k; }
    }
    ts[i * 16 + t] = bv; ti[i * 16 + t] = bi; pv = bv; pi = bi;
  }
}
__global__ void nk_peer_top2(const float* ts, const int* ti, int* pe, float* pg, int M) {
  long i = (long)blockIdx.x * blockDim.x + threadIdx.x;
  if (i >= (long)M * 8) return;
  const float* s1 = ts + i * 32; const float* s2 = s1 + 16; const int* i1 = ti + i * 32; const int* i2 = i1 + 16;
  float pv = 3e38f; int pi = -1; float mx = 0.f, sum = 0.f;
  for (int t = 0; t < 16; ++t) {
    float bv = -3e38f; int bi = -1;
    for (int c = 0; c < 256; ++c) {
      float v = s1[c / 16] + s2[c % 16]; bool ok = (v < pv) || (v == pv && c > pi);
      if (ok && (bi < 0 || v > bv)) { bv = v; bi = c; }
    }
    if (t == 0) mx = bv;
    float e = expf(bv - mx); sum += e;
    pe[i * 16 + t] = i1[bi / 16] * 128 + i2[bi % 16]; pg[i * 16 + t] = e; pv = bv; pi = bi;
  }
  for (int t = 0; t < 16; ++t) pg[i * 16 + t] /= sum;
}
__global__ void nk_peer_act(const float* xn, const float* u, const int* pe, const float* pg, float* pw, int M) {
  long i = (long)blockIdx.x * blockDim.x + threadIdx.x;
  if (i >= (long)M * 128) return;
  long r = i / 128; const float* ur = u + (long)pe[i] * DM; const float* xr = xn + r * DM;
  float acc = 0.f; for (int d = 0; d < DM; ++d) acc += xr[d] * ur[d];
  pw[i] = pg[i] * geluf_(acc);
}
__global__ void nk_peer_out(const float* v, const int* pe, const float* pw, const float* modl, float* xs, int M, int bidx) {
  long i = (long)blockIdx.x * blockDim.x + threadIdx.x;
  if (i >= (long)M * DM) return;
  int j = i % DM; long r = i / DM; int lr = r % RB; int bb = lr < SEQ ? bidx : BATCH;
  float acc = 0.f; for (int k = 0; k < 128; ++k) acc += pw[r * 128 + k] * v[(long)pe[r * 128 + k] * DM + j];
  xs[i] += modl[((long)bb * 6 + 5) * DM + j] * acc;
}


#ifndef PEER_EXP
#define PEER_EXP(x) expf(x)
#endif
__device__ __forceinline__ unsigned f2sortable(float s) { unsigned f = __float_as_uint(s); return (f & 0x80000000u) ? ~f : (f | 0x80000000u); }
__device__ __forceinline__ float sortable2f(unsigned o) { unsigned f = (o & 0x80000000u) ? (o & 0x7fffffffu) : ~o; return __uint_as_float(f); }
__device__ __forceinline__ unsigned enc_key(float s, int idx) { return (f2sortable(s) & ~127u) | (unsigned)(127 - idx); }
__device__ __forceinline__ void dec_key(unsigned k, float& s, int& idx) { idx = 127 - (int)(k & 127u); s = sortable2f(k & ~127u); }
__device__ __forceinline__ unsigned umax_(unsigned a, unsigned b) { return a > b ? a : b; }
__device__ __forceinline__ unsigned umin_(unsigned a, unsigned b) { return a < b ? a : b; }
__device__ __forceinline__ void ins16(unsigned (&l)[16], unsigned x) {
#pragma unroll
  for (int i = 0; i < 16; ++i) { unsigned mx = umax_(l[i], x); x = umin_(l[i], x); l[i] = mx; }
}
__device__ __forceinline__ void merge16(unsigned (&a)[16], const unsigned (&brev)[16]) {
#pragma unroll
  for (int i = 0; i < 16; ++i) a[i] = umax_(a[i], brev[i]);
#pragma unroll
  for (int d = 8; d >= 1; d >>= 1)
#pragma unroll
    for (int i = 0; i < 16; ++i) if ((i & d) == 0) { unsigned hi = umax_(a[i], a[i + d]), lo = umin_(a[i], a[i + d]); a[i] = hi; a[i + d] = lo; }
}
__device__ __forceinline__ void peer_combine(const unsigned* L0, const unsigned* L1, int* e_out, float* g_out) {
  float s0[16], s1[16];
#pragma unroll
  for (int i = 0; i < 16; ++i) { int ix; dec_key(L0[i], s0[i], ix); dec_key(L1[i], s1[i], ix); }
  unsigned sel[16];
#pragma unroll
  for (int i = 0; i < 16; ++i) sel[i] = 0u;
#pragma unroll
  for (int i = 0; i < 16; ++i)
#pragma unroll
    for (int j = 0; j < 16; ++j)
      if ((i + 1) * (j + 1) <= 16) { unsigned k = (f2sortable(s0[i] + s1[j]) & ~255u) | (unsigned)(255 - (i * 16 + j)); ins16(sel, k); }
  float mx = -3e38f;
#pragma unroll
  for (int t = 0; t < 16; ++t) {
    int c = 255 - (int)(sel[t] & 255u); int i = c >> 4, j = c & 15;
    float a, b; int ia, ib; dec_key(L0[i], a, ia); dec_key(L1[j], b, ib);
    float s = a + b; e_out[t] = ia * 128 + ib; g_out[t] = s; mx = fmaxf(mx, s);
  }
  float sum = 0.f;
#pragma unroll
  for (int t = 0; t < 16; ++t) { float e = PEER_EXP(g_out[t] - mx); g_out[t] = e; sum += e; }
  float inv = 1.f / sum;
#pragma unroll
  for (int t = 0; t < 16; ++t) g_out[t] *= inv;
}
__global__ void hk_peer_top1(const float* pq, const float* keys, unsigned* top1, int M) {
  long i = (long)blockIdx.x * blockDim.x + threadIdx.x;
  if (i >= (long)M * 16) return;
  int ps = i % 16; long r = i / 16; const float* q = pq + r * 2048 + ps * 128;
  unsigned la[16], lb[16], lbr[16];
#pragma unroll
  for (int t = 0; t < 16; ++t) { la[t] = 0u; lb[t] = 0u; }
  for (int k = 0; k < 128; ++k) {
    const float* ky = keys + ((long)ps * 128 + k) * 128; float acc = 0.f;
    for (int d = 0; d < 128; ++d) acc += q[d] * ky[d];
    unsigned key = enc_key(acc, k);
    if (k < 64) ins16(la, key); else ins16(lb, key);
  }
#pragma unroll
  for (int t = 0; t < 16; ++t) lbr[t] = lb[15 - t];
  merge16(la, lbr);
#pragma unroll
  for (int t = 0; t < 16; ++t) top1[i * 16 + t] = la[t];
}
__global__ void hk_peer_combine(const unsigned* top1, int* pe, float* pg, int M) {
  long i = (long)blockIdx.x * blockDim.x + threadIdx.x;
  if (i >= (long)M * 8) return;
  peer_combine(top1 + i * 32, top1 + i * 32 + 16, pe + i * 16, pg + i * 16);
}
typedef unsigned short bf16_t;
__device__ __forceinline__ int tid_opaque() { int t = threadIdx.x; asm volatile("" : "+v"(t)); return t; }
typedef __attribute__((ext_vector_type(8))) short bf16x8;
typedef __attribute__((ext_vector_type(4))) float f32x4;
typedef __attribute__((ext_vector_type(16))) float f32x16;
typedef __attribute__((ext_vector_type(4))) unsigned u32x4;

typedef __attribute__((ext_vector_type(2))) __bf16 bf16v2;
typedef __attribute__((ext_vector_type(2))) float f32v2;
template <int CTRL> __device__ __forceinline__ float dpp_get(float x) { return __builtin_bit_cast(float, __builtin_amdgcn_update_dpp(0, __builtin_bit_cast(int, x), CTRL, 0xf, 0xf, true)); }
__device__ __forceinline__ float swz_xor4(float x) { return __builtin_bit_cast(float, __builtin_amdgcn_ds_swizzle(__builtin_bit_cast(int, x), 0x101F)); }
__device__ __forceinline__ float xor4_get(float x) { const int xi = __builtin_bit_cast(int, x);
  int r = __builtin_amdgcn_update_dpp(xi, xi, 0x114, 0xf, 0xA, false); r = __builtin_amdgcn_update_dpp(r, xi, 0x104, 0xf, 0x5, false); return __builtin_bit_cast(float, r); }
__device__ __forceinline__ float xor16_sum(float x) { const unsigned xi = __builtin_bit_cast(unsigned, x); auto q = __builtin_amdgcn_permlane16_swap(xi, xi, false, false);
  return __builtin_bit_cast(float, (unsigned)q[0]) + __builtin_bit_cast(float, (unsigned)q[1]); }
__device__ __forceinline__ float xor32_sum(float x) { const unsigned xi = __builtin_bit_cast(unsigned, x); auto q = __builtin_amdgcn_permlane32_swap(xi, xi, false, false);
  return __builtin_bit_cast(float, (unsigned)q[0]) + __builtin_bit_cast(float, (unsigned)q[1]); }
__device__ __forceinline__ float xor32_max(float x) { const unsigned xi = __builtin_bit_cast(unsigned, x); auto q = __builtin_amdgcn_permlane32_swap(xi, xi, false, false);
  return fmaxf(__builtin_bit_cast(float, (unsigned)q[0]), __builtin_bit_cast(float, (unsigned)q[1])); }
__device__ __forceinline__ unsigned pack2bf(float a, float b) { f32v2 v = {a, b}; bf16v2 r = __builtin_convertvector(v, bf16v2); return __builtin_bit_cast(unsigned, r); }
__device__ __forceinline__ bf16_t f2bf(float f) { return (bf16_t)(pack2bf(f, 0.f) & 0xffffu); }
__device__ __forceinline__ float bf2f(bf16_t h) { return __uint_as_float(((unsigned)h) << 16); }

__device__ __forceinline__ float fexp_(float x) { return __builtin_amdgcn_exp2f(x * 1.4426950408889634f); }
__device__ __forceinline__ float frcp_(float x) { return __builtin_amdgcn_rcpf(x); }
__device__ __forceinline__ float fsigmoid_(float x) { return frcp_(1.f + fexp_(-x)); }
__device__ __forceinline__ float ftanh_(float x) { return 1.f - 2.f * frcp_(fexp_(2.f * x) + 1.f); }
__device__ __forceinline__ float fgelu_(float x) { return x * fsigmoid_(1.5957691216057308f * (x + 0.044715f * x * x * x)); }
__device__ __forceinline__ float fdecay_(float w) { return fexp_(-0.6065306597126334f * fsigmoid_(w)); }
#define GEMM_LDS_BYTES 32768
struct ALoadPlain { const bf16_t* A; int lda;
  __device__ __forceinline__ u32x4 operator()(int row, int k) const { return *(const u32x4*)(A + (long)row * lda + k); } };
#define GEMM_STAGE_WRITE(RA, RB) do { _Pragma("unroll") for (int i = 0; i < 4; ++i) { int r = lrow + 32 * i; int off = r * 128 + ((lchunk ^ (r & 7)) << 4); *(u32x4*)(As + off) = RA[i]; *(u32x4*)(Bs + off) = RB[i]; } } while (0)
#define GEMM_COMPUTE_TILE() do { _Pragma("unroll") for (int ks = 0; ks < 2; ++ks) { bf16x8 af[4], bfr[4]; \
    _Pragma("unroll") for (int i = 0; i < 4; ++i) { int r = wm * 64 + i * 16 + fr; af[i] = *(const bf16x8*)(As + r * 128 + (((ks * 4 + fq) ^ (r & 7)) << 4)); \
      int rn = wn * 64 + i * 16 + fr; bfr[i] = *(const bf16x8*)(Bs + rn * 128 + (((ks * 4 + fq) ^ (rn & 7)) << 4)); } \
    _Pragma("unroll") for (int i = 0; i < 4; ++i) _Pragma("unroll") for (int j = 0; j < 4; ++j) acc[i][j] = __builtin_amdgcn_mfma_f32_16x16x32_bf16(bfr[j], af[i], acc[i][j], 0, 0, 0); } } while (0)
template <class ALoad, class Epi>
__device__ __forceinline__ void gemm_tile_128(ALoad aload, const bf16_t* __restrict__ Bt, int ldb, int K,
                                              int tile_m, int tile_n, char* smem, Epi epi) {
  const int t = tid_opaque(), lane = t & 63, wave = t >> 6;
  const int wm = wave >> 1, wn = wave & 1;
  char* As = smem; char* Bs = smem + 16384;
  const int lrow = t >> 3, lchunk = t & 7;
  const int arow = tile_m * 128 + lrow;
  const bf16_t* bg = Bt + (long)(tile_n * 128 + lrow) * ldb + lchunk * 8;
  u32x4 ra0[4], rb0[4], ra1[4], rb1[4];
#pragma unroll
  for (int i = 0; i < 4; ++i) { ra0[i] = aload(arow + 32 * i, lchunk * 8); rb0[i] = *(const u32x4*)(bg + (long)(32 * i) * ldb); }
  if (K > 64) {
#pragma unroll
    for (int i = 0; i < 4; ++i) { ra1[i] = aload(arow + 32 * i, 64 + lchunk * 8); rb1[i] = *(const u32x4*)(bg + (long)(32 * i) * ldb + 64); }
  }
  f32x4 acc[4][4];
#pragma unroll
  for (int i = 0; i < 4; ++i)
#pragma unroll
    for (int j = 0; j < 4; ++j) acc[i][j] = (f32x4){0.f, 0.f, 0.f, 0.f};
  const int fr = lane & 15, fq = lane >> 4;
  for (int k0 = 0; k0 < K; k0 += 128) {
    __syncthreads();
    GEMM_STAGE_WRITE(ra0, rb0);
    __syncthreads();
    if (k0 + 128 < K) {
#pragma unroll
      for (int i = 0; i < 4; ++i) { ra0[i] = aload(arow + 32 * i, k0 + 128 + lchunk * 8); rb0[i] = *(const u32x4*)(bg + (long)(32 * i) * ldb + k0 + 128); }
    }
    GEMM_COMPUTE_TILE();
    if (k0 + 64 < K) {
      __syncthreads();
      GEMM_STAGE_WRITE(ra1, rb1);
      __syncthreads();
      if (k0 + 192 < K) {
#pragma unroll
        for (int i = 0; i < 4; ++i) { ra1[i] = aload(arow + 32 * i, k0 + 192 + lchunk * 8); rb1[i] = *(const u32x4*)(bg + (long)(32 * i) * ldb + k0 + 192); }
      }
      GEMM_COMPUTE_TILE();
    }
  }
#pragma unroll
  for (int i = 0; i < 4; ++i)
#pragma unroll
    for (int j = 0; j < 4; ++j) {
      int m = tile_m * 128 + wm * 64 + i * 16 + fr; int n0 = tile_n * 128 + wn * 64 + j * 16 + fq * 4;
      epi(m, n0, acc[i][j]);
    }
}

typedef __attribute__((address_space(3))) void lds_void_t;
typedef __attribute__((address_space(1))) const void glb_cvoid_t;
#define GEMM_GLDS_BYTES 65536
__device__ __forceinline__ void gemm_mainloop_glds(const bf16_t* __restrict__ A, int lda, const bf16_t* __restrict__ Bt, int ldb, int K,
                                                   int tile_m, int tile_n, char* smem, f32x4 (&acc)[4][4]) {
  const int t = tid_opaque(), lane = t & 63, wave = t >> 6;
  const int wm = wave >> 1, wn = wave & 1, fr = lane & 15, fq = lane >> 4;
  const int lrow = t >> 3, cl = (t & 7) ^ (lrow & 7);
  const bf16_t* ag = A + (long)(tile_m * 128 + lrow) * lda + cl * 8;
  const bf16_t* bg = Bt + (long)(tile_n * 128 + lrow) * ldb + cl * 8;
  const int wbase = __builtin_amdgcn_readfirstlane(wave) * 1024;
#pragma unroll
  for (int i = 0; i < 4; ++i)
#pragma unroll
    for (int j = 0; j < 4; ++j) acc[i][j] = (f32x4){0.f, 0.f, 0.f, 0.f};
  __syncthreads();
#pragma unroll
  for (int i = 0; i < 4; ++i) {
    __builtin_amdgcn_global_load_lds((glb_cvoid_t*)(ag + (long)(32 * i) * lda), (lds_void_t*)(smem + i * 4096 + wbase), 16, 0, 0);
    __builtin_amdgcn_global_load_lds((glb_cvoid_t*)(bg + (long)(32 * i) * ldb), (lds_void_t*)(smem + 16384 + i * 4096 + wbase), 16, 0, 0);
  }
  int buf = 0;
  for (int k0 = 0; k0 < K; k0 += 64, buf ^= 1) {
    __syncthreads();
    if (k0 + 64 < K) {
      char* nb = smem + (buf ^ 1) * 32768;
#pragma unroll
      for (int i = 0; i < 4; ++i) {
        __builtin_amdgcn_global_load_lds((glb_cvoid_t*)(ag + (long)(32 * i) * lda + k0 + 64), (lds_void_t*)(nb + i * 4096 + wbase), 16, 0, 0);
        __builtin_amdgcn_global_load_lds((glb_cvoid_t*)(bg + (long)(32 * i) * ldb + k0 + 64), (lds_void_t*)(nb + 16384 + i * 4096 + wbase), 16, 0, 0);
      }
    }
    const char* As = smem + buf * 32768; const char* Bs = As + 16384;
    GEMM_COMPUTE_TILE();
  }
}
#define GL4_ISSUE(st_, k0_) do { char* nb_ = smem + ((st_) & 3) * 16384; _Pragma("unroll") for (int j_ = 0; j_ < 2; ++j_) { \
    __builtin_amdgcn_global_load_lds((glb_cvoid_t*)(ag + (long)(64 * j_) * lda + (k0_)), (lds_void_t*)(nb_ + j_ * 4096 + wbase), 16, 0, 0); \
    __builtin_amdgcn_global_load_lds((glb_cvoid_t*)(bg + (long)(64 * j_) * ldb + (k0_)), (lds_void_t*)(nb_ + 8192 + j_ * 4096 + wbase), 16, 0, 0); } } while (0)
__device__ __forceinline__ void gemm_mainloop_glds4(const bf16_t* __restrict__ A, int lda, const bf16_t* __restrict__ Bt, int ldb, int K,
                                                    int tile_m, int tile_n, char* smem, f32x4 (&acc)[4][4]) {
  const int t = tid_opaque(), lane = t & 63, wave = t >> 6;
  const int wm = wave >> 1, wn = wave & 1, fr = lane & 15, fq = lane >> 4;
  const int lrow = t >> 2, cs = (t & 3) ^ ((t >> 4) & 3);
  const bf16_t* ag = A + (long)(tile_m * 128 + lrow) * lda + cs * 8;
  const bf16_t* bg = Bt + (long)(tile_n * 128 + lrow) * ldb + cs * 8;
  const int wbase = __builtin_amdgcn_readfirstlane(wave) * 1024;
#pragma unroll
  for (int i = 0; i < 4; ++i)
#pragma unroll
    for (int j = 0; j < 4; ++j) acc[i][j] = (f32x4){0.f, 0.f, 0.f, 0.f};
  const int nsteps = K >> 5;
  __syncthreads();
  GL4_ISSUE(0, 0);
  if (nsteps > 1) GL4_ISSUE(1, 32);
  if (nsteps > 2) GL4_ISSUE(2, 64);
  for (int s = 0; s < nsteps; ++s) {
    if (s + 2 < nsteps) asm volatile("s_waitcnt vmcnt(8)\n\ts_barrier" ::: "memory");
    else if (s + 1 < nsteps) asm volatile("s_waitcnt vmcnt(4)\n\ts_barrier" ::: "memory");
    else asm volatile("s_waitcnt vmcnt(0)\n\ts_barrier" ::: "memory");
    if (s + 3 < nsteps) GL4_ISSUE(s + 3, (s + 3) * 32);
    const char* As = smem + (s & 3) * 16384; const char* Bs = As + 8192;
    bf16x8 af[4], bfr[4];
#pragma unroll
    for (int i = 0; i < 4; ++i) {
      const int r = wm * 64 + i * 16 + fr; af[i] = *(const bf16x8*)(As + r * 64 + ((fq ^ ((r >> 2) & 3)) << 4));
      const int rn = wn * 64 + i * 16 + fr; bfr[i] = *(const bf16x8*)(Bs + rn * 64 + ((fq ^ ((rn >> 2) & 3)) << 4));
    }
#pragma unroll
    for (int i = 0; i < 4; ++i)
#pragma unroll
      for (int j = 0; j < 4; ++j) acc[i][j] = __builtin_amdgcn_mfma_f32_16x16x32_bf16(bfr[j], af[i], acc[i][j], 0, 0, 0);
  }
}
#ifdef GEMM_GLDS4
#define gemm_mainloop_glds gemm_mainloop_glds4
#endif
template <class Epi>
__device__ __forceinline__ void gemm_tile_128_glds(const bf16_t* __restrict__ A, int lda, const bf16_t* __restrict__ Bt, int ldb, int K,
                                                   int tile_m, int tile_n, char* smem, Epi epi) {
  f32x4 acc[4][4];
  gemm_mainloop_glds(A, lda, Bt, ldb, K, tile_m, tile_n, smem, acc);
  const int t = tid_opaque(), lane = t & 63, wave = t >> 6, wm = wave >> 1, wn = wave & 1, fr = lane & 15, fq = lane >> 4;
#pragma unroll
  for (int i = 0; i < 4; ++i)
#pragma unroll
    for (int j = 0; j < 4; ++j) {
      int m = tile_m * 128 + wm * 64 + i * 16 + fr; int n0 = tile_n * 128 + wn * 64 + j * 16 + fq * 4;
      epi(m, n0, acc[i][j]);
    }
}

__global__ void ok_cvt_wT(const float* W, bf16_t* Wt, int K, int N, int Npad) {
  long i = (long)blockIdx.x * blockDim.x + threadIdx.x;
  if (i >= (long)Npad * K) return;
  int k = i % K; int n = i / K;
  Wt[i] = n < N ? f2bf(W[(long)k * N + n]) : (bf16_t)0;
}
__global__ void ok_f32_to_bf16(const float* s, bf16_t* d, long n) {
  long i = (long)blockIdx.x * blockDim.x + threadIdx.x; if (i < n) d[i] = f2bf(s[i]);
}
__global__ void ok_bf16_to_f32(const bf16_t* s, float* d, long n) {
  long i = (long)blockIdx.x * blockDim.x + threadIdx.x; if (i < n) d[i] = bf2f(s[i]);
}
__global__ void ok_norm_mod_bf16(const float* xs, const float* g, const float* modl, int shift_idx, bf16_t* xn, int M) {
  int row = blockIdx.x * 4 + (threadIdx.x >> 6); int lane = threadIdx.x & 63;
  if (row >= M) return;
  int b = row / RB, lr = row % RB; int bb = lr < SEQ ? b : BATCH;
  const float* sh = modl + ((long)bb * 6 + shift_idx) * DM; const float* sc = sh + DM;
  const float* xr = xs + (long)row * DM; float v[16]; float ss = 0.f;
#pragma unroll
  for (int i = 0; i < 4; ++i) { float4 q = *(const float4*)(xr + i * 256 + lane * 4); v[i*4]=q.x; v[i*4+1]=q.y; v[i*4+2]=q.z; v[i*4+3]=q.w; ss += q.x*q.x+q.y*q.y+q.z*q.z+q.w*q.w; }
#pragma unroll
  for (int o = 32; o > 0; o >>= 1) ss += __shfl_xor(ss, o);
  float inv = __builtin_amdgcn_rsqf(ss / DM + EPSN);
#pragma unroll
  for (int i = 0; i < 4; ++i) {
    int d = i * 256 + lane * 4; float o[4];
#pragma unroll
    for (int e = 0; e < 4; ++e) o[e] = v[i*4+e] * inv * g[d+e] * (1.f + sc[d+e]) + sh[d+e];
    uint2 pk; pk.x = pack2bf(o[0], o[1]); pk.y = pack2bf(o[2], o[3]);
    *(uint2*)(xn + (long)row * DM + d) = pk;
  }
}

struct EpiStoreBf16 { bf16_t* C; int ldc; int N;
  __device__ __forceinline__ void operator()(int m, int n0, f32x4 v) const {
    if (n0 < N) { uint2 pk; pk.x = pack2bf(v[0], v[1]); pk.y = pack2bf(v[2], v[3]); *(uint2*)(C + (long)m * ldc + n0) = pk; } } };
struct EpiStoreF32 { float* C; int ldc; int N;
  __device__ __forceinline__ void operator()(int m, int n0, f32x4 v) const {
    if (n0 < N) *(float4*)(C + (long)m * ldc + n0) = make_float4(v[0], v[1], v[2], v[3]); } };
struct EpiResid { float* xs; const float* modl; int gi; int pad; const float* x_in; const float* ctx_in;
  __device__ __forceinline__ void operator()(int m, int n0, f32x4 v) const {
    int b = m / RB, lr = m % RB; int bb = lr < SEQ ? b : BATCH; const float* g = modl + ((long)bb * 6 + gi) * DM + n0;
    const float* src = x_in ? (lr < SEQ ? x_in + ((long)b * SEQ + lr) * DM + n0 : ctx_in + ((long)b * CTX_LEN + (lr - SEQ)) * DM + n0) : xs + (long)m * DM + n0;
    f32x4 x = *(const f32x4*)src;
    x[0] += g[0] * v[0]; x[1] += g[1] * v[1]; x[2] += g[2] * v[2]; x[3] += g[3] * v[3];
    *(f32x4*)(xs + (long)m * DM + n0) = x; } };

template <class Epi>
__global__ void __launch_bounds__(256) ok_gemm(const bf16_t* A, int lda, const bf16_t* Bt, int ldb, int K, int tiles_m, int tiles_n, Epi epi) {
  __shared__ __attribute__((aligned(16))) char smem[GEMM_LDS_BYTES];
  for (int tile = blockIdx.x; tile < tiles_m * tiles_n; tile += gridDim.x) {
    int tm = tile / tiles_n, tn = tile % tiles_n;
    gemm_tile_128(ALoadPlain{A, lda}, Bt, ldb, K, tm, tn, smem, epi);
  }
}

__device__ __forceinline__ float dot2bf(unsigned a, unsigned b, float c) {
  return __builtin_amdgcn_fdot2_f32_bf16(*(bf16v2*)&a, *(bf16v2*)&b, c, false);
}
__global__ void ok_cvt_bf16_v8(const float* s, bf16_t* d, long n8) {
  long i = (long)blockIdx.x * blockDim.x + threadIdx.x; if (i >= n8) return;
  float4 a = *(const float4*)(s + i * 8), b = *(const float4*)(s + i * 8 + 4);
  u32x4 o; o[0] = pack2bf(a.x, a.y); o[1] = pack2bf(a.z, a.w); o[2] = pack2bf(b.x, b.y); o[3] = pack2bf(b.z, b.w);
  *(u32x4*)(d + i * 8) = o;
}

#define P5_LDS_BYTES (128 * 128 * 4)
__device__ __forceinline__ void peer_q_top1_tile(const bf16_t* __restrict__ A, const bf16_t* __restrict__ WqT, const bf16_t* __restrict__ keysb,
                                                 unsigned* __restrict__ top1, int tm, int ps, char* smem) {
  const int t = tid_opaque(), lane = t & 63, wave = t >> 6, wm = wave >> 1, wn = wave & 1, fr = lane & 15, fq = lane >> 4;
  f32x4 acc[4][4];
  gemm_mainloop_glds(A, DM, WqT, DM, DM, tm, ps, smem, acc);
  __syncthreads();
  char* Qs = smem; char* Ks = smem + 32768;
#pragma unroll
  for (int i = 0; i < 4; ++i)
#pragma unroll
    for (int j = 0; j < 4; ++j) {
      int m = wm * 64 + i * 16 + fr; int n0 = wn * 64 + j * 16 + fq * 4;
      uint2 pk; pk.x = pack2bf(acc[i][j][0], acc[i][j][1]); pk.y = pack2bf(acc[i][j][2], acc[i][j][3]);
      *(uint2*)(Qs + m * 256 + ((((n0 >> 3) ^ (m & 15)) << 4) | ((n0 & 7) << 1))) = pk;
    }
  {
    const bf16_t* kg = keysb + (long)ps * 128 * 128;
#pragma unroll
    for (int i = 0; i < 8; ++i) { int idx = t + 256 * i; int r = idx >> 4, c = idx & 15; *(u32x4*)(Ks + r * 256 + ((c ^ (r & 15)) << 4)) = *(const u32x4*)(kg + r * 128 + c * 8); }
  }
  __syncthreads();
#pragma unroll
  for (int i = 0; i < 4; ++i)
#pragma unroll
    for (int j = 0; j < 4; ++j) acc[i][j] = (f32x4){0.f, 0.f, 0.f, 0.f};
#pragma unroll
  for (int ks = 0; ks < 4; ++ks) {
    bf16x8 af[4], bfr[4];
#pragma unroll
    for (int i = 0; i < 4; ++i) {
      int r = wm * 64 + i * 16 + fr; af[i] = *(const bf16x8*)(Qs + r * 256 + (((ks * 4 + fq) ^ (r & 15)) << 4));
      int rn = wn * 64 + i * 16 + fr; bfr[i] = *(const bf16x8*)(Ks + rn * 256 + (((ks * 4 + fq) ^ (rn & 15)) << 4));
    }
#pragma unroll
    for (int i = 0; i < 4; ++i)
#pragma unroll
      for (int j = 0; j < 4; ++j) acc[i][j] = __builtin_amdgcn_mfma_f32_16x16x32_bf16(bfr[j], af[i], acc[i][j], 0, 0, 0);
  }
  __syncthreads();
  unsigned* Sc = (unsigned*)smem;
#pragma unroll
  for (int i = 0; i < 4; ++i)
#pragma unroll
    for (int j = 0; j < 4; ++j) {
      int m = wm * 64 + i * 16 + fr; int n0 = wn * 64 + j * 16 + fq * 4;
#pragma unroll
      for (int e = 0; e < 4; ++e) Sc[(n0 + e) * 128 + (m ^ ((((n0 + e) >> 2) & 1) << 4))] = enc_key(acc[i][j][e], n0 + e);
    }
  __syncthreads();
  {
    const int r = t & 127, half = t >> 7;
    unsigned l[16];
#pragma unroll
    for (int i = 0; i < 16; ++i) l[i] = 0u;
    for (int k = 0; k < 64; ++k) ins16(l, Sc[(half * 64 + k) * 128 + (r ^ (((k >> 2) & 1) << 4))]);
    __syncthreads();
    unsigned* Ls = (unsigned*)smem;
    if (half == 1) {
#pragma unroll
      for (int i = 0; i < 16; ++i) Ls[r * 17 + i] = l[15 - i];
    }
    __syncthreads();
    if (half == 0) {
      unsigned br[16];
#pragma unroll
      for (int i = 0; i < 16; ++i) br[i] = Ls[r * 17 + i];
      merge16(l, br);
      unsigned* o = top1 + ((long)(tm * 128 + r) * 16 + ps) * 16;
#pragma unroll
      for (int i = 0; i < 4; ++i) { u32x4 v; v[0] = l[4*i]; v[1] = l[4*i+1]; v[2] = l[4*i+2]; v[3] = l[4*i+3]; *(u32x4*)(o + 4 * i) = v; }
    }
  }
}
__global__ void __launch_bounds__(256) ok_peer_q_top1(const bf16_t* A, const bf16_t* WqT, const bf16_t* keysb, unsigned* top1, int tiles_m) {
  __shared__ __attribute__((aligned(16))) char smem[P5_LDS_BYTES];
  for (int tile = blockIdx.x; tile < tiles_m * 16; tile += gridDim.x) { peer_q_top1_tile(A, WqT, keysb, top1, tile / 16, tile % 16, smem); __syncthreads(); }
}

#define P6_LDS_BYTES (32 * 128 * 4 * 3)
__device__ __forceinline__ void peer_gather_group(const bf16_t* __restrict__ xn, const unsigned* __restrict__ top1, const bf16_t* __restrict__ ub,
                                                  const bf16_t* __restrict__ vb, const float* __restrict__ modl, float* __restrict__ xs, int grp, char* smem) {
  const int t = tid_opaque(), lane = t & 63, wave = t >> 6;
  int* pe_l = (int*)smem; float* pg_l = (float*)(smem + 32 * 128 * 4); float* pw_l = (float*)(smem + 2 * 32 * 128 * 4);
  {
    int tl = t >> 3, p = t & 7; long row = (long)grp * 32 + tl;
    peer_combine(top1 + (row * 16 + p * 2) * 16, top1 + (row * 16 + p * 2 + 1) * 16, pe_l + tl * 128 + p * 16, pg_l + tl * 128 + p * 16);
  }
  __syncthreads();
  for (int ti = 0; ti < 8; ++ti) {
    const int tl = wave * 8 + ti; const long row = (long)grp * 32 + tl;
    const int* pe = pe_l + tl * 128; float* pw = pw_l + tl * 128;
    u32x4 h0 = *(const u32x4*)(xn + row * DM + lane * 8), h1 = *(const u32x4*)(xn + row * DM + 512 + lane * 8);
    for (int b = 0; b < 16; ++b) {
      u32x4 u0[8], u1[8];
#pragma unroll
      for (int j = 0; j < 8; ++j) { const bf16_t* ur = ub + (long)pe[b * 8 + j] * DM + lane * 8; u0[j] = *(const u32x4*)ur; u1[j] = *(const u32x4*)(ur + 512); }
      float pd[8];
#pragma unroll
      for (int j = 0; j < 8; ++j) {
        float a = 0.f;
#pragma unroll
        for (int e = 0; e < 4; ++e) { a = dot2bf(h0[e], u0[j][e], a); a = dot2bf(h1[e], u1[j][e], a); }
        pd[j] = a;
      }
      float q4[4], q2[2], q1;
#pragma unroll
      for (int j = 0; j < 4; ++j) { bool hi = lane & 1; float keep = hi ? pd[2*j+1] : pd[2*j], send = hi ? pd[2*j] : pd[2*j+1]; q4[j] = keep + __shfl_xor(send, 1); }
#pragma unroll
      for (int j = 0; j < 2; ++j) { bool hi = lane & 2; float keep = hi ? q4[2*j+1] : q4[2*j], send = hi ? q4[2*j] : q4[2*j+1]; q2[j] = keep + __shfl_xor(send, 2); }
      { bool hi = lane & 4; float keep = hi ? q2[1] : q2[0], send = hi ? q2[0] : q2[1]; q1 = keep + __shfl_xor(send, 4); }
      q1 += __shfl_xor(q1, 8); q1 += __shfl_xor(q1, 16); q1 += __shfl_xor(q1, 32);
      if (lane < 8) { int j = lane & 7; pw[b * 8 + j] = q1; }
    }
    {
      float d0 = pw[lane], d1 = pw[64 + lane];
      pw[lane] = pg_l[tl * 128 + lane] * fgelu_(d0); pw[64 + lane] = pg_l[tl * 128 + 64 + lane] * fgelu_(d1);
    }
    float o[16];
#pragma unroll
    for (int e = 0; e < 16; ++e) o[e] = 0.f;
    for (int b = 0; b < 16; ++b) {
      u32x4 v0[8], v1[8];
#pragma unroll
      for (int j = 0; j < 8; ++j) { const bf16_t* vr = vb + (long)pe[b * 8 + j] * DM + lane * 8; v0[j] = *(const u32x4*)vr; v1[j] = *(const u32x4*)(vr + 512); }
#pragma unroll
      for (int j = 0; j < 8; ++j) {
        float w = pw[b * 8 + j];
#pragma unroll
        for (int e = 0; e < 4; ++e) {
          o[2*e]     += w * __uint_as_float(v0[j][e] << 16); o[2*e+1]     += w * __uint_as_float(v0[j][e] & 0xffff0000u);
          o[8 + 2*e] += w * __uint_as_float(v1[j][e] << 16); o[8 + 2*e+1] += w * __uint_as_float(v1[j][e] & 0xffff0000u);
        }
      }
    }
    {
      int b = row / RB, lr = row % RB; int bb = lr < SEQ ? b : BATCH; const float* g5 = modl + ((long)bb * 6 + 5) * DM;
      float* xr = xs + row * DM;
#pragma unroll
      for (int hf = 0; hf < 2; ++hf) {
        int d = hf * 512 + lane * 8;
        float4 x0 = *(float4*)(xr + d), x1 = *(float4*)(xr + d + 4); float4 g0 = *(const float4*)(g5 + d), g1 = *(const float4*)(g5 + d + 4);
        x0.x += g0.x * o[hf*8+0]; x0.y += g0.y * o[hf*8+1]; x0.z += g0.z * o[hf*8+2]; x0.w += g0.w * o[hf*8+3];
        x1.x += g1.x * o[hf*8+4]; x1.y += g1.y * o[hf*8+5]; x1.z += g1.z * o[hf*8+6]; x1.w += g1.w * o[hf*8+7];
        *(float4*)(xr + d) = x0; *(float4*)(xr + d + 4) = x1;
      }
    }
  }
}
__global__ void __launch_bounds__(256) ok_peer_gather(const bf16_t* xn, const unsigned* top1, const bf16_t* ub, const bf16_t* vb, const float* modl, float* xs, int ngroups) {
  __shared__ __attribute__((aligned(16))) char smem[P6_LDS_BYTES];
  for (int g = blockIdx.x; g < ngroups; g += gridDim.x) { peer_gather_group(xn, top1, ub, vb, modl, xs, g, smem); __syncthreads(); }
}

template <int DQ> struct AttnCfg { static constexpr int KROW = DQ * 2 + 16; static constexpr int VROW = 136; static constexpr int KBYTES = 64 * KROW; static constexpr int LDS = 64 * KROW + 64 * VROW; };
#define ATTN_LDS_BYTES (64 * 208 + 64 * 136)
__device__ __forceinline__ void attn_score_bound(const float* __restrict__ qk_g, int DQ, float sqrt_dq, float* __restrict__ dst, int lane) {
  float gq = 0.f, gk = 0.f;
  for (int i = lane; i < DQ; i += 64) { gq = fmaxf(gq, fabsf(qk_g[i])); gk = fmaxf(gk, fabsf(qk_g[DQ + i])); }
#pragma unroll
  for (int o_ = 32; o_ > 0; o_ >>= 1) { gq = fmaxf(gq, __shfl_xor(gq, o_)); gk = fmaxf(gk, __shfl_xor(gk, o_)); }
  if (lane == 0) *dst = -fminf(1.02f * 1.4426950408889634f * sqrt_dq * gq * gk, 60.f);
}
template <int DQ>
__device__ __forceinline__ void attn_block(const bf16_t* __restrict__ qb, int HQ, const bf16_t* __restrict__ kb, int HK, const bf16_t* __restrict__ vT, int G,
                                           bf16_t* __restrict__ mixall, int ooff, int b, int head, int qt, char* smem, const float* __restrict__ negC_p) {
  constexpr int KROW = AttnCfg<DQ>::KROW, VROW = 136, NKK = DQ / 16, KCH = DQ / 8;
  constexpr int KLD = (64 * KCH) / 256;
  const int t = tid_opaque(), lane = t & 63, wave = t >> 6, lq = lane & 31, lh = lane >> 5;
  const int hk = head / G;
  char* Ks = smem; char* Vs = smem + 64 * KROW;
  const float negC = *negC_p;
  const long qrow = (long)b * RB + qt * 128 + wave * 32 + lq;
  bf16x8 qf[NKK];
#pragma unroll
  for (int kk = 0; kk < NKK; ++kk) qf[kk] = *(const bf16x8*)(qb + (qrow * HQ + head) * DQ + kk * 16 + lh * 8);
  const int key0 = qt < 16 ? 0 : SEQ; const int nt = qt < 16 ? RB / 64 : CTX_LEN / 64;
  const bf16_t* kp[KLD]; const bf16_t* vp_[2];
#pragma unroll
  for (int i = 0; i < KLD; ++i) { int c = t + 256 * i; int r = c / KCH, cc = c % KCH; kp[i] = kb + ((long)b * RB * HK + hk) * DQ + (long)(key0 + r) * HK * DQ + cc * 8; }
#pragma unroll
  for (int i = 0; i < 2; ++i) { int c = t + 256 * i; int r = c >> 3, cc = c & 7; vp_[i] = vT + ((long)(b * HK + hk) * 64 + r) * RB + key0 + cc * 8; }
  u32x4 rk[KLD], rv[2];
#pragma unroll
  for (int i = 0; i < KLD; ++i) { rk[i] = *(const u32x4*)kp[i]; kp[i] += 64 * HK * DQ; }
#pragma unroll
  for (int i = 0; i < 2; ++i) { rv[i] = *(const u32x4*)vp_[i]; vp_[i] += 64; }
  f32x16 ot[2];
#pragma unroll
  for (int d = 0; d < 2; ++d)
#pragma unroll
    for (int r = 0; r < 16; ++r) ot[d][r] = 0.f;
  float lrun = 0.f;
  for (int tile = 0; tile < nt; ++tile) {
    __syncthreads();
#pragma unroll
    for (int i = 0; i < KLD; ++i) { int c = t + 256 * i; int r = c / KCH, cc = c % KCH; *(u32x4*)(Ks + r * KROW + cc * 16) = rk[i]; }
#pragma unroll
    for (int i = 0; i < 2; ++i) { int c = t + 256 * i; int r = c >> 3, cc = c & 7; *(uint2*)(Vs + r * VROW + cc * 16) = make_uint2(rv[i][0], rv[i][1]); *(uint2*)(Vs + r * VROW + cc * 16 + 8) = make_uint2(rv[i][2], rv[i][3]); }
    __syncthreads();
    if (tile + 1 < nt) {
#pragma unroll
      for (int i = 0; i < KLD; ++i) { rk[i] = *(const u32x4*)kp[i]; kp[i] += 64 * HK * DQ; }
#pragma unroll
      for (int i = 0; i < 2; ++i) { rv[i] = *(const u32x4*)vp_[i]; vp_[i] += 64; }
    }
    f32x16 st[2];
#pragma unroll
    for (int kt = 0; kt < 2; ++kt) {
#pragma unroll
      for (int r = 0; r < 16; ++r) st[kt][r] = negC;
#pragma unroll
      for (int kk = 0; kk < NKK; ++kk) {
        bf16x8 ka = *(const bf16x8*)(Ks + (kt * 32 + lq) * KROW + kk * 32 + lh * 16);
        st[kt] = __builtin_amdgcn_mfma_f32_32x32x16_bf16(ka, qf[kk], st[kt], 0, 0, 0);
      }
    }
    float ps = 0.f;
#pragma unroll
    for (int kt = 0; kt < 2; ++kt)
#pragma unroll
      for (int r = 0; r < 16; ++r) { float p = __builtin_amdgcn_exp2f(st[kt][r]); st[kt][r] = p; ps += p; }
    lrun += ps;
#pragma unroll
    for (int kt = 0; kt < 2; ++kt)
#pragma unroll
      for (int s = 0; s < 2; ++s) {
        union { bf16x8 v; unsigned u[4]; } pb;
#pragma unroll
        for (int j = 0; j < 4; ++j) pb.u[j] = pack2bf(st[kt][8 * s + 2 * j], st[kt][8 * s + 2 * j + 1]);
#pragma unroll
        for (int d = 0; d < 2; ++d) {
          const char* vp = Vs + (d * 32 + lq) * VROW + (kt * 32 + 16 * s + 4 * lh) * 2;
          union { bf16x8 v; uint2 h[2]; } va; va.h[0] = *(const uint2*)vp; va.h[1] = *(const uint2*)(vp + 16);
          ot[d] = __builtin_amdgcn_mfma_f32_32x32x16_bf16(va.v, pb.v, ot[d], 0, 0, 0);
        }
      }
  }
  float ltot = xor32_sum(lrun); float inv = 1.f / ltot;
  bf16_t* orow = mixall + qrow * DM + ooff + head * 64;
#pragma unroll
  for (int d = 0; d < 2; ++d)
#pragma unroll
    for (int g = 0; g < 4; ++g) {
      uint2 pk; pk.x = pack2bf(ot[d][4 * g] * inv, ot[d][4 * g + 1] * inv); pk.y = pack2bf(ot[d][4 * g + 2] * inv, ot[d][4 * g + 3] * inv);
      *(uint2*)(orow + d * 32 + 8 * g + 4 * lh) = pk;
    }
}
__global__ void ok_adapt_rows(const float* src, int sld, int scol, int ncols, float scale, bf16_t* dst, int dld, int nrows) {
  long i = (long)blockIdx.x * blockDim.x + threadIdx.x; if (i >= (long)nrows * ncols) return;
  int c = i % ncols; long r = i / ncols; dst[r * dld + c] = f2bf(src[r * sld + scol + c] * scale);
}
__global__ void ok_adapt_vT(const float* src, int sld, int scol, int hstride, int H, bf16_t* dst) {
  long i = (long)blockIdx.x * blockDim.x + threadIdx.x; if (i >= (long)H * 64 * RB) return;
  int lr = i % RB; int d = (i / RB) % 64; int h = i / ((long)RB * 64);
  dst[i] = f2bf(src[(long)lr * sld + scol + h * hstride + d]);
}

typedef __attribute__((ext_vector_type(2))) float f32x2;
#define SCAN_TS 16
#define SCAN_LDS_BYTES (2 * SCAN_TS * 1536 + 2 * SCAN_TS * 32 * 4)
__device__ __forceinline__ float reduce8(float x) {
  x += __builtin_bit_cast(float, __builtin_amdgcn_update_dpp(0, __builtin_bit_cast(int, x), 0xB1, 0xf, 0xf, true));
  x += __builtin_bit_cast(float, __builtin_amdgcn_update_dpp(0, __builtin_bit_cast(int, x), 0x4E, 0xf, 0xf, true));
  x += __builtin_bit_cast(float, __builtin_amdgcn_update_dpp(0, __builtin_bit_cast(int, x), 0x141, 0xf, 0xf, true));
  return x;
}
__device__ __forceinline__ int scan_row(int dir, int s) {
  if (s < CTX_LEN) return SEQ + (dir == 0 ? s : CTX_LEN - 1 - s);
  return dir == 0 ? s - CTX_LEN : SEQ - 1 - (s - CTX_LEN);
}
__device__ __forceinline__ void rw_scan_block(const bf16_t* __restrict__ r_, const bf16_t* __restrict__ v_, const bf16_t* __restrict__ kk_, const bf16_t* __restrict__ kd_,
                                              const bf16_t* __restrict__ bd_, const float* __restrict__ w_, float* __restrict__ y_, int item, long dstride, char* smem) {
  const int t = tid_opaque(), lane = t & 63, wave = t >> 6, cg = lane & 7, il = wave * 8 + (lane >> 3);
  const int half = item & 1, dir = (item >> 1) & 1, h = (item >> 2) % 6, b = item / 24;
  const long rowbase = (long)b * RB; const int col0 = h * 64;
  float* ybuf = (float*)(smem + 2 * SCAN_TS * 1536);
  const int st_ld = t >> 4, part = t & 15;
  u32x4 la, lb, lc, lw;
  auto issue = [&](int c) {
    long row = rowbase + scan_row(dir, c * SCAN_TS + st_ld); long o = row * 384 + col0;
    const int ch = (part & 7) * 8;
    la = *(const u32x4*)((part < 8 ? kk_ + o : bd_ + dir * dstride + o) + ch);
    lb = *(const u32x4*)((part < 8 ? kd_ + dir * dstride + o : r_ + o) + ch);
    lc = *(const u32x4*)(v_ + o + ch);
    lw = *(const u32x4*)(w_ + dir * dstride + o + part * 4);
  };
  auto stash = [&](int buf) {
    float* base = (float*)(smem + buf * SCAN_TS * 1536 + st_ld * 1536);
    const int ch = (part & 7) * 8;
    float* pa = base + (part < 8 ? 64 : 128) + ch; float* pb = base + (part < 8 ? 192 : 256) + ch;
    f32x4 x0, x1;
#pragma unroll
    for (int e = 0; e < 2; ++e) { x0[2*e] = __uint_as_float(la[e] << 16); x0[2*e+1] = __uint_as_float(la[e] & 0xffff0000u); x1[2*e] = __uint_as_float(la[2+e] << 16); x1[2*e+1] = __uint_as_float(la[2+e] & 0xffff0000u); }
    *(f32x4*)pa = x0; *(f32x4*)(pa + 4) = x1;
#pragma unroll
    for (int e = 0; e < 2; ++e) { x0[2*e] = __uint_as_float(lb[e] << 16); x0[2*e+1] = __uint_as_float(lb[e] & 0xffff0000u); x1[2*e] = __uint_as_float(lb[2+e] << 16); x1[2*e+1] = __uint_as_float(lb[2+e] & 0xffff0000u); }
    *(f32x4*)pb = x0; *(f32x4*)(pb + 4) = x1;
    if (part < 8) {
      float* pc = base + 320 + ch;
#pragma unroll
      for (int e = 0; e < 2; ++e) { x0[2*e] = __uint_as_float(lc[e] << 16); x0[2*e+1] = __uint_as_float(lc[e] & 0xffff0000u); x1[2*e] = __uint_as_float(lc[2+e] << 16); x1[2*e+1] = __uint_as_float(lc[2+e] & 0xffff0000u); }
      *(f32x4*)pc = x0; *(f32x4*)(pc + 4) = x1;
    }
    *(u32x4*)(base + part * 4) = lw;
  };
  f32x2 S[4];
#pragma unroll
  for (int j = 0; j < 4; ++j) S[j] = (f32x2){0.f, 0.f};
  const int NCH = RB / SCAN_TS;
  __builtin_amdgcn_s_setprio(3);
  issue(0);
  for (int c = 0; c < NCH; ++c) {
    const int buf = c & 1;
    stash(buf);
    __syncthreads();
    if (c > 0 && t < 128) {
      int st = t >> 3, i4 = (t & 7) * 4; long row = rowbase + scan_row(dir, (c - 1) * SCAN_TS + st);
      *(f32x4*)(y_ + dir * dstride + row * 384 + col0 + half * 32 + i4) = *(const f32x4*)(ybuf + (buf ^ 1) * SCAN_TS * 32 + st * 32 + i4);
    }
    if (c + 1 < NCH) issue(c + 1);
    const float* ob = (const float*)(smem + buf * SCAN_TS * 1536) + cg * 8;
    const float* vb_ = (const float*)(smem + buf * SCAN_TS * 1536) + 320 + half * 32 + il;
    float yk[SCAN_TS];
    f32x4 nw0 = *(const f32x4*)(ob), nw1 = *(const f32x4*)(ob + 4), nk0 = *(const f32x4*)(ob + 64), nk1 = *(const f32x4*)(ob + 68);
    f32x4 nb0 = *(const f32x4*)(ob + 128), nb1 = *(const f32x4*)(ob + 132), nd0 = *(const f32x4*)(ob + 192), nd1 = *(const f32x4*)(ob + 196);
    f32x4 nr0 = *(const f32x4*)(ob + 256), nr1 = *(const f32x4*)(ob + 260); float nvi = vb_[0];
#pragma unroll
    for (int st = 0; st < SCAN_TS; ++st) {
      const f32x4 w0 = nw0, w1 = nw1, k0 = nk0, k1 = nk1, b0 = nb0, b1 = nb1, d0 = nd0, d1 = nd1, r0 = nr0, r1 = nr1; const float vi = nvi;
      if (st + 1 < SCAN_TS) {
        const float* o = ob + (st + 1) * 384;
        nw0 = *(const f32x4*)(o); nw1 = *(const f32x4*)(o + 4); nk0 = *(const f32x4*)(o + 64); nk1 = *(const f32x4*)(o + 68);
        nb0 = *(const f32x4*)(o + 128); nb1 = *(const f32x4*)(o + 132); nd0 = *(const f32x4*)(o + 192); nd1 = *(const f32x4*)(o + 196);
        nr0 = *(const f32x4*)(o + 256); nr1 = *(const f32x4*)(o + 260); nvi = vb_[(st + 1) * 384];
      }
      __builtin_amdgcn_sched_barrier(0);
      f32x2 a2 = S[0] * (f32x2){k0[0], k0[1]}, c2 = S[2] * (f32x2){k1[0], k1[1]};
      a2 += S[1] * (f32x2){k0[2], k0[3]}; c2 += S[3] * (f32x2){k1[2], k1[3]};
      a2 += c2;
      const f32x2 vv = (f32x2){vi, vi};
      f32x2 t0 = vv * (f32x2){d0[0], d0[1]}, t1 = vv * (f32x2){d0[2], d0[3]}, t2 = vv * (f32x2){d1[0], d1[1]}, t3 = vv * (f32x2){d1[2], d1[3]};
      float skk = reduce8(a2[0] + a2[1]);
      const f32x2 ns = (f32x2){-skk, -skk};
      t0 += ns * (f32x2){b0[0], b0[1]}; t1 += ns * (f32x2){b0[2], b0[3]}; t2 += ns * (f32x2){b1[0], b1[1]}; t3 += ns * (f32x2){b1[2], b1[3]};
      S[0] = S[0] * (f32x2){w0[0], w0[1]} + t0; S[1] = S[1] * (f32x2){w0[2], w0[3]} + t1; S[2] = S[2] * (f32x2){w1[0], w1[1]} + t2; S[3] = S[3] * (f32x2){w1[2], w1[3]} + t3;
      f32x2 y2 = S[0] * (f32x2){r0[0], r0[1]}, z2 = S[2] * (f32x2){r1[0], r1[1]};
      y2 += S[1] * (f32x2){r0[2], r0[3]}; z2 += S[3] * (f32x2){r1[2], r1[3]};
      y2 += z2;
      yk[st] = y2[0] + y2[1];
      __builtin_amdgcn_sched_barrier(0);
    }
#pragma unroll
    for (int g = 0; g < 2; ++g) {
      float q4[4], q2[2], q1;
#pragma unroll
      for (int j = 0; j < 4; ++j) { bool hi = cg & 1; float keep = hi ? yk[g*8 + 2*j+1] : yk[g*8 + 2*j], send = hi ? yk[g*8 + 2*j] : yk[g*8 + 2*j+1]; q4[j] = keep + dpp_get<0xB1>(send); }
#pragma unroll
      for (int j = 0; j < 2; ++j) { bool hi = cg & 2; float keep = hi ? q4[2*j+1] : q4[2*j], send = hi ? q4[2*j] : q4[2*j+1]; q2[j] = keep + dpp_get<0x4E>(send); }
      { bool hi = cg & 4; float keep = hi ? q2[1] : q2[0], send = hi ? q2[0] : q2[1]; q1 = keep + xor4_get(send); }
      ybuf[buf * SCAN_TS * 32 + (g * 8 + cg) * 32 + il] = q1;
    }
  }
  __builtin_amdgcn_s_setprio(0);
  __syncthreads();
  if (t < 128) {
    int st = t >> 3, i4 = (t & 7) * 4; long row = rowbase + scan_row(dir, (NCH - 1) * SCAN_TS + st);
    *(f32x4*)(y_ + dir * dstride + row * 384 + col0 + half * 32 + i4) = *(const f32x4*)(ybuf + ((NCH - 1) & 1) * SCAN_TS * 32 + st * 32 + i4);
  }
}
__global__ void __launch_bounds__(256) ok_rw_scan(const bf16_t* r_, const bf16_t* v_, const bf16_t* kk_, const bf16_t* kd_, const bf16_t* bd_, const float* w_, float* y_, int item0, int nitems, long dstride) {
  __shared__ __attribute__((aligned(16))) char smem[SCAN_LDS_BYTES];
  for (int it = item0 + blockIdx.x; it < item0 + nitems; it += gridDim.x) { rw_scan_block(r_, v_, kk_, kd_, bd_, w_, y_, it, dstride, smem); __syncthreads(); }
}
__global__ void ok_copy_rows_f32(const float* src, int sld, int scol, int ncols, float* dst, int dld, int nrows) {
  long i = (long)blockIdx.x * blockDim.x + threadIdx.x; if (i >= (long)nrows * ncols) return;
  int c = i % ncols; long r = i / ncols; dst[r * dld + c] = src[r * sld + scol + c];
}

__global__ void ok_cvt_wT_g(const float* W, const float* g, bf16_t* Wt, int K, int N, int Kpad) {
  long i = (long)blockIdx.x * blockDim.x + threadIdx.x;
  if (i >= (long)N * Kpad) return;
  int k = i % Kpad; int n = i / Kpad;
  Wt[i] = k < K ? f2bf(W[(long)k * N + n] * (g ? g[k] : 1.f)) : (bf16_t)0;
}
struct ALoadShift { const bf16_t* P; const float* mu; int col0; int mucol0; int act; int kvalid;
  __device__ __forceinline__ u32x4 operator()(int row, int k) const {
    u32x4 z = {0u, 0u, 0u, 0u};
    if (k >= kvalid) return z;
    int lr = row % RB; bool first = (lr == 0) || (lr == SEQ), last = (lr == SEQ - 1) || (lr == RB - 1);
    const bf16_t* p = P + (long)row * IN_COLS + col0 + k;
    u32x4 c = *(const u32x4*)p; u32x4 pv = first ? z : *(const u32x4*)(p - IN_COLS); u32x4 nx = last ? z : *(const u32x4*)(p + IN_COLS);
    const float* m0 = mu + mucol0 + k; const float* m1 = m0 + RWC;
    u32x4 o;
#pragma unroll
    for (int e = 0; e < 4; ++e) {
      float c0 = __uint_as_float(c[e] << 16), c1 = __uint_as_float(c[e] & 0xffff0000u);
      float p0 = __uint_as_float(pv[e] << 16), p1 = __uint_as_float(pv[e] & 0xffff0000u);
      float n0 = __uint_as_float(nx[e] << 16), n1 = __uint_as_float(nx[e] & 0xffff0000u);
      float x0 = c0 + m0[2*e] * (p0 - c0) + m1[2*e] * (n0 - c0), x1 = c1 + m0[2*e+1] * (p1 - c1) + m1[2*e+1] * (n1 - c1);
      if (act == 1) { x0 = ftanh_(x0); x1 = ftanh_(x1); } else if (act == 2) { x0 = fsigmoid_(x0); x1 = fsigmoid_(x1); }
      o[e] = pack2bf(x0, x1);
    }
    return o;
  } };
struct EpiDecay { float* w; const float* w0; int pad0; int pad1;
  __device__ __forceinline__ void operator()(int m, int n0, f32x4 v) const {
    f32x4 o;
#pragma unroll
    for (int e = 0; e < 4; ++e) o[e] = fdecay_(w0[n0 + e] + v[e]);
    *(f32x4*)(w + (long)m * 384 + n0) = o; } };
struct EpiSigA { bf16_t* a; const float* a0;
  __device__ __forceinline__ void operator()(int m, int n0, f32x4 v) const {
    uint2 pk; pk.x = pack2bf(fsigmoid_(a0[n0] + v[0]), fsigmoid_(a0[n0+1] + v[1])); pk.y = pack2bf(fsigmoid_(a0[n0+2] + v[2]), fsigmoid_(a0[n0+3] + v[3]));
    *(uint2*)(a + (long)m * 384 + n0) = pk; } };

struct PrepW { const bf16_t *wqbT, *wkvbT, *w2T, *a2T, *g2T; const float *mu, *w0, *a0; };
struct PrepBuf { const bf16_t* P; bf16_t *tq, *tkv, *a_b, *g_b; float* w_f; };
__device__ __forceinline__ void prep_gemm_tile(const PrepW& W, const PrepBuf& B, int tm, int ct, char* smem) {
  const long MA = NROWS;
  if (ct < 3) gemm_tile_128(ALoadPlain{B.P, IN_COLS}, W.wqbT, 256, 256, tm, ct, smem, EpiStoreBf16{B.tq, 384, 384});
  else if (ct < 7) gemm_tile_128(ALoadPlain{B.P + 256, IN_COLS}, W.wkvbT, 128, 128, tm, ct - 3, smem, EpiStoreBf16{B.tkv, 512, 512});
  else if (ct < 13) { int d = (ct - 7) / 3, tn = (ct - 7) % 3;
    gemm_tile_128(ALoadShift{B.P, W.mu, RW_OFF + 1152 + d * 64, 1152 + d * 64, 1, 64}, W.w2T + d * 384 * 64, 64, 64, tm, tn, smem, EpiDecay{B.w_f + d * MA * 384, W.w0 + d * 384, 0, 0}); }
  else if (ct < 19) { int d = (ct - 13) / 3, tn = (ct - 13) % 3;
    gemm_tile_128(ALoadShift{B.P, W.mu, RW_OFF + 1280 + d * 64, 1280 + d * 64, 0, 64}, W.a2T + d * 384 * 64, 64, 64, tm, tn, smem, EpiSigA{B.a_b + d * MA * 384, W.a0 + d * 384}); }
  else gemm_tile_128(ALoadShift{B.P, W.mu, RW_OFF + 1408, 1408, 2, 160}, W.g2T, 192, 192, tm, ct - 19, smem, EpiStoreBf16{B.g_b, 384, 384});
}
__global__ void __launch_bounds__(256) ok_prep_gemm(PrepW W, PrepBuf B) {
  __shared__ __attribute__((aligned(16))) char smem[GEMM_LDS_BYTES];
  for (int tile = blockIdx.x; tile < (NROWS / 128) * 22; tile += gridDim.x) prep_gemm_tile(W, B, tile / 22, tile % 22, smem);
}

__device__ __forceinline__ float wave_sum(float x) {
#pragma unroll
  for (int o = 32; o > 0; o >>= 1) x += __shfl_xor(x, o);
  return x;
}
__device__ __forceinline__ float ldbf(const bf16_t* p) { return bf2f(*p); }
struct FinW { const float *mla_qk_g, *gqa_qk_g, *mu, *k_k, *k_a; };
struct FinBuf { const bf16_t *P, *tq, *tkv, *a_b; bf16_t *mq, *mk, *mvT, *gq, *gk, *gvT, *r_b, *v_b, *kk_b, *kd_b, *bd_b; };
#define FIN_LDS_BYTES (384 * 132)
__device__ __forceinline__ void prep_finish_tile(const FinW& W, const FinBuf& B, int tile, char* smem) {
  const int t = tid_opaque(), lane = t & 63, wave = t >> 6; const long MA = NROWS;
  bf16_t* vbuf = (bf16_t*)smem;
  const long row0 = (long)tile * 64; const int b = row0 / RB; const int lr0 = row0 % RB;
  for (int it = 0; it < 16; ++it) {
    const int rl = it * 4 + wave; const long row = row0 + rl; const int lr = lr0 + rl; const bool lat = lr < SEQ;
    const bf16_t* Pr = B.P + row * IN_COLS;
    float sq = 0.f;
#pragma unroll
    for (int i = 0; i < 4; ++i) { float x = ldbf(Pr + i * 64 + lane); sq += x * x; }
    float skv = 0.f;
#pragma unroll
    for (int i = 0; i < 2; ++i) { float x = ldbf(Pr + 256 + i * 64 + lane); skv += x * x; }
    const float cq = __builtin_amdgcn_rsqf(wave_sum(sq) / 256.f + EPSN), ckv = __builtin_amdgcn_rsqf(wave_sum(skv) / 128.f + EPSN);
    const float krope = lane < 32 ? ldbf(Pr + 384 + lane) : 0.f;
    float cs_m = 1.f, sn_m = 0.f;
    { int j = lane & 15; int pos = j < 8 ? lr / 64 : lr % 64; float ang = (float)pos * powf(10000.f, -(float)(j & 7) / 8.f); if (lat) { cs_m = cosf(ang); sn_m = sinf(ang); } }
    const float* gq_ = W.mla_qk_g; const float* gk_ = W.mla_qk_g + 96;
#pragma unroll
    for (int h = 0; h < 4; ++h) {
      float qa = cq * ldbf(B.tq + row * 384 + h * 96 + lane); float qb = lane < 32 ? cq * ldbf(B.tq + row * 384 + h * 96 + 64 + lane) : 0.f;
      float inv = __builtin_amdgcn_rsqf(wave_sum(qa * qa + qb * qb) / 96.f + EPSN);
      qa *= inv * gq_[lane]; qb *= inv * (lane < 32 ? gq_[64 + lane] : 0.f);
      { float other = __shfl_xor(qb, 16); float rr = (lane & 16) ? (other * sn_m + qb * cs_m) : (qb * cs_m - other * sn_m); qb = rr; }
      const float qs = 0.14724445f;
      B.mq[row * 384 + h * 96 + lane] = f2bf(qa * qs); if (lane < 32) B.mq[row * 384 + h * 96 + 64 + lane] = f2bf(qb * qs);
      float ka = ckv * ldbf(B.tkv + row * 512 + h * 128 + lane); float kb = krope;
      float invk = __builtin_amdgcn_rsqf(wave_sum(ka * ka + kb * kb) / 96.f + EPSN);
      ka *= invk * gk_[lane]; kb *= invk * (lane < 32 ? gk_[64 + lane] : 0.f);
      { float other = __shfl_xor(kb, 16); float rr = (lane & 16) ? (other * sn_m + kb * cs_m) : (kb * cs_m - other * sn_m); kb = rr; }
      B.mk[row * 384 + h * 96 + lane] = f2bf(ka); if (lane < 32) B.mk[row * 384 + h * 96 + 64 + lane] = f2bf(kb);
      vbuf[(h * 64 + lane) * 66 + rl] = f2bf(ckv * ldbf(B.tkv + row * 512 + h * 128 + 64 + lane));
    }
    float cs_g = 1.f, sn_g = 0.f;
    { int j = lane & 31; int pos = j < 16 ? lr / 64 : lr % 64; float ang = (float)pos * powf(10000.f, -(float)(j & 15) / 16.f); if (lat) { cs_g = cosf(ang); sn_g = sinf(ang); } }
#pragma unroll
    for (int h = 0; h < 8; ++h) {
      float x = ldbf(Pr + GQA_OFF + h * 64 + lane);
      float inv = __builtin_amdgcn_rsqf(wave_sum(x * x) / 64.f + EPSN);
      x *= inv * W.gqa_qk_g[(h < 6 ? 0 : 64) + lane];
      float other = __shfl_xor(x, 32); float rr = (lane & 32) ? (other * sn_g + x * cs_g) : (x * cs_g - other * sn_g);
      if (h < 6) B.gq[row * 384 + h * 64 + lane] = f2bf(rr * 0.18033688f); else B.gk[row * 128 + (h - 6) * 64 + lane] = f2bf(rr);
    }
#pragma unroll
    for (int hk = 0; hk < 2; ++hk) vbuf[((4 + hk) * 64 + lane) * 66 + rl] = Pr[GQA_OFF + 512 + hk * 64 + lane];
    const bool first = (lr == 0) || (lr == SEQ), last = (lr == SEQ - 1) || (lr == RB - 1);
#pragma unroll
    for (int h = 0; h < 6; ++h) {
      float xs3[3];
#pragma unroll
      for (int part = 0; part < 3; ++part) {
        int c = part * 384 + h * 64 + lane; const bf16_t* pp = Pr + RW_OFF + c;
        float p = ldbf(pp), pv = first ? 0.f : ldbf(pp - IN_COLS), nx = last ? 0.f : ldbf(pp + IN_COLS);
        xs3[part] = p + W.mu[c] * (pv - p) + W.mu[RWC + c] * (nx - p);
      }
      const int c = h * 64 + lane; const long o = row * 384 + c;
      float kv = xs3[1]; float tk = kv * W.k_k[c]; float kkv = tk * __builtin_amdgcn_rsqf(wave_sum(tk * tk) + 1e-12f);
      B.r_b[o] = f2bf(xs3[0]); B.v_b[o] = f2bf(xs3[2]); B.kk_b[o] = f2bf(kkv);
#pragma unroll
      for (int d = 0; d < 2; ++d) { float a = ldbf(B.a_b + d * MA * 384 + o); B.kd_b[d * MA * 384 + o] = f2bf(kv * (1.f + (a - 1.f) * W.k_a[c])); B.bd_b[d * MA * 384 + o] = f2bf(kkv * a); }
    }
  }
  __syncthreads();
  for (int i = t; i < 384 * 32; i += 256) {
    int rr = i >> 5, w2 = i & 31; int slot = rr >> 6, d = rr & 63;
    unsigned val = *(const unsigned*)(vbuf + rr * 66 + w2 * 2);
    bf16_t* dst = slot < 4 ? B.mvT + ((long)(b * 4 + slot) * 64 + d) * RB : B.gvT + ((long)(b * 2 + (slot - 4)) * 64 + d) * RB;
    *(unsigned*)(dst + lr0 + w2 * 2) = val;
  }
  __syncthreads();
}
__global__ void __launch_bounds__(256) ok_prep_finish(FinW W, FinBuf B) {
  __shared__ __attribute__((aligned(16))) char smem[FIN_LDS_BYTES];
  for (int tile = blockIdx.x; tile < NROWS / 64; tile += gridDim.x) prep_finish_tile(W, B, tile, smem);
}
struct RdW { const float *r_k, *ln_g, *ln_b; };
__device__ __forceinline__ void rw_readout_row(const RdW& W, const float* __restrict__ y, const bf16_t* __restrict__ r_b, const bf16_t* __restrict__ v_b, const bf16_t* __restrict__ kd_b,
                                               const bf16_t* __restrict__ g_b, bf16_t* __restrict__ mixall, long row, int lane) {
  const long MA = NROWS;
#pragma unroll
  for (int h = 0; h < 6; ++h) {
    const int c = h * 64 + lane; const long o = row * 384 + c;
    float yy = y[o] + y[MA * 384 + o];
    float mean = wave_sum(yy) * (1.f / 64.f); float dv = yy - mean; float var = wave_sum(dv * dv) * (1.f / 64.f);
    float coef = wave_sum(ldbf(r_b + o) * (ldbf(kd_b + o) + ldbf(kd_b + MA * 384 + o)) * W.r_k[c]);
    float yn = dv * __builtin_amdgcn_rsqf(var + 64e-5f) * W.ln_g[c] + W.ln_b[c];
    mixall[row * DM + 256 + c] = f2bf((yn + coef * ldbf(v_b + o)) * ldbf(g_b + o));
  }
}
__global__ void __launch_bounds__(256) ok_rw_readout(RdW W, const float* y, const bf16_t* r_b, const bf16_t* v_b, const bf16_t* kd_b, const bf16_t* g_b, bf16_t* mixall) {
  for (long row = blockIdx.x * 4 + (threadIdx.x >> 6); row < NROWS; row += gridDim.x * 4) rw_readout_row(W, y, r_b, v_b, kd_b, g_b, mixall, row, threadIdx.x & 63);
}

__device__ __forceinline__ void ph_cvt_fp8_rows(const float* __restrict__ tab, unsigned char* __restrict__ q, float* __restrict__ scale, int r0 = -1, int r1 = 0) {
  const int t = tid_opaque(); const int lane = t & 63;
  const int rbeg = r0 < 0 ? (int)blockIdx.x * 4 + (t >> 6) : r0 + (t >> 6), rend = r0 < 0 ? 16384 : r1, rstep = r0 < 0 ? (int)gridDim.x * 4 : 4;
  for (int row = rbeg; row < rend; row += rstep) {
    const float* src = tab + (long)row * DM + lane * 16;
    f32x4 a[4]; float m = 0.f;
#pragma unroll
    for (int i = 0; i < 4; ++i) { a[i] = *(const f32x4*)(src + 4 * i); m = fmaxf(m, fmaxf(fmaxf(fabsf(a[i][0]), fabsf(a[i][1])), fmaxf(fabsf(a[i][2]), fabsf(a[i][3])))); }
#pragma unroll
    for (int o = 32; o > 0; o >>= 1) m = fmaxf(m, __shfl_xor(m, o));
    const float sc = m > 0.f ? m * (1.f / 440.f) : 1.f; const float inv = 1.f / sc;
    u32x4 p;
#pragma unroll
    for (int i = 0; i < 4; ++i) { int w = __builtin_amdgcn_cvt_pk_fp8_f32(a[i][0] * inv, a[i][1] * inv, 0, false); w = __builtin_amdgcn_cvt_pk_fp8_f32(a[i][2] * inv, a[i][3] * inv, w, true); p[i] = (unsigned)w; }
    *(u32x4*)(q + (long)row * DM + lane * 16) = p;
    if (lane == 0) scale[row] = sc;
  }
}
__device__ __forceinline__ float dot16_fp8(const float (&h)[16], u32x4 q) {
  float a = 0.f;
#pragma unroll
  for (int d = 0; d < 4; ++d) {
    f32v2 lo = __builtin_amdgcn_cvt_pk_f32_fp8((int)q[d], false), hi = __builtin_amdgcn_cvt_pk_f32_fp8((int)q[d], true);
    a += h[4*d] * lo[0]; a += h[4*d+1] * lo[1]; a += h[4*d+2] * hi[0]; a += h[4*d+3] * hi[1];
  }
  return a;
}
__device__ __forceinline__ void axpy16_fp8(float (&o)[16], float w, u32x4 q) {
#pragma unroll
  for (int d = 0; d < 4; ++d) {
    f32v2 lo = __builtin_amdgcn_cvt_pk_f32_fp8((int)q[d], false), hi = __builtin_amdgcn_cvt_pk_f32_fp8((int)q[d], true);
    o[4*d] += w * lo[0]; o[4*d+1] += w * lo[1]; o[4*d+2] += w * hi[0]; o[4*d+3] += w * hi[1];
  }
}
__device__ __forceinline__ void peer_gather_group_fp8(const bf16_t* __restrict__ xn, const unsigned* __restrict__ top1, const unsigned char* __restrict__ ub, const float* __restrict__ su,
                                                      const unsigned char* __restrict__ vb, const float* __restrict__ sv, const float* __restrict__ modl, float* __restrict__ xs, int grp, char* smem) {
  const int t = tid_opaque(), lane = t & 63, wave = t >> 6;
  int* pe_l = (int*)smem; float* pg_l = (float*)(smem + 32 * 128 * 4); float* pw_l = (float*)(smem + 2 * 32 * 128 * 4);
  {
    int tl = t >> 3, p = t & 7; long row = (long)grp * 32 + tl;
    peer_combine(top1 + (row * 16 + p * 2) * 16, top1 + (row * 16 + p * 2 + 1) * 16, pe_l + tl * 128 + p * 16, pg_l + tl * 128 + p * 16);
  }
  __syncthreads();
  for (int ti = 0; ti < 8; ++ti) {
    const int tl = wave * 8 + ti; const long row = (long)grp * 32 + tl;
    const int* pe = pe_l + tl * 128; float* pw = pw_l + tl * 128;
    float h[16];
    { u32x4 h0 = *(const u32x4*)(xn + row * DM + lane * 16), h1 = *(const u32x4*)(xn + row * DM + lane * 16 + 8);
#pragma unroll
      for (int e = 0; e < 4; ++e) { h[2*e] = __uint_as_float(h0[e] << 16); h[2*e+1] = __uint_as_float(h0[e] & 0xffff0000u); h[8+2*e] = __uint_as_float(h1[e] << 16); h[8+2*e+1] = __uint_as_float(h1[e] & 0xffff0000u); } }
    u32x4 u[8];
#pragma unroll
    for (int j = 0; j < 8; ++j) u[j] = *(const u32x4*)(ub + (long)pe[j] * DM + lane * 16);
    for (int b = 0; b < 16; ++b) {
      float pd[8];
#pragma unroll
      for (int j = 0; j < 8; ++j) pd[j] = dot16_fp8(h, u[j]);
      if (b + 1 < 16) {
#pragma unroll
        for (int j = 0; j < 8; ++j) u[j] = *(const u32x4*)(ub + (long)pe[(b + 1) * 8 + j] * DM + lane * 16);
      }
      float q4[4], q2[2], q1;
#pragma unroll
      for (int j = 0; j < 4; ++j) { bool hi = lane & 1; float keep = hi ? pd[2*j+1] : pd[2*j], send = hi ? pd[2*j] : pd[2*j+1]; q4[j] = keep + __shfl_xor(send, 1); }
#pragma unroll
      for (int j = 0; j < 2; ++j) { bool hi = lane & 2; float keep = hi ? q4[2*j+1] : q4[2*j], send = hi ? q4[2*j] : q4[2*j+1]; q2[j] = keep + __shfl_xor(send, 2); }
      { bool hi = lane & 4; float keep = hi ? q2[1] : q2[0], send = hi ? q2[0] : q2[1]; q1 = keep + __shfl_xor(send, 4); }
      q1 += __shfl_xor(q1, 8); q1 += __shfl_xor(q1, 16); q1 += __shfl_xor(q1, 32);
      if (lane < 8) pw[b * 8 + lane] = q1 * su[pe[b * 8 + lane]];
    }
    u32x4 v[8];
#pragma unroll
    for (int j = 0; j < 8; ++j) v[j] = *(const u32x4*)(vb + (long)pe[j] * DM + lane * 16);
    {
      float d0 = pw[lane], d1 = pw[64 + lane];
      pw[lane] = pg_l[tl * 128 + lane] * fgelu_(d0) * sv[pe[lane]]; pw[64 + lane] = pg_l[tl * 128 + 64 + lane] * fgelu_(d1) * sv[pe[64 + lane]];
    }
    float o[16];
#pragma unroll
    for (int e = 0; e < 16; ++e) o[e] = 0.f;
    for (int b = 0; b < 16; ++b) {
      u32x4 vc[8];
#pragma unroll
      for (int j = 0; j < 8; ++j) vc[j] = v[j];
      if (b + 1 < 16) {
#pragma unroll
        for (int j = 0; j < 8; ++j) v[j] = *(const u32x4*)(vb + (long)pe[(b + 1) * 8 + j] * DM + lane * 16);
      }
#pragma unroll
      for (int j = 0; j < 8; ++j) axpy16_fp8(o, pw[b * 8 + j], vc[j]);
    }
    {
      int b = row / RB, lr = row % RB; int bb = lr < SEQ ? b : BATCH; const float* g5 = modl + ((long)bb * 6 + 5) * DM + lane * 16;
      float* xr = xs + row * DM + lane * 16;
#pragma unroll
      for (int i = 0; i < 4; ++i) {
        f32x4 x = *(f32x4*)(xr + 4 * i); f32x4 g = *(const f32x4*)(g5 + 4 * i);
        x[0] += g[0] * o[4*i]; x[1] += g[1] * o[4*i+1]; x[2] += g[2] * o[4*i+2]; x[3] += g[3] * o[4*i+3];
        *(f32x4*)(xr + 4 * i) = x;
      }
    }
  }
}

__device__ __forceinline__ float reduce16(float x) { x = reduce8(x); x += dpp_get<0x140>(x); return x; }
__device__ __forceinline__ void unpack8(u32x4 v, float (&f)[8]) {
#pragma unroll
  for (int e = 0; e < 4; ++e) { f[2*e] = __uint_as_float(v[e] << 16); f[2*e+1] = __uint_as_float(v[e] & 0xffff0000u); }
}
__device__ __forceinline__ u32x4 pack8(const float (&f)[8]) { u32x4 o;
#pragma unroll
  for (int e = 0; e < 4; ++e) o[e] = pack2bf(f[2*e], f[2*e+1]);
  return o; }
__device__ __forceinline__ void ph_rope_tables(float* rope_g, float* rope_m) {
  const int t = tid_opaque();
  for (int i = blockIdx.x * 256 + t; i < SEQ * 48; i += gridDim.x * 256) {
    int lr = i / 48, j = i % 48;
    if (j < 32) { int pos = j < 16 ? lr / 64 : lr % 64; float ang = (float)pos * powf(10000.f, -(float)(j & 15) / 16.f); rope_g[(lr * 32 + j) * 2] = cosf(ang); rope_g[(lr * 32 + j) * 2 + 1] = sinf(ang); }
    else { int jj = j - 32; int pos = jj < 8 ? lr / 64 : lr % 64; float ang = (float)pos * powf(10000.f, -(float)(jj & 7) / 8.f); rope_m[(lr * 16 + jj) * 2] = cosf(ang); rope_m[(lr * 16 + jj) * 2 + 1] = sinf(ang); }
  }
}
struct FinW2 { const float *mla_qk_g, *gqa_qk_g, *mu, *k_k, *k_a, *rope_g, *rope_m; };
#define FIN2_LDS_BYTES (64 * 384 * 2)
struct FinRow { u32x4 gqa, mla, vraw, rw[3][3], ab[2]; uint2 tqa, tkva; unsigned tqr, kr; };
__device__ __forceinline__ void fin_row_load(FinRow& R, const FinBuf& B, long row, int lr, int lane) {
  const long MA = NROWS; const int g8 = lane & 7, h8 = lane >> 3, s16 = lane & 15, h16 = lane >> 4;
  const bf16_t* Pr = B.P + row * IN_COLS; const u32x4 z = {0u, 0u, 0u, 0u};
  R.gqa = *(const u32x4*)(Pr + GQA_OFF + lane * 8);
  R.mla = lane < 48 ? *(const u32x4*)(Pr + lane * 8) : z;
  R.tqa = *(const uint2*)(B.tq + row * 384 + h16 * 96 + s16 * 4); R.tqr = *(const unsigned*)(B.tq + row * 384 + h16 * 96 + 64 + s16 * 2);
  R.tkva = *(const uint2*)(B.tkv + row * 512 + h16 * 128 + s16 * 4);
  R.kr = *(const unsigned*)(Pr + 384 + s16 * 2);
  R.vraw = lane < 32 ? *(const u32x4*)(B.tkv + row * 512 + h8 * 128 + 64 + g8 * 8) : (lane < 48 ? *(const u32x4*)(Pr + GQA_OFF + 512 + (lane - 32) * 8) : z);
  const bool first = (lr == 0) || (lr == SEQ), last = (lr == SEQ - 1) || (lr == RB - 1);
#pragma unroll
  for (int part = 0; part < 3; ++part) {
    const bf16_t* pp = Pr + RW_OFF + part * 384 + (lane < 48 ? lane : 0) * 8;
    R.rw[part][0] = *(const u32x4*)pp; R.rw[part][1] = first ? z : *(const u32x4*)(pp - IN_COLS); R.rw[part][2] = last ? z : *(const u32x4*)(pp + IN_COLS);
  }
  const long o = row * 384 + (lane < 48 ? lane : 0) * 8;
  R.ab[0] = *(const u32x4*)(B.a_b + o); R.ab[1] = *(const u32x4*)(B.a_b + MA * 384 + o);
}
__device__ __forceinline__ void prep_finish_tile2(const FinW2& W, const FinBuf& B, int tile, char* smem) {
  const int t = tid_opaque(), lane = t & 63, wave = t >> 6; const long MA = NROWS;
  bf16_t* vbuf = (bf16_t*)smem;
  const long row0 = (long)tile * 8; const int b = row0 / RB; const int lr0 = row0 % RB;
  const int g8 = lane & 7, h8 = lane >> 3, s16 = lane & 15, h16 = lane >> 4;
  FinRow RR[2];
  fin_row_load(RR[0], B, row0 + wave, lr0 + wave, lane);
  fin_row_load(RR[1], B, row0 + 4 + wave, lr0 + 4 + wave, lane);
#pragma unroll
  for (int it = 0; it < 2; ++it) {
    const FinRow& R = RR[it];
    const int rl = it * 4 + wave; const long row = row0 + rl; const int lr = lr0 + rl; const bool lat = lr < SEQ;
    {
      float x[8]; unpack8(R.gqa, x);
      float ss = 0.f;
#pragma unroll
      for (int e = 0; e < 8; ++e) ss += x[e] * x[e];
      ss = reduce8(ss); const float inv = __builtin_amdgcn_rsqf(ss * (1.f / 64.f) + EPSN);
      const float* gp = W.gqa_qk_g + (h8 < 6 ? 0 : 64) + g8 * 8; f32x4 ga = *(const f32x4*)gp, gb = *(const f32x4*)(gp + 4);
#pragma unroll
      for (int e = 0; e < 4; ++e) { x[e] *= inv * ga[e]; x[4 + e] *= inv * gb[e]; }
      float o[8];
      if (lat) {
        const float* rt = W.rope_g + ((long)lr * 32 + (g8 & 3) * 8) * 2;
#pragma unroll
        for (int e = 0; e < 8; ++e) { float ot = swz_xor4(x[e]); float cs = rt[2 * e], sn = rt[2 * e + 1]; o[e] = (g8 & 4) ? (ot * sn + x[e] * cs) : (x[e] * cs - ot * sn); }
      } else {
#pragma unroll
        for (int e = 0; e < 8; ++e) o[e] = x[e];
      }
      if (h8 < 6) {
#pragma unroll
        for (int e = 0; e < 8; ++e) o[e] *= 0.18033688f;
        *(u32x4*)(B.gq + row * 384 + lane * 8) = pack8(o);
      } else *(u32x4*)(B.gk + row * 128 + (lane - 48) * 8) = pack8(o);
    }
    float cq, ckv;
    {
      float ss = 0.f;
      { float x[8]; unpack8(R.mla, x);
#pragma unroll
        for (int e = 0; e < 8; ++e) ss += x[e] * x[e]; }
      float sq = wave_sum(lane < 32 ? ss : 0.f), skv = wave_sum(lane >= 32 ? ss : 0.f);
      cq = __builtin_amdgcn_rsqf(sq * (1.f / 256.f) + EPSN); ckv = __builtin_amdgcn_rsqf(skv * (1.f / 128.f) + EPSN);
    }
    {
      float cs0 = 1.f, sn0 = 0.f, cs1 = 1.f, sn1 = 0.f;
      if (lat) { f32x4 r4 = *(const f32x4*)(W.rope_m + ((long)lr * 16 + (s16 & 7) * 2) * 2); cs0 = r4[0]; sn0 = r4[1]; cs1 = r4[2]; sn1 = r4[3]; }
      const float kr0 = __uint_as_float(R.kr << 16), kr1 = __uint_as_float(R.kr & 0xffff0000u);
#pragma unroll
      for (int which = 0; which < 2; ++which) {
        float n[4], r0, r1;
        if (which == 0) {
          const uint2 a = R.tqa; const unsigned rr = R.tqr;
          n[0] = cq * __uint_as_float(a.x << 16); n[1] = cq * __uint_as_float(a.x & 0xffff0000u); n[2] = cq * __uint_as_float(a.y << 16); n[3] = cq * __uint_as_float(a.y & 0xffff0000u);
          r0 = cq * __uint_as_float(rr << 16); r1 = cq * __uint_as_float(rr & 0xffff0000u);
        } else {
          const uint2 a = R.tkva;
          n[0] = ckv * __uint_as_float(a.x << 16); n[1] = ckv * __uint_as_float(a.x & 0xffff0000u); n[2] = ckv * __uint_as_float(a.y << 16); n[3] = ckv * __uint_as_float(a.y & 0xffff0000u);
          r0 = kr0; r1 = kr1;
        }
        float ss = n[0]*n[0] + n[1]*n[1] + n[2]*n[2] + n[3]*n[3] + r0*r0 + r1*r1;
        ss = reduce16(ss); const float inv = __builtin_amdgcn_rsqf(ss * (1.f / 96.f) + EPSN);
        const float* gp = W.mla_qk_g + which * 96; f32x4 gn = *(const f32x4*)(gp + s16 * 4); const float g0 = gp[64 + s16 * 2], g1 = gp[64 + s16 * 2 + 1];
#pragma unroll
        for (int e = 0; e < 4; ++e) n[e] *= inv * gn[e];
        r0 *= inv * g0; r1 *= inv * g1;
        float o0 = dpp_get<0x128>(r0), o1 = dpp_get<0x128>(r1);
        float q0, q1;
        if (s16 & 8) { q0 = o0 * sn0 + r0 * cs0; q1 = o1 * sn1 + r1 * cs1; } else { q0 = r0 * cs0 - o0 * sn0; q1 = r1 * cs1 - o1 * sn1; }
        const float sc = which == 0 ? 0.14724445f : 1.f;
        bf16_t* dst = (which == 0 ? B.mq : B.mk) + row * 384 + h16 * 96;
        uint2 pk; pk.x = pack2bf(n[0] * sc, n[1] * sc); pk.y = pack2bf(n[2] * sc, n[3] * sc);
        *(uint2*)(dst + s16 * 4) = pk; *(unsigned*)(dst + 64 + s16 * 2) = pack2bf(q0 * sc, q1 * sc);
      }
      if (lane < 32) { float x[8]; unpack8(R.vraw, x);
#pragma unroll
        for (int e = 0; e < 8; ++e) x[e] *= ckv;
        *(u32x4*)(vbuf + rl * 384 + h8 * 64 + g8 * 8) = pack8(x); }
      else if (lane < 48) *(u32x4*)(vbuf + rl * 384 + 256 + (lane - 32) * 8) = R.vraw;
    }
    if (lane < 48) {
      const long o = row * 384 + lane * 8;
      float xs3[3][8];
#pragma unroll
      for (int part = 0; part < 3; ++part) {
        const int c = part * 384 + lane * 8;
        float p[8], pv[8], nx[8]; unpack8(R.rw[part][0], p); unpack8(R.rw[part][1], pv); unpack8(R.rw[part][2], nx);
        f32x4 m0a = *(const f32x4*)(W.mu + c), m0b = *(const f32x4*)(W.mu + c + 4), m1a = *(const f32x4*)(W.mu + RWC + c), m1b = *(const f32x4*)(W.mu + RWC + c + 4);
#pragma unroll
        for (int e = 0; e < 4; ++e) { xs3[part][e] = p[e] + m0a[e] * (pv[e] - p[e]) + m1a[e] * (nx[e] - p[e]); xs3[part][4+e] = p[4+e] + m0b[e] * (pv[4+e] - p[4+e]) + m1b[e] * (nx[4+e] - p[4+e]); }
      }
      *(u32x4*)(B.r_b + o) = pack8(xs3[0]); *(u32x4*)(B.v_b + o) = pack8(xs3[2]);
      f32x4 kka = *(const f32x4*)(W.k_k + lane * 8), kkb = *(const f32x4*)(W.k_k + lane * 8 + 4), kaa = *(const f32x4*)(W.k_a + lane * 8), kab = *(const f32x4*)(W.k_a + lane * 8 + 4);
      float tk[8], ss = 0.f;
#pragma unroll
      for (int e = 0; e < 4; ++e) { tk[e] = xs3[1][e] * kka[e]; tk[4+e] = xs3[1][4+e] * kkb[e]; }
#pragma unroll
      for (int e = 0; e < 8; ++e) ss += tk[e] * tk[e];
      ss = reduce8(ss); const float invk = __builtin_amdgcn_rsqf(ss + 1e-12f);
#pragma unroll
      for (int e = 0; e < 8; ++e) tk[e] *= invk;
      *(u32x4*)(B.kk_b + o) = pack8(tk);
#pragma unroll
      for (int d = 0; d < 2; ++d) {
        float a[8], kd[8], bd[8]; unpack8(R.ab[d], a);
#pragma unroll
        for (int e = 0; e < 8; ++e) { float ka = e < 4 ? kaa[e] : kab[e - 4]; kd[e] = xs3[1][e] * (1.f + (a[e] - 1.f) * ka); bd[e] = tk[e] * a[e]; }
        *(u32x4*)(B.kd_b + d * MA * 384 + o) = pack8(kd); *(u32x4*)(B.bd_b + d * MA * 384 + o) = pack8(bd);
      }
    } else { (void)reduce8(0.f); }
  }
  __syncthreads();
  for (int i = t; i < 384; i += 256) {
    int c = i % 384, rc = i / 384;
    unsigned short v8[8];
#pragma unroll
    for (int e = 0; e < 8; ++e) v8[e] = vbuf[(rc * 8 + e) * 384 + c];
    u32x4 o; o[0] = v8[0] | ((unsigned)v8[1] << 16); o[1] = v8[2] | ((unsigned)v8[3] << 16); o[2] = v8[4] | ((unsigned)v8[5] << 16); o[3] = v8[6] | ((unsigned)v8[7] << 16);
    bf16_t* dst = c < 256 ? B.mvT + ((long)(b * 4 + (c >> 6)) * 64 + (c & 63)) * RB : B.gvT + ((long)(b * 2 + ((c - 256) >> 6)) * 64 + (c & 63)) * RB;
    *(u32x4*)(dst + lr0 + rc * 8) = o;
  }
  __syncthreads();
}
__device__ __forceinline__ void rw_readout_row2(const RdW& W, const float* __restrict__ y, const bf16_t* __restrict__ r_b, const bf16_t* __restrict__ v_b, const bf16_t* __restrict__ kd_b,
                                                const bf16_t* __restrict__ g_b, bf16_t* __restrict__ mixall, long row, int lane) {
  const long MA = NROWS;
  float yy[8], s = 0.f; float r[8], k0[8], k1[8], vv[8], gg[8];
  const int c = lane * 8; const long o = row * 384 + c;
  if (lane < 48) {
    f32x4 a0 = *(const f32x4*)(y + o), a1 = *(const f32x4*)(y + o + 4), b0 = *(const f32x4*)(y + MA * 384 + o), b1 = *(const f32x4*)(y + MA * 384 + o + 4);
#pragma unroll
    for (int e = 0; e < 4; ++e) { yy[e] = a0[e] + b0[e]; yy[4+e] = a1[e] + b1[e]; }
    unpack8(*(const u32x4*)(r_b + o), r); unpack8(*(const u32x4*)(kd_b + o), k0); unpack8(*(const u32x4*)(kd_b + MA * 384 + o), k1);
    unpack8(*(const u32x4*)(v_b + o), vv); unpack8(*(const u32x4*)(g_b + o), gg);
  } else {
#pragma unroll
    for (int e = 0; e < 8; ++e) { yy[e] = 0.f; r[e] = 0.f; k0[e] = 0.f; k1[e] = 0.f; vv[e] = 0.f; gg[e] = 0.f; }
  }
#pragma unroll
  for (int e = 0; e < 8; ++e) s += yy[e];
  const float mean = reduce8(s) * (1.f / 64.f);
  float vs = 0.f, cf = 0.f;
  const int cc = lane < 48 ? c : 0;
  f32x4 rk0 = *(const f32x4*)(W.r_k + cc), rk1 = *(const f32x4*)(W.r_k + cc + 4);
#pragma unroll
  for (int e = 0; e < 8; ++e) { float d = yy[e] - mean; vs += d * d; cf += r[e] * (k0[e] + k1[e]) * (e < 4 ? rk0[e] : rk1[e - 4]); }
  const float var = reduce8(vs) * (1.f / 64.f), coef = reduce8(cf);
  const float inv = __builtin_amdgcn_rsqf(var + 64e-5f);
  if (lane < 48) {
    f32x4 lg0 = *(const f32x4*)(W.ln_g + c), lg1 = *(const f32x4*)(W.ln_g + c + 4), lb0 = *(const f32x4*)(W.ln_b + c), lb1 = *(const f32x4*)(W.ln_b + c + 4);
    float out[8];
#pragma unroll
    for (int e = 0; e < 8; ++e) { float yn = (yy[e] - mean) * inv * (e < 4 ? lg0[e] : lg1[e - 4]) + (e < 4 ? lb0[e] : lb1[e - 4]); out[e] = (yn + coef * vv[e]) * gg[e]; }
    *(u32x4*)(mixall + row * DM + 256 + c) = pack8(out);
  }
}

#define PG_NT 4
#define PG_TOK (4 * PG_NT)
#define PG_OFF_H 0
#define PG_OFF_E (PG_TOK * 2048)
#define PG_OFF_G (PG_OFF_E + PG_TOK * 128 * 2)
#define PG_OFF_ST (PG_OFF_G + PG_TOK * 128 * 4)
#define PG_OFF_CNT (PG_OFF_ST + PG_TOK * 18 * 2)
#define PG_LDS_BYTES (PG_OFF_CNT + PG_TOK * 8 * 16 * 2)
__device__ __forceinline__ long pg_row(int g, int ntok) { return ntok == NROWS ? (long)g : (long)(g / SEQ) * RB + (g % SEQ); }
__device__ __forceinline__ void peer_gather_sliced(const bf16_t* __restrict__ xn, const unsigned* __restrict__ top1, const unsigned char* __restrict__ ub, const float* __restrict__ su,
                                                   const unsigned char* __restrict__ vb, const float* __restrict__ sv, const float* __restrict__ modl, float* __restrict__ xs,
                                                   int ntok, char* smem, const float* __restrict__ ng, const float* __restrict__ nmod, bf16_t* __restrict__ xn_next, float* __restrict__ out, bool dry = false, unsigned emask = 0x3FFFu) {
  bf16_t* hs = (bf16_t*)(smem + PG_OFF_H); unsigned short* se = (unsigned short*)(smem + PG_OFF_E); float* sg = (float*)(smem + PG_OFF_G);
  unsigned short* sst = (unsigned short*)(smem + PG_OFF_ST); unsigned short* cnt = (unsigned short*)(smem + PG_OFF_CNT);
  const int per_block = (ntok + (int)gridDim.x - 1) / (int)gridDim.x;
  const int npass = (per_block + PG_TOK - 1) / PG_TOK; const int tpp = (per_block + npass - 1) / npass;
  for (int pass = 0; pass < npass; ++pass) {
    const int t = tid_opaque(), lane = t & 63, wave = t >> 6;
    __syncthreads();
    for (int i = t; i < PG_TOK * 8 * 16; i += 256) cnt[i] = 0;
    for (int i = t; i < PG_TOK * 128; i += 256) {
      int tl = i >> 7, ch = i & 127; int q = (tl % PG_NT) * 4 + tl / PG_NT; int idx = pass * tpp + q; int g = (int)blockIdx.x + idx * (int)gridDim.x;
      u32x4 v = {0u, 0u, 0u, 0u};
      if (q < tpp && idx < per_block && g < ntok) v = *(const u32x4*)(xn + pg_row(g, ntok) * DM + ch * 8);
      *(u32x4*)(hs + tl * 1024 + ch * 8) = v;
    }
    __syncthreads();
    int my_e[16]; float my_g[16];
    const int ctl = t >> 3, cp = t & 7;
    bool cact = false;
    if (ctl < PG_TOK) {
      int q = (ctl % PG_NT) * 4 + ctl / PG_NT; int idx = pass * tpp + q; int g = (int)blockIdx.x + idx * (int)gridDim.x;
      cact = q < tpp && idx < per_block && g < ntok;
      if (cact) {
        long row = pg_row(g, ntok);
        peer_combine(top1 + (row * 16 + cp * 2) * 16, top1 + (row * 16 + cp * 2 + 1) * 16, my_e, my_g);
#pragma unroll
        for (int k = 0; k < 16; ++k) cnt[(ctl * 8 + cp) * 16 + (my_e[k] >> 10)] += 1;
      }
    }
    __syncthreads();
    if (t < PG_TOK) {
      int run = 0;
      for (int s = 0; s < 16; ++s) {
        sst[t * 18 + s] = (unsigned short)run;
        for (int h = 0; h < 8; ++h) { int c = cnt[(t * 8 + h) * 16 + s]; cnt[(t * 8 + h) * 16 + s] = (unsigned short)run; run += c; }
      }
      sst[t * 18 + 16] = (unsigned short)run;
    }
    __syncthreads();
    if (cact) {
#pragma unroll
      for (int k = 0; k < 16; ++k) { int s = my_e[k] >> 10; int pos = cnt[(ctl * 8 + cp) * 16 + s]; cnt[(ctl * 8 + cp) * 16 + s] = (unsigned short)(pos + 1); se[ctl * 128 + pos] = (unsigned short)my_e[k]; sg[ctl * 128 + pos] = my_g[k]; }
    }
    __syncthreads();
    float acc[PG_NT][16];
#pragma unroll
    for (int tk = 0; tk < PG_NT; ++tk)
#pragma unroll
      for (int e = 0; e < 16; ++e) acc[tk][e] = 0.f;
    for (int s = 0; s < 16; ++s) {
#pragma unroll
      for (int tk = 0; tk < PG_NT; ++tk) {
        const int tl = wave * PG_NT + tk;
        const int st = sst[tl * 18 + s], en = sst[tl * 18 + s + 1];
        for (int base = st; base < en; base += 8) {
          const int nb = en - base < 8 ? en - base : 8;
          u32x4 u[8], v[8];
#pragma unroll
          for (int j = 0; j < 8; ++j) if (j < nb) { const unsigned off = ((unsigned)se[tl * 128 + base + j] & emask) * 1024u + (unsigned)lane * 16u; u[j] = *(const u32x4*)(ub + off); v[j] = *(const u32x4*)(vb + off); }
          float h[16];
          { u32x4 h0 = *(const u32x4*)(hs + tl * 1024 + lane * 16), h1 = *(const u32x4*)(hs + tl * 1024 + lane * 16 + 8);
#pragma unroll
            for (int e = 0; e < 4; ++e) { h[2*e] = __uint_as_float(h0[e] << 16); h[2*e+1] = __uint_as_float(h0[e] & 0xffff0000u); h[8+2*e] = __uint_as_float(h1[e] << 16); h[8+2*e+1] = __uint_as_float(h1[e] & 0xffff0000u); } }
          float pd[8];
#pragma unroll
          for (int j = 0; j < 8; ++j) pd[j] = j < nb ? dot16_fp8(h, u[j]) : 0.f;
          float q4[4], q2[2], q1;
#pragma unroll
          for (int j = 0; j < 4; ++j) { bool hi = lane & 1; float keep = hi ? pd[2*j+1] : pd[2*j], send = hi ? pd[2*j] : pd[2*j+1]; q4[j] = keep + dpp_get<0xB1>(send); }
#pragma unroll
          for (int j = 0; j < 2; ++j) { bool hi = lane & 2; float keep = hi ? q4[2*j+1] : q4[2*j], send = hi ? q4[2*j] : q4[2*j+1]; q2[j] = keep + dpp_get<0x4E>(send); }
          { bool hi = lane & 4; float keep = hi ? q2[1] : q2[0], send = hi ? q2[0] : q2[1]; q1 = keep + xor4_get(send); }
          q1 += dpp_get<0x128>(q1);
          q1 = xor16_sum(q1);
          q1 = xor32_sum(q1);
          float w = 0.f;
          { const int jj = lane & 7; if (jj < nb) { int e = se[tl * 128 + base + jj]; w = sg[tl * 128 + base + jj] * fgelu_(q1 * su[e]) * sv[e]; } }
#pragma unroll
          for (int j = 0; j < 8; ++j) { float wj = __builtin_bit_cast(float, __builtin_amdgcn_readlane(__builtin_bit_cast(int, w), j)); if (j < nb) axpy16_fp8(acc[tk], wj, v[j]); }
        }
      }
    }
    if (dry) {
#pragma unroll
      for (int tk = 0; tk < PG_NT; ++tk)
#pragma unroll
        for (int e = 0; e < 16; ++e) asm volatile("" :: "v"(acc[tk][e]));
    }
#pragma unroll
    for (int tk = 0; tk < PG_NT; ++tk) {
      int q = tk * 4 + wave; int idx = pass * tpp + q; int g = (int)blockIdx.x + idx * (int)gridDim.x;
      if (!dry && q < tpp && idx < per_block && g < ntok) {
        long row = pg_row(g, ntok); int b = row / RB, lr = row % RB; int bb = lr < SEQ ? b : BATCH; const float* g5 = modl + ((long)bb * 6 + 5) * DM + lane * 16;
        float* xr = xs + row * DM + lane * 16;
        f32x4 xv[4]; float ss = 0.f;
#pragma unroll
        for (int i = 0; i < 4; ++i) {
          f32x4 x = *(f32x4*)(xr + 4 * i); f32x4 gg = *(const f32x4*)(g5 + 4 * i);
          x[0] += gg[0] * acc[tk][4*i]; x[1] += gg[1] * acc[tk][4*i+1]; x[2] += gg[2] * acc[tk][4*i+2]; x[3] += gg[3] * acc[tk][4*i+3];
          xv[i] = x; ss += x[0] * x[0] + x[1] * x[1] + x[2] * x[2] + x[3] * x[3];
        }
        if (out) {
          float* orow = out + ((long)b * SEQ + lr) * DM + lane * 16;
#pragma unroll
          for (int i = 0; i < 4; ++i) *(f32x4*)(orow + 4 * i) = xv[i];
        } else {
#pragma unroll
          for (int i = 0; i < 4; ++i) *(f32x4*)(xr + 4 * i) = xv[i];
          ss = wave_sum(ss); const float inv = __builtin_amdgcn_rsqf(ss * (1.f / DM) + EPSN);
          const float* sh = nmod + ((long)bb * 6 + 0) * DM + lane * 16; const float* sc = sh + DM; const float* gp = ng + lane * 16;
          u32x4 p0, p1;
#pragma unroll
          for (int i = 0; i < 4; ++i) { f32x4 g4 = *(const f32x4*)(gp + 4 * i), s4 = *(const f32x4*)(sc + 4 * i), h4 = *(const f32x4*)(sh + 4 * i);
            const float a0 = xv[i][0] * inv * g4[0] * (1.f + s4[0]) + h4[0], a1 = xv[i][1] * inv * g4[1] * (1.f + s4[1]) + h4[1];
            const float a2 = xv[i][2] * inv * g4[2] * (1.f + s4[2]) + h4[2], a3 = xv[i][3] * inv * g4[3] * (1.f + s4[3]) + h4[3];
            if (i < 2) { p0[2 * i] = pack2bf(a0, a1); p0[2 * i + 1] = pack2bf(a2, a3); } else { p1[2 * (i - 2)] = pack2bf(a0, a1); p1[2 * (i - 2) + 1] = pack2bf(a2, a3); } }
          *(u32x4*)(xn_next + row * DM + lane * 16) = p0; *(u32x4*)(xn_next + row * DM + lane * 16 + 8) = p1;
        }
      }
    }
  }
}

#define PG3_OFF_H 0
#define PG3_OFF_FE (12 * 2048)
#define PG3_OFF_FG (PG3_OFF_FE + 4 * 384 * 2)
#define PG3_OFF_FS (PG3_OFF_FG + 4 * 384 * 4)
#define PG3_OFF_BT (PG3_OFF_FS + 4 * 384 * 4)
#define PG3_OFF_CNT (PG3_OFF_BT + 4 * 160 * 4)
#define PG3_OFF_TOT (PG3_OFF_CNT + 4 * 512 * 2)
#define PG3_LDS_BYTES (PG3_OFF_TOT + 512)
#define PG3_REC_BYTES (384 * 2 + 384 * 4 + 384 * 4 + 160 * 4 + 16)
__device__ __forceinline__ void peer_lists_build3(const unsigned* __restrict__ top1, const float* __restrict__ su, const float* __restrict__ sv, char* __restrict__ gl, int ntok, char* smem) {
  unsigned short* fe = (unsigned short*)(smem + PG3_OFF_FE); float* fg = (float*)(smem + PG3_OFF_FG); float* fs = (float*)(smem + PG3_OFF_FS);
  unsigned* bt = (unsigned*)(smem + PG3_OFF_BT); unsigned short* cnt = (unsigned short*)(smem + PG3_OFF_CNT); unsigned short* tot = (unsigned short*)(smem + PG3_OFF_TOT);
  int* nbt = (int*)(smem + PG3_OFF_TOT + 320);
  const int per_block = (ntok + (int)gridDim.x - 1) / (int)gridDim.x;
  const int npass = (per_block + 11) / 12; const int tpp = (per_block + npass - 1) / npass;
  unsigned short* st_e = (unsigned short*)(smem + PG3_OFF_H); float* st_g = (float*)(smem + PG3_OFF_H + 2 * 96 * 16 * 2);
  const bool pre = npass <= 3;
  int my_e[16]; float my_g[16];
#pragma unroll
  for (int k = 0; k < 16; ++k) { my_e[k] = 0; my_g[k] = 0.f; }
  if (pre) {
    const int t = tid_opaque();
    __syncthreads();
    for (int j = t; j < npass * 96; j += 256) {
      const int pj = j / 96, rem = j % 96; const int ctl = rem >> 3, cp = rem & 7; const int cw = ctl / 3, ctk = ctl % 3;
      const int q = ctk * 4 + cw; const int idx = pj * tpp + q; const int g = (int)blockIdx.x + idx * (int)gridDim.x;
      if (q < tpp && idx < per_block && g < ntok) {
        int e_[16]; float g_[16];
        const long row = pg_row(g, ntok);
        peer_combine(top1 + (row * 16 + cp * 2) * 16, top1 + (row * 16 + cp * 2 + 1) * 16, e_, g_);
        if (pj == 0) {
#pragma unroll
          for (int k = 0; k < 16; ++k) { my_e[k] = e_[k]; my_g[k] = g_[k]; }
        } else {
          const int sj = (pj - 1) * 96 + rem;
#pragma unroll
          for (int k = 0; k < 16; ++k) { st_e[sj * 16 + k] = (unsigned short)e_[k]; st_g[sj * 16 + k] = g_[k]; }
        }
      }
    }
  }
  for (int pass = 0; pass < npass; ++pass) {
    const int t = tid_opaque();
    __syncthreads();
    for (int i = t; i < 4 * 512; i += 256) cnt[i] = 0;
    __syncthreads();
    const int ctl = t >> 3, cp = t & 7; const int cw = ctl / 3, ctk = ctl % 3;
    bool cact = false;
    float my_su[16], my_sv[16];
    if (ctl < 12) {
      int q = ctk * 4 + cw; int idx = pass * tpp + q; int g = (int)blockIdx.x + idx * (int)gridDim.x;
      cact = q < tpp && idx < per_block && g < ntok;
      if (cact) {
        if (!pre) {
          long row = pg_row(g, ntok);
          peer_combine(top1 + (row * 16 + cp * 2) * 16, top1 + (row * 16 + cp * 2 + 1) * 16, my_e, my_g);
        } else if (pass > 0) {
          const int sj = (pass - 1) * 96 + t;
#pragma unroll
          for (int k = 0; k < 16; ++k) { my_e[k] = st_e[sj * 16 + k]; my_g[k] = st_g[sj * 16 + k]; }
        }
#pragma unroll
        for (int k = 0; k < 16; ++k) { my_su[k] = su[my_e[k]]; my_sv[k] = sv[my_e[k]]; }
#pragma unroll
        for (int k = 0; k < 16; ++k) cnt[((cw * 16 + (my_e[k] >> 10)) * 4 + ctk) * 8 + cp] += 1;
      }
    }
    __syncthreads();
    unsigned short* tot2 = tot + 80;
    if (t < 64) {
      int w_ = t >> 4, s = t & 15; int ne = 0, nbk = 0;
      for (int tk = 0; tk < 3; ++tk) { int n = 0; for (int h = 0; h < 8; ++h) n += cnt[((w_ * 16 + s) * 4 + tk) * 8 + h]; ne += n; nbk += (n + 7) >> 3; }
      tot[w_ * 16 + s] = (unsigned short)ne; tot2[w_ * 16 + s] = (unsigned short)nbk;
    }
    __syncthreads();
    if (t < 64) {
      int w_ = t >> 4, s = t & 15; int run = 0, nb_ = 0;
      for (int i = 0; i < s; ++i) { run += tot[w_ * 16 + i]; nb_ += tot2[w_ * 16 + i]; }
      for (int tk = 0; tk < 3; ++tk) {
        int gstart = run;
        for (int h = 0; h < 8; ++h) { int ci = ((w_ * 16 + s) * 4 + tk) * 8 + h; int c = cnt[ci]; cnt[ci] = (unsigned short)run; run += c; }
        for (int b0 = gstart; b0 < run; b0 += 8) { int n = run - b0 < 8 ? run - b0 : 8; bt[w_ * 160 + nb_] = (unsigned)tk | ((unsigned)b0 << 4) | ((unsigned)n << 16); ++nb_; }
      }
      if (s == 15) { while (nb_ % 3) { bt[w_ * 160 + nb_] = 0u; ++nb_; } nbt[w_] = nb_; }
    }
    __syncthreads();
    if (cact) {
#pragma unroll
      for (int k = 0; k < 16; ++k) { int ci = ((cw * 16 + (my_e[k] >> 10)) * 4 + ctk) * 8 + cp; int pos = cnt[ci]; cnt[ci] = (unsigned short)(pos + 1);
        fe[cw * 384 + pos] = (unsigned short)my_e[k]; fg[cw * 384 + pos] = my_g[k] * my_sv[k]; fs[cw * 384 + pos] = my_su[k]; }
    }
    __syncthreads();
    char* rec = gl + ((long)blockIdx.x * 4 + pass) * 4 * PG3_REC_BYTES;
    for (int i = t; i < 4 * 48; i += 256) { int w_ = i / 48, c = i % 48; *(u32x4*)(rec + w_ * PG3_REC_BYTES + c * 16) = *(const u32x4*)((const char*)fe + w_ * 768 + c * 16); }
    for (int i = t; i < 4 * 96; i += 256) { int w_ = i / 96, c = i % 96; *(u32x4*)(rec + w_ * PG3_REC_BYTES + 768 + c * 16) = *(const u32x4*)((const char*)fg + w_ * 1536 + c * 16); }
    for (int i = t; i < 4 * 96; i += 256) { int w_ = i / 96, c = i % 96; *(u32x4*)(rec + w_ * PG3_REC_BYTES + 2304 + c * 16) = *(const u32x4*)((const char*)fs + w_ * 1536 + c * 16); }
    for (int i = t; i < 4 * 40; i += 256) { int w_ = i / 40, c = i % 40; *(u32x4*)(rec + w_ * PG3_REC_BYTES + 3840 + c * 16) = *(const u32x4*)((const char*)bt + w_ * 640 + c * 16); }
    if (t < 4) *(int*)(rec + t * PG3_REC_BYTES + 4480) = nbt[t];
  }
  __syncthreads();
}
__device__ __forceinline__ void pg3_issue(u32x4 (&B)[8], const unsigned char* __restrict__ tab, const unsigned short* we, unsigned desc, int lane) {
  const int base = (desc >> 4) & 0xFFF, nb = desc >> 16;
#pragma unroll
  for (int j = 0; j < 8; ++j) { const int jj = j < nb ? j : (nb > 0 ? nb - 1 : 0); const unsigned off = (unsigned)we[base + jj] * 1024u + (unsigned)lane * 16u; B[j] = *(const u32x4*)(tab + off); }
}
__device__ __forceinline__ void pg3_axpy8(float (&a)[16], const u32x4 (&V)[8], float w, int nb) {
#pragma unroll
  for (int j = 0; j < 8; ++j) { const float wj = __builtin_bit_cast(float, __builtin_amdgcn_readlane(__builtin_bit_cast(int, w), j)); if (j < nb) axpy16_fp8(a, wj, V[j]); }
}
__device__ __forceinline__ void pg3_step(u32x4 (&U)[8], u32x4 (&V)[8], u32x4 (&F)[8], int k, int nbat, float (&acc)[3][16],
                                         const unsigned char* __restrict__ ub, const unsigned char* __restrict__ vb,
                                         const unsigned short* we, const float* wg, const float* wsc, const unsigned* wb, const bf16_t* hw, int lane) {
  const unsigned desc = __builtin_amdgcn_readfirstlane(wb[k]);
  const int tk = desc & 15, base = (desc >> 4) & 0xFFF, nb = desc >> 16;
  const unsigned dnext = __builtin_amdgcn_readfirstlane(wb[k + 1 < nbat ? k + 1 : k]);
  pg3_issue(F, ub, we, dnext, lane);
  float h[16];
  { const bf16_t* hp = hw + tk * 1024 + lane * 16; u32x4 h0 = *(const u32x4*)hp, h1 = *(const u32x4*)(hp + 8);
#pragma unroll
    for (int e = 0; e < 4; ++e) { h[2*e] = __uint_as_float(h0[e] << 16); h[2*e+1] = __uint_as_float(h0[e] & 0xffff0000u); h[8+2*e] = __uint_as_float(h1[e] << 16); h[8+2*e+1] = __uint_as_float(h1[e] & 0xffff0000u); } }
  float pd[8];
#pragma unroll
  for (int j = 0; j < 8; ++j) pd[j] = j < nb ? dot16_fp8(h, U[j]) : 0.f;
  pg3_issue(U, vb, we, dnext, lane);
  float q4[4], q2[2], q1;
#pragma unroll
  for (int j = 0; j < 4; ++j) { bool hi = lane & 1; float keep = hi ? pd[2*j+1] : pd[2*j], send = hi ? pd[2*j] : pd[2*j+1]; q4[j] = keep + dpp_get<0xB1>(send); }
#pragma unroll
  for (int j = 0; j < 2; ++j) { bool hi = lane & 2; float keep = hi ? q4[2*j+1] : q4[2*j], send = hi ? q4[2*j] : q4[2*j+1]; q2[j] = keep + dpp_get<0x4E>(send); }
  { bool hi = lane & 4; float keep = hi ? q2[1] : q2[0], send = hi ? q2[0] : q2[1]; q1 = keep + xor4_get(send); }
  q1 += dpp_get<0x128>(q1);
  q1 = xor16_sum(q1);
  q1 = xor32_sum(q1);
  float w = 0.f;
  { const int jj = lane & 7; if (jj < nb) w = wg[base + jj] * fgelu_(q1 * wsc[base + jj]); }
  if (tk == 0) pg3_axpy8(acc[0], V, w, nb); else if (tk == 1) pg3_axpy8(acc[1], V, w, nb); else pg3_axpy8(acc[2], V, w, nb);
}
__device__ __forceinline__ void peer_gather_sweep3(const bf16_t* __restrict__ xn, const char* __restrict__ gl, const unsigned char* __restrict__ ub,
                                                   const unsigned char* __restrict__ vb, const float* __restrict__ modl, float* __restrict__ xs, int ntok, char* smem,
                                                   const float* __restrict__ ng, const float* __restrict__ nmod, bf16_t* __restrict__ xn_next, float* __restrict__ out,
                                                   int pass_begin, int pass_end) {
  bf16_t* hs = (bf16_t*)(smem + PG3_OFF_H); unsigned short* fe = (unsigned short*)(smem + PG3_OFF_FE); float* fg = (float*)(smem + PG3_OFF_FG); float* fs = (float*)(smem + PG3_OFF_FS);
  unsigned* bt = (unsigned*)(smem + PG3_OFF_BT); int* nbt = (int*)(smem + PG3_OFF_TOT + 320);
  const int per_block = (ntok + (int)gridDim.x - 1) / (int)gridDim.x;
  const int npass = (per_block + 11) / 12; const int tpp = (per_block + npass - 1) / npass;
  for (int pass = pass_begin; pass < pass_end && pass < npass; ++pass) {
    {
      const int t = tid_opaque();
      __syncthreads();
      const char* rec = gl + ((long)blockIdx.x * 4 + pass) * 4 * PG3_REC_BYTES;
      for (int i = t; i < 4 * 48; i += 256) { int w_ = i / 48, c = i % 48; *(u32x4*)((char*)fe + w_ * 768 + c * 16) = *(const u32x4*)(rec + w_ * PG3_REC_BYTES + c * 16); }
      for (int i = t; i < 4 * 96; i += 256) { int w_ = i / 96, c = i % 96; *(u32x4*)((char*)fg + w_ * 1536 + c * 16) = *(const u32x4*)(rec + w_ * PG3_REC_BYTES + 768 + c * 16); }
      for (int i = t; i < 4 * 96; i += 256) { int w_ = i / 96, c = i % 96; *(u32x4*)((char*)fs + w_ * 1536 + c * 16) = *(const u32x4*)(rec + w_ * PG3_REC_BYTES + 2304 + c * 16); }
      for (int i = t; i < 4 * 40; i += 256) { int w_ = i / 40, c = i % 40; *(u32x4*)((char*)bt + w_ * 640 + c * 16) = *(const u32x4*)(rec + w_ * PG3_REC_BYTES + 3840 + c * 16); }
      if (t < 4) nbt[t] = *(const int*)(rec + t * PG3_REC_BYTES + 4480);
      for (int i = t; i < 12 * 128; i += 256) {
        int tl = i >> 7, ch = i & 127; int q = (tl % 3) * 4 + (tl / 3); int idx = pass * tpp + q; int g = (int)blockIdx.x + idx * (int)gridDim.x;
        u32x4 v = {0u, 0u, 0u, 0u};
        if (q < tpp && idx < per_block && g < ntok) v = *(const u32x4*)(xn + pg_row(g, ntok) * DM + ch * 8);
        *(u32x4*)(hs + tl * 1024 + ch * 8) = v;
      }
      __syncthreads();
    }
    const int t_s = tid_opaque(); const int lane = t_s & 63, wave = t_s >> 6;
    float acc[3][16];
#pragma unroll
    for (int tk = 0; tk < 3; ++tk)
#pragma unroll
      for (int e = 0; e < 16; ++e) acc[tk][e] = 0.f;
    const int nbat = nbt[wave];
    const unsigned short* we = fe + wave * 384; const float* wg = fg + wave * 384; const float* wsc = fs + wave * 384; const unsigned* wb = bt + wave * 160;
    const bf16_t* hw = hs + wave * 3 * 1024;
    u32x4 X[8], Y[8], Z[8];
    if (nbat > 0) { const unsigned d0 = __builtin_amdgcn_readfirstlane(wb[0]); pg3_issue(X, ub, we, d0, lane); pg3_issue(Y, vb, we, d0, lane); }
    for (int k = 0; k < nbat; k += 3) {
      pg3_step(X, Y, Z, k, nbat, acc, ub, vb, we, wg, wsc, wb, hw, lane);
      pg3_step(Z, X, Y, k + 1, nbat, acc, ub, vb, we, wg, wsc, wb, hw, lane);
      pg3_step(Y, Z, X, k + 2, nbat, acc, ub, vb, we, wg, wsc, wb, hw, lane);
    }
#pragma unroll
    for (int tk = 0; tk < 3; ++tk) {
      int q = tk * 4 + wave; int idx = pass * tpp + q; int g = (int)blockIdx.x + idx * (int)gridDim.x;
      if (q < tpp && idx < per_block && g < ntok) {
        long row = pg_row(g, ntok); int b = row / RB, lr = row % RB; int bb = lr < SEQ ? b : BATCH; const float* g5 = modl + ((long)bb * 6 + 5) * DM + lane * 16;
        float* xr = xs + row * DM + lane * 16;
        f32x4 xv[4]; float ss = 0.f;
#pragma unroll
        for (int i = 0; i < 4; ++i) {
          f32x4 x = *(f32x4*)(xr + 4 * i); f32x4 gg = *(const f32x4*)(g5 + 4 * i);
          x[0] += gg[0] * acc[tk][4*i]; x[1] += gg[1] * acc[tk][4*i+1]; x[2] += gg[2] * acc[tk][4*i+2]; x[3] += gg[3] * acc[tk][4*i+3];
          xv[i] = x; ss += x[0] * x[0] + x[1] * x[1] + x[2] * x[2] + x[3] * x[3];
        }
        if (out) {
          float* orow = out + ((long)b * SEQ + lr) * DM + lane * 16;
#pragma unroll
          for (int i = 0; i < 4; ++i) *(f32x4*)(orow + 4 * i) = xv[i];
        } else {
#pragma unroll
          for (int i = 0; i < 4; ++i) *(f32x4*)(xr + 4 * i) = xv[i];
          ss = wave_sum(ss); const float inv = __builtin_amdgcn_rsqf(ss * (1.f / DM) + EPSN);
          const float* sh = nmod + ((long)bb * 6 + 0) * DM + lane * 16; const float* sc = sh + DM; const float* gp = ng + lane * 16;
          u32x4 p0, p1;
#pragma unroll
          for (int i = 0; i < 4; ++i) { f32x4 g4 = *(const f32x4*)(gp + 4 * i), s4 = *(const f32x4*)(sc + 4 * i), h4 = *(const f32x4*)(sh + 4 * i);
            const float a0 = xv[i][0] * inv * g4[0] * (1.f + s4[0]) + h4[0], a1 = xv[i][1] * inv * g4[1] * (1.f + s4[1]) + h4[1];
            const float a2 = xv[i][2] * inv * g4[2] * (1.f + s4[2]) + h4[2], a3 = xv[i][3] * inv * g4[3] * (1.f + s4[3]) + h4[3];
            if (i < 2) { p0[2 * i] = pack2bf(a0, a1); p0[2 * i + 1] = pack2bf(a2, a3); } else { p1[2 * (i - 2)] = pack2bf(a0, a1); p1[2 * (i - 2) + 1] = pack2bf(a2, a3); } }
          *(u32x4*)(xn_next + row * DM + lane * 16) = p0; *(u32x4*)(xn_next + row * DM + lane * 16 + 8) = p1;
        }
      }
    }
  }
}

#define CS_L 32
#define CS_LDA 72
#define CS_LDS_ 40
#define CS_OFF_KK 0
#define CS_OFF_R  (CS_OFF_KK + 32 * CS_LDA * 2)
#define CS_OFF_K  (CS_OFF_R + 32 * CS_LDA * 2)
#define CS_OFF_B  (CS_OFF_K + 32 * CS_LDA * 2)
#define CS_OFF_S  (CS_OFF_B + 32 * CS_LDA * 2)
#define CS_OFF_VT (CS_OFF_S + 64 * CS_LDA * 2)
#define CS_OFF_UT (CS_OFF_VT + 64 * CS_LDS_ * 2)
#define CS_OFF_KP (CS_OFF_UT + 64 * CS_LDS_ * 2)
#define CS_OFF_BP (CS_OFF_KP + 64 * CS_LDS_ * 2)
#define CS_OFF_A  (CS_OFF_BP + 64 * CS_LDS_ * 2)
#define CS_OFF_P1 (CS_OFF_A + 32 * CS_LDS_ * 2)
#define CS_OFF_P2 (CS_OFF_P1 + 32 * CS_LDS_ * 2)
#define CS_OFF_C  (CS_OFF_P2 + 32 * CS_LDS_ * 2)
#define CS_OFF_G  (CS_OFF_C + 32 * 36 * 4)
#define CS_LDS_BYTES (CS_OFF_G + 5 * 64 * 4)
template <int KS>
__device__ __forceinline__ void cs_mma(const bf16_t* A, int lda, int m0, const bf16_t* Bt, int ldb, int n0, int lane, f32x4& acc) {
  const int fr = lane & 15, fq = lane >> 4;
#pragma unroll
  for (int ks = 0; ks < KS; ++ks) {
    bf16x8 af = *(const bf16x8*)(A + (m0 + fr) * lda + ks * 32 + fq * 8);
    bf16x8 bfr = *(const bf16x8*)(Bt + (n0 + fr) * ldb + ks * 32 + fq * 8);
    acc = __builtin_amdgcn_mfma_f32_16x16x32_bf16(bfr, af, acc, 0, 0, 0);
  }
}
#define CSP_WAVE_BYTES (2 * 32 * CS_LDA * 2 + 32 * 36 * 4)
__device__ __forceinline__ void rw_chunk_inverse(const bf16_t* __restrict__ kk_, const bf16_t* __restrict__ bd_, const float* __restrict__ w_, bf16_t* __restrict__ Mg,
                                                 int job, long dstride, char* smem_wave, int lane) {
  const int job_u = __builtin_amdgcn_readfirstlane(job);
  const int c = job_u % (RB / CS_L), item = job_u / (RB / CS_L);
  const int dir = item & 1, h = (item >> 1) % 6, b = item / 12;
  const long rowbase = (long)b * RB; const int col0 = h * 64;
  bf16_t* KKs = (bf16_t*)smem_wave; bf16_t* Bs_ = KKs + 32 * CS_LDA; float* Cf = (float*)(smem_wave + 2 * 32 * CS_LDA * 2);
  const int fr = lane & 15, fq = lane >> 4;
  const int rlo = dir ? scan_row(1, c * CS_L + 31) : scan_row(0, c * CS_L);
  const long ub_ = (rowbase + rlo) * 384 + col0;
  const char* sw_ = (const char*)(w_ + dir * dstride + ub_); const char* skk_ = (const char*)(kk_ + ub_); const char* sb_ = (const char*)(bd_ + dir * dstride + ub_);
  float wv[32]; unsigned kkr[32], br[32];
#pragma unroll
  for (int tt = 0; tt < 32; ++tt) {
    const unsigned m_ = dir ? 31 - tt : tt;
    wv[tt] = *(const float*)(sw_ + (size_t)((unsigned)lane * 4u + m_ * 1536u)); kkr[tt] = *(const bf16_t*)(skk_ + (size_t)((unsigned)lane * 2u + m_ * 768u)); br[tt] = *(const bf16_t*)(sb_ + (size_t)((unsigned)lane * 2u + m_ * 768u));
  }
  float G = 1.f;
#pragma unroll
  for (int tt = 0; tt < 32; ++tt) {
    KKs[tt * CS_LDA + lane] = f2bf(bf2f((bf16_t)kkr[tt]) * G);
    G *= wv[tt];
    Bs_[tt * CS_LDA + lane] = f2bf(bf2f((bf16_t)br[tt]) * __builtin_amdgcn_rcpf(G));
  }
#pragma unroll
  for (int mt = 0; mt < 2; ++mt)
#pragma unroll
    for (int nt = 0; nt < 2; ++nt) {
      f32x4 a = {0.f, 0.f, 0.f, 0.f};
      cs_mma<2>(KKs, CS_LDA, mt * 16, Bs_, CS_LDA, nt * 16, lane, a);
      const int tt = mt * 16 + fr, s0 = nt * 16 + fq * 4;
      f32x4 o4;
#pragma unroll
      for (int e = 0; e < 4; ++e) o4[e] = (s0 + e < tt) ? a[e] : 0.f;
      *(f32x4*)(Cf + tt * 36 + s0) = o4;
    }
  float m[32];
#pragma unroll
  for (int tt = 0; tt < 32; ++tt) {
    float acc = (tt == lane) ? 1.f : 0.f;
#pragma unroll
    for (int s4 = 0; s4 < tt; s4 += 4) {
      const f32x4 cv = *(const f32x4*)(Cf + tt * 36 + s4);
#pragma unroll
      for (int e = 0; e < 4; ++e) if (s4 + e < tt) acc -= cv[e] * m[s4 + e];
    }
    m[tt] = acc;
  }
  if (lane < 32) {
    bf16_t* dst = Mg + (long)job_u * 1024;
#pragma unroll
    for (int tt = 0; tt < 32; ++tt) dst[tt * 32 + lane] = f2bf(m[tt]);
  }
}
#define CS_FETCH(c_) do { const int s0_ = (c_) * CS_L + cq * 8; const int rlo_ = dir ? scan_row(1, s0_ + 7) : scan_row(0, s0_); \
      const char* fw_ = s_w + (long)rlo_ * 1536; const char* fkk_ = s_kk + (long)rlo_ * 768; const char* fb_ = s_b + (long)rlo_ * 768; \
      const char* fk_ = s_k + (long)rlo_ * 768; const char* fr_ = s_r + (long)rlo_ * 768; const char* fv_ = s_v + (long)rlo_ * 768; \
      _Pragma("unroll") for (int e = 0; e < 8; ++e) { asm volatile("" : "+v"(vo2e[e]), "+v"(vo4e[e]));   \
        pw[e] = *(const float*)(fw_ + (size_t)vo4e[e]); pkk[e] = *(const bf16_t*)(fkk_ + (size_t)vo2e[e]); pb[e] = *(const bf16_t*)(fb_ + (size_t)vo2e[e]); \
        pk[e] = *(const bf16_t*)(fk_ + (size_t)vo2e[e]); pr[e] = *(const bf16_t*)(fr_ + (size_t)vo2e[e]); pv[e] = *(const bf16_t*)(fv_ + (size_t)vo2e[e]); } } while (0)
__device__ __forceinline__ void rw_scan_chunked(const bf16_t* __restrict__ r_, const bf16_t* __restrict__ v_, const bf16_t* __restrict__ kk_, const bf16_t* __restrict__ kd_,
                                                const bf16_t* __restrict__ bd_, const float* __restrict__ w_, float* __restrict__ y_, int item, long dstride, char* smem, const bf16_t* __restrict__ Mg) {
  const int t = tid_opaque(), lane = t & 63, wave = t >> 6, fr = lane & 15, fq = lane >> 4;
  const int item_u = __builtin_amdgcn_readfirstlane(item);
  const int dir = item_u & 1, h = (item_u >> 1) % 6, b = item_u / 12;
  const long rowbase = (long)b * RB; const int col0 = h * 64;
  bf16_t* KKs = (bf16_t*)(smem + CS_OFF_KK); bf16_t* Rs = (bf16_t*)(smem + CS_OFF_R); bf16_t* Ks_ = (bf16_t*)(smem + CS_OFF_K); bf16_t* Bs_ = (bf16_t*)(smem + CS_OFF_B);
  bf16_t* Ss = (bf16_t*)(smem + CS_OFF_S); bf16_t* Vt = (bf16_t*)(smem + CS_OFF_VT); bf16_t* Ut = (bf16_t*)(smem + CS_OFF_UT);
  bf16_t* KpT = (bf16_t*)(smem + CS_OFF_KP); bf16_t* BpT = (bf16_t*)(smem + CS_OFF_BP);
  bf16_t* As_ = (bf16_t*)(smem + CS_OFF_A); bf16_t* P1s = (bf16_t*)(smem + CS_OFF_P1); bf16_t* P2s = (bf16_t*)(smem + CS_OFF_P2);
  bf16_t* Ms = (bf16_t*)(smem + CS_OFF_C);
  float* Gq = (float*)(smem + CS_OFF_G); float* GL = Gq + 256;
  bf16_t* rhsT = (bf16_t*)(smem + CS_OFF_K);
  const int cj = t & 63, cq = __builtin_amdgcn_readfirstlane(t >> 6);
  unsigned vo2e[8], vo4e[8];
#pragma unroll
  for (int e = 0; e < 8; ++e) { const int m_ = dir ? 7 - e : e; vo2e[e] = (unsigned)cj * 2u + (unsigned)m_ * 768u; vo4e[e] = (unsigned)cj * 4u + (unsigned)m_ * 1536u; }
  const long ubase_ = rowbase * 384 + col0;
  const char* s_w = (const char*)(w_ + dir * dstride + ubase_); const char* s_kk = (const char*)(kk_ + ubase_); const char* s_b = (const char*)(bd_ + dir * dstride + ubase_);
  const char* s_k = (const char*)(kd_ + dir * dstride + ubase_); const char* s_r = (const char*)(r_ + ubase_); const char* s_v = (const char*)(v_ + ubase_);
  __syncthreads();
  for (int i = t; i < 64 * CS_LDA; i += 256) Ss[i] = 0;
  f32x4 Sacc[4];
#pragma unroll
  for (int it = 0; it < 4; ++it) Sacc[it] = (f32x4){0.f, 0.f, 0.f, 0.f};
  float pw[8]; unsigned pkk[8], pb[8], pk[8], pr[8], pv[8]; uint2 pm;
  const bf16_t* Mitem = Mg + (long)item * (RB / CS_L) * 1024 + t * 4;
  CS_FETCH(0); pm = *(const uint2*)Mitem;
  __builtin_amdgcn_s_setprio(3);
  const int NCH = RB / CS_L;
  for (int c = 0; c < NCH; ++c) {
#pragma unroll
    for (int e = 0; e < 8; ++e) asm volatile("" : "+v"(pw[e]), "+v"(pkk[e]), "+v"(pb[e]), "+v"(pk[e]), "+v"(pr[e]), "+v"(pv[e]));
    asm volatile("" : "+v"(pm.x), "+v"(pm.y));
    float g[8]; float run = 1.f;
#pragma unroll
    for (int e = 0; e < 8; ++e) { run *= pw[e]; g[e] = run; }
    Gq[cq * 64 + cj] = run;
    float kkv[8], bv[8], kv[8], rv[8]; bf16_t vv[8];
#pragma unroll
    for (int e = 0; e < 8; ++e) { kkv[e] = bf2f((bf16_t)pkk[e]); bv[e] = bf2f((bf16_t)pb[e]); kv[e] = bf2f((bf16_t)pk[e]); rv[e] = bf2f((bf16_t)pr[e]); vv[e] = (bf16_t)pv[e]; }
    __syncthreads();
    const uint2 pm_cur = pm;
    if (c + 1 < NCH) { CS_FETCH(c + 1); pm = *(const uint2*)(Mitem + (long)(c + 1) * 1024); }
    float base = 1.f, tot = 1.f;
#pragma unroll
    for (int q = 0; q < 4; ++q) { float pq = Gq[q * 64 + cj]; if (q < cq) base *= pq; tot *= pq; }
    if (cq == 0) GL[cj] = tot;
    {
      u32x4 kp4, bp4, vt4;
#pragma unroll
      for (int e = 0; e < 8; ++e) {
        const float G = base * g[e], Gp = e == 0 ? base : base * g[e - 1], iG = __builtin_amdgcn_rcpf(G);
        const int tt = cq * 8 + e;
        KKs[tt * CS_LDA + cj] = f2bf(kkv[e] * Gp); Rs[tt * CS_LDA + cj] = f2bf(rv[e] * G);
        const float kt = kv[e] * iG, bt = bv[e] * iG;
        Ks_[tt * CS_LDA + cj] = f2bf(kt); Bs_[tt * CS_LDA + cj] = f2bf(bt);
        kv[e] = kt * tot; bv[e] = -bt * tot;
      }
#pragma unroll
      for (int e = 0; e < 4; ++e) { kp4[e] = pack2bf(kv[2 * e], kv[2 * e + 1]); bp4[e] = pack2bf(bv[2 * e], bv[2 * e + 1]); vt4[e] = (unsigned)vv[2 * e] | ((unsigned)vv[2 * e + 1] << 16); }
      *(uint2*)(Ms + (t >> 3) * CS_LDS_ + (t & 7) * 4) = pm_cur;
      *(u32x4*)(KpT + cj * CS_LDS_ + cq * 8) = kp4; *(u32x4*)(BpT + cj * CS_LDS_ + cq * 8) = bp4; *(u32x4*)(Vt + cj * CS_LDS_ + cq * 8) = vt4;
    }
    __syncthreads();
    if (wave == 1) {
    } else {
      const bf16_t* X = wave == 0 ? KKs : Rs; const bf16_t* Y = wave == 3 ? Bs_ : Ks_;
#pragma unroll
      for (int mt = 0; mt < 2; ++mt)
#pragma unroll
        for (int nt = 0; nt < 2; ++nt) {
          f32x4 a = {0.f, 0.f, 0.f, 0.f};
          cs_mma<2>(X, CS_LDA, mt * 16, Y, CS_LDA, nt * 16, lane, a);
          const int tt = mt * 16 + fr, s0 = nt * 16 + fq * 4;
          float o[4];
#pragma unroll
          for (int e = 0; e < 4; ++e) { const int s = s0 + e; const bool keep = wave == 0 ? (s < tt) : (s <= tt); o[e] = keep ? a[e] : 0.f; }
          bf16_t* dst = wave == 0 ? As_ : (wave == 2 ? P1s : P2s); const float sg = wave == 3 ? -1.f : 1.f;
          uint2 pk2; pk2.x = pack2bf(sg * o[0], sg * o[1]); pk2.y = pack2bf(sg * o[2], sg * o[3]);
          *(uint2*)(dst + tt * CS_LDS_ + s0) = pk2;
        }
    }
    __syncthreads();
    f32x4 yp[2];
    {
      const bf16x8 sb0 = *(const bf16x8*)(Ss + (wave * 16 + fr) * CS_LDA + fq * 8), sb1 = *(const bf16x8*)(Ss + (wave * 16 + fr) * CS_LDA + 32 + fq * 8);
      const bf16x8 vb = *(const bf16x8*)(Vt + (wave * 16 + fr) * CS_LDS_ + fq * 8);
      bf16x8 ak[2][2], ar[2][2], aa[2], ap[2];
#pragma unroll
      for (int mt = 0; mt < 2; ++mt) {
        ak[mt][0] = *(const bf16x8*)(KKs + (mt * 16 + fr) * CS_LDA + fq * 8); ak[mt][1] = *(const bf16x8*)(KKs + (mt * 16 + fr) * CS_LDA + 32 + fq * 8);
        ar[mt][0] = *(const bf16x8*)(Rs + (mt * 16 + fr) * CS_LDA + fq * 8);  ar[mt][1] = *(const bf16x8*)(Rs + (mt * 16 + fr) * CS_LDA + 32 + fq * 8);
        aa[mt] = *(const bf16x8*)(As_ + (mt * 16 + fr) * CS_LDS_ + fq * 8);   ap[mt] = *(const bf16x8*)(P1s + (mt * 16 + fr) * CS_LDS_ + fq * 8);
      }
#pragma unroll
      for (int mt = 0; mt < 2; ++mt) {
        f32x4 a = {0.f, 0.f, 0.f, 0.f}, y2 = {0.f, 0.f, 0.f, 0.f};
        a = __builtin_amdgcn_mfma_f32_16x16x32_bf16(sb0, ak[mt][0], a, 0, 0, 0);   y2 = __builtin_amdgcn_mfma_f32_16x16x32_bf16(sb0, ar[mt][0], y2, 0, 0, 0);
        a = __builtin_amdgcn_mfma_f32_16x16x32_bf16(sb1, ak[mt][1], a, 0, 0, 0);   y2 = __builtin_amdgcn_mfma_f32_16x16x32_bf16(sb1, ar[mt][1], y2, 0, 0, 0);
        a = __builtin_amdgcn_mfma_f32_16x16x32_bf16(vb, aa[mt], a, 0, 0, 0);       y2 = __builtin_amdgcn_mfma_f32_16x16x32_bf16(vb, ap[mt], y2, 0, 0, 0);
#pragma unroll
        for (int e = 0; e < 4; ++e) rhsT[(wave * 16 + fq * 4 + e) * CS_LDS_ + mt * 16 + fr] = f2bf(a[e]);
        yp[mt] = y2;
      }
    }
    __syncthreads();
#pragma unroll
    for (int nt = 0; nt < 2; ++nt) {
      f32x4 a = {0.f, 0.f, 0.f, 0.f};
      cs_mma<1>(rhsT, CS_LDS_, wave * 16, Ms, CS_LDS_, nt * 16, lane, a);
      uint2 pk2; pk2.x = pack2bf(a[0], a[1]); pk2.y = pack2bf(a[2], a[3]);
      *(uint2*)(Ut + (wave * 16 + fr) * CS_LDS_ + nt * 16 + fq * 4) = pk2;
    }
    __syncthreads();
    {
      const bf16x8 ub_ = *(const bf16x8*)(Ut + (wave * 16 + fr) * CS_LDS_ + fq * 8);
      const bf16x8 kpb = *(const bf16x8*)(KpT + (wave * 16 + fr) * CS_LDS_ + fq * 8), bpb = *(const bf16x8*)(BpT + (wave * 16 + fr) * CS_LDS_ + fq * 8);
      bf16x8 p2a[2], va[4], ua[4];
#pragma unroll
      for (int mt = 0; mt < 2; ++mt) p2a[mt] = *(const bf16x8*)(P2s + (mt * 16 + fr) * CS_LDS_ + fq * 8);
#pragma unroll
      for (int it = 0; it < 4; ++it) { va[it] = *(const bf16x8*)(Vt + (it * 16 + fr) * CS_LDS_ + fq * 8); ua[it] = *(const bf16x8*)(Ut + (it * 16 + fr) * CS_LDS_ + fq * 8); }
      const f32x4 gl = *(const f32x4*)(GL + wave * 16 + fq * 4);
#pragma unroll
      for (int mt = 0; mt < 2; ++mt) {
        yp[mt] = __builtin_amdgcn_mfma_f32_16x16x32_bf16(ub_, p2a[mt], yp[mt], 0, 0, 0);
        const long row = rowbase + scan_row(dir, c * CS_L) + (dir ? -(mt * 16 + fr) : (mt * 16 + fr));
        *(f32x4*)(y_ + dir * dstride + row * 384 + col0 + wave * 16 + fq * 4) = yp[mt];
      }
#pragma unroll
      for (int it = 0; it < 4; ++it) {
        f32x4 a = Sacc[it]; a[0] *= gl[0]; a[1] *= gl[1]; a[2] *= gl[2]; a[3] *= gl[3];
        a = __builtin_amdgcn_mfma_f32_16x16x32_bf16(kpb, va[it], a, 0, 0, 0);
        a = __builtin_amdgcn_mfma_f32_16x16x32_bf16(bpb, ua[it], a, 0, 0, 0);
        Sacc[it] = a;
      }
    }
    __syncthreads();
#pragma unroll
    for (int it = 0; it < 4; ++it) { uint2 pk2; pk2.x = pack2bf(Sacc[it][0], Sacc[it][1]); pk2.y = pack2bf(Sacc[it][2], Sacc[it][3]); *(uint2*)(Ss + (it * 16 + fr) * CS_LDA + wave * 16 + fq * 4) = pk2; }
  }
  __builtin_amdgcn_s_setprio(0);
  __syncthreads();
}
#include <hip/hip_cooperative_groups.h>
namespace cg = cooperative_groups;

#define XB_TMO      128
#define XB_XCNT(j)  (256  + 64 * (j))
#define XB_XSUB(j)  (1280 + 64 * (j))
#define XB_XGEN(j)  (2304 + 64 * (j))
#define XB_TOP      3328
#define XB_TOPGEN   3392
#define XB_QUEUE(i) (3456 + 64 * (i))
#define XCD_BAR_WORDS 4096
#define XB_SPIN_CAP (1u << 22)
#define LAS __attribute__((address_space(3)))
__device__ __forceinline__ unsigned xb_ld(unsigned* p)              { return __hip_atomic_load(p, __ATOMIC_RELAXED, __HIP_MEMORY_SCOPE_AGENT); }
__device__ __forceinline__ unsigned xb_add(unsigned* p, unsigned v) { return __hip_atomic_fetch_add(p, v, __ATOMIC_RELAXED, __HIP_MEMORY_SCOPE_AGENT); }
__device__ __forceinline__ unsigned xb_xcc_id() { return (unsigned)__builtin_amdgcn_s_getreg((3 << 11) | 20) & 0xFu; }
#define XB_SPIN(cond, bar) do { unsigned _sp = 0; while (cond) { __builtin_amdgcn_s_sleep(1); \
    if ((++_sp & 255u) == 0u) { if (xb_ld(&(bar)[XB_TMO])) break; if (_sp > XB_SPIN_CAP) { atomicAdd(&(bar)[XB_TMO], 1u); break; } } } } while (0)
struct XcdBarrier { unsigned* bar; unsigned x; volatile LAS unsigned* st; };
__device__ __forceinline__ XcdBarrier xcd_barrier_post(unsigned* bar, volatile LAS unsigned* st) {
  XcdBarrier b; b.bar = bar; b.x = xb_xcc_id(); b.st = st;
  if (threadIdx.x == 0) (void)xb_add(&bar[XB_XCNT(b.x)], 1u);
  return b;
}
__device__ __forceinline__ void xcd_barrier_complete(unsigned* bar, unsigned x, unsigned& nloc, unsigned& nx) {
  const unsigned G = gridDim.x; unsigned sum, cnt, mine, sp = 0u;
  for (;;) {
    sum = 0u; cnt = 0u; mine = 0u;
#pragma unroll
    for (unsigned j = 0; j < 16; ++j) { const unsigned c = xb_ld(&bar[XB_XCNT(j)]); sum += c; cnt += (c > 0u) ? 1u : 0u; mine = (j == x) ? c : mine; }
    if (sum == G) break;
    __builtin_amdgcn_s_sleep(1);
    if ((++sp & 255u) == 0u) { if (xb_ld(&bar[XB_TMO])) break; if (sp > XB_SPIN_CAP) { atomicAdd(&bar[XB_TMO], 1u); break; } }
  }
  nloc = mine > 0u ? mine : 1u; nx = cnt > 0u ? cnt : 1u;
}
__device__ __forceinline__ void xcd_barrier(const XcdBarrier& b) {
  asm volatile("s_waitcnt vmcnt(0)" ::: "memory");
  __syncthreads();
  if (threadIdx.x == 0) {
    unsigned* bar = b.bar;
    __builtin_amdgcn_s_waitcnt(0);
    unsigned nloc = b.st[0], nx = b.st[1];
    if (nloc == 0u) { xcd_barrier_complete(bar, b.x, nloc, nx); b.st[0] = nloc; b.st[1] = nx; }
    const unsigned old = xb_add(&bar[XB_XSUB(b.x)], 1u);
    const unsigned gen = old / nloc;
    if (old + 1u == (gen + 1u) * nloc) {
      __builtin_amdgcn_fence(__ATOMIC_RELEASE, "agent");
      asm volatile("s_waitcnt vmcnt(0)" ::: "memory");
      const unsigned og = xb_add(&bar[XB_TOP], 1u);
      const unsigned tg = og / nx;
      if (og + 1u == (tg + 1u) * nx) xb_add(&bar[XB_TOPGEN], 1u);
      else XB_SPIN(xb_ld(&bar[XB_TOPGEN]) == tg, bar);
      __builtin_amdgcn_fence(__ATOMIC_ACQUIRE, "agent");
      xb_add(&bar[XB_XGEN(b.x)], 1u);
      asm volatile("s_waitcnt vmcnt(0)" ::: "memory");
    } else {
      XB_SPIN(xb_ld(&bar[XB_XGEN(b.x)]) == gen, bar);
      __builtin_amdgcn_fence(__ATOMIC_ACQUIRE, "agent");
      asm volatile("s_waitcnt vmcnt(0)" ::: "memory");
    }
  }
  __syncthreads();
}


constexpr size_t al256(size_t x) { return (x + 255) & ~(size_t)255; }
struct WsOff { size_t xs, mod, xn, Pb, tq, tkv, a_b, g_b, w_f, mq, mk, mvT, gq, gk, gvT, r_b, v_b, kk_b, kd_b, bd_b, w_inT, w_outT, wqT, keysb, wqbT, wkvbT, w2T, a2T, g2T, rope_g, rope_m, total; };
constexpr WsOff make_wsoff() {
  WsOff o{}; size_t p = 32768; const size_t MA = NROWS;
  o.mod = p; p += al256(2 * (BATCH + 1) * 6144 * 4); o.xs = p; p += al256(MA * DM * 4); o.xn = p; p += al256(MA * DM * 2);
  o.Pb = p; p += al256(MA * IN_COLS * 2);
  o.tq = p; p += al256(MA * 384 * 2); o.tkv = p; p += al256(MA * 512 * 2); o.a_b = p; p += al256(2 * MA * 384 * 2);
  o.g_b = p; p += al256(MA * 384 * 2); o.w_f = p; p += al256(2 * MA * 384 * 4);
  o.mq = p; p += al256(MA * 384 * 2); o.mk = p; p += al256(MA * 384 * 2); o.mvT = p; p += al256((size_t)BATCH * 4 * 64 * RB * 2);
  o.gq = p; p += al256(MA * 384 * 2); o.gk = p; p += al256(MA * 128 * 2); o.gvT = p; p += al256((size_t)BATCH * 2 * 64 * RB * 2);
  o.r_b = p; p += al256(MA * 384 * 2); o.v_b = p; p += al256(MA * 384 * 2); o.kk_b = p; p += al256(MA * 384 * 2);
  o.kd_b = p; p += al256(2 * MA * 384 * 2); o.bd_b = p; p += al256(2 * MA * 384 * 2);
  o.w_inT = p; p += al256((size_t)2 * 2688 * 1024 * 2); o.w_outT = p; p += al256((size_t)2 * 1024 * 1024 * 2); o.wqT = p; p += al256((size_t)2 * 2048 * 1024 * 2);
  o.keysb = p; p += al256((size_t)2 * 16 * 128 * 128 * 2); o.wqbT = p; p += al256((size_t)2 * 384 * 256 * 2); o.wkvbT = p; p += al256((size_t)2 * 512 * 128 * 2);
  o.w2T = p; p += al256((size_t)2 * 2 * 384 * 64 * 2); o.a2T = p; p += al256((size_t)2 * 2 * 384 * 64 * 2); o.g2T = p; p += al256((size_t)2 * 384 * 192 * 2);
  o.rope_g = p; p += al256((size_t)SEQ * 64 * 4); o.rope_m = p; p += al256((size_t)SEQ * 32 * 4);
  o.total = p; return o;
}
constexpr WsOff WO = make_wsoff();
#define WS_PTR(T, off) ((T*)(ws + (off)))
#define MINV_OFF (WO.tq + (size_t)40 * 1024 * 1024)
#define TAB_OFF (WO.Pb + ((size_t)2 * NROWS * 384 * 4 + 1048576 & ~(size_t)255))
#define TAB_U (TAB_OFF)
#define TAB_V (TAB_OFF + (size_t)16384 * 1024)
#define TAB_SU (TAB_OFF + (size_t)2 * 16384 * 1024)
#define TAB_SV (TAB_OFF + (size_t)2 * 16384 * 1024 + 65536)
#define LAUNDER_S(x) asm volatile("" : "+s"(x))
#define KARG_AS __attribute__((address_space(4)))
#define KP_DECL const KARG_AS MegaP* kp_ = (const KARG_AS MegaP*)__builtin_amdgcn_kernarg_segment_ptr(); LAUNDER_S(kp_)

struct NaiveIn {
  const float *x, *c, *ctx, *c_ctx, *ada_w, *ada_b, *norm_mix_g, *norm_ffn_g, *w_in, *w_out, *mla_q_norm_g, *mla_w_qb, *mla_kv_norm_g,
      *mla_w_kvb, *mla_qk_g, *rw_mu, *rw_w0, *rw_w2, *rw_a0, *rw_a2, *rw_g2, *rw_k_k, *rw_k_a, *rw_r_k, *rw_ln_g, *rw_ln_b, *gqa_qk_g,
      *pe_wq, *pe_keys, *pe_u, *pe_v;
};
struct MegaP { NaiveIn in; char* ws; float* out; };

#ifndef MEGA_CG
#define MEGA_CG 0
#endif
#if MEGA_CG
#define GRID_BARRIER() cg::this_grid().sync()
#else
#ifdef BAR_TWICE
#define GRID_BARRIER() do { GRID_BARRIER1(); GRID_BARRIER1(); } while (0)
#else
#define GRID_BARRIER() GRID_BARRIER1()
#endif
#define GRID_BARRIER1() do { XcdBarrier xb_; xb_.bar = (unsigned*)((const KARG_AS MegaP*)__builtin_amdgcn_kernarg_segment_ptr())->ws; xb_.x = xb_xcc_id(); xb_.st = (volatile LAS unsigned*)&xb_words; xcd_barrier(xb_); } while (0)
#endif
#define MEGA_LDS_BYTES 65536
#ifndef PHASE_MASK
#define PHASE_MASK 0xFFFF
#endif
#define PH(k) if (PHASE_MASK & (1 << (k)))
#define LAT_TM(i) (((i) >> 4) * 18 + ((i) & 15))
#define XCD_TILE_LOOP(tile, T) for (int xt_base_ = (int)(((long)(T) * (blockIdx.x & 7)) >> 3), xt_cnt_ = (int)(((long)(T) * ((blockIdx.x & 7) + 1)) >> 3) - xt_base_, xt_q_ = blockIdx.x >> 3, tile = xt_base_ + xt_q_; xt_q_ < xt_cnt_; xt_q_ += gridDim.x >> 3, tile = xt_base_ + xt_q_)
#ifndef DIL_PH
#define DIL_PH -1
#endif
#ifndef DIL_MULT
#define DIL_MULT 4
#endif
#define DIL_BEGIN(k) unsigned long long dil_t0 = 0; if (DIL_PH == (k)) dil_t0 = __builtin_amdgcn_s_memrealtime();
#define DIL_END(k) if (DIL_PH == (k)) { GRID_BARRIER(); if (blockIdx.x == 0 && threadIdx.x == 0) { unsigned long long t1 = __builtin_amdgcn_s_memrealtime(); unsigned long long dt = (t1 - dil_t0) * DIL_MULT; \
    while (__builtin_amdgcn_s_memrealtime() - t1 < dt) __builtin_amdgcn_s_sleep(32); } }

__device__ __forceinline__ void ph_norm_mod(const float* xs, const float* g, const float* modl, int shift_idx, bf16_t* xn, bool skip_ctx = false, const float* x_in = nullptr, const float* ctx_in = nullptr) {
  const int tt_ = tid_opaque(); const int lane = tt_ & 63;
  for (long row = blockIdx.x * 4 + (tt_ >> 6); row < NROWS; row += (long)gridDim.x * 4) {
    int b = row / RB, lr = row % RB; int bb = lr < SEQ ? b : BATCH;
    if (skip_ctx && lr >= SEQ) continue;
    const float* sh = modl + ((long)bb * 6 + shift_idx) * DM; const float* sc = sh + DM;
    const float* xr = x_in ? (lr < SEQ ? x_in + ((long)b * SEQ + lr) * DM : ctx_in + ((long)b * CTX_LEN + (lr - SEQ)) * DM) : xs + row * DM; f32x4 v[4]; float ss = 0.f;
#pragma unroll
    for (int i = 0; i < 4; ++i) { v[i] = *(const f32x4*)(xr + i * 256 + lane * 4); ss += v[i][0]*v[i][0] + v[i][1]*v[i][1] + v[i][2]*v[i][2] + v[i][3]*v[i][3]; }
    ss = wave_sum(ss);
    float inv = __builtin_amdgcn_rsqf(ss / DM + EPSN);
#pragma unroll
    for (int i = 0; i < 4; ++i) {
      int d = i * 256 + lane * 4; float o[4];
#pragma unroll
      for (int e = 0; e < 4; ++e) o[e] = v[i][e] * inv * g[d+e] * (1.f + sc[d+e]) + sh[d+e];
      uint2 pk; pk.x = pack2bf(o[0], o[1]); pk.y = pack2bf(o[2], o[3]);
      *(uint2*)(xn + row * DM + d) = pk;
    }
  }
}
__device__ __forceinline__ void ph_cvt_wT(const float* W, const float* g, bf16_t* Wt, int K, int N, int Npad, int Kpad) {
  const long n_el = (long)Npad * Kpad;
  const int tt_ = tid_opaque();
  for (long i = (long)blockIdx.x * 256 + tt_; i < n_el; i += (long)gridDim.x * 256) {
    int k = i % Kpad; int n = i / Kpad;
    Wt[i] = (k < K && n < N) ? f2bf(W[(long)k * N + n] * (g ? g[k] : 1.f)) : (bf16_t)0;
  }
}
__device__ __forceinline__ void ph_cvt_bf16(const float* s, bf16_t* d, long n8) {
  const int tt_ = tid_opaque();
  for (long i = (long)blockIdx.x * 256 + tt_; i < n8; i += (long)gridDim.x * 256) {
    f32x4 a = *(const f32x4*)(s + i * 8), b = *(const f32x4*)(s + i * 8 + 4);
    u32x4 o; o[0] = pack2bf(a[0], a[1]); o[1] = pack2bf(a[2], a[3]); o[2] = pack2bf(b[0], b[1]); o[3] = pack2bf(b[2], b[3]);
    *(u32x4*)(d + i * 8) = o;
  }
}


__device__ __forceinline__ void ph_cvt_wT_tiled(const float* __restrict__ W, const float* __restrict__ g, bf16_t* __restrict__ Wt, int K, int N, int Npad, int Kpad, char* smem) {
  const int t = tid_opaque(); float* s = (float*)smem;
  const int tk = Kpad / 64, tn = Npad / 64;
  for (int tile = blockIdx.x; tile < tk * tn; tile += gridDim.x) {
    const int k0 = (tile % tk) * 64, n0 = (tile / tk) * 64;
    __syncthreads();
#pragma unroll
    for (int i = 0; i < 4; ++i) {
      int kk = (t >> 4) + 16 * i, nn = (t & 15) * 4; int k = k0 + kk;
      f32x4 v = {0.f, 0.f, 0.f, 0.f};
      if (k < K) {
        const float* src = W + (long)k * N + n0 + nn; float gs = g ? g[k] : 1.f;
        if (n0 + nn + 3 < N) v = *(const f32x4*)src; else { for (int e = 0; e < 4; ++e) if (n0 + nn + e < N) v[e] = src[e]; }
        v *= gs;
      }
#pragma unroll
      for (int e = 0; e < 4; ++e) s[kk * 65 + nn + e] = v[e];
    }
    __syncthreads();
    {
      int nn = t >> 2, kq = (t & 3) * 16; u32x4 o0, o1;
#pragma unroll
      for (int e = 0; e < 4; ++e) { o0[e] = pack2bf(s[(kq + 2*e) * 65 + nn], s[(kq + 2*e + 1) * 65 + nn]); o1[e] = pack2bf(s[(kq + 8 + 2*e) * 65 + nn], s[(kq + 8 + 2*e + 1) * 65 + nn]); }
      bf16_t* dst = Wt + (long)(n0 + nn) * Kpad + k0 + kq;
      *(u32x4*)dst = o0; *(u32x4*)(dst + 8) = o1;
    }
  }
}
__device__ __forceinline__ void ph_mod_gemv(const float* __restrict__ c, const float* __restrict__ c_ctx, const float* __restrict__ ada_w, const float* __restrict__ ada_b, float* __restrict__ mod, char* smem) {
  const int t = tid_opaque(); float* s = (float*)smem;
  if ((int)blockIdx.x >= 2 * 96) return;
  for (int i = t; i < 9 * 1024; i += 256) { int bb = i >> 10, k = i & 1023; float v = bb < BATCH ? c[bb * DM + k] : c_ctx[k]; s[i] = v * __builtin_amdgcn_rcpf(1.f + __builtin_amdgcn_exp2f(-v * 1.4426950408889634f)); }
  __syncthreads();
  float* part = s + 9 * 1024;
  for (int item = blockIdx.x; item < 2 * 96; item += gridDim.x) {
    const int cb = item % 96, l = item / 96; const int kq = t >> 6, col = t & 63;
    const int j = cb * 64 + col; const float* wp = ada_w + ((long)l * DM + kq * 256) * 6144 + j;
    float acc[9];
#pragma unroll
    for (int bb = 0; bb < 9; ++bb) acc[bb] = 0.f;
#pragma unroll 16
    for (int k = 0; k < 256; ++k) { float w = wp[(long)k * 6144];
#pragma unroll
      for (int bb = 0; bb < 9; ++bb) acc[bb] += s[bb * 1024 + kq * 256 + k] * w; }
#pragma unroll
    for (int bb = 0; bb < 9; ++bb) part[(kq * 9 + bb) * 64 + col] = acc[bb];
    __syncthreads();
    for (int i = t; i < 9 * 64; i += 256) { int bb = i >> 6, cc = i & 63;
      float v = ((part[(0 * 9 + bb) * 64 + cc] + part[(1 * 9 + bb) * 64 + cc]) + part[(2 * 9 + bb) * 64 + cc]) + part[(3 * 9 + bb) * 64 + cc];
      mod[((long)l * (BATCH + 1) + bb) * 6144 + cb * 64 + cc] = v + ada_b[l * 6144 + cb * 64 + cc]; }
    __syncthreads();
  }
}

__global__ void __launch_bounds__(256, 2) mega_kernel(MegaP p) {
  __shared__ __attribute__((aligned(16))) char smem[MEGA_LDS_BYTES];
  __shared__ uint4 xb_words;
  const int t0 = threadIdx.x;
#if !MEGA_CG
  if (t0 == 0) xb_words = make_uint4(0u, 0u, 0u, 0u);
  __syncthreads();
  (void)xcd_barrier_post((unsigned*)p.ws, (volatile LAS unsigned*)&xb_words);
#endif
  const long MA = NROWS; const int TM = NROWS / 128;
#define I (kp_->in)
  const int scan_role = (int)blockIdx.x < BATCH * 12 ? 1 : 0;
  { DIL_BEGIN(0)
  PH(0) {
    KP_DECL; char* ws = kp_->ws; const int t = tid_opaque();
    float* xs = WS_PTR(float, WO.xs); float* mod = WS_PTR(float, WO.mod);
    ph_mod_gemv(I.c, I.c_ctx, I.ada_w, I.ada_b, mod, smem);
    for (int l = 0; l < 2; ++l) {
      ph_cvt_wT_tiled(I.w_in + (long)l * DM * IN_COLS, nullptr, WS_PTR(bf16_t, WO.w_inT) + (long)l * 2688 * 1024, 1024, IN_COLS, 2688, 1024, smem);
      ph_cvt_wT_tiled(I.w_out + (long)l * DM * DM, nullptr, WS_PTR(bf16_t, WO.w_outT) + (long)l * 1024 * 1024, 1024, 1024, 1024, 1024, smem);
      ph_cvt_wT_tiled(I.pe_wq + (long)l * DM * 2048, nullptr, WS_PTR(bf16_t, WO.wqT) + (long)l * 2048 * 1024, 1024, 2048, 2048, 1024, smem);
      ph_cvt_wT_tiled(I.mla_w_qb + (long)l * 256 * 384, I.mla_q_norm_g + l * 256, WS_PTR(bf16_t, WO.wqbT) + (long)l * 384 * 256, 256, 384, 384, 256, smem);
      ph_cvt_wT_tiled(I.mla_w_kvb + (long)l * 128 * 512, I.mla_kv_norm_g + l * 128, WS_PTR(bf16_t, WO.wkvbT) + (long)l * 512 * 128, 128, 512, 512, 128, smem);
      for (int d = 0; d < 2; ++d) {
        ph_cvt_wT_tiled(I.rw_w2 + ((long)l * 2 + d) * 64 * 384, nullptr, WS_PTR(bf16_t, WO.w2T) + ((long)l * 2 + d) * 384 * 64, 64, 384, 384, 64, smem);
        ph_cvt_wT_tiled(I.rw_a2 + ((long)l * 2 + d) * 64 * 384, nullptr, WS_PTR(bf16_t, WO.a2T) + ((long)l * 2 + d) * 384 * 64, 64, 384, 384, 64, smem);
      }
      ph_cvt_wT_tiled(I.rw_g2 + (long)l * 160 * 384, nullptr, WS_PTR(bf16_t, WO.g2T) + (long)l * 384 * 192, 160, 384, 384, 192, smem);
    }
    ph_cvt_bf16(I.pe_keys, WS_PTR(bf16_t, WO.keysb), 2L * 16 * 128 * 128 / 8);
    ph_rope_tables(WS_PTR(float, WO.rope_g), WS_PTR(float, WO.rope_m));
  }
  DIL_END(0) }
  GRID_BARRIER();
  for (int lq = 0; lq < 2; ++lq) {
    int l = lq; LAUNDER_S(l);
    { DIL_BEGIN(1)
    PH(1) if (l == 0) {
      KP_DECL; char* ws = kp_->ws; const int t = tid_opaque(); (void)t;
      ph_norm_mod(WS_PTR(float, WO.xs), I.norm_mix_g + l * DM, WS_PTR(float, WO.mod) + (long)l * (BATCH + 1) * 6144, 0, WS_PTR(bf16_t, WO.xn), false, I.x, I.ctx);
    }
    DIL_END(1) }
    GRID_BARRIER();
    { DIL_BEGIN(2)
    PH(2) {
      KP_DECL; char* ws = kp_->ws; const int t = tid_opaque(); (void)t;
      const bf16_t* xn = WS_PTR(bf16_t, WO.xn); const bf16_t* wT = WS_PTR(bf16_t, WO.w_inT) + (long)l * 2688 * 1024; bf16_t* Pb = WS_PTR(bf16_t, WO.Pb);
      XCD_TILE_LOOP(tile, TM * 21)
        gemm_tile_128_glds(xn, DM, wT, 1024, 1024, tile / 21, tile % 21, smem, EpiStoreBf16{Pb, IN_COLS, IN_COLS});
    }
    DIL_END(2) }
    GRID_BARRIER();
    { DIL_BEGIN(3)
    PH(3) {
      KP_DECL; char* ws = kp_->ws; const int t = tid_opaque(); (void)t;
      PrepW pw{WS_PTR(bf16_t, WO.wqbT) + (long)l * 384 * 256, WS_PTR(bf16_t, WO.wkvbT) + (long)l * 512 * 128, WS_PTR(bf16_t, WO.w2T) + (long)l * 2 * 384 * 64,
               WS_PTR(bf16_t, WO.a2T) + (long)l * 2 * 384 * 64, WS_PTR(bf16_t, WO.g2T) + (long)l * 384 * 192, I.rw_mu + (long)l * 2 * RWC, I.rw_w0 + l * 768, I.rw_a0 + l * 768};
      PrepBuf pb{WS_PTR(bf16_t, WO.Pb), WS_PTR(bf16_t, WO.tq), WS_PTR(bf16_t, WO.tkv), WS_PTR(bf16_t, WO.a_b), WS_PTR(bf16_t, WO.g_b), WS_PTR(float, WO.w_f)};
      XCD_TILE_LOOP(tile, TM * 22) prep_gemm_tile(pw, pb, tile / 22, tile % 22, smem);
    }
    DIL_END(3) }
    GRID_BARRIER();
    { DIL_BEGIN(4)
    PH(4) {
      KP_DECL; char* ws = kp_->ws; const int t = tid_opaque(); (void)t;
      FinW2 fw{I.mla_qk_g + l * 192, I.gqa_qk_g + l * 128, I.rw_mu + (long)l * 2 * RWC, I.rw_k_k + l * 384, I.rw_k_a + l * 384, WS_PTR(float, WO.rope_g), WS_PTR(float, WO.rope_m)};
      FinBuf fb{WS_PTR(bf16_t, WO.Pb), WS_PTR(bf16_t, WO.tq), WS_PTR(bf16_t, WO.tkv), WS_PTR(bf16_t, WO.a_b), WS_PTR(bf16_t, WO.mq), WS_PTR(bf16_t, WO.mk), WS_PTR(bf16_t, WO.mvT),
                WS_PTR(bf16_t, WO.gq), WS_PTR(bf16_t, WO.gk), WS_PTR(bf16_t, WO.gvT), WS_PTR(bf16_t, WO.r_b), WS_PTR(bf16_t, WO.v_b), WS_PTR(bf16_t, WO.kk_b), WS_PTR(bf16_t, WO.kd_b), WS_PTR(bf16_t, WO.bd_b)};
      for (int tile = blockIdx.x; tile < NROWS / 8; tile += gridDim.x) prep_finish_tile2(fw, fb, tile, smem);
      if (blockIdx.x == gridDim.x - 1 && t < 64) { attn_score_bound(I.mla_qk_g + l * 192, 96, 9.79795897f, (float*)(ws + 16384) + l * 4, t); attn_score_bound(I.gqa_qk_g + l * 128, 64, 8.f, (float*)(ws + 16384) + l * 4 + 1, t); }
    }
    DIL_END(4) }
    GRID_BARRIER();
    { unsigned long long dil_t0 = 0, dil_scan = 0; if (DIL_PH == 5 || DIL_PH == 11) dil_t0 = __builtin_amdgcn_s_memrealtime();
    PH(5) {
      {
        KP_DECL; char* ws = kp_->ws; const int tp = tid_opaque();
        const int njobs = BATCH * 12 * (RB / CS_L);
        for (int job = (int)blockIdx.x * 4 + (tp >> 6); job < njobs; job += (int)gridDim.x * 4)
          rw_chunk_inverse(WS_PTR(bf16_t, WO.kk_b), WS_PTR(bf16_t, WO.bd_b), WS_PTR(float, WO.w_f), WS_PTR(bf16_t, MINV_OFF), job, (long)MA * 384, smem + (tp >> 6) * CSP_WAVE_BYTES, tp & 63);
      }
      GRID_BARRIER();
      KP_DECL; char* ws = kp_->ws; const int t = tid_opaque(); (void)t;
      int* s_item = (int*)(smem + MEGA_LDS_BYTES - 16);
      unsigned* sctr = (unsigned*)ws + XB_QUEUE(4 + l);
      auto scan_loop = [&]() __attribute__((always_inline)) {
        for (;;) {
          __syncthreads();
          if (tid_opaque() == 0) *s_item = (int)xb_add(sctr, 1u);
          __syncthreads();
          const int it = *s_item;
          if (it >= BATCH * 12) break;
          rw_scan_chunked(WS_PTR(bf16_t, WO.r_b), WS_PTR(bf16_t, WO.v_b), WS_PTR(bf16_t, WO.kk_b), WS_PTR(bf16_t, WO.kd_b), WS_PTR(bf16_t, WO.bd_b), WS_PTR(float, WO.w_f), WS_PTR(float, WO.Pb),
                          it, (long)MA * 384, smem, WS_PTR(bf16_t, MINV_OFF));
        }
      };
      if (scan_role) scan_loop();
#if DIL_PH == 11
      dil_scan = __builtin_amdgcn_s_memrealtime() - dil_t0;
#endif
#ifdef SPLIT5
      GRID_BARRIER();
#endif
      const int nqt = l == 0 ? 18 : 16; const int n_mla = BATCH * 4 * nqt, n_all = BATCH * 10 * nqt;
      unsigned* qctr = (unsigned*)ws + XB_QUEUE(l);
      for (;;) {
        __syncthreads();
        if (tid_opaque() == 0) *s_item = (int)xb_add(qctr, 1u);
        __syncthreads();
        const int it = *s_item;
        if (it >= n_all) break;
        const KARG_AS MegaP* kp2_ = (const KARG_AS MegaP*)__builtin_amdgcn_kernarg_segment_ptr(); LAUNDER_S(kp2_); char* ws2 = kp2_->ws;
        if (it < n_mla) { int qt = it / (BATCH * 4), r = it % (BATCH * 4);
          attn_block<96>((const bf16_t*)(ws2 + WO.mq), 4, (const bf16_t*)(ws2 + WO.mk), 4, (const bf16_t*)(ws2 + WO.mvT), 1, (bf16_t*)(ws2 + WO.tq), 0, r / 4, r % 4, qt, smem, (const float*)(ws2 + 16384) + l * 4); }
        else { int v = it - n_mla; int qt = v / (BATCH * 6), r = v % (BATCH * 6);
          attn_block<64>((const bf16_t*)(ws2 + WO.gq), 6, (const bf16_t*)(ws2 + WO.gk), 2, (const bf16_t*)(ws2 + WO.gvT), 3, (bf16_t*)(ws2 + WO.tq), 640, r / 6, r % 6, qt, smem, (const float*)(ws2 + 16384) + l * 4 + 1); }
      }
      if (!scan_role) scan_loop();
      {
        unsigned* cctr = (unsigned*)ws + XB_QUEUE(2 + l);
        for (;;) {
          __syncthreads();
          if (tid_opaque() == 0) *s_item = (int)xb_add(cctr, 1u);
          __syncthreads();
          const int it = *s_item;
          if (it >= 512) break;
          const int tab = it >> 8, r0 = (it & 255) * 64;
          if (tab == 0) ph_cvt_fp8_rows(I.pe_u + (long)l * 16384 * DM, WS_PTR(unsigned char, TAB_U), WS_PTR(float, TAB_SU), r0, r0 + 64);
          else ph_cvt_fp8_rows(I.pe_v + (long)l * 16384 * DM, WS_PTR(unsigned char, TAB_V), WS_PTR(float, TAB_SV), r0, r0 + 64);
        }
      }
    }
#if DIL_PH == 11
    GRID_BARRIER(); if (blockIdx.x == 0 && threadIdx.x == 0) { unsigned long long t1 = __builtin_amdgcn_s_memrealtime(); unsigned long long dt = dil_scan * DIL_MULT; while (__builtin_amdgcn_s_memrealtime() - t1 < dt) __builtin_amdgcn_s_sleep(32); }
#endif
    (void)dil_scan;
    DIL_END(5) }
    GRID_BARRIER();
    { DIL_BEGIN(6)
    PH(6) {
      KP_DECL; char* ws = kp_->ws; const int t = tid_opaque(); (void)t;
      RdW rw{I.rw_r_k + l * 384, I.rw_ln_g + l * 384, I.rw_ln_b + l * 384};
      for (long row = blockIdx.x * 4 + (t >> 6); row < NROWS; row += (long)gridDim.x * 4)
        if (l == 0 || (row % RB) < SEQ) rw_readout_row2(rw, WS_PTR(float, WO.Pb), WS_PTR(bf16_t, WO.r_b), WS_PTR(bf16_t, WO.v_b), WS_PTR(bf16_t, WO.kd_b), WS_PTR(bf16_t, WO.g_b), WS_PTR(bf16_t, WO.tq), row, t & 63);
    }
    DIL_END(6) }
    GRID_BARRIER();
    { DIL_BEGIN(7)
    PH(7) {
      KP_DECL; char* ws = kp_->ws; const int t = tid_opaque(); (void)t;
      const bf16_t* mix = WS_PTR(bf16_t, WO.tq); const bf16_t* wT = WS_PTR(bf16_t, WO.w_outT) + (long)l * 1024 * 1024; float* xs = WS_PTR(float, WO.xs);
      const float* modl = WS_PTR(float, WO.mod) + (long)l * (BATCH + 1) * 6144;
      const int TM7 = l == 0 ? TM : BATCH * 16;
      XCD_TILE_LOOP(tile, TM7 * 8)
        gemm_tile_128_glds(mix, DM, wT, 1024, 1024, l == 0 ? tile / 8 : LAT_TM(tile / 8), tile % 8, smem, EpiResid{xs, modl, 2, 0, l == 0 ? I.x : (const float*)nullptr, I.ctx});
    }
    DIL_END(7) }
    GRID_BARRIER();
    { DIL_BEGIN(8)
    PH(8) {
      KP_DECL; char* ws = kp_->ws; const int t = tid_opaque(); (void)t;
      ph_norm_mod(WS_PTR(float, WO.xs), I.norm_ffn_g + l * DM, WS_PTR(float, WO.mod) + (long)l * (BATCH + 1) * 6144, 3, WS_PTR(bf16_t, WO.xn), l != 0);
    }
    DIL_END(8) }
    GRID_BARRIER();
    { DIL_BEGIN(9)
    PH(9) {
      KP_DECL; char* ws = kp_->ws; const int t = tid_opaque(); (void)t;
      const bf16_t* xn = WS_PTR(bf16_t, WO.xn); const bf16_t* wT = WS_PTR(bf16_t, WO.wqT) + (long)l * 2048 * 1024; const bf16_t* kb = WS_PTR(bf16_t, WO.keysb) + (long)l * 16 * 128 * 128;
      unsigned* top1 = WS_PTR(unsigned, WO.tq);
      const int TM9 = l == 0 ? TM : BATCH * 16;
      XCD_TILE_LOOP(tile, TM9 * 16) { peer_q_top1_tile(xn, wT, kb, top1, l == 0 ? tile / 16 : LAT_TM(tile / 16), tile % 16, smem); __syncthreads(); }
    }
    DIL_END(9) }
    GRID_BARRIER();
    { DIL_BEGIN(10)
    PH(10) {
      KP_DECL; char* ws = kp_->ws; const int t = tid_opaque(); (void)t;
      const float* modl = WS_PTR(float, WO.mod) + (long)l * (BATCH + 1) * 6144;
      const int ntok10 = l == 0 ? NROWS : BATCH * SEQ;
      peer_lists_build3(WS_PTR(unsigned, WO.tq), WS_PTR(float, TAB_SU), WS_PTR(float, TAB_SV), WS_PTR(char, WO.mq), ntok10, smem);
#ifdef BUILD_TWICE
      peer_lists_build3(WS_PTR(unsigned, WO.tq), WS_PTR(float, TAB_SU), WS_PTR(float, TAB_SV), WS_PTR(char, WO.mq), ntok10, smem);
#endif
#ifdef PASS_SYNC
      { const int per_block10 = (ntok10 + (int)gridDim.x - 1) / (int)gridDim.x; const int npass10 = (per_block10 + 11) / 12;
        for (int ps = 0; ps < npass10; ++ps) {
          if (ps) GRID_BARRIER();
          peer_gather_sweep3(WS_PTR(bf16_t, WO.xn), WS_PTR(char, WO.mq), WS_PTR(unsigned char, TAB_U), WS_PTR(unsigned char, TAB_V), modl, WS_PTR(float, WO.xs), ntok10, smem,
                         I.norm_mix_g + (l == 0 ? DM : 0), WS_PTR(float, WO.mod) + (long)(l == 0 ? 1 : 0) * (BATCH + 1) * 6144, WS_PTR(bf16_t, WO.xn), l == 0 ? (float*)nullptr : kp_->out, ps, ps + 1);
        } }
#else
      peer_gather_sweep3(WS_PTR(bf16_t, WO.xn), WS_PTR(char, WO.mq), WS_PTR(unsigned char, TAB_U), WS_PTR(unsigned char, TAB_V), modl, WS_PTR(float, WO.xs), ntok10, smem,
                         I.norm_mix_g + (l == 0 ? DM : 0), WS_PTR(float, WO.mod) + (long)(l == 0 ? 1 : 0) * (BATCH + 1) * 6144, WS_PTR(bf16_t, WO.xn), l == 0 ? (float*)nullptr : kp_->out, 0, 1 << 20);
#endif
    }
    DIL_END(10) }
    GRID_BARRIER();
  }
}

extern "C" void kernel_launch(void* const* d_in, const int* in_sizes, int n_in, void* d_out, int out_size, void* d_ws, size_t ws_size,
                              hipStream_t stream) {
  MegaP p{};
  const float** pp = (const float**)&p.in;
  for (int i = 0; i < 31; ++i) pp[i] = (const float*)d_in[i];
  p.ws = (char*)d_ws; p.out = (float*)d_out;
  if (WO.total > ws_size) return;
  static int grid_blocks = 0;
  if (!grid_blocks) {
    int dev = 0, cus = 0, per_cu = 0;
    hipGetDevice(&dev);
    hipDeviceGetAttribute(&cus, hipDeviceAttributeMultiprocessorCount, dev);
    hipOccupancyMaxActiveBlocksPerMultiprocessor(&per_cu, mega_kernel, 256, 0);
    if (per_cu > 2) per_cu = 2;
    if (per_cu < 1) per_cu = 1;
    grid_blocks = cus * per_cu;
  }
  hipMemsetAsync(d_ws, 0, 32768, stream);
  void* args[] = {&p};
  hipLaunchCooperativeKernel((void*)mega_kernel, dim3(grid_blocks), dim3(256), args, 0, stream);
}
```

```cpp
#include <hip/hip_runtime.h>
#define PEER_EXP(x) __builtin_amdgcn_exp2f((x) * 1.4426950408889634f)
#ifndef BATCH
#define BATCH 8
#endif
#ifndef SEQ
#define SEQ 2048
#endif
#ifndef CTX_LEN
#define CTX_LEN 256
#endif
#define DM 1024
#define RB (SEQ + CTX_LEN)
#define NROWS (BATCH * RB)
#define IN_COLS 2624
#define MLA_OFF 0
#define RW_OFF 416
#define GQA_OFF 1984
#define RWC 1568
#define EPSN 1e-6f

__device__ inline float sigmoidf_(float x) { return 1.f / (1.f + expf(-x)); }
__device__ inline float siluf_(float x) { return x * sigmoidf_(x); }
__device__ inline float softplusf_(float x) { return fmaxf(x, 0.f) + log1pf(expf(-fabsf(x))); }
__device__ inline float geluf_(float x) { return 0.5f * x * (1.f + tanhf(0.7978845608028654f * (x + 0.044715f * x * x * x))); }

__global__ void nk_copy_in(const float* x, const float* ctx, float* xs) {
  long i = (long)blockIdx.x * blockDim.x + threadIdx.x;
  if (i >= (long)NROWS * DM) return;
  int d = i % DM; long row = i / DM; int b = row / RB, lr = row % RB;
  xs[i] = lr < SEQ ? x[((long)b * SEQ + lr) * DM + d] : ctx[((long)b * CTX_LEN + (lr - SEQ)) * DM + d];
}
__global__ void nk_copy_out(const float* xs, float* out) {
  long i = (long)blockIdx.x * blockDim.x + threadIdx.x;
  if (i >= (long)BATCH * SEQ * DM) return;
  int d = i % DM; long row = i / DM; int b = row / SEQ, t = row % SEQ;
  out[i] = xs[((long)b * RB + t) * DM + d];
}
__global__ void nk_mod(const float* c, const float* c_ctx, const float* ada_w, const float* ada_b, float* mod) {
  long i = (long)blockIdx.x * blockDim.x + threadIdx.x;
  if (i >= 2L * (BATCH + 1) * 6144) return;
  int j = i % 6144; int bb = (i / 6144) % (BATCH + 1); int l = i / (6144 * (BATCH + 1));
  const float* cv = bb < BATCH ? c + (long)bb * DM : c_ctx;
  const float* w = ada_w + (long)l * DM * 6144;
  float acc = 0.f;
  for (int k = 0; k < DM; ++k) acc += siluf_(cv[k]) * w[(long)k * 6144 + j];
  mod[i] = acc + ada_b[l * 6144 + j];
}
__global__ void nk_norm_mod(const float* xs, const float* g, const float* modl, int shift_idx, float* xn, int M, int bidx) {
  long row = (long)blockIdx.x * blockDim.x + threadIdx.x;
  if (row >= M) return;
  int lr = row % RB; int bb = lr < SEQ ? bidx : BATCH;
  const float* sh = modl + ((long)bb * 6 + shift_idx) * DM; const float* sc = sh + DM;
  const float* xr = xs + row * DM; float ss = 0.f;
  for (int d = 0; d < DM; ++d) ss += xr[d] * xr[d];
  float inv = 1.f / sqrtf(ss / DM + EPSN);
  for (int d = 0; d < DM; ++d) xn[row * DM + d] = xr[d] * inv * g[d] * (1.f + sc[d]) + sh[d];
}
__global__ void nk_gemm(const float* A, const float* W, float* C, int M, int N, int K) {
  long i = (long)blockIdx.x * blockDim.x + threadIdx.x;
  if (i >= (long)M * N) return;
  int n = i % N; long m = i / N; float acc = 0.f;
  for (int k = 0; k < K; ++k) acc += A[m * K + k] * W[(long)k * N + n];
  C[i] = acc;
}
__global__ void nk_mla_q1(const float* P, const float* qng, const float* wqb, float* tq, int M) {
  long i = (long)blockIdx.x * blockDim.x + threadIdx.x;
  if (i >= (long)M * 384) return;
  int j = i % 384; long r = i / 384; const float* cq = P + r * IN_COLS;
  float ss = 0.f; for (int k = 0; k < 256; ++k) ss += cq[k] * cq[k];
  float inv = 1.f / sqrtf(ss / 256 + EPSN), acc = 0.f;
  for (int k = 0; k < 256; ++k) acc += cq[k] * inv * qng[k] * wqb[k * 384 + j];
  tq[i] = acc;
}
__global__ void nk_mla_kv1(const float* P, const float* kvng, const float* wkvb, float* tkv, int M) {
  long i = (long)blockIdx.x * blockDim.x + threadIdx.x;
  if (i >= (long)M * 512) return;
  int j = i % 512; long r = i / 512; const float* ck = P + r * IN_COLS + 256;
  float ss = 0.f; for (int k = 0; k < 128; ++k) ss += ck[k] * ck[k];
  float inv = 1.f / sqrtf(ss / 128 + EPSN), acc = 0.f;
  for (int k = 0; k < 128; ++k) acc += ck[k] * inv * kvng[k] * wkvb[k * 512 + j];
  tkv[i] = acc;
}
__global__ void nk_mla_qk2(const float* P, const float* tq, const float* tkv, const float* qkg, float* mq, float* mk, int M) {
  long i = (long)blockIdx.x * blockDim.x + threadIdx.x;
  if (i >= (long)M * 8) return;
  int which = i % 2, h = (i / 2) % 4; long r = i / 8; int lr = r % RB;
  float ss = 0.f;
  for (int e = 0; e < 96; ++e) {
    float v = which == 0 ? tq[r * 384 + h * 96 + e] : (e < 64 ? tkv[r * 512 + h * 128 + e] : P[r * IN_COLS + 384 + (e - 64)]);
    ss += v * v;
  }
  float inv = 1.f / sqrtf(ss / 96 + EPSN);
  const float* g = qkg + which * 96; float* o = (which == 0 ? mq : mk) + r * 384 + h * 96;
  for (int e = 0; e < 64; ++e) {
    float v = which == 0 ? tq[r * 384 + h * 96 + e] : tkv[r * 512 + h * 128 + e];
    o[e] = v * inv * g[e];
  }
  for (int j = 0; j < 16; ++j) {
    float va = which == 0 ? tq[r * 384 + h * 96 + 64 + j] : P[r * IN_COLS + 384 + j];
    float vb = which == 0 ? tq[r * 384 + h * 96 + 80 + j] : P[r * IN_COLS + 384 + 16 + j];
    va *= inv * g[64 + j]; vb *= inv * g[80 + j];
    if (lr < SEQ) {
      int pos = j < 8 ? lr / 64 : lr % 64; float fr = powf(10000.f, -(float)(j & 7) / 8.f);
      float ang = (float)pos * fr, cs = cosf(ang), sn = sinf(ang);
      o[64 + j] = va * cs - vb * sn; o[80 + j] = va * sn + vb * cs;
    } else { o[64 + j] = va; o[80 + j] = vb; }
  }
}
__global__ void nk_gqa_prep(const float* P, const float* qkg, float* gq, float* gk, int M) {
  long i = (long)blockIdx.x * blockDim.x + threadIdx.x;
  if (i >= (long)M * 8) return;
  int h = i % 8; long r = i / 8; int lr = r % RB;
  const float* src = P + r * IN_COLS + GQA_OFF + h * 64;
  const float* g = qkg + (h < 6 ? 0 : 64);
  float* o = h < 6 ? gq + r * 384 + h * 64 : gk + r * 128 + (h - 6) * 64;
  float ss = 0.f; for (int e = 0; e < 64; ++e) ss += src[e] * src[e];
  float inv = 1.f / sqrtf(ss / 64 + EPSN);
  for (int j = 0; j < 32; ++j) {
    float va = src[j] * inv * g[j], vb = src[32 + j] * inv * g[32 + j];
    if (lr < SEQ) {
      int pos = j < 16 ? lr / 64 : lr % 64; float fr = powf(10000.f, -(float)(j & 15) / 16.f);
      float ang = (float)pos * fr, cs = cosf(ang), sn = sinf(ang);
      o[j] = va * cs - vb * sn; o[32 + j] = va * sn + vb * cs;
    } else { o[j] = va; o[32 + j] = vb; }
  }
}
template <int DQ>
__global__ void __launch_bounds__(256) nk_attn(const float* q, int qs, const float* k, int ks, const float* v, int vs, int vhs, int H, int G, float* mix, int ooff, int M) {
  long i = (long)blockIdx.x * blockDim.x + threadIdx.x;
  if (i >= (long)M * H) return;
  int h = i % H; long r = i / H; int b = r / RB, lr = r % RB; int kh = h / G;
  float qv[DQ];
#pragma unroll
  for (int e = 0; e < DQ; ++e) qv[e] = q[r * qs + h * DQ + e];
  float acc[64];
#pragma unroll
  for (int e = 0; e < 64; ++e) acc[e] = 0.f;
  float mx = -1e30f, l = 0.f; const float scale = 1.f / sqrtf((float)DQ);
  int k0 = lr < SEQ ? 0 : SEQ, k1 = RB;
  for (int kr = k0; kr < k1; ++kr) {
    long rr = (long)b * RB + kr; const float* kp = k + rr * ks + kh * DQ; float s = 0.f;
#pragma unroll
    for (int e = 0; e < DQ; ++e) s += qv[e] * kp[e];
    s *= scale;
    float mn = fmaxf(mx, s), al = expf(mx - mn), pp = expf(s - mn);
    l = l * al + pp; mx = mn; const float* vp = v + rr * vs + kh * vhs;
#pragma unroll
    for (int e = 0; e < 64; ++e) acc[e] = acc[e] * al + pp * vp[e];
  }
#pragma unroll
  for (int e = 0; e < 64; ++e) mix[r * DM + ooff + h * 64 + e] = acc[e] / l;
}
__global__ void nk_rw_shift(const float* P, const float* mu, float* rwx, int M) {
  long i = (long)blockIdx.x * blockDim.x + threadIdx.x;
  if (i >= (long)M * RWC) return;
  int c = i % RWC; long r = i / RWC; int lr = r % RB;
  bool first = (lr == 0) || (lr == SEQ), last = (lr == SEQ - 1) || (lr == RB - 1);
  float p = P[r * IN_COLS + RW_OFF + c];
  float pv = first ? 0.f : P[(r - 1) * IN_COLS + RW_OFF + c], nx = last ? 0.f : P[(r + 1) * IN_COLS + RW_OFF + c];
  rwx[i] = p + mu[c] * (pv - p) + mu[RWC + c] * (nx - p);
}
__global__ void nk_rw_prep(const float* rwx, const float* w0, const float* w2, const float* a0, const float* a2, const float* g2,
                           const float* k_k, const float* k_a, float* dec, float* kd, float* bd, float* kk, float* gg, int M) {
  long i = (long)blockIdx.x * blockDim.x + threadIdx.x;
  if (i >= (long)M * 384) return;
  int c = i % 384; long r = i / 384; int h = c / 64; const float* xr = rwx + r * RWC;
  float kv = xr[384 + c];
  float ss = 0.f; for (int n = 0; n < 64; ++n) { float t = xr[384 + h * 64 + n] * k_k[h * 64 + n]; ss += t * t; }
  float kkv = kv * k_k[c] / sqrtf(ss + 1e-12f);
  kk[i] = kkv;
  for (int d = 0; d < 2; ++d) {
    float wr = w0[d * 384 + c], ar = a0[d * 384 + c];
    for (int j = 0; j < 64; ++j) { wr += tanhf(xr[1152 + d * 64 + j]) * w2[(d * 64 + j) * 384 + c]; ar += xr[1280 + d * 64 + j] * a2[(d * 64 + j) * 384 + c]; }
    float dc = expf(-expf(-softplusf_(-wr) - 0.5f)); float a = sigmoidf_(ar);
    dec[(long)d * M * 384 + i] = dc; kd[(long)d * M * 384 + i] = kv * (1.f + (a - 1.f) * k_a[c]); bd[(long)d * M * 384 + i] = kkv * a;
  }
  float g = 0.f; for (int j = 0; j < 160; ++j) g += sigmoidf_(xr[1408 + j]) * g2[j * 384 + c];
  gg[i] = g;
}
__global__ void __launch_bounds__(256) nk_rw_scan(const float* rwx, const float* dec, const float* kd, const float* bd, const float* kk, float* y, int M, int nb) {
  long t = (long)blockIdx.x * blockDim.x + threadIdx.x;
  if (t >= (long)nb * 2 * 6 * 64) return;
  int i = t % 64, h = (t / 64) % 6, d = (t / 384) % 2, b = t / 768;
  float S[64];
#pragma unroll
  for (int j = 0; j < 64; ++j) S[j] = 0.f;
  for (int step = 0; step < RB; ++step) {
    int lr;
    if (step < CTX_LEN) lr = SEQ + (d == 0 ? step : CTX_LEN - 1 - step);
    else lr = d == 0 ? step - CTX_LEN : SEQ - 1 - (step - CTX_LEN);
    long r = (long)b * RB + lr; long o = (long)d * M * 384 + r * 384 + h * 64;
    const float* rp = rwx + r * RWC + h * 64; const float* wp = dec + o; const float* kp = kd + o; const float* bp = bd + o; const float* kkp = kk + r * 384 + h * 64;
    float vi = rwx[r * RWC + 768 + h * 64 + i];
    float skk = 0.f;
#pragma unroll
    for (int j = 0; j < 64; ++j) skk += S[j] * kkp[j];
    float yy = 0.f;
#pragma unroll
    for (int j = 0; j < 64; ++j) { S[j] = S[j] * wp[j] - skk * bp[j] + vi * kp[j]; yy += S[j] * rp[j]; }
    y[o + i] = yy;
  }
}
__global__ void nk_rw_readout(const float* rwx, const float* y, const float* kd, const float* gg, const float* r_k, const float* ln_g, const float* ln_b, float* mix, int M, long yds) {
  long i = (long)blockIdx.x * blockDim.x + threadIdx.x;
  if (i >= (long)M * 6) return;
  int h = i % 6; long r = i / 6; long o = r * 384 + h * 64; long ds = (long)M * 384;
  float mean = 0.f; for (int n = 0; n < 64; ++n) mean += y[o + n] + y[yds + o + n];
  mean /= 64.f;
  float var = 0.f, coef = 0.f;
  for (int n = 0; n < 64; ++n) {
    float yy = y[o + n] + y[yds + o + n] - mean; var += yy * yy;
    coef += rwx[r * RWC + h * 64 + n] * (kd[o + n] + kd[ds + o + n]) * r_k[h * 64 + n];
  }
  var /= 64.f; float inv = 1.f / sqrtf(var + 64e-5f);
  for (int n = 0; n < 64; ++n) {
    float yn = (y[o + n] + y[yds + o + n] - mean) * inv * ln_g[h * 64 + n] + ln_b[h * 64 + n];
    mix[r * DM + 256 + h * 64 + n] = (yn + coef * rwx[r * RWC + 768 + h * 64 + n]) * gg[o + n];
  }
}
__global__ void nk_gemm_res(const float* A, const float* W, const float* modl, int gi, float* xs, int M, int bidx) {
  long i = (long)blockIdx.x * blockDim.x + threadIdx.x;
  if (i >= (long)M * DM) return;
  int j = i % DM; long r = i / DM; int lr = r % RB; int bb = lr < SEQ ? bidx : BATCH;
  float acc = 0.f; for (int k = 0; k < DM; ++k) acc += A[r * DM + k] * W[(long)k * DM + j];
  xs[i] += modl[((long)bb * 6 + gi) * DM + j] * acc;
}
__global__ void nk_peer_score(const float* pq, const float* keys, float* sc, int M) {
  long i = (long)blockIdx.x * blockDim.x + threadIdx.x;
  if (i >= (long)M * 2048) return;
  int k = i % 128, ps = (i / 128) % 16; long r = i / 2048;
  const float* q = pq + r * 2048 + ps * 128; const float* ky = keys + ((long)ps * 128 + k) * 128;
  float acc = 0.f; for (int d = 0; d < 128; ++d) acc += q[d] * ky[d];
  sc[i] = acc;
}
__global__ void nk_peer_top1(const float* sc, float* ts, int* ti, int M) {
  long i = (long)blockIdx.x * blockDim.x + threadIdx.x;
  if (i >= (long)M * 16) return;
  const float* s = sc + i * 128; float pv = 3e38f; int pi = -1;
  for (int t = 0; t < 16; ++t) {
    float bv = -3e38f; int bi = -1;
    for (int k = 0; k < 128; ++k) {
      float v = s[k]; bool ok = (v < pv) || (v == pv && k > pi);
      if (ok && (bi < 0 || v > bv)) { bv = v; bi = k; }
    }
    ts[i * 16 + t] = bv; ti[i * 16 + t] = bi; pv = bv; pi = bi;
  }
}
__global__ void nk_peer_top2(const float* ts, const int* ti, int* pe, float* pg, int M) {
  long i = (long)blockIdx.x * blockDim.x + threadIdx.x;
  if (i >= (long)M * 8) return;
  const float* s1 = ts + i * 32; const float* s2 = s1 + 16; const int* i1 = ti + i * 32; const int* i2 = i1 + 16;
  float pv = 3e38f; int pi = -1; float mx = 0.f, sum = 0.f;
  for (int t = 0; t < 16; ++t) {
    float bv = -3e38f; int bi = -1;
    for (int c = 0; c < 256; ++c) {
      float v = s1[c / 16] + s2[c % 16]; bool ok = (v < pv) || (v == pv && c > pi);
      if (ok && (bi < 0 || v > bv)) { bv = v; bi = c; }
    }
    if (t == 0) mx = bv;
    float e = expf(bv - mx); sum += e;
    pe[i * 16 + t] = i1[bi / 16] * 128 + i2[bi % 16]; pg[i * 16 + t] = e; pv = bv; pi = bi;
  }
  for (int t = 0; t < 16; ++t) pg[i * 16 + t] /= sum;
}
__global__ void nk_peer_act(const float* xn, const float* u, const int* pe, const float* pg, float* pw, int M) {
  long i = (long)blockIdx.x * blockDim.x + threadIdx.x;
  if (i >= (long)M * 128) return;
  long r = i / 128; const float* ur = u + (long)pe[i] * DM; const float* xr = xn + r * DM;
  float acc = 0.f; for (int d = 0; d < DM; ++d) acc += xr[d] * ur[d];
  pw[i] = pg[i] * geluf_(acc);
}
__global__ void nk_peer_out(const float* v, const int* pe, const float* pw, const float* modl, float* xs, int M, int bidx) {
  long i = (long)blockIdx.x * blockDim.x + threadIdx.x;
  if (i >= (long)M * DM) return;
  int j = i % DM; long r = i / DM; int lr = r % RB; int bb = lr < SEQ ? bidx : BATCH;
  float acc = 0.f; for (int k = 0; k < 128; ++k) acc += pw[r * 128 + k] * v[(long)pe[r * 128 + k] * DM + j];
  xs[i] += modl[((long)bb * 6 + 5) * DM + j] * acc;
}


#ifndef PEER_EXP
#define PEER_EXP(x) expf(x)
#endif
__device__ __forceinline__ unsigned f2sortable(float s) { unsigned f = __float_as_uint(s); return (f & 0x80000000u) ? ~f : (f | 0x80000000u); }
__device__ __forceinline__ float sortable2f(unsigned o) { unsigned f = (o & 0x80000000u) ? (o & 0x7fffffffu) : ~o; return __uint_as_float(f); }
__device__ __forceinline__ unsigned enc_key(float s, int idx) { return (f2sortable(s) & ~127u) | (unsigned)(127 - idx); }
__device__ __forceinline__ void dec_key(unsigned k, float& s, int& idx) { idx = 127 - (int)(k & 127u); s = sortable2f(k & ~127u); }
__device__ __forceinline__ unsigned umax_(unsigned a, unsigned b) { return a > b ? a : b; }
__device__ __forceinline__ unsigned umin_(unsigned a, unsigned b) { return a < b ? a : b; }
__device__ __forceinline__ void ins16(unsigned (&l)[16], unsigned x) {
#pragma unroll
  for (int i = 0; i < 16; ++i) { unsigned mx = umax_(l[i], x); x = umin_(l[i], x); l[i] = mx; }
}
__device__ __forceinline__ void merge16(unsigned (&a)[16], const unsigned (&brev)[16]) {
#pragma unroll
  for (int i = 0; i < 16; ++i) a[i] = umax_(a[i], brev[i]);
#pragma unroll
  for (int d = 8; d >= 1; d >>= 1)
#pragma unroll
    for (int i = 0; i < 16; ++i) if ((i & d) == 0) { unsigned hi = umax_(a[i], a[i + d]), lo = umin_(a[i], a[i + d]); a[i] = hi; a[i + d] = lo; }
}
__device__ __forceinline__ void peer_combine(const unsigned* L0, const unsigned* L1, int* e_out, float* g_out) {
  float s0[16], s1[16];
#pragma unroll
  for (int i = 0; i < 16; ++i) { int ix; dec_key(L0[i], s0[i], ix); dec_key(L1[i], s1[i], ix); }
  unsigned sel[16];
#pragma unroll
  for (int i = 0; i < 16; ++i) sel[i] = 0u;
#pragma unroll
  for (int i = 0; i < 16; ++i)
#pragma unroll
    for (int j = 0; j < 16; ++j)
      if ((i + 1) * (j + 1) <= 16) { unsigned k = (f2sortable(s0[i] + s1[j]) & ~255u) | (unsigned)(255 - (i * 16 + j)); ins16(sel, k); }
  float mx = -3e38f;
#pragma unroll
  for (int t = 0; t < 16; ++t) {
    int c = 255 - (int)(sel[t] & 255u); int i = c >> 4, j = c & 15;
    float a, b; int ia, ib; dec_key(L0[i], a, ia); dec_key(L1[j], b, ib);
    float s = a + b; e_out[t] = ia * 128 + ib; g_out[t] = s; mx = fmaxf(mx, s);
  }
  float sum = 0.f;
#pragma unroll
  for (int t = 0; t < 16; ++t) { float e = PEER_EXP(g_out[t] - mx); g_out[t] = e; sum += e; }
  float inv = 1.f / sum;
#pragma unroll
  for (int t = 0; t < 16; ++t) g_out[t] *= inv;
}
__global__ void hk_peer_top1(const float* pq, const float* keys, unsigned* top1, int M) {
  long i = (long)blockIdx.x * blockDim.x + threadIdx.x;
  if (i >= (long)M * 16) return;
  int ps = i % 16; long r = i / 16; const float* q = pq + r * 2048 + ps * 128;
  unsigned la[16], lb[16], lbr[16];
#pragma unroll
  for (int t = 0; t < 16; ++t) { la[t] = 0u; lb[t] = 0u; }
  for (int k = 0; k < 128; ++k) {
    const float* ky = keys + ((long)ps * 128 + k) * 128; float acc = 0.f;
    for (int d = 0; d < 128; ++d) acc += q[d] * ky[d];
    unsigned key = enc_key(acc, k);
    if (k < 64) ins16(la, key); else ins16(lb, key);
  }
#pragma unroll
  for (int t = 0; t < 16; ++t) lbr[t] = lb[15 - t];
  merge16(la, lbr);
#pragma unroll
  for (int t = 0; t < 16; ++t) top1[i * 16 + t] = la[t];
}
__global__ void hk_peer_combine(const unsigned* top1, int* pe, float* pg, int M) {
  long i = (long)blockIdx.x * blockDim.x + threadIdx.x;
  if (i >= (long)M * 8) return;
  peer_combine(top1 + i * 32, top1 + i * 32 + 16, pe + i * 16, pg + i * 16);
}
typedef unsigned short bf16_t;
__device__ __forceinline__ int tid_opaque() { int t = threadIdx.x; asm volatile("" : "+v"(t)); return t; }
typedef __attribute__((ext_vector_type(8))) short bf16x8;
typedef __attribute__((ext_vector_type(4))) float f32x4;
typedef __attribute__((ext_vector_type(16))) float f32x16;
typedef __attribute__((ext_vector_type(4))) unsigned u32x4;

typedef __attribute__((ext_vector_type(2))) __bf16 bf16v2;
typedef __attribute__((ext_vector_type(2))) float f32v2;
template <int CTRL> __device__ __forceinline__ float dpp_get(float x) { return __builtin_bit_cast(float, __builtin_amdgcn_update_dpp(0, __builtin_bit_cast(int, x), CTRL, 0xf, 0xf, true)); }
__device__ __forceinline__ float swz_xor4(float x) { return __builtin_bit_cast(float, __builtin_amdgcn_ds_swizzle(__builtin_bit_cast(int, x), 0x101F)); }
__device__ __forceinline__ float xor4_get(float x) { const int xi = __builtin_bit_cast(int, x);
  int r = __builtin_amdgcn_update_dpp(xi, xi, 0x114, 0xf, 0xA, false); r = __builtin_amdgcn_update_dpp(r, xi, 0x104, 0xf, 0x5, false); return __builtin_bit_cast(float, r); }
__device__ __forceinline__ float xor16_sum(float x) { const unsigned xi = __builtin_bit_cast(unsigned, x); auto q = __builtin_amdgcn_permlane16_swap(xi, xi, false, false);
  return __builtin_bit_cast(float, (unsigned)q[0]) + __builtin_bit_cast(float, (unsigned)q[1]); }
__device__ __forceinline__ float xor32_sum(float x) { const unsigned xi = __builtin_bit_cast(unsigned, x); auto q = __builtin_amdgcn_permlane32_swap(xi, xi, false, false);
  return __builtin_bit_cast(float, (unsigned)q[0]) + __builtin_bit_cast(float, (unsigned)q[1]); }
__device__ __forceinline__ float xor32_max(float x) { const unsigned xi = __builtin_bit_cast(unsigned, x); auto q = __builtin_amdgcn_permlane32_swap(xi, xi, false, false);
  return fmaxf(__builtin_bit_cast(float, (unsigned)q[0]), __builtin_bit_cast(float, (unsigned)q[1])); }
__device__ __forceinline__ unsigned pack2bf(float a, float b) { f32v2 v = {a, b}; bf16v2 r = __builtin_convertvector(v, bf16v2); return __builtin_bit_cast(unsigned, r); }
__device__ __forceinline__ bf16_t f2bf(float f) { return (bf16_t)(pack2bf(f, 0.f) & 0xffffu); }
__device__ __forceinline__ float bf2f(bf16_t h) { return __uint_as_float(((unsigned)h) << 16); }

__device__ __forceinline__ float fexp_(float x) { return __builtin_amdgcn_exp2f(x * 1.4426950408889634f); }
__device__ __forceinline__ float frcp_(float x) { return __builtin_amdgcn_rcpf(x); }
__device__ __forceinline__ float fsigmoid_(float x) { return frcp_(1.f + fexp_(-x)); }
__device__ __forceinline__ float ftanh_(float x) { return 1.f - 2.f * frcp_(fexp_(2.f * x) + 1.f); }
__device__ __forceinline__ float fgelu_(float x) { return x * fsigmoid_(1.5957691216057308f * (x + 0.044715f * x * x * x)); }
__device__ __forceinline__ float fdecay_(float w) { return fexp_(-0.6065306597126334f * fsigmoid_(w)); }
#define GEMM_LDS_BYTES 32768
struct ALoadPlain { const bf16_t* A; int lda;
  __device__ __forceinline__ u32x4 operator()(int row, int k) const { return *(const u32x4*)(A + (long)row * lda + k); } };
#define GEMM_STAGE_WRITE(RA, RB) do { _Pragma("unroll") for (int i = 0; i < 4; ++i) { int r = lrow + 32 * i; int off = r * 128 + ((lchunk ^ (r & 7)) << 4); *(u32x4*)(As + off) = RA[i]; *(u32x4*)(Bs + off) = RB[i]; } } while (0)
#define GEMM_COMPUTE_TILE() do { _Pragma("unroll") for (int ks = 0; ks < 2; ++ks) { bf16x8 af[4], bfr[4]; \
    _Pragma("unroll") for (int i = 0; i < 4; ++i) { int r = wm * 64 + i * 16 + fr; af[i] = *(const bf16x8*)(As + r * 128 + (((ks * 4 + fq) ^ (r & 7)) << 4)); \
      int rn = wn * 64 + i * 16 + fr; bfr[i] = *(const bf16x8*)(Bs + rn * 128 + (((ks * 4 + fq) ^ (rn & 7)) << 4)); } \
    _Pragma("unroll") for (int i = 0; i < 4; ++i) _Pragma("unroll") for (int j = 0; j < 4; ++j) acc[i][j] = __builtin_amdgcn_mfma_f32_16x16x32_bf16(bfr[j], af[i], acc[i][j], 0, 0, 0); } } while (0)
template <class ALoad, class Epi>
__device__ __forceinline__ void gemm_tile_128(ALoad aload, const bf16_t* __restrict__ Bt, int ldb, int K,
                                              int tile_m, int tile_n, char* smem, Epi epi) {
  const int t = tid_opaque(), lane = t & 63, wave = t >> 6;
  const int wm = wave >> 1, wn = wave & 1;
  char* As = smem; char* Bs = smem + 16384;
  const int lrow = t >> 3, lchunk = t & 7;
  const int arow = tile_m * 128 + lrow;
  const bf16_t* bg = Bt + (long)(tile_n * 128 + lrow) * ldb + lchunk * 8;
  u32x4 ra0[4], rb0[4], ra1[4], rb1[4];
#pragma unroll
  for (int i = 0; i < 4; ++i) { ra0[i] = aload(arow + 32 * i, lchunk * 8); rb0[i] = *(const u32x4*)(bg + (long)(32 * i) * ldb); }
  if (K > 64) {
#pragma unroll
    for (int i = 0; i < 4; ++i) { ra1[i] = aload(arow + 32 * i, 64 + lchunk * 8); rb1[i] = *(const u32x4*)(bg + (long)(32 * i) * ldb + 64); }
  }
  f32x4 acc[4][4];
#pragma unroll
  for (int i = 0; i < 4; ++i)
#pragma unroll
    for (int j = 0; j < 4; ++j) acc[i][j] = (f32x4){0.f, 0.f, 0.f, 0.f};
  const int fr = lane & 15, fq = lane >> 4;
  for (int k0 = 0; k0 < K; k0 += 128) {
    __syncthreads();
    GEMM_STAGE_WRITE(ra0, rb0);
    __syncthreads();
    if (k0 + 128 < K) {
#pragma unroll
      for (int i = 0; i < 4; ++i) { ra0[i] = aload(arow + 32 * i, k0 + 128 + lchunk * 8); rb0[i] = *(const u32x4*)(bg + (long)(32 * i) * ldb + k0 + 128); }
    }
    GEMM_COMPUTE_TILE();
    if (k0 + 64 < K) {
      __syncthreads();
      GEMM_STAGE_WRITE(ra1, rb1);
      __syncthreads();
      if (k0 + 192 < K) {
#pragma unroll
        for (int i = 0; i < 4; ++i) { ra1[i] = aload(arow + 32 * i, k0 + 192 + lchunk * 8); rb1[i] = *(const u32x4*)(bg + (long)(32 * i) * ldb + k0 + 192); }
      }
      GEMM_COMPUTE_TILE();
    }
  }
#pragma unroll
  for (int i = 0; i < 4; ++i)
#pragma unroll
    for (int j = 0; j < 4; ++j) {
      int m = tile_m * 128 + wm * 64 + i * 16 + fr; int n0 = tile_n * 128 + wn * 64 + j * 16 + fq * 4;
      epi(m, n0, acc[i][j]);
    }
}

typedef __attribute__((address_space(3))) void lds_void_t;
typedef __attribute__((address_space(1))) const void glb_cvoid_t;
#define GEMM_GLDS_BYTES 65536
__device__ __forceinline__ void gemm_mainloop_glds(const bf16_t* __restrict__ A, int lda, const bf16_t* __restrict__ Bt, int ldb, int K,
                                                   int tile_m, int tile_n, char* smem, f32x4 (&acc)[4][4]) {
  const int t = tid_opaque(), lane = t & 63, wave = t >> 6;
  const int wm = wave >> 1, wn = wave & 1, fr = lane & 15, fq = lane >> 4;
  const int lrow = t >> 3, cl = (t & 7) ^ (lrow & 7);
  const bf16_t* ag = A + (long)(tile_m * 128 + lrow) * lda + cl * 8;
  const bf16_t* bg = Bt + (long)(tile_n * 128 + lrow) * ldb + cl * 8;
  const int wbase = __builtin_amdgcn_readfirstlane(wave) * 1024;
#pragma unroll
  for (int i = 0; i < 4; ++i)
#pragma unroll
    for (int j = 0; j < 4; ++j) acc[i][j] = (f32x4){0.f, 0.f, 0.f, 0.f};
  __syncthreads();
#pragma unroll
  for (int i = 0; i < 4; ++i) {
    __builtin_amdgcn_global_load_lds((glb_cvoid_t*)(ag + (long)(32 * i) * lda), (lds_void_t*)(smem + i * 4096 + wbase), 16, 0, 0);
    __builtin_amdgcn_global_load_lds((glb_cvoid_t*)(bg + (long)(32 * i) * ldb), (lds_void_t*)(smem + 16384 + i * 4096 + wbase), 16, 0, 0);
  }
  int buf = 0;
  for (int k0 = 0; k0 < K; k0 += 64, buf ^= 1) {
    __syncthreads();
    if (k0 + 64 < K) {
      char* nb = smem + (buf ^ 1) * 32768;
#pragma unroll
      for (int i = 0; i < 4; ++i) {
        __builtin_amdgcn_global_load_lds((glb_cvoid_t*)(ag + (long)(32 * i) * lda + k0 + 64), (lds_void_t*)(nb + i * 4096 + wbase), 16, 0, 0);
        __builtin_amdgcn_global_load_lds((glb_cvoid_t*)(bg + (long)(32 * i) * ldb + k0 + 64), (lds_void_t*)(nb + 16384 + i * 4096 + wbase), 16, 0, 0);
      }
    }
    const char* As = smem + buf * 32768; const char* Bs = As + 16384;
    GEMM_COMPUTE_TILE();
  }
}
#define GL4_ISSUE(st_, k0_) do { char* nb_ = smem + ((st_) & 3) * 16384; _Pragma("unroll") for (int j_ = 0; j_ < 2; ++j_) { \
    __builtin_amdgcn_global_load_lds((glb_cvoid_t*)(ag + (long)(64 * j_) * lda + (k0_)), (lds_void_t*)(nb_ + j_ * 4096 + wbase), 16, 0, 0); \
    __builtin_amdgcn_global_load_lds((glb_cvoid_t*)(bg + (long)(64 * j_) * ldb + (k0_)), (lds_void_t*)(nb_ + 8192 + j_ * 4096 + wbase), 16, 0, 0); } } while (0)
__device__ __forceinline__ void gemm_mainloop_glds4(const bf16_t* __restrict__ A, int lda, const bf16_t* __restrict__ Bt, int ldb, int K,
                                                    int tile_m, int tile_n, char* smem, f32x4 (&acc)[4][4]) {
  const int t = tid_opaque(), lane = t & 63, wave = t >> 6;
  const int wm = wave >> 1, wn = wave & 1, fr = lane & 15, fq = lane >> 4;
  const int lrow = t >> 2, cs = (t & 3) ^ ((t >> 4) & 3);
  const bf16_t* ag = A + (long)(tile_m * 128 + lrow) * lda + cs * 8;
  const bf16_t* bg = Bt + (long)(tile_n * 128 + lrow) * ldb + cs * 8;
  const int wbase = __builtin_amdgcn_readfirstlane(wave) * 1024;
#pragma unroll
  for (int i = 0; i < 4; ++i)
#pragma unroll
    for (int j = 0; j < 4; ++j) acc[i][j] = (f32x4){0.f, 0.f, 0.f, 0.f};
  const int nsteps = K >> 5;
  __syncthreads();
  GL4_ISSUE(0, 0);
  if (nsteps > 1) GL4_ISSUE(1, 32);
  if (nsteps > 2) GL4_ISSUE(2, 64);
  for (int s = 0; s < nsteps; ++s) {
    if (s + 2 < nsteps) asm volatile("s_waitcnt vmcnt(8)\n\ts_barrier" ::: "memory");
    else if (s + 1 < nsteps) asm volatile("s_waitcnt vmcnt(4)\n\ts_barrier" ::: "memory");
    else asm volatile("s_waitcnt vmcnt(0)\n\ts_barrier" ::: "memory");
    if (s + 3 < nsteps) GL4_ISSUE(s + 3, (s + 3) * 32);
    const char* As = smem + (s & 3) * 16384; const char* Bs = As + 8192;
    bf16x8 af[4], bfr[4];
#pragma unroll
    for (int i = 0; i < 4; ++i) {
      const int r = wm * 64 + i * 16 + fr; af[i] = *(const bf16x8*)(As + r * 64 + ((fq ^ ((r >> 2) & 3)) << 4));
      const int rn = wn * 64 + i * 16 + fr; bfr[i] = *(const bf16x8*)(Bs + rn * 64 + ((fq ^ ((rn >> 2) & 3)) << 4));
    }
#pragma unroll
    for (int i = 0; i < 4; ++i)
#pragma unroll
      for (int j = 0; j < 4; ++j) acc[i][j] = __builtin_amdgcn_mfma_f32_16x16x32_bf16(bfr[j], af[i], acc[i][j], 0, 0, 0);
  }
}
#ifdef GEMM_GLDS4
#define gemm_mainloop_glds gemm_mainloop_glds4
#endif
template <class Epi>
__device__ __forceinline__ void gemm_tile_128_glds(const bf16_t* __restrict__ A, int lda, const bf16_t* __restrict__ Bt, int ldb, int K,
                                                   int tile_m, int tile_n, char* smem, Epi epi) {
  f32x4 acc[4][4];
  gemm_mainloop_glds(A, lda, Bt, ldb, K, tile_m, tile_n, smem, acc);
  const int t = tid_opaque(), lane = t & 63, wave = t >> 6, wm = wave >> 1, wn = wave & 1, fr = lane & 15, fq = lane >> 4;
#pragma unroll
  for (int i = 0; i < 4; ++i)
#pragma unroll
    for (int j = 0; j < 4; ++j) {
      int m = tile_m * 128 + wm * 64 + i * 16 + fr; int n0 = tile_n * 128 + wn * 64 + j * 16 + fq * 4;
      epi(m, n0, acc[i][j]);
    }
}

__global__ void ok_cvt_wT(const float* W, bf16_t* Wt, int K, int N, int Npad) {
  long i = (long)blockIdx.x * blockDim.x + threadIdx.x;
  if (i >= (long)Npad * K) return;
  int k = i % K; int n = i / K;
  Wt[i] = n < N ? f2bf(W[(long)k * N + n]) : (bf16_t)0;
}
__global__ void ok_f32_to_bf16(const float* s, bf16_t* d, long n) {
  long i = (long)blockIdx.x * blockDim.x + threadIdx.x; if (i < n) d[i] = f2bf(s[i]);
}
__global__ void ok_bf16_to_f32(const bf16_t* s, float* d, long n) {
  long i = (long)blockIdx.x * blockDim.x + threadIdx.x; if (i < n) d[i] = bf2f(s[i]);
}
__global__ void ok_norm_mod_bf16(const float* xs, const float* g, const float* modl, int shift_idx, bf16_t* xn, int M) {
  int row = blockIdx.x * 4 + (threadIdx.x >> 6); int lane = threadIdx.x & 63;
  if (row >= M) return;
  int b = row / RB, lr = row % RB; int bb = lr < SEQ ? b : BATCH;
  const float* sh = modl + ((long)bb * 6 + shift_idx) * DM; const float* sc = sh + DM;
  const float* xr = xs + (long)row * DM; float v[16]; float ss = 0.f;
#pragma unroll
  for (int i = 0; i < 4; ++i) { float4 q = *(const float4*)(xr + i * 256 + lane * 4); v[i*4]=q.x; v[i*4+1]=q.y; v[i*4+2]=q.z; v[i*4+3]=q.w; ss += q.x*q.x+q.y*q.y+q.z*q.z+q.w*q.w; }
#pragma unroll
  for (int o = 32; o > 0; o >>= 1) ss += __shfl_xor(ss, o);
  float inv = __builtin_amdgcn_rsqf(ss / DM + EPSN);
#pragma unroll
  for (int i = 0; i < 4; ++i) {
    int d = i * 256 + lane * 4; float o[4];
#pragma unroll
    for (int e = 0; e < 4; ++e) o[e] = v[i*4+e] * inv * g[d+e] * (1.f + sc[d+e]) + sh[d+e];
    uint2 pk; pk.x = pack2bf(o[0], o[1]); pk.y = pack2bf(o[2], o[3]);
    *(uint2*)(xn + (long)row * DM + d) = pk;
  }
}

struct EpiStoreBf16 { bf16_t* C; int ldc; int N;
  __device__ __forceinline__ void operator()(int m, int n0, f32x4 v) const {
    if (n0 < N) { uint2 pk; pk.x = pack2bf(v[0], v[1]); pk.y = pack2bf(v[2], v[3]); *(uint2*)(C + (long)m * ldc + n0) = pk; } } };
struct EpiStoreF32 { float* C; int ldc; int N;
  __device__ __forceinline__ void operator()(int m, int n0, f32x4 v) const {
    if (n0 < N) *(float4*)(C + (long)m * ldc + n0) = make_float4(v[0], v[1], v[2], v[3]); } };
struct EpiResid { float* xs; const float* modl; int gi; int pad; const float* x_in; const float* ctx_in;
  __device__ __forceinline__ void operator()(int m, int n0, f32x4 v) const {
    int b = m / RB, lr = m % RB; int bb = lr < SEQ ? b : BATCH; const float* g = modl + ((long)bb * 6 + gi) * DM + n0;
    const float* src = x_in ? (lr < SEQ ? x_in + ((long)b * SEQ + lr) * DM + n0 : ctx_in + ((long)b * CTX_LEN + (lr - SEQ)) * DM + n0) : xs + (long)m * DM + n0;
    f32x4 x = *(const f32x4*)src;
    x[0] += g[0] * v[0]; x[1] += g[1] * v[1]; x[2] += g[2] * v[2]; x[3] += g[3] * v[3];
    *(f32x4*)(xs + (long)m * DM + n0) = x; } };

template <class Epi>
__global__ void __launch_bounds__(256) ok_gemm(const bf16_t* A, int lda, const bf16_t* Bt, int ldb, int K, int tiles_m, int tiles_n, Epi epi) {
  __shared__ __attribute__((aligned(16))) char smem[GEMM_LDS_BYTES];
  for (int tile = blockIdx.x; tile < tiles_m * tiles_n; tile += gridDim.x) {
    int tm = tile / tiles_n, tn = tile % tiles_n;
    gemm_tile_128(ALoadPlain{A, lda}, Bt, ldb, K, tm, tn, smem, epi);
  }
}

__device__ __forceinline__ float dot2bf(unsigned a, unsigned b, float c) {
  return __builtin_amdgcn_fdot2_f32_bf16(*(bf16v2*)&a, *(bf16v2*)&b, c, false);
}
__global__ void ok_cvt_bf16_v8(const float* s, bf16_t* d, long n8) {
  long i = (long)blockIdx.x * blockDim.x + threadIdx.x; if (i >= n8) return;
  float4 a = *(const float4*)(s + i * 8), b = *(const float4*)(s + i * 8 + 4);
  u32x4 o; o[0] = pack2bf(a.x, a.y); o[1] = pack2bf(a.z, a.w); o[2] = pack2bf(b.x, b.y); o[3] = pack2bf(b.z, b.w);
  *(u32x4*)(d + i * 8) = o;
}

#define P5_LDS_BYTES (128 * 128 * 4)
__device__ __forceinline__ void peer_q_top1_tile(const bf16_t* __restrict__ A, const bf16_t* __restrict__ WqT, const bf16_t* __restrict__ keysb,
                                                 unsigned* __restrict__ top1, int tm, int ps, char* smem) {
  const int t = tid_opaque(), lane = t & 63, wave = t >> 6, wm = wave >> 1, wn = wave & 1, fr = lane & 15, fq = lane >> 4;
  f32x4 acc[4][4];
  gemm_mainloop_glds(A, DM, WqT, DM, DM, tm, ps, smem, acc);
  __syncthreads();
  char* Qs = smem; char* Ks = smem + 32768;
#pragma unroll
  for (int i = 0; i < 4; ++i)
#pragma unroll
    for (int j = 0; j < 4; ++j) {
      int m = wm * 64 + i * 16 + fr; int n0 = wn * 64 + j * 16 + fq * 4;
      uint2 pk; pk.x = pack2bf(acc[i][j][0], acc[i][j][1]); pk.y = pack2bf(acc[i][j][2], acc[i][j][3]);
      *(uint2*)(Qs + m * 256 + ((((n0 >> 3) ^ (m & 15)) << 4) | ((n0 & 7) << 1))) = pk;
    }
  {
    const bf16_t* kg = keysb + (long)ps * 128 * 128;
#pragma unroll
    for (int i = 0; i < 8; ++i) { int idx = t + 256 * i; int r = idx >> 4, c = idx & 15; *(u32x4*)(Ks + r * 256 + ((c ^ (r & 15)) << 4)) = *(const u32x4*)(kg + r * 128 + c * 8); }
  }
  __syncthreads();
#pragma unroll
  for (int i = 0; i < 4; ++i)
#pragma unroll
    for (int j = 0; j < 4; ++j) acc[i][j] = (f32x4){0.f, 0.f, 0.f, 0.f};
#pragma unroll
  for (int ks = 0; ks < 4; ++ks) {
    bf16x8 af[4], bfr[4];
#pragma unroll
    for (int i = 0; i < 4; ++i) {
      int r = wm * 64 + i * 16 + fr; af[i] = *(const bf16x8*)(Qs + r * 256 + (((ks * 4 + fq) ^ (r & 15)) << 4));
      int rn = wn * 64 + i * 16 + fr; bfr[i] = *(const bf16x8*)(Ks + rn * 256 + (((ks * 4 + fq) ^ (rn & 15)) << 4));
    }
#pragma unroll
    for (int i = 0; i < 4; ++i)
#pragma unroll
      for (int j = 0; j < 4; ++j) acc[i][j] = __builtin_amdgcn_mfma_f32_16x16x32_bf16(bfr[j], af[i], acc[i][j], 0, 0, 0);
  }
  __syncthreads();
  unsigned* Sc = (unsigned*)smem;
#pragma unroll
  for (int i = 0; i < 4; ++i)
#pragma unroll
    for (int j = 0; j < 4; ++j) {
      int m = wm * 64 + i * 16 + fr; int n0 = wn * 64 + j * 16 + fq * 4;
#pragma unroll
      for (int e = 0; e < 4; ++e) Sc[(n0 + e) * 128 + (m ^ ((((n0 + e) >> 2) & 1) << 4))] = enc_key(acc[i][j][e], n0 + e);
    }
  __syncthreads();
  {
    const int r = t & 127, half = t >> 7;
    unsigned l[16];
#pragma unroll
    for (int i = 0; i < 16; ++i) l[i] = 0u;
    for (int k = 0; k < 64; ++k) ins16(l, Sc[(half * 64 + k) * 128 + (r ^ (((k >> 2) & 1) << 4))]);
    __syncthreads();
    unsigned* Ls = (unsigned*)smem;
    if (half == 1) {
#pragma unroll
      for (int i = 0; i < 16; ++i) Ls[r * 17 + i] = l[15 - i];
    }
    __syncthreads();
    if (half == 0) {
      unsigned br[16];
#pragma unroll
      for (int i = 0; i < 16; ++i) br[i] = Ls[r * 17 + i];
      merge16(l, br);
      unsigned* o = top1 + ((long)(tm * 128 + r) * 16 + ps) * 16;
#pragma unroll
      for (int i = 0; i < 4; ++i) { u32x4 v; v[0] = l[4*i]; v[1] = l[4*i+1]; v[2] = l[4*i+2]; v[3] = l[4*i+3]; *(u32x4*)(o + 4 * i) = v; }
    }
  }
}
__global__ void __launch_bounds__(256) ok_peer_q_top1(const bf16_t* A, const bf16_t* WqT, const bf16_t* keysb, unsigned* top1, int tiles_m) {
  __shared__ __attribute__((aligned(16))) char smem[P5_LDS_BYTES];
  for (int tile = blockIdx.x; tile < tiles_m * 16; tile += gridDim.x) { peer_q_top1_tile(A, WqT, keysb, top1, tile / 16, tile % 16, smem); __syncthreads(); }
}

#define P6_LDS_BYTES (32 * 128 * 4 * 3)
__device__ __forceinline__ void peer_gather_group(const bf16_t* __restrict__ xn, const unsigned* __restrict__ top1, const bf16_t* __restrict__ ub,
                                                  const bf16_t* __restrict__ vb, const float* __restrict__ modl, float* __restrict__ xs, int grp, char* smem) {
  const int t = tid_opaque(), lane = t & 63, wave = t >> 6;
  int* pe_l = (int*)smem; float* pg_l = (float*)(smem + 32 * 128 * 4); float* pw_l = (float*)(smem + 2 * 32 * 128 * 4);
  {
    int tl = t >> 3, p = t & 7; long row = (long)grp * 32 + tl;
    peer_combine(top1 + (row * 16 + p * 2) * 16, top1 + (row * 16 + p * 2 + 1) * 16, pe_l + tl * 128 + p * 16, pg_l + tl * 128 + p * 16);
  }
  __syncthreads();
  for (int ti = 0; ti < 8; ++ti) {
    const int tl = wave * 8 + ti; const long row = (long)grp * 32 + tl;
    const int* pe = pe_l + tl * 128; float* pw = pw_l + tl * 128;
    u32x4 h0 = *(const u32x4*)(xn + row * DM + lane * 8), h1 = *(const u32x4*)(xn + row * DM + 512 + lane * 8);
    for (int b = 0; b < 16; ++b) {
      u32x4 u0[8], u1[8];
#pragma unroll
      for (int j = 0; j < 8; ++j) { const bf16_t* ur = ub + (long)pe[b * 8 + j] * DM + lane * 8; u0[j] = *(const u32x4*)ur; u1[j] = *(const u32x4*)(ur + 512); }
      float pd[8];
#pragma unroll
      for (int j = 0; j < 8; ++j) {
        float a = 0.f;
#pragma unroll
        for (int e = 0; e < 4; ++e) { a = dot2bf(h0[e], u0[j][e], a); a = dot2bf(h1[e], u1[j][e], a); }
        pd[j] = a;
      }
      float q4[4], q2[2], q1;
#pragma unroll
      for (int j = 0; j < 4; ++j) { bool hi = lane & 1; float keep = hi ? pd[2*j+1] : pd[2*j], send = hi ? pd[2*j] : pd[2*j+1]; q4[j] = keep + __shfl_xor(send, 1); }
#pragma unroll
      for (int j = 0; j < 2; ++j) { bool hi = lane & 2; float keep = hi ? q4[2*j+1] : q4[2*j], send = hi ? q4[2*j] : q4[2*j+1]; q2[j] = keep + __shfl_xor(send, 2); }
      { bool hi = lane & 4; float keep = hi ? q2[1] : q2[0], send = hi ? q2[0] : q2[1]; q1 = keep + __shfl_xor(send, 4); }
      q1 += __shfl_xor(q1, 8); q1 += __shfl_xor(q1, 16); q1 += __shfl_xor(q1, 32);
      if (lane < 8) { int j = lane & 7; pw[b * 8 + j] = q1; }
    }
    {
      float d0 = pw[lane], d1 = pw[64 + lane];
      pw[lane] = pg_l[tl * 128 + lane] * fgelu_(d0); pw[64 + lane] = pg_l[tl * 128 + 64 + lane] * fgelu_(d1);
    }
    float o[16];
#pragma unroll
    for (int e = 0; e < 16; ++e) o[e] = 0.f;
    for (int b = 0; b < 16; ++b) {
      u32x4 v0[8], v1[8];
#pragma unroll
      for (int j = 0; j < 8; ++j) { const bf16_t* vr = vb + (long)pe[b * 8 + j] * DM + lane * 8; v0[j] = *(const u32x4*)vr; v1[j] = *(const u32x4*)(vr + 512); }
#pragma unroll
      for (int j = 0; j < 8; ++j) {
        float w = pw[b * 8 + j];
#pragma unroll
        for (int e = 0; e < 4; ++e) {
          o[2*e]     += w * __uint_as_float(v0[j][e] << 16); o[2*e+1]     += w * __uint_as_float(v0[j][e] & 0xffff0000u);
          o[8 + 2*e] += w * __uint_as_float(v1[j][e] << 16); o[8 + 2*e+1] += w * __uint_as_float(v1[j][e] & 0xffff0000u);
        }
      }
    }
    {
      int b = row / RB, lr = row % RB; int bb = lr < SEQ ? b : BATCH; const float* g5 = modl + ((long)bb * 6 + 5) * DM;
      float* xr = xs + row * DM;
#pragma unroll
      for (int hf = 0; hf < 2; ++hf) {
        int d = hf * 512 + lane * 8;
        float4 x0 = *(float4*)(xr + d), x1 = *(float4*)(xr + d + 4); float4 g0 = *(const float4*)(g5 + d), g1 = *(const float4*)(g5 + d + 4);
        x0.x += g0.x * o[hf*8+0]; x0.y += g0.y * o[hf*8+1]; x0.z += g0.z * o[hf*8+2]; x0.w += g0.w * o[hf*8+3];
        x1.x += g1.x * o[hf*8+4]; x1.y += g1.y * o[hf*8+5]; x1.z += g1.z * o[hf*8+6]; x1.w += g1.w * o[hf*8+7];
        *(float4*)(xr + d) = x0; *(float4*)(xr + d + 4) = x1;
      }
    }
  }
}
__global__ void __launch_bounds__(256) ok_peer_gather(const bf16_t* xn, const unsigned* top1, const bf16_t* ub, const bf16_t* vb, const float* modl, float* xs, int ngroups) {
  __shared__ __attribute__((aligned(16))) char smem[P6_LDS_BYTES];
  for (int g = blockIdx.x; g < ngroups; g += gridDim.x) { peer_gather_group(xn, top1, ub, vb, modl, xs, g, smem); __syncthreads(); }
}

template <int DQ> struct AttnCfg { static constexpr int KROW = DQ * 2 + 16; static constexpr int VROW = 136; static constexpr int KBYTES = 64 * KROW; static constexpr int LDS = 64 * KROW + 64 * VROW; };
#define ATTN_LDS_BYTES (64 * 208 + 64 * 136)
__device__ __forceinline__ void attn_score_bound(const float* __restrict__ qk_g, int DQ, float sqrt_dq, float* __restrict__ dst, int lane) {
  float gq = 0.f, gk = 0.f;
  for (int i = lane; i < DQ; i += 64) { gq = fmaxf(gq, fabsf(qk_g[i])); gk = fmaxf(gk, fabsf(qk_g[DQ + i])); }
#pragma unroll
  for (int o_ = 32; o_ > 0; o_ >>= 1) { gq = fmaxf(gq, __shfl_xor(gq, o_)); gk = fmaxf(gk, __shfl_xor(gk, o_)); }
  if (lane == 0) *dst = -fminf(1.02f * 1.4426950408889634f * sqrt_dq * gq * gk, 60.f);
}
template <int DQ>
__device__ __forceinline__ void attn_block(const bf16_t* __restrict__ qb, int HQ, const bf16_t* __restrict__ kb, int HK, const bf16_t* __restrict__ vT, int G,
                                           bf16_t* __restrict__ mixall, int ooff, int b, int head, int qt, char* smem, const float* __restrict__ negC_p) {
  constexpr int KROW = AttnCfg<DQ>::KROW, VROW = 136, NKK = DQ / 16, KCH = DQ / 8;
  constexpr int KLD = (64 * KCH) / 256;
  const int t = tid_opaque(), lane = t & 63, wave = t >> 6, lq = lane & 31, lh = lane >> 5;
  const int hk = head / G;
  char* Ks = smem; char* Vs = smem + 64 * KROW;
  const float negC = *negC_p;
  const long qrow = (long)b * RB + qt * 128 + wave * 32 + lq;
  bf16x8 qf[NKK];
#pragma unroll
  for (int kk = 0; kk < NKK; ++kk) qf[kk] = *(const bf16x8*)(qb + (qrow * HQ + head) * DQ + kk * 16 + lh * 8);
  const int key0 = qt < 16 ? 0 : SEQ; const int nt = qt < 16 ? RB / 64 : CTX_LEN / 64;
  const bf16_t* kp[KLD]; const bf16_t* vp_[2];
#pragma unroll
  for (int i = 0; i < KLD; ++i) { int c = t + 256 * i; int r = c / KCH, cc = c % KCH; kp[i] = kb + ((long)b * RB * HK + hk) * DQ + (long)(key0 + r) * HK * DQ + cc * 8; }
#pragma unroll
  for (int i = 0; i < 2; ++i) { int c = t + 256 * i; int r = c >> 3, cc = c & 7; vp_[i] = vT + ((long)(b * HK + hk) * 64 + r) * RB + key0 + cc * 8; }
  u32x4 rk[KLD], rv[2];
#pragma unroll
  for (int i = 0; i < KLD; ++i) { rk[i] = *(const u32x4*)kp[i]; kp[i] += 64 * HK * DQ; }
#pragma unroll
  for (int i = 0; i < 2; ++i) { rv[i] = *(const u32x4*)vp_[i]; vp_[i] += 64; }
  f32x16 ot[2];
#pragma unroll
  for (int d = 0; d < 2; ++d)
#pragma unroll
    for (int r = 0; r < 16; ++r) ot[d][r] = 0.f;
  float lrun = 0.f;
  for (int tile = 0; tile < nt; ++tile) {
    __syncthreads();
#pragma unroll
    for (int i = 0; i < KLD; ++i) { int c = t + 256 * i; int r = c / KCH, cc = c % KCH; *(u32x4*)(Ks + r * KROW + cc * 16) = rk[i]; }
#pragma unroll
    for (int i = 0; i < 2; ++i) { int c = t + 256 * i; int r = c >> 3, cc = c & 7; *(uint2*)(Vs + r * VROW + cc * 16) = make_uint2(rv[i][0], rv[i][1]); *(uint2*)(Vs + r * VROW + cc * 16 + 8) = make_uint2(rv[i][2], rv[i][3]); }
    __syncthreads();
    if (tile + 1 < nt) {
#pragma unroll
      for (int i = 0; i < KLD; ++i) { rk[i] = *(const u32x4*)kp[i]; kp[i] += 64 * HK * DQ; }
#pragma unroll
      for (int i = 0; i < 2; ++i) { rv[i] = *(const u32x4*)vp_[i]; vp_[i] += 64; }
    }
    f32x16 st[2];
#pragma unroll
    for (int kt = 0; kt < 2; ++kt) {
#pragma unroll
      for (int r = 0; r < 16; ++r) st[kt][r] = negC;
#pragma unroll
      for (int kk = 0; kk < NKK; ++kk) {
        bf16x8 ka = *(const bf16x8*)(Ks + (kt * 32 + lq) * KROW + kk * 32 + lh * 16);
        st[kt] = __builtin_amdgcn_mfma_f32_32x32x16_bf16(ka, qf[kk], st[kt], 0, 0, 0);
      }
    }
    float ps = 0.f;
#pragma unroll
    for (int kt = 0; kt < 2; ++kt)
#pragma unroll
      for (int r = 0; r < 16; ++r) { float p = __builtin_amdgcn_exp2f(st[kt][r]); st[kt][r] = p; ps += p; }
    lrun += ps;
#pragma unroll
    for (int kt = 0; kt < 2; ++kt)
#pragma unroll
      for (int s = 0; s < 2; ++s) {
        union { bf16x8 v; unsigned u[4]; } pb;
#pragma unroll
        for (int j = 0; j < 4; ++j) pb.u[j] = pack2bf(st[kt][8 * s + 2 * j], st[kt][8 * s + 2 * j + 1]);
#pragma unroll
        for (int d = 0; d < 2; ++d) {
          const char* vp = Vs + (d * 32 + lq) * VROW + (kt * 32 + 16 * s + 4 * lh) * 2;
          union { bf16x8 v; uint2 h[2]; } va; va.h[0] = *(const uint2*)vp; va.h[1] = *(const uint2*)(vp + 16);
          ot[d] = __builtin_amdgcn_mfma_f32_32x32x16_bf16(va.v, pb.v, ot[d], 0, 0, 0);
        }
      }
  }
  float ltot = xor32_sum(lrun); float inv = 1.f / ltot;
  bf16_t* orow = mixall + qrow * DM + ooff + head * 64;
#pragma unroll
  for (int d = 0; d < 2; ++d)
#pragma unroll
    for (int g = 0; g < 4; ++g) {
      uint2 pk; pk.x = pack2bf(ot[d][4 * g] * inv, ot[d][4 * g + 1] * inv); pk.y = pack2bf(ot[d][4 * g + 2] * inv, ot[d][4 * g + 3] * inv);
      *(uint2*)(orow + d * 32 + 8 * g + 4 * lh) = pk;
    }
}
__global__ void ok_adapt_rows(const float* src, int sld, int scol, int ncols, float scale, bf16_t* dst, int dld, int nrows) {
  long i = (long)blockIdx.x * blockDim.x + threadIdx.x; if (i >= (long)nrows * ncols) return;
  int c = i % ncols; long r = i / ncols; dst[r * dld + c] = f2bf(src[r * sld + scol + c] * scale);
}
__global__ void ok_adapt_vT(const float* src, int sld, int scol, int hstride, int H, bf16_t* dst) {
  long i = (long)blockIdx.x * blockDim.x + threadIdx.x; if (i >= (long)H * 64 * RB) return;
  int lr = i % RB; int d = (i / RB) % 64; int h = i / ((long)RB * 64);
  dst[i] = f2bf(src[(long)lr * sld + scol + h * hstride + d]);
}

typedef __attribute__((ext_vector_type(2))) float f32x2;
#define SCAN_TS 16
#define SCAN_LDS_BYTES (2 * SCAN_TS * 1536 + 2 * SCAN_TS * 32 * 4)
__device__ __forceinline__ float reduce8(float x) {
  x += __builtin_bit_cast(float, __builtin_amdgcn_update_dpp(0, __builtin_bit_cast(int, x), 0xB1, 0xf, 0xf, true));
  x += __builtin_bit_cast(float, __builtin_amdgcn_update_dpp(0, __builtin_bit_cast(int, x), 0x4E, 0xf, 0xf, true));
  x += __builtin_bit_cast(float, __builtin_amdgcn_update_dpp(0, __builtin_bit_cast(int, x), 0x141, 0xf, 0xf, true));
  return x;
}
__device__ __forceinline__ int scan_row(int dir, int s) {
  if (s < CTX_LEN) return SEQ + (dir == 0 ? s : CTX_LEN - 1 - s);
  return dir == 0 ? s - CTX_LEN : SEQ - 1 - (s - CTX_LEN);
}
__device__ __forceinline__ void rw_scan_block(const bf16_t* __restrict__ r_, const bf16_t* __restrict__ v_, const bf16_t* __restrict__ kk_, const bf16_t* __restrict__ kd_,
                                              const bf16_t* __restrict__ bd_, const float* __restrict__ w_, float* __restrict__ y_, int item, long dstride, char* smem) {
  const int t = tid_opaque(), lane = t & 63, wave = t >> 6, cg = lane & 7, il = wave * 8 + (lane >> 3);
  const int half = item & 1, dir = (item >> 1) & 1, h = (item >> 2) % 6, b = item / 24;
  const long rowbase = (long)b * RB; const int col0 = h * 64;
  float* ybuf = (float*)(smem + 2 * SCAN_TS * 1536);
  const int st_ld = t >> 4, part = t & 15;
  u32x4 la, lb, lc, lw;
  auto issue = [&](int c) {
    long row = rowbase + scan_row(dir, c * SCAN_TS + st_ld); long o = row * 384 + col0;
    const int ch = (part & 7) * 8;
    la = *(const u32x4*)((part < 8 ? kk_ + o : bd_ + dir * dstride + o) + ch);
    lb = *(const u32x4*)((part < 8 ? kd_ + dir * dstride + o : r_ + o) + ch);
    lc = *(const u32x4*)(v_ + o + ch);
    lw = *(const u32x4*)(w_ + dir * dstride + o + part * 4);
  };
  auto stash = [&](int buf) {
    float* base = (float*)(smem + buf * SCAN_TS * 1536 + st_ld * 1536);
    const int ch = (part & 7) * 8;
    float* pa = base + (part < 8 ? 64 : 128) + ch; float* pb = base + (part < 8 ? 192 : 256) + ch;
    f32x4 x0, x1;
#pragma unroll
    for (int e = 0; e < 2; ++e) { x0[2*e] = __uint_as_float(la[e] << 16); x0[2*e+1] = __uint_as_float(la[e] & 0xffff0000u); x1[2*e] = __uint_as_float(la[2+e] << 16); x1[2*e+1] = __uint_as_float(la[2+e] & 0xffff0000u); }
    *(f32x4*)pa = x0; *(f32x4*)(pa + 4) = x1;
#pragma unroll
    for (int e = 0; e < 2; ++e) { x0[2*e] = __uint_as_float(lb[e] << 16); x0[2*e+1] = __uint_as_float(lb[e] & 0xffff0000u); x1[2*e] = __uint_as_float(lb[2+e] << 16); x1[2*e+1] = __uint_as_float(lb[2+e] & 0xffff0000u); }
    *(f32x4*)pb = x0; *(f32x4*)(pb + 4) = x1;
    if (part < 8) {
      float* pc = base + 320 + ch;
#pragma unroll
      for (int e = 0; e < 2; ++e) { x0[2*e] = __uint_as_float(lc[e] << 16); x0[2*e+1] = __uint_as_float(lc[e] & 0xffff0000u); x1[2*e] = __uint_as_float(lc[2+e] << 16); x1[2*e+1] = __uint_as_float(lc[2+e] & 0xffff0000u); }
      *(f32x4*)pc = x0; *(f32x4*)(pc + 4) = x1;
    }
    *(u32x4*)(base + part * 4) = lw;
  };
  f32x2 S[4];
#pragma unroll
  for (int j = 0; j < 4; ++j) S[j] = (f32x2){0.f, 0.f};
  const int NCH = RB / SCAN_TS;
  __builtin_amdgcn_s_setprio(3);
  issue(0);
  for (int c = 0; c < NCH; ++c) {
    const int buf = c & 1;
    stash(buf);
    __syncthreads();
    if (c > 0 && t < 128) {
      int st = t >> 3, i4 = (t & 7) * 4; long row = rowbase + scan_row(dir, (c - 1) * SCAN_TS + st);
      *(f32x4*)(y_ + dir * dstride + row * 384 + col0 + half * 32 + i4) = *(const f32x4*)(ybuf + (buf ^ 1) * SCAN_TS * 32 + st * 32 + i4);
    }
    if (c + 1 < NCH) issue(c + 1);
    const float* ob = (const float*)(smem + buf * SCAN_TS * 1536) + cg * 8;
    const float* vb_ = (const float*)(smem + buf * SCAN_TS * 1536) + 320 + half * 32 + il;
    float yk[SCAN_TS];
    f32x4 nw0 = *(const f32x4*)(ob), nw1 = *(const f32x4*)(ob + 4), nk0 = *(const f32x4*)(ob + 64), nk1 = *(const f32x4*)(ob + 68);
    f32x4 nb0 = *(const f32x4*)(ob + 128), nb1 = *(const f32x4*)(ob + 132), nd0 = *(const f32x4*)(ob + 192), nd1 = *(const f32x4*)(ob + 196);
    f32x4 nr0 = *(const f32x4*)(ob + 256), nr1 = *(const f32x4*)(ob + 260); float nvi = vb_[0];
#pragma unroll
    for (int st = 0; st < SCAN_TS; ++st) {
      const f32x4 w0 = nw0, w1 = nw1, k0 = nk0, k1 = nk1, b0 = nb0, b1 = nb1, d0 = nd0, d1 = nd1, r0 = nr0, r1 = nr1; const float vi = nvi;
      if (st + 1 < SCAN_TS) {
        const float* o = ob + (st + 1) * 384;
        nw0 = *(const f32x4*)(o); nw1 = *(const f32x4*)(o + 4); nk0 = *(const f32x4*)(o + 64); nk1 = *(const f32x4*)(o + 68);
        nb0 = *(const f32x4*)(o + 128); nb1 = *(const f32x4*)(o + 132); nd0 = *(const f32x4*)(o + 192); nd1 = *(const f32x4*)(o + 196);
        nr0 = *(const f32x4*)(o + 256); nr1 = *(const f32x4*)(o + 260); nvi = vb_[(st + 1) * 384];
      }
      __builtin_amdgcn_sched_barrier(0);
      f32x2 a2 = S[0] * (f32x2){k0[0], k0[1]}, c2 = S[2] * (f32x2){k1[0], k1[1]};
      a2 += S[1] * (f32x2){k0[2], k0[3]}; c2 += S[3] * (f32x2){k1[2], k1[3]};
      a2 += c2;
      const f32x2 vv = (f32x2){vi, vi};
      f32x2 t0 = vv * (f32x2){d0[0], d0[1]}, t1 = vv * (f32x2){d0[2], d0[3]}, t2 = vv * (f32x2){d1[0], d1[1]}, t3 = vv * (f32x2){d1[2], d1[3]};
      float skk = reduce8(a2[0] + a2[1]);
      const f32x2 ns = (f32x2){-skk, -skk};
      t0 += ns * (f32x2){b0[0], b0[1]}; t1 += ns * (f32x2){b0[2], b0[3]}; t2 += ns * (f32x2){b1[0], b1[1]}; t3 += ns * (f32x2){b1[2], b1[3]};
      S[0] = S[0] * (f32x2){w0[0], w0[1]} + t0; S[1] = S[1] * (f32x2){w0[2], w0[3]} + t1; S[2] = S[2] * (f32x2){w1[0], w1[1]} + t2; S[3] = S[3] * (f32x2){w1[2], w1[3]} + t3;
      f32x2 y2 = S[0] * (f32x2){r0[0], r0[1]}, z2 = S[2] * (f32x2){r1[0], r1[1]};
      y2 += S[1] * (f32x2){r0[2], r0[3]}; z2 += S[3] * (f32x2){r1[2], r1[3]};
      y2 += z2;
      yk[st] = y2[0] + y2[1];
      __builtin_amdgcn_sched_barrier(0);
    }
#pragma unroll
    for (int g = 0; g < 2; ++g) {
      float q4[4], q2[2], q1;
#pragma unroll
      for (int j = 0; j < 4; ++j) { bool hi = cg & 1; float keep = hi ? yk[g*8 + 2*j+1] : yk[g*8 + 2*j], send = hi ? yk[g*8 + 2*j] : yk[g*8 + 2*j+1]; q4[j] = keep + dpp_get<0xB1>(send); }
#pragma unroll
      for (int j = 0; j < 2; ++j) { bool hi = cg & 2; float keep = hi ? q4[2*j+1] : q4[2*j], send = hi ? q4[2*j] : q4[2*j+1]; q2[j] = keep + dpp_get<0x4E>(send); }
      { bool hi = cg & 4; float keep = hi ? q2[1] : q2[0], send = hi ? q2[0] : q2[1]; q1 = keep + xor4_get(send); }
      ybuf[buf * SCAN_TS * 32 + (g * 8 + cg) * 32 + il] = q1;
    }
  }
  __builtin_amdgcn_s_setprio(0);
  __syncthreads();
  if (t < 128) {
    int st = t >> 3, i4 = (t & 7) * 4; long row = rowbase + scan_row(dir, (NCH - 1) * SCAN_TS + st);
    *(f32x4*)(y_ + dir * dstride + row * 384 + col0 + half * 32 + i4) = *(const f32x4*)(ybuf + ((NCH - 1) & 1) * SCAN_TS * 32 + st * 32 + i4);
  }
}
__global__ void __launch_bounds__(256) ok_rw_scan(const bf16_t* r_, const bf16_t* v_, const bf16_t* kk_, const bf16_t* kd_, const bf16_t* bd_, const float* w_, float* y_, int item0, int nitems, long dstride) {
  __shared__ __attribute__((aligned(16))) char smem[SCAN_LDS_BYTES];
  for (int it = item0 + blockIdx.x; it < item0 + nitems; it += gridDim.x) { rw_scan_block(r_, v_, kk_, kd_, bd_, w_, y_, it, dstride, smem); __syncthreads(); }
}
__global__ void ok_copy_rows_f32(const float* src, int sld, int scol, int ncols, float* dst, int dld, int nrows) {
  long i = (long)blockIdx.x * blockDim.x + threadIdx.x; if (i >= (long)nrows * ncols) return;
  int c = i % ncols; long r = i / ncols; dst[r * dld + c] = src[r * sld + scol + c];
}

__global__ void ok_cvt_wT_g(const float* W, const float* g, bf16_t* Wt, int K, int N, int Kpad) {
  long i = (long)blockIdx.x * blockDim.x + threadIdx.x;
  if (i >= (long)N * Kpad) return;
  int k = i % Kpad; int n = i / Kpad;
  Wt[i] = k < K ? f2bf(W[(long)k * N + n] * (g ? g[k] : 1.f)) : (bf16_t)0;
}
struct ALoadShift { const bf16_t* P; const float* mu; int col0; int mucol0; int act; int kvalid;
  __device__ __forceinline__ u32x4 operator()(int row, int k) const {
    u32x4 z = {0u, 0u, 0u, 0u};
    if (k >= kvalid) return z;
    int lr = row % RB; bool first = (lr == 0) || (lr == SEQ), last = (lr == SEQ - 1) || (lr == RB - 1);
    const bf16_t* p = P + (long)row * IN_COLS + col0 + k;
    u32x4 c = *(const u32x4*)p; u32x4 pv = first ? z : *(const u32x4*)(p - IN_COLS); u32x4 nx = last ? z : *(const u32x4*)(p + IN_COLS);
    const float* m0 = mu + mucol0 + k; const float* m1 = m0 + RWC;
    u32x4 o;
#pragma unroll
    for (int e = 0; e < 4; ++e) {
      float c0 = __uint_as_float(c[e] << 16), c1 = __uint_as_float(c[e] & 0xffff0000u);
      float p0 = __uint_as_float(pv[e] << 16), p1 = __uint_as_float(pv[e] & 0xffff0000u);
      float n0 = __uint_as_float(nx[e] << 16), n1 = __uint_as_float(nx[e] & 0xffff0000u);
      float x0 = c0 + m0[2*e] * (p0 - c0) + m1[2*e] * (n0 - c0), x1 = c1 + m0[2*e+1] * (p1 - c1) + m1[2*e+1] * (n1 - c1);
      if (act == 1) { x0 = ftanh_(x0); x1 = ftanh_(x1); } else if (act == 2) { x0 = fsigmoid_(x0); x1 = fsigmoid_(x1); }
      o[e] = pack2bf(x0, x1);
    }
    return o;
  } };
struct EpiDecay { float* w; const float* w0; int pad0; int pad1;
  __device__ __forceinline__ void operator()(int m, int n0, f32x4 v) const {
    f32x4 o;
#pragma unroll
    for (int e = 0; e < 4; ++e) o[e] = fdecay_(w0[n0 + e] + v[e]);
    *(f32x4*)(w + (long)m * 384 + n0) = o; } };
struct EpiSigA { bf16_t* a; const float* a0;
  __device__ __forceinline__ void operator()(int m, int n0, f32x4 v) const {
    uint2 pk; pk.x = pack2bf(fsigmoid_(a0[n0] + v[0]), fsigmoid_(a0[n0+1] + v[1])); pk.y = pack2bf(fsigmoid_(a0[n0+2] + v[2]), fsigmoid_(a0[n0+3] + v[3]));
    *(uint2*)(a + (long)m * 384 + n0) = pk; } };

struct PrepW { const bf16_t *wqbT, *wkvbT, *w2T, *a2T, *g2T; const float *mu, *w0, *a0; };
struct PrepBuf { const bf16_t* P; bf16_t *tq, *tkv, *a_b, *g_b; float* w_f; };
__device__ __forceinline__ void prep_gemm_tile(const PrepW& W, const PrepBuf& B, int tm, int ct, char* smem) {
  const long MA = NROWS;
  if (ct < 3) gemm_tile_128(ALoadPlain{B.P, IN_COLS}, W.wqbT, 256, 256, tm, ct, smem, EpiStoreBf16{B.tq, 384, 384});
  else if (ct < 7) gemm_tile_128(ALoadPlain{B.P + 256, IN_COLS}, W.wkvbT, 128, 128, tm, ct - 3, smem, EpiStoreBf16{B.tkv, 512, 512});
  else if (ct < 13) { int d = (ct - 7) / 3, tn = (ct - 7) % 3;
    gemm_tile_128(ALoadShift{B.P, W.mu, RW_OFF + 1152 + d * 64, 1152 + d * 64, 1, 64}, W.w2T + d * 384 * 64, 64, 64, tm, tn, smem, EpiDecay{B.w_f + d * MA * 384, W.w0 + d * 384, 0, 0}); }
  else if (ct < 19) { int d = (ct - 13) / 3, tn = (ct - 13) % 3;
    gemm_tile_128(ALoadShift{B.P, W.mu, RW_OFF + 1280 + d * 64, 1280 + d * 64, 0, 64}, W.a2T + d * 384 * 64, 64, 64, tm, tn, smem, EpiSigA{B.a_b + d * MA * 384, W.a0 + d * 384}); }
  else gemm_tile_128(ALoadShift{B.P, W.mu, RW_OFF + 1408, 1408, 2, 160}, W.g2T, 192, 192, tm, ct - 19, smem, EpiStoreBf16{B.g_b, 384, 384});
}
__global__ void __launch_bounds__(256) ok_prep_gemm(PrepW W, PrepBuf B) {
  __shared__ __attribute__((aligned(16))) char smem[GEMM_LDS_BYTES];
  for (int tile = blockIdx.x; tile < (NROWS / 128) * 22; tile += gridDim.x) prep_gemm_tile(W, B, tile / 22, tile % 22, smem);
}

__device__ __forceinline__ float wave_sum(float x) {
#pragma unroll
  for (int o = 32; o > 0; o >>= 1) x += __shfl_xor(x, o);
  return x;
}
__device__ __forceinline__ float ldbf(const bf16_t* p) { return bf2f(*p); }
struct FinW { const float *mla_qk_g, *gqa_qk_g, *mu, *k_k, *k_a; };
struct FinBuf { const bf16_t *P, *tq, *tkv, *a_b; bf16_t *mq, *mk, *mvT, *gq, *gk, *gvT, *r_b, *v_b, *kk_b, *kd_b, *bd_b; };
#define FIN_LDS_BYTES (384 * 132)
__device__ __forceinline__ void prep_finish_tile(const FinW& W, const FinBuf& B, int tile, char* smem) {
  const int t = tid_opaque(), lane = t & 63, wave = t >> 6; const long MA = NROWS;
  bf16_t* vbuf = (bf16_t*)smem;
  const long row0 = (long)tile * 64; const int b = row0 / RB; const int lr0 = row0 % RB;
  for (int it = 0; it < 16; ++it) {
    const int rl = it * 4 + wave; const long row = row0 + rl; const int lr = lr0 + rl; const bool lat = lr < SEQ;
    const bf16_t* Pr = B.P + row * IN_COLS;
    float sq = 0.f;
#pragma unroll
    for (int i = 0; i < 4; ++i) { float x = ldbf(Pr + i * 64 + lane); sq += x * x; }
    float skv = 0.f;
#pragma unroll
    for (int i = 0; i < 2; ++i) { float x = ldbf(Pr + 256 + i * 64 + lane); skv += x * x; }
    const float cq = __builtin_amdgcn_rsqf(wave_sum(sq) / 256.f + EPSN), ckv = __builtin_amdgcn_rsqf(wave_sum(skv) / 128.f + EPSN);
    const float krope = lane < 32 ? ldbf(Pr + 384 + lane) : 0.f;
    float cs_m = 1.f, sn_m = 0.f;
    { int j = lane & 15; int pos = j < 8 ? lr / 64 : lr % 64; float ang = (float)pos * powf(10000.f, -(float)(j & 7) / 8.f); if (lat) { cs_m = cosf(ang); sn_m = sinf(ang); } }
    const float* gq_ = W.mla_qk_g; const float* gk_ = W.mla_qk_g + 96;
#pragma unroll
    for (int h = 0; h < 4; ++h) {
      float qa = cq * ldbf(B.tq + row * 384 + h * 96 + lane); float qb = lane < 32 ? cq * ldbf(B.tq + row * 384 + h * 96 + 64 + lane) : 0.f;
      float inv = __builtin_amdgcn_rsqf(wave_sum(qa * qa + qb * qb) / 96.f + EPSN);
      qa *= inv * gq_[lane]; qb *= inv * (lane < 32 ? gq_[64 + lane] : 0.f);
      { float other = __shfl_xor(qb, 16); float rr = (lane & 16) ? (other * sn_m + qb * cs_m) : (qb * cs_m - other * sn_m); qb = rr; }
      const float qs = 0.14724445f;
      B.mq[row * 384 + h * 96 + lane] = f2bf(qa * qs); if (lane < 32) B.mq[row * 384 + h * 96 + 64 + lane] = f2bf(qb * qs);
      float ka = ckv * ldbf(B.tkv + row * 512 + h * 128 + lane); float kb = krope;
      float invk = __builtin_amdgcn_rsqf(wave_sum(ka * ka + kb * kb) / 96.f + EPSN);
      ka *= invk * gk_[lane]; kb *= invk * (lane < 32 ? gk_[64 + lane] : 0.f);
      { float other = __shfl_xor(kb, 16); float rr = (lane & 16) ? (other * sn_m + kb * cs_m) : (kb * cs_m - other * sn_m); kb = rr; }
      B.mk[row * 384 + h * 96 + lane] = f2bf(ka); if (lane < 32) B.mk[row * 384 + h * 96 + 64 + lane] = f2bf(kb);
      vbuf[(h * 64 + lane) * 66 + rl] = f2bf(ckv * ldbf(B.tkv + row * 512 + h * 128 + 64 + lane));
    }
    float cs_g = 1.f, sn_g = 0.f;
    { int j = lane & 31; int pos = j < 16 ? lr / 64 : lr % 64; float ang = (float)pos * powf(10000.f, -(float)(j & 15) / 16.f); if (lat) { cs_g = cosf(ang); sn_g = sinf(ang); } }
#pragma unroll
    for (int h = 0; h < 8; ++h) {
      float x = ldbf(Pr + GQA_OFF + h * 64 + lane);
      float inv = __builtin_amdgcn_rsqf(wave_sum(x * x) / 64.f + EPSN);
      x *= inv * W.gqa_qk_g[(h < 6 ? 0 : 64) + lane];
      float other = __shfl_xor(x, 32); float rr = (lane & 32) ? (other * sn_g + x * cs_g) : (x * cs_g - other * sn_g);
      if (h < 6) B.gq[row * 384 + h * 64 + lane] = f2bf(rr * 0.18033688f); else B.gk[row * 128 + (h - 6) * 64 + lane] = f2bf(rr);
    }
#pragma unroll
    for (int hk = 0; hk < 2; ++hk) vbuf[((4 + hk) * 64 + lane) * 66 + rl] = Pr[GQA_OFF + 512 + hk * 64 + lane];
    const bool first = (lr == 0) || (lr == SEQ), last = (lr == SEQ - 1) || (lr == RB - 1);
#pragma unroll
    for (int h = 0; h < 6; ++h) {
      float xs3[3];
#pragma unroll
      for (int part = 0; part < 3; ++part) {
        int c = part * 384 + h * 64 + lane; const bf16_t* pp = Pr + RW_OFF + c;
        float p = ldbf(pp), pv = first ? 0.f : ldbf(pp - IN_COLS), nx = last ? 0.f : ldbf(pp + IN_COLS);
        xs3[part] = p + W.mu[c] * (pv - p) + W.mu[RWC + c] * (nx - p);
      }
      const int c = h * 64 + lane; const long o = row * 384 + c;
      float kv = xs3[1]; float tk = kv * W.k_k[c]; float kkv = tk * __builtin_amdgcn_rsqf(wave_sum(tk * tk) + 1e-12f);
      B.r_b[o] = f2bf(xs3[0]); B.v_b[o] = f2bf(xs3[2]); B.kk_b[o] = f2bf(kkv);
#pragma unroll
      for (int d = 0; d < 2; ++d) { float a = ldbf(B.a_b + d * MA * 384 + o); B.kd_b[d * MA * 384 + o] = f2bf(kv * (1.f + (a - 1.f) * W.k_a[c])); B.bd_b[d * MA * 384 + o] = f2bf(kkv * a); }
    }
  }
  __syncthreads();
  for (int i = t; i < 384 * 32; i += 256) {
    int rr = i >> 5, w2 = i & 31; int slot = rr >> 6, d = rr & 63;
    unsigned val = *(const unsigned*)(vbuf + rr * 66 + w2 * 2);
    bf16_t* dst = slot < 4 ? B.mvT + ((long)(b * 4 + slot) * 64 + d) * RB : B.gvT + ((long)(b * 2 + (slot - 4)) * 64 + d) * RB;
    *(unsigned*)(dst + lr0 + w2 * 2) = val;
  }
  __syncthreads();
}
__global__ void __launch_bounds__(256) ok_prep_finish(FinW W, FinBuf B) {
  __shared__ __attribute__((aligned(16))) char smem[FIN_LDS_BYTES];
  for (int tile = blockIdx.x; tile < NROWS / 64; tile += gridDim.x) prep_finish_tile(W, B, tile, smem);
}
struct RdW { const float *r_k, *ln_g, *ln_b; };
__device__ __forceinline__ void rw_readout_row(const RdW& W, const float* __restrict__ y, const bf16_t* __restrict__ r_b, const bf16_t* __restrict__ v_b, const bf16_t* __restrict__ kd_b,
                                               const bf16_t* __restrict__ g_b, bf16_t* __restrict__ mixall, long row, int lane) {
  const long MA = NROWS;
#pragma unroll
  for (int h = 0; h < 6; ++h) {
    const int c = h * 64 + lane; const long o = row * 384 + c;
    float yy = y[o] + y[MA * 384 + o];
    float mean = wave_sum(yy) * (1.f / 64.f); float dv = yy - mean; float var = wave_sum(dv * dv) * (1.f / 64.f);
    float coef = wave_sum(ldbf(r_b + o) * (ldbf(kd_b + o) + ldbf(kd_b + MA * 384 + o)) * W.r_k[c]);
    float yn = dv * __builtin_amdgcn_rsqf(var + 64e-5f) * W.ln_g[c] + W.ln_b[c];
    mixall[row * DM + 256 + c] = f2bf((yn + coef * ldbf(v_b + o)) * ldbf(g_b + o));
  }
}
__global__ void __launch_bounds__(256) ok_rw_readout(RdW W, const float* y, const bf16_t* r_b, const bf16_t* v_b, const bf16_t* kd_b, const bf16_t* g_b, bf16_t* mixall) {
  for (long row = blockIdx.x * 4 + (threadIdx.x >> 6); row < NROWS; row += gridDim.x * 4) rw_readout_row(W, y, r_b, v_b, kd_b, g_b, mixall, row, threadIdx.x & 63);
}

__device__ __forceinline__ void ph_cvt_fp8_rows(const float* __restrict__ tab, unsigned char* __restrict__ q, float* __restrict__ scale, int r0 = -1, int r1 = 0) {
  const int t = tid_opaque(); const int lane = t & 63;
  const int rbeg = r0 < 0 ? (int)blockIdx.x * 4 + (t >> 6) : r0 + (t >> 6), rend = r0 < 0 ? 16384 : r1, rstep = r0 < 0 ? (int)gridDim.x * 4 : 4;
  for (int row = rbeg; row < rend; row += rstep) {
    const float* src = tab + (long)row * DM + lane * 16;
    f32x4 a[4]; float m = 0.f;
#pragma unroll
    for (int i = 0; i < 4; ++i) { a[i] = *(const f32x4*)(src + 4 * i); m = fmaxf(m, fmaxf(fmaxf(fabsf(a[i][0]), fabsf(a[i][1])), fmaxf(fabsf(a[i][2]), fabsf(a[i][3])))); }
#pragma unroll
    for (int o = 32; o > 0; o >>= 1) m = fmaxf(m, __shfl_xor(m, o));
    const float sc = m > 0.f ? m * (1.f / 440.f) : 1.f; const float inv = 1.f / sc;
    u32x4 p;
#pragma unroll
    for (int i = 0; i < 4; ++i) { int w = __builtin_amdgcn_cvt_pk_fp8_f32(a[i][0] * inv, a[i][1] * inv, 0, false); w = __builtin_amdgcn_cvt_pk_fp8_f32(a[i][2] * inv, a[i][3] * inv, w, true); p[i] = (unsigned)w; }
    *(u32x4*)(q + (long)row * DM + lane * 16) = p;
    if (lane == 0) scale[row] = sc;
  }
}
__device__ __forceinline__ float dot16_fp8(const float (&h)[16], u32x4 q) {
  float a = 0.f;
#pragma unroll
  for (int d = 0; d < 4; ++d) {
    f32v2 lo = __builtin_amdgcn_cvt_pk_f32_fp8((int)q[d], false), hi = __builtin_amdgcn_cvt_pk_f32_fp8((int)q[d], true);
    a += h[4*d] * lo[0]; a += h[4*d+1] * lo[1]; a += h[4*d+2] * hi[0]; a += h[4*d+3] * hi[1];
  }
  return a;
}
__device__ __forceinline__ void axpy16_fp8(float (&o)[16], float w, u32x4 q) {
#pragma unroll
  for (int d = 0; d < 4; ++d) {
    f32v2 lo = __builtin_amdgcn_cvt_pk_f32_fp8((int)q[d], false), hi = __builtin_amdgcn_cvt_pk_f32_fp8((int)q[d], true);
    o[4*d] += w * lo[0]; o[4*d+1] += w * lo[1]; o[4*d+2] += w * hi[0]; o[4*d+3] += w * hi[1];
  }
}
__device__ __forceinline__ void peer_gather_group_fp8(const bf16_t* __restrict__ xn, const unsigned* __restrict__ top1, const unsigned char* __restrict__ ub, const float* __restrict__ su,
                                                      const unsigned char* __restrict__ vb, const float* __restrict__ sv, const float* __restrict__ modl, float* __restrict__ xs, int grp, char* smem) {
  const int t = tid_opaque(), lane = t & 63, wave = t >> 6;
  int* pe_l = (int*)smem; float* pg_l = (float*)(smem + 32 * 128 * 4); float* pw_l = (float*)(smem + 2 * 32 * 128 * 4);
  {
    int tl = t >> 3, p = t & 7; long row = (long)grp * 32 + tl;
    peer_combine(top1 + (row * 16 + p * 2) * 16, top1 + (row * 16 + p * 2 + 1) * 16, pe_l + tl * 128 + p * 16, pg_l + tl * 128 + p * 16);
  }
  __syncthreads();
  for (int ti = 0; ti < 8; ++ti) {
    const int tl = wave * 8 + ti; const long row = (long)grp * 32 + tl;
    const int* pe = pe_l + tl * 128; float* pw = pw_l + tl * 128;
    float h[16];
    { u32x4 h0 = *(const u32x4*)(xn + row * DM + lane * 16), h1 = *(const u32x4*)(xn + row * DM + lane * 16 + 8);
#pragma unroll
      for (int e = 0; e < 4; ++e) { h[2*e] = __uint_as_float(h0[e] << 16); h[2*e+1] = __uint_as_float(h0[e] & 0xffff0000u); h[8+2*e] = __uint_as_float(h1[e] << 16); h[8+2*e+1] = __uint_as_float(h1[e] & 0xffff0000u); } }
    u32x4 u[8];
#pragma unroll
    for (int j = 0; j < 8; ++j) u[j] = *(const u32x4*)(ub + (long)pe[j] * DM + lane * 16);
    for (int b = 0; b < 16; ++b) {
      float pd[8];
#pragma unroll
      for (int j = 0; j < 8; ++j) pd[j] = dot16_fp8(h, u[j]);
      if (b + 1 < 16) {
#pragma unroll
        for (int j = 0; j < 8; ++j) u[j] = *(const u32x4*)(ub + (long)pe[(b + 1) * 8 + j] * DM + lane * 16);
      }
      float q4[4], q2[2], q1;
#pragma unroll
      for (int j = 0; j < 4; ++j) { bool hi = lane & 1; float keep = hi ? pd[2*j+1] : pd[2*j], send = hi ? pd[2*j] : pd[2*j+1]; q4[j] = keep + __shfl_xor(send, 1); }
#pragma unroll
      for (int j = 0; j < 2; ++j) { bool hi = lane & 2; float keep = hi ? q4[2*j+1] : q4[2*j], send = hi ? q4[2*j] : q4[2*j+1]; q2[j] = keep + __shfl_xor(send, 2); }
      { bool hi = lane & 4; float keep = hi ? q2[1] : q2[0], send = hi ? q2[0] : q2[1]; q1 = keep + __shfl_xor(send, 4); }
      q1 += __shfl_xor(q1, 8); q1 += __shfl_xor(q1, 16); q1 += __shfl_xor(q1, 32);
      if (lane < 8) pw[b * 8 + lane] = q1 * su[pe[b * 8 + lane]];
    }
    u32x4 v[8];
#pragma unroll
    for (int j = 0; j < 8; ++j) v[j] = *(const u32x4*)(vb + (long)pe[j] * DM + lane * 16);
    {
      float d0 = pw[lane], d1 = pw[64 + lane];
      pw[lane] = pg_l[tl * 128 + lane] * fgelu_(d0) * sv[pe[lane]]; pw[64 + lane] = pg_l[tl * 128 + 64 + lane] * fgelu_(d1) * sv[pe[64 + lane]];
    }
    float o[16];
#pragma unroll
    for (int e = 0; e < 16; ++e) o[e] = 0.f;
    for (int b = 0; b < 16; ++b) {
      u32x4 vc[8];
#pragma unroll
      for (int j = 0; j < 8; ++j) vc[j] = v[j];
      if (b + 1 < 16) {
#pragma unroll
        for (int j = 0; j < 8; ++j) v[j] = *(const u32x4*)(vb + (long)pe[(b + 1) * 8 + j] * DM + lane * 16);
      }
#pragma unroll
      for (int j = 0; j < 8; ++j) axpy16_fp8(o, pw[b * 8 + j], vc[j]);
    }
    {
      int b = row / RB, lr = row % RB; int bb = lr < SEQ ? b : BATCH; const float* g5 = modl + ((long)bb * 6 + 5) * DM + lane * 16;
      float* xr = xs + row * DM + lane * 16;
#pragma unroll
      for (int i = 0; i < 4; ++i) {
        f32x4 x = *(f32x4*)(xr + 4 * i); f32x4 g = *(const f32x4*)(g5 + 4 * i);
        x[0] += g[0] * o[4*i]; x[1] += g[1] * o[4*i+1]; x[2] += g[2] * o[4*i+2]; x[3] += g[3] * o[4*i+3];
        *(f32x4*)(xr + 4 * i) = x;
      }
    }
  }
}

__device__ __forceinline__ float reduce16(float x) { x = reduce8(x); x += dpp_get<0x140>(x); return x; }
__device__ __forceinline__ void unpack8(u32x4 v, float (&f)[8]) {
#pragma unroll
  for (int e = 0; e < 4; ++e) { f[2*e] = __uint_as_float(v[e] << 16); f[2*e+1] = __uint_as_float(v[e] & 0xffff0000u); }
}
__device__ __forceinline__ u32x4 pack8(const float (&f)[8]) { u32x4 o;
#pragma unroll
  for (int e = 0; e < 4; ++e) o[e] = pack2bf(f[2*e], f[2*e+1]);
  return o; }
__device__ __forceinline__ void ph_rope_tables(float* rope_g, float* rope_m) {
  const int t = tid_opaque();
  for (int i = blockIdx.x * 256 + t; i < SEQ * 48; i += gridDim.x * 256) {
    int lr = i / 48, j = i % 48;
    if (j < 32) { int pos = j < 16 ? lr / 64 : lr % 64; float ang = (float)pos * powf(10000.f, -(float)(j & 15) / 16.f); rope_g[(lr * 32 + j) * 2] = cosf(ang); rope_g[(lr * 32 + j) * 2 + 1] = sinf(ang); }
    else { int jj = j - 32; int pos = jj < 8 ? lr / 64 : lr % 64; float ang = (float)pos * powf(10000.f, -(float)(jj & 7) / 8.f); rope_m[(lr * 16 + jj) * 2] = cosf(ang); rope_m[(lr * 16 + jj) * 2 + 1] = sinf(ang); }
  }
}
struct FinW2 { const float *mla_qk_g, *gqa_qk_g, *mu, *k_k, *k_a, *rope_g, *rope_m; };
#define FIN2_LDS_BYTES (64 * 384 * 2)
struct FinRow { u32x4 gqa, mla, vraw, rw[3][3], ab[2]; uint2 tqa, tkva; unsigned tqr, kr; };
__device__ __forceinline__ void fin_row_load(FinRow& R, const FinBuf& B, long row, int lr, int lane) {
  const long MA = NROWS; const int g8 = lane & 7, h8 = lane >> 3, s16 = lane & 15, h16 = lane >> 4;
  const bf16_t* Pr = B.P + row * IN_COLS; const u32x4 z = {0u, 0u, 0u, 0u};
  R.gqa = *(const u32x4*)(Pr + GQA_OFF + lane * 8);
  R.mla = lane < 48 ? *(const u32x4*)(Pr + lane * 8) : z;
  R.tqa = *(const uint2*)(B.tq + row * 384 + h16 * 96 + s16 * 4); R.tqr = *(const unsigned*)(B.tq + row * 384 + h16 * 96 + 64 + s16 * 2);
  R.tkva = *(const uint2*)(B.tkv + row * 512 + h16 * 128 + s16 * 4);
  R.kr = *(const unsigned*)(Pr + 384 + s16 * 2);
  R.vraw = lane < 32 ? *(const u32x4*)(B.tkv + row * 512 + h8 * 128 + 64 + g8 * 8) : (lane < 48 ? *(const u32x4*)(Pr + GQA_OFF + 512 + (lane - 32) * 8) : z);
  const bool first = (lr == 0) || (lr == SEQ), last = (lr == SEQ - 1) || (lr == RB - 1);
#pragma unroll
  for (int part = 0; part < 3; ++part) {
    const bf16_t* pp = Pr + RW_OFF + part * 384 + (lane < 48 ? lane : 0) * 8;
    R.rw[part][0] = *(const u32x4*)pp; R.rw[part][1] = first ? z : *(const u32x4*)(pp - IN_COLS); R.rw[part][2] = last ? z : *(const u32x4*)(pp + IN_COLS);
  }
  const long o = row * 384 + (lane < 48 ? lane : 0) * 8;
  R.ab[0] = *(const u32x4*)(B.a_b + o); R.ab[1] = *(const u32x4*)(B.a_b + MA * 384 + o);
}
__device__ __forceinline__ void prep_finish_tile2(const FinW2& W, const FinBuf& B, int tile, char* smem) {
  const int t = tid_opaque(), lane = t & 63, wave = t >> 6; const long MA = NROWS;
  bf16_t* vbuf = (bf16_t*)smem;
  const long row0 = (long)tile * 8; const int b = row0 / RB; const int lr0 = row0 % RB;
  const int g8 = lane & 7, h8 = lane >> 3, s16 = lane & 15, h16 = lane >> 4;
  FinRow RR[2];
  fin_row_load(RR[0], B, row0 + wave, lr0 + wave, lane);
  fin_row_load(RR[1], B, row0 + 4 + wave, lr0 + 4 + wave, lane);
#pragma unroll
  for (int it = 0; it < 2; ++it) {
    const FinRow& R = RR[it];
    const int rl = it * 4 + wave; const long row = row0 + rl; const int lr = lr0 + rl; const bool lat = lr < SEQ;
    {
      float x[8]; unpack8(R.gqa, x);
      float ss = 0.f;
#pragma unroll
      for (int e = 0; e < 8; ++e) ss += x[e] * x[e];
      ss = reduce8(ss); const float inv = __builtin_amdgcn_rsqf(ss * (1.f / 64.f) + EPSN);
      const float* gp = W.gqa_qk_g + (h8 < 6 ? 0 : 64) + g8 * 8; f32x4 ga = *(const f32x4*)gp, gb = *(const f32x4*)(gp + 4);
#pragma unroll
      for (int e = 0; e < 4; ++e) { x[e] *= inv * ga[e]; x[4 + e] *= inv * gb[e]; }
      float o[8];
      if (lat) {
        const float* rt = W.rope_g + ((long)lr * 32 + (g8 & 3) * 8) * 2;
#pragma unroll
        for (int e = 0; e < 8; ++e) { float ot = swz_xor4(x[e]); float cs = rt[2 * e], sn = rt[2 * e + 1]; o[e] = (g8 & 4) ? (ot * sn + x[e] * cs) : (x[e] * cs - ot * sn); }
      } else {
#pragma unroll
        for (int e = 0; e < 8; ++e) o[e] = x[e];
      }
      if (h8 < 6) {
#pragma unroll
        for (int e = 0; e < 8; ++e) o[e] *= 0.18033688f;
        *(u32x4*)(B.gq + row * 384 + lane * 8) = pack8(o);
      } else *(u32x4*)(B.gk + row * 128 + (lane - 48) * 8) = pack8(o);
    }
    float cq, ckv;
    {
      float ss = 0.f;
      { float x[8]; unpack8(R.mla, x);
#pragma unroll
        for (int e = 0; e < 8; ++e) ss += x[e] * x[e]; }
      float sq = wave_sum(lane < 32 ? ss : 0.f), skv = wave_sum(lane >= 32 ? ss : 0.f);
      cq = __builtin_amdgcn_rsqf(sq * (1.f / 256.f) + EPSN); ckv = __builtin_amdgcn_rsqf(skv * (1.f / 128.f) + EPSN);
    }
    {
      float cs0 = 1.f, sn0 = 0.f, cs1 = 1.f, sn1 = 0.f;
      if (lat) { f32x4 r4 = *(const f32x4*)(W.rope_m + ((long)lr * 16 + (s16 & 7) * 2) * 2); cs0 = r4[0]; sn0 = r4[1]; cs1 = r4[2]; sn1 = r4[3]; }
      const float kr0 = __uint_as_float(R.kr << 16), kr1 = __uint_as_float(R.kr & 0xffff0000u);
#pragma unroll
      for (int which = 0; which < 2; ++which) {
        float n[4], r0, r1;
        if (which == 0) {
          const uint2 a = R.tqa; const unsigned rr = R.tqr;
          n[0] = cq * __uint_as_float(a.x << 16); n[1] = cq * __uint_as_float(a.x & 0xffff0000u); n[2] = cq * __uint_as_float(a.y << 16); n[3] = cq * __uint_as_float(a.y & 0xffff0000u);
          r0 = cq * __uint_as_float(rr << 16); r1 = cq * __uint_as_float(rr & 0xffff0000u);
        } else {
          const uint2 a = R.tkva;
          n[0] = ckv * __uint_as_float(a.x << 16); n[1] = ckv * __uint_as_float(a.x & 0xffff0000u); n[2] = ckv * __uint_as_float(a.y << 16); n[3] = ckv * __uint_as_float(a.y & 0xffff0000u);
          r0 = kr0; r1 = kr1;
        }
        float ss = n[0]*n[0] + n[1]*n[1] + n[2]*n[2] + n[3]*n[3] + r0*r0 + r1*r1;
        ss = reduce16(ss); const float inv = __builtin_amdgcn_rsqf(ss * (1.f / 96.f) + EPSN);
        const float* gp = W.mla_qk_g + which * 96; f32x4 gn = *(const f32x4*)(gp + s16 * 4); const float g0 = gp[64 + s16 * 2], g1 = gp[64 + s16 * 2 + 1];
#pragma unroll
        for (int e = 0; e < 4; ++e) n[e] *= inv * gn[e];
        r0 *= inv * g0; r1 *= inv * g1;
        float o0 = dpp_get<0x128>(r0), o1 = dpp_get<0x128>(r1);
        float q0, q1;
        if (s16 & 8) { q0 = o0 * sn0 + r0 * cs0; q1 = o1 * sn1 + r1 * cs1; } else { q0 = r0 * cs0 - o0 * sn0; q1 = r1 * cs1 - o1 * sn1; }
        const float sc = which == 0 ? 0.14724445f : 1.f;
        bf16_t* dst = (which == 0 ? B.mq : B.mk) + row * 384 + h16 * 96;
        uint2 pk; pk.x = pack2bf(n[0] * sc, n[1] * sc); pk.y = pack2bf(n[2] * sc, n[3] * sc);
        *(uint2*)(dst + s16 * 4) = pk; *(unsigned*)(dst + 64 + s16 * 2) = pack2bf(q0 * sc, q1 * sc);
      }
      if (lane < 32) { float x[8]; unpack8(R.vraw, x);
#pragma unroll
        for (int e = 0; e < 8; ++e) x[e] *= ckv;
        *(u32x4*)(vbuf + rl * 384 + h8 * 64 + g8 * 8) = pack8(x); }
      else if (lane < 48) *(u32x4*)(vbuf + rl * 384 + 256 + (lane - 32) * 8) = R.vraw;
    }
    if (lane < 48) {
      const long o = row * 384 + lane * 8;
      float xs3[3][8];
#pragma unroll
      for (int part = 0; part < 3; ++part) {
        const int c = part * 384 + lane * 8;
        float p[8], pv[8], nx[8]; unpack8(R.rw[part][0], p); unpack8(R.rw[part][1], pv); unpack8(R.rw[part][2], nx);
        f32x4 m0a = *(const f32x4*)(W.mu + c), m0b = *(const f32x4*)(W.mu + c + 4), m1a = *(const f32x4*)(W.mu + RWC + c), m1b = *(const f32x4*)(W.mu + RWC + c + 4);
#pragma unroll
        for (int e = 0; e < 4; ++e) { xs3[part][e] = p[e] + m0a[e] * (pv[e] - p[e]) + m1a[e] * (nx[e] - p[e]); xs3[part][4+e] = p[4+e] + m0b[e] * (pv[4+e] - p[4+e]) + m1b[e] * (nx[4+e] - p[4+e]); }
      }
      *(u32x4*)(B.r_b + o) = pack8(xs3[0]); *(u32x4*)(B.v_b + o) = pack8(xs3[2]);
      f32x4 kka = *(const f32x4*)(W.k_k + lane * 8), kkb = *(const f32x4*)(W.k_k + lane * 8 + 4), kaa = *(const f32x4*)(W.k_a + lane * 8), kab = *(const f32x4*)(W.k_a + lane * 8 + 4);
      float tk[8], ss = 0.f;
#pragma unroll
      for (int e = 0; e < 4; ++e) { tk[e] = xs3[1][e] * kka[e]; tk[4+e] = xs3[1][4+e] * kkb[e]; }
#pragma unroll
      for (int e = 0; e < 8; ++e) ss += tk[e] * tk[e];
      ss = reduce8(ss); const float invk = __builtin_amdgcn_rsqf(ss + 1e-12f);
#pragma unroll
      for (int e = 0; e < 8; ++e) tk[e] *= invk;
      *(u32x4*)(B.kk_b + o) = pack8(tk);
#pragma unroll
      for (int d = 0; d < 2; ++d) {
        float a[8], kd[8], bd[8]; unpack8(R.ab[d], a);
#pragma unroll
        for (int e = 0; e < 8; ++e) { float ka = e < 4 ? kaa[e] : kab[e - 4]; kd[e] = xs3[1][e] * (1.f + (a[e] - 1.f) * ka); bd[e] = tk[e] * a[e]; }
        *(u32x4*)(B.kd_b + d * MA * 384 + o) = pack8(kd); *(u32x4*)(B.bd_b + d * MA * 384 + o) = pack8(bd);
      }
    } else { (void)reduce8(0.f); }
  }
  __syncthreads();
  for (int i = t; i < 384; i += 256) {
    int c = i % 384, rc = i / 384;
    unsigned short v8[8];
#pragma unroll
    for (int e = 0; e < 8; ++e) v8[e] = vbuf[(rc * 8 + e) * 384 + c];
    u32x4 o; o[0] = v8[0] | ((unsigned)v8[1] << 16); o[1] = v8[2] | ((unsigned)v8[3] << 16); o[2] = v8[4] | ((unsigned)v8[5] << 16); o[3] = v8[6] | ((unsigned)v8[7] << 16);
    bf16_t* dst = c < 256 ? B.mvT + ((long)(b * 4 + (c >> 6)) * 64 + (c & 63)) * RB : B.gvT + ((long)(b * 2 + ((c - 256) >> 6)) * 64 + (c & 63)) * RB;
    *(u32x4*)(dst + lr0 + rc * 8) = o;
  }
  __syncthreads();
}
struct RdIn { f32x4 a0, a1, b0, b1; u32x4 r, k0, k1, v, g; };
__device__ __forceinline__ void rw_readout_load(RdIn& R, const float* __restrict__ y, const bf16_t* __restrict__ r_b, const bf16_t* __restrict__ v_b, const bf16_t* __restrict__ kd_b,
                                                const bf16_t* __restrict__ g_b, long row, int lane) {
  const long MA = NROWS; const long o = row * 384 + (lane < 48 ? lane : 0) * 8;
  R.a0 = *(const f32x4*)(y + o); R.a1 = *(const f32x4*)(y + o + 4); R.b0 = *(const f32x4*)(y + MA * 384 + o); R.b1 = *(const f32x4*)(y + MA * 384 + o + 4);
  R.r = *(const u32x4*)(r_b + o); R.k0 = *(const u32x4*)(kd_b + o); R.k1 = *(const u32x4*)(kd_b + MA * 384 + o); R.v = *(const u32x4*)(v_b + o); R.g = *(const u32x4*)(g_b + o);
}
__device__ __forceinline__ void rw_readout_row3(const RdW& W, const RdIn& R, bf16_t* __restrict__ mixall, long row, int lane) {
  float yy[8], s = 0.f; float r[8], k0[8], k1[8], vv[8], gg[8];
  const int c = lane * 8;
  if (lane < 48) {
#pragma unroll
    for (int e = 0; e < 4; ++e) { yy[e] = R.a0[e] + R.b0[e]; yy[4+e] = R.a1[e] + R.b1[e]; }
    unpack8(R.r, r); unpack8(R.k0, k0); unpack8(R.k1, k1); unpack8(R.v, vv); unpack8(R.g, gg);
  } else {
#pragma unroll
    for (int e = 0; e < 8; ++e) { yy[e] = 0.f; r[e] = 0.f; k0[e] = 0.f; k1[e] = 0.f; vv[e] = 0.f; gg[e] = 0.f; }
  }
#pragma unroll
  for (int e = 0; e < 8; ++e) s += yy[e];
  const float mean = reduce8(s) * (1.f / 64.f);
  float vs = 0.f, cf = 0.f;
  const int cc = lane < 48 ? c : 0;
  f32x4 rk0 = *(const f32x4*)(W.r_k + cc), rk1 = *(const f32x4*)(W.r_k + cc + 4);
#pragma unroll
  for (int e = 0; e < 8; ++e) { float d = yy[e] - mean; vs += d * d; cf += r[e] * (k0[e] + k1[e]) * (e < 4 ? rk0[e] : rk1[e - 4]); }
  const float var = reduce8(vs) * (1.f / 64.f), coef = reduce8(cf);
  const float inv = __builtin_amdgcn_rsqf(var + 64e-5f);
  if (lane < 48) {
    f32x4 lg0 = *(const f32x4*)(W.ln_g + c), lg1 = *(const f32x4*)(W.ln_g + c + 4), lb0 = *(const f32x4*)(W.ln_b + c), lb1 = *(const f32x4*)(W.ln_b + c + 4);
    float out[8];
#pragma unroll
    for (int e = 0; e < 8; ++e) { float yn = (yy[e] - mean) * inv * (e < 4 ? lg0[e] : lg1[e - 4]) + (e < 4 ? lb0[e] : lb1[e - 4]); out[e] = (yn + coef * vv[e]) * gg[e]; }
    *(u32x4*)(mixall + row * DM + 256 + c) = pack8(out);
  }
}
__device__ __forceinline__ void rw_readout_row2(const RdW& W, const float* __restrict__ y, const bf16_t* __restrict__ r_b, const bf16_t* __restrict__ v_b, const bf16_t* __restrict__ kd_b,
                                                const bf16_t* __restrict__ g_b, bf16_t* __restrict__ mixall, long row, int lane) {
  const long MA = NROWS;
  float yy[8], s = 0.f; float r[8], k0[8], k1[8], vv[8], gg[8];
  const int c = lane * 8; const long o = row * 384 + c;
  if (lane < 48) {
    f32x4 a0 = *(const f32x4*)(y + o), a1 = *(const f32x4*)(y + o + 4), b0 = *(const f32x4*)(y + MA * 384 + o), b1 = *(const f32x4*)(y + MA * 384 + o + 4);
#pragma unroll
    for (int e = 0; e < 4; ++e) { yy[e] = a0[e] + b0[e]; yy[4+e] = a1[e] + b1[e]; }
    unpack8(*(const u32x4*)(r_b + o), r); unpack8(*(const u32x4*)(kd_b + o), k0); unpack8(*(const u32x4*)(kd_b + MA * 384 + o), k1);
    unpack8(*(const u32x4*)(v_b + o), vv); unpack8(*(const u32x4*)(g_b + o), gg);
  } else {
#pragma unroll
    for (int e = 0; e < 8; ++e) { yy[e] = 0.f; r[e] = 0.f; k0[e] = 0.f; k1[e] = 0.f; vv[e] = 0.f; gg[e] = 0.f; }
  }
#pragma unroll
  for (int e = 0; e < 8; ++e) s += yy[e];
  const float mean = reduce8(s) * (1.f / 64.f);
  float vs = 0.f, cf = 0.f;
  const int cc = lane < 48 ? c : 0;
  f32x4 rk0 = *(const f32x4*)(W.r_k + cc), rk1 = *(const f32x4*)(W.r_k + cc + 4);
#pragma unroll
  for (int e = 0; e < 8; ++e) { float d = yy[e] - mean; vs += d * d; cf += r[e] * (k0[e] + k1[e]) * (e < 4 ? rk0[e] : rk1[e - 4]); }
  const float var = reduce8(vs) * (1.f / 64.f), coef = reduce8(cf);
  const float inv = __builtin_amdgcn_rsqf(var + 64e-5f);
  if (lane < 48) {
    f32x4 lg0 = *(const f32x4*)(W.ln_g + c), lg1 = *(const f32x4*)(W.ln_g + c + 4), lb0 = *(const f32x4*)(W.ln_b + c), lb1 = *(const f32x4*)(W.ln_b + c + 4);
    float out[8];
#pragma unroll
    for (int e = 0; e < 8; ++e) { float yn = (yy[e] - mean) * inv * (e < 4 ? lg0[e] : lg1[e - 4]) + (e < 4 ? lb0[e] : lb1[e - 4]); out[e] = (yn + coef * vv[e]) * gg[e]; }
    *(u32x4*)(mixall + row * DM + 256 + c) = pack8(out);
  }
}

#define PG_NT 4
#define PG_TOK (4 * PG_NT)
#define PG_OFF_H 0
#define PG_OFF_E (PG_TOK * 2048)
#define PG_OFF_G (PG_OFF_E + PG_TOK * 128 * 2)
#define PG_OFF_ST (PG_OFF_G + PG_TOK * 128 * 4)
#define PG_OFF_CNT (PG_OFF_ST + PG_TOK * 18 * 2)
#define PG_LDS_BYTES (PG_OFF_CNT + PG_TOK * 8 * 16 * 2)
__device__ __forceinline__ long pg_row(int g, int ntok) { return ntok == NROWS ? (long)g : (long)(g / SEQ) * RB + (g % SEQ); }
__device__ __forceinline__ void peer_gather_sliced(const bf16_t* __restrict__ xn, const unsigned* __restrict__ top1, const unsigned char* __restrict__ ub, const float* __restrict__ su,
                                                   const unsigned char* __restrict__ vb, const float* __restrict__ sv, const float* __restrict__ modl, float* __restrict__ xs,
                                                   int ntok, char* smem, const float* __restrict__ ng, const float* __restrict__ nmod, bf16_t* __restrict__ xn_next, float* __restrict__ out, bool dry = false, unsigned emask = 0x3FFFu) {
  bf16_t* hs = (bf16_t*)(smem + PG_OFF_H); unsigned short* se = (unsigned short*)(smem + PG_OFF_E); float* sg = (float*)(smem + PG_OFF_G);
  unsigned short* sst = (unsigned short*)(smem + PG_OFF_ST); unsigned short* cnt = (unsigned short*)(smem + PG_OFF_CNT);
  const int per_block = (ntok + (int)gridDim.x - 1) / (int)gridDim.x;
  const int npass = (per_block + PG_TOK - 1) / PG_TOK; const int tpp = (per_block + npass - 1) / npass;
  for (int pass = 0; pass < npass; ++pass) {
    const int t = tid_opaque(), lane = t & 63, wave = t >> 6;
    __syncthreads();
    for (int i = t; i < PG_TOK * 8 * 16; i += 256) cnt[i] = 0;
    for (int i = t; i < PG_TOK * 128; i += 256) {
      int tl = i >> 7, ch = i & 127; int q = (tl % PG_NT) * 4 + tl / PG_NT; int idx = pass * tpp + q; int g = (int)blockIdx.x + idx * (int)gridDim.x;
      u32x4 v = {0u, 0u, 0u, 0u};
      if (q < tpp && idx < per_block && g < ntok) v = *(const u32x4*)(xn + pg_row(g, ntok) * DM + ch * 8);
      *(u32x4*)(hs + tl * 1024 + ch * 8) = v;
    }
    __syncthreads();
    int my_e[16]; float my_g[16];
    const int ctl = t >> 3, cp = t & 7;
    bool cact = false;
    if (ctl < PG_TOK) {
      int q = (ctl % PG_NT) * 4 + ctl / PG_NT; int idx = pass * tpp + q; int g = (int)blockIdx.x + idx * (int)gridDim.x;
      cact = q < tpp && idx < per_block && g < ntok;
      if (cact) {
        long row = pg_row(g, ntok);
        peer_combine(top1 + (row * 16 + cp * 2) * 16, top1 + (row * 16 + cp * 2 + 1) * 16, my_e, my_g);
#pragma unroll
        for (int k = 0; k < 16; ++k) cnt[(ctl * 8 + cp) * 16 + (my_e[k] >> 10)] += 1;
      }
    }
    __syncthreads();
    if (t < PG_TOK) {
      int run = 0;
      for (int s = 0; s < 16; ++s) {
        sst[t * 18 + s] = (unsigned short)run;
        for (int h = 0; h < 8; ++h) { int c = cnt[(t * 8 + h) * 16 + s]; cnt[(t * 8 + h) * 16 + s] = (unsigned short)run; run += c; }
      }
      sst[t * 18 + 16] = (unsigned short)run;
    }
    __syncthreads();
    if (cact) {
#pragma unroll
      for (int k = 0; k < 16; ++k) { int s = my_e[k] >> 10; int pos = cnt[(ctl * 8 + cp) * 16 + s]; cnt[(ctl * 8 + cp) * 16 + s] = (unsigned short)(pos + 1); se[ctl * 128 + pos] = (unsigned short)my_e[k]; sg[ctl * 128 + pos] = my_g[k]; }
    }
    __syncthreads();
    float acc[PG_NT][16];
#pragma unroll
    for (int tk = 0; tk < PG_NT; ++tk)
#pragma unroll
      for (int e = 0; e < 16; ++e) acc[tk][e] = 0.f;
    for (int s = 0; s < 16; ++s) {
#pragma unroll
      for (int tk = 0; tk < PG_NT; ++tk) {
        const int tl = wave * PG_NT + tk;
        const int st = sst[tl * 18 + s], en = sst[tl * 18 + s + 1];
        for (int base = st; base < en; base += 8) {
          const int nb = en - base < 8 ? en - base : 8;
          u32x4 u[8], v[8];
#pragma unroll
          for (int j = 0; j < 8; ++j) if (j < nb) { const unsigned off = ((unsigned)se[tl * 128 + base + j] & emask) * 1024u + (unsigned)lane * 16u; u[j] = *(const u32x4*)(ub + off); v[j] = *(const u32x4*)(vb + off); }
          float h[16];
          { u32x4 h0 = *(const u32x4*)(hs + tl * 1024 + lane * 16), h1 = *(const u32x4*)(hs + tl * 1024 + lane * 16 + 8);
#pragma unroll
            for (int e = 0; e < 4; ++e) { h[2*e] = __uint_as_float(h0[e] << 16); h[2*e+1] = __uint_as_float(h0[e] & 0xffff0000u); h[8+2*e] = __uint_as_float(h1[e] << 16); h[8+2*e+1] = __uint_as_float(h1[e] & 0xffff0000u); } }
          float pd[8];
#pragma unroll
          for (int j = 0; j < 8; ++j) pd[j] = j < nb ? dot16_fp8(h, u[j]) : 0.f;
          float q4[4], q2[2], q1;
#pragma unroll
          for (int j = 0; j < 4; ++j) { bool hi = lane & 1; float keep = hi ? pd[2*j+1] : pd[2*j], send = hi ? pd[2*j] : pd[2*j+1]; q4[j] = keep + dpp_get<0xB1>(send); }
#pragma unroll
          for (int j = 0; j < 2; ++j) { bool hi = lane & 2; float keep = hi ? q4[2*j+1] : q4[2*j], send = hi ? q4[2*j] : q4[2*j+1]; q2[j] = keep + dpp_get<0x4E>(send); }
          { bool hi = lane & 4; float keep = hi ? q2[1] : q2[0], send = hi ? q2[0] : q2[1]; q1 = keep + xor4_get(send); }
          q1 += dpp_get<0x128>(q1);
          q1 = xor16_sum(q1);
          q1 = xor32_sum(q1);
          float w = 0.f;
          { const int jj = lane & 7; if (jj < nb) { int e = se[tl * 128 + base + jj]; w = sg[tl * 128 + base + jj] * fgelu_(q1 * su[e]) * sv[e]; } }
#pragma unroll
          for (int j = 0; j < 8; ++j) { float wj = __builtin_bit_cast(float, __builtin_amdgcn_readlane(__builtin_bit_cast(int, w), j)); if (j < nb) axpy16_fp8(acc[tk], wj, v[j]); }
        }
      }
    }
    if (dry) {
#pragma unroll
      for (int tk = 0; tk < PG_NT; ++tk)
#pragma unroll
        for (int e = 0; e < 16; ++e) asm volatile("" :: "v"(acc[tk][e]));
    }
#pragma unroll
    for (int tk = 0; tk < PG_NT; ++tk) {
      int q = tk * 4 + wave; int idx = pass * tpp + q; int g = (int)blockIdx.x + idx * (int)gridDim.x;
      if (!dry && q < tpp && idx < per_block && g < ntok) {
        long row = pg_row(g, ntok); int b = row / RB, lr = row % RB; int bb = lr < SEQ ? b : BATCH; const float* g5 = modl + ((long)bb * 6 + 5) * DM + lane * 16;
        float* xr = xs + row * DM + lane * 16;
        f32x4 xv[4]; float ss = 0.f;
#pragma unroll
        for (int i = 0; i < 4; ++i) {
          f32x4 x = *(f32x4*)(xr + 4 * i); f32x4 gg = *(const f32x4*)(g5 + 4 * i);
          x[0] += gg[0] * acc[tk][4*i]; x[1] += gg[1] * acc[tk][4*i+1]; x[2] += gg[2] * acc[tk][4*i+2]; x[3] += gg[3] * acc[tk][4*i+3];
          xv[i] = x; ss += x[0] * x[0] + x[1] * x[1] + x[2] * x[2] + x[3] * x[3];
        }
        if (out) {
          float* orow = out + ((long)b * SEQ + lr) * DM + lane * 16;
#pragma unroll
          for (int i = 0; i < 4; ++i) *(f32x4*)(orow + 4 * i) = xv[i];
        } else {
#pragma unroll
          for (int i = 0; i < 4; ++i) *(f32x4*)(xr + 4 * i) = xv[i];
          ss = wave_sum(ss); const float inv = __builtin_amdgcn_rsqf(ss * (1.f / DM) + EPSN);
          const float* sh = nmod + ((long)bb * 6 + 0) * DM + lane * 16; const float* sc = sh + DM; const float* gp = ng + lane * 16;
          u32x4 p0, p1;
#pragma unroll
          for (int i = 0; i < 4; ++i) { f32x4 g4 = *(const f32x4*)(gp + 4 * i), s4 = *(const f32x4*)(sc + 4 * i), h4 = *(const f32x4*)(sh + 4 * i);
            const float a0 = xv[i][0] * inv * g4[0] * (1.f + s4[0]) + h4[0], a1 = xv[i][1] * inv * g4[1] * (1.f + s4[1]) + h4[1];
            const float a2 = xv[i][2] * inv * g4[2] * (1.f + s4[2]) + h4[2], a3 = xv[i][3] * inv * g4[3] * (1.f + s4[3]) + h4[3];
            if (i < 2) { p0[2 * i] = pack2bf(a0, a1); p0[2 * i + 1] = pack2bf(a2, a3); } else { p1[2 * (i - 2)] = pack2bf(a0, a1); p1[2 * (i - 2) + 1] = pack2bf(a2, a3); } }
          *(u32x4*)(xn_next + row * DM + lane * 16) = p0; *(u32x4*)(xn_next + row * DM + lane * 16 + 8) = p1;
        }
      }
    }
  }
}

#define PG3_OFF_H 0
#define PG3_OFF_FE (12 * 2048)
#define PG3_OFF_FG (PG3_OFF_FE + 4 * 384 * 2)
#define PG3_OFF_FS (PG3_OFF_FG + 4 * 384 * 4)
#define PG3_OFF_BT (PG3_OFF_FS + 4 * 384 * 4)
#define PG3_OFF_CNT (PG3_OFF_BT + 4 * 160 * 4)
#define PG3_OFF_TOT (PG3_OFF_CNT + 4 * 512 * 2)
#define PG3_LDS_BYTES (PG3_OFF_TOT + 512)
#define PG3_REC_BYTES (384 * 2 + 384 * 4 + 384 * 4 + 160 * 4 + 16)
__device__ __forceinline__ void peer_lists_build3(const unsigned* __restrict__ top1, const float* __restrict__ su, const float* __restrict__ sv, char* __restrict__ gl, int ntok, char* smem) {
  unsigned short* fe = (unsigned short*)(smem + PG3_OFF_FE); float* fg = (float*)(smem + PG3_OFF_FG); float* fs = (float*)(smem + PG3_OFF_FS);
  unsigned* bt = (unsigned*)(smem + PG3_OFF_BT); unsigned short* cnt = (unsigned short*)(smem + PG3_OFF_CNT); unsigned short* tot = (unsigned short*)(smem + PG3_OFF_TOT);
  int* nbt = (int*)(smem + PG3_OFF_TOT + 320);
  const int per_block = (ntok + (int)gridDim.x - 1) / (int)gridDim.x;
  const int npass = (per_block + 11) / 12; const int tpp = (per_block + npass - 1) / npass;
  unsigned short* st_e = (unsigned short*)(smem + PG3_OFF_H); float* st_g = (float*)(smem + PG3_OFF_H + 2 * 96 * 16 * 2);
  const bool pre = npass <= 3;
  int my_e[16]; float my_g[16];
#pragma unroll
  for (int k = 0; k < 16; ++k) { my_e[k] = 0; my_g[k] = 0.f; }
  if (pre) {
    const int t = tid_opaque();
    __syncthreads();
    for (int j = t; j < npass * 96; j += 256) {
      const int pj = j / 96, rem = j % 96; const int ctl = rem >> 3, cp = rem & 7; const int cw = ctl / 3, ctk = ctl % 3;
      const int q = ctk * 4 + cw; const int idx = pj * tpp + q; const int g = (int)blockIdx.x + idx * (int)gridDim.x;
      if (q < tpp && idx < per_block && g < ntok) {
        int e_[16]; float g_[16];
        const long row = pg_row(g, ntok);
        peer_combine(top1 + (row * 16 + cp * 2) * 16, top1 + (row * 16 + cp * 2 + 1) * 16, e_, g_);
        if (pj == 0) {
#pragma unroll
          for (int k = 0; k < 16; ++k) { my_e[k] = e_[k]; my_g[k] = g_[k]; }
        } else {
          const int sj = (pj - 1) * 96 + rem;
#pragma unroll
          for (int k = 0; k < 16; ++k) { st_e[sj * 16 + k] = (unsigned short)e_[k]; st_g[sj * 16 + k] = g_[k]; }
        }
      }
    }
  }
  for (int pass = 0; pass < npass; ++pass) {
    const int t = tid_opaque();
    __syncthreads();
    for (int i = t; i < 4 * 512; i += 256) cnt[i] = 0;
    __syncthreads();
    const int ctl = t >> 3, cp = t & 7; const int cw = ctl / 3, ctk = ctl % 3;
    bool cact = false;
    float my_su[16], my_sv[16];
    if (ctl < 12) {
      int q = ctk * 4 + cw; int idx = pass * tpp + q; int g = (int)blockIdx.x + idx * (int)gridDim.x;
      cact = q < tpp && idx < per_block && g < ntok;
      if (cact) {
        if (!pre) {
          long row = pg_row(g, ntok);
          peer_combine(top1 + (row * 16 + cp * 2) * 16, top1 + (row * 16 + cp * 2 + 1) * 16, my_e, my_g);
        } else if (pass > 0) {
          const int sj = (pass - 1) * 96 + t;
#pragma unroll
          for (int k = 0; k < 16; ++k) { my_e[k] = st_e[sj * 16 + k]; my_g[k] = st_g[sj * 16 + k]; }
        }
#pragma unroll
        for (int k = 0; k < 16; ++k) { my_su[k] = su[my_e[k]]; my_sv[k] = sv[my_e[k]]; }
#pragma unroll
        for (int k = 0; k < 16; ++k) cnt[((cw * 16 + (my_e[k] >> 10)) * 4 + ctk) * 8 + cp] += 1;
      }
    }
    __syncthreads();
    unsigned short* tot2 = tot + 80;
    if (t < 64) {
      int w_ = t >> 4, s = t & 15; int ne = 0, nbk = 0;
      for (int tk = 0; tk < 3; ++tk) { int n = 0; for (int h = 0; h < 8; ++h) n += cnt[((w_ * 16 + s) * 4 + tk) * 8 + h]; ne += n; nbk += (n + 7) >> 3; }
      tot[w_ * 16 + s] = (unsigned short)ne; tot2[w_ * 16 + s] = (unsigned short)nbk;
    }
    __syncthreads();
    if (t < 64) {
      int w_ = t >> 4, s = t & 15; int run = 0, nb_ = 0;
      for (int i = 0; i < s; ++i) { run += tot[w_ * 16 + i]; nb_ += tot2[w_ * 16 + i]; }
      for (int tk = 0; tk < 3; ++tk) {
        int gstart = run;
        for (int h = 0; h < 8; ++h) { int ci = ((w_ * 16 + s) * 4 + tk) * 8 + h; int c = cnt[ci]; cnt[ci] = (unsigned short)run; run += c; }
        for (int b0 = gstart; b0 < run; b0 += 8) { int n = run - b0 < 8 ? run - b0 : 8; bt[w_ * 160 + nb_] = (unsigned)tk | ((unsigned)b0 << 4) | ((unsigned)n << 16); ++nb_; }
      }
      if (s == 15) { while (nb_ % 3) { bt[w_ * 160 + nb_] = 0u; ++nb_; } nbt[w_] = nb_; }
    }
    __syncthreads();
    if (cact) {
#pragma unroll
      for (int k = 0; k < 16; ++k) { int ci = ((cw * 16 + (my_e[k] >> 10)) * 4 + ctk) * 8 + cp; int pos = cnt[ci]; cnt[ci] = (unsigned short)(pos + 1);
        fe[cw * 384 + pos] = (unsigned short)my_e[k]; fg[cw * 384 + pos] = my_g[k] * my_sv[k]; fs[cw * 384 + pos] = my_su[k]; }
    }
    __syncthreads();
    char* rec = gl + ((long)blockIdx.x * 4 + pass) * 4 * PG3_REC_BYTES;
    for (int i = t; i < 4 * 48; i += 256) { int w_ = i / 48, c = i % 48; *(u32x4*)(rec + w_ * PG3_REC_BYTES + c * 16) = *(const u32x4*)((const char*)fe + w_ * 768 + c * 16); }
    for (int i = t; i < 4 * 96; i += 256) { int w_ = i / 96, c = i % 96; *(u32x4*)(rec + w_ * PG3_REC_BYTES + 768 + c * 16) = *(const u32x4*)((const char*)fg + w_ * 1536 + c * 16); }
    for (int i = t; i < 4 * 96; i += 256) { int w_ = i / 96, c = i % 96; *(u32x4*)(rec + w_ * PG3_REC_BYTES + 2304 + c * 16) = *(const u32x4*)((const char*)fs + w_ * 1536 + c * 16); }
    for (int i = t; i < 4 * 40; i += 256) { int w_ = i / 40, c = i % 40; *(u32x4*)(rec + w_ * PG3_REC_BYTES + 3840 + c * 16) = *(const u32x4*)((const char*)bt + w_ * 640 + c * 16); }
    if (t < 4) *(int*)(rec + t * PG3_REC_BYTES + 4480) = nbt[t];
  }
  __syncthreads();
}
__device__ __forceinline__ void pg3_issue(u32x4 (&B)[8], const unsigned char* __restrict__ tab, const unsigned short* we, unsigned desc, int lane) {
  const int base = (desc >> 4) & 0xFFF, nb = desc >> 16;
#pragma unroll
  for (int j = 0; j < 8; ++j) { const int jj = j < nb ? j : (nb > 0 ? nb - 1 : 0); const unsigned off = (unsigned)we[base + jj] * 1024u + (unsigned)lane * 16u; B[j] = *(const u32x4*)(tab + off); }
}
__device__ __forceinline__ void pg3_axpy8(float (&a)[16], const u32x4 (&V)[8], float w, int nb) {
#pragma unroll
  for (int j = 0; j < 8; ++j) { const float wj = __builtin_bit_cast(float, __builtin_amdgcn_readlane(__builtin_bit_cast(int, w), j)); if (j < nb) axpy16_fp8(a, wj, V[j]); }
}
__device__ __forceinline__ void pg3_step(u32x4 (&U)[8], u32x4 (&V)[8], u32x4 (&F)[8], int k, int nbat, float (&acc)[3][16],
                                         const unsigned char* __restrict__ ub, const unsigned char* __restrict__ vb,
                                         const unsigned short* we, const float* wg, const float* wsc, const unsigned* wb, const bf16_t* hw, int lane) {
  const unsigned desc = __builtin_amdgcn_readfirstlane(wb[k]);
  const int tk = desc & 15, base = (desc >> 4) & 0xFFF, nb = desc >> 16;
  const unsigned dnext = __builtin_amdgcn_readfirstlane(wb[k + 1 < nbat ? k + 1 : k]);
  pg3_issue(F, ub, we, dnext, lane);
  float h[16];
  { const bf16_t* hp = hw + tk * 1024 + lane * 16; u32x4 h0 = *(const u32x4*)hp, h1 = *(const u32x4*)(hp + 8);
#pragma unroll
    for (int e = 0; e < 4; ++e) { h[2*e] = __uint_as_float(h0[e] << 16); h[2*e+1] = __uint_as_float(h0[e] & 0xffff0000u); h[8+2*e] = __uint_as_float(h1[e] << 16); h[8+2*e+1] = __uint_as_float(h1[e] & 0xffff0000u); } }
  float pd[8];
#pragma unroll
  for (int j = 0; j < 8; ++j) pd[j] = j < nb ? dot16_fp8(h, U[j]) : 0.f;
  pg3_issue(U, vb, we, dnext, lane);
  float q4[4], q2[2], q1;
#pragma unroll
  for (int j = 0; j < 4; ++j) { bool hi = lane & 1; float keep = hi ? pd[2*j+1] : pd[2*j], send = hi ? pd[2*j] : pd[2*j+1]; q4[j] = keep + dpp_get<0xB1>(send); }
#pragma unroll
  for (int j = 0; j < 2; ++j) { bool hi = lane & 2; float keep = hi ? q4[2*j+1] : q4[2*j], send = hi ? q4[2*j] : q4[2*j+1]; q2[j] = keep + dpp_get<0x4E>(send); }
  { bool hi = lane & 4; float keep = hi ? q2[1] : q2[0], send = hi ? q2[0] : q2[1]; q1 = keep + xor4_get(send); }
  q1 += dpp_get<0x128>(q1);
  q1 = xor16_sum(q1);
  q1 = xor32_sum(q1);
  float w = 0.f;
  { const int jj = lane & 7; if (jj < nb) w = wg[base + jj] * fgelu_(q1 * wsc[base + jj]); }
  if (tk == 0) pg3_axpy8(acc[0], V, w, nb); else if (tk == 1) pg3_axpy8(acc[1], V, w, nb); else pg3_axpy8(acc[2], V, w, nb);
}
__device__ __forceinline__ void peer_gather_sweep3(const bf16_t* __restrict__ xn, const char* __restrict__ gl, const unsigned char* __restrict__ ub,
                                                   const unsigned char* __restrict__ vb, const float* __restrict__ modl, float* __restrict__ xs, int ntok, char* smem,
                                                   const float* __restrict__ ng, const float* __restrict__ nmod, bf16_t* __restrict__ xn_next, float* __restrict__ out,
                                                   int pass_begin, int pass_end) {
  bf16_t* hs = (bf16_t*)(smem + PG3_OFF_H); unsigned short* fe = (unsigned short*)(smem + PG3_OFF_FE); float* fg = (float*)(smem + PG3_OFF_FG); float* fs = (float*)(smem + PG3_OFF_FS);
  unsigned* bt = (unsigned*)(smem + PG3_OFF_BT); int* nbt = (int*)(smem + PG3_OFF_TOT + 320);
  const int per_block = (ntok + (int)gridDim.x - 1) / (int)gridDim.x;
  const int npass = (per_block + 11) / 12; const int tpp = (per_block + npass - 1) / npass;
  for (int pass = pass_begin; pass < pass_end && pass < npass; ++pass) {
    {
      const int t = tid_opaque();
      __syncthreads();
      const char* rec = gl + ((long)blockIdx.x * 4 + pass) * 4 * PG3_REC_BYTES;
      for (int i = t; i < 4 * 48; i += 256) { int w_ = i / 48, c = i % 48; *(u32x4*)((char*)fe + w_ * 768 + c * 16) = *(const u32x4*)(rec + w_ * PG3_REC_BYTES + c * 16); }
      for (int i = t; i < 4 * 96; i += 256) { int w_ = i / 96, c = i % 96; *(u32x4*)((char*)fg + w_ * 1536 + c * 16) = *(const u32x4*)(rec + w_ * PG3_REC_BYTES + 768 + c * 16); }
      for (int i = t; i < 4 * 96; i += 256) { int w_ = i / 96, c = i % 96; *(u32x4*)((char*)fs + w_ * 1536 + c * 16) = *(const u32x4*)(rec + w_ * PG3_REC_BYTES + 2304 + c * 16); }
      for (int i = t; i < 4 * 40; i += 256) { int w_ = i / 40, c = i % 40; *(u32x4*)((char*)bt + w_ * 640 + c * 16) = *(const u32x4*)(rec + w_ * PG3_REC_BYTES + 3840 + c * 16); }
      if (t < 4) nbt[t] = *(const int*)(rec + t * PG3_REC_BYTES + 4480);
      for (int i = t; i < 12 * 128; i += 256) {
        int tl = i >> 7, ch = i & 127; int q = (tl % 3) * 4 + (tl / 3); int idx = pass * tpp + q; int g = (int)blockIdx.x + idx * (int)gridDim.x;
        u32x4 v = {0u, 0u, 0u, 0u};
        if (q < tpp && idx < per_block && g < ntok) v = *(const u32x4*)(xn + pg_row(g, ntok) * DM + ch * 8);
        *(u32x4*)(hs + tl * 1024 + ch * 8) = v;
      }
      __syncthreads();
    }
    const int t_s = tid_opaque(); const int lane = t_s & 63, wave = t_s >> 6;
    float acc[3][16];
#pragma unroll
    for (int tk = 0; tk < 3; ++tk)
#pragma unroll
      for (int e = 0; e < 16; ++e) acc[tk][e] = 0.f;
    const int nbat = nbt[wave];
    const unsigned short* we = fe + wave * 384; const float* wg = fg + wave * 384; const float* wsc = fs + wave * 384; const unsigned* wb = bt + wave * 160;
    const bf16_t* hw = hs + wave * 3 * 1024;
    u32x4 X[8], Y[8], Z[8];
    if (nbat > 0) { const unsigned d0 = __builtin_amdgcn_readfirstlane(wb[0]); pg3_issue(X, ub, we, d0, lane); pg3_issue(Y, vb, we, d0, lane); }
    for (int k = 0; k < nbat; k += 3) {
      pg3_step(X, Y, Z, k, nbat, acc, ub, vb, we, wg, wsc, wb, hw, lane);
      pg3_step(Z, X, Y, k + 1, nbat, acc, ub, vb, we, wg, wsc, wb, hw, lane);
      pg3_step(Y, Z, X, k + 2, nbat, acc, ub, vb, we, wg, wsc, wb, hw, lane);
    }
#pragma unroll
    for (int tk = 0; tk < 3; ++tk) {
      int q = tk * 4 + wave; int idx = pass * tpp + q; int g = (int)blockIdx.x + idx * (int)gridDim.x;
      if (q < tpp && idx < per_block && g < ntok) {
        long row = pg_row(g, ntok); int b = row / RB, lr = row % RB; int bb = lr < SEQ ? b : BATCH; const float* g5 = modl + ((long)bb * 6 + 5) * DM + lane * 16;
        float* xr = xs + row * DM + lane * 16;
        f32x4 xv[4]; float ss = 0.f;
#pragma unroll
        for (int i = 0; i < 4; ++i) {
          f32x4 x = *(f32x4*)(xr + 4 * i); f32x4 gg = *(const f32x4*)(g5 + 4 * i);
          x[0] += gg[0] * acc[tk][4*i]; x[1] += gg[1] * acc[tk][4*i+1]; x[2] += gg[2] * acc[tk][4*i+2]; x[3] += gg[3] * acc[tk][4*i+3];
          xv[i] = x; ss += x[0] * x[0] + x[1] * x[1] + x[2] * x[2] + x[3] * x[3];
        }
        if (out) {
          float* orow = out + ((long)b * SEQ + lr) * DM + lane * 16;
#pragma unroll
          for (int i = 0; i < 4; ++i) *(f32x4*)(orow + 4 * i) = xv[i];
        } else {
#pragma unroll
          for (int i = 0; i < 4; ++i) *(f32x4*)(xr + 4 * i) = xv[i];
          ss = wave_sum(ss); const float inv = __builtin_amdgcn_rsqf(ss * (1.f / DM) + EPSN);
          const float* sh = nmod + ((long)bb * 6 + 0) * DM + lane * 16; const float* sc = sh + DM; const float* gp = ng + lane * 16;
          u32x4 p0, p1;
#pragma unroll
          for (int i = 0; i < 4; ++i) { f32x4 g4 = *(const f32x4*)(gp + 4 * i), s4 = *(const f32x4*)(sc + 4 * i), h4 = *(const f32x4*)(sh + 4 * i);
            const float a0 = xv[i][0] * inv * g4[0] * (1.f + s4[0]) + h4[0], a1 = xv[i][1] * inv * g4[1] * (1.f + s4[1]) + h4[1];
            const float a2 = xv[i][2] * inv * g4[2] * (1.f + s4[2]) + h4[2], a3 = xv[i][3] * inv * g4[3] * (1.f + s4[3]) + h4[3];
            if (i < 2) { p0[2 * i] = pack2bf(a0, a1); p0[2 * i + 1] = pack2bf(a2, a3); } else { p1[2 * (i - 2)] = pack2bf(a0, a1); p1[2 * (i - 2) + 1] = pack2bf(a2, a3); } }
          *(u32x4*)(xn_next + row * DM + lane * 16) = p0; *(u32x4*)(xn_next + row * DM + lane * 16 + 8) = p1;
        }
      }
    }
  }
}

#define CS_L 32
#define CS_LDA 72
#define CS_LDS_ 40
#define CS_OFF_KK 0
#define CS_OFF_R  (CS_OFF_KK + 32 * CS_LDA * 2)
#define CS_OFF_K  (CS_OFF_R + 32 * CS_LDA * 2)
#define CS_OFF_B  (CS_OFF_K + 32 * CS_LDA * 2)
#define CS_OFF_S  (CS_OFF_B + 32 * CS_LDA * 2)
#define CS_OFF_VT (CS_OFF_S + 64 * CS_LDA * 2)
#define CS_OFF_UT (CS_OFF_VT + 64 * CS_LDS_ * 2)
#define CS_OFF_KP (CS_OFF_UT + 64 * CS_LDS_ * 2)
#define CS_OFF_BP (CS_OFF_KP + 64 * CS_LDS_ * 2)
#define CS_OFF_A  (CS_OFF_BP + 64 * CS_LDS_ * 2)
#define CS_OFF_P1 (CS_OFF_A + 32 * CS_LDS_ * 2)
#define CS_OFF_P2 (CS_OFF_P1 + 32 * CS_LDS_ * 2)
#define CS_OFF_C  (CS_OFF_P2 + 32 * CS_LDS_ * 2)
#define CS_OFF_G  (CS_OFF_C + 32 * 36 * 4)
#define CS_LDS_BYTES (CS_OFF_G + 5 * 64 * 4)
template <int KS>
__device__ __forceinline__ void cs_mma(const bf16_t* A, int lda, int m0, const bf16_t* Bt, int ldb, int n0, int lane, f32x4& acc) {
  const int fr = lane & 15, fq = lane >> 4;
#pragma unroll
  for (int ks = 0; ks < KS; ++ks) {
    bf16x8 af = *(const bf16x8*)(A + (m0 + fr) * lda + ks * 32 + fq * 8);
    bf16x8 bfr = *(const bf16x8*)(Bt + (n0 + fr) * ldb + ks * 32 + fq * 8);
    acc = __builtin_amdgcn_mfma_f32_16x16x32_bf16(bfr, af, acc, 0, 0, 0);
  }
}
#define CSP_WAVE_BYTES (2 * 32 * CS_LDA * 2 + 32 * 36 * 4)
__device__ __forceinline__ void rw_chunk_inverse(const bf16_t* __restrict__ kk_, const bf16_t* __restrict__ bd_, const float* __restrict__ w_, bf16_t* __restrict__ Mg,
                                                 int job, long dstride, char* smem_wave, int lane) {
  const int job_u = __builtin_amdgcn_readfirstlane(job);
  const int c = job_u % (RB / CS_L), item = job_u / (RB / CS_L);
  const int dir = item & 1, h = (item >> 1) % 6, b = item / 12;
  const long rowbase = (long)b * RB; const int col0 = h * 64;
  bf16_t* KKs = (bf16_t*)smem_wave; bf16_t* Bs_ = KKs + 32 * CS_LDA; float* Cf = (float*)(smem_wave + 2 * 32 * CS_LDA * 2);
  const int fr = lane & 15, fq = lane >> 4;
  const int rlo = dir ? scan_row(1, c * CS_L + 31) : scan_row(0, c * CS_L);
  const long ub_ = (rowbase + rlo) * 384 + col0;
  const char* sw_ = (const char*)(w_ + dir * dstride + ub_); const char* skk_ = (const char*)(kk_ + ub_); const char* sb_ = (const char*)(bd_ + dir * dstride + ub_);
  float wv[32]; unsigned kkr[32], br[32];
#pragma unroll
  for (int tt = 0; tt < 32; ++tt) {
    const unsigned m_ = dir ? 31 - tt : tt;
    wv[tt] = *(const float*)(sw_ + (size_t)((unsigned)lane * 4u + m_ * 1536u)); kkr[tt] = *(const bf16_t*)(skk_ + (size_t)((unsigned)lane * 2u + m_ * 768u)); br[tt] = *(const bf16_t*)(sb_ + (size_t)((unsigned)lane * 2u + m_ * 768u));
  }
  float G = 1.f;
#pragma unroll
  for (int tt = 0; tt < 32; ++tt) {
    KKs[tt * CS_LDA + lane] = f2bf(bf2f((bf16_t)kkr[tt]) * G);
    G *= wv[tt];
    Bs_[tt * CS_LDA + lane] = f2bf(bf2f((bf16_t)br[tt]) * __builtin_amdgcn_rcpf(G));
  }
#pragma unroll
  for (int mt = 0; mt < 2; ++mt)
#pragma unroll
    for (int nt = 0; nt < 2; ++nt) {
      f32x4 a = {0.f, 0.f, 0.f, 0.f};
      cs_mma<2>(KKs, CS_LDA, mt * 16, Bs_, CS_LDA, nt * 16, lane, a);
      const int tt = mt * 16 + fr, s0 = nt * 16 + fq * 4;
      f32x4 o4;
#pragma unroll
      for (int e = 0; e < 4; ++e) o4[e] = (s0 + e < tt) ? a[e] : 0.f;
      *(f32x4*)(Cf + tt * 36 + s0) = o4;
    }
  float m[32];
#pragma unroll
  for (int tt = 0; tt < 32; ++tt) {
    float acc = (tt == lane) ? 1.f : 0.f;
#pragma unroll
    for (int s4 = 0; s4 < tt; s4 += 4) {
      const f32x4 cv = *(const f32x4*)(Cf + tt * 36 + s4);
#pragma unroll
      for (int e = 0; e < 4; ++e) if (s4 + e < tt) acc -= cv[e] * m[s4 + e];
    }
    m[tt] = acc;
  }
  if (lane < 32) {
    bf16_t* dst = Mg + (long)job_u * 1024;
#pragma unroll
    for (int tt = 0; tt < 32; ++tt) dst[tt * 32 + lane] = f2bf(m[tt]);
  }
}
#define CS_FETCH(c_) do { const int s0_ = (c_) * CS_L + cq * 8; const int rlo_ = dir ? scan_row(1, s0_ + 7) : scan_row(0, s0_); \
      const char* fw_ = s_w + (long)rlo_ * 1536; const char* fkk_ = s_kk + (long)rlo_ * 768; const char* fb_ = s_b + (long)rlo_ * 768; \
      const char* fk_ = s_k + (long)rlo_ * 768; const char* fr_ = s_r + (long)rlo_ * 768; const char* fv_ = s_v + (long)rlo_ * 768; \
      _Pragma("unroll") for (int e = 0; e < 8; ++e) { asm volatile("" : "+v"(vo2e[e]), "+v"(vo4e[e]));   \
        pw[e] = *(const float*)(fw_ + (size_t)vo4e[e]); pkk[e] = *(const bf16_t*)(fkk_ + (size_t)vo2e[e]); pb[e] = *(const bf16_t*)(fb_ + (size_t)vo2e[e]); \
        pk[e] = *(const bf16_t*)(fk_ + (size_t)vo2e[e]); pr[e] = *(const bf16_t*)(fr_ + (size_t)vo2e[e]); pv[e] = *(const bf16_t*)(fv_ + (size_t)vo2e[e]); } } while (0)
__device__ __forceinline__ void rw_scan_chunked(const bf16_t* __restrict__ r_, const bf16_t* __restrict__ v_, const bf16_t* __restrict__ kk_, const bf16_t* __restrict__ kd_,
                                                const bf16_t* __restrict__ bd_, const float* __restrict__ w_, float* __restrict__ y_, int item, long dstride, char* smem, const bf16_t* __restrict__ Mg) {
  const int t = tid_opaque(), lane = t & 63, wave = t >> 6, fr = lane & 15, fq = lane >> 4;
  const int item_u = __builtin_amdgcn_readfirstlane(item);
  const int dir = item_u & 1, h = (item_u >> 1) % 6, b = item_u / 12;
  const long rowbase = (long)b * RB; const int col0 = h * 64;
  bf16_t* KKs = (bf16_t*)(smem + CS_OFF_KK); bf16_t* Rs = (bf16_t*)(smem + CS_OFF_R); bf16_t* Ks_ = (bf16_t*)(smem + CS_OFF_K); bf16_t* Bs_ = (bf16_t*)(smem + CS_OFF_B);
  bf16_t* Ss = (bf16_t*)(smem + CS_OFF_S); bf16_t* Vt = (bf16_t*)(smem + CS_OFF_VT); bf16_t* Ut = (bf16_t*)(smem + CS_OFF_UT);
  bf16_t* KpT = (bf16_t*)(smem + CS_OFF_KP); bf16_t* BpT = (bf16_t*)(smem + CS_OFF_BP);
  bf16_t* As_ = (bf16_t*)(smem + CS_OFF_A); bf16_t* P1s = (bf16_t*)(smem + CS_OFF_P1); bf16_t* P2s = (bf16_t*)(smem + CS_OFF_P2);
  bf16_t* Ms = (bf16_t*)(smem + CS_OFF_C);
  float* Gq = (float*)(smem + CS_OFF_G); float* GL = Gq + 256;
  bf16_t* rhsT = (bf16_t*)(smem + CS_OFF_K);
  const int cj = t & 63, cq = __builtin_amdgcn_readfirstlane(t >> 6);
  unsigned vo2e[8], vo4e[8];
#pragma unroll
  for (int e = 0; e < 8; ++e) { const int m_ = dir ? 7 - e : e; vo2e[e] = (unsigned)cj * 2u + (unsigned)m_ * 768u; vo4e[e] = (unsigned)cj * 4u + (unsigned)m_ * 1536u; }
  const long ubase_ = rowbase * 384 + col0;
  const char* s_w = (const char*)(w_ + dir * dstride + ubase_); const char* s_kk = (const char*)(kk_ + ubase_); const char* s_b = (const char*)(bd_ + dir * dstride + ubase_);
  const char* s_k = (const char*)(kd_ + dir * dstride + ubase_); const char* s_r = (const char*)(r_ + ubase_); const char* s_v = (const char*)(v_ + ubase_);
  __syncthreads();
  for (int i = t; i < 64 * CS_LDA; i += 256) Ss[i] = 0;
  f32x4 Sacc[4];
#pragma unroll
  for (int it = 0; it < 4; ++it) Sacc[it] = (f32x4){0.f, 0.f, 0.f, 0.f};
  float pw[8]; unsigned pkk[8], pb[8], pk[8], pr[8], pv[8]; uint2 pm;
  const bf16_t* Mitem = Mg + (long)item * (RB / CS_L) * 1024 + t * 4;
  CS_FETCH(0); pm = *(const uint2*)Mitem;
  __builtin_amdgcn_s_setprio(3);
  const int NCH = RB / CS_L;
  for (int c = 0; c < NCH; ++c) {
#pragma unroll
    for (int e = 0; e < 8; ++e) asm volatile("" : "+v"(pw[e]), "+v"(pkk[e]), "+v"(pb[e]), "+v"(pk[e]), "+v"(pr[e]), "+v"(pv[e]));
    asm volatile("" : "+v"(pm.x), "+v"(pm.y));
    float g[8]; float run = 1.f;
#pragma unroll
    for (int e = 0; e < 8; ++e) { run *= pw[e]; g[e] = run; }
    Gq[cq * 64 + cj] = run;
    float kkv[8], bv[8], kv[8], rv[8]; bf16_t vv[8];
#pragma unroll
    for (int e = 0; e < 8; ++e) { kkv[e] = bf2f((bf16_t)pkk[e]); bv[e] = bf2f((bf16_t)pb[e]); kv[e] = bf2f((bf16_t)pk[e]); rv[e] = bf2f((bf16_t)pr[e]); vv[e] = (bf16_t)pv[e]; }
    __syncthreads();
    const uint2 pm_cur = pm;
    if (c + 1 < NCH) { CS_FETCH(c + 1); pm = *(const uint2*)(Mitem + (long)(c + 1) * 1024); }
    float base = 1.f, tot = 1.f;
#pragma unroll
    for (int q = 0; q < 4; ++q) { float pq = Gq[q * 64 + cj]; if (q < cq) base *= pq; tot *= pq; }
    if (cq == 0) GL[cj] = tot;
    {
      u32x4 kp4, bp4, vt4;
#pragma unroll
      for (int e = 0; e < 8; ++e) {
        const float G = base * g[e], Gp = e == 0 ? base : base * g[e - 1], iG = __builtin_amdgcn_rcpf(G);
        const int tt = cq * 8 + e;
        KKs[tt * CS_LDA + cj] = f2bf(kkv[e] * Gp); Rs[tt * CS_LDA + cj] = f2bf(rv[e] * G);
        const float kt = kv[e] * iG, bt = bv[e] * iG;
        Ks_[tt * CS_LDA + cj] = f2bf(kt); Bs_[tt * CS_LDA + cj] = f2bf(bt);
        kv[e] = kt * tot; bv[e] = -bt * tot;
      }
#pragma unroll
      for (int e = 0; e < 4; ++e) { kp4[e] = pack2bf(kv[2 * e], kv[2 * e + 1]); bp4[e] = pack2bf(bv[2 * e], bv[2 * e + 1]); vt4[e] = (unsigned)vv[2 * e] | ((unsigned)vv[2 * e + 1] << 16); }
      *(uint2*)(Ms + (t >> 3) * CS_LDS_ + (t & 7) * 4) = pm_cur;
      *(u32x4*)(KpT + cj * CS_LDS_ + cq * 8) = kp4; *(u32x4*)(BpT + cj * CS_LDS_ + cq * 8) = bp4; *(u32x4*)(Vt + cj * CS_LDS_ + cq * 8) = vt4;
    }
    __syncthreads();
    if (wave == 1) {
    } else {
      const bf16_t* X = wave == 0 ? KKs : Rs; const bf16_t* Y = wave == 3 ? Bs_ : Ks_;
#pragma unroll
      for (int mt = 0; mt < 2; ++mt)
#pragma unroll
        for (int nt = 0; nt < 2; ++nt) {
          f32x4 a = {0.f, 0.f, 0.f, 0.f};
          cs_mma<2>(X, CS_LDA, mt * 16, Y, CS_LDA, nt * 16, lane, a);
          const int tt = mt * 16 + fr, s0 = nt * 16 + fq * 4;
          float o[4];
#pragma unroll
          for (int e = 0; e < 4; ++e) { const int s = s0 + e; const bool keep = wave == 0 ? (s < tt) : (s <= tt); o[e] = keep ? a[e] : 0.f; }
          bf16_t* dst = wave == 0 ? As_ : (wave == 2 ? P1s : P2s); const float sg = wave == 3 ? -1.f : 1.f;
          uint2 pk2; pk2.x = pack2bf(sg * o[0], sg * o[1]); pk2.y = pack2bf(sg * o[2], sg * o[3]);
          *(uint2*)(dst + tt * CS_LDS_ + s0) = pk2;
        }
    }
    __syncthreads();
    f32x4 yp[2];
    {
      const bf16x8 sb0 = *(const bf16x8*)(Ss + (wave * 16 + fr) * CS_LDA + fq * 8), sb1 = *(const bf16x8*)(Ss + (wave * 16 + fr) * CS_LDA + 32 + fq * 8);
      const bf16x8 vb = *(const bf16x8*)(Vt + (wave * 16 + fr) * CS_LDS_ + fq * 8);
      bf16x8 ak[2][2], ar[2][2], aa[2], ap[2];
#pragma unroll
      for (int mt = 0; mt < 2; ++mt) {
        ak[mt][0] = *(const bf16x8*)(KKs + (mt * 16 + fr) * CS_LDA + fq * 8); ak[mt][1] = *(const bf16x8*)(KKs + (mt * 16 + fr) * CS_LDA + 32 + fq * 8);
        ar[mt][0] = *(const bf16x8*)(Rs + (mt * 16 + fr) * CS_LDA + fq * 8);  ar[mt][1] = *(const bf16x8*)(Rs + (mt * 16 + fr) * CS_LDA + 32 + fq * 8);
        aa[mt] = *(const bf16x8*)(As_ + (mt * 16 + fr) * CS_LDS_ + fq * 8);   ap[mt] = *(const bf16x8*)(P1s + (mt * 16 + fr) * CS_LDS_ + fq * 8);
      }
#pragma unroll
      for (int mt = 0; mt < 2; ++mt) {
        f32x4 a = {0.f, 0.f, 0.f, 0.f}, y2 = {0.f, 0.f, 0.f, 0.f};
        a = __builtin_amdgcn_mfma_f32_16x16x32_bf16(sb0, ak[mt][0], a, 0, 0, 0);   y2 = __builtin_amdgcn_mfma_f32_16x16x32_bf16(sb0, ar[mt][0], y2, 0, 0, 0);
        a = __builtin_amdgcn_mfma_f32_16x16x32_bf16(sb1, ak[mt][1], a, 0, 0, 0);   y2 = __builtin_amdgcn_mfma_f32_16x16x32_bf16(sb1, ar[mt][1], y2, 0, 0, 0);
        a = __builtin_amdgcn_mfma_f32_16x16x32_bf16(vb, aa[mt], a, 0, 0, 0);       y2 = __builtin_amdgcn_mfma_f32_16x16x32_bf16(vb, ap[mt], y2, 0, 0, 0);
#pragma unroll
        for (int e = 0; e < 4; ++e) rhsT[(wave * 16 + fq * 4 + e) * CS_LDS_ + mt * 16 + fr] = f2bf(a[e]);
        yp[mt] = y2;
      }
    }
    __syncthreads();
#pragma unroll
    for (int nt = 0; nt < 2; ++nt) {
      f32x4 a = {0.f, 0.f, 0.f, 0.f};
      cs_mma<1>(rhsT, CS_LDS_, wave * 16, Ms, CS_LDS_, nt * 16, lane, a);
      uint2 pk2; pk2.x = pack2bf(a[0], a[1]); pk2.y = pack2bf(a[2], a[3]);
      *(uint2*)(Ut + (wave * 16 + fr) * CS_LDS_ + nt * 16 + fq * 4) = pk2;
    }
    __syncthreads();
    {
      const bf16x8 ub_ = *(const bf16x8*)(Ut + (wave * 16 + fr) * CS_LDS_ + fq * 8);
      const bf16x8 kpb = *(const bf16x8*)(KpT + (wave * 16 + fr) * CS_LDS_ + fq * 8), bpb = *(const bf16x8*)(BpT + (wave * 16 + fr) * CS_LDS_ + fq * 8);
      bf16x8 p2a[2], va[4], ua[4];
#pragma unroll
      for (int mt = 0; mt < 2; ++mt) p2a[mt] = *(const bf16x8*)(P2s + (mt * 16 + fr) * CS_LDS_ + fq * 8);
#pragma unroll
      for (int it = 0; it < 4; ++it) { va[it] = *(const bf16x8*)(Vt + (it * 16 + fr) * CS_LDS_ + fq * 8); ua[it] = *(const bf16x8*)(Ut + (it * 16 + fr) * CS_LDS_ + fq * 8); }
      const f32x4 gl = *(const f32x4*)(GL + wave * 16 + fq * 4);
#pragma unroll
      for (int mt = 0; mt < 2; ++mt) {
        yp[mt] = __builtin_amdgcn_mfma_f32_16x16x32_bf16(ub_, p2a[mt], yp[mt], 0, 0, 0);
        const long row = rowbase + scan_row(dir, c * CS_L) + (dir ? -(mt * 16 + fr) : (mt * 16 + fr));
        *(f32x4*)(y_ + dir * dstride + row * 384 + col0 + wave * 16 + fq * 4) = yp[mt];
      }
#pragma unroll
      for (int it = 0; it < 4; ++it) {
        f32x4 a = Sacc[it]; a[0] *= gl[0]; a[1] *= gl[1]; a[2] *= gl[2]; a[3] *= gl[3];
        a = __builtin_amdgcn_mfma_f32_16x16x32_bf16(kpb, va[it], a, 0, 0, 0);
        a = __builtin_amdgcn_mfma_f32_16x16x32_bf16(bpb, ua[it], a, 0, 0, 0);
        Sacc[it] = a;
      }
    }
    __syncthreads();
#pragma unroll
    for (int it = 0; it < 4; ++it) { uint2 pk2; pk2.x = pack2bf(Sacc[it][0], Sacc[it][1]); pk2.y = pack2bf(Sacc[it][2], Sacc[it][3]); *(uint2*)(Ss + (it * 16 + fr) * CS_LDA + wave * 16 + fq * 4) = pk2; }
  }
  __builtin_amdgcn_s_setprio(0);
  __syncthreads();
}
#include <hip/hip_cooperative_groups.h>
namespace cg = cooperative_groups;

#define XB_TMO      128
#define XB_XCNT(j)  (256  + 64 * (j))
#define XB_XSUB(j)  (1280 + 64 * (j))
#define XB_XGEN(j)  (2304 + 64 * (j))
#define XB_TOP      3328
#define XB_TOPGEN   3392
#define XB_QUEUE(i) (3456 + 64 * (i))
#define XCD_BAR_WORDS 4096
#define XB_SPIN_CAP (1u << 22)
#define LAS __attribute__((address_space(3)))
__device__ __forceinline__ unsigned xb_ld(unsigned* p)              { return __hip_atomic_load(p, __ATOMIC_RELAXED, __HIP_MEMORY_SCOPE_AGENT); }
__device__ __forceinline__ unsigned xb_add(unsigned* p, unsigned v) { return __hip_atomic_fetch_add(p, v, __ATOMIC_RELAXED, __HIP_MEMORY_SCOPE_AGENT); }
__device__ __forceinline__ unsigned xb_xcc_id() { return (unsigned)__builtin_amdgcn_s_getreg((3 << 11) | 20) & 0xFu; }
#define XB_SPIN(cond, bar) do { unsigned _sp = 0; while (cond) { __builtin_amdgcn_s_sleep(1); \
    if ((++_sp & 255u) == 0u) { if (xb_ld(&(bar)[XB_TMO])) break; if (_sp > XB_SPIN_CAP) { atomicAdd(&(bar)[XB_TMO], 1u); break; } } } } while (0)
struct XcdBarrier { unsigned* bar; unsigned x; volatile LAS unsigned* st; };
__device__ __forceinline__ XcdBarrier xcd_barrier_post(unsigned* bar, volatile LAS unsigned* st) {
  XcdBarrier b; b.bar = bar; b.x = xb_xcc_id(); b.st = st;
  if (threadIdx.x == 0) (void)xb_add(&bar[XB_XCNT(b.x)], 1u);
  return b;
}
__device__ __forceinline__ void xcd_barrier_complete(unsigned* bar, unsigned x, unsigned& nloc, unsigned& nx) {
  const unsigned G = gridDim.x; unsigned sum, cnt, mine, sp = 0u;
  for (;;) {
    sum = 0u; cnt = 0u; mine = 0u;
#pragma unroll
    for (unsigned j = 0; j < 16; ++j) { const unsigned c = xb_ld(&bar[XB_XCNT(j)]); sum += c; cnt += (c > 0u) ? 1u : 0u; mine = (j == x) ? c : mine; }
    if (sum == G) break;
    __builtin_amdgcn_s_sleep(1);
    if ((++sp & 255u) == 0u) { if (xb_ld(&bar[XB_TMO])) break; if (sp > XB_SPIN_CAP) { atomicAdd(&bar[XB_TMO], 1u); break; } }
  }
  nloc = mine > 0u ? mine : 1u; nx = cnt > 0u ? cnt : 1u;
}
__device__ __forceinline__ void xcd_barrier(const XcdBarrier& b) {
  asm volatile("s_waitcnt vmcnt(0)" ::: "memory");
  __syncthreads();
  if (threadIdx.x == 0) {
    unsigned* bar = b.bar;
    __builtin_amdgcn_s_waitcnt(0);
    unsigned nloc = b.st[0], nx = b.st[1];
    if (nloc == 0u) { xcd_barrier_complete(bar, b.x, nloc, nx); b.st[0] = nloc; b.st[1] = nx; }
    const unsigned old = xb_add(&bar[XB_XSUB(b.x)], 1u);
    const unsigned gen = old / nloc;
    if (old + 1u == (gen + 1u) * nloc) {
      __builtin_amdgcn_fence(__ATOMIC_RELEASE, "agent");
      asm volatile("s_waitcnt vmcnt(0)" ::: "memory");
      const unsigned og = xb_add(&bar[XB_TOP], 1u);
      const unsigned tg = og / nx;
      if (og + 1u == (tg + 1u) * nx) xb_add(&bar[XB_TOPGEN], 1u);
      else XB_SPIN(xb_ld(&bar[XB_TOPGEN]) == tg, bar);
      __builtin_amdgcn_fence(__ATOMIC_ACQUIRE, "agent");
      xb_add(&bar[XB_XGEN(b.x)], 1u);
      asm volatile("s_waitcnt vmcnt(0)" ::: "memory");
    } else {
      XB_SPIN(xb_ld(&bar[XB_XGEN(b.x)]) == gen, bar);
      __builtin_amdgcn_fence(__ATOMIC_ACQUIRE, "agent");
      asm volatile("s_waitcnt vmcnt(0)" ::: "memory");
    }
  }
  __syncthreads();
}


constexpr size_t al256(size_t x) { return (x + 255) & ~(size_t)255; }
struct WsOff { size_t xs, mod, xn, Pb, tq, tkv, a_b, g_b, w_f, mq, mk, mvT, gq, gk, gvT, r_b, v_b, kk_b, kd_b, bd_b, w_inT, w_outT, wqT, keysb, wqbT, wkvbT, w2T, a2T, g2T, rope_g, rope_m, total; };
constexpr WsOff make_wsoff() {
  WsOff o{}; size_t p = 32768; const size_t MA = NROWS;
  o.mod = p; p += al256(2 * (BATCH + 1) * 6144 * 4); o.xs = p; p += al256(MA * DM * 4); o.xn = p; p += al256(MA * DM * 2);
  o.Pb = p; p += al256(MA * IN_COLS * 2);
  o.tq = p; p += al256(MA * 384 * 2); o.tkv = p; p += al256(MA * 512 * 2); o.a_b = p; p += al256(2 * MA * 384 * 2);
  o.g_b = p; p += al256(MA * 384 * 2); o.w_f = p; p += al256(2 * MA * 384 * 4);
  o.mq = p; p += al256(MA * 384 * 2); o.mk = p; p += al256(MA * 384 * 2); o.mvT = p; p += al256((size_t)BATCH * 4 * 64 * RB * 2);
  o.gq = p; p += al256(MA * 384 * 2); o.gk = p; p += al256(MA * 128 * 2); o.gvT = p; p += al256((size_t)BATCH * 2 * 64 * RB * 2);
  o.r_b = p; p += al256(MA * 384 * 2); o.v_b = p; p += al256(MA * 384 * 2); o.kk_b = p; p += al256(MA * 384 * 2);
  o.kd_b = p; p += al256(2 * MA * 384 * 2); o.bd_b = p; p += al256(2 * MA * 384 * 2);
  o.w_inT = p; p += al256((size_t)2 * 2688 * 1024 * 2); o.w_outT = p; p += al256((size_t)2 * 1024 * 1024 * 2); o.wqT = p; p += al256((size_t)2 * 2048 * 1024 * 2);
  o.keysb = p; p += al256((size_t)2 * 16 * 128 * 128 * 2); o.wqbT = p; p += al256((size_t)2 * 384 * 256 * 2); o.wkvbT = p; p += al256((size_t)2 * 512 * 128 * 2);
  o.w2T = p; p += al256((size_t)2 * 2 * 384 * 64 * 2); o.a2T = p; p += al256((size_t)2 * 2 * 384 * 64 * 2); o.g2T = p; p += al256((size_t)2 * 384 * 192 * 2);
  o.rope_g = p; p += al256((size_t)SEQ * 64 * 4); o.rope_m = p; p += al256((size_t)SEQ * 32 * 4);
  o.total = p; return o;
}
constexpr WsOff WO = make_wsoff();
#define WS_PTR(T, off) ((T*)(ws + (off)))
#define MINV_OFF (WO.tq + (size_t)40 * 1024 * 1024)
#define TAB_OFF (WO.Pb + ((size_t)2 * NROWS * 384 * 4 + 1048576 & ~(size_t)255))
#define TAB_U (TAB_OFF)
#define TAB_V (TAB_OFF + (size_t)16384 * 1024)
#define TAB_SU (TAB_OFF + (size_t)2 * 16384 * 1024)
#define TAB_SV (TAB_OFF + (size_t)2 * 16384 * 1024 + 65536)
#define LAUNDER_S(x) asm volatile("" : "+s"(x))
#define KARG_AS __attribute__((address_space(4)))
#define KP_DECL const KARG_AS MegaP* kp_ = (const KARG_AS MegaP*)__builtin_amdgcn_kernarg_segment_ptr(); LAUNDER_S(kp_)

struct NaiveIn {
  const float *x, *c, *ctx, *c_ctx, *ada_w, *ada_b, *norm_mix_g, *norm_ffn_g, *w_in, *w_out, *mla_q_norm_g, *mla_w_qb, *mla_kv_norm_g,
      *mla_w_kvb, *mla_qk_g, *rw_mu, *rw_w0, *rw_w2, *rw_a0, *rw_a2, *rw_g2, *rw_k_k, *rw_k_a, *rw_r_k, *rw_ln_g, *rw_ln_b, *gqa_qk_g,
      *pe_wq, *pe_keys, *pe_u, *pe_v;
};
struct MegaP { NaiveIn in; char* ws; float* out; };

#ifndef MEGA_CG
#define MEGA_CG 0
#endif
#if MEGA_CG
#define GRID_BARRIER() cg::this_grid().sync()
#else
#ifdef BAR_TWICE
#define GRID_BARRIER() do { GRID_BARRIER1(); GRID_BARRIER1(); } while (0)
#else
#define GRID_BARRIER() GRID_BARRIER1()
#endif
#define GRID_BARRIER1() do { XcdBarrier xb_; xb_.bar = (unsigned*)((const KARG_AS MegaP*)__builtin_amdgcn_kernarg_segment_ptr())->ws; xb_.x = xb_xcc_id(); xb_.st = (volatile LAS unsigned*)&xb_words; xcd_barrier(xb_); } while (0)
#endif
#define MEGA_LDS_BYTES 65536
#ifndef PHASE_MASK
#define PHASE_MASK 0xFFFF
#endif
#define PH(k) if (PHASE_MASK & (1 << (k)))
#define LAT_TM(i) (((i) >> 4) * 18 + ((i) & 15))
#define XCD_TILE_LOOP(tile, T) for (int xt_base_ = (int)(((long)(T) * (blockIdx.x & 7)) >> 3), xt_cnt_ = (int)(((long)(T) * ((blockIdx.x & 7) + 1)) >> 3) - xt_base_, xt_q_ = blockIdx.x >> 3, tile = xt_base_ + xt_q_; xt_q_ < xt_cnt_; xt_q_ += gridDim.x >> 3, tile = xt_base_ + xt_q_)
#ifndef DIL_PH
#define DIL_PH -1
#endif
#ifndef DIL_MULT
#define DIL_MULT 4
#endif
#define DIL_BEGIN(k) unsigned long long dil_t0 = 0; if (DIL_PH == (k)) dil_t0 = __builtin_amdgcn_s_memrealtime();
#define DIL_END(k) if (DIL_PH == (k)) { GRID_BARRIER(); if (blockIdx.x == 0 && threadIdx.x == 0) { unsigned long long t1 = __builtin_amdgcn_s_memrealtime(); unsigned long long dt = (t1 - dil_t0) * DIL_MULT; \
    while (__builtin_amdgcn_s_memrealtime() - t1 < dt) __builtin_amdgcn_s_sleep(32); } }

__device__ __forceinline__ void ph_norm_mod(const float* __restrict__ xs, const float* __restrict__ g, const float* __restrict__ modl, int shift_idx, bf16_t* __restrict__ xn, bool skip_ctx = false,
                                            const float* __restrict__ x_in = nullptr, const float* __restrict__ ctx_in = nullptr) {
  const int tt_ = tid_opaque(); const int lane = tt_ & 63;
  const long nidx = skip_ctx ? (long)BATCH * SEQ : (long)NROWS;
  const long stride = (long)gridDim.x * 4;
  f32x4 gv[4];
#pragma unroll
  for (int i = 0; i < 4; ++i) gv[i] = *(const f32x4*)(g + i * 256 + lane * 4);
  f32x4 v[4], scv[4], shv[4], nv[4], nsc[4], nsh[4];
#define NM_ROW(idx_) (skip_ctx ? ((idx_) / SEQ) * RB + (idx_) % SEQ : (idx_))
#define NM_LOAD(V, SC, SH, idx_) do { const long row_ = NM_ROW(idx_); const int b_ = row_ / RB, lr_ = row_ % RB; const int bb_ = lr_ < SEQ ? b_ : BATCH; \
    const float* sh_ = modl + ((long)bb_ * 6 + shift_idx) * DM; const float* sc_ = sh_ + DM; \
    const float* xr_ = x_in ? (lr_ < SEQ ? x_in + ((long)b_ * SEQ + lr_) * DM : ctx_in + ((long)b_ * CTX_LEN + (lr_ - SEQ)) * DM) : xs + row_ * DM; \
    _Pragma("unroll") for (int i = 0; i < 4; ++i) { V[i] = *(const f32x4*)(xr_ + i * 256 + lane * 4); SC[i] = *(const f32x4*)(sc_ + i * 256 + lane * 4); SH[i] = *(const f32x4*)(sh_ + i * 256 + lane * 4); } } while (0)
  long idx = (long)blockIdx.x * 4 + (tt_ >> 6);
  if (idx < nidx) NM_LOAD(v, scv, shv, idx);
  for (; idx < nidx; idx += stride) {
    const bool more = idx + stride < nidx;
    if (more) NM_LOAD(nv, nsc, nsh, idx + stride);
    const long row = NM_ROW(idx);
    float ss = 0.f;
#pragma unroll
    for (int i = 0; i < 4; ++i) ss += v[i][0]*v[i][0] + v[i][1]*v[i][1] + v[i][2]*v[i][2] + v[i][3]*v[i][3];
    ss = wave_sum(ss);
    const float inv = __builtin_amdgcn_rsqf(ss / DM + EPSN);
#pragma unroll
    for (int i = 0; i < 4; ++i) {
      const int d = i * 256 + lane * 4; float o[4];
#pragma unroll
      for (int e = 0; e < 4; ++e) o[e] = v[i][e] * inv * gv[i][e] * (1.f + scv[i][e]) + shv[i][e];
      uint2 pk; pk.x = pack2bf(o[0], o[1]); pk.y = pack2bf(o[2], o[3]);
      *(uint2*)(xn + row * DM + d) = pk;
    }
    if (more) {
#pragma unroll
      for (int i = 0; i < 4; ++i) { v[i] = nv[i]; scv[i] = nsc[i]; shv[i] = nsh[i]; }
    }
  }
#undef NM_LOAD
#undef NM_ROW
}
__device__ __forceinline__ void ph_cvt_wT(const float* W, const float* g, bf16_t* Wt, int K, int N, int Npad, int Kpad) {
  const long n_el = (long)Npad * Kpad;
  const int tt_ = tid_opaque();
  for (long i = (long)blockIdx.x * 256 + tt_; i < n_el; i += (long)gridDim.x * 256) {
    int k = i % Kpad; int n = i / Kpad;
    Wt[i] = (k < K && n < N) ? f2bf(W[(long)k * N + n] * (g ? g[k] : 1.f)) : (bf16_t)0;
  }
}
__device__ __forceinline__ void ph_cvt_bf16(const float* s, bf16_t* d, long n8) {
  const int tt_ = tid_opaque();
  for (long i = (long)blockIdx.x * 256 + tt_; i < n8; i += (long)gridDim.x * 256) {
    f32x4 a = *(const f32x4*)(s + i * 8), b = *(const f32x4*)(s + i * 8 + 4);
    u32x4 o; o[0] = pack2bf(a[0], a[1]); o[1] = pack2bf(a[2], a[3]); o[2] = pack2bf(b[0], b[1]); o[3] = pack2bf(b[2], b[3]);
    *(u32x4*)(d + i * 8) = o;
  }
}


__device__ __forceinline__ void ph_cvt_wT_tiled(const float* __restrict__ W, const float* __restrict__ g, bf16_t* __restrict__ Wt, int K, int N, int Npad, int Kpad, char* smem) {
  const int t = tid_opaque(); float* s = (float*)smem;
  const int tk = Kpad / 64, tn = Npad / 64;
  for (int tile = blockIdx.x; tile < tk * tn; tile += gridDim.x) {
    const int k0 = (tile % tk) * 64, n0 = (tile / tk) * 64;
    __syncthreads();
#pragma unroll
    for (int i = 0; i < 4; ++i) {
      int kk = (t >> 4) + 16 * i, nn = (t & 15) * 4; int k = k0 + kk;
      f32x4 v = {0.f, 0.f, 0.f, 0.f};
      if (k < K) {
        const float* src = W + (long)k * N + n0 + nn; float gs = g ? g[k] : 1.f;
        if (n0 + nn + 3 < N) v = *(const f32x4*)src; else { for (int e = 0; e < 4; ++e) if (n0 + nn + e < N) v[e] = src[e]; }
        v *= gs;
      }
#pragma unroll
      for (int e = 0; e < 4; ++e) s[kk * 65 + nn + e] = v[e];
    }
    __syncthreads();
    {
      int nn = t >> 2, kq = (t & 3) * 16; u32x4 o0, o1;
#pragma unroll
      for (int e = 0; e < 4; ++e) { o0[e] = pack2bf(s[(kq + 2*e) * 65 + nn], s[(kq + 2*e + 1) * 65 + nn]); o1[e] = pack2bf(s[(kq + 8 + 2*e) * 65 + nn], s[(kq + 8 + 2*e + 1) * 65 + nn]); }
      bf16_t* dst = Wt + (long)(n0 + nn) * Kpad + k0 + kq;
      *(u32x4*)dst = o0; *(u32x4*)(dst + 8) = o1;
    }
  }
}
__device__ __forceinline__ void ph_mod_gemv(const float* __restrict__ c, const float* __restrict__ c_ctx, const float* __restrict__ ada_w, const float* __restrict__ ada_b, float* __restrict__ mod, char* smem) {
  const int t = tid_opaque(); float* s = (float*)smem;
  if ((int)blockIdx.x >= 2 * 96) return;
  for (int i = t; i < 9 * 1024; i += 256) { int bb = i >> 10, k = i & 1023; float v = bb < BATCH ? c[bb * DM + k] : c_ctx[k]; s[i] = v * __builtin_amdgcn_rcpf(1.f + __builtin_amdgcn_exp2f(-v * 1.4426950408889634f)); }
  __syncthreads();
  float* part = s + 9 * 1024;
  for (int item = blockIdx.x; item < 2 * 96; item += gridDim.x) {
    const int cb = item % 96, l = item / 96; const int kq = t >> 6, col = t & 63;
    const int j = cb * 64 + col; const float* wp = ada_w + ((long)l * DM + kq * 256) * 6144 + j;
    float acc[9];
#pragma unroll
    for (int bb = 0; bb < 9; ++bb) acc[bb] = 0.f;
#pragma unroll 16
    for (int k = 0; k < 256; ++k) { float w = wp[(long)k * 6144];
#pragma unroll
      for (int bb = 0; bb < 9; ++bb) acc[bb] += s[bb * 1024 + kq * 256 + k] * w; }
#pragma unroll
    for (int bb = 0; bb < 9; ++bb) part[(kq * 9 + bb) * 64 + col] = acc[bb];
    __syncthreads();
    for (int i = t; i < 9 * 64; i += 256) { int bb = i >> 6, cc = i & 63;
      float v = ((part[(0 * 9 + bb) * 64 + cc] + part[(1 * 9 + bb) * 64 + cc]) + part[(2 * 9 + bb) * 64 + cc]) + part[(3 * 9 + bb) * 64 + cc];
      mod[((long)l * (BATCH + 1) + bb) * 6144 + cb * 64 + cc] = v + ada_b[l * 6144 + cb * 64 + cc]; }
    __syncthreads();
  }
}

__global__ void __launch_bounds__(256, 2) mega_kernel(MegaP p) {
  __shared__ __attribute__((aligned(16))) char smem[MEGA_LDS_BYTES];
  __shared__ uint4 xb_words;
  const int t0 = threadIdx.x;
#if !MEGA_CG
  if (t0 == 0) xb_words = make_uint4(0u, 0u, 0u, 0u);
  __syncthreads();
  (void)xcd_barrier_post((unsigned*)p.ws, (volatile LAS unsigned*)&xb_words);
#endif
  const long MA = NROWS; const int TM = NROWS / 128;
#define I (kp_->in)
  const int scan_role = (int)blockIdx.x < BATCH * 12 ? 1 : 0;
  { DIL_BEGIN(0)
  PH(0) {
    KP_DECL; char* ws = kp_->ws; const int t = tid_opaque();
    float* xs = WS_PTR(float, WO.xs); float* mod = WS_PTR(float, WO.mod);
    ph_mod_gemv(I.c, I.c_ctx, I.ada_w, I.ada_b, mod, smem);
    for (int l = 0; l < 2; ++l) {
      ph_cvt_wT_tiled(I.w_in + (long)l * DM * IN_COLS, nullptr, WS_PTR(bf16_t, WO.w_inT) + (long)l * 2688 * 1024, 1024, IN_COLS, 2688, 1024, smem);
      ph_cvt_wT_tiled(I.w_out + (long)l * DM * DM, nullptr, WS_PTR(bf16_t, WO.w_outT) + (long)l * 1024 * 1024, 1024, 1024, 1024, 1024, smem);
      ph_cvt_wT_tiled(I.pe_wq + (long)l * DM * 2048, nullptr, WS_PTR(bf16_t, WO.wqT) + (long)l * 2048 * 1024, 1024, 2048, 2048, 1024, smem);
      ph_cvt_wT_tiled(I.mla_w_qb + (long)l * 256 * 384, I.mla_q_norm_g + l * 256, WS_PTR(bf16_t, WO.wqbT) + (long)l * 384 * 256, 256, 384, 384, 256, smem);
      ph_cvt_wT_tiled(I.mla_w_kvb + (long)l * 128 * 512, I.mla_kv_norm_g + l * 128, WS_PTR(bf16_t, WO.wkvbT) + (long)l * 512 * 128, 128, 512, 512, 128, smem);
      for (int d = 0; d < 2; ++d) {
        ph_cvt_wT_tiled(I.rw_w2 + ((long)l * 2 + d) * 64 * 384, nullptr, WS_PTR(bf16_t, WO.w2T) + ((long)l * 2 + d) * 384 * 64, 64, 384, 384, 64, smem);
        ph_cvt_wT_tiled(I.rw_a2 + ((long)l * 2 + d) * 64 * 384, nullptr, WS_PTR(bf16_t, WO.a2T) + ((long)l * 2 + d) * 384 * 64, 64, 384, 384, 64, smem);
      }
      ph_cvt_wT_tiled(I.rw_g2 + (long)l * 160 * 384, nullptr, WS_PTR(bf16_t, WO.g2T) + (long)l * 384 * 192, 160, 384, 384, 192, smem);
    }
    ph_cvt_bf16(I.pe_keys, WS_PTR(bf16_t, WO.keysb), 2L * 16 * 128 * 128 / 8);
    ph_rope_tables(WS_PTR(float, WO.rope_g), WS_PTR(float, WO.rope_m));
  }
  DIL_END(0) }
  GRID_BARRIER();
  for (int lq = 0; lq < 2; ++lq) {
    int l = lq; LAUNDER_S(l);
    { DIL_BEGIN(1)
    PH(1) if (l == 0) {
      KP_DECL; char* ws = kp_->ws; const int t = tid_opaque(); (void)t;
      ph_norm_mod(WS_PTR(float, WO.xs), I.norm_mix_g + l * DM, WS_PTR(float, WO.mod) + (long)l * (BATCH + 1) * 6144, 0, WS_PTR(bf16_t, WO.xn), false, I.x, I.ctx);
    }
    DIL_END(1) }
    GRID_BARRIER();
    { DIL_BEGIN(2)
    PH(2) {
      KP_DECL; char* ws = kp_->ws; const int t = tid_opaque(); (void)t;
      const bf16_t* xn = WS_PTR(bf16_t, WO.xn); const bf16_t* wT = WS_PTR(bf16_t, WO.w_inT) + (long)l * 2688 * 1024; bf16_t* Pb = WS_PTR(bf16_t, WO.Pb);
      XCD_TILE_LOOP(tile, TM * 21)
        gemm_tile_128_glds(xn, DM, wT, 1024, 1024, tile / 21, tile % 21, smem, EpiStoreBf16{Pb, IN_COLS, IN_COLS});
    }
    DIL_END(2) }
    GRID_BARRIER();
    { DIL_BEGIN(3)
    PH(3) {
      KP_DECL; char* ws = kp_->ws; const int t = tid_opaque(); (void)t;
      PrepW pw{WS_PTR(bf16_t, WO.wqbT) + (long)l * 384 * 256, WS_PTR(bf16_t, WO.wkvbT) + (long)l * 512 * 128, WS_PTR(bf16_t, WO.w2T) + (long)l * 2 * 384 * 64,
               WS_PTR(bf16_t, WO.a2T) + (long)l * 2 * 384 * 64, WS_PTR(bf16_t, WO.g2T) + (long)l * 384 * 192, I.rw_mu + (long)l * 2 * RWC, I.rw_w0 + l * 768, I.rw_a0 + l * 768};
      PrepBuf pb{WS_PTR(bf16_t, WO.Pb), WS_PTR(bf16_t, WO.tq), WS_PTR(bf16_t, WO.tkv), WS_PTR(bf16_t, WO.a_b), WS_PTR(bf16_t, WO.g_b), WS_PTR(float, WO.w_f)};
      XCD_TILE_LOOP(tile, TM * 22) prep_gemm_tile(pw, pb, tile / 22, tile % 22, smem);
    }
    DIL_END(3) }
    GRID_BARRIER();
    { DIL_BEGIN(4)
    PH(4) {
      KP_DECL; char* ws = kp_->ws; const int t = tid_opaque(); (void)t;
      FinW2 fw{I.mla_qk_g + l * 192, I.gqa_qk_g + l * 128, I.rw_mu + (long)l * 2 * RWC, I.rw_k_k + l * 384, I.rw_k_a + l * 384, WS_PTR(float, WO.rope_g), WS_PTR(float, WO.rope_m)};
      FinBuf fb{WS_PTR(bf16_t, WO.Pb), WS_PTR(bf16_t, WO.tq), WS_PTR(bf16_t, WO.tkv), WS_PTR(bf16_t, WO.a_b), WS_PTR(bf16_t, WO.mq), WS_PTR(bf16_t, WO.mk), WS_PTR(bf16_t, WO.mvT),
                WS_PTR(bf16_t, WO.gq), WS_PTR(bf16_t, WO.gk), WS_PTR(bf16_t, WO.gvT), WS_PTR(bf16_t, WO.r_b), WS_PTR(bf16_t, WO.v_b), WS_PTR(bf16_t, WO.kk_b), WS_PTR(bf16_t, WO.kd_b), WS_PTR(bf16_t, WO.bd_b)};
      for (int tile = blockIdx.x; tile < NROWS / 8; tile += gridDim.x) prep_finish_tile2(fw, fb, tile, smem);
      if (blockIdx.x == gridDim.x - 1 && t < 64) { attn_score_bound(I.mla_qk_g + l * 192, 96, 9.79795897f, (float*)(ws + 16384) + l * 4, t); attn_score_bound(I.gqa_qk_g + l * 128, 64, 8.f, (float*)(ws + 16384) + l * 4 + 1, t); }
    }
    DIL_END(4) }
    GRID_BARRIER();
    { unsigned long long dil_t0 = 0, dil_scan = 0; if (DIL_PH == 5 || DIL_PH == 11) dil_t0 = __builtin_amdgcn_s_memrealtime();
    PH(5) {
      {
        KP_DECL; char* ws = kp_->ws; const int tp = tid_opaque();
        const int njobs = BATCH * 12 * (RB / CS_L);
        for (int job = (int)blockIdx.x * 4 + (tp >> 6); job < njobs; job += (int)gridDim.x * 4)
          rw_chunk_inverse(WS_PTR(bf16_t, WO.kk_b), WS_PTR(bf16_t, WO.bd_b), WS_PTR(float, WO.w_f), WS_PTR(bf16_t, MINV_OFF), job, (long)MA * 384, smem + (tp >> 6) * CSP_WAVE_BYTES, tp & 63);
      }
      GRID_BARRIER();
      KP_DECL; char* ws = kp_->ws; const int t = tid_opaque(); (void)t;
      int* s_item = (int*)(smem + MEGA_LDS_BYTES - 16);
      unsigned* sctr = (unsigned*)ws + XB_QUEUE(4 + l);
      auto scan_loop = [&]() __attribute__((always_inline)) {
        for (;;) {
          __syncthreads();
          if (tid_opaque() == 0) *s_item = (int)xb_add(sctr, 1u);
          __syncthreads();
          const int it = *s_item;
          if (it >= BATCH * 12) break;
          rw_scan_chunked(WS_PTR(bf16_t, WO.r_b), WS_PTR(bf16_t, WO.v_b), WS_PTR(bf16_t, WO.kk_b), WS_PTR(bf16_t, WO.kd_b), WS_PTR(bf16_t, WO.bd_b), WS_PTR(float, WO.w_f), WS_PTR(float, WO.Pb),
                          it, (long)MA * 384, smem, WS_PTR(bf16_t, MINV_OFF));
        }
      };
      if (scan_role) scan_loop();
#if DIL_PH == 11
      dil_scan = __builtin_amdgcn_s_memrealtime() - dil_t0;
#endif
#ifdef SPLIT5
      GRID_BARRIER();
#endif
      const int nqt = l == 0 ? 18 : 16; const int n_mla = BATCH * 4 * nqt, n_all = BATCH * 10 * nqt;
      unsigned* qctr = (unsigned*)ws + XB_QUEUE(l);
      for (;;) {
        __syncthreads();
        if (tid_opaque() == 0) *s_item = (int)xb_add(qctr, 1u);
        __syncthreads();
        const int it = *s_item;
        if (it >= n_all) break;
        const KARG_AS MegaP* kp2_ = (const KARG_AS MegaP*)__builtin_amdgcn_kernarg_segment_ptr(); LAUNDER_S(kp2_); char* ws2 = kp2_->ws;
        if (it < n_mla) { int qt = it / (BATCH * 4), r = it % (BATCH * 4);
          attn_block<96>((const bf16_t*)(ws2 + WO.mq), 4, (const bf16_t*)(ws2 + WO.mk), 4, (const bf16_t*)(ws2 + WO.mvT), 1, (bf16_t*)(ws2 + WO.tq), 0, r / 4, r % 4, qt, smem, (const float*)(ws2 + 16384) + l * 4); }
        else { int v = it - n_mla; int qt = v / (BATCH * 6), r = v % (BATCH * 6);
          attn_block<64>((const bf16_t*)(ws2 + WO.gq), 6, (const bf16_t*)(ws2 + WO.gk), 2, (const bf16_t*)(ws2 + WO.gvT), 3, (bf16_t*)(ws2 + WO.tq), 640, r / 6, r % 6, qt, smem, (const float*)(ws2 + 16384) + l * 4 + 1); }
      }
      if (!scan_role) scan_loop();
      {
        unsigned* cctr = (unsigned*)ws + XB_QUEUE(2 + l);
        for (;;) {
          __syncthreads();
          if (tid_opaque() == 0) *s_item = (int)xb_add(cctr, 1u);
          __syncthreads();
          const int it = *s_item;
          if (it >= 512) break;
          const int tab = it >> 8, r0 = (it & 255) * 64;
          if (tab == 0) ph_cvt_fp8_rows(I.pe_u + (long)l * 16384 * DM, WS_PTR(unsigned char, TAB_U), WS_PTR(float, TAB_SU), r0, r0 + 64);
          else ph_cvt_fp8_rows(I.pe_v + (long)l * 16384 * DM, WS_PTR(unsigned char, TAB_V), WS_PTR(float, TAB_SV), r0, r0 + 64);
        }
      }
    }
#if DIL_PH == 11
    GRID_BARRIER(); if (blockIdx.x == 0 && threadIdx.x == 0) { unsigned long long t1 = __builtin_amdgcn_s_memrealtime(); unsigned long long dt = dil_scan * DIL_MULT; while (__builtin_amdgcn_s_memrealtime() - t1 < dt) __builtin_amdgcn_s_sleep(32); }
#endif
    (void)dil_scan;
    DIL_END(5) }
    GRID_BARRIER();
    { DIL_BEGIN(6)
    PH(6) {
      KP_DECL; char* ws = kp_->ws; const int t = tid_opaque(); (void)t;
      RdW rw{I.rw_r_k + l * 384, I.rw_ln_g + l * 384, I.rw_ln_b + l * 384};
for (long row = blockIdx.x * 4 + (t >> 6); row < NROWS; row += (long)gridDim.x * 4)
        if (l == 0 || (row % RB) < SEQ) rw_readout_row2(rw, WS_PTR(float, WO.Pb), WS_PTR(bf16_t, WO.r_b), WS_PTR(bf16_t, WO.v_b), WS_PTR(bf16_t, WO.kd_b), WS_PTR(bf16_t, WO.g_b), WS_PTR(bf16_t, WO.tq), row, t & 63);
    }
    DIL_END(6) }
    GRID_BARRIER();
    { DIL_BEGIN(7)
    PH(7) {
      KP_DECL; char* ws = kp_->ws; const int t = tid_opaque(); (void)t;
      const bf16_t* mix = WS_PTR(bf16_t, WO.tq); const bf16_t* wT = WS_PTR(bf16_t, WO.w_outT) + (long)l * 1024 * 1024; float* xs = WS_PTR(float, WO.xs);
      const float* modl = WS_PTR(float, WO.mod) + (long)l * (BATCH + 1) * 6144;
      const int TM7 = l == 0 ? TM : BATCH * 16;
      XCD_TILE_LOOP(tile, TM7 * 8)
        gemm_tile_128_glds(mix, DM, wT, 1024, 1024, l == 0 ? tile / 8 : LAT_TM(tile / 8), tile % 8, smem, EpiResid{xs, modl, 2, 0, l == 0 ? I.x : (const float*)nullptr, I.ctx});
    }
    DIL_END(7) }
    GRID_BARRIER();
    { DIL_BEGIN(8)
    PH(8) {
      KP_DECL; char* ws = kp_->ws; const int t = tid_opaque(); (void)t;
      ph_norm_mod(WS_PTR(float, WO.xs), I.norm_ffn_g + l * DM, WS_PTR(float, WO.mod) + (long)l * (BATCH + 1) * 6144, 3, WS_PTR(bf16_t, WO.xn), l != 0);
    }
    DIL_END(8) }
    GRID_BARRIER();
    { DIL_BEGIN(9)
    PH(9) {
      KP_DECL; char* ws = kp_->ws; const int t = tid_opaque(); (void)t;
      const bf16_t* xn = WS_PTR(bf16_t, WO.xn); const bf16_t* wT = WS_PTR(bf16_t, WO.wqT) + (long)l * 2048 * 1024; const bf16_t* kb = WS_PTR(bf16_t, WO.keysb) + (long)l * 16 * 128 * 128;
      unsigned* top1 = WS_PTR(unsigned, WO.tq);
      const int TM9 = l == 0 ? TM : BATCH * 16;
      XCD_TILE_LOOP(tile, TM9 * 16) { peer_q_top1_tile(xn, wT, kb, top1, l == 0 ? tile / 16 : LAT_TM(tile / 16), tile % 16, smem); __syncthreads(); }
    }
    DIL_END(9) }
    GRID_BARRIER();
    { DIL_BEGIN(10)
    PH(10) {
      KP_DECL; char* ws = kp_->ws; const int t = tid_opaque(); (void)t;
      const float* modl = WS_PTR(float, WO.mod) + (long)l * (BATCH + 1) * 6144;
      const int ntok10 = l == 0 ? NROWS : BATCH * SEQ;
      peer_lists_build3(WS_PTR(unsigned, WO.tq), WS_PTR(float, TAB_SU), WS_PTR(float, TAB_SV), WS_PTR(char, WO.mq), ntok10, smem);
#ifdef BUILD_TWICE
      peer_lists_build3(WS_PTR(unsigned, WO.tq), WS_PTR(float, TAB_SU), WS_PTR(float, TAB_SV), WS_PTR(char, WO.mq), ntok10, smem);
#endif
#ifdef PASS_SYNC
      { const int per_block10 = (ntok10 + (int)gridDim.x - 1) / (int)gridDim.x; const int npass10 = (per_block10 + 11) / 12;
        for (int ps = 0; ps < npass10; ++ps) {
          if (ps) GRID_BARRIER();
          peer_gather_sweep3(WS_PTR(bf16_t, WO.xn), WS_PTR(char, WO.mq), WS_PTR(unsigned char, TAB_U), WS_PTR(unsigned char, TAB_V), modl, WS_PTR(float, WO.xs), ntok10, smem,
                         I.norm_mix_g + (l == 0 ? DM : 0), WS_PTR(float, WO.mod) + (long)(l == 0 ? 1 : 0) * (BATCH + 1) * 6144, WS_PTR(bf16_t, WO.xn), l == 0 ? (float*)nullptr : kp_->out, ps, ps + 1);
        } }
#else
      peer_gather_sweep3(WS_PTR(bf16_t, WO.xn), WS_PTR(char, WO.mq), WS_PTR(unsigned char, TAB_U), WS_PTR(unsigned char, TAB_V), modl, WS_PTR(float, WO.xs), ntok10, smem,
                         I.norm_mix_g + (l == 0 ? DM : 0), WS_PTR(float, WO.mod) + (long)(l == 0 ? 1 : 0) * (BATCH + 1) * 6144, WS_PTR(bf16_t, WO.xn), l == 0 ? (float*)nullptr : kp_->out, 0, 1 << 20);
#endif
    }
    DIL_END(10) }
    GRID_BARRIER();
  }
}

extern "C" void kernel_launch(void* const* d_in, const int* in_sizes, int n_in, void* d_out, int out_size, void* d_ws, size_t ws_size,
                              hipStream_t stream) {
  MegaP p{};
  const float** pp = (const float**)&p.in;
  for (int i = 0; i < 31; ++i) pp[i] = (const float*)d_in[i];
  p.ws = (char*)d_ws; p.out = (float*)d_out;
  if (WO.total > ws_size) return;
  static int grid_blocks = 0;
  if (!grid_blocks) {
    int dev = 0, cus = 0, per_cu = 0;
    hipGetDevice(&dev);
    hipDeviceGetAttribute(&cus, hipDeviceAttributeMultiprocessorCount, dev);
    hipOccupancyMaxActiveBlocksPerMultiprocessor(&per_cu, mega_kernel, 256, 0);
    if (per_cu > 2) per_cu = 2;
    if (per_cu < 1) per_cu = 1;
    grid_blocks = cus * per_cu;
  }
  hipMemsetAsync(d_ws, 0, 32768, stream);
  void* args[] = {&p};
  hipLaunchCooperativeKernel((void*)mega_kernel, dim3(grid_blocks), dim3(256), args, 0, stream);
}
```

```cpp
#include <hip/hip_runtime.h>
#define PEER_EXP(x) __builtin_amdgcn_exp2f((x) * 1.4426950408889634f)
#ifndef BATCH
#define BATCH 8
#endif
#ifndef SEQ
#define SEQ 2048
#endif
#ifndef CTX_LEN
#define CTX_LEN 256
#endif
#define DM 1024
#define RB (SEQ + CTX_LEN)
#define NROWS (BATCH * RB)
#define IN_COLS 2624
#define MLA_OFF 0
#define RW_OFF 416
#define GQA_OFF 1984
#define RWC 1568
#define EPSN 1e-6f

__device__ inline float sigmoidf_(float x) { return 1.f / (1.f + expf(-x)); }
__device__ inline float siluf_(float x) { return x * sigmoidf_(x); }
__device__ inline float softplusf_(float x) { return fmaxf(x, 0.f) + log1pf(expf(-fabsf(x))); }
__device__ inline float geluf_(float x) { return 0.5f * x * (1.f + tanhf(0.7978845608028654f * (x + 0.044715f * x * x * x))); }

__global__ void nk_copy_in(const float* x, const float* ctx, float* xs) {
  long i = (long)blockIdx.x * blockDim.x + threadIdx.x;
  if (i >= (long)NROWS * DM) return;
  int d = i % DM; long row = i / DM; int b = row / RB, lr = row % RB;
  xs[i] = lr < SEQ ? x[((long)b * SEQ + lr) * DM + d] : ctx[((long)b * CTX_LEN + (lr - SEQ)) * DM + d];
}
__global__ void nk_copy_out(const float* xs, float* out) {
  long i = (long)blockIdx.x * blockDim.x + threadIdx.x;
  if (i >= (long)BATCH * SEQ * DM) return;
  int d = i % DM; long row = i / DM; int b = row / SEQ, t = row % SEQ;
  out[i] = xs[((long)b * RB + t) * DM + d];
}
__global__ void nk_mod(const float* c, const float* c_ctx, const float* ada_w, const float* ada_b, float* mod) {
  long i = (long)blockIdx.x * blockDim.x + threadIdx.x;
  if (i >= 2L * (BATCH + 1) * 6144) return;
  int j = i % 6144; int bb = (i / 6144) % (BATCH + 1); int l = i / (6144 * (BATCH + 1));
  const float* cv = bb < BATCH ? c + (long)bb * DM : c_ctx;
  const float* w = ada_w + (long)l * DM * 6144;
  float acc = 0.f;
  for (int k = 0; k < DM; ++k) acc += siluf_(cv[k]) * w[(long)k * 6144 + j];
  mod[i] = acc + ada_b[l * 6144 + j];
}
__global__ void nk_norm_mod(const float* xs, const float* g, const float* modl, int shift_idx, float* xn, int M, int bidx) {
  long row = (long)blockIdx.x * blockDim.x + threadIdx.x;
  if (row >= M) return;
  int lr = row % RB; int bb = lr < SEQ ? bidx : BATCH;
  const float* sh = modl + ((long)bb * 6 + shift_idx) * DM; const float* sc = sh + DM;
  const float* xr = xs + row * DM; float ss = 0.f;
  for (int d = 0; d < DM; ++d) ss += xr[d] * xr[d];
  float inv = 1.f / sqrtf(ss / DM + EPSN);
  for (int d = 0; d < DM; ++d) xn[row * DM + d] = xr[d] * inv * g[d] * (1.f + sc[d]) + sh[d];
}
__global__ void nk_gemm(const float* A, const float* W, float* C, int M, int N, int K) {
  long i = (long)blockIdx.x * blockDim.x + threadIdx.x;
  if (i >= (long)M * N) return;
  int n = i % N; long m = i / N; float acc = 0.f;
  for (int k = 0; k < K; ++k) acc += A[m * K + k] * W[(long)k * N + n];
  C[i] = acc;
}
__global__ void nk_mla_q1(const float* P, const float* qng, const float* wqb, float* tq, int M) {
  long i = (long)blockIdx.x * blockDim.x + threadIdx.x;
  if (i >= (long)M * 384) return;
  int j = i % 384; long r = i / 384; const float* cq = P + r * IN_COLS;
  float ss = 0.f; for (int k = 0; k < 256; ++k) ss += cq[k] * cq[k];
  float inv = 1.f / sqrtf(ss / 256 + EPSN), acc = 0.f;
  for (int k = 0; k < 256; ++k) acc += cq[k] * inv * qng[k] * wqb[k * 384 + j];
  tq[i] = acc;
}
__global__ void nk_mla_kv1(const float* P, const float* kvng, const float* wkvb, float* tkv, int M) {
  long i = (long)blockIdx.x * blockDim.x + threadIdx.x;
  if (i >= (long)M * 512) return;
  int j = i % 512; long r = i / 512; const float* ck = P + r * IN_COLS + 256;
  float ss = 0.f; for (int k = 0; k < 128; ++k) ss += ck[k] * ck[k];
  float inv = 1.f / sqrtf(ss / 128 + EPSN), acc = 0.f;
  for (int k = 0; k < 128; ++k) acc += ck[k] * inv * kvng[k] * wkvb[k * 512 + j];
  tkv[i] = acc;
}
__global__ void nk_mla_qk2(const float* P, const float* tq, const float* tkv, const float* qkg, float* mq, float* mk, int M) {
  long i = (long)blockIdx.x * blockDim.x + threadIdx.x;
  if (i >= (long)M * 8) return;
  int which = i % 2, h = (i / 2) % 4; long r = i / 8; int lr = r % RB;
  float ss = 0.f;
  for (int e = 0; e < 96; ++e) {
    float v = which == 0 ? tq[r * 384 + h * 96 + e] : (e < 64 ? tkv[r * 512 + h * 128 + e] : P[r * IN_COLS + 384 + (e - 64)]);
    ss += v * v;
  }
  float inv = 1.f / sqrtf(ss / 96 + EPSN);
  const float* g = qkg + which * 96; float* o = (which == 0 ? mq : mk) + r * 384 + h * 96;
  for (int e = 0; e < 64; ++e) {
    float v = which == 0 ? tq[r * 384 + h * 96 + e] : tkv[r * 512 + h * 128 + e];
    o[e] = v * inv * g[e];
  }
  for (int j = 0; j < 16; ++j) {
    float va = which == 0 ? tq[r * 384 + h * 96 + 64 + j] : P[r * IN_COLS + 384 + j];
    float vb = which == 0 ? tq[r * 384 + h * 96 + 80 + j] : P[r * IN_COLS + 384 + 16 + j];
    va *= inv * g[64 + j]; vb *= inv * g[80 + j];
    if (lr < SEQ) {
      int pos = j < 8 ? lr / 64 : lr % 64; float fr = powf(10000.f, -(float)(j & 7) / 8.f);
      float ang = (float)pos * fr, cs = cosf(ang), sn = sinf(ang);
      o[64 + j] = va * cs - vb * sn; o[80 + j] = va * sn + vb * cs;
    } else { o[64 + j] = va; o[80 + j] = vb; }
  }
}
__global__ void nk_gqa_prep(const float* P, const float* qkg, float* gq, float* gk, int M) {
  long i = (long)blockIdx.x * blockDim.x + threadIdx.x;
  if (i >= (long)M * 8) return;
  int h = i % 8; long r = i / 8; int lr = r % RB;
  const float* src = P + r * IN_COLS + GQA_OFF + h * 64;
  const float* g = qkg + (h < 6 ? 0 : 64);
  float* o = h < 6 ? gq + r * 384 + h * 64 : gk + r * 128 + (h - 6) * 64;
  float ss = 0.f; for (int e = 0; e < 64; ++e) ss += src[e] * src[e];
  float inv = 1.f / sqrtf(ss / 64 + EPSN);
  for (int j = 0; j < 32; ++j) {
    float va = src[j] * inv * g[j], vb = src[32 + j] * inv * g[32 + j];
    if (lr < SEQ) {
      int pos = j < 16 ? lr / 64 : lr % 64; float fr = powf(10000.f, -(float)(j & 15) / 16.f);
      float ang = (float)pos * fr, cs = cosf(ang), sn = sinf(ang);
      o[j] = va * cs - vb * sn; o[32 + j] = va * sn + vb * cs;
    } else { o[j] = va; o[32 + j] = vb; }
  }
}
template <int DQ>
__global__ void __launch_bounds__(256) nk_attn(const float* q, int qs, const float* k, int ks, const float* v, int vs, int vhs, int H, int G, float* mix, int ooff, int M) {
  long i = (long)blockIdx.x * blockDim.x + threadIdx.x;
  if (i >= (long)M * H) return;
  int h = i % H; long r = i / H; int b = r / RB, lr = r % RB; int kh = h / G;
  float qv[DQ];
#pragma unroll
  for (int e = 0; e < DQ; ++e) qv[e] = q[r * qs + h * DQ + e];
  float acc[64];
#pragma unroll
  for (int e = 0; e < 64; ++e) acc[e] = 0.f;
  float mx = -1e30f, l = 0.f; const float scale = 1.f / sqrtf((float)DQ);
  int k0 = lr < SEQ ? 0 : SEQ, k1 = RB;
  for (int kr = k0; kr < k1; ++kr) {
    long rr = (long)b * RB + kr; const float* kp = k + rr * ks + kh * DQ; float s = 0.f;
#pragma unroll
    for (int e = 0; e < DQ; ++e) s += qv[e] * kp[e];
    s *= scale;
    float mn = fmaxf(mx, s), al = expf(mx - mn), pp = expf(s - mn);
    l = l * al + pp; mx = mn; const float* vp = v + rr * vs + kh * vhs;
#pragma unroll
    for (int e = 0; e < 64; ++e) acc[e] = acc[e] * al + pp * vp[e];
  }
#pragma unroll
  for (int e = 0; e < 64; ++e) mix[r * DM + ooff + h * 64 + e] = acc[e] / l;
}
__global__ void nk_rw_shift(const float* P, const float* mu, float* rwx, int M) {
  long i = (long)blockIdx.x * blockDim.x + threadIdx.x;
  if (i >= (long)M * RWC) return;
  int c = i % RWC; long r = i / RWC; int lr = r % RB;
  bool first = (lr == 0) || (lr == SEQ), last = (lr == SEQ - 1) || (lr == RB - 1);
  float p = P[r * IN_COLS + RW_OFF + c];
  float pv = first ? 0.f : P[(r - 1) * IN_COLS + RW_OFF + c], nx = last ? 0.f : P[(r + 1) * IN_COLS + RW_OFF + c];
  rwx[i] = p + mu[c] * (pv - p) + mu[RWC + c] * (nx - p);
}
__global__ void nk_rw_prep(const float* rwx, const float* w0, const float* w2, const float* a0, const float* a2, const float* g2,
                           const float* k_k, const float* k_a, float* dec, float* kd, float* bd, float* kk, float* gg, int M) {
  long i = (long)blockIdx.x * blockDim.x + threadIdx.x;
  if (i >= (long)M * 384) return;
  int c = i % 384; long r = i / 384; int h = c / 64; const float* xr = rwx + r * RWC;
  float kv = xr[384 + c];
  float ss = 0.f; for (int n = 0; n < 64; ++n) { float t = xr[384 + h * 64 + n] * k_k[h * 64 + n]; ss += t * t; }
  float kkv = kv * k_k[c] / sqrtf(ss + 1e-12f);
  kk[i] = kkv;
  for (int d = 0; d < 2; ++d) {
    float wr = w0[d * 384 + c], ar = a0[d * 384 + c];
    for (int j = 0; j < 64; ++j) { wr += tanhf(xr[1152 + d * 64 + j]) * w2[(d * 64 + j) * 384 + c]; ar += xr[1280 + d * 64 + j] * a2[(d * 64 + j) * 384 + c]; }
    float dc = expf(-expf(-softplusf_(-wr) - 0.5f)); float a = sigmoidf_(ar);
    dec[(long)d * M * 384 + i] = dc; kd[(long)d * M * 384 + i] = kv * (1.f + (a - 1.f) * k_a[c]); bd[(long)d * M * 384 + i] = kkv * a;
  }
  float g = 0.f; for (int j = 0; j < 160; ++j) g += sigmoidf_(xr[1408 + j]) * g2[j * 384 + c];
  gg[i] = g;
}
__global__ void __launch_bounds__(256) nk_rw_scan(const float* rwx, const float* dec, const float* kd, const float* bd, const float* kk, float* y, int M, int nb) {
  long t = (long)blockIdx.x * blockDim.x + threadIdx.x;
  if (t >= (long)nb * 2 * 6 * 64) return;
  int i = t % 64, h = (t / 64) % 6, d = (t / 384) % 2, b = t / 768;
  float S[64];
#pragma unroll
  for (int j = 0; j < 64; ++j) S[j] = 0.f;
  for (int step = 0; step < RB; ++step) {
    int lr;
    if (step < CTX_LEN) lr = SEQ + (d == 0 ? step : CTX_LEN - 1 - step);
    else lr = d == 0 ? step - CTX_LEN : SEQ - 1 - (step - CTX_LEN);
    long r = (long)b * RB + lr; long o = (long)d * M * 384 + r * 384 + h * 64;
    const float* rp = rwx + r * RWC + h * 64; const float* wp = dec + o; const float* kp = kd + o; const float* bp = bd + o; const float* kkp = kk + r * 384 + h * 64;
    float vi = rwx[r * RWC + 768 + h * 64 + i];
    float skk = 0.f;
#pragma unroll
    for (int j = 0; j < 64; ++j) skk += S[j] * kkp[j];
    float yy = 0.f;
#pragma unroll
    for (int j = 0; j < 64; ++j) { S[j] = S[j] * wp[j] - skk * bp[j] + vi * kp[j]; yy += S[j] * rp[j]; }
    y[o + i] = yy;
  }
}
__global__ void nk_rw_readout(const float* rwx, const float* y, const float* kd, const float* gg, const float* r_k, const float* ln_g, const float* ln_b, float* mix, int M, long yds) {
  long i = (long)blockIdx.x * blockDim.x + threadIdx.x;
  if (i >= (long)M * 6) return;
  int h = i % 6; long r = i / 6; long o = r * 384 + h * 64; long ds = (long)M * 384;
  float mean = 0.f; for (int n = 0; n < 64; ++n) mean += y[o + n] + y[yds + o + n];
  mean /= 64.f;
  float var = 0.f, coef = 0.f;
  for (int n = 0; n < 64; ++n) {
    float yy = y[o + n] + y[yds + o + n] - mean; var += yy * yy;
    coef += rwx[r * RWC + h * 64 + n] * (kd[o + n] + kd[ds + o + n]) * r_k[h * 64 + n];
  }
  var /= 64.f; float inv = 1.f / sqrtf(var + 64e-5f);
  for (int n = 0; n < 64; ++n) {
    float yn = (y[o + n] + y[yds + o + n] - mean) * inv * ln_g[h * 64 + n] + ln_b[h * 64 + n];
    mix[r * DM + 256 + h * 64 + n] = (yn + coef * rwx[r * RWC + 768 + h * 64 + n]) * gg[o + n];
  }
}
__global__ void nk_gemm_res(const float* A, const float* W, const float* modl, int gi, float* xs, int M, int bidx) {
  long i = (long)blockIdx.x * blockDim.x + threadIdx.x;
  if (i >= (long)M * DM) return;
  int j = i % DM; long r = i / DM; int lr = r % RB; int bb = lr < SEQ ? bidx : BATCH;
  float acc = 0.f; for (int k = 0; k < DM; ++k) acc += A[r * DM + k] * W[(long)k * DM + j];
  xs[i] += modl[((long)bb * 6 + gi) * DM + j] * acc;
}
__global__ void nk_peer_score(const float* pq, const float* keys, float* sc, int M) {
  long i = (long)blockIdx.x * blockDim.x + threadIdx.x;
  if (i >= (long)M * 2048) return;
  int k = i % 128, ps = (i / 128) % 16; long r = i / 2048;
  const float* q = pq + r * 2048 + ps * 128; const float* ky = keys + ((long)ps * 128 + k) * 128;
  float acc = 0.f; for (int d = 0; d < 128; ++d) acc += q[d] * ky[d];
  sc[i] = acc;
}
__global__ void nk_peer_top1(const float* sc, float* ts, int* ti, int M) {
  long i = (long)blockIdx.x * blockDim.x + threadIdx.x;
  if (i >= (long)M * 16) return;
  const float* s = sc + i * 128; float pv = 3e38f; int pi = -1;
  for (int t = 0; t < 16; ++t) {
    float bv = -3e38f; int bi = -1;
    for (int k = 0; k < 128; ++k) {
      float v = s[k]; bool ok = (v < pv) || (v == pv && k > pi);
      if (ok && (bi < 0 || v > bv)) { bv = v; bi = k; }
    }
    ts[i * 16 + t] = bv; ti[i * 16 + t] = bi; pv = bv; pi = bi;
  }
}
__global__ void nk_peer_top2(const float* ts, const int* ti, int* pe, float* pg, int M) {
  long i = (long)blockIdx.x * blockDim.x + threadIdx.x;
  if (i >= (long)M * 8) return;
  const float* s1 = ts + i * 32; const float* s2 = s1 + 16; const int* i1 = ti + i * 32; const int* i2 = i1 + 16;
  float pv = 3e38f; int pi = -1; float mx = 0.f, sum = 0.f;
  for (int t = 0; t < 16; ++t) {
    float bv = -3e38f; int bi = -1;
    for (int c = 0; c < 256; ++c) {
      float v = s1[c / 16] + s2[c % 16]; bool ok = (v < pv) || (v == pv && c > pi);
      if (ok && (bi < 0 || v > bv)) { bv = v; bi = c; }
    }
    if (t == 0) mx = bv;
    float e = expf(bv - mx); sum += e;
    pe[i * 16 + t] = i1[bi / 16] * 128 + i2[bi % 16]; pg[i * 16 + t] = e; pv = bv; pi = bi;
  }
  for (int t = 0; t < 16; ++t) pg[i * 16 + t] /= sum;
}
__global__ void nk_peer_act(const float* xn, const float* u, const int* pe, const float* pg, float* pw, int M) {
  long i = (long)blockIdx.x * blockDim.x + threadIdx.x;
  if (i >= (long)M * 128) return;
  long r = i / 128; const float* ur = u + (long)pe[i] * DM; const float* xr = xn + r * DM;
  float acc = 0.f; for (int d = 0; d < DM; ++d) acc += xr[d] * ur[d];
  pw[i] = pg[i] * geluf_(acc);
}
__global__ void nk_peer_out(const float* v, const int* pe, const float* pw, const float* modl, float* xs, int M, int bidx) {
  long i = (long)blockIdx.x * blockDim.x + threadIdx.x;
  if (i >= (long)M * DM) return;
  int j = i % DM; long r = i / DM; int lr = r % RB; int bb = lr < SEQ ? bidx : BATCH;
  float acc = 0.f; for (int k = 0; k < 128; ++k) acc += pw[r * 128 + k] * v[(long)pe[r * 128 + k] * DM + j];
  xs[i] += modl[((long)bb * 6 + 5) * DM + j] * acc;
}


#ifndef PEER_EXP
#define PEER_EXP(x) expf(x)
#endif
__device__ __forceinline__ unsigned f2sortable(float s) { unsigned f = __float_as_uint(s); return (f & 0x80000000u) ? ~f : (f | 0x80000000u); }
__device__ __forceinline__ float sortable2f(unsigned o) { unsigned f = (o & 0x80000000u) ? (o & 0x7fffffffu) : ~o; return __uint_as_float(f); }
__device__ __forceinline__ unsigned enc_key(float s, int idx) { return (f2sortable(s) & ~127u) | (unsigned)(127 - idx); }
__device__ __forceinline__ void dec_key(unsigned k, float& s, int& idx) { idx = 127 - (int)(k & 127u); s = sortable2f(k & ~127u); }
__device__ __forceinline__ unsigned umax_(unsigned a, unsigned b) { return a > b ? a : b; }
__device__ __forceinline__ unsigned umin_(unsigned a, unsigned b) { return a < b ? a : b; }
__device__ __forceinline__ void ins16(unsigned (&l)[16], unsigned x) {
#pragma unroll
  for (int i = 0; i < 16; ++i) { unsigned mx = umax_(l[i], x); x = umin_(l[i], x); l[i] = mx; }
}
__device__ __forceinline__ void merge16(unsigned (&a)[16], const unsigned (&brev)[16]) {
#pragma unroll
  for (int i = 0; i < 16; ++i) a[i] = umax_(a[i], brev[i]);
#pragma unroll
  for (int d = 8; d >= 1; d >>= 1)
#pragma unroll
    for (int i = 0; i < 16; ++i) if ((i & d) == 0) { unsigned hi = umax_(a[i], a[i + d]), lo = umin_(a[i], a[i + d]); a[i] = hi; a[i + d] = lo; }
}
__device__ __forceinline__ void sort16_desc(unsigned (&a)[16]) {
#pragma unroll
  for (int k = 2; k <= 16; k <<= 1)
#pragma unroll
    for (int j = k >> 1; j > 0; j >>= 1)
#pragma unroll
      for (int i = 0; i < 16; ++i) {
        const int l = i ^ j;
        if (l > i) {
          const unsigned hi = umax_(a[i], a[l]), lo = umin_(a[i], a[l]);
          if ((i & k) == 0) { a[i] = hi; a[l] = lo; } else { a[i] = lo; a[l] = hi; }
        }
      }
}
__device__ __forceinline__ void peer_combine(const unsigned* L0, const unsigned* L1, int* e_out, float* g_out) {
  float s0[16], s1[16];
#pragma unroll
  for (int i = 0; i < 16; ++i) { int ix; dec_key(L0[i], s0[i], ix); dec_key(L1[i], s1[i], ix); }
  unsigned sel[16];
#pragma unroll
  for (int i = 0; i < 16; ++i) sel[i] = 0u;
#pragma unroll
  for (int i = 0; i < 16; ++i)
#pragma unroll
    for (int j = 0; j < 16; ++j)
      if ((i + 1) * (j + 1) <= 16) { unsigned k = (f2sortable(s0[i] + s1[j]) & ~255u) | (unsigned)(255 - (i * 16 + j)); ins16(sel, k); }
  float mx = -3e38f;
#pragma unroll
  for (int t = 0; t < 16; ++t) {
    int c = 255 - (int)(sel[t] & 255u); int i = c >> 4, j = c & 15;
    float a, b; int ia, ib; dec_key(L0[i], a, ia); dec_key(L1[j], b, ib);
    float s = a + b; e_out[t] = ia * 128 + ib; g_out[t] = s; mx = fmaxf(mx, s);
  }
  float sum = 0.f;
#pragma unroll
  for (int t = 0; t < 16; ++t) { float e = PEER_EXP(g_out[t] - mx); g_out[t] = e; sum += e; }
  float inv = 1.f / sum;
#pragma unroll
  for (int t = 0; t < 16; ++t) g_out[t] *= inv;
}
__global__ void hk_peer_top1(const float* pq, const float* keys, unsigned* top1, int M) {
  long i = (long)blockIdx.x * blockDim.x + threadIdx.x;
  if (i >= (long)M * 16) return;
  int ps = i % 16; long r = i / 16; const float* q = pq + r * 2048 + ps * 128;
  unsigned la[16], lb[16], lbr[16];
#pragma unroll
  for (int t = 0; t < 16; ++t) { la[t] = 0u; lb[t] = 0u; }
  for (int k = 0; k < 128; ++k) {
    const float* ky = keys + ((long)ps * 128 + k) * 128; float acc = 0.f;
    for (int d = 0; d < 128; ++d) acc += q[d] * ky[d];
    unsigned key = enc_key(acc, k);
    if (k < 64) ins16(la, key); else ins16(lb, key);
  }
#pragma unroll
  for (int t = 0; t < 16; ++t) lbr[t] = lb[15 - t];
  merge16(la, lbr);
#pragma unroll
  for (int t = 0; t < 16; ++t) top1[i * 16 + t] = la[t];
}
__global__ void hk_peer_combine(const unsigned* top1, int* pe, float* pg, int M) {
  long i = (long)blockIdx.x * blockDim.x + threadIdx.x;
  if (i >= (long)M * 8) return;
  peer_combine(top1 + i * 32, top1 + i * 32 + 16, pe + i * 16, pg + i * 16);
}
typedef unsigned short bf16_t;
__device__ __forceinline__ int tid_opaque() { int t = threadIdx.x; asm volatile("" : "+v"(t)); return t; }
typedef __attribute__((ext_vector_type(8))) short bf16x8;
typedef __attribute__((ext_vector_type(4))) float f32x4;
typedef __attribute__((ext_vector_type(16))) float f32x16;
typedef __attribute__((ext_vector_type(4))) unsigned u32x4;

typedef __attribute__((ext_vector_type(2))) __bf16 bf16v2;
typedef __attribute__((ext_vector_type(2))) float f32v2;
template <int CTRL> __device__ __forceinline__ float dpp_get(float x) { return __builtin_bit_cast(float, __builtin_amdgcn_update_dpp(0, __builtin_bit_cast(int, x), CTRL, 0xf, 0xf, true)); }
__device__ __forceinline__ float swz_xor4(float x) { return __builtin_bit_cast(float, __builtin_amdgcn_ds_swizzle(__builtin_bit_cast(int, x), 0x101F)); }
__device__ __forceinline__ float xor4_get(float x) { const int xi = __builtin_bit_cast(int, x);
  int r = __builtin_amdgcn_update_dpp(xi, xi, 0x114, 0xf, 0xA, false); r = __builtin_amdgcn_update_dpp(r, xi, 0x104, 0xf, 0x5, false); return __builtin_bit_cast(float, r); }
__device__ __forceinline__ float xor16_sum(float x) { const unsigned xi = __builtin_bit_cast(unsigned, x); auto q = __builtin_amdgcn_permlane16_swap(xi, xi, false, false);
  return __builtin_bit_cast(float, (unsigned)q[0]) + __builtin_bit_cast(float, (unsigned)q[1]); }
__device__ __forceinline__ float xor32_sum(float x) { const unsigned xi = __builtin_bit_cast(unsigned, x); auto q = __builtin_amdgcn_permlane32_swap(xi, xi, false, false);
  return __builtin_bit_cast(float, (unsigned)q[0]) + __builtin_bit_cast(float, (unsigned)q[1]); }
__device__ __forceinline__ float xor32_max(float x) { const unsigned xi = __builtin_bit_cast(unsigned, x); auto q = __builtin_amdgcn_permlane32_swap(xi, xi, false, false);
  return fmaxf(__builtin_bit_cast(float, (unsigned)q[0]), __builtin_bit_cast(float, (unsigned)q[1])); }
__device__ __forceinline__ unsigned pack2bf(float a, float b) { f32v2 v = {a, b}; bf16v2 r = __builtin_convertvector(v, bf16v2); return __builtin_bit_cast(unsigned, r); }
__device__ __forceinline__ bf16_t f2bf(float f) { return (bf16_t)(pack2bf(f, 0.f) & 0xffffu); }
__device__ __forceinline__ float bf2f(bf16_t h) { return __uint_as_float(((unsigned)h) << 16); }

__device__ __forceinline__ float fexp_(float x) { return __builtin_amdgcn_exp2f(x * 1.4426950408889634f); }
__device__ __forceinline__ float frcp_(float x) { return __builtin_amdgcn_rcpf(x); }
__device__ __forceinline__ float fsigmoid_(float x) { return frcp_(1.f + fexp_(-x)); }
__device__ __forceinline__ float ftanh_(float x) { return 1.f - 2.f * frcp_(fexp_(2.f * x) + 1.f); }
__device__ __forceinline__ float fgelu_(float x) { return x * fsigmoid_(1.5957691216057308f * (x + 0.044715f * x * x * x)); }
__device__ __forceinline__ float fdecay_(float w) { return fexp_(-0.6065306597126334f * fsigmoid_(w)); }
#define GEMM_LDS_BYTES 32768
struct ALoadPlain { const bf16_t* A; int lda;
  __device__ __forceinline__ u32x4 operator()(int row, int k) const { return *(const u32x4*)(A + (long)row * lda + k); } };
#define GEMM_STAGE_WRITE(RA, RB) do { _Pragma("unroll") for (int i = 0; i < 4; ++i) { int r = lrow + 32 * i; int off = r * 128 + ((lchunk ^ (r & 7)) << 4); *(u32x4*)(As + off) = RA[i]; *(u32x4*)(Bs + off) = RB[i]; } } while (0)
#define GEMM_COMPUTE_TILE() do { _Pragma("unroll") for (int ks = 0; ks < 2; ++ks) { bf16x8 af[4], bfr[4]; \
    _Pragma("unroll") for (int i = 0; i < 4; ++i) { int r = wm * 64 + i * 16 + fr; af[i] = *(const bf16x8*)(As + r * 128 + (((ks * 4 + fq) ^ (r & 7)) << 4)); \
      int rn = wn * 64 + i * 16 + fr; bfr[i] = *(const bf16x8*)(Bs + rn * 128 + (((ks * 4 + fq) ^ (rn & 7)) << 4)); } \
    _Pragma("unroll") for (int i = 0; i < 4; ++i) _Pragma("unroll") for (int j = 0; j < 4; ++j) acc[i][j] = __builtin_amdgcn_mfma_f32_16x16x32_bf16(bfr[j], af[i], acc[i][j], 0, 0, 0); } } while (0)
template <class Epi> struct EpiStage {
  __device__ __forceinline__ void load(const Epi&, int, int, int, int) {}
  __device__ __forceinline__ void apply(const Epi& e, int, int, int m, int n0, f32x4 v) { e(m, n0, v); }
};
template <class ALoad, class Epi>
__device__ __forceinline__ void gemm_tile_128(ALoad aload, const bf16_t* __restrict__ Bt, int ldb, int K,
                                              int tile_m, int tile_n, char* smem, Epi epi) {
  const int t = tid_opaque(), lane = t & 63, wave = t >> 6;
  const int wm = wave >> 1, wn = wave & 1;
  char* As = smem; char* Bs = smem + 16384;
  const int lrow = t >> 3, lchunk = t & 7;
  const int arow = tile_m * 128 + lrow;
  const bf16_t* bg = Bt + (long)(tile_n * 128 + lrow) * ldb + lchunk * 8;
  u32x4 ra0[4], rb0[4], ra1[4], rb1[4];
#pragma unroll
  for (int i = 0; i < 4; ++i) { ra0[i] = aload(arow + 32 * i, lchunk * 8); rb0[i] = *(const u32x4*)(bg + (long)(32 * i) * ldb); }
  if (K > 64) {
#pragma unroll
    for (int i = 0; i < 4; ++i) { ra1[i] = aload(arow + 32 * i, 64 + lchunk * 8); rb1[i] = *(const u32x4*)(bg + (long)(32 * i) * ldb + 64); }
  }
  f32x4 acc[4][4];
#pragma unroll
  for (int i = 0; i < 4; ++i)
#pragma unroll
    for (int j = 0; j < 4; ++j) acc[i][j] = (f32x4){0.f, 0.f, 0.f, 0.f};
  const int fr = lane & 15, fq = lane >> 4;
  for (int k0 = 0; k0 < K; k0 += 128) {
    __syncthreads();
    GEMM_STAGE_WRITE(ra0, rb0);
    __syncthreads();
    if (k0 + 128 < K) {
#pragma unroll
      for (int i = 0; i < 4; ++i) { ra0[i] = aload(arow + 32 * i, k0 + 128 + lchunk * 8); rb0[i] = *(const u32x4*)(bg + (long)(32 * i) * ldb + k0 + 128); }
    }
    GEMM_COMPUTE_TILE();
    if (k0 + 64 < K) {
      __syncthreads();
      GEMM_STAGE_WRITE(ra1, rb1);
      __syncthreads();
      if (k0 + 192 < K) {
#pragma unroll
        for (int i = 0; i < 4; ++i) { ra1[i] = aload(arow + 32 * i, k0 + 192 + lchunk * 8); rb1[i] = *(const u32x4*)(bg + (long)(32 * i) * ldb + k0 + 192); }
      }
      GEMM_COMPUTE_TILE();
    }
  }
  EpiStage<Epi> est;
#pragma unroll
  for (int i = 0; i < 4; ++i)
#pragma unroll
    for (int j = 0; j < 4; ++j) {
      int m = tile_m * 128 + wm * 64 + i * 16 + fr; int n0 = tile_n * 128 + wn * 64 + j * 16 + fq * 4;
      est.load(epi, i, j, m, n0);
    }
#pragma unroll
  for (int i = 0; i < 4; ++i)
#pragma unroll
    for (int j = 0; j < 4; ++j) {
      int m = tile_m * 128 + wm * 64 + i * 16 + fr; int n0 = tile_n * 128 + wn * 64 + j * 16 + fq * 4;
      est.apply(epi, i, j, m, n0, acc[i][j]);
    }
}

typedef __attribute__((address_space(3))) void lds_void_t;
typedef __attribute__((address_space(1))) const void glb_cvoid_t;
#define GEMM_GLDS_BYTES 65536
__device__ __forceinline__ void gemm_mainloop_glds(const bf16_t* __restrict__ A, int lda, const bf16_t* __restrict__ Bt, int ldb, int K,
                                                   int tile_m, int tile_n, char* smem, f32x4 (&acc)[4][4]) {
  const int t = tid_opaque(), lane = t & 63, wave = t >> 6;
  const int wm = wave >> 1, wn = wave & 1, fr = lane & 15, fq = lane >> 4;
  const int lrow = t >> 3, cl = (t & 7) ^ (lrow & 7);
  const bf16_t* ag = A + (long)(tile_m * 128 + lrow) * lda + cl * 8;
  const bf16_t* bg = Bt + (long)(tile_n * 128 + lrow) * ldb + cl * 8;
  const int wbase = __builtin_amdgcn_readfirstlane(wave) * 1024;
#pragma unroll
  for (int i = 0; i < 4; ++i)
#pragma unroll
    for (int j = 0; j < 4; ++j) acc[i][j] = (f32x4){0.f, 0.f, 0.f, 0.f};
  __syncthreads();
#pragma unroll
  for (int i = 0; i < 4; ++i) {
    __builtin_amdgcn_global_load_lds((glb_cvoid_t*)(ag + (long)(32 * i) * lda), (lds_void_t*)(smem + i * 4096 + wbase), 16, 0, 0);
    __builtin_amdgcn_global_load_lds((glb_cvoid_t*)(bg + (long)(32 * i) * ldb), (lds_void_t*)(smem + 16384 + i * 4096 + wbase), 16, 0, 0);
  }
  int buf = 0;
  for (int k0 = 0; k0 < K; k0 += 64, buf ^= 1) {
    __syncthreads();
    if (k0 + 64 < K) {
      char* nb = smem + (buf ^ 1) * 32768;
#pragma unroll
      for (int i = 0; i < 4; ++i) {
        __builtin_amdgcn_global_load_lds((glb_cvoid_t*)(ag + (long)(32 * i) * lda + k0 + 64), (lds_void_t*)(nb + i * 4096 + wbase), 16, 0, 0);
        __builtin_amdgcn_global_load_lds((glb_cvoid_t*)(bg + (long)(32 * i) * ldb + k0 + 64), (lds_void_t*)(nb + 16384 + i * 4096 + wbase), 16, 0, 0);
      }
    }
    const char* As = smem + buf * 32768; const char* Bs = As + 16384;
    GEMM_COMPUTE_TILE();
  }
}
#define GL4_ISSUE(st_, k0_) do { char* nb_ = smem + ((st_) & 3) * 16384; _Pragma("unroll") for (int j_ = 0; j_ < 2; ++j_) { \
    __builtin_amdgcn_global_load_lds((glb_cvoid_t*)(ag + (long)(64 * j_) * lda + (k0_)), (lds_void_t*)(nb_ + j_ * 4096 + wbase), 16, 0, 0); \
    __builtin_amdgcn_global_load_lds((glb_cvoid_t*)(bg + (long)(64 * j_) * ldb + (k0_)), (lds_void_t*)(nb_ + 8192 + j_ * 4096 + wbase), 16, 0, 0); } } while (0)
__device__ __forceinline__ void gemm_mainloop_glds4(const bf16_t* __restrict__ A, int lda, const bf16_t* __restrict__ Bt, int ldb, int K,
                                                    int tile_m, int tile_n, char* smem, f32x4 (&acc)[4][4]) {
  const int t = tid_opaque(), lane = t & 63, wave = t >> 6;
  const int wm = wave >> 1, wn = wave & 1, fr = lane & 15, fq = lane >> 4;
  const int lrow = t >> 2, cs = (t & 3) ^ ((t >> 4) & 3);
  const bf16_t* ag = A + (long)(tile_m * 128 + lrow) * lda + cs * 8;
  const bf16_t* bg = Bt + (long)(tile_n * 128 + lrow) * ldb + cs * 8;
  const int wbase = __builtin_amdgcn_readfirstlane(wave) * 1024;
#pragma unroll
  for (int i = 0; i < 4; ++i)
#pragma unroll
    for (int j = 0; j < 4; ++j) acc[i][j] = (f32x4){0.f, 0.f, 0.f, 0.f};
  const int nsteps = K >> 5;
  __syncthreads();
  GL4_ISSUE(0, 0);
  if (nsteps > 1) GL4_ISSUE(1, 32);
  if (nsteps > 2) GL4_ISSUE(2, 64);
  for (int s = 0; s < nsteps; ++s) {
    if (s + 2 < nsteps) asm volatile("s_waitcnt vmcnt(8)\n\ts_barrier" ::: "memory");
    else if (s + 1 < nsteps) asm volatile("s_waitcnt vmcnt(4)\n\ts_barrier" ::: "memory");
    else asm volatile("s_waitcnt vmcnt(0)\n\ts_barrier" ::: "memory");
    if (s + 3 < nsteps) GL4_ISSUE(s + 3, (s + 3) * 32);
    const char* As = smem + (s & 3) * 16384; const char* Bs = As + 8192;
    bf16x8 af[4], bfr[4];
#pragma unroll
    for (int i = 0; i < 4; ++i) {
      const int r = wm * 64 + i * 16 + fr; af[i] = *(const bf16x8*)(As + r * 64 + ((fq ^ ((r >> 2) & 3)) << 4));
      const int rn = wn * 64 + i * 16 + fr; bfr[i] = *(const bf16x8*)(Bs + rn * 64 + ((fq ^ ((rn >> 2) & 3)) << 4));
    }
#pragma unroll
    for (int i = 0; i < 4; ++i)
#pragma unroll
      for (int j = 0; j < 4; ++j) acc[i][j] = __builtin_amdgcn_mfma_f32_16x16x32_bf16(bfr[j], af[i], acc[i][j], 0, 0, 0);
  }
}
#ifdef GEMM_GLDS4
#define gemm_mainloop_glds gemm_mainloop_glds4
#endif
__device__ __forceinline__ void gemm_mainloop_glds_x(const bf16_t* __restrict__ A, int lda, const bf16_t* __restrict__ Bt, int ldb, int K,
                                                     int tile_m, int tile_n, char* smem, f32x4 (&acc)[4][4], bool pre, int next_tm, int next_tn) {
  const int t = tid_opaque(), lane = t & 63, wave = t >> 6;
  const int wm = wave >> 1, wn = wave & 1, fr = lane & 15, fq = lane >> 4;
  const int lrow = t >> 3, cl = (t & 7) ^ (lrow & 7);
  const bf16_t* ag = A + (long)(tile_m * 128 + lrow) * lda + cl * 8;
  const bf16_t* bg = Bt + (long)(tile_n * 128 + lrow) * ldb + cl * 8;
  const int wbase = __builtin_amdgcn_readfirstlane(wave) * 1024;
#pragma unroll
  for (int i = 0; i < 4; ++i)
#pragma unroll
    for (int j = 0; j < 4; ++j) acc[i][j] = (f32x4){0.f, 0.f, 0.f, 0.f};
  if (!pre) {
    __syncthreads();
#pragma unroll
    for (int i = 0; i < 4; ++i) {
      __builtin_amdgcn_global_load_lds((glb_cvoid_t*)(ag + (long)(32 * i) * lda), (lds_void_t*)(smem + i * 4096 + wbase), 16, 0, 0);
      __builtin_amdgcn_global_load_lds((glb_cvoid_t*)(bg + (long)(32 * i) * ldb), (lds_void_t*)(smem + 16384 + i * 4096 + wbase), 16, 0, 0);
    }
  }
  int buf = 0;
  for (int k0 = 0; k0 < K; k0 += 64, buf ^= 1) {
    __syncthreads();
    char* nb = smem + (buf ^ 1) * 32768;
    if (k0 + 64 < K) {
#pragma unroll
      for (int i = 0; i < 4; ++i) {
        __builtin_amdgcn_global_load_lds((glb_cvoid_t*)(ag + (long)(32 * i) * lda + k0 + 64), (lds_void_t*)(nb + i * 4096 + wbase), 16, 0, 0);
        __builtin_amdgcn_global_load_lds((glb_cvoid_t*)(bg + (long)(32 * i) * ldb + k0 + 64), (lds_void_t*)(nb + 16384 + i * 4096 + wbase), 16, 0, 0);
      }
    } else if (next_tm >= 0) {
      const bf16_t* ag2 = A + (long)(next_tm * 128 + lrow) * lda + cl * 8; const bf16_t* bg2 = Bt + (long)(next_tn * 128 + lrow) * ldb + cl * 8;
#pragma unroll
      for (int i = 0; i < 4; ++i) {
        __builtin_amdgcn_global_load_lds((glb_cvoid_t*)(ag2 + (long)(32 * i) * lda), (lds_void_t*)(nb + i * 4096 + wbase), 16, 0, 0);
        __builtin_amdgcn_global_load_lds((glb_cvoid_t*)(bg2 + (long)(32 * i) * ldb), (lds_void_t*)(nb + 16384 + i * 4096 + wbase), 16, 0, 0);
      }
    }
    const char* As = smem + buf * 32768; const char* Bs = As + 16384;
    GEMM_COMPUTE_TILE();
  }
}
template <class Epi>
__device__ __forceinline__ void gemm_tile_128_glds_x(const bf16_t* __restrict__ A, int lda, const bf16_t* __restrict__ Bt, int ldb, int K,
                                                     int tile_m, int tile_n, char* smem, Epi epi, bool pre, int next_tm, int next_tn) {
  f32x4 acc[4][4];
  gemm_mainloop_glds_x(A, lda, Bt, ldb, K, tile_m, tile_n, smem, acc, pre, next_tm, next_tn);
  const int t = tid_opaque(), lane = t & 63, wave = t >> 6, wm = wave >> 1, wn = wave & 1, fr = lane & 15, fq = lane >> 4;
  EpiStage<Epi> est;
#pragma unroll
  for (int i = 0; i < 4; ++i)
#pragma unroll
    for (int j = 0; j < 4; ++j) {
      int m = tile_m * 128 + wm * 64 + i * 16 + fr; int n0 = tile_n * 128 + wn * 64 + j * 16 + fq * 4;
      est.load(epi, i, j, m, n0);
    }
#pragma unroll
  for (int i = 0; i < 4; ++i)
#pragma unroll
    for (int j = 0; j < 4; ++j) {
      int m = tile_m * 128 + wm * 64 + i * 16 + fr; int n0 = tile_n * 128 + wn * 64 + j * 16 + fq * 4;
      est.apply(epi, i, j, m, n0, acc[i][j]);
    }
}
template <class Epi>
__device__ __forceinline__ void gemm_tile_128_glds(const bf16_t* __restrict__ A, int lda, const bf16_t* __restrict__ Bt, int ldb, int K,
                                                   int tile_m, int tile_n, char* smem, Epi epi) {
  f32x4 acc[4][4];
  gemm_mainloop_glds(A, lda, Bt, ldb, K, tile_m, tile_n, smem, acc);
  const int t = tid_opaque(), lane = t & 63, wave = t >> 6, wm = wave >> 1, wn = wave & 1, fr = lane & 15, fq = lane >> 4;
  EpiStage<Epi> est;
#pragma unroll
  for (int i = 0; i < 4; ++i)
#pragma unroll
    for (int j = 0; j < 4; ++j) {
      int m = tile_m * 128 + wm * 64 + i * 16 + fr; int n0 = tile_n * 128 + wn * 64 + j * 16 + fq * 4;
      est.load(epi, i, j, m, n0);
    }
#pragma unroll
  for (int i = 0; i < 4; ++i)
#pragma unroll
    for (int j = 0; j < 4; ++j) {
      int m = tile_m * 128 + wm * 64 + i * 16 + fr; int n0 = tile_n * 128 + wn * 64 + j * 16 + fq * 4;
      est.apply(epi, i, j, m, n0, acc[i][j]);
    }
}

__global__ void ok_cvt_wT(const float* W, bf16_t* Wt, int K, int N, int Npad) {
  long i = (long)blockIdx.x * blockDim.x + threadIdx.x;
  if (i >= (long)Npad * K) return;
  int k = i % K; int n = i / K;
  Wt[i] = n < N ? f2bf(W[(long)k * N + n]) : (bf16_t)0;
}
__global__ void ok_f32_to_bf16(const float* s, bf16_t* d, long n) {
  long i = (long)blockIdx.x * blockDim.x + threadIdx.x; if (i < n) d[i] = f2bf(s[i]);
}
__global__ void ok_bf16_to_f32(const bf16_t* s, float* d, long n) {
  long i = (long)blockIdx.x * blockDim.x + threadIdx.x; if (i < n) d[i] = bf2f(s[i]);
}
__global__ void ok_norm_mod_bf16(const float* xs, const float* g, const float* modl, int shift_idx, bf16_t* xn, int M) {
  int row = blockIdx.x * 4 + (threadIdx.x >> 6); int lane = threadIdx.x & 63;
  if (row >= M) return;
  int b = row / RB, lr = row % RB; int bb = lr < SEQ ? b : BATCH;
  const float* sh = modl + ((long)bb * 6 + shift_idx) * DM; const float* sc = sh + DM;
  const float* xr = xs + (long)row * DM; float v[16]; float ss = 0.f;
#pragma unroll
  for (int i = 0; i < 4; ++i) { float4 q = *(const float4*)(xr + i * 256 + lane * 4); v[i*4]=q.x; v[i*4+1]=q.y; v[i*4+2]=q.z; v[i*4+3]=q.w; ss += q.x*q.x+q.y*q.y+q.z*q.z+q.w*q.w; }
#pragma unroll
  for (int o = 32; o > 0; o >>= 1) ss += __shfl_xor(ss, o);
  float inv = __builtin_amdgcn_rsqf(ss / DM + EPSN);
#pragma unroll
  for (int i = 0; i < 4; ++i) {
    int d = i * 256 + lane * 4; float o[4];
#pragma unroll
    for (int e = 0; e < 4; ++e) o[e] = v[i*4+e] * inv * g[d+e] * (1.f + sc[d+e]) + sh[d+e];
    uint2 pk; pk.x = pack2bf(o[0], o[1]); pk.y = pack2bf(o[2], o[3]);
    *(uint2*)(xn + (long)row * DM + d) = pk;
  }
}

struct EpiStoreBf16 { bf16_t* C; int ldc; int N;
  __device__ __forceinline__ void operator()(int m, int n0, f32x4 v) const {
    if (n0 < N) { uint2 pk; pk.x = pack2bf(v[0], v[1]); pk.y = pack2bf(v[2], v[3]); *(uint2*)(C + (long)m * ldc + n0) = pk; } } };
struct EpiStoreF32 { float* C; int ldc; int N;
  __device__ __forceinline__ void operator()(int m, int n0, f32x4 v) const {
    if (n0 < N) *(float4*)(C + (long)m * ldc + n0) = make_float4(v[0], v[1], v[2], v[3]); } };
struct EpiResid { float* xs; const float* modl; int gi; int pad; const float* x_in; const float* ctx_in;
  __device__ __forceinline__ void operator()(int m, int n0, f32x4 v) const {
    int b = m / RB, lr = m % RB; int bb = lr < SEQ ? b : BATCH; const float* g = modl + ((long)bb * 6 + gi) * DM + n0;
    const float* src = x_in ? (lr < SEQ ? x_in + ((long)b * SEQ + lr) * DM + n0 : ctx_in + ((long)b * CTX_LEN + (lr - SEQ)) * DM + n0) : xs + (long)m * DM + n0;
    f32x4 x = *(const f32x4*)src;
    x[0] += g[0] * v[0]; x[1] += g[1] * v[1]; x[2] += g[2] * v[2]; x[3] += g[3] * v[3];
    *(f32x4*)(xs + (long)m * DM + n0) = x; } };

template <class Epi>
__global__ void __launch_bounds__(256) ok_gemm(const bf16_t* A, int lda, const bf16_t* Bt, int ldb, int K, int tiles_m, int tiles_n, Epi epi) {
  __shared__ __attribute__((aligned(16))) char smem[GEMM_LDS_BYTES];
  for (int tile = blockIdx.x; tile < tiles_m * tiles_n; tile += gridDim.x) {
    int tm = tile / tiles_n, tn = tile % tiles_n;
    gemm_tile_128(ALoadPlain{A, lda}, Bt, ldb, K, tm, tn, smem, epi);
  }
}

__device__ __forceinline__ float dot2bf(unsigned a, unsigned b, float c) {
  return __builtin_amdgcn_fdot2_f32_bf16(*(bf16v2*)&a, *(bf16v2*)&b, c, false);
}
__global__ void ok_cvt_bf16_v8(const float* s, bf16_t* d, long n8) {
  long i = (long)blockIdx.x * blockDim.x + threadIdx.x; if (i >= n8) return;
  float4 a = *(const float4*)(s + i * 8), b = *(const float4*)(s + i * 8 + 4);
  u32x4 o; o[0] = pack2bf(a.x, a.y); o[1] = pack2bf(a.z, a.w); o[2] = pack2bf(b.x, b.y); o[3] = pack2bf(b.z, b.w);
  *(u32x4*)(d + i * 8) = o;
}

#define P5_LDS_BYTES (128 * 128 * 4)
__device__ __forceinline__ void peer_q_top1_tile(const bf16_t* __restrict__ A, const bf16_t* __restrict__ WqT, const bf16_t* __restrict__ keysb,
                                                 unsigned* __restrict__ top1, int tm, int ps, char* smem) {
  const int t = tid_opaque(), lane = t & 63, wave = t >> 6, wm = wave >> 1, wn = wave & 1, fr = lane & 15, fq = lane >> 4;
  f32x4 acc[4][4];
  u32x4 kreg[8];
  {
    const bf16_t* kg = keysb + (long)ps * 128 * 128;
#pragma unroll
    for (int i = 0; i < 8; ++i) { int idx = t + 256 * i; int r = idx >> 4, c = idx & 15; kreg[i] = *(const u32x4*)(kg + r * 128 + c * 8); }
  }
  gemm_mainloop_glds(A, DM, WqT, DM, DM, tm, ps, smem, acc);
  __syncthreads();
  char* Qs = smem; char* Ks = smem + 32768;
#pragma unroll
  for (int i = 0; i < 4; ++i)
#pragma unroll
    for (int j = 0; j < 4; ++j) {
      int m = wm * 64 + i * 16 + fr; int n0 = wn * 64 + j * 16 + fq * 4;
      uint2 pk; pk.x = pack2bf(acc[i][j][0], acc[i][j][1]); pk.y = pack2bf(acc[i][j][2], acc[i][j][3]);
      *(uint2*)(Qs + m * 256 + ((((n0 >> 3) ^ (m & 15)) << 4) | ((n0 & 7) << 1))) = pk;
    }
  {
#pragma unroll
    for (int i = 0; i < 8; ++i) { int idx = t + 256 * i; int r = idx >> 4, c = idx & 15; *(u32x4*)(Ks + r * 256 + ((c ^ (r & 15)) << 4)) = kreg[i]; }
  }
  __syncthreads();
#pragma unroll
  for (int i = 0; i < 4; ++i)
#pragma unroll
    for (int j = 0; j < 4; ++j) acc[i][j] = (f32x4){0.f, 0.f, 0.f, 0.f};
#pragma unroll
  for (int ks = 0; ks < 4; ++ks) {
    bf16x8 af[4], bfr[4];
#pragma unroll
    for (int i = 0; i < 4; ++i) {
      int r = wm * 64 + i * 16 + fr; af[i] = *(const bf16x8*)(Qs + r * 256 + (((ks * 4 + fq) ^ (r & 15)) << 4));
      int rn = wn * 64 + i * 16 + fr; bfr[i] = *(const bf16x8*)(Ks + rn * 256 + (((ks * 4 + fq) ^ (rn & 15)) << 4));
    }
#pragma unroll
    for (int i = 0; i < 4; ++i)
#pragma unroll
      for (int j = 0; j < 4; ++j) acc[i][j] = __builtin_amdgcn_mfma_f32_16x16x32_bf16(bfr[j], af[i], acc[i][j], 0, 0, 0);
  }
  __syncthreads();
  unsigned* Sc = (unsigned*)smem;
#pragma unroll
  for (int i = 0; i < 4; ++i)
#pragma unroll
    for (int j = 0; j < 4; ++j) {
      int m = wm * 64 + i * 16 + fr; int n0 = wn * 64 + j * 16 + fq * 4;
#pragma unroll
      for (int e = 0; e < 4; ++e) Sc[(n0 + e) * 128 + (m ^ ((((n0 + e) >> 2) & 1) << 4))] = enc_key(acc[i][j][e], n0 + e);
    }
  __syncthreads();
  {
    const int r = t & 127, half = t >> 7;
    unsigned l[16];
#pragma unroll
    for (int i = 0; i < 16; ++i) l[i] = Sc[(half * 64 + i) * 128 + (r ^ (((i >> 2) & 1) << 4))];
    sort16_desc(l);
    for (int g4 = 1; g4 < 4; ++g4) {
      unsigned gk[16], grev[16];
#pragma unroll
      for (int i = 0; i < 16; ++i) { const int k = g4 * 16 + i; gk[i] = Sc[(half * 64 + k) * 128 + (r ^ (((k >> 2) & 1) << 4))]; }
      sort16_desc(gk);
#pragma unroll
      for (int i = 0; i < 16; ++i) grev[i] = gk[15 - i];
      merge16(l, grev);
    }
    __syncthreads();
    unsigned* Ls = (unsigned*)smem;
    if (half == 1) {
#pragma unroll
      for (int i = 0; i < 16; ++i) Ls[r * 17 + i] = l[15 - i];
    }
    __syncthreads();
    if (half == 0) {
      unsigned br[16];
#pragma unroll
      for (int i = 0; i < 16; ++i) br[i] = Ls[r * 17 + i];
      merge16(l, br);
      unsigned* o = top1 + ((long)(tm * 128 + r) * 16 + ps) * 16;
#pragma unroll
      for (int i = 0; i < 4; ++i) { u32x4 v; v[0] = l[4*i]; v[1] = l[4*i+1]; v[2] = l[4*i+2]; v[3] = l[4*i+3]; *(u32x4*)(o + 4 * i) = v; }
    }
  }
}
__global__ void __launch_bounds__(256) ok_peer_q_top1(const bf16_t* A, const bf16_t* WqT, const bf16_t* keysb, unsigned* top1, int tiles_m) {
  __shared__ __attribute__((aligned(16))) char smem[P5_LDS_BYTES];
  for (int tile = blockIdx.x; tile < tiles_m * 16; tile += gridDim.x) { peer_q_top1_tile(A, WqT, keysb, top1, tile / 16, tile % 16, smem); __syncthreads(); }
}

#define P6_LDS_BYTES (32 * 128 * 4 * 3)
__device__ __forceinline__ void peer_gather_group(const bf16_t* __restrict__ xn, const unsigned* __restrict__ top1, const bf16_t* __restrict__ ub,
                                                  const bf16_t* __restrict__ vb, const float* __restrict__ modl, float* __restrict__ xs, int grp, char* smem) {
  const int t = tid_opaque(), lane = t & 63, wave = t >> 6;
  int* pe_l = (int*)smem; float* pg_l = (float*)(smem + 32 * 128 * 4); float* pw_l = (float*)(smem + 2 * 32 * 128 * 4);
  {
    int tl = t >> 3, p = t & 7; long row = (long)grp * 32 + tl;
    peer_combine(top1 + (row * 16 + p * 2) * 16, top1 + (row * 16 + p * 2 + 1) * 16, pe_l + tl * 128 + p * 16, pg_l + tl * 128 + p * 16);
  }
  __syncthreads();
  for (int ti = 0; ti < 8; ++ti) {
    const int tl = wave * 8 + ti; const long row = (long)grp * 32 + tl;
    const int* pe = pe_l + tl * 128; float* pw = pw_l + tl * 128;
    u32x4 h0 = *(const u32x4*)(xn + row * DM + lane * 8), h1 = *(const u32x4*)(xn + row * DM + 512 + lane * 8);
    for (int b = 0; b < 16; ++b) {
      u32x4 u0[8], u1[8];
#pragma unroll
      for (int j = 0; j < 8; ++j) { const bf16_t* ur = ub + (long)pe[b * 8 + j] * DM + lane * 8; u0[j] = *(const u32x4*)ur; u1[j] = *(const u32x4*)(ur + 512); }
      float pd[8];
#pragma unroll
      for (int j = 0; j < 8; ++j) {
        float a = 0.f;
#pragma unroll
        for (int e = 0; e < 4; ++e) { a = dot2bf(h0[e], u0[j][e], a); a = dot2bf(h1[e], u1[j][e], a); }
        pd[j] = a;
      }
      float q4[4], q2[2], q1;
#pragma unroll
      for (int j = 0; j < 4; ++j) { bool hi = lane & 1; float keep = hi ? pd[2*j+1] : pd[2*j], send = hi ? pd[2*j] : pd[2*j+1]; q4[j] = keep + __shfl_xor(send, 1); }
#pragma unroll
      for (int j = 0; j < 2; ++j) { bool hi = lane & 2; float keep = hi ? q4[2*j+1] : q4[2*j], send = hi ? q4[2*j] : q4[2*j+1]; q2[j] = keep + __shfl_xor(send, 2); }
      { bool hi = lane & 4; float keep = hi ? q2[1] : q2[0], send = hi ? q2[0] : q2[1]; q1 = keep + __shfl_xor(send, 4); }
      q1 += __shfl_xor(q1, 8); q1 += __shfl_xor(q1, 16); q1 += __shfl_xor(q1, 32);
      if (lane < 8) { int j = lane & 7; pw[b * 8 + j] = q1; }
    }
    {
      float d0 = pw[lane], d1 = pw[64 + lane];
      pw[lane] = pg_l[tl * 128 + lane] * fgelu_(d0); pw[64 + lane] = pg_l[tl * 128 + 64 + lane] * fgelu_(d1);
    }
    float o[16];
#pragma unroll
    for (int e = 0; e < 16; ++e) o[e] = 0.f;
    for (int b = 0; b < 16; ++b) {
      u32x4 v0[8], v1[8];
#pragma unroll
      for (int j = 0; j < 8; ++j) { const bf16_t* vr = vb + (long)pe[b * 8 + j] * DM + lane * 8; v0[j] = *(const u32x4*)vr; v1[j] = *(const u32x4*)(vr + 512); }
#pragma unroll
      for (int j = 0; j < 8; ++j) {
        float w = pw[b * 8 + j];
#pragma unroll
        for (int e = 0; e < 4; ++e) {
          o[2*e]     += w * __uint_as_float(v0[j][e] << 16); o[2*e+1]     += w * __uint_as_float(v0[j][e] & 0xffff0000u);
          o[8 + 2*e] += w * __uint_as_float(v1[j][e] << 16); o[8 + 2*e+1] += w * __uint_as_float(v1[j][e] & 0xffff0000u);
        }
      }
    }
    {
      int b = row / RB, lr = row % RB; int bb = lr < SEQ ? b : BATCH; const float* g5 = modl + ((long)bb * 6 + 5) * DM;
      float* xr = xs + row * DM;
#pragma unroll
      for (int hf = 0; hf < 2; ++hf) {
        int d = hf * 512 + lane * 8;
        float4 x0 = *(float4*)(xr + d), x1 = *(float4*)(xr + d + 4); float4 g0 = *(const float4*)(g5 + d), g1 = *(const float4*)(g5 + d + 4);
        x0.x += g0.x * o[hf*8+0]; x0.y += g0.y * o[hf*8+1]; x0.z += g0.z * o[hf*8+2]; x0.w += g0.w * o[hf*8+3];
        x1.x += g1.x * o[hf*8+4]; x1.y += g1.y * o[hf*8+5]; x1.z += g1.z * o[hf*8+6]; x1.w += g1.w * o[hf*8+7];
        *(float4*)(xr + d) = x0; *(float4*)(xr + d + 4) = x1;
      }
    }
  }
}
__global__ void __launch_bounds__(256) ok_peer_gather(const bf16_t* xn, const unsigned* top1, const bf16_t* ub, const bf16_t* vb, const float* modl, float* xs, int ngroups) {
  __shared__ __attribute__((aligned(16))) char smem[P6_LDS_BYTES];
  for (int g = blockIdx.x; g < ngroups; g += gridDim.x) { peer_gather_group(xn, top1, ub, vb, modl, xs, g, smem); __syncthreads(); }
}

template <int DQ> struct AttnCfg { static constexpr int KROW = DQ * 2 + 16; static constexpr int VROW = 136; static constexpr int KBYTES = 64 * KROW; static constexpr int LDS = 64 * KROW + 64 * VROW; };
#define ATTN_LDS_BYTES (64 * 208 + 64 * 136)
__device__ __forceinline__ void attn_score_bound(const float* __restrict__ qk_g, int DQ, float sqrt_dq, float* __restrict__ dst, int lane) {
  float gq = 0.f, gk = 0.f;
  for (int i = lane; i < DQ; i += 64) { gq = fmaxf(gq, fabsf(qk_g[i])); gk = fmaxf(gk, fabsf(qk_g[DQ + i])); }
#pragma unroll
  for (int o_ = 32; o_ > 0; o_ >>= 1) { gq = fmaxf(gq, __shfl_xor(gq, o_)); gk = fmaxf(gk, __shfl_xor(gk, o_)); }
  if (lane == 0) *dst = -fminf(1.02f * 1.4426950408889634f * sqrt_dq * gq * gk, 60.f);
}
template <int DQ>
__device__ __forceinline__ void attn_block(const bf16_t* __restrict__ qb, int HQ, const bf16_t* __restrict__ kb, int HK, const bf16_t* __restrict__ vT, int G,
                                           bf16_t* __restrict__ mixall, int ooff, int b, int head, int qt, char* smem, const float* __restrict__ negC_p) {
  constexpr int KROW = AttnCfg<DQ>::KROW, VROW = 136, NKK = DQ / 16, KCH = DQ / 8;
  constexpr int KLD = (64 * KCH) / 256;
  const int t = tid_opaque(), lane = t & 63, wave = t >> 6, lq = lane & 31, lh = lane >> 5;
  const int hk = head / G;
  char* Ks = smem; char* Vs = smem + 64 * KROW;
  const float negC = *negC_p;
  const long qrow = (long)b * RB + qt * 128 + wave * 32 + lq;
  bf16x8 qf[NKK];
#pragma unroll
  for (int kk = 0; kk < NKK; ++kk) qf[kk] = *(const bf16x8*)(qb + (qrow * HQ + head) * DQ + kk * 16 + lh * 8);
  const int key0 = qt < 16 ? 0 : SEQ; const int nt = qt < 16 ? RB / 64 : CTX_LEN / 64;
  const bf16_t* kp[KLD]; const bf16_t* vp_[2];
#pragma unroll
  for (int i = 0; i < KLD; ++i) { int c = t + 256 * i; int r = c / KCH, cc = c % KCH; kp[i] = kb + ((long)b * RB * HK + hk) * DQ + (long)(key0 + r) * HK * DQ + cc * 8; }
#pragma unroll
  for (int i = 0; i < 2; ++i) { int c = t + 256 * i; int r = c >> 3, cc = c & 7; vp_[i] = vT + ((long)(b * HK + hk) * 64 + r) * RB + key0 + cc * 8; }
  u32x4 rk[KLD], rv[2];
#pragma unroll
  for (int i = 0; i < KLD; ++i) { rk[i] = *(const u32x4*)kp[i]; kp[i] += 64 * HK * DQ; }
#pragma unroll
  for (int i = 0; i < 2; ++i) { rv[i] = *(const u32x4*)vp_[i]; vp_[i] += 64; }
  f32x16 ot[2];
#pragma unroll
  for (int d = 0; d < 2; ++d)
#pragma unroll
    for (int r = 0; r < 16; ++r) ot[d][r] = 0.f;
  float lrun = 0.f;
  for (int tile = 0; tile < nt; ++tile) {
    __syncthreads();
#pragma unroll
    for (int i = 0; i < KLD; ++i) { int c = t + 256 * i; int r = c / KCH, cc = c % KCH; *(u32x4*)(Ks + r * KROW + cc * 16) = rk[i]; }
#pragma unroll
    for (int i = 0; i < 2; ++i) { int c = t + 256 * i; int r = c >> 3, cc = c & 7; *(uint2*)(Vs + r * VROW + cc * 16) = make_uint2(rv[i][0], rv[i][1]); *(uint2*)(Vs + r * VROW + cc * 16 + 8) = make_uint2(rv[i][2], rv[i][3]); }
    __syncthreads();
    if (tile + 1 < nt) {
#pragma unroll
      for (int i = 0; i < KLD; ++i) { rk[i] = *(const u32x4*)kp[i]; kp[i] += 64 * HK * DQ; }
#pragma unroll
      for (int i = 0; i < 2; ++i) { rv[i] = *(const u32x4*)vp_[i]; vp_[i] += 64; }
    }
    f32x16 st[2];
#pragma unroll
    for (int kt = 0; kt < 2; ++kt) {
#pragma unroll
      for (int r = 0; r < 16; ++r) st[kt][r] = negC;
#pragma unroll
      for (int kk = 0; kk < NKK; ++kk) {
        bf16x8 ka = *(const bf16x8*)(Ks + (kt * 32 + lq) * KROW + kk * 32 + lh * 16);
        st[kt] = __builtin_amdgcn_mfma_f32_32x32x16_bf16(ka, qf[kk], st[kt], 0, 0, 0);
      }
    }
    float ps = 0.f;
#pragma unroll
    for (int kt = 0; kt < 2; ++kt)
#pragma unroll
      for (int r = 0; r < 16; ++r) { float p = __builtin_amdgcn_exp2f(st[kt][r]); st[kt][r] = p; ps += p; }
    lrun += ps;
#pragma unroll
    for (int kt = 0; kt < 2; ++kt)
#pragma unroll
      for (int s = 0; s < 2; ++s) {
        union { bf16x8 v; unsigned u[4]; } pb;
#pragma unroll
        for (int j = 0; j < 4; ++j) pb.u[j] = pack2bf(st[kt][8 * s + 2 * j], st[kt][8 * s + 2 * j + 1]);
#pragma unroll
        for (int d = 0; d < 2; ++d) {
          const char* vp = Vs + (d * 32 + lq) * VROW + (kt * 32 + 16 * s + 4 * lh) * 2;
          union { bf16x8 v; uint2 h[2]; } va; va.h[0] = *(const uint2*)vp; va.h[1] = *(const uint2*)(vp + 16);
          ot[d] = __builtin_amdgcn_mfma_f32_32x32x16_bf16(va.v, pb.v, ot[d], 0, 0, 0);
        }
      }
  }
  float ltot = xor32_sum(lrun); float inv = 1.f / ltot;
  bf16_t* orow = mixall + qrow * DM + ooff + head * 64;
#pragma unroll
  for (int d = 0; d < 2; ++d)
#pragma unroll
    for (int g = 0; g < 4; ++g) {
      uint2 pk; pk.x = pack2bf(ot[d][4 * g] * inv, ot[d][4 * g + 1] * inv); pk.y = pack2bf(ot[d][4 * g + 2] * inv, ot[d][4 * g + 3] * inv);
      *(uint2*)(orow + d * 32 + 8 * g + 4 * lh) = pk;
    }
}
__global__ void ok_adapt_rows(const float* src, int sld, int scol, int ncols, float scale, bf16_t* dst, int dld, int nrows) {
  long i = (long)blockIdx.x * blockDim.x + threadIdx.x; if (i >= (long)nrows * ncols) return;
  int c = i % ncols; long r = i / ncols; dst[r * dld + c] = f2bf(src[r * sld + scol + c] * scale);
}
__global__ void ok_adapt_vT(const float* src, int sld, int scol, int hstride, int H, bf16_t* dst) {
  long i = (long)blockIdx.x * blockDim.x + threadIdx.x; if (i >= (long)H * 64 * RB) return;
  int lr = i % RB; int d = (i / RB) % 64; int h = i / ((long)RB * 64);
  dst[i] = f2bf(src[(long)lr * sld + scol + h * hstride + d]);
}

typedef __attribute__((ext_vector_type(2))) float f32x2;
#define SCAN_TS 16
#define SCAN_LDS_BYTES (2 * SCAN_TS * 1536 + 2 * SCAN_TS * 32 * 4)
__device__ __forceinline__ float reduce8(float x) {
  x += __builtin_bit_cast(float, __builtin_amdgcn_update_dpp(0, __builtin_bit_cast(int, x), 0xB1, 0xf, 0xf, true));
  x += __builtin_bit_cast(float, __builtin_amdgcn_update_dpp(0, __builtin_bit_cast(int, x), 0x4E, 0xf, 0xf, true));
  x += __builtin_bit_cast(float, __builtin_amdgcn_update_dpp(0, __builtin_bit_cast(int, x), 0x141, 0xf, 0xf, true));
  return x;
}
__device__ __forceinline__ int scan_row(int dir, int s) {
  if (s < CTX_LEN) return SEQ + (dir == 0 ? s : CTX_LEN - 1 - s);
  return dir == 0 ? s - CTX_LEN : SEQ - 1 - (s - CTX_LEN);
}
__device__ __forceinline__ void rw_scan_block(const bf16_t* __restrict__ r_, const bf16_t* __restrict__ v_, const bf16_t* __restrict__ kk_, const bf16_t* __restrict__ kd_,
                                              const bf16_t* __restrict__ bd_, const float* __restrict__ w_, float* __restrict__ y_, int item, long dstride, char* smem) {
  const int t = tid_opaque(), lane = t & 63, wave = t >> 6, cg = lane & 7, il = wave * 8 + (lane >> 3);
  const int half = item & 1, dir = (item >> 1) & 1, h = (item >> 2) % 6, b = item / 24;
  const long rowbase = (long)b * RB; const int col0 = h * 64;
  float* ybuf = (float*)(smem + 2 * SCAN_TS * 1536);
  const int st_ld = t >> 4, part = t & 15;
  u32x4 la, lb, lc, lw;
  auto issue = [&](int c) {
    long row = rowbase + scan_row(dir, c * SCAN_TS + st_ld); long o = row * 384 + col0;
    const int ch = (part & 7) * 8;
    la = *(const u32x4*)((part < 8 ? kk_ + o : bd_ + dir * dstride + o) + ch);
    lb = *(const u32x4*)((part < 8 ? kd_ + dir * dstride + o : r_ + o) + ch);
    lc = *(const u32x4*)(v_ + o + ch);
    lw = *(const u32x4*)(w_ + dir * dstride + o + part * 4);
  };
  auto stash = [&](int buf) {
    float* base = (float*)(smem + buf * SCAN_TS * 1536 + st_ld * 1536);
    const int ch = (part & 7) * 8;
    float* pa = base + (part < 8 ? 64 : 128) + ch; float* pb = base + (part < 8 ? 192 : 256) + ch;
    f32x4 x0, x1;
#pragma unroll
    for (int e = 0; e < 2; ++e) { x0[2*e] = __uint_as_float(la[e] << 16); x0[2*e+1] = __uint_as_float(la[e] & 0xffff0000u); x1[2*e] = __uint_as_float(la[2+e] << 16); x1[2*e+1] = __uint_as_float(la[2+e] & 0xffff0000u); }
    *(f32x4*)pa = x0; *(f32x4*)(pa + 4) = x1;
#pragma unroll
    for (int e = 0; e < 2; ++e) { x0[2*e] = __uint_as_float(lb[e] << 16); x0[2*e+1] = __uint_as_float(lb[e] & 0xffff0000u); x1[2*e] = __uint_as_float(lb[2+e] << 16); x1[2*e+1] = __uint_as_float(lb[2+e] & 0xffff0000u); }
    *(f32x4*)pb = x0; *(f32x4*)(pb + 4) = x1;
    if (part < 8) {
      float* pc = base + 320 + ch;
#pragma unroll
      for (int e = 0; e < 2; ++e) { x0[2*e] = __uint_as_float(lc[e] << 16); x0[2*e+1] = __uint_as_float(lc[e] & 0xffff0000u); x1[2*e] = __uint_as_float(lc[2+e] << 16); x1[2*e+1] = __uint_as_float(lc[2+e] & 0xffff0000u); }
      *(f32x4*)pc = x0; *(f32x4*)(pc + 4) = x1;
    }
    *(u32x4*)(base + part * 4) = lw;
  };
  f32x2 S[4];
#pragma unroll
  for (int j = 0; j < 4; ++j) S[j] = (f32x2){0.f, 0.f};
  const int NCH = RB / SCAN_TS;
  __builtin_amdgcn_s_setprio(3);
  issue(0);
  for (int c = 0; c < NCH; ++c) {
    const int buf = c & 1;
    stash(buf);
    __syncthreads();
    if (c > 0 && t < 128) {
      int st = t >> 3, i4 = (t & 7) * 4; long row = rowbase + scan_row(dir, (c - 1) * SCAN_TS + st);
      *(f32x4*)(y_ + dir * dstride + row * 384 + col0 + half * 32 + i4) = *(const f32x4*)(ybuf + (buf ^ 1) * SCAN_TS * 32 + st * 32 + i4);
    }
    if (c + 1 < NCH) issue(c + 1);
    const float* ob = (const float*)(smem + buf * SCAN_TS * 1536) + cg * 8;
    const float* vb_ = (const float*)(smem + buf * SCAN_TS * 1536) + 320 + half * 32 + il;
    float yk[SCAN_TS];
    f32x4 nw0 = *(const f32x4*)(ob), nw1 = *(const f32x4*)(ob + 4), nk0 = *(const f32x4*)(ob + 64), nk1 = *(const f32x4*)(ob + 68);
    f32x4 nb0 = *(const f32x4*)(ob + 128), nb1 = *(const f32x4*)(ob + 132), nd0 = *(const f32x4*)(ob + 192), nd1 = *(const f32x4*)(ob + 196);
    f32x4 nr0 = *(const f32x4*)(ob + 256), nr1 = *(const f32x4*)(ob + 260); float nvi = vb_[0];
#pragma unroll
    for (int st = 0; st < SCAN_TS; ++st) {
      const f32x4 w0 = nw0, w1 = nw1, k0 = nk0, k1 = nk1, b0 = nb0, b1 = nb1, d0 = nd0, d1 = nd1, r0 = nr0, r1 = nr1; const float vi = nvi;
      if (st + 1 < SCAN_TS) {
        const float* o = ob + (st + 1) * 384;
        nw0 = *(const f32x4*)(o); nw1 = *(const f32x4*)(o + 4); nk0 = *(const f32x4*)(o + 64); nk1 = *(const f32x4*)(o + 68);
        nb0 = *(const f32x4*)(o + 128); nb1 = *(const f32x4*)(o + 132); nd0 = *(const f32x4*)(o + 192); nd1 = *(const f32x4*)(o + 196);
        nr0 = *(const f32x4*)(o + 256); nr1 = *(const f32x4*)(o + 260); nvi = vb_[(st + 1) * 384];
      }
      __builtin_amdgcn_sched_barrier(0);
      f32x2 a2 = S[0] * (f32x2){k0[0], k0[1]}, c2 = S[2] * (f32x2){k1[0], k1[1]};
      a2 += S[1] * (f32x2){k0[2], k0[3]}; c2 += S[3] * (f32x2){k1[2], k1[3]};
      a2 += c2;
      const f32x2 vv = (f32x2){vi, vi};
      f32x2 t0 = vv * (f32x2){d0[0], d0[1]}, t1 = vv * (f32x2){d0[2], d0[3]}, t2 = vv * (f32x2){d1[0], d1[1]}, t3 = vv * (f32x2){d1[2], d1[3]};
      float skk = reduce8(a2[0] + a2[1]);
      const f32x2 ns = (f32x2){-skk, -skk};
      t0 += ns * (f32x2){b0[0], b0[1]}; t1 += ns * (f32x2){b0[2], b0[3]}; t2 += ns * (f32x2){b1[0], b1[1]}; t3 += ns * (f32x2){b1[2], b1[3]};
      S[0] = S[0] * (f32x2){w0[0], w0[1]} + t0; S[1] = S[1] * (f32x2){w0[2], w0[3]} + t1; S[2] = S[2] * (f32x2){w1[0], w1[1]} + t2; S[3] = S[3] * (f32x2){w1[2], w1[3]} + t3;
      f32x2 y2 = S[0] * (f32x2){r0[0], r0[1]}, z2 = S[2] * (f32x2){r1[0], r1[1]};
      y2 += S[1] * (f32x2){r0[2], r0[3]}; z2 += S[3] * (f32x2){r1[2], r1[3]};
      y2 += z2;
      yk[st] = y2[0] + y2[1];
      __builtin_amdgcn_sched_barrier(0);
    }
#pragma unroll
    for (int g = 0; g < 2; ++g) {
      float q4[4], q2[2], q1;
#pragma unroll
      for (int j = 0; j < 4; ++j) { bool hi = cg & 1; float keep = hi ? yk[g*8 + 2*j+1] : yk[g*8 + 2*j], send = hi ? yk[g*8 + 2*j] : yk[g*8 + 2*j+1]; q4[j] = keep + dpp_get<0xB1>(send); }
#pragma unroll
      for (int j = 0; j < 2; ++j) { bool hi = cg & 2; float keep = hi ? q4[2*j+1] : q4[2*j], send = hi ? q4[2*j] : q4[2*j+1]; q2[j] = keep + dpp_get<0x4E>(send); }
      { bool hi = cg & 4; float keep = hi ? q2[1] : q2[0], send = hi ? q2[0] : q2[1]; q1 = keep + xor4_get(send); }
      ybuf[buf * SCAN_TS * 32 + (g * 8 + cg) * 32 + il] = q1;
    }
  }
  __builtin_amdgcn_s_setprio(0);
  __syncthreads();
  if (t < 128) {
    int st = t >> 3, i4 = (t & 7) * 4; long row = rowbase + scan_row(dir, (NCH - 1) * SCAN_TS + st);
    *(f32x4*)(y_ + dir * dstride + row * 384 + col0 + half * 32 + i4) = *(const f32x4*)(ybuf + ((NCH - 1) & 1) * SCAN_TS * 32 + st * 32 + i4);
  }
}
__global__ void __launch_bounds__(256) ok_rw_scan(const bf16_t* r_, const bf16_t* v_, const bf16_t* kk_, const bf16_t* kd_, const bf16_t* bd_, const float* w_, float* y_, int item0, int nitems, long dstride) {
  __shared__ __attribute__((aligned(16))) char smem[SCAN_LDS_BYTES];
  for (int it = item0 + blockIdx.x; it < item0 + nitems; it += gridDim.x) { rw_scan_block(r_, v_, kk_, kd_, bd_, w_, y_, it, dstride, smem); __syncthreads(); }
}
__global__ void ok_copy_rows_f32(const float* src, int sld, int scol, int ncols, float* dst, int dld, int nrows) {
  long i = (long)blockIdx.x * blockDim.x + threadIdx.x; if (i >= (long)nrows * ncols) return;
  int c = i % ncols; long r = i / ncols; dst[r * dld + c] = src[r * sld + scol + c];
}

__global__ void ok_cvt_wT_g(const float* W, const float* g, bf16_t* Wt, int K, int N, int Kpad) {
  long i = (long)blockIdx.x * blockDim.x + threadIdx.x;
  if (i >= (long)N * Kpad) return;
  int k = i % Kpad; int n = i / Kpad;
  Wt[i] = k < K ? f2bf(W[(long)k * N + n] * (g ? g[k] : 1.f)) : (bf16_t)0;
}
struct ALoadShift { const bf16_t* P; const float* mu; int col0; int mucol0; int act; int kvalid;
  __device__ __forceinline__ u32x4 operator()(int row, int k) const {
    u32x4 z = {0u, 0u, 0u, 0u};
    if (k >= kvalid) return z;
    int lr = row % RB; bool first = (lr == 0) || (lr == SEQ), last = (lr == SEQ - 1) || (lr == RB - 1);
    const bf16_t* p = P + (long)row * IN_COLS + col0 + k;
    u32x4 c = *(const u32x4*)p; u32x4 pv = first ? z : *(const u32x4*)(p - IN_COLS); u32x4 nx = last ? z : *(const u32x4*)(p + IN_COLS);
    const float* m0 = mu + mucol0 + k; const float* m1 = m0 + RWC;
    u32x4 o;
#pragma unroll
    for (int e = 0; e < 4; ++e) {
      float c0 = __uint_as_float(c[e] << 16), c1 = __uint_as_float(c[e] & 0xffff0000u);
      float p0 = __uint_as_float(pv[e] << 16), p1 = __uint_as_float(pv[e] & 0xffff0000u);
      float n0 = __uint_as_float(nx[e] << 16), n1 = __uint_as_float(nx[e] & 0xffff0000u);
      float x0 = c0 + m0[2*e] * (p0 - c0) + m1[2*e] * (n0 - c0), x1 = c1 + m0[2*e+1] * (p1 - c1) + m1[2*e+1] * (n1 - c1);
      if (act == 1) { x0 = ftanh_(x0); x1 = ftanh_(x1); } else if (act == 2) { x0 = fsigmoid_(x0); x1 = fsigmoid_(x1); }
      o[e] = pack2bf(x0, x1);
    }
    return o;
  } };
struct EpiDecay { float* w; const float* w0; int pad0; int pad1;
  __device__ __forceinline__ void operator()(int m, int n0, f32x4 v) const {
    f32x4 o;
#pragma unroll
    for (int e = 0; e < 4; ++e) o[e] = fdecay_(w0[n0 + e] + v[e]);
    *(f32x4*)(w + (long)m * 384 + n0) = o; } };
struct EpiSigA { bf16_t* a; const float* a0;
  __device__ __forceinline__ void operator()(int m, int n0, f32x4 v) const {
    uint2 pk; pk.x = pack2bf(fsigmoid_(a0[n0] + v[0]), fsigmoid_(a0[n0+1] + v[1])); pk.y = pack2bf(fsigmoid_(a0[n0+2] + v[2]), fsigmoid_(a0[n0+3] + v[3]));
    *(uint2*)(a + (long)m * 384 + n0) = pk; } };

template <> struct EpiStage<EpiResid> {
  f32x4 x[4][4], g[4];
  __device__ __forceinline__ void load(const EpiResid& e, int i, int j, int m, int n0) {
    int b = m / RB, lr = m % RB; int bb = lr < SEQ ? b : BATCH;
    if (i == 0) g[j] = *(const f32x4*)(e.modl + ((long)bb * 6 + e.gi) * DM + n0);
    const float* src = e.x_in ? (lr < SEQ ? e.x_in + ((long)b * SEQ + lr) * DM + n0 : e.ctx_in + ((long)b * CTX_LEN + (lr - SEQ)) * DM + n0) : e.xs + (long)m * DM + n0;
    x[i][j] = *(const f32x4*)src;
  }
  __device__ __forceinline__ void apply(const EpiResid& e, int i, int j, int m, int n0, f32x4 v) {
    f32x4 o = x[i][j]; o[0] += g[j][0] * v[0]; o[1] += g[j][1] * v[1]; o[2] += g[j][2] * v[2]; o[3] += g[j][3] * v[3];
    *(f32x4*)(e.xs + (long)m * DM + n0) = o;
  }
};
template <> struct EpiStage<EpiDecay> {
  f32x4 b[4];
  __device__ __forceinline__ void load(const EpiDecay& e, int i, int j, int, int n0) { if (i == 0) b[j] = *(const f32x4*)(e.w0 + n0); }
  __device__ __forceinline__ void apply(const EpiDecay& e, int, int j, int m, int n0, f32x4 v) {
    f32x4 o;
#pragma unroll
    for (int q = 0; q < 4; ++q) o[q] = fdecay_(b[j][q] + v[q]);
    *(f32x4*)(e.w + (long)m * 384 + n0) = o;
  }
};
template <> struct EpiStage<EpiSigA> {
  f32x4 b[4];
  __device__ __forceinline__ void load(const EpiSigA& e, int i, int j, int, int n0) { if (i == 0) b[j] = *(const f32x4*)(e.a0 + n0); }
  __device__ __forceinline__ void apply(const EpiSigA& e, int, int j, int m, int n0, f32x4 v) {
    uint2 pk; pk.x = pack2bf(fsigmoid_(b[j][0] + v[0]), fsigmoid_(b[j][1] + v[1])); pk.y = pack2bf(fsigmoid_(b[j][2] + v[2]), fsigmoid_(b[j][3] + v[3]));
    *(uint2*)(e.a + (long)m * 384 + n0) = pk;
  }
};
struct PrepW { const bf16_t *wqbT, *wkvbT, *w2T, *a2T, *g2T; const float *mu, *w0, *a0; };
struct PrepBuf { const bf16_t* P; bf16_t *tq, *tkv, *a_b, *g_b; float* w_f; };
__device__ __forceinline__ void prep_gemm_tile(const PrepW& W, const PrepBuf& B, int tm, int ct, char* smem) {
  const long MA = NROWS;
  if (ct < 3) gemm_tile_128(ALoadPlain{B.P, IN_COLS}, W.wqbT, 256, 256, tm, ct, smem, EpiStoreBf16{B.tq, 384, 384});
  else if (ct < 7) gemm_tile_128(ALoadPlain{B.P + 256, IN_COLS}, W.wkvbT, 128, 128, tm, ct - 3, smem, EpiStoreBf16{B.tkv, 512, 512});
  else if (ct < 13) { int d = (ct - 7) / 3, tn = (ct - 7) % 3;
    gemm_tile_128(ALoadShift{B.P, W.mu, RW_OFF + 1152 + d * 64, 1152 + d * 64, 1, 64}, W.w2T + d * 384 * 64, 64, 64, tm, tn, smem, EpiDecay{B.w_f + d * MA * 384, W.w0 + d * 384, 0, 0}); }
  else if (ct < 19) { int d = (ct - 13) / 3, tn = (ct - 13) % 3;
    gemm_tile_128(ALoadShift{B.P, W.mu, RW_OFF + 1280 + d * 64, 1280 + d * 64, 0, 64}, W.a2T + d * 384 * 64, 64, 64, tm, tn, smem, EpiSigA{B.a_b + d * MA * 384, W.a0 + d * 384}); }
  else gemm_tile_128(ALoadShift{B.P, W.mu, RW_OFF + 1408, 1408, 2, 160}, W.g2T, 192, 192, tm, ct - 19, smem, EpiStoreBf16{B.g_b, 384, 384});
}
template <class Epi>
__device__ __forceinline__ void prep_triple_tile(const ALoadShift& aload, const bf16_t* __restrict__ Bt, int tm, char* smem, const Epi& epi) {
  const int t = tid_opaque(), lane = t & 63, wave = t >> 6;
  const int wm = wave >> 1, wn = wave & 1, fr = lane & 15, fq = lane >> 4;
  char* As = smem; char* Bs = smem + 16384;
  const int lrow = t >> 3, lchunk = t & 7;
  const int arow = tm * 128 + lrow;
  const bf16_t* bg = Bt + (long)lrow * 64 + lchunk * 8;
  u32x4 ra[4], rb[4];
#pragma unroll
  for (int i = 0; i < 4; ++i) { ra[i] = aload(arow + 32 * i, lchunk * 8); rb[i] = *(const u32x4*)(bg + (long)(32 * i) * 64); }
  __syncthreads();
#pragma unroll
  for (int i = 0; i < 4; ++i) { int r = lrow + 32 * i; int off = r * 128 + ((lchunk ^ (r & 7)) << 4); *(u32x4*)(As + off) = ra[i]; *(u32x4*)(Bs + off) = rb[i]; }
  __syncthreads();
#pragma unroll
  for (int tn = 0; tn < 3; ++tn) {
    if (tn < 2) {
#pragma unroll
      for (int i = 0; i < 4; ++i) rb[i] = *(const u32x4*)(bg + (long)((tn + 1) * 128 + 32 * i) * 64);
    }
    f32x4 acc[4][4];
#pragma unroll
    for (int i = 0; i < 4; ++i)
#pragma unroll
      for (int j = 0; j < 4; ++j) acc[i][j] = (f32x4){0.f, 0.f, 0.f, 0.f};
    GEMM_COMPUTE_TILE();
    EpiStage<Epi> est;
#pragma unroll
    for (int i = 0; i < 4; ++i)
#pragma unroll
      for (int j = 0; j < 4; ++j) { int m = tm * 128 + wm * 64 + i * 16 + fr; int n0 = tn * 128 + wn * 64 + j * 16 + fq * 4; est.load(epi, i, j, m, n0); }
#pragma unroll
    for (int i = 0; i < 4; ++i)
#pragma unroll
      for (int j = 0; j < 4; ++j) { int m = tm * 128 + wm * 64 + i * 16 + fr; int n0 = tn * 128 + wn * 64 + j * 16 + fq * 4; est.apply(epi, i, j, m, n0, acc[i][j]); }
    if (tn < 2) {
      __syncthreads();
#pragma unroll
      for (int i = 0; i < 4; ++i) { int r = lrow + 32 * i; int off = r * 128 + ((lchunk ^ (r & 7)) << 4); *(u32x4*)(Bs + off) = rb[i]; }
      __syncthreads();
    }
  }
}
__device__ __forceinline__ void prep_gemm_item(const PrepW& W, const PrepBuf& B, int tm, int it, char* smem) {
  const long MA = NROWS;
  if (it < 7) prep_gemm_tile(W, B, tm, it, smem);
  else if (it < 10) prep_gemm_tile(W, B, tm, 19 + (it - 7), smem);
  else if (it < 12) { const int d = it - 10;
    prep_triple_tile(ALoadShift{B.P, W.mu, RW_OFF + 1152 + d * 64, 1152 + d * 64, 1, 64}, W.w2T + d * 384 * 64, tm, smem, EpiDecay{B.w_f + d * MA * 384, W.w0 + d * 384, 0, 0}); }
  else { const int d = it - 12;
    prep_triple_tile(ALoadShift{B.P, W.mu, RW_OFF + 1280 + d * 64, 1280 + d * 64, 0, 64}, W.a2T + d * 384 * 64, tm, smem, EpiSigA{B.a_b + d * MA * 384, W.a0 + d * 384}); }
}
__global__ void __launch_bounds__(256) ok_prep_gemm(PrepW W, PrepBuf B) {
  __shared__ __attribute__((aligned(16))) char smem[GEMM_LDS_BYTES];
  for (int tile = blockIdx.x; tile < (NROWS / 128) * 22; tile += gridDim.x) prep_gemm_tile(W, B, tile / 22, tile % 22, smem);
}

__device__ __forceinline__ float wave_sum(float x) {
#pragma unroll
  for (int o = 32; o > 0; o >>= 1) x += __shfl_xor(x, o);
  return x;
}
__device__ __forceinline__ float ldbf(const bf16_t* p) { return bf2f(*p); }
struct FinW { const float *mla_qk_g, *gqa_qk_g, *mu, *k_k, *k_a; };
struct FinBuf { const bf16_t *P, *tq, *tkv, *a_b; bf16_t *mq, *mk, *mvT, *gq, *gk, *gvT, *r_b, *v_b, *kk_b, *kd_b, *bd_b; };
#define FIN_LDS_BYTES (384 * 132)
__device__ __forceinline__ void prep_finish_tile(const FinW& W, const FinBuf& B, int tile, char* smem) {
  const int t = tid_opaque(), lane = t & 63, wave = t >> 6; const long MA = NROWS;
  bf16_t* vbuf = (bf16_t*)smem;
  const long row0 = (long)tile * 64; const int b = row0 / RB; const int lr0 = row0 % RB;
  for (int it = 0; it < 16; ++it) {
    const int rl = it * 4 + wave; const long row = row0 + rl; const int lr = lr0 + rl; const bool lat = lr < SEQ;
    const bf16_t* Pr = B.P + row * IN_COLS;
    float sq = 0.f;
#pragma unroll
    for (int i = 0; i < 4; ++i) { float x = ldbf(Pr + i * 64 + lane); sq += x * x; }
    float skv = 0.f;
#pragma unroll
    for (int i = 0; i < 2; ++i) { float x = ldbf(Pr + 256 + i * 64 + lane); skv += x * x; }
    const float cq = __builtin_amdgcn_rsqf(wave_sum(sq) / 256.f + EPSN), ckv = __builtin_amdgcn_rsqf(wave_sum(skv) / 128.f + EPSN);
    const float krope = lane < 32 ? ldbf(Pr + 384 + lane) : 0.f;
    float cs_m = 1.f, sn_m = 0.f;
    { int j = lane & 15; int pos = j < 8 ? lr / 64 : lr % 64; float ang = (float)pos * powf(10000.f, -(float)(j & 7) / 8.f); if (lat) { cs_m = cosf(ang); sn_m = sinf(ang); } }
    const float* gq_ = W.mla_qk_g; const float* gk_ = W.mla_qk_g + 96;
#pragma unroll
    for (int h = 0; h < 4; ++h) {
      float qa = cq * ldbf(B.tq + row * 384 + h * 96 + lane); float qb = lane < 32 ? cq * ldbf(B.tq + row * 384 + h * 96 + 64 + lane) : 0.f;
      float inv = __builtin_amdgcn_rsqf(wave_sum(qa * qa + qb * qb) / 96.f + EPSN);
      qa *= inv * gq_[lane]; qb *= inv * (lane < 32 ? gq_[64 + lane] : 0.f);
      { float other = __shfl_xor(qb, 16); float rr = (lane & 16) ? (other * sn_m + qb * cs_m) : (qb * cs_m - other * sn_m); qb = rr; }
      const float qs = 0.14724445f;
      B.mq[row * 384 + h * 96 + lane] = f2bf(qa * qs); if (lane < 32) B.mq[row * 384 + h * 96 + 64 + lane] = f2bf(qb * qs);
      float ka = ckv * ldbf(B.tkv + row * 512 + h * 128 + lane); float kb = krope;
      float invk = __builtin_amdgcn_rsqf(wave_sum(ka * ka + kb * kb) / 96.f + EPSN);
      ka *= invk * gk_[lane]; kb *= invk * (lane < 32 ? gk_[64 + lane] : 0.f);
      { float other = __shfl_xor(kb, 16); float rr = (lane & 16) ? (other * sn_m + kb * cs_m) : (kb * cs_m - other * sn_m); kb = rr; }
      B.mk[row * 384 + h * 96 + lane] = f2bf(ka); if (lane < 32) B.mk[row * 384 + h * 96 + 64 + lane] = f2bf(kb);
      vbuf[(h * 64 + lane) * 66 + rl] = f2bf(ckv * ldbf(B.tkv + row * 512 + h * 128 + 64 + lane));
    }
    float cs_g = 1.f, sn_g = 0.f;
    { int j = lane & 31; int pos = j < 16 ? lr / 64 : lr % 64; float ang = (float)pos * powf(10000.f, -(float)(j & 15) / 16.f); if (lat) { cs_g = cosf(ang); sn_g = sinf(ang); } }
#pragma unroll
    for (int h = 0; h < 8; ++h) {
      float x = ldbf(Pr + GQA_OFF + h * 64 + lane);
      float inv = __builtin_amdgcn_rsqf(wave_sum(x * x) / 64.f + EPSN);
      x *= inv * W.gqa_qk_g[(h < 6 ? 0 : 64) + lane];
      float other = __shfl_xor(x, 32); float rr = (lane & 32) ? (other * sn_g + x * cs_g) : (x * cs_g - other * sn_g);
      if (h < 6) B.gq[row * 384 + h * 64 + lane] = f2bf(rr * 0.18033688f); else B.gk[row * 128 + (h - 6) * 64 + lane] = f2bf(rr);
    }
#pragma unroll
    for (int hk = 0; hk < 2; ++hk) vbuf[((4 + hk) * 64 + lane) * 66 + rl] = Pr[GQA_OFF + 512 + hk * 64 + lane];
    const bool first = (lr == 0) || (lr == SEQ), last = (lr == SEQ - 1) || (lr == RB - 1);
#pragma unroll
    for (int h = 0; h < 6; ++h) {
      float xs3[3];
#pragma unroll
      for (int part = 0; part < 3; ++part) {
        int c = part * 384 + h * 64 + lane; const bf16_t* pp = Pr + RW_OFF + c;
        float p = ldbf(pp), pv = first ? 0.f : ldbf(pp - IN_COLS), nx = last ? 0.f : ldbf(pp + IN_COLS);
        xs3[part] = p + W.mu[c] * (pv - p) + W.mu[RWC + c] * (nx - p);
      }
      const int c = h * 64 + lane; const long o = row * 384 + c;
      float kv = xs3[1]; float tk = kv * W.k_k[c]; float kkv = tk * __builtin_amdgcn_rsqf(wave_sum(tk * tk) + 1e-12f);
      B.r_b[o] = f2bf(xs3[0]); B.v_b[o] = f2bf(xs3[2]); B.kk_b[o] = f2bf(kkv);
#pragma unroll
      for (int d = 0; d < 2; ++d) { float a = ldbf(B.a_b + d * MA * 384 + o); B.kd_b[d * MA * 384 + o] = f2bf(kv * (1.f + (a - 1.f) * W.k_a[c])); B.bd_b[d * MA * 384 + o] = f2bf(kkv * a); }
    }
  }
  __syncthreads();
  for (int i = t; i < 384 * 32; i += 256) {
    int rr = i >> 5, w2 = i & 31; int slot = rr >> 6, d = rr & 63;
    unsigned val = *(const unsigned*)(vbuf + rr * 66 + w2 * 2);
    bf16_t* dst = slot < 4 ? B.mvT + ((long)(b * 4 + slot) * 64 + d) * RB : B.gvT + ((long)(b * 2 + (slot - 4)) * 64 + d) * RB;
    *(unsigned*)(dst + lr0 + w2 * 2) = val;
  }
  __syncthreads();
}
__global__ void __launch_bounds__(256) ok_prep_finish(FinW W, FinBuf B) {
  __shared__ __attribute__((aligned(16))) char smem[FIN_LDS_BYTES];
  for (int tile = blockIdx.x; tile < NROWS / 64; tile += gridDim.x) prep_finish_tile(W, B, tile, smem);
}
struct RdW { const float *r_k, *ln_g, *ln_b; };
__device__ __forceinline__ void rw_readout_row(const RdW& W, const float* __restrict__ y, const bf16_t* __restrict__ r_b, const bf16_t* __restrict__ v_b, const bf16_t* __restrict__ kd_b,
                                               const bf16_t* __restrict__ g_b, bf16_t* __restrict__ mixall, long row, int lane) {
  const long MA = NROWS;
#pragma unroll
  for (int h = 0; h < 6; ++h) {
    const int c = h * 64 + lane; const long o = row * 384 + c;
    float yy = y[o] + y[MA * 384 + o];
    float mean = wave_sum(yy) * (1.f / 64.f); float dv = yy - mean; float var = wave_sum(dv * dv) * (1.f / 64.f);
    float coef = wave_sum(ldbf(r_b + o) * (ldbf(kd_b + o) + ldbf(kd_b + MA * 384 + o)) * W.r_k[c]);
    float yn = dv * __builtin_amdgcn_rsqf(var + 64e-5f) * W.ln_g[c] + W.ln_b[c];
    mixall[row * DM + 256 + c] = f2bf((yn + coef * ldbf(v_b + o)) * ldbf(g_b + o));
  }
}
__global__ void __launch_bounds__(256) ok_rw_readout(RdW W, const float* y, const bf16_t* r_b, const bf16_t* v_b, const bf16_t* kd_b, const bf16_t* g_b, bf16_t* mixall) {
  for (long row = blockIdx.x * 4 + (threadIdx.x >> 6); row < NROWS; row += gridDim.x * 4) rw_readout_row(W, y, r_b, v_b, kd_b, g_b, mixall, row, threadIdx.x & 63);
}

__device__ __forceinline__ void ph_cvt_fp8_rows(const float* __restrict__ tab, unsigned char* __restrict__ q, float* __restrict__ scale, int r0 = -1, int r1 = 0) {
  const int t = tid_opaque(); const int lane = t & 63;
  const int rbeg = r0 < 0 ? (int)blockIdx.x * 4 + (t >> 6) : r0 + (t >> 6), rend = r0 < 0 ? 16384 : r1, rstep = r0 < 0 ? (int)gridDim.x * 4 : 4;
  for (int row = rbeg; row < rend; row += rstep) {
    const float* src = tab + (long)row * DM + lane * 16;
    f32x4 a[4]; float m = 0.f;
#pragma unroll
    for (int i = 0; i < 4; ++i) { a[i] = *(const f32x4*)(src + 4 * i); m = fmaxf(m, fmaxf(fmaxf(fabsf(a[i][0]), fabsf(a[i][1])), fmaxf(fabsf(a[i][2]), fabsf(a[i][3])))); }
#pragma unroll
    for (int o = 32; o > 0; o >>= 1) m = fmaxf(m, __shfl_xor(m, o));
    const float sc = m > 0.f ? m * (1.f / 440.f) : 1.f; const float inv = 1.f / sc;
    u32x4 p;
#pragma unroll
    for (int i = 0; i < 4; ++i) { int w = __builtin_amdgcn_cvt_pk_fp8_f32(a[i][0] * inv, a[i][1] * inv, 0, false); w = __builtin_amdgcn_cvt_pk_fp8_f32(a[i][2] * inv, a[i][3] * inv, w, true); p[i] = (unsigned)w; }
    *(u32x4*)(q + (long)row * DM + lane * 16) = p;
    if (lane == 0) scale[row] = sc;
  }
}
__device__ __forceinline__ float dot16_fp8(const float (&h)[16], u32x4 q) {
  float a = 0.f;
#pragma unroll
  for (int d = 0; d < 4; ++d) {
    f32v2 lo = __builtin_amdgcn_cvt_pk_f32_fp8((int)q[d], false), hi = __builtin_amdgcn_cvt_pk_f32_fp8((int)q[d], true);
    a += h[4*d] * lo[0]; a += h[4*d+1] * lo[1]; a += h[4*d+2] * hi[0]; a += h[4*d+3] * hi[1];
  }
  return a;
}
__device__ __forceinline__ void axpy16_fp8(float (&o)[16], float w, u32x4 q) {
#pragma unroll
  for (int d = 0; d < 4; ++d) {
    f32v2 lo = __builtin_amdgcn_cvt_pk_f32_fp8((int)q[d], false), hi = __builtin_amdgcn_cvt_pk_f32_fp8((int)q[d], true);
    o[4*d] += w * lo[0]; o[4*d+1] += w * lo[1]; o[4*d+2] += w * hi[0]; o[4*d+3] += w * hi[1];
  }
}
__device__ __forceinline__ void peer_gather_group_fp8(const bf16_t* __restrict__ xn, const unsigned* __restrict__ top1, const unsigned char* __restrict__ ub, const float* __restrict__ su,
                                                      const unsigned char* __restrict__ vb, const float* __restrict__ sv, const float* __restrict__ modl, float* __restrict__ xs, int grp, char* smem) {
  const int t = tid_opaque(), lane = t & 63, wave = t >> 6;
  int* pe_l = (int*)smem; float* pg_l = (float*)(smem + 32 * 128 * 4); float* pw_l = (float*)(smem + 2 * 32 * 128 * 4);
  {
    int tl = t >> 3, p = t & 7; long row = (long)grp * 32 + tl;
    peer_combine(top1 + (row * 16 + p * 2) * 16, top1 + (row * 16 + p * 2 + 1) * 16, pe_l + tl * 128 + p * 16, pg_l + tl * 128 + p * 16);
  }
  __syncthreads();
  for (int ti = 0; ti < 8; ++ti) {
    const int tl = wave * 8 + ti; const long row = (long)grp * 32 + tl;
    const int* pe = pe_l + tl * 128; float* pw = pw_l + tl * 128;
    float h[16];
    { u32x4 h0 = *(const u32x4*)(xn + row * DM + lane * 16), h1 = *(const u32x4*)(xn + row * DM + lane * 16 + 8);
#pragma unroll
      for (int e = 0; e < 4; ++e) { h[2*e] = __uint_as_float(h0[e] << 16); h[2*e+1] = __uint_as_float(h0[e] & 0xffff0000u); h[8+2*e] = __uint_as_float(h1[e] << 16); h[8+2*e+1] = __uint_as_float(h1[e] & 0xffff0000u); } }
    u32x4 u[8];
#pragma unroll
    for (int j = 0; j < 8; ++j) u[j] = *(const u32x4*)(ub + (long)pe[j] * DM + lane * 16);
    for (int b = 0; b < 16; ++b) {
      float pd[8];
#pragma unroll
      for (int j = 0; j < 8; ++j) pd[j] = dot16_fp8(h, u[j]);
      if (b + 1 < 16) {
#pragma unroll
        for (int j = 0; j < 8; ++j) u[j] = *(const u32x4*)(ub + (long)pe[(b + 1) * 8 + j] * DM + lane * 16);
      }
      float q4[4], q2[2], q1;
#pragma unroll
      for (int j = 0; j < 4; ++j) { bool hi = lane & 1; float keep = hi ? pd[2*j+1] : pd[2*j], send = hi ? pd[2*j] : pd[2*j+1]; q4[j] = keep + __shfl_xor(send, 1); }
#pragma unroll
      for (int j = 0; j < 2; ++j) { bool hi = lane & 2; float keep = hi ? q4[2*j+1] : q4[2*j], send = hi ? q4[2*j] : q4[2*j+1]; q2[j] = keep + __shfl_xor(send, 2); }
      { bool hi = lane & 4; float keep = hi ? q2[1] : q2[0], send = hi ? q2[0] : q2[1]; q1 = keep + __shfl_xor(send, 4); }
      q1 += __shfl_xor(q1, 8); q1 += __shfl_xor(q1, 16); q1 += __shfl_xor(q1, 32);
      if (lane < 8) pw[b * 8 + lane] = q1 * su[pe[b * 8 + lane]];
    }
    u32x4 v[8];
#pragma unroll
    for (int j = 0; j < 8; ++j) v[j] = *(const u32x4*)(vb + (long)pe[j] * DM + lane * 16);
    {
      float d0 = pw[lane], d1 = pw[64 + lane];
      pw[lane] = pg_l[tl * 128 + lane] * fgelu_(d0) * sv[pe[lane]]; pw[64 + lane] = pg_l[tl * 128 + 64 + lane] * fgelu_(d1) * sv[pe[64 + lane]];
    }
    float o[16];
#pragma unroll
    for (int e = 0; e < 16; ++e) o[e] = 0.f;
    for (int b = 0; b < 16; ++b) {
      u32x4 vc[8];
#pragma unroll
      for (int j = 0; j < 8; ++j) vc[j] = v[j];
      if (b + 1 < 16) {
#pragma unroll
        for (int j = 0; j < 8; ++j) v[j] = *(const u32x4*)(vb + (long)pe[(b + 1) * 8 + j] * DM + lane * 16);
      }
#pragma unroll
      for (int j = 0; j < 8; ++j) axpy16_fp8(o, pw[b * 8 + j], vc[j]);
    }
    {
      int b = row / RB, lr = row % RB; int bb = lr < SEQ ? b : BATCH; const float* g5 = modl + ((long)bb * 6 + 5) * DM + lane * 16;
      float* xr = xs + row * DM + lane * 16;
#pragma unroll
      for (int i = 0; i < 4; ++i) {
        f32x4 x = *(f32x4*)(xr + 4 * i); f32x4 g = *(const f32x4*)(g5 + 4 * i);
        x[0] += g[0] * o[4*i]; x[1] += g[1] * o[4*i+1]; x[2] += g[2] * o[4*i+2]; x[3] += g[3] * o[4*i+3];
        *(f32x4*)(xr + 4 * i) = x;
      }
    }
  }
}

__device__ __forceinline__ float reduce16(float x) { x = reduce8(x); x += dpp_get<0x140>(x); return x; }
__device__ __forceinline__ void unpack8(u32x4 v, float (&f)[8]) {
#pragma unroll
  for (int e = 0; e < 4; ++e) { f[2*e] = __uint_as_float(v[e] << 16); f[2*e+1] = __uint_as_float(v[e] & 0xffff0000u); }
}
__device__ __forceinline__ u32x4 pack8(const float (&f)[8]) { u32x4 o;
#pragma unroll
  for (int e = 0; e < 4; ++e) o[e] = pack2bf(f[2*e], f[2*e+1]);
  return o; }
__device__ __forceinline__ void ph_rope_tables(float* rope_g, float* rope_m) {
  const int t = tid_opaque();
  for (int i = blockIdx.x * 256 + t; i < SEQ * 48; i += gridDim.x * 256) {
    int lr = i / 48, j = i % 48;
    if (j < 32) { int pos = j < 16 ? lr / 64 : lr % 64; float rev = (float)pos * __builtin_amdgcn_exp2f(-(float)(j & 15) * (13.287712379549449f / 16.f)) * 0.15915494309189535f;
      rope_g[(lr * 32 + j) * 2] = __builtin_amdgcn_cosf(rev); rope_g[(lr * 32 + j) * 2 + 1] = __builtin_amdgcn_sinf(rev); }
    else { int jj = j - 32; int pos = jj < 8 ? lr / 64 : lr % 64; float rev = (float)pos * __builtin_amdgcn_exp2f(-(float)(jj & 7) * (13.287712379549449f / 8.f)) * 0.15915494309189535f;
      rope_m[(lr * 16 + jj) * 2] = __builtin_amdgcn_cosf(rev); rope_m[(lr * 16 + jj) * 2 + 1] = __builtin_amdgcn_sinf(rev); }
  }
}
struct FinW2 { const float *mla_qk_g, *gqa_qk_g, *mu, *k_k, *k_a, *rope_g, *rope_m; };
#define FIN2_LDS_BYTES (64 * 384 * 2)
struct FinRow { u32x4 gqa, mla, vraw, rw[3][3], ab[2]; uint2 tqa, tkva; unsigned tqr, kr; };
__device__ __forceinline__ void fin_row_load(FinRow& R, const FinBuf& B, long row, int lr, int lane) {
  const long MA = NROWS; const int g8 = lane & 7, h8 = lane >> 3, s16 = lane & 15, h16 = lane >> 4;
  const bf16_t* Pr = B.P + row * IN_COLS; const u32x4 z = {0u, 0u, 0u, 0u};
  const int l48 = lane < 48 ? lane : 0;
  R.gqa = *(const u32x4*)(Pr + GQA_OFF + lane * 8);
  R.mla = *(const u32x4*)(Pr + l48 * 8);
  R.tqa = *(const uint2*)(B.tq + row * 384 + h16 * 96 + s16 * 4); R.tqr = *(const unsigned*)(B.tq + row * 384 + h16 * 96 + 64 + s16 * 2);
  R.tkva = *(const uint2*)(B.tkv + row * 512 + h16 * 128 + s16 * 4);
  R.kr = *(const unsigned*)(Pr + 384 + s16 * 2);
  const bf16_t* vsrc = lane < 32 ? B.tkv + row * 512 + h8 * 128 + 64 + g8 * 8 : Pr + GQA_OFF + 512 + ((lane < 48 ? lane : 32) - 32) * 8;
  R.vraw = *(const u32x4*)vsrc;
  const bool first = (lr == 0) || (lr == SEQ), last = (lr == SEQ - 1) || (lr == RB - 1);
  const long dprev = first ? 0 : -(long)IN_COLS, dnext = last ? 0 : (long)IN_COLS;
#pragma unroll
  for (int part = 0; part < 3; ++part) {
    const bf16_t* pp = Pr + RW_OFF + part * 384 + l48 * 8;
    R.rw[part][0] = *(const u32x4*)pp; R.rw[part][1] = *(const u32x4*)(pp + dprev); R.rw[part][2] = *(const u32x4*)(pp + dnext);
  }
  const long o = row * 384 + l48 * 8;
  R.ab[0] = *(const u32x4*)(B.a_b + o); R.ab[1] = *(const u32x4*)(B.a_b + MA * 384 + o);
  (void)z;
}
__device__ __forceinline__ void prep_finish_tile2(const FinW2& W, const FinBuf& B, int tile, char* smem) {
  const int t = tid_opaque(), lane = t & 63, wave = t >> 6; const long MA = NROWS;
  bf16_t* vbuf = (bf16_t*)smem;
  const long row0 = (long)tile * 8; const int b = row0 / RB; const int lr0 = row0 % RB;
  const int g8 = lane & 7, h8 = lane >> 3, s16 = lane & 15, h16 = lane >> 4;
  FinRow RR[2];
  fin_row_load(RR[0], B, row0 + wave, lr0 + wave, lane);
  fin_row_load(RR[1], B, row0 + 4 + wave, lr0 + 4 + wave, lane);
#pragma unroll
  for (int it = 0; it < 2; ++it) {
    const FinRow& R = RR[it];
    const int rl = it * 4 + wave; const long row = row0 + rl; const int lr = lr0 + rl; const bool lat = lr < SEQ;
    {
      float x[8]; unpack8(R.gqa, x);
      float ss = 0.f;
#pragma unroll
      for (int e = 0; e < 8; ++e) ss += x[e] * x[e];
      ss = reduce8(ss); const float inv = __builtin_amdgcn_rsqf(ss * (1.f / 64.f) + EPSN);
      const float* gp = W.gqa_qk_g + (h8 < 6 ? 0 : 64) + g8 * 8; f32x4 ga = *(const f32x4*)gp, gb = *(const f32x4*)(gp + 4);
#pragma unroll
      for (int e = 0; e < 4; ++e) { x[e] *= inv * ga[e]; x[4 + e] *= inv * gb[e]; }
      float o[8];
      if (lat) {
        const float* rt = W.rope_g + ((long)lr * 32 + (g8 & 3) * 8) * 2;
#pragma unroll
        for (int e = 0; e < 8; ++e) { float ot = swz_xor4(x[e]); float cs = rt[2 * e], sn = rt[2 * e + 1]; o[e] = (g8 & 4) ? (ot * sn + x[e] * cs) : (x[e] * cs - ot * sn); }
      } else {
#pragma unroll
        for (int e = 0; e < 8; ++e) o[e] = x[e];
      }
      if (h8 < 6) {
#pragma unroll
        for (int e = 0; e < 8; ++e) o[e] *= 0.18033688f;
        *(u32x4*)(B.gq + row * 384 + lane * 8) = pack8(o);
      } else *(u32x4*)(B.gk + row * 128 + (lane - 48) * 8) = pack8(o);
    }
    float cq, ckv;
    {
      float ss = 0.f;
      { float x[8]; unpack8(R.mla, x);
#pragma unroll
        for (int e = 0; e < 8; ++e) ss += x[e] * x[e];
        if (lane >= 48) ss = 0.f; }
      float sq = wave_sum(lane < 32 ? ss : 0.f), skv = wave_sum(lane >= 32 ? ss : 0.f);
      cq = __builtin_amdgcn_rsqf(sq * (1.f / 256.f) + EPSN); ckv = __builtin_amdgcn_rsqf(skv * (1.f / 128.f) + EPSN);
    }
    {
      float cs0 = 1.f, sn0 = 0.f, cs1 = 1.f, sn1 = 0.f;
      if (lat) { f32x4 r4 = *(const f32x4*)(W.rope_m + ((long)lr * 16 + (s16 & 7) * 2) * 2); cs0 = r4[0]; sn0 = r4[1]; cs1 = r4[2]; sn1 = r4[3]; }
      const float kr0 = __uint_as_float(R.kr << 16), kr1 = __uint_as_float(R.kr & 0xffff0000u);
#pragma unroll
      for (int which = 0; which < 2; ++which) {
        float n[4], r0, r1;
        if (which == 0) {
          const uint2 a = R.tqa; const unsigned rr = R.tqr;
          n[0] = cq * __uint_as_float(a.x << 16); n[1] = cq * __uint_as_float(a.x & 0xffff0000u); n[2] = cq * __uint_as_float(a.y << 16); n[3] = cq * __uint_as_float(a.y & 0xffff0000u);
          r0 = cq * __uint_as_float(rr << 16); r1 = cq * __uint_as_float(rr & 0xffff0000u);
        } else {
          const uint2 a = R.tkva;
          n[0] = ckv * __uint_as_float(a.x << 16); n[1] = ckv * __uint_as_float(a.x & 0xffff0000u); n[2] = ckv * __uint_as_float(a.y << 16); n[3] = ckv * __uint_as_float(a.y & 0xffff0000u);
          r0 = kr0; r1 = kr1;
        }
        float ss = n[0]*n[0] + n[1]*n[1] + n[2]*n[2] + n[3]*n[3] + r0*r0 + r1*r1;
        ss = reduce16(ss); const float inv = __builtin_amdgcn_rsqf(ss * (1.f / 96.f) + EPSN);
        const float* gp = W.mla_qk_g + which * 96; f32x4 gn = *(const f32x4*)(gp + s16 * 4); const float g0 = gp[64 + s16 * 2], g1 = gp[64 + s16 * 2 + 1];
#pragma unroll
        for (int e = 0; e < 4; ++e) n[e] *= inv * gn[e];
        r0 *= inv * g0; r1 *= inv * g1;
        float o0 = dpp_get<0x128>(r0), o1 = dpp_get<0x128>(r1);
        float q0, q1;
        if (s16 & 8) { q0 = o0 * sn0 + r0 * cs0; q1 = o1 * sn1 + r1 * cs1; } else { q0 = r0 * cs0 - o0 * sn0; q1 = r1 * cs1 - o1 * sn1; }
        const float sc = which == 0 ? 0.14724445f : 1.f;
        bf16_t* dst = (which == 0 ? B.mq : B.mk) + row * 384 + h16 * 96;
        uint2 pk; pk.x = pack2bf(n[0] * sc, n[1] * sc); pk.y = pack2bf(n[2] * sc, n[3] * sc);
        *(uint2*)(dst + s16 * 4) = pk; *(unsigned*)(dst + 64 + s16 * 2) = pack2bf(q0 * sc, q1 * sc);
      }
      if (lane < 32) { float x[8]; unpack8(R.vraw, x);
#pragma unroll
        for (int e = 0; e < 8; ++e) x[e] *= ckv;
        *(u32x4*)(vbuf + rl * 384 + h8 * 64 + g8 * 8) = pack8(x); }
      else if (lane < 48) *(u32x4*)(vbuf + rl * 384 + 256 + (lane - 32) * 8) = R.vraw;
    }
    if (lane < 48) {
      const long o = row * 384 + lane * 8;
      const bool firstr = (lr == 0) || (lr == SEQ), lastr = (lr == SEQ - 1) || (lr == RB - 1);
      float xs3[3][8];
#pragma unroll
      for (int part = 0; part < 3; ++part) {
        const int c = part * 384 + lane * 8;
        const u32x4 z4 = {0u, 0u, 0u, 0u};
        float p[8], pv[8], nx[8]; unpack8(R.rw[part][0], p); unpack8(firstr ? z4 : R.rw[part][1], pv); unpack8(lastr ? z4 : R.rw[part][2], nx);
        f32x4 m0a = *(const f32x4*)(W.mu + c), m0b = *(const f32x4*)(W.mu + c + 4), m1a = *(const f32x4*)(W.mu + RWC + c), m1b = *(const f32x4*)(W.mu + RWC + c + 4);
#pragma unroll
        for (int e = 0; e < 4; ++e) { xs3[part][e] = p[e] + m0a[e] * (pv[e] - p[e]) + m1a[e] * (nx[e] - p[e]); xs3[part][4+e] = p[4+e] + m0b[e] * (pv[4+e] - p[4+e]) + m1b[e] * (nx[4+e] - p[4+e]); }
      }
      *(u32x4*)(B.r_b + o) = pack8(xs3[0]); *(u32x4*)(B.v_b + o) = pack8(xs3[2]);
      f32x4 kka = *(const f32x4*)(W.k_k + lane * 8), kkb = *(const f32x4*)(W.k_k + lane * 8 + 4), kaa = *(const f32x4*)(W.k_a + lane * 8), kab = *(const f32x4*)(W.k_a + lane * 8 + 4);
      float tk[8], ss = 0.f;
#pragma unroll
      for (int e = 0; e < 4; ++e) { tk[e] = xs3[1][e] * kka[e]; tk[4+e] = xs3[1][4+e] * kkb[e]; }
#pragma unroll
      for (int e = 0; e < 8; ++e) ss += tk[e] * tk[e];
      ss = reduce8(ss); const float invk = __builtin_amdgcn_rsqf(ss + 1e-12f);
#pragma unroll
      for (int e = 0; e < 8; ++e) tk[e] *= invk;
      *(u32x4*)(B.kk_b + o) = pack8(tk);
#pragma unroll
      for (int d = 0; d < 2; ++d) {
        float a[8], kd[8], bd[8]; unpack8(R.ab[d], a);
#pragma unroll
        for (int e = 0; e < 8; ++e) { float ka = e < 4 ? kaa[e] : kab[e - 4]; kd[e] = xs3[1][e] * (1.f + (a[e] - 1.f) * ka); bd[e] = tk[e] * a[e]; }
        *(u32x4*)(B.kd_b + d * MA * 384 + o) = pack8(kd); *(u32x4*)(B.bd_b + d * MA * 384 + o) = pack8(bd);
      }
    } else { (void)reduce8(0.f); }
  }
  __syncthreads();
  for (int i = t; i < 384; i += 256) {
    int c = i % 384, rc = i / 384;
    unsigned short v8[8];
#pragma unroll
    for (int e = 0; e < 8; ++e) v8[e] = vbuf[(rc * 8 + e) * 384 + c];
    u32x4 o; o[0] = v8[0] | ((unsigned)v8[1] << 16); o[1] = v8[2] | ((unsigned)v8[3] << 16); o[2] = v8[4] | ((unsigned)v8[5] << 16); o[3] = v8[6] | ((unsigned)v8[7] << 16);
    bf16_t* dst = c < 256 ? B.mvT + ((long)(b * 4 + (c >> 6)) * 64 + (c & 63)) * RB : B.gvT + ((long)(b * 2 + ((c - 256) >> 6)) * 64 + (c & 63)) * RB;
    *(u32x4*)(dst + lr0 + rc * 8) = o;
  }
  __syncthreads();
}
struct RdIn { u32x4 ya, yb; u32x4 r, k0, k1, v, g; };
__device__ __forceinline__ void rw_readout_load(RdIn& R, const float* __restrict__ y, const bf16_t* __restrict__ r_b, const bf16_t* __restrict__ v_b, const bf16_t* __restrict__ kd_b,
                                                const bf16_t* __restrict__ g_b, long row, int lane) {
  const long MA = NROWS; const long o = row * 384 + (lane < 48 ? lane : 0) * 8;
  R.ya = *(const u32x4*)((const bf16_t*)y + o); R.yb = *(const u32x4*)((const bf16_t*)y + MA * 384 + o);
  R.r = *(const u32x4*)(r_b + o); R.k0 = *(const u32x4*)(kd_b + o); R.k1 = *(const u32x4*)(kd_b + MA * 384 + o); R.v = *(const u32x4*)(v_b + o); R.g = *(const u32x4*)(g_b + o);
}
__device__ __forceinline__ void rw_readout_row3(const RdW& W, const RdIn& R, bf16_t* __restrict__ mixall, long row, int lane) {
  float yy[8], s = 0.f; float r[8], k0[8], k1[8], vv[8], gg[8];
  const int c = lane * 8;
  if (lane < 48) {
#pragma unroll
    for (int e = 0; e < 4; ++e) { yy[2*e] = __uint_as_float(R.ya[e] << 16) + __uint_as_float(R.yb[e] << 16); yy[2*e+1] = __uint_as_float(R.ya[e] & 0xffff0000u) + __uint_as_float(R.yb[e] & 0xffff0000u); }
    unpack8(R.r, r); unpack8(R.k0, k0); unpack8(R.k1, k1); unpack8(R.v, vv); unpack8(R.g, gg);
  } else {
#pragma unroll
    for (int e = 0; e < 8; ++e) { yy[e] = 0.f; r[e] = 0.f; k0[e] = 0.f; k1[e] = 0.f; vv[e] = 0.f; gg[e] = 0.f; }
  }
#pragma unroll
  for (int e = 0; e < 8; ++e) s += yy[e];
  const float mean = reduce8(s) * (1.f / 64.f);
  float vs = 0.f, cf = 0.f;
  const int cc = lane < 48 ? c : 0;
  f32x4 rk0 = *(const f32x4*)(W.r_k + cc), rk1 = *(const f32x4*)(W.r_k + cc + 4);
#pragma unroll
  for (int e = 0; e < 8; ++e) { float d = yy[e] - mean; vs += d * d; cf += r[e] * (k0[e] + k1[e]) * (e < 4 ? rk0[e] : rk1[e - 4]); }
  const float var = reduce8(vs) * (1.f / 64.f), coef = reduce8(cf);
  const float inv = __builtin_amdgcn_rsqf(var + 64e-5f);
  if (lane < 48) {
    f32x4 lg0 = *(const f32x4*)(W.ln_g + c), lg1 = *(const f32x4*)(W.ln_g + c + 4), lb0 = *(const f32x4*)(W.ln_b + c), lb1 = *(const f32x4*)(W.ln_b + c + 4);
    float out[8];
#pragma unroll
    for (int e = 0; e < 8; ++e) { float yn = (yy[e] - mean) * inv * (e < 4 ? lg0[e] : lg1[e - 4]) + (e < 4 ? lb0[e] : lb1[e - 4]); out[e] = (yn + coef * vv[e]) * gg[e]; }
    *(u32x4*)(mixall + row * DM + 256 + c) = pack8(out);
  }
}
__device__ __forceinline__ void ph_readout(const RdW& W, const float* __restrict__ y, const bf16_t* __restrict__ r_b, const bf16_t* __restrict__ v_b, const bf16_t* __restrict__ kd_b,
                                           const bf16_t* __restrict__ g_b, bf16_t* __restrict__ mixall, bool skip_ctx) {
  const int t = tid_opaque(); const int lane = t & 63;
  const long nidx = skip_ctx ? (long)BATCH * SEQ : (long)NROWS; const long stride = (long)gridDim.x * 4;
  RdIn cur, nxt;
  long idx = (long)blockIdx.x * 4 + (t >> 6);
  if (idx < nidx) rw_readout_load(cur, y, r_b, v_b, kd_b, g_b, skip_ctx ? (idx / SEQ) * RB + idx % SEQ : idx, lane);
  for (; idx < nidx; idx += stride) {
    const long in = idx + stride < nidx ? idx + stride : idx;
    rw_readout_load(nxt, y, r_b, v_b, kd_b, g_b, skip_ctx ? (in / SEQ) * RB + in % SEQ : in, lane);
    rw_readout_row3(W, cur, mixall, skip_ctx ? (idx / SEQ) * RB + idx % SEQ : idx, lane);
    cur = nxt;
  }
}
__device__ __forceinline__ void rw_readout_row2(const RdW& W, const float* __restrict__ y, const bf16_t* __restrict__ r_b, const bf16_t* __restrict__ v_b, const bf16_t* __restrict__ kd_b,
                                                const bf16_t* __restrict__ g_b, bf16_t* __restrict__ mixall, long row, int lane) {
  const long MA = NROWS;
  float yy[8], s = 0.f; float r[8], k0[8], k1[8], vv[8], gg[8];
  const int c = lane * 8; const long o = row * 384 + c;
  if (lane < 48) {
    f32x4 a0 = *(const f32x4*)(y + o), a1 = *(const f32x4*)(y + o + 4), b0 = *(const f32x4*)(y + MA * 384 + o), b1 = *(const f32x4*)(y + MA * 384 + o + 4);
#pragma unroll
    for (int e = 0; e < 4; ++e) { yy[e] = a0[e] + b0[e]; yy[4+e] = a1[e] + b1[e]; }
    unpack8(*(const u32x4*)(r_b + o), r); unpack8(*(const u32x4*)(kd_b + o), k0); unpack8(*(const u32x4*)(kd_b + MA * 384 + o), k1);
    unpack8(*(const u32x4*)(v_b + o), vv); unpack8(*(const u32x4*)(g_b + o), gg);
  } else {
#pragma unroll
    for (int e = 0; e < 8; ++e) { yy[e] = 0.f; r[e] = 0.f; k0[e] = 0.f; k1[e] = 0.f; vv[e] = 0.f; gg[e] = 0.f; }
  }
#pragma unroll
  for (int e = 0; e < 8; ++e) s += yy[e];
  const float mean = reduce8(s) * (1.f / 64.f);
  float vs = 0.f, cf = 0.f;
  const int cc = lane < 48 ? c : 0;
  f32x4 rk0 = *(const f32x4*)(W.r_k + cc), rk1 = *(const f32x4*)(W.r_k + cc + 4);
#pragma unroll
  for (int e = 0; e < 8; ++e) { float d = yy[e] - mean; vs += d * d; cf += r[e] * (k0[e] + k1[e]) * (e < 4 ? rk0[e] : rk1[e - 4]); }
  const float var = reduce8(vs) * (1.f / 64.f), coef = reduce8(cf);
  const float inv = __builtin_amdgcn_rsqf(var + 64e-5f);
  if (lane < 48) {
    f32x4 lg0 = *(const f32x4*)(W.ln_g + c), lg1 = *(const f32x4*)(W.ln_g + c + 4), lb0 = *(const f32x4*)(W.ln_b + c), lb1 = *(const f32x4*)(W.ln_b + c + 4);
    float out[8];
#pragma unroll
    for (int e = 0; e < 8; ++e) { float yn = (yy[e] - mean) * inv * (e < 4 ? lg0[e] : lg1[e - 4]) + (e < 4 ? lb0[e] : lb1[e - 4]); out[e] = (yn + coef * vv[e]) * gg[e]; }
    *(u32x4*)(mixall + row * DM + 256 + c) = pack8(out);
  }
}

#define PG_NT 4
#define PG_TOK (4 * PG_NT)
#define PG_OFF_H 0
#define PG_OFF_E (PG_TOK * 2048)
#define PG_OFF_G (PG_OFF_E + PG_TOK * 128 * 2)
#define PG_OFF_ST (PG_OFF_G + PG_TOK * 128 * 4)
#define PG_OFF_CNT (PG_OFF_ST + PG_TOK * 18 * 2)
#define PG_LDS_BYTES (PG_OFF_CNT + PG_TOK * 8 * 16 * 2)
__device__ __forceinline__ long pg_row(int g, int ntok) { return ntok == NROWS ? (long)g : (long)(g / SEQ) * RB + (g % SEQ); }
__device__ __forceinline__ void peer_gather_sliced(const bf16_t* __restrict__ xn, const unsigned* __restrict__ top1, const unsigned char* __restrict__ ub, const float* __restrict__ su,
                                                   const unsigned char* __restrict__ vb, const float* __restrict__ sv, const float* __restrict__ modl, float* __restrict__ xs,
                                                   int ntok, char* smem, const float* __restrict__ ng, const float* __restrict__ nmod, bf16_t* __restrict__ xn_next, float* __restrict__ out, bool dry = false, unsigned emask = 0x3FFFu) {
  bf16_t* hs = (bf16_t*)(smem + PG_OFF_H); unsigned short* se = (unsigned short*)(smem + PG_OFF_E); float* sg = (float*)(smem + PG_OFF_G);
  unsigned short* sst = (unsigned short*)(smem + PG_OFF_ST); unsigned short* cnt = (unsigned short*)(smem + PG_OFF_CNT);
  const int per_block = (ntok + (int)gridDim.x - 1) / (int)gridDim.x;
  const int npass = (per_block + PG_TOK - 1) / PG_TOK; const int tpp = (per_block + npass - 1) / npass;
  for (int pass = 0; pass < npass; ++pass) {
    const int t = tid_opaque(), lane = t & 63, wave = t >> 6;
    __syncthreads();
    for (int i = t; i < PG_TOK * 8 * 16; i += 256) cnt[i] = 0;
    for (int i = t; i < PG_TOK * 128; i += 256) {
      int tl = i >> 7, ch = i & 127; int q = (tl % PG_NT) * 4 + tl / PG_NT; int idx = pass * tpp + q; int g = (int)blockIdx.x + idx * (int)gridDim.x;
      u32x4 v = {0u, 0u, 0u, 0u};
      if (q < tpp && idx < per_block && g < ntok) v = *(const u32x4*)(xn + pg_row(g, ntok) * DM + ch * 8);
      *(u32x4*)(hs + tl * 1024 + ch * 8) = v;
    }
    __syncthreads();
    int my_e[16]; float my_g[16];
    const int ctl = t >> 3, cp = t & 7;
    bool cact = false;
    if (ctl < PG_TOK) {
      int q = (ctl % PG_NT) * 4 + ctl / PG_NT; int idx = pass * tpp + q; int g = (int)blockIdx.x + idx * (int)gridDim.x;
      cact = q < tpp && idx < per_block && g < ntok;
      if (cact) {
        long row = pg_row(g, ntok);
        peer_combine(top1 + (row * 16 + cp * 2) * 16, top1 + (row * 16 + cp * 2 + 1) * 16, my_e, my_g);
#pragma unroll
        for (int k = 0; k < 16; ++k) cnt[(ctl * 8 + cp) * 16 + (my_e[k] >> 10)] += 1;
      }
    }
    __syncthreads();
    if (t < PG_TOK) {
      int run = 0;
      for (int s = 0; s < 16; ++s) {
        sst[t * 18 + s] = (unsigned short)run;
        for (int h = 0; h < 8; ++h) { int c = cnt[(t * 8 + h) * 16 + s]; cnt[(t * 8 + h) * 16 + s] = (unsigned short)run; run += c; }
      }
      sst[t * 18 + 16] = (unsigned short)run;
    }
    __syncthreads();
    if (cact) {
#pragma unroll
      for (int k = 0; k < 16; ++k) { int s = my_e[k] >> 10; int pos = cnt[(ctl * 8 + cp) * 16 + s]; cnt[(ctl * 8 + cp) * 16 + s] = (unsigned short)(pos + 1); se[ctl * 128 + pos] = (unsigned short)my_e[k]; sg[ctl * 128 + pos] = my_g[k]; }
    }
    __syncthreads();
    float acc[PG_NT][16];
#pragma unroll
    for (int tk = 0; tk < PG_NT; ++tk)
#pragma unroll
      for (int e = 0; e < 16; ++e) acc[tk][e] = 0.f;
    for (int s = 0; s < 16; ++s) {
#pragma unroll
      for (int tk = 0; tk < PG_NT; ++tk) {
        const int tl = wave * PG_NT + tk;
        const int st = sst[tl * 18 + s], en = sst[tl * 18 + s + 1];
        for (int base = st; base < en; base += 8) {
          const int nb = en - base < 8 ? en - base : 8;
          u32x4 u[8], v[8];
#pragma unroll
          for (int j = 0; j < 8; ++j) if (j < nb) { const unsigned off = ((unsigned)se[tl * 128 + base + j] & emask) * 1024u + (unsigned)lane * 16u; u[j] = *(const u32x4*)(ub + off); v[j] = *(const u32x4*)(vb + off); }
          float h[16];
          { u32x4 h0 = *(const u32x4*)(hs + tl * 1024 + lane * 16), h1 = *(const u32x4*)(hs + tl * 1024 + lane * 16 + 8);
#pragma unroll
            for (int e = 0; e < 4; ++e) { h[2*e] = __uint_as_float(h0[e] << 16); h[2*e+1] = __uint_as_float(h0[e] & 0xffff0000u); h[8+2*e] = __uint_as_float(h1[e] << 16); h[8+2*e+1] = __uint_as_float(h1[e] & 0xffff0000u); } }
          float pd[8];
#pragma unroll
          for (int j = 0; j < 8; ++j) pd[j] = j < nb ? dot16_fp8(h, u[j]) : 0.f;
          float q4[4], q2[2], q1;
#pragma unroll
          for (int j = 0; j < 4; ++j) { bool hi = lane & 1; float keep = hi ? pd[2*j+1] : pd[2*j], send = hi ? pd[2*j] : pd[2*j+1]; q4[j] = keep + dpp_get<0xB1>(send); }
#pragma unroll
          for (int j = 0; j < 2; ++j) { bool hi = lane & 2; float keep = hi ? q4[2*j+1] : q4[2*j], send = hi ? q4[2*j] : q4[2*j+1]; q2[j] = keep + dpp_get<0x4E>(send); }
          { bool hi = lane & 4; float keep = hi ? q2[1] : q2[0], send = hi ? q2[0] : q2[1]; q1 = keep + xor4_get(send); }
          q1 += dpp_get<0x128>(q1);
          q1 = xor16_sum(q1);
          q1 = xor32_sum(q1);
          float w = 0.f;
          { const int jj = lane & 7; if (jj < nb) { int e = se[tl * 128 + base + jj]; w = sg[tl * 128 + base + jj] * fgelu_(q1 * su[e]) * sv[e]; } }
#pragma unroll
          for (int j = 0; j < 8; ++j) { float wj = __builtin_bit_cast(float, __builtin_amdgcn_readlane(__builtin_bit_cast(int, w), j)); if (j < nb) axpy16_fp8(acc[tk], wj, v[j]); }
        }
      }
    }
    if (dry) {
#pragma unroll
      for (int tk = 0; tk < PG_NT; ++tk)
#pragma unroll
        for (int e = 0; e < 16; ++e) asm volatile("" :: "v"(acc[tk][e]));
    }
#pragma unroll
    for (int tk = 0; tk < PG_NT; ++tk) {
      int q = tk * 4 + wave; int idx = pass * tpp + q; int g = (int)blockIdx.x + idx * (int)gridDim.x;
      if (!dry && q < tpp && idx < per_block && g < ntok) {
        long row = pg_row(g, ntok); int b = row / RB, lr = row % RB; int bb = lr < SEQ ? b : BATCH; const float* g5 = modl + ((long)bb * 6 + 5) * DM + lane * 16;
        float* xr = xs + row * DM + lane * 16;
        f32x4 xv[4]; float ss = 0.f;
#pragma unroll
        for (int i = 0; i < 4; ++i) {
          f32x4 x = *(f32x4*)(xr + 4 * i); f32x4 gg = *(const f32x4*)(g5 + 4 * i);
          x[0] += gg[0] * acc[tk][4*i]; x[1] += gg[1] * acc[tk][4*i+1]; x[2] += gg[2] * acc[tk][4*i+2]; x[3] += gg[3] * acc[tk][4*i+3];
          xv[i] = x; ss += x[0] * x[0] + x[1] * x[1] + x[2] * x[2] + x[3] * x[3];
        }
        if (out) {
          float* orow = out + ((long)b * SEQ + lr) * DM + lane * 16;
#pragma unroll
          for (int i = 0; i < 4; ++i) *(f32x4*)(orow + 4 * i) = xv[i];
        } else {
#pragma unroll
          for (int i = 0; i < 4; ++i) *(f32x4*)(xr + 4 * i) = xv[i];
          ss = wave_sum(ss); const float inv = __builtin_amdgcn_rsqf(ss * (1.f / DM) + EPSN);
          const float* sh = nmod + ((long)bb * 6 + 0) * DM + lane * 16; const float* sc = sh + DM; const float* gp = ng + lane * 16;
          u32x4 p0, p1;
#pragma unroll
          for (int i = 0; i < 4; ++i) { f32x4 g4 = *(const f32x4*)(gp + 4 * i), s4 = *(const f32x4*)(sc + 4 * i), h4 = *(const f32x4*)(sh + 4 * i);
            const float a0 = xv[i][0] * inv * g4[0] * (1.f + s4[0]) + h4[0], a1 = xv[i][1] * inv * g4[1] * (1.f + s4[1]) + h4[1];
            const float a2 = xv[i][2] * inv * g4[2] * (1.f + s4[2]) + h4[2], a3 = xv[i][3] * inv * g4[3] * (1.f + s4[3]) + h4[3];
            if (i < 2) { p0[2 * i] = pack2bf(a0, a1); p0[2 * i + 1] = pack2bf(a2, a3); } else { p1[2 * (i - 2)] = pack2bf(a0, a1); p1[2 * (i - 2) + 1] = pack2bf(a2, a3); } }
          *(u32x4*)(xn_next + row * DM + lane * 16) = p0; *(u32x4*)(xn_next + row * DM + lane * 16 + 8) = p1;
        }
      }
    }
  }
}

#define PG3_OFF_H 0
#define PG3_LST 512
#define PG3_OFF_FE (16 * 2048)
#define PG3_OFF_FG (PG3_OFF_FE + 4 * PG3_LST * 2)
#define PG3_OFF_FS (PG3_OFF_FG + 4 * PG3_LST * 4)
#define PG3_OFF_BT (PG3_OFF_FS + 4 * PG3_LST * 4)
#define PG3_OFF_CNT (PG3_OFF_BT + 4 * 160 * 4)
#define PG3_OFF_TOT (PG3_OFF_CNT + 4 * 512 * 2)
#define PG3_LDS_BYTES (PG3_OFF_TOT + 512)
#define PG3_REC_BYTES (PG3_LST * 2 + PG3_LST * 4 + PG3_LST * 4 + 160 * 4 + 16)
template <int NT>
__device__ __forceinline__ void peer_lists_build3(const unsigned* __restrict__ top1, const float* __restrict__ su, const float* __restrict__ sv, char* __restrict__ gl, int ntok, char* smem,
                                                  int pass_begin = 0, int pass_end = 1 << 20, bool fused = false, const bf16_t* __restrict__ xn = nullptr) {
  unsigned short* fe = (unsigned short*)(smem + PG3_OFF_FE); float* fg = (float*)(smem + PG3_OFF_FG); float* fs = (float*)(smem + PG3_OFF_FS);
  unsigned* bt = (unsigned*)(smem + PG3_OFF_BT); unsigned short* cnt = (unsigned short*)(smem + PG3_OFF_CNT); unsigned short* tot = (unsigned short*)(smem + PG3_OFF_TOT);
  int* nbt = (int*)(smem + PG3_OFF_TOT + 320);
  const int per_block = (ntok + (int)gridDim.x - 1) / (int)gridDim.x;
  const int npass = (per_block + 4 * NT - 1) / (4 * NT); const int tpp = (per_block + npass - 1) / npass;
  char* st_base = fused ? gl + ((long)blockIdx.x * 4 + 1) * 4 * PG3_REC_BYTES : smem + PG3_OFF_H;
  unsigned short* st_e = (unsigned short*)st_base; float* st_g = (float*)(st_base + 2 * (32 * NT) * 16 * 2);
  const bool pre = npass <= 3;
  int my_e[16]; float my_g[16];
#pragma unroll
  for (int k = 0; k < 16; ++k) { my_e[k] = 0; my_g[k] = 0.f; }
  if (pre && pass_begin == 0) {
    const int t = tid_opaque();
    __syncthreads();
    for (int j = t; j < npass * (32 * NT); j += 256) {
      const int pj = j / (32 * NT), rem = j % (32 * NT); const int ctl = rem >> 3, cp = rem & 7; const int cw = ctl / NT, ctk = ctl % NT;
      const int q = ctk * 4 + cw; const int idx = pj * tpp + q; const int g = (int)blockIdx.x + idx * (int)gridDim.x;
      if (q < tpp && idx < per_block && g < ntok) {
        int e_[16]; float g_[16];
        const long row = pg_row(g, ntok);
        peer_combine(top1 + (row * 16 + cp * 2) * 16, top1 + (row * 16 + cp * 2 + 1) * 16, e_, g_);
        if (pj == 0) {
#pragma unroll
          for (int k = 0; k < 16; ++k) { my_e[k] = e_[k]; my_g[k] = g_[k]; }
        } else {
          const int sj = (pj - 1) * (32 * NT) + rem;
#pragma unroll
          for (int k = 0; k < 16; ++k) { st_e[sj * 16 + k] = (unsigned short)e_[k]; st_g[sj * 16 + k] = g_[k]; }
        }
      }
    }
  }
  for (int pass = pass_begin; pass < pass_end && pass < npass; ++pass) {
    const int t = tid_opaque();
    u32x4 hreg[2 * NT];
    if (fused) {
#pragma unroll
      for (int u = 0; u < 2 * NT; ++u) {
        const int i = t + 256 * u; const int tl = i >> 7, ch = i & 127; const int q = (tl % NT) * 4 + (tl / NT); const int idx = pass * tpp + q; const int g = (int)blockIdx.x + idx * (int)gridDim.x;
        const bool ok = q < tpp && idx < per_block && g < ntok;
        hreg[u] = *(const u32x4*)(xn + pg_row(ok ? g : (int)blockIdx.x, ntok) * DM + ch * 8);
      }
    }
    __syncthreads();
    for (int i = t; i < 4 * 512; i += 256) cnt[i] = 0;
    __syncthreads();
    const int ctl = t >> 3, cp = t & 7; const int cw = ctl / NT, ctk = ctl % NT;
    bool cact = false;
    float my_su[16], my_sv[16];
    if (ctl < 4 * NT) {
      int q = ctk * 4 + cw; int idx = pass * tpp + q; int g = (int)blockIdx.x + idx * (int)gridDim.x;
      cact = q < tpp && idx < per_block && g < ntok;
      if (cact) {
        if (!pre) {
          long row = pg_row(g, ntok);
          peer_combine(top1 + (row * 16 + cp * 2) * 16, top1 + (row * 16 + cp * 2 + 1) * 16, my_e, my_g);
        } else if (pass > 0) {
          const int sj = (pass - 1) * (32 * NT) + t;
#pragma unroll
          for (int k = 0; k < 16; ++k) { my_e[k] = st_e[sj * 16 + k]; my_g[k] = st_g[sj * 16 + k]; }
        }
#pragma unroll
        for (int k = 0; k < 16; ++k) { my_su[k] = su[my_e[k]]; my_sv[k] = sv[my_e[k]]; }
#pragma unroll
        for (int k = 0; k < 16; ++k) cnt[((cw * 16 + (my_e[k] >> 10)) * 4 + ctk) * 8 + cp] += 1;
      }
    }
    __syncthreads();
    unsigned short* tot2 = tot + 80;
    if (t < 64) {
      int w_ = t >> 4, s = t & 15; int ne = 0, nbk = 0;
      for (int tk = 0; tk < NT; ++tk) { int n = 0; for (int h = 0; h < 8; ++h) n += cnt[((w_ * 16 + s) * 4 + tk) * 8 + h]; ne += n; nbk += (n + 7) >> 3; }
      tot[w_ * 16 + s] = (unsigned short)ne; tot2[w_ * 16 + s] = (unsigned short)nbk;
    }
    __syncthreads();
    if (t < 64) {
      int w_ = t >> 4, s = t & 15; int run = 0, nb_ = 0;
      for (int i = 0; i < s; ++i) { run += tot[w_ * 16 + i]; nb_ += tot2[w_ * 16 + i]; }
      for (int tk = 0; tk < NT; ++tk) {
        int gstart = run;
        for (int h = 0; h < 8; ++h) { int ci = ((w_ * 16 + s) * 4 + tk) * 8 + h; int c = cnt[ci]; cnt[ci] = (unsigned short)run; run += c; }
        for (int b0 = gstart; b0 < run; b0 += 8) { int n = run - b0 < 8 ? run - b0 : 8; bt[w_ * 160 + nb_] = (unsigned)tk | ((unsigned)b0 << 4) | ((unsigned)n << 16); ++nb_; }
      }
      if (s == 15) { while (nb_ % 3) { bt[w_ * 160 + nb_] = 0u; ++nb_; } nbt[w_] = nb_; }
    }
    __syncthreads();
    if (cact) {
#pragma unroll
      for (int k = 0; k < 16; ++k) { int ci = ((cw * 16 + (my_e[k] >> 10)) * 4 + ctk) * 8 + cp; int pos = cnt[ci]; cnt[ci] = (unsigned short)(pos + 1);
        fe[cw * PG3_LST + pos] = (unsigned short)my_e[k]; fg[cw * PG3_LST + pos] = my_g[k] * my_sv[k]; fs[cw * PG3_LST + pos] = my_su[k]; }
    }
    __syncthreads();
    if (fused) {
      bf16_t* hs = (bf16_t*)(smem + PG3_OFF_H);
#pragma unroll
      for (int u = 0; u < 2 * NT; ++u) {
        const int i = t + 256 * u; const int tl = i >> 7, ch = i & 127; const int q = (tl % NT) * 4 + (tl / NT); const int idx = pass * tpp + q; const int g = (int)blockIdx.x + idx * (int)gridDim.x;
        const bool ok = q < tpp && idx < per_block && g < ntok;
        u32x4 v = hreg[u]; if (!ok) v = (u32x4){0u, 0u, 0u, 0u};
        *(u32x4*)(hs + tl * 1024 + ch * 8) = v;
      }
      continue;
    }
    char* rec = gl + ((long)blockIdx.x * 4 + pass) * 4 * PG3_REC_BYTES;
    for (int i = t; i < 4 * 64; i += 256) { int w_ = i / 64, c = i % 64; *(u32x4*)(rec + w_ * PG3_REC_BYTES + c * 16) = *(const u32x4*)((const char*)fe + w_ * 1024 + c * 16); }
    for (int i = t; i < 4 * 128; i += 256) { int w_ = i / 128, c = i % 128; *(u32x4*)(rec + w_ * PG3_REC_BYTES + 1024 + c * 16) = *(const u32x4*)((const char*)fg + w_ * 2048 + c * 16); }
    for (int i = t; i < 4 * 128; i += 256) { int w_ = i / 128, c = i % 128; *(u32x4*)(rec + w_ * PG3_REC_BYTES + 3072 + c * 16) = *(const u32x4*)((const char*)fs + w_ * 2048 + c * 16); }
    for (int i = t; i < 4 * 40; i += 256) { int w_ = i / 40, c = i % 40; *(u32x4*)(rec + w_ * PG3_REC_BYTES + 5120 + c * 16) = *(const u32x4*)((const char*)bt + w_ * 640 + c * 16); }
    if (t < 4) *(int*)(rec + t * PG3_REC_BYTES + 5760) = nbt[t];
  }
  __syncthreads();
}
__device__ __forceinline__ void pg3_issue(u32x4 (&B)[8], const unsigned char* __restrict__ tab, const unsigned short* we, unsigned desc, int lane) {
  const int base = (desc >> 4) & 0xFFF, nb = desc >> 16;
#pragma unroll
  for (int j = 0; j < 8; ++j) { const int jj = j < nb ? j : (nb > 0 ? nb - 1 : 0); const unsigned off = (unsigned)we[base + jj] * 1024u + (unsigned)lane * 16u; B[j] = *(const u32x4*)(tab + off); }
}
__device__ __forceinline__ void pg3_axpy8(float (&a)[16], const u32x4 (&V)[8], float w, int nb) {
#pragma unroll
  for (int j = 0; j < 8; ++j) { const float wj = __builtin_bit_cast(float, __builtin_amdgcn_readlane(__builtin_bit_cast(int, w), j)); if (j < nb) axpy16_fp8(a, wj, V[j]); }
}
template <int NT>
__device__ __forceinline__ void pg3_step(u32x4 (&U)[8], u32x4 (&V)[8], u32x4 (&F)[8], int k, int nbat, float (&acc)[NT][16],
                                         const unsigned char* __restrict__ ub, const unsigned char* __restrict__ vb,
                                         const unsigned short* we, const float* wg, const float* wsc, const unsigned* wb, const bf16_t* hw, int lane) {
  const unsigned desc = __builtin_amdgcn_readfirstlane(wb[k]);
  const int tk = desc & 15, base = (desc >> 4) & 0xFFF, nb = desc >> 16;
  const unsigned dnext = __builtin_amdgcn_readfirstlane(wb[k + 1 < nbat ? k + 1 : k]);
  pg3_issue(F, ub, we, dnext, lane);
  float h[16];
  { const bf16_t* hp = hw + tk * 1024 + lane * 16; u32x4 h0 = *(const u32x4*)hp, h1 = *(const u32x4*)(hp + 8);
#pragma unroll
    for (int e = 0; e < 4; ++e) { h[2*e] = __uint_as_float(h0[e] << 16); h[2*e+1] = __uint_as_float(h0[e] & 0xffff0000u); h[8+2*e] = __uint_as_float(h1[e] << 16); h[8+2*e+1] = __uint_as_float(h1[e] & 0xffff0000u); } }
  float pd[8];
#pragma unroll
  for (int j = 0; j < 8; ++j) { pd[j] = 0.f; if (j < nb) { asm volatile(""); pd[j] = dot16_fp8(h, U[j]); } }
  pg3_issue(U, vb, we, dnext, lane);
  float q4[4], q2[2], q1;
#pragma unroll
  for (int j = 0; j < 4; ++j) { bool hi = lane & 1; float keep = hi ? pd[2*j+1] : pd[2*j], send = hi ? pd[2*j] : pd[2*j+1]; q4[j] = keep + dpp_get<0xB1>(send); }
#pragma unroll
  for (int j = 0; j < 2; ++j) { bool hi = lane & 2; float keep = hi ? q4[2*j+1] : q4[2*j], send = hi ? q4[2*j] : q4[2*j+1]; q2[j] = keep + dpp_get<0x4E>(send); }
  { bool hi = lane & 4; float keep = hi ? q2[1] : q2[0], send = hi ? q2[0] : q2[1]; q1 = keep + xor4_get(send); }
  q1 += dpp_get<0x128>(q1);
  q1 = xor16_sum(q1);
  q1 = xor32_sum(q1);
  float w = 0.f;
  { const int jj = lane & 7; if (jj < nb) w = wg[base + jj] * fgelu_(q1 * wsc[base + jj]); }
  if (tk == 0) pg3_axpy8(acc[0], V, w, nb); else if (tk == 1) pg3_axpy8(acc[1], V, w, nb); else if (NT == 3 || tk == 2) pg3_axpy8(acc[2], V, w, nb); else pg3_axpy8(acc[NT - 1], V, w, nb);
}
template <int NT>
__device__ __forceinline__ void peer_gather_sweep3(const bf16_t* __restrict__ xn, const char* __restrict__ gl, const unsigned char* __restrict__ ub,
                                                   const unsigned char* __restrict__ vb, const float* __restrict__ modl, float* __restrict__ xs, int ntok, char* smem,
                                                   const float* __restrict__ ng, const float* __restrict__ nmod, bf16_t* __restrict__ xn_next, float* __restrict__ out,
                                                   int pass_begin, int pass_end, bool fused = false) {
  bf16_t* hs = (bf16_t*)(smem + PG3_OFF_H); unsigned short* fe = (unsigned short*)(smem + PG3_OFF_FE); float* fg = (float*)(smem + PG3_OFF_FG); float* fs = (float*)(smem + PG3_OFF_FS);
  unsigned* bt = (unsigned*)(smem + PG3_OFF_BT); int* nbt = (int*)(smem + PG3_OFF_TOT + 320);
  const int per_block = (ntok + (int)gridDim.x - 1) / (int)gridDim.x;
  const int npass = (per_block + 4 * NT - 1) / (4 * NT); const int tpp = (per_block + npass - 1) / npass;
  for (int pass = pass_begin; pass < pass_end && pass < npass; ++pass) {
    {
      const int t = tid_opaque();
      __syncthreads();
      if (!fused) {
      const char* rec = gl + ((long)blockIdx.x * 4 + pass) * 4 * PG3_REC_BYTES;
      for (int i = t; i < 4 * 64; i += 256) { int w_ = i / 64, c = i % 64; *(u32x4*)((char*)fe + w_ * 1024 + c * 16) = *(const u32x4*)(rec + w_ * PG3_REC_BYTES + c * 16); }
      for (int i = t; i < 4 * 128; i += 256) { int w_ = i / 128, c = i % 128; *(u32x4*)((char*)fg + w_ * 2048 + c * 16) = *(const u32x4*)(rec + w_ * PG3_REC_BYTES + 1024 + c * 16); }
      for (int i = t; i < 4 * 128; i += 256) { int w_ = i / 128, c = i % 128; *(u32x4*)((char*)fs + w_ * 2048 + c * 16) = *(const u32x4*)(rec + w_ * PG3_REC_BYTES + 3072 + c * 16); }
      for (int i = t; i < 4 * 40; i += 256) { int w_ = i / 40, c = i % 40; *(u32x4*)((char*)bt + w_ * 640 + c * 16) = *(const u32x4*)(rec + w_ * PG3_REC_BYTES + 5120 + c * 16); }
      if (t < 4) nbt[t] = *(const int*)(rec + t * PG3_REC_BYTES + 5760);
      }
      if (!fused) {
      for (int i = t; i < 4 * NT * 128; i += 256) {
        int tl = i >> 7, ch = i & 127; int q = (tl % NT) * 4 + (tl / NT); int idx = pass * tpp + q; int g = (int)blockIdx.x + idx * (int)gridDim.x;
        u32x4 v = {0u, 0u, 0u, 0u};
        if (q < tpp && idx < per_block && g < ntok) v = *(const u32x4*)(xn + pg_row(g, ntok) * DM + ch * 8);
        *(u32x4*)(hs + tl * 1024 + ch * 8) = v;
      }
      }
      __syncthreads();
    }
    const int t_s = tid_opaque(); const int lane = t_s & 63, wave = t_s >> 6;
    float acc[NT][16];
#pragma unroll
    for (int tk = 0; tk < NT; ++tk)
#pragma unroll
      for (int e = 0; e < 16; ++e) acc[tk][e] = 0.f;
    const int nbat = nbt[wave];
    const unsigned short* we = fe + wave * PG3_LST; const float* wg = fg + wave * PG3_LST; const float* wsc = fs + wave * PG3_LST; const unsigned* wb = bt + wave * 160;
    const bf16_t* hw = hs + wave * NT * 1024;
    u32x4 X[8], Y[8], Z[8];
    if (nbat > 0) { const unsigned d0 = __builtin_amdgcn_readfirstlane(wb[0]); pg3_issue(X, ub, we, d0, lane); pg3_issue(Y, vb, we, d0, lane); }
    for (int k = 0; k < nbat; k += 3) {
      pg3_step<NT>(X, Y, Z, k, nbat, acc, ub, vb, we, wg, wsc, wb, hw, lane);
      pg3_step<NT>(Z, X, Y, k + 1, nbat, acc, ub, vb, we, wg, wsc, wb, hw, lane);
      pg3_step<NT>(Y, Z, X, k + 2, nbat, acc, ub, vb, we, wg, wsc, wb, hw, lane);
    }
    f32x4 ex[NT][4];
#pragma unroll
    for (int tk = 0; tk < NT; ++tk) {
      int q = tk * 4 + wave; int idx = pass * tpp + q; int g = (int)blockIdx.x + idx * (int)gridDim.x;
      const bool act_ = q < tpp && idx < per_block && g < ntok;
      long row = pg_row(act_ ? g : (int)blockIdx.x, ntok); int b = row / RB, lr = row % RB; int bb = lr < SEQ ? b : BATCH;
      const float* xr = xs + row * DM + lane * 16; (void)bb;
#pragma unroll
      for (int i = 0; i < 4; ++i) ex[tk][i] = *(const f32x4*)(xr + 4 * i);
    }
#pragma unroll
    for (int tk = 0; tk < NT; ++tk) {
      int q = tk * 4 + wave; int idx = pass * tpp + q; int g = (int)blockIdx.x + idx * (int)gridDim.x;
      if (q < tpp && idx < per_block && g < ntok) {
        long row = pg_row(g, ntok); int b = row / RB, lr = row % RB; int bb = lr < SEQ ? b : BATCH; const float* g5 = modl + ((long)bb * 6 + 5) * DM + lane * 16;
        float* xr = xs + row * DM + lane * 16;
        f32x4 xv[4]; float ss = 0.f;
#pragma unroll
        for (int i = 0; i < 4; ++i) {
          f32x4 x = ex[tk][i]; f32x4 gg = *(const f32x4*)(g5 + 4 * i);
          x[0] += gg[0] * acc[tk][4*i]; x[1] += gg[1] * acc[tk][4*i+1]; x[2] += gg[2] * acc[tk][4*i+2]; x[3] += gg[3] * acc[tk][4*i+3];
          xv[i] = x; ss += x[0] * x[0] + x[1] * x[1] + x[2] * x[2] + x[3] * x[3];
        }
        if (out) {
          float* orow = out + ((long)b * SEQ + lr) * DM + lane * 16;
#pragma unroll
          for (int i = 0; i < 4; ++i) *(f32x4*)(orow + 4 * i) = xv[i];
        } else {
#pragma unroll
          for (int i = 0; i < 4; ++i) *(f32x4*)(xr + 4 * i) = xv[i];
          ss = wave_sum(ss); const float inv = __builtin_amdgcn_rsqf(ss * (1.f / DM) + EPSN);
          const float* sh = nmod + ((long)bb * 6 + 0) * DM + lane * 16; const float* sc = sh + DM; const float* gp = ng + lane * 16;
          u32x4 p0, p1;
#pragma unroll
          for (int i = 0; i < 4; ++i) { f32x4 g4 = *(const f32x4*)(gp + 4 * i), s4 = *(const f32x4*)(sc + 4 * i), h4 = *(const f32x4*)(sh + 4 * i);
            const float a0 = xv[i][0] * inv * g4[0] * (1.f + s4[0]) + h4[0], a1 = xv[i][1] * inv * g4[1] * (1.f + s4[1]) + h4[1];
            const float a2 = xv[i][2] * inv * g4[2] * (1.f + s4[2]) + h4[2], a3 = xv[i][3] * inv * g4[3] * (1.f + s4[3]) + h4[3];
            if (i < 2) { p0[2 * i] = pack2bf(a0, a1); p0[2 * i + 1] = pack2bf(a2, a3); } else { p1[2 * (i - 2)] = pack2bf(a0, a1); p1[2 * (i - 2) + 1] = pack2bf(a2, a3); } }
          *(u32x4*)(xn_next + row * DM + lane * 16) = p0; *(u32x4*)(xn_next + row * DM + lane * 16 + 8) = p1;
        }
      }
    }
  }
}

#define CS_L 32
#define CS_LDA 72
#define CS_LDS_ 40
#define CS_OFF_KK 0
#define CS_OFF_R  (CS_OFF_KK + 32 * CS_LDA * 2)
#define CS_OFF_K  (CS_OFF_R + 32 * CS_LDA * 2)
#define CS_OFF_B  (CS_OFF_K + 32 * CS_LDA * 2)
#define CS_OFF_S  (CS_OFF_B + 32 * CS_LDA * 2)
#define CS_OFF_VT (CS_OFF_S + 64 * CS_LDA * 2)
#define CS_OFF_UT (CS_OFF_VT + 64 * CS_LDS_ * 2)
#define CS_OFF_KP (CS_OFF_UT + 64 * CS_LDS_ * 2)
#define CS_OFF_BP (CS_OFF_KP + 64 * CS_LDS_ * 2)
#define CS_OFF_A  (CS_OFF_BP + 64 * CS_LDS_ * 2)
#define CS_OFF_P1 (CS_OFF_A + 32 * CS_LDS_ * 2)
#define CS_OFF_P2 (CS_OFF_P1 + 32 * CS_LDS_ * 2)
#define CS_OFF_C  (CS_OFF_P2 + 32 * CS_LDS_ * 2)
#define CS_OFF_G  (CS_OFF_C + 32 * 36 * 4)
#define CS_LDS_BYTES (CS_OFF_G + 5 * 64 * 4)
template <int KS>
__device__ __forceinline__ void cs_mma(const bf16_t* A, int lda, int m0, const bf16_t* Bt, int ldb, int n0, int lane, f32x4& acc) {
  const int fr = lane & 15, fq = lane >> 4;
#pragma unroll
  for (int ks = 0; ks < KS; ++ks) {
    bf16x8 af = *(const bf16x8*)(A + (m0 + fr) * lda + ks * 32 + fq * 8);
    bf16x8 bfr = *(const bf16x8*)(Bt + (n0 + fr) * ldb + ks * 32 + fq * 8);
    acc = __builtin_amdgcn_mfma_f32_16x16x32_bf16(bfr, af, acc, 0, 0, 0);
  }
}
#define CSP_WAVE_BYTES (2 * 32 * CS_LDA * 2 + 32 * 36 * 4)
__device__ __forceinline__ void rw_chunk_inverse(const bf16_t* __restrict__ kk_, const bf16_t* __restrict__ bd_, const float* __restrict__ w_, bf16_t* __restrict__ Mg,
                                                 int job, long dstride, char* smem_wave, int lane) {
  const int job_u = __builtin_amdgcn_readfirstlane(job);
  const int c = job_u % (RB / CS_L), item = job_u / (RB / CS_L);
  const int dir = item & 1, h = (item >> 1) % 6, b = item / 12;
  const long rowbase = (long)b * RB; const int col0 = h * 64;
  bf16_t* KKs = (bf16_t*)smem_wave; bf16_t* Bs_ = KKs + 32 * CS_LDA; float* Cf = (float*)(smem_wave + 2 * 32 * CS_LDA * 2);
  const int fr = lane & 15, fq = lane >> 4;
  const int rlo = dir ? scan_row(1, c * CS_L + 31) : scan_row(0, c * CS_L);
  const long ub_ = (rowbase + rlo) * 384 + col0;
  const char* sw_ = (const char*)(w_ + dir * dstride + ub_); const char* skk_ = (const char*)(kk_ + ub_); const char* sb_ = (const char*)(bd_ + dir * dstride + ub_);
  float wv[32]; unsigned kkr[32], br[32];
#pragma unroll
  for (int tt = 0; tt < 32; ++tt) {
    const unsigned m_ = dir ? 31 - tt : tt;
    wv[tt] = *(const float*)(sw_ + (size_t)((unsigned)lane * 4u + m_ * 1536u)); kkr[tt] = *(const bf16_t*)(skk_ + (size_t)((unsigned)lane * 2u + m_ * 768u)); br[tt] = *(const bf16_t*)(sb_ + (size_t)((unsigned)lane * 2u + m_ * 768u));
  }
  float G = 1.f;
#pragma unroll
  for (int tt = 0; tt < 32; ++tt) {
    KKs[tt * CS_LDA + lane] = f2bf(bf2f((bf16_t)kkr[tt]) * G);
    G *= wv[tt];
    Bs_[tt * CS_LDA + lane] = f2bf(bf2f((bf16_t)br[tt]) * __builtin_amdgcn_rcpf(G));
  }
#pragma unroll
  for (int mt = 0; mt < 2; ++mt)
#pragma unroll
    for (int nt = 0; nt < 2; ++nt) {
      f32x4 a = {0.f, 0.f, 0.f, 0.f};
      cs_mma<2>(KKs, CS_LDA, mt * 16, Bs_, CS_LDA, nt * 16, lane, a);
      const int tt = mt * 16 + fr, s0 = nt * 16 + fq * 4;
      f32x4 o4;
#pragma unroll
      for (int e = 0; e < 4; ++e) o4[e] = (s0 + e < tt) ? a[e] : 0.f;
      *(f32x4*)(Cf + tt * 36 + s0) = o4;
    }
  float m[32];
#pragma unroll
  for (int tt = 0; tt < 32; ++tt) {
    float acc = (tt == lane) ? 1.f : 0.f;
#pragma unroll
    for (int s4 = 0; s4 < tt; s4 += 4) {
      const f32x4 cv = *(const f32x4*)(Cf + tt * 36 + s4);
#pragma unroll
      for (int e = 0; e < 4; ++e) if (s4 + e < tt) acc -= cv[e] * m[s4 + e];
    }
    m[tt] = acc;
  }
  if (lane < 32) {
    bf16_t* dst = Mg + (long)job_u * 1024;
#pragma unroll
    for (int tt = 0; tt < 32; ++tt) dst[tt * 32 + lane] = f2bf(m[tt]);
  }
}
#define CS_FETCH(c_) do { const int s0_ = (c_) * CS_L + cq * 8; const int rlo_ = dir ? scan_row(1, s0_ + 7) : scan_row(0, s0_); \
      const char* fw_ = s_w + (long)rlo_ * 1536; const char* fkk_ = s_kk + (long)rlo_ * 768; const char* fb_ = s_b + (long)rlo_ * 768; \
      const char* fk_ = s_k + (long)rlo_ * 768; const char* fr_ = s_r + (long)rlo_ * 768; const char* fv_ = s_v + (long)rlo_ * 768; \
      _Pragma("unroll") for (int e = 0; e < 8; ++e) { asm volatile("" : "+v"(vo2e[e]), "+v"(vo4e[e]));   \
        pw[e] = *(const float*)(fw_ + (size_t)vo4e[e]); pkk[e] = *(const bf16_t*)(fkk_ + (size_t)vo2e[e]); pb[e] = *(const bf16_t*)(fb_ + (size_t)vo2e[e]); \
        pk[e] = *(const bf16_t*)(fk_ + (size_t)vo2e[e]); pr[e] = *(const bf16_t*)(fr_ + (size_t)vo2e[e]); pv[e] = *(const bf16_t*)(fv_ + (size_t)vo2e[e]); } } while (0)
__device__ __forceinline__ void rw_scan_chunked(const bf16_t* __restrict__ r_, const bf16_t* __restrict__ v_, const bf16_t* __restrict__ kk_, const bf16_t* __restrict__ kd_,
                                                const bf16_t* __restrict__ bd_, const float* __restrict__ w_, float* __restrict__ y_, int item, long dstride, char* smem, const bf16_t* __restrict__ Mg) {
  const int t = tid_opaque(), lane = t & 63, wave = t >> 6, fr = lane & 15, fq = lane >> 4;
  const int item_u = __builtin_amdgcn_readfirstlane(item);
  const int dir = item_u & 1, h = (item_u >> 1) % 6, b = item_u / 12;
  const long rowbase = (long)b * RB; const int col0 = h * 64;
  bf16_t* KKs = (bf16_t*)(smem + CS_OFF_KK); bf16_t* Rs = (bf16_t*)(smem + CS_OFF_R); bf16_t* Ks_ = (bf16_t*)(smem + CS_OFF_K); bf16_t* Bs_ = (bf16_t*)(smem + CS_OFF_B);
  bf16_t* Ss = (bf16_t*)(smem + CS_OFF_S); bf16_t* Vt = (bf16_t*)(smem + CS_OFF_VT); bf16_t* Ut = (bf16_t*)(smem + CS_OFF_UT);
  bf16_t* KpT = (bf16_t*)(smem + CS_OFF_KP); bf16_t* BpT = (bf16_t*)(smem + CS_OFF_BP);
  bf16_t* As_ = (bf16_t*)(smem + CS_OFF_A); bf16_t* P1s = (bf16_t*)(smem + CS_OFF_P1); bf16_t* P2s = (bf16_t*)(smem + CS_OFF_P2);
  bf16_t* Ms = (bf16_t*)(smem + CS_OFF_C);
  float* Gq = (float*)(smem + CS_OFF_G); float* GL = Gq + 256;
  bf16_t* rhsT = (bf16_t*)(smem + CS_OFF_K);
  const int cj = t & 63, cq = __builtin_amdgcn_readfirstlane(t >> 6);
  unsigned vo2e[8], vo4e[8];
#pragma unroll
  for (int e = 0; e < 8; ++e) { const int m_ = dir ? 7 - e : e; vo2e[e] = (unsigned)cj * 2u + (unsigned)m_ * 768u; vo4e[e] = (unsigned)cj * 4u + (unsigned)m_ * 1536u; }
  const long ubase_ = rowbase * 384 + col0;
  const char* s_w = (const char*)(w_ + dir * dstride + ubase_); const char* s_kk = (const char*)(kk_ + ubase_); const char* s_b = (const char*)(bd_ + dir * dstride + ubase_);
  const char* s_k = (const char*)(kd_ + dir * dstride + ubase_); const char* s_r = (const char*)(r_ + ubase_); const char* s_v = (const char*)(v_ + ubase_);
  __syncthreads();
  for (int i = t; i < 64 * CS_LDA; i += 256) Ss[i] = 0;
  f32x4 Sacc[4];
#pragma unroll
  for (int it = 0; it < 4; ++it) Sacc[it] = (f32x4){0.f, 0.f, 0.f, 0.f};
  float pw[8]; unsigned pkk[8], pb[8], pk[8], pr[8], pv[8]; uint2 pm;
  const bf16_t* Mitem = Mg + (long)item * (RB / CS_L) * 1024 + t * 4;
  CS_FETCH(0); pm = *(const uint2*)Mitem;
  __builtin_amdgcn_s_setprio(3);
  const int NCH = RB / CS_L;
  for (int c = 0; c < NCH; ++c) {
#pragma unroll
    for (int e = 0; e < 8; ++e) asm volatile("" : "+v"(pw[e]), "+v"(pkk[e]), "+v"(pb[e]), "+v"(pk[e]), "+v"(pr[e]), "+v"(pv[e]));
    asm volatile("" : "+v"(pm.x), "+v"(pm.y));
    float g[8]; float run = 1.f;
#pragma unroll
    for (int e = 0; e < 8; ++e) { run *= pw[e]; g[e] = run; }
    Gq[cq * 64 + cj] = run;
    float kkv[8], bv[8], kv[8], rv[8]; bf16_t vv[8];
#pragma unroll
    for (int e = 0; e < 8; ++e) { kkv[e] = bf2f((bf16_t)pkk[e]); bv[e] = bf2f((bf16_t)pb[e]); kv[e] = bf2f((bf16_t)pk[e]); rv[e] = bf2f((bf16_t)pr[e]); vv[e] = (bf16_t)pv[e]; }
    __syncthreads();
    const uint2 pm_cur = pm;
    if (c + 1 < NCH) { CS_FETCH(c + 1); pm = *(const uint2*)(Mitem + (long)(c + 1) * 1024); }
    float base = 1.f, tot = 1.f;
#pragma unroll
    for (int q = 0; q < 4; ++q) { float pq = Gq[q * 64 + cj]; if (q < cq) base *= pq; tot *= pq; }
    if (cq == 0) GL[cj] = tot;
    {
      u32x4 kp4, bp4, vt4;
#pragma unroll
      for (int e = 0; e < 8; ++e) {
        const float G = base * g[e], Gp = e == 0 ? base : base * g[e - 1], iG = __builtin_amdgcn_rcpf(G);
        const int tt = cq * 8 + e;
        KKs[tt * CS_LDA + cj] = f2bf(kkv[e] * Gp); Rs[tt * CS_LDA + cj] = f2bf(rv[e] * G);
        const float kt = kv[e] * iG, bt = bv[e] * iG;
        Ks_[tt * CS_LDA + cj] = f2bf(kt); Bs_[tt * CS_LDA + cj] = f2bf(bt);
        kv[e] = kt * tot; bv[e] = -bt * tot;
      }
#pragma unroll
      for (int e = 0; e < 4; ++e) { kp4[e] = pack2bf(kv[2 * e], kv[2 * e + 1]); bp4[e] = pack2bf(bv[2 * e], bv[2 * e + 1]); vt4[e] = (unsigned)vv[2 * e] | ((unsigned)vv[2 * e + 1] << 16); }
      *(uint2*)(Ms + (t >> 3) * CS_LDS_ + (t & 7) * 4) = pm_cur;
      *(u32x4*)(KpT + cj * CS_LDS_ + cq * 8) = kp4; *(u32x4*)(BpT + cj * CS_LDS_ + cq * 8) = bp4; *(u32x4*)(Vt + cj * CS_LDS_ + cq * 8) = vt4;
    }
    __syncthreads();
    if (wave == 1) {
    } else {
      const bf16_t* X = wave == 0 ? KKs : Rs; const bf16_t* Y = wave == 3 ? Bs_ : Ks_;
#pragma unroll
      for (int mt = 0; mt < 2; ++mt)
#pragma unroll
        for (int nt = 0; nt < 2; ++nt) {
          f32x4 a = {0.f, 0.f, 0.f, 0.f};
          cs_mma<2>(X, CS_LDA, mt * 16, Y, CS_LDA, nt * 16, lane, a);
          const int tt = mt * 16 + fr, s0 = nt * 16 + fq * 4;
          float o[4];
#pragma unroll
          for (int e = 0; e < 4; ++e) { const int s = s0 + e; const bool keep = wave == 0 ? (s < tt) : (s <= tt); o[e] = keep ? a[e] : 0.f; }
          bf16_t* dst = wave == 0 ? As_ : (wave == 2 ? P1s : P2s); const float sg = wave == 3 ? -1.f : 1.f;
          uint2 pk2; pk2.x = pack2bf(sg * o[0], sg * o[1]); pk2.y = pack2bf(sg * o[2], sg * o[3]);
          *(uint2*)(dst + tt * CS_LDS_ + s0) = pk2;
        }
    }
    __syncthreads();
    f32x4 yp[2];
    {
      const bf16x8 sb0 = *(const bf16x8*)(Ss + (wave * 16 + fr) * CS_LDA + fq * 8), sb1 = *(const bf16x8*)(Ss + (wave * 16 + fr) * CS_LDA + 32 + fq * 8);
      const bf16x8 vb = *(const bf16x8*)(Vt + (wave * 16 + fr) * CS_LDS_ + fq * 8);
      bf16x8 ak[2][2], ar[2][2], aa[2], ap[2];
#pragma unroll
      for (int mt = 0; mt < 2; ++mt) {
        ak[mt][0] = *(const bf16x8*)(KKs + (mt * 16 + fr) * CS_LDA + fq * 8); ak[mt][1] = *(const bf16x8*)(KKs + (mt * 16 + fr) * CS_LDA + 32 + fq * 8);
        ar[mt][0] = *(const bf16x8*)(Rs + (mt * 16 + fr) * CS_LDA + fq * 8);  ar[mt][1] = *(const bf16x8*)(Rs + (mt * 16 + fr) * CS_LDA + 32 + fq * 8);
        aa[mt] = *(const bf16x8*)(As_ + (mt * 16 + fr) * CS_LDS_ + fq * 8);   ap[mt] = *(const bf16x8*)(P1s + (mt * 16 + fr) * CS_LDS_ + fq * 8);
      }
#pragma unroll
      for (int mt = 0; mt < 2; ++mt) {
        f32x4 a = {0.f, 0.f, 0.f, 0.f}, y2 = {0.f, 0.f, 0.f, 0.f};
        a = __builtin_amdgcn_mfma_f32_16x16x32_bf16(sb0, ak[mt][0], a, 0, 0, 0);   y2 = __builtin_amdgcn_mfma_f32_16x16x32_bf16(sb0, ar[mt][0], y2, 0, 0, 0);
        a = __builtin_amdgcn_mfma_f32_16x16x32_bf16(sb1, ak[mt][1], a, 0, 0, 0);   y2 = __builtin_amdgcn_mfma_f32_16x16x32_bf16(sb1, ar[mt][1], y2, 0, 0, 0);
        a = __builtin_amdgcn_mfma_f32_16x16x32_bf16(vb, aa[mt], a, 0, 0, 0);       y2 = __builtin_amdgcn_mfma_f32_16x16x32_bf16(vb, ap[mt], y2, 0, 0, 0);
#pragma unroll
        for (int e = 0; e < 4; ++e) rhsT[(wave * 16 + fq * 4 + e) * CS_LDS_ + mt * 16 + fr] = f2bf(a[e]);
        yp[mt] = y2;
      }
    }
    __syncthreads();
#pragma unroll
    for (int nt = 0; nt < 2; ++nt) {
      f32x4 a = {0.f, 0.f, 0.f, 0.f};
      cs_mma<1>(rhsT, CS_LDS_, wave * 16, Ms, CS_LDS_, nt * 16, lane, a);
      uint2 pk2; pk2.x = pack2bf(a[0], a[1]); pk2.y = pack2bf(a[2], a[3]);
      *(uint2*)(Ut + (wave * 16 + fr) * CS_LDS_ + nt * 16 + fq * 4) = pk2;
    }
    __syncthreads();
    {
      const bf16x8 ub_ = *(const bf16x8*)(Ut + (wave * 16 + fr) * CS_LDS_ + fq * 8);
      const bf16x8 kpb = *(const bf16x8*)(KpT + (wave * 16 + fr) * CS_LDS_ + fq * 8), bpb = *(const bf16x8*)(BpT + (wave * 16 + fr) * CS_LDS_ + fq * 8);
      bf16x8 p2a[2], va[4], ua[4];
#pragma unroll
      for (int mt = 0; mt < 2; ++mt) p2a[mt] = *(const bf16x8*)(P2s + (mt * 16 + fr) * CS_LDS_ + fq * 8);
#pragma unroll
      for (int it = 0; it < 4; ++it) { va[it] = *(const bf16x8*)(Vt + (it * 16 + fr) * CS_LDS_ + fq * 8); ua[it] = *(const bf16x8*)(Ut + (it * 16 + fr) * CS_LDS_ + fq * 8); }
      const f32x4 gl = *(const f32x4*)(GL + wave * 16 + fq * 4);
#pragma unroll
      for (int mt = 0; mt < 2; ++mt) {
        yp[mt] = __builtin_amdgcn_mfma_f32_16x16x32_bf16(ub_, p2a[mt], yp[mt], 0, 0, 0);
        const long row = rowbase + scan_row(dir, c * CS_L) + (dir ? -(mt * 16 + fr) : (mt * 16 + fr));
        { uint2 yq; yq.x = pack2bf(yp[mt][0], yp[mt][1]); yq.y = pack2bf(yp[mt][2], yp[mt][3]);
          *(uint2*)((bf16_t*)y_ + dir * dstride + row * 384 + col0 + wave * 16 + fq * 4) = yq; }
      }
#pragma unroll
      for (int it = 0; it < 4; ++it) {
        f32x4 a = Sacc[it]; a[0] *= gl[0]; a[1] *= gl[1]; a[2] *= gl[2]; a[3] *= gl[3];
        a = __builtin_amdgcn_mfma_f32_16x16x32_bf16(kpb, va[it], a, 0, 0, 0);
        a = __builtin_amdgcn_mfma_f32_16x16x32_bf16(bpb, ua[it], a, 0, 0, 0);
        Sacc[it] = a;
      }
    }
    __syncthreads();
#pragma unroll
    for (int it = 0; it < 4; ++it) { uint2 pk2; pk2.x = pack2bf(Sacc[it][0], Sacc[it][1]); pk2.y = pack2bf(Sacc[it][2], Sacc[it][3]); *(uint2*)(Ss + (it * 16 + fr) * CS_LDA + wave * 16 + fq * 4) = pk2; }
  }
  __builtin_amdgcn_s_setprio(0);
  __syncthreads();
}
#include <hip/hip_cooperative_groups.h>
namespace cg = cooperative_groups;

#define XB_TMO      128
#define XB_XCNT(j)  (256  + 64 * (j))
#define XB_XSUB(j)  (1280 + 64 * (j))
#define XB_XGEN(j)  (2304 + 64 * (j))
#define XB_TOP      3328
#define XB_TOPGEN   3392
#define XB_QUEUE(i) (3456 + 64 * (i))
#define XCD_BAR_WORDS 4096
#define XB_SPIN_CAP (1u << 22)
#define LAS __attribute__((address_space(3)))
__device__ __forceinline__ unsigned xb_ld(unsigned* p)              { return __hip_atomic_load(p, __ATOMIC_RELAXED, __HIP_MEMORY_SCOPE_AGENT); }
__device__ __forceinline__ unsigned xb_add(unsigned* p, unsigned v) { return __hip_atomic_fetch_add(p, v, __ATOMIC_RELAXED, __HIP_MEMORY_SCOPE_AGENT); }
__device__ __forceinline__ unsigned xb_xcc_id() { return (unsigned)__builtin_amdgcn_s_getreg((3 << 11) | 20) & 0xFu; }
#define XB_SPIN(cond, bar) do { unsigned _sp = 0; while (cond) { __builtin_amdgcn_s_sleep(1); \
    if ((++_sp & 255u) == 0u) { if (xb_ld(&(bar)[XB_TMO])) break; if (_sp > XB_SPIN_CAP) { atomicAdd(&(bar)[XB_TMO], 1u); break; } } } } while (0)
struct XcdBarrier { unsigned* bar; unsigned x; volatile LAS unsigned* st; };
__device__ __forceinline__ XcdBarrier xcd_barrier_post(unsigned* bar, volatile LAS unsigned* st) {
  XcdBarrier b; b.bar = bar; b.x = xb_xcc_id(); b.st = st;
  if (threadIdx.x == 0) (void)xb_add(&bar[XB_XCNT(b.x)], 1u);
  return b;
}
__device__ __forceinline__ void xcd_barrier_complete(unsigned* bar, unsigned x, unsigned& nloc, unsigned& nx) {
  const unsigned G = gridDim.x; unsigned sum, cnt, mine, sp = 0u;
  for (;;) {
    sum = 0u; cnt = 0u; mine = 0u;
#pragma unroll
    for (unsigned j = 0; j < 16; ++j) { const unsigned c = xb_ld(&bar[XB_XCNT(j)]); sum += c; cnt += (c > 0u) ? 1u : 0u; mine = (j == x) ? c : mine; }
    if (sum == G) break;
    __builtin_amdgcn_s_sleep(1);
    if ((++sp & 255u) == 0u) { if (xb_ld(&bar[XB_TMO])) break; if (sp > XB_SPIN_CAP) { atomicAdd(&bar[XB_TMO], 1u); break; } }
  }
  nloc = mine > 0u ? mine : 1u; nx = cnt > 0u ? cnt : 1u;
}
__device__ __forceinline__ void xcd_barrier(const XcdBarrier& b) {
  asm volatile("s_waitcnt vmcnt(0)" ::: "memory");
  __syncthreads();
  if (threadIdx.x == 0) {
    unsigned* bar = b.bar;
    __builtin_amdgcn_s_waitcnt(0);
    unsigned nloc = b.st[0], nx = b.st[1];
    if (nloc == 0u) { xcd_barrier_complete(bar, b.x, nloc, nx); b.st[0] = nloc; b.st[1] = nx; }
    const unsigned old = xb_add(&bar[XB_XSUB(b.x)], 1u);
    const unsigned gen = old / nloc;
    if (old + 1u == (gen + 1u) * nloc) {
      __builtin_amdgcn_fence(__ATOMIC_RELEASE, "agent");
      asm volatile("s_waitcnt vmcnt(0)" ::: "memory");
      const unsigned og = xb_add(&bar[XB_TOP], 1u);
      const unsigned tg = og / nx;
      if (og + 1u == (tg + 1u) * nx) xb_add(&bar[XB_TOPGEN], 1u);
      else XB_SPIN(xb_ld(&bar[XB_TOPGEN]) == tg, bar);
      __builtin_amdgcn_fence(__ATOMIC_ACQUIRE, "agent");
      xb_add(&bar[XB_XGEN(b.x)], 1u);
      asm volatile("s_waitcnt vmcnt(0)" ::: "memory");
    } else {
      XB_SPIN(xb_ld(&bar[XB_XGEN(b.x)]) == gen, bar);
      __builtin_amdgcn_fence(__ATOMIC_ACQUIRE, "agent");
      asm volatile("s_waitcnt vmcnt(0)" ::: "memory");
    }
  }
  __syncthreads();
}


constexpr size_t al256(size_t x) { return (x + 255) & ~(size_t)255; }
struct WsOff { size_t xs, mod, xn, Pb, tq, tkv, a_b, g_b, w_f, mq, mk, mvT, gq, gk, gvT, r_b, v_b, kk_b, kd_b, bd_b, w_inT, w_outT, wqT, keysb, wqbT, wkvbT, w2T, a2T, g2T, rope_g, rope_m, total; };
constexpr WsOff make_wsoff() {
  WsOff o{}; size_t p = 32768; const size_t MA = NROWS;
  o.mod = p; p += al256(2 * (BATCH + 1) * 6144 * 4); o.xs = p; p += al256(MA * DM * 4); o.xn = p; p += al256(MA * DM * 2);
  o.Pb = p; p += al256(MA * IN_COLS * 2);
  o.tq = p; p += al256(MA * 384 * 2); o.tkv = p; p += al256(MA * 512 * 2); o.a_b = p; p += al256(2 * MA * 384 * 2);
  o.g_b = p; p += al256(MA * 384 * 2); o.w_f = p; p += al256(2 * MA * 384 * 4);
  o.mq = p; p += al256(MA * 384 * 2); o.mk = p; p += al256(MA * 384 * 2); o.mvT = p; p += al256((size_t)BATCH * 4 * 64 * RB * 2);
  o.gq = p; p += al256(MA * 384 * 2); o.gk = p; p += al256(MA * 128 * 2); o.gvT = p; p += al256((size_t)BATCH * 2 * 64 * RB * 2);
  o.r_b = p; p += al256(MA * 384 * 2); o.v_b = p; p += al256(MA * 384 * 2); o.kk_b = p; p += al256(MA * 384 * 2);
  o.kd_b = p; p += al256(2 * MA * 384 * 2); o.bd_b = p; p += al256(2 * MA * 384 * 2);
  o.w_inT = p; p += al256((size_t)2 * 2688 * 1024 * 2); o.w_outT = p; p += al256((size_t)2 * 1024 * 1024 * 2); o.wqT = p; p += al256((size_t)2 * 2048 * 1024 * 2);
  o.keysb = p; p += al256((size_t)2 * 16 * 128 * 128 * 2); o.wqbT = p; p += al256((size_t)2 * 384 * 256 * 2); o.wkvbT = p; p += al256((size_t)2 * 512 * 128 * 2);
  o.w2T = p; p += al256((size_t)2 * 2 * 384 * 64 * 2); o.a2T = p; p += al256((size_t)2 * 2 * 384 * 64 * 2); o.g2T = p; p += al256((size_t)2 * 384 * 192 * 2);
  o.rope_g = p; p += al256((size_t)SEQ * 64 * 4); o.rope_m = p; p += al256((size_t)SEQ * 32 * 4);
  o.total = p; return o;
}
constexpr WsOff WO = make_wsoff();
#define WS_PTR(T, off) ((T*)(ws + (off)))
#define MINV_OFF (WO.tq + (size_t)40 * 1024 * 1024)
#define TAB_OFF (WO.Pb + ((size_t)2 * NROWS * 384 * 4 + 1048576 & ~(size_t)255))
#define TAB_U (TAB_OFF)
#define TAB_V (TAB_OFF + (size_t)16384 * 1024)
#define TAB_SU (TAB_OFF + (size_t)2 * 16384 * 1024)
#define TAB_SV (TAB_OFF + (size_t)2 * 16384 * 1024 + 65536)
#define LAUNDER_S(x) asm volatile("" : "+s"(x))
#define KARG_AS __attribute__((address_space(4)))
#define KP_DECL const KARG_AS MegaP* kp_ = (const KARG_AS MegaP*)__builtin_amdgcn_kernarg_segment_ptr(); LAUNDER_S(kp_)

struct NaiveIn {
  const float *x, *c, *ctx, *c_ctx, *ada_w, *ada_b, *norm_mix_g, *norm_ffn_g, *w_in, *w_out, *mla_q_norm_g, *mla_w_qb, *mla_kv_norm_g,
      *mla_w_kvb, *mla_qk_g, *rw_mu, *rw_w0, *rw_w2, *rw_a0, *rw_a2, *rw_g2, *rw_k_k, *rw_k_a, *rw_r_k, *rw_ln_g, *rw_ln_b, *gqa_qk_g,
      *pe_wq, *pe_keys, *pe_u, *pe_v;
};
struct MegaP { NaiveIn in; char* ws; float* out; };

#ifndef MEGA_CG
#define MEGA_CG 0
#endif
#if MEGA_CG
#define GRID_BARRIER() cg::this_grid().sync()
#else
#ifdef BAR_TWICE
#define GRID_BARRIER() do { GRID_BARRIER1(); GRID_BARRIER1(); } while (0)
#else
#define GRID_BARRIER() GRID_BARRIER1()
#endif
#define GRID_BARRIER1() do { XcdBarrier xb_; xb_.bar = (unsigned*)((const KARG_AS MegaP*)__builtin_amdgcn_kernarg_segment_ptr())->ws; xb_.x = xb_xcc_id(); xb_.st = (volatile LAS unsigned*)&xb_words; xcd_barrier(xb_); } while (0)
#endif
#define MEGA_LDS_BYTES 65536
#ifndef PHASE_MASK
#define PHASE_MASK 0xFFFF
#endif
#define PH(k) if (PHASE_MASK & (1 << (k)))
#define LAT_TM(i) (((i) >> 4) * 18 + ((i) & 15))
#define XCD_TILE_LOOP(tile, T) for (int xt_base_ = (int)(((long)(T) * (blockIdx.x & 7)) >> 3), xt_cnt_ = (int)(((long)(T) * ((blockIdx.x & 7) + 1)) >> 3) - xt_base_, xt_q_ = blockIdx.x >> 3, tile = xt_base_ + xt_q_; xt_q_ < xt_cnt_; xt_q_ += gridDim.x >> 3, tile = xt_base_ + xt_q_)
#ifndef DIL_PH
#define DIL_PH -1
#endif
#ifndef DIL_MULT
#define DIL_MULT 4
#endif
#define DIL_BEGIN(k) unsigned long long dil_t0 = 0; if (DIL_PH == (k)) dil_t0 = __builtin_amdgcn_s_memrealtime();
#define DIL_END(k) if (DIL_PH == (k)) { GRID_BARRIER(); if (blockIdx.x == 0 && threadIdx.x == 0) { unsigned long long t1 = __builtin_amdgcn_s_memrealtime(); unsigned long long dt = (t1 - dil_t0) * DIL_MULT; \
    while (__builtin_amdgcn_s_memrealtime() - t1 < dt) __builtin_amdgcn_s_sleep(32); } }

__device__ __forceinline__ void ph_norm_mod(const float* __restrict__ xs, const float* __restrict__ g, const float* __restrict__ modl, int shift_idx, bf16_t* __restrict__ xn, bool skip_ctx = false,
                                            const float* __restrict__ x_in = nullptr, const float* __restrict__ ctx_in = nullptr) {
  const int tt_ = tid_opaque(); const int lane = tt_ & 63;
  const long nidx = skip_ctx ? (long)BATCH * SEQ : (long)NROWS;
  const long stride = (long)gridDim.x * 4;
  f32x4 gv[4];
#pragma unroll
  for (int i = 0; i < 4; ++i) gv[i] = *(const f32x4*)(g + i * 256 + lane * 4);
  f32x4 v[4], scv[4], shv[4], nv[4], nsc[4], nsh[4];
#define NM_ROW(idx_) (skip_ctx ? ((idx_) / SEQ) * RB + (idx_) % SEQ : (idx_))
#define NM_LOAD(V, SC, SH, idx_) do { const long row_ = NM_ROW(idx_); const int b_ = row_ / RB, lr_ = row_ % RB; const int bb_ = lr_ < SEQ ? b_ : BATCH; \
    const float* sh_ = modl + ((long)bb_ * 6 + shift_idx) * DM; const float* sc_ = sh_ + DM; \
    const float* xr_ = x_in ? (lr_ < SEQ ? x_in + ((long)b_ * SEQ + lr_) * DM : ctx_in + ((long)b_ * CTX_LEN + (lr_ - SEQ)) * DM) : xs + row_ * DM; \
    _Pragma("unroll") for (int i = 0; i < 4; ++i) { V[i] = *(const f32x4*)(xr_ + i * 256 + lane * 4); SC[i] = *(const f32x4*)(sc_ + i * 256 + lane * 4); SH[i] = *(const f32x4*)(sh_ + i * 256 + lane * 4); } } while (0)
  long idx = (long)blockIdx.x * 4 + (tt_ >> 6);
  if (idx < nidx) NM_LOAD(v, scv, shv, idx);
  for (; idx < nidx; idx += stride) {
    const bool more = idx + stride < nidx;
    NM_LOAD(nv, nsc, nsh, (more ? idx + stride : idx));
    const long row = NM_ROW(idx);
    float ss = 0.f;
#pragma unroll
    for (int i = 0; i < 4; ++i) ss += v[i][0]*v[i][0] + v[i][1]*v[i][1] + v[i][2]*v[i][2] + v[i][3]*v[i][3];
    ss = wave_sum(ss);
    const float inv = __builtin_amdgcn_rsqf(ss / DM + EPSN);
#pragma unroll
    for (int i = 0; i < 4; ++i) {
      const int d = i * 256 + lane * 4; float o[4];
#pragma unroll
      for (int e = 0; e < 4; ++e) o[e] = v[i][e] * inv * gv[i][e] * (1.f + scv[i][e]) + shv[i][e];
      uint2 pk; pk.x = pack2bf(o[0], o[1]); pk.y = pack2bf(o[2], o[3]);
      *(uint2*)(xn + row * DM + d) = pk;
    }
#pragma unroll
    for (int i = 0; i < 4; ++i) { v[i] = nv[i]; scv[i] = nsc[i]; shv[i] = nsh[i]; }
  }
#undef NM_LOAD
#undef NM_ROW
}
__device__ __forceinline__ void ph_cvt_wT(const float* W, const float* g, bf16_t* Wt, int K, int N, int Npad, int Kpad) {
  const long n_el = (long)Npad * Kpad;
  const int tt_ = tid_opaque();
  for (long i = (long)blockIdx.x * 256 + tt_; i < n_el; i += (long)gridDim.x * 256) {
    int k = i % Kpad; int n = i / Kpad;
    Wt[i] = (k < K && n < N) ? f2bf(W[(long)k * N + n] * (g ? g[k] : 1.f)) : (bf16_t)0;
  }
}
__device__ __forceinline__ void ph_cvt_bf16(const float* s, bf16_t* d, long n8) {
  const int tt_ = tid_opaque();
  for (long i = (long)blockIdx.x * 256 + tt_; i < n8; i += (long)gridDim.x * 256) {
    f32x4 a = *(const f32x4*)(s + i * 8), b = *(const f32x4*)(s + i * 8 + 4);
    u32x4 o; o[0] = pack2bf(a[0], a[1]); o[1] = pack2bf(a[2], a[3]); o[2] = pack2bf(b[0], b[1]); o[3] = pack2bf(b[2], b[3]);
    *(u32x4*)(d + i * 8) = o;
  }
}


__device__ __forceinline__ void ph_cvt_wT_tiled(const float* __restrict__ W, const float* __restrict__ g, bf16_t* __restrict__ Wt, int K, int N, int Npad, int Kpad, char* smem) {
  const int t = tid_opaque(); float* s = (float*)smem;
  const int tk = Kpad / 64, tn = Npad / 64;
  for (int tile = blockIdx.x; tile < tk * tn; tile += gridDim.x) {
    const int k0 = (tile % tk) * 64, n0 = (tile / tk) * 64;
    __syncthreads();
#pragma unroll
    for (int i = 0; i < 4; ++i) {
      int kk = (t >> 4) + 16 * i, nn = (t & 15) * 4; int k = k0 + kk;
      f32x4 v = {0.f, 0.f, 0.f, 0.f};
      if (k < K) {
        const float* src = W + (long)k * N + n0 + nn; float gs = g ? g[k] : 1.f;
        if (n0 + nn + 3 < N) v = *(const f32x4*)src; else { for (int e = 0; e < 4; ++e) if (n0 + nn + e < N) v[e] = src[e]; }
        v *= gs;
      }
#pragma unroll
      for (int e = 0; e < 4; ++e) s[kk * 65 + nn + e] = v[e];
    }
    __syncthreads();
    {
      int nn = t >> 2, kq = (t & 3) * 16; u32x4 o0, o1;
#pragma unroll
      for (int e = 0; e < 4; ++e) { o0[e] = pack2bf(s[(kq + 2*e) * 65 + nn], s[(kq + 2*e + 1) * 65 + nn]); o1[e] = pack2bf(s[(kq + 8 + 2*e) * 65 + nn], s[(kq + 8 + 2*e + 1) * 65 + nn]); }
      bf16_t* dst = Wt + (long)(n0 + nn) * Kpad + k0 + kq;
      *(u32x4*)dst = o0; *(u32x4*)(dst + 8) = o1;
    }
  }
}
__device__ __forceinline__ void ph_mod_gemv(const float* __restrict__ c, const float* __restrict__ c_ctx, const float* __restrict__ ada_w, const float* __restrict__ ada_b, float* __restrict__ mod, char* smem) {
  const int t = tid_opaque(); float* s = (float*)smem;
  if ((int)blockIdx.x >= 2 * 96) return;
  for (int i = t; i < 9 * 1024; i += 256) { int bb = i >> 10, k = i & 1023; float v = bb < BATCH ? c[bb * DM + k] : c_ctx[k]; s[i] = v * __builtin_amdgcn_rcpf(1.f + __builtin_amdgcn_exp2f(-v * 1.4426950408889634f)); }
  __syncthreads();
  float* part = s + 9 * 1024;
  for (int item = blockIdx.x; item < 2 * 96; item += gridDim.x) {
    const int cb = item % 96, l = item / 96; const int kq = t >> 6, col = t & 63;
    const int j = cb * 64 + col; const float* wp = ada_w + ((long)l * DM + kq * 256) * 6144 + j;
    float acc[9];
#pragma unroll
    for (int bb = 0; bb < 9; ++bb) acc[bb] = 0.f;
#pragma unroll 16
    for (int k = 0; k < 256; ++k) { float w = wp[(long)k * 6144];
#pragma unroll
      for (int bb = 0; bb < 9; ++bb) acc[bb] += s[bb * 1024 + kq * 256 + k] * w; }
#pragma unroll
    for (int bb = 0; bb < 9; ++bb) part[(kq * 9 + bb) * 64 + col] = acc[bb];
    __syncthreads();
    for (int i = t; i < 9 * 64; i += 256) { int bb = i >> 6, cc = i & 63;
      float v = ((part[(0 * 9 + bb) * 64 + cc] + part[(1 * 9 + bb) * 64 + cc]) + part[(2 * 9 + bb) * 64 + cc]) + part[(3 * 9 + bb) * 64 + cc];
      mod[((long)l * (BATCH + 1) + bb) * 6144 + cb * 64 + cc] = v + ada_b[l * 6144 + cb * 64 + cc]; }
    __syncthreads();
  }
}

__device__ __forceinline__ void ph_mod_gemv2(const float* __restrict__ c, const float* __restrict__ c_ctx, const float* __restrict__ ada_w, const float* __restrict__ ada_b, float* __restrict__ mod, char* smem) {
  const int t = tid_opaque(), lane = t & 63, wave = t >> 6; float* s = (float*)smem;
  const int nitem = 2 * 192;
  if ((int)blockIdx.x >= nitem) return;
  {
    f32x4 cv[9];
#pragma unroll
    for (int bb = 0; bb < 9; ++bb) cv[bb] = *(const f32x4*)((bb < BATCH ? c + bb * DM : c_ctx) + t * 4);
#pragma unroll
    for (int bb = 0; bb < 9; ++bb) { f32x4 o;
#pragma unroll
      for (int e = 0; e < 4; ++e) { const float v = cv[bb][e]; o[e] = v * __builtin_amdgcn_rcpf(1.f + __builtin_amdgcn_exp2f(-v * 1.4426950408889634f)); }
      *(f32x4*)(s + bb * 1024 + t * 4) = o; }
  }
  __syncthreads();
  float* part = s + 9 * 1024;
  for (int item = blockIdx.x; item < nitem; item += gridDim.x) {
    const int cb = item % 192, l = item / 192; const int cg = lane & 7, ks = wave * 8 + (lane >> 3);
    const float* wp = ada_w + ((long)l * DM + ks * 32) * 6144 + cb * 32 + cg * 4;
    f32x4 acc[9];
#pragma unroll
    for (int bb = 0; bb < 9; ++bb) acc[bb] = (f32x4){0.f, 0.f, 0.f, 0.f};
#pragma unroll 16
    for (int k = 0; k < 32; ++k) { const f32x4 w = *(const f32x4*)(wp + (long)k * 6144);
#pragma unroll
      for (int bb = 0; bb < 9; ++bb) { const float sv = s[bb * 1024 + ks * 32 + k]; acc[bb][0] += sv * w[0]; acc[bb][1] += sv * w[1]; acc[bb][2] += sv * w[2]; acc[bb][3] += sv * w[3]; } }
#pragma unroll
    for (int bb = 0; bb < 9; ++bb)
#pragma unroll
      for (int e = 0; e < 4; ++e) { float v = acc[bb][e]; v += dpp_get<0x128>(v); v = xor16_sum(v); v = xor32_sum(v); if (lane < 8) part[(wave * 9 + bb) * 32 + cg * 4 + e] = v; }
    __syncthreads();
    for (int i = t; i < 9 * 32; i += 256) { int bb = i >> 5, cc = i & 31;
      float v = ((part[(0 * 9 + bb) * 32 + cc] + part[(1 * 9 + bb) * 32 + cc]) + part[(2 * 9 + bb) * 32 + cc]) + part[(3 * 9 + bb) * 32 + cc];
      mod[((long)l * (BATCH + 1) + bb) * 6144 + cb * 32 + cc] = v + ada_b[l * 6144 + cb * 32 + cc]; }
    __syncthreads();
  }
}
struct CvtDesc { const float* W; const float* g; bf16_t* Wt; int K, N, Kpad, k0, n0; };
#define CVT_TILES_PER_LAYER (672 + 256 + 512 + 24 + 16 + 12 + 12 + 18)
__device__ __forceinline__ void cvt_lookup(int f, const KARG_AS MegaP* kp, char* ws, CvtDesc& d) {
  const int l = f / CVT_TILES_PER_LAYER; int r = f % CVT_TILES_PER_LAYER; int tk;
  if (r < 672) { d.W = kp->in.w_in + (long)l * DM * IN_COLS; d.g = nullptr; d.Wt = WS_PTR(bf16_t, WO.w_inT) + (long)l * 2688 * 1024; d.K = 1024; d.N = IN_COLS; d.Kpad = 1024; tk = 16; }
  else if ((r -= 672) < 256) { d.W = kp->in.w_out + (long)l * DM * DM; d.g = nullptr; d.Wt = WS_PTR(bf16_t, WO.w_outT) + (long)l * 1024 * 1024; d.K = 1024; d.N = 1024; d.Kpad = 1024; tk = 16; }
  else if ((r -= 256) < 512) { d.W = kp->in.pe_wq + (long)l * DM * 2048; d.g = nullptr; d.Wt = WS_PTR(bf16_t, WO.wqT) + (long)l * 2048 * 1024; d.K = 1024; d.N = 2048; d.Kpad = 1024; tk = 16; }
  else if ((r -= 512) < 24) { d.W = kp->in.mla_w_qb + (long)l * 256 * 384; d.g = kp->in.mla_q_norm_g + l * 256; d.Wt = WS_PTR(bf16_t, WO.wqbT) + (long)l * 384 * 256; d.K = 256; d.N = 384; d.Kpad = 256; tk = 4; }
  else if ((r -= 24) < 16) { d.W = kp->in.mla_w_kvb + (long)l * 128 * 512; d.g = kp->in.mla_kv_norm_g + l * 128; d.Wt = WS_PTR(bf16_t, WO.wkvbT) + (long)l * 512 * 128; d.K = 128; d.N = 512; d.Kpad = 128; tk = 2; }
  else if ((r -= 16) < 12) { const int dd = r / 6; r %= 6; d.W = kp->in.rw_w2 + ((long)l * 2 + dd) * 64 * 384; d.g = nullptr; d.Wt = WS_PTR(bf16_t, WO.w2T) + ((long)l * 2 + dd) * 384 * 64; d.K = 64; d.N = 384; d.Kpad = 64; tk = 1; }
  else if ((r -= 12) < 12) { const int dd = r / 6; r %= 6; d.W = kp->in.rw_a2 + ((long)l * 2 + dd) * 64 * 384; d.g = nullptr; d.Wt = WS_PTR(bf16_t, WO.a2T) + ((long)l * 2 + dd) * 384 * 64; d.K = 64; d.N = 384; d.Kpad = 64; tk = 1; }
  else { r -= 12; d.W = kp->in.rw_g2 + (long)l * 160 * 384; d.g = nullptr; d.Wt = WS_PTR(bf16_t, WO.g2T) + (long)l * 384 * 192; d.K = 160; d.N = 384; d.Kpad = 192; tk = 3; }
  d.k0 = (r % tk) * 64; d.n0 = (r / tk) * 64;
}
__device__ __forceinline__ void cvt_tile_load(const CvtDesc& d, int t, f32x4 (&v)[4]) {
#pragma unroll
  for (int i = 0; i < 4; ++i) {
    const int kk = (t >> 4) + 16 * i, nn = (t & 15) * 4; const int k = d.k0 + kk;
    f32x4 x = {0.f, 0.f, 0.f, 0.f};
    if (k < d.K) {
      const float* src = d.W + (long)k * d.N + d.n0 + nn; const float gs = d.g ? d.g[k] : 1.f;
      if (d.n0 + nn + 3 < d.N) x = *(const f32x4*)src; else { for (int e = 0; e < 4; ++e) if (d.n0 + nn + e < d.N) x[e] = src[e]; }
      x *= gs;
    }
    v[i] = x;
  }
}
__device__ __forceinline__ void ph_cvt_all(const KARG_AS MegaP* kp, char* ws, char* smem) {
  const int t = tid_opaque();
  const int NT = 2 * CVT_TILES_PER_LAYER;
  int f = blockIdx.x, buf = 0;
  CvtDesc d; f32x4 v[4];
  __syncthreads();
  if (f < NT) { cvt_lookup(f, kp, ws, d); cvt_tile_load(d, t, v); }
  while (f < NT) {
    float* s = (float*)(smem + buf * (64 * 65 * 4));
#pragma unroll
    for (int i = 0; i < 4; ++i) { const int kk = (t >> 4) + 16 * i, nn = (t & 15) * 4;
#pragma unroll
      for (int e = 0; e < 4; ++e) s[kk * 65 + nn + e] = v[i][e]; }
    const CvtDesc dc = d;
    const int fn = f + (int)gridDim.x;
    if (fn < NT) { cvt_lookup(fn, kp, ws, d); cvt_tile_load(d, t, v); }
    __syncthreads();
    {
      const int nn = t >> 2, kq = (t & 3) * 16; u32x4 o0, o1;
#pragma unroll
      for (int e = 0; e < 4; ++e) { o0[e] = pack2bf(s[(kq + 2*e) * 65 + nn], s[(kq + 2*e + 1) * 65 + nn]); o1[e] = pack2bf(s[(kq + 8 + 2*e) * 65 + nn], s[(kq + 8 + 2*e + 1) * 65 + nn]); }
      bf16_t* dst = dc.Wt + (long)(dc.n0 + nn) * dc.Kpad + dc.k0 + kq;
      *(u32x4*)dst = o0; *(u32x4*)(dst + 8) = o1;
    }
    f = fn; buf ^= 1;
  }
}

__global__ void __launch_bounds__(256, 2) mega_kernel(MegaP p) {
  __shared__ __attribute__((aligned(16))) char smem[MEGA_LDS_BYTES];
  __shared__ uint4 xb_words;
  const int t0 = threadIdx.x;
#if !MEGA_CG
  if (t0 == 0) xb_words = make_uint4(0u, 0u, 0u, 0u);
  __syncthreads();
  (void)xcd_barrier_post((unsigned*)p.ws, (volatile LAS unsigned*)&xb_words);
#endif
  const long MA = NROWS; const int TM = NROWS / 128;
#define I (kp_->in)
  const int scan_role = (int)blockIdx.x < BATCH * 12 ? 1 : 0;
  { DIL_BEGIN(0)
  PH(0) {
    KP_DECL; char* ws = kp_->ws; const int t = tid_opaque();
    float* xs = WS_PTR(float, WO.xs); float* mod = WS_PTR(float, WO.mod);
#ifdef P0_OLD
    ph_mod_gemv(I.c, I.c_ctx, I.ada_w, I.ada_b, mod, smem);
    for (int l = 0; l < 2; ++l) {
      ph_cvt_wT_tiled(I.w_in + (long)l * DM * IN_COLS, nullptr, WS_PTR(bf16_t, WO.w_inT) + (long)l * 2688 * 1024, 1024, IN_COLS, 2688, 1024, smem);
      ph_cvt_wT_tiled(I.w_out + (long)l * DM * DM, nullptr, WS_PTR(bf16_t, WO.w_outT) + (long)l * 1024 * 1024, 1024, 1024, 1024, 1024, smem);
      ph_cvt_wT_tiled(I.pe_wq + (long)l * DM * 2048, nullptr, WS_PTR(bf16_t, WO.wqT) + (long)l * 2048 * 1024, 1024, 2048, 2048, 1024, smem);
      ph_cvt_wT_tiled(I.mla_w_qb + (long)l * 256 * 384, I.mla_q_norm_g + l * 256, WS_PTR(bf16_t, WO.wqbT) + (long)l * 384 * 256, 256, 384, 384, 256, smem);
      ph_cvt_wT_tiled(I.mla_w_kvb + (long)l * 128 * 512, I.mla_kv_norm_g + l * 128, WS_PTR(bf16_t, WO.wkvbT) + (long)l * 512 * 128, 128, 512, 512, 128, smem);
      for (int d = 0; d < 2; ++d) {
        ph_cvt_wT_tiled(I.rw_w2 + ((long)l * 2 + d) * 64 * 384, nullptr, WS_PTR(bf16_t, WO.w2T) + ((long)l * 2 + d) * 384 * 64, 64, 384, 384, 64, smem);
        ph_cvt_wT_tiled(I.rw_a2 + ((long)l * 2 + d) * 64 * 384, nullptr, WS_PTR(bf16_t, WO.a2T) + ((long)l * 2 + d) * 384 * 64, 64, 384, 384, 64, smem);
      }
      ph_cvt_wT_tiled(I.rw_g2 + (long)l * 160 * 384, nullptr, WS_PTR(bf16_t, WO.g2T) + (long)l * 384 * 192, 160, 384, 384, 192, smem);
    }
#else
    ph_mod_gemv2(I.c, I.c_ctx, I.ada_w, I.ada_b, mod, smem);
#ifdef P0_TWICE_G
    __syncthreads(); ph_mod_gemv2(I.c, I.c_ctx, I.ada_w, I.ada_b, mod, smem);
#endif
    ph_cvt_all(kp_, ws, smem);
#ifdef P0_TWICE_C
    ph_cvt_all(kp_, ws, smem);
#endif
#endif
    ph_cvt_bf16(I.pe_keys, WS_PTR(bf16_t, WO.keysb), 2L * 16 * 128 * 128 / 8);
    ph_rope_tables(WS_PTR(float, WO.rope_g), WS_PTR(float, WO.rope_m));
#ifdef P0_TWICE_R
    ph_rope_tables(WS_PTR(float, WO.rope_g), WS_PTR(float, WO.rope_m));
    ph_cvt_bf16(I.pe_keys, WS_PTR(bf16_t, WO.keysb), 2L * 16 * 128 * 128 / 8);
#endif
  }
  DIL_END(0) }
  GRID_BARRIER();
  for (int lq = 0; lq < 2; ++lq) {
    int l = lq; LAUNDER_S(l);
    { DIL_BEGIN(1)
    PH(1) if (l == 0) {
      KP_DECL; char* ws = kp_->ws; const int t = tid_opaque(); (void)t;
      ph_norm_mod(WS_PTR(float, WO.xs), I.norm_mix_g + l * DM, WS_PTR(float, WO.mod) + (long)l * (BATCH + 1) * 6144, 0, WS_PTR(bf16_t, WO.xn), false, I.x, I.ctx);
    }
    DIL_END(1) }
    GRID_BARRIER();
    { DIL_BEGIN(2)
    PH(2) {
      KP_DECL; char* ws = kp_->ws; const int t = tid_opaque(); (void)t;
      const bf16_t* xn = WS_PTR(bf16_t, WO.xn); const bf16_t* wT = WS_PTR(bf16_t, WO.w_inT) + (long)l * 2688 * 1024; bf16_t* Pb = WS_PTR(bf16_t, WO.Pb);
      {
        const int T_ = TM * 21; const int xb_ = (int)(((long)T_ * (blockIdx.x & 7)) >> 3), xc_ = (int)(((long)T_ * ((blockIdx.x & 7) + 1)) >> 3) - xb_; const int st_ = (int)(gridDim.x >> 3);
        bool pre_ = false;
        for (int q_ = blockIdx.x >> 3; q_ < xc_; q_ += st_) {
          const int tile = xb_ + q_; const bool hn_ = q_ + st_ < xc_; const int nt_ = tile + st_;
          gemm_tile_128_glds_x(xn, DM, wT, 1024, 1024, tile / 21, tile % 21, smem, EpiStoreBf16{Pb, IN_COLS, IN_COLS}, pre_, hn_ ? nt_ / 21 : -1, hn_ ? nt_ % 21 : 0);
          pre_ = hn_;
        }
      }
    }
    DIL_END(2) }
    GRID_BARRIER();
    { DIL_BEGIN(3)
    PH(3) {
      KP_DECL; char* ws = kp_->ws; const int t = tid_opaque(); (void)t;
      PrepW pw{WS_PTR(bf16_t, WO.wqbT) + (long)l * 384 * 256, WS_PTR(bf16_t, WO.wkvbT) + (long)l * 512 * 128, WS_PTR(bf16_t, WO.w2T) + (long)l * 2 * 384 * 64,
               WS_PTR(bf16_t, WO.a2T) + (long)l * 2 * 384 * 64, WS_PTR(bf16_t, WO.g2T) + (long)l * 384 * 192, I.rw_mu + (long)l * 2 * RWC, I.rw_w0 + l * 768, I.rw_a0 + l * 768};
      PrepBuf pb{WS_PTR(bf16_t, WO.Pb), WS_PTR(bf16_t, WO.tq), WS_PTR(bf16_t, WO.tkv), WS_PTR(bf16_t, WO.a_b), WS_PTR(bf16_t, WO.g_b), WS_PTR(float, WO.w_f)};
      XCD_TILE_LOOP(tile, TM * 14) prep_gemm_item(pw, pb, tile / 14, tile % 14, smem);
#ifdef PH3_TWICE
      XCD_TILE_LOOP(tile, TM * 22) prep_gemm_tile(pw, pb, tile / 22, tile % 22, smem);
#endif
    }
    DIL_END(3) }
    GRID_BARRIER();
    { DIL_BEGIN(4)
    PH(4) {
      KP_DECL; char* ws = kp_->ws; const int t = tid_opaque(); (void)t;
      FinW2 fw{I.mla_qk_g + l * 192, I.gqa_qk_g + l * 128, I.rw_mu + (long)l * 2 * RWC, I.rw_k_k + l * 384, I.rw_k_a + l * 384, WS_PTR(float, WO.rope_g), WS_PTR(float, WO.rope_m)};
      FinBuf fb{WS_PTR(bf16_t, WO.Pb), WS_PTR(bf16_t, WO.tq), WS_PTR(bf16_t, WO.tkv), WS_PTR(bf16_t, WO.a_b), WS_PTR(bf16_t, WO.mq), WS_PTR(bf16_t, WO.mk), WS_PTR(bf16_t, WO.mvT),
                WS_PTR(bf16_t, WO.gq), WS_PTR(bf16_t, WO.gk), WS_PTR(bf16_t, WO.gvT), WS_PTR(bf16_t, WO.r_b), WS_PTR(bf16_t, WO.v_b), WS_PTR(bf16_t, WO.kk_b), WS_PTR(bf16_t, WO.kd_b), WS_PTR(bf16_t, WO.bd_b)};
      for (int tile = blockIdx.x; tile < NROWS / 8; tile += gridDim.x) prep_finish_tile2(fw, fb, tile, smem);
      if (blockIdx.x == gridDim.x - 1 && t < 64) { attn_score_bound(I.mla_qk_g + l * 192, 96, 9.79795897f, (float*)(ws + 16384) + l * 4, t); attn_score_bound(I.gqa_qk_g + l * 128, 64, 8.f, (float*)(ws + 16384) + l * 4 + 1, t); }
    }
    DIL_END(4) }
    GRID_BARRIER();
    { unsigned long long dil_t0 = 0, dil_scan = 0; if (DIL_PH == 5 || DIL_PH == 11) dil_t0 = __builtin_amdgcn_s_memrealtime();
    PH(5) {
      {
        KP_DECL; char* ws = kp_->ws; const int tp = tid_opaque();
        const int njobs = BATCH * 12 * (RB / CS_L);
        for (int job = (int)blockIdx.x * 4 + (tp >> 6); job < njobs; job += (int)gridDim.x * 4)
          rw_chunk_inverse(WS_PTR(bf16_t, WO.kk_b), WS_PTR(bf16_t, WO.bd_b), WS_PTR(float, WO.w_f), WS_PTR(bf16_t, MINV_OFF), job, (long)MA * 384, smem + (tp >> 6) * CSP_WAVE_BYTES, tp & 63);
      }
      GRID_BARRIER();
      KP_DECL; char* ws = kp_->ws; const int t = tid_opaque(); (void)t;
      int* s_item = (int*)(smem + MEGA_LDS_BYTES - 16);
      unsigned* sctr = (unsigned*)ws + XB_QUEUE(4 + l);
      auto scan_loop = [&]() __attribute__((always_inline)) {
        for (;;) {
          __syncthreads();
          if (tid_opaque() == 0) *s_item = (int)xb_add(sctr, 1u);
          __syncthreads();
          const int it = *s_item;
          if (it >= BATCH * 12) break;
          rw_scan_chunked(WS_PTR(bf16_t, WO.r_b), WS_PTR(bf16_t, WO.v_b), WS_PTR(bf16_t, WO.kk_b), WS_PTR(bf16_t, WO.kd_b), WS_PTR(bf16_t, WO.bd_b), WS_PTR(float, WO.w_f), WS_PTR(float, WO.Pb),
                          it, (long)MA * 384, smem, WS_PTR(bf16_t, MINV_OFF));
        }
      };
      if (scan_role) scan_loop();
#if DIL_PH == 11
      dil_scan = __builtin_amdgcn_s_memrealtime() - dil_t0;
#endif
#ifdef SPLIT5
      GRID_BARRIER();
#endif
      const int nqt = l == 0 ? 18 : 16; const int n_mla = BATCH * 4 * nqt, n_all = BATCH * 10 * nqt;
      unsigned* qctr = (unsigned*)ws + XB_QUEUE(l);
      for (;;) {
        __syncthreads();
        if (tid_opaque() == 0) *s_item = (int)xb_add(qctr, 1u);
        __syncthreads();
        const int it = *s_item;
        if (it >= n_all) break;
        const KARG_AS MegaP* kp2_ = (const KARG_AS MegaP*)__builtin_amdgcn_kernarg_segment_ptr(); LAUNDER_S(kp2_); char* ws2 = kp2_->ws;
        if (it < n_mla) { int qt = it / (BATCH * 4), r = it % (BATCH * 4);
          attn_block<96>((const bf16_t*)(ws2 + WO.mq), 4, (const bf16_t*)(ws2 + WO.mk), 4, (const bf16_t*)(ws2 + WO.mvT), 1, (bf16_t*)(ws2 + WO.tq), 0, r / 4, r % 4, qt, smem, (const float*)(ws2 + 16384) + l * 4); }
        else { int v = it - n_mla; int qt = v / (BATCH * 6), r = v % (BATCH * 6);
          attn_block<64>((const bf16_t*)(ws2 + WO.gq), 6, (const bf16_t*)(ws2 + WO.gk), 2, (const bf16_t*)(ws2 + WO.gvT), 3, (bf16_t*)(ws2 + WO.tq), 640, r / 6, r % 6, qt, smem, (const float*)(ws2 + 16384) + l * 4 + 1); }
      }
      if (!scan_role) scan_loop();
      {
        unsigned* cctr = (unsigned*)ws + XB_QUEUE(2 + l);
        for (;;) {
          __syncthreads();
          if (tid_opaque() == 0) *s_item = (int)xb_add(cctr, 1u);
          __syncthreads();
          const int it = *s_item;
          if (it >= 512) break;
          const int tab = it >> 8, r0 = (it & 255) * 64;
          if (tab == 0) ph_cvt_fp8_rows(I.pe_u + (long)l * 16384 * DM, WS_PTR(unsigned char, TAB_U), WS_PTR(float, TAB_SU), r0, r0 + 64);
          else ph_cvt_fp8_rows(I.pe_v + (long)l * 16384 * DM, WS_PTR(unsigned char, TAB_V), WS_PTR(float, TAB_SV), r0, r0 + 64);
        }
      }
    }
#if DIL_PH == 11
    GRID_BARRIER(); if (blockIdx.x == 0 && threadIdx.x == 0) { unsigned long long t1 = __builtin_amdgcn_s_memrealtime(); unsigned long long dt = dil_scan * DIL_MULT; while (__builtin_amdgcn_s_memrealtime() - t1 < dt) __builtin_amdgcn_s_sleep(32); }
#endif
    (void)dil_scan;
    DIL_END(5) }
    GRID_BARRIER();
    { DIL_BEGIN(6)
    PH(6) {
      KP_DECL; char* ws = kp_->ws; const int t = tid_opaque(); (void)t;
      RdW rw{I.rw_r_k + l * 384, I.rw_ln_g + l * 384, I.rw_ln_b + l * 384};
ph_readout(rw, WS_PTR(float, WO.Pb), WS_PTR(bf16_t, WO.r_b), WS_PTR(bf16_t, WO.v_b), WS_PTR(bf16_t, WO.kd_b), WS_PTR(bf16_t, WO.g_b), WS_PTR(bf16_t, WO.tq), l != 0);
    }
    DIL_END(6) }
    GRID_BARRIER();
    { DIL_BEGIN(7)
    PH(7) {
      KP_DECL; char* ws = kp_->ws; const int t = tid_opaque(); (void)t;
      const bf16_t* mix = WS_PTR(bf16_t, WO.tq); const bf16_t* wT = WS_PTR(bf16_t, WO.w_outT) + (long)l * 1024 * 1024; float* xs = WS_PTR(float, WO.xs);
      const float* modl = WS_PTR(float, WO.mod) + (long)l * (BATCH + 1) * 6144;
      const int TM7 = l == 0 ? TM : BATCH * 16;
      {
        const int T_ = TM7 * 8; const int xb_ = (int)(((long)T_ * (blockIdx.x & 7)) >> 3), xc_ = (int)(((long)T_ * ((blockIdx.x & 7) + 1)) >> 3) - xb_; const int st_ = (int)(gridDim.x >> 3);
        bool pre_ = false;
        for (int q_ = blockIdx.x >> 3; q_ < xc_; q_ += st_) {
          const int tile = xb_ + q_; const bool hn_ = q_ + st_ < xc_; const int nt_ = tile + st_;
          gemm_tile_128_glds_x(mix, DM, wT, 1024, 1024, l == 0 ? tile / 8 : LAT_TM(tile / 8), tile % 8, smem, EpiResid{xs, modl, 2, 0, l == 0 ? I.x : (const float*)nullptr, I.ctx},
                               pre_, hn_ ? (l == 0 ? nt_ / 8 : LAT_TM(nt_ / 8)) : -1, hn_ ? nt_ % 8 : 0);
          pre_ = hn_;
        }
      }
    }
    DIL_END(7) }
    GRID_BARRIER();
    { DIL_BEGIN(8)
    PH(8) {
      KP_DECL; char* ws = kp_->ws; const int t = tid_opaque(); (void)t;
      ph_norm_mod(WS_PTR(float, WO.xs), I.norm_ffn_g + l * DM, WS_PTR(float, WO.mod) + (long)l * (BATCH + 1) * 6144, 3, WS_PTR(bf16_t, WO.xn), l != 0);
    }
    DIL_END(8) }
    GRID_BARRIER();
    { DIL_BEGIN(9)
    PH(9) {
      KP_DECL; char* ws = kp_->ws; const int t = tid_opaque(); (void)t;
      const bf16_t* xn = WS_PTR(bf16_t, WO.xn); const bf16_t* wT = WS_PTR(bf16_t, WO.wqT) + (long)l * 2048 * 1024; const bf16_t* kb = WS_PTR(bf16_t, WO.keysb) + (long)l * 16 * 128 * 128;
      unsigned* top1 = WS_PTR(unsigned, WO.tq);
      const int TM9 = l == 0 ? TM : BATCH * 16;
      XCD_TILE_LOOP(tile, TM9 * 16) { peer_q_top1_tile(xn, wT, kb, top1, l == 0 ? tile / 16 : LAT_TM(tile / 16), tile % 16, smem); __syncthreads(); }
    }
    DIL_END(9) }
    GRID_BARRIER();
    { DIL_BEGIN(10)
    PH(10) {
      KP_DECL; char* ws = kp_->ws; const int t = tid_opaque(); (void)t;
      const float* modl = WS_PTR(float, WO.mod) + (long)l * (BATCH + 1) * 6144;
      const int ntok10 = l == 0 ? NROWS : BATCH * SEQ;
      {
        const int per_block10 = (ntok10 + (int)gridDim.x - 1) / (int)gridDim.x;
#define PH10_RUN(NT_) do { const int npass10 = (per_block10 + 4 * (NT_) - 1) / (4 * (NT_)); const bool fused10 = npass10 <= 3; \
        if (!fused10) peer_lists_build3<NT_>(WS_PTR(unsigned, WO.tq), WS_PTR(float, TAB_SU), WS_PTR(float, TAB_SV), WS_PTR(char, WO.mq), ntok10, smem); \
        for (int ps = 0; ps < npass10; ++ps) { \
          if (fused10) peer_lists_build3<NT_>(WS_PTR(unsigned, WO.tq), WS_PTR(float, TAB_SU), WS_PTR(float, TAB_SV), WS_PTR(char, WO.mq), ntok10, smem, ps, ps + 1, true, WS_PTR(bf16_t, WO.xn)); \
          peer_gather_sweep3<NT_>(WS_PTR(bf16_t, WO.xn), WS_PTR(char, WO.mq), WS_PTR(unsigned char, TAB_U), WS_PTR(unsigned char, TAB_V), modl, WS_PTR(float, WO.xs), ntok10, smem, \
                         I.norm_mix_g + (l == 0 ? DM : 0), WS_PTR(float, WO.mod) + (long)(l == 0 ? 1 : 0) * (BATCH + 1) * 6144, WS_PTR(bf16_t, WO.xn), l == 0 ? (float*)nullptr : kp_->out, ps, ps + 1, fused10); \
        } } while (0)
        if ((per_block10 & 15) == 0) PH10_RUN(4); else PH10_RUN(3);
#undef PH10_RUN
      }
    }
    DIL_END(10) }
    GRID_BARRIER();
  }
}

extern "C" void kernel_launch(void* const* d_in, const int* in_sizes, int n_in, void* d_out, int out_size, void* d_ws, size_t ws_size,
                              hipStream_t stream) {
  MegaP p{};
  const float** pp = (const float**)&p.in;
  for (int i = 0; i < 31; ++i) pp[i] = (const float*)d_in[i];
  p.ws = (char*)d_ws; p.out = (float*)d_out;
  if (WO.total > ws_size) return;
  static int grid_blocks = 0;
  if (!grid_blocks) {
    int dev = 0, cus = 0, per_cu = 0;
    hipGetDevice(&dev);
    hipDeviceGetAttribute(&cus, hipDeviceAttributeMultiprocessorCount, dev);
    hipOccupancyMaxActiveBlocksPerMultiprocessor(&per_cu, mega_kernel, 256, 0);
    if (per_cu > 2) per_cu = 2;
    if (per_cu < 1) per_cu = 1;
    grid_blocks = cus * per_cu;
  }
  hipMemsetAsync(d_ws, 0, 32768, stream);
  void* args[] = {&p};
  hipLaunchCooperativeKernel((void*)mega_kernel, dim3(grid_blocks), dim3(256), args, 0, stream);
}
```
